# Optimizing an MI355X kernel written in HIP

```python
import math
import jax, jax.numpy as jnp
from jax import lax
import numpy as np

D_MODEL = 1024
BATCH = 4
SEQ = 8192
DEPTH = 4

N_MEM = 256
A_HEADS = 8
A_HEAD_DIM = 64
A_WIDTH = A_HEADS * A_HEAD_DIM
KV_RANK = 128
IDX_HEADS = 8
IDX_DIM = 32
TOPK_MAX = 256
Q_BLOCK = 128
POOL_WINDOWS = (2, 4, 8, 16)
N_POOL_GROUPS = 4
POOL_GROUP = 64
POOL_WIDTH = N_POOL_GROUPS * POOL_GROUP
C_HEADS = 4
C_HEAD_DIM = 64
C_WIDTH = C_HEADS * C_HEAD_DIM
N_BRANCH = 3
REL_BUCKETS = 32
REL_MAX_DIST = 128
D_FF = 2816
EPS = 1e-6
NEG = -1e30

IN_SPLITS = (A_WIDTH, KV_RANK, IDX_HEADS * IDX_DIM, IDX_DIM, IDX_HEADS,
             POOL_WIDTH, C_WIDTH, N_BRANCH * D_MODEL)
IN_WIDTH = sum(IN_SPLITS)

kernel_name = "hybrid_dsa_pool_memattn_macaron"


def _split_points(sizes):
    pts, acc = [], 0
    for s in sizes[:-1]:
        acc += s
        pts.append(acc)
    return pts


def rmsnorm(x, g):
    xf = x.astype(jnp.float32)
    y = xf * lax.rsqrt(jnp.mean(xf * xf, axis=-1, keepdims=True) + EPS)
    return (y * g.astype(jnp.float32)).astype(x.dtype)


def swiglu(x, w_in, w_out):
    a, b = jnp.split(x @ w_in, 2, axis=-1)
    return (jax.nn.silu(a) * b) @ w_out


def t5_bucket(dist):
    max_exact = REL_BUCKETS // 2
    n = jnp.maximum(dist, 0)
    nf = jnp.maximum(n, 1).astype(jnp.float32)
    large = max_exact + (jnp.log(nf / max_exact) / math.log(REL_MAX_DIST / max_exact)
                         * (REL_BUCKETS - max_exact)).astype(jnp.int32)
    large = jnp.minimum(large, REL_BUCKETS - 1)
    return jnp.where(n < max_exact, n, large)


def dsa_attention(q, c_kv, iq, ik, iw, w_uk, w_uv, rel_bias):
    B, S = q.shape[0], q.shape[1]
    k_sel = min(TOPK_MAX, S // 4)
    n_blk = S // Q_BLOCK
    q_lat = jnp.einsum('bshd,rhd->bshr', q, w_uk)
    key_pos = jnp.arange(S)
    scale = A_HEAD_DIM ** -0.5
    idx_scale = IDX_DIM ** -0.5
    w_scale = IDX_HEADS ** -0.5

    def block(i):
        start = i * Q_BLOCK
        qp = start + jnp.arange(Q_BLOCK)
        iq_b = lax.dynamic_slice_in_dim(iq, start, Q_BLOCK, axis=1)
        iw_b = lax.dynamic_slice_in_dim(iw, start, Q_BLOCK, axis=1)
        ql_b = lax.dynamic_slice_in_dim(q_lat, start, Q_BLOCK, axis=1)
        dots = jax.nn.relu(jnp.einsum('bqhd,bkd->bqhk', iq_b, ik) * idx_scale)
        score = jnp.einsum('bqh,bqhk->bqk', iw_b * w_scale, dots).astype(jnp.float32)
        causal = key_pos[None, :] <= qp[:, None]
        score = jnp.where(causal[None], score, -jnp.inf)
        _, idx = lax.top_k(score, k_sel)
        valid = idx <= qp[None, :, None]
        c_sel = jax.vmap(lambda c, j: c[j])(c_kv, idx)
        logits = jnp.einsum('bqhr,bqkr->bqhk', ql_b, c_sel).astype(jnp.float32) * scale
        bias = rel_bias[t5_bucket(qp[None, :, None] - idx)]
        logits = logits + jnp.transpose(bias, (0, 1, 3, 2)).astype(jnp.float32)
        logits = jnp.where(valid[:, :, None, :], logits, NEG)
        p = jax.nn.softmax(logits, axis=-1).astype(c_sel.dtype)
        o_lat = jnp.einsum('bqhk,bqkr->bqhr', p, c_sel)
        return jnp.einsum('bqhr,rhd->bqhd', o_lat, w_uv)

    out = lax.map(block, jnp.arange(n_blk))
    return jnp.moveaxis(out, 0, 1).reshape(B, S, A_WIDTH)


def pool_mixer(z, w_pool, pool_scale):
    B, S, C = z.shape
    zf = z.astype(jnp.float32)
    cs = jnp.cumsum(zf, axis=1)
    wmax = max(POOL_WINDOWS)
    cs_pad = jnp.pad(cs, ((0, 0), (wmax, 0), (0, 0)))
    pos = jnp.arange(1, S + 1, dtype=jnp.float32)
    outs = []
    for g, w in enumerate(POOL_WINDOWS):
        lo, hi = g * POOL_GROUP, (g + 1) * POOL_GROUP
        win_sum = cs[:, :, lo:hi] - cs_pad[:, wmax - w: wmax - w + S, lo:hi]
        count = jnp.minimum(pos, float(w))[None, :, None]
        pooled = win_sum / count - zf[:, :, lo:hi]
        outs.append(jnp.einsum('bsc,cd->bsd', pooled.astype(z.dtype), w_pool[g]))
    return jnp.concatenate(outs, axis=-1) * pool_scale


def mem_attention(qc, mem_n, w_mem_kv):
    B, S = qc.shape[0], qc.shape[1]
    M = mem_n.shape[1]
    k, v = jnp.split(mem_n @ w_mem_kv, 2, axis=-1)
    q = qc.reshape(B, S, C_HEADS, C_HEAD_DIM)
    k = k.reshape(B, M, C_HEADS, C_HEAD_DIM)
    v = v.reshape(B, M, C_HEADS, C_HEAD_DIM)
    logits = jnp.einsum('bshd,bmhd->bhsm', q, k).astype(jnp.float32) * C_HEAD_DIM ** -0.5
    p = jax.nn.softmax(logits, axis=-1).astype(v.dtype)
    return jnp.einsum('bhsm,bmhd->bshd', p, v).reshape(B, S, C_WIDTH)


def setup_inputs(seed: int = 0) -> dict:
    key = jax.random.key(seed)
    ks = jax.random.split(key, 24)
    f32 = jnp.float32
    L = DEPTH

    def nrm(k, shape, fan_in):
        return jax.random.normal(k, shape, f32) * fan_in ** -0.5

    def gain(k, shape):
        return 1.0 + 0.05 * jax.random.normal(k, shape, f32)

    return {
        "x": jax.random.normal(ks[0], (BATCH, SEQ, D_MODEL), f32),
        "mem": jax.random.normal(ks[1], (BATCH, N_MEM, D_MODEL), f32),
        "rel_bias": 0.5 * jax.random.normal(ks[2], (REL_BUCKETS, A_HEADS), f32),
        "ffn1_norm": gain(ks[3], (L, D_MODEL)),
        "ffn1_w_in": nrm(ks[4], (L, D_MODEL, 2 * D_FF), D_MODEL),
        "ffn1_w_out": nrm(ks[5], (L, D_FF, D_MODEL), D_FF),
        "mix_norm": gain(ks[6], (L, D_MODEL)),
        "w_in": nrm(ks[7], (L, D_MODEL, IN_WIDTH), D_MODEL),
        "kv_norm": gain(ks[8], (L, KV_RANK)),
        "w_uk": nrm(ks[9], (L, KV_RANK, A_HEADS, A_HEAD_DIM), KV_RANK),
        "w_uv": nrm(ks[10], (L, KV_RANK, A_HEADS, A_HEAD_DIM), KV_RANK),
        "w_pool": nrm(ks[11], (L, N_POOL_GROUPS, POOL_GROUP, POOL_GROUP), POOL_GROUP),
        "pool_scale": gain(ks[12], (L, POOL_WIDTH)),
        "mem_norm": gain(ks[13], (L, D_MODEL)),
        "w_mem_kv": nrm(ks[14], (L, D_MODEL, 2 * C_WIDTH), D_MODEL),
        "w_branch_a": nrm(ks[15], (L, A_WIDTH, D_MODEL), A_WIDTH),
        "w_branch_b": nrm(ks[16], (L, POOL_WIDTH, D_MODEL), POOL_WIDTH),
        "w_branch_c": nrm(ks[17], (L, C_WIDTH, D_MODEL), C_WIDTH),
        "w_out": nrm(ks[18], (L, D_MODEL, D_MODEL), D_MODEL),
        "ffn2_norm": gain(ks[19], (L, D_MODEL)),
        "ffn2_w_in": nrm(ks[20], (L, D_MODEL, 2 * D_FF), D_MODEL),
        "ffn2_w_out": nrm(ks[21], (L, D_FF, D_MODEL), D_FF),
        "final_norm": gain(ks[22], (D_MODEL,)),
    }


def reference(x, mem, rel_bias, ffn1_norm, ffn1_w_in, ffn1_w_out, mix_norm, w_in, kv_norm,
              w_uk, w_uv, w_pool, pool_scale, mem_norm, w_mem_kv, w_branch_a, w_branch_b,
              w_branch_c, w_out, ffn2_norm, ffn2_w_in, ffn2_w_out, final_norm):
    B, S, D = x.shape
    split_pts = _split_points(IN_SPLITS)
    h = x
    for l in range(DEPTH):
        h = h + 0.5 * swiglu(rmsnorm(h, ffn1_norm[l]), ffn1_w_in[l], ffn1_w_out[l])

        u = rmsnorm(h, mix_norm[l])
        q_a, c_kv, iq, ik, iw, z_pool, q_c, gate_pre = jnp.split(u @ w_in[l], split_pts, axis=-1)
        q_a = q_a.reshape(B, S, A_HEADS, A_HEAD_DIM)
        c_kv = rmsnorm(c_kv, kv_norm[l])
        iq = iq.reshape(B, S, IDX_HEADS, IDX_DIM)

        y_a = dsa_attention(q_a, c_kv, iq, ik, iw, w_uk[l], w_uv[l], rel_bias)
        y_b = pool_mixer(z_pool, w_pool[l], pool_scale[l])
        y_c = mem_attention(q_c, rmsnorm(mem, mem_norm[l]), w_mem_kv[l])

        g = jax.nn.sigmoid(gate_pre).reshape(B, S, N_BRANCH, D)
        merged = (g[:, :, 0] * (y_a @ w_branch_a[l])
                  + g[:, :, 1] * (y_b @ w_branch_b[l])
                  + g[:, :, 2] * (y_c @ w_branch_c[l]))
        h = h + merged @ w_out[l]

        h = h + 0.5 * swiglu(rmsnorm(h, ffn2_norm[l]), ffn2_w_in[l], ffn2_w_out[l])
    return rmsnorm(h, final_norm)
```

```cpp
#include <hip/hip_runtime.h>
#include <cstdio>
#include <cstdint>

#ifndef MK_ONE_LAUNCH
#define MK_ONE_LAUNCH 1
#endif
#ifndef EN_P0
#define EN_P0 MK_ONE_LAUNCH
#endif
#ifndef EN_PREP
#define EN_PREP MK_ONE_LAUNCH
#endif
#ifndef EN_DSA
#define EN_DSA MK_ONE_LAUNCH
#endif
#ifndef DIS_MASK
#define DIS_MASK 0
#endif
#ifndef MK_ONE_LAUNCH
#define MK_ONE_LAUNCH 1
#endif

__device__ __forceinline__ int lane_id_v() { int l; asm volatile("v_mbcnt_lo_u32_b32 %0, -1, 0\n\tv_mbcnt_hi_u32_b32 %0, -1, %0" : "=v"(l)); return l; }
namespace pg8 {
#define PG8_LAS __attribute__((address_space(3)))
typedef unsigned short bf16_t;
typedef short bf16x8 __attribute__((ext_vector_type(8)));
typedef float f32x4 __attribute__((ext_vector_type(4)));
typedef unsigned u32x4 __attribute__((ext_vector_type(4)));
typedef unsigned u32x2 __attribute__((ext_vector_type(2)));
constexpr int BM = 256, BK = 64, HALF = 128, HTB = HALF * BK * 2, STAGE_BYTES = 8 * HTB, NXCD = 8, WGM = 8;

__host__ __device__ __forceinline__ int lds_byte(int r, int c) { const int st = (r >> 4) * 2 + (c >> 5), rr = r & 15, cc = c & 31, ob = rr * 64 + cc * 2; return st * 1024 + (ob ^ (((ob >> 9) & 1) << 5)); }
__host__ __device__ __forceinline__ void stage_rc(int b, int& R, int& C) { const int st = b / 1024, sb = b % 1024, swz = sb ^ (((sb >> 9) & 1) << 5); R = (st >> 1) * 16 + swz / 64; C = (st & 1) * 32 + (swz % 64) / 2; }
__host__ __device__ __forceinline__ int perm32(int rho) { const int n = rho >> 4, i = rho & 15; return 8 * (i >> 2) + 4 * n + (i & 3); }

struct Unit { int pm, pn; };
struct Gemm { const bf16_t* A; const bf16_t* Bt; int M, N, K; };

struct StaticOrder {
    int nM, nN, nwg, G, c;
    __host__ __device__ void init(int M, int N, int G_, int c_) { nM = M / BM; nN = N / BM; nwg = nM * nN; G = G_; c = c_; }
    __host__ __device__ bool next(int i, Unit& u) const {
        const long L = (long)i * G + c; if (L >= nwg) return false;
        int wgid = (int)L; { const int q = nwg / NXCD, r = nwg % NXCD, xcd = wgid % NXCD, off = wgid / NXCD; wgid = (xcd < r ? xcd * (q + 1) : r * (q + 1) + (xcd - r) * q) + off; }
        const int nig = WGM * nN, gid = wgid / nig, fm = gid * WGM, gsz = (nM - fm) < WGM ? (nM - fm) : WGM;
        u.pm = fm + ((wgid % nig) % gsz); u.pn = (wgid % nig) / gsz; return true;
    }
    __device__ __forceinline__ void a_ready(const Unit&) const {}
    __device__ __forceinline__ void done(const Unit&) const {}
};

__device__ __forceinline__ unsigned cvt_pk_bf16(float lo, float hi) { unsigned r; asm volatile("v_cvt_pk_bf16_f32 %0, %1, %2" : "=v"(r) : "v"(lo), "v"(hi)); return r; }

template <class Epi, class Sched, bool ALIGN_EPI = false, bool SP2 = false>
__device__ __forceinline__ void gemm_phase(PG8_LAS unsigned char* lds, const Gemm g, const Sched& S, const Epi& E, const int wid_) {
    int wid = wid_; asm volatile("" : "+s"(wid));
    const int lane = lane_id_v(), tid = wid * 64 + lane,
              wr = wid >> 2, wc = wid & 3, fr = lane & 15, fq = lane >> 4;
    const int K = g.K, nt = K / BK;
    unsigned voffA[2], voffB[2];
#pragma unroll
    for (int i = 0; i < 2; ++i) { int R, C; stage_rc(tid * 16 + i * 8192, R, C); const int Rb = Epi::PERM ? ((R & ~31) + perm32(R & 31)) : R;
        voffA[i] = (unsigned)(R * K + C) * 2u; voffB[i] = (unsigned)(Rb * K + C) * 2u; }
    const size_t kstep = (size_t)(BK * 2);
    const size_t hstep = (size_t)HALF * K * 2;
    const size_t tstep = 2 * hstep;
    const unsigned ldsw = (unsigned)wid * 1024u;
    const int aoff = lds_byte(wr * 64 + fr, fq * 8), boff = lds_byte(wc * 32 + fr, fq * 8);
#define PG8_SA(b, h) (((b) * 2 + (h)) * HTB)
#define PG8_SB(b, h) ((4 + (b) * 2 + (h)) * HTB)
#define PG8_STAGE(bufoff, gbase, voff) do { _Pragma("unroll") for (int _i = 0; _i < 2; ++_i) \
        __builtin_amdgcn_global_load_lds((const unsigned*)((const char*)(gbase) + (voff)[_i]), (PG8_LAS unsigned*)(lds + (bufoff) + ldsw + _i * 8192), 16, 0, 0); } while (0)
#define PG8_LDA(dst, b, h) do { _Pragma("unroll") for (int m = 0; m < 4; ++m) _Pragma("unroll") for (int k = 0; k < 2; ++k) dst[m][k] = *(const PG8_LAS bf16x8*)(lds + PG8_SA(b, h) + aoff + m * 2048 + k * 1024); } while (0)
#define PG8_LDB(dst, b, h) do { _Pragma("unroll") for (int n = 0; n < 2; ++n) _Pragma("unroll") for (int k = 0; k < 2; ++k) dst[n][k] = *(const PG8_LAS bf16x8*)(lds + PG8_SB(b, h) + boff + n * 2048 + k * 1024); } while (0)
#define PG8_MMA(ai, bj, At, Bt) do { __builtin_amdgcn_s_setprio(1); _Pragma("unroll") for (int m = 0; m < 4; ++m) _Pragma("unroll") for (int n = 0; n < 2; ++n) _Pragma("unroll") for (int k = 0; k < 2; ++k) \
        acc[ai][bj][m][n] = __builtin_amdgcn_mfma_f32_16x16x32_bf16(Bt[n][k], At[m][k], acc[ai][bj][m][n], 0, 0, 0); __builtin_amdgcn_s_setprio(0); } while (0)
#define PG8_WAIT_V(n) asm volatile("s_waitcnt vmcnt(" #n ")" ::: "memory")
#define PG8_WAIT_L(n) asm volatile("s_waitcnt lgkmcnt(" #n ")" ::: "memory")
#define PG8_BAR __builtin_amdgcn_s_barrier()
#define PG8_SCHED __builtin_amdgcn_sched_barrier(0)
    Unit cur, nxt; int ui = 0;
    if (!S.next(0, cur)) return;
    f32x4 acc[2][2][4][2];
#pragma unroll
    for (int a = 0; a < 2; ++a)
#pragma unroll
        for (int b = 0; b < 2; ++b)
#pragma unroll
            for (int m = 0; m < 4; ++m)
#pragma unroll
                for (int n = 0; n < 2; ++n) acc[a][b][m][n] = (f32x4){0.f, 0.f, 0.f, 0.f};
    bf16x8 At[4][2], B0[2][2], B1[2][2];
    const char* cA = (const char*)g.A + (size_t)cur.pm * tstep; const char* cB = (const char*)g.Bt + (size_t)cur.pn * tstep;
    S.a_ready(cur);
    if constexpr (SP2) {
        PG8_STAGE(PG8_SB(0, 0), cB, voffB); PG8_STAGE(PG8_SB(0, 1), cB + hstep, voffB); PG8_STAGE(PG8_SA(0, 0), cA, voffA); PG8_STAGE(PG8_SA(0, 1), cA + hstep, voffA);
        if (wr == 1) PG8_BAR;
        PG8_WAIT_V(2); PG8_BAR;
        PG8_STAGE(PG8_SB(1, 0), cB + kstep, voffB); PG8_STAGE(PG8_SA(1, 0), cA + kstep, voffA); PG8_STAGE(PG8_SB(1, 1), cB + hstep + kstep, voffB);
        PG8_WAIT_V(6); PG8_BAR;
    } else {
        PG8_STAGE(PG8_SB(0, 0), cB, voffB); PG8_STAGE(PG8_SA(0, 0), cA, voffA); PG8_STAGE(PG8_SB(0, 1), cB + hstep, voffB); PG8_STAGE(PG8_SA(0, 1), cA + hstep, voffA);
        if (wr == 1) PG8_BAR;
        PG8_WAIT_V(4); PG8_BAR;
        PG8_STAGE(PG8_SB(1, 0), cB + kstep, voffB); PG8_STAGE(PG8_SA(1, 0), cA + kstep, voffA); PG8_STAGE(PG8_SB(1, 1), cB + hstep + kstep, voffB);
        PG8_WAIT_V(6); PG8_BAR;
    }
    for (;;) {
        const bool has_next = S.next(ui + 1, nxt);
        const char* nA = has_next ? (const char*)g.A + (size_t)nxt.pm * tstep : cA; const char* nB = has_next ? (const char*)g.Bt + (size_t)nxt.pn * tstep : cB;
        for (int t = 0; t < nt; t += 2) {
            const bool last = (t == nt - 2);
            const char* a1 = cA + (size_t)(t + 1) * kstep;
            const char* a2 = last ? nA : cA + (size_t)(t + 2) * kstep; const char* b2 = last ? nB : cB + (size_t)(t + 2) * kstep;
            const char* a3 = a2 + kstep; const char* b3 = b2 + kstep;
            if (last && has_next) S.a_ready(nxt);
            if constexpr (SP2) {
            PG8_LDB(B0, 0, 0); PG8_LDB(B1, 0, 1); PG8_SCHED; PG8_LDA(At, 0, 0); PG8_STAGE(PG8_SA(1, 1), a1 + hstep, voffA);
            PG8_WAIT_V(8); PG8_WAIT_L(0); PG8_BAR; PG8_MMA(0, 0, At, B0); PG8_MMA(0, 1, At, B1); PG8_BAR; PG8_SCHED;
            PG8_LDA(At, 0, 1); PG8_STAGE(PG8_SB(0, 0), b2, voffB); PG8_STAGE(PG8_SB(0, 1), b2 + hstep, voffB); PG8_STAGE(PG8_SA(0, 0), a2, voffA);
            PG8_WAIT_V(8); PG8_WAIT_L(0); PG8_BAR; PG8_MMA(1, 0, At, B0); PG8_MMA(1, 1, At, B1); PG8_BAR; PG8_SCHED;
            PG8_LDB(B0, 1, 0); PG8_LDB(B1, 1, 1); PG8_SCHED; PG8_LDA(At, 1, 0); PG8_STAGE(PG8_SA(0, 1), a2 + hstep, voffA);
            PG8_WAIT_V(8); PG8_WAIT_L(0); PG8_BAR; PG8_MMA(0, 0, At, B0); PG8_MMA(0, 1, At, B1); PG8_BAR; PG8_SCHED;
            PG8_LDA(At, 1, 1); PG8_STAGE(PG8_SB(1, 0), b3, voffB); PG8_STAGE(PG8_SB(1, 1), b3 + hstep, voffB); PG8_STAGE(PG8_SA(1, 0), a3, voffA);
            PG8_WAIT_V(8); PG8_WAIT_L(0); PG8_BAR; PG8_MMA(1, 0, At, B0); PG8_MMA(1, 1, At, B1); PG8_BAR; PG8_SCHED;
            } else {
            PG8_LDB(B0, 0, 0); PG8_SCHED; PG8_LDA(At, 0, 0); PG8_STAGE(PG8_SA(1, 1), a1 + hstep, voffA);
            PG8_WAIT_L(8); PG8_BAR; PG8_WAIT_L(0); PG8_MMA(0, 0, At, B0); PG8_BAR; PG8_SCHED;
            PG8_LDB(B1, 0, 1); PG8_STAGE(PG8_SB(0, 0), b2, voffB);
            PG8_BAR; PG8_WAIT_L(0); PG8_MMA(0, 1, At, B1); PG8_BAR;
            PG8_LDA(At, 0, 1); PG8_STAGE(PG8_SA(0, 0), a2, voffA);
            PG8_BAR; PG8_WAIT_L(0); PG8_MMA(1, 0, At, B0); PG8_BAR; PG8_SCHED;
            PG8_STAGE(PG8_SB(0, 1), b2 + hstep, voffB);
            PG8_WAIT_V(6); PG8_BAR; PG8_MMA(1, 1, At, B1); PG8_BAR;
            PG8_LDB(B0, 1, 0); PG8_SCHED; PG8_LDA(At, 1, 0); PG8_STAGE(PG8_SA(0, 1), a2 + hstep, voffA);
            PG8_WAIT_L(8); PG8_BAR; PG8_WAIT_L(0); PG8_MMA(0, 0, At, B0); PG8_BAR; PG8_SCHED;
            PG8_LDB(B1, 1, 1); PG8_STAGE(PG8_SB(1, 0), b3, voffB);
            PG8_BAR; PG8_WAIT_L(0); PG8_MMA(0, 1, At, B1); PG8_BAR;
            PG8_LDA(At, 1, 1); PG8_STAGE(PG8_SA(1, 0), a3, voffA);
            PG8_BAR; PG8_WAIT_L(0); PG8_MMA(1, 0, At, B0); PG8_BAR; PG8_SCHED;
            PG8_STAGE(PG8_SB(1, 1), b3 + hstep, voffB);
            PG8_WAIT_V(6); PG8_BAR; PG8_MMA(1, 1, At, B1); PG8_BAR;
            }
        }
        if constexpr (ALIGN_EPI) { if (wr == 0) PG8_BAR; }
        E(acc, cur, wr, wc, fr, fq); S.done(cur);
        if (!has_next) break;
#pragma unroll
        for (int a = 0; a < 2; ++a)
#pragma unroll
            for (int b = 0; b < 2; ++b)
#pragma unroll
                for (int m = 0; m < 4; ++m)
#pragma unroll
                    for (int n = 0; n < 2; ++n) acc[a][b][m][n] = (f32x4){0.f, 0.f, 0.f, 0.f};
        cur = nxt; cA = nA; cB = nB; ++ui;
        if constexpr (ALIGN_EPI) { if (wr == 1) PG8_BAR; }
    }
    PG8_WAIT_V(0);
    if constexpr (!ALIGN_EPI) { if (wr == 0) PG8_BAR; }
    PG8_BAR;
#undef PG8_SA
#undef PG8_SB
#undef PG8_STAGE
#undef PG8_LDA
#undef PG8_LDB
#undef PG8_MMA
#undef PG8_WAIT_V
#undef PG8_WAIT_L
#undef PG8_BAR
#undef PG8_SCHED
}
}

constexpr int NWAVES = 8;
constexpr int BATCH = 4, SEQ = 8192, D = 1024, DEPTH = 4, M = BATCH * SEQ;
constexpr int NMEM = 256, MROWS = BATCH * NMEM;
constexpr int AH = 8, AHD = 64, AW = 512, KVR = 128, IH = 8, IDIM = 32, TOPK = 256;
constexpr int PW_ = 256, CH = 4, CHD = 64, CW = 256;
constexpr int DFF = 2816, INW = 4520, INP = 4608;
constexpr float EPS = 1e-6f;
constexpr int C_QA = 0, C_CKV = 512, C_IQ = 640, C_IK = 896, C_IW = 928, C_Z = 936, C_QC = 1192, C_G = 1448;

constexpr size_t MiB = 1u << 20;
constexpr size_t WS_CTL = 0, CTL_ZERO_BYTES = 1 * MiB;
constexpr size_t WS_SS = 1 * MiB;
constexpr size_t WS_IW = 3 * MiB;
constexpr size_t WS_SGN = 4 * MiB;
constexpr size_t WS_MEMN = 5 * MiB;
constexpr size_t WS_WMEM = 7 * MiB;
constexpr size_t WS_MEMKV = 11 * MiB;
constexpr size_t WS_WUKT = 15 * MiB;
constexpr size_t WS_W1IN = 16 * MiB, WS_W1OUT = 27 * MiB, WS_WIN = 33 * MiB, WS_WA = 42 * MiB, WS_WB = 43 * MiB, WS_WC = 43 * MiB + 512 * 1024, WS_WOUT = 44 * MiB, WS_W2IN = 46 * MiB, WS_W2OUT = 57 * MiB;
constexpr size_t WS_HB = 64 * MiB;
constexpr size_t WS_ACT = 128 * MiB;
constexpr size_t WS_G = 128 * MiB;
constexpr size_t WS_QA = 320 * MiB;
constexpr size_t WS_CKV = 352 * MiB;
constexpr size_t WS_CKVRAW = 360 * MiB;
constexpr size_t WS_IQRAW = 376 * MiB;
constexpr size_t WS_IQF = 392 * MiB;
constexpr size_t WS_IK = 408 * MiB;
constexpr size_t WS_Z = 410 * MiB;
constexpr size_t WS_MERGED = 352 * MiB;
constexpr size_t WS_YB = 426 * MiB;
constexpr size_t WS_QC = 442 * MiB;
constexpr size_t WS_END = 458 * MiB;
constexpr int CW_BAR = 4096;

constexpr int RING_OFF = 0, RING_BYTES = 131072;
constexpr int LDS_BYTES = 155648;
constexpr int MISC_OFF = LDS_BYTES - 256;

#define GAS __attribute__((address_space(1)))
#define LAS __attribute__((address_space(3)))
typedef unsigned short bf16;
typedef unsigned v4u __attribute__((ext_vector_type(4)));
typedef unsigned v2u __attribute__((ext_vector_type(2)));
typedef float f32x4 __attribute__((ext_vector_type(4)));
typedef float f32x2 __attribute__((ext_vector_type(2)));
typedef GAS unsigned gu32;
#define RLX_AGENT __ATOMIC_RELAXED, __HIP_MEMORY_SCOPE_AGENT
#define LDS_WAIT() asm volatile("s_waitcnt lgkmcnt(0)" ::: "memory")
#define VM_WAIT() asm volatile("s_waitcnt vmcnt(0)" ::: "memory")
__device__ __forceinline__ unsigned f2bf(float f) { unsigned u = __builtin_bit_cast(unsigned, f); return (u + 0x7fffu + ((u >> 16) & 1u)) >> 16; }
__device__ __forceinline__ unsigned pk2(float lo, float hi) { return f2bf(lo) | (f2bf(hi) << 16); }
__device__ __forceinline__ float bflo(unsigned w) { return __builtin_bit_cast(float, w << 16); }
__device__ __forceinline__ float bfhi(unsigned w) { return __builtin_bit_cast(float, w & 0xffff0000u); }
__device__ __forceinline__ float bf2f(bf16 b) { return __builtin_bit_cast(float, ((unsigned)b) << 16); }

#define XB_TMO      128
#define XB_XCNT(j)  (256  + 64 * (j))
#define XB_XSUB(j)  (1280 + 64 * (j))
#define XB_XGEN(j)  (2304 + 64 * (j))
#define XB_TOP      3328
#define XB_TOPGEN   3392
#define XCD_BAR_WORDS 3456
#define XB_SPIN_CAP (1u << 23)

__device__ __forceinline__ unsigned xb_ld(unsigned* p)              { return __hip_atomic_load(p, __ATOMIC_RELAXED, __HIP_MEMORY_SCOPE_AGENT); }
__device__ __forceinline__ unsigned xb_add(unsigned* p, unsigned v) { return __hip_atomic_fetch_add(p, v, __ATOMIC_RELAXED, __HIP_MEMORY_SCOPE_AGENT); }
__device__ __forceinline__ unsigned xb_xcc_id() { return (unsigned)__builtin_amdgcn_s_getreg((3 << 11) | 20) & 0xFu; }
#define XB_SPIN(cond, bar) do { unsigned _sp = 0; while (cond) { __builtin_amdgcn_s_sleep(1); \
    if ((++_sp & 255u) == 0u) { if (xb_ld(&(bar)[XB_TMO])) break; if (_sp > XB_SPIN_CAP) { atomicAdd(&(bar)[XB_TMO], 1u); break; } } } } while (0)

struct XcdBarrier { unsigned* bar; unsigned x; volatile LAS unsigned* st; int wave; };

__device__ __forceinline__ XcdBarrier xcd_barrier_post(unsigned* bar, volatile LAS unsigned* st, int wave) {
    XcdBarrier b; b.bar = bar; b.x = xb_xcc_id(); b.st = st; b.wave = wave;
    if (threadIdx.x == 0) (void)xb_add(&bar[XB_XCNT(b.x)], 1u);
    return b;
}
__device__ __forceinline__ void xcd_barrier_complete(unsigned* bar, unsigned x, unsigned& nloc, unsigned& nx) {
    const unsigned G = gridDim.x * gridDim.y * gridDim.z;
    unsigned sum, cnt, mine, sp = 0u;
    for (;;) {
        sum = 0u; cnt = 0u; mine = 0u;
#pragma unroll
        for (unsigned j = 0; j < 16; ++j) { const unsigned c = xb_ld(&bar[XB_XCNT(j)]); sum += c; cnt += (c > 0u) ? 1u : 0u; mine = (j == x) ? c : mine; }
        if (sum == G) break;
        __builtin_amdgcn_s_sleep(1);
        if ((++sp & 255u) == 0u) { if (xb_ld(&bar[XB_TMO])) break; if (sp > XB_SPIN_CAP) { atomicAdd(&bar[XB_TMO], 1u); break; } }
    }
    nloc = mine > 0u ? mine : 1u; nx = cnt > 0u ? cnt : 1u;
}
__device__ __forceinline__ void xcd_barrier(const XcdBarrier& b) {
    asm volatile("s_waitcnt vmcnt(0)" ::: "memory");
    __syncthreads();
    if (b.wave == 0 && lane_id_v() == 0) {
        unsigned* bar = b.bar;
        __builtin_amdgcn_s_waitcnt(0);
        unsigned nloc = b.st[0], nx = b.st[1];
        if (nloc == 0u) { xcd_barrier_complete(bar, b.x, nloc, nx); b.st[0] = nloc; b.st[1] = nx; }
        const unsigned old = xb_add(&bar[XB_XSUB(b.x)], 1u);
        const unsigned gen = old / nloc;
        if (old + 1u == (gen + 1u) * nloc) {
            __builtin_amdgcn_fence(__ATOMIC_RELEASE, "agent");
            asm volatile("s_waitcnt vmcnt(0)" ::: "memory");
            const unsigned og = xb_add(&bar[XB_TOP], 1u);
            const unsigned tg = og / nx;
            if (og + 1u == (tg + 1u) * nx) xb_add(&bar[XB_TOPGEN], 1u);
            else XB_SPIN(xb_ld(&bar[XB_TOPGEN]) == tg, bar);
            __builtin_amdgcn_fence(__ATOMIC_ACQUIRE, "agent");
            xb_add(&bar[XB_XGEN(b.x)], 1u);
            asm volatile("s_waitcnt vmcnt(0)" ::: "memory");
        } else {
            XB_SPIN(xb_ld(&bar[XB_XGEN(b.x)]) == gen, bar);
            __builtin_amdgcn_fence(__ATOMIC_ACQUIRE, "agent");
            asm volatile("s_waitcnt vmcnt(0)" ::: "memory");
        }
    }
    __syncthreads();
}

struct Args {
    const float* in[23]; float* out; unsigned char* ws; int ph_lo, ph_hi;
};
template <class T> __device__ __forceinline__ T* uni(T* p) { const unsigned long long v = (unsigned long long)p; const unsigned lo = __builtin_amdgcn_readfirstlane((unsigned)v), hi = __builtin_amdgcn_readfirstlane((unsigned)(v >> 32)); return (T*)(((unsigned long long)hi << 32) | lo); }
__device__ __forceinline__ LAS unsigned char* uni_l(LAS unsigned char* p) { return (LAS unsigned char*)(unsigned)__builtin_amdgcn_readfirstlane((int)(unsigned)(size_t)p); }
__device__ __forceinline__ int uni_i(int v) { return __builtin_amdgcn_readfirstlane(v); }
struct PC { const float* const* in; float* out; unsigned char* ws; LAS unsigned char* lds; int wave, vcu, G; };
struct Frame {
    LAS unsigned char* lds;
    volatile LAS unsigned* MISC;
    gu32* ctl;
    int wave, vcu, G;
    unsigned char* ws;
};
__device__ __forceinline__ unsigned char* launder_p(unsigned char* p) { asm volatile("" : "+s"(p)); return p; }
__device__ __forceinline__ int launder_s(int v) { asm volatile("" : "+s"(v)); return v; }
__device__ __forceinline__ int launder_v(int v) { asm volatile("" : "+v"(v)); return v; }
__device__ __forceinline__ float wave_sum(float v) {
#pragma unroll
    for (int o = 1; o < 64; o <<= 1) v += __shfl_xor(v, o);
    return v;
}
__device__ __forceinline__ float wave_max(float v) {
#pragma unroll
    for (int o = 1; o < 64; o <<= 1) v = fmaxf(v, __shfl_xor(v, o));
    return v;
}

using pg8::Unit; using pg8::bf16_t;
#define LAUNDER2(a, b) asm volatile("" : "+v"(a), "+v"(b))
__device__ __forceinline__ float row_scale(const float* ss, int row) {
    const f32x4 a = *(const f32x4*)(ss + (size_t)row * 4);
    const float s = (a.x + a.y) + (a.z + a.w);
    return 1.0f / sqrtf(s * (1.0f / D) + EPS);
}
__device__ __forceinline__ float sigmoidf_(float x) { return 1.0f / (1.0f + __expf(-x)); }
__device__ __forceinline__ pg8::u32x2 pack4(const f32x4 v) { pg8::u32x2 w; w.x = pg8::cvt_pk_bf16(v[0], v[1]); w.y = pg8::cvt_pk_bf16(v[2], v[3]); return w; }

struct EpiSwiglu {
    static constexpr bool PERM = false;
    bf16_t* O; const float* ss;
    __device__ __forceinline__ void operator()(const f32x4 (&acc)[2][2][4][2], const Unit& u, int wr, int wc, int fr, int fq) const {
        int rb = wr * 64 + fr, cb = wc * 16 + 4 * fq; LAUNDER2(rb, cb);
        const int row0 = u.pm * 256 + rb, col0 = u.pn * 128 + cb;
#pragma unroll
        for (int ai = 0; ai < 2; ++ai)
#pragma unroll
            for (int m = 0; m < 4; ++m) { const int row = row0 + ai * 128 + m * 16; const float s = row_scale(ss, row);
                bf16_t* rowp = O + (size_t)row * DFF + col0;
#pragma unroll
                for (int bj = 0; bj < 2; ++bj) { const f32x4 a = acc[ai][bj][m][0] * s, b = acc[ai][bj][m][1] * s; f32x4 o;
#pragma unroll
                    for (int i = 0; i < 4; ++i) o[i] = a[i] * sigmoidf_(a[i]) * b[i];
                    *(pg8::u32x2*)(rowp + bj * 64) = pack4(o); } }
    }
};
struct EpiResid {
    static constexpr bool PERM = false;
    const float* base; float* out; bf16_t* hb; float* ss; float alpha; LAS float* P;
    __device__ __forceinline__ void operator()(const f32x4 (&acc)[2][2][4][2], const Unit& u, int wr, int wc, int fr, int fq) const {
        int rb = wr * 64 + fr, cb = wc * 32 + 4 * fq; LAUNDER2(rb, cb);
        const int row0 = u.pm * 256 + rb, col0 = u.pn * 256 + cb;
#pragma unroll
        for (int ai = 0; ai < 2; ++ai)
#pragma unroll
            for (int m = 0; m < 4; ++m) { const int row = row0 + ai * 128 + m * 16; const size_t off = (size_t)row * D + col0; float q = 0.f;
#pragma unroll
                for (int bj = 0; bj < 2; ++bj)
#pragma unroll
                    for (int n = 0; n < 2; ++n) { const f32x4 bs = *(const f32x4*)(base + off + bj * 128 + n * 16); const f32x4 v = bs + acc[ai][bj][m][n] * alpha;
                        *(f32x4*)(out + off + bj * 128 + n * 16) = v;
                        *(pg8::u32x2*)(hb + off + bj * 128 + n * 16) = pack4(v);
                        q += (v[0] * v[0] + v[1] * v[1]) + (v[2] * v[2] + v[3] * v[3]); }
                q += __shfl_xor(q, 16); q += __shfl_xor(q, 32);
                if (fq == 0) P[(rb + ai * 128 + m * 16) * 4 + wc] = q;
                asm volatile("" ::: "memory"); }
        asm volatile("s_waitcnt lgkmcnt(0)" ::: "memory"); __builtin_amdgcn_s_barrier(); asm volatile("" ::: "memory");
        const int tid = (wr * 4 + wc) * 64 + fq * 16 + fr;
        if (tid < 256) { const f32x4 p = *(const LAS f32x4*)(P + tid * 4); ss[(size_t)(u.pm * 256 + tid) * 4 + u.pn] = (p.x + p.y) + (p.z + p.w); }
    }
};
struct EpiPlainBf16 {
    static constexpr bool PERM = false;
    bf16_t* O; int ldo;
    __device__ __forceinline__ void operator()(const f32x4 (&acc)[2][2][4][2], const Unit& u, int wr, int wc, int fr, int fq) const {
        int rb = wr * 64 + fr, cb = wc * 32 + 4 * fq; LAUNDER2(rb, cb);
        const int row0 = u.pm * 256 + rb, col0 = u.pn * 256 + cb;
#pragma unroll
        for (int ai = 0; ai < 2; ++ai)
#pragma unroll
            for (int m = 0; m < 4; ++m) { bf16_t* rowp = O + (size_t)(row0 + ai * 128 + m * 16) * ldo + col0;
#pragma unroll
                for (int bj = 0; bj < 2; ++bj)
#pragma unroll
                    for (int n = 0; n < 2; ++n) *(pg8::u32x2*)(rowp + bj * 128 + n * 16) = pack4(acc[ai][bj][m][n]); }
    }
};
struct EpiInProj {
    static constexpr bool PERM = false;
    const float* ss; bf16_t* qa; float* ckvraw; bf16_t* ik; float* iw; bf16_t* iqraw; bf16_t* z; bf16_t* qc; bf16_t* G;
    __device__ __forceinline__ void operator()(const f32x4 (&acc)[2][2][4][2], const Unit& u, int wr, int wc, int fr, int fq) const {
        int rb = wr * 64 + fr, ct = wc * 32 + 4 * fq; LAUNDER2(rb, ct);
        const int row0 = u.pm * 256 + rb; const int pn = u.pn;
        if (pn == 2) {
#pragma unroll
            for (int ai = 0; ai < 2; ++ai)
#pragma unroll
                for (int m = 0; m < 4; ++m) { const int row = row0 + ai * 128 + m * 16; const float s = row_scale(ss, row);
#pragma unroll
                    for (int n = 0; n < 2; ++n) { *(f32x4*)(ckvraw + (size_t)row * KVR + ct + n * 16) = acc[ai][0][m][n] * s;
                        if (wc == 0) *(pg8::u32x2*)(ik + (size_t)row * IDIM + 4 * fq + n * 16) = pack4(acc[ai][1][m][n] * s); }
                    if (wc == 1 && fq < 2) *(f32x4*)(iw + (size_t)row * IH + 4 * fq) = acc[ai][1][m][0] * s; }
        } else {
            bf16_t* dst0; int ld; bool sig = false;
            if (pn < 2) { dst0 = qa + pn * 256; ld = AW; } else if (pn == 3) { dst0 = iqraw; ld = 256; } else if (pn == 4) { dst0 = z; ld = 256; } else if (pn == 5) { dst0 = qc; ld = 256; } else { dst0 = G + (pn - 6) * 256; ld = 3072; sig = true; }
#pragma unroll
            for (int ai = 0; ai < 2; ++ai)
#pragma unroll
                for (int m = 0; m < 4; ++m) { const int row = row0 + ai * 128 + m * 16; const float s = row_scale(ss, row); bf16_t* rowp = dst0 + (size_t)row * ld + ct;
#pragma unroll
                    for (int bj = 0; bj < 2; ++bj)
#pragma unroll
                        for (int n = 0; n < 2; ++n) { f32x4 o = acc[ai][bj][m][n] * s;
                            if (sig) {
#pragma unroll
                                for (int i = 0; i < 4; ++i) o[i] = sigmoidf_(o[i]); }
                            *(pg8::u32x2*)(rowp + bj * 128 + n * 16) = pack4(o); } }
        }
    }
};
template <int MODE> struct EpiMerge {
    static constexpr bool PERM = false;
    bf16_t* Mg; const bf16_t* G;
    __device__ __forceinline__ void operator()(const f32x4 (&acc)[2][2][4][2], const Unit& u, int wr, int wc, int fr, int fq) const {
        int rb = wr * 64 + fr, cb = wc * 32 + 4 * fq; LAUNDER2(rb, cb);
        const int row0 = u.pm * 256 + rb, col0 = u.pn * 256 + cb;
#pragma unroll
        for (int ai = 0; ai < 2; ++ai)
#pragma unroll
            for (int m = 0; m < 4; ++m) { const int row = row0 + ai * 128 + m * 16;
                const bf16_t* gp = G + (size_t)row * 3072 + MODE * 1024 + col0; bf16_t* mp = Mg + (size_t)row * D + col0;
#pragma unroll
                for (int bj = 0; bj < 2; ++bj)
#pragma unroll
                    for (int n = 0; n < 2; ++n) { const int co = bj * 128 + n * 16;
                        const pg8::u32x2 gw = *(const pg8::u32x2*)(gp + co);
                        f32x4 o = acc[ai][bj][m][n]; o[0] *= bflo(gw.x); o[1] *= bfhi(gw.x); o[2] *= bflo(gw.y); o[3] *= bfhi(gw.y);
                        if (MODE > 0) { const pg8::u32x2 pw = *(const pg8::u32x2*)(mp + co); o[0] += bflo(pw.x); o[1] += bfhi(pw.x); o[2] += bflo(pw.y); o[3] += bfhi(pw.y); }
                        *(pg8::u32x2*)(mp + co) = pack4(o); }
                asm volatile("" ::: "memory"); }
    }
};

template <class Map>
__device__ __forceinline__ void transpose_item(const float* W, int K, int N, const float* gain, bf16* WT, LAS float* scr, int item, int lane, Map map) {
    const int nblk = (N + 31) / 32, kb = item / nblk, nb = item % nblk, k0 = 64 * kb, n0 = 32 * nb;
    const int nn = n0 + (lane & 31); const bool nok = nn < N;
#pragma unroll 8
    for (int i = 0; i < 32; ++i) { const int kk = 2 * i + (lane >> 5); float v = nok ? W[(size_t)(k0 + kk) * N + nn] : 0.f; if (gain) v *= gain[k0 + kk]; scr[kk * 33 + (lane & 31)] = v; }
    LDS_WAIT(); asm volatile("" ::: "memory");
    const int c = lane & 7;
#pragma unroll
    for (int j = 0; j < 4; ++j) { const int n = (lane >> 3) + 8 * j; const LAS float* s = scr + (8 * c) * 33 + n;
        v4u o; o.x = pk2(s[0 * 33], s[1 * 33]); o.y = pk2(s[2 * 33], s[3 * 33]); o.z = pk2(s[4 * 33], s[5 * 33]); o.w = pk2(s[6 * 33], s[7 * 33]);
        if (n0 + n < N) *(GAS v4u*)(WT + (size_t)map(n0 + n) * K + k0 + 8 * c) = o; }
    LDS_WAIT(); asm volatile("" ::: "memory");
}
struct MapId { int off; __device__ __forceinline__ int operator()(int n) const { return off + n; } };
struct MapSwiglu { __device__ __forceinline__ int operator()(int c) const { const int half = c >= DFF ? 1 : 0, j = c - half * DFF; return 32 * (j >> 4) + 16 * half + (j & 15); } };
struct MapInProj { __device__ __forceinline__ int operator()(int c) const {
    if (c < C_IQ) return c;
    if (c < C_IK) return 768 + (c - C_IQ);
    if (c < C_IW) return 640 + (c - C_IK);
    if (c < C_Z) return 672 + (c - C_IW);
    if (c < C_QC) return 1024 + (c - C_Z);
    if (c < C_G) return 1280 + (c - C_QC);
    return 1536 + (c - C_G); } };

__device__ __forceinline__ int items_of(int K, int N) { return (K / 64) * ((N + 31) / 32); }

__device__ __forceinline__ void prep_layer_weights_body(const PC& F, int l) {
    struct { const float* const* in; } a{F.in};
    const int lane_ = lane_id_v();
    LAS float* scr = (LAS float*)(F.lds + RING_OFF + F.wave * 16384);
    const int gw = F.vcu * NWAVES + F.wave, NGW = F.G * NWAVES;
    const float* f1n = a.in[3] + (size_t)l * D; const float* f1in = a.in[4] + (size_t)l * D * 2 * DFF; const float* f1out = a.in[5] + (size_t)l * DFF * D;
    const float* mixn = a.in[6] + (size_t)l * D; const float* win = a.in[7] + (size_t)l * D * INW;
    const float* wba = a.in[15] + (size_t)l * AW * D; const float* wbb = a.in[16] + (size_t)l * PW_ * D; const float* wbc = a.in[17] + (size_t)l * CW * D;
    const float* wout = a.in[18] + (size_t)l * D * D;
    const float* f2n = a.in[19] + (size_t)l * D; const float* f2in = a.in[20] + (size_t)l * D * 2 * DFF; const float* f2out = a.in[21] + (size_t)l * DFF * D;
    unsigned char* ws = launder_p(F.ws);
    const int I0 = items_of(D, 2 * DFF), I1 = items_of(DFF, D), I2 = items_of(D, INW), I3 = items_of(AW, D), I4 = items_of(PW_, D), I5 = items_of(CW, D), I6 = items_of(D, D);
    const int NIT = 2 * I0 + 2 * I1 + I2 + I3 + I4 + I5 + I6;
    for (int it = gw; it < NIT; it += NGW) {
        int r = it;
        if (r < I0) { transpose_item(f1in, D, 2 * DFF, f1n, (bf16*)(ws + WS_W1IN), scr, r, lane_, MapSwiglu{}); continue; } r -= I0;
        if (r < I0) { transpose_item(f2in, D, 2 * DFF, f2n, (bf16*)(ws + WS_W2IN), scr, r, lane_, MapSwiglu{}); continue; } r -= I0;
        if (r < I1) { transpose_item(f1out, DFF, D, nullptr, (bf16*)(ws + WS_W1OUT), scr, r, lane_, MapId{0}); continue; } r -= I1;
        if (r < I1) { transpose_item(f2out, DFF, D, nullptr, (bf16*)(ws + WS_W2OUT), scr, r, lane_, MapId{0}); continue; } r -= I1;
        if (r < I2) { transpose_item(win, D, INW, mixn, (bf16*)(ws + WS_WIN), scr, r, lane_, MapInProj{}); continue; } r -= I2;
        if (r < I3) { transpose_item(wba, AW, D, nullptr, (bf16*)(ws + WS_WA), scr, r, lane_, MapId{0}); continue; } r -= I3;
        if (r < I4) { transpose_item(wbb, PW_, D, nullptr, (bf16*)(ws + WS_WB), scr, r, lane_, MapId{0}); continue; } r -= I4;
        if (r < I5) { transpose_item(wbc, CW, D, nullptr, (bf16*)(ws + WS_WC), scr, r, lane_, MapId{0}); continue; } r -= I5;
        transpose_item(wout, D, D, nullptr, (bf16*)(ws + WS_WOUT), scr, r, lane_, MapId{0});
    }
    const float* wuk = a.in[9] + (size_t)l * KVR * AH * AHD; float* wukT = (float*)(ws + WS_WUKT);
    for (int i = (F.vcu * NWAVES + F.wave) * 64 + lane_; i < KVR * AH * AHD; i += F.G * NWAVES * 64) { const int r = i & 127, hd = i >> 7; wukT[i] = wuk[(size_t)r * (AH * AHD) + hd]; }
}

__device__ __noinline__ void p0_prologue(const float* const* in_, float* out_, unsigned char* ws_, LAS unsigned char* lds_, int wave_, int vcu_, int G_) {
    const PC F{uni(in_), uni(out_), uni(ws_), uni_l(lds_), uni_i(wave_), uni_i(vcu_), uni_i(G_)}; struct { const float* const* in; } a{F.in};
    const int lane_ = lane_id_v();
    const int gw = F.vcu * NWAVES + F.wave, NGW = F.G * NWAVES;
    const float* x = a.in[0]; const float* mem = a.in[1];
    bf16* hb = (bf16*)(F.ws + WS_HB); float* ss = (float*)(F.ws + WS_SS); bf16* memn = (bf16*)(F.ws + WS_MEMN);
    for (int m = gw; m < M + MROWS; m += NGW) {
        const bool ismem = m >= M; const int r = ismem ? m - M : m;
        const GAS f32x4* xr = (const GAS f32x4*)((ismem ? mem : x) + (size_t)r * D) + lane_;
        f32x4 v[4]; float s = 0.f;
#pragma unroll
        for (int j = 0; j < 4; ++j) { v[j] = xr[64 * j]; s += (v[j].x * v[j].x + v[j].y * v[j].y) + (v[j].z * v[j].z + v[j].w * v[j].w); }
        s = wave_sum(s);
        float sc = 1.f;
        if (ismem) sc = 1.0f / sqrtf(s * (1.0f / D) + EPS);
        else if (lane_ < 4) ss[(size_t)r * 4 + lane_] = lane_ == 0 ? s : 0.f;
        GAS unsigned long long* o8 = (GAS unsigned long long*)((ismem ? memn : hb) + (size_t)r * D) + lane_;
#pragma unroll
        for (int j = 0; j < 4; ++j) o8[64 * j] = (unsigned long long)pk2(v[j].x * sc, v[j].y * sc) | ((unsigned long long)pk2(v[j].z * sc, v[j].w * sc) << 32);
    }
    LAS float* scr = (LAS float*)(F.lds + RING_OFF + F.wave * 16384);
    const int IM = items_of(D, 2 * CW);
    for (int it = gw; it < DEPTH * IM; it += NGW) { const int l = it / IM, r = it % IM;
        transpose_item(a.in[14] + (size_t)l * D * 2 * CW, D, 2 * CW, a.in[13] + (size_t)l * D, (bf16*)(F.ws + WS_WMEM), scr, r, lane_, MapId{l * 2 * CW}); }
    prep_layer_weights_body(F, 0);
}
__device__ __noinline__ void prep_layer_weights(const float* const* in_, float* out_, unsigned char* ws_, LAS unsigned char* lds_, int l, int wave_, int vcu_, int G_) {
    const PC F{uni(in_), uni(out_), uni(ws_), uni_l(lds_), uni_i(wave_), uni_i(vcu_), uni_i(G_)}; prep_layer_weights_body(F, uni_i(l));
}

__constant__ unsigned char T5_BUCKET[128] = {0, 1, 2, 3, 4, 5, 6, 7, 8, 9, 10, 11, 12, 13, 14, 15, 16, 16, 16, 17, 17, 18, 18, 18, 19, 19, 19, 20, 20, 20, 20, 21, 21, 21, 21, 22, 22, 22, 22, 22, 23, 23, 23, 23, 23, 23, 24, 24, 24, 24, 24, 24, 25, 25, 25, 25, 25, 25, 25, 26, 26, 26, 26, 26, 26, 26, 26, 27, 27, 27, 27, 27, 27, 27, 27, 27, 27, 28, 28, 28, 28, 28, 28, 28, 28, 28, 28, 29, 29, 29, 29, 29, 29, 29, 29, 29, 29, 29, 29, 30, 30, 30, 30, 30, 30, 30, 30, 30, 30, 30, 30, 30, 30, 31, 31, 31, 31, 31, 31, 31, 31, 31, 31, 31, 31, 31, 31, 31};

__device__ __noinline__ void prep_tokens(const float* const* in_, float* out_, unsigned char* ws_, LAS unsigned char* lds_, int l_, int wave_, int vcu_, int G_) {
    const PC F{uni(in_), uni(out_), uni(ws_), uni_l(lds_), uni_i(wave_), uni_i(vcu_), uni_i(G_)}; struct { const float* const* in; } a{F.in}; const int l = uni_i(l_);
    unsigned char* ws = launder_p(F.ws);
    const float* ckvraw = (const float*)(ws + WS_CKVRAW); bf16* ckv = (bf16*)(ws + WS_CKV);
    const bf16* iqraw = (const bf16*)(ws + WS_IQRAW); bf16* iqf = (bf16*)(ws + WS_IQF); const float* iw = (const float*)(ws + WS_IW); unsigned* sgn = (unsigned*)(ws + WS_SGN);
    const bf16* z = (const bf16*)(ws + WS_Z); bf16* yb = (bf16*)(ws + WS_YB); bf16* qc = (bf16*)(ws + WS_QC);
    const bf16* memkv = (const bf16*)(ws + WS_MEMKV);
    const float* kvn = a.in[8] + (size_t)l * KVR; const float* wpool = a.in[11] + (size_t)l * 4 * 64 * 64; const float* pscale = a.in[12] + (size_t)l * PW_;
    LAS float* wp = (LAS float*)(F.lds + RING_OFF);
    for (int i = (F.wave * 64 + lane_id_v()); i < 4 * 64 * 64; i += NWAVES * 64) wp[i] = wpool[i];
    __syncthreads();
    const int gw = F.vcu * NWAVES + F.wave, lane = lane_id_v();
    constexpr int TPW = 16;
    for (int t = gw * TPW; t < M; t += F.G * NWAVES * TPW)
    for (int tt = 0; tt < TPW; ++tt) {
        const int row = t + tt, b = row / SEQ, s = row % SEQ;
        { const f32x2 v = *(const f32x2*)(ckvraw + (size_t)row * KVR + 2 * lane); const float q = wave_sum(v.x * v.x + v.y * v.y);
          const float rs = 1.0f / sqrtf(q * (1.0f / KVR) + EPS); const f32x2 g = *(const f32x2*)(kvn + 2 * lane);
          *(unsigned*)(ckv + (size_t)row * KVR + 2 * lane) = pk2(v.x * rs * g.x, v.y * rs * g.y); }
        { const float wv = iw[(size_t)row * IH + (lane >> 3)]; const float aw = fabsf(wv) * (1.0f / 16.0f);
          const v2u q = *(const v2u*)(iqraw + (size_t)row * 256 + 4 * lane);
          v2u o; o.x = pk2(bflo(q.x) * aw, bfhi(q.x) * aw); o.y = pk2(bflo(q.y) * aw, bfhi(q.y) * aw);
          *(v2u*)(iqf + (size_t)row * 256 + 4 * lane) = o;
          const unsigned long long bal = __ballot(wv < 0.f);
          unsigned mask = 0;
#pragma unroll
          for (int h = 0; h < 8; ++h) mask |= ((unsigned)(bal >> (8 * h)) & 1u) << h;
          if (lane == 0) sgn[row] = mask; }
#pragma unroll
        for (int g = 0; g < 4; ++g) {
            const int w = 2 << g; const int cnt = (s + 1) < w ? (s + 1) : w;
            float sum = 0.f; float z0 = 0.f;
            for (int j = 0; j < cnt; ++j) { const float v = bf2f(z[(size_t)(row - j) * 256 + g * 64 + lane]); sum += v; if (j == 0) z0 = v; }
            const float pooled = sum / (float)cnt - z0;
            float o = 0.f;
#pragma unroll 4
            for (int c = 0; c < 64; ++c) { const float pc = __shfl(pooled, c); o += pc * wp[(g * 64 + c) * 64 + lane]; }
            yb[(size_t)row * 256 + g * 64 + lane] = (bf16)f2bf(o * pscale[g * 64 + lane]);
        }
#pragma unroll 1
        for (int h = 0; h < CH; ++h) {
            const float qd = bf2f(qc[(size_t)row * 256 + h * 64 + lane]);
            float lg[4] = {0.f, 0.f, 0.f, 0.f};
#pragma unroll
            for (int i = 0; i < 4; ++i) { const int mm = lane + 64 * i;
                const v4u* kp = (const v4u*)(memkv + (size_t)(b * NMEM + mm) * 2048 + l * 512 + h * 64);
                float accd = 0.f;
#pragma unroll 2
                for (int c8 = 0; c8 < 8; ++c8) { const v4u kv = kp[c8];
                    const unsigned kw[4] = {kv.x, kv.y, kv.z, kv.w};
#pragma unroll
                    for (int e = 0; e < 4; ++e) { const float q0 = __shfl(qd, c8 * 8 + 2 * e);
                        const float q1 = __shfl(qd, c8 * 8 + 2 * e + 1);
                        accd += q0 * bflo(kw[e]) + q1 * bfhi(kw[e]); } }
                lg[i] = accd * 0.125f; asm volatile("" ::: "memory"); }
            float mx = fmaxf(fmaxf(lg[0], lg[1]), fmaxf(lg[2], lg[3])); mx = wave_max(mx);
            float p[4], sm = 0.f;
#pragma unroll
            for (int i = 0; i < 4; ++i) { p[i] = __expf(lg[i] - mx); sm += p[i]; }
            sm = wave_sum(sm); const float inv = 1.0f / sm;
            float o = 0.f;
#pragma unroll
            for (int i = 0; i < 4; ++i) {
#pragma unroll 8
                for (int j = 0; j < 64; ++j) { const float pj = __shfl(p[i], j); o += pj * bf2f(memkv[(size_t)(b * NMEM + j + 64 * i) * 2048 + l * 512 + 256 + h * 64 + lane]); } }
            qc[(size_t)row * 256 + h * 64 + lane] = (bf16)f2bf(o * inv);
        }
    }
    __syncthreads();
}

__device__ __forceinline__ unsigned key_of(float s) { const unsigned u = __builtin_bit_cast(unsigned, s); return (u & 0x80000000u) ? ~u : (u | 0x80000000u); }

__device__ __noinline__ void dsa_phase_v1(unsigned char* ws_, LAS unsigned char* lds_, const float* wuv_l, const float* relb, int wave_, int vcu_, int G_) {
    struct { LAS unsigned char* lds; int wave, vcu, G; } F{uni_l(lds_), uni_i(wave_), uni_i(vcu_), uni_i(G_)};
    unsigned char* ws = uni(ws_); wuv_l = uni(wuv_l); relb = uni(relb);
    const bf16* iqf = (const bf16*)(ws + WS_IQF); const unsigned* sgn = (const unsigned*)(ws + WS_SGN); const bf16* ik = (const bf16*)(ws + WS_IK);
    const bf16* ckv = (const bf16*)(ws + WS_CKV); bf16* qa = (bf16*)(ws + WS_QA);
    const float* wukT = (const float*)(ws + WS_WUKT); const float* wuv = wuv_l;
    const int lane = lane_id_v();
    if (F.wave < 4) {
        constexpr int WB = 36864;
        LAS unsigned char* base = F.lds + F.wave * WB;
        LAS unsigned* keys = (LAS unsigned*)base;
        LAS float* qf = (LAS float*)(base + 32768);
        LAS int* idx = (LAS int*)(base + 32768 + 1024);
        LAS float* qlat = (LAS float*)base;
        LAS float* pl = (LAS float*)(base + 4096);
        LAS float* olat = (LAS float*)(base + 4096 + 8192);
        const int gw4 = F.vcu * 4 + F.wave, NGW4 = F.G * 4;
        for (int q = gw4; q < M; q += NGW4) {
            const int b = q / SEQ, t = q % SEQ; const int n = t + 1;
            const size_t brow = (size_t)b * SEQ;
            { const v2u w = *(const v2u*)(iqf + (size_t)q * 256 + 4 * lane); qf[4 * lane] = bflo(w.x); qf[4 * lane + 1] = bfhi(w.x); qf[4 * lane + 2] = bflo(w.y); qf[4 * lane + 3] = bfhi(w.y); }
            const unsigned smask = sgn[q];
            LDS_WAIT();
            for (int s0 = 0; s0 < n; s0 += 64) { const int s = s0 + lane;
                if (s < n) {
                    const v4u* kp = (const v4u*)(ik + (brow + s) * IDIM);
                    float kf[32];
#pragma unroll
                    for (int c = 0; c < 4; ++c) { const v4u kv = kp[c]; kf[8 * c] = bflo(kv.x); kf[8 * c + 1] = bfhi(kv.x); kf[8 * c + 2] = bflo(kv.y); kf[8 * c + 3] = bfhi(kv.y); kf[8 * c + 4] = bflo(kv.z); kf[8 * c + 5] = bfhi(kv.z); kf[8 * c + 6] = bflo(kv.w); kf[8 * c + 7] = bfhi(kv.w); }
                    float sc = 0.f;
#pragma unroll
                    for (int h = 0; h < 8; ++h) { float d = 0.f;
#pragma unroll
                        for (int j4 = 0; j4 < 8; ++j4) { const f32x4 qv = *(const LAS f32x4*)(qf + h * 32 + 4 * j4); d += qv.x * kf[4 * j4] + qv.y * kf[4 * j4 + 1] + qv.z * kf[4 * j4 + 2] + qv.w * kf[4 * j4 + 3]; }
                        d = fmaxf(d, 0.f); sc += ((smask >> h) & 1u) ? -d : d; }
                    keys[s] = key_of(sc + 0.0f);
                } }
            LDS_WAIT();
            int nsel;
            if (n <= TOPK) { nsel = n; for (int j = lane; j < n; j += 64) idx[j] = j; }
            else {
                unsigned T = 0u;
                for (int bit = 31; bit >= 0; --bit) { const unsigned cand = T | (1u << bit); int cnt = 0;
                    for (int s0 = 0; s0 < n; s0 += 64) { const int s = s0 + lane; const bool ge = (s < n) && (keys[s] >= cand); cnt += (int)__builtin_popcountll(__ballot(ge)); }
                    if (cnt >= TOPK) T = cand; }
                int cgt = 0;
                for (int s0 = 0; s0 < n; s0 += 64) { const int s = s0 + lane; const bool gt = (s < n) && (keys[s] > T); cgt += (int)__builtin_popcountll(__ballot(gt)); }
                const int need_eq = TOPK - cgt;
                int pos = 0, peq = 0; const unsigned long long lt = (lane == 0) ? 0ull : (~0ull >> (64 - lane));
                for (int s0 = 0; s0 < n; s0 += 64) { const int s = s0 + lane; const unsigned k = (s < n) ? keys[s] : 0u;
                    const bool gt = (s < n) && (k > T), eq = (s < n) && (k == T);
                    const unsigned long long be = __ballot(eq);
                    const int eqrank = peq + (int)__builtin_popcountll(be & lt);
                    const bool take = gt || (eq && eqrank < need_eq);
                    const unsigned long long bt = __ballot(take);
                    if (take) idx[pos + (int)__builtin_popcountll(bt & lt)] = s;
                    pos += (int)__builtin_popcountll(bt); peq += (int)__builtin_popcountll(be); }
                nsel = TOPK;
            }
            LDS_WAIT();
            { const bf16* qrow = qa + (size_t)q * AW;
#pragma unroll 1
              for (int h = 0; h < 8; ++h) { const float qd = bf2f(qrow[h * 64 + lane]); float o0 = 0.f, o1 = 0.f;
#pragma unroll 8
                  for (int d = 0; d < 64; ++d) { const float qv = __shfl(qd, d); const float* wp = wukT + (size_t)(h * 64 + d) * 128; o0 += qv * wp[lane]; o1 += qv * wp[lane + 64]; }
                  qlat[h * 128 + lane] = o0; qlat[h * 128 + lane + 64] = o1; } }
            LDS_WAIT();
#pragma unroll 1
            for (int i = 0; i < 4; ++i) { const int j = lane + 64 * i; const bool valid = j < nsel; const int sidx = valid ? idx[j] : 0;
                const v4u* cp = (const v4u*)(ckv + (brow + sidx) * KVR);
                float lg[8] = {0.f, 0.f, 0.f, 0.f, 0.f, 0.f, 0.f, 0.f};
#pragma unroll 2
                for (int c = 0; c < 16; ++c) { const v4u cv = cp[c]; const float cf[8] = {bflo(cv.x), bfhi(cv.x), bflo(cv.y), bfhi(cv.y), bflo(cv.z), bfhi(cv.z), bflo(cv.w), bfhi(cv.w)};
#pragma unroll
                    for (int h = 0; h < 8; ++h) { const f32x4 q0 = *(const LAS f32x4*)(qlat + h * 128 + 8 * c), q1 = *(const LAS f32x4*)(qlat + h * 128 + 8 * c + 4);
                        lg[h] += q0.x * cf[0] + q0.y * cf[1] + q0.z * cf[2] + q0.w * cf[3] + q1.x * cf[4] + q1.y * cf[5] + q1.z * cf[6] + q1.w * cf[7]; } }
                const int dist = t - sidx; const int bk = dist < 128 ? (int)T5_BUCKET[dist < 0 ? 0 : dist] : 31;
#pragma unroll
                for (int h = 0; h < 8; ++h) pl[h * 256 + j] = valid ? (lg[h] * 0.125f + relb[bk * 8 + h]) : -1e30f; }
            LDS_WAIT();
#pragma unroll 1
            for (int h = 0; h < 8; ++h) { float v[4]; float mx = -3e38f;
#pragma unroll
                for (int i = 0; i < 4; ++i) { v[i] = pl[h * 256 + lane + 64 * i]; mx = fmaxf(mx, v[i]); }
                mx = wave_max(mx); float sm = 0.f;
#pragma unroll
                for (int i = 0; i < 4; ++i) { v[i] = __expf(v[i] - mx); sm += v[i]; }
                sm = wave_sum(sm); const float inv = 1.0f / sm;
#pragma unroll
                for (int i = 0; i < 4; ++i) pl[h * 256 + lane + 64 * i] = v[i] * inv; }
            LDS_WAIT();
            { float o[8][2];
#pragma unroll
              for (int h = 0; h < 8; ++h) { o[h][0] = 0.f; o[h][1] = 0.f; }
              for (int j = 0; j < nsel; ++j) { const int sidx = idx[j]; const unsigned cw = *(const unsigned*)(ckv + (brow + sidx) * KVR + 2 * lane); const float c0 = bflo(cw), c1 = bfhi(cw);
#pragma unroll
                  for (int h = 0; h < 8; ++h) { const float p = pl[h * 256 + j]; o[h][0] += p * c0; o[h][1] += p * c1; } }
#pragma unroll
              for (int h = 0; h < 8; ++h) { olat[h * 128 + 2 * lane] = o[h][0]; olat[h * 128 + 2 * lane + 1] = o[h][1]; } }
            LDS_WAIT();
#pragma unroll 1
            for (int h = 0; h < 8; ++h) { float o = 0.f;
#pragma unroll 8
                for (int r = 0; r < 128; ++r) o += olat[h * 128 + r] * wuv[(size_t)r * (AH * AHD) + h * 64 + lane];
                qa[(size_t)q * AW + h * 64 + lane] = (bf16)f2bf(o); }
            LDS_WAIT();
        }
    }
    __syncthreads();
}

__device__ __noinline__ void final_norm(const float* const* in_, float* out_, unsigned char* ws_, LAS unsigned char* lds_, int wave_, int vcu_, int G_) {
    const PC F{uni(in_), uni(out_), uni(ws_), uni_l(lds_), uni_i(wave_), uni_i(vcu_), uni_i(G_)}; struct { const float* const* in; float* out; } a{F.in, F.out};
    const int lane_ = lane_id_v(); const int gw = F.vcu * NWAVES + F.wave, NGW = F.G * NWAVES; const float* g = a.in[22];
    f32x4 gv[4];
#pragma unroll
    for (int j = 0; j < 4; ++j) gv[j] = ((const f32x4*)g)[lane_ + 64 * j];
    for (int m = gw; m < M; m += NGW) {
        GAS f32x4* xr = (GAS f32x4*)(a.out + (size_t)m * D) + lane_;
        f32x4 v[4]; float s = 0.f;
#pragma unroll
        for (int j = 0; j < 4; ++j) { v[j] = xr[64 * j]; s += (v[j].x * v[j].x + v[j].y * v[j].y) + (v[j].z * v[j].z + v[j].w * v[j].w); }
        const float rs = 1.0f / sqrtf(wave_sum(s) * (1.0f / D) + EPS);
#pragma unroll
        for (int j = 0; j < 4; ++j) xr[64 * j] = v[j] * rs * gv[j];
    }
}

#define KIN ((const float* const*)__builtin_amdgcn_kernarg_segment_ptr())
constexpr int PH_PER_LAYER = 10, PH_LAYER0 = 2, N_PHASES = PH_LAYER0 + PH_PER_LAYER * DEPTH + 1;

__global__ void __launch_bounds__(NWAVES * 64, 2) mk_fwd(Args args) {
    extern __shared__ __attribute__((aligned(16))) unsigned char lds[];
    Frame F;
    F.lds = (LAS unsigned char*)lds;
    F.MISC = (volatile LAS unsigned*)(F.lds + MISC_OFF);
    F.wave = __builtin_amdgcn_readfirstlane((int)threadIdx.x >> 6);
    F.G = gridDim.x; { const int bx = blockIdx.x; F.vcu = (F.G % 8 == 0) ? (bx % 8) * (F.G / 8) + bx / 8 : bx; }
    F.ws = args.ws; F.ctl = (gu32*)(args.ws + WS_CTL);
    if (threadIdx.x < 64) ((LAS unsigned*)(F.lds + MISC_OFF))[threadIdx.x] = 0u;
    __syncthreads();
    const int lo = args.ph_lo, hi = args.ph_hi;
    const bool multi = (hi - lo) > 1;
    XcdBarrier bar; bar.bar = (unsigned*)(F.ctl + CW_BAR); bar.x = 0; bar.st = nullptr; bar.wave = F.wave;
    if (multi) bar = xcd_barrier_post((unsigned*)(F.ctl + CW_BAR), F.MISC + 8, F.wave);
#define IN(k) (lo <= (k) && (k) < hi)
#define SEAM(k) do { if (IN(k) && IN((k) + 1)) xcd_barrier(bar); } while (0)

    if (IN(0)) {
#if EN_P0
 p0_prologue(KIN, args.out, args.ws, F.lds, F.wave, F.vcu, F.G);
#endif
 } SEAM(0);
    if (IN(1)) {
#if !((DIS_MASK >> 7) & 1)
 unsigned char* ws = launder_p(args.ws); bf16* hb = (bf16*)(ws + WS_HB); float* ss = (float*)(ws + WS_SS); (void)hb; (void)ss;
        pg8::Gemm g{(const bf16_t*)(ws + WS_MEMN), (const bf16_t*)(ws + WS_WMEM), MROWS, DEPTH * 2 * CW, D}; pg8::StaticOrder S; S.init(MROWS, DEPTH * 2 * CW, F.G, launder_s((int)blockIdx.x));
        EpiPlainBf16 E{(bf16_t*)(ws + WS_MEMKV), DEPTH * 2 * CW};
        pg8::gemm_phase<EpiPlainBf16, pg8::StaticOrder, true, true>(F.lds + RING_OFF, g, S, E, F.wave);
#endif
    } SEAM(1);

    for (int l = 0; l < DEPTH; ++l) {
        const int pb = PH_LAYER0 + PH_PER_LAYER * l;
        const float* hbase = (l == 0) ? args.in[0] : args.out;
        if (IN(pb + 0)) {
#if EN_P0
 if (l > 0) prep_layer_weights(KIN, args.out, args.ws, F.lds, l, F.wave, F.vcu, F.G);
#endif
 } SEAM(pb + 0);
        if (IN(pb + 1)) {
#if !((DIS_MASK >> 0) & 1)
 unsigned char* ws = launder_p(args.ws); bf16* hb = (bf16*)(ws + WS_HB); float* ss = (float*)(ws + WS_SS); (void)hb; (void)ss;
            pg8::Gemm g{hb, (const bf16_t*)(ws + WS_W1IN), M, 2 * DFF, D}; pg8::StaticOrder S; S.init(M, 2 * DFF, F.G, launder_s((int)blockIdx.x));
            EpiSwiglu E{(bf16_t*)(ws + WS_ACT), ss};
            pg8::gemm_phase<EpiSwiglu, pg8::StaticOrder, true, true>(F.lds + RING_OFF, g, S, E, F.wave);
#endif
        } SEAM(pb + 1);
        if (IN(pb + 2)) {
#if !((DIS_MASK >> 1) & 1)
 unsigned char* ws = launder_p(args.ws); bf16* hb = (bf16*)(ws + WS_HB); float* ss = (float*)(ws + WS_SS); (void)hb; (void)ss;
            pg8::Gemm g{(const bf16_t*)(ws + WS_ACT), (const bf16_t*)(ws + WS_W1OUT), M, D, DFF}; pg8::StaticOrder S; S.init(M, D, F.G, launder_s((int)blockIdx.x));
            EpiResid E{hbase, args.out, hb, ss, 0.5f, (LAS float*)(F.lds + RING_BYTES)};
            pg8::gemm_phase<EpiResid, pg8::StaticOrder, true, true>(F.lds + RING_OFF, g, S, E, F.wave);
#endif
        } SEAM(pb + 2);
        if (IN(pb + 3)) {
#if !((DIS_MASK >> 2) & 1)
 unsigned char* ws = launder_p(args.ws); bf16* hb = (bf16*)(ws + WS_HB); float* ss = (float*)(ws + WS_SS); (void)hb; (void)ss;
            pg8::Gemm g{hb, (const bf16_t*)(ws + WS_WIN), M, INP, D}; pg8::StaticOrder S; S.init(M, INP, F.G, launder_s((int)blockIdx.x));
            EpiInProj E{ss, (bf16_t*)(ws + WS_QA), (float*)(ws + WS_CKVRAW), (bf16_t*)(ws + WS_IK), (float*)(ws + WS_IW), (bf16_t*)(ws + WS_IQRAW), (bf16_t*)(ws + WS_Z), (bf16_t*)(ws + WS_QC), (bf16_t*)(ws + WS_G)};
            pg8::gemm_phase<EpiInProj, pg8::StaticOrder, true, true>(F.lds + RING_OFF, g, S, E, F.wave);
#endif
        } SEAM(pb + 3);
        if (IN(pb + 4)) {
#if EN_PREP
 prep_tokens(KIN, args.out, args.ws, F.lds, l, F.wave, F.vcu, F.G);
#endif
 } SEAM(pb + 4);
        if (IN(pb + 5)) {
#if EN_DSA
 dsa_phase_v1(args.ws, F.lds, args.in[10] + (size_t)l * KVR * AH * AHD, args.in[2], F.wave, F.vcu, F.G);
#endif
 } SEAM(pb + 5);
        if (IN(pb + 6)) {
#if !((DIS_MASK >> 3) & 1)
 unsigned char* ws = launder_p(args.ws); bf16* hb = (bf16*)(ws + WS_HB); float* ss = (float*)(ws + WS_SS); (void)hb; (void)ss;
            { pg8::Gemm g{(const bf16_t*)(ws + WS_QA), (const bf16_t*)(ws + WS_WA), M, D, AW}; pg8::StaticOrder S; S.init(M, D, F.G, launder_s((int)blockIdx.x));
              EpiMerge<0> E{(bf16_t*)(ws + WS_MERGED), (const bf16_t*)(ws + WS_G)};
              pg8::gemm_phase<EpiMerge<0>, pg8::StaticOrder, true, true>(F.lds + RING_OFF, g, S, E, F.wave); }
            { pg8::Gemm g{(const bf16_t*)(ws + WS_YB), (const bf16_t*)(ws + WS_WB), M, D, PW_}; pg8::StaticOrder S; S.init(M, D, F.G, launder_s((int)blockIdx.x));
              EpiMerge<1> E{(bf16_t*)(ws + WS_MERGED), (const bf16_t*)(ws + WS_G)};
              pg8::gemm_phase<EpiMerge<1>, pg8::StaticOrder, true, true>(F.lds + RING_OFF, g, S, E, F.wave); }
            { pg8::Gemm g{(const bf16_t*)(ws + WS_QC), (const bf16_t*)(ws + WS_WC), M, D, CW}; pg8::StaticOrder S; S.init(M, D, F.G, launder_s((int)blockIdx.x));
              EpiMerge<2> E{(bf16_t*)(ws + WS_MERGED), (const bf16_t*)(ws + WS_G)};
              pg8::gemm_phase<EpiMerge<2>, pg8::StaticOrder, true, true>(F.lds + RING_OFF, g, S, E, F.wave); }
#endif
        } SEAM(pb + 6);
        if (IN(pb + 7)) {
#if !((DIS_MASK >> 4) & 1)
 unsigned char* ws = launder_p(args.ws); bf16* hb = (bf16*)(ws + WS_HB); float* ss = (float*)(ws + WS_SS); (void)hb; (void)ss;
            pg8::Gemm g{(const bf16_t*)(ws + WS_MERGED), (const bf16_t*)(ws + WS_WOUT), M, D, D}; pg8::StaticOrder S; S.init(M, D, F.G, launder_s((int)blockIdx.x));
            EpiResid E{args.out, args.out, hb, ss, 1.0f, (LAS float*)(F.lds + RING_BYTES)};
            pg8::gemm_phase<EpiResid, pg8::StaticOrder, true, true>(F.lds + RING_OFF, g, S, E, F.wave);
#endif
        } SEAM(pb + 7);
        if (IN(pb + 8)) {
#if !((DIS_MASK >> 5) & 1)
 unsigned char* ws = launder_p(args.ws); bf16* hb = (bf16*)(ws + WS_HB); float* ss = (float*)(ws + WS_SS); (void)hb; (void)ss;
            pg8::Gemm g{hb, (const bf16_t*)(ws + WS_W2IN), M, 2 * DFF, D}; pg8::StaticOrder S; S.init(M, 2 * DFF, F.G, launder_s((int)blockIdx.x));
            EpiSwiglu E{(bf16_t*)(ws + WS_ACT), ss};
            pg8::gemm_phase<EpiSwiglu, pg8::StaticOrder, true, true>(F.lds + RING_OFF, g, S, E, F.wave);
#endif
        } SEAM(pb + 8);
        if (IN(pb + 9)) {
#if !((DIS_MASK >> 6) & 1)
 unsigned char* ws = launder_p(args.ws); bf16* hb = (bf16*)(ws + WS_HB); float* ss = (float*)(ws + WS_SS); (void)hb; (void)ss;
            pg8::Gemm g{(const bf16_t*)(ws + WS_ACT), (const bf16_t*)(ws + WS_W2OUT), M, D, DFF}; pg8::StaticOrder S; S.init(M, D, F.G, launder_s((int)blockIdx.x));
            EpiResid E{args.out, args.out, hb, ss, 0.5f, (LAS float*)(F.lds + RING_BYTES)};
            pg8::gemm_phase<EpiResid, pg8::StaticOrder, true, true>(F.lds + RING_OFF, g, S, E, F.wave);
#endif
        } SEAM(pb + 9);
    }
#if EN_P0
    if (IN(N_PHASES - 1)) { final_norm(KIN, args.out, args.ws, F.lds, F.wave, F.vcu, F.G); }
#endif
#undef IN
#undef SEAM
}

__global__ void __launch_bounds__(NWAVES * 64, 2) mk_aux(Args args) {
    extern __shared__ __attribute__((aligned(16))) unsigned char lds[];
    Frame F;
    F.lds = (LAS unsigned char*)lds;
    F.MISC = (volatile LAS unsigned*)(F.lds + MISC_OFF);
    F.wave = __builtin_amdgcn_readfirstlane((int)threadIdx.x >> 6);
    F.G = gridDim.x; { const int bx = blockIdx.x; F.vcu = (F.G % 8 == 0) ? (bx % 8) * (F.G / 8) + bx / 8 : bx; }
    F.ws = args.ws; F.ctl = (gu32*)(args.ws + WS_CTL);
    const int which = args.ph_lo, l = args.ph_hi;
    if (which == 0) p0_prologue(KIN, args.out, args.ws, F.lds, F.wave, F.vcu, F.G);
    else if (which == 1) prep_layer_weights(KIN, args.out, args.ws, F.lds, l, F.wave, F.vcu, F.G);
    else if (which == 4) final_norm(KIN, args.out, args.ws, F.lds, F.wave, F.vcu, F.G);
}
__global__ void __launch_bounds__(NWAVES * 64, 2) mk_prep(Args args) {
    extern __shared__ __attribute__((aligned(16))) unsigned char lds[];
    Frame F;
    F.lds = (LAS unsigned char*)lds;
    F.MISC = (volatile LAS unsigned*)(F.lds + MISC_OFF);
    F.wave = __builtin_amdgcn_readfirstlane((int)threadIdx.x >> 6);
    F.G = gridDim.x; { const int bx = blockIdx.x; F.vcu = (F.G % 8 == 0) ? (bx % 8) * (F.G / 8) + bx / 8 : bx; }
    F.ws = args.ws; F.ctl = (gu32*)(args.ws + WS_CTL);
    prep_tokens(KIN, args.out, args.ws, F.lds, args.ph_hi, F.wave, F.vcu, F.G);
}
__global__ void __launch_bounds__(NWAVES * 64, 2) mk_dsa(Args args) {
    extern __shared__ __attribute__((aligned(16))) unsigned char lds[];
    Frame F;
    F.lds = (LAS unsigned char*)lds;
    F.MISC = (volatile LAS unsigned*)(F.lds + MISC_OFF);
    F.wave = __builtin_amdgcn_readfirstlane((int)threadIdx.x >> 6);
    F.G = gridDim.x; { const int bx = blockIdx.x; F.vcu = (F.G % 8 == 0) ? (bx % 8) * (F.G / 8) + bx / 8 : bx; }
    F.ws = args.ws; F.ctl = (gu32*)(args.ws + WS_CTL);
    dsa_phase_v1(args.ws, F.lds, args.in[10] + (size_t)args.ph_hi * KVR * AH * AHD, args.in[2], F.wave, F.vcu, F.G);
}

extern "C" void kernel_launch(void* const* d_in, const int* in_sizes, int n_in, void* d_out, int out_size, void* d_ws, size_t ws_size, hipStream_t stream) {
    static int grid = 0;
    if (grid == 0) {
        if (n_in != 23 || in_sizes[0] != M * D || out_size != M * D || ws_size < WS_END) { fprintf(stderr, "kernel_launch: unexpected shapes (n_in %d, ws %zu)\n", n_in, ws_size); grid = -1; return; }
        int dev = 0, cus = 0, per_cu = 0;
        if (hipGetDevice(&dev) != hipSuccess || hipDeviceGetAttribute(&cus, hipDeviceAttributeMultiprocessorCount, dev) != hipSuccess) { grid = -1; return; }
        if (hipFuncSetAttribute((const void*)mk_fwd, hipFuncAttributeMaxDynamicSharedMemorySize, LDS_BYTES) != hipSuccess || hipFuncSetAttribute((const void*)mk_aux, hipFuncAttributeMaxDynamicSharedMemorySize, LDS_BYTES) != hipSuccess || hipFuncSetAttribute((const void*)mk_prep, hipFuncAttributeMaxDynamicSharedMemorySize, LDS_BYTES) != hipSuccess || hipFuncSetAttribute((const void*)mk_dsa, hipFuncAttributeMaxDynamicSharedMemorySize, LDS_BYTES) != hipSuccess) { fprintf(stderr, "kernel_launch: hipFuncSetAttribute failed\n"); grid = -1; return; }
        if (hipOccupancyMaxActiveBlocksPerMultiprocessor(&per_cu, (const void*)mk_fwd, NWAVES * 64, LDS_BYTES) != hipSuccess || per_cu < 1) { fprintf(stderr, "kernel_launch: occupancy query says %d\n", per_cu); }
        (void)hipGetLastError();
        grid = cus;
    }
    if (grid < 0) return;
    if (hipMemsetAsync((char*)d_ws + WS_CTL, 0, CTL_ZERO_BYTES, stream) != hipSuccess) return;
    Args a{};
    for (int i = 0; i < 23; ++i) a.in[i] = (const float*)d_in[i];
    a.out = (float*)d_out; a.ws = (unsigned char*)d_ws;
#if MK_ONE_LAUNCH
    a.ph_lo = 0; a.ph_hi = N_PHASES;
    hipLaunchKernelGGL(mk_fwd, dim3(grid), dim3(NWAVES * 64), LDS_BYTES, stream, a);
#else
    auto L = [&](void (*k)(Args), int lo, int hi) { a.ph_lo = lo; a.ph_hi = hi; hipLaunchKernelGGL(k, dim3(grid), dim3(NWAVES * 64), LDS_BYTES, stream, a); };
    L(mk_aux, 0, 0);
    L(mk_fwd, 1, 2);
    for (int l = 0; l < DEPTH; ++l) { const int pb = PH_LAYER0 + PH_PER_LAYER * l;
        if (l > 0) L(mk_aux, 1, l);
        L(mk_fwd, pb + 1, pb + 2); L(mk_fwd, pb + 2, pb + 3); L(mk_fwd, pb + 3, pb + 4);
        L(mk_prep, 0, l); L(mk_dsa, 0, l);
        L(mk_fwd, pb + 6, pb + 7); L(mk_fwd, pb + 7, pb + 8); L(mk_fwd, pb + 8, pb + 9); L(mk_fwd, pb + 9, pb + 10); }
    L(mk_aux, 4, 0);
#endif
}
```

```cpp
#include <hip/hip_runtime.h>
#include <cstdio>
#include <cstdint>

#ifndef MK_ONE_LAUNCH
#define MK_ONE_LAUNCH 1
#endif
#ifndef EN_P0
#define EN_P0 MK_ONE_LAUNCH
#endif
#ifndef EN_PREP
#define EN_PREP MK_ONE_LAUNCH
#endif
#ifndef EN_DSA
#define EN_DSA MK_ONE_LAUNCH
#endif
#ifndef DIS_MASK
#define DIS_MASK 0
#endif
#ifndef MK_ONE_LAUNCH
#define MK_ONE_LAUNCH 1
#endif

__device__ __forceinline__ int lane_id_v() { int l; asm volatile("v_mbcnt_lo_u32_b32 %0, -1, 0\n\tv_mbcnt_hi_u32_b32 %0, -1, %0" : "=v"(l)); return l; }
namespace pg8 {
#define PG8_LAS __attribute__((address_space(3)))
typedef unsigned short bf16_t;
typedef short bf16x8 __attribute__((ext_vector_type(8)));
typedef float f32x4 __attribute__((ext_vector_type(4)));
typedef unsigned u32x4 __attribute__((ext_vector_type(4)));
typedef unsigned u32x2 __attribute__((ext_vector_type(2)));
constexpr int BM = 256, BK = 64, HALF = 128, HTB = HALF * BK * 2, STAGE_BYTES = 8 * HTB, NXCD = 8, WGM = 8;

__host__ __device__ __forceinline__ int lds_byte(int r, int c) { const int st = (r >> 4) * 2 + (c >> 5), rr = r & 15, cc = c & 31, ob = rr * 64 + cc * 2; return st * 1024 + (ob ^ (((ob >> 9) & 1) << 5)); }
__host__ __device__ __forceinline__ void stage_rc(int b, int& R, int& C) { const int st = b / 1024, sb = b % 1024, swz = sb ^ (((sb >> 9) & 1) << 5); R = (st >> 1) * 16 + swz / 64; C = (st & 1) * 32 + (swz % 64) / 2; }
__host__ __device__ __forceinline__ int perm32(int rho) { const int n = rho >> 4, i = rho & 15; return 8 * (i >> 2) + 4 * n + (i & 3); }

struct Unit { int pm, pn; };
struct Gemm { const bf16_t* A; const bf16_t* Bt; int M, N, K; };

struct StaticOrder {
    int nM, nN, nwg, G, c;
    __host__ __device__ void init(int M, int N, int G_, int c_) { nM = M / BM; nN = N / BM; nwg = nM * nN; G = G_; c = c_; }
    __host__ __device__ bool next(int i, Unit& u) const {
        const long L = (long)i * G + c; if (L >= nwg) return false;
        int wgid = (int)L; { const int q = nwg / NXCD, r = nwg % NXCD, xcd = wgid % NXCD, off = wgid / NXCD; wgid = (xcd < r ? xcd * (q + 1) : r * (q + 1) + (xcd - r) * q) + off; }
        const int nig = WGM * nN, gid = wgid / nig, fm = gid * WGM, gsz = (nM - fm) < WGM ? (nM - fm) : WGM;
        u.pm = fm + ((wgid % nig) % gsz); u.pn = (wgid % nig) / gsz; return true;
    }
    __device__ __forceinline__ void a_ready(const Unit&) const {}
    __device__ __forceinline__ void done(const Unit&) const {}
};

__device__ __forceinline__ unsigned cvt_pk_bf16(float lo, float hi) { unsigned r; asm volatile("v_cvt_pk_bf16_f32 %0, %1, %2" : "=v"(r) : "v"(lo), "v"(hi)); return r; }

template <class Epi, class Sched, bool ALIGN_EPI = false, bool SP2 = false>
__device__ __forceinline__ void gemm_phase(PG8_LAS unsigned char* lds, const Gemm g, const Sched& S, const Epi& E, const int wid_) {
    int wid = wid_; asm volatile("" : "+s"(wid));
    const int lane = lane_id_v(), tid = wid * 64 + lane,
              wr = wid >> 2, wc = wid & 3, fr = lane & 15, fq = lane >> 4;
    const int K = g.K, nt = K / BK;
    unsigned voffA[2], voffB[2];
#pragma unroll
    for (int i = 0; i < 2; ++i) { int R, C; stage_rc(tid * 16 + i * 8192, R, C); const int Rb = Epi::PERM ? ((R & ~31) + perm32(R & 31)) : R;
        voffA[i] = (unsigned)(R * K + C) * 2u; voffB[i] = (unsigned)(Rb * K + C) * 2u; }
    const size_t kstep = (size_t)(BK * 2);
    const size_t hstep = (size_t)HALF * K * 2;
    const size_t tstep = 2 * hstep;
    const unsigned ldsw = (unsigned)wid * 1024u;
    const int aoff = lds_byte(wr * 64 + fr, fq * 8), boff = lds_byte(wc * 32 + fr, fq * 8);
#define PG8_SA(b, h) (((b) * 2 + (h)) * HTB)
#define PG8_SB(b, h) ((4 + (b) * 2 + (h)) * HTB)
#define PG8_STAGE(bufoff, gbase, voff) do { _Pragma("unroll") for (int _i = 0; _i < 2; ++_i) \
        __builtin_amdgcn_global_load_lds((const unsigned*)((const char*)(gbase) + (voff)[_i]), (PG8_LAS unsigned*)(lds + (bufoff) + ldsw + _i * 8192), 16, 0, 0); } while (0)
#define PG8_LDA(dst, b, h) do { _Pragma("unroll") for (int m = 0; m < 4; ++m) _Pragma("unroll") for (int k = 0; k < 2; ++k) dst[m][k] = *(const PG8_LAS bf16x8*)(lds + PG8_SA(b, h) + aoff + m * 2048 + k * 1024); } while (0)
#define PG8_LDB(dst, b, h) do { _Pragma("unroll") for (int n = 0; n < 2; ++n) _Pragma("unroll") for (int k = 0; k < 2; ++k) dst[n][k] = *(const PG8_LAS bf16x8*)(lds + PG8_SB(b, h) + boff + n * 2048 + k * 1024); } while (0)
#define PG8_MMA(ai, bj, At, Bt) do { __builtin_amdgcn_s_setprio(1); _Pragma("unroll") for (int m = 0; m < 4; ++m) _Pragma("unroll") for (int n = 0; n < 2; ++n) _Pragma("unroll") for (int k = 0; k < 2; ++k) \
        acc[ai][bj][m][n] = __builtin_amdgcn_mfma_f32_16x16x32_bf16(Bt[n][k], At[m][k], acc[ai][bj][m][n], 0, 0, 0); __builtin_amdgcn_s_setprio(0); } while (0)
#define PG8_WAIT_V(n) asm volatile("s_waitcnt vmcnt(" #n ")" ::: "memory")
#define PG8_WAIT_L(n) asm volatile("s_waitcnt lgkmcnt(" #n ")" ::: "memory")
#define PG8_BAR __builtin_amdgcn_s_barrier()
#define PG8_SCHED __builtin_amdgcn_sched_barrier(0)
    Unit cur, nxt; int ui = 0;
    if (!S.next(0, cur)) return;
    f32x4 acc[2][2][4][2];
#pragma unroll
    for (int a = 0; a < 2; ++a)
#pragma unroll
        for (int b = 0; b < 2; ++b)
#pragma unroll
            for (int m = 0; m < 4; ++m)
#pragma unroll
                for (int n = 0; n < 2; ++n) acc[a][b][m][n] = (f32x4){0.f, 0.f, 0.f, 0.f};
    bf16x8 At[4][2], B0[2][2], B1[2][2];
    const char* cA = (const char*)g.A + (size_t)cur.pm * tstep; const char* cB = (const char*)g.Bt + (size_t)cur.pn * tstep;
    S.a_ready(cur);
    if constexpr (SP2) {
        PG8_STAGE(PG8_SB(0, 0), cB, voffB); PG8_STAGE(PG8_SB(0, 1), cB + hstep, voffB); PG8_STAGE(PG8_SA(0, 0), cA, voffA); PG8_STAGE(PG8_SA(0, 1), cA + hstep, voffA);
        if (wr == 1) PG8_BAR;
        PG8_WAIT_V(2); PG8_BAR;
        PG8_STAGE(PG8_SB(1, 0), cB + kstep, voffB); PG8_STAGE(PG8_SA(1, 0), cA + kstep, voffA); PG8_STAGE(PG8_SB(1, 1), cB + hstep + kstep, voffB);
        PG8_WAIT_V(6); PG8_BAR;
    } else {
        PG8_STAGE(PG8_SB(0, 0), cB, voffB); PG8_STAGE(PG8_SA(0, 0), cA, voffA); PG8_STAGE(PG8_SB(0, 1), cB + hstep, voffB); PG8_STAGE(PG8_SA(0, 1), cA + hstep, voffA);
        if (wr == 1) PG8_BAR;
        PG8_WAIT_V(4); PG8_BAR;
        PG8_STAGE(PG8_SB(1, 0), cB + kstep, voffB); PG8_STAGE(PG8_SA(1, 0), cA + kstep, voffA); PG8_STAGE(PG8_SB(1, 1), cB + hstep + kstep, voffB);
        PG8_WAIT_V(6); PG8_BAR;
    }
    for (;;) {
        const bool has_next = S.next(ui + 1, nxt);
        const char* nA = has_next ? (const char*)g.A + (size_t)nxt.pm * tstep : cA; const char* nB = has_next ? (const char*)g.Bt + (size_t)nxt.pn * tstep : cB;
        for (int t = 0; t < nt; t += 2) {
            const bool last = (t == nt - 2);
            const char* a1 = cA + (size_t)(t + 1) * kstep;
            const char* a2 = last ? nA : cA + (size_t)(t + 2) * kstep; const char* b2 = last ? nB : cB + (size_t)(t + 2) * kstep;
            const char* a3 = a2 + kstep; const char* b3 = b2 + kstep;
            if (last && has_next) S.a_ready(nxt);
            if constexpr (SP2) {
            PG8_LDB(B0, 0, 0); PG8_LDB(B1, 0, 1); PG8_SCHED; PG8_LDA(At, 0, 0); PG8_STAGE(PG8_SA(1, 1), a1 + hstep, voffA);
            PG8_WAIT_V(8); PG8_WAIT_L(0); PG8_BAR; PG8_MMA(0, 0, At, B0); PG8_MMA(0, 1, At, B1); PG8_BAR; PG8_SCHED;
            PG8_LDA(At, 0, 1); PG8_STAGE(PG8_SB(0, 0), b2, voffB); PG8_STAGE(PG8_SB(0, 1), b2 + hstep, voffB); PG8_STAGE(PG8_SA(0, 0), a2, voffA);
            PG8_WAIT_V(8); PG8_WAIT_L(0); PG8_BAR; PG8_MMA(1, 0, At, B0); PG8_MMA(1, 1, At, B1); PG8_BAR; PG8_SCHED;
            PG8_LDB(B0, 1, 0); PG8_LDB(B1, 1, 1); PG8_SCHED; PG8_LDA(At, 1, 0); PG8_STAGE(PG8_SA(0, 1), a2 + hstep, voffA);
            PG8_WAIT_V(8); PG8_WAIT_L(0); PG8_BAR; PG8_MMA(0, 0, At, B0); PG8_MMA(0, 1, At, B1); PG8_BAR; PG8_SCHED;
            PG8_LDA(At, 1, 1); PG8_STAGE(PG8_SB(1, 0), b3, voffB); PG8_STAGE(PG8_SB(1, 1), b3 + hstep, voffB); PG8_STAGE(PG8_SA(1, 0), a3, voffA);
            PG8_WAIT_V(8); PG8_WAIT_L(0); PG8_BAR; PG8_MMA(1, 0, At, B0); PG8_MMA(1, 1, At, B1); PG8_BAR; PG8_SCHED;
            } else {
            PG8_LDB(B0, 0, 0); PG8_SCHED; PG8_LDA(At, 0, 0); PG8_STAGE(PG8_SA(1, 1), a1 + hstep, voffA);
            PG8_WAIT_L(8); PG8_BAR; PG8_WAIT_L(0); PG8_MMA(0, 0, At, B0); PG8_BAR; PG8_SCHED;
            PG8_LDB(B1, 0, 1); PG8_STAGE(PG8_SB(0, 0), b2, voffB);
            PG8_BAR; PG8_WAIT_L(0); PG8_MMA(0, 1, At, B1); PG8_BAR;
            PG8_LDA(At, 0, 1); PG8_STAGE(PG8_SA(0, 0), a2, voffA);
            PG8_BAR; PG8_WAIT_L(0); PG8_MMA(1, 0, At, B0); PG8_BAR; PG8_SCHED;
            PG8_STAGE(PG8_SB(0, 1), b2 + hstep, voffB);
            PG8_WAIT_V(6); PG8_BAR; PG8_MMA(1, 1, At, B1); PG8_BAR;
            PG8_LDB(B0, 1, 0); PG8_SCHED; PG8_LDA(At, 1, 0); PG8_STAGE(PG8_SA(0, 1), a2 + hstep, voffA);
            PG8_WAIT_L(8); PG8_BAR; PG8_WAIT_L(0); PG8_MMA(0, 0, At, B0); PG8_BAR; PG8_SCHED;
            PG8_LDB(B1, 1, 1); PG8_STAGE(PG8_SB(1, 0), b3, voffB);
            PG8_BAR; PG8_WAIT_L(0); PG8_MMA(0, 1, At, B1); PG8_BAR;
            PG8_LDA(At, 1, 1); PG8_STAGE(PG8_SA(1, 0), a3, voffA);
            PG8_BAR; PG8_WAIT_L(0); PG8_MMA(1, 0, At, B0); PG8_BAR; PG8_SCHED;
            PG8_STAGE(PG8_SB(1, 1), b3 + hstep, voffB);
            PG8_WAIT_V(6); PG8_BAR; PG8_MMA(1, 1, At, B1); PG8_BAR;
            }
        }
        if constexpr (ALIGN_EPI) { if (wr == 0) PG8_BAR; }
        E(acc, cur, wr, wc, fr, fq); S.done(cur);
        if (!has_next) break;
#pragma unroll
        for (int a = 0; a < 2; ++a)
#pragma unroll
            for (int b = 0; b < 2; ++b)
#pragma unroll
                for (int m = 0; m < 4; ++m)
#pragma unroll
                    for (int n = 0; n < 2; ++n) acc[a][b][m][n] = (f32x4){0.f, 0.f, 0.f, 0.f};
        cur = nxt; cA = nA; cB = nB; ++ui;
        if constexpr (ALIGN_EPI) { if (wr == 1) PG8_BAR; }
    }
    PG8_WAIT_V(0);
    if constexpr (!ALIGN_EPI) { if (wr == 0) PG8_BAR; }
    PG8_BAR;
#undef PG8_SA
#undef PG8_SB
#undef PG8_STAGE
#undef PG8_LDA
#undef PG8_LDB
#undef PG8_MMA
#undef PG8_WAIT_V
#undef PG8_WAIT_L
#undef PG8_BAR
#undef PG8_SCHED
}
}

constexpr int NWAVES = 8;
constexpr int BATCH = 4, SEQ = 8192, D = 1024, DEPTH = 4, M = BATCH * SEQ;
constexpr int NMEM = 256, MROWS = BATCH * NMEM;
constexpr int AH = 8, AHD = 64, AW = 512, KVR = 128, IH = 8, IDIM = 32, TOPK = 256;
constexpr int PW_ = 256, CH = 4, CHD = 64, CW = 256;
constexpr int DFF = 2816, INW = 4520, INP = 5120;
constexpr float EPS = 1e-6f;
constexpr int C_QA = 0, C_CKV = 512, C_IQ = 640, C_IK = 896, C_IW = 928, C_Z = 936, C_QC = 1192, C_G = 1448;

constexpr size_t MiB = 1u << 20;
constexpr size_t WS_CTL = 0, CTL_ZERO_BYTES = 1 * MiB;
constexpr size_t WS_SS = 1 * MiB;
constexpr size_t WS_IW = 3 * MiB;
constexpr size_t WS_SGN = 4 * MiB;
constexpr size_t WS_MEMN = 5 * MiB;
constexpr size_t WS_WMEM = 7 * MiB;
constexpr size_t WS_MEMKV = 11 * MiB;
constexpr size_t WS_W1IN = 15 * MiB, WS_W1OUT = 26 * MiB, WS_WIN = 32 * MiB, WS_WA = 42 * MiB, WS_WB = 44 * MiB, WS_WC = 44 * MiB + 512 * 1024, WS_WOUT = 45 * MiB, WS_W2IN = 47 * MiB, WS_W2OUT = 58 * MiB;
constexpr size_t WS_HB = 64 * MiB;
constexpr size_t WS_ACT = 128 * MiB;
constexpr size_t WS_G = 128 * MiB;
constexpr size_t WS_QL = 320 * MiB;
constexpr size_t WS_CKV = 384 * MiB;
constexpr size_t WS_CKVRAW = 392 * MiB;
constexpr size_t WS_IQRAW = 408 * MiB;
constexpr size_t WS_IQF = 424 * MiB;
constexpr size_t WS_IK = 440 * MiB;
constexpr size_t WS_Z = 442 * MiB;
constexpr size_t WS_MERGED = 384 * MiB;
constexpr size_t WS_YB = 458 * MiB;
constexpr size_t WS_QC = 474 * MiB;
constexpr size_t WS_SEL = 490 * MiB;
constexpr size_t WS_END = 506 * MiB;
constexpr int CW_BAR = 4096;

constexpr int RING_OFF = 0, RING_BYTES = 131072;
constexpr int LDS_BYTES = 155648;
constexpr int MISC_OFF = LDS_BYTES - 256;

#define GAS __attribute__((address_space(1)))
#define LAS __attribute__((address_space(3)))
typedef unsigned short bf16;
typedef unsigned v4u __attribute__((ext_vector_type(4)));
typedef unsigned v2u __attribute__((ext_vector_type(2)));
typedef float f32x4 __attribute__((ext_vector_type(4)));
typedef float f32x2 __attribute__((ext_vector_type(2)));
typedef GAS unsigned gu32;
#define RLX_AGENT __ATOMIC_RELAXED, __HIP_MEMORY_SCOPE_AGENT
#define LDS_WAIT() asm volatile("s_waitcnt lgkmcnt(0)" ::: "memory")
#define VM_WAIT() asm volatile("s_waitcnt vmcnt(0)" ::: "memory")
__device__ __forceinline__ unsigned f2bf(float f) { unsigned u = __builtin_bit_cast(unsigned, f); return (u + 0x7fffu + ((u >> 16) & 1u)) >> 16; }
__device__ __forceinline__ unsigned pk2(float lo, float hi) { return f2bf(lo) | (f2bf(hi) << 16); }
__device__ __forceinline__ float bflo(unsigned w) { return __builtin_bit_cast(float, w << 16); }
__device__ __forceinline__ float bfhi(unsigned w) { return __builtin_bit_cast(float, w & 0xffff0000u); }
__device__ __forceinline__ float bf2f(bf16 b) { return __builtin_bit_cast(float, ((unsigned)b) << 16); }

#define XB_TMO      128
#define XB_XCNT(j)  (256  + 64 * (j))
#define XB_XSUB(j)  (1280 + 64 * (j))
#define XB_XGEN(j)  (2304 + 64 * (j))
#define XB_TOP      3328
#define XB_TOPGEN   3392
#define XCD_BAR_WORDS 3456
#define XB_SPIN_CAP (1u << 23)

__device__ __forceinline__ unsigned xb_ld(unsigned* p)              { return __hip_atomic_load(p, __ATOMIC_RELAXED, __HIP_MEMORY_SCOPE_AGENT); }
__device__ __forceinline__ unsigned xb_add(unsigned* p, unsigned v) { return __hip_atomic_fetch_add(p, v, __ATOMIC_RELAXED, __HIP_MEMORY_SCOPE_AGENT); }
__device__ __forceinline__ unsigned xb_xcc_id() { return (unsigned)__builtin_amdgcn_s_getreg((3 << 11) | 20) & 0xFu; }
#define XB_SPIN(cond, bar) do { unsigned _sp = 0; while (cond) { __builtin_amdgcn_s_sleep(1); \
    if ((++_sp & 255u) == 0u) { if (xb_ld(&(bar)[XB_TMO])) break; if (_sp > XB_SPIN_CAP) { atomicAdd(&(bar)[XB_TMO], 1u); break; } } } } while (0)

struct XcdBarrier { unsigned* bar; unsigned x; volatile LAS unsigned* st; int wave; };

__device__ __forceinline__ XcdBarrier xcd_barrier_post(unsigned* bar, volatile LAS unsigned* st, int wave) {
    XcdBarrier b; b.bar = bar; b.x = xb_xcc_id(); b.st = st; b.wave = wave;
    if (threadIdx.x == 0) (void)xb_add(&bar[XB_XCNT(b.x)], 1u);
    return b;
}
__device__ __forceinline__ void xcd_barrier_complete(unsigned* bar, unsigned x, unsigned& nloc, unsigned& nx) {
    const unsigned G = gridDim.x * gridDim.y * gridDim.z;
    unsigned sum, cnt, mine, sp = 0u;
    for (;;) {
        sum = 0u; cnt = 0u; mine = 0u;
#pragma unroll
        for (unsigned j = 0; j < 16; ++j) { const unsigned c = xb_ld(&bar[XB_XCNT(j)]); sum += c; cnt += (c > 0u) ? 1u : 0u; mine = (j == x) ? c : mine; }
        if (sum == G) break;
        __builtin_amdgcn_s_sleep(1);
        if ((++sp & 255u) == 0u) { if (xb_ld(&bar[XB_TMO])) break; if (sp > XB_SPIN_CAP) { atomicAdd(&bar[XB_TMO], 1u); break; } }
    }
    nloc = mine > 0u ? mine : 1u; nx = cnt > 0u ? cnt : 1u;
}
__device__ __forceinline__ void xcd_barrier(const XcdBarrier& b) {
    asm volatile("s_waitcnt vmcnt(0)" ::: "memory");
    __syncthreads();
    int bw_ = b.wave; asm volatile("" : "+s"(bw_));
    if (bw_ == 0 && lane_id_v() == 0) {
        unsigned* bar = b.bar;
        __builtin_amdgcn_s_waitcnt(0);
        unsigned nloc = b.st[0], nx = b.st[1];
        if (nloc == 0u) { xcd_barrier_complete(bar, b.x, nloc, nx); b.st[0] = nloc; b.st[1] = nx; }
        const unsigned old = xb_add(&bar[XB_XSUB(b.x)], 1u);
        const unsigned gen = old / nloc;
        if (old + 1u == (gen + 1u) * nloc) {
            __builtin_amdgcn_fence(__ATOMIC_RELEASE, "agent");
            asm volatile("s_waitcnt vmcnt(0)" ::: "memory");
            const unsigned og = xb_add(&bar[XB_TOP], 1u);
            const unsigned tg = og / nx;
            if (og + 1u == (tg + 1u) * nx) xb_add(&bar[XB_TOPGEN], 1u);
            else XB_SPIN(xb_ld(&bar[XB_TOPGEN]) == tg, bar);
            __builtin_amdgcn_fence(__ATOMIC_ACQUIRE, "agent");
            xb_add(&bar[XB_XGEN(b.x)], 1u);
            asm volatile("s_waitcnt vmcnt(0)" ::: "memory");
        } else {
            XB_SPIN(xb_ld(&bar[XB_XGEN(b.x)]) == gen, bar);
            __builtin_amdgcn_fence(__ATOMIC_ACQUIRE, "agent");
            asm volatile("s_waitcnt vmcnt(0)" ::: "memory");
        }
    }
    __syncthreads();
}

struct Args {
    const float* in[23]; float* out; unsigned char* ws; int ph_lo, ph_hi;
};
template <class T> __device__ __forceinline__ T* uni(T* p) { const unsigned long long v = (unsigned long long)p; const unsigned lo = __builtin_amdgcn_readfirstlane((unsigned)v), hi = __builtin_amdgcn_readfirstlane((unsigned)(v >> 32)); return (T*)(((unsigned long long)hi << 32) | lo); }
__device__ __forceinline__ LAS unsigned char* uni_l(LAS unsigned char* p) { return (LAS unsigned char*)(unsigned)__builtin_amdgcn_readfirstlane((int)(unsigned)(size_t)p); }
__device__ __forceinline__ int uni_i(int v) { return __builtin_amdgcn_readfirstlane(v); }
struct PC { const float* const* in; float* out; unsigned char* ws; LAS unsigned char* lds; int wave, vcu, G; };
struct Frame {
    LAS unsigned char* lds;
    volatile LAS unsigned* MISC;
    gu32* ctl;
    int wave, vcu, G;
    unsigned char* ws;
};
__device__ __forceinline__ unsigned char* launder_p(unsigned char* p) { asm volatile("" : "+s"(p)); return p; }
__device__ __forceinline__ int launder_s(int v) { asm volatile("" : "+s"(v)); return v; }
__device__ __forceinline__ int launder_v(int v) { asm volatile("" : "+v"(v)); return v; }
__device__ __forceinline__ float wave_sum(float v) {
#pragma unroll
    for (int o = 1; o < 64; o <<= 1) v += __shfl_xor(v, o);
    return v;
}
__device__ __forceinline__ float wave_max(float v) {
#pragma unroll
    for (int o = 1; o < 64; o <<= 1) v = fmaxf(v, __shfl_xor(v, o));
    return v;
}

using pg8::Unit; using pg8::bf16_t;
#define LAUNDER2(a, b) asm volatile("" : "+v"(a), "+v"(b))
__device__ __forceinline__ float row_scale(const float* ss, int row) {
    const f32x4 a = *(const f32x4*)(ss + (size_t)row * 4);
    const float s = (a.x + a.y) + (a.z + a.w);
    return 1.0f / sqrtf(s * (1.0f / D) + EPS);
}
__device__ __forceinline__ float sigmoidf_(float x) { return 1.0f / (1.0f + __expf(-x)); }
__device__ __forceinline__ pg8::u32x2 pack4(const f32x4 v) { pg8::u32x2 w; w.x = pg8::cvt_pk_bf16(v[0], v[1]); w.y = pg8::cvt_pk_bf16(v[2], v[3]); return w; }

struct EpiSwiglu {
    static constexpr bool PERM = false;
    bf16_t* O; const float* ss;
    __device__ __forceinline__ void operator()(const f32x4 (&acc)[2][2][4][2], const Unit& u, int wr, int wc, int fr_, int fq_) const {
        const int l_ = lane_id_v(); const int fr = l_ & 15, fq = l_ >> 4; (void)fr_; (void)fq_;
        int rb = wr * 64 + fr, cb = wc * 16 + 4 * fq; LAUNDER2(rb, cb);
        const int row0 = u.pm * 256 + rb, col0 = u.pn * 128 + cb;
#pragma unroll
        for (int ai = 0; ai < 2; ++ai)
#pragma unroll
            for (int m = 0; m < 4; ++m) { const int row = row0 + ai * 128 + m * 16; const float s = row_scale(ss, row);
                bf16_t* rowp = O + (size_t)row * DFF + col0;
#pragma unroll
                for (int bj = 0; bj < 2; ++bj) { const f32x4 a = acc[ai][bj][m][0] * s, b = acc[ai][bj][m][1] * s; f32x4 o;
#pragma unroll
                    for (int i = 0; i < 4; ++i) o[i] = a[i] * sigmoidf_(a[i]) * b[i];
                    *(pg8::u32x2*)(rowp + bj * 64) = pack4(o); } }
    }
};
struct EpiResid {
    static constexpr bool PERM = false;
    const float* base; float* out; bf16_t* hb; float* ss; float alpha; LAS float* P;
    __device__ __forceinline__ void operator()(const f32x4 (&acc)[2][2][4][2], const Unit& u, int wr, int wc, int fr_, int fq_) const {
        const int l_ = lane_id_v(); const int fr = l_ & 15, fq = l_ >> 4; (void)fr_; (void)fq_;
        int rb = wr * 64 + fr, cb = wc * 32 + 4 * fq; LAUNDER2(rb, cb);
        const int row0 = u.pm * 256 + rb, col0 = u.pn * 256 + cb;
#pragma unroll
        for (int ai = 0; ai < 2; ++ai)
#pragma unroll
            for (int m = 0; m < 4; ++m) { const int row = row0 + ai * 128 + m * 16; const size_t off = (size_t)row * D + col0; float q = 0.f;
#pragma unroll
                for (int bj = 0; bj < 2; ++bj)
#pragma unroll
                    for (int n = 0; n < 2; ++n) { const f32x4 bs = *(const f32x4*)(base + off + bj * 128 + n * 16); const f32x4 v = bs + acc[ai][bj][m][n] * alpha;
                        *(f32x4*)(out + off + bj * 128 + n * 16) = v;
                        *(pg8::u32x2*)(hb + off + bj * 128 + n * 16) = pack4(v);
                        q += (v[0] * v[0] + v[1] * v[1]) + (v[2] * v[2] + v[3] * v[3]); }
                q += __shfl_xor(q, 16); q += __shfl_xor(q, 32);
                if (fq == 0) P[(rb + ai * 128 + m * 16) * 4 + wc] = q;
                asm volatile("" ::: "memory"); }
        asm volatile("s_waitcnt lgkmcnt(0)" ::: "memory"); __builtin_amdgcn_s_barrier(); asm volatile("" ::: "memory");
        const int tid = (wr * 4 + wc) * 64 + fq * 16 + fr;
        if (tid < 256) { const f32x4 p = *(const LAS f32x4*)(P + tid * 4); ss[(size_t)(u.pm * 256 + tid) * 4 + u.pn] = (p.x + p.y) + (p.z + p.w); }
    }
};
struct EpiPlainBf16 {
    static constexpr bool PERM = false;
    bf16_t* O; int ldo;
    __device__ __forceinline__ void operator()(const f32x4 (&acc)[2][2][4][2], const Unit& u, int wr, int wc, int fr_, int fq_) const {
        const int l_ = lane_id_v(); const int fr = l_ & 15, fq = l_ >> 4; (void)fr_; (void)fq_;
        int rb = wr * 64 + fr, cb = wc * 32 + 4 * fq; LAUNDER2(rb, cb);
        const int row0 = u.pm * 256 + rb, col0 = u.pn * 256 + cb;
#pragma unroll
        for (int ai = 0; ai < 2; ++ai)
#pragma unroll
            for (int m = 0; m < 4; ++m) { bf16_t* rowp = O + (size_t)(row0 + ai * 128 + m * 16) * ldo + col0;
#pragma unroll
                for (int bj = 0; bj < 2; ++bj)
#pragma unroll
                    for (int n = 0; n < 2; ++n) *(pg8::u32x2*)(rowp + bj * 128 + n * 16) = pack4(acc[ai][bj][m][n]); }
    }
};
struct EpiInProj {
    static constexpr bool PERM = false;
    const float* ss; bf16_t* qa; float* ckvraw; bf16_t* ik; float* iw; bf16_t* iqraw; bf16_t* z; bf16_t* qc; bf16_t* G;
    __device__ __forceinline__ void operator()(const f32x4 (&acc)[2][2][4][2], const Unit& u, int wr, int wc, int fr_, int fq_) const {
        const int l_ = lane_id_v(); const int fr = l_ & 15, fq = l_ >> 4; (void)fr_; (void)fq_;
        int rb = wr * 64 + fr, ct = wc * 32 + 4 * fq; LAUNDER2(rb, ct);
        const int row0 = u.pm * 256 + rb; const int pn = u.pn;
        if (pn == 4) {
#pragma unroll
            for (int ai = 0; ai < 2; ++ai)
#pragma unroll
                for (int m = 0; m < 4; ++m) { const int row = row0 + ai * 128 + m * 16; const float s = row_scale(ss, row);
#pragma unroll
                    for (int n = 0; n < 2; ++n) { *(f32x4*)(ckvraw + (size_t)row * KVR + ct + n * 16) = acc[ai][0][m][n] * s;
                        if (wc == 0) *(pg8::u32x2*)(ik + (size_t)row * IDIM + 4 * fq + n * 16) = pack4(acc[ai][1][m][n] * s); }
                    if (wc == 1 && fq < 2) *(f32x4*)(iw + (size_t)row * IH + 4 * fq) = acc[ai][1][m][0] * s; }
        } else {
            bf16_t* dst0; int ld; bool sig = false;
            if (pn < 4) { dst0 = qa + pn * 256; ld = 1024; } else if (pn == 5) { dst0 = iqraw; ld = 256; } else if (pn == 6) { dst0 = z; ld = 256; } else if (pn == 7) { dst0 = qc; ld = 256; } else { dst0 = G + (pn - 8) * 256; ld = 3072; sig = true; }
#pragma unroll
            for (int ai = 0; ai < 2; ++ai)
#pragma unroll
                for (int m = 0; m < 4; ++m) { const int row = row0 + ai * 128 + m * 16; const float s = row_scale(ss, row); bf16_t* rowp = dst0 + (size_t)row * ld + ct;
#pragma unroll
                    for (int bj = 0; bj < 2; ++bj)
#pragma unroll
                        for (int n = 0; n < 2; ++n) { f32x4 o = acc[ai][bj][m][n] * s;
                            if (sig) {
#pragma unroll
                                for (int i = 0; i < 4; ++i) o[i] = sigmoidf_(o[i]); }
                            *(pg8::u32x2*)(rowp + bj * 128 + n * 16) = pack4(o); } }
        }
    }
};
template <int MODE> struct EpiMerge {
    static constexpr bool PERM = false;
    bf16_t* Mg; const bf16_t* G;
    __device__ __forceinline__ void operator()(const f32x4 (&acc)[2][2][4][2], const Unit& u, int wr, int wc, int fr_, int fq_) const {
        const int l_ = lane_id_v(); const int fr = l_ & 15, fq = l_ >> 4; (void)fr_; (void)fq_;
        int rb = wr * 64 + fr, cb = wc * 32 + 4 * fq; LAUNDER2(rb, cb);
        const int row0 = u.pm * 256 + rb, col0 = u.pn * 256 + cb;
#pragma unroll
        for (int ai = 0; ai < 2; ++ai)
#pragma unroll
            for (int m = 0; m < 4; ++m) { const int row = row0 + ai * 128 + m * 16;
                const bf16_t* gp = G + (size_t)row * 3072 + MODE * 1024 + col0; bf16_t* mp = Mg + (size_t)row * D + col0;
#pragma unroll
                for (int bj = 0; bj < 2; ++bj)
#pragma unroll
                    for (int n = 0; n < 2; ++n) { const int co = bj * 128 + n * 16;
                        const pg8::u32x2 gw = *(const pg8::u32x2*)(gp + co);
                        f32x4 o = acc[ai][bj][m][n]; o[0] *= bflo(gw.x); o[1] *= bfhi(gw.x); o[2] *= bflo(gw.y); o[3] *= bfhi(gw.y);
                        if (MODE > 0) { const pg8::u32x2 pw = *(const pg8::u32x2*)(mp + co); o[0] += bflo(pw.x); o[1] += bfhi(pw.x); o[2] += bflo(pw.y); o[3] += bfhi(pw.y); }
                        *(pg8::u32x2*)(mp + co) = pack4(o); }
                asm volatile("" ::: "memory"); }
    }
};

template <class Map>
__device__ __forceinline__ void transpose_item(const float* W, int K, int N, const float* gain, bf16* WT, LAS float* scr, int item, int lane, Map map) {
    const int nblk = (N + 31) / 32, kb = item / nblk, nb = item % nblk, k0 = 64 * kb, n0 = 32 * nb;
    const int nn = n0 + (lane & 31); const bool nok = nn < N;
#pragma unroll 4
    for (int i = 0; i < 32; ++i) { const int kk = 2 * i + (lane >> 5); float v = nok ? W[(size_t)(k0 + kk) * N + nn] : 0.f; if (gain) v *= gain[k0 + kk]; scr[kk * 33 + (lane & 31)] = v; }
    LDS_WAIT(); asm volatile("" ::: "memory");
    const int c = lane & 7;
#pragma unroll
    for (int j = 0; j < 4; ++j) { const int n = (lane >> 3) + 8 * j; const LAS float* s = scr + (8 * c) * 33 + n;
        v4u o; o.x = pk2(s[0 * 33], s[1 * 33]); o.y = pk2(s[2 * 33], s[3 * 33]); o.z = pk2(s[4 * 33], s[5 * 33]); o.w = pk2(s[6 * 33], s[7 * 33]);
        if (n0 + n < N) { const int dr = map(n0 + n); if (dr >= 0) *(GAS v4u*)(WT + (size_t)dr * K + k0 + 8 * c) = o; } }
    LDS_WAIT(); asm volatile("" ::: "memory");
}
struct MapId { int off; __device__ __forceinline__ int operator()(int n) const { return off + n; } };
struct MapSwiglu { __device__ __forceinline__ int operator()(int c) const { const int half = c >= DFF ? 1 : 0, j = c - half * DFF; return 32 * (j >> 4) + 16 * half + (j & 15); } };
struct MapInProj { __device__ __forceinline__ int operator()(int c) const {
    if (c < C_CKV) return -1;
    if (c < C_IQ) return 1024 + (c - C_CKV);
    if (c < C_IK) return 1280 + (c - C_IQ);
    if (c < C_IW) return 1152 + (c - C_IK);
    if (c < C_Z) return 1184 + (c - C_IW);
    if (c < C_QC) return 1536 + (c - C_Z);
    if (c < C_G) return 1792 + (c - C_QC);
    return 2048 + (c - C_G); } };
__device__ __forceinline__ void qlat_item(const float* win, const float* mixn, const float* wuk, bf16* WT, int item, int lane) {
    const int kc = item & 127, rh = (item >> 7) & 1, h = item >> 8; const int r = rh * 64 + lane;
    const f32x4* wp = (const f32x4*)(wuk + (size_t)r * (AH * AHD) + h * 64);
    float acc[8] = {0.f, 0.f, 0.f, 0.f, 0.f, 0.f, 0.f, 0.f};
#pragma unroll 1
    for (int dc = 0; dc < 4; ++dc) {
        const f32x4 w0 = wp[4 * dc], w1 = wp[4 * dc + 1], w2 = wp[4 * dc + 2], w3 = wp[4 * dc + 3];
#pragma unroll
        for (int kk = 0; kk < 8; ++kk) { const f32x4* ip = (const f32x4*)(win + (size_t)(kc * 8 + kk) * INW + h * 64 + 16 * dc);
            const f32x4 a0 = ip[0], a1 = ip[1], a2 = ip[2], a3 = ip[3];
            acc[kk] += (a0.x * w0.x + a0.y * w0.y + a0.z * w0.z + a0.w * w0.w) + (a1.x * w1.x + a1.y * w1.y + a1.z * w1.z + a1.w * w1.w)
                     + (a2.x * w2.x + a2.y * w2.y + a2.z * w2.z + a2.w * w2.w) + (a3.x * w3.x + a3.y * w3.y + a3.z * w3.z + a3.w * w3.w);
            if (kk & 1) asm volatile("" ::: "memory"); }
    }
    const f32x4 g0 = *(const f32x4*)(mixn + kc * 8), g1 = *(const f32x4*)(mixn + kc * 8 + 4);
    v4u w; w.x = pk2(acc[0] * g0.x, acc[1] * g0.y); w.y = pk2(acc[2] * g0.z, acc[3] * g0.w); w.z = pk2(acc[4] * g1.x, acc[5] * g1.y); w.w = pk2(acc[6] * g1.z, acc[7] * g1.w);
    *(GAS v4u*)(WT + (size_t)(h * 128 + r) * D + kc * 8) = w;
}
__device__ __forceinline__ void wafold_item(const float* wuv, const float* wba, bf16* WT, int item, int lane) {
    const int ng = item & 15, rg = (item >> 4) & 15, h = item >> 8; const int n = ng * 64 + lane, r0 = rg * 8;
    float acc[8] = {0.f, 0.f, 0.f, 0.f, 0.f, 0.f, 0.f, 0.f};
#pragma unroll 4
    for (int d = 0; d < 64; ++d) { const float wa = wba[(size_t)(h * 64 + d) * D + n];
#pragma unroll
        for (int j = 0; j < 8; ++j) acc[j] += wuv[(size_t)(r0 + j) * (AH * AHD) + h * 64 + d] * wa; }
    v4u w; w.x = pk2(acc[0], acc[1]); w.y = pk2(acc[2], acc[3]); w.z = pk2(acc[4], acc[5]); w.w = pk2(acc[6], acc[7]);
    *(GAS v4u*)(WT + (size_t)n * 1024 + h * 128 + r0) = w;
}
__device__ __forceinline__ int items_of(int K, int N) { return (K / 64) * ((N + 31) / 32); }

__device__ __forceinline__ void prep_layer_weights_body(const PC& F, int l) {
    struct { const float* const* in; } a{F.in};
    const int lane_ = lane_id_v();
    LAS float* scr = (LAS float*)(F.lds + RING_OFF + F.wave * 16384);
    const int gw = F.vcu * NWAVES + F.wave, NGW = F.G * NWAVES;
    const float* f1n = a.in[3] + (size_t)l * D; const float* f1in = a.in[4] + (size_t)l * D * 2 * DFF; const float* f1out = a.in[5] + (size_t)l * DFF * D;
    const float* mixn = a.in[6] + (size_t)l * D; const float* win = a.in[7] + (size_t)l * D * INW;
    const float* wba = a.in[15] + (size_t)l * AW * D; const float* wbb = a.in[16] + (size_t)l * PW_ * D; const float* wbc = a.in[17] + (size_t)l * CW * D;
    const float* wout = a.in[18] + (size_t)l * D * D;
    const float* f2n = a.in[19] + (size_t)l * D; const float* f2in = a.in[20] + (size_t)l * D * 2 * DFF; const float* f2out = a.in[21] + (size_t)l * DFF * D;
    unsigned char* ws = launder_p(F.ws);
    const float* wuk = a.in[9] + (size_t)l * KVR * AH * AHD; const float* wuv = a.in[10] + (size_t)l * KVR * AH * AHD;
    const int I0 = items_of(D, 2 * DFF), I1 = items_of(DFF, D), I2 = items_of(D, INW), I4 = items_of(PW_, D), I5 = items_of(CW, D), I6 = items_of(D, D);
    const int NIT = 2 * I0 + 2 * I1 + I2 + I4 + I5 + I6;
#pragma unroll 1
    for (int it = gw; it < NIT; it += NGW) {
        int r = it;
        if (r < I0) { transpose_item(f1in, D, 2 * DFF, f1n, (bf16*)(ws + WS_W1IN), scr, r, lane_, MapSwiglu{}); continue; } r -= I0;
        if (r < I0) { transpose_item(f2in, D, 2 * DFF, f2n, (bf16*)(ws + WS_W2IN), scr, r, lane_, MapSwiglu{}); continue; } r -= I0;
        if (r < I1) { transpose_item(f1out, DFF, D, nullptr, (bf16*)(ws + WS_W1OUT), scr, r, lane_, MapId{0}); continue; } r -= I1;
        if (r < I1) { transpose_item(f2out, DFF, D, nullptr, (bf16*)(ws + WS_W2OUT), scr, r, lane_, MapId{0}); continue; } r -= I1;
        if (r < I2) { transpose_item(win, D, INW, mixn, (bf16*)(ws + WS_WIN), scr, r, lane_, MapInProj{}); continue; } r -= I2;
        if (r < I4) { transpose_item(wbb, PW_, D, nullptr, (bf16*)(ws + WS_WB), scr, r, lane_, MapId{0}); continue; } r -= I4;
        if (r < I5) { transpose_item(wbc, CW, D, nullptr, (bf16*)(ws + WS_WC), scr, r, lane_, MapId{0}); continue; } r -= I5;
        transpose_item(wout, D, D, nullptr, (bf16*)(ws + WS_WOUT), scr, r, lane_, MapId{0});
    }
    asm volatile("" ::: "memory");
#pragma unroll 1
    for (int it = gw; it < 2048; it += NGW) wafold_item(wuv, wba, (bf16*)(ws + WS_WA), it, lane_);
    asm volatile("" ::: "memory");
#pragma unroll 1
    for (int it = gw; it < 2048; it += NGW) qlat_item(win, mixn, wuk, (bf16*)(ws + WS_WIN), it, lane_);
}

__device__ __noinline__ void p0_prologue(const float* const* in_, float* out_, unsigned char* ws_, LAS unsigned char* lds_, int wave_, int vcu_, int G_) {
    const PC F{uni(in_), uni(out_), uni(ws_), uni_l(lds_), uni_i(wave_), uni_i(vcu_), uni_i(G_)}; struct { const float* const* in; } a{F.in};
    const int lane_ = lane_id_v();
    const int gw = F.vcu * NWAVES + F.wave, NGW = F.G * NWAVES;
    const float* x = a.in[0]; const float* mem = a.in[1];
    bf16* hb = (bf16*)(F.ws + WS_HB); float* ss = (float*)(F.ws + WS_SS); bf16* memn = (bf16*)(F.ws + WS_MEMN);
    for (int m = gw; m < M + MROWS; m += NGW) {
        const bool ismem = m >= M; const int r = ismem ? m - M : m;
        const GAS f32x4* xr = (const GAS f32x4*)((ismem ? mem : x) + (size_t)r * D) + lane_;
        f32x4 v[4]; float s = 0.f;
#pragma unroll
        for (int j = 0; j < 4; ++j) { v[j] = xr[64 * j]; s += (v[j].x * v[j].x + v[j].y * v[j].y) + (v[j].z * v[j].z + v[j].w * v[j].w); }
        s = wave_sum(s);
        float sc = 1.f;
        if (ismem) sc = 1.0f / sqrtf(s * (1.0f / D) + EPS);
        else if (lane_ < 4) ss[(size_t)r * 4 + lane_] = lane_ == 0 ? s : 0.f;
        GAS unsigned long long* o8 = (GAS unsigned long long*)((ismem ? memn : hb) + (size_t)r * D) + lane_;
#pragma unroll
        for (int j = 0; j < 4; ++j) o8[64 * j] = (unsigned long long)pk2(v[j].x * sc, v[j].y * sc) | ((unsigned long long)pk2(v[j].z * sc, v[j].w * sc) << 32);
    }
    LAS float* scr = (LAS float*)(F.lds + RING_OFF + F.wave * 16384);
    const int IM = items_of(D, 2 * CW);
    for (int it = gw; it < DEPTH * IM; it += NGW) { const int l = it / IM, r = it % IM;
        transpose_item(a.in[14] + (size_t)l * D * 2 * CW, D, 2 * CW, a.in[13] + (size_t)l * D, (bf16*)(F.ws + WS_WMEM), scr, r, lane_, MapId{l * 2 * CW}); }
    prep_layer_weights_body(F, 0);
}
__device__ __noinline__ void prep_layer_weights(const float* const* in_, float* out_, unsigned char* ws_, LAS unsigned char* lds_, int l, int wave_, int vcu_, int G_) {
    const PC F{uni(in_), uni(out_), uni(ws_), uni_l(lds_), uni_i(wave_), uni_i(vcu_), uni_i(G_)}; prep_layer_weights_body(F, uni_i(l));
}

__constant__ unsigned char T5_BUCKET[128] = {0, 1, 2, 3, 4, 5, 6, 7, 8, 9, 10, 11, 12, 13, 14, 15, 16, 16, 16, 17, 17, 18, 18, 18, 19, 19, 19, 20, 20, 20, 20, 21, 21, 21, 21, 22, 22, 22, 22, 22, 23, 23, 23, 23, 23, 23, 24, 24, 24, 24, 24, 24, 25, 25, 25, 25, 25, 25, 25, 26, 26, 26, 26, 26, 26, 26, 26, 27, 27, 27, 27, 27, 27, 27, 27, 27, 27, 28, 28, 28, 28, 28, 28, 28, 28, 28, 28, 29, 29, 29, 29, 29, 29, 29, 29, 29, 29, 29, 29, 30, 30, 30, 30, 30, 30, 30, 30, 30, 30, 30, 30, 30, 30, 31, 31, 31, 31, 31, 31, 31, 31, 31, 31, 31, 31, 31, 31, 31};

__device__ __noinline__ void prep_tokens(const float* const* in_, float* out_, unsigned char* ws_, LAS unsigned char* lds_, int l_, int wave_, int vcu_, int G_) {
    const PC F{uni(in_), uni(out_), uni(ws_), uni_l(lds_), uni_i(wave_), uni_i(vcu_), uni_i(G_)}; struct { const float* const* in; } a{F.in}; const int l = uni_i(l_);
    unsigned char* ws = launder_p(F.ws);
    const float* ckvraw = (const float*)(ws + WS_CKVRAW); bf16* ckv = (bf16*)(ws + WS_CKV);
    const bf16* iqraw = (const bf16*)(ws + WS_IQRAW); bf16* iqf = (bf16*)(ws + WS_IQF); const float* iw = (const float*)(ws + WS_IW); unsigned* sgn = (unsigned*)(ws + WS_SGN);
    const bf16* z = (const bf16*)(ws + WS_Z); bf16* yb = (bf16*)(ws + WS_YB); bf16* qc = (bf16*)(ws + WS_QC);
    const bf16* memkv = (const bf16*)(ws + WS_MEMKV);
    const float* kvn = a.in[8] + (size_t)l * KVR; const float* wpool = a.in[11] + (size_t)l * 4 * 64 * 64; const float* pscale = a.in[12] + (size_t)l * PW_;
    LAS float* wp = (LAS float*)(F.lds + RING_OFF);
    for (int i = (F.wave * 64 + lane_id_v()); i < 4 * 64 * 64; i += NWAVES * 64) wp[i] = wpool[i];
    __syncthreads();
    const int gw = F.vcu * NWAVES + F.wave, lane = lane_id_v();
    constexpr int TPW = 16;
    for (int t = gw * TPW; t < M; t += F.G * NWAVES * TPW)
    for (int tt = 0; tt < TPW; ++tt) {
        const int row = t + tt, b = row / SEQ, s = row % SEQ;
        { const f32x2 v = *(const f32x2*)(ckvraw + (size_t)row * KVR + 2 * lane); const float q = wave_sum(v.x * v.x + v.y * v.y);
          const float rs = 1.0f / sqrtf(q * (1.0f / KVR) + EPS); const f32x2 g = *(const f32x2*)(kvn + 2 * lane);
          *(unsigned*)(ckv + (size_t)row * KVR + 2 * lane) = pk2(v.x * rs * g.x, v.y * rs * g.y); }
        { const float wv = iw[(size_t)row * IH + (lane >> 3)]; const float aw = fabsf(wv) * (1.0f / 16.0f);
          const v2u q = *(const v2u*)(iqraw + (size_t)row * 256 + 4 * lane);
          v2u o; o.x = pk2(bflo(q.x) * aw, bfhi(q.x) * aw); o.y = pk2(bflo(q.y) * aw, bfhi(q.y) * aw);
          *(v2u*)(iqf + (size_t)row * 256 + 4 * lane) = o;
          const unsigned long long bal = __ballot(wv < 0.f);
          unsigned mask = 0;
#pragma unroll
          for (int h = 0; h < 8; ++h) mask |= ((unsigned)(bal >> (8 * h)) & 1u) << h;
          if (lane == 0) sgn[row] = mask; }
#pragma unroll
        for (int g = 0; g < 4; ++g) {
            const int w = 2 << g; const int cnt = (s + 1) < w ? (s + 1) : w;
            float sum = 0.f; float z0 = 0.f;
            for (int j = 0; j < cnt; ++j) { const float v = bf2f(z[(size_t)(row - j) * 256 + g * 64 + lane]); sum += v; if (j == 0) z0 = v; }
            const float pooled = sum / (float)cnt - z0;
            float o = 0.f;
#pragma unroll 4
            for (int c = 0; c < 64; ++c) { const float pc = __shfl(pooled, c); o += pc * wp[(g * 64 + c) * 64 + lane]; }
            yb[(size_t)row * 256 + g * 64 + lane] = (bf16)f2bf(o * pscale[g * 64 + lane]);
        }
#pragma unroll 1
        for (int h = 0; h < CH; ++h) {
            const float qd = bf2f(qc[(size_t)row * 256 + h * 64 + lane]);
            float lg[4] = {0.f, 0.f, 0.f, 0.f};
#pragma unroll
            for (int i = 0; i < 4; ++i) { const int mm = lane + 64 * i;
                const v4u* kp = (const v4u*)(memkv + (size_t)(b * NMEM + mm) * 2048 + l * 512 + h * 64);
                float accd = 0.f;
#pragma unroll 2
                for (int c8 = 0; c8 < 8; ++c8) { const v4u kv = kp[c8];
                    const unsigned kw[4] = {kv.x, kv.y, kv.z, kv.w};
#pragma unroll
                    for (int e = 0; e < 4; ++e) { const float q0 = __shfl(qd, c8 * 8 + 2 * e);
                        const float q1 = __shfl(qd, c8 * 8 + 2 * e + 1);
                        accd += q0 * bflo(kw[e]) + q1 * bfhi(kw[e]); } }
                lg[i] = accd * 0.125f; asm volatile("" ::: "memory"); }
            float mx = fmaxf(fmaxf(lg[0], lg[1]), fmaxf(lg[2], lg[3])); mx = wave_max(mx);
            float p[4], sm = 0.f;
#pragma unroll
            for (int i = 0; i < 4; ++i) { p[i] = __expf(lg[i] - mx); sm += p[i]; }
            sm = wave_sum(sm); const float inv = 1.0f / sm;
            float o = 0.f;
#pragma unroll
            for (int i = 0; i < 4; ++i) {
#pragma unroll 8
                for (int j = 0; j < 64; ++j) { const float pj = __shfl(p[i], j); o += pj * bf2f(memkv[(size_t)(b * NMEM + j + 64 * i) * 2048 + l * 512 + 256 + h * 64 + lane]); } }
            qc[(size_t)row * 256 + h * 64 + lane] = (bf16)f2bf(o * inv);
        }
    }
    __syncthreads();
}

__device__ __forceinline__ unsigned key_of(float s) { const unsigned u = __builtin_bit_cast(unsigned, s); return (u & 0x80000000u) ? ~u : (u | 0x80000000u); }

typedef short bf16x8_t __attribute__((ext_vector_type(8)));
typedef short s16x4_t __attribute__((ext_vector_type(4)));
__device__ __forceinline__ void select_query_slow(int q, LAS unsigned char* base  , const bf16* iqf, const unsigned* sgn, const bf16* ik, unsigned short* sel, int lane) {
    LAS unsigned* keys = (LAS unsigned*)base;
    LAS float* qf = (LAS float*)(base + 32768);
    const int b = q / SEQ, t = q % SEQ; const int n = t + 1;
    const size_t brow = (size_t)b * SEQ;
    unsigned short* srow = sel + (size_t)q * TOPK;
    { const v2u w = *(const v2u*)(iqf + (size_t)q * 256 + 4 * lane); qf[4 * lane] = bflo(w.x); qf[4 * lane + 1] = bfhi(w.x); qf[4 * lane + 2] = bflo(w.y); qf[4 * lane + 3] = bfhi(w.y); }
    const unsigned smask = sgn[q];
    LDS_WAIT();
    if (n <= TOPK) { for (int j = lane; j < TOPK; j += 64) srow[j] = (unsigned short)(j < n ? j : 0); return; }
    for (int s0 = 0; s0 < n; s0 += 64) { const int s = s0 + lane;
        if (s < n) {
            const v4u* kp = (const v4u*)(ik + (brow + s) * IDIM);
            float kf[32];
#pragma unroll
            for (int c = 0; c < 4; ++c) { const v4u kv = kp[c]; kf[8 * c] = bflo(kv.x); kf[8 * c + 1] = bfhi(kv.x); kf[8 * c + 2] = bflo(kv.y); kf[8 * c + 3] = bfhi(kv.y); kf[8 * c + 4] = bflo(kv.z); kf[8 * c + 5] = bfhi(kv.z); kf[8 * c + 6] = bflo(kv.w); kf[8 * c + 7] = bfhi(kv.w); }
            float sc = 0.f;
#pragma unroll
            for (int h = 0; h < 8; ++h) { float d = 0.f;
#pragma unroll
                for (int j4 = 0; j4 < 8; ++j4) { const f32x4 qv = *(const LAS f32x4*)(qf + h * 32 + 4 * j4); d += qv.x * kf[4 * j4] + qv.y * kf[4 * j4 + 1] + qv.z * kf[4 * j4 + 2] + qv.w * kf[4 * j4 + 3]; }
                d = fmaxf(d, 0.f); sc += ((smask >> h) & 1u) ? -d : d; }
            keys[s] = key_of(sc + 0.0f);
        } }
    LDS_WAIT();
    unsigned T = 0u;
    for (int bit = 31; bit >= 0; --bit) { const unsigned cand = T | (1u << bit); int cnt = 0;
        for (int s0 = 0; s0 < n; s0 += 64) { const int s = s0 + lane; const bool ge = (s < n) && (keys[s] >= cand); cnt += (int)__builtin_popcountll(__ballot(ge)); }
        if (cnt >= TOPK) T = cand; }
    int cgt = 0;
    for (int s0 = 0; s0 < n; s0 += 64) { const int s = s0 + lane; const bool gt = (s < n) && (keys[s] > T); cgt += (int)__builtin_popcountll(__ballot(gt)); }
    const int need_eq = TOPK - cgt;
    int pos = 0, peq = 0; const unsigned long long lt = (lane == 0) ? 0ull : (~0ull >> (64 - lane));
    for (int s0 = 0; s0 < n; s0 += 64) { const int s = s0 + lane; const unsigned k = (s < n) ? keys[s] : 0u;
        const bool gt = (s < n) && (k > T), eq = (s < n) && (k == T);
        const unsigned long long be = __ballot(eq);
        const int eqrank = peq + (int)__builtin_popcountll(be & lt);
        const bool take = gt || (eq && eqrank < need_eq);
        const unsigned long long bt = __ballot(take);
        if (take) srow[pos + (int)__builtin_popcountll(bt & lt)] = (unsigned short)s;
        pos += (int)__builtin_popcountll(bt); peq += (int)__builtin_popcountll(be); }
    LDS_WAIT();
}

typedef float f32x16 __attribute__((ext_vector_type(16)));
constexpr int SEL_CAP = 128;
constexpr int SL_HIST = 0, SL_SEL = 0, SL_CS = 32768, SL_CI = 65536, SL_KEYS = 81920, SL_ST = 98304;

#define SEL_DECLS \
    LAS unsigned char* const lds = uni_l(lds_); const int wave = uni_i(wave_), b = uni_i(b_), ub = uni_i(ub_); unsigned char* ws = uni(ws_); \
    const bf16* iqf = (const bf16*)(ws + WS_IQF); const unsigned* sgn = (const unsigned*)(ws + WS_SGN); const bf16* ik = (const bf16*)(ws + WS_IK); \
    const int lane = lane_id_v(), tid = wave * 64 + lane; const int kl = lane & 31, c5 = lane >> 5; \
    LAS unsigned* hist = (LAS unsigned*)(lds + SL_HIST); LAS unsigned short* lsel = (LAS unsigned short*)(lds + SL_SEL); LAS float* lcs = (LAS float*)(lds + SL_CS); \
    LAS unsigned short* lci = (LAS unsigned short*)(lds + SL_CI); LAS unsigned* st = (LAS unsigned*)(lds + SL_ST); LAS float* stf = (LAS float*)(lds + SL_ST); \
    const int t0 = ub * 64; const int q0 = b * SEQ + t0; const bf16* ikb = ik + (size_t)b * SEQ * IDIM; const int ntile = (t0 + 64 + 127) >> 7; \
    (void)hist; (void)lsel; (void)lcs; (void)lci; (void)stf; (void)tid;
#define SEL_LOAD_A \
    bf16x8_t af[2][2]; unsigned sm[2][2]; \
    { const int i = kl, a_ = i >> 3, cc_ = (i >> 2) & 1, e_ = i & 3; const int qq_ = 2 * cc_ + (a_ >> 1), hh_ = 4 * (a_ & 1) + e_; \
      _Pragma("unroll") for (int rt = 0; rt < 2; ++rt) _Pragma("unroll") for (int ks = 0; ks < 2; ++ks) af[rt][ks] = *(const bf16x8_t*)(iqf + (size_t)(q0 + 8 * wave + 4 * rt + qq_) * 256 + hh_ * 32 + 16 * ks + 8 * c5); \
      _Pragma("unroll") for (int rt = 0; rt < 2; ++rt) _Pragma("unroll") for (int u = 0; u < 2; ++u) sm[rt][u] = sgn[q0 + 8 * wave + 4 * rt + 2 * c5 + u]; }
#define SEL_STAGE(kt_) do { const int key_ = 16 * wave + (lane >> 2); const int ch_ = (lane & 3) ^ ((key_ >> 2) & 3); \
    __builtin_amdgcn_global_load_lds((const unsigned*)(ikb + (size_t)(128 * (kt_) + key_) * IDIM + ch_ * 8), (LAS unsigned*)(lds + SL_KEYS + ((kt_) & 1) * 8192 + wave * 1024), 16, 0, 0); } while (0)
#define SEL_SCORES(kt_) do { const LAS unsigned char* kb_ = lds + SL_KEYS + ((kt_) & 1) * 8192; \
    _Pragma("unroll") for (int kh = 0; kh < 4; ++kh) { const int key_ = 32 * kh + kl; \
        const bf16x8_t b0_ = *(const LAS bf16x8_t*)(kb_ + key_ * 64 + 16 * ((0 + c5) ^ ((key_ >> 2) & 3))); \
        const bf16x8_t b1_ = *(const LAS bf16x8_t*)(kb_ + key_ * 64 + 16 * ((2 + c5) ^ ((key_ >> 2) & 3))); \
        _Pragma("unroll") for (int rt = 0; rt < 2; ++rt) { f32x16 acc_ = {0.f,0.f,0.f,0.f,0.f,0.f,0.f,0.f,0.f,0.f,0.f,0.f,0.f,0.f,0.f,0.f}; \
            acc_ = __builtin_amdgcn_mfma_f32_32x32x16_bf16(af[rt][0], b0_, acc_, 0, 0, 0); acc_ = __builtin_amdgcn_mfma_f32_32x32x16_bf16(af[rt][1], b1_, acc_, 0, 0, 0); \
            _Pragma("unroll") for (int u = 0; u < 2; ++u) { float s_ = 0.f; \
                _Pragma("unroll") for (int h = 0; h < 8; ++h) { const float d_ = fmaxf(acc_[8 * u + h], 0.f); s_ += ((sm[rt][u] >> h) & 1u) ? -d_ : d_; } \
                sc[rt][kh][u] = s_ + 0.0f; } __builtin_amdgcn_sched_barrier(0); } } } while (0)
#define SEL_BOUNDARY(FINAL) do { \
    const int qq = tid >> 3, part = tid & 7; const LAS v4u* hp = (const LAS v4u*)(hist + qq * 256 + 32 * part); \
    unsigned bins[32]; \
    _Pragma("unroll") for (int i = 0; i < 8; ++i) { const v4u v = hp[i]; bins[4 * i] = v.x; bins[4 * i + 1] = v.y; bins[4 * i + 2] = v.z; bins[4 * i + 3] = v.w; } \
    unsigned ps = 0; \
    _Pragma("unroll") for (int i = 0; i < 32; ++i) ps += bins[i]; \
    unsigned v = ps, tt; \
    tt = __shfl_down(v, 1, 8); if (part + 1 < 8) v += tt; \
    tt = __shfl_down(v, 2, 8); if (part + 2 < 8) v += tt; \
    tt = __shfl_down(v, 4, 8); if (part + 4 < 8) v += tt; \
    unsigned cacc = v - ps; \
    if (cacc < (unsigned)TOPK && v >= (unsigned)TOPK) { int bsel = 0; unsigned na = 0, cb = 0; bool found = false; \
        _Pragma("unroll") for (int i = 31; i >= 0; --i) { const bool hit = !found && (cacc + bins[i] >= (unsigned)TOPK); if (hit) { bsel = i; na = cacc; cb = bins[i]; found = true; } cacc += bins[i]; } \
        st[128 + qq] = (unsigned)(32 * part + bsel); if (FINAL) { st[192 + qq] = na; st[256 + qq] = cb; st[448 + qq] = cb > (unsigned)SEL_CAP ? 1u : 0u; } } } while (0)

__device__ __forceinline__ void sel_pass1(unsigned char* ws_, LAS unsigned char* lds_, int wave_, int b_, int ub_) {
    SEL_DECLS
    unsigned short* sel = (unsigned short*)(ws + WS_SEL);
    __syncthreads();
    if (ub < 4) {
        for (int i = tid; i < 64 * TOPK; i += NWAVES * 64) { const int qq = i >> 8, sl = i & 255; sel[(size_t)(q0 + qq) * TOPK + sl] = (unsigned short)(sl <= t0 + qq ? sl : 0); }
        if (tid == 0) st[512] = 1u;
        asm volatile("s_waitcnt vmcnt(0) lgkmcnt(0)" ::: "memory"); __syncthreads();
        return;
    }
    SEL_LOAD_A
    for (int i = tid; i < 64 * 256; i += NWAVES * 64) hist[i] = 0u;
    if (tid < 64) { st[128 + tid] = 0u; st[448 + tid] = 0u; }
    if (tid == 0) st[512] = 0u;
    float sc[2][4][2];
    float scl[2][2]; int bcur[2][2];
#pragma unroll
    for (int rt = 0; rt < 2; ++rt)
#pragma unroll
        for (int u = 0; u < 2; ++u) { scl[rt][u] = 0.f; bcur[rt][u] = 0; }
    SEL_STAGE(0);
#pragma unroll 1
    for (int kt = 0; kt < ntile; ++kt) {
        asm volatile("s_waitcnt vmcnt(0) lgkmcnt(0)" ::: "memory"); __syncthreads();
        if (kt > 0 && (kt & 3) == 0) {
            SEL_BOUNDARY(false);
            asm volatile("s_waitcnt lgkmcnt(0)" ::: "memory"); __syncthreads();
#pragma unroll
            for (int rt = 0; rt < 2; ++rt)
#pragma unroll
                for (int u = 0; u < 2; ++u) bcur[rt][u] = (int)st[128 + 8 * wave + 4 * rt + 2 * c5 + u];
        }
        if (kt + 1 < ntile) SEL_STAGE(kt + 1);
        SEL_SCORES(kt);
        if (kt == 0) {
#pragma unroll
            for (int rt = 0; rt < 2; ++rt)
#pragma unroll
                for (int u = 0; u < 2; ++u) { float mx = 0.f;
#pragma unroll
                    for (int kh = 0; kh < 4; ++kh) mx = fmaxf(mx, fabsf(sc[rt][kh][u]));
#pragma unroll
                    for (int o = 1; o < 32; o <<= 1) mx = fmaxf(mx, __shfl_xor(mx, o));
                    const float R = mx > 0.f ? 2.0f * mx : 1.0f;
                    scl[rt][u] = 128.0f / R;
                    if (kl == 0) stf[8 * wave + 4 * rt + 2 * c5 + u] = scl[rt][u]; }
        }
        const bool masked = 128 * kt + 127 > t0;
#pragma unroll
        for (int rt = 0; rt < 2; ++rt)
#pragma unroll
            for (int u = 0; u < 2; ++u) { const int qq = 8 * wave + 4 * rt + 2 * c5 + u; const int lim = masked ? (t0 + qq - 128 * kt - kl) : 1000;
#pragma unroll
                for (int kh = 0; kh < 4; ++kh) { const float fb = fmaf(sc[rt][kh][u], scl[rt][u], 128.0f); const int bin = (int)fminf(fmaxf(fb, 0.f), 255.f);
                    if (bin >= bcur[rt][u] && 32 * kh <= lim) (void)__hip_atomic_fetch_add(hist + qq * 256 + bin, 1u, __ATOMIC_RELAXED, __HIP_MEMORY_SCOPE_WORKGROUP); } }
    }
    asm volatile("s_waitcnt vmcnt(0) lgkmcnt(0)" ::: "memory"); __syncthreads();
    SEL_BOUNDARY(true);
    if (tid < 64) { st[320 + tid] = 0u; st[384 + tid] = 0u; }
    asm volatile("s_waitcnt lgkmcnt(0)" ::: "memory"); __syncthreads();
}
__device__ __forceinline__ void sel_pass2(unsigned char* ws_, LAS unsigned char* lds_, int wave_, int b_, int ub_) {
    SEL_DECLS
    if (st[512] != 0u) return;
    SEL_LOAD_A
    float sc[2][4][2];
    float scl[2][2]; int bcur[2][2];
#pragma unroll
    for (int rt = 0; rt < 2; ++rt)
#pragma unroll
        for (int u = 0; u < 2; ++u) { const int qq = 8 * wave + 4 * rt + 2 * c5 + u; scl[rt][u] = stf[qq]; bcur[rt][u] = (int)st[128 + qq]; }
    SEL_STAGE(0);
#pragma unroll 1
    for (int kt = 0; kt < ntile; ++kt) {
        asm volatile("s_waitcnt vmcnt(0) lgkmcnt(0)" ::: "memory"); __syncthreads();
        if (kt + 1 < ntile) SEL_STAGE(kt + 1);
        SEL_SCORES(kt);
        const bool masked = 128 * kt + 127 > t0;
        unsigned slot[2][2][4]; unsigned okm = 0u, abm = 0u;
#pragma unroll
        for (int rt = 0; rt < 2; ++rt)
#pragma unroll
            for (int u = 0; u < 2; ++u) { const int qq = 8 * wave + 4 * rt + 2 * c5 + u; const int lim = masked ? (t0 + qq - 128 * kt - kl) : 1000;
#pragma unroll
                for (int kh = 0; kh < 4; ++kh) { const float fb = fmaf(sc[rt][kh][u], scl[rt][u], 128.0f); const int bin = (int)fminf(fmaxf(fb, 0.f), 255.f);
                    const bool ok = bin >= bcur[rt][u] && 32 * kh <= lim; const bool ab = bin > bcur[rt][u];
                    slot[rt][u][kh] = 0u;
                    if (ok) { slot[rt][u][kh] = __hip_atomic_fetch_add(st + (ab ? 320 : 384) + qq, 1u, __ATOMIC_RELAXED, __HIP_MEMORY_SCOPE_WORKGROUP); okm |= 1u << (rt * 8 + u * 4 + kh); if (ab) abm |= 1u << (rt * 8 + u * 4 + kh); } } }
        if (okm != 0u) {
#pragma unroll
            for (int rt = 0; rt < 2; ++rt)
#pragma unroll
                for (int u = 0; u < 2; ++u) { const int qq = 8 * wave + 4 * rt + 2 * c5 + u;
#pragma unroll
                    for (int kh = 0; kh < 4; ++kh) { const int bit = rt * 8 + u * 4 + kh; const unsigned sl = slot[rt][u][kh]; const int kpos = 128 * kt + 32 * kh + kl;
                        if ((okm >> bit) & 1u) {
                            if ((abm >> bit) & 1u) { if (sl < (unsigned)TOPK) lsel[qq * 256 + sl] = (unsigned short)kpos; }
                            else if (sl < (unsigned)SEL_CAP) { lcs[qq * SEL_CAP + sl] = sc[rt][kh][u]; lci[qq * SEL_CAP + sl] = (unsigned short)kpos; } } } }
        }
    }
    asm volatile("s_waitcnt vmcnt(0) lgkmcnt(0)" ::: "memory"); __syncthreads();
}
__device__ __forceinline__ void sel_resolve(unsigned char* ws_, LAS unsigned char* lds_, int wave_, int b_, int ub_, int wg_, int first_) {
    SEL_DECLS
    const int wg = uni_i(wg_), first = uni_i(first_);
    unsigned short* sel = (unsigned short*)(ws + WS_SEL);
    gu32* slowl = (gu32*)(ws + WS_CTL + 65536) + (size_t)wg * 132;
    if (first && tid == 0) __hip_atomic_store(slowl, 0u, RLX_AGENT);
    if (st[512] != 0u) return;
#pragma unroll 1
    for (int qi = 0; qi < 8; ++qi) { const int qq = 8 * wave + qi; const int q = q0 + qq;
        const int na = (int)st[192 + qq], need = TOPK - na; int C = (int)st[384 + qq]; C = C < SEL_CAP ? C : SEL_CAP;
        const bool slow = st[448 + qq] != 0u;
        if (!slow) {
#pragma unroll
            for (int e = 0; e < SEL_CAP / 64; ++e) { const int i = lane + 64 * e;
                if (i < C) { const float si = lcs[qq * SEL_CAP + i]; const int ii = lci[qq * SEL_CAP + i]; int rank = 0;
                    for (int jx = 0; jx < C; ++jx) { const float sj = lcs[qq * SEL_CAP + jx]; const int ij = lci[qq * SEL_CAP + jx]; rank += (sj > si || (sj == si && ij < ii)) ? 1 : 0; }
                    if (rank < need) lsel[qq * 256 + na + rank] = (unsigned short)ii; } }
            LDS_WAIT();
            *(v2u*)(sel + (size_t)q * TOPK + 4 * lane) = *(const LAS v2u*)(lsel + qq * 256 + 4 * lane);
        }
    }
    __syncthreads();
    if (tid == 0) { unsigned n = first ? 0u : __hip_atomic_load(slowl, RLX_AGENT);
        for (int qq = 0; qq < 64; ++qq) if (st[448 + qq] != 0u) { if (n < 128u) { __hip_atomic_store(slowl + 1 + n, (unsigned)(q0 + qq), RLX_AGENT); ++n; } }
        __hip_atomic_store(slowl, n, RLX_AGENT); }
    asm volatile("s_waitcnt vmcnt(0)" ::: "memory");
    __syncthreads();
}
#undef SEL_DECLS
#undef SEL_LOAD_A
#undef SEL_STAGE
#undef SEL_SCORES
#undef SEL_BOUNDARY
__device__ __noinline__ void dsa_select_slow(unsigned char* ws_, LAS unsigned char* lds_, int wave_, int wg_) {
    LAS unsigned char* const lds = uni_l(lds_); const int wave = uni_i(wave_), wg = uni_i(wg_);
    unsigned char* ws = uni(ws_);
    const bf16* iqf = (const bf16*)(ws + WS_IQF); const unsigned* sgn = (const unsigned*)(ws + WS_SGN); const bf16* ik = (const bf16*)(ws + WS_IK);
    unsigned short* sel = (unsigned short*)(ws + WS_SEL);
    gu32* slowl = (gu32*)(ws + WS_CTL + 65536) + (size_t)wg * 132;
    const int lane = lane_id_v();
    const int n = (int)__builtin_amdgcn_readfirstlane(__hip_atomic_load(slowl, RLX_AGENT));
    if (wave < 4) for (int k = wave; k < n; k += 4) { const int q = (int)__builtin_amdgcn_readfirstlane(__hip_atomic_load(slowl + 1 + k, RLX_AGENT)); select_query_slow(q, lds + wave * 36864, iqf, sgn, ik, sel, lane); }
    asm volatile("s_waitcnt vmcnt(0)" ::: "memory");
    __syncthreads();
}

__device__ __forceinline__ unsigned offb(unsigned row, unsigned ch) { return 256u * row + 16u * (ch ^ (((row & 3u) << 2) | ((row >> 2) & 3u))); }
__device__ __forceinline__ s16x4_t vtr(const LAS unsigned char* p) { return __builtin_bit_cast(s16x4_t, __builtin_amdgcn_ds_read_tr16_b64_v4i16((LAS s16x4_t*)p)); }

__device__ __noinline__ void dsa_attend(unsigned char* ws_, LAS unsigned char* lds_, const float* relb_, int wave_, int vcu_, int G_) {
    LAS unsigned char* const lds = uni_l(lds_); const int wave = uni_i(wave_), vcu = uni_i(vcu_), G = uni_i(G_);
    unsigned char* ws = uni(ws_); const float* relb = uni(relb_);
    const bf16* ckv = (const bf16*)(ws + WS_CKV); bf16* ql = (bf16*)(ws + WS_QL); const unsigned short* sel = (const unsigned short*)(ws + WS_SEL);
    const int lane = lane_id_v(), tid = wave * 64 + lane;
    LAS unsigned char* cb = lds + wave * 16384;
    LAS unsigned short* sidx = (LAS unsigned short*)(lds + 131072 + wave * 512);
    LAS float* biasd = (LAS float*)(lds + 135168);
    for (int i = tid; i < 129 * 8; i += NWAVES * 64) { const int d = i >> 3, h = i & 7; const int bk = d < 128 ? (int)T5_BUCKET[d] : 31; biasd[i] = relb[bk * 8 + h]; }
    __syncthreads();
    const int hl = lane & 15, g = lane >> 4, hq = hl & 7;
    for (int p = vcu; p < BATCH * 64; p += G) {
        const int b = p >> 6, j = p & 63;
#pragma unroll 1
        for (int half = 0; half < 2; ++half) {
            const int ub = half == 0 ? j : 127 - j;
#pragma unroll 1
            for (int qi = 0; qi < 8; ++qi) {
                const int t = ub * 64 + wave * 8 + qi; const int q = b * SEQ + t; const int nsel = (t + 1) < TOPK ? (t + 1) : TOPK;
                const bf16* ckvb = ckv + (size_t)b * SEQ * KVR; bf16* qlrow = ql + (size_t)q * 1024;
                { const v2u w = *(const v2u*)(sel + (size_t)q * TOPK + 4 * lane); *(LAS v2u*)(sidx + 4 * lane) = w; }
                bf16x8_t qf[4];
#pragma unroll
                for (int s = 0; s < 4; ++s) qf[s] = *(const bf16x8_t*)(qlrow + hq * 128 + 32 * s + 8 * g);
                LDS_WAIT();
                float mrun = -1e30f, lsum = 0.f;
                f32x4 O[8];
#pragma unroll
                for (int c = 0; c < 8; ++c) O[c] = (f32x4){0.f, 0.f, 0.f, 0.f};
#define DSA_GATHER(c_) do { LAS unsigned char* dst_ = cb + ((c_) & 1) * 8192; \
                    _Pragma("unroll") for (int k_ = 0; k_ < 8; ++k_) { const int row_ = 4 * k_ + g; const int kidx_ = sidx[32 * (c_) + row_]; \
                        const int ch_ = hl ^ ((g << 2) | (k_ & 3)); \
                        __builtin_amdgcn_global_load_lds((const unsigned*)(ckvb + (size_t)kidx_ * KVR + ch_ * 8), (LAS unsigned*)(dst_ + k_ * 1024), 16, 0, 0); } } while (0)
                DSA_GATHER(0);
#pragma unroll 1
                for (int c = 0; c < 8; ++c) {
                    if (c < 7) { DSA_GATHER(c + 1); asm volatile("s_waitcnt vmcnt(8)" ::: "memory"); }
                    else asm volatile("s_waitcnt vmcnt(0)" ::: "memory");
                    const LAS unsigned char* img = cb + (c & 1) * 8192;
                    f32x4 S[2];
#pragma unroll
                    for (int rb = 0; rb < 2; ++rb) { S[rb] = (f32x4){0.f, 0.f, 0.f, 0.f}; const unsigned row = 8u * (hl >> 2) + 4u * rb + (hl & 3);
#pragma unroll
                        for (int s = 0; s < 4; ++s) { const bf16x8_t af = *(const LAS bf16x8_t*)(img + offb(row, 4 * s + g)); S[rb] = __builtin_amdgcn_mfma_f32_16x16x32_bf16(af, qf[s], S[rb], 0, 0, 0); } }
                    float pv[2][4]; float mx = -1e30f;
#pragma unroll
                    for (int rb = 0; rb < 2; ++rb) { const v2u iw2 = *(const LAS v2u*)(sidx + 32 * c + 8 * g + 4 * rb);
                        const int ki[4] = {(int)(iw2.x & 0xffffu), (int)(iw2.x >> 16), (int)(iw2.y & 0xffffu), (int)(iw2.y >> 16)};
#pragma unroll
                        for (int r = 0; r < 4; ++r) { int dist = t - ki[r]; dist = dist < 0 ? 0 : (dist > 128 ? 128 : dist);
                            float lg = S[rb][r] * 0.125f + biasd[dist * 8 + hq];
                            if (32 * c + 8 * g + 4 * rb + r >= nsel) lg = -1e30f;
                            pv[rb][r] = lg; mx = fmaxf(mx, lg); } }
                    mx = fmaxf(mx, __shfl_xor(mx, 16)); mx = fmaxf(mx, __shfl_xor(mx, 32));
                    const float mnew = fmaxf(mrun, mx); const float alpha = __expf(mrun - mnew); mrun = mnew;
                    float rs = 0.f;
#pragma unroll
                    for (int rb = 0; rb < 2; ++rb)
#pragma unroll
                        for (int r = 0; r < 4; ++r) { pv[rb][r] = __expf(pv[rb][r] - mnew); rs += pv[rb][r]; }
                    rs += __shfl_xor(rs, 16); rs += __shfl_xor(rs, 32);
                    lsum = lsum * alpha + rs;
                    v4u pw; pw.x = pg8::cvt_pk_bf16(pv[0][0], pv[0][1]); pw.y = pg8::cvt_pk_bf16(pv[0][2], pv[0][3]); pw.z = pg8::cvt_pk_bf16(pv[1][0], pv[1][1]); pw.w = pg8::cvt_pk_bf16(pv[1][2], pv[1][3]);
                    const bf16x8_t pf = __builtin_bit_cast(bf16x8_t, pw);
                    float al[4];
#pragma unroll
                    for (int r = 0; r < 4; ++r) al[r] = __shfl(alpha, 4 * g + r);
#pragma unroll
                    for (int cd = 0; cd < 8; ++cd) {
                        f32x4 o = O[cd]; o[0] *= al[0]; o[1] *= al[1]; o[2] *= al[2]; o[3] *= al[3];
                        const unsigned q4 = hl >> 2, p4 = hl & 3;
                        const s16x4_t b0 = vtr(img + offb(8u * g + q4, 2 * cd + (p4 >> 1)) + 8u * (p4 & 1));
                        const s16x4_t b1 = vtr(img + offb(8u * g + 4u + q4, 2 * cd + (p4 >> 1)) + 8u * (p4 & 1));
                        bf16x8_t bf; bf[0] = b0[0]; bf[1] = b0[1]; bf[2] = b0[2]; bf[3] = b0[3]; bf[4] = b1[0]; bf[5] = b1[1]; bf[6] = b1[2]; bf[7] = b1[3];
                        O[cd] = __builtin_amdgcn_mfma_f32_16x16x32_bf16(pf, bf, o, 0, 0, 0);
                    }
                }
#undef DSA_GATHER
                const float linv = 1.0f / lsum; float li[4];
#pragma unroll
                for (int r = 0; r < 4; ++r) li[r] = __shfl(linv, 4 * g + r);
                LAS unsigned short* ost = (LAS unsigned short*)cb;
                if (g < 2) {
#pragma unroll
                    for (int cd = 0; cd < 8; ++cd)
#pragma unroll
                        for (int r = 0; r < 4; ++r) ost[(4 * g + r) * 128 + 16 * cd + hl] = (unsigned short)f2bf(O[cd][r] * li[r]);
                }
                LDS_WAIT();
                { const v4u w0 = *(const LAS v4u*)(cb + 32 * lane), w1 = *(const LAS v4u*)(cb + 32 * lane + 16);
                  *(v4u*)(qlrow + 16 * lane) = w0; *(v4u*)(qlrow + 16 * lane + 8) = w1; }
                LDS_WAIT();
            }
        }
    }
    __syncthreads();
}

__device__ __noinline__ void final_norm(const float* const* in_, float* out_, unsigned char* ws_, LAS unsigned char* lds_, int wave_, int vcu_, int G_) {
    const PC F{uni(in_), uni(out_), uni(ws_), uni_l(lds_), uni_i(wave_), uni_i(vcu_), uni_i(G_)}; struct { const float* const* in; float* out; } a{F.in, F.out};
    const int lane_ = lane_id_v(); const int gw = F.vcu * NWAVES + F.wave, NGW = F.G * NWAVES; const float* g = a.in[22];
    f32x4 gv[4];
#pragma unroll
    for (int j = 0; j < 4; ++j) gv[j] = ((const f32x4*)g)[lane_ + 64 * j];
    for (int m = gw; m < M; m += NGW) {
        GAS f32x4* xr = (GAS f32x4*)(a.out + (size_t)m * D) + lane_;
        f32x4 v[4]; float s = 0.f;
#pragma unroll
        for (int j = 0; j < 4; ++j) { v[j] = xr[64 * j]; s += (v[j].x * v[j].x + v[j].y * v[j].y) + (v[j].z * v[j].z + v[j].w * v[j].w); }
        const float rs = 1.0f / sqrtf(wave_sum(s) * (1.0f / D) + EPS);
#pragma unroll
        for (int j = 0; j < 4; ++j) xr[64 * j] = v[j] * rs * gv[j];
    }
}

#define KIN ((const float* const*)__builtin_amdgcn_kernarg_segment_ptr())
constexpr int PH_PER_LAYER = 10, PH_LAYER0 = 2, N_PHASES = PH_LAYER0 + PH_PER_LAYER * DEPTH + 1;

__global__ void __launch_bounds__(NWAVES * 64, 2) mk_fwd(Args args) {
    extern __shared__ __attribute__((aligned(16))) unsigned char lds[];
    Frame F;
    F.lds = (LAS unsigned char*)lds;
    F.MISC = (volatile LAS unsigned*)(F.lds + MISC_OFF);
    F.wave = __builtin_amdgcn_readfirstlane((int)threadIdx.x >> 6);
    F.G = gridDim.x; { const int bx = blockIdx.x; F.vcu = (F.G % 8 == 0) ? (bx % 8) * (F.G / 8) + bx / 8 : bx; }
    F.ws = args.ws; F.ctl = (gu32*)(args.ws + WS_CTL);
    if (threadIdx.x < 64) ((LAS unsigned*)(F.lds + MISC_OFF))[threadIdx.x] = 0u;
    __syncthreads();
    const int lo = args.ph_lo, hi = args.ph_hi;
    const bool multi = (hi - lo) > 1;
    XcdBarrier bar; bar.bar = (unsigned*)(F.ctl + CW_BAR); bar.x = 0; bar.st = nullptr; bar.wave = F.wave;
    if (multi) bar = xcd_barrier_post((unsigned*)(F.ctl + CW_BAR), F.MISC + 8, F.wave);
#define IN(k) (lo <= (k) && (k) < hi)
#define SEAM(k) do { if (IN(k) && IN((k) + 1)) xcd_barrier(bar); } while (0)

    if (IN(0)) {
#if EN_P0
 p0_prologue(KIN, args.out, args.ws, F.lds, F.wave, F.vcu, F.G);
#endif
 } SEAM(0);
    if (IN(1)) {
#if !((DIS_MASK >> 7) & 1)
 unsigned char* ws = launder_p(args.ws); bf16* hb = (bf16*)(ws + WS_HB); float* ss = (float*)(ws + WS_SS); (void)hb; (void)ss;
        pg8::Gemm g{(const bf16_t*)(ws + WS_MEMN), (const bf16_t*)(ws + WS_WMEM), MROWS, DEPTH * 2 * CW, D}; pg8::StaticOrder S; S.init(MROWS, DEPTH * 2 * CW, F.G, launder_s((int)blockIdx.x));
        EpiPlainBf16 E{(bf16_t*)(ws + WS_MEMKV), DEPTH * 2 * CW};
        pg8::gemm_phase<EpiPlainBf16, pg8::StaticOrder, true, true>(F.lds + RING_OFF, g, S, E, F.wave);
#endif
    } SEAM(1);

    for (int l = 0; l < DEPTH; ++l) {
        const int pb = PH_LAYER0 + PH_PER_LAYER * l;
        const float* hbase = (l == 0) ? args.in[0] : args.out;
        if (IN(pb + 0)) {
#if EN_P0
 if (l > 0) prep_layer_weights(KIN, args.out, args.ws, F.lds, l, F.wave, F.vcu, F.G);
#endif
 } SEAM(pb + 0);
        if (IN(pb + 1)) {
#if !((DIS_MASK >> 0) & 1)
 unsigned char* ws = launder_p(args.ws); bf16* hb = (bf16*)(ws + WS_HB); float* ss = (float*)(ws + WS_SS); (void)hb; (void)ss;
            pg8::Gemm g{hb, (const bf16_t*)(ws + WS_W1IN), M, 2 * DFF, D}; pg8::StaticOrder S; S.init(M, 2 * DFF, F.G, launder_s((int)blockIdx.x));
            EpiSwiglu E{(bf16_t*)(ws + WS_ACT), ss};
            pg8::gemm_phase<EpiSwiglu, pg8::StaticOrder, true, true>(F.lds + RING_OFF, g, S, E, F.wave);
#endif
        } SEAM(pb + 1);
        if (IN(pb + 2)) {
#if !((DIS_MASK >> 1) & 1)
 unsigned char* ws = launder_p(args.ws); bf16* hb = (bf16*)(ws + WS_HB); float* ss = (float*)(ws + WS_SS); (void)hb; (void)ss;
            pg8::Gemm g{(const bf16_t*)(ws + WS_ACT), (const bf16_t*)(ws + WS_W1OUT), M, D, DFF}; pg8::StaticOrder S; S.init(M, D, F.G, launder_s((int)blockIdx.x));
            EpiResid E{hbase, args.out, hb, ss, 0.5f, (LAS float*)(F.lds + RING_BYTES)};
            pg8::gemm_phase<EpiResid, pg8::StaticOrder, true, true>(F.lds + RING_OFF, g, S, E, F.wave);
#endif
        } SEAM(pb + 2);
        if (IN(pb + 3)) {
#if !((DIS_MASK >> 2) & 1)
 unsigned char* ws = launder_p(args.ws); bf16* hb = (bf16*)(ws + WS_HB); float* ss = (float*)(ws + WS_SS); (void)hb; (void)ss;
            pg8::Gemm g{hb, (const bf16_t*)(ws + WS_WIN), M, INP, D}; pg8::StaticOrder S; S.init(M, INP, F.G, launder_s((int)blockIdx.x));
            EpiInProj E{ss, (bf16_t*)(ws + WS_QL), (float*)(ws + WS_CKVRAW), (bf16_t*)(ws + WS_IK), (float*)(ws + WS_IW), (bf16_t*)(ws + WS_IQRAW), (bf16_t*)(ws + WS_Z), (bf16_t*)(ws + WS_QC), (bf16_t*)(ws + WS_G)};
            pg8::gemm_phase<EpiInProj, pg8::StaticOrder, true, true>(F.lds + RING_OFF, g, S, E, F.wave);
#endif
        } SEAM(pb + 3);
        if (IN(pb + 4)) {
#if EN_PREP
 prep_tokens(KIN, args.out, args.ws, F.lds, l, F.wave, F.vcu, F.G);
#endif
 } SEAM(pb + 4);
        if (IN(pb + 5)) {
#if EN_DSA
 for (int p = F.vcu; p < BATCH * 64; p += F.G) { for (int half = 0; half < 2; ++half) { const int b_ = p >> 6, ub_ = half == 0 ? (p & 63) : 127 - (p & 63);
   sel_pass1(args.ws, F.lds, F.wave, b_, ub_); sel_pass2(args.ws, F.lds, F.wave, b_, ub_); sel_resolve(args.ws, F.lds, F.wave, b_, ub_, (int)blockIdx.x, (p == F.vcu && half == 0) ? 1 : 0); } }
 dsa_select_slow(args.ws, F.lds, F.wave, (int)blockIdx.x); dsa_attend(args.ws, F.lds, args.in[2], F.wave, F.vcu, F.G);
#endif
 } SEAM(pb + 5);
        if (IN(pb + 6)) {
#if !((DIS_MASK >> 3) & 1)
 unsigned char* ws = launder_p(args.ws); bf16* hb = (bf16*)(ws + WS_HB); float* ss = (float*)(ws + WS_SS); (void)hb; (void)ss;
            { pg8::Gemm g{(const bf16_t*)(ws + WS_QL), (const bf16_t*)(ws + WS_WA), M, D, 1024}; pg8::StaticOrder S; S.init(M, D, F.G, launder_s((int)blockIdx.x));
              EpiMerge<0> E{(bf16_t*)(ws + WS_MERGED), (const bf16_t*)(ws + WS_G)};
              pg8::gemm_phase<EpiMerge<0>, pg8::StaticOrder, true, true>(F.lds + RING_OFF, g, S, E, F.wave); }
            { pg8::Gemm g{(const bf16_t*)(ws + WS_YB), (const bf16_t*)(ws + WS_WB), M, D, PW_}; pg8::StaticOrder S; S.init(M, D, F.G, launder_s((int)blockIdx.x));
              EpiMerge<1> E{(bf16_t*)(ws + WS_MERGED), (const bf16_t*)(ws + WS_G)};
              pg8::gemm_phase<EpiMerge<1>, pg8::StaticOrder, true, true>(F.lds + RING_OFF, g, S, E, F.wave); }
            { pg8::Gemm g{(const bf16_t*)(ws + WS_QC), (const bf16_t*)(ws + WS_WC), M, D, CW}; pg8::StaticOrder S; S.init(M, D, F.G, launder_s((int)blockIdx.x));
              EpiMerge<2> E{(bf16_t*)(ws + WS_MERGED), (const bf16_t*)(ws + WS_G)};
              pg8::gemm_phase<EpiMerge<2>, pg8::StaticOrder, true, true>(F.lds + RING_OFF, g, S, E, F.wave); }
#endif
        } SEAM(pb + 6);
        if (IN(pb + 7)) {
#if !((DIS_MASK >> 4) & 1)
 unsigned char* ws = launder_p(args.ws); bf16* hb = (bf16*)(ws + WS_HB); float* ss = (float*)(ws + WS_SS); (void)hb; (void)ss;
            pg8::Gemm g{(const bf16_t*)(ws + WS_MERGED), (const bf16_t*)(ws + WS_WOUT), M, D, D}; pg8::StaticOrder S; S.init(M, D, F.G, launder_s((int)blockIdx.x));
            EpiResid E{args.out, args.out, hb, ss, 1.0f, (LAS float*)(F.lds + RING_BYTES)};
            pg8::gemm_phase<EpiResid, pg8::StaticOrder, true, true>(F.lds + RING_OFF, g, S, E, F.wave);
#endif
        } SEAM(pb + 7);
        if (IN(pb + 8)) {
#if !((DIS_MASK >> 5) & 1)
 unsigned char* ws = launder_p(args.ws); bf16* hb = (bf16*)(ws + WS_HB); float* ss = (float*)(ws + WS_SS); (void)hb; (void)ss;
            pg8::Gemm g{hb, (const bf16_t*)(ws + WS_W2IN), M, 2 * DFF, D}; pg8::StaticOrder S; S.init(M, 2 * DFF, F.G, launder_s((int)blockIdx.x));
            EpiSwiglu E{(bf16_t*)(ws + WS_ACT), ss};
            pg8::gemm_phase<EpiSwiglu, pg8::StaticOrder, true, true>(F.lds + RING_OFF, g, S, E, F.wave);
#endif
        } SEAM(pb + 8);
        if (IN(pb + 9)) {
#if !((DIS_MASK >> 6) & 1)
 unsigned char* ws = launder_p(args.ws); bf16* hb = (bf16*)(ws + WS_HB); float* ss = (float*)(ws + WS_SS); (void)hb; (void)ss;
            pg8::Gemm g{(const bf16_t*)(ws + WS_ACT), (const bf16_t*)(ws + WS_W2OUT), M, D, DFF}; pg8::StaticOrder S; S.init(M, D, F.G, launder_s((int)blockIdx.x));
            EpiResid E{args.out, args.out, hb, ss, 0.5f, (LAS float*)(F.lds + RING_BYTES)};
            pg8::gemm_phase<EpiResid, pg8::StaticOrder, true, true>(F.lds + RING_OFF, g, S, E, F.wave);
#endif
        } SEAM(pb + 9);
    }
#if EN_P0
    if (IN(N_PHASES - 1)) { final_norm(KIN, args.out, args.ws, F.lds, F.wave, F.vcu, F.G); }
#endif
#undef IN
#undef SEAM
}

extern "C" void kernel_launch(void* const* d_in, const int* in_sizes, int n_in, void* d_out, int out_size, void* d_ws, size_t ws_size, hipStream_t stream) {
    static int grid = 0;
    if (grid == 0) {
        if (n_in != 23 || in_sizes[0] != M * D || out_size != M * D || ws_size < WS_END) { fprintf(stderr, "kernel_launch: unexpected shapes (n_in %d, ws %zu)\n", n_in, ws_size); grid = -1; return; }
        int dev = 0, cus = 0, per_cu = 0;
        if (hipGetDevice(&dev) != hipSuccess || hipDeviceGetAttribute(&cus, hipDeviceAttributeMultiprocessorCount, dev) != hipSuccess) { grid = -1; return; }
        if (hipFuncSetAttribute((const void*)mk_fwd, hipFuncAttributeMaxDynamicSharedMemorySize, LDS_BYTES) != hipSuccess) { fprintf(stderr, "kernel_launch: hipFuncSetAttribute failed\n"); grid = -1; return; }
        if (hipOccupancyMaxActiveBlocksPerMultiprocessor(&per_cu, (const void*)mk_fwd, NWAVES * 64, LDS_BYTES) != hipSuccess || per_cu < 1) { fprintf(stderr, "kernel_launch: occupancy query says %d\n", per_cu); }
        (void)hipGetLastError();
        grid = cus;
    }
    if (grid < 0) return;
    if (hipMemsetAsync((char*)d_ws + WS_CTL, 0, CTL_ZERO_BYTES, stream) != hipSuccess) return;
    Args a{};
    for (int i = 0; i < 23; ++i) a.in[i] = (const float*)d_in[i];
    a.out = (float*)d_out; a.ws = (unsigned char*)d_ws;
#if MK_ONE_LAUNCH
    a.ph_lo = 0; a.ph_hi = N_PHASES;
    hipLaunchKernelGGL(mk_fwd, dim3(grid), dim3(NWAVES * 64), LDS_BYTES, stream, a);
#endif
}
```

```cpp
#include <hip/hip_runtime.h>
#include <cstdio>
#include <cstdint>

#ifndef MK_ONE_LAUNCH
#define MK_ONE_LAUNCH 1
#endif
#ifndef PROBE_PHASE
#define PROBE_PHASE 0
#endif
#ifndef EN_P0
#define EN_P0 MK_ONE_LAUNCH
#endif
#ifndef EN_PREP
#define EN_PREP MK_ONE_LAUNCH
#endif
#ifndef EN_DSA
#define EN_DSA MK_ONE_LAUNCH
#endif
#ifndef DIS_MASK
#define DIS_MASK 0
#endif
#ifndef MK_ONE_LAUNCH
#define MK_ONE_LAUNCH 1
#endif

__device__ __forceinline__ int lane_id_v() { int l; asm volatile("v_mbcnt_lo_u32_b32 %0, -1, 0\n\tv_mbcnt_hi_u32_b32 %0, -1, %0" : "=v"(l)); return l; }
namespace pg8 {
#define PG8_LAS __attribute__((address_space(3)))
typedef unsigned short bf16_t;
typedef short bf16x8 __attribute__((ext_vector_type(8)));
typedef float f32x4 __attribute__((ext_vector_type(4)));
typedef unsigned u32x4 __attribute__((ext_vector_type(4)));
typedef unsigned u32x2 __attribute__((ext_vector_type(2)));
constexpr int BM = 256, BK = 64, HALF = 128, HTB = HALF * BK * 2, STAGE_BYTES = 8 * HTB, NXCD = 8, WGM = 8;

__host__ __device__ __forceinline__ int lds_byte(int r, int c) { const int st = (r >> 4) * 2 + (c >> 5), rr = r & 15, cc = c & 31, ob = rr * 64 + cc * 2; return st * 1024 + (ob ^ (((ob >> 9) & 1) << 5)); }
__host__ __device__ __forceinline__ void stage_rc(int b, int& R, int& C) { const int st = b / 1024, sb = b % 1024, swz = sb ^ (((sb >> 9) & 1) << 5); R = (st >> 1) * 16 + swz / 64; C = (st & 1) * 32 + (swz % 64) / 2; }
__host__ __device__ __forceinline__ int perm32(int rho) { const int n = rho >> 4, i = rho & 15; return 8 * (i >> 2) + 4 * n + (i & 3); }

struct Unit { int pm, pn; };
struct Gemm { const bf16_t* A; const bf16_t* Bt; int M, N, K; };

struct StaticOrder {
    int nM, nN, nwg, G, c;
    __host__ __device__ void init(int M, int N, int G_, int c_) { nM = M / BM; nN = N / BM; nwg = nM * nN; G = G_; c = c_; }
    __host__ __device__ bool next(int i, Unit& u) const {
        const long L = (long)i * G + c; if (L >= nwg) return false;
        int wgid = (int)L; { const int q = nwg / NXCD, r = nwg % NXCD, xcd = wgid % NXCD, off = wgid / NXCD; wgid = (xcd < r ? xcd * (q + 1) : r * (q + 1) + (xcd - r) * q) + off; }
        const int nig = WGM * nN, gid = wgid / nig, fm = gid * WGM, gsz = (nM - fm) < WGM ? (nM - fm) : WGM;
        u.pm = fm + ((wgid % nig) % gsz); u.pn = (wgid % nig) / gsz; return true;
    }
    __device__ __forceinline__ void a_ready(const Unit&) const {}
    __device__ __forceinline__ void done(const Unit&) const {}
};

__device__ __forceinline__ unsigned cvt_pk_bf16(float lo, float hi) { unsigned r; asm volatile("v_cvt_pk_bf16_f32 %0, %1, %2" : "=v"(r) : "v"(lo), "v"(hi)); return r; }

template <class Epi, class Sched, bool ALIGN_EPI = false, bool SP2 = false>
__device__ __forceinline__ void gemm_phase(PG8_LAS unsigned char* lds, const Gemm g, const Sched& S, const Epi& E, const int wid_) {
    int wid = wid_; asm volatile("" : "+s"(wid));
    const int lane = lane_id_v(), tid = wid * 64 + lane,
              wr = wid >> 2, wc = wid & 3, fr = lane & 15, fq = lane >> 4;
    const int K = g.K, nt = K / BK;
    unsigned voffA[2], voffB[2];
#pragma unroll
    for (int i = 0; i < 2; ++i) { int R, C; stage_rc(tid * 16 + i * 8192, R, C); const int Rb = Epi::PERM ? ((R & ~31) + perm32(R & 31)) : R;
        voffA[i] = (unsigned)(R * K + C) * 2u; voffB[i] = (unsigned)(Rb * K + C) * 2u; }
    const size_t kstep = (size_t)(BK * 2);
    const size_t hstep = (size_t)HALF * K * 2;
    const size_t tstep = 2 * hstep;
    const unsigned ldsw = (unsigned)wid * 1024u;
    const int aoff = lds_byte(wr * 64 + fr, fq * 8), boff = lds_byte(wc * 32 + fr, fq * 8);
#define PG8_SA(b, h) (((b) * 2 + (h)) * HTB)
#define PG8_SB(b, h) ((4 + (b) * 2 + (h)) * HTB)
#define PG8_STAGE(bufoff, gbase, voff) do { _Pragma("unroll") for (int _i = 0; _i < 2; ++_i) \
        __builtin_amdgcn_global_load_lds((const unsigned*)((const char*)(gbase) + (voff)[_i]), (PG8_LAS unsigned*)(lds + (bufoff) + ldsw + _i * 8192), 16, 0, 0); } while (0)
#define PG8_LDA(dst, b, h) do { _Pragma("unroll") for (int m = 0; m < 4; ++m) _Pragma("unroll") for (int k = 0; k < 2; ++k) dst[m][k] = *(const PG8_LAS bf16x8*)(lds + PG8_SA(b, h) + aoff + m * 2048 + k * 1024); } while (0)
#define PG8_LDB(dst, b, h) do { _Pragma("unroll") for (int n = 0; n < 2; ++n) _Pragma("unroll") for (int k = 0; k < 2; ++k) dst[n][k] = *(const PG8_LAS bf16x8*)(lds + PG8_SB(b, h) + boff + n * 2048 + k * 1024); } while (0)
#define PG8_MMA(ai, bj, At, Bt) do { __builtin_amdgcn_s_setprio(1); _Pragma("unroll") for (int m = 0; m < 4; ++m) _Pragma("unroll") for (int n = 0; n < 2; ++n) _Pragma("unroll") for (int k = 0; k < 2; ++k) \
        acc[ai][bj][m][n] = __builtin_amdgcn_mfma_f32_16x16x32_bf16(Bt[n][k], At[m][k], acc[ai][bj][m][n], 0, 0, 0); __builtin_amdgcn_s_setprio(0); } while (0)
#define PG8_WAIT_V(n) asm volatile("s_waitcnt vmcnt(" #n ")" ::: "memory")
#define PG8_WAIT_L(n) asm volatile("s_waitcnt lgkmcnt(" #n ")" ::: "memory")
#define PG8_BAR __builtin_amdgcn_s_barrier()
#define PG8_SCHED __builtin_amdgcn_sched_barrier(0)
    Unit cur, nxt; int ui = 0;
    if (!S.next(0, cur)) return;
    f32x4 acc[2][2][4][2];
#pragma unroll
    for (int a = 0; a < 2; ++a)
#pragma unroll
        for (int b = 0; b < 2; ++b)
#pragma unroll
            for (int m = 0; m < 4; ++m)
#pragma unroll
                for (int n = 0; n < 2; ++n) acc[a][b][m][n] = (f32x4){0.f, 0.f, 0.f, 0.f};
    bf16x8 At[4][2], B0[2][2], B1[2][2];
    const char* cA = (const char*)g.A + (size_t)cur.pm * tstep; const char* cB = (const char*)g.Bt + (size_t)cur.pn * tstep;
    S.a_ready(cur);
    if constexpr (SP2) {
        PG8_STAGE(PG8_SB(0, 0), cB, voffB); PG8_STAGE(PG8_SB(0, 1), cB + hstep, voffB); PG8_STAGE(PG8_SA(0, 0), cA, voffA); PG8_STAGE(PG8_SA(0, 1), cA + hstep, voffA);
        if (wr == 1) PG8_BAR;
        PG8_WAIT_V(2); PG8_BAR;
        PG8_STAGE(PG8_SB(1, 0), cB + kstep, voffB); PG8_STAGE(PG8_SA(1, 0), cA + kstep, voffA); PG8_STAGE(PG8_SB(1, 1), cB + hstep + kstep, voffB);
        PG8_WAIT_V(6); PG8_BAR;
    } else {
        PG8_STAGE(PG8_SB(0, 0), cB, voffB); PG8_STAGE(PG8_SA(0, 0), cA, voffA); PG8_STAGE(PG8_SB(0, 1), cB + hstep, voffB); PG8_STAGE(PG8_SA(0, 1), cA + hstep, voffA);
        if (wr == 1) PG8_BAR;
        PG8_WAIT_V(4); PG8_BAR;
        PG8_STAGE(PG8_SB(1, 0), cB + kstep, voffB); PG8_STAGE(PG8_SA(1, 0), cA + kstep, voffA); PG8_STAGE(PG8_SB(1, 1), cB + hstep + kstep, voffB);
        PG8_WAIT_V(6); PG8_BAR;
    }
    for (;;) {
        const bool has_next = S.next(ui + 1, nxt);
        const char* nA = has_next ? (const char*)g.A + (size_t)nxt.pm * tstep : cA; const char* nB = has_next ? (const char*)g.Bt + (size_t)nxt.pn * tstep : cB;
        for (int t = 0; t < nt; t += 2) {
            const bool last = (t == nt - 2);
            const char* a1 = cA + (size_t)(t + 1) * kstep;
            const char* a2 = last ? nA : cA + (size_t)(t + 2) * kstep; const char* b2 = last ? nB : cB + (size_t)(t + 2) * kstep;
            const char* a3 = a2 + kstep; const char* b3 = b2 + kstep;
            if (last && has_next) S.a_ready(nxt);
            if constexpr (SP2) {
            PG8_LDB(B0, 0, 0); PG8_LDB(B1, 0, 1); PG8_SCHED; PG8_LDA(At, 0, 0); PG8_STAGE(PG8_SA(1, 1), a1 + hstep, voffA);
            PG8_WAIT_V(8); PG8_WAIT_L(0); PG8_BAR; PG8_MMA(0, 0, At, B0); PG8_MMA(0, 1, At, B1); PG8_BAR; PG8_SCHED;
            PG8_LDA(At, 0, 1); PG8_STAGE(PG8_SB(0, 0), b2, voffB); PG8_STAGE(PG8_SB(0, 1), b2 + hstep, voffB); PG8_STAGE(PG8_SA(0, 0), a2, voffA);
            PG8_WAIT_V(8); PG8_WAIT_L(0); PG8_BAR; PG8_MMA(1, 0, At, B0); PG8_MMA(1, 1, At, B1); PG8_BAR; PG8_SCHED;
            PG8_LDB(B0, 1, 0); PG8_LDB(B1, 1, 1); PG8_SCHED; PG8_LDA(At, 1, 0); PG8_STAGE(PG8_SA(0, 1), a2 + hstep, voffA);
            PG8_WAIT_V(8); PG8_WAIT_L(0); PG8_BAR; PG8_MMA(0, 0, At, B0); PG8_MMA(0, 1, At, B1); PG8_BAR; PG8_SCHED;
            PG8_LDA(At, 1, 1); PG8_STAGE(PG8_SB(1, 0), b3, voffB); PG8_STAGE(PG8_SB(1, 1), b3 + hstep, voffB); PG8_STAGE(PG8_SA(1, 0), a3, voffA);
            PG8_WAIT_V(8); PG8_WAIT_L(0); PG8_BAR; PG8_MMA(1, 0, At, B0); PG8_MMA(1, 1, At, B1); PG8_BAR; PG8_SCHED;
            } else {
            PG8_LDB(B0, 0, 0); PG8_SCHED; PG8_LDA(At, 0, 0); PG8_STAGE(PG8_SA(1, 1), a1 + hstep, voffA);
            PG8_WAIT_L(8); PG8_BAR; PG8_WAIT_L(0); PG8_MMA(0, 0, At, B0); PG8_BAR; PG8_SCHED;
            PG8_LDB(B1, 0, 1); PG8_STAGE(PG8_SB(0, 0), b2, voffB);
            PG8_BAR; PG8_WAIT_L(0); PG8_MMA(0, 1, At, B1); PG8_BAR;
            PG8_LDA(At, 0, 1); PG8_STAGE(PG8_SA(0, 0), a2, voffA);
            PG8_BAR; PG8_WAIT_L(0); PG8_MMA(1, 0, At, B0); PG8_BAR; PG8_SCHED;
            PG8_STAGE(PG8_SB(0, 1), b2 + hstep, voffB);
            PG8_WAIT_V(6); PG8_BAR; PG8_MMA(1, 1, At, B1); PG8_BAR;
            PG8_LDB(B0, 1, 0); PG8_SCHED; PG8_LDA(At, 1, 0); PG8_STAGE(PG8_SA(0, 1), a2 + hstep, voffA);
            PG8_WAIT_L(8); PG8_BAR; PG8_WAIT_L(0); PG8_MMA(0, 0, At, B0); PG8_BAR; PG8_SCHED;
            PG8_LDB(B1, 1, 1); PG8_STAGE(PG8_SB(1, 0), b3, voffB);
            PG8_BAR; PG8_WAIT_L(0); PG8_MMA(0, 1, At, B1); PG8_BAR;
            PG8_LDA(At, 1, 1); PG8_STAGE(PG8_SA(1, 0), a3, voffA);
            PG8_BAR; PG8_WAIT_L(0); PG8_MMA(1, 0, At, B0); PG8_BAR; PG8_SCHED;
            PG8_STAGE(PG8_SB(1, 1), b3 + hstep, voffB);
            PG8_WAIT_V(6); PG8_BAR; PG8_MMA(1, 1, At, B1); PG8_BAR;
            }
        }
        if constexpr (ALIGN_EPI) { if (wr == 0) PG8_BAR; }
        E(acc, cur, wr, wc, fr, fq); S.done(cur);
        if (!has_next) break;
#pragma unroll
        for (int a = 0; a < 2; ++a)
#pragma unroll
            for (int b = 0; b < 2; ++b)
#pragma unroll
                for (int m = 0; m < 4; ++m)
#pragma unroll
                    for (int n = 0; n < 2; ++n) acc[a][b][m][n] = (f32x4){0.f, 0.f, 0.f, 0.f};
        cur = nxt; cA = nA; cB = nB; ++ui;
        if constexpr (ALIGN_EPI) { if (wr == 1) PG8_BAR; }
    }
    PG8_WAIT_V(0);
    if constexpr (!ALIGN_EPI) { if (wr == 0) PG8_BAR; }
    PG8_BAR;
#undef PG8_SA
#undef PG8_SB
#undef PG8_STAGE
#undef PG8_LDA
#undef PG8_LDB
#undef PG8_MMA
#undef PG8_WAIT_V
#undef PG8_WAIT_L
#undef PG8_BAR
#undef PG8_SCHED
}
}

constexpr int NWAVES = 8;
constexpr int BATCH = 4, SEQ = 8192, D = 1024, DEPTH = 4, M = BATCH * SEQ;
constexpr int NMEM = 256, MROWS = BATCH * NMEM;
constexpr int AH = 8, AHD = 64, AW = 512, KVR = 128, IH = 8, IDIM = 32, TOPK = 256;
constexpr int PW_ = 256, CH = 4, CHD = 64, CW = 256;
constexpr int DFF = 2816, INW = 4520, INP = 5120;
constexpr float EPS = 1e-6f;
constexpr int C_QA = 0, C_CKV = 512, C_IQ = 640, C_IK = 896, C_IW = 928, C_Z = 936, C_QC = 1192, C_G = 1448;

constexpr size_t MiB = 1u << 20;
constexpr size_t WS_CTL = 0, CTL_ZERO_BYTES = 1 * MiB;
constexpr size_t WS_SS = 1 * MiB;
constexpr size_t WS_IW = 3 * MiB;
constexpr size_t WS_SGN = 4 * MiB;
constexpr size_t WS_MEMN = 5 * MiB;
constexpr size_t WS_WMEM = 7 * MiB;
constexpr size_t WS_MEMKV = 11 * MiB;
constexpr size_t WS_W1IN = 15 * MiB, WS_W1OUT = 26 * MiB, WS_WIN = 32 * MiB, WS_WA = 42 * MiB, WS_WB = 44 * MiB, WS_WC = 44 * MiB + 512 * 1024, WS_WOUT = 45 * MiB, WS_W2IN = 47 * MiB, WS_W2OUT = 58 * MiB;
constexpr size_t WS_HB = 64 * MiB;
constexpr size_t WS_ACT = 128 * MiB;
constexpr size_t WS_G = 128 * MiB;
constexpr size_t WS_QL = 320 * MiB;
constexpr size_t WS_CKV = 384 * MiB;
constexpr size_t WS_CKVRAW = 392 * MiB;
constexpr size_t WS_IQRAW = 408 * MiB;
constexpr size_t WS_IQF = 424 * MiB;
constexpr size_t WS_IK = 440 * MiB;
constexpr size_t WS_Z = 442 * MiB;
constexpr size_t WS_MERGED = 384 * MiB;
constexpr size_t WS_YB = 458 * MiB;
constexpr size_t WS_QC = 474 * MiB;
constexpr size_t WS_SEL = 490 * MiB;
constexpr size_t WS_VT = 506 * MiB;
constexpr size_t WS_WPT = 4 * MiB + 512 * 1024;
constexpr size_t WS_END = 510 * MiB;
constexpr int CW_BAR = 4096;

constexpr int RING_OFF = 0, RING_BYTES = 131072;
constexpr int LDS_BYTES = 155648;
constexpr int MISC_OFF = LDS_BYTES - 256;

#define GAS __attribute__((address_space(1)))
#define LAS __attribute__((address_space(3)))
typedef unsigned short bf16;
typedef unsigned v4u __attribute__((ext_vector_type(4)));
typedef unsigned v2u __attribute__((ext_vector_type(2)));
typedef float f32x4 __attribute__((ext_vector_type(4)));
typedef float f32x2 __attribute__((ext_vector_type(2)));
typedef GAS unsigned gu32;
#define RLX_AGENT __ATOMIC_RELAXED, __HIP_MEMORY_SCOPE_AGENT
#define LDS_WAIT() asm volatile("s_waitcnt lgkmcnt(0)" ::: "memory")
#define VM_WAIT() asm volatile("s_waitcnt vmcnt(0)" ::: "memory")
__device__ __forceinline__ unsigned f2bf(float f) { unsigned u = __builtin_bit_cast(unsigned, f); return (u + 0x7fffu + ((u >> 16) & 1u)) >> 16; }
__device__ __forceinline__ unsigned pk2(float lo, float hi) { return f2bf(lo) | (f2bf(hi) << 16); }
__device__ __forceinline__ float bflo(unsigned w) { return __builtin_bit_cast(float, w << 16); }
__device__ __forceinline__ float bfhi(unsigned w) { return __builtin_bit_cast(float, w & 0xffff0000u); }
__device__ __forceinline__ float bf2f(bf16 b) { return __builtin_bit_cast(float, ((unsigned)b) << 16); }

#define XB_TMO      128
#define XB_XCNT(j)  (256  + 64 * (j))
#define XB_XSUB(j)  (1280 + 64 * (j))
#define XB_XGEN(j)  (2304 + 64 * (j))
#define XB_TOP      3328
#define XB_TOPGEN   3392
#define XCD_BAR_WORDS 3456
#define XB_SPIN_CAP (1u << 23)

__device__ __forceinline__ unsigned xb_ld(unsigned* p)              { return __hip_atomic_load(p, __ATOMIC_RELAXED, __HIP_MEMORY_SCOPE_AGENT); }
__device__ __forceinline__ unsigned xb_add(unsigned* p, unsigned v) { return __hip_atomic_fetch_add(p, v, __ATOMIC_RELAXED, __HIP_MEMORY_SCOPE_AGENT); }
__device__ __forceinline__ unsigned xb_xcc_id() { return (unsigned)__builtin_amdgcn_s_getreg((3 << 11) | 20) & 0xFu; }
#define XB_SPIN(cond, bar) do { unsigned _sp = 0; while (cond) { __builtin_amdgcn_s_sleep(1); \
    if ((++_sp & 255u) == 0u) { if (xb_ld(&(bar)[XB_TMO])) break; if (_sp > XB_SPIN_CAP) { atomicAdd(&(bar)[XB_TMO], 1u); break; } } } } while (0)

struct XcdBarrier { unsigned* bar; unsigned x; volatile LAS unsigned* st; int wave; };

__device__ __forceinline__ XcdBarrier xcd_barrier_post(unsigned* bar, volatile LAS unsigned* st, int wave) {
    XcdBarrier b; b.bar = bar; b.x = xb_xcc_id(); b.st = st; b.wave = wave;
    if (threadIdx.x == 0) (void)xb_add(&bar[XB_XCNT(b.x)], 1u);
    return b;
}
__device__ __forceinline__ void xcd_barrier_complete(unsigned* bar, unsigned x, unsigned& nloc, unsigned& nx) {
    const unsigned G = gridDim.x * gridDim.y * gridDim.z;
    unsigned sum, cnt, mine, sp = 0u;
    for (;;) {
        sum = 0u; cnt = 0u; mine = 0u;
#pragma unroll
        for (unsigned j = 0; j < 16; ++j) { const unsigned c = xb_ld(&bar[XB_XCNT(j)]); sum += c; cnt += (c > 0u) ? 1u : 0u; mine = (j == x) ? c : mine; }
        if (sum == G) break;
        __builtin_amdgcn_s_sleep(1);
        if ((++sp & 255u) == 0u) { if (xb_ld(&bar[XB_TMO])) break; if (sp > XB_SPIN_CAP) { atomicAdd(&bar[XB_TMO], 1u); break; } }
    }
    nloc = mine > 0u ? mine : 1u; nx = cnt > 0u ? cnt : 1u;
}
__device__ __forceinline__ void xcd_barrier(const XcdBarrier& b) {
    asm volatile("s_waitcnt vmcnt(0)" ::: "memory");
    __syncthreads();
    int bw_ = b.wave; asm volatile("" : "+s"(bw_));
    if (bw_ == 0 && lane_id_v() == 0) {
        unsigned* bar = b.bar;
        __builtin_amdgcn_s_waitcnt(0);
        unsigned nloc = b.st[0], nx = b.st[1];
        if (nloc == 0u) { xcd_barrier_complete(bar, b.x, nloc, nx); b.st[0] = nloc; b.st[1] = nx; }
        const unsigned old = xb_add(&bar[XB_XSUB(b.x)], 1u);
        const unsigned gen = old / nloc;
        if (old + 1u == (gen + 1u) * nloc) {
            __builtin_amdgcn_fence(__ATOMIC_RELEASE, "agent");
            asm volatile("s_waitcnt vmcnt(0)" ::: "memory");
            const unsigned og = xb_add(&bar[XB_TOP], 1u);
            const unsigned tg = og / nx;
            if (og + 1u == (tg + 1u) * nx) xb_add(&bar[XB_TOPGEN], 1u);
            else XB_SPIN(xb_ld(&bar[XB_TOPGEN]) == tg, bar);
            __builtin_amdgcn_fence(__ATOMIC_ACQUIRE, "agent");
            xb_add(&bar[XB_XGEN(b.x)], 1u);
            asm volatile("s_waitcnt vmcnt(0)" ::: "memory");
        } else {
            XB_SPIN(xb_ld(&bar[XB_XGEN(b.x)]) == gen, bar);
            __builtin_amdgcn_fence(__ATOMIC_ACQUIRE, "agent");
            asm volatile("s_waitcnt vmcnt(0)" ::: "memory");
        }
    }
    __syncthreads();
}

struct Args {
    const float* in[23]; float* out; unsigned char* ws; int ph_lo, ph_hi;
};
template <class T> __device__ __forceinline__ T* uni(T* p) { const unsigned long long v = (unsigned long long)p; const unsigned lo = __builtin_amdgcn_readfirstlane((unsigned)v), hi = __builtin_amdgcn_readfirstlane((unsigned)(v >> 32)); return (T*)(((unsigned long long)hi << 32) | lo); }
__device__ __forceinline__ LAS unsigned char* uni_l(LAS unsigned char* p) { return (LAS unsigned char*)(unsigned)__builtin_amdgcn_readfirstlane((int)(unsigned)(size_t)p); }
__device__ __forceinline__ int uni_i(int v) { return __builtin_amdgcn_readfirstlane(v); }
struct PC { const float* const* in; float* out; unsigned char* ws; LAS unsigned char* lds; int wave, vcu, G; };
struct Frame {
    LAS unsigned char* lds;
    volatile LAS unsigned* MISC;
    gu32* ctl;
    int wave, vcu, G;
    unsigned char* ws;
};
__device__ __forceinline__ unsigned char* launder_p(unsigned char* p) { asm volatile("" : "+s"(p)); return p; }
__device__ __forceinline__ int launder_s(int v) { asm volatile("" : "+s"(v)); return v; }
__device__ __forceinline__ int launder_v(int v) { asm volatile("" : "+v"(v)); return v; }
__device__ __forceinline__ float wave_sum(float v) {
#pragma unroll
    for (int o = 1; o < 64; o <<= 1) v += __shfl_xor(v, o);
    return v;
}
__device__ __forceinline__ float wave_max(float v) {
#pragma unroll
    for (int o = 1; o < 64; o <<= 1) v = fmaxf(v, __shfl_xor(v, o));
    return v;
}

using pg8::Unit; using pg8::bf16_t;
#define LAUNDER2(a, b) asm volatile("" : "+v"(a), "+v"(b))
__device__ __forceinline__ float row_scale(const float* ss, int row) {
    const f32x4 a = *(const f32x4*)(ss + (size_t)row * 4);
    const float s = (a.x + a.y) + (a.z + a.w);
    return 1.0f / sqrtf(s * (1.0f / D) + EPS);
}
__device__ __forceinline__ float sigmoidf_(float x) { return 1.0f / (1.0f + __expf(-x)); }
__device__ __forceinline__ pg8::u32x2 pack4(const f32x4 v) { pg8::u32x2 w; w.x = pg8::cvt_pk_bf16(v[0], v[1]); w.y = pg8::cvt_pk_bf16(v[2], v[3]); return w; }

struct EpiSwiglu {
    static constexpr bool PERM = false;
    bf16_t* O; const float* ss;
    __device__ __forceinline__ void operator()(const f32x4 (&acc)[2][2][4][2], const Unit& u, int wr, int wc, int fr_, int fq_) const {
        const int l_ = lane_id_v(); const int fr = l_ & 15, fq = l_ >> 4; (void)fr_; (void)fq_;
        int rb = wr * 64 + fr, cb = wc * 16 + 4 * fq; LAUNDER2(rb, cb);
        const int row0 = u.pm * 256 + rb, col0 = u.pn * 128 + cb;
#pragma unroll
        for (int ai = 0; ai < 2; ++ai)
#pragma unroll
            for (int m = 0; m < 4; ++m) { const int row = row0 + ai * 128 + m * 16; const float s = row_scale(ss, row);
                bf16_t* rowp = O + (size_t)row * DFF + col0;
#pragma unroll
                for (int bj = 0; bj < 2; ++bj) { const f32x4 a = acc[ai][bj][m][0] * s, b = acc[ai][bj][m][1] * s; f32x4 o;
#pragma unroll
                    for (int i = 0; i < 4; ++i) o[i] = a[i] * sigmoidf_(a[i]) * b[i];
                    *(pg8::u32x2*)(rowp + bj * 64) = pack4(o); } }
    }
};
struct EpiResid {
    static constexpr bool PERM = false;
    const float* base; float* out; bf16_t* hb; float* ss; float alpha; LAS float* P;
    __device__ __forceinline__ void operator()(const f32x4 (&acc)[2][2][4][2], const Unit& u, int wr, int wc, int fr_, int fq_) const {
        const int l_ = lane_id_v(); const int fr = l_ & 15, fq = l_ >> 4; (void)fr_; (void)fq_;
        int rb = wr * 64 + fr, cb = wc * 32 + 4 * fq; LAUNDER2(rb, cb);
        const int row0 = u.pm * 256 + rb, col0 = u.pn * 256 + cb;
#pragma unroll
        for (int ai = 0; ai < 2; ++ai)
#pragma unroll
            for (int m = 0; m < 4; ++m) { const int row = row0 + ai * 128 + m * 16; const size_t off = (size_t)row * D + col0; float q = 0.f;
#pragma unroll
                for (int bj = 0; bj < 2; ++bj)
#pragma unroll
                    for (int n = 0; n < 2; ++n) { const f32x4 bs = *(const f32x4*)(base + off + bj * 128 + n * 16); const f32x4 v = bs + acc[ai][bj][m][n] * alpha;
                        *(f32x4*)(out + off + bj * 128 + n * 16) = v;
                        *(pg8::u32x2*)(hb + off + bj * 128 + n * 16) = pack4(v);
                        q += (v[0] * v[0] + v[1] * v[1]) + (v[2] * v[2] + v[3] * v[3]); }
                q += __shfl_xor(q, 16); q += __shfl_xor(q, 32);
                if (fq == 0) P[(rb + ai * 128 + m * 16) * 4 + wc] = q;
                asm volatile("" ::: "memory"); }
        asm volatile("s_waitcnt lgkmcnt(0)" ::: "memory"); __builtin_amdgcn_s_barrier(); asm volatile("" ::: "memory");
        const int tid = (wr * 4 + wc) * 64 + fq * 16 + fr;
        if (tid < 256) { const f32x4 p = *(const LAS f32x4*)(P + tid * 4); ss[(size_t)(u.pm * 256 + tid) * 4 + u.pn] = (p.x + p.y) + (p.z + p.w); }
    }
};
struct EpiPlainBf16 {
    static constexpr bool PERM = false;
    bf16_t* O; int ldo;
    __device__ __forceinline__ void operator()(const f32x4 (&acc)[2][2][4][2], const Unit& u, int wr, int wc, int fr_, int fq_) const {
        const int l_ = lane_id_v(); const int fr = l_ & 15, fq = l_ >> 4; (void)fr_; (void)fq_;
        int rb = wr * 64 + fr, cb = wc * 32 + 4 * fq; LAUNDER2(rb, cb);
        const int row0 = u.pm * 256 + rb, col0 = u.pn * 256 + cb;
#pragma unroll
        for (int ai = 0; ai < 2; ++ai)
#pragma unroll
            for (int m = 0; m < 4; ++m) { bf16_t* rowp = O + (size_t)(row0 + ai * 128 + m * 16) * ldo + col0;
#pragma unroll
                for (int bj = 0; bj < 2; ++bj)
#pragma unroll
                    for (int n = 0; n < 2; ++n) *(pg8::u32x2*)(rowp + bj * 128 + n * 16) = pack4(acc[ai][bj][m][n]); }
    }
};
struct EpiInProj {
    static constexpr bool PERM = false;
    const float* ss; bf16_t* qa; float* ckvraw; bf16_t* ik; float* iw; bf16_t* iqraw; bf16_t* z; bf16_t* qc; bf16_t* G;
    __device__ __forceinline__ void operator()(const f32x4 (&acc)[2][2][4][2], const Unit& u, int wr, int wc, int fr_, int fq_) const {
        const int l_ = lane_id_v(); const int fr = l_ & 15, fq = l_ >> 4; (void)fr_; (void)fq_;
        int rb = wr * 64 + fr, ct = wc * 32 + 4 * fq; LAUNDER2(rb, ct);
        const int row0 = u.pm * 256 + rb; const int pn = u.pn;
        if (pn == 4) {
#pragma unroll
            for (int ai = 0; ai < 2; ++ai)
#pragma unroll
                for (int m = 0; m < 4; ++m) { const int row = row0 + ai * 128 + m * 16; const float s = row_scale(ss, row);
#pragma unroll
                    for (int n = 0; n < 2; ++n) { *(f32x4*)(ckvraw + (size_t)row * KVR + ct + n * 16) = acc[ai][0][m][n] * s;
                        if (wc == 0) *(pg8::u32x2*)(ik + (size_t)row * IDIM + 4 * fq + n * 16) = pack4(acc[ai][1][m][n] * s); }
                    if (wc == 1 && fq < 2) *(f32x4*)(iw + (size_t)row * IH + 4 * fq) = acc[ai][1][m][0] * s; }
        } else {
            bf16_t* dst0; int ld; bool sig = false;
            if (pn < 4) { dst0 = qa + pn * 256; ld = 1024; } else if (pn == 5) { dst0 = iqraw; ld = 256; } else if (pn == 6) { dst0 = z; ld = 256; } else if (pn == 7) { dst0 = qc; ld = 256; } else { dst0 = G + (pn - 8) * 256; ld = 3072; sig = true; }
#pragma unroll
            for (int ai = 0; ai < 2; ++ai)
#pragma unroll
                for (int m = 0; m < 4; ++m) { const int row = row0 + ai * 128 + m * 16; const float s = row_scale(ss, row); bf16_t* rowp = dst0 + (size_t)row * ld + ct;
#pragma unroll
                    for (int bj = 0; bj < 2; ++bj)
#pragma unroll
                        for (int n = 0; n < 2; ++n) { f32x4 o = acc[ai][bj][m][n] * s;
                            if (sig) {
#pragma unroll
                                for (int i = 0; i < 4; ++i) o[i] = sigmoidf_(o[i]); }
                            *(pg8::u32x2*)(rowp + bj * 128 + n * 16) = pack4(o); } }
        }
    }
};
template <int MODE> struct EpiMerge {
    static constexpr bool PERM = false;
    bf16_t* Mg; const bf16_t* G;
    __device__ __forceinline__ void operator()(const f32x4 (&acc)[2][2][4][2], const Unit& u, int wr, int wc, int fr_, int fq_) const {
        const int l_ = lane_id_v(); const int fr = l_ & 15, fq = l_ >> 4; (void)fr_; (void)fq_;
        int rb = wr * 64 + fr, cb = wc * 32 + 4 * fq; LAUNDER2(rb, cb);
        const int row0 = u.pm * 256 + rb, col0 = u.pn * 256 + cb;
#pragma unroll
        for (int ai = 0; ai < 2; ++ai)
#pragma unroll
            for (int m = 0; m < 4; ++m) { const int row = row0 + ai * 128 + m * 16;
                const bf16_t* gp = G + (size_t)row * 3072 + MODE * 1024 + col0; bf16_t* mp = Mg + (size_t)row * D + col0;
#pragma unroll
                for (int bj = 0; bj < 2; ++bj)
#pragma unroll
                    for (int n = 0; n < 2; ++n) { const int co = bj * 128 + n * 16;
                        const pg8::u32x2 gw = *(const pg8::u32x2*)(gp + co);
                        f32x4 o = acc[ai][bj][m][n]; o[0] *= bflo(gw.x); o[1] *= bfhi(gw.x); o[2] *= bflo(gw.y); o[3] *= bfhi(gw.y);
                        if (MODE > 0) { const pg8::u32x2 pw = *(const pg8::u32x2*)(mp + co); o[0] += bflo(pw.x); o[1] += bfhi(pw.x); o[2] += bflo(pw.y); o[3] += bfhi(pw.y); }
                        *(pg8::u32x2*)(mp + co) = pack4(o); }
                asm volatile("" ::: "memory"); }
    }
};

template <class Map>
__device__ __forceinline__ void transpose_item(const float* W, int K, int N, const float* gain, bf16* WT, LAS float* scr, int item, int lane, Map map) {
    const int nblk = (N + 31) / 32, kb = item / nblk, nb = item % nblk, k0 = 64 * kb, n0 = 32 * nb;
    const int nn = n0 + (lane & 31); const bool nok = nn < N;
#pragma unroll 4
    for (int i = 0; i < 32; ++i) { const int kk = 2 * i + (lane >> 5); float v = nok ? W[(size_t)(k0 + kk) * N + nn] : 0.f; if (gain) v *= gain[k0 + kk]; scr[kk * 33 + (lane & 31)] = v; }
    LDS_WAIT(); asm volatile("" ::: "memory");
    const int c = lane & 7;
#pragma unroll
    for (int j = 0; j < 4; ++j) { const int n = (lane >> 3) + 8 * j; const LAS float* s = scr + (8 * c) * 33 + n;
        v4u o; o.x = pk2(s[0 * 33], s[1 * 33]); o.y = pk2(s[2 * 33], s[3 * 33]); o.z = pk2(s[4 * 33], s[5 * 33]); o.w = pk2(s[6 * 33], s[7 * 33]);
        if (n0 + n < N) { const int dr = map(n0 + n); if (dr >= 0) *(GAS v4u*)(WT + (size_t)dr * K + k0 + 8 * c) = o; } }
    LDS_WAIT(); asm volatile("" ::: "memory");
}
struct MapId { int off; __device__ __forceinline__ int operator()(int n) const { return off + n; } };
struct MapSwiglu { __device__ __forceinline__ int operator()(int c) const { const int half = c >= DFF ? 1 : 0, j = c - half * DFF; return 32 * (j >> 4) + 16 * half + (j & 15); } };
struct MapInProj { __device__ __forceinline__ int operator()(int c) const {
    if (c < C_CKV) return -1;
    if (c < C_IQ) return 1024 + (c - C_CKV);
    if (c < C_IK) return 1280 + (c - C_IQ);
    if (c < C_IW) return 1152 + (c - C_IK);
    if (c < C_Z) return 1184 + (c - C_IW);
    if (c < C_QC) return 1536 + (c - C_Z);
    if (c < C_G) return 1792 + (c - C_QC);
    return 2048 + (c - C_G); } };
__device__ __forceinline__ void qlat_item(const float* win, const float* mixn, const float* wuk, bf16* WT, int item, int lane) {
    const int kc = item & 127, rh = (item >> 7) & 1, h = item >> 8; const int r = rh * 64 + lane;
    const f32x4* wp = (const f32x4*)(wuk + (size_t)r * (AH * AHD) + h * 64);
    float acc[8] = {0.f, 0.f, 0.f, 0.f, 0.f, 0.f, 0.f, 0.f};
#pragma unroll 1
    for (int dc = 0; dc < 4; ++dc) {
        const f32x4 w0 = wp[4 * dc], w1 = wp[4 * dc + 1], w2 = wp[4 * dc + 2], w3 = wp[4 * dc + 3];
#pragma unroll
        for (int kk = 0; kk < 8; ++kk) { const f32x4* ip = (const f32x4*)(win + (size_t)(kc * 8 + kk) * INW + h * 64 + 16 * dc);
            const f32x4 a0 = ip[0], a1 = ip[1], a2 = ip[2], a3 = ip[3];
            acc[kk] += (a0.x * w0.x + a0.y * w0.y + a0.z * w0.z + a0.w * w0.w) + (a1.x * w1.x + a1.y * w1.y + a1.z * w1.z + a1.w * w1.w)
                     + (a2.x * w2.x + a2.y * w2.y + a2.z * w2.z + a2.w * w2.w) + (a3.x * w3.x + a3.y * w3.y + a3.z * w3.z + a3.w * w3.w);
            if (kk & 1) asm volatile("" ::: "memory"); }
    }
    const f32x4 g0 = *(const f32x4*)(mixn + kc * 8), g1 = *(const f32x4*)(mixn + kc * 8 + 4);
    v4u w; w.x = pk2(acc[0] * g0.x, acc[1] * g0.y); w.y = pk2(acc[2] * g0.z, acc[3] * g0.w); w.z = pk2(acc[4] * g1.x, acc[5] * g1.y); w.w = pk2(acc[6] * g1.z, acc[7] * g1.w);
    *(GAS v4u*)(WT + (size_t)(h * 128 + r) * D + kc * 8) = w;
}
__device__ __forceinline__ void wafold_item(const float* wuv, const float* wba, bf16* WT, int item, int lane) {
    const int ng = item & 15, rg = (item >> 4) & 15, h = item >> 8; const int n = ng * 64 + lane, r0 = rg * 8;
    float acc[8] = {0.f, 0.f, 0.f, 0.f, 0.f, 0.f, 0.f, 0.f};
#pragma unroll 4
    for (int d = 0; d < 64; ++d) { const float wa = wba[(size_t)(h * 64 + d) * D + n];
#pragma unroll
        for (int j = 0; j < 8; ++j) acc[j] += wuv[(size_t)(r0 + j) * (AH * AHD) + h * 64 + d] * wa; }
    v4u w; w.x = pk2(acc[0], acc[1]); w.y = pk2(acc[2], acc[3]); w.z = pk2(acc[4], acc[5]); w.w = pk2(acc[6], acc[7]);
    *(GAS v4u*)(WT + (size_t)n * 1024 + h * 128 + r0) = w;
}
__device__ __forceinline__ int items_of(int K, int N) { return (K / 64) * ((N + 31) / 32); }

__device__ __forceinline__ void prep_layer_weights_body(const PC& F, int l) {
    struct { const float* const* in; } a{F.in};
    const int lane_ = lane_id_v();
    LAS float* scr = (LAS float*)(F.lds + RING_OFF + F.wave * 16384);
    const int gw = F.vcu * NWAVES + F.wave, NGW = F.G * NWAVES;
    const float* f1n = a.in[3] + (size_t)l * D; const float* f1in = a.in[4] + (size_t)l * D * 2 * DFF; const float* f1out = a.in[5] + (size_t)l * DFF * D;
    const float* mixn = a.in[6] + (size_t)l * D; const float* win = a.in[7] + (size_t)l * D * INW;
    const float* wba = a.in[15] + (size_t)l * AW * D; const float* wbb = a.in[16] + (size_t)l * PW_ * D; const float* wbc = a.in[17] + (size_t)l * CW * D;
    const float* wout = a.in[18] + (size_t)l * D * D;
    const float* f2n = a.in[19] + (size_t)l * D; const float* f2in = a.in[20] + (size_t)l * D * 2 * DFF; const float* f2out = a.in[21] + (size_t)l * DFF * D;
    unsigned char* ws = launder_p(F.ws);
    const float* wuk = a.in[9] + (size_t)l * KVR * AH * AHD; const float* wuv = a.in[10] + (size_t)l * KVR * AH * AHD;
    const int I0 = items_of(D, 2 * DFF), I1 = items_of(DFF, D), I2 = items_of(D, INW), I4 = items_of(PW_, D), I5 = items_of(CW, D), I6 = items_of(D, D);
    const int NIT = 2 * I0 + 2 * I1 + I2 + I4 + I5 + I6;
#pragma unroll 1
    for (int it = gw; it < NIT; it += NGW) {
        int r = it;
        if (r < I0) { transpose_item(f1in, D, 2 * DFF, f1n, (bf16*)(ws + WS_W1IN), scr, r, lane_, MapSwiglu{}); continue; } r -= I0;
        if (r < I0) { transpose_item(f2in, D, 2 * DFF, f2n, (bf16*)(ws + WS_W2IN), scr, r, lane_, MapSwiglu{}); continue; } r -= I0;
        if (r < I1) { transpose_item(f1out, DFF, D, nullptr, (bf16*)(ws + WS_W1OUT), scr, r, lane_, MapId{0}); continue; } r -= I1;
        if (r < I1) { transpose_item(f2out, DFF, D, nullptr, (bf16*)(ws + WS_W2OUT), scr, r, lane_, MapId{0}); continue; } r -= I1;
        if (r < I2) { transpose_item(win, D, INW, mixn, (bf16*)(ws + WS_WIN), scr, r, lane_, MapInProj{}); continue; } r -= I2;
        if (r < I4) { transpose_item(wbb, PW_, D, nullptr, (bf16*)(ws + WS_WB), scr, r, lane_, MapId{0}); continue; } r -= I4;
        if (r < I5) { transpose_item(wbc, CW, D, nullptr, (bf16*)(ws + WS_WC), scr, r, lane_, MapId{0}); continue; } r -= I5;
        transpose_item(wout, D, D, nullptr, (bf16*)(ws + WS_WOUT), scr, r, lane_, MapId{0});
    }
    { const float* wpool = a.in[11] + (size_t)l * 4 * 64 * 64; bf16* wpT = (bf16*)(ws + WS_WPT);
      for (int i = gw * 64 + lane_; i < 4 * 64 * 64; i += NGW * 64) { const int c = i & 63, d = (i >> 6) & 63, g = i >> 12; wpT[i] = (bf16)f2bf(wpool[(g * 64 + c) * 64 + d]); } }
    asm volatile("" ::: "memory");
#pragma unroll 1
    for (int it = gw; it < 2048; it += NGW) wafold_item(wuv, wba, (bf16*)(ws + WS_WA), it, lane_);
    asm volatile("" ::: "memory");
#pragma unroll 1
    for (int it = gw; it < 2048; it += NGW) qlat_item(win, mixn, wuk, (bf16*)(ws + WS_WIN), it, lane_);
}

__device__ __noinline__ void p0_prologue(const float* const* in_, float* out_, unsigned char* ws_, LAS unsigned char* lds_, int wave_, int vcu_, int G_) {
    const PC F{uni(in_), uni(out_), uni(ws_), uni_l(lds_), uni_i(wave_), uni_i(vcu_), uni_i(G_)}; struct { const float* const* in; } a{F.in};
    const int lane_ = lane_id_v();
    const int gw = F.vcu * NWAVES + F.wave, NGW = F.G * NWAVES;
    const float* x = a.in[0]; const float* mem = a.in[1];
    bf16* hb = (bf16*)(F.ws + WS_HB); float* ss = (float*)(F.ws + WS_SS); bf16* memn = (bf16*)(F.ws + WS_MEMN);
    for (int m = gw; m < M + MROWS; m += NGW) {
        const bool ismem = m >= M; const int r = ismem ? m - M : m;
        const GAS f32x4* xr = (const GAS f32x4*)((ismem ? mem : x) + (size_t)r * D) + lane_;
        f32x4 v[4]; float s = 0.f;
#pragma unroll
        for (int j = 0; j < 4; ++j) { v[j] = xr[64 * j]; s += (v[j].x * v[j].x + v[j].y * v[j].y) + (v[j].z * v[j].z + v[j].w * v[j].w); }
        s = wave_sum(s);
        float sc = 1.f;
        if (ismem) sc = 1.0f / sqrtf(s * (1.0f / D) + EPS);
        else if (lane_ < 4) ss[(size_t)r * 4 + lane_] = lane_ == 0 ? s : 0.f;
        GAS unsigned long long* o8 = (GAS unsigned long long*)((ismem ? memn : hb) + (size_t)r * D) + lane_;
#pragma unroll
        for (int j = 0; j < 4; ++j) o8[64 * j] = (unsigned long long)pk2(v[j].x * sc, v[j].y * sc) | ((unsigned long long)pk2(v[j].z * sc, v[j].w * sc) << 32);
    }
    LAS float* scr = (LAS float*)(F.lds + RING_OFF + F.wave * 16384);
    const int IM = items_of(D, 2 * CW);
    for (int it = gw; it < DEPTH * IM; it += NGW) { const int l = it / IM, r = it % IM;
        transpose_item(a.in[14] + (size_t)l * D * 2 * CW, D, 2 * CW, a.in[13] + (size_t)l * D, (bf16*)(F.ws + WS_WMEM), scr, r, lane_, MapId{l * 2 * CW}); }
    prep_layer_weights_body(F, 0);
}
__device__ __noinline__ void prep_layer_weights(const float* const* in_, float* out_, unsigned char* ws_, LAS unsigned char* lds_, int l, int wave_, int vcu_, int G_) {
    const PC F{uni(in_), uni(out_), uni(ws_), uni_l(lds_), uni_i(wave_), uni_i(vcu_), uni_i(G_)}; prep_layer_weights_body(F, uni_i(l));
}

__constant__ unsigned char T5_BUCKET[128] = {0, 1, 2, 3, 4, 5, 6, 7, 8, 9, 10, 11, 12, 13, 14, 15, 16, 16, 16, 17, 17, 18, 18, 18, 19, 19, 19, 20, 20, 20, 20, 21, 21, 21, 21, 22, 22, 22, 22, 22, 23, 23, 23, 23, 23, 23, 24, 24, 24, 24, 24, 24, 25, 25, 25, 25, 25, 25, 25, 26, 26, 26, 26, 26, 26, 26, 26, 27, 27, 27, 27, 27, 27, 27, 27, 27, 27, 28, 28, 28, 28, 28, 28, 28, 28, 28, 28, 29, 29, 29, 29, 29, 29, 29, 29, 29, 29, 29, 29, 30, 30, 30, 30, 30, 30, 30, 30, 30, 30, 30, 30, 30, 30, 31, 31, 31, 31, 31, 31, 31, 31, 31, 31, 31, 31, 31, 31, 31};

typedef short bf16x8_p __attribute__((ext_vector_type(8)));
__device__ __forceinline__ void prep_tokens(const float* const* in_, float* out_, unsigned char* ws_, LAS unsigned char* lds_, int l_, int wave_, int vcu_, int G_, int dry_) {
    const int dry = uni_i(dry_);
    const PC F{uni(in_), uni(out_), uni(ws_), uni_l(lds_), uni_i(wave_), uni_i(vcu_), uni_i(G_)}; struct { const float* const* in; } a{F.in}; const int l = uni_i(l_);
    unsigned char* ws = launder_p(F.ws);
    const float* ckvraw = (const float*)(ws + WS_CKVRAW); bf16* ckv = (bf16*)(ws + WS_CKV);
    const bf16* iqraw = (const bf16*)(ws + WS_IQRAW); bf16* iqf = (bf16*)(ws + WS_IQF); const float* iw = (const float*)(ws + WS_IW); unsigned* sgn = (unsigned*)(ws + WS_SGN);
    const bf16* z = (const bf16*)(ws + WS_Z); bf16* yb = (bf16*)(ws + WS_YB); bf16* qc = (bf16*)(ws + WS_QC);
    const bf16* memkv = (const bf16*)(ws + WS_MEMKV); const bf16* vT = (const bf16*)(ws + WS_VT); const bf16* wpT = (const bf16*)(ws + WS_WPT);
    const float* kvn = a.in[8] + (size_t)l * KVR; const float* pscale = a.in[12] + (size_t)l * PW_;
    const int lane = lane_id_v(), tid = F.wave * 64 + lane;
    const int tok = lane & 15, g4 = lane >> 4;
    LAS unsigned char* Ks = F.lds;
    LAS unsigned char* Vs = F.lds + 36864;
    for (int blk = F.vcu; blk < M / 128; blk += F.G) {
        const int rowb = blk * 128, b = rowb / SEQ, row0 = rowb + F.wave * 16;
#pragma unroll 1
        for (int tt = 0; tt < 16; ++tt) { const int row = row0 + tt;
            { const f32x2 v = *(const f32x2*)(ckvraw + (size_t)row * KVR + 2 * lane); const float q = wave_sum(v.x * v.x + v.y * v.y);
              const float rs = 1.0f / sqrtf(q * (1.0f / KVR) + EPS); const f32x2 g = *(const f32x2*)(kvn + 2 * lane);
              *(unsigned*)(ckv + (size_t)row * KVR + 2 * lane) = pk2(v.x * rs * g.x, v.y * rs * g.y); }
            { const float wv = iw[(size_t)row * IH + (lane >> 3)]; const float aw = fabsf(wv) * (1.0f / 16.0f);
              const v2u q = *(const v2u*)(iqraw + (size_t)row * 256 + 4 * lane);
              v2u o; o.x = pk2(bflo(q.x) * aw, bfhi(q.x) * aw); o.y = pk2(bflo(q.y) * aw, bfhi(q.y) * aw);
              *(v2u*)(iqf + (size_t)row * 256 + 4 * lane) = o;
              const unsigned long long bal = __ballot(wv < 0.f);
              unsigned mask = 0;
#pragma unroll
              for (int h = 0; h < 8; ++h) mask |= ((unsigned)(bal >> (8 * h)) & 1u) << h;
              if (lane == 0) sgn[row] = mask; } }
        { const int row = row0 + tok, spos = row % SEQ;
#pragma unroll 1
          for (int g = 0; g < 4; ++g) { const int w = 2 << g; const int cnt = (spos + 1) < w ? (spos + 1) : w; const float rc = 1.0f / (float)cnt;
              bf16x8_p pf[2];
#pragma unroll
              for (int ks = 0; ks < 2; ++ks) { const int c0 = g * 64 + 32 * ks + 8 * g4; float sum[8], z0[8];
#pragma unroll
                  for (int e = 0; e < 8; ++e) { sum[e] = 0.f; z0[e] = 0.f; }
                  for (int j = 0; j < w; ++j) { if (j < cnt) { const v4u v = *(const v4u*)(z + (size_t)(row - j) * 256 + c0);
                      const float f[8] = {bflo(v.x), bfhi(v.x), bflo(v.y), bfhi(v.y), bflo(v.z), bfhi(v.z), bflo(v.w), bfhi(v.w)};
#pragma unroll
                      for (int e = 0; e < 8; ++e) { sum[e] += f[e]; if (j == 0) z0[e] = f[e]; } } }
                  v4u pw; pw.x = pk2(sum[0] * rc - z0[0], sum[1] * rc - z0[1]); pw.y = pk2(sum[2] * rc - z0[2], sum[3] * rc - z0[3]); pw.z = pk2(sum[4] * rc - z0[4], sum[5] * rc - z0[5]); pw.w = pk2(sum[6] * rc - z0[6], sum[7] * rc - z0[7]);
                  pf[ks] = __builtin_bit_cast(bf16x8_p, pw); }
#pragma unroll
              for (int dt = 0; dt < 4; ++dt) { f32x4 acc = {0.f, 0.f, 0.f, 0.f};
#pragma unroll
                  for (int ks = 0; ks < 2; ++ks) { const bf16x8_p af = *(const bf16x8_p*)(wpT + (size_t)(g * 64 + 16 * dt + tok) * 64 + 32 * ks + 8 * g4); acc = __builtin_amdgcn_mfma_f32_16x16x32_bf16(af, pf[ks], acc, 0, 0, 0); }
                  const f32x4 ps = *(const f32x4*)(pscale + g * 64 + 16 * dt + 4 * g4);
                  v2u o; o.x = pk2(acc[0] * ps.x, acc[1] * ps.y); o.y = pk2(acc[2] * ps.z, acc[3] * ps.w);
                  *(v2u*)(yb + (size_t)row * 256 + g * 64 + 16 * dt + 4 * g4) = o; } } }
#pragma unroll 1
        for (int h = 0; h < CH; ++h) {
            __syncthreads();
#pragma unroll
            for (int e = 0; e < 4; ++e) { const int i = tid + 512 * e;
                { const int m = i >> 3, c = i & 7; const v4u v = *(const v4u*)(memkv + (size_t)(b * NMEM + m) * 2048 + l * 512 + h * 64 + c * 8); *(LAS v4u*)(Ks + m * 144 + c * 16) = v; }
                { const int d = i >> 5, c = i & 31; const v4u v = *(const v4u*)(vT + (size_t)(l * 512 + 256 + h * 64 + d) * MROWS + b * NMEM + c * 8); *(LAS v4u*)(Vs + d * 528 + c * 16) = v; } }
            LDS_WAIT(); __syncthreads();
            const int row = row0 + tok;
            bf16x8_p qf[2];
#pragma unroll
            for (int ks = 0; ks < 2; ++ks) qf[ks] = *(const bf16x8_p*)(qc + (size_t)row * 256 + h * 64 + 32 * ks + 8 * g4);
            f32x4 S[16]; float mx = -1e30f;
#pragma unroll
            for (int mt = 0; mt < 16; ++mt) { f32x4 acc = {0.f, 0.f, 0.f, 0.f};
#pragma unroll
                for (int ks = 0; ks < 2; ++ks) { const bf16x8_p kf = *(const LAS bf16x8_p*)(Ks + (16 * mt + tok) * 144 + (4 * ks + g4) * 16); acc = __builtin_amdgcn_mfma_f32_16x16x32_bf16(kf, qf[ks], acc, 0, 0, 0); }
                S[mt] = acc; mx = fmaxf(mx, fmaxf(fmaxf(acc[0], acc[1]), fmaxf(acc[2], acc[3]))); if ((mt & 3) == 3) __builtin_amdgcn_sched_barrier(0); }
            mx = fmaxf(mx, __shfl_xor(mx, 16)); mx = fmaxf(mx, __shfl_xor(mx, 32));
            float sm = 0.f;
#pragma unroll
            for (int mt = 0; mt < 16; ++mt)
#pragma unroll
                for (int r = 0; r < 4; ++r) { const float p = __expf((S[mt][r] - mx) * 0.125f); S[mt][r] = p; sm += p; }
            sm += __shfl_xor(sm, 16); sm += __shfl_xor(sm, 32);
            const float inv = 1.0f / sm;
            f32x4 oacc[4];
#pragma unroll
            for (int dt = 0; dt < 4; ++dt) oacc[dt] = (f32x4){0.f, 0.f, 0.f, 0.f};
#pragma unroll
            for (int kk = 0; kk < 8; ++kk) { v4u pw; pw.x = pg8::cvt_pk_bf16(S[2 * kk][0], S[2 * kk][1]); pw.y = pg8::cvt_pk_bf16(S[2 * kk][2], S[2 * kk][3]); pw.z = pg8::cvt_pk_bf16(S[2 * kk + 1][0], S[2 * kk + 1][1]); pw.w = pg8::cvt_pk_bf16(S[2 * kk + 1][2], S[2 * kk + 1][3]);
                const bf16x8_p pfr = __builtin_bit_cast(bf16x8_p, pw);
#pragma unroll
                for (int dt = 0; dt < 4; ++dt) { const LAS unsigned char* vp = Vs + (16 * dt + tok) * 528 + (32 * kk + 4 * g4) * 2;
                    const v2u lo = *(const LAS v2u*)vp, hi = *(const LAS v2u*)(vp + 32);
                    v4u vw; vw.x = lo.x; vw.y = lo.y; vw.z = hi.x; vw.w = hi.y;
                    oacc[dt] = __builtin_amdgcn_mfma_f32_16x16x32_bf16(__builtin_bit_cast(bf16x8_p, vw), pfr, oacc[dt], 0, 0, 0); }
                __builtin_amdgcn_sched_barrier(0); }
#pragma unroll
            for (int dt = 0; dt < 4; ++dt) { v2u o; o.x = pk2(oacc[dt][0] * inv, oacc[dt][1] * inv); o.y = pk2(oacc[dt][2] * inv, oacc[dt][3] * inv);
                if (!dry) *(v2u*)(qc + (size_t)row * 256 + h * 64 + 16 * dt + 4 * g4) = o; else asm volatile("" :: "v"(o.x), "v"(o.y)); }
        }
    }
    __syncthreads();
}

__device__ __forceinline__ unsigned key_of(float s) { const unsigned u = __builtin_bit_cast(unsigned, s); return (u & 0x80000000u) ? ~u : (u | 0x80000000u); }

typedef short bf16x8_t __attribute__((ext_vector_type(8)));
typedef short s16x4_t __attribute__((ext_vector_type(4)));
__device__ __forceinline__ void select_query_slow(int q, LAS unsigned char* base  , const bf16* iqf, const unsigned* sgn, const bf16* ik, unsigned short* sel, int lane) {
    LAS unsigned* keys = (LAS unsigned*)base;
    LAS float* qf = (LAS float*)(base + 32768);
    const int b = q / SEQ, t = q % SEQ; const int n = t + 1;
    const size_t brow = (size_t)b * SEQ;
    unsigned short* srow = sel + (size_t)q * TOPK;
    { const v2u w = *(const v2u*)(iqf + (size_t)q * 256 + 4 * lane); qf[4 * lane] = bflo(w.x); qf[4 * lane + 1] = bfhi(w.x); qf[4 * lane + 2] = bflo(w.y); qf[4 * lane + 3] = bfhi(w.y); }
    const unsigned smask = sgn[q];
    LDS_WAIT();
    if (n <= TOPK) { for (int j = lane; j < TOPK; j += 64) srow[j] = (unsigned short)(j < n ? j : 0); return; }
    for (int s0 = 0; s0 < n; s0 += 64) { const int s = s0 + lane;
        if (s < n) {
            const v4u* kp = (const v4u*)(ik + (brow + s) * IDIM);
            float kf[32];
#pragma unroll
            for (int c = 0; c < 4; ++c) { const v4u kv = kp[c]; kf[8 * c] = bflo(kv.x); kf[8 * c + 1] = bfhi(kv.x); kf[8 * c + 2] = bflo(kv.y); kf[8 * c + 3] = bfhi(kv.y); kf[8 * c + 4] = bflo(kv.z); kf[8 * c + 5] = bfhi(kv.z); kf[8 * c + 6] = bflo(kv.w); kf[8 * c + 7] = bfhi(kv.w); }
            float sc = 0.f;
#pragma unroll
            for (int h = 0; h < 8; ++h) { float d = 0.f;
#pragma unroll
                for (int j4 = 0; j4 < 8; ++j4) { const f32x4 qv = *(const LAS f32x4*)(qf + h * 32 + 4 * j4); d += qv.x * kf[4 * j4] + qv.y * kf[4 * j4 + 1] + qv.z * kf[4 * j4 + 2] + qv.w * kf[4 * j4 + 3]; }
                d = fmaxf(d, 0.f); sc += ((smask >> h) & 1u) ? -d : d; }
            keys[s] = key_of(sc + 0.0f);
        } }
    LDS_WAIT();
    unsigned T = 0u;
    for (int bit = 31; bit >= 0; --bit) { const unsigned cand = T | (1u << bit); int cnt = 0;
        for (int s0 = 0; s0 < n; s0 += 64) { const int s = s0 + lane; const bool ge = (s < n) && (keys[s] >= cand); cnt += (int)__builtin_popcountll(__ballot(ge)); }
        if (cnt >= TOPK) T = cand; }
    int cgt = 0;
    for (int s0 = 0; s0 < n; s0 += 64) { const int s = s0 + lane; const bool gt = (s < n) && (keys[s] > T); cgt += (int)__builtin_popcountll(__ballot(gt)); }
    const int need_eq = TOPK - cgt;
    int pos = 0, peq = 0; const unsigned long long lt = (lane == 0) ? 0ull : (~0ull >> (64 - lane));
    for (int s0 = 0; s0 < n; s0 += 64) { const int s = s0 + lane; const unsigned k = (s < n) ? keys[s] : 0u;
        const bool gt = (s < n) && (k > T), eq = (s < n) && (k == T);
        const unsigned long long be = __ballot(eq);
        const int eqrank = peq + (int)__builtin_popcountll(be & lt);
        const bool take = gt || (eq && eqrank < need_eq);
        const unsigned long long bt = __ballot(take);
        if (take) srow[pos + (int)__builtin_popcountll(bt & lt)] = (unsigned short)s;
        pos += (int)__builtin_popcountll(bt); peq += (int)__builtin_popcountll(be); }
    LDS_WAIT();
}

typedef float f32x16 __attribute__((ext_vector_type(16)));
constexpr int SEL_CAP = 128;
constexpr int SL_HIST = 0, SL_SEL = 0, SL_CS = 32768, SL_CI = 65536, SL_KEYS = 81920, SL_ST = 98304;

#define SEL_DECLS \
    LAS unsigned char* const lds = uni_l(lds_); const int wave = uni_i(wave_), b = uni_i(b_), ub = uni_i(ub_); unsigned char* ws = uni(ws_); \
    const bf16* iqf = (const bf16*)(ws + WS_IQF); const unsigned* sgn = (const unsigned*)(ws + WS_SGN); const bf16* ik = (const bf16*)(ws + WS_IK); \
    const int lane = lane_id_v(), tid = wave * 64 + lane; const int kl = lane & 31, c5 = lane >> 5; \
    LAS unsigned* hist = (LAS unsigned*)(lds + SL_HIST); LAS unsigned short* lsel = (LAS unsigned short*)(lds + SL_SEL); LAS float* lcs = (LAS float*)(lds + SL_CS); \
    LAS unsigned short* lci = (LAS unsigned short*)(lds + SL_CI); LAS unsigned* st = (LAS unsigned*)(lds + SL_ST); LAS float* stf = (LAS float*)(lds + SL_ST); \
    const int t0 = ub * 64; const int q0 = b * SEQ + t0; const bf16* ikb = ik + (size_t)b * SEQ * IDIM; const int ntile = (t0 + 64 + 127) >> 7; \
    (void)hist; (void)lsel; (void)lcs; (void)lci; (void)stf; (void)tid;
#define SEL_LOAD_A \
    bf16x8_t af[2][2]; unsigned sm[2][2]; \
    { const int i = kl, a_ = i >> 3, cc_ = (i >> 2) & 1, e_ = i & 3; const int qq_ = 2 * cc_ + (a_ >> 1), hh_ = 4 * (a_ & 1) + e_; \
      _Pragma("unroll") for (int rt = 0; rt < 2; ++rt) _Pragma("unroll") for (int ks = 0; ks < 2; ++ks) af[rt][ks] = *(const bf16x8_t*)(iqf + (size_t)(q0 + 8 * wave + 4 * rt + qq_) * 256 + hh_ * 32 + 16 * ks + 8 * c5); \
      _Pragma("unroll") for (int rt = 0; rt < 2; ++rt) _Pragma("unroll") for (int u = 0; u < 2; ++u) sm[rt][u] = sgn[q0 + 8 * wave + 4 * rt + 2 * c5 + u]; }
#define SEL_STAGE(kt_) do { const int key_ = 16 * wave + (lane >> 2); const int ch_ = (lane & 3) ^ ((key_ >> 2) & 3); \
    __builtin_amdgcn_global_load_lds((const unsigned*)(ikb + (size_t)(128 * (kt_) + key_) * IDIM + ch_ * 8), (LAS unsigned*)(lds + SL_KEYS + ((kt_) & 1) * 8192 + wave * 1024), 16, 0, 0); } while (0)
#define SEL_SCORES(kt_) do { const LAS unsigned char* kb_ = lds + SL_KEYS + ((kt_) & 1) * 8192; \
    _Pragma("unroll") for (int kh = 0; kh < 4; ++kh) { const int key_ = 32 * kh + kl; \
        const bf16x8_t b0_ = *(const LAS bf16x8_t*)(kb_ + key_ * 64 + 16 * ((0 + c5) ^ ((key_ >> 2) & 3))); \
        const bf16x8_t b1_ = *(const LAS bf16x8_t*)(kb_ + key_ * 64 + 16 * ((2 + c5) ^ ((key_ >> 2) & 3))); \
        _Pragma("unroll") for (int rt = 0; rt < 2; ++rt) { f32x16 acc_ = {0.f,0.f,0.f,0.f,0.f,0.f,0.f,0.f,0.f,0.f,0.f,0.f,0.f,0.f,0.f,0.f}; \
            acc_ = __builtin_amdgcn_mfma_f32_32x32x16_bf16(af[rt][0], b0_, acc_, 0, 0, 0); acc_ = __builtin_amdgcn_mfma_f32_32x32x16_bf16(af[rt][1], b1_, acc_, 0, 0, 0); \
            _Pragma("unroll") for (int u = 0; u < 2; ++u) { float s_ = 0.f; \
                _Pragma("unroll") for (int h = 0; h < 8; ++h) { const float d_ = fmaxf(acc_[8 * u + h], 0.f); s_ += ((sm[rt][u] >> h) & 1u) ? -d_ : d_; } \
                sc[rt][kh][u] = s_ + 0.0f; } __builtin_amdgcn_sched_barrier(0); } } } while (0)
#define SEL_BOUNDARY(FINAL) do { \
    const int qq = tid >> 3, part = tid & 7; const LAS v4u* hp = (const LAS v4u*)(hist + qq * 256 + 32 * part); \
    unsigned bins[32]; \
    _Pragma("unroll") for (int i = 0; i < 8; ++i) { const v4u v = hp[i]; bins[4 * i] = v.x; bins[4 * i + 1] = v.y; bins[4 * i + 2] = v.z; bins[4 * i + 3] = v.w; } \
    unsigned ps = 0; \
    _Pragma("unroll") for (int i = 0; i < 32; ++i) ps += bins[i]; \
    unsigned v = ps, tt; \
    tt = __shfl_down(v, 1, 8); if (part + 1 < 8) v += tt; \
    tt = __shfl_down(v, 2, 8); if (part + 2 < 8) v += tt; \
    tt = __shfl_down(v, 4, 8); if (part + 4 < 8) v += tt; \
    unsigned cacc = v - ps; \
    if (cacc < (unsigned)TOPK && v >= (unsigned)TOPK) { int bsel = 0; unsigned na = 0, cb = 0; bool found = false; \
        _Pragma("unroll") for (int i = 31; i >= 0; --i) { const bool hit = !found && (cacc + bins[i] >= (unsigned)TOPK); if (hit) { bsel = i; na = cacc; cb = bins[i]; found = true; } cacc += bins[i]; } \
        st[128 + qq] = (unsigned)(32 * part + bsel); if (FINAL) { st[192 + qq] = na; st[256 + qq] = cb; st[448 + qq] = cb > (unsigned)SEL_CAP ? 1u : 0u; } } } while (0)

__device__ __forceinline__ void sel_pass1(unsigned char* ws_, LAS unsigned char* lds_, int wave_, int b_, int ub_) {
    SEL_DECLS
    unsigned short* sel = (unsigned short*)(ws + WS_SEL);
    __syncthreads();
    if (ub < 4) {
        for (int i = tid; i < 64 * TOPK; i += NWAVES * 64) { const int qq = i >> 8, sl = i & 255; sel[(size_t)(q0 + qq) * TOPK + sl] = (unsigned short)(sl <= t0 + qq ? sl : 0); }
        if (tid == 0) st[512] = 1u;
        asm volatile("s_waitcnt vmcnt(0) lgkmcnt(0)" ::: "memory"); __syncthreads();
        return;
    }
    SEL_LOAD_A
    for (int i = tid; i < 64 * 256; i += NWAVES * 64) hist[i] = 0u;
    if (tid < 64) { st[128 + tid] = 0u; st[448 + tid] = 0u; }
    if (tid == 0) st[512] = 0u;
    float sc[2][4][2];
    float scl[2][2]; int bcur[2][2];
#pragma unroll
    for (int rt = 0; rt < 2; ++rt)
#pragma unroll
        for (int u = 0; u < 2; ++u) { scl[rt][u] = 0.f; bcur[rt][u] = 0; }
    SEL_STAGE(0);
#pragma unroll 1
    for (int kt = 0; kt < ntile; ++kt) {
        asm volatile("s_waitcnt vmcnt(0) lgkmcnt(0)" ::: "memory"); __syncthreads();
        if (kt > 0 && (kt & 3) == 0) {
            SEL_BOUNDARY(false);
            asm volatile("s_waitcnt lgkmcnt(0)" ::: "memory"); __syncthreads();
#pragma unroll
            for (int rt = 0; rt < 2; ++rt)
#pragma unroll
                for (int u = 0; u < 2; ++u) bcur[rt][u] = (int)st[128 + 8 * wave + 4 * rt + 2 * c5 + u];
        }
        if (kt + 1 < ntile) SEL_STAGE(kt + 1);
        SEL_SCORES(kt);
        if (kt == 0) {
#pragma unroll
            for (int rt = 0; rt < 2; ++rt)
#pragma unroll
                for (int u = 0; u < 2; ++u) { float mx = 0.f;
#pragma unroll
                    for (int kh = 0; kh < 4; ++kh) mx = fmaxf(mx, fabsf(sc[rt][kh][u]));
#pragma unroll
                    for (int o = 1; o < 32; o <<= 1) mx = fmaxf(mx, __shfl_xor(mx, o));
                    const float R = mx > 0.f ? 2.0f * mx : 1.0f;
                    scl[rt][u] = 128.0f / R;
                    if (kl == 0) stf[8 * wave + 4 * rt + 2 * c5 + u] = scl[rt][u]; }
        }
        const bool masked = 128 * kt + 127 > t0;
#pragma unroll
        for (int rt = 0; rt < 2; ++rt)
#pragma unroll
            for (int u = 0; u < 2; ++u) { const int qq = 8 * wave + 4 * rt + 2 * c5 + u; const int lim = masked ? (t0 + qq - 128 * kt - kl) : 1000;
#pragma unroll
                for (int kh = 0; kh < 4; ++kh) { const float fb = fmaf(sc[rt][kh][u], scl[rt][u], 128.0f); const int bin = (int)fminf(fmaxf(fb, 0.f), 255.f);
                    if (bin >= bcur[rt][u] && 32 * kh <= lim) (void)__hip_atomic_fetch_add(hist + qq * 256 + bin, 1u, __ATOMIC_RELAXED, __HIP_MEMORY_SCOPE_WORKGROUP); } }
    }
    asm volatile("s_waitcnt vmcnt(0) lgkmcnt(0)" ::: "memory"); __syncthreads();
    SEL_BOUNDARY(true);
    if (tid < 64) { st[320 + tid] = 0u; st[384 + tid] = 0u; }
    asm volatile("s_waitcnt lgkmcnt(0)" ::: "memory"); __syncthreads();
}
__device__ __forceinline__ void sel_pass2(unsigned char* ws_, LAS unsigned char* lds_, int wave_, int b_, int ub_) {
    SEL_DECLS
    if (st[512] != 0u) return;
    SEL_LOAD_A
    float sc[2][4][2];
    float scl[2][2]; int bcur[2][2];
#pragma unroll
    for (int rt = 0; rt < 2; ++rt)
#pragma unroll
        for (int u = 0; u < 2; ++u) { const int qq = 8 * wave + 4 * rt + 2 * c5 + u; scl[rt][u] = stf[qq]; bcur[rt][u] = (int)st[128 + qq]; }
    SEL_STAGE(0);
#pragma unroll 1
    for (int kt = 0; kt < ntile; ++kt) {
        asm volatile("s_waitcnt vmcnt(0) lgkmcnt(0)" ::: "memory"); __syncthreads();
        if (kt + 1 < ntile) SEL_STAGE(kt + 1);
        SEL_SCORES(kt);
        const bool masked = 128 * kt + 127 > t0;
        unsigned slot[2][2][4]; unsigned okm = 0u, abm = 0u;
#pragma unroll
        for (int rt = 0; rt < 2; ++rt)
#pragma unroll
            for (int u = 0; u < 2; ++u) { const int qq = 8 * wave + 4 * rt + 2 * c5 + u; const int lim = masked ? (t0 + qq - 128 * kt - kl) : 1000;
#pragma unroll
                for (int kh = 0; kh < 4; ++kh) { const float fb = fmaf(sc[rt][kh][u], scl[rt][u], 128.0f); const int bin = (int)fminf(fmaxf(fb, 0.f), 255.f);
                    const bool ok = bin >= bcur[rt][u] && 32 * kh <= lim; const bool ab = bin > bcur[rt][u];
                    slot[rt][u][kh] = 0u;
                    if (ok) { slot[rt][u][kh] = __hip_atomic_fetch_add(st + (ab ? 320 : 384) + qq, 1u, __ATOMIC_RELAXED, __HIP_MEMORY_SCOPE_WORKGROUP); okm |= 1u << (rt * 8 + u * 4 + kh); if (ab) abm |= 1u << (rt * 8 + u * 4 + kh); } } }
        if (okm != 0u) {
#pragma unroll
            for (int rt = 0; rt < 2; ++rt)
#pragma unroll
                for (int u = 0; u < 2; ++u) { const int qq = 8 * wave + 4 * rt + 2 * c5 + u;
#pragma unroll
                    for (int kh = 0; kh < 4; ++kh) { const int bit = rt * 8 + u * 4 + kh; const unsigned sl = slot[rt][u][kh]; const int kpos = 128 * kt + 32 * kh + kl;
                        if ((okm >> bit) & 1u) {
                            if ((abm >> bit) & 1u) { if (sl < (unsigned)TOPK) lsel[qq * 256 + sl] = (unsigned short)kpos; }
                            else if (sl < (unsigned)SEL_CAP) { lcs[qq * SEL_CAP + sl] = sc[rt][kh][u]; lci[qq * SEL_CAP + sl] = (unsigned short)kpos; } } } }
        }
    }
    asm volatile("s_waitcnt vmcnt(0) lgkmcnt(0)" ::: "memory"); __syncthreads();
}
__device__ __forceinline__ void sel_resolve(unsigned char* ws_, LAS unsigned char* lds_, int wave_, int b_, int ub_, int wg_, int first_) {
    SEL_DECLS
    const int wg = uni_i(wg_), first = uni_i(first_);
    unsigned short* sel = (unsigned short*)(ws + WS_SEL);
    gu32* slowl = (gu32*)(ws + WS_CTL + 65536) + (size_t)wg * 132;
    if (first && tid == 0) __hip_atomic_store(slowl, 0u, RLX_AGENT);
    if (st[512] != 0u) return;
#pragma unroll 1
    for (int qi = 0; qi < 8; ++qi) { const int qq = 8 * wave + qi; const int q = q0 + qq;
        const int na = (int)st[192 + qq], need = TOPK - na; int C = (int)st[384 + qq]; C = C < SEL_CAP ? C : SEL_CAP;
        const bool slow = st[448 + qq] != 0u;
        if (!slow) {
#pragma unroll
            for (int e = 0; e < SEL_CAP / 64; ++e) { const int i = lane + 64 * e;
                if (i < C) { const float si = lcs[qq * SEL_CAP + i]; const int ii = lci[qq * SEL_CAP + i]; int rank = 0;
                    for (int jx = 0; jx < C; ++jx) { const float sj = lcs[qq * SEL_CAP + jx]; const int ij = lci[qq * SEL_CAP + jx]; rank += (sj > si || (sj == si && ij < ii)) ? 1 : 0; }
                    if (rank < need) lsel[qq * 256 + na + rank] = (unsigned short)ii; } }
            LDS_WAIT();
            *(v2u*)(sel + (size_t)q * TOPK + 4 * lane) = *(const LAS v2u*)(lsel + qq * 256 + 4 * lane);
        }
    }
    __syncthreads();
    if (tid == 0) { unsigned n = first ? 0u : __hip_atomic_load(slowl, RLX_AGENT);
        for (int qq = 0; qq < 64; ++qq) if (st[448 + qq] != 0u) { if (n < 128u) { __hip_atomic_store(slowl + 1 + n, (unsigned)(q0 + qq), RLX_AGENT); ++n; } }
        __hip_atomic_store(slowl, n, RLX_AGENT); }
    asm volatile("s_waitcnt vmcnt(0)" ::: "memory");
    __syncthreads();
}
#undef SEL_DECLS
#undef SEL_LOAD_A
#undef SEL_STAGE
#undef SEL_SCORES
#undef SEL_BOUNDARY
__device__ __noinline__ void dsa_select_slow(unsigned char* ws_, LAS unsigned char* lds_, int wave_, int wg_) {
    LAS unsigned char* const lds = uni_l(lds_); const int wave = uni_i(wave_), wg = uni_i(wg_);
    unsigned char* ws = uni(ws_);
    const bf16* iqf = (const bf16*)(ws + WS_IQF); const unsigned* sgn = (const unsigned*)(ws + WS_SGN); const bf16* ik = (const bf16*)(ws + WS_IK);
    unsigned short* sel = (unsigned short*)(ws + WS_SEL);
    gu32* slowl = (gu32*)(ws + WS_CTL + 65536) + (size_t)wg * 132;
    const int lane = lane_id_v();
    const int n = (int)__builtin_amdgcn_readfirstlane(__hip_atomic_load(slowl, RLX_AGENT));
    if (wave < 4) for (int k = wave; k < n; k += 4) { const int q = (int)__builtin_amdgcn_readfirstlane(__hip_atomic_load(slowl + 1 + k, RLX_AGENT)); select_query_slow(q, lds + wave * 36864, iqf, sgn, ik, sel, lane); }
    asm volatile("s_waitcnt vmcnt(0)" ::: "memory");
    __syncthreads();
}

__device__ __forceinline__ unsigned offb(unsigned row, unsigned ch) { return 256u * row + 16u * (ch ^ (((row & 3u) << 2) | ((row >> 2) & 3u))); }
__device__ __forceinline__ s16x4_t vtr(const LAS unsigned char* p) { return __builtin_bit_cast(s16x4_t, __builtin_amdgcn_ds_read_tr16_b64_v4i16((LAS s16x4_t*)p)); }

__device__ __noinline__ void dsa_attend(unsigned char* ws_, LAS unsigned char* lds_, const float* relb_, int wave_, int vcu_, int G_, int dry_) {
    const int dry = uni_i(dry_);
    LAS unsigned char* const lds = uni_l(lds_); const int wave = uni_i(wave_), vcu = uni_i(vcu_), G = uni_i(G_);
    unsigned char* ws = uni(ws_); const float* relb = uni(relb_);
    const bf16* ckv = (const bf16*)(ws + WS_CKV); bf16* ql = (bf16*)(ws + WS_QL); const unsigned short* sel = (const unsigned short*)(ws + WS_SEL);
    const int lane = lane_id_v(), tid = wave * 64 + lane;
    LAS unsigned char* cb = lds + wave * 16384;
    LAS unsigned short* sidx = (LAS unsigned short*)(lds + 131072 + wave * 512);
    LAS float* biasd = (LAS float*)(lds + 135168);
    for (int i = tid; i < 129 * 8; i += NWAVES * 64) { const int d = i >> 3, h = i & 7; const int bk = d < 128 ? (int)T5_BUCKET[d] : 31; biasd[i] = relb[bk * 8 + h]; }
    __syncthreads();
    const int hl = lane & 15, g = lane >> 4, hq = hl & 7;
    for (int p = vcu; p < BATCH * 64; p += G) {
        const int b = p >> 6, j = p & 63;
#pragma unroll 1
        for (int half = 0; half < 2; ++half) {
            const int ub = half == 0 ? j : 127 - j;
#pragma unroll 1
            for (int qi = 0; qi < 8; ++qi) {
                const int t = ub * 64 + wave * 8 + qi; const int q = b * SEQ + t; const int nsel = (t + 1) < TOPK ? (t + 1) : TOPK;
                const bf16* ckvb = ckv + (size_t)b * SEQ * KVR; bf16* qlrow = ql + (size_t)q * 1024;
                { const v2u w = *(const v2u*)(sel + (size_t)q * TOPK + 4 * lane); *(LAS v2u*)(sidx + 4 * lane) = w; }
                bf16x8_t qf[4];
#pragma unroll
                for (int s = 0; s < 4; ++s) qf[s] = *(const bf16x8_t*)(qlrow + hq * 128 + 32 * s + 8 * g);
                LDS_WAIT();
                float mrun = -1e30f, lsum = 0.f;
                f32x4 O[8];
#pragma unroll
                for (int c = 0; c < 8; ++c) O[c] = (f32x4){0.f, 0.f, 0.f, 0.f};
#define DSA_GATHER(c_) do { LAS unsigned char* dst_ = cb + ((c_) & 1) * 8192; \
                    _Pragma("unroll") for (int k_ = 0; k_ < 8; ++k_) { const int row_ = 4 * k_ + g; const int kidx_ = sidx[32 * (c_) + row_]; \
                        const int ch_ = hl ^ ((g << 2) | (k_ & 3)); \
                        __builtin_amdgcn_global_load_lds((const unsigned*)(ckvb + (size_t)kidx_ * KVR + ch_ * 8), (LAS unsigned*)(dst_ + k_ * 1024), 16, 0, 0); } } while (0)
                DSA_GATHER(0);
#pragma unroll 1
                for (int c = 0; c < 8; ++c) {
                    if (c < 7) { DSA_GATHER(c + 1); asm volatile("s_waitcnt vmcnt(8)" ::: "memory"); }
                    else asm volatile("s_waitcnt vmcnt(0)" ::: "memory");
                    const LAS unsigned char* img = cb + (c & 1) * 8192;
                    f32x4 S[2];
#pragma unroll
                    for (int rb = 0; rb < 2; ++rb) { S[rb] = (f32x4){0.f, 0.f, 0.f, 0.f}; const unsigned row = 8u * (hl >> 2) + 4u * rb + (hl & 3);
#pragma unroll
                        for (int s = 0; s < 4; ++s) { const bf16x8_t af = *(const LAS bf16x8_t*)(img + offb(row, 4 * s + g)); S[rb] = __builtin_amdgcn_mfma_f32_16x16x32_bf16(af, qf[s], S[rb], 0, 0, 0); } }
                    float pv[2][4]; float mx = -1e30f;
#pragma unroll
                    for (int rb = 0; rb < 2; ++rb) { const v2u iw2 = *(const LAS v2u*)(sidx + 32 * c + 8 * g + 4 * rb);
                        const int ki[4] = {(int)(iw2.x & 0xffffu), (int)(iw2.x >> 16), (int)(iw2.y & 0xffffu), (int)(iw2.y >> 16)};
#pragma unroll
                        for (int r = 0; r < 4; ++r) { int dist = t - ki[r]; dist = dist < 0 ? 0 : (dist > 128 ? 128 : dist);
                            float lg = S[rb][r] * 0.125f + biasd[dist * 8 + hq];
                            if (32 * c + 8 * g + 4 * rb + r >= nsel) lg = -1e30f;
                            pv[rb][r] = lg; mx = fmaxf(mx, lg); } }
                    mx = fmaxf(mx, __shfl_xor(mx, 16)); mx = fmaxf(mx, __shfl_xor(mx, 32));
                    const float mnew = fmaxf(mrun, mx); const float alpha = __expf(mrun - mnew); mrun = mnew;
                    float rs = 0.f;
#pragma unroll
                    for (int rb = 0; rb < 2; ++rb)
#pragma unroll
                        for (int r = 0; r < 4; ++r) { pv[rb][r] = __expf(pv[rb][r] - mnew); rs += pv[rb][r]; }
                    rs += __shfl_xor(rs, 16); rs += __shfl_xor(rs, 32);
                    lsum = lsum * alpha + rs;
                    v4u pw; pw.x = pg8::cvt_pk_bf16(pv[0][0], pv[0][1]); pw.y = pg8::cvt_pk_bf16(pv[0][2], pv[0][3]); pw.z = pg8::cvt_pk_bf16(pv[1][0], pv[1][1]); pw.w = pg8::cvt_pk_bf16(pv[1][2], pv[1][3]);
                    const bf16x8_t pf = __builtin_bit_cast(bf16x8_t, pw);
                    float al[4];
#pragma unroll
                    for (int r = 0; r < 4; ++r) al[r] = __shfl(alpha, 4 * g + r);
#pragma unroll
                    for (int cd = 0; cd < 8; ++cd) {
                        f32x4 o = O[cd]; o[0] *= al[0]; o[1] *= al[1]; o[2] *= al[2]; o[3] *= al[3];
                        const unsigned q4 = hl >> 2, p4 = hl & 3;
                        const s16x4_t b0 = vtr(img + offb(8u * g + q4, 2 * cd + (p4 >> 1)) + 8u * (p4 & 1));
                        const s16x4_t b1 = vtr(img + offb(8u * g + 4u + q4, 2 * cd + (p4 >> 1)) + 8u * (p4 & 1));
                        bf16x8_t bf; bf[0] = b0[0]; bf[1] = b0[1]; bf[2] = b0[2]; bf[3] = b0[3]; bf[4] = b1[0]; bf[5] = b1[1]; bf[6] = b1[2]; bf[7] = b1[3];
                        O[cd] = __builtin_amdgcn_mfma_f32_16x16x32_bf16(pf, bf, o, 0, 0, 0);
                    }
                }
#undef DSA_GATHER
                const float linv = 1.0f / lsum; float li[4];
#pragma unroll
                for (int r = 0; r < 4; ++r) li[r] = __shfl(linv, 4 * g + r);
                LAS unsigned short* ost = (LAS unsigned short*)cb;
                if (g < 2) {
#pragma unroll
                    for (int cd = 0; cd < 8; ++cd)
#pragma unroll
                        for (int r = 0; r < 4; ++r) ost[(4 * g + r) * 128 + 16 * cd + hl] = (unsigned short)f2bf(O[cd][r] * li[r]);
                }
                LDS_WAIT();
                { const v4u w0 = *(const LAS v4u*)(cb + 32 * lane), w1 = *(const LAS v4u*)(cb + 32 * lane + 16);
                  if (!dry) { *(v4u*)(qlrow + 16 * lane) = w0; *(v4u*)(qlrow + 16 * lane + 8) = w1; } else asm volatile("" :: "v"(w0), "v"(w1)); }
                LDS_WAIT();
            }
        }
    }
    __syncthreads();
}

__device__ __noinline__ void final_norm(const float* const* in_, float* out_, unsigned char* ws_, LAS unsigned char* lds_, int wave_, int vcu_, int G_) {
    const PC F{uni(in_), uni(out_), uni(ws_), uni_l(lds_), uni_i(wave_), uni_i(vcu_), uni_i(G_)}; struct { const float* const* in; float* out; } a{F.in, F.out};
    const int lane_ = lane_id_v(); const int gw = F.vcu * NWAVES + F.wave, NGW = F.G * NWAVES; const float* g = a.in[22];
    f32x4 gv[4];
#pragma unroll
    for (int j = 0; j < 4; ++j) gv[j] = ((const f32x4*)g)[lane_ + 64 * j];
    for (int m = gw; m < M; m += NGW) {
        GAS f32x4* xr = (GAS f32x4*)(a.out + (size_t)m * D) + lane_;
        f32x4 v[4]; float s = 0.f;
#pragma unroll
        for (int j = 0; j < 4; ++j) { v[j] = xr[64 * j]; s += (v[j].x * v[j].x + v[j].y * v[j].y) + (v[j].z * v[j].z + v[j].w * v[j].w); }
        const float rs = 1.0f / sqrtf(wave_sum(s) * (1.0f / D) + EPS);
#pragma unroll
        for (int j = 0; j < 4; ++j) xr[64 * j] = v[j] * rs * gv[j];
    }
}

#define KIN ((const float* const*)__builtin_amdgcn_kernarg_segment_ptr())
constexpr int PH_PER_LAYER = 10, PH_LAYER0 = 2, N_PHASES = PH_LAYER0 + PH_PER_LAYER * DEPTH + 1;

__global__ void __launch_bounds__(NWAVES * 64, 2) mk_fwd(Args args) {
    extern __shared__ __attribute__((aligned(16))) unsigned char lds[];
    Frame F;
    F.lds = (LAS unsigned char*)lds;
    F.MISC = (volatile LAS unsigned*)(F.lds + MISC_OFF);
    F.wave = __builtin_amdgcn_readfirstlane((int)threadIdx.x >> 6);
    F.G = gridDim.x; { const int bx = blockIdx.x; F.vcu = (F.G % 8 == 0) ? (bx % 8) * (F.G / 8) + bx / 8 : bx; }
    F.ws = args.ws; F.ctl = (gu32*)(args.ws + WS_CTL);
    if (threadIdx.x < 64) ((LAS unsigned*)(F.lds + MISC_OFF))[threadIdx.x] = 0u;
    __syncthreads();
    const int lo = args.ph_lo, hi = args.ph_hi;
    const bool multi = (hi - lo) > 1;
    XcdBarrier bar; bar.bar = (unsigned*)(F.ctl + CW_BAR); bar.x = 0; bar.st = nullptr; bar.wave = F.wave;
    if (multi) bar = xcd_barrier_post((unsigned*)(F.ctl + CW_BAR), F.MISC + 8, F.wave);
#define IN(k) (lo <= (k) && (k) < hi)
#define SEAM(k) do { if (IN(k) && IN((k) + 1)) xcd_barrier(bar); } while (0)

    if (IN(0)) {
#if EN_P0
 for (int rep = (PROBE_PHASE == 1 ? 0 : 1); rep < 2; ++rep) p0_prologue(KIN, args.out, args.ws, F.lds, F.wave, F.vcu, F.G);
#endif
 } SEAM(0);
    if (IN(1)) {
#if !((DIS_MASK >> 7) & 1)
 unsigned char* ws = launder_p(args.ws); bf16* hb = (bf16*)(ws + WS_HB); float* ss = (float*)(ws + WS_SS); (void)hb; (void)ss;
        pg8::Gemm g{(const bf16_t*)(ws + WS_MEMN), (const bf16_t*)(ws + WS_WMEM), MROWS, DEPTH * 2 * CW, D}; pg8::StaticOrder S; S.init(MROWS, DEPTH * 2 * CW, F.G, launder_s((int)blockIdx.x));
        EpiPlainBf16 E{(bf16_t*)(ws + WS_MEMKV), DEPTH * 2 * CW};
        pg8::gemm_phase<EpiPlainBf16, pg8::StaticOrder, true, true>(F.lds + RING_OFF, g, S, E, F.wave);
        { pg8::Gemm g2{(const bf16_t*)(ws + WS_WMEM), (const bf16_t*)(ws + WS_MEMN), DEPTH * 2 * CW, MROWS, D}; pg8::StaticOrder S2; S2.init(DEPTH * 2 * CW, MROWS, F.G, launder_s((int)blockIdx.x));
          EpiPlainBf16 E2{(bf16_t*)(ws + WS_VT), MROWS};
          pg8::gemm_phase<EpiPlainBf16, pg8::StaticOrder, true, true>(F.lds + RING_OFF, g2, S2, E2, F.wave); }
#endif
    } SEAM(1);

    for (int l = 0; l < DEPTH; ++l) {
        const int pb = PH_LAYER0 + PH_PER_LAYER * l;
        const float* hbase = (l == 0) ? args.in[0] : args.out;
        if (IN(pb + 0)) {
#if EN_P0
 if (l > 0) for (int rep = (PROBE_PHASE == 1 ? 0 : 1); rep < 2; ++rep) prep_layer_weights(KIN, args.out, args.ws, F.lds, l, F.wave, F.vcu, F.G);
#endif
 } SEAM(pb + 0);
        if (IN(pb + 1)) {
#if !((DIS_MASK >> 0) & 1)
 unsigned char* ws = launder_p(args.ws); bf16* hb = (bf16*)(ws + WS_HB); float* ss = (float*)(ws + WS_SS); (void)hb; (void)ss;
            pg8::Gemm g{hb, (const bf16_t*)(ws + WS_W1IN), M, 2 * DFF, D}; pg8::StaticOrder S; S.init(M, 2 * DFF, F.G, launder_s((int)blockIdx.x));
            EpiSwiglu E{(bf16_t*)(ws + WS_ACT), ss};
            for (int rep = (PROBE_PHASE == 2 ? 0 : 1); rep < 2; ++rep) pg8::gemm_phase<EpiSwiglu, pg8::StaticOrder, true, true>(F.lds + RING_OFF, g, S, E, F.wave);
#endif
        } SEAM(pb + 1);
        if (IN(pb + 2)) {
#if !((DIS_MASK >> 1) & 1)
 unsigned char* ws = launder_p(args.ws); bf16* hb = (bf16*)(ws + WS_HB); float* ss = (float*)(ws + WS_SS); (void)hb; (void)ss;
            pg8::Gemm g{(const bf16_t*)(ws + WS_ACT), (const bf16_t*)(ws + WS_W1OUT), M, D, DFF}; pg8::StaticOrder S; S.init(M, D, F.G, launder_s((int)blockIdx.x));
            EpiResid E{hbase, args.out, hb, ss, 0.5f, (LAS float*)(F.lds + RING_BYTES)};
            pg8::gemm_phase<EpiResid, pg8::StaticOrder, true, true>(F.lds + RING_OFF, g, S, E, F.wave);
#endif
        } SEAM(pb + 2);
        if (IN(pb + 3)) {
#if !((DIS_MASK >> 2) & 1)
 unsigned char* ws = launder_p(args.ws); bf16* hb = (bf16*)(ws + WS_HB); float* ss = (float*)(ws + WS_SS); (void)hb; (void)ss;
            pg8::Gemm g{hb, (const bf16_t*)(ws + WS_WIN), M, INP, D}; pg8::StaticOrder S; S.init(M, INP, F.G, launder_s((int)blockIdx.x));
            EpiInProj E{ss, (bf16_t*)(ws + WS_QL), (float*)(ws + WS_CKVRAW), (bf16_t*)(ws + WS_IK), (float*)(ws + WS_IW), (bf16_t*)(ws + WS_IQRAW), (bf16_t*)(ws + WS_Z), (bf16_t*)(ws + WS_QC), (bf16_t*)(ws + WS_G)};
            for (int rep = (PROBE_PHASE == 4 ? 0 : 1); rep < 2; ++rep) pg8::gemm_phase<EpiInProj, pg8::StaticOrder, true, true>(F.lds + RING_OFF, g, S, E, F.wave);
#endif
        } SEAM(pb + 3);
        if (IN(pb + 4)) {
#if EN_PREP
 for (int rep = (PROBE_PHASE == 5 ? 0 : 1); rep < 2; ++rep) prep_tokens(KIN, args.out, args.ws, F.lds, l, F.wave, F.vcu, F.G, rep == 0 ? 1 : 0);
#endif
 } SEAM(pb + 4);
        if (IN(pb + 5)) {
#if EN_DSA
 for (int rep = (PROBE_PHASE == 6 ? 0 : 1); rep < 2; ++rep) for (int p = F.vcu; p < BATCH * 64; p += F.G) { for (int half = 0; half < 2; ++half) { const int b_ = p >> 6, ub_ = half == 0 ? (p & 63) : 127 - (p & 63);
   sel_pass1(args.ws, F.lds, F.wave, b_, ub_); sel_pass2(args.ws, F.lds, F.wave, b_, ub_); sel_resolve(args.ws, F.lds, F.wave, b_, ub_, (int)blockIdx.x, (p == F.vcu && half == 0) ? 1 : 0); } }
 dsa_select_slow(args.ws, F.lds, F.wave, (int)blockIdx.x); for (int rep = (PROBE_PHASE == 7 ? 0 : 1); rep < 2; ++rep) dsa_attend(args.ws, F.lds, args.in[2], F.wave, F.vcu, F.G, rep == 0 ? 1 : 0);
#endif
 } SEAM(pb + 5);
        if (IN(pb + 6)) {
#if !((DIS_MASK >> 3) & 1)
 unsigned char* ws = launder_p(args.ws); bf16* hb = (bf16*)(ws + WS_HB); float* ss = (float*)(ws + WS_SS); (void)hb; (void)ss;
            { pg8::Gemm g{(const bf16_t*)(ws + WS_QL), (const bf16_t*)(ws + WS_WA), M, D, 1024}; pg8::StaticOrder S; S.init(M, D, F.G, launder_s((int)blockIdx.x));
              EpiMerge<0> E{(bf16_t*)(ws + WS_MERGED), (const bf16_t*)(ws + WS_G)};
              pg8::gemm_phase<EpiMerge<0>, pg8::StaticOrder, true, true>(F.lds + RING_OFF, g, S, E, F.wave); }
            { pg8::Gemm g{(const bf16_t*)(ws + WS_YB), (const bf16_t*)(ws + WS_WB), M, D, PW_}; pg8::StaticOrder S; S.init(M, D, F.G, launder_s((int)blockIdx.x));
              EpiMerge<1> E{(bf16_t*)(ws + WS_MERGED), (const bf16_t*)(ws + WS_G)};
              pg8::gemm_phase<EpiMerge<1>, pg8::StaticOrder, true, true>(F.lds + RING_OFF, g, S, E, F.wave); }
            { pg8::Gemm g{(const bf16_t*)(ws + WS_QC), (const bf16_t*)(ws + WS_WC), M, D, CW}; pg8::StaticOrder S; S.init(M, D, F.G, launder_s((int)blockIdx.x));
              EpiMerge<2> E{(bf16_t*)(ws + WS_MERGED), (const bf16_t*)(ws + WS_G)};
              pg8::gemm_phase<EpiMerge<2>, pg8::StaticOrder, true, true>(F.lds + RING_OFF, g, S, E, F.wave); }
#endif
        } SEAM(pb + 6);
        if (IN(pb + 7)) {
#if !((DIS_MASK >> 4) & 1)
 unsigned char* ws = launder_p(args.ws); bf16* hb = (bf16*)(ws + WS_HB); float* ss = (float*)(ws + WS_SS); (void)hb; (void)ss;
            pg8::Gemm g{(const bf16_t*)(ws + WS_MERGED), (const bf16_t*)(ws + WS_WOUT), M, D, D}; pg8::StaticOrder S; S.init(M, D, F.G, launder_s((int)blockIdx.x));
            EpiResid E{args.out, args.out, hb, ss, 1.0f, (LAS float*)(F.lds + RING_BYTES)};
            pg8::gemm_phase<EpiResid, pg8::StaticOrder, true, true>(F.lds + RING_OFF, g, S, E, F.wave);
#endif
        } SEAM(pb + 7);
        if (IN(pb + 8)) {
#if !((DIS_MASK >> 5) & 1)
 unsigned char* ws = launder_p(args.ws); bf16* hb = (bf16*)(ws + WS_HB); float* ss = (float*)(ws + WS_SS); (void)hb; (void)ss;
            pg8::Gemm g{hb, (const bf16_t*)(ws + WS_W2IN), M, 2 * DFF, D}; pg8::StaticOrder S; S.init(M, 2 * DFF, F.G, launder_s((int)blockIdx.x));
            EpiSwiglu E{(bf16_t*)(ws + WS_ACT), ss};
            for (int rep = (PROBE_PHASE == 2 ? 0 : 1); rep < 2; ++rep) pg8::gemm_phase<EpiSwiglu, pg8::StaticOrder, true, true>(F.lds + RING_OFF, g, S, E, F.wave);
#endif
        } SEAM(pb + 8);
        if (IN(pb + 9)) {
#if !((DIS_MASK >> 6) & 1)
 unsigned char* ws = launder_p(args.ws); bf16* hb = (bf16*)(ws + WS_HB); float* ss = (float*)(ws + WS_SS); (void)hb; (void)ss;
            pg8::Gemm g{(const bf16_t*)(ws + WS_ACT), (const bf16_t*)(ws + WS_W2OUT), M, D, DFF}; pg8::StaticOrder S; S.init(M, D, F.G, launder_s((int)blockIdx.x));
            EpiResid E{args.out, args.out, hb, ss, 0.5f, (LAS float*)(F.lds + RING_BYTES)};
            pg8::gemm_phase<EpiResid, pg8::StaticOrder, true, true>(F.lds + RING_OFF, g, S, E, F.wave);
#endif
        } SEAM(pb + 9);
    }
#if EN_P0
    if (IN(N_PHASES - 1)) { final_norm(KIN, args.out, args.ws, F.lds, F.wave, F.vcu, F.G); }
#endif
#undef IN
#undef SEAM
}

extern "C" void kernel_launch(void* const* d_in, const int* in_sizes, int n_in, void* d_out, int out_size, void* d_ws, size_t ws_size, hipStream_t stream) {
    static int grid = 0;
    if (grid == 0) {
        if (n_in != 23 || in_sizes[0] != M * D || out_size != M * D || ws_size < WS_END) { fprintf(stderr, "kernel_launch: unexpected shapes (n_in %d, ws %zu)\n", n_in, ws_size); grid = -1; return; }
        int dev = 0, cus = 0, per_cu = 0;
        if (hipGetDevice(&dev) != hipSuccess || hipDeviceGetAttribute(&cus, hipDeviceAttributeMultiprocessorCount, dev) != hipSuccess) { grid = -1; return; }
        if (hipFuncSetAttribute((const void*)mk_fwd, hipFuncAttributeMaxDynamicSharedMemorySize, LDS_BYTES) != hipSuccess) { fprintf(stderr, "kernel_launch: hipFuncSetAttribute failed\n"); grid = -1; return; }
        if (hipOccupancyMaxActiveBlocksPerMultiprocessor(&per_cu, (const void*)mk_fwd, NWAVES * 64, LDS_BYTES) != hipSuccess || per_cu < 1) { fprintf(stderr, "kernel_launch: occupancy query says %d\n", per_cu); }
        (void)hipGetLastError();
        grid = cus;
    }
    if (grid < 0) return;
    if (hipMemsetAsync((char*)d_ws + WS_CTL, 0, CTL_ZERO_BYTES, stream) != hipSuccess) return;
    Args a{};
    for (int i = 0; i < 23; ++i) a.in[i] = (const float*)d_in[i];
    a.out = (float*)d_out; a.ws = (unsigned char*)d_ws;
#if MK_ONE_LAUNCH
    a.ph_lo = 0; a.ph_hi = N_PHASES;
    hipLaunchKernelGGL(mk_fwd, dim3(grid), dim3(NWAVES * 64), LDS_BYTES, stream, a);
#endif
}
```

```cpp
#include <hip/hip_runtime.h>
#include <cstdio>
#include <cstdint>

#ifndef MK_ONE_LAUNCH
#define MK_ONE_LAUNCH 1
#endif
#ifndef PROBE_PHASE
#define PROBE_PHASE 0
#endif
#ifndef EN_P0
#define EN_P0 MK_ONE_LAUNCH
#endif
#ifndef EN_PREP
#define EN_PREP MK_ONE_LAUNCH
#endif
#ifndef EN_DSA
#define EN_DSA MK_ONE_LAUNCH
#endif
#ifndef DIS_MASK
#define DIS_MASK 0
#endif
#ifndef MK_ONE_LAUNCH
#define MK_ONE_LAUNCH 1
#endif

__device__ __forceinline__ int lane_id_v() { int l; asm volatile("v_mbcnt_lo_u32_b32 %0, -1, 0\n\tv_mbcnt_hi_u32_b32 %0, -1, %0" : "=v"(l)); return l; }
namespace pg8 {
#define PG8_LAS __attribute__((address_space(3)))
typedef unsigned short bf16_t;
typedef short bf16x8 __attribute__((ext_vector_type(8)));
typedef float f32x4 __attribute__((ext_vector_type(4)));
typedef unsigned u32x4 __attribute__((ext_vector_type(4)));
typedef unsigned u32x2 __attribute__((ext_vector_type(2)));
constexpr int BM = 256, BK = 64, HALF = 128, HTB = HALF * BK * 2, STAGE_BYTES = 8 * HTB, NXCD = 8, WGM = 8;

__host__ __device__ __forceinline__ int lds_byte(int r, int c) { const int st = (r >> 4) * 2 + (c >> 5), rr = r & 15, cc = c & 31, ob = rr * 64 + cc * 2; return st * 1024 + (ob ^ (((ob >> 9) & 1) << 5)); }
__host__ __device__ __forceinline__ void stage_rc(int b, int& R, int& C) { const int st = b / 1024, sb = b % 1024, swz = sb ^ (((sb >> 9) & 1) << 5); R = (st >> 1) * 16 + swz / 64; C = (st & 1) * 32 + (swz % 64) / 2; }
__host__ __device__ __forceinline__ int perm32(int rho) { const int n = rho >> 4, i = rho & 15; return 8 * (i >> 2) + 4 * n + (i & 3); }

struct Unit { int pm, pn; };
struct Gemm { const bf16_t* A; const bf16_t* Bt; int M, N, K; };

struct StaticOrder {
    int nM, nN, nwg, G, c;
    __host__ __device__ void init(int M, int N, int G_, int c_) { nM = M / BM; nN = N / BM; nwg = nM * nN; G = G_; c = c_; }
    __host__ __device__ bool next(int i, Unit& u) const {
        const long L = (long)i * G + c; if (L >= nwg) return false;
        int wgid = (int)L; { const int q = nwg / NXCD, r = nwg % NXCD, xcd = wgid % NXCD, off = wgid / NXCD; wgid = (xcd < r ? xcd * (q + 1) : r * (q + 1) + (xcd - r) * q) + off; }
        const int nig = WGM * nN, gid = wgid / nig, fm = gid * WGM, gsz = (nM - fm) < WGM ? (nM - fm) : WGM;
        u.pm = fm + ((wgid % nig) % gsz); u.pn = (wgid % nig) / gsz; return true;
    }
    __device__ __forceinline__ void a_ready(const Unit&) const {}
    __device__ __forceinline__ void done(const Unit&) const {}
};

__device__ __forceinline__ unsigned cvt_pk_bf16(float lo, float hi) { unsigned r; asm volatile("v_cvt_pk_bf16_f32 %0, %1, %2" : "=v"(r) : "v"(lo), "v"(hi)); return r; }

template <class Epi, class Sched, bool ALIGN_EPI = false, bool SP2 = false>
__device__ __forceinline__ void gemm_phase(PG8_LAS unsigned char* lds, const Gemm g, const Sched& S, const Epi& E, const int wid_) {
    int wid = wid_; asm volatile("" : "+s"(wid));
    const int lane = lane_id_v(), tid = wid * 64 + lane,
              wr = wid >> 2, wc = wid & 3, fr = lane & 15, fq = lane >> 4;
    const int K = g.K, nt = K / BK;
    unsigned voffA[2], voffB[2];
#pragma unroll
    for (int i = 0; i < 2; ++i) { int R, C; stage_rc(tid * 16 + i * 8192, R, C); const int Rb = Epi::PERM ? ((R & ~31) + perm32(R & 31)) : R;
        voffA[i] = (unsigned)(R * K + C) * 2u; voffB[i] = (unsigned)(Rb * K + C) * 2u; }
    const size_t kstep = (size_t)(BK * 2);
    const size_t hstep = (size_t)HALF * K * 2;
    const size_t tstep = 2 * hstep;
    const unsigned ldsw = (unsigned)wid * 1024u;
    const int aoff = lds_byte(wr * 64 + fr, fq * 8), boff = lds_byte(wc * 32 + fr, fq * 8);
#define PG8_SA(b, h) (((b) * 2 + (h)) * HTB)
#define PG8_SB(b, h) ((4 + (b) * 2 + (h)) * HTB)
#define PG8_STAGE(bufoff, gbase, voff) do { _Pragma("unroll") for (int _i = 0; _i < 2; ++_i) \
        __builtin_amdgcn_global_load_lds((const unsigned*)((const char*)(gbase) + (voff)[_i]), (PG8_LAS unsigned*)(lds + (bufoff) + ldsw + _i * 8192), 16, 0, 0); } while (0)
#define PG8_LDA(dst, b, h) do { _Pragma("unroll") for (int m = 0; m < 4; ++m) _Pragma("unroll") for (int k = 0; k < 2; ++k) dst[m][k] = *(const PG8_LAS bf16x8*)(lds + PG8_SA(b, h) + aoff + m * 2048 + k * 1024); } while (0)
#define PG8_LDB(dst, b, h) do { _Pragma("unroll") for (int n = 0; n < 2; ++n) _Pragma("unroll") for (int k = 0; k < 2; ++k) dst[n][k] = *(const PG8_LAS bf16x8*)(lds + PG8_SB(b, h) + boff + n * 2048 + k * 1024); } while (0)
#define PG8_MMA(ai, bj, At, Bt) do { __builtin_amdgcn_s_setprio(1); _Pragma("unroll") for (int m = 0; m < 4; ++m) _Pragma("unroll") for (int n = 0; n < 2; ++n) _Pragma("unroll") for (int k = 0; k < 2; ++k) \
        acc[ai][bj][m][n] = __builtin_amdgcn_mfma_f32_16x16x32_bf16(Bt[n][k], At[m][k], acc[ai][bj][m][n], 0, 0, 0); __builtin_amdgcn_s_setprio(0); } while (0)
#define PG8_WAIT_V(n) asm volatile("s_waitcnt vmcnt(" #n ")" ::: "memory")
#define PG8_WAIT_L(n) asm volatile("s_waitcnt lgkmcnt(" #n ")" ::: "memory")
#define PG8_BAR __builtin_amdgcn_s_barrier()
#define PG8_SCHED __builtin_amdgcn_sched_barrier(0)
    Unit cur, nxt; int ui = 0;
    if (!S.next(0, cur)) return;
    f32x4 acc[2][2][4][2];
#pragma unroll
    for (int a = 0; a < 2; ++a)
#pragma unroll
        for (int b = 0; b < 2; ++b)
#pragma unroll
            for (int m = 0; m < 4; ++m)
#pragma unroll
                for (int n = 0; n < 2; ++n) acc[a][b][m][n] = (f32x4){0.f, 0.f, 0.f, 0.f};
    bf16x8 At[4][2], B0[2][2], B1[2][2];
    const char* cA = (const char*)g.A + (size_t)cur.pm * tstep; const char* cB = (const char*)g.Bt + (size_t)cur.pn * tstep;
    S.a_ready(cur);
    if constexpr (SP2) {
        PG8_STAGE(PG8_SB(0, 0), cB, voffB); PG8_STAGE(PG8_SB(0, 1), cB + hstep, voffB); PG8_STAGE(PG8_SA(0, 0), cA, voffA); PG8_STAGE(PG8_SA(0, 1), cA + hstep, voffA);
        if (wr == 1) PG8_BAR;
        PG8_WAIT_V(2); PG8_BAR;
        PG8_STAGE(PG8_SB(1, 0), cB + kstep, voffB); PG8_STAGE(PG8_SA(1, 0), cA + kstep, voffA); PG8_STAGE(PG8_SB(1, 1), cB + hstep + kstep, voffB);
        PG8_WAIT_V(6); PG8_BAR;
    } else {
        PG8_STAGE(PG8_SB(0, 0), cB, voffB); PG8_STAGE(PG8_SA(0, 0), cA, voffA); PG8_STAGE(PG8_SB(0, 1), cB + hstep, voffB); PG8_STAGE(PG8_SA(0, 1), cA + hstep, voffA);
        if (wr == 1) PG8_BAR;
        PG8_WAIT_V(4); PG8_BAR;
        PG8_STAGE(PG8_SB(1, 0), cB + kstep, voffB); PG8_STAGE(PG8_SA(1, 0), cA + kstep, voffA); PG8_STAGE(PG8_SB(1, 1), cB + hstep + kstep, voffB);
        PG8_WAIT_V(6); PG8_BAR;
    }
    for (;;) {
        const bool has_next = S.next(ui + 1, nxt);
        const char* nA = has_next ? (const char*)g.A + (size_t)nxt.pm * tstep : cA; const char* nB = has_next ? (const char*)g.Bt + (size_t)nxt.pn * tstep : cB;
        for (int t = 0; t < nt; t += 2) {
            const bool last = (t == nt - 2);
            const char* a1 = cA + (size_t)(t + 1) * kstep;
            const char* a2 = last ? nA : cA + (size_t)(t + 2) * kstep; const char* b2 = last ? nB : cB + (size_t)(t + 2) * kstep;
            const char* a3 = a2 + kstep; const char* b3 = b2 + kstep;
            if (last && has_next) S.a_ready(nxt);
            if constexpr (SP2) {
            PG8_LDB(B0, 0, 0); PG8_LDB(B1, 0, 1); PG8_SCHED; PG8_LDA(At, 0, 0); PG8_STAGE(PG8_SA(1, 1), a1 + hstep, voffA);
            PG8_WAIT_V(8); PG8_WAIT_L(0); PG8_BAR; PG8_MMA(0, 0, At, B0); PG8_MMA(0, 1, At, B1); PG8_BAR; PG8_SCHED;
            PG8_LDA(At, 0, 1); PG8_STAGE(PG8_SB(0, 0), b2, voffB); PG8_STAGE(PG8_SB(0, 1), b2 + hstep, voffB); PG8_STAGE(PG8_SA(0, 0), a2, voffA);
            PG8_WAIT_V(8); PG8_WAIT_L(0); PG8_BAR; PG8_MMA(1, 0, At, B0); PG8_MMA(1, 1, At, B1); PG8_BAR; PG8_SCHED;
            PG8_LDB(B0, 1, 0); PG8_LDB(B1, 1, 1); PG8_SCHED; PG8_LDA(At, 1, 0); PG8_STAGE(PG8_SA(0, 1), a2 + hstep, voffA);
            PG8_WAIT_V(8); PG8_WAIT_L(0); PG8_BAR; PG8_MMA(0, 0, At, B0); PG8_MMA(0, 1, At, B1); PG8_BAR; PG8_SCHED;
            PG8_LDA(At, 1, 1); PG8_STAGE(PG8_SB(1, 0), b3, voffB); PG8_STAGE(PG8_SB(1, 1), b3 + hstep, voffB); PG8_STAGE(PG8_SA(1, 0), a3, voffA);
            PG8_WAIT_V(8); PG8_WAIT_L(0); PG8_BAR; PG8_MMA(1, 0, At, B0); PG8_MMA(1, 1, At, B1); PG8_BAR; PG8_SCHED;
            } else {
            PG8_LDB(B0, 0, 0); PG8_SCHED; PG8_LDA(At, 0, 0); PG8_STAGE(PG8_SA(1, 1), a1 + hstep, voffA);
            PG8_WAIT_L(8); PG8_BAR; PG8_WAIT_L(0); PG8_MMA(0, 0, At, B0); PG8_BAR; PG8_SCHED;
            PG8_LDB(B1, 0, 1); PG8_STAGE(PG8_SB(0, 0), b2, voffB);
            PG8_BAR; PG8_WAIT_L(0); PG8_MMA(0, 1, At, B1); PG8_BAR;
            PG8_LDA(At, 0, 1); PG8_STAGE(PG8_SA(0, 0), a2, voffA);
            PG8_BAR; PG8_WAIT_L(0); PG8_MMA(1, 0, At, B0); PG8_BAR; PG8_SCHED;
            PG8_STAGE(PG8_SB(0, 1), b2 + hstep, voffB);
            PG8_WAIT_V(6); PG8_BAR; PG8_MMA(1, 1, At, B1); PG8_BAR;
            PG8_LDB(B0, 1, 0); PG8_SCHED; PG8_LDA(At, 1, 0); PG8_STAGE(PG8_SA(0, 1), a2 + hstep, voffA);
            PG8_WAIT_L(8); PG8_BAR; PG8_WAIT_L(0); PG8_MMA(0, 0, At, B0); PG8_BAR; PG8_SCHED;
            PG8_LDB(B1, 1, 1); PG8_STAGE(PG8_SB(1, 0), b3, voffB);
            PG8_BAR; PG8_WAIT_L(0); PG8_MMA(0, 1, At, B1); PG8_BAR;
            PG8_LDA(At, 1, 1); PG8_STAGE(PG8_SA(1, 0), a3, voffA);
            PG8_BAR; PG8_WAIT_L(0); PG8_MMA(1, 0, At, B0); PG8_BAR; PG8_SCHED;
            PG8_STAGE(PG8_SB(1, 1), b3 + hstep, voffB);
            PG8_WAIT_V(6); PG8_BAR; PG8_MMA(1, 1, At, B1); PG8_BAR;
            }
        }
        if constexpr (ALIGN_EPI) { if (wr == 0) PG8_BAR; }
        E(acc, cur, wr, wc, fr, fq); S.done(cur);
        if (!has_next) break;
#pragma unroll
        for (int a = 0; a < 2; ++a)
#pragma unroll
            for (int b = 0; b < 2; ++b)
#pragma unroll
                for (int m = 0; m < 4; ++m)
#pragma unroll
                    for (int n = 0; n < 2; ++n) acc[a][b][m][n] = (f32x4){0.f, 0.f, 0.f, 0.f};
        cur = nxt; cA = nA; cB = nB; ++ui;
        if constexpr (ALIGN_EPI) { if (wr == 1) PG8_BAR; }
    }
    PG8_WAIT_V(0);
    if constexpr (!ALIGN_EPI) { if (wr == 0) PG8_BAR; }
    PG8_BAR;
#undef PG8_SA
#undef PG8_SB
#undef PG8_STAGE
#undef PG8_LDA
#undef PG8_LDB
#undef PG8_MMA
#undef PG8_WAIT_V
#undef PG8_WAIT_L
#undef PG8_BAR
#undef PG8_SCHED
}
}

constexpr int NWAVES = 8;
constexpr int BATCH = 4, SEQ = 8192, D = 1024, DEPTH = 4, M = BATCH * SEQ;
constexpr int NMEM = 256, MROWS = BATCH * NMEM;
constexpr int AH = 8, AHD = 64, AW = 512, KVR = 128, IH = 8, IDIM = 32, TOPK = 256;
constexpr int PW_ = 256, CH = 4, CHD = 64, CW = 256;
constexpr int DFF = 2816, INW = 4520, INP = 5120;
constexpr float EPS = 1e-6f;
constexpr int C_QA = 0, C_CKV = 512, C_IQ = 640, C_IK = 896, C_IW = 928, C_Z = 936, C_QC = 1192, C_G = 1448;

constexpr size_t MiB = 1u << 20;
constexpr size_t WS_CTL = 0, CTL_ZERO_BYTES = 1 * MiB;
constexpr size_t WS_SS = 1 * MiB;
constexpr size_t WS_IW = 3 * MiB;
constexpr size_t WS_SGN = 4 * MiB;
constexpr size_t WS_MEMN = 5 * MiB;
constexpr size_t WS_WMEM = 7 * MiB;
constexpr size_t WS_MEMKV = 11 * MiB;
constexpr size_t WS_W1IN = 15 * MiB, WS_W1OUT = 26 * MiB, WS_WIN = 32 * MiB, WS_WA = 42 * MiB, WS_WB = 44 * MiB, WS_WC = 44 * MiB + 512 * 1024, WS_WOUT = 45 * MiB, WS_W2IN = 47 * MiB, WS_W2OUT = 58 * MiB;
constexpr size_t WS_HB = 64 * MiB;
constexpr size_t WS_ACT = 128 * MiB;
constexpr size_t WS_G = 128 * MiB;
constexpr size_t WS_QL = 320 * MiB;
constexpr size_t WS_CKV = 384 * MiB;
constexpr size_t WS_CKVRAW = 392 * MiB;
constexpr size_t WS_IQRAW = 408 * MiB;
constexpr size_t WS_IQF = 424 * MiB;
constexpr size_t WS_IK = 440 * MiB;
constexpr size_t WS_Z = 442 * MiB;
constexpr size_t WS_MERGED = 384 * MiB;
constexpr size_t WS_YB = 458 * MiB;
constexpr size_t WS_QC = 474 * MiB;
constexpr size_t WS_SEL = 490 * MiB;
constexpr size_t WS_VT = 506 * MiB;
constexpr size_t WS_WPT = 4 * MiB + 512 * 1024;
constexpr size_t WS_END = 510 * MiB;
constexpr int CW_BAR = 4096;

constexpr int RING_OFF = 0, RING_BYTES = 131072;
constexpr int LDS_BYTES = 155648;
constexpr int MISC_OFF = LDS_BYTES - 256;

#define GAS __attribute__((address_space(1)))
#define LAS __attribute__((address_space(3)))
typedef unsigned short bf16;
typedef unsigned v4u __attribute__((ext_vector_type(4)));
typedef unsigned v2u __attribute__((ext_vector_type(2)));
typedef float f32x4 __attribute__((ext_vector_type(4)));
typedef float f32x2 __attribute__((ext_vector_type(2)));
typedef GAS unsigned gu32;
#define RLX_AGENT __ATOMIC_RELAXED, __HIP_MEMORY_SCOPE_AGENT
#define LDS_WAIT() asm volatile("s_waitcnt lgkmcnt(0)" ::: "memory")
#define VM_WAIT() asm volatile("s_waitcnt vmcnt(0)" ::: "memory")
__device__ __forceinline__ unsigned f2bf(float f) { unsigned u = __builtin_bit_cast(unsigned, f); return (u + 0x7fffu + ((u >> 16) & 1u)) >> 16; }
__device__ __forceinline__ unsigned pk2(float lo, float hi) { return f2bf(lo) | (f2bf(hi) << 16); }
__device__ __forceinline__ float bflo(unsigned w) { return __builtin_bit_cast(float, w << 16); }
__device__ __forceinline__ float bfhi(unsigned w) { return __builtin_bit_cast(float, w & 0xffff0000u); }
__device__ __forceinline__ float bf2f(bf16 b) { return __builtin_bit_cast(float, ((unsigned)b) << 16); }

#define XB_TMO      128
#define XB_XCNT(j)  (256  + 64 * (j))
#define XB_XSUB(j)  (1280 + 64 * (j))
#define XB_XGEN(j)  (2304 + 64 * (j))
#define XB_TOP      3328
#define XB_TOPGEN   3392
#define XCD_BAR_WORDS 3456
#define XB_SPIN_CAP (1u << 23)

__device__ __forceinline__ unsigned xb_ld(unsigned* p)              { return __hip_atomic_load(p, __ATOMIC_RELAXED, __HIP_MEMORY_SCOPE_AGENT); }
__device__ __forceinline__ unsigned xb_add(unsigned* p, unsigned v) { return __hip_atomic_fetch_add(p, v, __ATOMIC_RELAXED, __HIP_MEMORY_SCOPE_AGENT); }
__device__ __forceinline__ unsigned xb_xcc_id() { return (unsigned)__builtin_amdgcn_s_getreg((3 << 11) | 20) & 0xFu; }
#define XB_SPIN(cond, bar) do { unsigned _sp = 0; while (cond) { __builtin_amdgcn_s_sleep(1); \
    if ((++_sp & 255u) == 0u) { if (xb_ld(&(bar)[XB_TMO])) break; if (_sp > XB_SPIN_CAP) { atomicAdd(&(bar)[XB_TMO], 1u); break; } } } } while (0)

struct XcdBarrier { unsigned* bar; unsigned x; volatile LAS unsigned* st; int wave; };

__device__ __forceinline__ XcdBarrier xcd_barrier_post(unsigned* bar, volatile LAS unsigned* st, int wave) {
    XcdBarrier b; b.bar = bar; b.x = xb_xcc_id(); b.st = st; b.wave = wave;
    if (threadIdx.x == 0) (void)xb_add(&bar[XB_XCNT(b.x)], 1u);
    return b;
}
__device__ __forceinline__ void xcd_barrier_complete(unsigned* bar, unsigned x, unsigned& nloc, unsigned& nx) {
    const unsigned G = gridDim.x * gridDim.y * gridDim.z;
    unsigned sum, cnt, mine, sp = 0u;
    for (;;) {
        sum = 0u; cnt = 0u; mine = 0u;
#pragma unroll
        for (unsigned j = 0; j < 16; ++j) { const unsigned c = xb_ld(&bar[XB_XCNT(j)]); sum += c; cnt += (c > 0u) ? 1u : 0u; mine = (j == x) ? c : mine; }
        if (sum == G) break;
        __builtin_amdgcn_s_sleep(1);
        if ((++sp & 255u) == 0u) { if (xb_ld(&bar[XB_TMO])) break; if (sp > XB_SPIN_CAP) { atomicAdd(&bar[XB_TMO], 1u); break; } }
    }
    nloc = mine > 0u ? mine : 1u; nx = cnt > 0u ? cnt : 1u;
}
__device__ __forceinline__ void xcd_barrier(const XcdBarrier& b) {
    asm volatile("s_waitcnt vmcnt(0)" ::: "memory");
    __syncthreads();
    int bw_ = b.wave; asm volatile("" : "+s"(bw_));
    if (bw_ == 0 && lane_id_v() == 0) {
        unsigned* bar = b.bar;
        __builtin_amdgcn_s_waitcnt(0);
        unsigned nloc = b.st[0], nx = b.st[1];
        if (nloc == 0u) { xcd_barrier_complete(bar, b.x, nloc, nx); b.st[0] = nloc; b.st[1] = nx; }
        const unsigned old = xb_add(&bar[XB_XSUB(b.x)], 1u);
        const unsigned gen = old / nloc;
        if (old + 1u == (gen + 1u) * nloc) {
            __builtin_amdgcn_fence(__ATOMIC_RELEASE, "agent");
            asm volatile("s_waitcnt vmcnt(0)" ::: "memory");
            const unsigned og = xb_add(&bar[XB_TOP], 1u);
            const unsigned tg = og / nx;
            if (og + 1u == (tg + 1u) * nx) xb_add(&bar[XB_TOPGEN], 1u);
            else XB_SPIN(xb_ld(&bar[XB_TOPGEN]) == tg, bar);
            __builtin_amdgcn_fence(__ATOMIC_ACQUIRE, "agent");
            xb_add(&bar[XB_XGEN(b.x)], 1u);
            asm volatile("s_waitcnt vmcnt(0)" ::: "memory");
        } else {
            XB_SPIN(xb_ld(&bar[XB_XGEN(b.x)]) == gen, bar);
            __builtin_amdgcn_fence(__ATOMIC_ACQUIRE, "agent");
            asm volatile("s_waitcnt vmcnt(0)" ::: "memory");
        }
    }
    __syncthreads();
}

struct Args {
    const float* in[23]; float* out; unsigned char* ws; int ph_lo, ph_hi;
};
template <class T> __device__ __forceinline__ T* uni(T* p) { const unsigned long long v = (unsigned long long)p; const unsigned lo = __builtin_amdgcn_readfirstlane((unsigned)v), hi = __builtin_amdgcn_readfirstlane((unsigned)(v >> 32)); return (T*)(((unsigned long long)hi << 32) | lo); }
__device__ __forceinline__ LAS unsigned char* uni_l(LAS unsigned char* p) { return (LAS unsigned char*)(unsigned)__builtin_amdgcn_readfirstlane((int)(unsigned)(size_t)p); }
__device__ __forceinline__ int uni_i(int v) { return __builtin_amdgcn_readfirstlane(v); }
struct PC { const float* const* in; float* out; unsigned char* ws; LAS unsigned char* lds; int wave, vcu, G; };
struct Frame {
    LAS unsigned char* lds;
    volatile LAS unsigned* MISC;
    gu32* ctl;
    int wave, vcu, G;
    unsigned char* ws;
};
__device__ __forceinline__ unsigned char* launder_p(unsigned char* p) { asm volatile("" : "+s"(p)); return p; }
__device__ __forceinline__ int launder_s(int v) { asm volatile("" : "+s"(v)); return v; }
__device__ __forceinline__ int launder_v(int v) { asm volatile("" : "+v"(v)); return v; }
__device__ __forceinline__ float wave_sum(float v) {
#pragma unroll
    for (int o = 1; o < 64; o <<= 1) v += __shfl_xor(v, o);
    return v;
}
__device__ __forceinline__ float wave_max(float v) {
#pragma unroll
    for (int o = 1; o < 64; o <<= 1) v = fmaxf(v, __shfl_xor(v, o));
    return v;
}

using pg8::Unit; using pg8::bf16_t;
#define LAUNDER2(a, b) asm volatile("" : "+v"(a), "+v"(b))
__device__ __forceinline__ float row_scale(const float* ss, int row) {
    const f32x4 a = *(const f32x4*)(ss + (size_t)row * 4);
    const float s = (a.x + a.y) + (a.z + a.w);
    return 1.0f / sqrtf(s * (1.0f / D) + EPS);
}
__device__ __forceinline__ float sigmoidf_(float x) { return 1.0f / (1.0f + __expf(-x)); }
__device__ __forceinline__ pg8::u32x2 pack4(const f32x4 v) { pg8::u32x2 w; w.x = pg8::cvt_pk_bf16(v[0], v[1]); w.y = pg8::cvt_pk_bf16(v[2], v[3]); return w; }

struct EpiSwiglu {
    static constexpr bool PERM = false;
    bf16_t* O; const float* ss;
    __device__ __forceinline__ void operator()(const f32x4 (&acc)[2][2][4][2], const Unit& u, int wr, int wc, int fr_, int fq_) const {
        const int l_ = lane_id_v(); const int fr = l_ & 15, fq = l_ >> 4; (void)fr_; (void)fq_;
        int rb = wr * 64 + fr, cb = wc * 16 + 4 * fq; LAUNDER2(rb, cb);
        const int row0 = u.pm * 256 + rb, col0 = u.pn * 128 + cb;
#pragma unroll
        for (int ai = 0; ai < 2; ++ai)
#pragma unroll
            for (int m = 0; m < 4; ++m) { const int row = row0 + ai * 128 + m * 16; const float s = row_scale(ss, row);
                bf16_t* rowp = O + (size_t)row * DFF + col0;
#pragma unroll
                for (int bj = 0; bj < 2; ++bj) { const f32x4 a = acc[ai][bj][m][0] * s, b = acc[ai][bj][m][1] * s; f32x4 o;
#pragma unroll
                    for (int i = 0; i < 4; ++i) o[i] = a[i] * sigmoidf_(a[i]) * b[i];
                    *(pg8::u32x2*)(rowp + bj * 64) = pack4(o); } }
    }
};
struct EpiResid {
    static constexpr bool PERM = false;
    const float* base; float* out; bf16_t* hb; float* ss; float alpha; LAS float* P;
    __device__ __forceinline__ void operator()(const f32x4 (&acc)[2][2][4][2], const Unit& u, int wr, int wc, int fr_, int fq_) const {
        const int l_ = lane_id_v(); const int fr = l_ & 15, fq = l_ >> 4; (void)fr_; (void)fq_;
        int rb = wr * 64 + fr, cb = wc * 32 + 4 * fq; LAUNDER2(rb, cb);
        const int row0 = u.pm * 256 + rb, col0 = u.pn * 256 + cb;
#pragma unroll
        for (int ai = 0; ai < 2; ++ai)
#pragma unroll
            for (int m = 0; m < 4; ++m) { const int row = row0 + ai * 128 + m * 16; const size_t off = (size_t)row * D + col0; float q = 0.f;
#pragma unroll
                for (int bj = 0; bj < 2; ++bj)
#pragma unroll
                    for (int n = 0; n < 2; ++n) { const f32x4 bs = *(const f32x4*)(base + off + bj * 128 + n * 16); const f32x4 v = bs + acc[ai][bj][m][n] * alpha;
                        *(f32x4*)(out + off + bj * 128 + n * 16) = v;
                        *(pg8::u32x2*)(hb + off + bj * 128 + n * 16) = pack4(v);
                        q += (v[0] * v[0] + v[1] * v[1]) + (v[2] * v[2] + v[3] * v[3]); }
                q += __shfl_xor(q, 16); q += __shfl_xor(q, 32);
                if (fq == 0) P[(rb + ai * 128 + m * 16) * 4 + wc] = q;
                asm volatile("" ::: "memory"); }
        asm volatile("s_waitcnt lgkmcnt(0)" ::: "memory"); __builtin_amdgcn_s_barrier(); asm volatile("" ::: "memory");
        const int tid = (wr * 4 + wc) * 64 + fq * 16 + fr;
        if (tid < 256) { const f32x4 p = *(const LAS f32x4*)(P + tid * 4); ss[(size_t)(u.pm * 256 + tid) * 4 + u.pn] = (p.x + p.y) + (p.z + p.w); }
    }
};
struct EpiPlainBf16 {
    static constexpr bool PERM = false;
    bf16_t* O; int ldo;
    __device__ __forceinline__ void operator()(const f32x4 (&acc)[2][2][4][2], const Unit& u, int wr, int wc, int fr_, int fq_) const {
        const int l_ = lane_id_v(); const int fr = l_ & 15, fq = l_ >> 4; (void)fr_; (void)fq_;
        int rb = wr * 64 + fr, cb = wc * 32 + 4 * fq; LAUNDER2(rb, cb);
        const int row0 = u.pm * 256 + rb, col0 = u.pn * 256 + cb;
#pragma unroll
        for (int ai = 0; ai < 2; ++ai)
#pragma unroll
            for (int m = 0; m < 4; ++m) { bf16_t* rowp = O + (size_t)(row0 + ai * 128 + m * 16) * ldo + col0;
#pragma unroll
                for (int bj = 0; bj < 2; ++bj)
#pragma unroll
                    for (int n = 0; n < 2; ++n) *(pg8::u32x2*)(rowp + bj * 128 + n * 16) = pack4(acc[ai][bj][m][n]); }
    }
};
struct EpiInProj {
    static constexpr bool PERM = false;
    const float* ss; bf16_t* qa; float* ckvraw; bf16_t* ik; float* iw; bf16_t* iqraw; bf16_t* z; bf16_t* qc; bf16_t* G;
    __device__ __forceinline__ void operator()(const f32x4 (&acc)[2][2][4][2], const Unit& u, int wr, int wc, int fr_, int fq_) const {
        const int l_ = lane_id_v(); const int fr = l_ & 15, fq = l_ >> 4; (void)fr_; (void)fq_;
        int rb = wr * 64 + fr, ct = wc * 32 + 4 * fq; LAUNDER2(rb, ct);
        const int row0 = u.pm * 256 + rb; const int pn = u.pn;
        if (pn == 4) {
#pragma unroll
            for (int ai = 0; ai < 2; ++ai)
#pragma unroll
                for (int m = 0; m < 4; ++m) { const int row = row0 + ai * 128 + m * 16; const float s = row_scale(ss, row);
#pragma unroll
                    for (int n = 0; n < 2; ++n) { *(f32x4*)(ckvraw + (size_t)row * KVR + ct + n * 16) = acc[ai][0][m][n] * s;
                        if (wc == 0) *(pg8::u32x2*)(ik + (size_t)row * IDIM + 4 * fq + n * 16) = pack4(acc[ai][1][m][n] * s); }
                    if (wc == 1 && fq < 2) *(f32x4*)(iw + (size_t)row * IH + 4 * fq) = acc[ai][1][m][0] * s; }
        } else {
            bf16_t* dst0; int ld; bool sig = false;
            if (pn < 4) { dst0 = qa + pn * 256; ld = 1024; } else if (pn == 5) { dst0 = iqraw; ld = 256; } else if (pn == 6) { dst0 = z; ld = 256; } else if (pn == 7) { dst0 = qc; ld = 256; } else { dst0 = G + (pn - 8) * 256; ld = 3072; sig = true; }
#pragma unroll
            for (int ai = 0; ai < 2; ++ai)
#pragma unroll
                for (int m = 0; m < 4; ++m) { const int row = row0 + ai * 128 + m * 16; const float s = row_scale(ss, row); bf16_t* rowp = dst0 + (size_t)row * ld + ct;
#pragma unroll
                    for (int bj = 0; bj < 2; ++bj)
#pragma unroll
                        for (int n = 0; n < 2; ++n) { f32x4 o = acc[ai][bj][m][n] * s;
                            if (sig) {
#pragma unroll
                                for (int i = 0; i < 4; ++i) o[i] = sigmoidf_(o[i]); }
                            *(pg8::u32x2*)(rowp + bj * 128 + n * 16) = pack4(o); } }
        }
    }
};
template <int MODE> struct EpiMerge {
    static constexpr bool PERM = false;
    bf16_t* Mg; const bf16_t* G;
    __device__ __forceinline__ void operator()(const f32x4 (&acc)[2][2][4][2], const Unit& u, int wr, int wc, int fr_, int fq_) const {
        const int l_ = lane_id_v(); const int fr = l_ & 15, fq = l_ >> 4; (void)fr_; (void)fq_;
        int rb = wr * 64 + fr, cb = wc * 32 + 4 * fq; LAUNDER2(rb, cb);
        const int row0 = u.pm * 256 + rb, col0 = u.pn * 256 + cb;
#pragma unroll
        for (int ai = 0; ai < 2; ++ai)
#pragma unroll
            for (int m = 0; m < 4; ++m) { const int row = row0 + ai * 128 + m * 16;
                const bf16_t* gp = G + (size_t)row * 3072 + MODE * 1024 + col0; bf16_t* mp = Mg + (size_t)row * D + col0;
#pragma unroll
                for (int bj = 0; bj < 2; ++bj)
#pragma unroll
                    for (int n = 0; n < 2; ++n) { const int co = bj * 128 + n * 16;
                        const pg8::u32x2 gw = *(const pg8::u32x2*)(gp + co);
                        f32x4 o = acc[ai][bj][m][n]; o[0] *= bflo(gw.x); o[1] *= bfhi(gw.x); o[2] *= bflo(gw.y); o[3] *= bfhi(gw.y);
                        if (MODE > 0) { const pg8::u32x2 pw = *(const pg8::u32x2*)(mp + co); o[0] += bflo(pw.x); o[1] += bfhi(pw.x); o[2] += bflo(pw.y); o[3] += bfhi(pw.y); }
                        *(pg8::u32x2*)(mp + co) = pack4(o); }
                asm volatile("" ::: "memory"); }
    }
};

template <class Map>
__device__ __forceinline__ void transpose_item(const float* W, int K, int N, const float* gain, bf16* WT, LAS float* scr, int item, int lane, Map map) {
    const int nblk = (N + 31) / 32, kb = item / nblk, nb = item % nblk, k0 = 64 * kb, n0 = 32 * nb;
    const int nn = n0 + (lane & 31); const bool nok = nn < N;
#pragma unroll 4
    for (int i = 0; i < 32; ++i) { const int kk = 2 * i + (lane >> 5); float v = nok ? W[(size_t)(k0 + kk) * N + nn] : 0.f; if (gain) v *= gain[k0 + kk]; scr[kk * 33 + (lane & 31)] = v; }
    LDS_WAIT(); asm volatile("" ::: "memory");
    const int c = lane & 7;
#pragma unroll
    for (int j = 0; j < 4; ++j) { const int n = (lane >> 3) + 8 * j; const LAS float* s = scr + (8 * c) * 33 + n;
        v4u o; o.x = pk2(s[0 * 33], s[1 * 33]); o.y = pk2(s[2 * 33], s[3 * 33]); o.z = pk2(s[4 * 33], s[5 * 33]); o.w = pk2(s[6 * 33], s[7 * 33]);
        if (n0 + n < N) { const int dr = map(n0 + n); if (dr >= 0) *(GAS v4u*)(WT + (size_t)dr * K + k0 + 8 * c) = o; } }
    LDS_WAIT(); asm volatile("" ::: "memory");
}
struct MapId { int off; __device__ __forceinline__ int operator()(int n) const { return off + n; } };
struct MapSwiglu { __device__ __forceinline__ int operator()(int c) const { const int half = c >= DFF ? 1 : 0, j = c - half * DFF; return 32 * (j >> 4) + 16 * half + (j & 15); } };
struct MapInProj { __device__ __forceinline__ int operator()(int c) const {
    if (c < C_CKV) return -1;
    if (c < C_IQ) return 1024 + (c - C_CKV);
    if (c < C_IK) return 1280 + (c - C_IQ);
    if (c < C_IW) return 1152 + (c - C_IK);
    if (c < C_Z) return 1184 + (c - C_IW);
    if (c < C_QC) return 1536 + (c - C_Z);
    if (c < C_G) return 1792 + (c - C_QC);
    return 2048 + (c - C_G); } };
__device__ __forceinline__ void qlat_item(const float* win, const float* mixn, const float* wuk, bf16* WT, int item, int lane) {
    const int kc = item & 127, rh = (item >> 7) & 1, h = item >> 8; const int r = rh * 64 + lane;
    const f32x4* wp = (const f32x4*)(wuk + (size_t)r * (AH * AHD) + h * 64);
    float acc[8] = {0.f, 0.f, 0.f, 0.f, 0.f, 0.f, 0.f, 0.f};
#pragma unroll 1
    for (int dc = 0; dc < 4; ++dc) {
        const f32x4 w0 = wp[4 * dc], w1 = wp[4 * dc + 1], w2 = wp[4 * dc + 2], w3 = wp[4 * dc + 3];
#pragma unroll
        for (int kk = 0; kk < 8; ++kk) { const f32x4* ip = (const f32x4*)(win + (size_t)(kc * 8 + kk) * INW + h * 64 + 16 * dc);
            const f32x4 a0 = ip[0], a1 = ip[1], a2 = ip[2], a3 = ip[3];
            acc[kk] += (a0.x * w0.x + a0.y * w0.y + a0.z * w0.z + a0.w * w0.w) + (a1.x * w1.x + a1.y * w1.y + a1.z * w1.z + a1.w * w1.w)
                     + (a2.x * w2.x + a2.y * w2.y + a2.z * w2.z + a2.w * w2.w) + (a3.x * w3.x + a3.y * w3.y + a3.z * w3.z + a3.w * w3.w);
            if (kk & 1) asm volatile("" ::: "memory"); }
    }
    const f32x4 g0 = *(const f32x4*)(mixn + kc * 8), g1 = *(const f32x4*)(mixn + kc * 8 + 4);
    v4u w; w.x = pk2(acc[0] * g0.x, acc[1] * g0.y); w.y = pk2(acc[2] * g0.z, acc[3] * g0.w); w.z = pk2(acc[4] * g1.x, acc[5] * g1.y); w.w = pk2(acc[6] * g1.z, acc[7] * g1.w);
    *(GAS v4u*)(WT + (size_t)(h * 128 + r) * D + kc * 8) = w;
}
__device__ __forceinline__ void wafold_item(const float* wuv, const float* wba, bf16* WT, int item, int lane) {
    const int ng = item & 15, rg = (item >> 4) & 15, h = item >> 8; const int n = ng * 64 + lane, r0 = rg * 8;
    float acc[8] = {0.f, 0.f, 0.f, 0.f, 0.f, 0.f, 0.f, 0.f};
#pragma unroll 4
    for (int d = 0; d < 64; ++d) { const float wa = wba[(size_t)(h * 64 + d) * D + n];
#pragma unroll
        for (int j = 0; j < 8; ++j) acc[j] += wuv[(size_t)(r0 + j) * (AH * AHD) + h * 64 + d] * wa; }
    v4u w; w.x = pk2(acc[0], acc[1]); w.y = pk2(acc[2], acc[3]); w.z = pk2(acc[4], acc[5]); w.w = pk2(acc[6], acc[7]);
    *(GAS v4u*)(WT + (size_t)n * 1024 + h * 128 + r0) = w;
}
__device__ __forceinline__ int items_of(int K, int N) { return (K / 64) * ((N + 31) / 32); }

__device__ __forceinline__ void prep_layer_weights_body(const PC& F, int l) {
    struct { const float* const* in; } a{F.in};
    const int lane_ = lane_id_v();
    LAS float* scr = (LAS float*)(F.lds + RING_OFF + F.wave * 16384);
    const int gw = F.vcu * NWAVES + F.wave, NGW = F.G * NWAVES;
    const float* f1n = a.in[3] + (size_t)l * D; const float* f1in = a.in[4] + (size_t)l * D * 2 * DFF; const float* f1out = a.in[5] + (size_t)l * DFF * D;
    const float* mixn = a.in[6] + (size_t)l * D; const float* win = a.in[7] + (size_t)l * D * INW;
    const float* wba = a.in[15] + (size_t)l * AW * D; const float* wbb = a.in[16] + (size_t)l * PW_ * D; const float* wbc = a.in[17] + (size_t)l * CW * D;
    const float* wout = a.in[18] + (size_t)l * D * D;
    const float* f2n = a.in[19] + (size_t)l * D; const float* f2in = a.in[20] + (size_t)l * D * 2 * DFF; const float* f2out = a.in[21] + (size_t)l * DFF * D;
    unsigned char* ws = launder_p(F.ws);
    const float* wuk = a.in[9] + (size_t)l * KVR * AH * AHD; const float* wuv = a.in[10] + (size_t)l * KVR * AH * AHD;
    const int I0 = items_of(D, 2 * DFF), I1 = items_of(DFF, D), I2 = items_of(D, INW), I4 = items_of(PW_, D), I5 = items_of(CW, D), I6 = items_of(D, D);
    const int NIT = 2 * I0 + 2 * I1 + I2 + I4 + I5 + I6;
#pragma unroll 1
    for (int it = gw; it < NIT; it += NGW) {
        int r = it;
        if (r < I0) { transpose_item(f1in, D, 2 * DFF, f1n, (bf16*)(ws + WS_W1IN), scr, r, lane_, MapSwiglu{}); continue; } r -= I0;
        if (r < I0) { transpose_item(f2in, D, 2 * DFF, f2n, (bf16*)(ws + WS_W2IN), scr, r, lane_, MapSwiglu{}); continue; } r -= I0;
        if (r < I1) { transpose_item(f1out, DFF, D, nullptr, (bf16*)(ws + WS_W1OUT), scr, r, lane_, MapId{0}); continue; } r -= I1;
        if (r < I1) { transpose_item(f2out, DFF, D, nullptr, (bf16*)(ws + WS_W2OUT), scr, r, lane_, MapId{0}); continue; } r -= I1;
        if (r < I2) { transpose_item(win, D, INW, mixn, (bf16*)(ws + WS_WIN), scr, r, lane_, MapInProj{}); continue; } r -= I2;
        if (r < I4) { transpose_item(wbb, PW_, D, nullptr, (bf16*)(ws + WS_WB), scr, r, lane_, MapId{0}); continue; } r -= I4;
        if (r < I5) { transpose_item(wbc, CW, D, nullptr, (bf16*)(ws + WS_WC), scr, r, lane_, MapId{0}); continue; } r -= I5;
        transpose_item(wout, D, D, nullptr, (bf16*)(ws + WS_WOUT), scr, r, lane_, MapId{0});
    }
    { const float* wpool = a.in[11] + (size_t)l * 4 * 64 * 64; bf16* wpT = (bf16*)(ws + WS_WPT);
      for (int i = gw * 64 + lane_; i < 4 * 64 * 64; i += NGW * 64) { const int c = i & 63, d = (i >> 6) & 63, g = i >> 12; wpT[i] = (bf16)f2bf(wpool[(g * 64 + c) * 64 + d]); } }
    asm volatile("" ::: "memory");
#pragma unroll 1
    for (int it = gw; it < 2048; it += NGW) wafold_item(wuv, wba, (bf16*)(ws + WS_WA), it, lane_);
    asm volatile("" ::: "memory");
#pragma unroll 1
    for (int it = gw; it < 2048; it += NGW) qlat_item(win, mixn, wuk, (bf16*)(ws + WS_WIN), it, lane_);
}

__device__ __noinline__ void p0_prologue(const float* const* in_, float* out_, unsigned char* ws_, LAS unsigned char* lds_, int wave_, int vcu_, int G_) {
    const PC F{uni(in_), uni(out_), uni(ws_), uni_l(lds_), uni_i(wave_), uni_i(vcu_), uni_i(G_)}; struct { const float* const* in; } a{F.in};
    const int lane_ = lane_id_v();
    const int gw = F.vcu * NWAVES + F.wave, NGW = F.G * NWAVES;
    const float* x = a.in[0]; const float* mem = a.in[1];
    bf16* hb = (bf16*)(F.ws + WS_HB); float* ss = (float*)(F.ws + WS_SS); bf16* memn = (bf16*)(F.ws + WS_MEMN);
    for (int m = gw; m < M + MROWS; m += NGW) {
        const bool ismem = m >= M; const int r = ismem ? m - M : m;
        const GAS f32x4* xr = (const GAS f32x4*)((ismem ? mem : x) + (size_t)r * D) + lane_;
        f32x4 v[4]; float s = 0.f;
#pragma unroll
        for (int j = 0; j < 4; ++j) { v[j] = xr[64 * j]; s += (v[j].x * v[j].x + v[j].y * v[j].y) + (v[j].z * v[j].z + v[j].w * v[j].w); }
        s = wave_sum(s);
        float sc = 1.f;
        if (ismem) sc = 1.0f / sqrtf(s * (1.0f / D) + EPS);
        else if (lane_ < 4) ss[(size_t)r * 4 + lane_] = lane_ == 0 ? s : 0.f;
        GAS unsigned long long* o8 = (GAS unsigned long long*)((ismem ? memn : hb) + (size_t)r * D) + lane_;
#pragma unroll
        for (int j = 0; j < 4; ++j) o8[64 * j] = (unsigned long long)pk2(v[j].x * sc, v[j].y * sc) | ((unsigned long long)pk2(v[j].z * sc, v[j].w * sc) << 32);
    }
    LAS float* scr = (LAS float*)(F.lds + RING_OFF + F.wave * 16384);
    const int IM = items_of(D, 2 * CW);
    for (int it = gw; it < DEPTH * IM; it += NGW) { const int l = it / IM, r = it % IM;
        transpose_item(a.in[14] + (size_t)l * D * 2 * CW, D, 2 * CW, a.in[13] + (size_t)l * D, (bf16*)(F.ws + WS_WMEM), scr, r, lane_, MapId{l * 2 * CW}); }
    prep_layer_weights_body(F, 0);
}
__device__ __noinline__ void prep_layer_weights(const float* const* in_, float* out_, unsigned char* ws_, LAS unsigned char* lds_, int l, int wave_, int vcu_, int G_) {
    const PC F{uni(in_), uni(out_), uni(ws_), uni_l(lds_), uni_i(wave_), uni_i(vcu_), uni_i(G_)}; prep_layer_weights_body(F, uni_i(l));
}

__constant__ unsigned char T5_BUCKET[128] = {0, 1, 2, 3, 4, 5, 6, 7, 8, 9, 10, 11, 12, 13, 14, 15, 16, 16, 16, 17, 17, 18, 18, 18, 19, 19, 19, 20, 20, 20, 20, 21, 21, 21, 21, 22, 22, 22, 22, 22, 23, 23, 23, 23, 23, 23, 24, 24, 24, 24, 24, 24, 25, 25, 25, 25, 25, 25, 25, 26, 26, 26, 26, 26, 26, 26, 26, 27, 27, 27, 27, 27, 27, 27, 27, 27, 27, 28, 28, 28, 28, 28, 28, 28, 28, 28, 28, 29, 29, 29, 29, 29, 29, 29, 29, 29, 29, 29, 29, 30, 30, 30, 30, 30, 30, 30, 30, 30, 30, 30, 30, 30, 30, 31, 31, 31, 31, 31, 31, 31, 31, 31, 31, 31, 31, 31, 31, 31};

typedef short bf16x8_p __attribute__((ext_vector_type(8)));
__device__ __forceinline__ void prep_tokens(const float* const* in_, float* out_, unsigned char* ws_, LAS unsigned char* lds_, int l_, int wave_, int vcu_, int G_, int dry_) {
    const int dry = uni_i(dry_);
    const PC F{uni(in_), uni(out_), uni(ws_), uni_l(lds_), uni_i(wave_), uni_i(vcu_), uni_i(G_)}; struct { const float* const* in; } a{F.in}; const int l = uni_i(l_);
    unsigned char* ws = launder_p(F.ws);
    const float* ckvraw = (const float*)(ws + WS_CKVRAW); bf16* ckv = (bf16*)(ws + WS_CKV);
    const bf16* iqraw = (const bf16*)(ws + WS_IQRAW); bf16* iqf = (bf16*)(ws + WS_IQF); const float* iw = (const float*)(ws + WS_IW); unsigned* sgn = (unsigned*)(ws + WS_SGN);
    const bf16* z = (const bf16*)(ws + WS_Z); bf16* yb = (bf16*)(ws + WS_YB); bf16* qc = (bf16*)(ws + WS_QC);
    const bf16* memkv = (const bf16*)(ws + WS_MEMKV); const bf16* vT = (const bf16*)(ws + WS_VT); const bf16* wpT = (const bf16*)(ws + WS_WPT);
    const float* kvn = a.in[8] + (size_t)l * KVR; const float* pscale = a.in[12] + (size_t)l * PW_;
    const int lane = lane_id_v(), tid = F.wave * 64 + lane;
    const int tok = lane & 15, g4 = lane >> 4;
    LAS unsigned char* Ks = F.lds;
    LAS unsigned char* Vs = F.lds + 36864;
    for (int blk = F.vcu; blk < M / 128; blk += F.G) {
        const int rowb = blk * 128, b = rowb / SEQ, row0 = rowb + F.wave * 16;
#pragma unroll 1
        for (int tt = 0; tt < 16; ++tt) { const int row = row0 + tt;
            { const f32x2 v = *(const f32x2*)(ckvraw + (size_t)row * KVR + 2 * lane); const float q = wave_sum(v.x * v.x + v.y * v.y);
              const float rs = 1.0f / sqrtf(q * (1.0f / KVR) + EPS); const f32x2 g = *(const f32x2*)(kvn + 2 * lane);
              *(unsigned*)(ckv + (size_t)row * KVR + 2 * lane) = pk2(v.x * rs * g.x, v.y * rs * g.y); }
            { const float wv = iw[(size_t)row * IH + (lane >> 3)]; const float aw = fabsf(wv) * (1.0f / 16.0f);
              const v2u q = *(const v2u*)(iqraw + (size_t)row * 256 + 4 * lane);
              v2u o; o.x = pk2(bflo(q.x) * aw, bfhi(q.x) * aw); o.y = pk2(bflo(q.y) * aw, bfhi(q.y) * aw);
              *(v2u*)(iqf + (size_t)row * 256 + 4 * lane) = o;
              const unsigned long long bal = __ballot(wv < 0.f);
              unsigned mask = 0;
#pragma unroll
              for (int h = 0; h < 8; ++h) mask |= ((unsigned)(bal >> (8 * h)) & 1u) << h;
              if (lane == 0) sgn[row] = mask; } }
        { const int row = row0 + tok, spos = row % SEQ;
#pragma unroll 1
          for (int g = 0; g < 4; ++g) { const int w = 2 << g; const int cnt = (spos + 1) < w ? (spos + 1) : w; const float rc = 1.0f / (float)cnt;
              bf16x8_p pf[2];
#pragma unroll
              for (int ks = 0; ks < 2; ++ks) { const int c0 = g * 64 + 32 * ks + 8 * g4; float sum[8], z0[8];
#pragma unroll
                  for (int e = 0; e < 8; ++e) { sum[e] = 0.f; z0[e] = 0.f; }
                  for (int j = 0; j < w; ++j) { if (j < cnt) { const v4u v = *(const v4u*)(z + (size_t)(row - j) * 256 + c0);
                      const float f[8] = {bflo(v.x), bfhi(v.x), bflo(v.y), bfhi(v.y), bflo(v.z), bfhi(v.z), bflo(v.w), bfhi(v.w)};
#pragma unroll
                      for (int e = 0; e < 8; ++e) { sum[e] += f[e]; if (j == 0) z0[e] = f[e]; } } }
                  v4u pw; pw.x = pk2(sum[0] * rc - z0[0], sum[1] * rc - z0[1]); pw.y = pk2(sum[2] * rc - z0[2], sum[3] * rc - z0[3]); pw.z = pk2(sum[4] * rc - z0[4], sum[5] * rc - z0[5]); pw.w = pk2(sum[6] * rc - z0[6], sum[7] * rc - z0[7]);
                  pf[ks] = __builtin_bit_cast(bf16x8_p, pw); }
#pragma unroll
              for (int dt = 0; dt < 4; ++dt) { f32x4 acc = {0.f, 0.f, 0.f, 0.f};
#pragma unroll
                  for (int ks = 0; ks < 2; ++ks) { const bf16x8_p af = *(const bf16x8_p*)(wpT + (size_t)(g * 64 + 16 * dt + tok) * 64 + 32 * ks + 8 * g4); acc = __builtin_amdgcn_mfma_f32_16x16x32_bf16(af, pf[ks], acc, 0, 0, 0); }
                  const f32x4 ps = *(const f32x4*)(pscale + g * 64 + 16 * dt + 4 * g4);
                  v2u o; o.x = pk2(acc[0] * ps.x, acc[1] * ps.y); o.y = pk2(acc[2] * ps.z, acc[3] * ps.w);
                  *(v2u*)(yb + (size_t)row * 256 + g * 64 + 16 * dt + 4 * g4) = o; } } }
#pragma unroll 1
        for (int h = 0; h < CH; ++h) {
            __syncthreads();
#pragma unroll
            for (int e = 0; e < 4; ++e) { const int i = tid + 512 * e;
                { const int m = i >> 3, c = i & 7; const v4u v = *(const v4u*)(memkv + (size_t)(b * NMEM + m) * 2048 + l * 512 + h * 64 + c * 8); *(LAS v4u*)(Ks + m * 144 + c * 16) = v; }
                { const int d = i >> 5, c = i & 31; const v4u v = *(const v4u*)(vT + (size_t)(l * 512 + 256 + h * 64 + d) * MROWS + b * NMEM + c * 8); *(LAS v4u*)(Vs + d * 528 + c * 16) = v; } }
            LDS_WAIT(); __syncthreads();
            const int row = row0 + tok;
            bf16x8_p qf[2];
#pragma unroll
            for (int ks = 0; ks < 2; ++ks) qf[ks] = *(const bf16x8_p*)(qc + (size_t)row * 256 + h * 64 + 32 * ks + 8 * g4);
            f32x4 S[16]; float mx = -1e30f;
#pragma unroll
            for (int mt = 0; mt < 16; ++mt) { f32x4 acc = {0.f, 0.f, 0.f, 0.f};
#pragma unroll
                for (int ks = 0; ks < 2; ++ks) { const bf16x8_p kf = *(const LAS bf16x8_p*)(Ks + (16 * mt + tok) * 144 + (4 * ks + g4) * 16); acc = __builtin_amdgcn_mfma_f32_16x16x32_bf16(kf, qf[ks], acc, 0, 0, 0); }
                S[mt] = acc; mx = fmaxf(mx, fmaxf(fmaxf(acc[0], acc[1]), fmaxf(acc[2], acc[3]))); if ((mt & 3) == 3) __builtin_amdgcn_sched_barrier(0); }
            mx = fmaxf(mx, __shfl_xor(mx, 16)); mx = fmaxf(mx, __shfl_xor(mx, 32));
            float sm = 0.f;
#pragma unroll
            for (int mt = 0; mt < 16; ++mt)
#pragma unroll
                for (int r = 0; r < 4; ++r) { const float p = __expf((S[mt][r] - mx) * 0.125f); S[mt][r] = p; sm += p; }
            sm += __shfl_xor(sm, 16); sm += __shfl_xor(sm, 32);
            const float inv = 1.0f / sm;
            f32x4 oacc[4];
#pragma unroll
            for (int dt = 0; dt < 4; ++dt) oacc[dt] = (f32x4){0.f, 0.f, 0.f, 0.f};
#pragma unroll
            for (int kk = 0; kk < 8; ++kk) { v4u pw; pw.x = pg8::cvt_pk_bf16(S[2 * kk][0], S[2 * kk][1]); pw.y = pg8::cvt_pk_bf16(S[2 * kk][2], S[2 * kk][3]); pw.z = pg8::cvt_pk_bf16(S[2 * kk + 1][0], S[2 * kk + 1][1]); pw.w = pg8::cvt_pk_bf16(S[2 * kk + 1][2], S[2 * kk + 1][3]);
                const bf16x8_p pfr = __builtin_bit_cast(bf16x8_p, pw);
#pragma unroll
                for (int dt = 0; dt < 4; ++dt) { const LAS unsigned char* vp = Vs + (16 * dt + tok) * 528 + (32 * kk + 4 * g4) * 2;
                    const v2u lo = *(const LAS v2u*)vp, hi = *(const LAS v2u*)(vp + 32);
                    v4u vw; vw.x = lo.x; vw.y = lo.y; vw.z = hi.x; vw.w = hi.y;
                    oacc[dt] = __builtin_amdgcn_mfma_f32_16x16x32_bf16(__builtin_bit_cast(bf16x8_p, vw), pfr, oacc[dt], 0, 0, 0); }
                __builtin_amdgcn_sched_barrier(0); }
#pragma unroll
            for (int dt = 0; dt < 4; ++dt) { v2u o; o.x = pk2(oacc[dt][0] * inv, oacc[dt][1] * inv); o.y = pk2(oacc[dt][2] * inv, oacc[dt][3] * inv);
                if (!dry) *(v2u*)(qc + (size_t)row * 256 + h * 64 + 16 * dt + 4 * g4) = o; else asm volatile("" :: "v"(o.x), "v"(o.y)); }
        }
    }
    __syncthreads();
}

__device__ __forceinline__ unsigned key_of(float s) { const unsigned u = __builtin_bit_cast(unsigned, s); return (u & 0x80000000u) ? ~u : (u | 0x80000000u); }

typedef short bf16x8_t __attribute__((ext_vector_type(8)));
typedef short s16x4_t __attribute__((ext_vector_type(4)));
__device__ __forceinline__ void glds16(const void* gsrc, unsigned lds_dst) { unsigned keep;
    asm volatile("s_mov_b32 %0, m0\n\ts_mov_b32 m0, %2\n\ts_nop 0\n\tglobal_load_lds_dwordx4 %1, off\n\ts_mov_b32 m0, %0" : "=&s"(keep) : "v"(gsrc), "s"(lds_dst) : "memory"); }
__device__ __forceinline__ void select_query_slow(int q, LAS unsigned char* base  , const bf16* iqf, const unsigned* sgn, const bf16* ik, unsigned short* sel, int lane) {
    LAS unsigned* keys = (LAS unsigned*)base;
    LAS float* qf = (LAS float*)(base + 32768);
    const int b = q / SEQ, t = q % SEQ; const int n = t + 1;
    const size_t brow = (size_t)b * SEQ;
    unsigned short* srow = sel + (size_t)q * TOPK;
    { const v2u w = *(const v2u*)(iqf + (size_t)q * 256 + 4 * lane); qf[4 * lane] = bflo(w.x); qf[4 * lane + 1] = bfhi(w.x); qf[4 * lane + 2] = bflo(w.y); qf[4 * lane + 3] = bfhi(w.y); }
    const unsigned smask = sgn[q];
    LDS_WAIT();
    if (n <= TOPK) { for (int j = lane; j < TOPK; j += 64) srow[j] = (unsigned short)(j < n ? j : 0); return; }
    for (int s0 = 0; s0 < n; s0 += 64) { const int s = s0 + lane;
        if (s < n) {
            const v4u* kp = (const v4u*)(ik + (brow + s) * IDIM);
            float kf[32];
#pragma unroll
            for (int c = 0; c < 4; ++c) { const v4u kv = kp[c]; kf[8 * c] = bflo(kv.x); kf[8 * c + 1] = bfhi(kv.x); kf[8 * c + 2] = bflo(kv.y); kf[8 * c + 3] = bfhi(kv.y); kf[8 * c + 4] = bflo(kv.z); kf[8 * c + 5] = bfhi(kv.z); kf[8 * c + 6] = bflo(kv.w); kf[8 * c + 7] = bfhi(kv.w); }
            float sc = 0.f;
#pragma unroll
            for (int h = 0; h < 8; ++h) { float d = 0.f;
#pragma unroll
                for (int j4 = 0; j4 < 8; ++j4) { const f32x4 qv = *(const LAS f32x4*)(qf + h * 32 + 4 * j4); d += qv.x * kf[4 * j4] + qv.y * kf[4 * j4 + 1] + qv.z * kf[4 * j4 + 2] + qv.w * kf[4 * j4 + 3]; }
                d = fmaxf(d, 0.f); sc += ((smask >> h) & 1u) ? -d : d; }
            keys[s] = key_of(sc + 0.0f);
        } }
    LDS_WAIT();
    unsigned T = 0u;
    for (int bit = 31; bit >= 0; --bit) { const unsigned cand = T | (1u << bit); int cnt = 0;
        for (int s0 = 0; s0 < n; s0 += 64) { const int s = s0 + lane; const bool ge = (s < n) && (keys[s] >= cand); cnt += (int)__builtin_popcountll(__ballot(ge)); }
        if (cnt >= TOPK) T = cand; }
    int cgt = 0;
    for (int s0 = 0; s0 < n; s0 += 64) { const int s = s0 + lane; const bool gt = (s < n) && (keys[s] > T); cgt += (int)__builtin_popcountll(__ballot(gt)); }
    const int need_eq = TOPK - cgt;
    int pos = 0, peq = 0; const unsigned long long lt = (lane == 0) ? 0ull : (~0ull >> (64 - lane));
    for (int s0 = 0; s0 < n; s0 += 64) { const int s = s0 + lane; const unsigned k = (s < n) ? keys[s] : 0u;
        const bool gt = (s < n) && (k > T), eq = (s < n) && (k == T);
        const unsigned long long be = __ballot(eq);
        const int eqrank = peq + (int)__builtin_popcountll(be & lt);
        const bool take = gt || (eq && eqrank < need_eq);
        const unsigned long long bt = __ballot(take);
        if (take) srow[pos + (int)__builtin_popcountll(bt & lt)] = (unsigned short)s;
        pos += (int)__builtin_popcountll(bt); peq += (int)__builtin_popcountll(be); }
    LDS_WAIT();
}

typedef float f32x16 __attribute__((ext_vector_type(16)));
constexpr int SEL_CAP = 256;
constexpr int SL_HIST = 0, SL_SEL = 0, SL_CS = 32768, SL_CI = 98304, SL_KEYS = 131072, SL_ST = 147456;

#define SEL_DECLS \
    LAS unsigned char* const lds = uni_l(lds_); const int wave = uni_i(wave_), b = uni_i(b_), ub = uni_i(ub_); unsigned char* ws = uni(ws_); \
    const bf16* iqf = (const bf16*)(ws + WS_IQF); const unsigned* sgn = (const unsigned*)(ws + WS_SGN); const bf16* ik = (const bf16*)(ws + WS_IK); \
    const int lane = lane_id_v(), tid = wave * 64 + lane; const int kl = lane & 31, c5 = lane >> 5; \
    LAS unsigned* hist = (LAS unsigned*)(lds + SL_HIST); LAS unsigned short* lsel = (LAS unsigned short*)(lds + SL_SEL); LAS float* lcs = (LAS float*)(lds + SL_CS); \
    LAS unsigned short* lci = (LAS unsigned short*)(lds + SL_CI); LAS unsigned* st = (LAS unsigned*)(lds + SL_ST); LAS float* stf = (LAS float*)(lds + SL_ST); \
    const int t0 = ub * 64; const int q0 = b * SEQ + t0; const bf16* ikb = ik + (size_t)b * SEQ * IDIM; const int ntile = (t0 + 64 + 127) >> 7; \
    (void)hist; (void)lsel; (void)lcs; (void)lci; (void)stf; (void)tid;
#define SEL_LOAD_A \
    bf16x8_t af[2][2]; float sgc[2][16]; \
    { const int i = kl, a_ = i >> 3, cc_ = (i >> 2) & 1, e_ = i & 3; const int qq_ = 2 * cc_ + (a_ >> 1), hh_ = 4 * (a_ & 1) + e_; \
      _Pragma("unroll") for (int rt = 0; rt < 2; ++rt) { const unsigned flip_ = ((sgn[q0 + 8 * wave + 4 * rt + qq_] >> hh_) & 1u) ? 0x80008000u : 0u;     \
          _Pragma("unroll") for (int ks = 0; ks < 2; ++ks) { v4u w_ = *(const v4u*)(iqf + (size_t)(q0 + 8 * wave + 4 * rt + qq_) * 256 + hh_ * 32 + 16 * ks + 8 * c5); \
              w_.x ^= flip_; w_.y ^= flip_; w_.z ^= flip_; w_.w ^= flip_; af[rt][ks] = __builtin_bit_cast(bf16x8_t, w_); } } \
      _Pragma("unroll") for (int rt = 0; rt < 2; ++rt) _Pragma("unroll") for (int u = 0; u < 2; ++u) { const unsigned m_ = sgn[q0 + 8 * wave + 4 * rt + 2 * c5 + u]; \
          _Pragma("unroll") for (int h = 0; h < 8; ++h) sgc[rt][8 * u + h] = ((m_ >> h) & 1u) ? -__builtin_inff() : __builtin_inff(); } }
#define SEL_STAGE(kt_) do { const int key_ = 16 * wave + (lane >> 2); const int ch_ = (lane & 3) ^ ((key_ >> 2) & 3); \
    glds16(ikb + (size_t)(128 * (kt_) + key_) * IDIM + ch_ * 8, (unsigned)__builtin_amdgcn_readfirstlane((int)(unsigned)(size_t)(lds + SL_KEYS + ((kt_) & 1) * 8192 + wave * 1024))); } while (0)
#define SEL_SCORES(kt_) do { const LAS unsigned char* kb_ = lds + SL_KEYS + ((kt_) & 1) * 8192; \
    _Pragma("unroll") for (int kh = 0; kh < 4; ++kh) { const int key_ = 32 * kh + kl; \
        const bf16x8_t b0_ = *(const LAS bf16x8_t*)(kb_ + key_ * 64 + 16 * ((0 + c5) ^ ((key_ >> 2) & 3))); \
        const bf16x8_t b1_ = *(const LAS bf16x8_t*)(kb_ + key_ * 64 + 16 * ((2 + c5) ^ ((key_ >> 2) & 3))); \
        _Pragma("unroll") for (int rt = 0; rt < 2; ++rt) { f32x16 acc_ = {0.f,0.f,0.f,0.f,0.f,0.f,0.f,0.f,0.f,0.f,0.f,0.f,0.f,0.f,0.f,0.f}; \
            acc_ = __builtin_amdgcn_mfma_f32_32x32x16_bf16(af[rt][0], b0_, acc_, 0, 0, 0); acc_ = __builtin_amdgcn_mfma_f32_32x32x16_bf16(af[rt][1], b1_, acc_, 0, 0, 0); \
            _Pragma("unroll") for (int u = 0; u < 2; ++u) { float s_ = 0.f;     \
                _Pragma("unroll") for (int h = 0; h < 8; ++h) s_ += __builtin_amdgcn_fmed3f(acc_[8 * u + h], 0.f, sgc[rt][8 * u + h]); \
                sc[rt][kh][u] = s_; } } } } while (0)
#define SEL_BOUNDARY(FINAL) do { \
    const int qq = tid >> 3, part = tid & 7; const LAS v4u* hp = (const LAS v4u*)(hist + qq * 256 + 32 * part); \
    unsigned bins[32]; \
    _Pragma("unroll") for (int i = 0; i < 8; ++i) { const v4u v = hp[i]; bins[4 * i] = v.x; bins[4 * i + 1] = v.y; bins[4 * i + 2] = v.z; bins[4 * i + 3] = v.w; } \
    unsigned ps = 0; \
    _Pragma("unroll") for (int i = 0; i < 32; ++i) ps += bins[i]; \
    unsigned v = ps, tt; \
    tt = __shfl_down(v, 1, 8); if (part + 1 < 8) v += tt; \
    tt = __shfl_down(v, 2, 8); if (part + 2 < 8) v += tt; \
    tt = __shfl_down(v, 4, 8); if (part + 4 < 8) v += tt; \
    unsigned cacc = v - ps; \
    if (cacc < (unsigned)TOPK && v >= (unsigned)TOPK) { int bsel = 0; unsigned na = 0, cb = 0; bool found = false; \
        _Pragma("unroll") for (int i = 31; i >= 0; --i) { const bool hit = !found && (cacc + bins[i] >= (unsigned)TOPK); if (hit) { bsel = i; na = cacc; cb = bins[i]; found = true; } cacc += bins[i]; } \
        st[128 + qq] = (unsigned)(32 * part + bsel); if (FINAL) { st[192 + qq] = na; st[256 + qq] = cb; st[448 + qq] = cb > (unsigned)SEL_CAP ? 1u : 0u; } } } while (0)

__device__ __forceinline__ void sel_pass1(unsigned char* ws_, LAS unsigned char* lds_, int wave_, int b_, int ub_) {
    SEL_DECLS
    unsigned short* sel = (unsigned short*)(ws + WS_SEL);
    __syncthreads();
    if (ub < 4) {
        for (int i = tid; i < 64 * TOPK; i += NWAVES * 64) { const int qq = i >> 8, sl = i & 255; sel[(size_t)(q0 + qq) * TOPK + sl] = (unsigned short)(sl <= t0 + qq ? sl : 0); }
        if (tid == 0) st[512] = 1u;
        asm volatile("s_waitcnt vmcnt(0) lgkmcnt(0)" ::: "memory"); __syncthreads();
        return;
    }
    SEL_LOAD_A
    for (int i = tid; i < 64 * 256; i += NWAVES * 64) hist[i] = 0u;
    if (tid < 64) { st[128 + tid] = 0u; st[448 + tid] = 0u; }
    if (tid == 0) st[512] = 0u;
    float sc[2][4][2];
    float scl[2][2]; int bcur[2][2];
#pragma unroll
    for (int rt = 0; rt < 2; ++rt)
#pragma unroll
        for (int u = 0; u < 2; ++u) { scl[rt][u] = 0.f; bcur[rt][u] = 0; }
    SEL_STAGE(0);
#pragma unroll 1
    for (int kt = 0; kt < ntile; ++kt) {
        asm volatile("s_waitcnt vmcnt(0) lgkmcnt(0)" ::: "memory"); __syncthreads();
        if (kt > 0 && (kt & 3) == 0) {
            SEL_BOUNDARY(false);
            asm volatile("s_waitcnt lgkmcnt(0)" ::: "memory"); __syncthreads();
#pragma unroll
            for (int rt = 0; rt < 2; ++rt)
#pragma unroll
                for (int u = 0; u < 2; ++u) bcur[rt][u] = (int)st[128 + 8 * wave + 4 * rt + 2 * c5 + u];
        }
        if (kt + 1 < ntile) SEL_STAGE(kt + 1);
        SEL_SCORES(kt);
        if (kt == 0) {
#pragma unroll
            for (int rt = 0; rt < 2; ++rt)
#pragma unroll
                for (int u = 0; u < 2; ++u) { float mx = 0.f;
#pragma unroll
                    for (int kh = 0; kh < 4; ++kh) mx = fmaxf(mx, fabsf(sc[rt][kh][u]));
#pragma unroll
                    for (int o = 1; o < 32; o <<= 1) mx = fmaxf(mx, __shfl_xor(mx, o));
                    const float R = mx > 0.f ? 2.0f * mx : 1.0f;
                    scl[rt][u] = 128.0f / R;
                    if (kl == 0) stf[8 * wave + 4 * rt + 2 * c5 + u] = scl[rt][u]; }
        }
        const bool masked = 128 * kt + 127 > t0;
#pragma unroll
        for (int rt = 0; rt < 2; ++rt)
#pragma unroll
            for (int u = 0; u < 2; ++u) { const int qq = 8 * wave + 4 * rt + 2 * c5 + u; const int lim = masked ? (t0 + qq - 128 * kt - kl) : 1000;
#pragma unroll
                for (int kh = 0; kh < 4; ++kh) { const float fb = __builtin_amdgcn_fmed3f(fmaf(sc[rt][kh][u], scl[rt][u], 128.0f), 0.f, 255.f);
                    if (fb >= (float)bcur[rt][u] && 32 * kh <= lim) (void)__hip_atomic_fetch_add(hist + qq * 256 + (int)fb, 1u, __ATOMIC_RELAXED, __HIP_MEMORY_SCOPE_WORKGROUP); } }
    }
    asm volatile("s_waitcnt vmcnt(0) lgkmcnt(0)" ::: "memory"); __syncthreads();
    SEL_BOUNDARY(true);
    if (tid < 64) { st[320 + tid] = 0u; st[384 + tid] = 0u; }
    asm volatile("s_waitcnt lgkmcnt(0)" ::: "memory"); __syncthreads();
}
__device__ __forceinline__ void sel_pass2(unsigned char* ws_, LAS unsigned char* lds_, int wave_, int b_, int ub_) {
    SEL_DECLS
    if (st[512] != 0u) return;
    if (tid < 64) { st[320 + tid] = 0u; st[384 + tid] = 0u; }
    SEL_LOAD_A
    float sc[2][4][2];
    float scl[2][2]; int bcur[2][2];
#pragma unroll
    for (int rt = 0; rt < 2; ++rt)
#pragma unroll
        for (int u = 0; u < 2; ++u) { const int qq = 8 * wave + 4 * rt + 2 * c5 + u; scl[rt][u] = stf[qq]; bcur[rt][u] = (int)st[128 + qq]; }
    SEL_STAGE(0);
#pragma unroll 1
    for (int kt = 0; kt < ntile; ++kt) {
        asm volatile("s_waitcnt vmcnt(0) lgkmcnt(0)" ::: "memory"); __syncthreads();
        if (kt + 1 < ntile) SEL_STAGE(kt + 1);
        SEL_SCORES(kt);
        const bool masked = 128 * kt + 127 > t0;
        unsigned slot[2][2][4]; unsigned okm = 0u, abm = 0u;
#pragma unroll
        for (int rt = 0; rt < 2; ++rt)
#pragma unroll
            for (int u = 0; u < 2; ++u) { const int qq = 8 * wave + 4 * rt + 2 * c5 + u; const int lim = masked ? (t0 + qq - 128 * kt - kl) : 1000;
#pragma unroll
                for (int kh = 0; kh < 4; ++kh) { const float fb = __builtin_amdgcn_fmed3f(fmaf(sc[rt][kh][u], scl[rt][u], 128.0f), 0.f, 255.f);
                    const bool ok = fb >= (float)bcur[rt][u] && 32 * kh <= lim; const bool ab = fb >= (float)(bcur[rt][u] + 1);
                    slot[rt][u][kh] = 0u;
                    if (ok) { slot[rt][u][kh] = __hip_atomic_fetch_add(st + (ab ? 320 : 384) + qq, 1u, __ATOMIC_RELAXED, __HIP_MEMORY_SCOPE_WORKGROUP); okm |= 1u << (rt * 8 + u * 4 + kh); if (ab) abm |= 1u << (rt * 8 + u * 4 + kh); } } }
        if (okm != 0u) {
#pragma unroll
            for (int rt = 0; rt < 2; ++rt)
#pragma unroll
                for (int u = 0; u < 2; ++u) { const int qq = 8 * wave + 4 * rt + 2 * c5 + u;
#pragma unroll
                    for (int kh = 0; kh < 4; ++kh) { const int bit = rt * 8 + u * 4 + kh; const unsigned sl = slot[rt][u][kh]; const int kpos = 128 * kt + 32 * kh + kl;
                        if ((okm >> bit) & 1u) {
                            if ((abm >> bit) & 1u) { if (sl < (unsigned)TOPK) lsel[qq * 256 + sl] = (unsigned short)kpos; }
                            else if (sl < (unsigned)SEL_CAP) { lcs[qq * SEL_CAP + sl] = sc[rt][kh][u]; lci[qq * SEL_CAP + sl] = (unsigned short)kpos; } } } }
        }
    }
    asm volatile("s_waitcnt vmcnt(0) lgkmcnt(0)" ::: "memory"); __syncthreads();
}
__device__ __forceinline__ void sel_resolve(unsigned char* ws_, LAS unsigned char* lds_, int wave_, int b_, int ub_, int wg_, int first_) {
    SEL_DECLS
    const int wg = uni_i(wg_), first = uni_i(first_);
    unsigned short* sel = (unsigned short*)(ws + WS_SEL);
    gu32* slowl = (gu32*)(ws + WS_CTL + 65536) + (size_t)wg * 132;
    if (first && tid == 0) __hip_atomic_store(slowl, 0u, RLX_AGENT);
    if (st[512] != 0u) return;
#pragma unroll 1
    for (int qi = 0; qi < 8; ++qi) { const int qq = 8 * wave + qi; const int q = q0 + qq;
        const int na = (int)st[192 + qq], need = TOPK - na; int C = (int)st[384 + qq]; C = C < SEL_CAP ? C : SEL_CAP;
        const bool slow = st[448 + qq] != 0u;
        if (!slow) {
#pragma unroll
            for (int e = 0; e < SEL_CAP / 64; ++e) { const int i = lane + 64 * e;
                if (i < C) { const float si = lcs[qq * SEL_CAP + i]; const int ii = lci[qq * SEL_CAP + i]; int rank = 0;
                    for (int jx = 0; jx < C; ++jx) { const float sj = lcs[qq * SEL_CAP + jx]; const int ij = lci[qq * SEL_CAP + jx]; rank += (sj > si || (sj == si && ij < ii)) ? 1 : 0; }
                    if (rank < need) lsel[qq * 256 + na + rank] = (unsigned short)ii; } }
            LDS_WAIT();
            *(v2u*)(sel + (size_t)q * TOPK + 4 * lane) = *(const LAS v2u*)(lsel + qq * 256 + 4 * lane);
        }
    }
    __syncthreads();
    if (tid == 0) { unsigned n = first ? 0u : __hip_atomic_load(slowl, RLX_AGENT);
        for (int qq = 0; qq < 64; ++qq) if (st[448 + qq] != 0u) { if (n < 128u) { __hip_atomic_store(slowl + 1 + n, (unsigned)(q0 + qq), RLX_AGENT); ++n; } }
        __hip_atomic_store(slowl, n, RLX_AGENT); }
    asm volatile("s_waitcnt vmcnt(0)" ::: "memory");
    __syncthreads();
}
#undef SEL_DECLS
#undef SEL_LOAD_A
#undef SEL_STAGE
#undef SEL_SCORES
#undef SEL_BOUNDARY
__device__ __noinline__ void dsa_select_slow(unsigned char* ws_, LAS unsigned char* lds_, int wave_, int wg_) {
    LAS unsigned char* const lds = uni_l(lds_); const int wave = uni_i(wave_), wg = uni_i(wg_);
    unsigned char* ws = uni(ws_);
    const bf16* iqf = (const bf16*)(ws + WS_IQF); const unsigned* sgn = (const unsigned*)(ws + WS_SGN); const bf16* ik = (const bf16*)(ws + WS_IK);
    unsigned short* sel = (unsigned short*)(ws + WS_SEL);
    gu32* slowl = (gu32*)(ws + WS_CTL + 65536) + (size_t)wg * 132;
    const int lane = lane_id_v();
    const int n = (int)__builtin_amdgcn_readfirstlane(__hip_atomic_load(slowl, RLX_AGENT));
    if (wave < 4) for (int k = wave; k < n; k += 4) { const int q = (int)__builtin_amdgcn_readfirstlane(__hip_atomic_load(slowl + 1 + k, RLX_AGENT)); select_query_slow(q, lds + wave * 36864, iqf, sgn, ik, sel, lane); }
    asm volatile("s_waitcnt vmcnt(0)" ::: "memory");
    __syncthreads();
}

__device__ __forceinline__ unsigned offb(unsigned row, unsigned ch) { return 256u * row + 16u * (ch ^ (((row & 3u) << 2) | ((row >> 2) & 3u))); }
__device__ __forceinline__ s16x4_t vtr(const LAS unsigned char* p) { return __builtin_bit_cast(s16x4_t, __builtin_amdgcn_ds_read_tr16_b64_v4i16((LAS s16x4_t*)p)); }

__device__ __noinline__ void dsa_attend(unsigned char* ws_, LAS unsigned char* lds_, const float* relb_, int wave_, int vcu_, int G_, int dry_) {
    const int dry = uni_i(dry_);
    LAS unsigned char* const lds = uni_l(lds_); const int wave = uni_i(wave_), vcu = uni_i(vcu_), G = uni_i(G_);
    unsigned char* ws = uni(ws_); const float* relb = uni(relb_);
    const bf16* ckv = (const bf16*)(ws + WS_CKV); bf16* ql = (bf16*)(ws + WS_QL); const unsigned short* sel = (const unsigned short*)(ws + WS_SEL);
    const int lane = lane_id_v(), tid = wave * 64 + lane;
    LAS unsigned char* cb = lds + wave * 16384;
    LAS unsigned short* sidx = (LAS unsigned short*)(lds + 131072 + wave * 512);
    LAS float* biasd = (LAS float*)(lds + 135168);
    for (int i = tid; i < 129 * 8; i += NWAVES * 64) { const int d = i >> 3, h = i & 7; const int bk = d < 128 ? (int)T5_BUCKET[d] : 31; biasd[i] = relb[bk * 8 + h]; }
    __syncthreads();
    const int hl = lane & 15, g = lane >> 4, hq = hl & 7;
    for (int p = vcu; p < BATCH * 64; p += G) {
        const int b = p >> 6, j = p & 63;
#pragma unroll 1
        for (int half = 0; half < 2; ++half) {
            const int ub = half == 0 ? j : 127 - j;
#pragma unroll 1
            for (int qi = 0; qi < 8; ++qi) {
                const int t = ub * 64 + wave * 8 + qi; const int q = b * SEQ + t; const int nsel = (t + 1) < TOPK ? (t + 1) : TOPK;
                const bf16* ckvb = ckv + (size_t)b * SEQ * KVR; bf16* qlrow = ql + (size_t)q * 1024;
                { const v2u w = *(const v2u*)(sel + (size_t)q * TOPK + 4 * lane); *(LAS v2u*)(sidx + 4 * lane) = w; }
                bf16x8_t qf[4];
#pragma unroll
                for (int s = 0; s < 4; ++s) qf[s] = *(const bf16x8_t*)(qlrow + hq * 128 + 32 * s + 8 * g);
                LDS_WAIT();
                float mrun = -1e30f, lsum = 0.f;
                f32x4 O[8];
#pragma unroll
                for (int c = 0; c < 8; ++c) O[c] = (f32x4){0.f, 0.f, 0.f, 0.f};
#define DSA_GATHER(c_) do { LAS unsigned char* dst_ = cb + ((c_) & 1) * 8192; \
                    _Pragma("unroll") for (int k_ = 0; k_ < 8; ++k_) { const int row_ = 4 * k_ + g; const int kidx_ = sidx[32 * (c_) + row_]; \
                        const int ch_ = hl ^ ((g << 2) | (k_ & 3)); \
                        glds16(ckvb + (size_t)kidx_ * KVR + ch_ * 8, (unsigned)__builtin_amdgcn_readfirstlane((int)(unsigned)(size_t)(dst_ + k_ * 1024))); } } while (0)
                DSA_GATHER(0);
#pragma unroll 1
                for (int c = 0; c < 8; ++c) {
                    if (c < 7) { DSA_GATHER(c + 1); asm volatile("s_waitcnt vmcnt(8)" ::: "memory"); }
                    else asm volatile("s_waitcnt vmcnt(0)" ::: "memory");
                    const LAS unsigned char* img = cb + (c & 1) * 8192;
                    f32x4 S[2];
#pragma unroll
                    for (int rb = 0; rb < 2; ++rb) { S[rb] = (f32x4){0.f, 0.f, 0.f, 0.f}; const unsigned row = 8u * (hl >> 2) + 4u * rb + (hl & 3);
#pragma unroll
                        for (int s = 0; s < 4; ++s) { const bf16x8_t af = *(const LAS bf16x8_t*)(img + offb(row, 4 * s + g)); S[rb] = __builtin_amdgcn_mfma_f32_16x16x32_bf16(af, qf[s], S[rb], 0, 0, 0); } }
                    float pv[2][4]; float mx = -1e30f;
#pragma unroll
                    for (int rb = 0; rb < 2; ++rb) { const v2u iw2 = *(const LAS v2u*)(sidx + 32 * c + 8 * g + 4 * rb);
                        const int ki[4] = {(int)(iw2.x & 0xffffu), (int)(iw2.x >> 16), (int)(iw2.y & 0xffffu), (int)(iw2.y >> 16)};
#pragma unroll
                        for (int r = 0; r < 4; ++r) { int dist = t - ki[r]; dist = dist < 0 ? 0 : (dist > 128 ? 128 : dist);
                            float lg = S[rb][r] * 0.125f + biasd[dist * 8 + hq];
                            if (32 * c + 8 * g + 4 * rb + r >= nsel) lg = -1e30f;
                            pv[rb][r] = lg; mx = fmaxf(mx, lg); } }
                    mx = fmaxf(mx, __shfl_xor(mx, 16)); mx = fmaxf(mx, __shfl_xor(mx, 32));
                    const float mnew = fmaxf(mrun, mx); const float alpha = __expf(mrun - mnew); mrun = mnew;
                    float rs = 0.f;
#pragma unroll
                    for (int rb = 0; rb < 2; ++rb)
#pragma unroll
                        for (int r = 0; r < 4; ++r) { pv[rb][r] = __expf(pv[rb][r] - mnew); rs += pv[rb][r]; }
                    rs += __shfl_xor(rs, 16); rs += __shfl_xor(rs, 32);
                    lsum = lsum * alpha + rs;
                    v4u pw; pw.x = pg8::cvt_pk_bf16(pv[0][0], pv[0][1]); pw.y = pg8::cvt_pk_bf16(pv[0][2], pv[0][3]); pw.z = pg8::cvt_pk_bf16(pv[1][0], pv[1][1]); pw.w = pg8::cvt_pk_bf16(pv[1][2], pv[1][3]);
                    const bf16x8_t pf = __builtin_bit_cast(bf16x8_t, pw);
                    float al[4];
#pragma unroll
                    for (int r = 0; r < 4; ++r) al[r] = __shfl(alpha, 4 * g + r);
#pragma unroll
                    for (int cd = 0; cd < 8; ++cd) {
                        f32x4 o = O[cd]; o[0] *= al[0]; o[1] *= al[1]; o[2] *= al[2]; o[3] *= al[3];
                        const unsigned q4 = hl >> 2, p4 = hl & 3;
                        const s16x4_t b0 = vtr(img + offb(8u * g + q4, 2 * cd + (p4 >> 1)) + 8u * (p4 & 1));
                        const s16x4_t b1 = vtr(img + offb(8u * g + 4u + q4, 2 * cd + (p4 >> 1)) + 8u * (p4 & 1));
                        bf16x8_t bf; bf[0] = b0[0]; bf[1] = b0[1]; bf[2] = b0[2]; bf[3] = b0[3]; bf[4] = b1[0]; bf[5] = b1[1]; bf[6] = b1[2]; bf[7] = b1[3];
                        O[cd] = __builtin_amdgcn_mfma_f32_16x16x32_bf16(pf, bf, o, 0, 0, 0);
                    }
                }
#undef DSA_GATHER
                const float linv = 1.0f / lsum; float li[4];
#pragma unroll
                for (int r = 0; r < 4; ++r) li[r] = __shfl(linv, 4 * g + r);
                LAS unsigned short* ost = (LAS unsigned short*)cb;
                if (g < 2) {
#pragma unroll
                    for (int cd = 0; cd < 8; ++cd)
#pragma unroll
                        for (int r = 0; r < 4; ++r) ost[(4 * g + r) * 128 + 16 * cd + hl] = (unsigned short)f2bf(O[cd][r] * li[r]);
                }
                LDS_WAIT();
                { const v4u w0 = *(const LAS v4u*)(cb + 32 * lane), w1 = *(const LAS v4u*)(cb + 32 * lane + 16);
                  if (!dry) { *(v4u*)(qlrow + 16 * lane) = w0; *(v4u*)(qlrow + 16 * lane + 8) = w1; } else asm volatile("" :: "v"(w0), "v"(w1)); }
                LDS_WAIT();
            }
        }
    }
    __syncthreads();
}

__device__ __noinline__ void final_norm(const float* const* in_, float* out_, unsigned char* ws_, LAS unsigned char* lds_, int wave_, int vcu_, int G_) {
    const PC F{uni(in_), uni(out_), uni(ws_), uni_l(lds_), uni_i(wave_), uni_i(vcu_), uni_i(G_)}; struct { const float* const* in; float* out; } a{F.in, F.out};
    const int lane_ = lane_id_v(); const int gw = F.vcu * NWAVES + F.wave, NGW = F.G * NWAVES; const float* g = a.in[22];
    f32x4 gv[4];
#pragma unroll
    for (int j = 0; j < 4; ++j) gv[j] = ((const f32x4*)g)[lane_ + 64 * j];
    for (int m = gw; m < M; m += NGW) {
        GAS f32x4* xr = (GAS f32x4*)(a.out + (size_t)m * D) + lane_;
        f32x4 v[4]; float s = 0.f;
#pragma unroll
        for (int j = 0; j < 4; ++j) { v[j] = xr[64 * j]; s += (v[j].x * v[j].x + v[j].y * v[j].y) + (v[j].z * v[j].z + v[j].w * v[j].w); }
        const float rs = 1.0f / sqrtf(wave_sum(s) * (1.0f / D) + EPS);
#pragma unroll
        for (int j = 0; j < 4; ++j) xr[64 * j] = v[j] * rs * gv[j];
    }
}

#define KIN ((const float* const*)__builtin_amdgcn_kernarg_segment_ptr())
constexpr int PH_PER_LAYER = 10, PH_LAYER0 = 2, N_PHASES = PH_LAYER0 + PH_PER_LAYER * DEPTH + 1;

__global__ void __launch_bounds__(NWAVES * 64, 2) mk_fwd(Args args) {
    extern __shared__ __attribute__((aligned(16))) unsigned char lds[];
    Frame F;
    F.lds = (LAS unsigned char*)lds;
    F.MISC = (volatile LAS unsigned*)(F.lds + MISC_OFF);
    F.wave = __builtin_amdgcn_readfirstlane((int)threadIdx.x >> 6);
    F.G = gridDim.x; { const int bx = blockIdx.x; F.vcu = (F.G % 8 == 0) ? (bx % 8) * (F.G / 8) + bx / 8 : bx; }
    F.ws = args.ws; F.ctl = (gu32*)(args.ws + WS_CTL);
    if (threadIdx.x < 64) ((LAS unsigned*)(F.lds + MISC_OFF))[threadIdx.x] = 0u;
    __syncthreads();
    const int lo = args.ph_lo, hi = args.ph_hi;
    const bool multi = (hi - lo) > 1;
    XcdBarrier bar; bar.bar = (unsigned*)(F.ctl + CW_BAR); bar.x = 0; bar.st = nullptr; bar.wave = F.wave;
    if (multi) bar = xcd_barrier_post((unsigned*)(F.ctl + CW_BAR), F.MISC + 8, F.wave);
#define IN(k) (lo <= (k) && (k) < hi)
#define SEAM(k) do { if (IN(k) && IN((k) + 1)) xcd_barrier(bar); } while (0)

    if (IN(0)) {
#if EN_P0
 for (int rep = (PROBE_PHASE == 1 ? 0 : 1); rep < 2; ++rep) p0_prologue(KIN, args.out, args.ws, F.lds, F.wave, F.vcu, F.G);
#endif
 } SEAM(0);
    if (IN(1)) {
#if !((DIS_MASK >> 7) & 1)
 unsigned char* ws = launder_p(args.ws); bf16* hb = (bf16*)(ws + WS_HB); float* ss = (float*)(ws + WS_SS); (void)hb; (void)ss;
        pg8::Gemm g{(const bf16_t*)(ws + WS_MEMN), (const bf16_t*)(ws + WS_WMEM), MROWS, DEPTH * 2 * CW, D}; pg8::StaticOrder S; S.init(MROWS, DEPTH * 2 * CW, F.G, launder_s((int)blockIdx.x));
        EpiPlainBf16 E{(bf16_t*)(ws + WS_MEMKV), DEPTH * 2 * CW};
        pg8::gemm_phase<EpiPlainBf16, pg8::StaticOrder, true, true>(F.lds + RING_OFF, g, S, E, F.wave);
        { pg8::Gemm g2{(const bf16_t*)(ws + WS_WMEM), (const bf16_t*)(ws + WS_MEMN), DEPTH * 2 * CW, MROWS, D}; pg8::StaticOrder S2; S2.init(DEPTH * 2 * CW, MROWS, F.G, launder_s((int)blockIdx.x));
          EpiPlainBf16 E2{(bf16_t*)(ws + WS_VT), MROWS};
          pg8::gemm_phase<EpiPlainBf16, pg8::StaticOrder, true, true>(F.lds + RING_OFF, g2, S2, E2, F.wave); }
#endif
    } SEAM(1);

    for (int l = 0; l < DEPTH; ++l) {
        const int pb = PH_LAYER0 + PH_PER_LAYER * l;
        const float* hbase = (l == 0) ? args.in[0] : args.out;
        if (IN(pb + 0)) {
#if EN_P0
 if (l > 0) for (int rep = (PROBE_PHASE == 1 ? 0 : 1); rep < 2; ++rep) prep_layer_weights(KIN, args.out, args.ws, F.lds, l, F.wave, F.vcu, F.G);
#endif
 } SEAM(pb + 0);
        if (IN(pb + 1)) {
#if !((DIS_MASK >> 0) & 1)
 unsigned char* ws = launder_p(args.ws); bf16* hb = (bf16*)(ws + WS_HB); float* ss = (float*)(ws + WS_SS); (void)hb; (void)ss;
            pg8::Gemm g{hb, (const bf16_t*)(ws + WS_W1IN), M, 2 * DFF, D}; pg8::StaticOrder S; S.init(M, 2 * DFF, F.G, launder_s((int)blockIdx.x));
            EpiSwiglu E{(bf16_t*)(ws + WS_ACT), ss};
            for (int rep = (PROBE_PHASE == 2 ? 0 : 1); rep < 2; ++rep) pg8::gemm_phase<EpiSwiglu, pg8::StaticOrder, true, true>(F.lds + RING_OFF, g, S, E, F.wave);
#endif
        } SEAM(pb + 1);
        if (IN(pb + 2)) {
#if !((DIS_MASK >> 1) & 1)
 unsigned char* ws = launder_p(args.ws); bf16* hb = (bf16*)(ws + WS_HB); float* ss = (float*)(ws + WS_SS); (void)hb; (void)ss;
            pg8::Gemm g{(const bf16_t*)(ws + WS_ACT), (const bf16_t*)(ws + WS_W1OUT), M, D, DFF}; pg8::StaticOrder S; S.init(M, D, F.G, launder_s((int)blockIdx.x));
            EpiResid E{hbase, args.out, hb, ss, 0.5f, (LAS float*)(F.lds + RING_BYTES)};
            pg8::gemm_phase<EpiResid, pg8::StaticOrder, true, true>(F.lds + RING_OFF, g, S, E, F.wave);
#endif
        } SEAM(pb + 2);
        if (IN(pb + 3)) {
#if !((DIS_MASK >> 2) & 1)
 unsigned char* ws = launder_p(args.ws); bf16* hb = (bf16*)(ws + WS_HB); float* ss = (float*)(ws + WS_SS); (void)hb; (void)ss;
            pg8::Gemm g{hb, (const bf16_t*)(ws + WS_WIN), M, INP, D}; pg8::StaticOrder S; S.init(M, INP, F.G, launder_s((int)blockIdx.x));
            EpiInProj E{ss, (bf16_t*)(ws + WS_QL), (float*)(ws + WS_CKVRAW), (bf16_t*)(ws + WS_IK), (float*)(ws + WS_IW), (bf16_t*)(ws + WS_IQRAW), (bf16_t*)(ws + WS_Z), (bf16_t*)(ws + WS_QC), (bf16_t*)(ws + WS_G)};
            for (int rep = (PROBE_PHASE == 4 ? 0 : 1); rep < 2; ++rep) pg8::gemm_phase<EpiInProj, pg8::StaticOrder, true, true>(F.lds + RING_OFF, g, S, E, F.wave);
#endif
        } SEAM(pb + 3);
        if (IN(pb + 4)) {
#if EN_PREP
 for (int rep = (PROBE_PHASE == 5 ? 0 : 1); rep < 2; ++rep) prep_tokens(KIN, args.out, args.ws, F.lds, l, F.wave, F.vcu, F.G, rep == 0 ? 1 : 0);
#endif
 } SEAM(pb + 4);
        if (IN(pb + 5)) {
#if EN_DSA
 for (int rep = (PROBE_PHASE == 6 ? 0 : 1); rep < 2; ++rep) for (int p = F.vcu; p < BATCH * 64; p += F.G) { for (int half = 0; half < 2; ++half) { const int b_ = p >> 6, ub_ = half == 0 ? (p & 63) : 127 - (p & 63);
   sel_pass1(args.ws, F.lds, F.wave, b_, ub_); if (PROBE_PHASE == 61) sel_pass1(args.ws, F.lds, F.wave, b_, ub_); sel_pass2(args.ws, F.lds, F.wave, b_, ub_); if (PROBE_PHASE == 62) sel_pass2(args.ws, F.lds, F.wave, b_, ub_); sel_resolve(args.ws, F.lds, F.wave, b_, ub_, (int)blockIdx.x, (p == F.vcu && half == 0) ? 1 : 0); if (PROBE_PHASE == 63) sel_resolve(args.ws, F.lds, F.wave, b_, ub_, (int)blockIdx.x, 0); } }
 if (PROBE_PHASE != 64) dsa_select_slow(args.ws, F.lds, F.wave, (int)blockIdx.x); for (int rep = (PROBE_PHASE == 7 ? 0 : 1); rep < 2; ++rep) dsa_attend(args.ws, F.lds, args.in[2], F.wave, F.vcu, F.G, rep == 0 ? 1 : 0);
#endif
 } SEAM(pb + 5);
        if (IN(pb + 6)) {
#if !((DIS_MASK >> 3) & 1)
 unsigned char* ws = launder_p(args.ws); bf16* hb = (bf16*)(ws + WS_HB); float* ss = (float*)(ws + WS_SS); (void)hb; (void)ss;
            { pg8::Gemm g{(const bf16_t*)(ws + WS_QL), (const bf16_t*)(ws + WS_WA), M, D, 1024}; pg8::StaticOrder S; S.init(M, D, F.G, launder_s((int)blockIdx.x));
              EpiMerge<0> E{(bf16_t*)(ws + WS_MERGED), (const bf16_t*)(ws + WS_G)};
              pg8::gemm_phase<EpiMerge<0>, pg8::StaticOrder, true, true>(F.lds + RING_OFF, g, S, E, F.wave); }
            { pg8::Gemm g{(const bf16_t*)(ws + WS_YB), (const bf16_t*)(ws + WS_WB), M, D, PW_}; pg8::StaticOrder S; S.init(M, D, F.G, launder_s((int)blockIdx.x));
              EpiMerge<1> E{(bf16_t*)(ws + WS_MERGED), (const bf16_t*)(ws + WS_G)};
              pg8::gemm_phase<EpiMerge<1>, pg8::StaticOrder, true, true>(F.lds + RING_OFF, g, S, E, F.wave); }
            { pg8::Gemm g{(const bf16_t*)(ws + WS_QC), (const bf16_t*)(ws + WS_WC), M, D, CW}; pg8::StaticOrder S; S.init(M, D, F.G, launder_s((int)blockIdx.x));
              EpiMerge<2> E{(bf16_t*)(ws + WS_MERGED), (const bf16_t*)(ws + WS_G)};
              pg8::gemm_phase<EpiMerge<2>, pg8::StaticOrder, true, true>(F.lds + RING_OFF, g, S, E, F.wave); }
#endif
        } SEAM(pb + 6);
        if (IN(pb + 7)) {
#if !((DIS_MASK >> 4) & 1)
 unsigned char* ws = launder_p(args.ws); bf16* hb = (bf16*)(ws + WS_HB); float* ss = (float*)(ws + WS_SS); (void)hb; (void)ss;
            pg8::Gemm g{(const bf16_t*)(ws + WS_MERGED), (const bf16_t*)(ws + WS_WOUT), M, D, D}; pg8::StaticOrder S; S.init(M, D, F.G, launder_s((int)blockIdx.x));
            EpiResid E{args.out, args.out, hb, ss, 1.0f, (LAS float*)(F.lds + RING_BYTES)};
            pg8::gemm_phase<EpiResid, pg8::StaticOrder, true, true>(F.lds + RING_OFF, g, S, E, F.wave);
#endif
        } SEAM(pb + 7);
        if (IN(pb + 8)) {
#if !((DIS_MASK >> 5) & 1)
 unsigned char* ws = launder_p(args.ws); bf16* hb = (bf16*)(ws + WS_HB); float* ss = (float*)(ws + WS_SS); (void)hb; (void)ss;
            pg8::Gemm g{hb, (const bf16_t*)(ws + WS_W2IN), M, 2 * DFF, D}; pg8::StaticOrder S; S.init(M, 2 * DFF, F.G, launder_s((int)blockIdx.x));
            EpiSwiglu E{(bf16_t*)(ws + WS_ACT), ss};
            for (int rep = (PROBE_PHASE == 2 ? 0 : 1); rep < 2; ++rep) pg8::gemm_phase<EpiSwiglu, pg8::StaticOrder, true, true>(F.lds + RING_OFF, g, S, E, F.wave);
#endif
        } SEAM(pb + 8);
        if (IN(pb + 9)) {
#if !((DIS_MASK >> 6) & 1)
 unsigned char* ws = launder_p(args.ws); bf16* hb = (bf16*)(ws + WS_HB); float* ss = (float*)(ws + WS_SS); (void)hb; (void)ss;
            pg8::Gemm g{(const bf16_t*)(ws + WS_ACT), (const bf16_t*)(ws + WS_W2OUT), M, D, DFF}; pg8::StaticOrder S; S.init(M, D, F.G, launder_s((int)blockIdx.x));
            EpiResid E{args.out, args.out, hb, ss, 0.5f, (LAS float*)(F.lds + RING_BYTES)};
            pg8::gemm_phase<EpiResid, pg8::StaticOrder, true, true>(F.lds + RING_OFF, g, S, E, F.wave);
#endif
        } SEAM(pb + 9);
    }
#if EN_P0
    if (IN(N_PHASES - 1)) { final_norm(KIN, args.out, args.ws, F.lds, F.wave, F.vcu, F.G); }
#endif
#undef IN
#undef SEAM
}

extern "C" void kernel_launch(void* const* d_in, const int* in_sizes, int n_in, void* d_out, int out_size, void* d_ws, size_t ws_size, hipStream_t stream) {
    static int grid = 0;
    if (grid == 0) {
        if (n_in != 23 || in_sizes[0] != M * D || out_size != M * D || ws_size < WS_END) { fprintf(stderr, "kernel_launch: unexpected shapes (n_in %d, ws %zu)\n", n_in, ws_size); grid = -1; return; }
        int dev = 0, cus = 0, per_cu = 0;
        if (hipGetDevice(&dev) != hipSuccess || hipDeviceGetAttribute(&cus, hipDeviceAttributeMultiprocessorCount, dev) != hipSuccess) { grid = -1; return; }
        if (hipFuncSetAttribute((const void*)mk_fwd, hipFuncAttributeMaxDynamicSharedMemorySize, LDS_BYTES) != hipSuccess) { fprintf(stderr, "kernel_launch: hipFuncSetAttribute failed\n"); grid = -1; return; }
        if (hipOccupancyMaxActiveBlocksPerMultiprocessor(&per_cu, (const void*)mk_fwd, NWAVES * 64, LDS_BYTES) != hipSuccess || per_cu < 1) { fprintf(stderr, "kernel_launch: occupancy query says %d\n", per_cu); }
        (void)hipGetLastError();
        grid = cus;
    }
    if (grid < 0) return;
    if (hipMemsetAsync((char*)d_ws + WS_CTL, 0, CTL_ZERO_BYTES, stream) != hipSuccess) return;
    Args a{};
    for (int i = 0; i < 23; ++i) a.in[i] = (const float*)d_in[i];
    a.out = (float*)d_out; a.ws = (unsigned char*)d_ws;
#if MK_ONE_LAUNCH
    a.ph_lo = 0; a.ph_hi = N_PHASES;
    hipLaunchKernelGGL(mk_fwd, dim3(grid), dim3(NWAVES * 64), LDS_BYTES, stream, a);
#endif
}
```

```cpp
#include <hip/hip_runtime.h>
#include <cstdio>
#include <cstdint>

#ifndef MK_ONE_LAUNCH
#define MK_ONE_LAUNCH 1
#endif
#ifndef PROBE_PHASE
#define PROBE_PHASE 0
#endif
#ifndef EN_P0
#define EN_P0 MK_ONE_LAUNCH
#endif
#ifndef EN_PREP
#define EN_PREP MK_ONE_LAUNCH
#endif
#ifndef EN_DSA
#define EN_DSA MK_ONE_LAUNCH
#endif
#ifndef DIS_MASK
#define DIS_MASK 0
#endif
#ifndef MK_ONE_LAUNCH
#define MK_ONE_LAUNCH 1
#endif

__device__ __forceinline__ int lane_id_v() { int l; asm volatile("v_mbcnt_lo_u32_b32 %0, -1, 0\n\tv_mbcnt_hi_u32_b32 %0, -1, %0" : "=v"(l)); return l; }
namespace pg8 {
#define PG8_LAS __attribute__((address_space(3)))
typedef unsigned short bf16_t;
typedef short bf16x8 __attribute__((ext_vector_type(8)));
typedef float f32x4 __attribute__((ext_vector_type(4)));
typedef unsigned u32x4 __attribute__((ext_vector_type(4)));
typedef unsigned u32x2 __attribute__((ext_vector_type(2)));
constexpr int BM = 256, BK = 64, HALF = 128, HTB = HALF * BK * 2, STAGE_BYTES = 8 * HTB, NXCD = 8, WGM = 8;

__host__ __device__ __forceinline__ int lds_byte(int r, int c) { const int st = (r >> 4) * 2 + (c >> 5), rr = r & 15, cc = c & 31, ob = rr * 64 + cc * 2; return st * 1024 + (ob ^ (((ob >> 9) & 1) << 5)); }
__host__ __device__ __forceinline__ void stage_rc(int b, int& R, int& C) { const int st = b / 1024, sb = b % 1024, swz = sb ^ (((sb >> 9) & 1) << 5); R = (st >> 1) * 16 + swz / 64; C = (st & 1) * 32 + (swz % 64) / 2; }
__host__ __device__ __forceinline__ int perm32(int rho) { const int n = rho >> 4, i = rho & 15; return 8 * (i >> 2) + 4 * n + (i & 3); }

struct Unit { int pm, pn; };
struct Gemm { const bf16_t* A; const bf16_t* Bt; int M, N, K; };

struct StaticOrder {
    int nM, nN, nwg, G, c;
    __host__ __device__ void init(int M, int N, int G_, int c_) { nM = M / BM; nN = N / BM; nwg = nM * nN; G = G_; c = c_; }
    __host__ __device__ bool next(int i, Unit& u) const {
        const long L = (long)i * G + c; if (L >= nwg) return false;
        int wgid = (int)L; { const int q = nwg / NXCD, r = nwg % NXCD, xcd = wgid % NXCD, off = wgid / NXCD; wgid = (xcd < r ? xcd * (q + 1) : r * (q + 1) + (xcd - r) * q) + off; }
        const int nig = WGM * nN, gid = wgid / nig, fm = gid * WGM, gsz = (nM - fm) < WGM ? (nM - fm) : WGM;
        u.pm = fm + ((wgid % nig) % gsz); u.pn = (wgid % nig) / gsz; return true;
    }
    __device__ __forceinline__ void a_ready(const Unit&) const {}
    __device__ __forceinline__ void done(const Unit&) const {}
};

__device__ __forceinline__ unsigned cvt_pk_bf16(float lo, float hi) { unsigned r; asm volatile("v_cvt_pk_bf16_f32 %0, %1, %2" : "=v"(r) : "v"(lo), "v"(hi)); return r; }

template <class Epi, class Sched, bool ALIGN_EPI = false, bool SP2 = false>
__device__ __forceinline__ void gemm_phase(PG8_LAS unsigned char* lds, const Gemm g, const Sched& S, const Epi& E, const int wid_) {
    int wid = wid_; asm volatile("" : "+s"(wid));
    const int lane = lane_id_v(), tid = wid * 64 + lane,
              wr = wid >> 2, wc = wid & 3, fr = lane & 15, fq = lane >> 4;
    const int K = g.K, nt = K / BK;
    unsigned voffA[2], voffB[2];
#pragma unroll
    for (int i = 0; i < 2; ++i) { int R, C; stage_rc(tid * 16 + i * 8192, R, C); const int Rb = Epi::PERM ? ((R & ~31) + perm32(R & 31)) : R;
        voffA[i] = (unsigned)(R * K + C) * 2u; voffB[i] = (unsigned)(Rb * K + C) * 2u; }
    const size_t kstep = (size_t)(BK * 2);
    const size_t hstep = (size_t)HALF * K * 2;
    const size_t tstep = 2 * hstep;
    const unsigned ldsw = (unsigned)wid * 1024u;
    const int aoff = lds_byte(wr * 64 + fr, fq * 8), boff = lds_byte(wc * 32 + fr, fq * 8);
#define PG8_SA(b, h) (((b) * 2 + (h)) * HTB)
#define PG8_SB(b, h) ((4 + (b) * 2 + (h)) * HTB)
#define PG8_STAGE(bufoff, gbase, voff) do { _Pragma("unroll") for (int _i = 0; _i < 2; ++_i) \
        __builtin_amdgcn_global_load_lds((const unsigned*)((const char*)(gbase) + (voff)[_i]), (PG8_LAS unsigned*)(lds + (bufoff) + ldsw + _i * 8192), 16, 0, 0); } while (0)
#define PG8_LDA(dst, b, h) do { _Pragma("unroll") for (int m = 0; m < 4; ++m) _Pragma("unroll") for (int k = 0; k < 2; ++k) dst[m][k] = *(const PG8_LAS bf16x8*)(lds + PG8_SA(b, h) + aoff + m * 2048 + k * 1024); } while (0)
#define PG8_LDB(dst, b, h) do { _Pragma("unroll") for (int n = 0; n < 2; ++n) _Pragma("unroll") for (int k = 0; k < 2; ++k) dst[n][k] = *(const PG8_LAS bf16x8*)(lds + PG8_SB(b, h) + boff + n * 2048 + k * 1024); } while (0)
#define PG8_MMA(ai, bj, At, Bt) do { __builtin_amdgcn_s_setprio(1); _Pragma("unroll") for (int m = 0; m < 4; ++m) _Pragma("unroll") for (int n = 0; n < 2; ++n) _Pragma("unroll") for (int k = 0; k < 2; ++k) \
        acc[ai][bj][m][n] = __builtin_amdgcn_mfma_f32_16x16x32_bf16(Bt[n][k], At[m][k], acc[ai][bj][m][n], 0, 0, 0); __builtin_amdgcn_s_setprio(0); } while (0)
#define PG8_WAIT_V(n) asm volatile("s_waitcnt vmcnt(" #n ")" ::: "memory")
#define PG8_WAIT_L(n) asm volatile("s_waitcnt lgkmcnt(" #n ")" ::: "memory")
#define PG8_BAR __builtin_amdgcn_s_barrier()
#define PG8_SCHED __builtin_amdgcn_sched_barrier(0)
    Unit cur, nxt; int ui = 0;
    if (!S.next(0, cur)) return;
    f32x4 acc[2][2][4][2];
#pragma unroll
    for (int a = 0; a < 2; ++a)
#pragma unroll
        for (int b = 0; b < 2; ++b)
#pragma unroll
            for (int m = 0; m < 4; ++m)
#pragma unroll
                for (int n = 0; n < 2; ++n) acc[a][b][m][n] = (f32x4){0.f, 0.f, 0.f, 0.f};
    bf16x8 At[4][2], B0[2][2], B1[2][2];
    const char* cA = (const char*)g.A + (size_t)cur.pm * tstep; const char* cB = (const char*)g.Bt + (size_t)cur.pn * tstep;
    S.a_ready(cur);
    if constexpr (SP2) {
        PG8_STAGE(PG8_SB(0, 0), cB, voffB); PG8_STAGE(PG8_SB(0, 1), cB + hstep, voffB); PG8_STAGE(PG8_SA(0, 0), cA, voffA); PG8_STAGE(PG8_SA(0, 1), cA + hstep, voffA);
        if (wr == 1) PG8_BAR;
        PG8_WAIT_V(2); PG8_BAR;
        PG8_STAGE(PG8_SB(1, 0), cB + kstep, voffB); PG8_STAGE(PG8_SA(1, 0), cA + kstep, voffA); PG8_STAGE(PG8_SB(1, 1), cB + hstep + kstep, voffB);
        PG8_WAIT_V(6); PG8_BAR;
    } else {
        PG8_STAGE(PG8_SB(0, 0), cB, voffB); PG8_STAGE(PG8_SA(0, 0), cA, voffA); PG8_STAGE(PG8_SB(0, 1), cB + hstep, voffB); PG8_STAGE(PG8_SA(0, 1), cA + hstep, voffA);
        if (wr == 1) PG8_BAR;
        PG8_WAIT_V(4); PG8_BAR;
        PG8_STAGE(PG8_SB(1, 0), cB + kstep, voffB); PG8_STAGE(PG8_SA(1, 0), cA + kstep, voffA); PG8_STAGE(PG8_SB(1, 1), cB + hstep + kstep, voffB);
        PG8_WAIT_V(6); PG8_BAR;
    }
    for (;;) {
        const bool has_next = S.next(ui + 1, nxt);
        const char* nA = has_next ? (const char*)g.A + (size_t)nxt.pm * tstep : cA; const char* nB = has_next ? (const char*)g.Bt + (size_t)nxt.pn * tstep : cB;
        for (int t = 0; t < nt; t += 2) {
            const bool last = (t == nt - 2);
            const char* a1 = cA + (size_t)(t + 1) * kstep;
            const char* a2 = last ? nA : cA + (size_t)(t + 2) * kstep; const char* b2 = last ? nB : cB + (size_t)(t + 2) * kstep;
            const char* a3 = a2 + kstep; const char* b3 = b2 + kstep;
            if (last && has_next) S.a_ready(nxt);
            if constexpr (SP2) {
            PG8_LDB(B0, 0, 0); PG8_LDB(B1, 0, 1); PG8_SCHED; PG8_LDA(At, 0, 0); PG8_STAGE(PG8_SA(1, 1), a1 + hstep, voffA);
            PG8_WAIT_V(8); PG8_WAIT_L(0); PG8_BAR; PG8_MMA(0, 0, At, B0); PG8_MMA(0, 1, At, B1); PG8_BAR; PG8_SCHED;
            PG8_LDA(At, 0, 1); PG8_STAGE(PG8_SB(0, 0), b2, voffB); PG8_STAGE(PG8_SB(0, 1), b2 + hstep, voffB); PG8_STAGE(PG8_SA(0, 0), a2, voffA);
            PG8_WAIT_V(8); PG8_WAIT_L(0); PG8_BAR; PG8_MMA(1, 0, At, B0); PG8_MMA(1, 1, At, B1); PG8_BAR; PG8_SCHED;
            PG8_LDB(B0, 1, 0); PG8_LDB(B1, 1, 1); PG8_SCHED; PG8_LDA(At, 1, 0); PG8_STAGE(PG8_SA(0, 1), a2 + hstep, voffA);
            PG8_WAIT_V(8); PG8_WAIT_L(0); PG8_BAR; PG8_MMA(0, 0, At, B0); PG8_MMA(0, 1, At, B1); PG8_BAR; PG8_SCHED;
            PG8_LDA(At, 1, 1); PG8_STAGE(PG8_SB(1, 0), b3, voffB); PG8_STAGE(PG8_SB(1, 1), b3 + hstep, voffB); PG8_STAGE(PG8_SA(1, 0), a3, voffA);
            PG8_WAIT_V(8); PG8_WAIT_L(0); PG8_BAR; PG8_MMA(1, 0, At, B0); PG8_MMA(1, 1, At, B1); PG8_BAR; PG8_SCHED;
            } else {
            PG8_LDB(B0, 0, 0); PG8_SCHED; PG8_LDA(At, 0, 0); PG8_STAGE(PG8_SA(1, 1), a1 + hstep, voffA);
            PG8_WAIT_L(8); PG8_BAR; PG8_WAIT_L(0); PG8_MMA(0, 0, At, B0); PG8_BAR; PG8_SCHED;
            PG8_LDB(B1, 0, 1); PG8_STAGE(PG8_SB(0, 0), b2, voffB);
            PG8_BAR; PG8_WAIT_L(0); PG8_MMA(0, 1, At, B1); PG8_BAR;
            PG8_LDA(At, 0, 1); PG8_STAGE(PG8_SA(0, 0), a2, voffA);
            PG8_BAR; PG8_WAIT_L(0); PG8_MMA(1, 0, At, B0); PG8_BAR; PG8_SCHED;
            PG8_STAGE(PG8_SB(0, 1), b2 + hstep, voffB);
            PG8_WAIT_V(6); PG8_BAR; PG8_MMA(1, 1, At, B1); PG8_BAR;
            PG8_LDB(B0, 1, 0); PG8_SCHED; PG8_LDA(At, 1, 0); PG8_STAGE(PG8_SA(0, 1), a2 + hstep, voffA);
            PG8_WAIT_L(8); PG8_BAR; PG8_WAIT_L(0); PG8_MMA(0, 0, At, B0); PG8_BAR; PG8_SCHED;
            PG8_LDB(B1, 1, 1); PG8_STAGE(PG8_SB(1, 0), b3, voffB);
            PG8_BAR; PG8_WAIT_L(0); PG8_MMA(0, 1, At, B1); PG8_BAR;
            PG8_LDA(At, 1, 1); PG8_STAGE(PG8_SA(1, 0), a3, voffA);
            PG8_BAR; PG8_WAIT_L(0); PG8_MMA(1, 0, At, B0); PG8_BAR; PG8_SCHED;
            PG8_STAGE(PG8_SB(1, 1), b3 + hstep, voffB);
            PG8_WAIT_V(6); PG8_BAR; PG8_MMA(1, 1, At, B1); PG8_BAR;
            }
        }
        if constexpr (ALIGN_EPI) { if (wr == 0) PG8_BAR; }
        E(acc, cur, wr, wc, fr, fq); S.done(cur);
        if (!has_next) break;
#pragma unroll
        for (int a = 0; a < 2; ++a)
#pragma unroll
            for (int b = 0; b < 2; ++b)
#pragma unroll
                for (int m = 0; m < 4; ++m)
#pragma unroll
                    for (int n = 0; n < 2; ++n) acc[a][b][m][n] = (f32x4){0.f, 0.f, 0.f, 0.f};
        cur = nxt; cA = nA; cB = nB; ++ui;
        if constexpr (ALIGN_EPI) { if (wr == 1) PG8_BAR; }
    }
    PG8_WAIT_V(0);
    if constexpr (!ALIGN_EPI) { if (wr == 0) PG8_BAR; }
    PG8_BAR;
#undef PG8_SA
#undef PG8_SB
#undef PG8_STAGE
#undef PG8_LDA
#undef PG8_LDB
#undef PG8_MMA
#undef PG8_WAIT_V
#undef PG8_WAIT_L
#undef PG8_BAR
#undef PG8_SCHED
}
}

constexpr int NWAVES = 8;
constexpr int BATCH = 4, SEQ = 8192, D = 1024, DEPTH = 4, M = BATCH * SEQ;
constexpr int NMEM = 256, MROWS = BATCH * NMEM;
constexpr int AH = 8, AHD = 64, AW = 512, KVR = 128, IH = 8, IDIM = 32, TOPK = 256;
constexpr int PW_ = 256, CH = 4, CHD = 64, CW = 256;
constexpr int DFF = 2816, INW = 4520, INP = 5120;
constexpr float EPS = 1e-6f;
constexpr int C_QA = 0, C_CKV = 512, C_IQ = 640, C_IK = 896, C_IW = 928, C_Z = 936, C_QC = 1192, C_G = 1448;

constexpr size_t MiB = 1u << 20;
constexpr size_t WS_CTL = 0, CTL_ZERO_BYTES = 1 * MiB;
constexpr size_t WS_SS = 1 * MiB;
constexpr size_t WS_IW = 3 * MiB;
constexpr size_t WS_SGN = 4 * MiB;
constexpr size_t WS_MEMN = 5 * MiB;
constexpr size_t WS_WMEM = 7 * MiB;
constexpr size_t WS_MEMKV = 11 * MiB;
constexpr size_t WS_W1IN = 15 * MiB, WS_W1OUT = 26 * MiB, WS_WIN = 32 * MiB, WS_WA = 42 * MiB, WS_WB = 44 * MiB, WS_WC = 44 * MiB + 512 * 1024, WS_WOUT = 45 * MiB, WS_W2IN = 47 * MiB, WS_W2OUT = 58 * MiB;
constexpr size_t WS_HB = 64 * MiB;
constexpr size_t WS_ACT = 128 * MiB;
constexpr size_t WS_G = 128 * MiB;
constexpr size_t WS_QL = 320 * MiB;
constexpr size_t WS_CKV = 384 * MiB;
constexpr size_t WS_CKVRAW = 392 * MiB;
constexpr size_t WS_IQRAW = 408 * MiB;
constexpr size_t WS_IQF = 424 * MiB;
constexpr size_t WS_IK = 440 * MiB;
constexpr size_t WS_Z = 442 * MiB;
constexpr size_t WS_MERGED = 384 * MiB;
constexpr size_t WS_YB = 458 * MiB;
constexpr size_t WS_QC = 474 * MiB;
constexpr size_t WS_SEL = 490 * MiB;
constexpr size_t WS_VT = 506 * MiB;
constexpr size_t WS_WPT = 4 * MiB + 512 * 1024;
constexpr size_t WS_END = 510 * MiB;
constexpr int CW_BAR = 4096;

constexpr int RING_OFF = 0, RING_BYTES = 131072;
constexpr int LDS_BYTES = 155648;
constexpr int MISC_OFF = LDS_BYTES - 256;

#define GAS __attribute__((address_space(1)))
#define LAS __attribute__((address_space(3)))
typedef unsigned short bf16;
typedef unsigned v4u __attribute__((ext_vector_type(4)));
typedef unsigned v2u __attribute__((ext_vector_type(2)));
typedef float f32x4 __attribute__((ext_vector_type(4)));
typedef float f32x2 __attribute__((ext_vector_type(2)));
typedef GAS unsigned gu32;
#define RLX_AGENT __ATOMIC_RELAXED, __HIP_MEMORY_SCOPE_AGENT
#define LDS_WAIT() asm volatile("s_waitcnt lgkmcnt(0)" ::: "memory")
#define VM_WAIT() asm volatile("s_waitcnt vmcnt(0)" ::: "memory")
__device__ __forceinline__ unsigned f2bf(float f) { unsigned u = __builtin_bit_cast(unsigned, f); return (u + 0x7fffu + ((u >> 16) & 1u)) >> 16; }
__device__ __forceinline__ unsigned pk2(float lo, float hi) { return f2bf(lo) | (f2bf(hi) << 16); }
__device__ __forceinline__ float bflo(unsigned w) { return __builtin_bit_cast(float, w << 16); }
__device__ __forceinline__ float bfhi(unsigned w) { return __builtin_bit_cast(float, w & 0xffff0000u); }
__device__ __forceinline__ float bf2f(bf16 b) { return __builtin_bit_cast(float, ((unsigned)b) << 16); }

#define XB_TMO      128
#define XB_XCNT(j)  (256  + 64 * (j))
#define XB_XSUB(j)  (1280 + 64 * (j))
#define XB_XGEN(j)  (2304 + 64 * (j))
#define XB_TOP      3328
#define XB_TOPGEN   3392
#define XCD_BAR_WORDS 3456
#define XB_SPIN_CAP (1u << 23)

__device__ __forceinline__ unsigned xb_ld(unsigned* p)              { return __hip_atomic_load(p, __ATOMIC_RELAXED, __HIP_MEMORY_SCOPE_AGENT); }
__device__ __forceinline__ unsigned xb_add(unsigned* p, unsigned v) { return __hip_atomic_fetch_add(p, v, __ATOMIC_RELAXED, __HIP_MEMORY_SCOPE_AGENT); }
__device__ __forceinline__ unsigned xb_xcc_id() { return (unsigned)__builtin_amdgcn_s_getreg((3 << 11) | 20) & 0xFu; }
#define XB_SPIN(cond, bar) do { unsigned _sp = 0; while (cond) { __builtin_amdgcn_s_sleep(1); \
    if ((++_sp & 255u) == 0u) { if (xb_ld(&(bar)[XB_TMO])) break; if (_sp > XB_SPIN_CAP) { atomicAdd(&(bar)[XB_TMO], 1u); break; } } } } while (0)

struct XcdBarrier { unsigned* bar; unsigned x; volatile LAS unsigned* st; int wave; };

__device__ __forceinline__ XcdBarrier xcd_barrier_post(unsigned* bar, volatile LAS unsigned* st, int wave) {
    XcdBarrier b; b.bar = bar; b.x = xb_xcc_id(); b.st = st; b.wave = wave;
    if (threadIdx.x == 0) (void)xb_add(&bar[XB_XCNT(b.x)], 1u);
    return b;
}
__device__ __forceinline__ void xcd_barrier_complete(unsigned* bar, unsigned x, unsigned& nloc, unsigned& nx) {
    const unsigned G = gridDim.x * gridDim.y * gridDim.z;
    unsigned sum, cnt, mine, sp = 0u;
    for (;;) {
        sum = 0u; cnt = 0u; mine = 0u;
#pragma unroll
        for (unsigned j = 0; j < 16; ++j) { const unsigned c = xb_ld(&bar[XB_XCNT(j)]); sum += c; cnt += (c > 0u) ? 1u : 0u; mine = (j == x) ? c : mine; }
        if (sum == G) break;
        __builtin_amdgcn_s_sleep(1);
        if ((++sp & 255u) == 0u) { if (xb_ld(&bar[XB_TMO])) break; if (sp > XB_SPIN_CAP) { atomicAdd(&bar[XB_TMO], 1u); break; } }
    }
    nloc = mine > 0u ? mine : 1u; nx = cnt > 0u ? cnt : 1u;
}
__device__ __forceinline__ void xcd_barrier(const XcdBarrier& b) {
    asm volatile("s_waitcnt vmcnt(0)" ::: "memory");
    __syncthreads();
    int bw_ = b.wave; asm volatile("" : "+s"(bw_));
    if (bw_ == 0 && lane_id_v() == 0) {
        unsigned* bar = b.bar;
        __builtin_amdgcn_s_waitcnt(0);
        unsigned nloc = b.st[0], nx = b.st[1];
        if (nloc == 0u) { xcd_barrier_complete(bar, b.x, nloc, nx); b.st[0] = nloc; b.st[1] = nx; }
        const unsigned old = xb_add(&bar[XB_XSUB(b.x)], 1u);
        const unsigned gen = old / nloc;
        if (old + 1u == (gen + 1u) * nloc) {
            __builtin_amdgcn_fence(__ATOMIC_RELEASE, "agent");
            asm volatile("s_waitcnt vmcnt(0)" ::: "memory");
            const unsigned og = xb_add(&bar[XB_TOP], 1u);
            const unsigned tg = og / nx;
            if (og + 1u == (tg + 1u) * nx) xb_add(&bar[XB_TOPGEN], 1u);
            else XB_SPIN(xb_ld(&bar[XB_TOPGEN]) == tg, bar);
            __builtin_amdgcn_fence(__ATOMIC_ACQUIRE, "agent");
            xb_add(&bar[XB_XGEN(b.x)], 1u);
            asm volatile("s_waitcnt vmcnt(0)" ::: "memory");
        } else {
            XB_SPIN(xb_ld(&bar[XB_XGEN(b.x)]) == gen, bar);
            __builtin_amdgcn_fence(__ATOMIC_ACQUIRE, "agent");
            asm volatile("s_waitcnt vmcnt(0)" ::: "memory");
        }
    }
    __syncthreads();
}

struct Args {
    const float* in[23]; float* out; unsigned char* ws; int ph_lo, ph_hi;
};
template <class T> __device__ __forceinline__ T* uni(T* p) { const unsigned long long v = (unsigned long long)p; const unsigned lo = __builtin_amdgcn_readfirstlane((unsigned)v), hi = __builtin_amdgcn_readfirstlane((unsigned)(v >> 32)); return (T*)(((unsigned long long)hi << 32) | lo); }
__device__ __forceinline__ LAS unsigned char* uni_l(LAS unsigned char* p) { return (LAS unsigned char*)(unsigned)__builtin_amdgcn_readfirstlane((int)(unsigned)(size_t)p); }
__device__ __forceinline__ int uni_i(int v) { return __builtin_amdgcn_readfirstlane(v); }
struct PC { const float* const* in; float* out; unsigned char* ws; LAS unsigned char* lds; int wave, vcu, G; };
struct Frame {
    LAS unsigned char* lds;
    volatile LAS unsigned* MISC;
    gu32* ctl;
    int wave, vcu, G;
    unsigned char* ws;
};
__device__ __forceinline__ unsigned char* launder_p(unsigned char* p) { asm volatile("" : "+s"(p)); return p; }
__device__ __forceinline__ int launder_s(int v) { asm volatile("" : "+s"(v)); return v; }
__device__ __forceinline__ int launder_v(int v) { asm volatile("" : "+v"(v)); return v; }
__device__ __forceinline__ float wave_sum(float v) {
#pragma unroll
    for (int o = 1; o < 64; o <<= 1) v += __shfl_xor(v, o);
    return v;
}
__device__ __forceinline__ float wave_max(float v) {
#pragma unroll
    for (int o = 1; o < 64; o <<= 1) v = fmaxf(v, __shfl_xor(v, o));
    return v;
}

using pg8::Unit; using pg8::bf16_t;
#define LAUNDER2(a, b) asm volatile("" : "+v"(a), "+v"(b))
__device__ __forceinline__ float row_scale(const float* ss, int row) {
    const f32x4 a = *(const f32x4*)(ss + (size_t)row * 4);
    const float s = (a.x + a.y) + (a.z + a.w);
    return 1.0f / sqrtf(s * (1.0f / D) + EPS);
}
__device__ __forceinline__ float sigmoidf_(float x) { return 1.0f / (1.0f + __expf(-x)); }
__device__ __forceinline__ pg8::u32x2 pack4(const f32x4 v) { pg8::u32x2 w; w.x = pg8::cvt_pk_bf16(v[0], v[1]); w.y = pg8::cvt_pk_bf16(v[2], v[3]); return w; }

struct EpiSwiglu {
    static constexpr bool PERM = false;
    bf16_t* O; const float* ss;
    __device__ __forceinline__ void operator()(const f32x4 (&acc)[2][2][4][2], const Unit& u, int wr, int wc, int fr_, int fq_) const {
        const int l_ = lane_id_v(); const int fr = l_ & 15, fq = l_ >> 4; (void)fr_; (void)fq_;
        int rb = wr * 64 + fr, cb = wc * 16 + 4 * fq; LAUNDER2(rb, cb);
        const int row0 = u.pm * 256 + rb, col0 = u.pn * 128 + cb;
#pragma unroll
        for (int ai = 0; ai < 2; ++ai)
#pragma unroll
            for (int m = 0; m < 4; ++m) { const int row = row0 + ai * 128 + m * 16; const float s = row_scale(ss, row);
                bf16_t* rowp = O + (size_t)row * DFF + col0;
#pragma unroll
                for (int bj = 0; bj < 2; ++bj) { const f32x4 a = acc[ai][bj][m][0] * s, b = acc[ai][bj][m][1] * s; f32x4 o;
#pragma unroll
                    for (int i = 0; i < 4; ++i) o[i] = a[i] * sigmoidf_(a[i]) * b[i];
                    *(pg8::u32x2*)(rowp + bj * 64) = pack4(o); } }
    }
};
struct EpiResid {
    static constexpr bool PERM = false;
    const float* base; float* out; bf16_t* hb; float* ss; float alpha; LAS float* P; int dry;
    __device__ __forceinline__ void operator()(const f32x4 (&acc)[2][2][4][2], const Unit& u, int wr, int wc, int fr_, int fq_) const {
        const int l_ = lane_id_v(); const int fr = l_ & 15, fq = l_ >> 4; (void)fr_; (void)fq_;
        int rb = wr * 64 + fr, cb = wc * 32 + 4 * fq; LAUNDER2(rb, cb);
        const int row0 = u.pm * 256 + rb, col0 = u.pn * 256 + cb;
#pragma unroll
        for (int ai = 0; ai < 2; ++ai)
#pragma unroll
            for (int m = 0; m < 4; ++m) { const int row = row0 + ai * 128 + m * 16; const size_t off = (size_t)row * D + col0; float q = 0.f;
#pragma unroll
                for (int bj = 0; bj < 2; ++bj)
#pragma unroll
                    for (int n = 0; n < 2; ++n) { const f32x4 bs = *(const f32x4*)(base + off + bj * 128 + n * 16); const f32x4 v = bs + acc[ai][bj][m][n] * alpha;
                        if (!dry) { *(f32x4*)(out + off + bj * 128 + n * 16) = v;
                        *(pg8::u32x2*)(hb + off + bj * 128 + n * 16) = pack4(v); }
                        q += (v[0] * v[0] + v[1] * v[1]) + (v[2] * v[2] + v[3] * v[3]); }
                q += __shfl_xor(q, 16); q += __shfl_xor(q, 32);
                if (fq == 0) P[(rb + ai * 128 + m * 16) * 4 + wc] = q;
                asm volatile("" ::: "memory"); }
        asm volatile("s_waitcnt lgkmcnt(0)" ::: "memory"); __builtin_amdgcn_s_barrier(); asm volatile("" ::: "memory");
        const int tid = (wr * 4 + wc) * 64 + fq * 16 + fr;
        if (tid < 256 && !dry) { const f32x4 p = *(const LAS f32x4*)(P + tid * 4); ss[(size_t)(u.pm * 256 + tid) * 4 + u.pn] = (p.x + p.y) + (p.z + p.w); }
    }
};
struct EpiPlainBf16 {
    static constexpr bool PERM = false;
    bf16_t* O; int ldo;
    __device__ __forceinline__ void operator()(const f32x4 (&acc)[2][2][4][2], const Unit& u, int wr, int wc, int fr_, int fq_) const {
        const int l_ = lane_id_v(); const int fr = l_ & 15, fq = l_ >> 4; (void)fr_; (void)fq_;
        int rb = wr * 64 + fr, cb = wc * 32 + 4 * fq; LAUNDER2(rb, cb);
        const int row0 = u.pm * 256 + rb, col0 = u.pn * 256 + cb;
#pragma unroll
        for (int ai = 0; ai < 2; ++ai)
#pragma unroll
            for (int m = 0; m < 4; ++m) { bf16_t* rowp = O + (size_t)(row0 + ai * 128 + m * 16) * ldo + col0;
#pragma unroll
                for (int bj = 0; bj < 2; ++bj)
#pragma unroll
                    for (int n = 0; n < 2; ++n) *(pg8::u32x2*)(rowp + bj * 128 + n * 16) = pack4(acc[ai][bj][m][n]); }
    }
};
struct EpiInProj {
    static constexpr bool PERM = false;
    const float* ss; bf16_t* qa; float* ckvraw; bf16_t* ik; float* iw; bf16_t* iqraw; bf16_t* z; bf16_t* qc; bf16_t* G;
    __device__ __forceinline__ void operator()(const f32x4 (&acc)[2][2][4][2], const Unit& u, int wr, int wc, int fr_, int fq_) const {
        const int l_ = lane_id_v(); const int fr = l_ & 15, fq = l_ >> 4; (void)fr_; (void)fq_;
        int rb = wr * 64 + fr, ct = wc * 32 + 4 * fq; LAUNDER2(rb, ct);
        const int row0 = u.pm * 256 + rb; const int pn = u.pn;
        if (pn == 4) {
#pragma unroll
            for (int ai = 0; ai < 2; ++ai)
#pragma unroll
                for (int m = 0; m < 4; ++m) { const int row = row0 + ai * 128 + m * 16; const float s = row_scale(ss, row);
#pragma unroll
                    for (int n = 0; n < 2; ++n) { *(f32x4*)(ckvraw + (size_t)row * KVR + ct + n * 16) = acc[ai][0][m][n] * s;
                        if (wc == 0) *(pg8::u32x2*)(ik + (size_t)row * IDIM + 4 * fq + n * 16) = pack4(acc[ai][1][m][n] * s); }
                    if (wc == 1 && fq < 2) *(f32x4*)(iw + (size_t)row * IH + 4 * fq) = acc[ai][1][m][0] * s; }
        } else {
            bf16_t* dst0; int ld; bool sig = false;
            if (pn < 4) { dst0 = qa + pn * 256; ld = 1024; } else if (pn == 5) { dst0 = iqraw; ld = 256; } else if (pn == 6) { dst0 = z; ld = 256; } else if (pn == 7) { dst0 = qc; ld = 256; } else { dst0 = G + (pn - 8) * 256; ld = 3072; sig = true; }
#pragma unroll
            for (int ai = 0; ai < 2; ++ai)
#pragma unroll
                for (int m = 0; m < 4; ++m) { const int row = row0 + ai * 128 + m * 16; const float s = row_scale(ss, row); bf16_t* rowp = dst0 + (size_t)row * ld + ct;
#pragma unroll
                    for (int bj = 0; bj < 2; ++bj)
#pragma unroll
                        for (int n = 0; n < 2; ++n) { f32x4 o = acc[ai][bj][m][n] * s;
                            if (sig) {
#pragma unroll
                                for (int i = 0; i < 4; ++i) o[i] = sigmoidf_(o[i]); }
                            *(pg8::u32x2*)(rowp + bj * 128 + n * 16) = pack4(o); } }
        }
    }
};
template <int MODE> struct EpiMerge {
    static constexpr bool PERM = false;
    bf16_t* Mg; const bf16_t* G;
    __device__ __forceinline__ void operator()(const f32x4 (&acc)[2][2][4][2], const Unit& u, int wr, int wc, int fr_, int fq_) const {
        const int l_ = lane_id_v(); const int fr = l_ & 15, fq = l_ >> 4; (void)fr_; (void)fq_;
        int rb = wr * 64 + fr, cb = wc * 32 + 4 * fq; LAUNDER2(rb, cb);
        const int row0 = u.pm * 256 + rb, col0 = u.pn * 256 + cb;
#pragma unroll
        for (int ai = 0; ai < 2; ++ai)
#pragma unroll
            for (int m = 0; m < 4; ++m) { const int row = row0 + ai * 128 + m * 16;
                const bf16_t* gp = G + (size_t)row * 3072 + MODE * 1024 + col0; bf16_t* mp = Mg + (size_t)row * D + col0;
#pragma unroll
                for (int bj = 0; bj < 2; ++bj)
#pragma unroll
                    for (int n = 0; n < 2; ++n) { const int co = bj * 128 + n * 16;
                        const pg8::u32x2 gw = *(const pg8::u32x2*)(gp + co);
                        f32x4 o = acc[ai][bj][m][n]; o[0] *= bflo(gw.x); o[1] *= bfhi(gw.x); o[2] *= bflo(gw.y); o[3] *= bfhi(gw.y);
                        if (MODE > 0) { const pg8::u32x2 pw = *(const pg8::u32x2*)(mp + co); o[0] += bflo(pw.x); o[1] += bfhi(pw.x); o[2] += bflo(pw.y); o[3] += bfhi(pw.y); }
                        *(pg8::u32x2*)(mp + co) = pack4(o); }
                asm volatile("" ::: "memory"); }
    }
};

template <class Map>
__device__ __forceinline__ void transpose_item(const float* W, int K, int N, const float* gain, bf16* WT, LAS float* scr, int item, int lane, Map map) {
    const int nblk = (N + 31) / 32, kb = item / nblk, nb = item % nblk, k0 = 64 * kb, n0 = 32 * nb;
    const int nn = n0 + (lane & 31); const bool nok = nn < N;
#pragma unroll 4
    for (int i = 0; i < 32; ++i) { const int kk = 2 * i + (lane >> 5); float v = nok ? W[(size_t)(k0 + kk) * N + nn] : 0.f; if (gain) v *= gain[k0 + kk]; scr[kk * 33 + (lane & 31)] = v; }
    LDS_WAIT(); asm volatile("" ::: "memory");
    const int c = lane & 7;
#pragma unroll
    for (int j = 0; j < 4; ++j) { const int n = (lane >> 3) + 8 * j; const LAS float* s = scr + (8 * c) * 33 + n;
        v4u o; o.x = pk2(s[0 * 33], s[1 * 33]); o.y = pk2(s[2 * 33], s[3 * 33]); o.z = pk2(s[4 * 33], s[5 * 33]); o.w = pk2(s[6 * 33], s[7 * 33]);
        if (n0 + n < N) { const int dr = map(n0 + n); if (dr >= 0) *(GAS v4u*)(WT + (size_t)dr * K + k0 + 8 * c) = o; } }
    LDS_WAIT(); asm volatile("" ::: "memory");
}
struct MapId { int off; __device__ __forceinline__ int operator()(int n) const { return off + n; } };
struct MapSwiglu { __device__ __forceinline__ int operator()(int c) const { const int half = c >= DFF ? 1 : 0, j = c - half * DFF; return 32 * (j >> 4) + 16 * half + (j & 15); } };
struct MapInProj { __device__ __forceinline__ int operator()(int c) const {
    if (c < C_CKV) return -1;
    if (c < C_IQ) return 1024 + (c - C_CKV);
    if (c < C_IK) return 1280 + (c - C_IQ);
    if (c < C_IW) return 1152 + (c - C_IK);
    if (c < C_Z) return 1184 + (c - C_IW);
    if (c < C_QC) return 1536 + (c - C_Z);
    if (c < C_G) return 1792 + (c - C_QC);
    return 2048 + (c - C_G); } };
__device__ __forceinline__ void qlat_item(const float* win, const float* mixn, const float* wuk, bf16* WT, int item, int lane) {
    const int kc = item & 127, rh = (item >> 7) & 1, h = item >> 8; const int r = rh * 64 + lane;
    const f32x4* wp = (const f32x4*)(wuk + (size_t)r * (AH * AHD) + h * 64);
    float acc[8] = {0.f, 0.f, 0.f, 0.f, 0.f, 0.f, 0.f, 0.f};
#pragma unroll 1
    for (int dc = 0; dc < 4; ++dc) {
        const f32x4 w0 = wp[4 * dc], w1 = wp[4 * dc + 1], w2 = wp[4 * dc + 2], w3 = wp[4 * dc + 3];
#pragma unroll
        for (int kk = 0; kk < 8; ++kk) { const f32x4* ip = (const f32x4*)(win + (size_t)(kc * 8 + kk) * INW + h * 64 + 16 * dc);
            const f32x4 a0 = ip[0], a1 = ip[1], a2 = ip[2], a3 = ip[3];
            acc[kk] += (a0.x * w0.x + a0.y * w0.y + a0.z * w0.z + a0.w * w0.w) + (a1.x * w1.x + a1.y * w1.y + a1.z * w1.z + a1.w * w1.w)
                     + (a2.x * w2.x + a2.y * w2.y + a2.z * w2.z + a2.w * w2.w) + (a3.x * w3.x + a3.y * w3.y + a3.z * w3.z + a3.w * w3.w);
            if (kk & 1) asm volatile("" ::: "memory"); }
    }
    const f32x4 g0 = *(const f32x4*)(mixn + kc * 8), g1 = *(const f32x4*)(mixn + kc * 8 + 4);
    v4u w; w.x = pk2(acc[0] * g0.x, acc[1] * g0.y); w.y = pk2(acc[2] * g0.z, acc[3] * g0.w); w.z = pk2(acc[4] * g1.x, acc[5] * g1.y); w.w = pk2(acc[6] * g1.z, acc[7] * g1.w);
    *(GAS v4u*)(WT + (size_t)(h * 128 + r) * D + kc * 8) = w;
}
__device__ __forceinline__ void wafold_item(const float* wuv, const float* wba, bf16* WT, int item, int lane) {
    const int ng = item & 15, rg = (item >> 4) & 15, h = item >> 8; const int n = ng * 64 + lane, r0 = rg * 8;
    float acc[8] = {0.f, 0.f, 0.f, 0.f, 0.f, 0.f, 0.f, 0.f};
#pragma unroll 4
    for (int d = 0; d < 64; ++d) { const float wa = wba[(size_t)(h * 64 + d) * D + n];
#pragma unroll
        for (int j = 0; j < 8; ++j) acc[j] += wuv[(size_t)(r0 + j) * (AH * AHD) + h * 64 + d] * wa; }
    v4u w; w.x = pk2(acc[0], acc[1]); w.y = pk2(acc[2], acc[3]); w.z = pk2(acc[4], acc[5]); w.w = pk2(acc[6], acc[7]);
    *(GAS v4u*)(WT + (size_t)n * 1024 + h * 128 + r0) = w;
}
__device__ __forceinline__ int items_of(int K, int N) { return (K / 64) * ((N + 31) / 32); }

__device__ __forceinline__ void prep_layer_weights_body(const PC& F, int l) {
    struct { const float* const* in; } a{F.in};
    const int lane_ = lane_id_v();
    LAS float* scr = (LAS float*)(F.lds + RING_OFF + F.wave * 16384);
    const int gw = F.vcu * NWAVES + F.wave, NGW = F.G * NWAVES;
    const float* f1n = a.in[3] + (size_t)l * D; const float* f1in = a.in[4] + (size_t)l * D * 2 * DFF; const float* f1out = a.in[5] + (size_t)l * DFF * D;
    const float* mixn = a.in[6] + (size_t)l * D; const float* win = a.in[7] + (size_t)l * D * INW;
    const float* wba = a.in[15] + (size_t)l * AW * D; const float* wbb = a.in[16] + (size_t)l * PW_ * D; const float* wbc = a.in[17] + (size_t)l * CW * D;
    const float* wout = a.in[18] + (size_t)l * D * D;
    const float* f2n = a.in[19] + (size_t)l * D; const float* f2in = a.in[20] + (size_t)l * D * 2 * DFF; const float* f2out = a.in[21] + (size_t)l * DFF * D;
    unsigned char* ws = launder_p(F.ws);
    const float* wuk = a.in[9] + (size_t)l * KVR * AH * AHD; const float* wuv = a.in[10] + (size_t)l * KVR * AH * AHD;
    const int I0 = items_of(D, 2 * DFF), I1 = items_of(DFF, D), I2 = items_of(D, INW), I4 = items_of(PW_, D), I5 = items_of(CW, D), I6 = items_of(D, D);
    const int NIT = 2 * I0 + 2 * I1 + I2 + I4 + I5 + I6;
#pragma unroll 1
    for (int it = gw; it < NIT; it += NGW) {
        int r = it;
        if (r < I0) { transpose_item(f1in, D, 2 * DFF, f1n, (bf16*)(ws + WS_W1IN), scr, r, lane_, MapSwiglu{}); continue; } r -= I0;
        if (r < I0) { transpose_item(f2in, D, 2 * DFF, f2n, (bf16*)(ws + WS_W2IN), scr, r, lane_, MapSwiglu{}); continue; } r -= I0;
        if (r < I1) { transpose_item(f1out, DFF, D, nullptr, (bf16*)(ws + WS_W1OUT), scr, r, lane_, MapId{0}); continue; } r -= I1;
        if (r < I1) { transpose_item(f2out, DFF, D, nullptr, (bf16*)(ws + WS_W2OUT), scr, r, lane_, MapId{0}); continue; } r -= I1;
        if (r < I2) { transpose_item(win, D, INW, mixn, (bf16*)(ws + WS_WIN), scr, r, lane_, MapInProj{}); continue; } r -= I2;
        if (r < I4) { transpose_item(wbb, PW_, D, nullptr, (bf16*)(ws + WS_WB), scr, r, lane_, MapId{0}); continue; } r -= I4;
        if (r < I5) { transpose_item(wbc, CW, D, nullptr, (bf16*)(ws + WS_WC), scr, r, lane_, MapId{0}); continue; } r -= I5;
        transpose_item(wout, D, D, nullptr, (bf16*)(ws + WS_WOUT), scr, r, lane_, MapId{0});
    }
    { const float* wpool = a.in[11] + (size_t)l * 4 * 64 * 64; bf16* wpT = (bf16*)(ws + WS_WPT);
      for (int i = gw * 64 + lane_; i < 4 * 64 * 64; i += NGW * 64) { const int c = i & 63, d = (i >> 6) & 63, g = i >> 12; wpT[i] = (bf16)f2bf(wpool[(g * 64 + c) * 64 + d]); } }
    asm volatile("" ::: "memory");
#pragma unroll 1
    for (int it = gw; it < 2048; it += NGW) wafold_item(wuv, wba, (bf16*)(ws + WS_WA), it, lane_);
    asm volatile("" ::: "memory");
#pragma unroll 1
    for (int it = gw; it < 2048; it += NGW) qlat_item(win, mixn, wuk, (bf16*)(ws + WS_WIN), it, lane_);
}

__device__ __noinline__ void p0_prologue(const float* const* in_, float* out_, unsigned char* ws_, LAS unsigned char* lds_, int wave_, int vcu_, int G_) {
    const PC F{uni(in_), uni(out_), uni(ws_), uni_l(lds_), uni_i(wave_), uni_i(vcu_), uni_i(G_)}; struct { const float* const* in; } a{F.in};
    const int lane_ = lane_id_v();
    const int gw = F.vcu * NWAVES + F.wave, NGW = F.G * NWAVES;
    const float* x = a.in[0]; const float* mem = a.in[1];
    bf16* hb = (bf16*)(F.ws + WS_HB); float* ss = (float*)(F.ws + WS_SS); bf16* memn = (bf16*)(F.ws + WS_MEMN);
    for (int m = gw; m < M + MROWS; m += NGW) {
        const bool ismem = m >= M; const int r = ismem ? m - M : m;
        const GAS f32x4* xr = (const GAS f32x4*)((ismem ? mem : x) + (size_t)r * D) + lane_;
        f32x4 v[4]; float s = 0.f;
#pragma unroll
        for (int j = 0; j < 4; ++j) { v[j] = xr[64 * j]; s += (v[j].x * v[j].x + v[j].y * v[j].y) + (v[j].z * v[j].z + v[j].w * v[j].w); }
        s = wave_sum(s);
        float sc = 1.f;
        if (ismem) sc = 1.0f / sqrtf(s * (1.0f / D) + EPS);
        else if (lane_ < 4) ss[(size_t)r * 4 + lane_] = lane_ == 0 ? s : 0.f;
        GAS unsigned long long* o8 = (GAS unsigned long long*)((ismem ? memn : hb) + (size_t)r * D) + lane_;
#pragma unroll
        for (int j = 0; j < 4; ++j) o8[64 * j] = (unsigned long long)pk2(v[j].x * sc, v[j].y * sc) | ((unsigned long long)pk2(v[j].z * sc, v[j].w * sc) << 32);
    }
    LAS float* scr = (LAS float*)(F.lds + RING_OFF + F.wave * 16384);
    const int IM = items_of(D, 2 * CW);
    for (int it = gw; it < DEPTH * IM; it += NGW) { const int l = it / IM, r = it % IM;
        transpose_item(a.in[14] + (size_t)l * D * 2 * CW, D, 2 * CW, a.in[13] + (size_t)l * D, (bf16*)(F.ws + WS_WMEM), scr, r, lane_, MapId{l * 2 * CW}); }
    prep_layer_weights_body(F, 0);
}
__device__ __noinline__ void prep_layer_weights(const float* const* in_, float* out_, unsigned char* ws_, LAS unsigned char* lds_, int l, int wave_, int vcu_, int G_) {
    const PC F{uni(in_), uni(out_), uni(ws_), uni_l(lds_), uni_i(wave_), uni_i(vcu_), uni_i(G_)}; prep_layer_weights_body(F, uni_i(l));
}

__constant__ unsigned char T5_BUCKET[128] = {0, 1, 2, 3, 4, 5, 6, 7, 8, 9, 10, 11, 12, 13, 14, 15, 16, 16, 16, 17, 17, 18, 18, 18, 19, 19, 19, 20, 20, 20, 20, 21, 21, 21, 21, 22, 22, 22, 22, 22, 23, 23, 23, 23, 23, 23, 24, 24, 24, 24, 24, 24, 25, 25, 25, 25, 25, 25, 25, 26, 26, 26, 26, 26, 26, 26, 26, 27, 27, 27, 27, 27, 27, 27, 27, 27, 27, 28, 28, 28, 28, 28, 28, 28, 28, 28, 28, 29, 29, 29, 29, 29, 29, 29, 29, 29, 29, 29, 29, 30, 30, 30, 30, 30, 30, 30, 30, 30, 30, 30, 30, 30, 30, 31, 31, 31, 31, 31, 31, 31, 31, 31, 31, 31, 31, 31, 31, 31};

typedef short bf16x8_p __attribute__((ext_vector_type(8)));
__device__ __forceinline__ void prep_tokens(const float* const* in_, float* out_, unsigned char* ws_, LAS unsigned char* lds_, int l_, int wave_, int vcu_, int G_, int dry_) {
    const int dry = uni_i(dry_);
    const PC F{uni(in_), uni(out_), uni(ws_), uni_l(lds_), uni_i(wave_), uni_i(vcu_), uni_i(G_)}; struct { const float* const* in; } a{F.in}; const int l = uni_i(l_);
    unsigned char* ws = launder_p(F.ws);
    const float* ckvraw = (const float*)(ws + WS_CKVRAW); bf16* ckv = (bf16*)(ws + WS_CKV);
    const bf16* iqraw = (const bf16*)(ws + WS_IQRAW); bf16* iqf = (bf16*)(ws + WS_IQF); const float* iw = (const float*)(ws + WS_IW); unsigned* sgn = (unsigned*)(ws + WS_SGN);
    const bf16* z = (const bf16*)(ws + WS_Z); bf16* yb = (bf16*)(ws + WS_YB); bf16* qc = (bf16*)(ws + WS_QC);
    const bf16* memkv = (const bf16*)(ws + WS_MEMKV); const bf16* vT = (const bf16*)(ws + WS_VT); const bf16* wpT = (const bf16*)(ws + WS_WPT);
    const float* kvn = a.in[8] + (size_t)l * KVR; const float* pscale = a.in[12] + (size_t)l * PW_;
    const int lane = lane_id_v(), tid = F.wave * 64 + lane;
    const int tok = lane & 15, g4 = lane >> 4;
    LAS unsigned char* Ks = F.lds;
    LAS unsigned char* Vs = F.lds + 36864;
    for (int blk = F.vcu; blk < M / 128; blk += F.G) {
        const int rowb = blk * 128, b = rowb / SEQ, row0 = rowb + F.wave * 16;
#pragma unroll 1
        for (int tt = 0; tt < 16; ++tt) { const int row = row0 + tt;
            { const f32x2 v = *(const f32x2*)(ckvraw + (size_t)row * KVR + 2 * lane); const float q = wave_sum(v.x * v.x + v.y * v.y);
              const float rs = 1.0f / sqrtf(q * (1.0f / KVR) + EPS); const f32x2 g = *(const f32x2*)(kvn + 2 * lane);
              *(unsigned*)(ckv + (size_t)row * KVR + 2 * lane) = pk2(v.x * rs * g.x, v.y * rs * g.y); }
            { const float wv = iw[(size_t)row * IH + (lane >> 3)]; const float aw = fabsf(wv) * (1.0f / 16.0f);
              const v2u q = *(const v2u*)(iqraw + (size_t)row * 256 + 4 * lane);
              v2u o; o.x = pk2(bflo(q.x) * aw, bfhi(q.x) * aw); o.y = pk2(bflo(q.y) * aw, bfhi(q.y) * aw);
              *(v2u*)(iqf + (size_t)row * 256 + 4 * lane) = o;
              const unsigned long long bal = __ballot(wv < 0.f);
              unsigned mask = 0;
#pragma unroll
              for (int h = 0; h < 8; ++h) mask |= ((unsigned)(bal >> (8 * h)) & 1u) << h;
              if (lane == 0) sgn[row] = mask; } }
        { const int row = row0 + tok, spos = row % SEQ;
#pragma unroll 1
          for (int g = 0; g < 4; ++g) { const int w = 2 << g; const int cnt = (spos + 1) < w ? (spos + 1) : w; const float rc = 1.0f / (float)cnt;
              bf16x8_p pf[2];
#pragma unroll
              for (int ks = 0; ks < 2; ++ks) { const int c0 = g * 64 + 32 * ks + 8 * g4; float sum[8], z0[8];
#pragma unroll
                  for (int e = 0; e < 8; ++e) { sum[e] = 0.f; z0[e] = 0.f; }
                  for (int j = 0; j < w; ++j) { if (j < cnt) { const v4u v = *(const v4u*)(z + (size_t)(row - j) * 256 + c0);
                      const float f[8] = {bflo(v.x), bfhi(v.x), bflo(v.y), bfhi(v.y), bflo(v.z), bfhi(v.z), bflo(v.w), bfhi(v.w)};
#pragma unroll
                      for (int e = 0; e < 8; ++e) { sum[e] += f[e]; if (j == 0) z0[e] = f[e]; } } }
                  v4u pw; pw.x = pk2(sum[0] * rc - z0[0], sum[1] * rc - z0[1]); pw.y = pk2(sum[2] * rc - z0[2], sum[3] * rc - z0[3]); pw.z = pk2(sum[4] * rc - z0[4], sum[5] * rc - z0[5]); pw.w = pk2(sum[6] * rc - z0[6], sum[7] * rc - z0[7]);
                  pf[ks] = __builtin_bit_cast(bf16x8_p, pw); }
#pragma unroll
              for (int dt = 0; dt < 4; ++dt) { f32x4 acc = {0.f, 0.f, 0.f, 0.f};
#pragma unroll
                  for (int ks = 0; ks < 2; ++ks) { const bf16x8_p af = *(const bf16x8_p*)(wpT + (size_t)(g * 64 + 16 * dt + tok) * 64 + 32 * ks + 8 * g4); acc = __builtin_amdgcn_mfma_f32_16x16x32_bf16(af, pf[ks], acc, 0, 0, 0); }
                  const f32x4 ps = *(const f32x4*)(pscale + g * 64 + 16 * dt + 4 * g4);
                  v2u o; o.x = pk2(acc[0] * ps.x, acc[1] * ps.y); o.y = pk2(acc[2] * ps.z, acc[3] * ps.w);
                  *(v2u*)(yb + (size_t)row * 256 + g * 64 + 16 * dt + 4 * g4) = o; } } }
#pragma unroll 1
        for (int h = 0; h < CH; ++h) {
            __syncthreads();
#pragma unroll
            for (int e = 0; e < 4; ++e) { const int i = tid + 512 * e;
                { const int m = i >> 3, c = i & 7; const v4u v = *(const v4u*)(memkv + (size_t)(b * NMEM + m) * 2048 + l * 512 + h * 64 + c * 8); *(LAS v4u*)(Ks + m * 144 + c * 16) = v; }
                { const int d = i >> 5, c = i & 31; const v4u v = *(const v4u*)(vT + (size_t)(l * 512 + 256 + h * 64 + d) * MROWS + b * NMEM + c * 8); *(LAS v4u*)(Vs + d * 528 + c * 16) = v; } }
            LDS_WAIT(); __syncthreads();
            const int row = row0 + tok;
            bf16x8_p qf[2];
#pragma unroll
            for (int ks = 0; ks < 2; ++ks) qf[ks] = *(const bf16x8_p*)(qc + (size_t)row * 256 + h * 64 + 32 * ks + 8 * g4);
            f32x4 S[16]; float mx = -1e30f;
#pragma unroll
            for (int mt = 0; mt < 16; ++mt) { f32x4 acc = {0.f, 0.f, 0.f, 0.f};
#pragma unroll
                for (int ks = 0; ks < 2; ++ks) { const bf16x8_p kf = *(const LAS bf16x8_p*)(Ks + (16 * mt + tok) * 144 + (4 * ks + g4) * 16); acc = __builtin_amdgcn_mfma_f32_16x16x32_bf16(kf, qf[ks], acc, 0, 0, 0); }
                S[mt] = acc; mx = fmaxf(mx, fmaxf(fmaxf(acc[0], acc[1]), fmaxf(acc[2], acc[3]))); if ((mt & 3) == 3) __builtin_amdgcn_sched_barrier(0); }
            mx = fmaxf(mx, __shfl_xor(mx, 16)); mx = fmaxf(mx, __shfl_xor(mx, 32));
            float sm = 0.f;
#pragma unroll
            for (int mt = 0; mt < 16; ++mt)
#pragma unroll
                for (int r = 0; r < 4; ++r) { const float p = __expf((S[mt][r] - mx) * 0.125f); S[mt][r] = p; sm += p; }
            sm += __shfl_xor(sm, 16); sm += __shfl_xor(sm, 32);
            const float inv = 1.0f / sm;
            f32x4 oacc[4];
#pragma unroll
            for (int dt = 0; dt < 4; ++dt) oacc[dt] = (f32x4){0.f, 0.f, 0.f, 0.f};
#pragma unroll
            for (int kk = 0; kk < 8; ++kk) { v4u pw; pw.x = pg8::cvt_pk_bf16(S[2 * kk][0], S[2 * kk][1]); pw.y = pg8::cvt_pk_bf16(S[2 * kk][2], S[2 * kk][3]); pw.z = pg8::cvt_pk_bf16(S[2 * kk + 1][0], S[2 * kk + 1][1]); pw.w = pg8::cvt_pk_bf16(S[2 * kk + 1][2], S[2 * kk + 1][3]);
                const bf16x8_p pfr = __builtin_bit_cast(bf16x8_p, pw);
#pragma unroll
                for (int dt = 0; dt < 4; ++dt) { const LAS unsigned char* vp = Vs + (16 * dt + tok) * 528 + (32 * kk + 4 * g4) * 2;
                    const v2u lo = *(const LAS v2u*)vp, hi = *(const LAS v2u*)(vp + 32);
                    v4u vw; vw.x = lo.x; vw.y = lo.y; vw.z = hi.x; vw.w = hi.y;
                    oacc[dt] = __builtin_amdgcn_mfma_f32_16x16x32_bf16(__builtin_bit_cast(bf16x8_p, vw), pfr, oacc[dt], 0, 0, 0); }
                __builtin_amdgcn_sched_barrier(0); }
#pragma unroll
            for (int dt = 0; dt < 4; ++dt) { v2u o; o.x = pk2(oacc[dt][0] * inv, oacc[dt][1] * inv); o.y = pk2(oacc[dt][2] * inv, oacc[dt][3] * inv);
                if (!dry) *(v2u*)(qc + (size_t)row * 256 + h * 64 + 16 * dt + 4 * g4) = o; else asm volatile("" :: "v"(o.x), "v"(o.y)); }
        }
    }
    __syncthreads();
}

__device__ __forceinline__ unsigned key_of(float s) { const unsigned u = __builtin_bit_cast(unsigned, s); return (u & 0x80000000u) ? ~u : (u | 0x80000000u); }

typedef short bf16x8_t __attribute__((ext_vector_type(8)));
typedef short s16x4_t __attribute__((ext_vector_type(4)));
__device__ __forceinline__ void glds16(const void* gsrc, unsigned lds_dst) { unsigned keep;
    asm volatile("s_mov_b32 %0, m0\n\ts_mov_b32 m0, %2\n\ts_nop 0\n\tglobal_load_lds_dwordx4 %1, off\n\ts_mov_b32 m0, %0" : "=&s"(keep) : "v"(gsrc), "s"(lds_dst) : "memory"); }
typedef float f32x16 __attribute__((ext_vector_type(16)));
constexpr int SEL_CAP = 256;
constexpr int SL_HIST = 0, SL_SEL = 0, SL_CS = 32768, SL_CI = 98304, SL_KEYS = 131072, SL_ST = 147456;

#define SEL_DECLS \
    LAS unsigned char* const lds = uni_l(lds_); const int wave = uni_i(wave_), b = uni_i(b_), ub = uni_i(ub_); unsigned char* ws = uni(ws_); \
    const bf16* iqf = (const bf16*)(ws + WS_IQF); const unsigned* sgn = (const unsigned*)(ws + WS_SGN); const bf16* ik = (const bf16*)(ws + WS_IK); \
    const int lane = lane_id_v(), tid = wave * 64 + lane; const int kl = lane & 31, c5 = lane >> 5; \
    LAS unsigned* hist = (LAS unsigned*)(lds + SL_HIST); LAS unsigned short* lsel = (LAS unsigned short*)(lds + SL_SEL); LAS float* lcs = (LAS float*)(lds + SL_CS); \
    LAS unsigned short* lci = (LAS unsigned short*)(lds + SL_CI); LAS unsigned* st = (LAS unsigned*)(lds + SL_ST); LAS float* stf = (LAS float*)(lds + SL_ST); \
    const int t0 = ub * 64; const int q0 = b * SEQ + t0; const bf16* ikb = ik + (size_t)b * SEQ * IDIM; const int ntile = (t0 + 64 + 127) >> 7; \
    (void)hist; (void)lsel; (void)lcs; (void)lci; (void)stf; (void)tid;
#define SEL_LOAD_A \
    bf16x8_t af[2][2]; float sgc[2][16]; \
    { const int i = kl, a_ = i >> 3, cc_ = (i >> 2) & 1, e_ = i & 3; const int qq_ = 2 * cc_ + (a_ >> 1), hh_ = 4 * (a_ & 1) + e_; \
      _Pragma("unroll") for (int rt = 0; rt < 2; ++rt) { const unsigned flip_ = ((sgn[q0 + 8 * wave + 4 * rt + qq_] >> hh_) & 1u) ? 0x80008000u : 0u;     \
          _Pragma("unroll") for (int ks = 0; ks < 2; ++ks) { v4u w_ = *(const v4u*)(iqf + (size_t)(q0 + 8 * wave + 4 * rt + qq_) * 256 + hh_ * 32 + 16 * ks + 8 * c5); \
              w_.x ^= flip_; w_.y ^= flip_; w_.z ^= flip_; w_.w ^= flip_; af[rt][ks] = __builtin_bit_cast(bf16x8_t, w_); } } \
      _Pragma("unroll") for (int rt = 0; rt < 2; ++rt) _Pragma("unroll") for (int u = 0; u < 2; ++u) { const unsigned m_ = sgn[q0 + 8 * wave + 4 * rt + 2 * c5 + u]; \
          _Pragma("unroll") for (int h = 0; h < 8; ++h) sgc[rt][8 * u + h] = ((m_ >> h) & 1u) ? -__builtin_inff() : __builtin_inff(); } }
#define SEL_STAGE(kt_) do { const int key_ = 16 * wave + (lane >> 2); const int ch_ = (lane & 3) ^ ((key_ >> 2) & 3); \
    glds16(ikb + (size_t)(128 * (kt_) + key_) * IDIM + ch_ * 8, (unsigned)__builtin_amdgcn_readfirstlane((int)(unsigned)(size_t)(lds + SL_KEYS + ((kt_) & 1) * 8192 + wave * 1024))); } while (0)
#define SEL_SCORES(kt_) do { const LAS unsigned char* kb_ = lds + SL_KEYS + ((kt_) & 1) * 8192; \
    _Pragma("unroll") for (int kh = 0; kh < 4; ++kh) { const int key_ = 32 * kh + kl; \
        const bf16x8_t b0_ = *(const LAS bf16x8_t*)(kb_ + key_ * 64 + 16 * ((0 + c5) ^ ((key_ >> 2) & 3))); \
        const bf16x8_t b1_ = *(const LAS bf16x8_t*)(kb_ + key_ * 64 + 16 * ((2 + c5) ^ ((key_ >> 2) & 3))); \
        _Pragma("unroll") for (int rt = 0; rt < 2; ++rt) { f32x16 acc_ = {0.f,0.f,0.f,0.f,0.f,0.f,0.f,0.f,0.f,0.f,0.f,0.f,0.f,0.f,0.f,0.f}; \
            acc_ = __builtin_amdgcn_mfma_f32_32x32x16_bf16(af[rt][0], b0_, acc_, 0, 0, 0); acc_ = __builtin_amdgcn_mfma_f32_32x32x16_bf16(af[rt][1], b1_, acc_, 0, 0, 0); \
            _Pragma("unroll") for (int u = 0; u < 2; ++u) { float s_ = 0.f;     \
                _Pragma("unroll") for (int h = 0; h < 8; ++h) s_ += __builtin_amdgcn_fmed3f(acc_[8 * u + h], 0.f, sgc[rt][8 * u + h]); \
                sc[rt][kh][u] = s_; } } } } while (0)
#define SEL_BOUNDARY(FINAL) do { \
    const int qq = tid >> 3, part = tid & 7; const LAS v4u* hp = (const LAS v4u*)(hist + qq * 256 + 32 * part); \
    unsigned bins[32]; \
    _Pragma("unroll") for (int i = 0; i < 8; ++i) { const v4u v = hp[i]; bins[4 * i] = v.x; bins[4 * i + 1] = v.y; bins[4 * i + 2] = v.z; bins[4 * i + 3] = v.w; } \
    unsigned ps = 0; \
    _Pragma("unroll") for (int i = 0; i < 32; ++i) ps += bins[i]; \
    unsigned v = ps, tt; \
    tt = __shfl_down(v, 1, 8); if (part + 1 < 8) v += tt; \
    tt = __shfl_down(v, 2, 8); if (part + 2 < 8) v += tt; \
    tt = __shfl_down(v, 4, 8); if (part + 4 < 8) v += tt; \
    unsigned cacc = v - ps; \
    if (cacc < (unsigned)TOPK && v >= (unsigned)TOPK) { int bsel = 0; unsigned na = 0, cb = 0; bool found = false; \
        _Pragma("unroll") for (int i = 31; i >= 0; --i) { const bool hit = !found && (cacc + bins[i] >= (unsigned)TOPK); if (hit) { bsel = i; na = cacc; cb = bins[i]; found = true; } cacc += bins[i]; } \
        st[128 + qq] = (unsigned)(32 * part + bsel); if (FINAL) { st[192 + qq] = na; st[256 + qq] = cb; st[448 + qq] = cb > (unsigned)SEL_CAP ? 1u : 0u; } } } while (0)

__device__ __forceinline__ void sel_pass1(unsigned char* ws_, LAS unsigned char* lds_, int wave_, int b_, int ub_) {
    SEL_DECLS
    unsigned short* sel = (unsigned short*)(ws + WS_SEL);
    __syncthreads();
    if (ub < 4) {
        for (int i = tid; i < 64 * TOPK; i += NWAVES * 64) { const int qq = i >> 8, sl = i & 255; sel[(size_t)(q0 + qq) * TOPK + sl] = (unsigned short)(sl <= t0 + qq ? sl : 0); }
        if (tid == 0) st[512] = 1u;
        asm volatile("s_waitcnt vmcnt(0) lgkmcnt(0)" ::: "memory"); __syncthreads();
        return;
    }
    SEL_LOAD_A
    for (int i = tid; i < 64 * 256; i += NWAVES * 64) hist[i] = 0u;
    if (tid < 64) { st[128 + tid] = 0u; st[448 + tid] = 0u; }
    if (tid == 0) st[512] = 0u;
    float sc[2][4][2];
    float scl[2][2]; int bcur[2][2];
#pragma unroll
    for (int rt = 0; rt < 2; ++rt)
#pragma unroll
        for (int u = 0; u < 2; ++u) { scl[rt][u] = 0.f; bcur[rt][u] = 0; }
    SEL_STAGE(0);
#pragma unroll 1
    for (int kt = 0; kt < ntile; ++kt) {
        asm volatile("s_waitcnt vmcnt(0) lgkmcnt(0)" ::: "memory"); __syncthreads();
        if (kt > 0 && (kt & 3) == 0) {
            SEL_BOUNDARY(false);
            asm volatile("s_waitcnt lgkmcnt(0)" ::: "memory"); __syncthreads();
#pragma unroll
            for (int rt = 0; rt < 2; ++rt)
#pragma unroll
                for (int u = 0; u < 2; ++u) bcur[rt][u] = (int)st[128 + 8 * wave + 4 * rt + 2 * c5 + u];
        }
        if (kt + 1 < ntile) SEL_STAGE(kt + 1);
        SEL_SCORES(kt);
        if (kt == 0) {
#pragma unroll
            for (int rt = 0; rt < 2; ++rt)
#pragma unroll
                for (int u = 0; u < 2; ++u) { float mx = 0.f;
#pragma unroll
                    for (int kh = 0; kh < 4; ++kh) mx = fmaxf(mx, fabsf(sc[rt][kh][u]));
#pragma unroll
                    for (int o = 1; o < 32; o <<= 1) mx = fmaxf(mx, __shfl_xor(mx, o));
                    const float R = mx > 0.f ? 2.0f * mx : 1.0f;
                    scl[rt][u] = 128.0f / R;
                    if (kl == 0) stf[8 * wave + 4 * rt + 2 * c5 + u] = scl[rt][u]; }
        }
        const bool masked = 128 * kt + 127 > t0;
#pragma unroll
        for (int rt = 0; rt < 2; ++rt)
#pragma unroll
            for (int u = 0; u < 2; ++u) { const int qq = 8 * wave + 4 * rt + 2 * c5 + u; const int lim = masked ? (t0 + qq - 128 * kt - kl) : 1000;
#pragma unroll
                for (int kh = 0; kh < 4; ++kh) { const float fb = __builtin_amdgcn_fmed3f(fmaf(sc[rt][kh][u], scl[rt][u], 128.0f), 0.f, 255.f);
                    if (fb >= (float)bcur[rt][u] && 32 * kh <= lim) (void)__hip_atomic_fetch_add(hist + qq * 256 + (int)fb, 1u, __ATOMIC_RELAXED, __HIP_MEMORY_SCOPE_WORKGROUP); } }
    }
    asm volatile("s_waitcnt vmcnt(0) lgkmcnt(0)" ::: "memory"); __syncthreads();
    SEL_BOUNDARY(true);
    if (tid < 64) { st[320 + tid] = 0u; st[384 + tid] = 0u; }
    asm volatile("s_waitcnt lgkmcnt(0)" ::: "memory"); __syncthreads();
}
__device__ __forceinline__ void sel_pass2(unsigned char* ws_, LAS unsigned char* lds_, int wave_, int b_, int ub_) {
    SEL_DECLS
    if (st[512] != 0u) return;
    if (tid < 64) { st[320 + tid] = 0u; st[384 + tid] = 0u; }
    SEL_LOAD_A
    float sc[2][4][2];
    float scl[2][2]; int bcur[2][2];
#pragma unroll
    for (int rt = 0; rt < 2; ++rt)
#pragma unroll
        for (int u = 0; u < 2; ++u) { const int qq = 8 * wave + 4 * rt + 2 * c5 + u; scl[rt][u] = stf[qq]; bcur[rt][u] = (int)st[128 + qq]; }
    SEL_STAGE(0);
#pragma unroll 1
    for (int kt = 0; kt < ntile; ++kt) {
        asm volatile("s_waitcnt vmcnt(0) lgkmcnt(0)" ::: "memory"); __syncthreads();
        if (kt + 1 < ntile) SEL_STAGE(kt + 1);
        SEL_SCORES(kt);
        const bool masked = 128 * kt + 127 > t0;
        unsigned slot[2][2][4]; unsigned okm = 0u, abm = 0u;
#pragma unroll
        for (int rt = 0; rt < 2; ++rt)
#pragma unroll
            for (int u = 0; u < 2; ++u) { const int qq = 8 * wave + 4 * rt + 2 * c5 + u; const int lim = masked ? (t0 + qq - 128 * kt - kl) : 1000;
#pragma unroll
                for (int kh = 0; kh < 4; ++kh) { const float fb = __builtin_amdgcn_fmed3f(fmaf(sc[rt][kh][u], scl[rt][u], 128.0f), 0.f, 255.f);
                    const bool ok = fb >= (float)bcur[rt][u] && 32 * kh <= lim; const bool ab = fb >= (float)(bcur[rt][u] + 1);
                    slot[rt][u][kh] = 0u;
                    if (ok) { slot[rt][u][kh] = __hip_atomic_fetch_add(st + (ab ? 320 : 384) + qq, 1u, __ATOMIC_RELAXED, __HIP_MEMORY_SCOPE_WORKGROUP); okm |= 1u << (rt * 8 + u * 4 + kh); if (ab) abm |= 1u << (rt * 8 + u * 4 + kh); } } }
        if (okm != 0u) {
#pragma unroll
            for (int rt = 0; rt < 2; ++rt)
#pragma unroll
                for (int u = 0; u < 2; ++u) { const int qq = 8 * wave + 4 * rt + 2 * c5 + u;
#pragma unroll
                    for (int kh = 0; kh < 4; ++kh) { const int bit = rt * 8 + u * 4 + kh; const unsigned sl = slot[rt][u][kh]; const int kpos = 128 * kt + 32 * kh + kl;
                        if ((okm >> bit) & 1u) {
                            if ((abm >> bit) & 1u) { if (sl < (unsigned)TOPK) lsel[qq * 256 + sl] = (unsigned short)kpos; }
                            else if (sl < (unsigned)SEL_CAP) { lcs[qq * SEL_CAP + sl] = sc[rt][kh][u]; lci[qq * SEL_CAP + sl] = (unsigned short)kpos; } } } }
        }
    }
    asm volatile("s_waitcnt vmcnt(0) lgkmcnt(0)" ::: "memory"); __syncthreads();
}
__device__ __forceinline__ void sel_resolve(unsigned char* ws_, LAS unsigned char* lds_, int wave_, int b_, int ub_, int wg_, int first_) {
    SEL_DECLS
    const int wg = uni_i(wg_), first = uni_i(first_);
    unsigned short* sel = (unsigned short*)(ws + WS_SEL);
    gu32* slowl = (gu32*)(ws + WS_CTL + 65536) + (size_t)wg * 132;
    if (first && tid == 0) __hip_atomic_store(slowl, 0u, RLX_AGENT);
    if (st[512] != 0u) return;
#pragma unroll 1
    for (int qi = 0; qi < 8; ++qi) { const int qq = 8 * wave + qi; const int q = q0 + qq;
        const int na = (int)st[192 + qq], need = TOPK - na; int C = (int)st[384 + qq]; C = C < SEL_CAP ? C : SEL_CAP;
        const bool slow = st[448 + qq] != 0u;
        if (!slow) {
#pragma unroll
            for (int e = 0; e < SEL_CAP / 64; ++e) { const int i = lane + 64 * e;
                if (i < C) { const float si = lcs[qq * SEL_CAP + i]; const int ii = lci[qq * SEL_CAP + i]; int rank = 0;
                    for (int jx = 0; jx < C; ++jx) { const float sj = lcs[qq * SEL_CAP + jx]; const int ij = lci[qq * SEL_CAP + jx]; rank += (sj > si || (sj == si && ij < ii)) ? 1 : 0; }
                    if (rank < need) lsel[qq * 256 + na + rank] = (unsigned short)ii; } }
            LDS_WAIT();
            *(v2u*)(sel + (size_t)q * TOPK + 4 * lane) = *(const LAS v2u*)(lsel + qq * 256 + 4 * lane);
        }
    }
    __syncthreads();
    if (tid == 0) { unsigned n = first ? 0u : __hip_atomic_load(slowl, RLX_AGENT);
        for (int qq = 0; qq < 64; ++qq) if (st[448 + qq] != 0u) { if (n < 128u) { __hip_atomic_store(slowl + 1 + n, (unsigned)(q0 + qq), RLX_AGENT); ++n; } }
        __hip_atomic_store(slowl, n, RLX_AGENT); }
    asm volatile("s_waitcnt vmcnt(0)" ::: "memory");
    __syncthreads();
}
#undef SEL_DECLS
#undef SEL_LOAD_A
#undef SEL_STAGE
#undef SEL_SCORES
#undef SEL_BOUNDARY
__device__ __forceinline__ void dsa_select_slow(unsigned char* ws_, LAS unsigned char* lds_, int wave_, int wg_) {
    LAS unsigned char* const lds = uni_l(lds_); const int wave = uni_i(wave_), wg = uni_i(wg_);
    unsigned char* ws = uni(ws_);
    const bf16* iqf = (const bf16*)(ws + WS_IQF); const unsigned* sgn = (const unsigned*)(ws + WS_SGN); const bf16* ik = (const bf16*)(ws + WS_IK);
    unsigned short* sel = (unsigned short*)(ws + WS_SEL);
    gu32* slowl = (gu32*)(ws + WS_CTL + 65536) + (size_t)wg * 132;
    const int lane = lane_id_v(), tid = wave * 64 + lane; const int kl = lane & 31, c5 = lane >> 5;
    LAS unsigned* keys = (LAS unsigned*)lds;
    LAS unsigned* hist = (LAS unsigned*)(lds + 32768);
    LAS unsigned* ctl = (LAS unsigned*)(lds + 40960);
    const int nq = (int)__builtin_amdgcn_readfirstlane(__hip_atomic_load(slowl, RLX_AGENT));
#pragma unroll 1
    for (int k = 0; k < nq; ++k) {
        const int q = (int)__builtin_amdgcn_readfirstlane(__hip_atomic_load(slowl + 1 + k, RLX_AGENT));
        const int b = q / SEQ, t = q % SEQ, n = t + 1;
        const bf16* ikb = ik + (size_t)b * SEQ * IDIM;
        __syncthreads();
        bf16x8_t af[2]; float sgc[8];
        { const int i = kl, a_ = i >> 3, e_ = i & 3; const int hh_ = 4 * (a_ & 1) + e_; const unsigned m_ = sgn[q];
          const unsigned flip_ = ((m_ >> hh_) & 1u) ? 0x80008000u : 0u;
#pragma unroll
          for (int ks = 0; ks < 2; ++ks) { v4u w_ = *(const v4u*)(iqf + (size_t)q * 256 + hh_ * 32 + 16 * ks + 8 * c5); w_.x ^= flip_; w_.y ^= flip_; w_.z ^= flip_; w_.w ^= flip_; af[ks] = __builtin_bit_cast(bf16x8_t, w_); }
#pragma unroll
          for (int h = 0; h < 8; ++h) sgc[h] = ((m_ >> h) & 1u) ? -__builtin_inff() : __builtin_inff(); }
#pragma unroll 1
        for (int kb = wave; kb * 32 < n; kb += NWAVES) { const int key = 32 * kb + kl;
            const bf16x8_t b0 = *(const bf16x8_t*)(ikb + (size_t)key * IDIM + 8 * c5), b1 = *(const bf16x8_t*)(ikb + (size_t)key * IDIM + 16 + 8 * c5);
            f32x16 acc = {0.f,0.f,0.f,0.f,0.f,0.f,0.f,0.f,0.f,0.f,0.f,0.f,0.f,0.f,0.f,0.f};
            acc = __builtin_amdgcn_mfma_f32_32x32x16_bf16(af[0], b0, acc, 0, 0, 0); acc = __builtin_amdgcn_mfma_f32_32x32x16_bf16(af[1], b1, acc, 0, 0, 0);
            float sc = 0.f;
#pragma unroll
            for (int h = 0; h < 8; ++h) sc += __builtin_amdgcn_fmed3f(acc[h], 0.f, sgc[h]);
            if (c5 == 0) keys[key] = key_of(sc); }
        if (tid == 0) { const unsigned z_ = (unsigned)launder_v(0); ctl[0] = z_; ctl[1] = z_ + (unsigned)TOPK; ctl[2] = z_; ctl[3] = z_; }
        unsigned P = 0u, Plo = 0u;
#pragma unroll 1
        for (int lev = 0; lev < 5; ++lev) {
            for (int i = tid; i < 2048; i += NWAVES * 64) hist[i] = 0u;
            asm volatile("s_waitcnt lgkmcnt(0)" ::: "memory"); __syncthreads();
#pragma unroll 1
            for (int i = 0; i < 16; ++i) { const int s_ = tid * 16 + i;
                if (s_ < n) { const unsigned hi = keys[s_], lo = 8191u - (unsigned)s_; bool mt; unsigned dg;
                    if (lev == 0) { mt = true; dg = hi >> 21; } else if (lev == 1) { mt = (hi >> 21) == P; dg = (hi >> 10) & 0x7ffu; } else if (lev == 2) { mt = (hi >> 10) == P; dg = hi & 0x3ffu; }
                    else if (lev == 3) { mt = hi == P; dg = lo >> 6; } else { mt = hi == P && (lo >> 6) == Plo; dg = lo & 63u; }
                    if (mt) (void)__hip_atomic_fetch_add(hist + dg, 1u, __ATOMIC_RELAXED, __HIP_MEMORY_SCOPE_WORKGROUP); } }
            asm volatile("s_waitcnt lgkmcnt(0)" ::: "memory"); __syncthreads();
            const unsigned need = ctl[1];
            const v4u hb = *(const LAS v4u*)(hist + 4 * tid); const unsigned ls = hb.x + hb.y + hb.z + hb.w;
            unsigned v = ls, tt;
            tt = __shfl_down(v, 1); if (lane + 1 < 64) v += tt;
            tt = __shfl_down(v, 2); if (lane + 2 < 64) v += tt;
            tt = __shfl_down(v, 4); if (lane + 4 < 64) v += tt;
            tt = __shfl_down(v, 8); if (lane + 8 < 64) v += tt;
            tt = __shfl_down(v, 16); if (lane + 16 < 64) v += tt;
            tt = __shfl_down(v, 32); if (lane + 32 < 64) v += tt;
            if (lane == 0) ctl[8 + wave] = v;
            asm volatile("s_waitcnt lgkmcnt(0)" ::: "memory"); __syncthreads();
            unsigned above = v - ls;
            for (int w2 = wave + 1; w2 < NWAVES; ++w2) above += ctl[8 + w2];
            if (above < need && above + ls >= need) { unsigned c = above; const unsigned bb[4] = {hb.x, hb.y, hb.z, hb.w}; int bsel = 0; unsigned cab = 0; bool found = false;
#pragma unroll
                for (int i = 3; i >= 0; --i) { const bool hit = !found && (c + bb[i] >= need); if (hit) { bsel = i; cab = c; found = true; } c += bb[i]; }
                const unsigned dv = (unsigned)(4 * tid + bsel);
                if (lev == 0) ctl[0] = dv; else if (lev == 1) ctl[0] = (P << 11) | dv; else if (lev == 2) ctl[0] = (P << 10) | dv; else if (lev == 3) ctl[3] = dv; else ctl[3] = (Plo << 6) | dv;
                ctl[1] = need - cab; }
            asm volatile("s_waitcnt lgkmcnt(0)" ::: "memory"); __syncthreads();
            P = ctl[0]; Plo = ctl[3];
        }
        unsigned short* srow = sel + (size_t)q * TOPK;
        unsigned mymask = 0u;
#pragma unroll 1
        for (int i = 0; i < 16; ++i) { const int s_ = tid * 16 + i;
            if (s_ < n) { const unsigned hi = keys[s_], lo = 8191u - (unsigned)s_; if (hi > P || (hi == P && lo >= Plo)) mymask |= 1u << i; } }
        const unsigned mycnt = (unsigned)__builtin_popcount(mymask);
        unsigned pv_ = mycnt, tt_;
        tt_ = __shfl_up(pv_, 1); if (lane >= 1) pv_ += tt_;
        tt_ = __shfl_up(pv_, 2); if (lane >= 2) pv_ += tt_;
        tt_ = __shfl_up(pv_, 4); if (lane >= 4) pv_ += tt_;
        tt_ = __shfl_up(pv_, 8); if (lane >= 8) pv_ += tt_;
        tt_ = __shfl_up(pv_, 16); if (lane >= 16) pv_ += tt_;
        tt_ = __shfl_up(pv_, 32); if (lane >= 32) pv_ += tt_;
        if (lane == 63) ctl[16 + wave] = pv_;
        asm volatile("s_waitcnt lgkmcnt(0)" ::: "memory"); __syncthreads();
        unsigned slot0 = pv_ - mycnt;
        for (int w2 = 0; w2 < wave; ++w2) slot0 += ctl[16 + w2];
#pragma unroll 1
        for (int i = 0; i < 16; ++i) if ((mymask >> i) & 1u) { if (slot0 < (unsigned)TOPK) srow[slot0] = (unsigned short)(tid * 16 + i); ++slot0; }
    }
    asm volatile("s_waitcnt vmcnt(0) lgkmcnt(0)" ::: "memory");
    __syncthreads();
}

__device__ __forceinline__ unsigned offb(unsigned row, unsigned ch) { return 256u * row + 16u * (ch ^ (((row & 3u) << 2) | ((row >> 2) & 3u))); }
__device__ __forceinline__ s16x4_t vtr(const LAS unsigned char* p) { return __builtin_bit_cast(s16x4_t, __builtin_amdgcn_ds_read_tr16_b64_v4i16((LAS s16x4_t*)p)); }

__device__ __noinline__ void dsa_attend(unsigned char* ws_, LAS unsigned char* lds_, const float* relb_, int wave_, int vcu_, int G_, int dry_) {
    const int dry = uni_i(dry_);
    LAS unsigned char* const lds = uni_l(lds_); const int wave = uni_i(wave_), vcu = uni_i(vcu_), G = uni_i(G_);
    unsigned char* ws = uni(ws_); const float* relb = uni(relb_);
    const bf16* ckv = (const bf16*)(ws + WS_CKV); bf16* ql = (bf16*)(ws + WS_QL); const unsigned short* sel = (const unsigned short*)(ws + WS_SEL);
    const int lane = lane_id_v(), tid = wave * 64 + lane;
    LAS unsigned char* cb = lds + wave * 16384;
    LAS unsigned short* sidx = (LAS unsigned short*)(lds + 131072 + wave * 512);
    LAS float* biasd = (LAS float*)(lds + 135168);
    for (int i = tid; i < 129 * 8; i += NWAVES * 64) { const int d = i >> 3, h = i & 7; const int bk = d < 128 ? (int)T5_BUCKET[d] : 31; biasd[i] = relb[bk * 8 + h]; }
    __syncthreads();
    const int hl = lane & 15, g = lane >> 4, hq = hl & 7;
    for (int p = vcu; p < BATCH * 64; p += G) {
        const int b = p >> 6, j = p & 63;
#pragma unroll 1
        for (int half = 0; half < 2; ++half) {
            const int ub = half == 0 ? j : 127 - j;
#pragma unroll 1
            for (int qi = 0; qi < 8; ++qi) {
                const int t = ub * 64 + wave * 8 + qi; const int q = b * SEQ + t; const int nsel = (t + 1) < TOPK ? (t + 1) : TOPK;
                const bf16* ckvb = ckv + (size_t)b * SEQ * KVR; bf16* qlrow = ql + (size_t)q * 1024;
                { const v2u w = *(const v2u*)(sel + (size_t)q * TOPK + 4 * lane); *(LAS v2u*)(sidx + 4 * lane) = w; }
                bf16x8_t qf[4];
#pragma unroll
                for (int s = 0; s < 4; ++s) qf[s] = *(const bf16x8_t*)(qlrow + hq * 128 + 32 * s + 8 * g);
                LDS_WAIT();
                float mrun = -1e30f, lsum = 0.f;
                f32x4 O[8];
#pragma unroll
                for (int c = 0; c < 8; ++c) O[c] = (f32x4){0.f, 0.f, 0.f, 0.f};
#define DSA_GATHER(c_) do { LAS unsigned char* dst_ = cb + ((c_) & 1) * 8192; \
                    _Pragma("unroll") for (int k_ = 0; k_ < 8; ++k_) { const int row_ = 4 * k_ + g; const int kidx_ = sidx[32 * (c_) + row_]; \
                        const int ch_ = hl ^ ((g << 2) | (k_ & 3)); \
                        glds16(ckvb + (size_t)kidx_ * KVR + ch_ * 8, (unsigned)__builtin_amdgcn_readfirstlane((int)(unsigned)(size_t)(dst_ + k_ * 1024))); } } while (0)
                DSA_GATHER(0);
#pragma unroll 1
                for (int c = 0; c < 8; ++c) {
                    if (c < 7) { DSA_GATHER(c + 1); asm volatile("s_waitcnt vmcnt(8)" ::: "memory"); }
                    else asm volatile("s_waitcnt vmcnt(0)" ::: "memory");
                    const LAS unsigned char* img = cb + (c & 1) * 8192;
                    f32x4 S[2];
#pragma unroll
                    for (int rb = 0; rb < 2; ++rb) { S[rb] = (f32x4){0.f, 0.f, 0.f, 0.f}; const unsigned row = 8u * (hl >> 2) + 4u * rb + (hl & 3);
#pragma unroll
                        for (int s = 0; s < 4; ++s) { const bf16x8_t af = *(const LAS bf16x8_t*)(img + offb(row, 4 * s + g)); S[rb] = __builtin_amdgcn_mfma_f32_16x16x32_bf16(af, qf[s], S[rb], 0, 0, 0); } }
                    float pv[2][4]; float mx = -1e30f;
#pragma unroll
                    for (int rb = 0; rb < 2; ++rb) { const v2u iw2 = *(const LAS v2u*)(sidx + 32 * c + 8 * g + 4 * rb);
                        const int ki[4] = {(int)(iw2.x & 0xffffu), (int)(iw2.x >> 16), (int)(iw2.y & 0xffffu), (int)(iw2.y >> 16)};
#pragma unroll
                        for (int r = 0; r < 4; ++r) { int dist = t - ki[r]; dist = dist < 0 ? 0 : (dist > 128 ? 128 : dist);
                            float lg = S[rb][r] * 0.125f + biasd[dist * 8 + hq];
                            if (32 * c + 8 * g + 4 * rb + r >= nsel) lg = -1e30f;
                            pv[rb][r] = lg; mx = fmaxf(mx, lg); } }
                    mx = fmaxf(mx, __shfl_xor(mx, 16)); mx = fmaxf(mx, __shfl_xor(mx, 32));
                    const float mnew = fmaxf(mrun, mx); const float alpha = __expf(mrun - mnew); mrun = mnew;
                    float rs = 0.f;
#pragma unroll
                    for (int rb = 0; rb < 2; ++rb)
#pragma unroll
                        for (int r = 0; r < 4; ++r) { pv[rb][r] = __expf(pv[rb][r] - mnew); rs += pv[rb][r]; }
                    rs += __shfl_xor(rs, 16); rs += __shfl_xor(rs, 32);
                    lsum = lsum * alpha + rs;
                    v4u pw; pw.x = pg8::cvt_pk_bf16(pv[0][0], pv[0][1]); pw.y = pg8::cvt_pk_bf16(pv[0][2], pv[0][3]); pw.z = pg8::cvt_pk_bf16(pv[1][0], pv[1][1]); pw.w = pg8::cvt_pk_bf16(pv[1][2], pv[1][3]);
                    const bf16x8_t pf = __builtin_bit_cast(bf16x8_t, pw);
                    float al[4];
#pragma unroll
                    for (int r = 0; r < 4; ++r) al[r] = __shfl(alpha, 4 * g + r);
#pragma unroll
                    for (int cd = 0; cd < 8; ++cd) {
                        f32x4 o = O[cd]; o[0] *= al[0]; o[1] *= al[1]; o[2] *= al[2]; o[3] *= al[3];
                        const unsigned q4 = hl >> 2, p4 = hl & 3;
                        const s16x4_t b0 = vtr(img + offb(8u * g + q4, 2 * cd + (p4 >> 1)) + 8u * (p4 & 1));
                        const s16x4_t b1 = vtr(img + offb(8u * g + 4u + q4, 2 * cd + (p4 >> 1)) + 8u * (p4 & 1));
                        bf16x8_t bf; bf[0] = b0[0]; bf[1] = b0[1]; bf[2] = b0[2]; bf[3] = b0[3]; bf[4] = b1[0]; bf[5] = b1[1]; bf[6] = b1[2]; bf[7] = b1[3];
                        O[cd] = __builtin_amdgcn_mfma_f32_16x16x32_bf16(pf, bf, o, 0, 0, 0);
                    }
                }
#undef DSA_GATHER
                const float linv = 1.0f / lsum; float li[4];
#pragma unroll
                for (int r = 0; r < 4; ++r) li[r] = __shfl(linv, 4 * g + r);
                LAS unsigned short* ost = (LAS unsigned short*)cb;
                if (g < 2) {
#pragma unroll
                    for (int cd = 0; cd < 8; ++cd)
#pragma unroll
                        for (int r = 0; r < 4; ++r) ost[(4 * g + r) * 128 + 16 * cd + hl] = (unsigned short)f2bf(O[cd][r] * li[r]);
                }
                LDS_WAIT();
                { const v4u w0 = *(const LAS v4u*)(cb + 32 * lane), w1 = *(const LAS v4u*)(cb + 32 * lane + 16);
                  if (!dry) { *(v4u*)(qlrow + 16 * lane) = w0; *(v4u*)(qlrow + 16 * lane + 8) = w1; } else asm volatile("" :: "v"(w0), "v"(w1)); }
                LDS_WAIT();
            }
        }
    }
    __syncthreads();
}

__device__ __noinline__ void final_norm(const float* const* in_, float* out_, unsigned char* ws_, LAS unsigned char* lds_, int wave_, int vcu_, int G_) {
    const PC F{uni(in_), uni(out_), uni(ws_), uni_l(lds_), uni_i(wave_), uni_i(vcu_), uni_i(G_)}; struct { const float* const* in; float* out; } a{F.in, F.out};
    const int lane_ = lane_id_v(); const int gw = F.vcu * NWAVES + F.wave, NGW = F.G * NWAVES; const float* g = a.in[22];
    f32x4 gv[4];
#pragma unroll
    for (int j = 0; j < 4; ++j) gv[j] = ((const f32x4*)g)[lane_ + 64 * j];
    for (int m = gw; m < M; m += NGW) {
        GAS f32x4* xr = (GAS f32x4*)(a.out + (size_t)m * D) + lane_;
        f32x4 v[4]; float s = 0.f;
#pragma unroll
        for (int j = 0; j < 4; ++j) { v[j] = xr[64 * j]; s += (v[j].x * v[j].x + v[j].y * v[j].y) + (v[j].z * v[j].z + v[j].w * v[j].w); }
        const float rs = 1.0f / sqrtf(wave_sum(s) * (1.0f / D) + EPS);
#pragma unroll
        for (int j = 0; j < 4; ++j) xr[64 * j] = v[j] * rs * gv[j];
    }
}

#define KIN ((const float* const*)__builtin_amdgcn_kernarg_segment_ptr())
constexpr int PH_PER_LAYER = 10, PH_LAYER0 = 2, N_PHASES = PH_LAYER0 + PH_PER_LAYER * DEPTH + 1;

__global__ void __launch_bounds__(NWAVES * 64, 2) mk_fwd(Args args) {
    extern __shared__ __attribute__((aligned(16))) unsigned char lds[];
    Frame F;
    F.lds = (LAS unsigned char*)lds;
    F.MISC = (volatile LAS unsigned*)(F.lds + MISC_OFF);
    F.wave = __builtin_amdgcn_readfirstlane((int)threadIdx.x >> 6);
    F.G = gridDim.x; { const int bx = blockIdx.x; F.vcu = (F.G % 8 == 0) ? (bx % 8) * (F.G / 8) + bx / 8 : bx; }
    F.ws = args.ws; F.ctl = (gu32*)(args.ws + WS_CTL);
    if (threadIdx.x < 64) ((LAS unsigned*)(F.lds + MISC_OFF))[threadIdx.x] = 0u;
    __syncthreads();
    const int lo = args.ph_lo, hi = args.ph_hi;
    const bool multi = (hi - lo) > 1;
    XcdBarrier bar; bar.bar = (unsigned*)(F.ctl + CW_BAR); bar.x = 0; bar.st = nullptr; bar.wave = F.wave;
    if (multi) bar = xcd_barrier_post((unsigned*)(F.ctl + CW_BAR), F.MISC + 8, F.wave);
#define IN(k) (lo <= (k) && (k) < hi)
#define SEAM(k) do { if (IN(k) && IN((k) + 1)) xcd_barrier(bar); } while (0)

    if (IN(0)) {
#if EN_P0
 for (int rep = (PROBE_PHASE == 1 ? 0 : 1); rep < 2; ++rep) p0_prologue(KIN, args.out, args.ws, F.lds, F.wave, F.vcu, F.G);
#endif
 } SEAM(0);
    if (IN(1)) {
#if !((DIS_MASK >> 7) & 1)
 unsigned char* ws = launder_p(args.ws); bf16* hb = (bf16*)(ws + WS_HB); float* ss = (float*)(ws + WS_SS); (void)hb; (void)ss;
        pg8::Gemm g{(const bf16_t*)(ws + WS_MEMN), (const bf16_t*)(ws + WS_WMEM), MROWS, DEPTH * 2 * CW, D}; pg8::StaticOrder S; S.init(MROWS, DEPTH * 2 * CW, F.G, launder_s((int)blockIdx.x));
        EpiPlainBf16 E{(bf16_t*)(ws + WS_MEMKV), DEPTH * 2 * CW};
        pg8::gemm_phase<EpiPlainBf16, pg8::StaticOrder, true, true>(F.lds + RING_OFF, g, S, E, F.wave);
        { pg8::Gemm g2{(const bf16_t*)(ws + WS_WMEM), (const bf16_t*)(ws + WS_MEMN), DEPTH * 2 * CW, MROWS, D}; pg8::StaticOrder S2; S2.init(DEPTH * 2 * CW, MROWS, F.G, launder_s((int)blockIdx.x));
          EpiPlainBf16 E2{(bf16_t*)(ws + WS_VT), MROWS};
          pg8::gemm_phase<EpiPlainBf16, pg8::StaticOrder, true, true>(F.lds + RING_OFF, g2, S2, E2, F.wave); }
#endif
    } SEAM(1);

    for (int l = 0; l < DEPTH; ++l) {
        const int pb = PH_LAYER0 + PH_PER_LAYER * l;
        const float* hbase = (l == 0) ? args.in[0] : args.out;
        if (IN(pb + 0)) {
#if EN_P0
 if (l > 0) for (int rep = (PROBE_PHASE == 1 ? 0 : 1); rep < 2; ++rep) prep_layer_weights(KIN, args.out, args.ws, F.lds, l, F.wave, F.vcu, F.G);
#endif
 } SEAM(pb + 0);
        if (IN(pb + 1)) {
#if !((DIS_MASK >> 0) & 1)
 unsigned char* ws = launder_p(args.ws); bf16* hb = (bf16*)(ws + WS_HB); float* ss = (float*)(ws + WS_SS); (void)hb; (void)ss;
            pg8::Gemm g{hb, (const bf16_t*)(ws + WS_W1IN), M, 2 * DFF, D}; pg8::StaticOrder S; S.init(M, 2 * DFF, F.G, launder_s((int)blockIdx.x));
            EpiSwiglu E{(bf16_t*)(ws + WS_ACT), ss};
            for (int rep = (PROBE_PHASE == 2 ? 0 : 1); rep < 2; ++rep) pg8::gemm_phase<EpiSwiglu, pg8::StaticOrder, true, true>(F.lds + RING_OFF, g, S, E, F.wave);
#endif
        } SEAM(pb + 1);
        if (IN(pb + 2)) {
#if !((DIS_MASK >> 1) & 1)
 unsigned char* ws = launder_p(args.ws); bf16* hb = (bf16*)(ws + WS_HB); float* ss = (float*)(ws + WS_SS); (void)hb; (void)ss;
            pg8::Gemm g{(const bf16_t*)(ws + WS_ACT), (const bf16_t*)(ws + WS_W1OUT), M, D, DFF}; pg8::StaticOrder S; S.init(M, D, F.G, launder_s((int)blockIdx.x));
            for (int rep = (PROBE_PHASE == 3 ? 0 : 1); rep < 2; ++rep) { EpiResid E{hbase, args.out, hb, ss, 0.5f, (LAS float*)(F.lds + RING_BYTES), rep == 0 ? 1 : 0};
            pg8::gemm_phase<EpiResid, pg8::StaticOrder, true, true>(F.lds + RING_OFF, g, S, E, F.wave); }
#endif
        } SEAM(pb + 2);
        if (IN(pb + 3)) {
#if !((DIS_MASK >> 2) & 1)
 unsigned char* ws = launder_p(args.ws); bf16* hb = (bf16*)(ws + WS_HB); float* ss = (float*)(ws + WS_SS); (void)hb; (void)ss;
            pg8::Gemm g{hb, (const bf16_t*)(ws + WS_WIN), M, INP, D}; pg8::StaticOrder S; S.init(M, INP, F.G, launder_s((int)blockIdx.x));
            EpiInProj E{ss, (bf16_t*)(ws + WS_QL), (float*)(ws + WS_CKVRAW), (bf16_t*)(ws + WS_IK), (float*)(ws + WS_IW), (bf16_t*)(ws + WS_IQRAW), (bf16_t*)(ws + WS_Z), (bf16_t*)(ws + WS_QC), (bf16_t*)(ws + WS_G)};
            for (int rep = (PROBE_PHASE == 4 ? 0 : 1); rep < 2; ++rep) pg8::gemm_phase<EpiInProj, pg8::StaticOrder, true, true>(F.lds + RING_OFF, g, S, E, F.wave);
#endif
        } SEAM(pb + 3);
        if (IN(pb + 4)) {
#if EN_PREP
 for (int rep = (PROBE_PHASE == 5 ? 0 : 1); rep < 2; ++rep) prep_tokens(KIN, args.out, args.ws, F.lds, l, F.wave, F.vcu, F.G, rep == 0 ? 1 : 0);
#endif
 } SEAM(pb + 4);
        if (IN(pb + 5)) {
#if EN_DSA
 for (int rep = (PROBE_PHASE == 6 ? 0 : 1); rep < 2; ++rep) for (int p = F.vcu; p < BATCH * 64; p += F.G) { for (int half = 0; half < 2; ++half) { const int b_ = p >> 6, ub_ = half == 0 ? (p & 63) : 127 - (p & 63);
   sel_pass1(args.ws, F.lds, F.wave, b_, ub_); if (PROBE_PHASE == 61) sel_pass1(args.ws, F.lds, F.wave, b_, ub_); sel_pass2(args.ws, F.lds, F.wave, b_, ub_); if (PROBE_PHASE == 62) sel_pass2(args.ws, F.lds, F.wave, b_, ub_); sel_resolve(args.ws, F.lds, F.wave, b_, ub_, (int)blockIdx.x, (p == F.vcu && half == 0) ? 1 : 0); if (PROBE_PHASE == 63) sel_resolve(args.ws, F.lds, F.wave, b_, ub_, (int)blockIdx.x, 0); } }
 dsa_select_slow(args.ws, F.lds, F.wave, (int)blockIdx.x); for (int rep = (PROBE_PHASE == 7 ? 0 : 1); rep < 2; ++rep) dsa_attend(args.ws, F.lds, args.in[2], F.wave, F.vcu, F.G, rep == 0 ? 1 : 0);
#endif
 } SEAM(pb + 5);
        if (IN(pb + 6)) {
#if !((DIS_MASK >> 3) & 1)
        for (int rep6 = (PROBE_PHASE == 8 ? 0 : 1); rep6 < 2; ++rep6) {
 unsigned char* ws = launder_p(args.ws); bf16* hb = (bf16*)(ws + WS_HB); float* ss = (float*)(ws + WS_SS); (void)hb; (void)ss;
            { pg8::Gemm g{(const bf16_t*)(ws + WS_QL), (const bf16_t*)(ws + WS_WA), M, D, 1024}; pg8::StaticOrder S; S.init(M, D, F.G, launder_s((int)blockIdx.x));
              EpiMerge<0> E{(bf16_t*)(ws + WS_MERGED), (const bf16_t*)(ws + WS_G)};
              pg8::gemm_phase<EpiMerge<0>, pg8::StaticOrder, true, true>(F.lds + RING_OFF, g, S, E, F.wave); }
            { pg8::Gemm g{(const bf16_t*)(ws + WS_YB), (const bf16_t*)(ws + WS_WB), M, D, PW_}; pg8::StaticOrder S; S.init(M, D, F.G, launder_s((int)blockIdx.x));
              EpiMerge<1> E{(bf16_t*)(ws + WS_MERGED), (const bf16_t*)(ws + WS_G)};
              pg8::gemm_phase<EpiMerge<1>, pg8::StaticOrder, true, true>(F.lds + RING_OFF, g, S, E, F.wave); }
            { pg8::Gemm g{(const bf16_t*)(ws + WS_QC), (const bf16_t*)(ws + WS_WC), M, D, CW}; pg8::StaticOrder S; S.init(M, D, F.G, launder_s((int)blockIdx.x));
              EpiMerge<2> E{(bf16_t*)(ws + WS_MERGED), (const bf16_t*)(ws + WS_G)};
              pg8::gemm_phase<EpiMerge<2>, pg8::StaticOrder, true, true>(F.lds + RING_OFF, g, S, E, F.wave); }
        }
#endif
        } SEAM(pb + 6);
        if (IN(pb + 7)) {
#if !((DIS_MASK >> 4) & 1)
 unsigned char* ws = launder_p(args.ws); bf16* hb = (bf16*)(ws + WS_HB); float* ss = (float*)(ws + WS_SS); (void)hb; (void)ss;
            pg8::Gemm g{(const bf16_t*)(ws + WS_MERGED), (const bf16_t*)(ws + WS_WOUT), M, D, D}; pg8::StaticOrder S; S.init(M, D, F.G, launder_s((int)blockIdx.x));
            for (int rep = (PROBE_PHASE == 9 ? 0 : 1); rep < 2; ++rep) { EpiResid E{args.out, args.out, hb, ss, 1.0f, (LAS float*)(F.lds + RING_BYTES), rep == 0 ? 1 : 0};
            pg8::gemm_phase<EpiResid, pg8::StaticOrder, true, true>(F.lds + RING_OFF, g, S, E, F.wave); }
#endif
        } SEAM(pb + 7);
        if (IN(pb + 8)) {
#if !((DIS_MASK >> 5) & 1)
 unsigned char* ws = launder_p(args.ws); bf16* hb = (bf16*)(ws + WS_HB); float* ss = (float*)(ws + WS_SS); (void)hb; (void)ss;
            pg8::Gemm g{hb, (const bf16_t*)(ws + WS_W2IN), M, 2 * DFF, D}; pg8::StaticOrder S; S.init(M, 2 * DFF, F.G, launder_s((int)blockIdx.x));
            EpiSwiglu E{(bf16_t*)(ws + WS_ACT), ss};
            for (int rep = (PROBE_PHASE == 2 ? 0 : 1); rep < 2; ++rep) pg8::gemm_phase<EpiSwiglu, pg8::StaticOrder, true, true>(F.lds + RING_OFF, g, S, E, F.wave);
#endif
        } SEAM(pb + 8);
        if (IN(pb + 9)) {
#if !((DIS_MASK >> 6) & 1)
 unsigned char* ws = launder_p(args.ws); bf16* hb = (bf16*)(ws + WS_HB); float* ss = (float*)(ws + WS_SS); (void)hb; (void)ss;
            pg8::Gemm g{(const bf16_t*)(ws + WS_ACT), (const bf16_t*)(ws + WS_W2OUT), M, D, DFF}; pg8::StaticOrder S; S.init(M, D, F.G, launder_s((int)blockIdx.x));
            for (int rep = (PROBE_PHASE == 3 ? 0 : 1); rep < 2; ++rep) { EpiResid E{args.out, args.out, hb, ss, 0.5f, (LAS float*)(F.lds + RING_BYTES), rep == 0 ? 1 : 0};
            pg8::gemm_phase<EpiResid, pg8::StaticOrder, true, true>(F.lds + RING_OFF, g, S, E, F.wave); }
#endif
        } SEAM(pb + 9);
    }
#if EN_P0
    if (IN(N_PHASES - 1)) { final_norm(KIN, args.out, args.ws, F.lds, F.wave, F.vcu, F.G); }
#endif
#undef IN
#undef SEAM
}

extern "C" void kernel_launch(void* const* d_in, const int* in_sizes, int n_in, void* d_out, int out_size, void* d_ws, size_t ws_size, hipStream_t stream) {
    static int grid = 0;
    if (grid == 0) {
        if (n_in != 23 || in_sizes[0] != M * D || out_size != M * D || ws_size < WS_END) { fprintf(stderr, "kernel_launch: unexpected shapes (n_in %d, ws %zu)\n", n_in, ws_size); grid = -1; return; }
        int dev = 0, cus = 0, per_cu = 0;
        if (hipGetDevice(&dev) != hipSuccess || hipDeviceGetAttribute(&cus, hipDeviceAttributeMultiprocessorCount, dev) != hipSuccess) { grid = -1; return; }
        if (hipFuncSetAttribute((const void*)mk_fwd, hipFuncAttributeMaxDynamicSharedMemorySize, LDS_BYTES) != hipSuccess) { fprintf(stderr, "kernel_launch: hipFuncSetAttribute failed\n"); grid = -1; return; }
        if (hipOccupancyMaxActiveBlocksPerMultiprocessor(&per_cu, (const void*)mk_fwd, NWAVES * 64, LDS_BYTES) != hipSuccess || per_cu < 1) { fprintf(stderr, "kernel_launch: occupancy query says %d\n", per_cu); }
        (void)hipGetLastError();
        grid = cus;
    }
    if (grid < 0) return;
    if (hipMemsetAsync((char*)d_ws + WS_CTL, 0, CTL_ZERO_BYTES, stream) != hipSuccess) return;
    Args a{};
    for (int i = 0; i < 23; ++i) a.in[i] = (const float*)d_in[i];
    a.out = (float*)d_out; a.ws = (unsigned char*)d_ws;
#if MK_ONE_LAUNCH
    a.ph_lo = 0; a.ph_hi = N_PHASES;
    hipLaunchKernelGGL(mk_fwd, dim3(grid), dim3(NWAVES * 64), LDS_BYTES, stream, a);
#endif
}
```

```cpp
#include <hip/hip_runtime.h>
#include <cstdio>
#include <cstdint>

#ifndef MK_ONE_LAUNCH
#define MK_ONE_LAUNCH 1
#endif
#ifndef PROBE_PHASE
#define PROBE_PHASE 0
#endif
#ifndef EN_P0
#define EN_P0 MK_ONE_LAUNCH
#endif
#ifndef EN_PREP
#define EN_PREP MK_ONE_LAUNCH
#endif
#ifndef EN_DSA
#define EN_DSA MK_ONE_LAUNCH
#endif
#ifndef DIS_MASK
#define DIS_MASK 0
#endif
#ifndef MK_ONE_LAUNCH
#define MK_ONE_LAUNCH 1
#endif

__device__ __forceinline__ int lane_id_v() { int l; asm volatile("v_mbcnt_lo_u32_b32 %0, -1, 0\n\tv_mbcnt_hi_u32_b32 %0, -1, %0" : "=v"(l)); return l; }
namespace pg8 {
#define PG8_LAS __attribute__((address_space(3)))
typedef unsigned short bf16_t;
typedef short bf16x8 __attribute__((ext_vector_type(8)));
typedef float f32x4 __attribute__((ext_vector_type(4)));
typedef unsigned u32x4 __attribute__((ext_vector_type(4)));
typedef unsigned u32x2 __attribute__((ext_vector_type(2)));
constexpr int BM = 256, BK = 64, HALF = 128, HTB = HALF * BK * 2, STAGE_BYTES = 8 * HTB, NXCD = 8, WGM = 8;

__host__ __device__ __forceinline__ int lds_byte(int r, int c) { const int st = (r >> 4) * 2 + (c >> 5), rr = r & 15, cc = c & 31, ob = rr * 64 + cc * 2; return st * 1024 + (ob ^ (((ob >> 9) & 1) << 5)); }
__host__ __device__ __forceinline__ void stage_rc(int b, int& R, int& C) { const int st = b / 1024, sb = b % 1024, swz = sb ^ (((sb >> 9) & 1) << 5); R = (st >> 1) * 16 + swz / 64; C = (st & 1) * 32 + (swz % 64) / 2; }
__host__ __device__ __forceinline__ int perm32(int rho) { const int n = rho >> 4, i = rho & 15; return 8 * (i >> 2) + 4 * n + (i & 3); }

struct Unit { int pm, pn; };
struct Gemm { const bf16_t* A; const bf16_t* Bt; int M, N, K; };

struct StaticOrder {
    int nM, nN, nwg, G, c;
    __host__ __device__ void init(int M, int N, int G_, int c_) { nM = M / BM; nN = N / BM; nwg = nM * nN; G = G_; c = c_; }
    __host__ __device__ bool next(int i, Unit& u) const {
        const long L = (long)i * G + c; if (L >= nwg) return false;
        int wgid = (int)L; { const int q = nwg / NXCD, r = nwg % NXCD, xcd = wgid % NXCD, off = wgid / NXCD; wgid = (xcd < r ? xcd * (q + 1) : r * (q + 1) + (xcd - r) * q) + off; }
        const int nig = WGM * nN, gid = wgid / nig, fm = gid * WGM, gsz = (nM - fm) < WGM ? (nM - fm) : WGM;
        u.pm = fm + ((wgid % nig) % gsz); u.pn = (wgid % nig) / gsz; return true;
    }
    __device__ __forceinline__ void a_ready(const Unit&) const {}
    __device__ __forceinline__ void done(const Unit&) const {}
};

__device__ __forceinline__ unsigned cvt_pk_bf16(float lo, float hi) { unsigned r; asm volatile("v_cvt_pk_bf16_f32 %0, %1, %2" : "=v"(r) : "v"(lo), "v"(hi)); return r; }

template <class Epi, class Sched, bool ALIGN_EPI = false, bool SP2 = false>
__device__ __forceinline__ void gemm_phase(PG8_LAS unsigned char* lds, const Gemm g, const Sched& S, const Epi& E, const int wid_) {
    int wid = wid_; asm volatile("" : "+s"(wid));
    const int lane = lane_id_v(), tid = wid * 64 + lane,
              wr = wid >> 2, wc = wid & 3, fr = lane & 15, fq = lane >> 4;
    const int K = g.K, nt = K / BK;
    unsigned voffA[2], voffB[2];
#pragma unroll
    for (int i = 0; i < 2; ++i) { int R, C; stage_rc(tid * 16 + i * 8192, R, C); const int Rb = Epi::PERM ? ((R & ~31) + perm32(R & 31)) : R;
        voffA[i] = (unsigned)(R * K + C) * 2u; voffB[i] = (unsigned)(Rb * K + C) * 2u; }
    const size_t kstep = (size_t)(BK * 2);
    const size_t hstep = (size_t)HALF * K * 2;
    const size_t tstep = 2 * hstep;
    const unsigned ldsw = (unsigned)wid * 1024u;
    const int aoff = lds_byte(wr * 64 + fr, fq * 8), boff = lds_byte(wc * 32 + fr, fq * 8);
#define PG8_SA(b, h) (((b) * 2 + (h)) * HTB)
#define PG8_SB(b, h) ((4 + (b) * 2 + (h)) * HTB)
#define PG8_STAGE(bufoff, gbase, voff) do { _Pragma("unroll") for (int _i = 0; _i < 2; ++_i) \
        __builtin_amdgcn_global_load_lds((const unsigned*)((const char*)(gbase) + (voff)[_i]), (PG8_LAS unsigned*)(lds + (bufoff) + ldsw + _i * 8192), 16, 0, 0); } while (0)
#define PG8_LDA(dst, b, h) do { _Pragma("unroll") for (int m = 0; m < 4; ++m) _Pragma("unroll") for (int k = 0; k < 2; ++k) dst[m][k] = *(const PG8_LAS bf16x8*)(lds + PG8_SA(b, h) + aoff + m * 2048 + k * 1024); } while (0)
#define PG8_LDB(dst, b, h) do { _Pragma("unroll") for (int n = 0; n < 2; ++n) _Pragma("unroll") for (int k = 0; k < 2; ++k) dst[n][k] = *(const PG8_LAS bf16x8*)(lds + PG8_SB(b, h) + boff + n * 2048 + k * 1024); } while (0)
#define PG8_MMA(ai, bj, At, Bt) do { __builtin_amdgcn_s_setprio(1); _Pragma("unroll") for (int m = 0; m < 4; ++m) _Pragma("unroll") for (int n = 0; n < 2; ++n) _Pragma("unroll") for (int k = 0; k < 2; ++k) \
        acc[ai][bj][m][n] = __builtin_amdgcn_mfma_f32_16x16x32_bf16(Bt[n][k], At[m][k], acc[ai][bj][m][n], 0, 0, 0); __builtin_amdgcn_s_setprio(0); } while (0)
#define PG8_WAIT_V(n) asm volatile("s_waitcnt vmcnt(" #n ")" ::: "memory")
#define PG8_WAIT_L(n) asm volatile("s_waitcnt lgkmcnt(" #n ")" ::: "memory")
#define PG8_BAR __builtin_amdgcn_s_barrier()
#define PG8_SCHED __builtin_amdgcn_sched_barrier(0)
    Unit cur, nxt; int ui = 0;
    if (!S.next(0, cur)) return;
    f32x4 acc[2][2][4][2];
#pragma unroll
    for (int a = 0; a < 2; ++a)
#pragma unroll
        for (int b = 0; b < 2; ++b)
#pragma unroll
            for (int m = 0; m < 4; ++m)
#pragma unroll
                for (int n = 0; n < 2; ++n) acc[a][b][m][n] = (f32x4){0.f, 0.f, 0.f, 0.f};
    bf16x8 At[4][2], B0[2][2], B1[2][2];
    const char* cA = (const char*)g.A + (size_t)cur.pm * tstep; const char* cB = (const char*)g.Bt + (size_t)cur.pn * tstep;
    S.a_ready(cur);
    if constexpr (SP2) {
        PG8_STAGE(PG8_SB(0, 0), cB, voffB); PG8_STAGE(PG8_SB(0, 1), cB + hstep, voffB); PG8_STAGE(PG8_SA(0, 0), cA, voffA); PG8_STAGE(PG8_SA(0, 1), cA + hstep, voffA);
        if (wr == 1) PG8_BAR;
        PG8_WAIT_V(2); PG8_BAR;
        PG8_STAGE(PG8_SB(1, 0), cB + kstep, voffB); PG8_STAGE(PG8_SA(1, 0), cA + kstep, voffA); PG8_STAGE(PG8_SB(1, 1), cB + hstep + kstep, voffB);
        PG8_WAIT_V(6); PG8_BAR;
    } else {
        PG8_STAGE(PG8_SB(0, 0), cB, voffB); PG8_STAGE(PG8_SA(0, 0), cA, voffA); PG8_STAGE(PG8_SB(0, 1), cB + hstep, voffB); PG8_STAGE(PG8_SA(0, 1), cA + hstep, voffA);
        if (wr == 1) PG8_BAR;
        PG8_WAIT_V(4); PG8_BAR;
        PG8_STAGE(PG8_SB(1, 0), cB + kstep, voffB); PG8_STAGE(PG8_SA(1, 0), cA + kstep, voffA); PG8_STAGE(PG8_SB(1, 1), cB + hstep + kstep, voffB);
        PG8_WAIT_V(6); PG8_BAR;
    }
    for (;;) {
        const bool has_next = S.next(ui + 1, nxt);
        const char* nA = has_next ? (const char*)g.A + (size_t)nxt.pm * tstep : cA; const char* nB = has_next ? (const char*)g.Bt + (size_t)nxt.pn * tstep : cB;
        for (int t = 0; t < nt; t += 2) {
            const bool last = (t == nt - 2);
            const char* a1 = cA + (size_t)(t + 1) * kstep;
            const char* a2 = last ? nA : cA + (size_t)(t + 2) * kstep; const char* b2 = last ? nB : cB + (size_t)(t + 2) * kstep;
            const char* a3 = a2 + kstep; const char* b3 = b2 + kstep;
            if (last && has_next) S.a_ready(nxt);
            if constexpr (SP2) {
            PG8_LDB(B0, 0, 0); PG8_LDB(B1, 0, 1); PG8_SCHED; PG8_LDA(At, 0, 0); PG8_STAGE(PG8_SA(1, 1), a1 + hstep, voffA);
            PG8_WAIT_V(8); PG8_WAIT_L(0); PG8_BAR; PG8_MMA(0, 0, At, B0); PG8_MMA(0, 1, At, B1); PG8_BAR; PG8_SCHED;
            PG8_LDA(At, 0, 1); PG8_STAGE(PG8_SB(0, 0), b2, voffB); PG8_STAGE(PG8_SB(0, 1), b2 + hstep, voffB); PG8_STAGE(PG8_SA(0, 0), a2, voffA);
            PG8_WAIT_V(8); PG8_WAIT_L(0); PG8_BAR; PG8_MMA(1, 0, At, B0); PG8_MMA(1, 1, At, B1); PG8_BAR; PG8_SCHED;
            PG8_LDB(B0, 1, 0); PG8_LDB(B1, 1, 1); PG8_SCHED; PG8_LDA(At, 1, 0); PG8_STAGE(PG8_SA(0, 1), a2 + hstep, voffA);
            PG8_WAIT_V(8); PG8_WAIT_L(0); PG8_BAR; PG8_MMA(0, 0, At, B0); PG8_MMA(0, 1, At, B1); PG8_BAR; PG8_SCHED;
            PG8_LDA(At, 1, 1); PG8_STAGE(PG8_SB(1, 0), b3, voffB); PG8_STAGE(PG8_SB(1, 1), b3 + hstep, voffB); PG8_STAGE(PG8_SA(1, 0), a3, voffA);
            PG8_WAIT_V(8); PG8_WAIT_L(0); PG8_BAR; PG8_MMA(1, 0, At, B0); PG8_MMA(1, 1, At, B1); PG8_BAR; PG8_SCHED;
            } else {
            PG8_LDB(B0, 0, 0); PG8_SCHED; PG8_LDA(At, 0, 0); PG8_STAGE(PG8_SA(1, 1), a1 + hstep, voffA);
            PG8_WAIT_L(8); PG8_BAR; PG8_WAIT_L(0); PG8_MMA(0, 0, At, B0); PG8_BAR; PG8_SCHED;
            PG8_LDB(B1, 0, 1); PG8_STAGE(PG8_SB(0, 0), b2, voffB);
            PG8_BAR; PG8_WAIT_L(0); PG8_MMA(0, 1, At, B1); PG8_BAR;
            PG8_LDA(At, 0, 1); PG8_STAGE(PG8_SA(0, 0), a2, voffA);
            PG8_BAR; PG8_WAIT_L(0); PG8_MMA(1, 0, At, B0); PG8_BAR; PG8_SCHED;
            PG8_STAGE(PG8_SB(0, 1), b2 + hstep, voffB);
            PG8_WAIT_V(6); PG8_BAR; PG8_MMA(1, 1, At, B1); PG8_BAR;
            PG8_LDB(B0, 1, 0); PG8_SCHED; PG8_LDA(At, 1, 0); PG8_STAGE(PG8_SA(0, 1), a2 + hstep, voffA);
            PG8_WAIT_L(8); PG8_BAR; PG8_WAIT_L(0); PG8_MMA(0, 0, At, B0); PG8_BAR; PG8_SCHED;
            PG8_LDB(B1, 1, 1); PG8_STAGE(PG8_SB(1, 0), b3, voffB);
            PG8_BAR; PG8_WAIT_L(0); PG8_MMA(0, 1, At, B1); PG8_BAR;
            PG8_LDA(At, 1, 1); PG8_STAGE(PG8_SA(1, 0), a3, voffA);
            PG8_BAR; PG8_WAIT_L(0); PG8_MMA(1, 0, At, B0); PG8_BAR; PG8_SCHED;
            PG8_STAGE(PG8_SB(1, 1), b3 + hstep, voffB);
            PG8_WAIT_V(6); PG8_BAR; PG8_MMA(1, 1, At, B1); PG8_BAR;
            }
        }
        if constexpr (ALIGN_EPI) { if (wr == 0) PG8_BAR; }
        E(acc, cur, wr, wc, fr, fq); S.done(cur);
        if (!has_next) break;
#pragma unroll
        for (int a = 0; a < 2; ++a)
#pragma unroll
            for (int b = 0; b < 2; ++b)
#pragma unroll
                for (int m = 0; m < 4; ++m)
#pragma unroll
                    for (int n = 0; n < 2; ++n) acc[a][b][m][n] = (f32x4){0.f, 0.f, 0.f, 0.f};
        cur = nxt; cA = nA; cB = nB; ++ui;
        if constexpr (ALIGN_EPI) { if (wr == 1) PG8_BAR; }
    }
    PG8_WAIT_V(0);
    if constexpr (!ALIGN_EPI) { if (wr == 0) PG8_BAR; }
    PG8_BAR;
#undef PG8_SA
#undef PG8_SB
#undef PG8_STAGE
#undef PG8_LDA
#undef PG8_LDB
#undef PG8_MMA
#undef PG8_WAIT_V
#undef PG8_WAIT_L
#undef PG8_BAR
#undef PG8_SCHED
}
}

constexpr int NWAVES = 8;
constexpr int BATCH = 4, SEQ = 8192, D = 1024, DEPTH = 4, M = BATCH * SEQ;
constexpr int NMEM = 256, MROWS = BATCH * NMEM;
constexpr int AH = 8, AHD = 64, AW = 512, KVR = 128, IH = 8, IDIM = 32, TOPK = 256;
constexpr int PW_ = 256, CH = 4, CHD = 64, CW = 256;
constexpr int DFF = 2816, INW = 4520, INP = 5120;
constexpr float EPS = 1e-6f;
constexpr int C_QA = 0, C_CKV = 512, C_IQ = 640, C_IK = 896, C_IW = 928, C_Z = 936, C_QC = 1192, C_G = 1448;

constexpr size_t MiB = 1u << 20;
constexpr size_t WS_CTL = 0, CTL_ZERO_BYTES = 1 * MiB;
constexpr size_t WS_SS = 1 * MiB;
constexpr size_t WS_IW = 3 * MiB;
constexpr size_t WS_SGN = 4 * MiB;
constexpr size_t WS_MEMN = 5 * MiB;
constexpr size_t WS_WMEM = 7 * MiB;
constexpr size_t WS_MEMKV = 11 * MiB;
constexpr size_t WS_W1IN = 15 * MiB, WS_W1OUT = 26 * MiB, WS_WIN = 32 * MiB, WS_WA = 42 * MiB, WS_WB = 44 * MiB, WS_WC = 44 * MiB + 512 * 1024, WS_WOUT = 45 * MiB, WS_W2IN = 47 * MiB, WS_W2OUT = 58 * MiB;
constexpr size_t WS_HB = 64 * MiB;
constexpr size_t WS_ACT = 128 * MiB;
constexpr size_t WS_G = 128 * MiB;
constexpr size_t WS_QL = 320 * MiB;
constexpr size_t WS_CKV = 384 * MiB;
constexpr size_t WS_CKVRAW = 392 * MiB;
constexpr size_t WS_IQRAW = 408 * MiB;
constexpr size_t WS_IQF = 424 * MiB;
constexpr size_t WS_IK = 440 * MiB;
constexpr size_t WS_Z = 442 * MiB;
constexpr size_t WS_MERGED = 384 * MiB;
constexpr size_t WS_YB = 458 * MiB;
constexpr size_t WS_QC = 474 * MiB;
constexpr size_t WS_SEL = 490 * MiB;
constexpr size_t WS_VT = 506 * MiB;
constexpr size_t WS_WPT = 4 * MiB + 512 * 1024;
constexpr size_t WS_END = 510 * MiB;
constexpr int CW_BAR = 4096;

constexpr int RING_OFF = 0, RING_BYTES = 131072;
constexpr int LDS_BYTES = 155648;
constexpr int MISC_OFF = LDS_BYTES - 256;

#define GAS __attribute__((address_space(1)))
#define LAS __attribute__((address_space(3)))
typedef unsigned short bf16;
typedef unsigned v4u __attribute__((ext_vector_type(4)));
typedef unsigned v2u __attribute__((ext_vector_type(2)));
typedef float f32x4 __attribute__((ext_vector_type(4)));
typedef float f32x2 __attribute__((ext_vector_type(2)));
typedef GAS unsigned gu32;
#define RLX_AGENT __ATOMIC_RELAXED, __HIP_MEMORY_SCOPE_AGENT
#define LDS_WAIT() asm volatile("s_waitcnt lgkmcnt(0)" ::: "memory")
#define VM_WAIT() asm volatile("s_waitcnt vmcnt(0)" ::: "memory")
__device__ __forceinline__ unsigned f2bf(float f) { unsigned u = __builtin_bit_cast(unsigned, f); return (u + 0x7fffu + ((u >> 16) & 1u)) >> 16; }
__device__ __forceinline__ unsigned pk2(float lo, float hi) { return f2bf(lo) | (f2bf(hi) << 16); }
__device__ __forceinline__ float bflo(unsigned w) { return __builtin_bit_cast(float, w << 16); }
__device__ __forceinline__ float bfhi(unsigned w) { return __builtin_bit_cast(float, w & 0xffff0000u); }
typedef _Float16 h2_t __attribute__((ext_vector_type(2)));
typedef _Float16 f16x8_t __attribute__((ext_vector_type(8)));
__device__ __forceinline__ unsigned pkh2(float lo, float hi) { const h2_t v = {(_Float16)lo, (_Float16)hi}; return __builtin_bit_cast(unsigned, v); }
__device__ __forceinline__ float hlo(unsigned w) { return (float)__builtin_bit_cast(h2_t, w)[0]; }
__device__ __forceinline__ float hhi(unsigned w) { return (float)__builtin_bit_cast(h2_t, w)[1]; }
__device__ __forceinline__ float bf2f(bf16 b) { return __builtin_bit_cast(float, ((unsigned)b) << 16); }

#define XB_TMO      128
#define XB_XCNT(j)  (256  + 64 * (j))
#define XB_XSUB(j)  (1280 + 64 * (j))
#define XB_XGEN(j)  (2304 + 64 * (j))
#define XB_TOP      3328
#define XB_TOPGEN   3392
#define XCD_BAR_WORDS 3456
#define XB_SPIN_CAP (1u << 23)

__device__ __forceinline__ unsigned xb_ld(unsigned* p)              { return __hip_atomic_load(p, __ATOMIC_RELAXED, __HIP_MEMORY_SCOPE_AGENT); }
__device__ __forceinline__ unsigned xb_add(unsigned* p, unsigned v) { return __hip_atomic_fetch_add(p, v, __ATOMIC_RELAXED, __HIP_MEMORY_SCOPE_AGENT); }
__device__ __forceinline__ unsigned xb_xcc_id() { return (unsigned)__builtin_amdgcn_s_getreg((3 << 11) | 20) & 0xFu; }
#define XB_SPIN(cond, bar) do { unsigned _sp = 0; while (cond) { __builtin_amdgcn_s_sleep(1); \
    if ((++_sp & 255u) == 0u) { if (xb_ld(&(bar)[XB_TMO])) break; if (_sp > XB_SPIN_CAP) { atomicAdd(&(bar)[XB_TMO], 1u); break; } } } } while (0)

struct XcdBarrier { unsigned* bar; unsigned x; volatile LAS unsigned* st; int wave; };

__device__ __forceinline__ XcdBarrier xcd_barrier_post(unsigned* bar, volatile LAS unsigned* st, int wave) {
    XcdBarrier b; b.bar = bar; b.x = xb_xcc_id(); b.st = st; b.wave = wave;
    if (threadIdx.x == 0) (void)xb_add(&bar[XB_XCNT(b.x)], 1u);
    return b;
}
__device__ __forceinline__ void xcd_barrier_complete(unsigned* bar, unsigned x, unsigned& nloc, unsigned& nx) {
    const unsigned G = gridDim.x * gridDim.y * gridDim.z;
    unsigned sum, cnt, mine, sp = 0u;
    for (;;) {
        sum = 0u; cnt = 0u; mine = 0u;
#pragma unroll
        for (unsigned j = 0; j < 16; ++j) { const unsigned c = xb_ld(&bar[XB_XCNT(j)]); sum += c; cnt += (c > 0u) ? 1u : 0u; mine = (j == x) ? c : mine; }
        if (sum == G) break;
        __builtin_amdgcn_s_sleep(1);
        if ((++sp & 255u) == 0u) { if (xb_ld(&bar[XB_TMO])) break; if (sp > XB_SPIN_CAP) { atomicAdd(&bar[XB_TMO], 1u); break; } }
    }
    nloc = mine > 0u ? mine : 1u; nx = cnt > 0u ? cnt : 1u;
}
__device__ __forceinline__ void xcd_barrier(const XcdBarrier& b) {
    asm volatile("s_waitcnt vmcnt(0)" ::: "memory");
    __syncthreads();
    int bw_ = b.wave; asm volatile("" : "+s"(bw_));
    if (bw_ == 0 && lane_id_v() == 0) {
        unsigned* bar = b.bar;
        __builtin_amdgcn_s_waitcnt(0);
        unsigned nloc = b.st[0], nx = b.st[1];
        if (nloc == 0u) { xcd_barrier_complete(bar, b.x, nloc, nx); b.st[0] = nloc; b.st[1] = nx; }
        const unsigned old = xb_add(&bar[XB_XSUB(b.x)], 1u);
        const unsigned gen = old / nloc;
        if (old + 1u == (gen + 1u) * nloc) {
            __builtin_amdgcn_fence(__ATOMIC_RELEASE, "agent");
            asm volatile("s_waitcnt vmcnt(0)" ::: "memory");
            const unsigned og = xb_add(&bar[XB_TOP], 1u);
            const unsigned tg = og / nx;
            if (og + 1u == (tg + 1u) * nx) xb_add(&bar[XB_TOPGEN], 1u);
            else XB_SPIN(xb_ld(&bar[XB_TOPGEN]) == tg, bar);
            __builtin_amdgcn_fence(__ATOMIC_ACQUIRE, "agent");
            xb_add(&bar[XB_XGEN(b.x)], 1u);
            asm volatile("s_waitcnt vmcnt(0)" ::: "memory");
        } else {
            XB_SPIN(xb_ld(&bar[XB_XGEN(b.x)]) == gen, bar);
            __builtin_amdgcn_fence(__ATOMIC_ACQUIRE, "agent");
            asm volatile("s_waitcnt vmcnt(0)" ::: "memory");
        }
    }
    __syncthreads();
}

struct Args {
    const float* in[23]; float* out; unsigned char* ws; int ph_lo, ph_hi;
};
template <class T> __device__ __forceinline__ T* uni(T* p) { const unsigned long long v = (unsigned long long)p; const unsigned lo = __builtin_amdgcn_readfirstlane((unsigned)v), hi = __builtin_amdgcn_readfirstlane((unsigned)(v >> 32)); return (T*)(((unsigned long long)hi << 32) | lo); }
__device__ __forceinline__ LAS unsigned char* uni_l(LAS unsigned char* p) { return (LAS unsigned char*)(unsigned)__builtin_amdgcn_readfirstlane((int)(unsigned)(size_t)p); }
__device__ __forceinline__ int uni_i(int v) { return __builtin_amdgcn_readfirstlane(v); }
struct PC { const float* const* in; float* out; unsigned char* ws; LAS unsigned char* lds; int wave, vcu, G; };
struct Frame {
    LAS unsigned char* lds;
    volatile LAS unsigned* MISC;
    gu32* ctl;
    int wave, vcu, G;
    unsigned char* ws;
};
__device__ __forceinline__ unsigned char* launder_p(unsigned char* p) { asm volatile("" : "+s"(p)); return p; }
__device__ __forceinline__ int launder_s(int v) { asm volatile("" : "+s"(v)); return v; }
__device__ __forceinline__ int launder_v(int v) { asm volatile("" : "+v"(v)); return v; }
__device__ __forceinline__ float wave_sum(float v) {
#pragma unroll
    for (int o = 1; o < 64; o <<= 1) v += __shfl_xor(v, o);
    return v;
}
__device__ __forceinline__ float wave_max(float v) {
#pragma unroll
    for (int o = 1; o < 64; o <<= 1) v = fmaxf(v, __shfl_xor(v, o));
    return v;
}

using pg8::Unit; using pg8::bf16_t;
#define LAUNDER2(a, b) asm volatile("" : "+v"(a), "+v"(b))
__device__ __forceinline__ float row_scale(const float* ss, int row) {
    const f32x4 a = *(const f32x4*)(ss + (size_t)row * 4);
    const float s = (a.x + a.y) + (a.z + a.w);
    return __builtin_amdgcn_rsqf(s * (1.0f / D) + EPS);
}
__device__ __forceinline__ float sigmoidf_(float x) { return 1.0f / (1.0f + __expf(-x)); }
__device__ __forceinline__ pg8::u32x2 pack4(const f32x4 v) { pg8::u32x2 w; w.x = pg8::cvt_pk_bf16(v[0], v[1]); w.y = pg8::cvt_pk_bf16(v[2], v[3]); return w; }

struct EpiSwiglu {
    static constexpr bool PERM = true;
    bf16_t* O; const float* ss;
    __device__ __forceinline__ void operator()(const f32x4 (&acc)[2][2][4][2], const Unit& u, int wr, int wc, int fr_, int fq_) const {
        const int l_ = lane_id_v(); const int fr = l_ & 15, fq = l_ >> 4; (void)fr_; (void)fq_;
        int rb = wr * 64 + fr, cb = wc * 32 + 8 * fq; LAUNDER2(rb, cb);
        const int row0 = u.pm * 256 + rb, col0 = u.pn * 128 + cb;
#pragma unroll
        for (int ai = 0; ai < 2; ++ai)
#pragma unroll
            for (int m = 0; m < 4; ++m) { const int row = row0 + ai * 128 + m * 16; const float s = row_scale(ss, row);
                pg8::u32x4 w;
                { const f32x4 a = acc[ai][0][m][0] * s, b = acc[ai][1][m][0] * s; f32x4 o;
#pragma unroll
                  for (int i = 0; i < 4; ++i) o[i] = a[i] * sigmoidf_(a[i]) * b[i];
                  w.x = pg8::cvt_pk_bf16(o[0], o[1]); w.y = pg8::cvt_pk_bf16(o[2], o[3]); }
                { const f32x4 a = acc[ai][0][m][1] * s, b = acc[ai][1][m][1] * s; f32x4 o;
#pragma unroll
                  for (int i = 0; i < 4; ++i) o[i] = a[i] * sigmoidf_(a[i]) * b[i];
                  w.z = pg8::cvt_pk_bf16(o[0], o[1]); w.w = pg8::cvt_pk_bf16(o[2], o[3]); }
                *(pg8::u32x4*)(O + (size_t)row * DFF + col0) = w; }
    }
};
struct EpiResid {
    static constexpr bool PERM = false;
    const float* base; float* out; bf16_t* hb; float* ss; float alpha; LAS float* P; int dry;
    __device__ __forceinline__ void operator()(const f32x4 (&acc)[2][2][4][2], const Unit& u, int wr, int wc, int fr_, int fq_) const {
        const int l_ = lane_id_v(); const int fr = l_ & 15, fq = l_ >> 4; (void)fr_; (void)fq_;
        int rb = wr * 64 + fr, cb = wc * 32 + 4 * fq; LAUNDER2(rb, cb);
        const int row0 = u.pm * 256 + rb, col0 = u.pn * 256 + cb;
#pragma unroll
        for (int ai = 0; ai < 2; ++ai)
#pragma unroll
            for (int m = 0; m < 4; ++m) { const int row = row0 + ai * 128 + m * 16; const size_t off = (size_t)row * D + col0; float q = 0.f;
#pragma unroll
                for (int bj = 0; bj < 2; ++bj)
#pragma unroll
                    for (int n = 0; n < 2; ++n) { const f32x4 bs = *(const f32x4*)(base + off + bj * 128 + n * 16); const f32x4 v = bs + acc[ai][bj][m][n] * alpha;
                        if (!dry) { *(f32x4*)(out + off + bj * 128 + n * 16) = v;
                        *(pg8::u32x2*)(hb + off + bj * 128 + n * 16) = pack4(v); }
                        q += (v[0] * v[0] + v[1] * v[1]) + (v[2] * v[2] + v[3] * v[3]); }
                q += __shfl_xor(q, 16); q += __shfl_xor(q, 32);
                if (fq == 0) P[(rb + ai * 128 + m * 16) * 4 + wc] = q;
                asm volatile("" ::: "memory"); }
        asm volatile("s_waitcnt lgkmcnt(0)" ::: "memory"); __builtin_amdgcn_s_barrier(); asm volatile("" ::: "memory");
        const int tid = (wr * 4 + wc) * 64 + fq * 16 + fr;
        if (tid < 256 && !dry) { const f32x4 p = *(const LAS f32x4*)(P + tid * 4); ss[(size_t)(u.pm * 256 + tid) * 4 + u.pn] = (p.x + p.y) + (p.z + p.w); }
    }
};
struct EpiPlainBf16 {
    static constexpr bool PERM = false;
    bf16_t* O; int ldo;
    __device__ __forceinline__ void operator()(const f32x4 (&acc)[2][2][4][2], const Unit& u, int wr, int wc, int fr_, int fq_) const {
        const int l_ = lane_id_v(); const int fr = l_ & 15, fq = l_ >> 4; (void)fr_; (void)fq_;
        int rb = wr * 64 + fr, cb = wc * 32 + 4 * fq; LAUNDER2(rb, cb);
        const int row0 = u.pm * 256 + rb, col0 = u.pn * 256 + cb;
#pragma unroll
        for (int ai = 0; ai < 2; ++ai)
#pragma unroll
            for (int m = 0; m < 4; ++m) { bf16_t* rowp = O + (size_t)(row0 + ai * 128 + m * 16) * ldo + col0;
#pragma unroll
                for (int bj = 0; bj < 2; ++bj)
#pragma unroll
                    for (int n = 0; n < 2; ++n) *(pg8::u32x2*)(rowp + bj * 128 + n * 16) = pack4(acc[ai][bj][m][n]); }
    }
};
struct EpiInProj {
    static constexpr bool PERM = true;
    const float* ss; bf16_t* qa; float* ckvraw; bf16_t* ik; float* iw; bf16_t* iqraw; bf16_t* z; bf16_t* qc; bf16_t* G;
    __device__ __forceinline__ void operator()(const f32x4 (&acc)[2][2][4][2], const Unit& u, int wr, int wc, int fr_, int fq_) const {
        const int l_ = lane_id_v(); const int fr = l_ & 15, fq = l_ >> 4; (void)fr_; (void)fq_;
        int rb = wr * 64 + fr, ct = wc * 32 + 8 * fq; LAUNDER2(rb, ct);
        const int row0 = u.pm * 256 + rb; const int pn = u.pn;
        if (pn == 4) {
#pragma unroll
            for (int ai = 0; ai < 2; ++ai)
#pragma unroll
                for (int m = 0; m < 4; ++m) { const int row = row0 + ai * 128 + m * 16; const float s = row_scale(ss, row);
#pragma unroll
                    for (int n = 0; n < 2; ++n) *(f32x4*)(ckvraw + (size_t)row * KVR + ct + n * 4) = acc[ai][0][m][n] * s;
                    if (wc == 0) { const f32x4 k0 = acc[ai][1][m][0] * s, k1 = acc[ai][1][m][1] * s; pg8::u32x4 w; w.x = pkh2(k0[0], k0[1]); w.y = pkh2(k0[2], k0[3]); w.z = pkh2(k1[0], k1[1]); w.w = pkh2(k1[2], k1[3]);
                        *(pg8::u32x4*)(ik + (size_t)row * IDIM + 8 * fq) = w; }
                    if (wc == 1 && fq == 0) { *(f32x4*)(iw + (size_t)row * IH) = acc[ai][1][m][0] * s; *(f32x4*)(iw + (size_t)row * IH + 4) = acc[ai][1][m][1] * s; } }
        } else {
            bf16_t* dst0; int ld; bool sig = false; const bool f16out = (pn == 5);
            if (pn < 4) { dst0 = qa + pn * 256; ld = 1024; } else if (pn == 5) { dst0 = iqraw; ld = 256; } else if (pn == 6) { dst0 = z; ld = 256; } else if (pn == 7) { dst0 = qc; ld = 256; } else { dst0 = G + (pn - 8) * 256; ld = 3072; sig = true; }
#pragma unroll
            for (int ai = 0; ai < 2; ++ai)
#pragma unroll
                for (int m = 0; m < 4; ++m) { const int row = row0 + ai * 128 + m * 16; const float s = row_scale(ss, row); bf16_t* rowp = dst0 + (size_t)row * ld + ct;
#pragma unroll
                    for (int bj = 0; bj < 2; ++bj) { f32x4 o0 = acc[ai][bj][m][0] * s, o1 = acc[ai][bj][m][1] * s;
                        if (sig) {
#pragma unroll
                            for (int i = 0; i < 4; ++i) { o0[i] = sigmoidf_(o0[i]); o1[i] = sigmoidf_(o1[i]); } }
                        pg8::u32x4 wo;
                        if (f16out) { wo.x = pkh2(o0[0], o0[1]); wo.y = pkh2(o0[2], o0[3]); wo.z = pkh2(o1[0], o1[1]); wo.w = pkh2(o1[2], o1[3]); }
                        else { wo.x = pg8::cvt_pk_bf16(o0[0], o0[1]); wo.y = pg8::cvt_pk_bf16(o0[2], o0[3]); wo.z = pg8::cvt_pk_bf16(o1[0], o1[1]); wo.w = pg8::cvt_pk_bf16(o1[2], o1[3]); }
                        *(pg8::u32x4*)(rowp + bj * 128) = wo; } }
        }
    }
};
template <int MODE> struct EpiMerge {
    static constexpr bool PERM = false;
    bf16_t* Mg; const bf16_t* G;
    __device__ __forceinline__ void operator()(const f32x4 (&acc)[2][2][4][2], const Unit& u, int wr, int wc, int fr_, int fq_) const {
        const int l_ = lane_id_v(); const int fr = l_ & 15, fq = l_ >> 4; (void)fr_; (void)fq_;
        int rb = wr * 64 + fr, cb = wc * 32 + 4 * fq; LAUNDER2(rb, cb);
        const int row0 = u.pm * 256 + rb, col0 = u.pn * 256 + cb;
#pragma unroll
        for (int ai = 0; ai < 2; ++ai)
#pragma unroll
            for (int m = 0; m < 4; ++m) { const int row = row0 + ai * 128 + m * 16;
                const bf16_t* gp = G + (size_t)row * 3072 + MODE * 1024 + col0; bf16_t* mp = Mg + (size_t)row * D + col0;
#pragma unroll
                for (int bj = 0; bj < 2; ++bj)
#pragma unroll
                    for (int n = 0; n < 2; ++n) { const int co = bj * 128 + n * 16;
                        const pg8::u32x2 gw = *(const pg8::u32x2*)(gp + co);
                        f32x4 o = acc[ai][bj][m][n]; o[0] *= bflo(gw.x); o[1] *= bfhi(gw.x); o[2] *= bflo(gw.y); o[3] *= bfhi(gw.y);
                        if (MODE > 0) { const pg8::u32x2 pw = *(const pg8::u32x2*)(mp + co); o[0] += bflo(pw.x); o[1] += bfhi(pw.x); o[2] += bflo(pw.y); o[3] += bfhi(pw.y); }
                        *(pg8::u32x2*)(mp + co) = pack4(o); }
                asm volatile("" ::: "memory"); }
    }
};

template <class Map>
__device__ __forceinline__ void transpose_item(const float* W, int K, int N, const float* gain, bf16* WT, LAS float* scr, int item, int lane, Map map) {
    const int nblk = (N + 31) / 32, kb = item / nblk, nb = item % nblk, k0 = 64 * kb, n0 = 32 * nb;
    const int nn = n0 + (lane & 31); const bool nok = nn < N;
#pragma unroll 4
    for (int i = 0; i < 32; ++i) { const int kk = 2 * i + (lane >> 5); float v = nok ? W[(size_t)(k0 + kk) * N + nn] : 0.f; if (gain) v *= gain[k0 + kk]; scr[kk * 33 + (lane & 31)] = v; }
    LDS_WAIT(); asm volatile("" ::: "memory");
    const int c = lane & 7;
#pragma unroll
    for (int j = 0; j < 4; ++j) { const int n = (lane >> 3) + 8 * j; const LAS float* s = scr + (8 * c) * 33 + n;
        v4u o; o.x = pk2(s[0 * 33], s[1 * 33]); o.y = pk2(s[2 * 33], s[3 * 33]); o.z = pk2(s[4 * 33], s[5 * 33]); o.w = pk2(s[6 * 33], s[7 * 33]);
        if (n0 + n < N) { const int dr = map(n0 + n); if (dr >= 0) *(GAS v4u*)(WT + (size_t)dr * K + k0 + 8 * c) = o; } }
    LDS_WAIT(); asm volatile("" ::: "memory");
}
struct MapId { int off; __device__ __forceinline__ int operator()(int n) const { return off + n; } };
struct MapSwiglu { __device__ __forceinline__ int operator()(int c) const { const int half = c >= DFF ? 1 : 0, j = c - half * DFF; return 256 * (j >> 7) + 128 * half + (j & 127); } };
struct MapInProj { __device__ __forceinline__ int operator()(int c) const {
    if (c < C_CKV) return -1;
    if (c < C_IQ) return 1024 + (c - C_CKV);
    if (c < C_IK) return 1280 + (c - C_IQ);
    if (c < C_IW) return 1152 + (c - C_IK);
    if (c < C_Z) return 1184 + (c - C_IW);
    if (c < C_QC) return 1536 + (c - C_Z);
    if (c < C_G) return 1792 + (c - C_QC);
    return 2048 + (c - C_G); } };
__device__ __forceinline__ void qlat_item(const float* win, const float* mixn, const float* wuk, bf16* WT, int item, int lane) {
    const int kc = item & 127, rh = (item >> 7) & 1, h = item >> 8; const int r = rh * 64 + lane;
    const f32x4* wp = (const f32x4*)(wuk + (size_t)r * (AH * AHD) + h * 64);
    float acc[8] = {0.f, 0.f, 0.f, 0.f, 0.f, 0.f, 0.f, 0.f};
#pragma unroll 1
    for (int dc = 0; dc < 4; ++dc) {
        const f32x4 w0 = wp[4 * dc], w1 = wp[4 * dc + 1], w2 = wp[4 * dc + 2], w3 = wp[4 * dc + 3];
#pragma unroll
        for (int kk = 0; kk < 8; ++kk) { const f32x4* ip = (const f32x4*)(win + (size_t)(kc * 8 + kk) * INW + h * 64 + 16 * dc);
            const f32x4 a0 = ip[0], a1 = ip[1], a2 = ip[2], a3 = ip[3];
            acc[kk] += (a0.x * w0.x + a0.y * w0.y + a0.z * w0.z + a0.w * w0.w) + (a1.x * w1.x + a1.y * w1.y + a1.z * w1.z + a1.w * w1.w)
                     + (a2.x * w2.x + a2.y * w2.y + a2.z * w2.z + a2.w * w2.w) + (a3.x * w3.x + a3.y * w3.y + a3.z * w3.z + a3.w * w3.w);
            if (kk & 1) asm volatile("" ::: "memory"); }
    }
    const f32x4 g0 = *(const f32x4*)(mixn + kc * 8), g1 = *(const f32x4*)(mixn + kc * 8 + 4);
    v4u w; w.x = pk2(acc[0] * g0.x, acc[1] * g0.y); w.y = pk2(acc[2] * g0.z, acc[3] * g0.w); w.z = pk2(acc[4] * g1.x, acc[5] * g1.y); w.w = pk2(acc[6] * g1.z, acc[7] * g1.w);
    *(GAS v4u*)(WT + (size_t)(h * 128 + r) * D + kc * 8) = w;
}
__device__ __forceinline__ void wafold_item(const float* wuv, const float* wba, bf16* WT, int item, int lane) {
    const int ng = item & 15, rg = (item >> 4) & 15, h = item >> 8; const int n = ng * 64 + lane, r0 = rg * 8;
    float acc[8] = {0.f, 0.f, 0.f, 0.f, 0.f, 0.f, 0.f, 0.f};
#pragma unroll 4
    for (int d = 0; d < 64; ++d) { const float wa = wba[(size_t)(h * 64 + d) * D + n];
#pragma unroll
        for (int j = 0; j < 8; ++j) acc[j] += wuv[(size_t)(r0 + j) * (AH * AHD) + h * 64 + d] * wa; }
    v4u w; w.x = pk2(acc[0], acc[1]); w.y = pk2(acc[2], acc[3]); w.z = pk2(acc[4], acc[5]); w.w = pk2(acc[6], acc[7]);
    *(GAS v4u*)(WT + (size_t)n * 1024 + h * 128 + r0) = w;
}
__device__ __forceinline__ int items_of(int K, int N) { return (K / 64) * ((N + 31) / 32); }

__device__ __forceinline__ void prep_layer_weights_body(const PC& F, int l) {
    struct { const float* const* in; } a{F.in};
    const int lane_ = lane_id_v();
    LAS float* scr = (LAS float*)(F.lds + RING_OFF + F.wave * 16384);
    const int gw = F.vcu * NWAVES + F.wave, NGW = F.G * NWAVES;
    const float* f1n = a.in[3] + (size_t)l * D; const float* f1in = a.in[4] + (size_t)l * D * 2 * DFF; const float* f1out = a.in[5] + (size_t)l * DFF * D;
    const float* mixn = a.in[6] + (size_t)l * D; const float* win = a.in[7] + (size_t)l * D * INW;
    const float* wba = a.in[15] + (size_t)l * AW * D; const float* wbb = a.in[16] + (size_t)l * PW_ * D; const float* wbc = a.in[17] + (size_t)l * CW * D;
    const float* wout = a.in[18] + (size_t)l * D * D;
    const float* f2n = a.in[19] + (size_t)l * D; const float* f2in = a.in[20] + (size_t)l * D * 2 * DFF; const float* f2out = a.in[21] + (size_t)l * DFF * D;
    unsigned char* ws = launder_p(F.ws);
    const float* wuk = a.in[9] + (size_t)l * KVR * AH * AHD; const float* wuv = a.in[10] + (size_t)l * KVR * AH * AHD;
    const int I0 = items_of(D, 2 * DFF), I1 = items_of(DFF, D), I2 = items_of(D, INW), I4 = items_of(PW_, D), I5 = items_of(CW, D), I6 = items_of(D, D);
    const int NIT = 2 * I0 + 2 * I1 + I2 + I4 + I5 + I6;
#pragma unroll 1
    for (int it = gw; it < NIT; it += NGW) {
        int r = it;
        if (r < I0) { transpose_item(f1in, D, 2 * DFF, f1n, (bf16*)(ws + WS_W1IN), scr, r, lane_, MapSwiglu{}); continue; } r -= I0;
        if (r < I0) { transpose_item(f2in, D, 2 * DFF, f2n, (bf16*)(ws + WS_W2IN), scr, r, lane_, MapSwiglu{}); continue; } r -= I0;
        if (r < I1) { transpose_item(f1out, DFF, D, nullptr, (bf16*)(ws + WS_W1OUT), scr, r, lane_, MapId{0}); continue; } r -= I1;
        if (r < I1) { transpose_item(f2out, DFF, D, nullptr, (bf16*)(ws + WS_W2OUT), scr, r, lane_, MapId{0}); continue; } r -= I1;
        if (r < I2) { transpose_item(win, D, INW, mixn, (bf16*)(ws + WS_WIN), scr, r, lane_, MapInProj{}); continue; } r -= I2;
        if (r < I4) { transpose_item(wbb, PW_, D, nullptr, (bf16*)(ws + WS_WB), scr, r, lane_, MapId{0}); continue; } r -= I4;
        if (r < I5) { transpose_item(wbc, CW, D, nullptr, (bf16*)(ws + WS_WC), scr, r, lane_, MapId{0}); continue; } r -= I5;
        transpose_item(wout, D, D, nullptr, (bf16*)(ws + WS_WOUT), scr, r, lane_, MapId{0});
    }
    { const float* wpool = a.in[11] + (size_t)l * 4 * 64 * 64; bf16* wpT = (bf16*)(ws + WS_WPT);
      for (int i = gw * 64 + lane_; i < 4 * 64 * 64; i += NGW * 64) { const int c = i & 63, d = (i >> 6) & 63, g = i >> 12; wpT[i] = (bf16)f2bf(wpool[(g * 64 + c) * 64 + d]); } }
    asm volatile("" ::: "memory");
#pragma unroll 1
    for (int it = gw; it < 2048; it += NGW) wafold_item(wuv, wba, (bf16*)(ws + WS_WA), it, lane_);
    asm volatile("" ::: "memory");
#pragma unroll 1
    for (int it = gw; it < 2048; it += NGW) qlat_item(win, mixn, wuk, (bf16*)(ws + WS_WIN), it, lane_);
}

__device__ __noinline__ void p0_prologue(const float* const* in_, float* out_, unsigned char* ws_, LAS unsigned char* lds_, int wave_, int vcu_, int G_) {
    const PC F{uni(in_), uni(out_), uni(ws_), uni_l(lds_), uni_i(wave_), uni_i(vcu_), uni_i(G_)}; struct { const float* const* in; } a{F.in};
    const int lane_ = lane_id_v();
    const int gw = F.vcu * NWAVES + F.wave, NGW = F.G * NWAVES;
    const float* x = a.in[0]; const float* mem = a.in[1];
    bf16* hb = (bf16*)(F.ws + WS_HB); float* ss = (float*)(F.ws + WS_SS); bf16* memn = (bf16*)(F.ws + WS_MEMN);
    for (int m = gw; m < M + MROWS; m += NGW) {
        const bool ismem = m >= M; const int r = ismem ? m - M : m;
        const GAS f32x4* xr = (const GAS f32x4*)((ismem ? mem : x) + (size_t)r * D) + lane_;
        f32x4 v[4]; float s = 0.f;
#pragma unroll
        for (int j = 0; j < 4; ++j) { v[j] = xr[64 * j]; s += (v[j].x * v[j].x + v[j].y * v[j].y) + (v[j].z * v[j].z + v[j].w * v[j].w); }
        s = wave_sum(s);
        float sc = 1.f;
        if (ismem) sc = 1.0f / sqrtf(s * (1.0f / D) + EPS);
        else if (lane_ < 4) ss[(size_t)r * 4 + lane_] = lane_ == 0 ? s : 0.f;
        GAS unsigned long long* o8 = (GAS unsigned long long*)((ismem ? memn : hb) + (size_t)r * D) + lane_;
#pragma unroll
        for (int j = 0; j < 4; ++j) o8[64 * j] = (unsigned long long)pk2(v[j].x * sc, v[j].y * sc) | ((unsigned long long)pk2(v[j].z * sc, v[j].w * sc) << 32);
    }
    LAS float* scr = (LAS float*)(F.lds + RING_OFF + F.wave * 16384);
    const int IM = items_of(D, 2 * CW);
    for (int it = gw; it < DEPTH * IM; it += NGW) { const int l = it / IM, r = it % IM;
        transpose_item(a.in[14] + (size_t)l * D * 2 * CW, D, 2 * CW, a.in[13] + (size_t)l * D, (bf16*)(F.ws + WS_WMEM), scr, r, lane_, MapId{l * 2 * CW}); }
    prep_layer_weights_body(F, 0);
}
__device__ __noinline__ void prep_layer_weights(const float* const* in_, float* out_, unsigned char* ws_, LAS unsigned char* lds_, int l, int wave_, int vcu_, int G_) {
    const PC F{uni(in_), uni(out_), uni(ws_), uni_l(lds_), uni_i(wave_), uni_i(vcu_), uni_i(G_)}; prep_layer_weights_body(F, uni_i(l));
}

__constant__ unsigned char T5_BUCKET[128] = {0, 1, 2, 3, 4, 5, 6, 7, 8, 9, 10, 11, 12, 13, 14, 15, 16, 16, 16, 17, 17, 18, 18, 18, 19, 19, 19, 20, 20, 20, 20, 21, 21, 21, 21, 22, 22, 22, 22, 22, 23, 23, 23, 23, 23, 23, 24, 24, 24, 24, 24, 24, 25, 25, 25, 25, 25, 25, 25, 26, 26, 26, 26, 26, 26, 26, 26, 27, 27, 27, 27, 27, 27, 27, 27, 27, 27, 28, 28, 28, 28, 28, 28, 28, 28, 28, 28, 29, 29, 29, 29, 29, 29, 29, 29, 29, 29, 29, 29, 30, 30, 30, 30, 30, 30, 30, 30, 30, 30, 30, 30, 30, 30, 31, 31, 31, 31, 31, 31, 31, 31, 31, 31, 31, 31, 31, 31, 31};

typedef short bf16x8_p __attribute__((ext_vector_type(8)));
__device__ __forceinline__ void prep_tokens(const float* const* in_, float* out_, unsigned char* ws_, LAS unsigned char* lds_, int l_, int wave_, int vcu_, int G_, int dry_) {
    const int dry = uni_i(dry_);
    const PC F{uni(in_), uni(out_), uni(ws_), uni_l(lds_), uni_i(wave_), uni_i(vcu_), uni_i(G_)}; struct { const float* const* in; } a{F.in}; const int l = uni_i(l_);
    unsigned char* ws = launder_p(F.ws);
    const float* ckvraw = (const float*)(ws + WS_CKVRAW); bf16* ckv = (bf16*)(ws + WS_CKV);
    const bf16* iqraw = (const bf16*)(ws + WS_IQRAW); bf16* iqf = (bf16*)(ws + WS_IQF); const float* iw = (const float*)(ws + WS_IW); unsigned* sgn = (unsigned*)(ws + WS_SGN);
    const bf16* z = (const bf16*)(ws + WS_Z); bf16* yb = (bf16*)(ws + WS_YB); bf16* qc = (bf16*)(ws + WS_QC);
    const bf16* memkv = (const bf16*)(ws + WS_MEMKV); const bf16* vT = (const bf16*)(ws + WS_VT); const bf16* wpT = (const bf16*)(ws + WS_WPT);
    const float* kvn = a.in[8] + (size_t)l * KVR; const float* pscale = a.in[12] + (size_t)l * PW_;
    const int lane = lane_id_v(), tid = F.wave * 64 + lane;
    const int tok = lane & 15, g4 = lane >> 4;
    LAS unsigned char* Ks = F.lds;
    LAS unsigned char* Vs = F.lds + 36864;
    for (int blk = F.vcu; blk < M / 128; blk += F.G) {
        const int rowb = blk * 128, b = rowb / SEQ, row0 = rowb + F.wave * 16;
#pragma unroll 1
        for (int tt = 0; tt < 16; ++tt) { const int row = row0 + tt;
            { const f32x2 v = *(const f32x2*)(ckvraw + (size_t)row * KVR + 2 * lane); const float q = wave_sum(v.x * v.x + v.y * v.y);
              const float rs = 1.0f / sqrtf(q * (1.0f / KVR) + EPS); const f32x2 g = *(const f32x2*)(kvn + 2 * lane);
              *(unsigned*)(ckv + (size_t)row * KVR + 2 * lane) = pk2(v.x * rs * g.x, v.y * rs * g.y); }
            { const float wv = iw[(size_t)row * IH + (lane >> 3)]; const float aw = fabsf(wv) * (1.0f / 16.0f);
              const v2u q = *(const v2u*)(iqraw + (size_t)row * 256 + 4 * lane);
              v2u o; o.x = pkh2(hlo(q.x) * aw, hhi(q.x) * aw); o.y = pkh2(hlo(q.y) * aw, hhi(q.y) * aw);
              *(v2u*)(iqf + (size_t)row * 256 + 4 * lane) = o;
              const unsigned long long bal = __ballot(wv < 0.f);
              unsigned mask = 0;
#pragma unroll
              for (int h = 0; h < 8; ++h) mask |= ((unsigned)(bal >> (8 * h)) & 1u) << h;
              if (lane == 0) sgn[row] = mask; } }
        { const int row = row0 + tok, spos = row % SEQ;
#pragma unroll 1
          for (int g = 0; g < 4; ++g) { const int w = 2 << g; const int cnt = (spos + 1) < w ? (spos + 1) : w; const float rc = 1.0f / (float)cnt;
              bf16x8_p pf[2];
#pragma unroll
              for (int ks = 0; ks < 2; ++ks) { const int c0 = g * 64 + 32 * ks + 8 * g4; float sum[8], z0[8];
#pragma unroll
                  for (int e = 0; e < 8; ++e) { sum[e] = 0.f; z0[e] = 0.f; }
                  for (int j = 0; j < w; ++j) { if (j < cnt) { const v4u v = *(const v4u*)(z + (size_t)(row - j) * 256 + c0);
                      const float f[8] = {bflo(v.x), bfhi(v.x), bflo(v.y), bfhi(v.y), bflo(v.z), bfhi(v.z), bflo(v.w), bfhi(v.w)};
#pragma unroll
                      for (int e = 0; e < 8; ++e) { sum[e] += f[e]; if (j == 0) z0[e] = f[e]; } } }
                  v4u pw; pw.x = pk2(sum[0] * rc - z0[0], sum[1] * rc - z0[1]); pw.y = pk2(sum[2] * rc - z0[2], sum[3] * rc - z0[3]); pw.z = pk2(sum[4] * rc - z0[4], sum[5] * rc - z0[5]); pw.w = pk2(sum[6] * rc - z0[6], sum[7] * rc - z0[7]);
                  pf[ks] = __builtin_bit_cast(bf16x8_p, pw); }
#pragma unroll
              for (int dt = 0; dt < 4; ++dt) { f32x4 acc = {0.f, 0.f, 0.f, 0.f};
#pragma unroll
                  for (int ks = 0; ks < 2; ++ks) { const bf16x8_p af = *(const bf16x8_p*)(wpT + (size_t)(g * 64 + 16 * dt + tok) * 64 + 32 * ks + 8 * g4); acc = __builtin_amdgcn_mfma_f32_16x16x32_bf16(af, pf[ks], acc, 0, 0, 0); }
                  const f32x4 ps = *(const f32x4*)(pscale + g * 64 + 16 * dt + 4 * g4);
                  v2u o; o.x = pk2(acc[0] * ps.x, acc[1] * ps.y); o.y = pk2(acc[2] * ps.z, acc[3] * ps.w);
                  *(v2u*)(yb + (size_t)row * 256 + g * 64 + 16 * dt + 4 * g4) = o; } } }
#pragma unroll 1
        for (int h = 0; h < CH; ++h) {
            __syncthreads();
#pragma unroll
            for (int e = 0; e < 4; ++e) { const int i = tid + 512 * e;
                { const int m = i >> 3, c = i & 7; const v4u v = *(const v4u*)(memkv + (size_t)(b * NMEM + m) * 2048 + l * 512 + h * 64 + c * 8); *(LAS v4u*)(Ks + m * 144 + c * 16) = v; }
                { const int d = i >> 5, c = i & 31; const v4u v = *(const v4u*)(vT + (size_t)(l * 512 + 256 + h * 64 + d) * MROWS + b * NMEM + c * 8); *(LAS v4u*)(Vs + d * 528 + c * 16) = v; } }
            LDS_WAIT(); __syncthreads();
            const int row = row0 + tok;
            bf16x8_p qf[2];
#pragma unroll
            for (int ks = 0; ks < 2; ++ks) qf[ks] = *(const bf16x8_p*)(qc + (size_t)row * 256 + h * 64 + 32 * ks + 8 * g4);
            f32x4 S[16]; float mx = -1e30f;
#pragma unroll
            for (int mt = 0; mt < 16; ++mt) { f32x4 acc = {0.f, 0.f, 0.f, 0.f};
#pragma unroll
                for (int ks = 0; ks < 2; ++ks) { const bf16x8_p kf = *(const LAS bf16x8_p*)(Ks + (16 * mt + tok) * 144 + (4 * ks + g4) * 16); acc = __builtin_amdgcn_mfma_f32_16x16x32_bf16(kf, qf[ks], acc, 0, 0, 0); }
                S[mt] = acc; mx = fmaxf(mx, fmaxf(fmaxf(acc[0], acc[1]), fmaxf(acc[2], acc[3]))); if ((mt & 3) == 3) __builtin_amdgcn_sched_barrier(0); }
            mx = fmaxf(mx, __shfl_xor(mx, 16)); mx = fmaxf(mx, __shfl_xor(mx, 32));
            float sm = 0.f;
#pragma unroll
            for (int mt = 0; mt < 16; ++mt)
#pragma unroll
                for (int r = 0; r < 4; ++r) { const float p = __expf((S[mt][r] - mx) * 0.125f); S[mt][r] = p; sm += p; }
            sm += __shfl_xor(sm, 16); sm += __shfl_xor(sm, 32);
            const float inv = 1.0f / sm;
            f32x4 oacc[4];
#pragma unroll
            for (int dt = 0; dt < 4; ++dt) oacc[dt] = (f32x4){0.f, 0.f, 0.f, 0.f};
#pragma unroll
            for (int kk = 0; kk < 8; ++kk) { v4u pw; pw.x = pg8::cvt_pk_bf16(S[2 * kk][0], S[2 * kk][1]); pw.y = pg8::cvt_pk_bf16(S[2 * kk][2], S[2 * kk][3]); pw.z = pg8::cvt_pk_bf16(S[2 * kk + 1][0], S[2 * kk + 1][1]); pw.w = pg8::cvt_pk_bf16(S[2 * kk + 1][2], S[2 * kk + 1][3]);
                const bf16x8_p pfr = __builtin_bit_cast(bf16x8_p, pw);
#pragma unroll
                for (int dt = 0; dt < 4; ++dt) { const LAS unsigned char* vp = Vs + (16 * dt + tok) * 528 + (32 * kk + 4 * g4) * 2;
                    const v2u lo = *(const LAS v2u*)vp, hi = *(const LAS v2u*)(vp + 32);
                    v4u vw; vw.x = lo.x; vw.y = lo.y; vw.z = hi.x; vw.w = hi.y;
                    oacc[dt] = __builtin_amdgcn_mfma_f32_16x16x32_bf16(__builtin_bit_cast(bf16x8_p, vw), pfr, oacc[dt], 0, 0, 0); }
                __builtin_amdgcn_sched_barrier(0); }
#pragma unroll
            for (int dt = 0; dt < 4; ++dt) { v2u o; o.x = pk2(oacc[dt][0] * inv, oacc[dt][1] * inv); o.y = pk2(oacc[dt][2] * inv, oacc[dt][3] * inv);
                if (!dry) *(v2u*)(qc + (size_t)row * 256 + h * 64 + 16 * dt + 4 * g4) = o; else asm volatile("" :: "v"(o.x), "v"(o.y)); }
        }
    }
    __syncthreads();
}

__device__ __forceinline__ unsigned key_of(float s) { const unsigned u = __builtin_bit_cast(unsigned, s); return (u & 0x80000000u) ? ~u : (u | 0x80000000u); }

typedef short bf16x8_t __attribute__((ext_vector_type(8)));
typedef short s16x4_t __attribute__((ext_vector_type(4)));
__device__ __forceinline__ void glds16(const void* gsrc, unsigned lds_dst) { unsigned keep;
    asm volatile("s_mov_b32 %0, m0\n\ts_mov_b32 m0, %2\n\ts_nop 0\n\tglobal_load_lds_dwordx4 %1, off\n\ts_mov_b32 m0, %0" : "=&s"(keep) : "v"(gsrc), "s"(lds_dst) : "memory"); }
typedef float f32x16 __attribute__((ext_vector_type(16)));
constexpr int SEL_CAP = 256;
constexpr int HSTR = 264;
constexpr int SL_HIST = 0, SL_SEL = 0, SL_CS = 32768, SL_CI = 98304, SL_KEYS = 131072, SL_ST = 147456;

#define SEL_DECLS \
    LAS unsigned char* const lds = uni_l(lds_); const int wave = uni_i(wave_), b = uni_i(b_), ub = uni_i(ub_); unsigned char* ws = uni(ws_); \
    const bf16* iqf = (const bf16*)(ws + WS_IQF); const unsigned* sgn = (const unsigned*)(ws + WS_SGN); const bf16* ik = (const bf16*)(ws + WS_IK); \
    const int lane = lane_id_v(), tid = wave * 64 + lane; const int kl = lane & 31, c5 = lane >> 5; \
    LAS unsigned* hist = (LAS unsigned*)(lds + SL_HIST); LAS unsigned short* lsel = (LAS unsigned short*)(lds + SL_SEL); LAS float* lcs = (LAS float*)(lds + SL_CS); \
    LAS unsigned short* lci = (LAS unsigned short*)(lds + SL_CI); LAS unsigned* st = (LAS unsigned*)(lds + SL_ST); LAS float* stf = (LAS float*)(lds + SL_ST); \
    const int t0 = ub * 64; const int q0 = b * SEQ + t0; const bf16* ikb = ik + (size_t)b * SEQ * IDIM; const int ntile = (t0 + 64 + 127) >> 7; \
    (void)hist; (void)lsel; (void)lcs; (void)lci; (void)stf; (void)tid;
#define SEL_LOAD_A \
    bf16x8_t af[2][2]; float sgc[2][16]; \
    { const int i = kl, a_ = i >> 3, cc_ = (i >> 2) & 1, e_ = i & 3; const int qq_ = 2 * cc_ + (a_ >> 1), hh_ = 4 * (a_ & 1) + e_; \
      _Pragma("unroll") for (int rt = 0; rt < 2; ++rt) { const unsigned flip_ = ((sgn[q0 + 8 * wave + 4 * rt + qq_] >> hh_) & 1u) ? 0x80008000u : 0u;     \
          _Pragma("unroll") for (int ks = 0; ks < 2; ++ks) { v4u w_ = *(const v4u*)(iqf + (size_t)(q0 + 8 * wave + 4 * rt + qq_) * 256 + hh_ * 32 + 16 * ks + 8 * c5); \
              w_.x ^= flip_; w_.y ^= flip_; w_.z ^= flip_; w_.w ^= flip_; af[rt][ks] = __builtin_bit_cast(bf16x8_t, w_); } } \
      _Pragma("unroll") for (int rt = 0; rt < 2; ++rt) _Pragma("unroll") for (int u = 0; u < 2; ++u) { const unsigned m_ = sgn[q0 + 8 * wave + 4 * rt + 2 * c5 + u]; \
          _Pragma("unroll") for (int h = 0; h < 8; ++h) sgc[rt][8 * u + h] = ((m_ >> h) & 1u) ? -__builtin_inff() : __builtin_inff(); } }
#define SEL_STAGE(kt_) do { const int key_ = 16 * wave + (lane >> 2); const int ch_ = (lane & 3) ^ ((key_ >> 2) & 3); \
    glds16(ikb + (size_t)(128 * (kt_) + key_) * IDIM + ch_ * 8, (unsigned)__builtin_amdgcn_readfirstlane((int)(unsigned)(size_t)(lds + SL_KEYS + ((kt_) & 1) * 8192 + wave * 1024))); } while (0)
#define SEL_MMA(acc_, rt_, kh_) do { acc_ = (f32x16){0.f,0.f,0.f,0.f,0.f,0.f,0.f,0.f,0.f,0.f,0.f,0.f,0.f,0.f,0.f,0.f}; \
    acc_ = __builtin_amdgcn_mfma_f32_32x32x16_f16(__builtin_bit_cast(f16x8_t, af[rt_][0]), __builtin_bit_cast(f16x8_t, bfr_[kh_][0]), acc_, 0, 0, 0); \
    acc_ = __builtin_amdgcn_mfma_f32_32x32x16_f16(__builtin_bit_cast(f16x8_t, af[rt_][1]), __builtin_bit_cast(f16x8_t, bfr_[kh_][1]), acc_, 0, 0, 0); } while (0)
#define SEL_SUM(acc_, rt_, kh_) do { _Pragma("unroll") for (int u = 0; u < 2; ++u) { float s_ = 0.f; \
    _Pragma("unroll") for (int h = 0; h < 8; ++h) s_ += __builtin_amdgcn_fmed3f(acc_[8 * u + h], 0.f, sgc[rt_][8 * u + h]); \
    sc[rt_][kh_][u] = s_; } } while (0)
#define SEL_SCORES(kt_) do { const LAS unsigned char* kb_ = lds + SL_KEYS + ((kt_) & 1) * 8192; bf16x8_t bfr_[4][2]; \
    _Pragma("unroll") for (int kh = 0; kh < 4; ++kh) { const int key_ = 32 * kh + kl; \
        bfr_[kh][0] = *(const LAS bf16x8_t*)(kb_ + key_ * 64 + 16 * ((0 + c5) ^ ((key_ >> 2) & 3))); \
        bfr_[kh][1] = *(const LAS bf16x8_t*)(kb_ + key_ * 64 + 16 * ((2 + c5) ^ ((key_ >> 2) & 3))); } \
    f32x16 accA_, accB_; \
    SEL_MMA(accA_, 0, 0); \
    SEL_MMA(accB_, 1, 0); __builtin_amdgcn_sched_barrier(0); SEL_SUM(accA_, 0, 0); __builtin_amdgcn_sched_barrier(0); \
    SEL_MMA(accA_, 0, 1); __builtin_amdgcn_sched_barrier(0); SEL_SUM(accB_, 1, 0); __builtin_amdgcn_sched_barrier(0); \
    SEL_MMA(accB_, 1, 1); __builtin_amdgcn_sched_barrier(0); SEL_SUM(accA_, 0, 1); __builtin_amdgcn_sched_barrier(0); \
    SEL_MMA(accA_, 0, 2); __builtin_amdgcn_sched_barrier(0); SEL_SUM(accB_, 1, 1); __builtin_amdgcn_sched_barrier(0); \
    SEL_MMA(accB_, 1, 2); __builtin_amdgcn_sched_barrier(0); SEL_SUM(accA_, 0, 2); __builtin_amdgcn_sched_barrier(0); \
    SEL_MMA(accA_, 0, 3); __builtin_amdgcn_sched_barrier(0); SEL_SUM(accB_, 1, 2); __builtin_amdgcn_sched_barrier(0); \
    SEL_MMA(accB_, 1, 3); __builtin_amdgcn_sched_barrier(0); SEL_SUM(accA_, 0, 3); __builtin_amdgcn_sched_barrier(0); \
    SEL_SUM(accB_, 1, 3); } while (0)
#define SEL_BOUNDARY(FINAL) do { \
    const int qq = tid >> 3, part = tid & 7; const LAS v4u* hp = (const LAS v4u*)(hist + qq * HSTR + 32 * part); \
    unsigned bins[32]; \
    _Pragma("unroll") for (int i = 0; i < 8; ++i) { const v4u v = hp[i]; bins[4 * i] = v.x; bins[4 * i + 1] = v.y; bins[4 * i + 2] = v.z; bins[4 * i + 3] = v.w; } \
    unsigned ps = 0; \
    _Pragma("unroll") for (int i = 0; i < 32; ++i) ps += bins[i]; \
    unsigned v = ps, tt; \
    tt = __shfl_down(v, 1, 8); if (part + 1 < 8) v += tt; \
    tt = __shfl_down(v, 2, 8); if (part + 2 < 8) v += tt; \
    tt = __shfl_down(v, 4, 8); if (part + 4 < 8) v += tt; \
    unsigned cacc = v - ps; \
    if (cacc < (unsigned)TOPK && v >= (unsigned)TOPK) { int bsel = 0; unsigned na = 0, cb = 0; bool found = false; \
        _Pragma("unroll") for (int i = 31; i >= 0; --i) { const bool hit = !found && (cacc + bins[i] >= (unsigned)TOPK); if (hit) { bsel = i; na = cacc; cb = bins[i]; found = true; } cacc += bins[i]; } \
        st[128 + qq] = (unsigned)(32 * part + bsel); if (FINAL) { st[192 + qq] = na; st[256 + qq] = cb; st[448 + qq] = cb > (unsigned)SEL_CAP ? 1u : 0u; } } } while (0)

__device__ __forceinline__ void sel_pass1(unsigned char* ws_, LAS unsigned char* lds_, int wave_, int b_, int ub_) {
    SEL_DECLS
    unsigned short* sel = (unsigned short*)(ws + WS_SEL);
    __syncthreads();
    if (ub < 4) {
        for (int i = tid; i < 64 * TOPK; i += NWAVES * 64) { const int qq = i >> 8, sl = i & 255; sel[(size_t)(q0 + qq) * TOPK + sl] = (unsigned short)(sl <= t0 + qq ? sl : 0); }
        if (tid == 0) st[512] = 1u;
        asm volatile("s_waitcnt vmcnt(0) lgkmcnt(0)" ::: "memory"); __syncthreads();
        return;
    }
    SEL_LOAD_A
    for (int i = tid; i < 64 * HSTR; i += NWAVES * 64) hist[i] = 0u;
    if (tid < 64) { st[128 + tid] = 0u; st[448 + tid] = 0u; }
    if (tid == 0) st[512] = 0u;
    float sc[2][4][2];
    float scl[2][2]; int bcur[2][2];
#pragma unroll
    for (int rt = 0; rt < 2; ++rt)
#pragma unroll
        for (int u = 0; u < 2; ++u) { scl[rt][u] = 0.f; bcur[rt][u] = 0; }
    SEL_STAGE(0);
#pragma unroll 1
    for (int kt = 0; kt < ntile; ++kt) {
        asm volatile("s_waitcnt vmcnt(0) lgkmcnt(0)" ::: "memory"); __syncthreads();
        if (kt > 0 && (kt & 3) == 0) {
            SEL_BOUNDARY(false);
            asm volatile("s_waitcnt lgkmcnt(0)" ::: "memory"); __syncthreads();
#pragma unroll
            for (int rt = 0; rt < 2; ++rt)
#pragma unroll
                for (int u = 0; u < 2; ++u) bcur[rt][u] = (int)st[128 + 8 * wave + 4 * rt + 2 * c5 + u];
        }
        if (kt + 1 < ntile) SEL_STAGE(kt + 1);
        SEL_SCORES(kt);
        if (kt == 0) {
#pragma unroll
            for (int rt = 0; rt < 2; ++rt)
#pragma unroll
                for (int u = 0; u < 2; ++u) { float mx = 0.f;
#pragma unroll
                    for (int kh = 0; kh < 4; ++kh) mx = fmaxf(mx, fabsf(sc[rt][kh][u]));
#pragma unroll
                    for (int o = 1; o < 32; o <<= 1) mx = fmaxf(mx, __shfl_xor(mx, o));
                    const float R = mx > 0.f ? 2.0f * mx : 1.0f;
                    scl[rt][u] = 128.0f / R;
                    if (kl == 0) stf[8 * wave + 4 * rt + 2 * c5 + u] = scl[rt][u]; }
        }
        const bool masked = 128 * kt + 127 > t0;
#pragma unroll
        for (int rt = 0; rt < 2; ++rt)
#pragma unroll
            for (int u = 0; u < 2; ++u) { const int qq = 8 * wave + 4 * rt + 2 * c5 + u; const int lim = masked ? (t0 + qq - 128 * kt - kl) : 1000;
#pragma unroll
                for (int kh = 0; kh < 4; ++kh) { const float fb = __builtin_amdgcn_fmed3f(fmaf(sc[rt][kh][u], scl[rt][u], 128.0f), 0.f, 255.f);
                    if (fb >= (float)bcur[rt][u] && 32 * kh <= lim) (void)__hip_atomic_fetch_add(hist + qq * HSTR + (int)fb, 1u, __ATOMIC_RELAXED, __HIP_MEMORY_SCOPE_WORKGROUP); } }
    }
    asm volatile("s_waitcnt vmcnt(0) lgkmcnt(0)" ::: "memory"); __syncthreads();
    SEL_BOUNDARY(true);
    if (tid < 64) { st[320 + tid] = 0u; st[384 + tid] = 0u; }
    asm volatile("s_waitcnt lgkmcnt(0)" ::: "memory"); __syncthreads();
}
__device__ __forceinline__ void sel_pass2(unsigned char* ws_, LAS unsigned char* lds_, int wave_, int b_, int ub_) {
    SEL_DECLS
    if (st[512] != 0u) return;
    if (tid < 64) { st[320 + tid] = 0u; st[384 + tid] = 0u; }
    SEL_LOAD_A
    float sc[2][4][2];
    float scl[2][2]; int bcur[2][2];
#pragma unroll
    for (int rt = 0; rt < 2; ++rt)
#pragma unroll
        for (int u = 0; u < 2; ++u) { const int qq = 8 * wave + 4 * rt + 2 * c5 + u; scl[rt][u] = stf[qq]; bcur[rt][u] = (int)st[128 + qq]; }
    SEL_STAGE(0);
#pragma unroll 1
    for (int kt = 0; kt < ntile; ++kt) {
        asm volatile("s_waitcnt vmcnt(0) lgkmcnt(0)" ::: "memory"); __syncthreads();
        if (kt + 1 < ntile) SEL_STAGE(kt + 1);
        SEL_SCORES(kt);
        const bool masked = 128 * kt + 127 > t0;
        unsigned okm = 0u, abm = 0u; unsigned basea[2][2], basec[2][2];
#pragma unroll
        for (int rt = 0; rt < 2; ++rt)
#pragma unroll
            for (int u = 0; u < 2; ++u) { const int qq = 8 * wave + 4 * rt + 2 * c5 + u; const int lim = masked ? (t0 + qq - 128 * kt - kl) : 1000; unsigned na_ = 0u, nc_ = 0u;
#pragma unroll
                for (int kh = 0; kh < 4; ++kh) { const float fb = __builtin_amdgcn_fmed3f(fmaf(sc[rt][kh][u], scl[rt][u], 128.0f), 0.f, 255.f);
                    const bool ok = fb >= (float)bcur[rt][u] && 32 * kh <= lim; const bool ab = fb >= (float)(bcur[rt][u] + 1);
                    if (ok) { okm |= 1u << (rt * 8 + u * 4 + kh); if (ab) { abm |= 1u << (rt * 8 + u * 4 + kh); ++na_; } else ++nc_; } }
                basea[rt][u] = 0u; basec[rt][u] = 0u;
                if (na_) basea[rt][u] = __hip_atomic_fetch_add(st + 320 + qq, na_, __ATOMIC_RELAXED, __HIP_MEMORY_SCOPE_WORKGROUP);
                if (nc_) basec[rt][u] = __hip_atomic_fetch_add(st + 384 + qq, nc_, __ATOMIC_RELAXED, __HIP_MEMORY_SCOPE_WORKGROUP); }
        if (okm != 0u) {
#pragma unroll
            for (int rt = 0; rt < 2; ++rt)
#pragma unroll
                for (int u = 0; u < 2; ++u) { const int qq = 8 * wave + 4 * rt + 2 * c5 + u; unsigned sa = basea[rt][u], scn = basec[rt][u];
#pragma unroll
                    for (int kh = 0; kh < 4; ++kh) { const int bit = rt * 8 + u * 4 + kh; const int kpos = 128 * kt + 32 * kh + kl;
                        if ((okm >> bit) & 1u) {
                            if ((abm >> bit) & 1u) { if (sa < (unsigned)TOPK) lsel[qq * 256 + sa] = (unsigned short)kpos; ++sa; }
                            else { if (scn < (unsigned)SEL_CAP) { lcs[qq * SEL_CAP + scn] = sc[rt][kh][u]; lci[qq * SEL_CAP + scn] = (unsigned short)kpos; } ++scn; } } } }
        }
    }
    asm volatile("s_waitcnt vmcnt(0) lgkmcnt(0)" ::: "memory"); __syncthreads();
}
__device__ __forceinline__ void sel_resolve(unsigned char* ws_, LAS unsigned char* lds_, int wave_, int b_, int ub_, int wg_, int first_) {
    SEL_DECLS
    const int wg = uni_i(wg_), first = uni_i(first_);
    unsigned short* sel = (unsigned short*)(ws + WS_SEL);
    gu32* slowl = (gu32*)(ws + WS_CTL + 65536) + (size_t)wg * 132;
    if (first && tid == 0) __hip_atomic_store(slowl, 0u, RLX_AGENT);
    if (st[512] != 0u) return;
#pragma unroll 1
    for (int qi = 0; qi < 8; ++qi) { const int qq = 8 * wave + qi; const int q = q0 + qq;
        const int na = (int)st[192 + qq], need = TOPK - na; int C = (int)st[384 + qq]; C = C < SEL_CAP ? C : SEL_CAP;
        const bool slow = st[448 + qq] != 0u;
        if (!slow) {
#pragma unroll
            for (int e = 0; e < SEL_CAP / 64; ++e) { const int i = lane + 64 * e;
                if (i < C) { const float si = lcs[qq * SEL_CAP + i]; const int ii = lci[qq * SEL_CAP + i]; int rank = 0;
#pragma unroll 8
                    for (int jx = 0; jx < C; ++jx) { const float sj = lcs[qq * SEL_CAP + jx]; const int ij = lci[qq * SEL_CAP + jx]; rank += (sj > si || (sj == si && ij < ii)) ? 1 : 0; }
                    if (rank < need) lsel[qq * 256 + na + rank] = (unsigned short)ii; } }
            LDS_WAIT();
            *(v2u*)(sel + (size_t)q * TOPK + 4 * lane) = *(const LAS v2u*)(lsel + qq * 256 + 4 * lane);
        }
    }
    __syncthreads();
    if (tid == 0) { unsigned n = first ? 0u : __hip_atomic_load(slowl, RLX_AGENT);
        for (int qq = 0; qq < 64; ++qq) if (st[448 + qq] != 0u) { if (n < 128u) { __hip_atomic_store(slowl + 1 + n, (unsigned)(q0 + qq), RLX_AGENT); ++n; } }
        __hip_atomic_store(slowl, n, RLX_AGENT); }
    asm volatile("s_waitcnt vmcnt(0)" ::: "memory");
    __syncthreads();
}
#undef SEL_DECLS
#undef SEL_LOAD_A
#undef SEL_STAGE
#undef SEL_SCORES
#undef SEL_MMA
#undef SEL_SUM
#undef SEL_BOUNDARY
__device__ __forceinline__ void dsa_select_slow(unsigned char* ws_, LAS unsigned char* lds_, int wave_, int wg_) {
    LAS unsigned char* const lds = uni_l(lds_); const int wave = uni_i(wave_), wg = uni_i(wg_);
    unsigned char* ws = uni(ws_);
    const bf16* iqf = (const bf16*)(ws + WS_IQF); const unsigned* sgn = (const unsigned*)(ws + WS_SGN); const bf16* ik = (const bf16*)(ws + WS_IK);
    unsigned short* sel = (unsigned short*)(ws + WS_SEL);
    gu32* slowl = (gu32*)(ws + WS_CTL + 65536) + (size_t)wg * 132;
    const int lane = lane_id_v(), tid = wave * 64 + lane; const int kl = lane & 31, c5 = lane >> 5;
    LAS unsigned* keys = (LAS unsigned*)lds;
    LAS unsigned* hist = (LAS unsigned*)(lds + 32768);
    LAS unsigned* ctl = (LAS unsigned*)(lds + 40960);
    const int nq = (int)__builtin_amdgcn_readfirstlane(__hip_atomic_load(slowl, RLX_AGENT));
#pragma unroll 1
    for (int k = 0; k < nq; ++k) {
        const int q = (int)__builtin_amdgcn_readfirstlane(__hip_atomic_load(slowl + 1 + k, RLX_AGENT));
        const int b = q / SEQ, t = q % SEQ, n = t + 1;
        const bf16* ikb = ik + (size_t)b * SEQ * IDIM;
        __syncthreads();
        bf16x8_t af[2]; float sgc[8];
        { const int i = kl, a_ = i >> 3, e_ = i & 3; const int hh_ = 4 * (a_ & 1) + e_; const unsigned m_ = sgn[q];
          const unsigned flip_ = ((m_ >> hh_) & 1u) ? 0x80008000u : 0u;
#pragma unroll
          for (int ks = 0; ks < 2; ++ks) { v4u w_ = *(const v4u*)(iqf + (size_t)q * 256 + hh_ * 32 + 16 * ks + 8 * c5); w_.x ^= flip_; w_.y ^= flip_; w_.z ^= flip_; w_.w ^= flip_; af[ks] = __builtin_bit_cast(bf16x8_t, w_); }
#pragma unroll
          for (int h = 0; h < 8; ++h) sgc[h] = ((m_ >> h) & 1u) ? -__builtin_inff() : __builtin_inff(); }
#pragma unroll 1
        for (int kb = wave; kb * 32 < n; kb += NWAVES) { const int key = 32 * kb + kl;
            const bf16x8_t b0 = *(const bf16x8_t*)(ikb + (size_t)key * IDIM + 8 * c5), b1 = *(const bf16x8_t*)(ikb + (size_t)key * IDIM + 16 + 8 * c5);
            f32x16 acc = {0.f,0.f,0.f,0.f,0.f,0.f,0.f,0.f,0.f,0.f,0.f,0.f,0.f,0.f,0.f,0.f};
            acc = __builtin_amdgcn_mfma_f32_32x32x16_f16(__builtin_bit_cast(f16x8_t, af[0]), __builtin_bit_cast(f16x8_t, b0), acc, 0, 0, 0); acc = __builtin_amdgcn_mfma_f32_32x32x16_f16(__builtin_bit_cast(f16x8_t, af[1]), __builtin_bit_cast(f16x8_t, b1), acc, 0, 0, 0);
            float sc = 0.f;
#pragma unroll
            for (int h = 0; h < 8; ++h) sc += __builtin_amdgcn_fmed3f(acc[h], 0.f, sgc[h]);
            if (c5 == 0) keys[key] = key_of(sc); }
        if (tid == 0) { const unsigned z_ = (unsigned)launder_v(0); ctl[0] = z_; ctl[1] = z_ + (unsigned)TOPK; ctl[2] = z_; ctl[3] = z_; }
        unsigned P = 0u, Plo = 0u;
#pragma unroll 1
        for (int lev = 0; lev < 5; ++lev) {
            for (int i = tid; i < 2048; i += NWAVES * 64) hist[i] = 0u;
            asm volatile("s_waitcnt lgkmcnt(0)" ::: "memory"); __syncthreads();
#pragma unroll 1
            for (int i = 0; i < 16; ++i) { const int s_ = tid * 16 + i;
                if (s_ < n) { const unsigned hi = keys[s_], lo = 8191u - (unsigned)s_; bool mt; unsigned dg;
                    if (lev == 0) { mt = true; dg = hi >> 21; } else if (lev == 1) { mt = (hi >> 21) == P; dg = (hi >> 10) & 0x7ffu; } else if (lev == 2) { mt = (hi >> 10) == P; dg = hi & 0x3ffu; }
                    else if (lev == 3) { mt = hi == P; dg = lo >> 6; } else { mt = hi == P && (lo >> 6) == Plo; dg = lo & 63u; }
                    if (mt) (void)__hip_atomic_fetch_add(hist + dg, 1u, __ATOMIC_RELAXED, __HIP_MEMORY_SCOPE_WORKGROUP); } }
            asm volatile("s_waitcnt lgkmcnt(0)" ::: "memory"); __syncthreads();
            const unsigned need = ctl[1];
            const v4u hb = *(const LAS v4u*)(hist + 4 * tid); const unsigned ls = hb.x + hb.y + hb.z + hb.w;
            unsigned v = ls, tt;
            tt = __shfl_down(v, 1); if (lane + 1 < 64) v += tt;
            tt = __shfl_down(v, 2); if (lane + 2 < 64) v += tt;
            tt = __shfl_down(v, 4); if (lane + 4 < 64) v += tt;
            tt = __shfl_down(v, 8); if (lane + 8 < 64) v += tt;
            tt = __shfl_down(v, 16); if (lane + 16 < 64) v += tt;
            tt = __shfl_down(v, 32); if (lane + 32 < 64) v += tt;
            if (lane == 0) ctl[8 + wave] = v;
            asm volatile("s_waitcnt lgkmcnt(0)" ::: "memory"); __syncthreads();
            unsigned above = v - ls;
            for (int w2 = wave + 1; w2 < NWAVES; ++w2) above += ctl[8 + w2];
            if (above < need && above + ls >= need) { unsigned c = above; const unsigned bb[4] = {hb.x, hb.y, hb.z, hb.w}; int bsel = 0; unsigned cab = 0; bool found = false;
#pragma unroll
                for (int i = 3; i >= 0; --i) { const bool hit = !found && (c + bb[i] >= need); if (hit) { bsel = i; cab = c; found = true; } c += bb[i]; }
                const unsigned dv = (unsigned)(4 * tid + bsel);
                if (lev == 0) ctl[0] = dv; else if (lev == 1) ctl[0] = (P << 11) | dv; else if (lev == 2) ctl[0] = (P << 10) | dv; else if (lev == 3) ctl[3] = dv; else ctl[3] = (Plo << 6) | dv;
                ctl[1] = need - cab; }
            asm volatile("s_waitcnt lgkmcnt(0)" ::: "memory"); __syncthreads();
            P = ctl[0]; Plo = ctl[3];
        }
        unsigned short* srow = sel + (size_t)q * TOPK;
        unsigned mymask = 0u;
#pragma unroll 1
        for (int i = 0; i < 16; ++i) { const int s_ = tid * 16 + i;
            if (s_ < n) { const unsigned hi = keys[s_], lo = 8191u - (unsigned)s_; if (hi > P || (hi == P && lo >= Plo)) mymask |= 1u << i; } }
        const unsigned mycnt = (unsigned)__builtin_popcount(mymask);
        unsigned pv_ = mycnt, tt_;
        tt_ = __shfl_up(pv_, 1); if (lane >= 1) pv_ += tt_;
        tt_ = __shfl_up(pv_, 2); if (lane >= 2) pv_ += tt_;
        tt_ = __shfl_up(pv_, 4); if (lane >= 4) pv_ += tt_;
        tt_ = __shfl_up(pv_, 8); if (lane >= 8) pv_ += tt_;
        tt_ = __shfl_up(pv_, 16); if (lane >= 16) pv_ += tt_;
        tt_ = __shfl_up(pv_, 32); if (lane >= 32) pv_ += tt_;
        if (lane == 63) ctl[16 + wave] = pv_;
        asm volatile("s_waitcnt lgkmcnt(0)" ::: "memory"); __syncthreads();
        unsigned slot0 = pv_ - mycnt;
        for (int w2 = 0; w2 < wave; ++w2) slot0 += ctl[16 + w2];
#pragma unroll 1
        for (int i = 0; i < 16; ++i) if ((mymask >> i) & 1u) { if (slot0 < (unsigned)TOPK) srow[slot0] = (unsigned short)(tid * 16 + i); ++slot0; }
    }
    asm volatile("s_waitcnt vmcnt(0) lgkmcnt(0)" ::: "memory");
    __syncthreads();
}

__device__ __forceinline__ unsigned offb(unsigned row, unsigned ch) { return 256u * row + 16u * (ch ^ (((row & 3u) << 2) | ((row >> 2) & 3u))); }
__device__ __forceinline__ s16x4_t vtr(const LAS unsigned char* p) { return __builtin_bit_cast(s16x4_t, __builtin_amdgcn_ds_read_tr16_b64_v4i16((LAS s16x4_t*)p)); }

__device__ __noinline__ void dsa_attend(unsigned char* ws_, LAS unsigned char* lds_, const float* relb_, int wave_, int vcu_, int G_, int dry_) {
    const int dry = uni_i(dry_);
    LAS unsigned char* const lds = uni_l(lds_); const int wave = uni_i(wave_), vcu = uni_i(vcu_), G = uni_i(G_);
    unsigned char* ws = uni(ws_); const float* relb = uni(relb_);
    const bf16* ckv = (const bf16*)(ws + WS_CKV); bf16* ql = (bf16*)(ws + WS_QL); const unsigned short* sel = (const unsigned short*)(ws + WS_SEL);
    const int lane = lane_id_v(), tid = wave * 64 + lane;
    LAS unsigned char* cb = lds + wave * 16384;
    LAS unsigned short* sidx = (LAS unsigned short*)(lds + 131072 + wave * 512);
    LAS float* biasd = (LAS float*)(lds + 135168);
    for (int i = tid; i < 129 * 8; i += NWAVES * 64) { const int d = i >> 3, h = i & 7; const int bk = d < 128 ? (int)T5_BUCKET[d] : 31; biasd[i] = relb[bk * 8 + h]; }
    __syncthreads();
    const int hl = lane & 15, g = lane >> 4, hq = hl & 7;
    for (int p = vcu; p < BATCH * 64; p += G) {
        const int b = p >> 6, j = p & 63;
#pragma unroll 1
        for (int half = 0; half < 2; ++half) {
            const int ub = half == 0 ? j : 127 - j;
#pragma unroll 1
            for (int qi = 0; qi < 8; ++qi) {
                const int t = ub * 64 + wave * 8 + qi; const int q = b * SEQ + t; const int nsel = (t + 1) < TOPK ? (t + 1) : TOPK;
                const bf16* ckvb = ckv + (size_t)b * SEQ * KVR; bf16* qlrow = ql + (size_t)q * 1024;
                { const v2u w = *(const v2u*)(sel + (size_t)q * TOPK + 4 * lane); *(LAS v2u*)(sidx + 4 * lane) = w; }
                bf16x8_t qf[4];
#pragma unroll
                for (int s = 0; s < 4; ++s) qf[s] = *(const bf16x8_t*)(qlrow + hq * 128 + 32 * s + 8 * g);
                LDS_WAIT();
                float mrun = -1e30f, lsum = 0.f;
                f32x4 O[8];
#pragma unroll
                for (int c = 0; c < 8; ++c) O[c] = (f32x4){0.f, 0.f, 0.f, 0.f};
#define DSA_GATHER(c_) do { LAS unsigned char* dst_ = cb + ((c_) & 1) * 8192; \
                    _Pragma("unroll") for (int k_ = 0; k_ < 8; ++k_) { const int row_ = 4 * k_ + g; const int kidx_ = sidx[32 * (c_) + row_]; \
                        const int ch_ = hl ^ ((g << 2) | (k_ & 3)); \
                        glds16(ckvb + (size_t)kidx_ * KVR + ch_ * 8, (unsigned)__builtin_amdgcn_readfirstlane((int)(unsigned)(size_t)(dst_ + k_ * 1024))); } } while (0)
                DSA_GATHER(0);
#pragma unroll 1
                for (int c = 0; c < 8; ++c) {
                    if (c < 7) { DSA_GATHER(c + 1); asm volatile("s_waitcnt vmcnt(8)" ::: "memory"); }
                    else asm volatile("s_waitcnt vmcnt(0)" ::: "memory");
                    const LAS unsigned char* img = cb + (c & 1) * 8192;
                    f32x4 S[2];
#pragma unroll
                    for (int rb = 0; rb < 2; ++rb) { S[rb] = (f32x4){0.f, 0.f, 0.f, 0.f}; const unsigned row = 8u * (hl >> 2) + 4u * rb + (hl & 3);
#pragma unroll
                        for (int s = 0; s < 4; ++s) { const bf16x8_t af = *(const LAS bf16x8_t*)(img + offb(row, 4 * s + g)); S[rb] = __builtin_amdgcn_mfma_f32_16x16x32_bf16(af, qf[s], S[rb], 0, 0, 0); } }
                    float pv[2][4]; float mx = -1e30f;
#pragma unroll
                    for (int rb = 0; rb < 2; ++rb) { const v2u iw2 = *(const LAS v2u*)(sidx + 32 * c + 8 * g + 4 * rb);
                        const int ki[4] = {(int)(iw2.x & 0xffffu), (int)(iw2.x >> 16), (int)(iw2.y & 0xffffu), (int)(iw2.y >> 16)};
#pragma unroll
                        for (int r = 0; r < 4; ++r) { int dist = t - ki[r]; dist = dist < 0 ? 0 : (dist > 128 ? 128 : dist);
                            float lg = S[rb][r] * 0.125f + biasd[dist * 8 + hq];
                            if (32 * c + 8 * g + 4 * rb + r >= nsel) lg = -1e30f;
                            pv[rb][r] = lg; mx = fmaxf(mx, lg); } }
                    mx = fmaxf(mx, __shfl_xor(mx, 16)); mx = fmaxf(mx, __shfl_xor(mx, 32));
                    const float mnew = fmaxf(mrun, mx); const float alpha = __expf(mrun - mnew); mrun = mnew;
                    float rs = 0.f;
#pragma unroll
                    for (int rb = 0; rb < 2; ++rb)
#pragma unroll
                        for (int r = 0; r < 4; ++r) { pv[rb][r] = __expf(pv[rb][r] - mnew); rs += pv[rb][r]; }
                    rs += __shfl_xor(rs, 16); rs += __shfl_xor(rs, 32);
                    lsum = lsum * alpha + rs;
                    v4u pw; pw.x = pg8::cvt_pk_bf16(pv[0][0], pv[0][1]); pw.y = pg8::cvt_pk_bf16(pv[0][2], pv[0][3]); pw.z = pg8::cvt_pk_bf16(pv[1][0], pv[1][1]); pw.w = pg8::cvt_pk_bf16(pv[1][2], pv[1][3]);
                    const bf16x8_t pf = __builtin_bit_cast(bf16x8_t, pw);
                    float al[4];
#pragma unroll
                    for (int r = 0; r < 4; ++r) al[r] = __shfl(alpha, 4 * g + r);
#pragma unroll
                    for (int cd = 0; cd < 8; ++cd) {
                        f32x4 o = O[cd]; o[0] *= al[0]; o[1] *= al[1]; o[2] *= al[2]; o[3] *= al[3];
                        const unsigned q4 = hl >> 2, p4 = hl & 3;
                        const s16x4_t b0 = vtr(img + offb(8u * g + q4, 2 * cd + (p4 >> 1)) + 8u * (p4 & 1));
                        const s16x4_t b1 = vtr(img + offb(8u * g + 4u + q4, 2 * cd + (p4 >> 1)) + 8u * (p4 & 1));
                        bf16x8_t bf; bf[0] = b0[0]; bf[1] = b0[1]; bf[2] = b0[2]; bf[3] = b0[3]; bf[4] = b1[0]; bf[5] = b1[1]; bf[6] = b1[2]; bf[7] = b1[3];
                        O[cd] = __builtin_amdgcn_mfma_f32_16x16x32_bf16(pf, bf, o, 0, 0, 0);
                    }
                }
#undef DSA_GATHER
                const float linv = 1.0f / lsum; float li[4];
#pragma unroll
                for (int r = 0; r < 4; ++r) li[r] = __shfl(linv, 4 * g + r);
                LAS unsigned short* ost = (LAS unsigned short*)cb;
                if (g < 2) {
#pragma unroll
                    for (int cd = 0; cd < 8; ++cd)
#pragma unroll
                        for (int r = 0; r < 4; ++r) ost[(4 * g + r) * 128 + 16 * cd + hl] = (unsigned short)f2bf(O[cd][r] * li[r]);
                }
                LDS_WAIT();
                { const v4u w0 = *(const LAS v4u*)(cb + 32 * lane), w1 = *(const LAS v4u*)(cb + 32 * lane + 16);
                  if (!dry) { *(v4u*)(qlrow + 16 * lane) = w0; *(v4u*)(qlrow + 16 * lane + 8) = w1; } else asm volatile("" :: "v"(w0), "v"(w1)); }
                LDS_WAIT();
            }
        }
    }
    __syncthreads();
}

__device__ __noinline__ void final_norm(const float* const* in_, float* out_, unsigned char* ws_, LAS unsigned char* lds_, int wave_, int vcu_, int G_) {
    const PC F{uni(in_), uni(out_), uni(ws_), uni_l(lds_), uni_i(wave_), uni_i(vcu_), uni_i(G_)}; struct { const float* const* in; float* out; } a{F.in, F.out};
    const int lane_ = lane_id_v(); const int gw = F.vcu * NWAVES + F.wave, NGW = F.G * NWAVES; const float* g = a.in[22];
    f32x4 gv[4];
#pragma unroll
    for (int j = 0; j < 4; ++j) gv[j] = ((const f32x4*)g)[lane_ + 64 * j];
    for (int m = gw; m < M; m += NGW) {
        GAS f32x4* xr = (GAS f32x4*)(a.out + (size_t)m * D) + lane_;
        f32x4 v[4]; float s = 0.f;
#pragma unroll
        for (int j = 0; j < 4; ++j) { v[j] = xr[64 * j]; s += (v[j].x * v[j].x + v[j].y * v[j].y) + (v[j].z * v[j].z + v[j].w * v[j].w); }
        const float rs = 1.0f / sqrtf(wave_sum(s) * (1.0f / D) + EPS);
#pragma unroll
        for (int j = 0; j < 4; ++j) xr[64 * j] = v[j] * rs * gv[j];
    }
}

#define KIN ((const float* const*)__builtin_amdgcn_kernarg_segment_ptr())
constexpr int PH_PER_LAYER = 10, PH_LAYER0 = 2, N_PHASES = PH_LAYER0 + PH_PER_LAYER * DEPTH + 1;

__global__ void __launch_bounds__(NWAVES * 64, 2) mk_fwd(Args args) {
    extern __shared__ __attribute__((aligned(16))) unsigned char lds[];
    Frame F;
    F.lds = (LAS unsigned char*)lds;
    F.MISC = (volatile LAS unsigned*)(F.lds + MISC_OFF);
    F.wave = __builtin_amdgcn_readfirstlane((int)threadIdx.x >> 6);
    F.G = gridDim.x; { const int bx = blockIdx.x; F.vcu = (F.G % 8 == 0) ? (bx % 8) * (F.G / 8) + bx / 8 : bx; }
    F.ws = args.ws; F.ctl = (gu32*)(args.ws + WS_CTL);
    if (threadIdx.x < 64) ((LAS unsigned*)(F.lds + MISC_OFF))[threadIdx.x] = 0u;
    __syncthreads();
    const int lo = args.ph_lo, hi = args.ph_hi;
    const bool multi = (hi - lo) > 1;
    XcdBarrier bar; bar.bar = (unsigned*)(F.ctl + CW_BAR); bar.x = 0; bar.st = nullptr; bar.wave = F.wave;
    if (multi) bar = xcd_barrier_post((unsigned*)(F.ctl + CW_BAR), F.MISC + 8, F.wave);
#define IN(k) (lo <= (k) && (k) < hi)
#define SEAM(k) do { if (IN(k) && IN((k) + 1)) { xcd_barrier(bar); if (PROBE_PHASE == 99) xcd_barrier(bar); } } while (0)

    if (IN(0)) {
#if EN_P0
 for (int rep = (PROBE_PHASE == 1 ? 0 : 1); rep < 2; ++rep) p0_prologue(KIN, args.out, args.ws, F.lds, F.wave, F.vcu, F.G);
#endif
 } SEAM(0);
    if (IN(1)) {
#if !((DIS_MASK >> 7) & 1)
 unsigned char* ws = launder_p(args.ws); bf16* hb = (bf16*)(ws + WS_HB); float* ss = (float*)(ws + WS_SS); (void)hb; (void)ss;
        pg8::Gemm g{(const bf16_t*)(ws + WS_MEMN), (const bf16_t*)(ws + WS_WMEM), MROWS, DEPTH * 2 * CW, D}; pg8::StaticOrder S; S.init(MROWS, DEPTH * 2 * CW, F.G, launder_s((int)blockIdx.x));
        EpiPlainBf16 E{(bf16_t*)(ws + WS_MEMKV), DEPTH * 2 * CW};
        pg8::gemm_phase<EpiPlainBf16, pg8::StaticOrder, true, true>(F.lds + RING_OFF, g, S, E, F.wave);
        { pg8::Gemm g2{(const bf16_t*)(ws + WS_WMEM), (const bf16_t*)(ws + WS_MEMN), DEPTH * 2 * CW, MROWS, D}; pg8::StaticOrder S2; S2.init(DEPTH * 2 * CW, MROWS, F.G, launder_s((int)blockIdx.x));
          EpiPlainBf16 E2{(bf16_t*)(ws + WS_VT), MROWS};
          pg8::gemm_phase<EpiPlainBf16, pg8::StaticOrder, true, true>(F.lds + RING_OFF, g2, S2, E2, F.wave); }
#endif
    } SEAM(1);

    for (int l = 0; l < DEPTH; ++l) {
        const int pb = PH_LAYER0 + PH_PER_LAYER * l;
        const float* hbase = (l == 0) ? args.in[0] : args.out;
        if (IN(pb + 0)) {
#if EN_P0
 if (l > 0) for (int rep = (PROBE_PHASE == 1 ? 0 : 1); rep < 2; ++rep) prep_layer_weights(KIN, args.out, args.ws, F.lds, l, F.wave, F.vcu, F.G);
#endif
 } SEAM(pb + 0);
        if (IN(pb + 1)) {
#if !((DIS_MASK >> 0) & 1)
 unsigned char* ws = launder_p(args.ws); bf16* hb = (bf16*)(ws + WS_HB); float* ss = (float*)(ws + WS_SS); (void)hb; (void)ss;
            pg8::Gemm g{hb, (const bf16_t*)(ws + WS_W1IN), M, 2 * DFF, D}; pg8::StaticOrder S; S.init(M, 2 * DFF, F.G, launder_s((int)blockIdx.x));
            EpiSwiglu E{(bf16_t*)(ws + WS_ACT), ss};
            for (int rep = (PROBE_PHASE == 2 ? 0 : 1); rep < 2; ++rep) pg8::gemm_phase<EpiSwiglu, pg8::StaticOrder, true, true>(F.lds + RING_OFF, g, S, E, F.wave);
#endif
        } SEAM(pb + 1);
        if (IN(pb + 2)) {
#if !((DIS_MASK >> 1) & 1)
 unsigned char* ws = launder_p(args.ws); bf16* hb = (bf16*)(ws + WS_HB); float* ss = (float*)(ws + WS_SS); (void)hb; (void)ss;
            pg8::Gemm g{(const bf16_t*)(ws + WS_ACT), (const bf16_t*)(ws + WS_W1OUT), M, D, DFF}; pg8::StaticOrder S; S.init(M, D, F.G, launder_s((int)blockIdx.x));
            for (int rep = (PROBE_PHASE == 3 ? 0 : 1); rep < 2; ++rep) { EpiResid E{hbase, args.out, hb, ss, 0.5f, (LAS float*)(F.lds + RING_BYTES), rep == 0 ? 1 : 0};
            pg8::gemm_phase<EpiResid, pg8::StaticOrder, true, true>(F.lds + RING_OFF, g, S, E, F.wave); }
#endif
        } SEAM(pb + 2);
        if (IN(pb + 3)) {
#if !((DIS_MASK >> 2) & 1)
 unsigned char* ws = launder_p(args.ws); bf16* hb = (bf16*)(ws + WS_HB); float* ss = (float*)(ws + WS_SS); (void)hb; (void)ss;
            pg8::Gemm g{hb, (const bf16_t*)(ws + WS_WIN), M, INP, D}; pg8::StaticOrder S; S.init(M, INP, F.G, launder_s((int)blockIdx.x));
            EpiInProj E{ss, (bf16_t*)(ws + WS_QL), (float*)(ws + WS_CKVRAW), (bf16_t*)(ws + WS_IK), (float*)(ws + WS_IW), (bf16_t*)(ws + WS_IQRAW), (bf16_t*)(ws + WS_Z), (bf16_t*)(ws + WS_QC), (bf16_t*)(ws + WS_G)};
            for (int rep = (PROBE_PHASE == 4 ? 0 : 1); rep < 2; ++rep) pg8::gemm_phase<EpiInProj, pg8::StaticOrder, true, true>(F.lds + RING_OFF, g, S, E, F.wave);
#endif
        } SEAM(pb + 3);
        if (IN(pb + 4)) {
#if EN_PREP
 for (int rep = (PROBE_PHASE == 5 ? 0 : 1); rep < 2; ++rep) prep_tokens(KIN, args.out, args.ws, F.lds, l, F.wave, F.vcu, F.G, rep == 0 ? 1 : 0);
#endif
 } SEAM(pb + 4);
        if (IN(pb + 5)) {
#if EN_DSA
 for (int rep = (PROBE_PHASE == 6 ? 0 : 1); rep < 2; ++rep) for (int p = F.vcu; p < BATCH * 64; p += F.G) { for (int half = 0; half < 2; ++half) { const int b_ = p >> 6, ub_ = half == 0 ? (p & 63) : 127 - (p & 63);
   sel_pass1(args.ws, F.lds, F.wave, b_, ub_); if (PROBE_PHASE == 61) sel_pass1(args.ws, F.lds, F.wave, b_, ub_); sel_pass2(args.ws, F.lds, F.wave, b_, ub_); if (PROBE_PHASE == 62) sel_pass2(args.ws, F.lds, F.wave, b_, ub_); sel_resolve(args.ws, F.lds, F.wave, b_, ub_, (int)blockIdx.x, (p == F.vcu && half == 0) ? 1 : 0); if (PROBE_PHASE == 63) sel_resolve(args.ws, F.lds, F.wave, b_, ub_, (int)blockIdx.x, 0); } }
 dsa_select_slow(args.ws, F.lds, F.wave, (int)blockIdx.x); for (int rep = (PROBE_PHASE == 7 ? 0 : 1); rep < 2; ++rep) dsa_attend(args.ws, F.lds, args.in[2], F.wave, F.vcu, F.G, rep == 0 ? 1 : 0);
#endif
 } SEAM(pb + 5);
        if (IN(pb + 6)) {
#if !((DIS_MASK >> 3) & 1)
        for (int rep6 = (PROBE_PHASE == 8 ? 0 : 1); rep6 < 2; ++rep6) {
 unsigned char* ws = launder_p(args.ws); bf16* hb = (bf16*)(ws + WS_HB); float* ss = (float*)(ws + WS_SS); (void)hb; (void)ss;
            { pg8::Gemm g{(const bf16_t*)(ws + WS_QL), (const bf16_t*)(ws + WS_WA), M, D, 1024}; pg8::StaticOrder S; S.init(M, D, F.G, launder_s((int)blockIdx.x));
              EpiMerge<0> E{(bf16_t*)(ws + WS_MERGED), (const bf16_t*)(ws + WS_G)};
              pg8::gemm_phase<EpiMerge<0>, pg8::StaticOrder, true, true>(F.lds + RING_OFF, g, S, E, F.wave); }
            { pg8::Gemm g{(const bf16_t*)(ws + WS_YB), (const bf16_t*)(ws + WS_WB), M, D, PW_}; pg8::StaticOrder S; S.init(M, D, F.G, launder_s((int)blockIdx.x));
              EpiMerge<1> E{(bf16_t*)(ws + WS_MERGED), (const bf16_t*)(ws + WS_G)};
              pg8::gemm_phase<EpiMerge<1>, pg8::StaticOrder, true, true>(F.lds + RING_OFF, g, S, E, F.wave); }
            { pg8::Gemm g{(const bf16_t*)(ws + WS_QC), (const bf16_t*)(ws + WS_WC), M, D, CW}; pg8::StaticOrder S; S.init(M, D, F.G, launder_s((int)blockIdx.x));
              EpiMerge<2> E{(bf16_t*)(ws + WS_MERGED), (const bf16_t*)(ws + WS_G)};
              pg8::gemm_phase<EpiMerge<2>, pg8::StaticOrder, true, true>(F.lds + RING_OFF, g, S, E, F.wave); }
        }
#endif
        } SEAM(pb + 6);
        if (IN(pb + 7)) {
#if !((DIS_MASK >> 4) & 1)
 unsigned char* ws = launder_p(args.ws); bf16* hb = (bf16*)(ws + WS_HB); float* ss = (float*)(ws + WS_SS); (void)hb; (void)ss;
            pg8::Gemm g{(const bf16_t*)(ws + WS_MERGED), (const bf16_t*)(ws + WS_WOUT), M, D, D}; pg8::StaticOrder S; S.init(M, D, F.G, launder_s((int)blockIdx.x));
            for (int rep = (PROBE_PHASE == 9 ? 0 : 1); rep < 2; ++rep) { EpiResid E{args.out, args.out, hb, ss, 1.0f, (LAS float*)(F.lds + RING_BYTES), rep == 0 ? 1 : 0};
            pg8::gemm_phase<EpiResid, pg8::StaticOrder, true, true>(F.lds + RING_OFF, g, S, E, F.wave); }
#endif
        } SEAM(pb + 7);
        if (IN(pb + 8)) {
#if !((DIS_MASK >> 5) & 1)
 unsigned char* ws = launder_p(args.ws); bf16* hb = (bf16*)(ws + WS_HB); float* ss = (float*)(ws + WS_SS); (void)hb; (void)ss;
            pg8::Gemm g{hb, (const bf16_t*)(ws + WS_W2IN), M, 2 * DFF, D}; pg8::StaticOrder S; S.init(M, 2 * DFF, F.G, launder_s((int)blockIdx.x));
            EpiSwiglu E{(bf16_t*)(ws + WS_ACT), ss};
            for (int rep = (PROBE_PHASE == 2 ? 0 : 1); rep < 2; ++rep) pg8::gemm_phase<EpiSwiglu, pg8::StaticOrder, true, true>(F.lds + RING_OFF, g, S, E, F.wave);
#endif
        } SEAM(pb + 8);
        if (IN(pb + 9)) {
#if !((DIS_MASK >> 6) & 1)
 unsigned char* ws = launder_p(args.ws); bf16* hb = (bf16*)(ws + WS_HB); float* ss = (float*)(ws + WS_SS); (void)hb; (void)ss;
            pg8::Gemm g{(const bf16_t*)(ws + WS_ACT), (const bf16_t*)(ws + WS_W2OUT), M, D, DFF}; pg8::StaticOrder S; S.init(M, D, F.G, launder_s((int)blockIdx.x));
            for (int rep = (PROBE_PHASE == 3 ? 0 : 1); rep < 2; ++rep) { EpiResid E{args.out, args.out, hb, ss, 0.5f, (LAS float*)(F.lds + RING_BYTES), rep == 0 ? 1 : 0};
            pg8::gemm_phase<EpiResid, pg8::StaticOrder, true, true>(F.lds + RING_OFF, g, S, E, F.wave); }
#endif
        } SEAM(pb + 9);
    }
#if EN_P0
    if (IN(N_PHASES - 1)) { final_norm(KIN, args.out, args.ws, F.lds, F.wave, F.vcu, F.G); }
#endif
#undef IN
#undef SEAM
}

extern "C" void kernel_launch(void* const* d_in, const int* in_sizes, int n_in, void* d_out, int out_size, void* d_ws, size_t ws_size, hipStream_t stream) {
    static int grid = 0;
    if (grid == 0) {
        if (n_in != 23 || in_sizes[0] != M * D || out_size != M * D || ws_size < WS_END) { fprintf(stderr, "kernel_launch: unexpected shapes (n_in %d, ws %zu)\n", n_in, ws_size); grid = -1; return; }
        int dev = 0, cus = 0, per_cu = 0;
        if (hipGetDevice(&dev) != hipSuccess || hipDeviceGetAttribute(&cus, hipDeviceAttributeMultiprocessorCount, dev) != hipSuccess) { grid = -1; return; }
        if (hipFuncSetAttribute((const void*)mk_fwd, hipFuncAttributeMaxDynamicSharedMemorySize, LDS_BYTES) != hipSuccess) { fprintf(stderr, "kernel_launch: hipFuncSetAttribute failed\n"); grid = -1; return; }
        if (hipOccupancyMaxActiveBlocksPerMultiprocessor(&per_cu, (const void*)mk_fwd, NWAVES * 64, LDS_BYTES) != hipSuccess || per_cu < 1) { fprintf(stderr, "kernel_launch: occupancy query says %d\n", per_cu); }
        (void)hipGetLastError();
        grid = cus;
    }
    if (grid < 0) return;
    if (hipMemsetAsync((char*)d_ws + WS_CTL, 0, CTL_ZERO_BYTES, stream) != hipSuccess) return;
    Args a{};
    for (int i = 0; i < 23; ++i) a.in[i] = (const float*)d_in[i];
    a.out = (float*)d_out; a.ws = (unsigned char*)d_ws;
#if MK_ONE_LAUNCH
    a.ph_lo = 0; a.ph_hi = N_PHASES;
    hipLaunchKernelGGL(mk_fwd, dim3(grid), dim3(NWAVES * 64), LDS_BYTES, stream, a);
#endif
}
```

```cpp
#include <hip/hip_runtime.h>
#include <cstdio>
#include <cstdint>

#ifndef MK_ONE_LAUNCH
#define MK_ONE_LAUNCH 1
#endif
#ifndef PROBE_PHASE
#define PROBE_PHASE 0
#endif
#ifndef EN_P0
#define EN_P0 MK_ONE_LAUNCH
#endif
#ifndef EN_PREP
#define EN_PREP MK_ONE_LAUNCH
#endif
#ifndef EN_DSA
#define EN_DSA MK_ONE_LAUNCH
#endif
#ifndef DIS_MASK
#define DIS_MASK 0
#endif
#ifndef MK_ONE_LAUNCH
#define MK_ONE_LAUNCH 1
#endif

__device__ __forceinline__ int lane_id_v() { int l; asm volatile("v_mbcnt_lo_u32_b32 %0, -1, 0\n\tv_mbcnt_hi_u32_b32 %0, -1, %0" : "=v"(l)); return l; }
namespace pg8 {
#define PG8_LAS __attribute__((address_space(3)))
typedef unsigned short bf16_t;
typedef short bf16x8 __attribute__((ext_vector_type(8)));
typedef float f32x4 __attribute__((ext_vector_type(4)));
typedef unsigned u32x4 __attribute__((ext_vector_type(4)));
typedef unsigned u32x2 __attribute__((ext_vector_type(2)));
constexpr int BM = 256, BK = 64, HALF = 128, HTB = HALF * BK * 2, STAGE_BYTES = 8 * HTB, NXCD = 8, WGM = 8;

__host__ __device__ __forceinline__ int lds_byte(int r, int c) { const int st = (r >> 4) * 2 + (c >> 5), rr = r & 15, cc = c & 31, ob = rr * 64 + cc * 2; return st * 1024 + (ob ^ (((ob >> 9) & 1) << 5)); }
__host__ __device__ __forceinline__ void stage_rc(int b, int& R, int& C) { const int st = b / 1024, sb = b % 1024, swz = sb ^ (((sb >> 9) & 1) << 5); R = (st >> 1) * 16 + swz / 64; C = (st & 1) * 32 + (swz % 64) / 2; }
__host__ __device__ __forceinline__ int perm32(int rho) { const int n = rho >> 4, i = rho & 15; return 8 * (i >> 2) + 4 * n + (i & 3); }

struct Unit { int pm, pn; };
struct Gemm { const bf16_t* A; const bf16_t* Bt; int M, N, K; };

struct StaticOrder {
    int nM, nN, nwg, G, c;
    __host__ __device__ void init(int M, int N, int G_, int c_) { nM = M / BM; nN = N / BM; nwg = nM * nN; G = G_; c = c_; }
    __host__ __device__ bool next(int i, Unit& u) const {
        const long L = (long)i * G + c; if (L >= nwg) return false;
        int wgid = (int)L; { const int q = nwg / NXCD, r = nwg % NXCD, xcd = wgid % NXCD, off = wgid / NXCD; wgid = (xcd < r ? xcd * (q + 1) : r * (q + 1) + (xcd - r) * q) + off; }
        const int nig = WGM * nN, gid = wgid / nig, fm = gid * WGM, gsz = (nM - fm) < WGM ? (nM - fm) : WGM;
        u.pm = fm + ((wgid % nig) % gsz); u.pn = (wgid % nig) / gsz; return true;
    }
    __device__ __forceinline__ void a_ready(const Unit&) const {}
    __device__ __forceinline__ void done(const Unit&) const {}
};

__device__ __forceinline__ unsigned cvt_pk_bf16(float lo, float hi) { unsigned r; asm volatile("v_cvt_pk_bf16_f32 %0, %1, %2" : "=v"(r) : "v"(lo), "v"(hi)); return r; }

template <class Epi, class Sched, bool ALIGN_EPI = false, bool SP2 = false>
__device__ __forceinline__ void gemm_phase(PG8_LAS unsigned char* lds, const Gemm g, const Sched& S, const Epi& E, const int wid_) {
    int wid = wid_; asm volatile("" : "+s"(wid));
    const int lane = lane_id_v(), tid = wid * 64 + lane,
              wr = wid >> 2, wc = wid & 3, fr = lane & 15, fq = lane >> 4;
    const int K = g.K, nt = K / BK;
    unsigned voffA[2], voffB[2];
#pragma unroll
    for (int i = 0; i < 2; ++i) { int R, C; stage_rc(tid * 16 + i * 8192, R, C); const int Rb = Epi::PERM ? ((R & ~31) + perm32(R & 31)) : R;
        voffA[i] = (unsigned)(R * K + C) * 2u; voffB[i] = (unsigned)(Rb * K + C) * 2u; }
    const size_t kstep = (size_t)(BK * 2);
    const size_t hstep = (size_t)HALF * K * 2;
    const size_t tstep = 2 * hstep;
    const unsigned ldsw = (unsigned)wid * 1024u;
    const int aoff = lds_byte(wr * 64 + fr, fq * 8), boff = lds_byte(wc * 32 + fr, fq * 8);
#define PG8_SA(b, h) (((b) * 2 + (h)) * HTB)
#define PG8_SB(b, h) ((4 + (b) * 2 + (h)) * HTB)
#define PG8_STAGE(bufoff, gbase, voff) do { _Pragma("unroll") for (int _i = 0; _i < 2; ++_i) \
        __builtin_amdgcn_global_load_lds((const unsigned*)((const char*)(gbase) + (voff)[_i]), (PG8_LAS unsigned*)(lds + (bufoff) + ldsw + _i * 8192), 16, 0, 0); } while (0)
#define PG8_LDA(dst, b, h) do { _Pragma("unroll") for (int m = 0; m < 4; ++m) _Pragma("unroll") for (int k = 0; k < 2; ++k) dst[m][k] = *(const PG8_LAS bf16x8*)(lds + PG8_SA(b, h) + aoff + m * 2048 + k * 1024); } while (0)
#define PG8_LDB(dst, b, h) do { _Pragma("unroll") for (int n = 0; n < 2; ++n) _Pragma("unroll") for (int k = 0; k < 2; ++k) dst[n][k] = *(const PG8_LAS bf16x8*)(lds + PG8_SB(b, h) + boff + n * 2048 + k * 1024); } while (0)
#define PG8_MMA(ai, bj, At, Bt) do { __builtin_amdgcn_s_setprio(1); _Pragma("unroll") for (int m = 0; m < 4; ++m) _Pragma("unroll") for (int n = 0; n < 2; ++n) _Pragma("unroll") for (int k = 0; k < 2; ++k) \
        acc[ai][bj][m][n] = __builtin_amdgcn_mfma_f32_16x16x32_bf16(Bt[n][k], At[m][k], acc[ai][bj][m][n], 0, 0, 0); __builtin_amdgcn_s_setprio(0); } while (0)
#define PG8_WAIT_V(n) asm volatile("s_waitcnt vmcnt(" #n ")" ::: "memory")
#define PG8_WAIT_L(n) asm volatile("s_waitcnt lgkmcnt(" #n ")" ::: "memory")
#define PG8_BAR __builtin_amdgcn_s_barrier()
#define PG8_SCHED __builtin_amdgcn_sched_barrier(0)
    Unit cur, nxt; int ui = 0;
    if (!S.next(0, cur)) return;
    f32x4 acc[2][2][4][2];
#pragma unroll
    for (int a = 0; a < 2; ++a)
#pragma unroll
        for (int b = 0; b < 2; ++b)
#pragma unroll
            for (int m = 0; m < 4; ++m)
#pragma unroll
                for (int n = 0; n < 2; ++n) acc[a][b][m][n] = (f32x4){0.f, 0.f, 0.f, 0.f};
    bf16x8 At[4][2], B0[2][2], B1[2][2];
    const char* cA = (const char*)g.A + (size_t)cur.pm * tstep; const char* cB = (const char*)g.Bt + (size_t)cur.pn * tstep;
    S.a_ready(cur);
    if constexpr (SP2) {
        PG8_STAGE(PG8_SB(0, 0), cB, voffB); PG8_STAGE(PG8_SB(0, 1), cB + hstep, voffB); PG8_STAGE(PG8_SA(0, 0), cA, voffA); PG8_STAGE(PG8_SA(0, 1), cA + hstep, voffA);
        if (wr == 1) PG8_BAR;
        PG8_WAIT_V(2); PG8_BAR;
        PG8_STAGE(PG8_SB(1, 0), cB + kstep, voffB); PG8_STAGE(PG8_SA(1, 0), cA + kstep, voffA); PG8_STAGE(PG8_SB(1, 1), cB + hstep + kstep, voffB);
        PG8_WAIT_V(6); PG8_BAR;
    } else {
        PG8_STAGE(PG8_SB(0, 0), cB, voffB); PG8_STAGE(PG8_SA(0, 0), cA, voffA); PG8_STAGE(PG8_SB(0, 1), cB + hstep, voffB); PG8_STAGE(PG8_SA(0, 1), cA + hstep, voffA);
        if (wr == 1) PG8_BAR;
        PG8_WAIT_V(4); PG8_BAR;
        PG8_STAGE(PG8_SB(1, 0), cB + kstep, voffB); PG8_STAGE(PG8_SA(1, 0), cA + kstep, voffA); PG8_STAGE(PG8_SB(1, 1), cB + hstep + kstep, voffB);
        PG8_WAIT_V(6); PG8_BAR;
    }
    for (;;) {
        const bool has_next = S.next(ui + 1, nxt);
        const char* nA = has_next ? (const char*)g.A + (size_t)nxt.pm * tstep : cA; const char* nB = has_next ? (const char*)g.Bt + (size_t)nxt.pn * tstep : cB;
        for (int t = 0; t < nt; t += 2) {
            const bool last = (t == nt - 2);
            const char* a1 = cA + (size_t)(t + 1) * kstep;
            const char* a2 = last ? nA : cA + (size_t)(t + 2) * kstep; const char* b2 = last ? nB : cB + (size_t)(t + 2) * kstep;
            const char* a3 = a2 + kstep; const char* b3 = b2 + kstep;
            if (last && has_next) S.a_ready(nxt);
            if constexpr (SP2) {
            PG8_LDB(B0, 0, 0); PG8_LDB(B1, 0, 1); PG8_SCHED; PG8_LDA(At, 0, 0); PG8_STAGE(PG8_SA(1, 1), a1 + hstep, voffA);
            PG8_WAIT_V(8); PG8_WAIT_L(0); PG8_BAR; PG8_MMA(0, 0, At, B0); PG8_MMA(0, 1, At, B1); PG8_BAR; PG8_SCHED;
            PG8_LDA(At, 0, 1); PG8_STAGE(PG8_SB(0, 0), b2, voffB); PG8_STAGE(PG8_SB(0, 1), b2 + hstep, voffB); PG8_STAGE(PG8_SA(0, 0), a2, voffA);
            PG8_WAIT_V(8); PG8_WAIT_L(0); PG8_BAR; PG8_MMA(1, 0, At, B0); PG8_MMA(1, 1, At, B1); PG8_BAR; PG8_SCHED;
            PG8_LDB(B0, 1, 0); PG8_LDB(B1, 1, 1); PG8_SCHED; PG8_LDA(At, 1, 0); PG8_STAGE(PG8_SA(0, 1), a2 + hstep, voffA);
            PG8_WAIT_V(8); PG8_WAIT_L(0); PG8_BAR; PG8_MMA(0, 0, At, B0); PG8_MMA(0, 1, At, B1); PG8_BAR; PG8_SCHED;
            PG8_LDA(At, 1, 1); PG8_STAGE(PG8_SB(1, 0), b3, voffB); PG8_STAGE(PG8_SB(1, 1), b3 + hstep, voffB); PG8_STAGE(PG8_SA(1, 0), a3, voffA);
            PG8_WAIT_V(8); PG8_WAIT_L(0); PG8_BAR; PG8_MMA(1, 0, At, B0); PG8_MMA(1, 1, At, B1); PG8_BAR; PG8_SCHED;
            } else {
            PG8_LDB(B0, 0, 0); PG8_SCHED; PG8_LDA(At, 0, 0); PG8_STAGE(PG8_SA(1, 1), a1 + hstep, voffA);
            PG8_WAIT_L(8); PG8_BAR; PG8_WAIT_L(0); PG8_MMA(0, 0, At, B0); PG8_BAR; PG8_SCHED;
            PG8_LDB(B1, 0, 1); PG8_STAGE(PG8_SB(0, 0), b2, voffB);
            PG8_BAR; PG8_WAIT_L(0); PG8_MMA(0, 1, At, B1); PG8_BAR;
            PG8_LDA(At, 0, 1); PG8_STAGE(PG8_SA(0, 0), a2, voffA);
            PG8_BAR; PG8_WAIT_L(0); PG8_MMA(1, 0, At, B0); PG8_BAR; PG8_SCHED;
            PG8_STAGE(PG8_SB(0, 1), b2 + hstep, voffB);
            PG8_WAIT_V(6); PG8_BAR; PG8_MMA(1, 1, At, B1); PG8_BAR;
            PG8_LDB(B0, 1, 0); PG8_SCHED; PG8_LDA(At, 1, 0); PG8_STAGE(PG8_SA(0, 1), a2 + hstep, voffA);
            PG8_WAIT_L(8); PG8_BAR; PG8_WAIT_L(0); PG8_MMA(0, 0, At, B0); PG8_BAR; PG8_SCHED;
            PG8_LDB(B1, 1, 1); PG8_STAGE(PG8_SB(1, 0), b3, voffB);
            PG8_BAR; PG8_WAIT_L(0); PG8_MMA(0, 1, At, B1); PG8_BAR;
            PG8_LDA(At, 1, 1); PG8_STAGE(PG8_SA(1, 0), a3, voffA);
            PG8_BAR; PG8_WAIT_L(0); PG8_MMA(1, 0, At, B0); PG8_BAR; PG8_SCHED;
            PG8_STAGE(PG8_SB(1, 1), b3 + hstep, voffB);
            PG8_WAIT_V(6); PG8_BAR; PG8_MMA(1, 1, At, B1); PG8_BAR;
            }
        }
        if constexpr (ALIGN_EPI) { if (wr == 0) PG8_BAR; }
        E(acc, cur, wr, wc, fr, fq); S.done(cur);
        if (!has_next) break;
#pragma unroll
        for (int a = 0; a < 2; ++a)
#pragma unroll
            for (int b = 0; b < 2; ++b)
#pragma unroll
                for (int m = 0; m < 4; ++m)
#pragma unroll
                    for (int n = 0; n < 2; ++n) acc[a][b][m][n] = (f32x4){0.f, 0.f, 0.f, 0.f};
        cur = nxt; cA = nA; cB = nB; ++ui;
        if constexpr (ALIGN_EPI) { if (wr == 1) PG8_BAR; }
    }
    PG8_WAIT_V(0);
    if constexpr (!ALIGN_EPI) { if (wr == 0) PG8_BAR; }
    PG8_BAR;
#undef PG8_SA
#undef PG8_SB
#undef PG8_STAGE
#undef PG8_LDA
#undef PG8_LDB
#undef PG8_MMA
#undef PG8_WAIT_V
#undef PG8_WAIT_L
#undef PG8_BAR
#undef PG8_SCHED
}
}

constexpr int NWAVES = 8;
constexpr int BATCH = 4, SEQ = 8192, D = 1024, DEPTH = 4, M = BATCH * SEQ;
constexpr int NMEM = 256, MROWS = BATCH * NMEM;
constexpr int AH = 8, AHD = 64, AW = 512, KVR = 128, IH = 8, IDIM = 32, TOPK = 256;
constexpr int PW_ = 256, CH = 4, CHD = 64, CW = 256;
constexpr int DFF = 2816, INW = 4520, INP = 5120;
constexpr float EPS = 1e-6f;
constexpr int C_QA = 0, C_CKV = 512, C_IQ = 640, C_IK = 896, C_IW = 928, C_Z = 936, C_QC = 1192, C_G = 1448;

constexpr size_t MiB = 1u << 20;
constexpr size_t WS_CTL = 0, CTL_ZERO_BYTES = 1 * MiB;
constexpr size_t WS_SS = 1 * MiB;
constexpr size_t WS_IW = 3 * MiB;
constexpr size_t WS_SGN = 4 * MiB;
constexpr size_t WS_MEMN = 5 * MiB;
constexpr size_t WS_WMEM = 7 * MiB;
constexpr size_t WS_MEMKV = 11 * MiB;
constexpr size_t WS_W1IN = 15 * MiB, WS_W1OUT = 26 * MiB, WS_WIN = 32 * MiB, WS_WA = 42 * MiB, WS_WB = 44 * MiB, WS_WC = 44 * MiB + 512 * 1024, WS_WOUT = 45 * MiB, WS_W2IN = 47 * MiB, WS_W2OUT = 58 * MiB;
constexpr size_t WS_HB = 64 * MiB;
constexpr size_t WS_ACT = 128 * MiB;
constexpr size_t WS_G = 128 * MiB;
constexpr size_t WS_QL = 320 * MiB;
constexpr size_t WS_CKV = 384 * MiB;
constexpr size_t WS_CKVRAW = 392 * MiB;
constexpr size_t WS_IQRAW = 408 * MiB;
constexpr size_t WS_IQF = 424 * MiB;
constexpr size_t WS_IK = 440 * MiB;
constexpr size_t WS_Z = 442 * MiB;
constexpr size_t WS_MERGED = 384 * MiB;
constexpr size_t WS_YB = 458 * MiB;
constexpr size_t WS_QC = 474 * MiB;
constexpr size_t WS_SEL = 490 * MiB;
constexpr size_t WS_VT = 506 * MiB;
constexpr size_t WS_WPT = 4 * MiB + 512 * 1024;
constexpr size_t WS_END = 510 * MiB;
constexpr int CW_BAR = 4096;

constexpr int RING_OFF = 0, RING_BYTES = 131072;
constexpr int LDS_BYTES = 155648;
constexpr int MISC_OFF = LDS_BYTES - 256;

#define GAS __attribute__((address_space(1)))
#define LAS __attribute__((address_space(3)))
typedef unsigned short bf16;
typedef unsigned v4u __attribute__((ext_vector_type(4)));
typedef unsigned v2u __attribute__((ext_vector_type(2)));
typedef float f32x4 __attribute__((ext_vector_type(4)));
typedef float f32x2 __attribute__((ext_vector_type(2)));
typedef GAS unsigned gu32;
#define RLX_AGENT __ATOMIC_RELAXED, __HIP_MEMORY_SCOPE_AGENT
#define LDS_WAIT() asm volatile("s_waitcnt lgkmcnt(0)" ::: "memory")
#define VM_WAIT() asm volatile("s_waitcnt vmcnt(0)" ::: "memory")
__device__ __forceinline__ unsigned f2bf(float f) { unsigned u = __builtin_bit_cast(unsigned, f); return (u + 0x7fffu + ((u >> 16) & 1u)) >> 16; }
__device__ __forceinline__ unsigned pk2(float lo, float hi) { return f2bf(lo) | (f2bf(hi) << 16); }
__device__ __forceinline__ float bflo(unsigned w) { return __builtin_bit_cast(float, w << 16); }
__device__ __forceinline__ float bfhi(unsigned w) { return __builtin_bit_cast(float, w & 0xffff0000u); }
typedef _Float16 h2_t __attribute__((ext_vector_type(2)));
typedef _Float16 f16x8_t __attribute__((ext_vector_type(8)));
__device__ __forceinline__ unsigned pkh2(float lo, float hi) { const h2_t v = {(_Float16)lo, (_Float16)hi}; return __builtin_bit_cast(unsigned, v); }
__device__ __forceinline__ float hlo(unsigned w) { return (float)__builtin_bit_cast(h2_t, w)[0]; }
__device__ __forceinline__ float hhi(unsigned w) { return (float)__builtin_bit_cast(h2_t, w)[1]; }
__device__ __forceinline__ float bf2f(bf16 b) { return __builtin_bit_cast(float, ((unsigned)b) << 16); }

#define XB_TMO      128
#define XB_XCNT(j)  (256  + 64 * (j))
#define XB_XSUB(j)  (1280 + 64 * (j))
#define XB_XGEN(j)  (2304 + 64 * (j))
#define XB_TOP      3328
#define XB_TOPGEN   3392
#define XCD_BAR_WORDS 3456
#define XB_SPIN_CAP (1u << 23)

__device__ __forceinline__ unsigned xb_ld(unsigned* p)              { return __hip_atomic_load(p, __ATOMIC_RELAXED, __HIP_MEMORY_SCOPE_AGENT); }
__device__ __forceinline__ unsigned xb_add(unsigned* p, unsigned v) { return __hip_atomic_fetch_add(p, v, __ATOMIC_RELAXED, __HIP_MEMORY_SCOPE_AGENT); }
__device__ __forceinline__ unsigned xb_xcc_id() { return (unsigned)__builtin_amdgcn_s_getreg((3 << 11) | 20) & 0xFu; }
#define XB_SPIN(cond, bar) do { unsigned _sp = 0; while (cond) { __builtin_amdgcn_s_sleep(1); \
    if ((++_sp & 255u) == 0u) { if (xb_ld(&(bar)[XB_TMO])) break; if (_sp > XB_SPIN_CAP) { atomicAdd(&(bar)[XB_TMO], 1u); break; } } } } while (0)

struct XcdBarrier { unsigned* bar; unsigned x; volatile LAS unsigned* st; int wave; };

__device__ __forceinline__ XcdBarrier xcd_barrier_post(unsigned* bar, volatile LAS unsigned* st, int wave) {
    XcdBarrier b; b.bar = bar; b.x = xb_xcc_id(); b.st = st; b.wave = wave;
    if (threadIdx.x == 0) (void)xb_add(&bar[XB_XCNT(b.x)], 1u);
    return b;
}
__device__ __forceinline__ void xcd_barrier_complete(unsigned* bar, unsigned x, unsigned& nloc, unsigned& nx) {
    const unsigned G = gridDim.x * gridDim.y * gridDim.z;
    unsigned sum, cnt, mine, sp = 0u;
    for (;;) {
        sum = 0u; cnt = 0u; mine = 0u;
#pragma unroll
        for (unsigned j = 0; j < 16; ++j) { const unsigned c = xb_ld(&bar[XB_XCNT(j)]); sum += c; cnt += (c > 0u) ? 1u : 0u; mine = (j == x) ? c : mine; }
        if (sum == G) break;
        __builtin_amdgcn_s_sleep(1);
        if ((++sp & 255u) == 0u) { if (xb_ld(&bar[XB_TMO])) break; if (sp > XB_SPIN_CAP) { atomicAdd(&bar[XB_TMO], 1u); break; } }
    }
    nloc = mine > 0u ? mine : 1u; nx = cnt > 0u ? cnt : 1u;
}
__device__ __forceinline__ void xcd_barrier(const XcdBarrier& b) {
    asm volatile("s_waitcnt vmcnt(0)" ::: "memory");
    __syncthreads();
    int bw_ = b.wave; asm volatile("" : "+s"(bw_));
    if (bw_ == 0 && lane_id_v() == 0) {
        unsigned* bar = b.bar;
        __builtin_amdgcn_s_waitcnt(0);
        unsigned nloc = b.st[0], nx = b.st[1];
        if (nloc == 0u) { xcd_barrier_complete(bar, b.x, nloc, nx); b.st[0] = nloc; b.st[1] = nx; }
        const unsigned old = xb_add(&bar[XB_XSUB(b.x)], 1u);
        const unsigned gen = old / nloc;
        if (old + 1u == (gen + 1u) * nloc) {
            __builtin_amdgcn_fence(__ATOMIC_RELEASE, "agent");
            asm volatile("s_waitcnt vmcnt(0)" ::: "memory");
            const unsigned og = xb_add(&bar[XB_TOP], 1u);
            const unsigned tg = og / nx;
            if (og + 1u == (tg + 1u) * nx) xb_add(&bar[XB_TOPGEN], 1u);
            else XB_SPIN(xb_ld(&bar[XB_TOPGEN]) == tg, bar);
            __builtin_amdgcn_fence(__ATOMIC_ACQUIRE, "agent");
            xb_add(&bar[XB_XGEN(b.x)], 1u);
            asm volatile("s_waitcnt vmcnt(0)" ::: "memory");
        } else {
            XB_SPIN(xb_ld(&bar[XB_XGEN(b.x)]) == gen, bar);
            __builtin_amdgcn_fence(__ATOMIC_ACQUIRE, "agent");
            asm volatile("s_waitcnt vmcnt(0)" ::: "memory");
        }
    }
    __syncthreads();
}

struct Args {
    const float* in[23]; float* out; unsigned char* ws; int ph_lo, ph_hi;
};
template <class T> __device__ __forceinline__ T* uni(T* p) { const unsigned long long v = (unsigned long long)p; const unsigned lo = __builtin_amdgcn_readfirstlane((unsigned)v), hi = __builtin_amdgcn_readfirstlane((unsigned)(v >> 32)); return (T*)(((unsigned long long)hi << 32) | lo); }
__device__ __forceinline__ LAS unsigned char* uni_l(LAS unsigned char* p) { return (LAS unsigned char*)(unsigned)__builtin_amdgcn_readfirstlane((int)(unsigned)(size_t)p); }
__device__ __forceinline__ int uni_i(int v) { return __builtin_amdgcn_readfirstlane(v); }
struct PC { const float* const* in; float* out; unsigned char* ws; LAS unsigned char* lds; int wave, vcu, G; };
struct Frame {
    LAS unsigned char* lds;
    volatile LAS unsigned* MISC;
    gu32* ctl;
    int wave, vcu, G;
    unsigned char* ws;
};
__device__ __forceinline__ unsigned char* launder_p(unsigned char* p) { asm volatile("" : "+s"(p)); return p; }
__device__ __forceinline__ int launder_s(int v) { asm volatile("" : "+s"(v)); return v; }
__device__ __forceinline__ int launder_v(int v) { asm volatile("" : "+v"(v)); return v; }
__device__ __forceinline__ float wave_sum(float v) {
#pragma unroll
    for (int o = 1; o < 64; o <<= 1) v += __shfl_xor(v, o);
    return v;
}
__device__ __forceinline__ float wave_max(float v) {
#pragma unroll
    for (int o = 1; o < 64; o <<= 1) v = fmaxf(v, __shfl_xor(v, o));
    return v;
}

using pg8::Unit; using pg8::bf16_t;
#define LAUNDER2(a, b) asm volatile("" : "+v"(a), "+v"(b))
__device__ __forceinline__ float row_scale(const float* ss, int row) {
    const f32x4 a = *(const f32x4*)(ss + (size_t)row * 4);
    const float s = (a.x + a.y) + (a.z + a.w);
    return __builtin_amdgcn_rsqf(s * (1.0f / D) + EPS);
}
__device__ __forceinline__ float sigmoidf_(float x) { return 1.0f / (1.0f + __expf(-x)); }
__device__ __forceinline__ pg8::u32x2 pack4(const f32x4 v) { pg8::u32x2 w; w.x = pg8::cvt_pk_bf16(v[0], v[1]); w.y = pg8::cvt_pk_bf16(v[2], v[3]); return w; }

struct EpiSwiglu {
    static constexpr bool PERM = true;
    bf16_t* O; const float* ss;
    __device__ __forceinline__ void operator()(const f32x4 (&acc)[2][2][4][2], const Unit& u, int wr, int wc, int fr_, int fq_) const {
        const int l_ = lane_id_v(); const int fr = l_ & 15, fq = l_ >> 4; (void)fr_; (void)fq_;
        int rb = wr * 64 + fr, cb = wc * 32 + 8 * fq; LAUNDER2(rb, cb);
        const int row0 = u.pm * 256 + rb, col0 = u.pn * 128 + cb;
#pragma unroll
        for (int ai = 0; ai < 2; ++ai)
#pragma unroll
            for (int m = 0; m < 4; ++m) { const int row = row0 + ai * 128 + m * 16; const float s = row_scale(ss, row);
                pg8::u32x4 w;
                { const f32x4 a = acc[ai][0][m][0] * s, b = acc[ai][1][m][0] * s; f32x4 o;
#pragma unroll
                  for (int i = 0; i < 4; ++i) o[i] = a[i] * sigmoidf_(a[i]) * b[i];
                  w.x = pg8::cvt_pk_bf16(o[0], o[1]); w.y = pg8::cvt_pk_bf16(o[2], o[3]); }
                { const f32x4 a = acc[ai][0][m][1] * s, b = acc[ai][1][m][1] * s; f32x4 o;
#pragma unroll
                  for (int i = 0; i < 4; ++i) o[i] = a[i] * sigmoidf_(a[i]) * b[i];
                  w.z = pg8::cvt_pk_bf16(o[0], o[1]); w.w = pg8::cvt_pk_bf16(o[2], o[3]); }
                *(pg8::u32x4*)(O + (size_t)row * DFF + col0) = w; }
    }
};
struct EpiResid {
    static constexpr bool PERM = true;
    const float* base; float* out; bf16_t* hb; float* ss; float alpha; LAS float* P; int dry;
    __device__ __forceinline__ void operator()(const f32x4 (&acc)[2][2][4][2], const Unit& u, int wr, int wc, int fr_, int fq_) const {
        const int l_ = lane_id_v(); const int fr = l_ & 15, fq = l_ >> 4; (void)fr_; (void)fq_;
        int rb = wr * 64 + fr, cb = wc * 32 + 8 * fq; LAUNDER2(rb, cb);
        const int row0 = u.pm * 256 + rb, col0 = u.pn * 256 + cb;
#pragma unroll
        for (int ai = 0; ai < 2; ++ai)
#pragma unroll
          for (int mh = 0; mh < 2; ++mh) {
            f32x4 bs[2][2][2];
#pragma unroll
            for (int mm = 0; mm < 2; ++mm) { const size_t off = (size_t)(row0 + ai * 128 + (2 * mh + mm) * 16) * D + col0;
#pragma unroll
                for (int bj = 0; bj < 2; ++bj)
#pragma unroll
                    for (int n = 0; n < 2; ++n) bs[mm][bj][n] = *(const f32x4*)(base + off + bj * 128 + n * 4); }
#pragma unroll
            for (int mm = 0; mm < 2; ++mm) { const int m = 2 * mh + mm; const int row = row0 + ai * 128 + m * 16; const size_t off = (size_t)row * D + col0; float q = 0.f;
#pragma unroll
                for (int bj = 0; bj < 2; ++bj) { const f32x4 v0 = bs[mm][bj][0] + acc[ai][bj][m][0] * alpha, v1 = bs[mm][bj][1] + acc[ai][bj][m][1] * alpha;
                    if (!dry) { *(f32x4*)(out + off + bj * 128) = v0; *(f32x4*)(out + off + bj * 128 + 4) = v1;
                        pg8::u32x4 w; w.x = pg8::cvt_pk_bf16(v0[0], v0[1]); w.y = pg8::cvt_pk_bf16(v0[2], v0[3]); w.z = pg8::cvt_pk_bf16(v1[0], v1[1]); w.w = pg8::cvt_pk_bf16(v1[2], v1[3]);
                        *(pg8::u32x4*)(hb + off + bj * 128) = w; }
                    q += ((v0[0] * v0[0] + v0[1] * v0[1]) + (v0[2] * v0[2] + v0[3] * v0[3])) + ((v1[0] * v1[0] + v1[1] * v1[1]) + (v1[2] * v1[2] + v1[3] * v1[3])); }
                q += __shfl_xor(q, 16); q += __shfl_xor(q, 32);
                if (fq == 0) P[(rb + ai * 128 + m * 16) * 4 + wc] = q; }
            asm volatile("" ::: "memory"); }
        asm volatile("s_waitcnt lgkmcnt(0)" ::: "memory"); __builtin_amdgcn_s_barrier(); asm volatile("" ::: "memory");
        const int tid = (wr * 4 + wc) * 64 + fq * 16 + fr;
        if (tid < 256 && !dry) { const f32x4 p = *(const LAS f32x4*)(P + tid * 4); ss[(size_t)(u.pm * 256 + tid) * 4 + u.pn] = (p.x + p.y) + (p.z + p.w); }
    }
};
struct EpiPlainBf16 {
    static constexpr bool PERM = false;
    bf16_t* O; int ldo;
    __device__ __forceinline__ void operator()(const f32x4 (&acc)[2][2][4][2], const Unit& u, int wr, int wc, int fr_, int fq_) const {
        const int l_ = lane_id_v(); const int fr = l_ & 15, fq = l_ >> 4; (void)fr_; (void)fq_;
        int rb = wr * 64 + fr, cb = wc * 32 + 4 * fq; LAUNDER2(rb, cb);
        const int row0 = u.pm * 256 + rb, col0 = u.pn * 256 + cb;
#pragma unroll
        for (int ai = 0; ai < 2; ++ai)
#pragma unroll
            for (int m = 0; m < 4; ++m) { bf16_t* rowp = O + (size_t)(row0 + ai * 128 + m * 16) * ldo + col0;
#pragma unroll
                for (int bj = 0; bj < 2; ++bj)
#pragma unroll
                    for (int n = 0; n < 2; ++n) *(pg8::u32x2*)(rowp + bj * 128 + n * 16) = pack4(acc[ai][bj][m][n]); }
    }
};
struct EpiInProj {
    static constexpr bool PERM = true;
    const float* ss; bf16_t* qa; float* ckvraw; bf16_t* ik; float* iw; bf16_t* iqraw; bf16_t* z; bf16_t* qc; bf16_t* G;
    __device__ __forceinline__ void operator()(const f32x4 (&acc)[2][2][4][2], const Unit& u, int wr, int wc, int fr_, int fq_) const {
        const int l_ = lane_id_v(); const int fr = l_ & 15, fq = l_ >> 4; (void)fr_; (void)fq_;
        int rb = wr * 64 + fr, ct = wc * 32 + 8 * fq; LAUNDER2(rb, ct);
        const int row0 = u.pm * 256 + rb; const int pn = u.pn;
        if (pn == 4) {
#pragma unroll
            for (int ai = 0; ai < 2; ++ai)
#pragma unroll
                for (int m = 0; m < 4; ++m) { const int row = row0 + ai * 128 + m * 16; const float s = row_scale(ss, row);
#pragma unroll
                    for (int n = 0; n < 2; ++n) *(f32x4*)(ckvraw + (size_t)row * KVR + ct + n * 4) = acc[ai][0][m][n] * s;
                    if (wc == 0) { const f32x4 k0 = acc[ai][1][m][0] * s, k1 = acc[ai][1][m][1] * s; pg8::u32x4 w; w.x = pkh2(k0[0], k0[1]); w.y = pkh2(k0[2], k0[3]); w.z = pkh2(k1[0], k1[1]); w.w = pkh2(k1[2], k1[3]);
                        *(pg8::u32x4*)(ik + (size_t)row * IDIM + 8 * fq) = w; }
                    if (wc == 1 && fq == 0) { *(f32x4*)(iw + (size_t)row * IH) = acc[ai][1][m][0] * s; *(f32x4*)(iw + (size_t)row * IH + 4) = acc[ai][1][m][1] * s; } }
        } else {
            bf16_t* dst0; int ld; bool sig = false; const bool f16out = (pn == 5);
            if (pn < 4) { dst0 = qa + pn * 256; ld = 1024; } else if (pn == 5) { dst0 = iqraw; ld = 256; } else if (pn == 6) { dst0 = z; ld = 256; } else if (pn == 7) { dst0 = qc; ld = 256; } else { dst0 = G + (pn - 8) * 256; ld = 3072; sig = true; }
#pragma unroll
            for (int ai = 0; ai < 2; ++ai)
#pragma unroll
                for (int m = 0; m < 4; ++m) { const int row = row0 + ai * 128 + m * 16; const float s = row_scale(ss, row); bf16_t* rowp = dst0 + (size_t)row * ld + ct;
#pragma unroll
                    for (int bj = 0; bj < 2; ++bj) { f32x4 o0 = acc[ai][bj][m][0] * s, o1 = acc[ai][bj][m][1] * s;
                        if (sig) {
#pragma unroll
                            for (int i = 0; i < 4; ++i) { o0[i] = sigmoidf_(o0[i]); o1[i] = sigmoidf_(o1[i]); } }
                        pg8::u32x4 wo;
                        if (f16out) { wo.x = pkh2(o0[0], o0[1]); wo.y = pkh2(o0[2], o0[3]); wo.z = pkh2(o1[0], o1[1]); wo.w = pkh2(o1[2], o1[3]); }
                        else { wo.x = pg8::cvt_pk_bf16(o0[0], o0[1]); wo.y = pg8::cvt_pk_bf16(o0[2], o0[3]); wo.z = pg8::cvt_pk_bf16(o1[0], o1[1]); wo.w = pg8::cvt_pk_bf16(o1[2], o1[3]); }
                        *(pg8::u32x4*)(rowp + bj * 128) = wo; } }
        }
    }
};
template <int MODE> struct EpiMerge {
    static constexpr bool PERM = false;
    bf16_t* Mg; const bf16_t* G;
    __device__ __forceinline__ void operator()(const f32x4 (&acc)[2][2][4][2], const Unit& u, int wr, int wc, int fr_, int fq_) const {
        const int l_ = lane_id_v(); const int fr = l_ & 15, fq = l_ >> 4; (void)fr_; (void)fq_;
        int rb = wr * 64 + fr, cb = wc * 32 + 4 * fq; LAUNDER2(rb, cb);
        const int row0 = u.pm * 256 + rb, col0 = u.pn * 256 + cb;
#pragma unroll
        for (int ai = 0; ai < 2; ++ai)
#pragma unroll
          for (int mh = 0; mh < 2; ++mh) {
            pg8::u32x2 gw[2][2][2], pw[2][2][2];
#pragma unroll
            for (int mm = 0; mm < 2; ++mm) { const int row = row0 + ai * 128 + (2 * mh + mm) * 16;
                const bf16_t* gp = G + (size_t)row * 3072 + MODE * 1024 + col0; const bf16_t* mp = Mg + (size_t)row * D + col0;
#pragma unroll
                for (int bj = 0; bj < 2; ++bj)
#pragma unroll
                    for (int n = 0; n < 2; ++n) { gw[mm][bj][n] = *(const pg8::u32x2*)(gp + bj * 128 + n * 16); if (MODE > 0) pw[mm][bj][n] = *(const pg8::u32x2*)(mp + bj * 128 + n * 16); } }
#pragma unroll
            for (int mm = 0; mm < 2; ++mm) { const int m = 2 * mh + mm; const int row = row0 + ai * 128 + m * 16; bf16_t* mp = Mg + (size_t)row * D + col0;
#pragma unroll
                for (int bj = 0; bj < 2; ++bj)
#pragma unroll
                    for (int n = 0; n < 2; ++n) { f32x4 o = acc[ai][bj][m][n]; const pg8::u32x2 g = gw[mm][bj][n];
                        o[0] *= bflo(g.x); o[1] *= bfhi(g.x); o[2] *= bflo(g.y); o[3] *= bfhi(g.y);
                        if (MODE > 0) { const pg8::u32x2 p = pw[mm][bj][n]; o[0] += bflo(p.x); o[1] += bfhi(p.x); o[2] += bflo(p.y); o[3] += bfhi(p.y); }
                        *(pg8::u32x2*)(mp + bj * 128 + n * 16) = pack4(o); } }
            asm volatile("" ::: "memory"); }
    }
};

template <class Map>
__device__ __forceinline__ void transpose_item(const float* W, int K, int N, const float* gain, bf16* WT, LAS float* scr, int item, int lane, Map map) {
    const int nblk = (N + 63) / 64, kb = item / nblk, nb = item % nblk, k0 = 64 * kb, n0 = 64 * nb;
    const int nn = n0 + 4 * (lane & 15); const bool nok = nn < N;
#pragma unroll 4
    for (int i = 0; i < 16; ++i) { const int kk = 4 * i + (lane >> 4); f32x4 v = nok ? *(const f32x4*)(W + (size_t)(k0 + kk) * N + nn) : (f32x4){0.f, 0.f, 0.f, 0.f};
        if (gain) v = v * gain[k0 + kk];
        *(LAS f32x4*)(scr + kk * 68 + 4 * (lane & 15)) = v; }
    LDS_WAIT(); asm volatile("" ::: "memory");
    const int c = lane & 7;
#pragma unroll
    for (int j = 0; j < 8; ++j) { const int n = (lane >> 3) + 8 * j; const LAS float* sp = scr + (8 * c) * 68 + n;
        v4u o; o.x = pk2(sp[0 * 68], sp[1 * 68]); o.y = pk2(sp[2 * 68], sp[3 * 68]); o.z = pk2(sp[4 * 68], sp[5 * 68]); o.w = pk2(sp[6 * 68], sp[7 * 68]);
        if (n0 + n < N) { const int dr = map(n0 + n); if (dr >= 0) *(GAS v4u*)(WT + (size_t)dr * K + k0 + 8 * c) = o; } }
    LDS_WAIT(); asm volatile("" ::: "memory");
}
struct MapId { int off; __device__ __forceinline__ int operator()(int n) const { return off + n; } };
struct MapSwiglu { __device__ __forceinline__ int operator()(int c) const { const int half = c >= DFF ? 1 : 0, j = c - half * DFF; return 256 * (j >> 7) + 128 * half + (j & 127); } };
struct MapInProj { __device__ __forceinline__ int operator()(int c) const {
    if (c < C_CKV) return -1;
    if (c < C_IQ) return 1024 + (c - C_CKV);
    if (c < C_IK) return 1280 + (c - C_IQ);
    if (c < C_IW) return 1152 + (c - C_IK);
    if (c < C_Z) return 1184 + (c - C_IW);
    if (c < C_QC) return 1536 + (c - C_Z);
    if (c < C_G) return 1792 + (c - C_QC);
    return 2048 + (c - C_G); } };
__device__ __forceinline__ void qlat_item(const float* win, const float* mixn, const float* wuk, bf16* WT, int item, int lane) {
    const int kc = item & 127, rh = (item >> 7) & 1, h = item >> 8; const int r = rh * 64 + lane;
    const f32x4* wp = (const f32x4*)(wuk + (size_t)r * (AH * AHD) + h * 64);
    float acc[8] = {0.f, 0.f, 0.f, 0.f, 0.f, 0.f, 0.f, 0.f};
#pragma unroll 1
    for (int dc = 0; dc < 4; ++dc) {
        const f32x4 w0 = wp[4 * dc], w1 = wp[4 * dc + 1], w2 = wp[4 * dc + 2], w3 = wp[4 * dc + 3];
#pragma unroll
        for (int kk = 0; kk < 8; ++kk) { const f32x4* ip = (const f32x4*)(win + (size_t)(kc * 8 + kk) * INW + h * 64 + 16 * dc);
            const f32x4 a0 = ip[0], a1 = ip[1], a2 = ip[2], a3 = ip[3];
            acc[kk] += (a0.x * w0.x + a0.y * w0.y + a0.z * w0.z + a0.w * w0.w) + (a1.x * w1.x + a1.y * w1.y + a1.z * w1.z + a1.w * w1.w)
                     + (a2.x * w2.x + a2.y * w2.y + a2.z * w2.z + a2.w * w2.w) + (a3.x * w3.x + a3.y * w3.y + a3.z * w3.z + a3.w * w3.w);
            if (kk & 1) asm volatile("" ::: "memory"); }
    }
    const f32x4 g0 = *(const f32x4*)(mixn + kc * 8), g1 = *(const f32x4*)(mixn + kc * 8 + 4);
    v4u w; w.x = pk2(acc[0] * g0.x, acc[1] * g0.y); w.y = pk2(acc[2] * g0.z, acc[3] * g0.w); w.z = pk2(acc[4] * g1.x, acc[5] * g1.y); w.w = pk2(acc[6] * g1.z, acc[7] * g1.w);
    *(GAS v4u*)(WT + (size_t)(h * 128 + r) * D + kc * 8) = w;
}
__device__ __forceinline__ void wafold_item(const float* wuv, const float* wba, bf16* WT, int item, int lane) {
    const int ng = item & 15, rg = (item >> 4) & 15, h = item >> 8; const int n = ng * 64 + lane, r0 = rg * 8;
    float acc[8] = {0.f, 0.f, 0.f, 0.f, 0.f, 0.f, 0.f, 0.f};
#pragma unroll 4
    for (int d = 0; d < 64; ++d) { const float wa = wba[(size_t)(h * 64 + d) * D + n];
#pragma unroll
        for (int j = 0; j < 8; ++j) acc[j] += wuv[(size_t)(r0 + j) * (AH * AHD) + h * 64 + d] * wa; }
    v4u w; w.x = pk2(acc[0], acc[1]); w.y = pk2(acc[2], acc[3]); w.z = pk2(acc[4], acc[5]); w.w = pk2(acc[6], acc[7]);
    *(GAS v4u*)(WT + (size_t)n * 1024 + h * 128 + r0) = w;
}
__device__ __forceinline__ int items_of(int K, int N) { return (K / 64) * ((N + 63) / 64); }

__device__ __forceinline__ void prep_layer_weights_body(const PC& F, int l) {
    struct { const float* const* in; } a{F.in};
    const int lane_ = lane_id_v();
    LAS float* scr = (LAS float*)(F.lds + RING_OFF + F.wave * 17408);
    const int gw = F.vcu * NWAVES + F.wave, NGW = F.G * NWAVES;
    const float* f1n = a.in[3] + (size_t)l * D; const float* f1in = a.in[4] + (size_t)l * D * 2 * DFF; const float* f1out = a.in[5] + (size_t)l * DFF * D;
    const float* mixn = a.in[6] + (size_t)l * D; const float* win = a.in[7] + (size_t)l * D * INW;
    const float* wba = a.in[15] + (size_t)l * AW * D; const float* wbb = a.in[16] + (size_t)l * PW_ * D; const float* wbc = a.in[17] + (size_t)l * CW * D;
    const float* wout = a.in[18] + (size_t)l * D * D;
    const float* f2n = a.in[19] + (size_t)l * D; const float* f2in = a.in[20] + (size_t)l * D * 2 * DFF; const float* f2out = a.in[21] + (size_t)l * DFF * D;
    unsigned char* ws = launder_p(F.ws);
    const float* wuk = a.in[9] + (size_t)l * KVR * AH * AHD; const float* wuv = a.in[10] + (size_t)l * KVR * AH * AHD;
    const int I0 = items_of(D, 2 * DFF), I1 = items_of(DFF, D), I2 = items_of(D, INW), I4 = items_of(PW_, D), I5 = items_of(CW, D), I6 = items_of(D, D);
    const int NIT = 2 * I0 + 2 * I1 + I2 + I4 + I5 + I6;
#pragma unroll 1
    for (int it = gw; it < NIT; it += NGW) {
        int r = it;
        if (r < I0) { transpose_item(f1in, D, 2 * DFF, f1n, (bf16*)(ws + WS_W1IN), scr, r, lane_, MapSwiglu{}); continue; } r -= I0;
        if (r < I0) { transpose_item(f2in, D, 2 * DFF, f2n, (bf16*)(ws + WS_W2IN), scr, r, lane_, MapSwiglu{}); continue; } r -= I0;
        if (r < I1) { transpose_item(f1out, DFF, D, nullptr, (bf16*)(ws + WS_W1OUT), scr, r, lane_, MapId{0}); continue; } r -= I1;
        if (r < I1) { transpose_item(f2out, DFF, D, nullptr, (bf16*)(ws + WS_W2OUT), scr, r, lane_, MapId{0}); continue; } r -= I1;
        if (r < I2) { transpose_item(win, D, INW, mixn, (bf16*)(ws + WS_WIN), scr, r, lane_, MapInProj{}); continue; } r -= I2;
        if (r < I4) { transpose_item(wbb, PW_, D, nullptr, (bf16*)(ws + WS_WB), scr, r, lane_, MapId{0}); continue; } r -= I4;
        if (r < I5) { transpose_item(wbc, CW, D, nullptr, (bf16*)(ws + WS_WC), scr, r, lane_, MapId{0}); continue; } r -= I5;
        transpose_item(wout, D, D, nullptr, (bf16*)(ws + WS_WOUT), scr, r, lane_, MapId{0});
    }
    { const float* wpool = a.in[11] + (size_t)l * 4 * 64 * 64; bf16* wpT = (bf16*)(ws + WS_WPT);
      for (int i = gw * 64 + lane_; i < 4 * 64 * 64; i += NGW * 64) { const int c = i & 63, d = (i >> 6) & 63, g = i >> 12; wpT[i] = (bf16)f2bf(wpool[(g * 64 + c) * 64 + d]); } }
    asm volatile("" ::: "memory");
#pragma unroll 1
    for (int it = gw; it < 2048; it += NGW) wafold_item(wuv, wba, (bf16*)(ws + WS_WA), it, lane_);
    asm volatile("" ::: "memory");
#pragma unroll 1
    for (int it = gw; it < 2048; it += NGW) qlat_item(win, mixn, wuk, (bf16*)(ws + WS_WIN), it, lane_);
}

__device__ __noinline__ void p0_prologue(const float* const* in_, float* out_, unsigned char* ws_, LAS unsigned char* lds_, int wave_, int vcu_, int G_) {
    const PC F{uni(in_), uni(out_), uni(ws_), uni_l(lds_), uni_i(wave_), uni_i(vcu_), uni_i(G_)}; struct { const float* const* in; } a{F.in};
    const int lane_ = lane_id_v();
    const int gw = F.vcu * NWAVES + F.wave, NGW = F.G * NWAVES;
    const float* x = a.in[0]; const float* mem = a.in[1];
    bf16* hb = (bf16*)(F.ws + WS_HB); float* ss = (float*)(F.ws + WS_SS); bf16* memn = (bf16*)(F.ws + WS_MEMN);
    for (int m = gw; m < M + MROWS; m += NGW) {
        const bool ismem = m >= M; const int r = ismem ? m - M : m;
        const GAS f32x4* xr = (const GAS f32x4*)((ismem ? mem : x) + (size_t)r * D) + lane_;
        f32x4 v[4]; float s = 0.f;
#pragma unroll
        for (int j = 0; j < 4; ++j) { v[j] = xr[64 * j]; s += (v[j].x * v[j].x + v[j].y * v[j].y) + (v[j].z * v[j].z + v[j].w * v[j].w); }
        s = wave_sum(s);
        float sc = 1.f;
        if (ismem) sc = 1.0f / sqrtf(s * (1.0f / D) + EPS);
        else if (lane_ < 4) ss[(size_t)r * 4 + lane_] = lane_ == 0 ? s : 0.f;
        GAS unsigned long long* o8 = (GAS unsigned long long*)((ismem ? memn : hb) + (size_t)r * D) + lane_;
#pragma unroll
        for (int j = 0; j < 4; ++j) o8[64 * j] = (unsigned long long)pk2(v[j].x * sc, v[j].y * sc) | ((unsigned long long)pk2(v[j].z * sc, v[j].w * sc) << 32);
    }
    LAS float* scr = (LAS float*)(F.lds + RING_OFF + F.wave * 17408);
    const int IM = items_of(D, 2 * CW);
    for (int it = gw; it < DEPTH * IM; it += NGW) { const int l = it / IM, r = it % IM;
        transpose_item(a.in[14] + (size_t)l * D * 2 * CW, D, 2 * CW, a.in[13] + (size_t)l * D, (bf16*)(F.ws + WS_WMEM), scr, r, lane_, MapId{l * 2 * CW}); }
    prep_layer_weights_body(F, 0);
}
__device__ __noinline__ void prep_layer_weights(const float* const* in_, float* out_, unsigned char* ws_, LAS unsigned char* lds_, int l, int wave_, int vcu_, int G_) {
    const PC F{uni(in_), uni(out_), uni(ws_), uni_l(lds_), uni_i(wave_), uni_i(vcu_), uni_i(G_)}; prep_layer_weights_body(F, uni_i(l));
}

__constant__ unsigned char T5_BUCKET[128] = {0, 1, 2, 3, 4, 5, 6, 7, 8, 9, 10, 11, 12, 13, 14, 15, 16, 16, 16, 17, 17, 18, 18, 18, 19, 19, 19, 20, 20, 20, 20, 21, 21, 21, 21, 22, 22, 22, 22, 22, 23, 23, 23, 23, 23, 23, 24, 24, 24, 24, 24, 24, 25, 25, 25, 25, 25, 25, 25, 26, 26, 26, 26, 26, 26, 26, 26, 27, 27, 27, 27, 27, 27, 27, 27, 27, 27, 28, 28, 28, 28, 28, 28, 28, 28, 28, 28, 29, 29, 29, 29, 29, 29, 29, 29, 29, 29, 29, 29, 30, 30, 30, 30, 30, 30, 30, 30, 30, 30, 30, 30, 30, 30, 31, 31, 31, 31, 31, 31, 31, 31, 31, 31, 31, 31, 31, 31, 31};

typedef short bf16x8_p __attribute__((ext_vector_type(8)));
__device__ __forceinline__ void prep_tokens(const float* const* in_, float* out_, unsigned char* ws_, LAS unsigned char* lds_, int l_, int wave_, int vcu_, int G_, int dry_) {
    const int dry = uni_i(dry_);
    const PC F{uni(in_), uni(out_), uni(ws_), uni_l(lds_), uni_i(wave_), uni_i(vcu_), uni_i(G_)}; struct { const float* const* in; } a{F.in}; const int l = uni_i(l_);
    unsigned char* ws = launder_p(F.ws);
    const float* ckvraw = (const float*)(ws + WS_CKVRAW); bf16* ckv = (bf16*)(ws + WS_CKV);
    const bf16* iqraw = (const bf16*)(ws + WS_IQRAW); bf16* iqf = (bf16*)(ws + WS_IQF); const float* iw = (const float*)(ws + WS_IW); unsigned* sgn = (unsigned*)(ws + WS_SGN);
    const bf16* z = (const bf16*)(ws + WS_Z); bf16* yb = (bf16*)(ws + WS_YB); bf16* qc = (bf16*)(ws + WS_QC);
    const bf16* memkv = (const bf16*)(ws + WS_MEMKV); const bf16* vT = (const bf16*)(ws + WS_VT); const bf16* wpT = (const bf16*)(ws + WS_WPT);
    const float* kvn = a.in[8] + (size_t)l * KVR; const float* pscale = a.in[12] + (size_t)l * PW_;
    const int lane = lane_id_v(), tid = F.wave * 64 + lane;
    const int tok = lane & 15, g4 = lane >> 4;
    LAS unsigned char* Ks = F.lds;
    LAS unsigned char* Vs = F.lds + 36864;
    for (int blk = F.vcu; blk < M / 128; blk += F.G) {
        const int rowb = blk * 128, b = rowb / SEQ, row0 = rowb + F.wave * 16;
#pragma unroll 1
        for (int tt = 0; tt < 16; ++tt) { const int row = row0 + tt;
            { const f32x2 v = *(const f32x2*)(ckvraw + (size_t)row * KVR + 2 * lane); const float q = wave_sum(v.x * v.x + v.y * v.y);
              const float rs = 1.0f / sqrtf(q * (1.0f / KVR) + EPS); const f32x2 g = *(const f32x2*)(kvn + 2 * lane);
              *(unsigned*)(ckv + (size_t)row * KVR + 2 * lane) = pk2(v.x * rs * g.x, v.y * rs * g.y); }
            { const float wv = iw[(size_t)row * IH + (lane >> 3)]; const float aw = fabsf(wv) * (1.0f / 16.0f);
              const v2u q = *(const v2u*)(iqraw + (size_t)row * 256 + 4 * lane);
              v2u o; o.x = pkh2(hlo(q.x) * aw, hhi(q.x) * aw); o.y = pkh2(hlo(q.y) * aw, hhi(q.y) * aw);
              *(v2u*)(iqf + (size_t)row * 256 + 4 * lane) = o;
              const unsigned long long bal = __ballot(wv < 0.f);
              unsigned mask = 0;
#pragma unroll
              for (int h = 0; h < 8; ++h) mask |= ((unsigned)(bal >> (8 * h)) & 1u) << h;
              if (lane == 0) sgn[row] = mask; } }
        { const int row = row0 + tok, spos = row % SEQ;
#pragma unroll 1
          for (int g = 0; g < 4; ++g) { const int w = 2 << g; const int cnt = (spos + 1) < w ? (spos + 1) : w; const float rc = 1.0f / (float)cnt;
              bf16x8_p pf[2];
#pragma unroll
              for (int ks = 0; ks < 2; ++ks) { const int c0 = g * 64 + 32 * ks + 8 * g4; float sum[8], z0[8];
#pragma unroll
                  for (int e = 0; e < 8; ++e) { sum[e] = 0.f; z0[e] = 0.f; }
                  for (int j = 0; j < w; ++j) { if (j < cnt) { const v4u v = *(const v4u*)(z + (size_t)(row - j) * 256 + c0);
                      const float f[8] = {bflo(v.x), bfhi(v.x), bflo(v.y), bfhi(v.y), bflo(v.z), bfhi(v.z), bflo(v.w), bfhi(v.w)};
#pragma unroll
                      for (int e = 0; e < 8; ++e) { sum[e] += f[e]; if (j == 0) z0[e] = f[e]; } } }
                  v4u pw; pw.x = pk2(sum[0] * rc - z0[0], sum[1] * rc - z0[1]); pw.y = pk2(sum[2] * rc - z0[2], sum[3] * rc - z0[3]); pw.z = pk2(sum[4] * rc - z0[4], sum[5] * rc - z0[5]); pw.w = pk2(sum[6] * rc - z0[6], sum[7] * rc - z0[7]);
                  pf[ks] = __builtin_bit_cast(bf16x8_p, pw); }
#pragma unroll
              for (int dt = 0; dt < 4; ++dt) { f32x4 acc = {0.f, 0.f, 0.f, 0.f};
#pragma unroll
                  for (int ks = 0; ks < 2; ++ks) { const bf16x8_p af = *(const bf16x8_p*)(wpT + (size_t)(g * 64 + 16 * dt + tok) * 64 + 32 * ks + 8 * g4); acc = __builtin_amdgcn_mfma_f32_16x16x32_bf16(af, pf[ks], acc, 0, 0, 0); }
                  const f32x4 ps = *(const f32x4*)(pscale + g * 64 + 16 * dt + 4 * g4);
                  v2u o; o.x = pk2(acc[0] * ps.x, acc[1] * ps.y); o.y = pk2(acc[2] * ps.z, acc[3] * ps.w);
                  *(v2u*)(yb + (size_t)row * 256 + g * 64 + 16 * dt + 4 * g4) = o; } } }
#pragma unroll 1
        for (int h = 0; h < CH; ++h) {
            __syncthreads();
#pragma unroll
            for (int e = 0; e < 4; ++e) { const int i = tid + 512 * e;
                { const int m = i >> 3, c = i & 7; const v4u v = *(const v4u*)(memkv + (size_t)(b * NMEM + m) * 2048 + l * 512 + h * 64 + c * 8); *(LAS v4u*)(Ks + m * 144 + c * 16) = v; }
                { const int d = i >> 5, c = i & 31; const v4u v = *(const v4u*)(vT + (size_t)(l * 512 + 256 + h * 64 + d) * MROWS + b * NMEM + c * 8); *(LAS v4u*)(Vs + d * 528 + c * 16) = v; } }
            LDS_WAIT(); __syncthreads();
            const int row = row0 + tok;
            bf16x8_p qf[2];
#pragma unroll
            for (int ks = 0; ks < 2; ++ks) qf[ks] = *(const bf16x8_p*)(qc + (size_t)row * 256 + h * 64 + 32 * ks + 8 * g4);
            f32x4 S[16]; float mx = -1e30f;
#pragma unroll
            for (int mt = 0; mt < 16; ++mt) { f32x4 acc = {0.f, 0.f, 0.f, 0.f};
#pragma unroll
                for (int ks = 0; ks < 2; ++ks) { const bf16x8_p kf = *(const LAS bf16x8_p*)(Ks + (16 * mt + tok) * 144 + (4 * ks + g4) * 16); acc = __builtin_amdgcn_mfma_f32_16x16x32_bf16(kf, qf[ks], acc, 0, 0, 0); }
                S[mt] = acc; mx = fmaxf(mx, fmaxf(fmaxf(acc[0], acc[1]), fmaxf(acc[2], acc[3]))); if ((mt & 3) == 3) __builtin_amdgcn_sched_barrier(0); }
            mx = fmaxf(mx, __shfl_xor(mx, 16)); mx = fmaxf(mx, __shfl_xor(mx, 32));
            float sm = 0.f;
#pragma unroll
            for (int mt = 0; mt < 16; ++mt)
#pragma unroll
                for (int r = 0; r < 4; ++r) { const float p = __expf((S[mt][r] - mx) * 0.125f); S[mt][r] = p; sm += p; }
            sm += __shfl_xor(sm, 16); sm += __shfl_xor(sm, 32);
            const float inv = 1.0f / sm;
            f32x4 oacc[4];
#pragma unroll
            for (int dt = 0; dt < 4; ++dt) oacc[dt] = (f32x4){0.f, 0.f, 0.f, 0.f};
#pragma unroll
            for (int kk = 0; kk < 8; ++kk) { v4u pw; pw.x = pg8::cvt_pk_bf16(S[2 * kk][0], S[2 * kk][1]); pw.y = pg8::cvt_pk_bf16(S[2 * kk][2], S[2 * kk][3]); pw.z = pg8::cvt_pk_bf16(S[2 * kk + 1][0], S[2 * kk + 1][1]); pw.w = pg8::cvt_pk_bf16(S[2 * kk + 1][2], S[2 * kk + 1][3]);
                const bf16x8_p pfr = __builtin_bit_cast(bf16x8_p, pw);
#pragma unroll
                for (int dt = 0; dt < 4; ++dt) { const LAS unsigned char* vp = Vs + (16 * dt + tok) * 528 + (32 * kk + 4 * g4) * 2;
                    const v2u lo = *(const LAS v2u*)vp, hi = *(const LAS v2u*)(vp + 32);
                    v4u vw; vw.x = lo.x; vw.y = lo.y; vw.z = hi.x; vw.w = hi.y;
                    oacc[dt] = __builtin_amdgcn_mfma_f32_16x16x32_bf16(__builtin_bit_cast(bf16x8_p, vw), pfr, oacc[dt], 0, 0, 0); }
                __builtin_amdgcn_sched_barrier(0); }
#pragma unroll
            for (int dt = 0; dt < 4; ++dt) { v2u o; o.x = pk2(oacc[dt][0] * inv, oacc[dt][1] * inv); o.y = pk2(oacc[dt][2] * inv, oacc[dt][3] * inv);
                if (!dry) *(v2u*)(qc + (size_t)row * 256 + h * 64 + 16 * dt + 4 * g4) = o; else asm volatile("" :: "v"(o.x), "v"(o.y)); }
        }
    }
    __syncthreads();
}

__device__ __forceinline__ unsigned key_of(float s) { const unsigned u = __builtin_bit_cast(unsigned, s); return (u & 0x80000000u) ? ~u : (u | 0x80000000u); }

typedef short bf16x8_t __attribute__((ext_vector_type(8)));
typedef short s16x4_t __attribute__((ext_vector_type(4)));
__device__ __forceinline__ void glds16(const void* gsrc, unsigned lds_dst) { unsigned keep;
    asm volatile("s_mov_b32 %0, m0\n\ts_mov_b32 m0, %2\n\ts_nop 0\n\tglobal_load_lds_dwordx4 %1, off\n\ts_mov_b32 m0, %0" : "=&s"(keep) : "v"(gsrc), "s"(lds_dst) : "memory"); }
typedef float f32x16 __attribute__((ext_vector_type(16)));
constexpr int SEL_CAP = 256;
constexpr int HSTR = 264;
constexpr int SL_HIST = 0, SL_SEL = 0, SL_CS = 32768, SL_CI = 98304, SL_KEYS = 131072, SL_ST = 147456;

#define SEL_DECLS \
    LAS unsigned char* const lds = uni_l(lds_); const int wave = uni_i(wave_), b = uni_i(b_), ub = uni_i(ub_); unsigned char* ws = uni(ws_); \
    const bf16* iqf = (const bf16*)(ws + WS_IQF); const unsigned* sgn = (const unsigned*)(ws + WS_SGN); const bf16* ik = (const bf16*)(ws + WS_IK); \
    const int lane = lane_id_v(), tid = wave * 64 + lane; const int kl = lane & 31, c5 = lane >> 5; \
    LAS unsigned* hist = (LAS unsigned*)(lds + SL_HIST); LAS unsigned short* lsel = (LAS unsigned short*)(lds + SL_SEL); LAS float* lcs = (LAS float*)(lds + SL_CS); \
    LAS unsigned short* lci = (LAS unsigned short*)(lds + SL_CI); LAS unsigned* st = (LAS unsigned*)(lds + SL_ST); LAS float* stf = (LAS float*)(lds + SL_ST); \
    const int t0 = ub * 64; const int q0 = b * SEQ + t0; const bf16* ikb = ik + (size_t)b * SEQ * IDIM; const int ntile = (t0 + 64 + 127) >> 7; \
    (void)hist; (void)lsel; (void)lcs; (void)lci; (void)stf; (void)tid;
#define SEL_LOAD_A \
    bf16x8_t af[2][2]; float sgc[2][16]; \
    { const int i = kl, a_ = i >> 3, cc_ = (i >> 2) & 1, e_ = i & 3; const int qq_ = 2 * cc_ + (a_ >> 1), hh_ = 4 * (a_ & 1) + e_; \
      _Pragma("unroll") for (int rt = 0; rt < 2; ++rt) { const unsigned flip_ = ((sgn[q0 + 8 * wave + 4 * rt + qq_] >> hh_) & 1u) ? 0x80008000u : 0u;     \
          _Pragma("unroll") for (int ks = 0; ks < 2; ++ks) { v4u w_ = *(const v4u*)(iqf + (size_t)(q0 + 8 * wave + 4 * rt + qq_) * 256 + hh_ * 32 + 16 * ks + 8 * c5); \
              w_.x ^= flip_; w_.y ^= flip_; w_.z ^= flip_; w_.w ^= flip_; af[rt][ks] = __builtin_bit_cast(bf16x8_t, w_); } } \
      _Pragma("unroll") for (int rt = 0; rt < 2; ++rt) _Pragma("unroll") for (int u = 0; u < 2; ++u) { const unsigned m_ = sgn[q0 + 8 * wave + 4 * rt + 2 * c5 + u]; \
          _Pragma("unroll") for (int h = 0; h < 8; ++h) sgc[rt][8 * u + h] = ((m_ >> h) & 1u) ? -__builtin_inff() : __builtin_inff(); } }
#define SEL_STAGE(kt_) do { const int key_ = 16 * wave + (lane >> 2); const int ch_ = (lane & 3) ^ ((key_ >> 2) & 3); \
    glds16(ikb + (size_t)(128 * (kt_) + key_) * IDIM + ch_ * 8, (unsigned)__builtin_amdgcn_readfirstlane((int)(unsigned)(size_t)(lds + SL_KEYS + ((kt_) & 1) * 8192 + wave * 1024))); } while (0)
#define SEL_MMA(acc_, rt_, kh_) do { acc_ = (f32x16){0.f,0.f,0.f,0.f,0.f,0.f,0.f,0.f,0.f,0.f,0.f,0.f,0.f,0.f,0.f,0.f}; \
    acc_ = __builtin_amdgcn_mfma_f32_32x32x16_f16(__builtin_bit_cast(f16x8_t, af[rt_][0]), __builtin_bit_cast(f16x8_t, bfr_[kh_][0]), acc_, 0, 0, 0); \
    acc_ = __builtin_amdgcn_mfma_f32_32x32x16_f16(__builtin_bit_cast(f16x8_t, af[rt_][1]), __builtin_bit_cast(f16x8_t, bfr_[kh_][1]), acc_, 0, 0, 0); } while (0)
#define SEL_SUM(acc_, rt_, kh_) do { _Pragma("unroll") for (int u = 0; u < 2; ++u) { float s_ = 0.f; \
    _Pragma("unroll") for (int h = 0; h < 8; ++h) s_ += __builtin_amdgcn_fmed3f(acc_[8 * u + h], 0.f, sgc[rt_][8 * u + h]); \
    sc[rt_][kh_][u] = s_; } } while (0)
#define SEL_SCORES(kt_) do { const LAS unsigned char* kb_ = lds + SL_KEYS + ((kt_) & 1) * 8192; bf16x8_t bfr_[4][2]; \
    _Pragma("unroll") for (int kh = 0; kh < 4; ++kh) { const int key_ = 32 * kh + kl; \
        bfr_[kh][0] = *(const LAS bf16x8_t*)(kb_ + key_ * 64 + 16 * ((0 + c5) ^ ((key_ >> 2) & 3))); \
        bfr_[kh][1] = *(const LAS bf16x8_t*)(kb_ + key_ * 64 + 16 * ((2 + c5) ^ ((key_ >> 2) & 3))); } \
    f32x16 accA_, accB_; \
    SEL_MMA(accA_, 0, 0); \
    SEL_MMA(accB_, 1, 0); __builtin_amdgcn_sched_barrier(0); SEL_SUM(accA_, 0, 0); __builtin_amdgcn_sched_barrier(0); \
    SEL_MMA(accA_, 0, 1); __builtin_amdgcn_sched_barrier(0); SEL_SUM(accB_, 1, 0); __builtin_amdgcn_sched_barrier(0); \
    SEL_MMA(accB_, 1, 1); __builtin_amdgcn_sched_barrier(0); SEL_SUM(accA_, 0, 1); __builtin_amdgcn_sched_barrier(0); \
    SEL_MMA(accA_, 0, 2); __builtin_amdgcn_sched_barrier(0); SEL_SUM(accB_, 1, 1); __builtin_amdgcn_sched_barrier(0); \
    SEL_MMA(accB_, 1, 2); __builtin_amdgcn_sched_barrier(0); SEL_SUM(accA_, 0, 2); __builtin_amdgcn_sched_barrier(0); \
    SEL_MMA(accA_, 0, 3); __builtin_amdgcn_sched_barrier(0); SEL_SUM(accB_, 1, 2); __builtin_amdgcn_sched_barrier(0); \
    SEL_MMA(accB_, 1, 3); __builtin_amdgcn_sched_barrier(0); SEL_SUM(accA_, 0, 3); __builtin_amdgcn_sched_barrier(0); \
    SEL_SUM(accB_, 1, 3); } while (0)
#define SEL_BOUNDARY(FINAL) do { \
    const int qq = tid >> 3, part = tid & 7; const LAS v4u* hp = (const LAS v4u*)(hist + qq * HSTR + 32 * part); \
    unsigned bins[32]; \
    _Pragma("unroll") for (int i = 0; i < 8; ++i) { const v4u v = hp[i]; bins[4 * i] = v.x; bins[4 * i + 1] = v.y; bins[4 * i + 2] = v.z; bins[4 * i + 3] = v.w; } \
    unsigned ps = 0; \
    _Pragma("unroll") for (int i = 0; i < 32; ++i) ps += bins[i]; \
    unsigned v = ps, tt; \
    tt = __shfl_down(v, 1, 8); if (part + 1 < 8) v += tt; \
    tt = __shfl_down(v, 2, 8); if (part + 2 < 8) v += tt; \
    tt = __shfl_down(v, 4, 8); if (part + 4 < 8) v += tt; \
    unsigned cacc = v - ps; \
    if (cacc < (unsigned)TOPK && v >= (unsigned)TOPK) { int bsel = 0; unsigned na = 0, cb = 0; bool found = false; \
        _Pragma("unroll") for (int i = 31; i >= 0; --i) { const bool hit = !found && (cacc + bins[i] >= (unsigned)TOPK); if (hit) { bsel = i; na = cacc; cb = bins[i]; found = true; } cacc += bins[i]; } \
        st[128 + qq] = (unsigned)(32 * part + bsel); if (FINAL) { st[192 + qq] = na; st[256 + qq] = cb; st[448 + qq] = cb > (unsigned)SEL_CAP ? 1u : 0u; } } } while (0)

__device__ __forceinline__ void sel_pass1(unsigned char* ws_, LAS unsigned char* lds_, int wave_, int b_, int ub_) {
    SEL_DECLS
    unsigned short* sel = (unsigned short*)(ws + WS_SEL);
    __syncthreads();
    if (ub < 4) {
        for (int i = tid; i < 64 * TOPK; i += NWAVES * 64) { const int qq = i >> 8, sl = i & 255; sel[(size_t)(q0 + qq) * TOPK + sl] = (unsigned short)(sl <= t0 + qq ? sl : 0); }
        if (tid == 0) st[512] = 1u;
        asm volatile("s_waitcnt vmcnt(0) lgkmcnt(0)" ::: "memory"); __syncthreads();
        return;
    }
    SEL_LOAD_A
    for (int i = tid; i < 64 * HSTR; i += NWAVES * 64) hist[i] = 0u;
    if (tid < 64) { st[128 + tid] = 0u; st[448 + tid] = 0u; }
    if (tid == 0) st[512] = 0u;
    float sc[2][4][2];
    float scl[2][2]; int bcur[2][2];
#pragma unroll
    for (int rt = 0; rt < 2; ++rt)
#pragma unroll
        for (int u = 0; u < 2; ++u) { scl[rt][u] = 0.f; bcur[rt][u] = 0; }
    SEL_STAGE(0);
#pragma unroll 1
    for (int kt = 0; kt < ntile; ++kt) {
        asm volatile("s_waitcnt vmcnt(0) lgkmcnt(0)" ::: "memory"); __syncthreads();
        if (kt > 0 && (kt & 3) == 0) {
            SEL_BOUNDARY(false);
            asm volatile("s_waitcnt lgkmcnt(0)" ::: "memory"); __syncthreads();
#pragma unroll
            for (int rt = 0; rt < 2; ++rt)
#pragma unroll
                for (int u = 0; u < 2; ++u) bcur[rt][u] = (int)st[128 + 8 * wave + 4 * rt + 2 * c5 + u];
        }
        if (kt + 1 < ntile) SEL_STAGE(kt + 1);
        SEL_SCORES(kt);
        if (kt == 0) {
#pragma unroll
            for (int rt = 0; rt < 2; ++rt)
#pragma unroll
                for (int u = 0; u < 2; ++u) { float mx = 0.f;
#pragma unroll
                    for (int kh = 0; kh < 4; ++kh) mx = fmaxf(mx, fabsf(sc[rt][kh][u]));
#pragma unroll
                    for (int o = 1; o < 32; o <<= 1) mx = fmaxf(mx, __shfl_xor(mx, o));
                    const float R = mx > 0.f ? mx : 1.0f;
                    scl[rt][u] = 128.0f / R;
                    if (kl == 0) stf[8 * wave + 4 * rt + 2 * c5 + u] = scl[rt][u]; }
        }
        const bool masked = 128 * kt + 127 > t0;
#pragma unroll
        for (int rt = 0; rt < 2; ++rt)
#pragma unroll
            for (int u = 0; u < 2; ++u) { const int qq = 8 * wave + 4 * rt + 2 * c5 + u; const int lim = masked ? (t0 + qq - 128 * kt - kl) : 1000;
#pragma unroll
                for (int kh = 0; kh < 4; ++kh) { const float fb = __builtin_amdgcn_fmed3f(fmaf(sc[rt][kh][u], scl[rt][u], 128.0f), 0.f, 255.f);
                    if (fb >= (float)bcur[rt][u] && 32 * kh <= lim) (void)__hip_atomic_fetch_add(hist + qq * HSTR + (int)fb, 1u, __ATOMIC_RELAXED, __HIP_MEMORY_SCOPE_WORKGROUP); } }
    }
    asm volatile("s_waitcnt vmcnt(0) lgkmcnt(0)" ::: "memory"); __syncthreads();
    SEL_BOUNDARY(true);
    if (tid < 64) { st[320 + tid] = 0u; st[384 + tid] = 0u; }
    asm volatile("s_waitcnt lgkmcnt(0)" ::: "memory"); __syncthreads();
}
__device__ __forceinline__ void sel_pass2(unsigned char* ws_, LAS unsigned char* lds_, int wave_, int b_, int ub_) {
    SEL_DECLS
    if (st[512] != 0u) return;
    if (tid < 64) { st[320 + tid] = 0u; st[384 + tid] = 0u; }
    SEL_LOAD_A
    float sc[2][4][2];
    float scl[2][2]; int bcur[2][2];
#pragma unroll
    for (int rt = 0; rt < 2; ++rt)
#pragma unroll
        for (int u = 0; u < 2; ++u) { const int qq = 8 * wave + 4 * rt + 2 * c5 + u; scl[rt][u] = stf[qq]; bcur[rt][u] = (int)st[128 + qq]; }
    SEL_STAGE(0);
#pragma unroll 1
    for (int kt = 0; kt < ntile; ++kt) {
        asm volatile("s_waitcnt vmcnt(0) lgkmcnt(0)" ::: "memory"); __syncthreads();
        if (kt + 1 < ntile) SEL_STAGE(kt + 1);
        SEL_SCORES(kt);
        const bool masked = 128 * kt + 127 > t0;
        unsigned okm = 0u, abm = 0u; unsigned basea[2][2], basec[2][2];
#pragma unroll
        for (int rt = 0; rt < 2; ++rt)
#pragma unroll
            for (int u = 0; u < 2; ++u) { const int qq = 8 * wave + 4 * rt + 2 * c5 + u; const int lim = masked ? (t0 + qq - 128 * kt - kl) : 1000; unsigned na_ = 0u, nc_ = 0u;
#pragma unroll
                for (int kh = 0; kh < 4; ++kh) { const float fb = __builtin_amdgcn_fmed3f(fmaf(sc[rt][kh][u], scl[rt][u], 128.0f), 0.f, 255.f);
                    const bool ok = fb >= (float)bcur[rt][u] && 32 * kh <= lim; const bool ab = fb >= (float)(bcur[rt][u] + 1);
                    if (ok) { okm |= 1u << (rt * 8 + u * 4 + kh); if (ab) { abm |= 1u << (rt * 8 + u * 4 + kh); ++na_; } else ++nc_; } }
                basea[rt][u] = 0u; basec[rt][u] = 0u;
                if (na_) basea[rt][u] = __hip_atomic_fetch_add(st + 320 + qq, na_, __ATOMIC_RELAXED, __HIP_MEMORY_SCOPE_WORKGROUP);
                if (nc_) basec[rt][u] = __hip_atomic_fetch_add(st + 384 + qq, nc_, __ATOMIC_RELAXED, __HIP_MEMORY_SCOPE_WORKGROUP); }
        if (okm != 0u) {
#pragma unroll
            for (int rt = 0; rt < 2; ++rt)
#pragma unroll
                for (int u = 0; u < 2; ++u) { const int qq = 8 * wave + 4 * rt + 2 * c5 + u; unsigned sa = basea[rt][u], scn = basec[rt][u];
#pragma unroll
                    for (int kh = 0; kh < 4; ++kh) { const int bit = rt * 8 + u * 4 + kh; const int kpos = 128 * kt + 32 * kh + kl;
                        if ((okm >> bit) & 1u) {
                            if ((abm >> bit) & 1u) { if (sa < (unsigned)TOPK) lsel[qq * 256 + sa] = (unsigned short)kpos; ++sa; }
                            else { if (scn < (unsigned)SEL_CAP) { lcs[qq * SEL_CAP + scn] = sc[rt][kh][u]; lci[qq * SEL_CAP + scn] = (unsigned short)kpos; } ++scn; } } } }
        }
    }
    asm volatile("s_waitcnt vmcnt(0) lgkmcnt(0)" ::: "memory"); __syncthreads();
}
__device__ __forceinline__ void sel_resolve(unsigned char* ws_, LAS unsigned char* lds_, int wave_, int b_, int ub_, int wg_, int first_) {
    SEL_DECLS
    const int wg = uni_i(wg_), first = uni_i(first_);
    unsigned short* sel = (unsigned short*)(ws + WS_SEL);
    gu32* slowl = (gu32*)(ws + WS_CTL + 65536) + (size_t)wg * 132;
    if (first && tid == 0) __hip_atomic_store(slowl, 0u, RLX_AGENT);
    if (st[512] != 0u) return;
#pragma unroll 1
    for (int qi = 0; qi < 8; ++qi) { const int qq = 8 * wave + qi; const int q = q0 + qq;
        const int na = (int)st[192 + qq], need = TOPK - na; int C = (int)st[384 + qq]; C = C < SEL_CAP ? C : SEL_CAP;
        const bool slow = st[448 + qq] != 0u;
        if (!slow) {
#pragma unroll
            for (int e = 0; e < SEL_CAP / 64; ++e) { const int i = lane + 64 * e;
                if (i < C) { const float si = lcs[qq * SEL_CAP + i]; const int ii = lci[qq * SEL_CAP + i]; int rank = 0;
#pragma unroll 8
                    for (int jx = 0; jx < C; ++jx) { const float sj = lcs[qq * SEL_CAP + jx]; const int ij = lci[qq * SEL_CAP + jx]; rank += (sj > si || (sj == si && ij < ii)) ? 1 : 0; }
                    if (rank < need) lsel[qq * 256 + na + rank] = (unsigned short)ii; } }
            LDS_WAIT();
            *(v2u*)(sel + (size_t)q * TOPK + 4 * lane) = *(const LAS v2u*)(lsel + qq * 256 + 4 * lane);
        }
    }
    __syncthreads();
    if (tid == 0) { unsigned n = first ? 0u : __hip_atomic_load(slowl, RLX_AGENT);
        for (int qq = 0; qq < 64; ++qq) if (st[448 + qq] != 0u) { if (n < 128u) { __hip_atomic_store(slowl + 1 + n, (unsigned)(q0 + qq), RLX_AGENT); ++n; } }
        __hip_atomic_store(slowl, n, RLX_AGENT); }
    asm volatile("s_waitcnt vmcnt(0)" ::: "memory");
    __syncthreads();
}
#undef SEL_DECLS
#undef SEL_LOAD_A
#undef SEL_STAGE
#undef SEL_SCORES
#undef SEL_MMA
#undef SEL_SUM
#undef SEL_BOUNDARY
__device__ __forceinline__ void dsa_select_slow(unsigned char* ws_, LAS unsigned char* lds_, int wave_, int wg_) {
    LAS unsigned char* const lds = uni_l(lds_); const int wave = uni_i(wave_), wg = uni_i(wg_);
    unsigned char* ws = uni(ws_);
    const bf16* iqf = (const bf16*)(ws + WS_IQF); const unsigned* sgn = (const unsigned*)(ws + WS_SGN); const bf16* ik = (const bf16*)(ws + WS_IK);
    unsigned short* sel = (unsigned short*)(ws + WS_SEL);
    gu32* slowl = (gu32*)(ws + WS_CTL + 65536) + (size_t)wg * 132;
    const int lane = lane_id_v(), tid = wave * 64 + lane; const int kl = lane & 31, c5 = lane >> 5;
    LAS unsigned* keys = (LAS unsigned*)lds;
    LAS unsigned* hist = (LAS unsigned*)(lds + 32768);
    LAS unsigned* ctl = (LAS unsigned*)(lds + 40960);
    const int nq = (int)__builtin_amdgcn_readfirstlane(__hip_atomic_load(slowl, RLX_AGENT));
#pragma unroll 1
    for (int k = 0; k < nq; ++k) {
        const int q = (int)__builtin_amdgcn_readfirstlane(__hip_atomic_load(slowl + 1 + k, RLX_AGENT));
        const int b = q / SEQ, t = q % SEQ, n = t + 1;
        const bf16* ikb = ik + (size_t)b * SEQ * IDIM;
        __syncthreads();
        bf16x8_t af[2]; float sgc[8];
        { const int i = kl, a_ = i >> 3, e_ = i & 3; const int hh_ = 4 * (a_ & 1) + e_; const unsigned m_ = sgn[q];
          const unsigned flip_ = ((m_ >> hh_) & 1u) ? 0x80008000u : 0u;
#pragma unroll
          for (int ks = 0; ks < 2; ++ks) { v4u w_ = *(const v4u*)(iqf + (size_t)q * 256 + hh_ * 32 + 16 * ks + 8 * c5); w_.x ^= flip_; w_.y ^= flip_; w_.z ^= flip_; w_.w ^= flip_; af[ks] = __builtin_bit_cast(bf16x8_t, w_); }
#pragma unroll
          for (int h = 0; h < 8; ++h) sgc[h] = ((m_ >> h) & 1u) ? -__builtin_inff() : __builtin_inff(); }
#pragma unroll 1
        for (int kb = wave; kb * 32 < n; kb += NWAVES) { const int key = 32 * kb + kl;
            const bf16x8_t b0 = *(const bf16x8_t*)(ikb + (size_t)key * IDIM + 8 * c5), b1 = *(const bf16x8_t*)(ikb + (size_t)key * IDIM + 16 + 8 * c5);
            f32x16 acc = {0.f,0.f,0.f,0.f,0.f,0.f,0.f,0.f,0.f,0.f,0.f,0.f,0.f,0.f,0.f,0.f};
            acc = __builtin_amdgcn_mfma_f32_32x32x16_f16(__builtin_bit_cast(f16x8_t, af[0]), __builtin_bit_cast(f16x8_t, b0), acc, 0, 0, 0); acc = __builtin_amdgcn_mfma_f32_32x32x16_f16(__builtin_bit_cast(f16x8_t, af[1]), __builtin_bit_cast(f16x8_t, b1), acc, 0, 0, 0);
            float sc = 0.f;
#pragma unroll
            for (int h = 0; h < 8; ++h) sc += __builtin_amdgcn_fmed3f(acc[h], 0.f, sgc[h]);
            if (c5 == 0) keys[key] = key_of(sc); }
        if (tid == 0) { const unsigned z_ = (unsigned)launder_v(0); ctl[0] = z_; ctl[1] = z_ + (unsigned)TOPK; ctl[2] = z_; ctl[3] = z_; }
        unsigned P = 0u, Plo = 0u;
#pragma unroll 1
        for (int lev = 0; lev < 5; ++lev) {
            for (int i = tid; i < 2048; i += NWAVES * 64) hist[i] = 0u;
            asm volatile("s_waitcnt lgkmcnt(0)" ::: "memory"); __syncthreads();
#pragma unroll 1
            for (int i = 0; i < 16; ++i) { const int s_ = tid * 16 + i;
                if (s_ < n) { const unsigned hi = keys[s_], lo = 8191u - (unsigned)s_; bool mt; unsigned dg;
                    if (lev == 0) { mt = true; dg = hi >> 21; } else if (lev == 1) { mt = (hi >> 21) == P; dg = (hi >> 10) & 0x7ffu; } else if (lev == 2) { mt = (hi >> 10) == P; dg = hi & 0x3ffu; }
                    else if (lev == 3) { mt = hi == P; dg = lo >> 6; } else { mt = hi == P && (lo >> 6) == Plo; dg = lo & 63u; }
                    if (mt) (void)__hip_atomic_fetch_add(hist + dg, 1u, __ATOMIC_RELAXED, __HIP_MEMORY_SCOPE_WORKGROUP); } }
            asm volatile("s_waitcnt lgkmcnt(0)" ::: "memory"); __syncthreads();
            const unsigned need = ctl[1];
            const v4u hb = *(const LAS v4u*)(hist + 4 * tid); const unsigned ls = hb.x + hb.y + hb.z + hb.w;
            unsigned v = ls, tt;
            tt = __shfl_down(v, 1); if (lane + 1 < 64) v += tt;
            tt = __shfl_down(v, 2); if (lane + 2 < 64) v += tt;
            tt = __shfl_down(v, 4); if (lane + 4 < 64) v += tt;
            tt = __shfl_down(v, 8); if (lane + 8 < 64) v += tt;
            tt = __shfl_down(v, 16); if (lane + 16 < 64) v += tt;
            tt = __shfl_down(v, 32); if (lane + 32 < 64) v += tt;
            if (lane == 0) ctl[8 + wave] = v;
            asm volatile("s_waitcnt lgkmcnt(0)" ::: "memory"); __syncthreads();
            unsigned above = v - ls;
            for (int w2 = wave + 1; w2 < NWAVES; ++w2) above += ctl[8 + w2];
            if (above < need && above + ls >= need) { unsigned c = above; const unsigned bb[4] = {hb.x, hb.y, hb.z, hb.w}; int bsel = 0; unsigned cab = 0; bool found = false;
#pragma unroll
                for (int i = 3; i >= 0; --i) { const bool hit = !found && (c + bb[i] >= need); if (hit) { bsel = i; cab = c; found = true; } c += bb[i]; }
                const unsigned dv = (unsigned)(4 * tid + bsel);
                if (lev == 0) ctl[0] = dv; else if (lev == 1) ctl[0] = (P << 11) | dv; else if (lev == 2) ctl[0] = (P << 10) | dv; else if (lev == 3) ctl[3] = dv; else ctl[3] = (Plo << 6) | dv;
                ctl[1] = need - cab; }
            asm volatile("s_waitcnt lgkmcnt(0)" ::: "memory"); __syncthreads();
            P = ctl[0]; Plo = ctl[3];
        }
        unsigned short* srow = sel + (size_t)q * TOPK;
        unsigned mymask = 0u;
#pragma unroll 1
        for (int i = 0; i < 16; ++i) { const int s_ = tid * 16 + i;
            if (s_ < n) { const unsigned hi = keys[s_], lo = 8191u - (unsigned)s_; if (hi > P || (hi == P && lo >= Plo)) mymask |= 1u << i; } }
        const unsigned mycnt = (unsigned)__builtin_popcount(mymask);
        unsigned pv_ = mycnt, tt_;
        tt_ = __shfl_up(pv_, 1); if (lane >= 1) pv_ += tt_;
        tt_ = __shfl_up(pv_, 2); if (lane >= 2) pv_ += tt_;
        tt_ = __shfl_up(pv_, 4); if (lane >= 4) pv_ += tt_;
        tt_ = __shfl_up(pv_, 8); if (lane >= 8) pv_ += tt_;
        tt_ = __shfl_up(pv_, 16); if (lane >= 16) pv_ += tt_;
        tt_ = __shfl_up(pv_, 32); if (lane >= 32) pv_ += tt_;
        if (lane == 63) ctl[16 + wave] = pv_;
        asm volatile("s_waitcnt lgkmcnt(0)" ::: "memory"); __syncthreads();
        unsigned slot0 = pv_ - mycnt;
        for (int w2 = 0; w2 < wave; ++w2) slot0 += ctl[16 + w2];
#pragma unroll 1
        for (int i = 0; i < 16; ++i) if ((mymask >> i) & 1u) { if (slot0 < (unsigned)TOPK) srow[slot0] = (unsigned short)(tid * 16 + i); ++slot0; }
    }
    asm volatile("s_waitcnt vmcnt(0) lgkmcnt(0)" ::: "memory");
    __syncthreads();
}

__device__ __forceinline__ unsigned offb(unsigned row, unsigned ch) { return 256u * row + 16u * (ch ^ (((row & 3u) << 2) | ((row >> 2) & 3u))); }
__device__ __forceinline__ s16x4_t vtr(const LAS unsigned char* p) { return __builtin_bit_cast(s16x4_t, __builtin_amdgcn_ds_read_tr16_b64_v4i16((LAS s16x4_t*)p)); }

__device__ __noinline__ void dsa_attend(unsigned char* ws_, LAS unsigned char* lds_, const float* relb_, int wave_, int vcu_, int G_, int dry_) {
    const int dry = uni_i(dry_);
    LAS unsigned char* const lds = uni_l(lds_); const int wave = uni_i(wave_), vcu = uni_i(vcu_), G = uni_i(G_);
    unsigned char* ws = uni(ws_); const float* relb = uni(relb_);
    const bf16* ckv = (const bf16*)(ws + WS_CKV); bf16* ql = (bf16*)(ws + WS_QL); const unsigned short* sel = (const unsigned short*)(ws + WS_SEL);
    const int lane = lane_id_v(), tid = wave * 64 + lane;
    LAS unsigned char* cb = lds + wave * 16384;
    LAS unsigned short* sidx = (LAS unsigned short*)(lds + 131072 + wave * 512);
    LAS float* biasd = (LAS float*)(lds + 135168);
    for (int i = tid; i < 129 * 8; i += NWAVES * 64) { const int d = i >> 3, h = i & 7; const int bk = d < 128 ? (int)T5_BUCKET[d] : 31; biasd[i] = relb[bk * 8 + h]; }
    __syncthreads();
    const int hl = lane & 15, g = lane >> 4, hq = hl & 7;
    for (int p = vcu; p < BATCH * 64; p += G) {
        const int b = p >> 6, j = p & 63;
#pragma unroll 1
        for (int half = 0; half < 2; ++half) {
            const int ub = half == 0 ? j : 127 - j;
#pragma unroll 1
            for (int qi = 0; qi < 8; ++qi) {
                const int t = ub * 64 + wave * 8 + qi; const int q = b * SEQ + t; const int nsel = (t + 1) < TOPK ? (t + 1) : TOPK;
                const bf16* ckvb = ckv + (size_t)b * SEQ * KVR; bf16* qlrow = ql + (size_t)q * 1024;
                { const v2u w = *(const v2u*)(sel + (size_t)q * TOPK + 4 * lane); *(LAS v2u*)(sidx + 4 * lane) = w; }
                bf16x8_t qf[4];
#pragma unroll
                for (int s = 0; s < 4; ++s) qf[s] = *(const bf16x8_t*)(qlrow + hq * 128 + 32 * s + 8 * g);
                LDS_WAIT();
                float mrun = -1e30f, lsum = 0.f;
                f32x4 O[8];
#pragma unroll
                for (int c = 0; c < 8; ++c) O[c] = (f32x4){0.f, 0.f, 0.f, 0.f};
#define DSA_GATHER(c_) do { LAS unsigned char* dst_ = cb + ((c_) & 1) * 8192; \
                    _Pragma("unroll") for (int k_ = 0; k_ < 8; ++k_) { const int row_ = 4 * k_ + g; const int kidx_ = sidx[32 * (c_) + row_]; \
                        const int ch_ = hl ^ ((g << 2) | (k_ & 3)); \
                        glds16(ckvb + (size_t)kidx_ * KVR + ch_ * 8, (unsigned)__builtin_amdgcn_readfirstlane((int)(unsigned)(size_t)(dst_ + k_ * 1024))); } } while (0)
                DSA_GATHER(0);
#pragma unroll 1
                for (int c = 0; c < 8; ++c) {
                    if (c < 7) { DSA_GATHER(c + 1); asm volatile("s_waitcnt vmcnt(8)" ::: "memory"); }
                    else asm volatile("s_waitcnt vmcnt(0)" ::: "memory");
                    const LAS unsigned char* img = cb + (c & 1) * 8192;
                    f32x4 S[2];
#pragma unroll
                    for (int rb = 0; rb < 2; ++rb) { S[rb] = (f32x4){0.f, 0.f, 0.f, 0.f}; const unsigned row = 8u * (hl >> 2) + 4u * rb + (hl & 3);
#pragma unroll
                        for (int s = 0; s < 4; ++s) { const bf16x8_t af = *(const LAS bf16x8_t*)(img + offb(row, 4 * s + g)); S[rb] = __builtin_amdgcn_mfma_f32_16x16x32_bf16(af, qf[s], S[rb], 0, 0, 0); } }
                    float pv[2][4]; float mx = -1e30f;
#pragma unroll
                    for (int rb = 0; rb < 2; ++rb) { const v2u iw2 = *(const LAS v2u*)(sidx + 32 * c + 8 * g + 4 * rb);
                        const int ki[4] = {(int)(iw2.x & 0xffffu), (int)(iw2.x >> 16), (int)(iw2.y & 0xffffu), (int)(iw2.y >> 16)};
#pragma unroll
                        for (int r = 0; r < 4; ++r) { int dist = t - ki[r]; dist = dist < 0 ? 0 : (dist > 128 ? 128 : dist);
                            float lg = S[rb][r] * 0.125f + biasd[dist * 8 + hq];
                            if (32 * c + 8 * g + 4 * rb + r >= nsel) lg = -1e30f;
                            pv[rb][r] = lg; mx = fmaxf(mx, lg); } }
                    mx = fmaxf(mx, __shfl_xor(mx, 16)); mx = fmaxf(mx, __shfl_xor(mx, 32));
                    const float mnew = fmaxf(mrun, mx); const float alpha = __expf(mrun - mnew); mrun = mnew;
                    float rs = 0.f;
#pragma unroll
                    for (int rb = 0; rb < 2; ++rb)
#pragma unroll
                        for (int r = 0; r < 4; ++r) { pv[rb][r] = __expf(pv[rb][r] - mnew); rs += pv[rb][r]; }
                    rs += __shfl_xor(rs, 16); rs += __shfl_xor(rs, 32);
                    lsum = lsum * alpha + rs;
                    v4u pw; pw.x = pg8::cvt_pk_bf16(pv[0][0], pv[0][1]); pw.y = pg8::cvt_pk_bf16(pv[0][2], pv[0][3]); pw.z = pg8::cvt_pk_bf16(pv[1][0], pv[1][1]); pw.w = pg8::cvt_pk_bf16(pv[1][2], pv[1][3]);
                    const bf16x8_t pf = __builtin_bit_cast(bf16x8_t, pw);
                    float al[4];
#pragma unroll
                    for (int r = 0; r < 4; ++r) al[r] = __shfl(alpha, 4 * g + r);
#pragma unroll
                    for (int cd = 0; cd < 8; ++cd) {
                        f32x4 o = O[cd]; o[0] *= al[0]; o[1] *= al[1]; o[2] *= al[2]; o[3] *= al[3];
                        const unsigned q4 = hl >> 2, p4 = hl & 3;
                        const s16x4_t b0 = vtr(img + offb(8u * g + q4, 2 * cd + (p4 >> 1)) + 8u * (p4 & 1));
                        const s16x4_t b1 = vtr(img + offb(8u * g + 4u + q4, 2 * cd + (p4 >> 1)) + 8u * (p4 & 1));
                        bf16x8_t bf; bf[0] = b0[0]; bf[1] = b0[1]; bf[2] = b0[2]; bf[3] = b0[3]; bf[4] = b1[0]; bf[5] = b1[1]; bf[6] = b1[2]; bf[7] = b1[3];
                        O[cd] = __builtin_amdgcn_mfma_f32_16x16x32_bf16(pf, bf, o, 0, 0, 0);
                    }
                }
#undef DSA_GATHER
                const float linv = 1.0f / lsum; float li[4];
#pragma unroll
                for (int r = 0; r < 4; ++r) li[r] = __shfl(linv, 4 * g + r);
                LAS unsigned short* ost = (LAS unsigned short*)cb;
                if (g < 2) {
#pragma unroll
                    for (int cd = 0; cd < 8; ++cd)
#pragma unroll
                        for (int r = 0; r < 4; ++r) ost[(4 * g + r) * 128 + 16 * cd + hl] = (unsigned short)f2bf(O[cd][r] * li[r]);
                }
                LDS_WAIT();
                { const v4u w0 = *(const LAS v4u*)(cb + 32 * lane), w1 = *(const LAS v4u*)(cb + 32 * lane + 16);
                  if (!dry) { *(v4u*)(qlrow + 16 * lane) = w0; *(v4u*)(qlrow + 16 * lane + 8) = w1; } else asm volatile("" :: "v"(w0), "v"(w1)); }
                LDS_WAIT();
            }
        }
    }
    __syncthreads();
}

__device__ __noinline__ void final_norm(const float* const* in_, float* out_, unsigned char* ws_, LAS unsigned char* lds_, int wave_, int vcu_, int G_) {
    const PC F{uni(in_), uni(out_), uni(ws_), uni_l(lds_), uni_i(wave_), uni_i(vcu_), uni_i(G_)}; struct { const float* const* in; float* out; } a{F.in, F.out};
    const int lane_ = lane_id_v(); const int gw = F.vcu * NWAVES + F.wave, NGW = F.G * NWAVES; const float* g = a.in[22];
    f32x4 gv[4];
#pragma unroll
    for (int j = 0; j < 4; ++j) gv[j] = ((const f32x4*)g)[lane_ + 64 * j];
    for (int m = gw; m < M; m += NGW) {
        GAS f32x4* xr = (GAS f32x4*)(a.out + (size_t)m * D) + lane_;
        f32x4 v[4]; float s = 0.f;
#pragma unroll
        for (int j = 0; j < 4; ++j) { v[j] = xr[64 * j]; s += (v[j].x * v[j].x + v[j].y * v[j].y) + (v[j].z * v[j].z + v[j].w * v[j].w); }
        const float rs = 1.0f / sqrtf(wave_sum(s) * (1.0f / D) + EPS);
#pragma unroll
        for (int j = 0; j < 4; ++j) xr[64 * j] = v[j] * rs * gv[j];
    }
}

#define KIN ((const float* const*)__builtin_amdgcn_kernarg_segment_ptr())
constexpr int PH_PER_LAYER = 10, PH_LAYER0 = 2, N_PHASES = PH_LAYER0 + PH_PER_LAYER * DEPTH + 1;

__global__ void __launch_bounds__(NWAVES * 64, 2) mk_fwd(Args args) {
    extern __shared__ __attribute__((aligned(16))) unsigned char lds[];
    Frame F;
    F.lds = (LAS unsigned char*)lds;
    F.MISC = (volatile LAS unsigned*)(F.lds + MISC_OFF);
    F.wave = __builtin_amdgcn_readfirstlane((int)threadIdx.x >> 6);
    F.G = gridDim.x; { const int bx = blockIdx.x; F.vcu = (F.G % 8 == 0) ? (bx % 8) * (F.G / 8) + bx / 8 : bx; }
    F.ws = args.ws; F.ctl = (gu32*)(args.ws + WS_CTL);
    if (threadIdx.x < 64) ((LAS unsigned*)(F.lds + MISC_OFF))[threadIdx.x] = 0u;
    __syncthreads();
    const int lo = args.ph_lo, hi = args.ph_hi;
    const bool multi = (hi - lo) > 1;
    XcdBarrier bar; bar.bar = (unsigned*)(F.ctl + CW_BAR); bar.x = 0; bar.st = nullptr; bar.wave = F.wave;
    if (multi) bar = xcd_barrier_post((unsigned*)(F.ctl + CW_BAR), F.MISC + 8, F.wave);
#define IN(k) (lo <= (k) && (k) < hi)
#define SEAM(k) do { if (IN(k) && IN((k) + 1)) { xcd_barrier(bar); if (PROBE_PHASE == 99) xcd_barrier(bar); } } while (0)

    if (IN(0)) {
#if EN_P0
 for (int rep = (PROBE_PHASE == 1 ? 0 : 1); rep < 2; ++rep) p0_prologue(KIN, args.out, args.ws, F.lds, F.wave, F.vcu, F.G);
#endif
 } SEAM(0);
    if (IN(1)) {
#if !((DIS_MASK >> 7) & 1)
 unsigned char* ws = launder_p(args.ws); bf16* hb = (bf16*)(ws + WS_HB); float* ss = (float*)(ws + WS_SS); (void)hb; (void)ss;
        pg8::Gemm g{(const bf16_t*)(ws + WS_MEMN), (const bf16_t*)(ws + WS_WMEM), MROWS, DEPTH * 2 * CW, D}; pg8::StaticOrder S; S.init(MROWS, DEPTH * 2 * CW, F.G, launder_s((int)blockIdx.x));
        EpiPlainBf16 E{(bf16_t*)(ws + WS_MEMKV), DEPTH * 2 * CW};
        pg8::gemm_phase<EpiPlainBf16, pg8::StaticOrder, true, true>(F.lds + RING_OFF, g, S, E, F.wave);
        { pg8::Gemm g2{(const bf16_t*)(ws + WS_WMEM), (const bf16_t*)(ws + WS_MEMN), DEPTH * 2 * CW, MROWS, D}; pg8::StaticOrder S2; S2.init(DEPTH * 2 * CW, MROWS, F.G, launder_s((int)blockIdx.x));
          EpiPlainBf16 E2{(bf16_t*)(ws + WS_VT), MROWS};
          pg8::gemm_phase<EpiPlainBf16, pg8::StaticOrder, true, true>(F.lds + RING_OFF, g2, S2, E2, F.wave); }
#endif
    } SEAM(1);

    for (int l = 0; l < DEPTH; ++l) {
        const int pb = PH_LAYER0 + PH_PER_LAYER * l;
        const float* hbase = (l == 0) ? args.in[0] : args.out;
        if (IN(pb + 0)) {
#if EN_P0
 if (l > 0) for (int rep = (PROBE_PHASE == 1 ? 0 : 1); rep < 2; ++rep) prep_layer_weights(KIN, args.out, args.ws, F.lds, l, F.wave, F.vcu, F.G);
#endif
 } SEAM(pb + 0);
        if (IN(pb + 1)) {
#if !((DIS_MASK >> 0) & 1)
 unsigned char* ws = launder_p(args.ws); bf16* hb = (bf16*)(ws + WS_HB); float* ss = (float*)(ws + WS_SS); (void)hb; (void)ss;
            pg8::Gemm g{hb, (const bf16_t*)(ws + WS_W1IN), M, 2 * DFF, D}; pg8::StaticOrder S; S.init(M, 2 * DFF, F.G, launder_s((int)blockIdx.x));
            EpiSwiglu E{(bf16_t*)(ws + WS_ACT), ss};
            for (int rep = (PROBE_PHASE == 2 ? 0 : 1); rep < 2; ++rep) pg8::gemm_phase<EpiSwiglu, pg8::StaticOrder, true, true>(F.lds + RING_OFF, g, S, E, F.wave);
#endif
        } SEAM(pb + 1);
        if (IN(pb + 2)) {
#if !((DIS_MASK >> 1) & 1)
 unsigned char* ws = launder_p(args.ws); bf16* hb = (bf16*)(ws + WS_HB); float* ss = (float*)(ws + WS_SS); (void)hb; (void)ss;
            pg8::Gemm g{(const bf16_t*)(ws + WS_ACT), (const bf16_t*)(ws + WS_W1OUT), M, D, DFF}; pg8::StaticOrder S; S.init(M, D, F.G, launder_s((int)blockIdx.x));
            for (int rep = (PROBE_PHASE == 3 ? 0 : 1); rep < 2; ++rep) { EpiResid E{hbase, args.out, hb, ss, 0.5f, (LAS float*)(F.lds + RING_BYTES), rep == 0 ? 1 : 0};
            pg8::gemm_phase<EpiResid, pg8::StaticOrder, true, true>(F.lds + RING_OFF, g, S, E, F.wave); }
#endif
        } SEAM(pb + 2);
        if (IN(pb + 3)) {
#if !((DIS_MASK >> 2) & 1)
 unsigned char* ws = launder_p(args.ws); bf16* hb = (bf16*)(ws + WS_HB); float* ss = (float*)(ws + WS_SS); (void)hb; (void)ss;
            pg8::Gemm g{hb, (const bf16_t*)(ws + WS_WIN), M, INP, D}; pg8::StaticOrder S; S.init(M, INP, F.G, launder_s((int)blockIdx.x));
            EpiInProj E{ss, (bf16_t*)(ws + WS_QL), (float*)(ws + WS_CKVRAW), (bf16_t*)(ws + WS_IK), (float*)(ws + WS_IW), (bf16_t*)(ws + WS_IQRAW), (bf16_t*)(ws + WS_Z), (bf16_t*)(ws + WS_QC), (bf16_t*)(ws + WS_G)};
            for (int rep = (PROBE_PHASE == 4 ? 0 : 1); rep < 2; ++rep) pg8::gemm_phase<EpiInProj, pg8::StaticOrder, true, true>(F.lds + RING_OFF, g, S, E, F.wave);
#endif
        } SEAM(pb + 3);
        if (IN(pb + 4)) {
#if EN_PREP
 for (int rep = (PROBE_PHASE == 5 ? 0 : 1); rep < 2; ++rep) prep_tokens(KIN, args.out, args.ws, F.lds, l, F.wave, F.vcu, F.G, rep == 0 ? 1 : 0);
#endif
 } SEAM(pb + 4);
        if (IN(pb + 5)) {
#if EN_DSA
 for (int rep = (PROBE_PHASE == 6 ? 0 : 1); rep < 2; ++rep) for (int p = F.vcu; p < BATCH * 64; p += F.G) { for (int half = 0; half < 2; ++half) { const int b_ = p >> 6, ub_ = half == 0 ? (p & 63) : 127 - (p & 63);
   sel_pass1(args.ws, F.lds, F.wave, b_, ub_); if (PROBE_PHASE == 61) sel_pass1(args.ws, F.lds, F.wave, b_, ub_); sel_pass2(args.ws, F.lds, F.wave, b_, ub_); if (PROBE_PHASE == 62) sel_pass2(args.ws, F.lds, F.wave, b_, ub_); sel_resolve(args.ws, F.lds, F.wave, b_, ub_, (int)blockIdx.x, (p == F.vcu && half == 0) ? 1 : 0); if (PROBE_PHASE == 63) sel_resolve(args.ws, F.lds, F.wave, b_, ub_, (int)blockIdx.x, 0); } }
 dsa_select_slow(args.ws, F.lds, F.wave, (int)blockIdx.x); for (int rep = (PROBE_PHASE == 7 ? 0 : 1); rep < 2; ++rep) dsa_attend(args.ws, F.lds, args.in[2], F.wave, F.vcu, F.G, rep == 0 ? 1 : 0);
#endif
 } SEAM(pb + 5);
        if (IN(pb + 6)) {
#if !((DIS_MASK >> 3) & 1)
        for (int rep6 = (PROBE_PHASE == 8 ? 0 : 1); rep6 < 2; ++rep6) {
 unsigned char* ws = launder_p(args.ws); bf16* hb = (bf16*)(ws + WS_HB); float* ss = (float*)(ws + WS_SS); (void)hb; (void)ss;
            { pg8::Gemm g{(const bf16_t*)(ws + WS_QL), (const bf16_t*)(ws + WS_WA), M, D, 1024}; pg8::StaticOrder S; S.init(M, D, F.G, launder_s((int)blockIdx.x));
              EpiMerge<0> E{(bf16_t*)(ws + WS_MERGED), (const bf16_t*)(ws + WS_G)};
              pg8::gemm_phase<EpiMerge<0>, pg8::StaticOrder, true, true>(F.lds + RING_OFF, g, S, E, F.wave); }
            { pg8::Gemm g{(const bf16_t*)(ws + WS_YB), (const bf16_t*)(ws + WS_WB), M, D, PW_}; pg8::StaticOrder S; S.init(M, D, F.G, launder_s((int)blockIdx.x));
              EpiMerge<1> E{(bf16_t*)(ws + WS_MERGED), (const bf16_t*)(ws + WS_G)};
              pg8::gemm_phase<EpiMerge<1>, pg8::StaticOrder, true, true>(F.lds + RING_OFF, g, S, E, F.wave); }
            { pg8::Gemm g{(const bf16_t*)(ws + WS_QC), (const bf16_t*)(ws + WS_WC), M, D, CW}; pg8::StaticOrder S; S.init(M, D, F.G, launder_s((int)blockIdx.x));
              EpiMerge<2> E{(bf16_t*)(ws + WS_MERGED), (const bf16_t*)(ws + WS_G)};
              pg8::gemm_phase<EpiMerge<2>, pg8::StaticOrder, true, true>(F.lds + RING_OFF, g, S, E, F.wave); }
        }
#endif
        } SEAM(pb + 6);
        if (IN(pb + 7)) {
#if !((DIS_MASK >> 4) & 1)
 unsigned char* ws = launder_p(args.ws); bf16* hb = (bf16*)(ws + WS_HB); float* ss = (float*)(ws + WS_SS); (void)hb; (void)ss;
            pg8::Gemm g{(const bf16_t*)(ws + WS_MERGED), (const bf16_t*)(ws + WS_WOUT), M, D, D}; pg8::StaticOrder S; S.init(M, D, F.G, launder_s((int)blockIdx.x));
            for (int rep = (PROBE_PHASE == 9 ? 0 : 1); rep < 2; ++rep) { EpiResid E{args.out, args.out, hb, ss, 1.0f, (LAS float*)(F.lds + RING_BYTES), rep == 0 ? 1 : 0};
            pg8::gemm_phase<EpiResid, pg8::StaticOrder, true, true>(F.lds + RING_OFF, g, S, E, F.wave); }
#endif
        } SEAM(pb + 7);
        if (IN(pb + 8)) {
#if !((DIS_MASK >> 5) & 1)
 unsigned char* ws = launder_p(args.ws); bf16* hb = (bf16*)(ws + WS_HB); float* ss = (float*)(ws + WS_SS); (void)hb; (void)ss;
            pg8::Gemm g{hb, (const bf16_t*)(ws + WS_W2IN), M, 2 * DFF, D}; pg8::StaticOrder S; S.init(M, 2 * DFF, F.G, launder_s((int)blockIdx.x));
            EpiSwiglu E{(bf16_t*)(ws + WS_ACT), ss};
            for (int rep = (PROBE_PHASE == 2 ? 0 : 1); rep < 2; ++rep) pg8::gemm_phase<EpiSwiglu, pg8::StaticOrder, true, true>(F.lds + RING_OFF, g, S, E, F.wave);
#endif
        } SEAM(pb + 8);
        if (IN(pb + 9)) {
#if !((DIS_MASK >> 6) & 1)
 unsigned char* ws = launder_p(args.ws); bf16* hb = (bf16*)(ws + WS_HB); float* ss = (float*)(ws + WS_SS); (void)hb; (void)ss;
            pg8::Gemm g{(const bf16_t*)(ws + WS_ACT), (const bf16_t*)(ws + WS_W2OUT), M, D, DFF}; pg8::StaticOrder S; S.init(M, D, F.G, launder_s((int)blockIdx.x));
            for (int rep = (PROBE_PHASE == 3 ? 0 : 1); rep < 2; ++rep) { EpiResid E{args.out, args.out, hb, ss, 0.5f, (LAS float*)(F.lds + RING_BYTES), rep == 0 ? 1 : 0};
            pg8::gemm_phase<EpiResid, pg8::StaticOrder, true, true>(F.lds + RING_OFF, g, S, E, F.wave); }
#endif
        } SEAM(pb + 9);
    }
#if EN_P0
    if (IN(N_PHASES - 1)) { final_norm(KIN, args.out, args.ws, F.lds, F.wave, F.vcu, F.G); }
#endif
#undef IN
#undef SEAM
}

extern "C" void kernel_launch(void* const* d_in, const int* in_sizes, int n_in, void* d_out, int out_size, void* d_ws, size_t ws_size, hipStream_t stream) {
    static int grid = 0;
    if (grid == 0) {
        if (n_in != 23 || in_sizes[0] != M * D || out_size != M * D || ws_size < WS_END) { fprintf(stderr, "kernel_launch: unexpected shapes (n_in %d, ws %zu)\n", n_in, ws_size); grid = -1; return; }
        int dev = 0, cus = 0, per_cu = 0;
        if (hipGetDevice(&dev) != hipSuccess || hipDeviceGetAttribute(&cus, hipDeviceAttributeMultiprocessorCount, dev) != hipSuccess) { grid = -1; return; }
        if (hipFuncSetAttribute((const void*)mk_fwd, hipFuncAttributeMaxDynamicSharedMemorySize, LDS_BYTES) != hipSuccess) { fprintf(stderr, "kernel_launch: hipFuncSetAttribute failed\n"); grid = -1; return; }
        if (hipOccupancyMaxActiveBlocksPerMultiprocessor(&per_cu, (const void*)mk_fwd, NWAVES * 64, LDS_BYTES) != hipSuccess || per_cu < 1) { fprintf(stderr, "kernel_launch: occupancy query says %d\n", per_cu); }
        (void)hipGetLastError();
        grid = cus;
    }
    if (grid < 0) return;
    if (hipMemsetAsync((char*)d_ws + WS_CTL, 0, CTL_ZERO_BYTES, stream) != hipSuccess) return;
    Args a{};
    for (int i = 0; i < 23; ++i) a.in[i] = (const float*)d_in[i];
    a.out = (float*)d_out; a.ws = (unsigned char*)d_ws;
#if MK_ONE_LAUNCH
    a.ph_lo = 0; a.ph_hi = N_PHASES;
    hipLaunchKernelGGL(mk_fwd, dim3(grid), dim3(NWAVES * 64), LDS_BYTES, stream, a);
#endif
}
```

```cpp
#include <hip/hip_runtime.h>
#include <cstdio>
#include <cstdint>

#ifndef MK_ONE_LAUNCH
#define MK_ONE_LAUNCH 1
#endif
#ifndef PROBE_PHASE
#define PROBE_PHASE 0
#endif
#ifndef EN_P0
#define EN_P0 MK_ONE_LAUNCH
#endif
#ifndef EN_PREP
#define EN_PREP MK_ONE_LAUNCH
#endif
#ifndef EN_DSA
#define EN_DSA MK_ONE_LAUNCH
#endif
#ifndef DIS_MASK
#define DIS_MASK 0
#endif
#ifndef MK_ONE_LAUNCH
#define MK_ONE_LAUNCH 1
#endif

__device__ __forceinline__ int lane_id_v() { int l; asm volatile("v_mbcnt_lo_u32_b32 %0, -1, 0\n\tv_mbcnt_hi_u32_b32 %0, -1, %0" : "=v"(l)); return l; }
namespace pg8 {
#define PG8_LAS __attribute__((address_space(3)))
typedef unsigned short bf16_t;
typedef short bf16x8 __attribute__((ext_vector_type(8)));
typedef float f32x4 __attribute__((ext_vector_type(4)));
typedef unsigned u32x4 __attribute__((ext_vector_type(4)));
typedef unsigned u32x2 __attribute__((ext_vector_type(2)));
constexpr int BM = 256, BK = 64, HALF = 128, HTB = HALF * BK * 2, STAGE_BYTES = 8 * HTB, NXCD = 8, WGM = 8;

__host__ __device__ __forceinline__ int lds_byte(int r, int c) { const int st = (r >> 4) * 2 + (c >> 5), rr = r & 15, cc = c & 31, ob = rr * 64 + cc * 2; return st * 1024 + (ob ^ (((ob >> 9) & 1) << 5)); }
__host__ __device__ __forceinline__ void stage_rc(int b, int& R, int& C) { const int st = b / 1024, sb = b % 1024, swz = sb ^ (((sb >> 9) & 1) << 5); R = (st >> 1) * 16 + swz / 64; C = (st & 1) * 32 + (swz % 64) / 2; }
__host__ __device__ __forceinline__ int perm32(int rho) { const int n = rho >> 4, i = rho & 15; return 8 * (i >> 2) + 4 * n + (i & 3); }

struct Unit { int pm, pn; };
struct Gemm { const bf16_t* A; const bf16_t* Bt; int M, N, K; };

struct StaticOrder {
    int nM, nN, nwg, G, c;
    __host__ __device__ void init(int M, int N, int G_, int c_) { nM = M / BM; nN = N / BM; nwg = nM * nN; G = G_; c = c_; }
    __host__ __device__ bool next(int i, Unit& u) const {
        const long L = (long)i * G + c; if (L >= nwg) return false;
        int wgid = (int)L; { const int q = nwg / NXCD, r = nwg % NXCD, xcd = wgid % NXCD, off = wgid / NXCD; wgid = (xcd < r ? xcd * (q + 1) : r * (q + 1) + (xcd - r) * q) + off; }
        const int nig = WGM * nN, gid = wgid / nig, fm = gid * WGM, gsz = (nM - fm) < WGM ? (nM - fm) : WGM;
        u.pm = fm + ((wgid % nig) % gsz); u.pn = (wgid % nig) / gsz; return true;
    }
    __device__ __forceinline__ void a_ready(const Unit&) const {}
    __device__ __forceinline__ void done(const Unit&) const {}
};

__device__ __forceinline__ unsigned cvt_pk_bf16(float lo, float hi) { unsigned r; asm volatile("v_cvt_pk_bf16_f32 %0, %1, %2" : "=v"(r) : "v"(lo), "v"(hi)); return r; }

template <class Epi, class Sched, bool ALIGN_EPI = false, bool SP2 = false>
__device__ __forceinline__ void gemm_phase(PG8_LAS unsigned char* lds, const Gemm g, const Sched& S, const Epi& E, const int wid_) {
    int wid = wid_; asm volatile("" : "+s"(wid));
    const int lane = lane_id_v(), tid = wid * 64 + lane,
              wr = wid >> 2, wc = wid & 3, fr = lane & 15, fq = lane >> 4;
    const int K = g.K, nt = K / BK;
    unsigned voffA[2], voffB[2];
#pragma unroll
    for (int i = 0; i < 2; ++i) { int R, C; stage_rc(tid * 16 + i * 8192, R, C); const int Rb = Epi::PERM ? ((R & ~31) + perm32(R & 31)) : R;
        voffA[i] = (unsigned)(R * K + C) * 2u; voffB[i] = (unsigned)(Rb * K + C) * 2u; }
    const size_t kstep = (size_t)(BK * 2);
    const size_t hstep = (size_t)HALF * K * 2;
    const size_t tstep = 2 * hstep;
    const unsigned ldsw = (unsigned)wid * 1024u;
    const int aoff = lds_byte(wr * 64 + fr, fq * 8), boff = lds_byte(wc * 32 + fr, fq * 8);
#define PG8_SA(b, h) (((b) * 2 + (h)) * HTB)
#define PG8_SB(b, h) ((4 + (b) * 2 + (h)) * HTB)
#define PG8_STAGE(bufoff, gbase, voff) do { _Pragma("unroll") for (int _i = 0; _i < 2; ++_i) \
        __builtin_amdgcn_global_load_lds((const unsigned*)((const char*)(gbase) + (voff)[_i]), (PG8_LAS unsigned*)(lds + (bufoff) + ldsw + _i * 8192), 16, 0, 0); } while (0)
#define PG8_LDA(dst, b, h) do { _Pragma("unroll") for (int m = 0; m < 4; ++m) _Pragma("unroll") for (int k = 0; k < 2; ++k) dst[m][k] = *(const PG8_LAS bf16x8*)(lds + PG8_SA(b, h) + aoff + m * 2048 + k * 1024); } while (0)
#define PG8_LDB(dst, b, h) do { _Pragma("unroll") for (int n = 0; n < 2; ++n) _Pragma("unroll") for (int k = 0; k < 2; ++k) dst[n][k] = *(const PG8_LAS bf16x8*)(lds + PG8_SB(b, h) + boff + n * 2048 + k * 1024); } while (0)
#define PG8_MMA(ai, bj, At, Bt) do { __builtin_amdgcn_s_setprio(1); _Pragma("unroll") for (int m = 0; m < 4; ++m) _Pragma("unroll") for (int n = 0; n < 2; ++n) _Pragma("unroll") for (int k = 0; k < 2; ++k) \
        acc[ai][bj][m][n] = __builtin_amdgcn_mfma_f32_16x16x32_bf16(Bt[n][k], At[m][k], acc[ai][bj][m][n], 0, 0, 0); __builtin_amdgcn_s_setprio(0); } while (0)
#define PG8_WAIT_V(n) asm volatile("s_waitcnt vmcnt(" #n ")" ::: "memory")
#define PG8_WAIT_L(n) asm volatile("s_waitcnt lgkmcnt(" #n ")" ::: "memory")
#define PG8_BAR __builtin_amdgcn_s_barrier()
#define PG8_SCHED __builtin_amdgcn_sched_barrier(0)
    Unit cur, nxt; int ui = 0;
    if (!S.next(0, cur)) return;
    f32x4 acc[2][2][4][2];
#pragma unroll
    for (int a = 0; a < 2; ++a)
#pragma unroll
        for (int b = 0; b < 2; ++b)
#pragma unroll
            for (int m = 0; m < 4; ++m)
#pragma unroll
                for (int n = 0; n < 2; ++n) acc[a][b][m][n] = (f32x4){0.f, 0.f, 0.f, 0.f};
    bf16x8 At[4][2], B0[2][2], B1[2][2];
    const char* cA = (const char*)g.A + (size_t)cur.pm * tstep; const char* cB = (const char*)g.Bt + (size_t)cur.pn * tstep;
    S.a_ready(cur);
    if constexpr (SP2) {
        PG8_STAGE(PG8_SB(0, 0), cB, voffB); PG8_STAGE(PG8_SB(0, 1), cB + hstep, voffB); PG8_STAGE(PG8_SA(0, 0), cA, voffA); PG8_STAGE(PG8_SA(0, 1), cA + hstep, voffA);
        if (wr == 1) PG8_BAR;
        PG8_WAIT_V(2); PG8_BAR;
        PG8_STAGE(PG8_SB(1, 0), cB + kstep, voffB); PG8_STAGE(PG8_SA(1, 0), cA + kstep, voffA); PG8_STAGE(PG8_SB(1, 1), cB + hstep + kstep, voffB);
        PG8_WAIT_V(6); PG8_BAR;
    } else {
        PG8_STAGE(PG8_SB(0, 0), cB, voffB); PG8_STAGE(PG8_SA(0, 0), cA, voffA); PG8_STAGE(PG8_SB(0, 1), cB + hstep, voffB); PG8_STAGE(PG8_SA(0, 1), cA + hstep, voffA);
        if (wr == 1) PG8_BAR;
        PG8_WAIT_V(4); PG8_BAR;
        PG8_STAGE(PG8_SB(1, 0), cB + kstep, voffB); PG8_STAGE(PG8_SA(1, 0), cA + kstep, voffA); PG8_STAGE(PG8_SB(1, 1), cB + hstep + kstep, voffB);
        PG8_WAIT_V(6); PG8_BAR;
    }
    for (;;) {
        const bool has_next = S.next(ui + 1, nxt);
        const char* nA = has_next ? (const char*)g.A + (size_t)nxt.pm * tstep : cA; const char* nB = has_next ? (const char*)g.Bt + (size_t)nxt.pn * tstep : cB;
        for (int t = 0; t < nt; t += 2) {
            const bool last = (t == nt - 2);
            const char* a1 = cA + (size_t)(t + 1) * kstep;
            const char* a2 = last ? nA : cA + (size_t)(t + 2) * kstep; const char* b2 = last ? nB : cB + (size_t)(t + 2) * kstep;
            const char* a3 = a2 + kstep; const char* b3 = b2 + kstep;
            if (last && has_next) S.a_ready(nxt);
            if constexpr (SP2) {
            PG8_LDB(B0, 0, 0); PG8_LDB(B1, 0, 1); PG8_SCHED; PG8_LDA(At, 0, 0); PG8_STAGE(PG8_SA(1, 1), a1 + hstep, voffA);
            PG8_WAIT_V(8); PG8_WAIT_L(0); PG8_BAR; PG8_MMA(0, 0, At, B0); PG8_MMA(0, 1, At, B1); PG8_BAR; PG8_SCHED;
            PG8_LDA(At, 0, 1); PG8_STAGE(PG8_SB(0, 0), b2, voffB); PG8_STAGE(PG8_SB(0, 1), b2 + hstep, voffB); PG8_STAGE(PG8_SA(0, 0), a2, voffA);
            PG8_WAIT_V(8); PG8_WAIT_L(0); PG8_BAR; PG8_MMA(1, 0, At, B0); PG8_MMA(1, 1, At, B1); PG8_BAR; PG8_SCHED;
            PG8_LDB(B0, 1, 0); PG8_LDB(B1, 1, 1); PG8_SCHED; PG8_LDA(At, 1, 0); PG8_STAGE(PG8_SA(0, 1), a2 + hstep, voffA);
            PG8_WAIT_V(8); PG8_WAIT_L(0); PG8_BAR; PG8_MMA(0, 0, At, B0); PG8_MMA(0, 1, At, B1); PG8_BAR; PG8_SCHED;
            PG8_LDA(At, 1, 1); PG8_STAGE(PG8_SB(1, 0), b3, voffB); PG8_STAGE(PG8_SB(1, 1), b3 + hstep, voffB); PG8_STAGE(PG8_SA(1, 0), a3, voffA);
            PG8_WAIT_V(8); PG8_WAIT_L(0); PG8_BAR; PG8_MMA(1, 0, At, B0); PG8_MMA(1, 1, At, B1); PG8_BAR; PG8_SCHED;
            } else {
            PG8_LDB(B0, 0, 0); PG8_SCHED; PG8_LDA(At, 0, 0); PG8_STAGE(PG8_SA(1, 1), a1 + hstep, voffA);
            PG8_WAIT_L(8); PG8_BAR; PG8_WAIT_L(0); PG8_MMA(0, 0, At, B0); PG8_BAR; PG8_SCHED;
            PG8_LDB(B1, 0, 1); PG8_STAGE(PG8_SB(0, 0), b2, voffB);
            PG8_BAR; PG8_WAIT_L(0); PG8_MMA(0, 1, At, B1); PG8_BAR;
            PG8_LDA(At, 0, 1); PG8_STAGE(PG8_SA(0, 0), a2, voffA);
            PG8_BAR; PG8_WAIT_L(0); PG8_MMA(1, 0, At, B0); PG8_BAR; PG8_SCHED;
            PG8_STAGE(PG8_SB(0, 1), b2 + hstep, voffB);
            PG8_WAIT_V(6); PG8_BAR; PG8_MMA(1, 1, At, B1); PG8_BAR;
            PG8_LDB(B0, 1, 0); PG8_SCHED; PG8_LDA(At, 1, 0); PG8_STAGE(PG8_SA(0, 1), a2 + hstep, voffA);
            PG8_WAIT_L(8); PG8_BAR; PG8_WAIT_L(0); PG8_MMA(0, 0, At, B0); PG8_BAR; PG8_SCHED;
            PG8_LDB(B1, 1, 1); PG8_STAGE(PG8_SB(1, 0), b3, voffB);
            PG8_BAR; PG8_WAIT_L(0); PG8_MMA(0, 1, At, B1); PG8_BAR;
            PG8_LDA(At, 1, 1); PG8_STAGE(PG8_SA(1, 0), a3, voffA);
            PG8_BAR; PG8_WAIT_L(0); PG8_MMA(1, 0, At, B0); PG8_BAR; PG8_SCHED;
            PG8_STAGE(PG8_SB(1, 1), b3 + hstep, voffB);
            PG8_WAIT_V(6); PG8_BAR; PG8_MMA(1, 1, At, B1); PG8_BAR;
            }
        }
        if constexpr (ALIGN_EPI) { if (wr == 0) PG8_BAR; }
        E(acc, cur, wr, wc, fr, fq); S.done(cur);
        if (!has_next) break;
#pragma unroll
        for (int a = 0; a < 2; ++a)
#pragma unroll
            for (int b = 0; b < 2; ++b)
#pragma unroll
                for (int m = 0; m < 4; ++m)
#pragma unroll
                    for (int n = 0; n < 2; ++n) acc[a][b][m][n] = (f32x4){0.f, 0.f, 0.f, 0.f};
        cur = nxt; cA = nA; cB = nB; ++ui;
        if constexpr (ALIGN_EPI) { if (wr == 1) PG8_BAR; }
    }
    PG8_WAIT_V(0);
    if constexpr (!ALIGN_EPI) { if (wr == 0) PG8_BAR; }
    PG8_BAR;
#undef PG8_SA
#undef PG8_SB
#undef PG8_STAGE
#undef PG8_LDA
#undef PG8_LDB
#undef PG8_MMA
#undef PG8_WAIT_V
#undef PG8_WAIT_L
#undef PG8_BAR
#undef PG8_SCHED
}
}

constexpr int NWAVES = 8;
constexpr int BATCH = 4, SEQ = 8192, D = 1024, DEPTH = 4, M = BATCH * SEQ;
constexpr int NMEM = 256, MROWS = BATCH * NMEM;
constexpr int AH = 8, AHD = 64, AW = 512, KVR = 128, IH = 8, IDIM = 32, TOPK = 256;
constexpr int PW_ = 256, CH = 4, CHD = 64, CW = 256;
constexpr int DFF = 2816, INW = 4520, INP = 5120;
constexpr float EPS = 1e-6f;
constexpr int C_QA = 0, C_CKV = 512, C_IQ = 640, C_IK = 896, C_IW = 928, C_Z = 936, C_QC = 1192, C_G = 1448;

constexpr size_t MiB = 1u << 20;
constexpr size_t WS_CTL = 0, CTL_ZERO_BYTES = 1 * MiB;
constexpr size_t WS_SS = 1 * MiB;
constexpr size_t WS_IW = 3 * MiB;
constexpr size_t WS_SGN = 4 * MiB;
constexpr size_t WS_MEMN = 5 * MiB;
constexpr size_t WS_WMEM = 7 * MiB;
constexpr size_t WS_MEMKV = 11 * MiB;
constexpr size_t WS_W1IN = 15 * MiB, WS_W1OUT = 26 * MiB, WS_WIN = 32 * MiB, WS_WA = 42 * MiB, WS_WB = 44 * MiB, WS_WC = 44 * MiB + 512 * 1024, WS_WOUT = 45 * MiB, WS_W2IN = 47 * MiB, WS_W2OUT = 58 * MiB;
constexpr size_t WS_HB = 64 * MiB;
constexpr size_t WS_ACT = 128 * MiB;
constexpr size_t WS_G = 128 * MiB;
constexpr size_t WS_QL = 320 * MiB;
constexpr size_t WS_CKV = 384 * MiB;
constexpr size_t WS_CKVRAW = 392 * MiB;
constexpr size_t WS_IQRAW = 408 * MiB;
constexpr size_t WS_IQF = 424 * MiB;
constexpr size_t WS_IK = 440 * MiB;
constexpr size_t WS_Z = 442 * MiB;
constexpr size_t WS_MERGED = 384 * MiB;
constexpr size_t WS_YB = 458 * MiB;
constexpr size_t WS_QC = 474 * MiB;
constexpr size_t WS_SEL = 490 * MiB;
constexpr size_t WS_VT = 506 * MiB;
constexpr size_t WS_WPT = 4 * MiB + 512 * 1024;
constexpr size_t WS_END = 510 * MiB;
constexpr int CW_BAR = 4096;

constexpr int RING_OFF = 0, RING_BYTES = 131072;
constexpr int LDS_BYTES = 155648;
constexpr int MISC_OFF = LDS_BYTES - 256;

#define GAS __attribute__((address_space(1)))
#define LAS __attribute__((address_space(3)))
typedef unsigned short bf16;
typedef unsigned v4u __attribute__((ext_vector_type(4)));
typedef unsigned v2u __attribute__((ext_vector_type(2)));
typedef float f32x4 __attribute__((ext_vector_type(4)));
typedef float f32x2 __attribute__((ext_vector_type(2)));
typedef GAS unsigned gu32;
#define RLX_AGENT __ATOMIC_RELAXED, __HIP_MEMORY_SCOPE_AGENT
#define LDS_WAIT() asm volatile("s_waitcnt lgkmcnt(0)" ::: "memory")
#define VM_WAIT() asm volatile("s_waitcnt vmcnt(0)" ::: "memory")
__device__ __forceinline__ unsigned f2bf(float f) { unsigned u = __builtin_bit_cast(unsigned, f); return (u + 0x7fffu + ((u >> 16) & 1u)) >> 16; }
__device__ __forceinline__ unsigned pk2(float lo, float hi) { return f2bf(lo) | (f2bf(hi) << 16); }
__device__ __forceinline__ float bflo(unsigned w) { return __builtin_bit_cast(float, w << 16); }
__device__ __forceinline__ float bfhi(unsigned w) { return __builtin_bit_cast(float, w & 0xffff0000u); }
typedef _Float16 h2_t __attribute__((ext_vector_type(2)));
typedef _Float16 f16x8_t __attribute__((ext_vector_type(8)));
__device__ __forceinline__ unsigned pkh2(float lo, float hi) { const h2_t v = {(_Float16)lo, (_Float16)hi}; return __builtin_bit_cast(unsigned, v); }
__device__ __forceinline__ float hlo(unsigned w) { return (float)__builtin_bit_cast(h2_t, w)[0]; }
__device__ __forceinline__ float hhi(unsigned w) { return (float)__builtin_bit_cast(h2_t, w)[1]; }
__device__ __forceinline__ float bf2f(bf16 b) { return __builtin_bit_cast(float, ((unsigned)b) << 16); }

#define XB_TMO      128
#define XB_XCNT(j)  (256  + 64 * (j))
#define XB_XSUB(j)  (1280 + 64 * (j))
#define XB_XGEN(j)  (2304 + 64 * (j))
#define XB_TOP      3328
#define XB_TOPGEN   3392
#define XCD_BAR_WORDS 3456
#define XB_SPIN_CAP (1u << 23)

__device__ __forceinline__ unsigned xb_ld(unsigned* p)              { return __hip_atomic_load(p, __ATOMIC_RELAXED, __HIP_MEMORY_SCOPE_AGENT); }
__device__ __forceinline__ unsigned xb_add(unsigned* p, unsigned v) { return __hip_atomic_fetch_add(p, v, __ATOMIC_RELAXED, __HIP_MEMORY_SCOPE_AGENT); }
__device__ __forceinline__ unsigned xb_xcc_id() { return (unsigned)__builtin_amdgcn_s_getreg((3 << 11) | 20) & 0xFu; }
#define XB_SPIN(cond, bar) do { unsigned _sp = 0; while (cond) { __builtin_amdgcn_s_sleep(1); \
    if ((++_sp & 255u) == 0u) { if (xb_ld(&(bar)[XB_TMO])) break; if (_sp > XB_SPIN_CAP) { atomicAdd(&(bar)[XB_TMO], 1u); break; } } } } while (0)

struct XcdBarrier { unsigned* bar; unsigned x; volatile LAS unsigned* st; int wave; };

__device__ __forceinline__ XcdBarrier xcd_barrier_post(unsigned* bar, volatile LAS unsigned* st, int wave) {
    XcdBarrier b; b.bar = bar; b.x = xb_xcc_id(); b.st = st; b.wave = wave;
    if (threadIdx.x == 0) (void)xb_add(&bar[XB_XCNT(b.x)], 1u);
    return b;
}
__device__ __forceinline__ void xcd_barrier_complete(unsigned* bar, unsigned x, unsigned& nloc, unsigned& nx) {
    const unsigned G = gridDim.x * gridDim.y * gridDim.z;
    unsigned sum, cnt, mine, sp = 0u;
    for (;;) {
        sum = 0u; cnt = 0u; mine = 0u;
#pragma unroll
        for (unsigned j = 0; j < 16; ++j) { const unsigned c = xb_ld(&bar[XB_XCNT(j)]); sum += c; cnt += (c > 0u) ? 1u : 0u; mine = (j == x) ? c : mine; }
        if (sum == G) break;
        __builtin_amdgcn_s_sleep(1);
        if ((++sp & 255u) == 0u) { if (xb_ld(&bar[XB_TMO])) break; if (sp > XB_SPIN_CAP) { atomicAdd(&bar[XB_TMO], 1u); break; } }
    }
    nloc = mine > 0u ? mine : 1u; nx = cnt > 0u ? cnt : 1u;
}
__device__ __forceinline__ void xcd_barrier(const XcdBarrier& b) {
    asm volatile("s_waitcnt vmcnt(0)" ::: "memory");
    __syncthreads();
    int bw_ = b.wave; asm volatile("" : "+s"(bw_));
    if (bw_ == 0 && lane_id_v() == 0) {
        unsigned* bar = b.bar;
        __builtin_amdgcn_s_waitcnt(0);
        unsigned nloc = b.st[0], nx = b.st[1];
        if (nloc == 0u) { xcd_barrier_complete(bar, b.x, nloc, nx); b.st[0] = nloc; b.st[1] = nx; }
        const unsigned old = xb_add(&bar[XB_XSUB(b.x)], 1u);
        const unsigned gen = old / nloc;
        if (old + 1u == (gen + 1u) * nloc) {
            __builtin_amdgcn_fence(__ATOMIC_RELEASE, "agent");
            asm volatile("s_waitcnt vmcnt(0)" ::: "memory");
            const unsigned og = xb_add(&bar[XB_TOP], 1u);
            const unsigned tg = og / nx;
            if (og + 1u == (tg + 1u) * nx) xb_add(&bar[XB_TOPGEN], 1u);
            else XB_SPIN(xb_ld(&bar[XB_TOPGEN]) == tg, bar);
            __builtin_amdgcn_fence(__ATOMIC_ACQUIRE, "agent");
            xb_add(&bar[XB_XGEN(b.x)], 1u);
            asm volatile("s_waitcnt vmcnt(0)" ::: "memory");
        } else {
            XB_SPIN(xb_ld(&bar[XB_XGEN(b.x)]) == gen, bar);
            __builtin_amdgcn_fence(__ATOMIC_ACQUIRE, "agent");
            asm volatile("s_waitcnt vmcnt(0)" ::: "memory");
        }
    }
    __syncthreads();
}

struct Args {
    const float* in[23]; float* out; unsigned char* ws; int ph_lo, ph_hi;
};
template <class T> __device__ __forceinline__ T* uni(T* p) { const unsigned long long v = (unsigned long long)p; const unsigned lo = __builtin_amdgcn_readfirstlane((unsigned)v), hi = __builtin_amdgcn_readfirstlane((unsigned)(v >> 32)); return (T*)(((unsigned long long)hi << 32) | lo); }
__device__ __forceinline__ LAS unsigned char* uni_l(LAS unsigned char* p) { return (LAS unsigned char*)(unsigned)__builtin_amdgcn_readfirstlane((int)(unsigned)(size_t)p); }
__device__ __forceinline__ int uni_i(int v) { return __builtin_amdgcn_readfirstlane(v); }
struct PC { const float* const* in; float* out; unsigned char* ws; LAS unsigned char* lds; int wave, vcu, G; };
struct Frame {
    LAS unsigned char* lds;
    volatile LAS unsigned* MISC;
    gu32* ctl;
    int wave, vcu, G;
    unsigned char* ws;
};
__device__ __forceinline__ unsigned char* launder_p(unsigned char* p) { asm volatile("" : "+s"(p)); return p; }
__device__ __forceinline__ int launder_s(int v) { asm volatile("" : "+s"(v)); return v; }
__device__ __forceinline__ int launder_v(int v) { asm volatile("" : "+v"(v)); return v; }
__device__ __forceinline__ float wave_sum(float v) {
#pragma unroll
    for (int o = 1; o < 64; o <<= 1) v += __shfl_xor(v, o);
    return v;
}
__device__ __forceinline__ float wave_max(float v) {
#pragma unroll
    for (int o = 1; o < 64; o <<= 1) v = fmaxf(v, __shfl_xor(v, o));
    return v;
}

using pg8::Unit; using pg8::bf16_t;
#define LAUNDER2(a, b) asm volatile("" : "+v"(a), "+v"(b))
__device__ __forceinline__ float row_scale(const float* ss, int row) {
    const f32x4 a = *(const f32x4*)(ss + (size_t)row * 4);
    const float s = (a.x + a.y) + (a.z + a.w);
    return __builtin_amdgcn_rsqf(s * (1.0f / D) + EPS);
}
__device__ __forceinline__ float sigmoidf_(float x) { return 1.0f / (1.0f + __expf(-x)); }
__device__ __forceinline__ pg8::u32x2 pack4(const f32x4 v) { pg8::u32x2 w; w.x = pg8::cvt_pk_bf16(v[0], v[1]); w.y = pg8::cvt_pk_bf16(v[2], v[3]); return w; }

struct EpiSwiglu {
    static constexpr bool PERM = true;
    bf16_t* O; const float* ss;
    __device__ __forceinline__ void operator()(const f32x4 (&acc)[2][2][4][2], const Unit& u, int wr, int wc, int fr_, int fq_) const {
        const int l_ = lane_id_v(); const int fr = l_ & 15, fq = l_ >> 4; (void)fr_; (void)fq_;
        int rb = wr * 64 + fr, cb = wc * 32 + 8 * fq; LAUNDER2(rb, cb);
        const int row0 = u.pm * 256 + rb, col0 = u.pn * 128 + cb;
#pragma unroll
        for (int ai = 0; ai < 2; ++ai)
#pragma unroll
            for (int m = 0; m < 4; ++m) { const int row = row0 + ai * 128 + m * 16; const float s = row_scale(ss, row);
                pg8::u32x4 w;
                { const f32x4 a = acc[ai][0][m][0] * s, b = acc[ai][1][m][0] * s; f32x4 o;
#pragma unroll
                  for (int i = 0; i < 4; ++i) o[i] = a[i] * sigmoidf_(a[i]) * b[i];
                  w.x = pg8::cvt_pk_bf16(o[0], o[1]); w.y = pg8::cvt_pk_bf16(o[2], o[3]); }
                { const f32x4 a = acc[ai][0][m][1] * s, b = acc[ai][1][m][1] * s; f32x4 o;
#pragma unroll
                  for (int i = 0; i < 4; ++i) o[i] = a[i] * sigmoidf_(a[i]) * b[i];
                  w.z = pg8::cvt_pk_bf16(o[0], o[1]); w.w = pg8::cvt_pk_bf16(o[2], o[3]); }
                *(pg8::u32x4*)(O + (size_t)row * DFF + col0) = w; }
    }
};
struct EpiResid {
    static constexpr bool PERM = true;
    const float* base; float* out; bf16_t* hb; float* ss; float alpha; LAS float* P; int dry;
    __device__ __forceinline__ void operator()(const f32x4 (&acc)[2][2][4][2], const Unit& u, int wr, int wc, int fr_, int fq_) const {
        const int l_ = lane_id_v(); const int fr = l_ & 15, fq = l_ >> 4; (void)fr_; (void)fq_;
        int rb = wr * 64 + fr, cb = wc * 32 + 8 * fq; LAUNDER2(rb, cb);
        const int row0 = u.pm * 256 + rb, col0 = u.pn * 256 + cb;
#pragma unroll
        for (int ai = 0; ai < 2; ++ai)
#pragma unroll
          for (int mh = 0; mh < 2; ++mh) {
            f32x4 bs[2][2][2];
#pragma unroll
            for (int mm = 0; mm < 2; ++mm) { const size_t off = (size_t)(row0 + ai * 128 + (2 * mh + mm) * 16) * D + col0;
#pragma unroll
                for (int bj = 0; bj < 2; ++bj)
#pragma unroll
                    for (int n = 0; n < 2; ++n) bs[mm][bj][n] = *(const f32x4*)(base + off + bj * 128 + n * 4); }
#pragma unroll
            for (int mm = 0; mm < 2; ++mm) { const int m = 2 * mh + mm; const int row = row0 + ai * 128 + m * 16; const size_t off = (size_t)row * D + col0; float q = 0.f;
#pragma unroll
                for (int bj = 0; bj < 2; ++bj) { const f32x4 v0 = bs[mm][bj][0] + acc[ai][bj][m][0] * alpha, v1 = bs[mm][bj][1] + acc[ai][bj][m][1] * alpha;
                    if (!dry) { *(f32x4*)(out + off + bj * 128) = v0; *(f32x4*)(out + off + bj * 128 + 4) = v1;
                        pg8::u32x4 w; w.x = pg8::cvt_pk_bf16(v0[0], v0[1]); w.y = pg8::cvt_pk_bf16(v0[2], v0[3]); w.z = pg8::cvt_pk_bf16(v1[0], v1[1]); w.w = pg8::cvt_pk_bf16(v1[2], v1[3]);
                        *(pg8::u32x4*)(hb + off + bj * 128) = w; }
                    q += ((v0[0] * v0[0] + v0[1] * v0[1]) + (v0[2] * v0[2] + v0[3] * v0[3])) + ((v1[0] * v1[0] + v1[1] * v1[1]) + (v1[2] * v1[2] + v1[3] * v1[3])); }
                q += __shfl_xor(q, 16); q += __shfl_xor(q, 32);
                if (fq == 0) P[(rb + ai * 128 + m * 16) * 4 + wc] = q; }
            asm volatile("" ::: "memory"); }
        asm volatile("s_waitcnt lgkmcnt(0)" ::: "memory"); __builtin_amdgcn_s_barrier(); asm volatile("" ::: "memory");
        const int tid = (wr * 4 + wc) * 64 + fq * 16 + fr;
        if (tid < 256 && !dry) { const f32x4 p = *(const LAS f32x4*)(P + tid * 4); ss[(size_t)(u.pm * 256 + tid) * 4 + u.pn] = (p.x + p.y) + (p.z + p.w); }
    }
};
struct EpiPlainBf16 {
    static constexpr bool PERM = false;
    bf16_t* O; int ldo;
    __device__ __forceinline__ void operator()(const f32x4 (&acc)[2][2][4][2], const Unit& u, int wr, int wc, int fr_, int fq_) const {
        const int l_ = lane_id_v(); const int fr = l_ & 15, fq = l_ >> 4; (void)fr_; (void)fq_;
        int rb = wr * 64 + fr, cb = wc * 32 + 4 * fq; LAUNDER2(rb, cb);
        const int row0 = u.pm * 256 + rb, col0 = u.pn * 256 + cb;
#pragma unroll
        for (int ai = 0; ai < 2; ++ai)
#pragma unroll
            for (int m = 0; m < 4; ++m) { bf16_t* rowp = O + (size_t)(row0 + ai * 128 + m * 16) * ldo + col0;
#pragma unroll
                for (int bj = 0; bj < 2; ++bj)
#pragma unroll
                    for (int n = 0; n < 2; ++n) *(pg8::u32x2*)(rowp + bj * 128 + n * 16) = pack4(acc[ai][bj][m][n]); }
    }
};
struct EpiInProj {
    static constexpr bool PERM = true;
    const float* ss; bf16_t* qa; float* ckvraw; bf16_t* ik; float* iw; bf16_t* iqraw; bf16_t* z; bf16_t* qc; bf16_t* G;
    __device__ __forceinline__ void operator()(const f32x4 (&acc)[2][2][4][2], const Unit& u, int wr, int wc, int fr_, int fq_) const {
        const int l_ = lane_id_v(); const int fr = l_ & 15, fq = l_ >> 4; (void)fr_; (void)fq_;
        int rb = wr * 64 + fr, ct = wc * 32 + 8 * fq; LAUNDER2(rb, ct);
        const int row0 = u.pm * 256 + rb; const int pn = u.pn;
        if (pn == 4) {
#pragma unroll
            for (int ai = 0; ai < 2; ++ai)
#pragma unroll
                for (int m = 0; m < 4; ++m) { const int row = row0 + ai * 128 + m * 16; const float s = row_scale(ss, row);
#pragma unroll
                    for (int n = 0; n < 2; ++n) *(f32x4*)(ckvraw + (size_t)row * KVR + ct + n * 4) = acc[ai][0][m][n] * s;
                    if (wc == 0) { const f32x4 k0 = acc[ai][1][m][0] * s, k1 = acc[ai][1][m][1] * s; pg8::u32x4 w; w.x = pkh2(k0[0], k0[1]); w.y = pkh2(k0[2], k0[3]); w.z = pkh2(k1[0], k1[1]); w.w = pkh2(k1[2], k1[3]);
                        *(pg8::u32x4*)(ik + (size_t)row * IDIM + 8 * fq) = w; }
                    if (wc == 1 && fq == 0) { *(f32x4*)(iw + (size_t)row * IH) = acc[ai][1][m][0] * s; *(f32x4*)(iw + (size_t)row * IH + 4) = acc[ai][1][m][1] * s; } }
        } else {
            bf16_t* dst0; int ld; bool sig = false; const bool f16out = (pn == 5);
            if (pn < 4) { dst0 = qa + pn * 256; ld = 1024; } else if (pn == 5) { dst0 = iqraw; ld = 256; } else if (pn == 6) { dst0 = z; ld = 256; } else if (pn == 7) { dst0 = qc; ld = 256; } else { dst0 = G + (pn - 8) * 256; ld = 3072; sig = true; }
#pragma unroll
            for (int ai = 0; ai < 2; ++ai)
#pragma unroll
                for (int m = 0; m < 4; ++m) { const int row = row0 + ai * 128 + m * 16; const float s = row_scale(ss, row); bf16_t* rowp = dst0 + (size_t)row * ld + ct;
#pragma unroll
                    for (int bj = 0; bj < 2; ++bj) { f32x4 o0 = acc[ai][bj][m][0] * s, o1 = acc[ai][bj][m][1] * s;
                        if (sig) {
#pragma unroll
                            for (int i = 0; i < 4; ++i) { o0[i] = sigmoidf_(o0[i]); o1[i] = sigmoidf_(o1[i]); } }
                        pg8::u32x4 wo;
                        if (f16out) { wo.x = pkh2(o0[0], o0[1]); wo.y = pkh2(o0[2], o0[3]); wo.z = pkh2(o1[0], o1[1]); wo.w = pkh2(o1[2], o1[3]); }
                        else { wo.x = pg8::cvt_pk_bf16(o0[0], o0[1]); wo.y = pg8::cvt_pk_bf16(o0[2], o0[3]); wo.z = pg8::cvt_pk_bf16(o1[0], o1[1]); wo.w = pg8::cvt_pk_bf16(o1[2], o1[3]); }
                        *(pg8::u32x4*)(rowp + bj * 128) = wo; } }
        }
    }
};
template <int MODE> struct EpiMerge {
    static constexpr bool PERM = false;
    bf16_t* Mg; const bf16_t* G;
    __device__ __forceinline__ void operator()(const f32x4 (&acc)[2][2][4][2], const Unit& u, int wr, int wc, int fr_, int fq_) const {
        const int l_ = lane_id_v(); const int fr = l_ & 15, fq = l_ >> 4; (void)fr_; (void)fq_;
        int rb = wr * 64 + fr, cb = wc * 32 + 4 * fq; LAUNDER2(rb, cb);
        const int row0 = u.pm * 256 + rb, col0 = u.pn * 256 + cb;
#pragma unroll
        for (int ai = 0; ai < 2; ++ai)
#pragma unroll
          for (int mh = 0; mh < 2; ++mh) {
            pg8::u32x2 gw[2][2][2], pw[2][2][2];
#pragma unroll
            for (int mm = 0; mm < 2; ++mm) { const int row = row0 + ai * 128 + (2 * mh + mm) * 16;
                const bf16_t* gp = G + (size_t)row * 3072 + MODE * 1024 + col0; const bf16_t* mp = Mg + (size_t)row * D + col0;
#pragma unroll
                for (int bj = 0; bj < 2; ++bj)
#pragma unroll
                    for (int n = 0; n < 2; ++n) { gw[mm][bj][n] = *(const pg8::u32x2*)(gp + bj * 128 + n * 16); if (MODE > 0) pw[mm][bj][n] = *(const pg8::u32x2*)(mp + bj * 128 + n * 16); } }
#pragma unroll
            for (int mm = 0; mm < 2; ++mm) { const int m = 2 * mh + mm; const int row = row0 + ai * 128 + m * 16; bf16_t* mp = Mg + (size_t)row * D + col0;
#pragma unroll
                for (int bj = 0; bj < 2; ++bj)
#pragma unroll
                    for (int n = 0; n < 2; ++n) { f32x4 o = acc[ai][bj][m][n]; const pg8::u32x2 g = gw[mm][bj][n];
                        o[0] *= bflo(g.x); o[1] *= bfhi(g.x); o[2] *= bflo(g.y); o[3] *= bfhi(g.y);
                        if (MODE > 0) { const pg8::u32x2 p = pw[mm][bj][n]; o[0] += bflo(p.x); o[1] += bfhi(p.x); o[2] += bflo(p.y); o[3] += bfhi(p.y); }
                        *(pg8::u32x2*)(mp + bj * 128 + n * 16) = pack4(o); } }
            asm volatile("" ::: "memory"); }
    }
};

template <class Map>
__device__ __forceinline__ void transpose_item(const float* W, int K, int N, const float* gain, bf16* WT, LAS float* scr, int item, int lane, Map map) {
    const int nblk = (N + 63) / 64, kb = item / nblk, nb = item % nblk, k0 = 64 * kb, n0 = 64 * nb;
    const int nn = n0 + 4 * (lane & 15); const bool nok = nn < N;
#pragma unroll 4
    for (int i = 0; i < 16; ++i) { const int kk = 4 * i + (lane >> 4); f32x4 v = nok ? *(const f32x4*)(W + (size_t)(k0 + kk) * N + nn) : (f32x4){0.f, 0.f, 0.f, 0.f};
        if (gain) v = v * gain[k0 + kk];
        *(LAS f32x4*)(scr + kk * 68 + 4 * (lane & 15)) = v; }
    LDS_WAIT(); asm volatile("" ::: "memory");
    const int c = lane & 7;
#pragma unroll
    for (int j = 0; j < 8; ++j) { const int n = (lane >> 3) + 8 * j; const LAS float* sp = scr + (8 * c) * 68 + n;
        v4u o; o.x = pk2(sp[0 * 68], sp[1 * 68]); o.y = pk2(sp[2 * 68], sp[3 * 68]); o.z = pk2(sp[4 * 68], sp[5 * 68]); o.w = pk2(sp[6 * 68], sp[7 * 68]);
        if (n0 + n < N) { const int dr = map(n0 + n); if (dr >= 0) *(GAS v4u*)(WT + (size_t)dr * K + k0 + 8 * c) = o; } }
    LDS_WAIT(); asm volatile("" ::: "memory");
}
struct MapId { int off; __device__ __forceinline__ int operator()(int n) const { return off + n; } };
struct MapSwiglu { __device__ __forceinline__ int operator()(int c) const { const int half = c >= DFF ? 1 : 0, j = c - half * DFF; return 256 * (j >> 7) + 128 * half + (j & 127); } };
struct MapInProj { __device__ __forceinline__ int operator()(int c) const {
    if (c < C_CKV) return -1;
    if (c < C_IQ) return 1024 + (c - C_CKV);
    if (c < C_IK) return 1280 + (c - C_IQ);
    if (c < C_IW) return 1152 + (c - C_IK);
    if (c < C_Z) return 1184 + (c - C_IW);
    if (c < C_QC) return 1536 + (c - C_Z);
    if (c < C_G) return 1792 + (c - C_QC);
    return 2048 + (c - C_G); } };
__device__ __forceinline__ void qlat_item(const float* win, const float* mixn, const float* wuk, bf16* WT, int item, int lane) {
    const int kc = item & 127, rh = (item >> 7) & 1, h = item >> 8; const int r = rh * 64 + lane;
    const f32x4* wp = (const f32x4*)(wuk + (size_t)r * (AH * AHD) + h * 64);
    float acc[8] = {0.f, 0.f, 0.f, 0.f, 0.f, 0.f, 0.f, 0.f};
#pragma unroll 1
    for (int dc = 0; dc < 4; ++dc) {
        const f32x4 w0 = wp[4 * dc], w1 = wp[4 * dc + 1], w2 = wp[4 * dc + 2], w3 = wp[4 * dc + 3];
#pragma unroll
        for (int kk = 0; kk < 8; ++kk) { const f32x4* ip = (const f32x4*)(win + (size_t)(kc * 8 + kk) * INW + h * 64 + 16 * dc);
            const f32x4 a0 = ip[0], a1 = ip[1], a2 = ip[2], a3 = ip[3];
            acc[kk] += (a0.x * w0.x + a0.y * w0.y + a0.z * w0.z + a0.w * w0.w) + (a1.x * w1.x + a1.y * w1.y + a1.z * w1.z + a1.w * w1.w)
                     + (a2.x * w2.x + a2.y * w2.y + a2.z * w2.z + a2.w * w2.w) + (a3.x * w3.x + a3.y * w3.y + a3.z * w3.z + a3.w * w3.w);
            if (kk & 1) asm volatile("" ::: "memory"); }
    }
    const f32x4 g0 = *(const f32x4*)(mixn + kc * 8), g1 = *(const f32x4*)(mixn + kc * 8 + 4);
    v4u w; w.x = pk2(acc[0] * g0.x, acc[1] * g0.y); w.y = pk2(acc[2] * g0.z, acc[3] * g0.w); w.z = pk2(acc[4] * g1.x, acc[5] * g1.y); w.w = pk2(acc[6] * g1.z, acc[7] * g1.w);
    *(GAS v4u*)(WT + (size_t)(h * 128 + r) * D + kc * 8) = w;
}
__device__ __forceinline__ void wafold_item(const float* wuv, const float* wba, bf16* WT, int item, int lane) {
    const int ng = item & 15, rg = (item >> 4) & 15, h = item >> 8; const int n = ng * 64 + lane, r0 = rg * 8;
    float acc[8] = {0.f, 0.f, 0.f, 0.f, 0.f, 0.f, 0.f, 0.f};
#pragma unroll 4
    for (int d = 0; d < 64; ++d) { const float wa = wba[(size_t)(h * 64 + d) * D + n];
#pragma unroll
        for (int j = 0; j < 8; ++j) acc[j] += wuv[(size_t)(r0 + j) * (AH * AHD) + h * 64 + d] * wa; }
    v4u w; w.x = pk2(acc[0], acc[1]); w.y = pk2(acc[2], acc[3]); w.z = pk2(acc[4], acc[5]); w.w = pk2(acc[6], acc[7]);
    *(GAS v4u*)(WT + (size_t)n * 1024 + h * 128 + r0) = w;
}
__device__ __forceinline__ int items_of(int K, int N) { return (K / 64) * ((N + 63) / 64); }

__device__ __forceinline__ void prep_layer_weights_body(const PC& F, int l) {
    struct { const float* const* in; } a{F.in};
    const int lane_ = lane_id_v();
    LAS float* scr = (LAS float*)(F.lds + RING_OFF + F.wave * 17408);
    const int gw = F.vcu * NWAVES + F.wave, NGW = F.G * NWAVES;
    const float* f1n = a.in[3] + (size_t)l * D; const float* f1in = a.in[4] + (size_t)l * D * 2 * DFF; const float* f1out = a.in[5] + (size_t)l * DFF * D;
    const float* mixn = a.in[6] + (size_t)l * D; const float* win = a.in[7] + (size_t)l * D * INW;
    const float* wba = a.in[15] + (size_t)l * AW * D; const float* wbb = a.in[16] + (size_t)l * PW_ * D; const float* wbc = a.in[17] + (size_t)l * CW * D;
    const float* wout = a.in[18] + (size_t)l * D * D;
    const float* f2n = a.in[19] + (size_t)l * D; const float* f2in = a.in[20] + (size_t)l * D * 2 * DFF; const float* f2out = a.in[21] + (size_t)l * DFF * D;
    unsigned char* ws = launder_p(F.ws);
    const float* wuk = a.in[9] + (size_t)l * KVR * AH * AHD; const float* wuv = a.in[10] + (size_t)l * KVR * AH * AHD;
    const int I0 = items_of(D, 2 * DFF), I1 = items_of(DFF, D), I2 = items_of(D, INW), I4 = items_of(PW_, D), I5 = items_of(CW, D), I6 = items_of(D, D);
    const int NIT = 2 * I0 + 2 * I1 + I2 + I4 + I5 + I6;
#pragma unroll 1
    for (int it = gw; it < NIT; it += NGW) {
        int r = it;
        if (r < I0) { transpose_item(f1in, D, 2 * DFF, f1n, (bf16*)(ws + WS_W1IN), scr, r, lane_, MapSwiglu{}); continue; } r -= I0;
        if (r < I0) { transpose_item(f2in, D, 2 * DFF, f2n, (bf16*)(ws + WS_W2IN), scr, r, lane_, MapSwiglu{}); continue; } r -= I0;
        if (r < I1) { transpose_item(f1out, DFF, D, nullptr, (bf16*)(ws + WS_W1OUT), scr, r, lane_, MapId{0}); continue; } r -= I1;
        if (r < I1) { transpose_item(f2out, DFF, D, nullptr, (bf16*)(ws + WS_W2OUT), scr, r, lane_, MapId{0}); continue; } r -= I1;
        if (r < I2) { transpose_item(win, D, INW, mixn, (bf16*)(ws + WS_WIN), scr, r, lane_, MapInProj{}); continue; } r -= I2;
        if (r < I4) { transpose_item(wbb, PW_, D, nullptr, (bf16*)(ws + WS_WB), scr, r, lane_, MapId{0}); continue; } r -= I4;
        if (r < I5) { transpose_item(wbc, CW, D, nullptr, (bf16*)(ws + WS_WC), scr, r, lane_, MapId{0}); continue; } r -= I5;
        transpose_item(wout, D, D, nullptr, (bf16*)(ws + WS_WOUT), scr, r, lane_, MapId{0});
    }
    { const float* wpool = a.in[11] + (size_t)l * 4 * 64 * 64; bf16* wpT = (bf16*)(ws + WS_WPT);
      for (int i = gw * 64 + lane_; i < 4 * 64 * 64; i += NGW * 64) { const int c = i & 63, d = (i >> 6) & 63, g = i >> 12; wpT[i] = (bf16)f2bf(wpool[(g * 64 + c) * 64 + d]); } }
    asm volatile("" ::: "memory");
#pragma unroll 1
    for (int it = gw; it < 2048; it += NGW) wafold_item(wuv, wba, (bf16*)(ws + WS_WA), it, lane_);
    asm volatile("" ::: "memory");
#pragma unroll 1
    for (int it = gw; it < 2048; it += NGW) qlat_item(win, mixn, wuk, (bf16*)(ws + WS_WIN), it, lane_);
}

__device__ __noinline__ void p0_prologue(const float* const* in_, float* out_, unsigned char* ws_, LAS unsigned char* lds_, int wave_, int vcu_, int G_) {
    const PC F{uni(in_), uni(out_), uni(ws_), uni_l(lds_), uni_i(wave_), uni_i(vcu_), uni_i(G_)}; struct { const float* const* in; } a{F.in};
    const int lane_ = lane_id_v();
    const int gw = F.vcu * NWAVES + F.wave, NGW = F.G * NWAVES;
    const float* x = a.in[0]; const float* mem = a.in[1];
    bf16* hb = (bf16*)(F.ws + WS_HB); float* ss = (float*)(F.ws + WS_SS); bf16* memn = (bf16*)(F.ws + WS_MEMN);
    for (int m = gw; m < M + MROWS; m += NGW) {
        const bool ismem = m >= M; const int r = ismem ? m - M : m;
        const GAS f32x4* xr = (const GAS f32x4*)((ismem ? mem : x) + (size_t)r * D) + lane_;
        f32x4 v[4]; float s = 0.f;
#pragma unroll
        for (int j = 0; j < 4; ++j) { v[j] = xr[64 * j]; s += (v[j].x * v[j].x + v[j].y * v[j].y) + (v[j].z * v[j].z + v[j].w * v[j].w); }
        s = wave_sum(s);
        float sc = 1.f;
        if (ismem) sc = 1.0f / sqrtf(s * (1.0f / D) + EPS);
        else if (lane_ < 4) ss[(size_t)r * 4 + lane_] = lane_ == 0 ? s : 0.f;
        GAS unsigned long long* o8 = (GAS unsigned long long*)((ismem ? memn : hb) + (size_t)r * D) + lane_;
#pragma unroll
        for (int j = 0; j < 4; ++j) o8[64 * j] = (unsigned long long)pk2(v[j].x * sc, v[j].y * sc) | ((unsigned long long)pk2(v[j].z * sc, v[j].w * sc) << 32);
    }
    LAS float* scr = (LAS float*)(F.lds + RING_OFF + F.wave * 17408);
    const int IM = items_of(D, 2 * CW);
    for (int it = gw; it < DEPTH * IM; it += NGW) { const int l = it / IM, r = it % IM;
        transpose_item(a.in[14] + (size_t)l * D * 2 * CW, D, 2 * CW, a.in[13] + (size_t)l * D, (bf16*)(F.ws + WS_WMEM), scr, r, lane_, MapId{l * 2 * CW}); }
    prep_layer_weights_body(F, 0);
}
__device__ __noinline__ void prep_layer_weights(const float* const* in_, float* out_, unsigned char* ws_, LAS unsigned char* lds_, int l, int wave_, int vcu_, int G_) {
    const PC F{uni(in_), uni(out_), uni(ws_), uni_l(lds_), uni_i(wave_), uni_i(vcu_), uni_i(G_)}; prep_layer_weights_body(F, uni_i(l));
}

__constant__ unsigned char T5_BUCKET[128] = {0, 1, 2, 3, 4, 5, 6, 7, 8, 9, 10, 11, 12, 13, 14, 15, 16, 16, 16, 17, 17, 18, 18, 18, 19, 19, 19, 20, 20, 20, 20, 21, 21, 21, 21, 22, 22, 22, 22, 22, 23, 23, 23, 23, 23, 23, 24, 24, 24, 24, 24, 24, 25, 25, 25, 25, 25, 25, 25, 26, 26, 26, 26, 26, 26, 26, 26, 27, 27, 27, 27, 27, 27, 27, 27, 27, 27, 28, 28, 28, 28, 28, 28, 28, 28, 28, 28, 29, 29, 29, 29, 29, 29, 29, 29, 29, 29, 29, 29, 30, 30, 30, 30, 30, 30, 30, 30, 30, 30, 30, 30, 30, 30, 31, 31, 31, 31, 31, 31, 31, 31, 31, 31, 31, 31, 31, 31, 31};

typedef short bf16x8_p __attribute__((ext_vector_type(8)));
__device__ __forceinline__ void prep_tokens(const float* const* in_, float* out_, unsigned char* ws_, LAS unsigned char* lds_, int l_, int wave_, int vcu_, int G_, int dry_) {
    const int dry = uni_i(dry_);
    const PC F{uni(in_), uni(out_), uni(ws_), uni_l(lds_), uni_i(wave_), uni_i(vcu_), uni_i(G_)}; struct { const float* const* in; } a{F.in}; const int l = uni_i(l_);
    unsigned char* ws = launder_p(F.ws);
    const float* ckvraw = (const float*)(ws + WS_CKVRAW); bf16* ckv = (bf16*)(ws + WS_CKV);
    const bf16* iqraw = (const bf16*)(ws + WS_IQRAW); bf16* iqf = (bf16*)(ws + WS_IQF); const float* iw = (const float*)(ws + WS_IW); unsigned* sgn = (unsigned*)(ws + WS_SGN);
    const bf16* z = (const bf16*)(ws + WS_Z); bf16* yb = (bf16*)(ws + WS_YB); bf16* qc = (bf16*)(ws + WS_QC);
    const bf16* memkv = (const bf16*)(ws + WS_MEMKV); const bf16* vT = (const bf16*)(ws + WS_VT); const bf16* wpT = (const bf16*)(ws + WS_WPT);
    const float* kvn = a.in[8] + (size_t)l * KVR; const float* pscale = a.in[12] + (size_t)l * PW_;
    const int lane = lane_id_v(), tid = F.wave * 64 + lane;
    const int tok = lane & 15, g4 = lane >> 4;
    LAS unsigned char* Ks = F.lds;
    LAS unsigned char* Vs = F.lds + 36864;
    for (int blk = F.vcu; blk < M / 128; blk += F.G) {
        const int rowb = blk * 128, b = rowb / SEQ, row0 = rowb + F.wave * 16;
#pragma unroll 1
        for (int tt = 0; tt < 16; ++tt) { const int row = row0 + tt;
            { const f32x2 v = *(const f32x2*)(ckvraw + (size_t)row * KVR + 2 * lane); const float q = wave_sum(v.x * v.x + v.y * v.y);
              const float rs = 1.0f / sqrtf(q * (1.0f / KVR) + EPS); const f32x2 g = *(const f32x2*)(kvn + 2 * lane);
              *(unsigned*)(ckv + (size_t)row * KVR + 2 * lane) = pk2(v.x * rs * g.x, v.y * rs * g.y); }
            { const float wv = iw[(size_t)row * IH + (lane >> 3)]; const float aw = fabsf(wv) * (1.0f / 16.0f);
              const v2u q = *(const v2u*)(iqraw + (size_t)row * 256 + 4 * lane);
              v2u o; o.x = pkh2(hlo(q.x) * aw, hhi(q.x) * aw); o.y = pkh2(hlo(q.y) * aw, hhi(q.y) * aw);
              *(v2u*)(iqf + (size_t)row * 256 + 4 * lane) = o;
              const unsigned long long bal = __ballot(wv < 0.f);
              unsigned mask = 0;
#pragma unroll
              for (int h = 0; h < 8; ++h) mask |= ((unsigned)(bal >> (8 * h)) & 1u) << h;
              if (lane == 0) sgn[row] = mask; } }
        { const int row = row0 + tok, spos = row % SEQ;
#pragma unroll 1
          for (int g = 0; g < 4; ++g) { const int w = 2 << g; const int cnt = (spos + 1) < w ? (spos + 1) : w; const float rc = 1.0f / (float)cnt;
              bf16x8_p pf[2];
#pragma unroll
              for (int ks = 0; ks < 2; ++ks) { const int c0 = g * 64 + 32 * ks + 8 * g4; float sum[8], z0[8];
#pragma unroll
                  for (int e = 0; e < 8; ++e) { sum[e] = 0.f; z0[e] = 0.f; }
                  for (int j = 0; j < w; ++j) { if (j < cnt) { const v4u v = *(const v4u*)(z + (size_t)(row - j) * 256 + c0);
                      const float f[8] = {bflo(v.x), bfhi(v.x), bflo(v.y), bfhi(v.y), bflo(v.z), bfhi(v.z), bflo(v.w), bfhi(v.w)};
#pragma unroll
                      for (int e = 0; e < 8; ++e) { sum[e] += f[e]; if (j == 0) z0[e] = f[e]; } } }
                  v4u pw; pw.x = pk2(sum[0] * rc - z0[0], sum[1] * rc - z0[1]); pw.y = pk2(sum[2] * rc - z0[2], sum[3] * rc - z0[3]); pw.z = pk2(sum[4] * rc - z0[4], sum[5] * rc - z0[5]); pw.w = pk2(sum[6] * rc - z0[6], sum[7] * rc - z0[7]);
                  pf[ks] = __builtin_bit_cast(bf16x8_p, pw); }
#pragma unroll
              for (int dt = 0; dt < 4; ++dt) { f32x4 acc = {0.f, 0.f, 0.f, 0.f};
#pragma unroll
                  for (int ks = 0; ks < 2; ++ks) { const bf16x8_p af = *(const bf16x8_p*)(wpT + (size_t)(g * 64 + 16 * dt + tok) * 64 + 32 * ks + 8 * g4); acc = __builtin_amdgcn_mfma_f32_16x16x32_bf16(af, pf[ks], acc, 0, 0, 0); }
                  const f32x4 ps = *(const f32x4*)(pscale + g * 64 + 16 * dt + 4 * g4);
                  v2u o; o.x = pk2(acc[0] * ps.x, acc[1] * ps.y); o.y = pk2(acc[2] * ps.z, acc[3] * ps.w);
                  *(v2u*)(yb + (size_t)row * 256 + g * 64 + 16 * dt + 4 * g4) = o; } } }
#pragma unroll 1
        for (int h = 0; h < CH; ++h) {
            __syncthreads();
#pragma unroll
            for (int e = 0; e < 4; ++e) { const int i = tid + 512 * e;
                { const int m = i >> 3, c = i & 7; const v4u v = *(const v4u*)(memkv + (size_t)(b * NMEM + m) * 2048 + l * 512 + h * 64 + c * 8); *(LAS v4u*)(Ks + m * 144 + c * 16) = v; }
                { const int d = i >> 5, c = i & 31; const v4u v = *(const v4u*)(vT + (size_t)(l * 512 + 256 + h * 64 + d) * MROWS + b * NMEM + c * 8); *(LAS v4u*)(Vs + d * 528 + c * 16) = v; } }
            LDS_WAIT(); __syncthreads();
            const int row = row0 + tok;
            bf16x8_p qf[2];
#pragma unroll
            for (int ks = 0; ks < 2; ++ks) qf[ks] = *(const bf16x8_p*)(qc + (size_t)row * 256 + h * 64 + 32 * ks + 8 * g4);
            f32x4 S[16]; float mx = -1e30f;
#pragma unroll
            for (int mt = 0; mt < 16; ++mt) { f32x4 acc = {0.f, 0.f, 0.f, 0.f};
#pragma unroll
                for (int ks = 0; ks < 2; ++ks) { const bf16x8_p kf = *(const LAS bf16x8_p*)(Ks + (16 * mt + tok) * 144 + (4 * ks + g4) * 16); acc = __builtin_amdgcn_mfma_f32_16x16x32_bf16(kf, qf[ks], acc, 0, 0, 0); }
                S[mt] = acc; mx = fmaxf(mx, fmaxf(fmaxf(acc[0], acc[1]), fmaxf(acc[2], acc[3]))); if ((mt & 3) == 3) __builtin_amdgcn_sched_barrier(0); }
            mx = fmaxf(mx, __shfl_xor(mx, 16)); mx = fmaxf(mx, __shfl_xor(mx, 32));
            float sm = 0.f;
#pragma unroll
            for (int mt = 0; mt < 16; ++mt)
#pragma unroll
                for (int r = 0; r < 4; ++r) { const float p = __expf((S[mt][r] - mx) * 0.125f); S[mt][r] = p; sm += p; }
            sm += __shfl_xor(sm, 16); sm += __shfl_xor(sm, 32);
            const float inv = 1.0f / sm;
            f32x4 oacc[4];
#pragma unroll
            for (int dt = 0; dt < 4; ++dt) oacc[dt] = (f32x4){0.f, 0.f, 0.f, 0.f};
#pragma unroll
            for (int kk = 0; kk < 8; ++kk) { v4u pw; pw.x = pg8::cvt_pk_bf16(S[2 * kk][0], S[2 * kk][1]); pw.y = pg8::cvt_pk_bf16(S[2 * kk][2], S[2 * kk][3]); pw.z = pg8::cvt_pk_bf16(S[2 * kk + 1][0], S[2 * kk + 1][1]); pw.w = pg8::cvt_pk_bf16(S[2 * kk + 1][2], S[2 * kk + 1][3]);
                const bf16x8_p pfr = __builtin_bit_cast(bf16x8_p, pw);
#pragma unroll
                for (int dt = 0; dt < 4; ++dt) { const LAS unsigned char* vp = Vs + (16 * dt + tok) * 528 + (32 * kk + 4 * g4) * 2;
                    const v2u lo = *(const LAS v2u*)vp, hi = *(const LAS v2u*)(vp + 32);
                    v4u vw; vw.x = lo.x; vw.y = lo.y; vw.z = hi.x; vw.w = hi.y;
                    oacc[dt] = __builtin_amdgcn_mfma_f32_16x16x32_bf16(__builtin_bit_cast(bf16x8_p, vw), pfr, oacc[dt], 0, 0, 0); }
                __builtin_amdgcn_sched_barrier(0); }
#pragma unroll
            for (int dt = 0; dt < 4; ++dt) { v2u o; o.x = pk2(oacc[dt][0] * inv, oacc[dt][1] * inv); o.y = pk2(oacc[dt][2] * inv, oacc[dt][3] * inv);
                if (!dry) *(v2u*)(qc + (size_t)row * 256 + h * 64 + 16 * dt + 4 * g4) = o; else asm volatile("" :: "v"(o.x), "v"(o.y)); }
        }
    }
    __syncthreads();
}

__device__ __forceinline__ unsigned key_of(float s) { const unsigned u = __builtin_bit_cast(unsigned, s); return (u & 0x80000000u) ? ~u : (u | 0x80000000u); }

typedef short bf16x8_t __attribute__((ext_vector_type(8)));
typedef short s16x4_t __attribute__((ext_vector_type(4)));
__device__ __forceinline__ void glds16(const void* gsrc, unsigned lds_dst) { unsigned keep;
    asm volatile("s_mov_b32 %0, m0\n\ts_mov_b32 m0, %2\n\ts_nop 0\n\tglobal_load_lds_dwordx4 %1, off\n\ts_mov_b32 m0, %0" : "=&s"(keep) : "v"(gsrc), "s"(lds_dst) : "memory"); }
typedef float f32x16 __attribute__((ext_vector_type(16)));
constexpr int SEL_CAP = 256;
constexpr int HSTR = 264;
constexpr int SL_HIST = 0, SL_SEL = 0, SL_CS = 32768, SL_CI = 98304, SL_KEYS = 131072, SL_ST = 147456;

#define SEL_DECLS \
    LAS unsigned char* const lds = uni_l(lds_); const int wave = uni_i(wave_), b = uni_i(b_), ub = uni_i(ub_); unsigned char* ws = uni(ws_); \
    const bf16* iqf = (const bf16*)(ws + WS_IQF); const unsigned* sgn = (const unsigned*)(ws + WS_SGN); const bf16* ik = (const bf16*)(ws + WS_IK); \
    const int lane = lane_id_v(), tid = wave * 64 + lane; const int kl = lane & 31, c5 = lane >> 5; \
    LAS unsigned* hist = (LAS unsigned*)(lds + SL_HIST); LAS unsigned short* lsel = (LAS unsigned short*)(lds + SL_SEL); LAS float* lcs = (LAS float*)(lds + SL_CS); \
    LAS unsigned short* lci = (LAS unsigned short*)(lds + SL_CI); LAS unsigned* st = (LAS unsigned*)(lds + SL_ST); LAS float* stf = (LAS float*)(lds + SL_ST); \
    const int t0 = ub * 64; const int q0 = b * SEQ + t0; const bf16* ikb = ik + (size_t)b * SEQ * IDIM; const int ntile = (t0 + 64 + 127) >> 7; \
    (void)hist; (void)lsel; (void)lcs; (void)lci; (void)stf; (void)tid;
#define SEL_LOAD_A \
    bf16x8_t af[2][2]; float sgc[2][16]; \
    { const int i = kl, a_ = i >> 3, cc_ = (i >> 2) & 1, e_ = i & 3; const int qq_ = 2 * cc_ + (a_ >> 1), hh_ = 4 * (a_ & 1) + e_; \
      _Pragma("unroll") for (int rt = 0; rt < 2; ++rt) { const unsigned flip_ = ((sgn[q0 + 8 * wave + 4 * rt + qq_] >> hh_) & 1u) ? 0x80008000u : 0u;     \
          _Pragma("unroll") for (int ks = 0; ks < 2; ++ks) { v4u w_ = *(const v4u*)(iqf + (size_t)(q0 + 8 * wave + 4 * rt + qq_) * 256 + hh_ * 32 + 16 * ks + 8 * c5); \
              w_.x ^= flip_; w_.y ^= flip_; w_.z ^= flip_; w_.w ^= flip_; af[rt][ks] = __builtin_bit_cast(bf16x8_t, w_); } } \
      _Pragma("unroll") for (int rt = 0; rt < 2; ++rt) _Pragma("unroll") for (int u = 0; u < 2; ++u) { const unsigned m_ = sgn[q0 + 8 * wave + 4 * rt + 2 * c5 + u]; \
          _Pragma("unroll") for (int h = 0; h < 8; ++h) sgc[rt][8 * u + h] = ((m_ >> h) & 1u) ? -__builtin_inff() : __builtin_inff(); } }
#define SEL_STAGE(kt_) do { const int key_ = 16 * wave + (lane >> 2); const int ch_ = (lane & 3) ^ ((key_ >> 2) & 3); \
    glds16(ikb + (size_t)(128 * (kt_) + key_) * IDIM + ch_ * 8, (unsigned)__builtin_amdgcn_readfirstlane((int)(unsigned)(size_t)(lds + SL_KEYS + ((kt_) & 1) * 8192 + wave * 1024))); } while (0)
#define SEL_MMA(acc_, rt_, kh_) do { acc_ = (f32x16){0.f,0.f,0.f,0.f,0.f,0.f,0.f,0.f,0.f,0.f,0.f,0.f,0.f,0.f,0.f,0.f}; \
    acc_ = __builtin_amdgcn_mfma_f32_32x32x16_f16(__builtin_bit_cast(f16x8_t, af[rt_][0]), __builtin_bit_cast(f16x8_t, bfr_[kh_][0]), acc_, 0, 0, 0); \
    acc_ = __builtin_amdgcn_mfma_f32_32x32x16_f16(__builtin_bit_cast(f16x8_t, af[rt_][1]), __builtin_bit_cast(f16x8_t, bfr_[kh_][1]), acc_, 0, 0, 0); } while (0)
#define SEL_SUM(acc_, rt_, kh_) do { _Pragma("unroll") for (int u = 0; u < 2; ++u) { float s_ = 0.f; \
    _Pragma("unroll") for (int h = 0; h < 8; ++h) s_ += __builtin_amdgcn_fmed3f(acc_[8 * u + h], 0.f, sgc[rt_][8 * u + h]); \
    sc[rt_][kh_][u] = s_; } } while (0)
#define SEL_SCORES(kt_) do { const LAS unsigned char* kb_ = lds + SL_KEYS + ((kt_) & 1) * 8192; bf16x8_t bfr_[4][2]; \
    _Pragma("unroll") for (int kh = 0; kh < 4; ++kh) { const int key_ = 32 * kh + kl; \
        bfr_[kh][0] = *(const LAS bf16x8_t*)(kb_ + key_ * 64 + 16 * ((0 + c5) ^ ((key_ >> 2) & 3))); \
        bfr_[kh][1] = *(const LAS bf16x8_t*)(kb_ + key_ * 64 + 16 * ((2 + c5) ^ ((key_ >> 2) & 3))); } \
    f32x16 accA_, accB_; \
    SEL_MMA(accA_, 0, 0); \
    SEL_MMA(accB_, 1, 0); __builtin_amdgcn_sched_barrier(0); SEL_SUM(accA_, 0, 0); __builtin_amdgcn_sched_barrier(0); \
    SEL_MMA(accA_, 0, 1); __builtin_amdgcn_sched_barrier(0); SEL_SUM(accB_, 1, 0); __builtin_amdgcn_sched_barrier(0); \
    SEL_MMA(accB_, 1, 1); __builtin_amdgcn_sched_barrier(0); SEL_SUM(accA_, 0, 1); __builtin_amdgcn_sched_barrier(0); \
    SEL_MMA(accA_, 0, 2); __builtin_amdgcn_sched_barrier(0); SEL_SUM(accB_, 1, 1); __builtin_amdgcn_sched_barrier(0); \
    SEL_MMA(accB_, 1, 2); __builtin_amdgcn_sched_barrier(0); SEL_SUM(accA_, 0, 2); __builtin_amdgcn_sched_barrier(0); \
    SEL_MMA(accA_, 0, 3); __builtin_amdgcn_sched_barrier(0); SEL_SUM(accB_, 1, 2); __builtin_amdgcn_sched_barrier(0); \
    SEL_MMA(accB_, 1, 3); __builtin_amdgcn_sched_barrier(0); SEL_SUM(accA_, 0, 3); __builtin_amdgcn_sched_barrier(0); \
    SEL_SUM(accB_, 1, 3); } while (0)
#define SEL_BOUNDARY(FINAL) do { \
    const int qq = tid >> 3, part = tid & 7; const LAS v4u* hp = (const LAS v4u*)(hist + qq * HSTR + 32 * part); \
    unsigned bins[32]; \
    _Pragma("unroll") for (int i = 0; i < 8; ++i) { const v4u v = hp[i]; bins[4 * i] = v.x; bins[4 * i + 1] = v.y; bins[4 * i + 2] = v.z; bins[4 * i + 3] = v.w; } \
    unsigned ps = 0; \
    _Pragma("unroll") for (int i = 0; i < 32; ++i) ps += bins[i]; \
    unsigned v = ps, tt; \
    tt = __shfl_down(v, 1, 8); if (part + 1 < 8) v += tt; \
    tt = __shfl_down(v, 2, 8); if (part + 2 < 8) v += tt; \
    tt = __shfl_down(v, 4, 8); if (part + 4 < 8) v += tt; \
    unsigned cacc = v - ps; \
    if (cacc < (unsigned)TOPK && v >= (unsigned)TOPK) { int bsel = 0; unsigned na = 0, cb = 0; bool found = false; \
        _Pragma("unroll") for (int i = 31; i >= 0; --i) { const bool hit = !found && (cacc + bins[i] >= (unsigned)TOPK); if (hit) { bsel = i; na = cacc; cb = bins[i]; found = true; } cacc += bins[i]; } \
        st[128 + qq] = (unsigned)(32 * part + bsel); if (FINAL) { st[192 + qq] = na; st[256 + qq] = cb; st[448 + qq] = cb > (unsigned)SEL_CAP ? 1u : 0u; } } } while (0)

__device__ __forceinline__ void sel_pass1(unsigned char* ws_, LAS unsigned char* lds_, int wave_, int b_, int ub_) {
    SEL_DECLS
    unsigned short* sel = (unsigned short*)(ws + WS_SEL);
    __syncthreads();
    if (ub < 4) {
        for (int i = tid; i < 64 * TOPK; i += NWAVES * 64) { const int qq = i >> 8, sl = i & 255; sel[(size_t)(q0 + qq) * TOPK + sl] = (unsigned short)(sl <= t0 + qq ? sl : 0); }
        if (tid == 0) st[512] = 1u;
        asm volatile("s_waitcnt vmcnt(0) lgkmcnt(0)" ::: "memory"); __syncthreads();
        return;
    }
    SEL_LOAD_A
    for (int i = tid; i < 64 * HSTR; i += NWAVES * 64) hist[i] = 0u;
    if (tid < 64) { st[128 + tid] = 0u; st[448 + tid] = 0u; }
    if (tid == 0) st[512] = 0u;
    float sc[2][4][2];
    float scl[2][2]; int bcur[2][2];
#pragma unroll
    for (int rt = 0; rt < 2; ++rt)
#pragma unroll
        for (int u = 0; u < 2; ++u) { scl[rt][u] = 0.f; bcur[rt][u] = 0; }
    SEL_STAGE(0);
#pragma unroll 1
    for (int kt = 0; kt < ntile; ++kt) {
        asm volatile("s_waitcnt vmcnt(0) lgkmcnt(0)" ::: "memory"); __syncthreads();
        if (kt > 0 && (kt & 3) == 0) {
            SEL_BOUNDARY(false);
            asm volatile("s_waitcnt lgkmcnt(0)" ::: "memory"); __syncthreads();
#pragma unroll
            for (int rt = 0; rt < 2; ++rt)
#pragma unroll
                for (int u = 0; u < 2; ++u) bcur[rt][u] = (int)st[128 + 8 * wave + 4 * rt + 2 * c5 + u];
        }
        if (kt + 1 < ntile) SEL_STAGE(kt + 1);
        SEL_SCORES(kt);
        if (kt == 0) {
#pragma unroll
            for (int rt = 0; rt < 2; ++rt)
#pragma unroll
                for (int u = 0; u < 2; ++u) { float mx = 0.f;
#pragma unroll
                    for (int kh = 0; kh < 4; ++kh) mx = fmaxf(mx, fabsf(sc[rt][kh][u]));
#pragma unroll
                    for (int o = 1; o < 32; o <<= 1) mx = fmaxf(mx, __shfl_xor(mx, o));
                    const float R = mx > 0.f ? mx : 1.0f;
                    scl[rt][u] = 128.0f / R;
                    if (kl == 0) stf[8 * wave + 4 * rt + 2 * c5 + u] = scl[rt][u]; }
        }
        const bool masked = 128 * kt + 127 > t0;
#pragma unroll
        for (int rt = 0; rt < 2; ++rt)
#pragma unroll
            for (int u = 0; u < 2; ++u) { const int qq = 8 * wave + 4 * rt + 2 * c5 + u; const int lim = masked ? (t0 + qq - 128 * kt - kl) : 1000;
#pragma unroll
                for (int kh = 0; kh < 4; ++kh) { const float fb = __builtin_amdgcn_fmed3f(fmaf(sc[rt][kh][u], scl[rt][u], 128.0f), 0.f, 255.f);
                    if (fb >= (float)bcur[rt][u] && 32 * kh <= lim) (void)__hip_atomic_fetch_add(hist + qq * HSTR + (int)fb, 1u, __ATOMIC_RELAXED, __HIP_MEMORY_SCOPE_WORKGROUP); } }
    }
    asm volatile("s_waitcnt vmcnt(0) lgkmcnt(0)" ::: "memory"); __syncthreads();
    SEL_BOUNDARY(true);
    if (tid < 64) { st[320 + tid] = 0u; st[384 + tid] = 0u; }
    asm volatile("s_waitcnt lgkmcnt(0)" ::: "memory"); __syncthreads();
}
__device__ __forceinline__ void sel_pass2(unsigned char* ws_, LAS unsigned char* lds_, int wave_, int b_, int ub_) {
    SEL_DECLS
    if (st[512] != 0u) return;
    if (tid < 64) { st[320 + tid] = 0u; st[384 + tid] = 0u; }
    SEL_LOAD_A
    float sc[2][4][2];
    float scl[2][2]; int bcur[2][2];
#pragma unroll
    for (int rt = 0; rt < 2; ++rt)
#pragma unroll
        for (int u = 0; u < 2; ++u) { const int qq = 8 * wave + 4 * rt + 2 * c5 + u; scl[rt][u] = stf[qq]; bcur[rt][u] = (int)st[128 + qq]; }
    SEL_STAGE(0);
#pragma unroll 1
    for (int kt = 0; kt < ntile; ++kt) {
        asm volatile("s_waitcnt vmcnt(0) lgkmcnt(0)" ::: "memory"); __syncthreads();
        if (kt + 1 < ntile) SEL_STAGE(kt + 1);
        SEL_SCORES(kt);
        const bool masked = 128 * kt + 127 > t0;
        unsigned okm = 0u, abm = 0u; unsigned basea[2][2], basec[2][2];
#pragma unroll
        for (int rt = 0; rt < 2; ++rt)
#pragma unroll
            for (int u = 0; u < 2; ++u) { const int qq = 8 * wave + 4 * rt + 2 * c5 + u; const int lim = masked ? (t0 + qq - 128 * kt - kl) : 1000; unsigned na_ = 0u, nc_ = 0u;
#pragma unroll
                for (int kh = 0; kh < 4; ++kh) { const float fb = __builtin_amdgcn_fmed3f(fmaf(sc[rt][kh][u], scl[rt][u], 128.0f), 0.f, 255.f);
                    const bool ok = fb >= (float)bcur[rt][u] && 32 * kh <= lim; const bool ab = fb >= (float)(bcur[rt][u] + 1);
                    if (ok) { okm |= 1u << (rt * 8 + u * 4 + kh); if (ab) { abm |= 1u << (rt * 8 + u * 4 + kh); ++na_; } else ++nc_; } }
                basea[rt][u] = 0u; basec[rt][u] = 0u;
                if (na_) basea[rt][u] = __hip_atomic_fetch_add(st + 320 + qq, na_, __ATOMIC_RELAXED, __HIP_MEMORY_SCOPE_WORKGROUP);
                if (nc_) basec[rt][u] = __hip_atomic_fetch_add(st + 384 + qq, nc_, __ATOMIC_RELAXED, __HIP_MEMORY_SCOPE_WORKGROUP); }
        if (okm != 0u) {
#pragma unroll
            for (int rt = 0; rt < 2; ++rt)
#pragma unroll
                for (int u = 0; u < 2; ++u) { const int qq = 8 * wave + 4 * rt + 2 * c5 + u; unsigned sa = basea[rt][u], scn = basec[rt][u];
#pragma unroll
                    for (int kh = 0; kh < 4; ++kh) { const int bit = rt * 8 + u * 4 + kh; const int kpos = 128 * kt + 32 * kh + kl;
                        if ((okm >> bit) & 1u) {
                            if ((abm >> bit) & 1u) { if (sa < (unsigned)TOPK) lsel[qq * 256 + sa] = (unsigned short)kpos; ++sa; }
                            else { if (scn < (unsigned)SEL_CAP) { lcs[qq * SEL_CAP + scn] = sc[rt][kh][u]; lci[qq * SEL_CAP + scn] = (unsigned short)kpos; } ++scn; } } } }
        }
    }
    asm volatile("s_waitcnt vmcnt(0) lgkmcnt(0)" ::: "memory"); __syncthreads();
}
__device__ __forceinline__ void sel_resolve(unsigned char* ws_, LAS unsigned char* lds_, int wave_, int b_, int ub_, int wg_, int first_) {
    SEL_DECLS
    const int wg = uni_i(wg_), first = uni_i(first_);
    unsigned short* sel = (unsigned short*)(ws + WS_SEL);
    gu32* slowl = (gu32*)(ws + WS_CTL + 65536) + (size_t)wg * 132;
    if (first && tid == 0) __hip_atomic_store(slowl, 0u, RLX_AGENT);
    if (st[512] != 0u) return;
#pragma unroll 1
    for (int qi = 0; qi < 8; ++qi) { const int qq = 8 * wave + qi; const int q = q0 + qq;
        const int na = (int)st[192 + qq], need = TOPK - na; int C = (int)st[384 + qq]; C = C < SEL_CAP ? C : SEL_CAP;
        const bool slow = st[448 + qq] != 0u;
        if (!slow) {
            LAS unsigned* sh = (LAS unsigned*)(lds + SL_KEYS + wave * 2048); LAS float* sls = (LAS float*)(lds + SL_KEYS + wave * 2048 + 256); LAS unsigned short* sli = (LAS unsigned short*)(lds + SL_KEYS + wave * 2048 + 1280);
            const float sclq = stf[qq]; const float fbase = (float)(int)st[128 + qq];
            sh[lane] = 0u;
            float cs[SEL_CAP / 64]; int ci[SEL_CAP / 64], sb[SEL_CAP / 64];
#pragma unroll
            for (int e = 0; e < SEL_CAP / 64; ++e) { const int i = lane + 64 * e; cs[e] = 0.f; ci[e] = 0; sb[e] = -1;
                if (i < C) { cs[e] = lcs[qq * SEL_CAP + i]; ci[e] = lci[qq * SEL_CAP + i];
                    const float fr_ = (fmaf(cs[e], sclq, 128.0f) - fbase) * 64.0f; sb[e] = (int)__builtin_amdgcn_fmed3f(fr_, 0.f, 63.f); } }
            LDS_WAIT();
#pragma unroll
            for (int e = 0; e < SEL_CAP / 64; ++e) if (sb[e] >= 0) (void)__hip_atomic_fetch_add(sh + sb[e], 1u, __ATOMIC_RELAXED, __HIP_MEMORY_SCOPE_WORKGROUP);
            LDS_WAIT();
            const unsigned cl = sh[lane];
            unsigned v = cl, tt;
            tt = __shfl_down(v, 1); if (lane + 1 < 64) v += tt;
            tt = __shfl_down(v, 2); if (lane + 2 < 64) v += tt;
            tt = __shfl_down(v, 4); if (lane + 4 < 64) v += tt;
            tt = __shfl_down(v, 8); if (lane + 8 < 64) v += tt;
            tt = __shfl_down(v, 16); if (lane + 16 < 64) v += tt;
            tt = __shfl_down(v, 32); if (lane + 32 < 64) v += tt;
            const unsigned ab_ = v - cl;
            const unsigned long long cross = __ballot(ab_ < (unsigned)need && v >= (unsigned)need);
            const int sstar = cross ? (int)__builtin_ctzll(cross) : 0;
            const int na2 = (int)__shfl(ab_, sstar);
            const int need2 = need - na2;
            int base = na; int nsub = 0;
#pragma unroll
            for (int e = 0; e < SEL_CAP / 64; ++e) { const bool up = sb[e] > sstar; const bool eq = sb[e] == sstar;
                const unsigned long long bu = __ballot(up), be = __ballot(eq);
                const unsigned long long lt = (lane == 0) ? 0ull : (~0ull >> (64 - lane));
                if (up) lsel[qq * 256 + base + (int)__builtin_popcountll(bu & lt)] = (unsigned short)ci[e];
                if (eq) { const int p_ = nsub + (int)__builtin_popcountll(be & lt); sls[p_] = cs[e]; sli[p_] = (unsigned short)ci[e]; }
                base += (int)__builtin_popcountll(bu); nsub += (int)__builtin_popcountll(be); }
            LDS_WAIT();
#pragma unroll 1
            for (int i0 = 0; i0 < nsub; i0 += 64) { const int i = i0 + lane;
                if (i < nsub) { const float si = sls[i]; const int ii = sli[i]; int rank = 0;
                    for (int jx = 0; jx < nsub; ++jx) { const float sj = sls[jx]; const int ij = sli[jx]; rank += (sj > si || (sj == si && ij < ii)) ? 1 : 0; }
                    if (rank < need2) lsel[qq * 256 + na + na2 + rank] = (unsigned short)ii; } }
            LDS_WAIT();
            *(v2u*)(sel + (size_t)q * TOPK + 4 * lane) = *(const LAS v2u*)(lsel + qq * 256 + 4 * lane);
        }
    }
    __syncthreads();
    if (tid == 0) { unsigned n = first ? 0u : __hip_atomic_load(slowl, RLX_AGENT);
        for (int qq = 0; qq < 64; ++qq) if (st[448 + qq] != 0u) { if (n < 128u) { __hip_atomic_store(slowl + 1 + n, (unsigned)(q0 + qq), RLX_AGENT); ++n; } }
        __hip_atomic_store(slowl, n, RLX_AGENT); }
    asm volatile("s_waitcnt vmcnt(0)" ::: "memory");
    __syncthreads();
}
#undef SEL_DECLS
#undef SEL_LOAD_A
#undef SEL_STAGE
#undef SEL_SCORES
#undef SEL_MMA
#undef SEL_SUM
#undef SEL_BOUNDARY
__device__ __forceinline__ void dsa_select_slow(unsigned char* ws_, LAS unsigned char* lds_, int wave_, int wg_) {
    LAS unsigned char* const lds = uni_l(lds_); const int wave = uni_i(wave_), wg = uni_i(wg_);
    unsigned char* ws = uni(ws_);
    const bf16* iqf = (const bf16*)(ws + WS_IQF); const unsigned* sgn = (const unsigned*)(ws + WS_SGN); const bf16* ik = (const bf16*)(ws + WS_IK);
    unsigned short* sel = (unsigned short*)(ws + WS_SEL);
    gu32* slowl = (gu32*)(ws + WS_CTL + 65536) + (size_t)wg * 132;
    const int lane = lane_id_v(), tid = wave * 64 + lane; const int kl = lane & 31, c5 = lane >> 5;
    LAS unsigned* keys = (LAS unsigned*)lds;
    LAS unsigned* hist = (LAS unsigned*)(lds + 32768);
    LAS unsigned* ctl = (LAS unsigned*)(lds + 40960);
    const int nq = (int)__builtin_amdgcn_readfirstlane(__hip_atomic_load(slowl, RLX_AGENT));
#pragma unroll 1
    for (int k = 0; k < nq; ++k) {
        const int q = (int)__builtin_amdgcn_readfirstlane(__hip_atomic_load(slowl + 1 + k, RLX_AGENT));
        const int b = q / SEQ, t = q % SEQ, n = t + 1;
        const bf16* ikb = ik + (size_t)b * SEQ * IDIM;
        __syncthreads();
        bf16x8_t af[2]; float sgc[8];
        { const int i = kl, a_ = i >> 3, e_ = i & 3; const int hh_ = 4 * (a_ & 1) + e_; const unsigned m_ = sgn[q];
          const unsigned flip_ = ((m_ >> hh_) & 1u) ? 0x80008000u : 0u;
#pragma unroll
          for (int ks = 0; ks < 2; ++ks) { v4u w_ = *(const v4u*)(iqf + (size_t)q * 256 + hh_ * 32 + 16 * ks + 8 * c5); w_.x ^= flip_; w_.y ^= flip_; w_.z ^= flip_; w_.w ^= flip_; af[ks] = __builtin_bit_cast(bf16x8_t, w_); }
#pragma unroll
          for (int h = 0; h < 8; ++h) sgc[h] = ((m_ >> h) & 1u) ? -__builtin_inff() : __builtin_inff(); }
#pragma unroll 1
        for (int kb = wave; kb * 32 < n; kb += NWAVES) { const int key = 32 * kb + kl;
            const bf16x8_t b0 = *(const bf16x8_t*)(ikb + (size_t)key * IDIM + 8 * c5), b1 = *(const bf16x8_t*)(ikb + (size_t)key * IDIM + 16 + 8 * c5);
            f32x16 acc = {0.f,0.f,0.f,0.f,0.f,0.f,0.f,0.f,0.f,0.f,0.f,0.f,0.f,0.f,0.f,0.f};
            acc = __builtin_amdgcn_mfma_f32_32x32x16_f16(__builtin_bit_cast(f16x8_t, af[0]), __builtin_bit_cast(f16x8_t, b0), acc, 0, 0, 0); acc = __builtin_amdgcn_mfma_f32_32x32x16_f16(__builtin_bit_cast(f16x8_t, af[1]), __builtin_bit_cast(f16x8_t, b1), acc, 0, 0, 0);
            float sc = 0.f;
#pragma unroll
            for (int h = 0; h < 8; ++h) sc += __builtin_amdgcn_fmed3f(acc[h], 0.f, sgc[h]);
            if (c5 == 0) keys[key] = key_of(sc); }
        if (tid == 0) { const unsigned z_ = (unsigned)launder_v(0); ctl[0] = z_; ctl[1] = z_ + (unsigned)TOPK; ctl[2] = z_; ctl[3] = z_; }
        unsigned P = 0u, Plo = 0u;
#pragma unroll 1
        for (int lev = 0; lev < 5; ++lev) {
            for (int i = tid; i < 2048; i += NWAVES * 64) hist[i] = 0u;
            asm volatile("s_waitcnt lgkmcnt(0)" ::: "memory"); __syncthreads();
#pragma unroll 1
            for (int i = 0; i < 16; ++i) { const int s_ = tid * 16 + i;
                if (s_ < n) { const unsigned hi = keys[s_], lo = 8191u - (unsigned)s_; bool mt; unsigned dg;
                    if (lev == 0) { mt = true; dg = hi >> 21; } else if (lev == 1) { mt = (hi >> 21) == P; dg = (hi >> 10) & 0x7ffu; } else if (lev == 2) { mt = (hi >> 10) == P; dg = hi & 0x3ffu; }
                    else if (lev == 3) { mt = hi == P; dg = lo >> 6; } else { mt = hi == P && (lo >> 6) == Plo; dg = lo & 63u; }
                    if (mt) (void)__hip_atomic_fetch_add(hist + dg, 1u, __ATOMIC_RELAXED, __HIP_MEMORY_SCOPE_WORKGROUP); } }
            asm volatile("s_waitcnt lgkmcnt(0)" ::: "memory"); __syncthreads();
            const unsigned need = ctl[1];
            const v4u hb = *(const LAS v4u*)(hist + 4 * tid); const unsigned ls = hb.x + hb.y + hb.z + hb.w;
            unsigned v = ls, tt;
            tt = __shfl_down(v, 1); if (lane + 1 < 64) v += tt;
            tt = __shfl_down(v, 2); if (lane + 2 < 64) v += tt;
            tt = __shfl_down(v, 4); if (lane + 4 < 64) v += tt;
            tt = __shfl_down(v, 8); if (lane + 8 < 64) v += tt;
            tt = __shfl_down(v, 16); if (lane + 16 < 64) v += tt;
            tt = __shfl_down(v, 32); if (lane + 32 < 64) v += tt;
            if (lane == 0) ctl[8 + wave] = v;
            asm volatile("s_waitcnt lgkmcnt(0)" ::: "memory"); __syncthreads();
            unsigned above = v - ls;
            for (int w2 = wave + 1; w2 < NWAVES; ++w2) above += ctl[8 + w2];
            if (above < need && above + ls >= need) { unsigned c = above; const unsigned bb[4] = {hb.x, hb.y, hb.z, hb.w}; int bsel = 0; unsigned cab = 0; bool found = false;
#pragma unroll
                for (int i = 3; i >= 0; --i) { const bool hit = !found && (c + bb[i] >= need); if (hit) { bsel = i; cab = c; found = true; } c += bb[i]; }
                const unsigned dv = (unsigned)(4 * tid + bsel);
                if (lev == 0) ctl[0] = dv; else if (lev == 1) ctl[0] = (P << 11) | dv; else if (lev == 2) ctl[0] = (P << 10) | dv; else if (lev == 3) ctl[3] = dv; else ctl[3] = (Plo << 6) | dv;
                ctl[1] = need - cab; }
            asm volatile("s_waitcnt lgkmcnt(0)" ::: "memory"); __syncthreads();
            P = ctl[0]; Plo = ctl[3];
        }
        unsigned short* srow = sel + (size_t)q * TOPK;
        unsigned mymask = 0u;
#pragma unroll 1
        for (int i = 0; i < 16; ++i) { const int s_ = tid * 16 + i;
            if (s_ < n) { const unsigned hi = keys[s_], lo = 8191u - (unsigned)s_; if (hi > P || (hi == P && lo >= Plo)) mymask |= 1u << i; } }
        const unsigned mycnt = (unsigned)__builtin_popcount(mymask);
        unsigned pv_ = mycnt, tt_;
        tt_ = __shfl_up(pv_, 1); if (lane >= 1) pv_ += tt_;
        tt_ = __shfl_up(pv_, 2); if (lane >= 2) pv_ += tt_;
        tt_ = __shfl_up(pv_, 4); if (lane >= 4) pv_ += tt_;
        tt_ = __shfl_up(pv_, 8); if (lane >= 8) pv_ += tt_;
        tt_ = __shfl_up(pv_, 16); if (lane >= 16) pv_ += tt_;
        tt_ = __shfl_up(pv_, 32); if (lane >= 32) pv_ += tt_;
        if (lane == 63) ctl[16 + wave] = pv_;
        asm volatile("s_waitcnt lgkmcnt(0)" ::: "memory"); __syncthreads();
        unsigned slot0 = pv_ - mycnt;
        for (int w2 = 0; w2 < wave; ++w2) slot0 += ctl[16 + w2];
#pragma unroll 1
        for (int i = 0; i < 16; ++i) if ((mymask >> i) & 1u) { if (slot0 < (unsigned)TOPK) srow[slot0] = (unsigned short)(tid * 16 + i); ++slot0; }
    }
    asm volatile("s_waitcnt vmcnt(0) lgkmcnt(0)" ::: "memory");
    __syncthreads();
}

__device__ __forceinline__ unsigned offb(unsigned row, unsigned ch) { return 256u * row + 16u * (ch ^ (((row & 3u) << 2) | ((row >> 2) & 3u))); }
__device__ __forceinline__ s16x4_t vtr(const LAS unsigned char* p) { return __builtin_bit_cast(s16x4_t, __builtin_amdgcn_ds_read_tr16_b64_v4i16((LAS s16x4_t*)p)); }

__device__ __noinline__ void dsa_attend(unsigned char* ws_, LAS unsigned char* lds_, const float* relb_, int wave_, int vcu_, int G_, int dry_) {
    const int dry = uni_i(dry_);
    LAS unsigned char* const lds = uni_l(lds_); const int wave = uni_i(wave_), vcu = uni_i(vcu_), G = uni_i(G_);
    unsigned char* ws = uni(ws_); const float* relb = uni(relb_);
    const bf16* ckv = (const bf16*)(ws + WS_CKV); bf16* ql = (bf16*)(ws + WS_QL); const unsigned short* sel = (const unsigned short*)(ws + WS_SEL);
    const int lane = lane_id_v(), tid = wave * 64 + lane;
    LAS unsigned char* cb = lds + wave * 16384;
    LAS unsigned short* sidx = (LAS unsigned short*)(lds + 131072 + wave * 512);
    LAS float* biasd = (LAS float*)(lds + 135168);
    for (int i = tid; i < 129 * 8; i += NWAVES * 64) { const int d = i >> 3, h = i & 7; const int bk = d < 128 ? (int)T5_BUCKET[d] : 31; biasd[i] = relb[bk * 8 + h]; }
    __syncthreads();
    const int hl = lane & 15, g = lane >> 4, hq = hl & 7;
    for (int p = vcu; p < BATCH * 64; p += G) {
        const int b = p >> 6, j = p & 63;
#pragma unroll 1
        for (int half = 0; half < 2; ++half) {
            const int ub = half == 0 ? j : 127 - j;
#pragma unroll 1
            for (int qi = 0; qi < 8; ++qi) {
                const int t = ub * 64 + wave * 8 + qi; const int q = b * SEQ + t; const int nsel = (t + 1) < TOPK ? (t + 1) : TOPK;
                const bf16* ckvb = ckv + (size_t)b * SEQ * KVR; bf16* qlrow = ql + (size_t)q * 1024;
                { const v2u w = *(const v2u*)(sel + (size_t)q * TOPK + 4 * lane); *(LAS v2u*)(sidx + 4 * lane) = w; }
                bf16x8_t qf[4];
#pragma unroll
                for (int s = 0; s < 4; ++s) qf[s] = *(const bf16x8_t*)(qlrow + hq * 128 + 32 * s + 8 * g);
                LDS_WAIT();
                float mrun = -1e30f, lsum = 0.f;
                f32x4 O[8];
#pragma unroll
                for (int c = 0; c < 8; ++c) O[c] = (f32x4){0.f, 0.f, 0.f, 0.f};
#define DSA_GATHER(c_) do { LAS unsigned char* dst_ = cb + ((c_) & 1) * 8192; \
                    _Pragma("unroll") for (int k_ = 0; k_ < 8; ++k_) { const int row_ = 4 * k_ + g; const int kidx_ = sidx[32 * (c_) + row_]; \
                        const int ch_ = hl ^ ((g << 2) | (k_ & 3)); \
                        glds16(ckvb + (size_t)kidx_ * KVR + ch_ * 8, (unsigned)__builtin_amdgcn_readfirstlane((int)(unsigned)(size_t)(dst_ + k_ * 1024))); } } while (0)
                DSA_GATHER(0);
#pragma unroll 1
                for (int c = 0; c < 8; ++c) {
                    if (c < 7) { DSA_GATHER(c + 1); asm volatile("s_waitcnt vmcnt(8)" ::: "memory"); }
                    else asm volatile("s_waitcnt vmcnt(0)" ::: "memory");
                    const LAS unsigned char* img = cb + (c & 1) * 8192;
                    f32x4 S[2];
#pragma unroll
                    for (int rb = 0; rb < 2; ++rb) { S[rb] = (f32x4){0.f, 0.f, 0.f, 0.f}; const unsigned row = 8u * (hl >> 2) + 4u * rb + (hl & 3);
#pragma unroll
                        for (int s = 0; s < 4; ++s) { const bf16x8_t af = *(const LAS bf16x8_t*)(img + offb(row, 4 * s + g)); S[rb] = __builtin_amdgcn_mfma_f32_16x16x32_bf16(af, qf[s], S[rb], 0, 0, 0); } }
                    float pv[2][4]; float mx = -1e30f;
#pragma unroll
                    for (int rb = 0; rb < 2; ++rb) { const v2u iw2 = *(const LAS v2u*)(sidx + 32 * c + 8 * g + 4 * rb);
                        const int ki[4] = {(int)(iw2.x & 0xffffu), (int)(iw2.x >> 16), (int)(iw2.y & 0xffffu), (int)(iw2.y >> 16)};
#pragma unroll
                        for (int r = 0; r < 4; ++r) { int dist = t - ki[r]; dist = dist < 0 ? 0 : (dist > 128 ? 128 : dist);
                            float lg = S[rb][r] * 0.125f + biasd[dist * 8 + hq];
                            if (32 * c + 8 * g + 4 * rb + r >= nsel) lg = -1e30f;
                            pv[rb][r] = lg; mx = fmaxf(mx, lg); } }
                    mx = fmaxf(mx, __shfl_xor(mx, 16)); mx = fmaxf(mx, __shfl_xor(mx, 32));
                    const float mnew = fmaxf(mrun, mx); const float alpha = __expf(mrun - mnew); mrun = mnew;
                    float rs = 0.f;
#pragma unroll
                    for (int rb = 0; rb < 2; ++rb)
#pragma unroll
                        for (int r = 0; r < 4; ++r) { pv[rb][r] = __expf(pv[rb][r] - mnew); rs += pv[rb][r]; }
                    rs += __shfl_xor(rs, 16); rs += __shfl_xor(rs, 32);
                    lsum = lsum * alpha + rs;
                    v4u pw; pw.x = pg8::cvt_pk_bf16(pv[0][0], pv[0][1]); pw.y = pg8::cvt_pk_bf16(pv[0][2], pv[0][3]); pw.z = pg8::cvt_pk_bf16(pv[1][0], pv[1][1]); pw.w = pg8::cvt_pk_bf16(pv[1][2], pv[1][3]);
                    const bf16x8_t pf = __builtin_bit_cast(bf16x8_t, pw);
                    float al[4];
#pragma unroll
                    for (int r = 0; r < 4; ++r) al[r] = __shfl(alpha, 4 * g + r);
#pragma unroll
                    for (int cd = 0; cd < 8; ++cd) {
                        f32x4 o = O[cd]; o[0] *= al[0]; o[1] *= al[1]; o[2] *= al[2]; o[3] *= al[3];
                        const unsigned q4 = hl >> 2, p4 = hl & 3;
                        const s16x4_t b0 = vtr(img + offb(8u * g + q4, 2 * cd + (p4 >> 1)) + 8u * (p4 & 1));
                        const s16x4_t b1 = vtr(img + offb(8u * g + 4u + q4, 2 * cd + (p4 >> 1)) + 8u * (p4 & 1));
                        bf16x8_t bf; bf[0] = b0[0]; bf[1] = b0[1]; bf[2] = b0[2]; bf[3] = b0[3]; bf[4] = b1[0]; bf[5] = b1[1]; bf[6] = b1[2]; bf[7] = b1[3];
                        O[cd] = __builtin_amdgcn_mfma_f32_16x16x32_bf16(pf, bf, o, 0, 0, 0);
                    }
                }
#undef DSA_GATHER
                const float linv = 1.0f / lsum; float li[4];
#pragma unroll
                for (int r = 0; r < 4; ++r) li[r] = __shfl(linv, 4 * g + r);
                LAS unsigned short* ost = (LAS unsigned short*)cb;
                if (g < 2) {
#pragma unroll
                    for (int cd = 0; cd < 8; ++cd)
#pragma unroll
                        for (int r = 0; r < 4; ++r) ost[(4 * g + r) * 128 + 16 * cd + hl] = (unsigned short)f2bf(O[cd][r] * li[r]);
                }
                LDS_WAIT();
                { const v4u w0 = *(const LAS v4u*)(cb + 32 * lane), w1 = *(const LAS v4u*)(cb + 32 * lane + 16);
                  if (!dry) { *(v4u*)(qlrow + 16 * lane) = w0; *(v4u*)(qlrow + 16 * lane + 8) = w1; } else asm volatile("" :: "v"(w0), "v"(w1)); }
                LDS_WAIT();
            }
        }
    }
    __syncthreads();
}

__device__ __noinline__ void final_norm(const float* const* in_, float* out_, unsigned char* ws_, LAS unsigned char* lds_, int wave_, int vcu_, int G_) {
    const PC F{uni(in_), uni(out_), uni(ws_), uni_l(lds_), uni_i(wave_), uni_i(vcu_), uni_i(G_)}; struct { const float* const* in; float* out; } a{F.in, F.out};
    const int lane_ = lane_id_v(); const int gw = F.vcu * NWAVES + F.wave, NGW = F.G * NWAVES; const float* g = a.in[22];
    f32x4 gv[4];
#pragma unroll
    for (int j = 0; j < 4; ++j) gv[j] = ((const f32x4*)g)[lane_ + 64 * j];
    for (int m = gw; m < M; m += NGW) {
        GAS f32x4* xr = (GAS f32x4*)(a.out + (size_t)m * D) + lane_;
        f32x4 v[4]; float s = 0.f;
#pragma unroll
        for (int j = 0; j < 4; ++j) { v[j] = xr[64 * j]; s += (v[j].x * v[j].x + v[j].y * v[j].y) + (v[j].z * v[j].z + v[j].w * v[j].w); }
        const float rs = 1.0f / sqrtf(wave_sum(s) * (1.0f / D) + EPS);
#pragma unroll
        for (int j = 0; j < 4; ++j) xr[64 * j] = v[j] * rs * gv[j];
    }
}

#define KIN ((const float* const*)__builtin_amdgcn_kernarg_segment_ptr())
constexpr int PH_PER_LAYER = 10, PH_LAYER0 = 2, N_PHASES = PH_LAYER0 + PH_PER_LAYER * DEPTH + 1;

__global__ void __launch_bounds__(NWAVES * 64, 2) mk_fwd(Args args) {
    extern __shared__ __attribute__((aligned(16))) unsigned char lds[];
    Frame F;
    F.lds = (LAS unsigned char*)lds;
    F.MISC = (volatile LAS unsigned*)(F.lds + MISC_OFF);
    F.wave = __builtin_amdgcn_readfirstlane((int)threadIdx.x >> 6);
    F.G = gridDim.x; { const int bx = blockIdx.x; F.vcu = (F.G % 8 == 0) ? (bx % 8) * (F.G / 8) + bx / 8 : bx; }
    F.ws = args.ws; F.ctl = (gu32*)(args.ws + WS_CTL);
    if (threadIdx.x < 64) ((LAS unsigned*)(F.lds + MISC_OFF))[threadIdx.x] = 0u;
    __syncthreads();
    const int lo = args.ph_lo, hi = args.ph_hi;
    const bool multi = (hi - lo) > 1;
    XcdBarrier bar; bar.bar = (unsigned*)(F.ctl + CW_BAR); bar.x = 0; bar.st = nullptr; bar.wave = F.wave;
    if (multi) bar = xcd_barrier_post((unsigned*)(F.ctl + CW_BAR), F.MISC + 8, F.wave);
#define IN(k) (lo <= (k) && (k) < hi)
#define SEAM(k) do { if (IN(k) && IN((k) + 1)) { xcd_barrier(bar); if (PROBE_PHASE == 99) xcd_barrier(bar); } } while (0)

    if (IN(0)) {
#if EN_P0
 for (int rep = (PROBE_PHASE == 1 ? 0 : 1); rep < 2; ++rep) p0_prologue(KIN, args.out, args.ws, F.lds, F.wave, F.vcu, F.G);
#endif
 } SEAM(0);
    if (IN(1)) {
#if !((DIS_MASK >> 7) & 1)
 unsigned char* ws = launder_p(args.ws); bf16* hb = (bf16*)(ws + WS_HB); float* ss = (float*)(ws + WS_SS); (void)hb; (void)ss;
        pg8::Gemm g{(const bf16_t*)(ws + WS_MEMN), (const bf16_t*)(ws + WS_WMEM), MROWS, DEPTH * 2 * CW, D}; pg8::StaticOrder S; S.init(MROWS, DEPTH * 2 * CW, F.G, launder_s((int)blockIdx.x));
        EpiPlainBf16 E{(bf16_t*)(ws + WS_MEMKV), DEPTH * 2 * CW};
        pg8::gemm_phase<EpiPlainBf16, pg8::StaticOrder, true, true>(F.lds + RING_OFF, g, S, E, F.wave);
        { pg8::Gemm g2{(const bf16_t*)(ws + WS_WMEM), (const bf16_t*)(ws + WS_MEMN), DEPTH * 2 * CW, MROWS, D}; pg8::StaticOrder S2; S2.init(DEPTH * 2 * CW, MROWS, F.G, launder_s((int)blockIdx.x));
          EpiPlainBf16 E2{(bf16_t*)(ws + WS_VT), MROWS};
          pg8::gemm_phase<EpiPlainBf16, pg8::StaticOrder, true, true>(F.lds + RING_OFF, g2, S2, E2, F.wave); }
#endif
    } SEAM(1);

    for (int l = 0; l < DEPTH; ++l) {
        const int pb = PH_LAYER0 + PH_PER_LAYER * l;
        const float* hbase = (l == 0) ? args.in[0] : args.out;
        if (IN(pb + 0)) {
#if EN_P0
 if (l > 0) for (int rep = (PROBE_PHASE == 1 ? 0 : 1); rep < 2; ++rep) prep_layer_weights(KIN, args.out, args.ws, F.lds, l, F.wave, F.vcu, F.G);
#endif
 } SEAM(pb + 0);
        if (IN(pb + 1)) {
#if !((DIS_MASK >> 0) & 1)
 unsigned char* ws = launder_p(args.ws); bf16* hb = (bf16*)(ws + WS_HB); float* ss = (float*)(ws + WS_SS); (void)hb; (void)ss;
            pg8::Gemm g{hb, (const bf16_t*)(ws + WS_W1IN), M, 2 * DFF, D}; pg8::StaticOrder S; S.init(M, 2 * DFF, F.G, launder_s((int)blockIdx.x));
            EpiSwiglu E{(bf16_t*)(ws + WS_ACT), ss};
            for (int rep = (PROBE_PHASE == 2 ? 0 : 1); rep < 2; ++rep) pg8::gemm_phase<EpiSwiglu, pg8::StaticOrder, true, true>(F.lds + RING_OFF, g, S, E, F.wave);
#endif
        } SEAM(pb + 1);
        if (IN(pb + 2)) {
#if !((DIS_MASK >> 1) & 1)
 unsigned char* ws = launder_p(args.ws); bf16* hb = (bf16*)(ws + WS_HB); float* ss = (float*)(ws + WS_SS); (void)hb; (void)ss;
            pg8::Gemm g{(const bf16_t*)(ws + WS_ACT), (const bf16_t*)(ws + WS_W1OUT), M, D, DFF}; pg8::StaticOrder S; S.init(M, D, F.G, launder_s((int)blockIdx.x));
            for (int rep = (PROBE_PHASE == 3 ? 0 : 1); rep < 2; ++rep) { EpiResid E{hbase, args.out, hb, ss, 0.5f, (LAS float*)(F.lds + RING_BYTES), rep == 0 ? 1 : 0};
            pg8::gemm_phase<EpiResid, pg8::StaticOrder, true, true>(F.lds + RING_OFF, g, S, E, F.wave); }
#endif
        } SEAM(pb + 2);
        if (IN(pb + 3)) {
#if !((DIS_MASK >> 2) & 1)
 unsigned char* ws = launder_p(args.ws); bf16* hb = (bf16*)(ws + WS_HB); float* ss = (float*)(ws + WS_SS); (void)hb; (void)ss;
            pg8::Gemm g{hb, (const bf16_t*)(ws + WS_WIN), M, INP, D}; pg8::StaticOrder S; S.init(M, INP, F.G, launder_s((int)blockIdx.x));
            EpiInProj E{ss, (bf16_t*)(ws + WS_QL), (float*)(ws + WS_CKVRAW), (bf16_t*)(ws + WS_IK), (float*)(ws + WS_IW), (bf16_t*)(ws + WS_IQRAW), (bf16_t*)(ws + WS_Z), (bf16_t*)(ws + WS_QC), (bf16_t*)(ws + WS_G)};
            for (int rep = (PROBE_PHASE == 4 ? 0 : 1); rep < 2; ++rep) pg8::gemm_phase<EpiInProj, pg8::StaticOrder, true, true>(F.lds + RING_OFF, g, S, E, F.wave);
#endif
        } SEAM(pb + 3);
        if (IN(pb + 4)) {
#if EN_PREP
 for (int rep = (PROBE_PHASE == 5 ? 0 : 1); rep < 2; ++rep) prep_tokens(KIN, args.out, args.ws, F.lds, l, F.wave, F.vcu, F.G, rep == 0 ? 1 : 0);
#endif
 } SEAM(pb + 4);
        if (IN(pb + 5)) {
#if EN_DSA
 for (int rep = (PROBE_PHASE == 6 ? 0 : 1); rep < 2; ++rep) for (int p = F.vcu; p < BATCH * 64; p += F.G) { for (int half = 0; half < 2; ++half) { const int b_ = p >> 6, ub_ = half == 0 ? (p & 63) : 127 - (p & 63);
   sel_pass1(args.ws, F.lds, F.wave, b_, ub_); if (PROBE_PHASE == 61) sel_pass1(args.ws, F.lds, F.wave, b_, ub_); sel_pass2(args.ws, F.lds, F.wave, b_, ub_); if (PROBE_PHASE == 62) sel_pass2(args.ws, F.lds, F.wave, b_, ub_); sel_resolve(args.ws, F.lds, F.wave, b_, ub_, (int)blockIdx.x, (p == F.vcu && half == 0) ? 1 : 0); if (PROBE_PHASE == 63) sel_resolve(args.ws, F.lds, F.wave, b_, ub_, (int)blockIdx.x, 0); } }
 dsa_select_slow(args.ws, F.lds, F.wave, (int)blockIdx.x); for (int rep = (PROBE_PHASE == 7 ? 0 : 1); rep < 2; ++rep) dsa_attend(args.ws, F.lds, args.in[2], F.wave, F.vcu, F.G, rep == 0 ? 1 : 0);
#endif
 } SEAM(pb + 5);
        if (IN(pb + 6)) {
#if !((DIS_MASK >> 3) & 1)
        for (int rep6 = (PROBE_PHASE == 8 ? 0 : 1); rep6 < 2; ++rep6) {
 unsigned char* ws = launder_p(args.ws); bf16* hb = (bf16*)(ws + WS_HB); float* ss = (float*)(ws + WS_SS); (void)hb; (void)ss;
            { pg8::Gemm g{(const bf16_t*)(ws + WS_QL), (const bf16_t*)(ws + WS_WA), M, D, 1024}; pg8::StaticOrder S; S.init(M, D, F.G, launder_s((int)blockIdx.x));
              EpiMerge<0> E{(bf16_t*)(ws + WS_MERGED), (const bf16_t*)(ws + WS_G)};
              pg8::gemm_phase<EpiMerge<0>, pg8::StaticOrder, true, true>(F.lds + RING_OFF, g, S, E, F.wave); }
            { pg8::Gemm g{(const bf16_t*)(ws + WS_YB), (const bf16_t*)(ws + WS_WB), M, D, PW_}; pg8::StaticOrder S; S.init(M, D, F.G, launder_s((int)blockIdx.x));
              EpiMerge<1> E{(bf16_t*)(ws + WS_MERGED), (const bf16_t*)(ws + WS_G)};
              pg8::gemm_phase<EpiMerge<1>, pg8::StaticOrder, true, true>(F.lds + RING_OFF, g, S, E, F.wave); }
            { pg8::Gemm g{(const bf16_t*)(ws + WS_QC), (const bf16_t*)(ws + WS_WC), M, D, CW}; pg8::StaticOrder S; S.init(M, D, F.G, launder_s((int)blockIdx.x));
              EpiMerge<2> E{(bf16_t*)(ws + WS_MERGED), (const bf16_t*)(ws + WS_G)};
              pg8::gemm_phase<EpiMerge<2>, pg8::StaticOrder, true, true>(F.lds + RING_OFF, g, S, E, F.wave); }
        }
#endif
        } SEAM(pb + 6);
        if (IN(pb + 7)) {
#if !((DIS_MASK >> 4) & 1)
 unsigned char* ws = launder_p(args.ws); bf16* hb = (bf16*)(ws + WS_HB); float* ss = (float*)(ws + WS_SS); (void)hb; (void)ss;
            pg8::Gemm g{(const bf16_t*)(ws + WS_MERGED), (const bf16_t*)(ws + WS_WOUT), M, D, D}; pg8::StaticOrder S; S.init(M, D, F.G, launder_s((int)blockIdx.x));
            for (int rep = (PROBE_PHASE == 9 ? 0 : 1); rep < 2; ++rep) { EpiResid E{args.out, args.out, hb, ss, 1.0f, (LAS float*)(F.lds + RING_BYTES), rep == 0 ? 1 : 0};
            pg8::gemm_phase<EpiResid, pg8::StaticOrder, true, true>(F.lds + RING_OFF, g, S, E, F.wave); }
#endif
        } SEAM(pb + 7);
        if (IN(pb + 8)) {
#if !((DIS_MASK >> 5) & 1)
 unsigned char* ws = launder_p(args.ws); bf16* hb = (bf16*)(ws + WS_HB); float* ss = (float*)(ws + WS_SS); (void)hb; (void)ss;
            pg8::Gemm g{hb, (const bf16_t*)(ws + WS_W2IN), M, 2 * DFF, D}; pg8::StaticOrder S; S.init(M, 2 * DFF, F.G, launder_s((int)blockIdx.x));
            EpiSwiglu E{(bf16_t*)(ws + WS_ACT), ss};
            for (int rep = (PROBE_PHASE == 2 ? 0 : 1); rep < 2; ++rep) pg8::gemm_phase<EpiSwiglu, pg8::StaticOrder, true, true>(F.lds + RING_OFF, g, S, E, F.wave);
#endif
        } SEAM(pb + 8);
        if (IN(pb + 9)) {
#if !((DIS_MASK >> 6) & 1)
 unsigned char* ws = launder_p(args.ws); bf16* hb = (bf16*)(ws + WS_HB); float* ss = (float*)(ws + WS_SS); (void)hb; (void)ss;
            pg8::Gemm g{(const bf16_t*)(ws + WS_ACT), (const bf16_t*)(ws + WS_W2OUT), M, D, DFF}; pg8::StaticOrder S; S.init(M, D, F.G, launder_s((int)blockIdx.x));
            for (int rep = (PROBE_PHASE == 3 ? 0 : 1); rep < 2; ++rep) { EpiResid E{args.out, args.out, hb, ss, 0.5f, (LAS float*)(F.lds + RING_BYTES), rep == 0 ? 1 : 0};
            pg8::gemm_phase<EpiResid, pg8::StaticOrder, true, true>(F.lds + RING_OFF, g, S, E, F.wave); }
#endif
        } SEAM(pb + 9);
    }
#if EN_P0
    if (IN(N_PHASES - 1)) { final_norm(KIN, args.out, args.ws, F.lds, F.wave, F.vcu, F.G); }
#endif
#undef IN
#undef SEAM
}

extern "C" void kernel_launch(void* const* d_in, const int* in_sizes, int n_in, void* d_out, int out_size, void* d_ws, size_t ws_size, hipStream_t stream) {
    static int grid = 0;
    if (grid == 0) {
        if (n_in != 23 || in_sizes[0] != M * D || out_size != M * D || ws_size < WS_END) { fprintf(stderr, "kernel_launch: unexpected shapes (n_in %d, ws %zu)\n", n_in, ws_size); grid = -1; return; }
        int dev = 0, cus = 0, per_cu = 0;
        if (hipGetDevice(&dev) != hipSuccess || hipDeviceGetAttribute(&cus, hipDeviceAttributeMultiprocessorCount, dev) != hipSuccess) { grid = -1; return; }
        if (hipFuncSetAttribute((const void*)mk_fwd, hipFuncAttributeMaxDynamicSharedMemorySize, LDS_BYTES) != hipSuccess) { fprintf(stderr, "kernel_launch: hipFuncSetAttribute failed\n"); grid = -1; return; }
        if (hipOccupancyMaxActiveBlocksPerMultiprocessor(&per_cu, (const void*)mk_fwd, NWAVES * 64, LDS_BYTES) != hipSuccess || per_cu < 1) { fprintf(stderr, "kernel_launch: occupancy query says %d\n", per_cu); }
        (void)hipGetLastError();
        grid = cus;
    }
    if (grid < 0) return;
    if (hipMemsetAsync((char*)d_ws + WS_CTL, 0, CTL_ZERO_BYTES, stream) != hipSuccess) return;
    Args a{};
    for (int i = 0; i < 23; ++i) a.in[i] = (const float*)d_in[i];
    a.out = (float*)d_out; a.ws = (unsigned char*)d_ws;
#if MK_ONE_LAUNCH
    a.ph_lo = 0; a.ph_hi = N_PHASES;
    hipLaunchKernelGGL(mk_fwd, dim3(grid), dim3(NWAVES * 64), LDS_BYTES, stream, a);
#endif
}
```

```cpp
#include <hip/hip_runtime.h>
#include <cstdio>
#include <cstdint>

#ifndef MK_ONE_LAUNCH
#define MK_ONE_LAUNCH 1
#endif
#ifndef PROBE_PHASE
#define PROBE_PHASE 0
#endif
#ifndef EN_P0
#define EN_P0 MK_ONE_LAUNCH
#endif
#ifndef EN_PREP
#define EN_PREP MK_ONE_LAUNCH
#endif
#ifndef EN_DSA
#define EN_DSA MK_ONE_LAUNCH
#endif
#ifndef DIS_MASK
#define DIS_MASK 0
#endif
#ifndef MK_ONE_LAUNCH
#define MK_ONE_LAUNCH 1
#endif

__device__ __forceinline__ int lane_id_v() { int l; asm volatile("v_mbcnt_lo_u32_b32 %0, -1, 0\n\tv_mbcnt_hi_u32_b32 %0, -1, %0" : "=v"(l)); return l; }
namespace pg8 {
#define PG8_LAS __attribute__((address_space(3)))
typedef unsigned short bf16_t;
typedef short bf16x8 __attribute__((ext_vector_type(8)));
typedef float f32x4 __attribute__((ext_vector_type(4)));
typedef unsigned u32x4 __attribute__((ext_vector_type(4)));
typedef unsigned u32x2 __attribute__((ext_vector_type(2)));
constexpr int BM = 256, BK = 64, HALF = 128, HTB = HALF * BK * 2, STAGE_BYTES = 8 * HTB, NXCD = 8, WGM = 8;

__host__ __device__ __forceinline__ int lds_byte(int r, int c) { const int st = (r >> 4) * 2 + (c >> 5), rr = r & 15, cc = c & 31, ob = rr * 64 + cc * 2; return st * 1024 + (ob ^ (((ob >> 9) & 1) << 5)); }
__host__ __device__ __forceinline__ void stage_rc(int b, int& R, int& C) { const int st = b / 1024, sb = b % 1024, swz = sb ^ (((sb >> 9) & 1) << 5); R = (st >> 1) * 16 + swz / 64; C = (st & 1) * 32 + (swz % 64) / 2; }
__host__ __device__ __forceinline__ int perm32(int rho) { const int n = rho >> 4, i = rho & 15; return 8 * (i >> 2) + 4 * n + (i & 3); }

struct Unit { int pm, pn; };
struct Gemm { const bf16_t* A; const bf16_t* Bt; int M, N, K; };

struct StaticOrder {
    int nM, nN, nwg, G, c;
    __host__ __device__ void init(int M, int N, int G_, int c_) { nM = M / BM; nN = N / BM; nwg = nM * nN; G = G_; c = c_; }
    __host__ __device__ bool next(int i, Unit& u) const {
        const long L = (long)i * G + c; if (L >= nwg) return false;
        int wgid = (int)L; { const int q = nwg / NXCD, r = nwg % NXCD, xcd = wgid % NXCD, off = wgid / NXCD; wgid = (xcd < r ? xcd * (q + 1) : r * (q + 1) + (xcd - r) * q) + off; }
        const int nig = WGM * nN, gid = wgid / nig, fm = gid * WGM, gsz = (nM - fm) < WGM ? (nM - fm) : WGM;
        u.pm = fm + ((wgid % nig) % gsz); u.pn = (wgid % nig) / gsz; return true;
    }
    __device__ __forceinline__ void a_ready(const Unit&) const {}
    __device__ __forceinline__ void done(const Unit&) const {}
};

__device__ __forceinline__ unsigned cvt_pk_bf16(float lo, float hi) { unsigned r; asm volatile("v_cvt_pk_bf16_f32 %0, %1, %2" : "=v"(r) : "v"(lo), "v"(hi)); return r; }

template <class Epi, class Sched, bool ALIGN_EPI = false, bool SP2 = false>
__device__ __forceinline__ void gemm_phase(PG8_LAS unsigned char* lds, const Gemm g, const Sched& S, const Epi& E, const int wid_) {
    int wid = wid_; asm volatile("" : "+s"(wid));
    const int lane = lane_id_v(), tid = wid * 64 + lane,
              wr = wid >> 2, wc = wid & 3, fr = lane & 15, fq = lane >> 4;
    const int K = g.K, nt = K / BK;
    unsigned voffA[2], voffB[2];
#pragma unroll
    for (int i = 0; i < 2; ++i) { int R, C; stage_rc(tid * 16 + i * 8192, R, C); const int Rb = Epi::PERM ? ((R & ~31) + perm32(R & 31)) : R;
        voffA[i] = (unsigned)(R * K + C) * 2u; voffB[i] = (unsigned)(Rb * K + C) * 2u; }
    const size_t kstep = (size_t)(BK * 2);
    const size_t hstep = (size_t)HALF * K * 2;
    const size_t tstep = 2 * hstep;
    const unsigned ldsw = (unsigned)wid * 1024u;
    const int aoff = lds_byte(wr * 64 + fr, fq * 8), boff = lds_byte(wc * 32 + fr, fq * 8);
#define PG8_SA(b, h) (((b) * 2 + (h)) * HTB)
#define PG8_SB(b, h) ((4 + (b) * 2 + (h)) * HTB)
#define PG8_STAGE(bufoff, gbase, voff) do { _Pragma("unroll") for (int _i = 0; _i < 2; ++_i) \
        __builtin_amdgcn_global_load_lds((const unsigned*)((const char*)(gbase) + (voff)[_i]), (PG8_LAS unsigned*)(lds + (bufoff) + ldsw + _i * 8192), 16, 0, 0); } while (0)
#define PG8_LDA(dst, b, h) do { _Pragma("unroll") for (int m = 0; m < 4; ++m) _Pragma("unroll") for (int k = 0; k < 2; ++k) dst[m][k] = *(const PG8_LAS bf16x8*)(lds + PG8_SA(b, h) + aoff + m * 2048 + k * 1024); } while (0)
#define PG8_LDB(dst, b, h) do { _Pragma("unroll") for (int n = 0; n < 2; ++n) _Pragma("unroll") for (int k = 0; k < 2; ++k) dst[n][k] = *(const PG8_LAS bf16x8*)(lds + PG8_SB(b, h) + boff + n * 2048 + k * 1024); } while (0)
#define PG8_MMA(ai, bj, At, Bt) do { __builtin_amdgcn_s_setprio(1); _Pragma("unroll") for (int m = 0; m < 4; ++m) _Pragma("unroll") for (int n = 0; n < 2; ++n) _Pragma("unroll") for (int k = 0; k < 2; ++k) \
        acc[ai][bj][m][n] = __builtin_amdgcn_mfma_f32_16x16x32_bf16(Bt[n][k], At[m][k], acc[ai][bj][m][n], 0, 0, 0); __builtin_amdgcn_s_setprio(0); } while (0)
#define PG8_WAIT_V(n) asm volatile("s_waitcnt vmcnt(" #n ")" ::: "memory")
#define PG8_WAIT_L(n) asm volatile("s_waitcnt lgkmcnt(" #n ")" ::: "memory")
#define PG8_BAR __builtin_amdgcn_s_barrier()
#define PG8_SCHED __builtin_amdgcn_sched_barrier(0)
    Unit cur, nxt; int ui = 0;
    if (!S.next(0, cur)) return;
    f32x4 acc[2][2][4][2];
#pragma unroll
    for (int a = 0; a < 2; ++a)
#pragma unroll
        for (int b = 0; b < 2; ++b)
#pragma unroll
            for (int m = 0; m < 4; ++m)
#pragma unroll
                for (int n = 0; n < 2; ++n) acc[a][b][m][n] = (f32x4){0.f, 0.f, 0.f, 0.f};
    bf16x8 At[4][2], B0[2][2], B1[2][2];
    const char* cA = (const char*)g.A + (size_t)cur.pm * tstep; const char* cB = (const char*)g.Bt + (size_t)cur.pn * tstep;
    S.a_ready(cur);
    if constexpr (SP2) {
        PG8_STAGE(PG8_SB(0, 0), cB, voffB); PG8_STAGE(PG8_SB(0, 1), cB + hstep, voffB); PG8_STAGE(PG8_SA(0, 0), cA, voffA); PG8_STAGE(PG8_SA(0, 1), cA + hstep, voffA);
        if (wr == 1) PG8_BAR;
        PG8_WAIT_V(2); PG8_BAR;
        PG8_STAGE(PG8_SB(1, 0), cB + kstep, voffB); PG8_STAGE(PG8_SA(1, 0), cA + kstep, voffA); PG8_STAGE(PG8_SB(1, 1), cB + hstep + kstep, voffB);
        PG8_WAIT_V(6); PG8_BAR;
    } else {
        PG8_STAGE(PG8_SB(0, 0), cB, voffB); PG8_STAGE(PG8_SA(0, 0), cA, voffA); PG8_STAGE(PG8_SB(0, 1), cB + hstep, voffB); PG8_STAGE(PG8_SA(0, 1), cA + hstep, voffA);
        if (wr == 1) PG8_BAR;
        PG8_WAIT_V(4); PG8_BAR;
        PG8_STAGE(PG8_SB(1, 0), cB + kstep, voffB); PG8_STAGE(PG8_SA(1, 0), cA + kstep, voffA); PG8_STAGE(PG8_SB(1, 1), cB + hstep + kstep, voffB);
        PG8_WAIT_V(6); PG8_BAR;
    }
    for (;;) {
        const bool has_next = S.next(ui + 1, nxt);
        const char* nA = has_next ? (const char*)g.A + (size_t)nxt.pm * tstep : cA; const char* nB = has_next ? (const char*)g.Bt + (size_t)nxt.pn * tstep : cB;
        for (int t = 0; t < nt; t += 2) {
            const bool last = (t == nt - 2);
            const char* a1 = cA + (size_t)(t + 1) * kstep;
            const char* a2 = last ? nA : cA + (size_t)(t + 2) * kstep; const char* b2 = last ? nB : cB + (size_t)(t + 2) * kstep;
            const char* a3 = a2 + kstep; const char* b3 = b2 + kstep;
            if (last && has_next) S.a_ready(nxt);
            if constexpr (SP2) {
            PG8_LDB(B0, 0, 0); PG8_LDB(B1, 0, 1); PG8_SCHED; PG8_LDA(At, 0, 0); PG8_STAGE(PG8_SA(1, 1), a1 + hstep, voffA);
            PG8_WAIT_V(8); PG8_WAIT_L(0); PG8_BAR; PG8_MMA(0, 0, At, B0); PG8_MMA(0, 1, At, B1); PG8_BAR; PG8_SCHED;
            PG8_LDA(At, 0, 1); PG8_STAGE(PG8_SB(0, 0), b2, voffB); PG8_STAGE(PG8_SB(0, 1), b2 + hstep, voffB); PG8_STAGE(PG8_SA(0, 0), a2, voffA);
            PG8_WAIT_V(8); PG8_WAIT_L(0); PG8_BAR; PG8_MMA(1, 0, At, B0); PG8_MMA(1, 1, At, B1); PG8_BAR; PG8_SCHED;
            PG8_LDB(B0, 1, 0); PG8_LDB(B1, 1, 1); PG8_SCHED; PG8_LDA(At, 1, 0); PG8_STAGE(PG8_SA(0, 1), a2 + hstep, voffA);
            PG8_WAIT_V(8); PG8_WAIT_L(0); PG8_BAR; PG8_MMA(0, 0, At, B0); PG8_MMA(0, 1, At, B1); PG8_BAR; PG8_SCHED;
            PG8_LDA(At, 1, 1); PG8_STAGE(PG8_SB(1, 0), b3, voffB); PG8_STAGE(PG8_SB(1, 1), b3 + hstep, voffB); PG8_STAGE(PG8_SA(1, 0), a3, voffA);
            PG8_WAIT_V(8); PG8_WAIT_L(0); PG8_BAR; PG8_MMA(1, 0, At, B0); PG8_MMA(1, 1, At, B1); PG8_BAR; PG8_SCHED;
            } else {
            PG8_LDB(B0, 0, 0); PG8_SCHED; PG8_LDA(At, 0, 0); PG8_STAGE(PG8_SA(1, 1), a1 + hstep, voffA);
            PG8_WAIT_L(8); PG8_BAR; PG8_WAIT_L(0); PG8_MMA(0, 0, At, B0); PG8_BAR; PG8_SCHED;
            PG8_LDB(B1, 0, 1); PG8_STAGE(PG8_SB(0, 0), b2, voffB);
            PG8_BAR; PG8_WAIT_L(0); PG8_MMA(0, 1, At, B1); PG8_BAR;
            PG8_LDA(At, 0, 1); PG8_STAGE(PG8_SA(0, 0), a2, voffA);
            PG8_BAR; PG8_WAIT_L(0); PG8_MMA(1, 0, At, B0); PG8_BAR; PG8_SCHED;
            PG8_STAGE(PG8_SB(0, 1), b2 + hstep, voffB);
            PG8_WAIT_V(6); PG8_BAR; PG8_MMA(1, 1, At, B1); PG8_BAR;
            PG8_LDB(B0, 1, 0); PG8_SCHED; PG8_LDA(At, 1, 0); PG8_STAGE(PG8_SA(0, 1), a2 + hstep, voffA);
            PG8_WAIT_L(8); PG8_BAR; PG8_WAIT_L(0); PG8_MMA(0, 0, At, B0); PG8_BAR; PG8_SCHED;
            PG8_LDB(B1, 1, 1); PG8_STAGE(PG8_SB(1, 0), b3, voffB);
            PG8_BAR; PG8_WAIT_L(0); PG8_MMA(0, 1, At, B1); PG8_BAR;
            PG8_LDA(At, 1, 1); PG8_STAGE(PG8_SA(1, 0), a3, voffA);
            PG8_BAR; PG8_WAIT_L(0); PG8_MMA(1, 0, At, B0); PG8_BAR; PG8_SCHED;
            PG8_STAGE(PG8_SB(1, 1), b3 + hstep, voffB);
            PG8_WAIT_V(6); PG8_BAR; PG8_MMA(1, 1, At, B1); PG8_BAR;
            }
        }
        if constexpr (ALIGN_EPI) { if (wr == 0) PG8_BAR; }
        E(acc, cur, wr, wc, fr, fq); S.done(cur);
        if (!has_next) break;
#pragma unroll
        for (int a = 0; a < 2; ++a)
#pragma unroll
            for (int b = 0; b < 2; ++b)
#pragma unroll
                for (int m = 0; m < 4; ++m)
#pragma unroll
                    for (int n = 0; n < 2; ++n) acc[a][b][m][n] = (f32x4){0.f, 0.f, 0.f, 0.f};
        cur = nxt; cA = nA; cB = nB; ++ui;
        if constexpr (ALIGN_EPI) { if (wr == 1) PG8_BAR; }
    }
    PG8_WAIT_V(0);
    if constexpr (!ALIGN_EPI) { if (wr == 0) PG8_BAR; }
    PG8_BAR;
#undef PG8_SA
#undef PG8_SB
#undef PG8_STAGE
#undef PG8_LDA
#undef PG8_LDB
#undef PG8_MMA
#undef PG8_WAIT_V
#undef PG8_WAIT_L
#undef PG8_BAR
#undef PG8_SCHED
}
}

constexpr int NWAVES = 8;
constexpr int BATCH = 4, SEQ = 8192, D = 1024, DEPTH = 4, M = BATCH * SEQ;
constexpr int NMEM = 256, MROWS = BATCH * NMEM;
constexpr int AH = 8, AHD = 64, AW = 512, KVR = 128, IH = 8, IDIM = 32, TOPK = 256;
constexpr int PW_ = 256, CH = 4, CHD = 64, CW = 256;
constexpr int DFF = 2816, INW = 4520, INP = 5120;
constexpr float EPS = 1e-6f;
constexpr int C_QA = 0, C_CKV = 512, C_IQ = 640, C_IK = 896, C_IW = 928, C_Z = 936, C_QC = 1192, C_G = 1448;

constexpr size_t MiB = 1u << 20;
constexpr size_t WS_CTL = 0, CTL_ZERO_BYTES = 1 * MiB;
constexpr size_t WS_SS = 1 * MiB;
constexpr size_t WS_IW = 3 * MiB;
constexpr size_t WS_SGN = 4 * MiB;
constexpr size_t WS_MEMN = 5 * MiB;
constexpr size_t WS_WMEM = 7 * MiB;
constexpr size_t WS_MEMKV = 11 * MiB;
constexpr size_t WS_W1IN = 15 * MiB, WS_W1OUT = 26 * MiB, WS_WIN = 32 * MiB, WS_WA = 42 * MiB, WS_WB = 44 * MiB, WS_WC = 44 * MiB + 512 * 1024, WS_WOUT = 45 * MiB, WS_W2IN = 47 * MiB, WS_W2OUT = 58 * MiB;
constexpr size_t WS_HB = 64 * MiB;
constexpr size_t WS_ACT = 128 * MiB;
constexpr size_t WS_G = 128 * MiB;
constexpr size_t WS_QL = 320 * MiB;
constexpr size_t WS_CKV = 384 * MiB;
constexpr size_t WS_CKVRAW = 392 * MiB;
constexpr size_t WS_IQRAW = 408 * MiB;
constexpr size_t WS_IQF = 424 * MiB;
constexpr size_t WS_IK = 440 * MiB;
constexpr size_t WS_Z = 442 * MiB;
constexpr size_t WS_MERGED = 384 * MiB;
constexpr size_t WS_YB = 458 * MiB;
constexpr size_t WS_QC = 474 * MiB;
constexpr size_t WS_SEL = 490 * MiB;
constexpr size_t WS_VT = 506 * MiB;
constexpr size_t WS_WPT = 4 * MiB + 512 * 1024;
constexpr size_t WS_END = 510 * MiB;
constexpr int CW_BAR = 4096;

constexpr int RING_OFF = 0, RING_BYTES = 131072;
constexpr int LDS_BYTES = 155648;
constexpr int MISC_OFF = LDS_BYTES - 256;

#define GAS __attribute__((address_space(1)))
#define LAS __attribute__((address_space(3)))
typedef unsigned short bf16;
typedef unsigned v4u __attribute__((ext_vector_type(4)));
typedef unsigned v2u __attribute__((ext_vector_type(2)));
typedef float f32x4 __attribute__((ext_vector_type(4)));
typedef float f32x2 __attribute__((ext_vector_type(2)));
typedef GAS unsigned gu32;
#define RLX_AGENT __ATOMIC_RELAXED, __HIP_MEMORY_SCOPE_AGENT
#define LDS_WAIT() asm volatile("s_waitcnt lgkmcnt(0)" ::: "memory")
#define VM_WAIT() asm volatile("s_waitcnt vmcnt(0)" ::: "memory")
__device__ __forceinline__ unsigned f2bf(float f) { unsigned u = __builtin_bit_cast(unsigned, f); return (u + 0x7fffu + ((u >> 16) & 1u)) >> 16; }
__device__ __forceinline__ unsigned pk2(float lo, float hi) { return f2bf(lo) | (f2bf(hi) << 16); }
__device__ __forceinline__ float bflo(unsigned w) { return __builtin_bit_cast(float, w << 16); }
__device__ __forceinline__ float bfhi(unsigned w) { return __builtin_bit_cast(float, w & 0xffff0000u); }
typedef _Float16 h2_t __attribute__((ext_vector_type(2)));
typedef _Float16 f16x8_t __attribute__((ext_vector_type(8)));
__device__ __forceinline__ unsigned pkh2(float lo, float hi) { const h2_t v = {(_Float16)lo, (_Float16)hi}; return __builtin_bit_cast(unsigned, v); }
__device__ __forceinline__ float hlo(unsigned w) { return (float)__builtin_bit_cast(h2_t, w)[0]; }
__device__ __forceinline__ float hhi(unsigned w) { return (float)__builtin_bit_cast(h2_t, w)[1]; }
__device__ __forceinline__ float bf2f(bf16 b) { return __builtin_bit_cast(float, ((unsigned)b) << 16); }

#define XB_TMO      128
#define XB_XCNT(j)  (256  + 64 * (j))
#define XB_XSUB(j)  (1280 + 64 * (j))
#define XB_XGEN(j)  (2304 + 64 * (j))
#define XB_TOP      3328
#define XB_TOPGEN   3392
#define XCD_BAR_WORDS 3456
#define XB_SPIN_CAP (1u << 23)

__device__ __forceinline__ unsigned xb_ld(unsigned* p)              { return __hip_atomic_load(p, __ATOMIC_RELAXED, __HIP_MEMORY_SCOPE_AGENT); }
__device__ __forceinline__ unsigned xb_add(unsigned* p, unsigned v) { return __hip_atomic_fetch_add(p, v, __ATOMIC_RELAXED, __HIP_MEMORY_SCOPE_AGENT); }
__device__ __forceinline__ unsigned xb_xcc_id() { return (unsigned)__builtin_amdgcn_s_getreg((3 << 11) | 20) & 0xFu; }
#define XB_SPIN(cond, bar) do { unsigned _sp = 0; while (cond) { __builtin_amdgcn_s_sleep(1); \
    if ((++_sp & 255u) == 0u) { if (xb_ld(&(bar)[XB_TMO])) break; if (_sp > XB_SPIN_CAP) { atomicAdd(&(bar)[XB_TMO], 1u); break; } } } } while (0)

struct XcdBarrier { unsigned* bar; unsigned x; volatile LAS unsigned* st; int wave; };

__device__ __forceinline__ XcdBarrier xcd_barrier_post(unsigned* bar, volatile LAS unsigned* st, int wave) {
    XcdBarrier b; b.bar = bar; b.x = xb_xcc_id(); b.st = st; b.wave = wave;
    if (threadIdx.x == 0) (void)xb_add(&bar[XB_XCNT(b.x)], 1u);
    return b;
}
__device__ __forceinline__ void xcd_barrier_complete(unsigned* bar, unsigned x, unsigned& nloc, unsigned& nx) {
    const unsigned G = gridDim.x * gridDim.y * gridDim.z;
    unsigned sum, cnt, mine, sp = 0u;
    for (;;) {
        sum = 0u; cnt = 0u; mine = 0u;
#pragma unroll
        for (unsigned j = 0; j < 16; ++j) { const unsigned c = xb_ld(&bar[XB_XCNT(j)]); sum += c; cnt += (c > 0u) ? 1u : 0u; mine = (j == x) ? c : mine; }
        if (sum == G) break;
        __builtin_amdgcn_s_sleep(1);
        if ((++sp & 255u) == 0u) { if (xb_ld(&bar[XB_TMO])) break; if (sp > XB_SPIN_CAP) { atomicAdd(&bar[XB_TMO], 1u); break; } }
    }
    nloc = mine > 0u ? mine : 1u; nx = cnt > 0u ? cnt : 1u;
}
__device__ __forceinline__ void xcd_barrier(const XcdBarrier& b) {
    asm volatile("s_waitcnt vmcnt(0)" ::: "memory");
    __syncthreads();
    int bw_ = b.wave; asm volatile("" : "+s"(bw_));
    if (bw_ == 0 && lane_id_v() == 0) {
        unsigned* bar = b.bar;
        __builtin_amdgcn_s_waitcnt(0);
        unsigned nloc = b.st[0], nx = b.st[1];
        if (nloc == 0u) { xcd_barrier_complete(bar, b.x, nloc, nx); b.st[0] = nloc; b.st[1] = nx; }
        const unsigned old = xb_add(&bar[XB_XSUB(b.x)], 1u);
        const unsigned gen = old / nloc;
        if (old + 1u == (gen + 1u) * nloc) {
            __builtin_amdgcn_fence(__ATOMIC_RELEASE, "agent");
            asm volatile("s_waitcnt vmcnt(0)" ::: "memory");
            const unsigned og = xb_add(&bar[XB_TOP], 1u);
            const unsigned tg = og / nx;
            if (og + 1u == (tg + 1u) * nx) xb_add(&bar[XB_TOPGEN], 1u);
            else XB_SPIN(xb_ld(&bar[XB_TOPGEN]) == tg, bar);
            __builtin_amdgcn_fence(__ATOMIC_ACQUIRE, "agent");
            xb_add(&bar[XB_XGEN(b.x)], 1u);
            asm volatile("s_waitcnt vmcnt(0)" ::: "memory");
        } else {
            XB_SPIN(xb_ld(&bar[XB_XGEN(b.x)]) == gen, bar);
            __builtin_amdgcn_fence(__ATOMIC_ACQUIRE, "agent");
            asm volatile("s_waitcnt vmcnt(0)" ::: "memory");
        }
    }
    __syncthreads();
}

struct Args {
    const float* in[23]; float* out; unsigned char* ws; int ph_lo, ph_hi;
};
template <class T> __device__ __forceinline__ T* uni(T* p) { const unsigned long long v = (unsigned long long)p; const unsigned lo = __builtin_amdgcn_readfirstlane((unsigned)v), hi = __builtin_amdgcn_readfirstlane((unsigned)(v >> 32)); return (T*)(((unsigned long long)hi << 32) | lo); }
__device__ __forceinline__ LAS unsigned char* uni_l(LAS unsigned char* p) { return (LAS unsigned char*)(unsigned)__builtin_amdgcn_readfirstlane((int)(unsigned)(size_t)p); }
__device__ __forceinline__ int uni_i(int v) { return __builtin_amdgcn_readfirstlane(v); }
struct PC { const float* const* in; float* out; unsigned char* ws; LAS unsigned char* lds; int wave, vcu, G; };
struct Frame {
    LAS unsigned char* lds;
    volatile LAS unsigned* MISC;
    gu32* ctl;
    int wave, vcu, G;
    unsigned char* ws;
};
__device__ __forceinline__ unsigned char* launder_p(unsigned char* p) { asm volatile("" : "+s"(p)); return p; }
__device__ __forceinline__ int launder_s(int v) { asm volatile("" : "+s"(v)); return v; }
__device__ __forceinline__ int launder_v(int v) { asm volatile("" : "+v"(v)); return v; }
__device__ __forceinline__ float wave_sum(float v) {
#pragma unroll
    for (int o = 1; o < 64; o <<= 1) v += __shfl_xor(v, o);
    return v;
}
__device__ __forceinline__ float wave_max(float v) {
#pragma unroll
    for (int o = 1; o < 64; o <<= 1) v = fmaxf(v, __shfl_xor(v, o));
    return v;
}

using pg8::Unit; using pg8::bf16_t;
#define LAUNDER2(a, b) asm volatile("" : "+v"(a), "+v"(b))
__device__ __forceinline__ float row_scale(const float* ss, int row) {
    const f32x4 a = *(const f32x4*)(ss + (size_t)row * 4);
    const float s = (a.x + a.y) + (a.z + a.w);
    return __builtin_amdgcn_rsqf(s * (1.0f / D) + EPS);
}
__device__ __forceinline__ float sigmoidf_(float x) { return 1.0f / (1.0f + __expf(-x)); }
__device__ __forceinline__ pg8::u32x2 pack4(const f32x4 v) { pg8::u32x2 w; w.x = pg8::cvt_pk_bf16(v[0], v[1]); w.y = pg8::cvt_pk_bf16(v[2], v[3]); return w; }

struct EpiSwiglu {
    static constexpr bool PERM = true;
    bf16_t* O; const float* ss;
    __device__ __forceinline__ void operator()(const f32x4 (&acc)[2][2][4][2], const Unit& u, int wr, int wc, int fr_, int fq_) const {
        const int l_ = lane_id_v(); const int fr = l_ & 15, fq = l_ >> 4; (void)fr_; (void)fq_;
        int rb = wr * 64 + fr, cb = wc * 32 + 8 * fq; LAUNDER2(rb, cb);
        const int row0 = u.pm * 256 + rb, col0 = u.pn * 128 + cb;
#pragma unroll
        for (int ai = 0; ai < 2; ++ai)
#pragma unroll
            for (int m = 0; m < 4; ++m) { const int row = row0 + ai * 128 + m * 16; const float s = row_scale(ss, row);
                pg8::u32x4 w;
                { const f32x4 a = acc[ai][0][m][0] * s, b = acc[ai][1][m][0] * s; f32x4 o;
#pragma unroll
                  for (int i = 0; i < 4; ++i) o[i] = a[i] * sigmoidf_(a[i]) * b[i];
                  w.x = pg8::cvt_pk_bf16(o[0], o[1]); w.y = pg8::cvt_pk_bf16(o[2], o[3]); }
                { const f32x4 a = acc[ai][0][m][1] * s, b = acc[ai][1][m][1] * s; f32x4 o;
#pragma unroll
                  for (int i = 0; i < 4; ++i) o[i] = a[i] * sigmoidf_(a[i]) * b[i];
                  w.z = pg8::cvt_pk_bf16(o[0], o[1]); w.w = pg8::cvt_pk_bf16(o[2], o[3]); }
                *(pg8::u32x4*)(O + (size_t)row * DFF + col0) = w; }
    }
};
struct EpiResid {
    static constexpr bool PERM = true;
    const float* base; float* out; bf16_t* hb; float* ss; float alpha; LAS float* P; int dry;
    __device__ __forceinline__ void operator()(const f32x4 (&acc)[2][2][4][2], const Unit& u, int wr, int wc, int fr_, int fq_) const {
        const int l_ = lane_id_v(); const int fr = l_ & 15, fq = l_ >> 4; (void)fr_; (void)fq_;
        int rb = wr * 64 + fr, cb = wc * 32 + 8 * fq; LAUNDER2(rb, cb);
        const int row0 = u.pm * 256 + rb, col0 = u.pn * 256 + cb;
#pragma unroll
        for (int ai = 0; ai < 2; ++ai)
#pragma unroll
          for (int mh = 0; mh < 2; ++mh) {
            f32x4 bs[2][2][2];
#pragma unroll
            for (int mm = 0; mm < 2; ++mm) { const size_t off = (size_t)(row0 + ai * 128 + (2 * mh + mm) * 16) * D + col0;
#pragma unroll
                for (int bj = 0; bj < 2; ++bj)
#pragma unroll
                    for (int n = 0; n < 2; ++n) bs[mm][bj][n] = *(const f32x4*)(base + off + bj * 128 + n * 4); }
#pragma unroll
            for (int mm = 0; mm < 2; ++mm) { const int m = 2 * mh + mm; const int row = row0 + ai * 128 + m * 16; const size_t off = (size_t)row * D + col0; float q = 0.f;
#pragma unroll
                for (int bj = 0; bj < 2; ++bj) { const f32x4 v0 = bs[mm][bj][0] + acc[ai][bj][m][0] * alpha, v1 = bs[mm][bj][1] + acc[ai][bj][m][1] * alpha;
                    if (!dry) { *(f32x4*)(out + off + bj * 128) = v0; *(f32x4*)(out + off + bj * 128 + 4) = v1;
                        pg8::u32x4 w; w.x = pg8::cvt_pk_bf16(v0[0], v0[1]); w.y = pg8::cvt_pk_bf16(v0[2], v0[3]); w.z = pg8::cvt_pk_bf16(v1[0], v1[1]); w.w = pg8::cvt_pk_bf16(v1[2], v1[3]);
                        *(pg8::u32x4*)(hb + off + bj * 128) = w; }
                    q += ((v0[0] * v0[0] + v0[1] * v0[1]) + (v0[2] * v0[2] + v0[3] * v0[3])) + ((v1[0] * v1[0] + v1[1] * v1[1]) + (v1[2] * v1[2] + v1[3] * v1[3])); }
                q += __shfl_xor(q, 16); q += __shfl_xor(q, 32);
                if (fq == 0) P[(rb + ai * 128 + m * 16) * 4 + wc] = q; }
            asm volatile("" ::: "memory"); }
        asm volatile("s_waitcnt lgkmcnt(0)" ::: "memory"); __builtin_amdgcn_s_barrier(); asm volatile("" ::: "memory");
        const int tid = (wr * 4 + wc) * 64 + fq * 16 + fr;
        if (tid < 256 && !dry) { const f32x4 p = *(const LAS f32x4*)(P + tid * 4); ss[(size_t)(u.pm * 256 + tid) * 4 + u.pn] = (p.x + p.y) + (p.z + p.w); }
    }
};
struct EpiPlainBf16 {
    static constexpr bool PERM = false;
    bf16_t* O; int ldo;
    __device__ __forceinline__ void operator()(const f32x4 (&acc)[2][2][4][2], const Unit& u, int wr, int wc, int fr_, int fq_) const {
        const int l_ = lane_id_v(); const int fr = l_ & 15, fq = l_ >> 4; (void)fr_; (void)fq_;
        int rb = wr * 64 + fr, cb = wc * 32 + 4 * fq; LAUNDER2(rb, cb);
        const int row0 = u.pm * 256 + rb, col0 = u.pn * 256 + cb;
#pragma unroll
        for (int ai = 0; ai < 2; ++ai)
#pragma unroll
            for (int m = 0; m < 4; ++m) { bf16_t* rowp = O + (size_t)(row0 + ai * 128 + m * 16) * ldo + col0;
#pragma unroll
                for (int bj = 0; bj < 2; ++bj)
#pragma unroll
                    for (int n = 0; n < 2; ++n) *(pg8::u32x2*)(rowp + bj * 128 + n * 16) = pack4(acc[ai][bj][m][n]); }
    }
};
struct EpiInProj {
    static constexpr bool PERM = true;
    const float* ss; bf16_t* qa; float* ckvraw; bf16_t* ik; float* iw; bf16_t* iqraw; bf16_t* z; bf16_t* qc; bf16_t* G;
    __device__ __forceinline__ void operator()(const f32x4 (&acc)[2][2][4][2], const Unit& u, int wr, int wc, int fr_, int fq_) const {
        const int l_ = lane_id_v(); const int fr = l_ & 15, fq = l_ >> 4; (void)fr_; (void)fq_;
        int rb = wr * 64 + fr, ct = wc * 32 + 8 * fq; LAUNDER2(rb, ct);
        const int row0 = u.pm * 256 + rb; const int pn = u.pn;
        if (pn == 4) {
#pragma unroll
            for (int ai = 0; ai < 2; ++ai)
#pragma unroll
                for (int m = 0; m < 4; ++m) { const int row = row0 + ai * 128 + m * 16; const float s = row_scale(ss, row);
#pragma unroll
                    for (int n = 0; n < 2; ++n) *(f32x4*)(ckvraw + (size_t)row * KVR + ct + n * 4) = acc[ai][0][m][n] * s;
                    if (wc == 0) { const f32x4 k0 = acc[ai][1][m][0] * s, k1 = acc[ai][1][m][1] * s; pg8::u32x4 w; w.x = pkh2(k0[0], k0[1]); w.y = pkh2(k0[2], k0[3]); w.z = pkh2(k1[0], k1[1]); w.w = pkh2(k1[2], k1[3]);
                        *(pg8::u32x4*)(ik + (size_t)row * IDIM + 8 * fq) = w; }
                    if (wc == 1 && fq == 0) { *(f32x4*)(iw + (size_t)row * IH) = acc[ai][1][m][0] * s; *(f32x4*)(iw + (size_t)row * IH + 4) = acc[ai][1][m][1] * s; } }
        } else {
            bf16_t* dst0; int ld; bool sig = false; const bool f16out = (pn == 5);
            if (pn < 4) { dst0 = qa + pn * 256; ld = 1024; } else if (pn == 5) { dst0 = iqraw; ld = 256; } else if (pn == 6) { dst0 = z; ld = 256; } else if (pn == 7) { dst0 = qc; ld = 256; } else { dst0 = G + (pn - 8) * 256; ld = 3072; sig = true; }
#pragma unroll
            for (int ai = 0; ai < 2; ++ai)
#pragma unroll
                for (int m = 0; m < 4; ++m) { const int row = row0 + ai * 128 + m * 16; const float s = row_scale(ss, row); bf16_t* rowp = dst0 + (size_t)row * ld + ct;
#pragma unroll
                    for (int bj = 0; bj < 2; ++bj) { f32x4 o0 = acc[ai][bj][m][0] * s, o1 = acc[ai][bj][m][1] * s;
                        if (sig) {
#pragma unroll
                            for (int i = 0; i < 4; ++i) { o0[i] = sigmoidf_(o0[i]); o1[i] = sigmoidf_(o1[i]); } }
                        pg8::u32x4 wo;
                        if (f16out) { wo.x = pkh2(o0[0], o0[1]); wo.y = pkh2(o0[2], o0[3]); wo.z = pkh2(o1[0], o1[1]); wo.w = pkh2(o1[2], o1[3]); }
                        else { wo.x = pg8::cvt_pk_bf16(o0[0], o0[1]); wo.y = pg8::cvt_pk_bf16(o0[2], o0[3]); wo.z = pg8::cvt_pk_bf16(o1[0], o1[1]); wo.w = pg8::cvt_pk_bf16(o1[2], o1[3]); }
                        *(pg8::u32x4*)(rowp + bj * 128) = wo; } }
        }
    }
};
template <int MODE> struct EpiMerge {
    static constexpr bool PERM = false;
    bf16_t* Mg; const bf16_t* G;
    __device__ __forceinline__ void operator()(const f32x4 (&acc)[2][2][4][2], const Unit& u, int wr, int wc, int fr_, int fq_) const {
        const int l_ = lane_id_v(); const int fr = l_ & 15, fq = l_ >> 4; (void)fr_; (void)fq_;
        int rb = wr * 64 + fr, cb = wc * 32 + 4 * fq; LAUNDER2(rb, cb);
        const int row0 = u.pm * 256 + rb, col0 = u.pn * 256 + cb;
#pragma unroll
        for (int ai = 0; ai < 2; ++ai)
#pragma unroll
            for (int m = 0; m < 4; ++m) { const int row = row0 + ai * 128 + m * 16;
                const bf16_t* gp = G + (size_t)row * 3072 + MODE * 1024 + col0; bf16_t* mp = Mg + (size_t)row * D + col0;
#pragma unroll
                for (int bj = 0; bj < 2; ++bj)
#pragma unroll
                    for (int n = 0; n < 2; ++n) { const int co = bj * 128 + n * 16;
                        const pg8::u32x2 gw = *(const pg8::u32x2*)(gp + co);
                        f32x4 o = acc[ai][bj][m][n]; o[0] *= bflo(gw.x); o[1] *= bfhi(gw.x); o[2] *= bflo(gw.y); o[3] *= bfhi(gw.y);
                        if (MODE > 0) { const pg8::u32x2 pw = *(const pg8::u32x2*)(mp + co); o[0] += bflo(pw.x); o[1] += bfhi(pw.x); o[2] += bflo(pw.y); o[3] += bfhi(pw.y); }
                        *(pg8::u32x2*)(mp + co) = pack4(o); }
                asm volatile("" ::: "memory"); }
    }
};

template <class Map>
__device__ __forceinline__ void transpose_item(const float* W, int K, int N, const float* gain, bf16* WT, LAS float* scr, int item, int lane, Map map) {
    const int nblk = (N + 63) / 64, kb = item / nblk, nb = item % nblk, k0 = 64 * kb, n0 = 64 * nb;
    const int nn = n0 + 4 * (lane & 15); const bool nok = nn < N;
#pragma unroll 4
    for (int i = 0; i < 16; ++i) { const int kk = 4 * i + (lane >> 4); f32x4 v = nok ? *(const f32x4*)(W + (size_t)(k0 + kk) * N + nn) : (f32x4){0.f, 0.f, 0.f, 0.f};
        if (gain) v = v * gain[k0 + kk];
        *(LAS f32x4*)(scr + kk * 68 + 4 * (lane & 15)) = v; }
    LDS_WAIT(); asm volatile("" ::: "memory");
    const int c = lane & 7;
#pragma unroll
    for (int j = 0; j < 8; ++j) { const int n = (lane >> 3) + 8 * j; const LAS float* sp = scr + (8 * c) * 68 + n;
        v4u o; o.x = pk2(sp[0 * 68], sp[1 * 68]); o.y = pk2(sp[2 * 68], sp[3 * 68]); o.z = pk2(sp[4 * 68], sp[5 * 68]); o.w = pk2(sp[6 * 68], sp[7 * 68]);
        if (n0 + n < N) { const int dr = map(n0 + n); if (dr >= 0) *(GAS v4u*)(WT + (size_t)dr * K + k0 + 8 * c) = o; } }
    LDS_WAIT(); asm volatile("" ::: "memory");
}
struct MapId { int off; __device__ __forceinline__ int operator()(int n) const { return off + n; } };
struct MapSwiglu { __device__ __forceinline__ int operator()(int c) const { const int half = c >= DFF ? 1 : 0, j = c - half * DFF; return 256 * (j >> 7) + 128 * half + (j & 127); } };
struct MapInProj { __device__ __forceinline__ int operator()(int c) const {
    if (c < C_CKV) return -1;
    if (c < C_IQ) return 1024 + (c - C_CKV);
    if (c < C_IK) return 1280 + (c - C_IQ);
    if (c < C_IW) return 1152 + (c - C_IK);
    if (c < C_Z) return 1184 + (c - C_IW);
    if (c < C_QC) return 1536 + (c - C_Z);
    if (c < C_G) return 1792 + (c - C_QC);
    return 2048 + (c - C_G); } };
__device__ __forceinline__ void qlat_item(const float* win, const float* mixn, const float* wuk, bf16* WT, int item, int lane) {
    const int kc = item & 127, rh = (item >> 7) & 1, h = item >> 8; const int r = rh * 64 + lane;
    const f32x4* wp = (const f32x4*)(wuk + (size_t)r * (AH * AHD) + h * 64);
    float acc[8] = {0.f, 0.f, 0.f, 0.f, 0.f, 0.f, 0.f, 0.f};
#pragma unroll 1
    for (int dc = 0; dc < 4; ++dc) {
        const f32x4 w0 = wp[4 * dc], w1 = wp[4 * dc + 1], w2 = wp[4 * dc + 2], w3 = wp[4 * dc + 3];
#pragma unroll
        for (int kk = 0; kk < 8; ++kk) { const f32x4* ip = (const f32x4*)(win + (size_t)(kc * 8 + kk) * INW + h * 64 + 16 * dc);
            const f32x4 a0 = ip[0], a1 = ip[1], a2 = ip[2], a3 = ip[3];
            acc[kk] += (a0.x * w0.x + a0.y * w0.y + a0.z * w0.z + a0.w * w0.w) + (a1.x * w1.x + a1.y * w1.y + a1.z * w1.z + a1.w * w1.w)
                     + (a2.x * w2.x + a2.y * w2.y + a2.z * w2.z + a2.w * w2.w) + (a3.x * w3.x + a3.y * w3.y + a3.z * w3.z + a3.w * w3.w);
            if (kk & 1) asm volatile("" ::: "memory"); }
    }
    const f32x4 g0 = *(const f32x4*)(mixn + kc * 8), g1 = *(const f32x4*)(mixn + kc * 8 + 4);
    v4u w; w.x = pk2(acc[0] * g0.x, acc[1] * g0.y); w.y = pk2(acc[2] * g0.z, acc[3] * g0.w); w.z = pk2(acc[4] * g1.x, acc[5] * g1.y); w.w = pk2(acc[6] * g1.z, acc[7] * g1.w);
    *(GAS v4u*)(WT + (size_t)(h * 128 + r) * D + kc * 8) = w;
}
__device__ __forceinline__ void wafold_item(const float* wuv, const float* wba, bf16* WT, int item, int lane) {
    const int ng = item & 15, rg = (item >> 4) & 15, h = item >> 8; const int n = ng * 64 + lane, r0 = rg * 8;
    float acc[8] = {0.f, 0.f, 0.f, 0.f, 0.f, 0.f, 0.f, 0.f};
#pragma unroll 4
    for (int d = 0; d < 64; ++d) { const float wa = wba[(size_t)(h * 64 + d) * D + n];
#pragma unroll
        for (int j = 0; j < 8; ++j) acc[j] += wuv[(size_t)(r0 + j) * (AH * AHD) + h * 64 + d] * wa; }
    v4u w; w.x = pk2(acc[0], acc[1]); w.y = pk2(acc[2], acc[3]); w.z = pk2(acc[4], acc[5]); w.w = pk2(acc[6], acc[7]);
    *(GAS v4u*)(WT + (size_t)n * 1024 + h * 128 + r0) = w;
}
__device__ __forceinline__ int items_of(int K, int N) { return (K / 64) * ((N + 63) / 64); }

__device__ __forceinline__ void prep_layer_weights_body(const PC& F, int l) {
    struct { const float* const* in; } a{F.in};
    const int lane_ = lane_id_v();
    LAS float* scr = (LAS float*)(F.lds + RING_OFF + F.wave * 17408);
    const int gw = F.vcu * NWAVES + F.wave, NGW = F.G * NWAVES;
    const float* f1n = a.in[3] + (size_t)l * D; const float* f1in = a.in[4] + (size_t)l * D * 2 * DFF; const float* f1out = a.in[5] + (size_t)l * DFF * D;
    const float* mixn = a.in[6] + (size_t)l * D; const float* win = a.in[7] + (size_t)l * D * INW;
    const float* wba = a.in[15] + (size_t)l * AW * D; const float* wbb = a.in[16] + (size_t)l * PW_ * D; const float* wbc = a.in[17] + (size_t)l * CW * D;
    const float* wout = a.in[18] + (size_t)l * D * D;
    const float* f2n = a.in[19] + (size_t)l * D; const float* f2in = a.in[20] + (size_t)l * D * 2 * DFF; const float* f2out = a.in[21] + (size_t)l * DFF * D;
    unsigned char* ws = launder_p(F.ws);
    const float* wuk = a.in[9] + (size_t)l * KVR * AH * AHD; const float* wuv = a.in[10] + (size_t)l * KVR * AH * AHD;
    const int I0 = items_of(D, 2 * DFF), I1 = items_of(DFF, D), I2 = items_of(D, INW), I4 = items_of(PW_, D), I5 = items_of(CW, D), I6 = items_of(D, D);
    const int NIT = 2 * I0 + 2 * I1 + I2 + I4 + I5 + I6;
#pragma unroll 1
    for (int it = gw; it < NIT; it += NGW) {
        int r = it;
        if (r < I0) { transpose_item(f1in, D, 2 * DFF, f1n, (bf16*)(ws + WS_W1IN), scr, r, lane_, MapSwiglu{}); continue; } r -= I0;
        if (r < I0) { transpose_item(f2in, D, 2 * DFF, f2n, (bf16*)(ws + WS_W2IN), scr, r, lane_, MapSwiglu{}); continue; } r -= I0;
        if (r < I1) { transpose_item(f1out, DFF, D, nullptr, (bf16*)(ws + WS_W1OUT), scr, r, lane_, MapId{0}); continue; } r -= I1;
        if (r < I1) { transpose_item(f2out, DFF, D, nullptr, (bf16*)(ws + WS_W2OUT), scr, r, lane_, MapId{0}); continue; } r -= I1;
        if (r < I2) { transpose_item(win, D, INW, mixn, (bf16*)(ws + WS_WIN), scr, r, lane_, MapInProj{}); continue; } r -= I2;
        if (r < I4) { transpose_item(wbb, PW_, D, nullptr, (bf16*)(ws + WS_WB), scr, r, lane_, MapId{0}); continue; } r -= I4;
        if (r < I5) { transpose_item(wbc, CW, D, nullptr, (bf16*)(ws + WS_WC), scr, r, lane_, MapId{0}); continue; } r -= I5;
        transpose_item(wout, D, D, nullptr, (bf16*)(ws + WS_WOUT), scr, r, lane_, MapId{0});
    }
    { const float* wpool = a.in[11] + (size_t)l * 4 * 64 * 64; bf16* wpT = (bf16*)(ws + WS_WPT);
      for (int i = gw * 64 + lane_; i < 4 * 64 * 64; i += NGW * 64) { const int c = i & 63, d = (i >> 6) & 63, g = i >> 12; wpT[i] = (bf16)f2bf(wpool[(g * 64 + c) * 64 + d]); } }
    asm volatile("" ::: "memory");
#pragma unroll 1
    for (int it = gw; it < 2048; it += NGW) wafold_item(wuv, wba, (bf16*)(ws + WS_WA), it, lane_);
    asm volatile("" ::: "memory");
#pragma unroll 1
    for (int it = gw; it < 2048; it += NGW) qlat_item(win, mixn, wuk, (bf16*)(ws + WS_WIN), it, lane_);
}

__device__ __noinline__ void p0_prologue(const float* const* in_, float* out_, unsigned char* ws_, LAS unsigned char* lds_, int wave_, int vcu_, int G_) {
    const PC F{uni(in_), uni(out_), uni(ws_), uni_l(lds_), uni_i(wave_), uni_i(vcu_), uni_i(G_)}; struct { const float* const* in; } a{F.in};
    const int lane_ = lane_id_v();
    const int gw = F.vcu * NWAVES + F.wave, NGW = F.G * NWAVES;
    const float* x = a.in[0]; const float* mem = a.in[1];
    bf16* hb = (bf16*)(F.ws + WS_HB); float* ss = (float*)(F.ws + WS_SS); bf16* memn = (bf16*)(F.ws + WS_MEMN);
    for (int m = gw; m < M + MROWS; m += NGW) {
        const bool ismem = m >= M; const int r = ismem ? m - M : m;
        const GAS f32x4* xr = (const GAS f32x4*)((ismem ? mem : x) + (size_t)r * D) + lane_;
        f32x4 v[4]; float s = 0.f;
#pragma unroll
        for (int j = 0; j < 4; ++j) { v[j] = xr[64 * j]; s += (v[j].x * v[j].x + v[j].y * v[j].y) + (v[j].z * v[j].z + v[j].w * v[j].w); }
        s = wave_sum(s);
        float sc = 1.f;
        if (ismem) sc = 1.0f / sqrtf(s * (1.0f / D) + EPS);
        else if (lane_ < 4) ss[(size_t)r * 4 + lane_] = lane_ == 0 ? s : 0.f;
        GAS unsigned long long* o8 = (GAS unsigned long long*)((ismem ? memn : hb) + (size_t)r * D) + lane_;
#pragma unroll
        for (int j = 0; j < 4; ++j) o8[64 * j] = (unsigned long long)pk2(v[j].x * sc, v[j].y * sc) | ((unsigned long long)pk2(v[j].z * sc, v[j].w * sc) << 32);
    }
    LAS float* scr = (LAS float*)(F.lds + RING_OFF + F.wave * 17408);
    const int IM = items_of(D, 2 * CW);
    for (int it = gw; it < DEPTH * IM; it += NGW) { const int l = it / IM, r = it % IM;
        transpose_item(a.in[14] + (size_t)l * D * 2 * CW, D, 2 * CW, a.in[13] + (size_t)l * D, (bf16*)(F.ws + WS_WMEM), scr, r, lane_, MapId{l * 2 * CW}); }
    prep_layer_weights_body(F, 0);
}
__device__ __noinline__ void prep_layer_weights(const float* const* in_, float* out_, unsigned char* ws_, LAS unsigned char* lds_, int l, int wave_, int vcu_, int G_) {
    const PC F{uni(in_), uni(out_), uni(ws_), uni_l(lds_), uni_i(wave_), uni_i(vcu_), uni_i(G_)}; prep_layer_weights_body(F, uni_i(l));
}

__constant__ unsigned char T5_BUCKET[128] = {0, 1, 2, 3, 4, 5, 6, 7, 8, 9, 10, 11, 12, 13, 14, 15, 16, 16, 16, 17, 17, 18, 18, 18, 19, 19, 19, 20, 20, 20, 20, 21, 21, 21, 21, 22, 22, 22, 22, 22, 23, 23, 23, 23, 23, 23, 24, 24, 24, 24, 24, 24, 25, 25, 25, 25, 25, 25, 25, 26, 26, 26, 26, 26, 26, 26, 26, 27, 27, 27, 27, 27, 27, 27, 27, 27, 27, 28, 28, 28, 28, 28, 28, 28, 28, 28, 28, 29, 29, 29, 29, 29, 29, 29, 29, 29, 29, 29, 29, 30, 30, 30, 30, 30, 30, 30, 30, 30, 30, 30, 30, 30, 30, 31, 31, 31, 31, 31, 31, 31, 31, 31, 31, 31, 31, 31, 31, 31};

typedef short bf16x8_p __attribute__((ext_vector_type(8)));
__device__ __forceinline__ void prep_tokens(const float* const* in_, float* out_, unsigned char* ws_, LAS unsigned char* lds_, int l_, int wave_, int vcu_, int G_, int dry_) {
    const int dry = uni_i(dry_);
    const PC F{uni(in_), uni(out_), uni(ws_), uni_l(lds_), uni_i(wave_), uni_i(vcu_), uni_i(G_)}; struct { const float* const* in; } a{F.in}; const int l = uni_i(l_);
    unsigned char* ws = launder_p(F.ws);
    const float* ckvraw = (const float*)(ws + WS_CKVRAW); bf16* ckv = (bf16*)(ws + WS_CKV);
    const bf16* iqraw = (const bf16*)(ws + WS_IQRAW); bf16* iqf = (bf16*)(ws + WS_IQF); const float* iw = (const float*)(ws + WS_IW); unsigned* sgn = (unsigned*)(ws + WS_SGN);
    const bf16* z = (const bf16*)(ws + WS_Z); bf16* yb = (bf16*)(ws + WS_YB); bf16* qc = (bf16*)(ws + WS_QC);
    const bf16* memkv = (const bf16*)(ws + WS_MEMKV); const bf16* vT = (const bf16*)(ws + WS_VT); const bf16* wpT = (const bf16*)(ws + WS_WPT);
    const float* kvn = a.in[8] + (size_t)l * KVR; const float* pscale = a.in[12] + (size_t)l * PW_;
    const int lane = lane_id_v(), tid = F.wave * 64 + lane;
    const int tok = lane & 15, g4 = lane >> 4;
    LAS unsigned char* Ks = F.lds;
    LAS unsigned char* Vs = F.lds + 36864;
    for (int blk = F.vcu; blk < M / 128; blk += F.G) {
        const int rowb = blk * 128, b = rowb / SEQ, row0 = rowb + F.wave * 16;
#pragma unroll 1
        for (int tt = 0; tt < 16; ++tt) { const int row = row0 + tt;
            { const f32x2 v = *(const f32x2*)(ckvraw + (size_t)row * KVR + 2 * lane); const float q = wave_sum(v.x * v.x + v.y * v.y);
              const float rs = 1.0f / sqrtf(q * (1.0f / KVR) + EPS); const f32x2 g = *(const f32x2*)(kvn + 2 * lane);
              *(unsigned*)(ckv + (size_t)row * KVR + 2 * lane) = pk2(v.x * rs * g.x, v.y * rs * g.y); }
            { const float wv = iw[(size_t)row * IH + (lane >> 3)]; const float aw = fabsf(wv) * (1.0f / 16.0f);
              const v2u q = *(const v2u*)(iqraw + (size_t)row * 256 + 4 * lane);
              v2u o; o.x = pkh2(hlo(q.x) * aw, hhi(q.x) * aw); o.y = pkh2(hlo(q.y) * aw, hhi(q.y) * aw);
              *(v2u*)(iqf + (size_t)row * 256 + 4 * lane) = o;
              const unsigned long long bal = __ballot(wv < 0.f);
              unsigned mask = 0;
#pragma unroll
              for (int h = 0; h < 8; ++h) mask |= ((unsigned)(bal >> (8 * h)) & 1u) << h;
              if (lane == 0) sgn[row] = mask; } }
        { const int row = row0 + tok, spos = row % SEQ;
#pragma unroll 1
          for (int g = 0; g < 4; ++g) { const int w = 2 << g; const int cnt = (spos + 1) < w ? (spos + 1) : w; const float rc = 1.0f / (float)cnt;
              bf16x8_p pf[2];
#pragma unroll
              for (int ks = 0; ks < 2; ++ks) { const int c0 = g * 64 + 32 * ks + 8 * g4; float sum[8], z0[8];
#pragma unroll
                  for (int e = 0; e < 8; ++e) { sum[e] = 0.f; z0[e] = 0.f; }
                  for (int j = 0; j < w; ++j) { if (j < cnt) { const v4u v = *(const v4u*)(z + (size_t)(row - j) * 256 + c0);
                      const float f[8] = {bflo(v.x), bfhi(v.x), bflo(v.y), bfhi(v.y), bflo(v.z), bfhi(v.z), bflo(v.w), bfhi(v.w)};
#pragma unroll
                      for (int e = 0; e < 8; ++e) { sum[e] += f[e]; if (j == 0) z0[e] = f[e]; } } }
                  v4u pw; pw.x = pk2(sum[0] * rc - z0[0], sum[1] * rc - z0[1]); pw.y = pk2(sum[2] * rc - z0[2], sum[3] * rc - z0[3]); pw.z = pk2(sum[4] * rc - z0[4], sum[5] * rc - z0[5]); pw.w = pk2(sum[6] * rc - z0[6], sum[7] * rc - z0[7]);
                  pf[ks] = __builtin_bit_cast(bf16x8_p, pw); }
#pragma unroll
              for (int dt = 0; dt < 4; ++dt) { f32x4 acc = {0.f, 0.f, 0.f, 0.f};
#pragma unroll
                  for (int ks = 0; ks < 2; ++ks) { const bf16x8_p af = *(const bf16x8_p*)(wpT + (size_t)(g * 64 + 16 * dt + tok) * 64 + 32 * ks + 8 * g4); acc = __builtin_amdgcn_mfma_f32_16x16x32_bf16(af, pf[ks], acc, 0, 0, 0); }
                  const f32x4 ps = *(const f32x4*)(pscale + g * 64 + 16 * dt + 4 * g4);
                  v2u o; o.x = pk2(acc[0] * ps.x, acc[1] * ps.y); o.y = pk2(acc[2] * ps.z, acc[3] * ps.w);
                  *(v2u*)(yb + (size_t)row * 256 + g * 64 + 16 * dt + 4 * g4) = o; } } }
#pragma unroll 1
        for (int h = 0; h < CH; ++h) {
            __syncthreads();
#pragma unroll
            for (int e = 0; e < 4; ++e) { const int i = tid + 512 * e;
                { const int m = i >> 3, c = i & 7; const v4u v = *(const v4u*)(memkv + (size_t)(b * NMEM + m) * 2048 + l * 512 + h * 64 + c * 8); *(LAS v4u*)(Ks + m * 144 + c * 16) = v; }
                { const int d = i >> 5, c = i & 31; const v4u v = *(const v4u*)(vT + (size_t)(l * 512 + 256 + h * 64 + d) * MROWS + b * NMEM + c * 8); *(LAS v4u*)(Vs + d * 528 + c * 16) = v; } }
            LDS_WAIT(); __syncthreads();
            const int row = row0 + tok;
            bf16x8_p qf[2];
#pragma unroll
            for (int ks = 0; ks < 2; ++ks) qf[ks] = *(const bf16x8_p*)(qc + (size_t)row * 256 + h * 64 + 32 * ks + 8 * g4);
            f32x4 S[16]; float mx = -1e30f;
#pragma unroll
            for (int mt = 0; mt < 16; ++mt) { f32x4 acc = {0.f, 0.f, 0.f, 0.f};
#pragma unroll
                for (int ks = 0; ks < 2; ++ks) { const bf16x8_p kf = *(const LAS bf16x8_p*)(Ks + (16 * mt + tok) * 144 + (4 * ks + g4) * 16); acc = __builtin_amdgcn_mfma_f32_16x16x32_bf16(kf, qf[ks], acc, 0, 0, 0); }
                S[mt] = acc; mx = fmaxf(mx, fmaxf(fmaxf(acc[0], acc[1]), fmaxf(acc[2], acc[3]))); if ((mt & 3) == 3) __builtin_amdgcn_sched_barrier(0); }
            mx = fmaxf(mx, __shfl_xor(mx, 16)); mx = fmaxf(mx, __shfl_xor(mx, 32));
            float sm = 0.f;
#pragma unroll
            for (int mt = 0; mt < 16; ++mt)
#pragma unroll
                for (int r = 0; r < 4; ++r) { const float p = __expf((S[mt][r] - mx) * 0.125f); S[mt][r] = p; sm += p; }
            sm += __shfl_xor(sm, 16); sm += __shfl_xor(sm, 32);
            const float inv = 1.0f / sm;
            f32x4 oacc[4];
#pragma unroll
            for (int dt = 0; dt < 4; ++dt) oacc[dt] = (f32x4){0.f, 0.f, 0.f, 0.f};
#pragma unroll
            for (int kk = 0; kk < 8; ++kk) { v4u pw; pw.x = pg8::cvt_pk_bf16(S[2 * kk][0], S[2 * kk][1]); pw.y = pg8::cvt_pk_bf16(S[2 * kk][2], S[2 * kk][3]); pw.z = pg8::cvt_pk_bf16(S[2 * kk + 1][0], S[2 * kk + 1][1]); pw.w = pg8::cvt_pk_bf16(S[2 * kk + 1][2], S[2 * kk + 1][3]);
                const bf16x8_p pfr = __builtin_bit_cast(bf16x8_p, pw);
#pragma unroll
                for (int dt = 0; dt < 4; ++dt) { const LAS unsigned char* vp = Vs + (16 * dt + tok) * 528 + (32 * kk + 4 * g4) * 2;
                    const v2u lo = *(const LAS v2u*)vp, hi = *(const LAS v2u*)(vp + 32);
                    v4u vw; vw.x = lo.x; vw.y = lo.y; vw.z = hi.x; vw.w = hi.y;
                    oacc[dt] = __builtin_amdgcn_mfma_f32_16x16x32_bf16(__builtin_bit_cast(bf16x8_p, vw), pfr, oacc[dt], 0, 0, 0); }
                __builtin_amdgcn_sched_barrier(0); }
#pragma unroll
            for (int dt = 0; dt < 4; ++dt) { v2u o; o.x = pk2(oacc[dt][0] * inv, oacc[dt][1] * inv); o.y = pk2(oacc[dt][2] * inv, oacc[dt][3] * inv);
                if (!dry) *(v2u*)(qc + (size_t)row * 256 + h * 64 + 16 * dt + 4 * g4) = o; else asm volatile("" :: "v"(o.x), "v"(o.y)); }
        }
    }
    __syncthreads();
}

__device__ __forceinline__ unsigned key_of(float s) { const unsigned u = __builtin_bit_cast(unsigned, s); return (u & 0x80000000u) ? ~u : (u | 0x80000000u); }

typedef short bf16x8_t __attribute__((ext_vector_type(8)));
typedef short s16x4_t __attribute__((ext_vector_type(4)));
__device__ __forceinline__ void glds16(const void* gsrc, unsigned lds_dst) { unsigned keep;
    asm volatile("s_mov_b32 %0, m0\n\ts_mov_b32 m0, %2\n\ts_nop 0\n\tglobal_load_lds_dwordx4 %1, off\n\ts_mov_b32 m0, %0" : "=&s"(keep) : "v"(gsrc), "s"(lds_dst) : "memory"); }
typedef float f32x16 __attribute__((ext_vector_type(16)));
constexpr int SEL_CAP = 256;
constexpr int HSTR = 264;
constexpr int SL_HIST = 0, SL_SEL = 0, SL_CS = 32768, SL_CI = 98304, SL_KEYS = 131072, SL_ST = 147456;

#define SEL_DECLS \
    LAS unsigned char* const lds = uni_l(lds_); const int wave = uni_i(wave_), b = uni_i(b_), ub = uni_i(ub_); unsigned char* ws = uni(ws_); \
    const bf16* iqf = (const bf16*)(ws + WS_IQF); const unsigned* sgn = (const unsigned*)(ws + WS_SGN); const bf16* ik = (const bf16*)(ws + WS_IK); \
    const int lane = lane_id_v(), tid = wave * 64 + lane; const int kl = lane & 31, c5 = lane >> 5; \
    LAS unsigned* hist = (LAS unsigned*)(lds + SL_HIST); LAS unsigned short* lsel = (LAS unsigned short*)(lds + SL_SEL); LAS float* lcs = (LAS float*)(lds + SL_CS); \
    LAS unsigned short* lci = (LAS unsigned short*)(lds + SL_CI); LAS unsigned* st = (LAS unsigned*)(lds + SL_ST); LAS float* stf = (LAS float*)(lds + SL_ST); \
    const int t0 = ub * 64; const int q0 = b * SEQ + t0; const bf16* ikb = ik + (size_t)b * SEQ * IDIM; const int ntile = (t0 + 64 + 127) >> 7; \
    (void)hist; (void)lsel; (void)lcs; (void)lci; (void)stf; (void)tid;
#define SEL_LOAD_A \
    bf16x8_t af[2][2]; float sgc[2][16]; \
    { const int i = kl, a_ = i >> 3, cc_ = (i >> 2) & 1, e_ = i & 3; const int qq_ = 2 * cc_ + (a_ >> 1), hh_ = 4 * (a_ & 1) + e_; \
      _Pragma("unroll") for (int rt = 0; rt < 2; ++rt) { const unsigned flip_ = ((sgn[q0 + 8 * wave + 4 * rt + qq_] >> hh_) & 1u) ? 0x80008000u : 0u;     \
          _Pragma("unroll") for (int ks = 0; ks < 2; ++ks) { v4u w_ = *(const v4u*)(iqf + (size_t)(q0 + 8 * wave + 4 * rt + qq_) * 256 + hh_ * 32 + 16 * ks + 8 * c5); \
              w_.x ^= flip_; w_.y ^= flip_; w_.z ^= flip_; w_.w ^= flip_; af[rt][ks] = __builtin_bit_cast(bf16x8_t, w_); } } \
      _Pragma("unroll") for (int rt = 0; rt < 2; ++rt) _Pragma("unroll") for (int u = 0; u < 2; ++u) { const unsigned m_ = sgn[q0 + 8 * wave + 4 * rt + 2 * c5 + u]; \
          _Pragma("unroll") for (int h = 0; h < 8; ++h) sgc[rt][8 * u + h] = ((m_ >> h) & 1u) ? -__builtin_inff() : __builtin_inff(); } }
#define SEL_STAGE(kt_) do { const int key_ = 16 * wave + (lane >> 2); const int ch_ = (lane & 3) ^ ((key_ >> 2) & 3); \
    glds16(ikb + (size_t)(128 * (kt_) + key_) * IDIM + ch_ * 8, (unsigned)__builtin_amdgcn_readfirstlane((int)(unsigned)(size_t)(lds + SL_KEYS + ((kt_) & 1) * 8192 + wave * 1024))); } while (0)
#define SEL_MMA(acc_, rt_, kh_) do { acc_ = (f32x16){0.f,0.f,0.f,0.f,0.f,0.f,0.f,0.f,0.f,0.f,0.f,0.f,0.f,0.f,0.f,0.f}; \
    acc_ = __builtin_amdgcn_mfma_f32_32x32x16_f16(__builtin_bit_cast(f16x8_t, af[rt_][0]), __builtin_bit_cast(f16x8_t, bfr_[kh_][0]), acc_, 0, 0, 0); \
    acc_ = __builtin_amdgcn_mfma_f32_32x32x16_f16(__builtin_bit_cast(f16x8_t, af[rt_][1]), __builtin_bit_cast(f16x8_t, bfr_[kh_][1]), acc_, 0, 0, 0); } while (0)
#define SEL_SUM(acc_, rt_, kh_) do { _Pragma("unroll") for (int u = 0; u < 2; ++u) { float s_ = 0.f; \
    _Pragma("unroll") for (int h = 0; h < 8; ++h) s_ += __builtin_amdgcn_fmed3f(acc_[8 * u + h], 0.f, sgc[rt_][8 * u + h]); \
    sc[rt_][kh_][u] = s_; } } while (0)
#define SEL_SCORES(kt_) do { const LAS unsigned char* kb_ = lds + SL_KEYS + ((kt_) & 1) * 8192; bf16x8_t bfr_[4][2]; \
    _Pragma("unroll") for (int kh = 0; kh < 4; ++kh) { const int key_ = 32 * kh + kl; \
        bfr_[kh][0] = *(const LAS bf16x8_t*)(kb_ + key_ * 64 + 16 * ((0 + c5) ^ ((key_ >> 2) & 3))); \
        bfr_[kh][1] = *(const LAS bf16x8_t*)(kb_ + key_ * 64 + 16 * ((2 + c5) ^ ((key_ >> 2) & 3))); } \
    f32x16 accA_, accB_; \
    SEL_MMA(accA_, 0, 0); \
    SEL_MMA(accB_, 1, 0); __builtin_amdgcn_sched_barrier(0); SEL_SUM(accA_, 0, 0); __builtin_amdgcn_sched_barrier(0); \
    SEL_MMA(accA_, 0, 1); __builtin_amdgcn_sched_barrier(0); SEL_SUM(accB_, 1, 0); __builtin_amdgcn_sched_barrier(0); \
    SEL_MMA(accB_, 1, 1); __builtin_amdgcn_sched_barrier(0); SEL_SUM(accA_, 0, 1); __builtin_amdgcn_sched_barrier(0); \
    SEL_MMA(accA_, 0, 2); __builtin_amdgcn_sched_barrier(0); SEL_SUM(accB_, 1, 1); __builtin_amdgcn_sched_barrier(0); \
    SEL_MMA(accB_, 1, 2); __builtin_amdgcn_sched_barrier(0); SEL_SUM(accA_, 0, 2); __builtin_amdgcn_sched_barrier(0); \
    SEL_MMA(accA_, 0, 3); __builtin_amdgcn_sched_barrier(0); SEL_SUM(accB_, 1, 2); __builtin_amdgcn_sched_barrier(0); \
    SEL_MMA(accB_, 1, 3); __builtin_amdgcn_sched_barrier(0); SEL_SUM(accA_, 0, 3); __builtin_amdgcn_sched_barrier(0); \
    SEL_SUM(accB_, 1, 3); } while (0)
#define SEL_BOUNDARY(FINAL) do { \
    const int qq = tid >> 3, part = tid & 7; const LAS v4u* hp = (const LAS v4u*)(hist + qq * HSTR + 32 * part); \
    unsigned bins[32]; \
    _Pragma("unroll") for (int i = 0; i < 8; ++i) { const v4u v = hp[i]; bins[4 * i] = v.x; bins[4 * i + 1] = v.y; bins[4 * i + 2] = v.z; bins[4 * i + 3] = v.w; } \
    unsigned ps = 0; \
    _Pragma("unroll") for (int i = 0; i < 32; ++i) ps += bins[i]; \
    unsigned v = ps, tt; \
    tt = __shfl_down(v, 1, 8); if (part + 1 < 8) v += tt; \
    tt = __shfl_down(v, 2, 8); if (part + 2 < 8) v += tt; \
    tt = __shfl_down(v, 4, 8); if (part + 4 < 8) v += tt; \
    unsigned cacc = v - ps; \
    if (cacc < (unsigned)TOPK && v >= (unsigned)TOPK) { int bsel = 0; unsigned na = 0, cb = 0; bool found = false; \
        _Pragma("unroll") for (int i = 31; i >= 0; --i) { const bool hit = !found && (cacc + bins[i] >= (unsigned)TOPK); if (hit) { bsel = i; na = cacc; cb = bins[i]; found = true; } cacc += bins[i]; } \
        st[128 + qq] = (unsigned)(32 * part + bsel); if (FINAL) { st[192 + qq] = na; st[256 + qq] = cb; st[448 + qq] = cb > (unsigned)SEL_CAP ? 1u : 0u; } } } while (0)

__device__ __forceinline__ void sel_pass1(unsigned char* ws_, LAS unsigned char* lds_, int wave_, int b_, int ub_) {
    SEL_DECLS
    unsigned short* sel = (unsigned short*)(ws + WS_SEL);
    __syncthreads();
    if (ub < 4) {
        for (int i = tid; i < 64 * TOPK; i += NWAVES * 64) { const int qq = i >> 8, sl = i & 255; sel[(size_t)(q0 + qq) * TOPK + sl] = (unsigned short)(sl <= t0 + qq ? sl : 0); }
        if (tid == 0) st[512] = 1u;
        asm volatile("s_waitcnt vmcnt(0) lgkmcnt(0)" ::: "memory"); __syncthreads();
        return;
    }
    SEL_LOAD_A
    for (int i = tid; i < 64 * HSTR; i += NWAVES * 64) hist[i] = 0u;
    if (tid < 64) { st[128 + tid] = 0u; st[448 + tid] = 0u; }
    if (tid == 0) st[512] = 0u;
    float sc[2][4][2];
    float scl[2][2]; int bcur[2][2];
#pragma unroll
    for (int rt = 0; rt < 2; ++rt)
#pragma unroll
        for (int u = 0; u < 2; ++u) { scl[rt][u] = 0.f; bcur[rt][u] = 0; }
    SEL_STAGE(0);
#pragma unroll 1
    for (int kt = 0; kt < ntile; ++kt) {
        asm volatile("s_waitcnt vmcnt(0) lgkmcnt(0)" ::: "memory"); __syncthreads();
        if (kt > 0 && (kt & 3) == 0) {
            SEL_BOUNDARY(false);
            asm volatile("s_waitcnt lgkmcnt(0)" ::: "memory"); __syncthreads();
#pragma unroll
            for (int rt = 0; rt < 2; ++rt)
#pragma unroll
                for (int u = 0; u < 2; ++u) bcur[rt][u] = (int)st[128 + 8 * wave + 4 * rt + 2 * c5 + u];
        }
        if (kt + 1 < ntile) SEL_STAGE(kt + 1);
        SEL_SCORES(kt);
        if (kt == 0) {
#pragma unroll
            for (int rt = 0; rt < 2; ++rt)
#pragma unroll
                for (int u = 0; u < 2; ++u) { float mx = 0.f;
#pragma unroll
                    for (int kh = 0; kh < 4; ++kh) mx = fmaxf(mx, fabsf(sc[rt][kh][u]));
#pragma unroll
                    for (int o = 1; o < 32; o <<= 1) mx = fmaxf(mx, __shfl_xor(mx, o));
                    const float R = mx > 0.f ? mx : 1.0f;
                    scl[rt][u] = 128.0f / R;
                    if (kl == 0) stf[8 * wave + 4 * rt + 2 * c5 + u] = scl[rt][u]; }
        }
        const bool masked = 128 * kt + 127 > t0;
#pragma unroll
        for (int rt = 0; rt < 2; ++rt)
#pragma unroll
            for (int u = 0; u < 2; ++u) { const int qq = 8 * wave + 4 * rt + 2 * c5 + u; const int lim = masked ? (t0 + qq - 128 * kt - kl) : 1000;
#pragma unroll
                for (int kh = 0; kh < 4; ++kh) { const float fb = __builtin_amdgcn_fmed3f(fmaf(sc[rt][kh][u], scl[rt][u], 128.0f), 0.f, 255.f);
                    if (fb >= (float)bcur[rt][u] && 32 * kh <= lim) (void)__hip_atomic_fetch_add(hist + qq * HSTR + (int)fb, 1u, __ATOMIC_RELAXED, __HIP_MEMORY_SCOPE_WORKGROUP); } }
    }
    asm volatile("s_waitcnt vmcnt(0) lgkmcnt(0)" ::: "memory"); __syncthreads();
    SEL_BOUNDARY(true);
    if (tid < 64) { st[320 + tid] = 0u; st[384 + tid] = 0u; }
    asm volatile("s_waitcnt lgkmcnt(0)" ::: "memory"); __syncthreads();
}
__device__ __forceinline__ void sel_pass2(unsigned char* ws_, LAS unsigned char* lds_, int wave_, int b_, int ub_) {
    SEL_DECLS
    if (st[512] != 0u) return;
    if (tid < 64) { st[320 + tid] = 0u; st[384 + tid] = 0u; }
    SEL_LOAD_A
    float sc[2][4][2];
    float scl[2][2]; int bcur[2][2];
#pragma unroll
    for (int rt = 0; rt < 2; ++rt)
#pragma unroll
        for (int u = 0; u < 2; ++u) { const int qq = 8 * wave + 4 * rt + 2 * c5 + u; scl[rt][u] = stf[qq]; bcur[rt][u] = (int)st[128 + qq]; }
    SEL_STAGE(0);
#pragma unroll 1
    for (int kt = 0; kt < ntile; ++kt) {
        asm volatile("s_waitcnt vmcnt(0) lgkmcnt(0)" ::: "memory"); __syncthreads();
        if (kt + 1 < ntile) SEL_STAGE(kt + 1);
        SEL_SCORES(kt);
        const bool masked = 128 * kt + 127 > t0;
        unsigned okm = 0u, abm = 0u; unsigned basea[2][2], basec[2][2];
#pragma unroll
        for (int rt = 0; rt < 2; ++rt)
#pragma unroll
            for (int u = 0; u < 2; ++u) { const int qq = 8 * wave + 4 * rt + 2 * c5 + u; const int lim = masked ? (t0 + qq - 128 * kt - kl) : 1000; unsigned na_ = 0u, nc_ = 0u;
#pragma unroll
                for (int kh = 0; kh < 4; ++kh) { const float fb = __builtin_amdgcn_fmed3f(fmaf(sc[rt][kh][u], scl[rt][u], 128.0f), 0.f, 255.f);
                    const bool ok = fb >= (float)bcur[rt][u] && 32 * kh <= lim; const bool ab = fb >= (float)(bcur[rt][u] + 1);
                    if (ok) { okm |= 1u << (rt * 8 + u * 4 + kh); if (ab) { abm |= 1u << (rt * 8 + u * 4 + kh); ++na_; } else ++nc_; } }
                basea[rt][u] = 0u; basec[rt][u] = 0u;
                if (na_) basea[rt][u] = __hip_atomic_fetch_add(st + 320 + qq, na_, __ATOMIC_RELAXED, __HIP_MEMORY_SCOPE_WORKGROUP);
                if (nc_) basec[rt][u] = __hip_atomic_fetch_add(st + 384 + qq, nc_, __ATOMIC_RELAXED, __HIP_MEMORY_SCOPE_WORKGROUP); }
        if (okm != 0u) {
#pragma unroll
            for (int rt = 0; rt < 2; ++rt)
#pragma unroll
                for (int u = 0; u < 2; ++u) { const int qq = 8 * wave + 4 * rt + 2 * c5 + u; unsigned sa = basea[rt][u], scn = basec[rt][u];
#pragma unroll
                    for (int kh = 0; kh < 4; ++kh) { const int bit = rt * 8 + u * 4 + kh; const int kpos = 128 * kt + 32 * kh + kl;
                        if ((okm >> bit) & 1u) {
                            if ((abm >> bit) & 1u) { if (sa < (unsigned)TOPK) lsel[qq * 256 + sa] = (unsigned short)kpos; ++sa; }
                            else { if (scn < (unsigned)SEL_CAP) { lcs[qq * SEL_CAP + scn] = sc[rt][kh][u]; lci[qq * SEL_CAP + scn] = (unsigned short)kpos; } ++scn; } } } }
        }
    }
    asm volatile("s_waitcnt vmcnt(0) lgkmcnt(0)" ::: "memory"); __syncthreads();
}
__device__ __forceinline__ void sel_resolve(unsigned char* ws_, LAS unsigned char* lds_, int wave_, int b_, int ub_, int wg_, int first_) {
    SEL_DECLS
    const int wg = uni_i(wg_), first = uni_i(first_);
    unsigned short* sel = (unsigned short*)(ws + WS_SEL);
    gu32* slowl = (gu32*)(ws + WS_CTL + 65536) + (size_t)wg * 132;
    if (first && tid == 0) __hip_atomic_store(slowl, 0u, RLX_AGENT);
    if (st[512] != 0u) return;
#pragma unroll 1
    for (int qi = 0; qi < 8; ++qi) { const int qq = 8 * wave + qi; const int q = q0 + qq;
        const int na = (int)st[192 + qq], need = TOPK - na; int C = (int)st[384 + qq]; C = C < SEL_CAP ? C : SEL_CAP;
        const bool slow = st[448 + qq] != 0u;
        if (!slow) {
            LAS unsigned* sh = (LAS unsigned*)(lds + SL_KEYS + wave * 2048); LAS float* sls = (LAS float*)(lds + SL_KEYS + wave * 2048 + 256); LAS unsigned short* sli = (LAS unsigned short*)(lds + SL_KEYS + wave * 2048 + 1280);
            const float sclq = stf[qq]; const float fbase = (float)(int)st[128 + qq];
            sh[lane] = 0u;
            float cs[SEL_CAP / 64]; int ci[SEL_CAP / 64], sb[SEL_CAP / 64];
#pragma unroll
            for (int e = 0; e < SEL_CAP / 64; ++e) { const int i = lane + 64 * e; cs[e] = 0.f; ci[e] = 0; sb[e] = -1;
                if (i < C) { cs[e] = lcs[qq * SEL_CAP + i]; ci[e] = lci[qq * SEL_CAP + i];
                    const float fr_ = (fmaf(cs[e], sclq, 128.0f) - fbase) * 64.0f; sb[e] = (int)__builtin_amdgcn_fmed3f(fr_, 0.f, 63.f); } }
            LDS_WAIT();
#pragma unroll
            for (int e = 0; e < SEL_CAP / 64; ++e) if (sb[e] >= 0) (void)__hip_atomic_fetch_add(sh + sb[e], 1u, __ATOMIC_RELAXED, __HIP_MEMORY_SCOPE_WORKGROUP);
            LDS_WAIT();
            const unsigned cl = sh[lane];
            unsigned v = cl, tt;
            tt = __shfl_down(v, 1); if (lane + 1 < 64) v += tt;
            tt = __shfl_down(v, 2); if (lane + 2 < 64) v += tt;
            tt = __shfl_down(v, 4); if (lane + 4 < 64) v += tt;
            tt = __shfl_down(v, 8); if (lane + 8 < 64) v += tt;
            tt = __shfl_down(v, 16); if (lane + 16 < 64) v += tt;
            tt = __shfl_down(v, 32); if (lane + 32 < 64) v += tt;
            const unsigned ab_ = v - cl;
            const unsigned long long cross = __ballot(ab_ < (unsigned)need && v >= (unsigned)need);
            const int sstar = cross ? (int)__builtin_ctzll(cross) : 0;
            const int na2 = (int)__shfl(ab_, sstar);
            const int need2 = need - na2;
            int base = na; int nsub = 0;
#pragma unroll
            for (int e = 0; e < SEL_CAP / 64; ++e) { const bool up = sb[e] > sstar; const bool eq = sb[e] == sstar;
                const unsigned long long bu = __ballot(up), be = __ballot(eq);
                const unsigned long long lt = (lane == 0) ? 0ull : (~0ull >> (64 - lane));
                if (up) lsel[qq * 256 + base + (int)__builtin_popcountll(bu & lt)] = (unsigned short)ci[e];
                if (eq) { const int p_ = nsub + (int)__builtin_popcountll(be & lt); sls[p_] = cs[e]; sli[p_] = (unsigned short)ci[e]; }
                base += (int)__builtin_popcountll(bu); nsub += (int)__builtin_popcountll(be); }
            LDS_WAIT();
#pragma unroll 1
            for (int i0 = 0; i0 < nsub; i0 += 64) { const int i = i0 + lane;
                if (i < nsub) { const float si = sls[i]; const int ii = sli[i]; int rank = 0;
                    for (int jx = 0; jx < nsub; ++jx) { const float sj = sls[jx]; const int ij = sli[jx]; rank += (sj > si || (sj == si && ij < ii)) ? 1 : 0; }
                    if (rank < need2) lsel[qq * 256 + na + na2 + rank] = (unsigned short)ii; } }
            LDS_WAIT();
            *(v2u*)(sel + (size_t)q * TOPK + 4 * lane) = *(const LAS v2u*)(lsel + qq * 256 + 4 * lane);
        }
    }
    __syncthreads();
    if (tid == 0) { unsigned n = first ? 0u : __hip_atomic_load(slowl, RLX_AGENT);
        for (int qq = 0; qq < 64; ++qq) if (st[448 + qq] != 0u) { if (n < 128u) { __hip_atomic_store(slowl + 1 + n, (unsigned)(q0 + qq), RLX_AGENT); ++n; } }
        __hip_atomic_store(slowl, n, RLX_AGENT); }
    asm volatile("s_waitcnt vmcnt(0)" ::: "memory");
    __syncthreads();
}
#undef SEL_DECLS
#undef SEL_LOAD_A
#undef SEL_STAGE
#undef SEL_SCORES
#undef SEL_MMA
#undef SEL_SUM
#undef SEL_BOUNDARY
__device__ __forceinline__ void dsa_select_slow(unsigned char* ws_, LAS unsigned char* lds_, int wave_, int wg_) {
    LAS unsigned char* const lds = uni_l(lds_); const int wave = uni_i(wave_), wg = uni_i(wg_);
    unsigned char* ws = uni(ws_);
    const bf16* iqf = (const bf16*)(ws + WS_IQF); const unsigned* sgn = (const unsigned*)(ws + WS_SGN); const bf16* ik = (const bf16*)(ws + WS_IK);
    unsigned short* sel = (unsigned short*)(ws + WS_SEL);
    gu32* slowl = (gu32*)(ws + WS_CTL + 65536) + (size_t)wg * 132;
    const int lane = lane_id_v(), tid = wave * 64 + lane; const int kl = lane & 31, c5 = lane >> 5;
    LAS unsigned* keys = (LAS unsigned*)lds;
    LAS unsigned* hist = (LAS unsigned*)(lds + 32768);
    LAS unsigned* ctl = (LAS unsigned*)(lds + 40960);
    const int nq = (int)__builtin_amdgcn_readfirstlane(__hip_atomic_load(slowl, RLX_AGENT));
#pragma unroll 1
    for (int k = 0; k < nq; ++k) {
        const int q = (int)__builtin_amdgcn_readfirstlane(__hip_atomic_load(slowl + 1 + k, RLX_AGENT));
        const int b = q / SEQ, t = q % SEQ, n = t + 1;
        const bf16* ikb = ik + (size_t)b * SEQ * IDIM;
        __syncthreads();
        bf16x8_t af[2]; float sgc[8];
        { const int i = kl, a_ = i >> 3, e_ = i & 3; const int hh_ = 4 * (a_ & 1) + e_; const unsigned m_ = sgn[q];
          const unsigned flip_ = ((m_ >> hh_) & 1u) ? 0x80008000u : 0u;
#pragma unroll
          for (int ks = 0; ks < 2; ++ks) { v4u w_ = *(const v4u*)(iqf + (size_t)q * 256 + hh_ * 32 + 16 * ks + 8 * c5); w_.x ^= flip_; w_.y ^= flip_; w_.z ^= flip_; w_.w ^= flip_; af[ks] = __builtin_bit_cast(bf16x8_t, w_); }
#pragma unroll
          for (int h = 0; h < 8; ++h) sgc[h] = ((m_ >> h) & 1u) ? -__builtin_inff() : __builtin_inff(); }
#pragma unroll 1
        for (int kb0 = wave; kb0 * 32 < n; kb0 += 4 * NWAVES) {
            bf16x8_t kb_[4][2];
#pragma unroll
            for (int j = 0; j < 4; ++j) { int key = 32 * (kb0 + j * NWAVES) + kl; key = key < SEQ ? key : SEQ - 1;
                kb_[j][0] = *(const bf16x8_t*)(ikb + (size_t)key * IDIM + 8 * c5); kb_[j][1] = *(const bf16x8_t*)(ikb + (size_t)key * IDIM + 16 + 8 * c5); }
#pragma unroll
            for (int j = 0; j < 4; ++j) { const int key = 32 * (kb0 + j * NWAVES) + kl;
                f32x16 acc = {0.f,0.f,0.f,0.f,0.f,0.f,0.f,0.f,0.f,0.f,0.f,0.f,0.f,0.f,0.f,0.f};
                acc = __builtin_amdgcn_mfma_f32_32x32x16_f16(__builtin_bit_cast(f16x8_t, af[0]), __builtin_bit_cast(f16x8_t, kb_[j][0]), acc, 0, 0, 0); acc = __builtin_amdgcn_mfma_f32_32x32x16_f16(__builtin_bit_cast(f16x8_t, af[1]), __builtin_bit_cast(f16x8_t, kb_[j][1]), acc, 0, 0, 0);
                float sc = 0.f;
#pragma unroll
                for (int h = 0; h < 8; ++h) sc += __builtin_amdgcn_fmed3f(acc[h], 0.f, sgc[h]);
                if (c5 == 0 && key < SEQ) keys[key] = key_of(sc); } }
        if (tid == 0) { const unsigned z_ = (unsigned)launder_v(0); ctl[0] = z_; ctl[1] = z_ + (unsigned)TOPK; ctl[2] = z_; ctl[3] = z_; }
        unsigned P = 0u, Plo = 0u;
#pragma unroll 1
        for (int lev = 0; lev < 5; ++lev) {
            for (int i = tid; i < 2048; i += NWAVES * 64) hist[i] = 0u;
            asm volatile("s_waitcnt lgkmcnt(0)" ::: "memory"); __syncthreads();
#pragma unroll 1
            for (int i = 0; i < 16; ++i) { const int s_ = tid * 16 + i;
                if (s_ < n) { const unsigned hi = keys[s_], lo = 8191u - (unsigned)s_; bool mt; unsigned dg;
                    if (lev == 0) { mt = true; dg = hi >> 21; } else if (lev == 1) { mt = (hi >> 21) == P; dg = (hi >> 10) & 0x7ffu; } else if (lev == 2) { mt = (hi >> 10) == P; dg = hi & 0x3ffu; }
                    else if (lev == 3) { mt = hi == P; dg = lo >> 6; } else { mt = hi == P && (lo >> 6) == Plo; dg = lo & 63u; }
                    if (mt) (void)__hip_atomic_fetch_add(hist + dg, 1u, __ATOMIC_RELAXED, __HIP_MEMORY_SCOPE_WORKGROUP); } }
            asm volatile("s_waitcnt lgkmcnt(0)" ::: "memory"); __syncthreads();
            const unsigned need = ctl[1];
            const v4u hb = *(const LAS v4u*)(hist + 4 * tid); const unsigned ls = hb.x + hb.y + hb.z + hb.w;
            unsigned v = ls, tt;
            tt = __shfl_down(v, 1); if (lane + 1 < 64) v += tt;
            tt = __shfl_down(v, 2); if (lane + 2 < 64) v += tt;
            tt = __shfl_down(v, 4); if (lane + 4 < 64) v += tt;
            tt = __shfl_down(v, 8); if (lane + 8 < 64) v += tt;
            tt = __shfl_down(v, 16); if (lane + 16 < 64) v += tt;
            tt = __shfl_down(v, 32); if (lane + 32 < 64) v += tt;
            if (lane == 0) ctl[8 + wave] = v;
            asm volatile("s_waitcnt lgkmcnt(0)" ::: "memory"); __syncthreads();
            unsigned above = v - ls;
            for (int w2 = wave + 1; w2 < NWAVES; ++w2) above += ctl[8 + w2];
            if (above < need && above + ls >= need) { unsigned c = above; const unsigned bb[4] = {hb.x, hb.y, hb.z, hb.w}; int bsel = 0; unsigned cab = 0; bool found = false;
#pragma unroll
                for (int i = 3; i >= 0; --i) { const bool hit = !found && (c + bb[i] >= need); if (hit) { bsel = i; cab = c; found = true; } c += bb[i]; }
                const unsigned dv = (unsigned)(4 * tid + bsel);
                if (lev == 0) ctl[0] = dv; else if (lev == 1) ctl[0] = (P << 11) | dv; else if (lev == 2) ctl[0] = (P << 10) | dv; else if (lev == 3) ctl[3] = dv; else ctl[3] = (Plo << 6) | dv;
                ctl[1] = need - cab; ctl[4] = bb[bsel]; }
            asm volatile("s_waitcnt lgkmcnt(0)" ::: "memory"); __syncthreads();
            P = ctl[0]; Plo = ctl[3];
            if (lev == 2 && ctl[1] == ctl[4]) break;
        }
        unsigned short* srow = sel + (size_t)q * TOPK;
        unsigned mymask = 0u;
#pragma unroll 1
        for (int i = 0; i < 16; ++i) { const int s_ = tid * 16 + i;
            if (s_ < n) { const unsigned hi = keys[s_], lo = 8191u - (unsigned)s_; if (hi > P || (hi == P && lo >= Plo)) mymask |= 1u << i; } }
        const unsigned mycnt = (unsigned)__builtin_popcount(mymask);
        unsigned pv_ = mycnt, tt_;
        tt_ = __shfl_up(pv_, 1); if (lane >= 1) pv_ += tt_;
        tt_ = __shfl_up(pv_, 2); if (lane >= 2) pv_ += tt_;
        tt_ = __shfl_up(pv_, 4); if (lane >= 4) pv_ += tt_;
        tt_ = __shfl_up(pv_, 8); if (lane >= 8) pv_ += tt_;
        tt_ = __shfl_up(pv_, 16); if (lane >= 16) pv_ += tt_;
        tt_ = __shfl_up(pv_, 32); if (lane >= 32) pv_ += tt_;
        if (lane == 63) ctl[16 + wave] = pv_;
        asm volatile("s_waitcnt lgkmcnt(0)" ::: "memory"); __syncthreads();
        unsigned slot0 = pv_ - mycnt;
        for (int w2 = 0; w2 < wave; ++w2) slot0 += ctl[16 + w2];
#pragma unroll 1
        for (int i = 0; i < 16; ++i) if ((mymask >> i) & 1u) { if (slot0 < (unsigned)TOPK) srow[slot0] = (unsigned short)(tid * 16 + i); ++slot0; }
    }
    asm volatile("s_waitcnt vmcnt(0) lgkmcnt(0)" ::: "memory");
    __syncthreads();
}

__device__ __forceinline__ unsigned offb(unsigned row, unsigned ch) { return 256u * row + 16u * (ch ^ (((row & 3u) << 2) | ((row >> 2) & 3u))); }
__device__ __forceinline__ s16x4_t vtr(const LAS unsigned char* p) { return __builtin_bit_cast(s16x4_t, __builtin_amdgcn_ds_read_tr16_b64_v4i16((LAS s16x4_t*)p)); }

__device__ __noinline__ void dsa_attend(unsigned char* ws_, LAS unsigned char* lds_, const float* relb_, int wave_, int vcu_, int G_, int dry_) {
    const int dry = uni_i(dry_);
    LAS unsigned char* const lds = uni_l(lds_); const int wave = uni_i(wave_), vcu = uni_i(vcu_), G = uni_i(G_);
    unsigned char* ws = uni(ws_); const float* relb = uni(relb_);
    const bf16* ckv = (const bf16*)(ws + WS_CKV); bf16* ql = (bf16*)(ws + WS_QL); const unsigned short* sel = (const unsigned short*)(ws + WS_SEL);
    const int lane = lane_id_v(), tid = wave * 64 + lane;
    LAS unsigned char* cb = lds + wave * 16384;
    LAS unsigned short* sidx = (LAS unsigned short*)(lds + 131072 + wave * 512);
    LAS float* biasd = (LAS float*)(lds + 135168);
    for (int i = tid; i < 129 * 8; i += NWAVES * 64) { const int d = i >> 3, h = i & 7; const int bk = d < 128 ? (int)T5_BUCKET[d] : 31; biasd[i] = relb[bk * 8 + h]; }
    __syncthreads();
    const int hl = lane & 15, g = lane >> 4, hq = hl & 7;
    for (int p = vcu; p < BATCH * 64; p += G) {
        const int b = p >> 6, j = p & 63;
#pragma unroll 1
        for (int half = 0; half < 2; ++half) {
            const int ub = half == 0 ? j : 127 - j;
#pragma unroll 1
            for (int qi = 0; qi < 8; ++qi) {
                const int t = ub * 64 + wave * 8 + qi; const int q = b * SEQ + t; const int nsel = (t + 1) < TOPK ? (t + 1) : TOPK;
                const bf16* ckvb = ckv + (size_t)b * SEQ * KVR; bf16* qlrow = ql + (size_t)q * 1024;
                { const v2u w = *(const v2u*)(sel + (size_t)q * TOPK + 4 * lane); *(LAS v2u*)(sidx + 4 * lane) = w; }
                bf16x8_t qf[4];
#pragma unroll
                for (int s = 0; s < 4; ++s) qf[s] = *(const bf16x8_t*)(qlrow + hq * 128 + 32 * s + 8 * g);
                LDS_WAIT();
                float mrun = -1e30f, lsum = 0.f;
                f32x4 O[8];
#pragma unroll
                for (int c = 0; c < 8; ++c) O[c] = (f32x4){0.f, 0.f, 0.f, 0.f};
#define DSA_GATHER(c_) do { LAS unsigned char* dst_ = cb + ((c_) & 1) * 8192; \
                    _Pragma("unroll") for (int k_ = 0; k_ < 8; ++k_) { const int row_ = 4 * k_ + g; const int kidx_ = sidx[32 * (c_) + row_]; \
                        const int ch_ = hl ^ ((g << 2) | (k_ & 3)); \
                        glds16(ckvb + (size_t)kidx_ * KVR + ch_ * 8, (unsigned)__builtin_amdgcn_readfirstlane((int)(unsigned)(size_t)(dst_ + k_ * 1024))); } } while (0)
                DSA_GATHER(0);
#pragma unroll 1
                for (int c = 0; c < 8; ++c) {
                    if (c < 7) { DSA_GATHER(c + 1); asm volatile("s_waitcnt vmcnt(8)" ::: "memory"); }
                    else asm volatile("s_waitcnt vmcnt(0)" ::: "memory");
                    const LAS unsigned char* img = cb + (c & 1) * 8192;
                    f32x4 S[2];
#pragma unroll
                    for (int rb = 0; rb < 2; ++rb) { S[rb] = (f32x4){0.f, 0.f, 0.f, 0.f}; const unsigned row = 8u * (hl >> 2) + 4u * rb + (hl & 3);
#pragma unroll
                        for (int s = 0; s < 4; ++s) { const bf16x8_t af = *(const LAS bf16x8_t*)(img + offb(row, 4 * s + g)); S[rb] = __builtin_amdgcn_mfma_f32_16x16x32_bf16(af, qf[s], S[rb], 0, 0, 0); } }
                    float pv[2][4]; float mx = -1e30f;
#pragma unroll
                    for (int rb = 0; rb < 2; ++rb) { const v2u iw2 = *(const LAS v2u*)(sidx + 32 * c + 8 * g + 4 * rb);
                        const int ki[4] = {(int)(iw2.x & 0xffffu), (int)(iw2.x >> 16), (int)(iw2.y & 0xffffu), (int)(iw2.y >> 16)};
#pragma unroll
                        for (int r = 0; r < 4; ++r) { int dist = t - ki[r]; dist = dist < 0 ? 0 : (dist > 128 ? 128 : dist);
                            float lg = S[rb][r] * 0.125f + biasd[dist * 8 + hq];
                            if (32 * c + 8 * g + 4 * rb + r >= nsel) lg = -1e30f;
                            pv[rb][r] = lg; mx = fmaxf(mx, lg); } }
                    mx = fmaxf(mx, __shfl_xor(mx, 16)); mx = fmaxf(mx, __shfl_xor(mx, 32));
                    const float mnew = fmaxf(mrun, mx); const float alpha = __expf(mrun - mnew); mrun = mnew;
                    float rs = 0.f;
#pragma unroll
                    for (int rb = 0; rb < 2; ++rb)
#pragma unroll
                        for (int r = 0; r < 4; ++r) { pv[rb][r] = __expf(pv[rb][r] - mnew); rs += pv[rb][r]; }
                    rs += __shfl_xor(rs, 16); rs += __shfl_xor(rs, 32);
                    lsum = lsum * alpha + rs;
                    v4u pw; pw.x = pg8::cvt_pk_bf16(pv[0][0], pv[0][1]); pw.y = pg8::cvt_pk_bf16(pv[0][2], pv[0][3]); pw.z = pg8::cvt_pk_bf16(pv[1][0], pv[1][1]); pw.w = pg8::cvt_pk_bf16(pv[1][2], pv[1][3]);
                    const bf16x8_t pf = __builtin_bit_cast(bf16x8_t, pw);
                    float al[4];
#pragma unroll
                    for (int r = 0; r < 4; ++r) al[r] = __shfl(alpha, 4 * g + r);
#pragma unroll
                    for (int cd = 0; cd < 8; ++cd) {
                        f32x4 o = O[cd]; o[0] *= al[0]; o[1] *= al[1]; o[2] *= al[2]; o[3] *= al[3];
                        const unsigned q4 = hl >> 2, p4 = hl & 3;
                        const s16x4_t b0 = vtr(img + offb(8u * g + q4, 2 * cd + (p4 >> 1)) + 8u * (p4 & 1));
                        const s16x4_t b1 = vtr(img + offb(8u * g + 4u + q4, 2 * cd + (p4 >> 1)) + 8u * (p4 & 1));
                        bf16x8_t bf; bf[0] = b0[0]; bf[1] = b0[1]; bf[2] = b0[2]; bf[3] = b0[3]; bf[4] = b1[0]; bf[5] = b1[1]; bf[6] = b1[2]; bf[7] = b1[3];
                        O[cd] = __builtin_amdgcn_mfma_f32_16x16x32_bf16(pf, bf, o, 0, 0, 0);
                    }
                }
#undef DSA_GATHER
                const float linv = 1.0f / lsum; float li[4];
#pragma unroll
                for (int r = 0; r < 4; ++r) li[r] = __shfl(linv, 4 * g + r);
                LAS unsigned short* ost = (LAS unsigned short*)cb;
                if (g < 2) {
#pragma unroll
                    for (int cd = 0; cd < 8; ++cd)
#pragma unroll
                        for (int r = 0; r < 4; ++r) ost[(4 * g + r) * 128 + 16 * cd + hl] = (unsigned short)f2bf(O[cd][r] * li[r]);
                }
                LDS_WAIT();
                { const v4u w0 = *(const LAS v4u*)(cb + 32 * lane), w1 = *(const LAS v4u*)(cb + 32 * lane + 16);
                  if (!dry) { *(v4u*)(qlrow + 16 * lane) = w0; *(v4u*)(qlrow + 16 * lane + 8) = w1; } else asm volatile("" :: "v"(w0), "v"(w1)); }
                LDS_WAIT();
            }
        }
    }
    __syncthreads();
}

__device__ __noinline__ void final_norm(const float* const* in_, float* out_, unsigned char* ws_, LAS unsigned char* lds_, int wave_, int vcu_, int G_) {
    const PC F{uni(in_), uni(out_), uni(ws_), uni_l(lds_), uni_i(wave_), uni_i(vcu_), uni_i(G_)}; struct { const float* const* in; float* out; } a{F.in, F.out};
    const int lane_ = lane_id_v(); const int gw = F.vcu * NWAVES + F.wave, NGW = F.G * NWAVES; const float* g = a.in[22];
    f32x4 gv[4];
#pragma unroll
    for (int j = 0; j < 4; ++j) gv[j] = ((const f32x4*)g)[lane_ + 64 * j];
    for (int m = gw; m < M; m += NGW) {
        GAS f32x4* xr = (GAS f32x4*)(a.out + (size_t)m * D) + lane_;
        f32x4 v[4]; float s = 0.f;
#pragma unroll
        for (int j = 0; j < 4; ++j) { v[j] = xr[64 * j]; s += (v[j].x * v[j].x + v[j].y * v[j].y) + (v[j].z * v[j].z + v[j].w * v[j].w); }
        const float rs = 1.0f / sqrtf(wave_sum(s) * (1.0f / D) + EPS);
#pragma unroll
        for (int j = 0; j < 4; ++j) xr[64 * j] = v[j] * rs * gv[j];
    }
}

#define KIN ((const float* const*)__builtin_amdgcn_kernarg_segment_ptr())
constexpr int PH_PER_LAYER = 10, PH_LAYER0 = 2, N_PHASES = PH_LAYER0 + PH_PER_LAYER * DEPTH + 1;

__global__ void __launch_bounds__(NWAVES * 64, 2) mk_fwd(Args args) {
    extern __shared__ __attribute__((aligned(16))) unsigned char lds[];
    Frame F;
    F.lds = (LAS unsigned char*)lds;
    F.MISC = (volatile LAS unsigned*)(F.lds + MISC_OFF);
    F.wave = __builtin_amdgcn_readfirstlane((int)threadIdx.x >> 6);
    F.G = gridDim.x; { const int bx = blockIdx.x; F.vcu = (F.G % 8 == 0) ? (bx % 8) * (F.G / 8) + bx / 8 : bx; }
    F.ws = args.ws; F.ctl = (gu32*)(args.ws + WS_CTL);
    if (threadIdx.x < 64) ((LAS unsigned*)(F.lds + MISC_OFF))[threadIdx.x] = 0u;
    __syncthreads();
    const int lo = args.ph_lo, hi = args.ph_hi;
    const bool multi = (hi - lo) > 1;
    XcdBarrier bar; bar.bar = (unsigned*)(F.ctl + CW_BAR); bar.x = 0; bar.st = nullptr; bar.wave = F.wave;
    if (multi) bar = xcd_barrier_post((unsigned*)(F.ctl + CW_BAR), F.MISC + 8, F.wave);
#define IN(k) (lo <= (k) && (k) < hi)
#define SEAM(k) do { if (IN(k) && IN((k) + 1)) { xcd_barrier(bar); if (PROBE_PHASE == 99) xcd_barrier(bar); } } while (0)

    if (IN(0)) {
#if EN_P0
 for (int rep = (PROBE_PHASE == 1 ? 0 : 1); rep < 2; ++rep) p0_prologue(KIN, args.out, args.ws, F.lds, F.wave, F.vcu, F.G);
#endif
 } SEAM(0);
    if (IN(1)) {
#if !((DIS_MASK >> 7) & 1)
 unsigned char* ws = launder_p(args.ws); bf16* hb = (bf16*)(ws + WS_HB); float* ss = (float*)(ws + WS_SS); (void)hb; (void)ss;
        pg8::Gemm g{(const bf16_t*)(ws + WS_MEMN), (const bf16_t*)(ws + WS_WMEM), MROWS, DEPTH * 2 * CW, D}; pg8::StaticOrder S; S.init(MROWS, DEPTH * 2 * CW, F.G, launder_s((int)blockIdx.x));
        EpiPlainBf16 E{(bf16_t*)(ws + WS_MEMKV), DEPTH * 2 * CW};
        pg8::gemm_phase<EpiPlainBf16, pg8::StaticOrder, true, true>(F.lds + RING_OFF, g, S, E, F.wave);
        { pg8::Gemm g2{(const bf16_t*)(ws + WS_WMEM), (const bf16_t*)(ws + WS_MEMN), DEPTH * 2 * CW, MROWS, D}; pg8::StaticOrder S2; S2.init(DEPTH * 2 * CW, MROWS, F.G, launder_s((int)blockIdx.x));
          EpiPlainBf16 E2{(bf16_t*)(ws + WS_VT), MROWS};
          pg8::gemm_phase<EpiPlainBf16, pg8::StaticOrder, true, true>(F.lds + RING_OFF, g2, S2, E2, F.wave); }
#endif
    } SEAM(1);

    for (int l = 0; l < DEPTH; ++l) {
        const int pb = PH_LAYER0 + PH_PER_LAYER * l;
        const float* hbase = (l == 0) ? args.in[0] : args.out;
        if (IN(pb + 0)) {
#if EN_P0
 if (l > 0) for (int rep = (PROBE_PHASE == 1 ? 0 : 1); rep < 2; ++rep) prep_layer_weights(KIN, args.out, args.ws, F.lds, l, F.wave, F.vcu, F.G);
#endif
 } SEAM(pb + 0);
        if (IN(pb + 1)) {
#if !((DIS_MASK >> 0) & 1)
 unsigned char* ws = launder_p(args.ws); bf16* hb = (bf16*)(ws + WS_HB); float* ss = (float*)(ws + WS_SS); (void)hb; (void)ss;
            pg8::Gemm g{hb, (const bf16_t*)(ws + WS_W1IN), M, 2 * DFF, D}; pg8::StaticOrder S; S.init(M, 2 * DFF, F.G, launder_s((int)blockIdx.x));
            EpiSwiglu E{(bf16_t*)(ws + WS_ACT), ss};
            for (int rep = (PROBE_PHASE == 2 ? 0 : 1); rep < 2; ++rep) pg8::gemm_phase<EpiSwiglu, pg8::StaticOrder, true, true>(F.lds + RING_OFF, g, S, E, F.wave);
#endif
        } SEAM(pb + 1);
        if (IN(pb + 2)) {
#if !((DIS_MASK >> 1) & 1)
 unsigned char* ws = launder_p(args.ws); bf16* hb = (bf16*)(ws + WS_HB); float* ss = (float*)(ws + WS_SS); (void)hb; (void)ss;
            pg8::Gemm g{(const bf16_t*)(ws + WS_ACT), (const bf16_t*)(ws + WS_W1OUT), M, D, DFF}; pg8::StaticOrder S; S.init(M, D, F.G, launder_s((int)blockIdx.x));
            for (int rep = (PROBE_PHASE == 3 ? 0 : 1); rep < 2; ++rep) { EpiResid E{hbase, args.out, hb, ss, 0.5f, (LAS float*)(F.lds + RING_BYTES), rep == 0 ? 1 : 0};
            pg8::gemm_phase<EpiResid, pg8::StaticOrder, true, true>(F.lds + RING_OFF, g, S, E, F.wave); }
#endif
        } SEAM(pb + 2);
        if (IN(pb + 3)) {
#if !((DIS_MASK >> 2) & 1)
 unsigned char* ws = launder_p(args.ws); bf16* hb = (bf16*)(ws + WS_HB); float* ss = (float*)(ws + WS_SS); (void)hb; (void)ss;
            pg8::Gemm g{hb, (const bf16_t*)(ws + WS_WIN), M, INP, D}; pg8::StaticOrder S; S.init(M, INP, F.G, launder_s((int)blockIdx.x));
            EpiInProj E{ss, (bf16_t*)(ws + WS_QL), (float*)(ws + WS_CKVRAW), (bf16_t*)(ws + WS_IK), (float*)(ws + WS_IW), (bf16_t*)(ws + WS_IQRAW), (bf16_t*)(ws + WS_Z), (bf16_t*)(ws + WS_QC), (bf16_t*)(ws + WS_G)};
            for (int rep = (PROBE_PHASE == 4 ? 0 : 1); rep < 2; ++rep) pg8::gemm_phase<EpiInProj, pg8::StaticOrder, true, true>(F.lds + RING_OFF, g, S, E, F.wave);
#endif
        } SEAM(pb + 3);
        if (IN(pb + 4)) {
#if EN_PREP
 for (int rep = (PROBE_PHASE == 5 ? 0 : 1); rep < 2; ++rep) prep_tokens(KIN, args.out, args.ws, F.lds, l, F.wave, F.vcu, F.G, rep == 0 ? 1 : 0);
#endif
 } SEAM(pb + 4);
        if (IN(pb + 5)) {
#if EN_DSA
 for (int rep = (PROBE_PHASE == 6 ? 0 : 1); rep < 2; ++rep) for (int p = F.vcu; p < BATCH * 64; p += F.G) { for (int half = 0; half < 2; ++half) { const int b_ = p >> 6, ub_ = half == 0 ? (p & 63) : 127 - (p & 63);
   sel_pass1(args.ws, F.lds, F.wave, b_, ub_); if (PROBE_PHASE == 61) sel_pass1(args.ws, F.lds, F.wave, b_, ub_); sel_pass2(args.ws, F.lds, F.wave, b_, ub_); if (PROBE_PHASE == 62) sel_pass2(args.ws, F.lds, F.wave, b_, ub_); sel_resolve(args.ws, F.lds, F.wave, b_, ub_, (int)blockIdx.x, (p == F.vcu && half == 0) ? 1 : 0); if (PROBE_PHASE == 63) sel_resolve(args.ws, F.lds, F.wave, b_, ub_, (int)blockIdx.x, 0); } }
 dsa_select_slow(args.ws, F.lds, F.wave, (int)blockIdx.x); for (int rep = (PROBE_PHASE == 7 ? 0 : 1); rep < 2; ++rep) dsa_attend(args.ws, F.lds, args.in[2], F.wave, F.vcu, F.G, rep == 0 ? 1 : 0);
#endif
 } SEAM(pb + 5);
        if (IN(pb + 6)) {
#if !((DIS_MASK >> 3) & 1)
        for (int rep6 = (PROBE_PHASE == 8 ? 0 : 1); rep6 < 2; ++rep6) {
 unsigned char* ws = launder_p(args.ws); bf16* hb = (bf16*)(ws + WS_HB); float* ss = (float*)(ws + WS_SS); (void)hb; (void)ss;
            { pg8::Gemm g{(const bf16_t*)(ws + WS_QL), (const bf16_t*)(ws + WS_WA), M, D, 1024}; pg8::StaticOrder S; S.init(M, D, F.G, launder_s((int)blockIdx.x));
              EpiMerge<0> E{(bf16_t*)(ws + WS_MERGED), (const bf16_t*)(ws + WS_G)};
              pg8::gemm_phase<EpiMerge<0>, pg8::StaticOrder, true, true>(F.lds + RING_OFF, g, S, E, F.wave); }
            { pg8::Gemm g{(const bf16_t*)(ws + WS_YB), (const bf16_t*)(ws + WS_WB), M, D, PW_}; pg8::StaticOrder S; S.init(M, D, F.G, launder_s((int)blockIdx.x));
              EpiMerge<1> E{(bf16_t*)(ws + WS_MERGED), (const bf16_t*)(ws + WS_G)};
              pg8::gemm_phase<EpiMerge<1>, pg8::StaticOrder, true, true>(F.lds + RING_OFF, g, S, E, F.wave); }
            { pg8::Gemm g{(const bf16_t*)(ws + WS_QC), (const bf16_t*)(ws + WS_WC), M, D, CW}; pg8::StaticOrder S; S.init(M, D, F.G, launder_s((int)blockIdx.x));
              EpiMerge<2> E{(bf16_t*)(ws + WS_MERGED), (const bf16_t*)(ws + WS_G)};
              pg8::gemm_phase<EpiMerge<2>, pg8::StaticOrder, true, true>(F.lds + RING_OFF, g, S, E, F.wave); }
        }
#endif
        } SEAM(pb + 6);
        if (IN(pb + 7)) {
#if !((DIS_MASK >> 4) & 1)
 unsigned char* ws = launder_p(args.ws); bf16* hb = (bf16*)(ws + WS_HB); float* ss = (float*)(ws + WS_SS); (void)hb; (void)ss;
            pg8::Gemm g{(const bf16_t*)(ws + WS_MERGED), (const bf16_t*)(ws + WS_WOUT), M, D, D}; pg8::StaticOrder S; S.init(M, D, F.G, launder_s((int)blockIdx.x));
            for (int rep = (PROBE_PHASE == 9 ? 0 : 1); rep < 2; ++rep) { EpiResid E{args.out, args.out, hb, ss, 1.0f, (LAS float*)(F.lds + RING_BYTES), rep == 0 ? 1 : 0};
            pg8::gemm_phase<EpiResid, pg8::StaticOrder, true, true>(F.lds + RING_OFF, g, S, E, F.wave); }
#endif
        } SEAM(pb + 7);
        if (IN(pb + 8)) {
#if !((DIS_MASK >> 5) & 1)
 unsigned char* ws = launder_p(args.ws); bf16* hb = (bf16*)(ws + WS_HB); float* ss = (float*)(ws + WS_SS); (void)hb; (void)ss;
            pg8::Gemm g{hb, (const bf16_t*)(ws + WS_W2IN), M, 2 * DFF, D}; pg8::StaticOrder S; S.init(M, 2 * DFF, F.G, launder_s((int)blockIdx.x));
            EpiSwiglu E{(bf16_t*)(ws + WS_ACT), ss};
            for (int rep = (PROBE_PHASE == 2 ? 0 : 1); rep < 2; ++rep) pg8::gemm_phase<EpiSwiglu, pg8::StaticOrder, true, true>(F.lds + RING_OFF, g, S, E, F.wave);
#endif
        } SEAM(pb + 8);
        if (IN(pb + 9)) {
#if !((DIS_MASK >> 6) & 1)
 unsigned char* ws = launder_p(args.ws); bf16* hb = (bf16*)(ws + WS_HB); float* ss = (float*)(ws + WS_SS); (void)hb; (void)ss;
            pg8::Gemm g{(const bf16_t*)(ws + WS_ACT), (const bf16_t*)(ws + WS_W2OUT), M, D, DFF}; pg8::StaticOrder S; S.init(M, D, F.G, launder_s((int)blockIdx.x));
            for (int rep = (PROBE_PHASE == 3 ? 0 : 1); rep < 2; ++rep) { EpiResid E{args.out, args.out, hb, ss, 0.5f, (LAS float*)(F.lds + RING_BYTES), rep == 0 ? 1 : 0};
            pg8::gemm_phase<EpiResid, pg8::StaticOrder, true, true>(F.lds + RING_OFF, g, S, E, F.wave); }
#endif
        } SEAM(pb + 9);
    }
#if EN_P0
    if (IN(N_PHASES - 1)) { final_norm(KIN, args.out, args.ws, F.lds, F.wave, F.vcu, F.G); }
#endif
#undef IN
#undef SEAM
}

extern "C" void kernel_launch(void* const* d_in, const int* in_sizes, int n_in, void* d_out, int out_size, void* d_ws, size_t ws_size, hipStream_t stream) {
    static int grid = 0;
    if (grid == 0) {
        if (n_in != 23 || in_sizes[0] != M * D || out_size != M * D || ws_size < WS_END) { fprintf(stderr, "kernel_launch: unexpected shapes (n_in %d, ws %zu)\n", n_in, ws_size); grid = -1; return; }
        int dev = 0, cus = 0, per_cu = 0;
        if (hipGetDevice(&dev) != hipSuccess || hipDeviceGetAttribute(&cus, hipDeviceAttributeMultiprocessorCount, dev) != hipSuccess) { grid = -1; return; }
        if (hipFuncSetAttribute((const void*)mk_fwd, hipFuncAttributeMaxDynamicSharedMemorySize, LDS_BYTES) != hipSuccess) { fprintf(stderr, "kernel_launch: hipFuncSetAttribute failed\n"); grid = -1; return; }
        if (hipOccupancyMaxActiveBlocksPerMultiprocessor(&per_cu, (const void*)mk_fwd, NWAVES * 64, LDS_BYTES) != hipSuccess || per_cu < 1) { fprintf(stderr, "kernel_launch: occupancy query says %d\n", per_cu); }
        (void)hipGetLastError();
        grid = cus;
    }
    if (grid < 0) return;
    if (hipMemsetAsync((char*)d_ws + WS_CTL, 0, CTL_ZERO_BYTES, stream) != hipSuccess) return;
    Args a{};
    for (int i = 0; i < 23; ++i) a.in[i] = (const float*)d_in[i];
    a.out = (float*)d_out; a.ws = (unsigned char*)d_ws;
#if MK_ONE_LAUNCH
    a.ph_lo = 0; a.ph_hi = N_PHASES;
    hipLaunchKernelGGL(mk_fwd, dim3(grid), dim3(NWAVES * 64), LDS_BYTES, stream, a);
#endif
}
```

```cpp
#include <hip/hip_runtime.h>
#include <cstdio>
#include <cstdint>

#ifndef MK_ONE_LAUNCH
#define MK_ONE_LAUNCH 1
#endif
#ifndef PROBE_PHASE
#define PROBE_PHASE 0
#endif
#ifndef EN_P0
#define EN_P0 MK_ONE_LAUNCH
#endif
#ifndef EN_PREP
#define EN_PREP MK_ONE_LAUNCH
#endif
#ifndef EN_DSA
#define EN_DSA MK_ONE_LAUNCH
#endif
#ifndef DIS_MASK
#define DIS_MASK 0
#endif
#ifndef MK_ONE_LAUNCH
#define MK_ONE_LAUNCH 1
#endif

__device__ __forceinline__ int lane_id_v() { int l; asm volatile("v_mbcnt_lo_u32_b32 %0, -1, 0\n\tv_mbcnt_hi_u32_b32 %0, -1, %0" : "=v"(l)); return l; }
namespace pg8 {
#define PG8_LAS __attribute__((address_space(3)))
typedef unsigned short bf16_t;
typedef short bf16x8 __attribute__((ext_vector_type(8)));
typedef float f32x4 __attribute__((ext_vector_type(4)));
typedef unsigned u32x4 __attribute__((ext_vector_type(4)));
typedef unsigned u32x2 __attribute__((ext_vector_type(2)));
constexpr int BM = 256, BK = 64, HALF = 128, HTB = HALF * BK * 2, STAGE_BYTES = 8 * HTB, NXCD = 8, WGM = 8;

__host__ __device__ __forceinline__ int lds_byte(int r, int c) { const int st = (r >> 4) * 2 + (c >> 5), rr = r & 15, cc = c & 31, ob = rr * 64 + cc * 2; return st * 1024 + (ob ^ (((ob >> 9) & 1) << 5)); }
__host__ __device__ __forceinline__ void stage_rc(int b, int& R, int& C) { const int st = b / 1024, sb = b % 1024, swz = sb ^ (((sb >> 9) & 1) << 5); R = (st >> 1) * 16 + swz / 64; C = (st & 1) * 32 + (swz % 64) / 2; }
__host__ __device__ __forceinline__ int perm32(int rho) { const int n = rho >> 4, i = rho & 15; return 8 * (i >> 2) + 4 * n + (i & 3); }

struct Unit { int pm, pn; };
struct Gemm { const bf16_t* A; const bf16_t* Bt; int M, N, K; };

struct StaticOrder {
    int nM, nN, nwg, G, c;
    __host__ __device__ void init(int M, int N, int G_, int c_) { nM = M / BM; nN = N / BM; nwg = nM * nN; G = G_; c = c_; }
    __host__ __device__ bool next(int i, Unit& u) const {
        const long L = (long)i * G + c; if (L >= nwg) return false;
        int wgid = (int)L; { const int q = nwg / NXCD, r = nwg % NXCD, xcd = wgid % NXCD, off = wgid / NXCD; wgid = (xcd < r ? xcd * (q + 1) : r * (q + 1) + (xcd - r) * q) + off; }
        const int nig = WGM * nN, gid = wgid / nig, fm = gid * WGM, gsz = (nM - fm) < WGM ? (nM - fm) : WGM;
        u.pm = fm + ((wgid % nig) % gsz); u.pn = (wgid % nig) / gsz; return true;
    }
    __device__ __forceinline__ void a_ready(const Unit&) const {}
    __device__ __forceinline__ void done(const Unit&) const {}
};

__device__ __forceinline__ unsigned cvt_pk_bf16(float lo, float hi) { unsigned r; asm volatile("v_cvt_pk_bf16_f32 %0, %1, %2" : "=v"(r) : "v"(lo), "v"(hi)); return r; }

template <class Epi, class Sched, bool ALIGN_EPI = false, bool SP2 = false>
__device__ __forceinline__ void gemm_phase(PG8_LAS unsigned char* lds, const Gemm g, const Sched& S, const Epi& E, const int wid_) {
    int wid = wid_; asm volatile("" : "+s"(wid));
    const int lane = lane_id_v(), tid = wid * 64 + lane,
              wr = wid >> 2, wc = wid & 3, fr = lane & 15, fq = lane >> 4;
    const int K = g.K, nt = K / BK;
    unsigned voffA[2], voffB[2];
#pragma unroll
    for (int i = 0; i < 2; ++i) { int R, C; stage_rc(tid * 16 + i * 8192, R, C); const int Rb = Epi::PERM ? ((R & ~31) + perm32(R & 31)) : R;
        voffA[i] = (unsigned)(R * K + C) * 2u; voffB[i] = (unsigned)(Rb * K + C) * 2u; }
    const size_t kstep = (size_t)(BK * 2);
    const size_t hstep = (size_t)HALF * K * 2;
    const size_t tstep = 2 * hstep;
    const unsigned ldsw = (unsigned)wid * 1024u;
    const int aoff = lds_byte(wr * 64 + fr, fq * 8), boff = lds_byte(wc * 32 + fr, fq * 8);
#define PG8_SA(b, h) (((b) * 2 + (h)) * HTB)
#define PG8_SB(b, h) ((4 + (b) * 2 + (h)) * HTB)
#define PG8_STAGE(bufoff, gbase, voff) do { _Pragma("unroll") for (int _i = 0; _i < 2; ++_i) \
        __builtin_amdgcn_global_load_lds((const unsigned*)((const char*)(gbase) + (voff)[_i]), (PG8_LAS unsigned*)(lds + (bufoff) + ldsw + _i * 8192), 16, 0, 0); } while (0)
#define PG8_LDA(dst, b, h) do { _Pragma("unroll") for (int m = 0; m < 4; ++m) _Pragma("unroll") for (int k = 0; k < 2; ++k) dst[m][k] = *(const PG8_LAS bf16x8*)(lds + PG8_SA(b, h) + aoff + m * 2048 + k * 1024); } while (0)
#define PG8_LDB(dst, b, h) do { _Pragma("unroll") for (int n = 0; n < 2; ++n) _Pragma("unroll") for (int k = 0; k < 2; ++k) dst[n][k] = *(const PG8_LAS bf16x8*)(lds + PG8_SB(b, h) + boff + n * 2048 + k * 1024); } while (0)
#define PG8_MMA(ai, bj, At, Bt) do { __builtin_amdgcn_s_setprio(1); _Pragma("unroll") for (int m = 0; m < 4; ++m) _Pragma("unroll") for (int n = 0; n < 2; ++n) _Pragma("unroll") for (int k = 0; k < 2; ++k) \
        acc[ai][bj][m][n] = __builtin_amdgcn_mfma_f32_16x16x32_bf16(Bt[n][k], At[m][k], acc[ai][bj][m][n], 0, 0, 0); __builtin_amdgcn_s_setprio(0); } while (0)
#define PG8_WAIT_V(n) asm volatile("s_waitcnt vmcnt(" #n ")" ::: "memory")
#define PG8_WAIT_L(n) asm volatile("s_waitcnt lgkmcnt(" #n ")" ::: "memory")
#define PG8_BAR __builtin_amdgcn_s_barrier()
#define PG8_SCHED __builtin_amdgcn_sched_barrier(0)
    Unit cur, nxt; int ui = 0;
    if (!S.next(0, cur)) return;
    f32x4 acc[2][2][4][2];
#pragma unroll
    for (int a = 0; a < 2; ++a)
#pragma unroll
        for (int b = 0; b < 2; ++b)
#pragma unroll
            for (int m = 0; m < 4; ++m)
#pragma unroll
                for (int n = 0; n < 2; ++n) acc[a][b][m][n] = (f32x4){0.f, 0.f, 0.f, 0.f};
    bf16x8 At[4][2], B0[2][2], B1[2][2];
    const char* cA = (const char*)g.A + (size_t)cur.pm * tstep; const char* cB = (const char*)g.Bt + (size_t)cur.pn * tstep;
    S.a_ready(cur);
    if constexpr (SP2) {
        PG8_STAGE(PG8_SB(0, 0), cB, voffB); PG8_STAGE(PG8_SB(0, 1), cB + hstep, voffB); PG8_STAGE(PG8_SA(0, 0), cA, voffA); PG8_STAGE(PG8_SA(0, 1), cA + hstep, voffA);
        if (wr == 1) PG8_BAR;
        PG8_WAIT_V(2); PG8_BAR;
        PG8_STAGE(PG8_SB(1, 0), cB + kstep, voffB); PG8_STAGE(PG8_SA(1, 0), cA + kstep, voffA); PG8_STAGE(PG8_SB(1, 1), cB + hstep + kstep, voffB);
        PG8_WAIT_V(6); PG8_BAR;
    } else {
        PG8_STAGE(PG8_SB(0, 0), cB, voffB); PG8_STAGE(PG8_SA(0, 0), cA, voffA); PG8_STAGE(PG8_SB(0, 1), cB + hstep, voffB); PG8_STAGE(PG8_SA(0, 1), cA + hstep, voffA);
        if (wr == 1) PG8_BAR;
        PG8_WAIT_V(4); PG8_BAR;
        PG8_STAGE(PG8_SB(1, 0), cB + kstep, voffB); PG8_STAGE(PG8_SA(1, 0), cA + kstep, voffA); PG8_STAGE(PG8_SB(1, 1), cB + hstep + kstep, voffB);
        PG8_WAIT_V(6); PG8_BAR;
    }
    for (;;) {
        const bool has_next = S.next(ui + 1, nxt);
        const char* nA = has_next ? (const char*)g.A + (size_t)nxt.pm * tstep : cA; const char* nB = has_next ? (const char*)g.Bt + (size_t)nxt.pn * tstep : cB;
        for (int t = 0; t < nt; t += 2) {
            const bool last = (t == nt - 2);
            const char* a1 = cA + (size_t)(t + 1) * kstep;
            const char* a2 = last ? nA : cA + (size_t)(t + 2) * kstep; const char* b2 = last ? nB : cB + (size_t)(t + 2) * kstep;
            const char* a3 = a2 + kstep; const char* b3 = b2 + kstep;
            if (last && has_next) S.a_ready(nxt);
            if constexpr (SP2) {
            PG8_LDB(B0, 0, 0); PG8_LDB(B1, 0, 1); PG8_SCHED; PG8_LDA(At, 0, 0); PG8_STAGE(PG8_SA(1, 1), a1 + hstep, voffA);
            PG8_WAIT_V(8); PG8_WAIT_L(0); PG8_BAR; PG8_MMA(0, 0, At, B0); PG8_MMA(0, 1, At, B1); PG8_BAR; PG8_SCHED;
            PG8_LDA(At, 0, 1); PG8_STAGE(PG8_SB(0, 0), b2, voffB); PG8_STAGE(PG8_SB(0, 1), b2 + hstep, voffB); PG8_STAGE(PG8_SA(0, 0), a2, voffA);
            PG8_WAIT_V(8); PG8_WAIT_L(0); PG8_BAR; PG8_MMA(1, 0, At, B0); PG8_MMA(1, 1, At, B1); PG8_BAR; PG8_SCHED;
            PG8_LDB(B0, 1, 0); PG8_LDB(B1, 1, 1); PG8_SCHED; PG8_LDA(At, 1, 0); PG8_STAGE(PG8_SA(0, 1), a2 + hstep, voffA);
            PG8_WAIT_V(8); PG8_WAIT_L(0); PG8_BAR; PG8_MMA(0, 0, At, B0); PG8_MMA(0, 1, At, B1); PG8_BAR; PG8_SCHED;
            PG8_LDA(At, 1, 1); PG8_STAGE(PG8_SB(1, 0), b3, voffB); PG8_STAGE(PG8_SB(1, 1), b3 + hstep, voffB); PG8_STAGE(PG8_SA(1, 0), a3, voffA);
            PG8_WAIT_V(8); PG8_WAIT_L(0); PG8_BAR; PG8_MMA(1, 0, At, B0); PG8_MMA(1, 1, At, B1); PG8_BAR; PG8_SCHED;
            } else {
            PG8_LDB(B0, 0, 0); PG8_SCHED; PG8_LDA(At, 0, 0); PG8_STAGE(PG8_SA(1, 1), a1 + hstep, voffA);
            PG8_WAIT_L(8); PG8_BAR; PG8_WAIT_L(0); PG8_MMA(0, 0, At, B0); PG8_BAR; PG8_SCHED;
            PG8_LDB(B1, 0, 1); PG8_STAGE(PG8_SB(0, 0), b2, voffB);
            PG8_BAR; PG8_WAIT_L(0); PG8_MMA(0, 1, At, B1); PG8_BAR;
            PG8_LDA(At, 0, 1); PG8_STAGE(PG8_SA(0, 0), a2, voffA);
            PG8_BAR; PG8_WAIT_L(0); PG8_MMA(1, 0, At, B0); PG8_BAR; PG8_SCHED;
            PG8_STAGE(PG8_SB(0, 1), b2 + hstep, voffB);
            PG8_WAIT_V(6); PG8_BAR; PG8_MMA(1, 1, At, B1); PG8_BAR;
            PG8_LDB(B0, 1, 0); PG8_SCHED; PG8_LDA(At, 1, 0); PG8_STAGE(PG8_SA(0, 1), a2 + hstep, voffA);
            PG8_WAIT_L(8); PG8_BAR; PG8_WAIT_L(0); PG8_MMA(0, 0, At, B0); PG8_BAR; PG8_SCHED;
            PG8_LDB(B1, 1, 1); PG8_STAGE(PG8_SB(1, 0), b3, voffB);
            PG8_BAR; PG8_WAIT_L(0); PG8_MMA(0, 1, At, B1); PG8_BAR;
            PG8_LDA(At, 1, 1); PG8_STAGE(PG8_SA(1, 0), a3, voffA);
            PG8_BAR; PG8_WAIT_L(0); PG8_MMA(1, 0, At, B0); PG8_BAR; PG8_SCHED;
            PG8_STAGE(PG8_SB(1, 1), b3 + hstep, voffB);
            PG8_WAIT_V(6); PG8_BAR; PG8_MMA(1, 1, At, B1); PG8_BAR;
            }
        }
        if constexpr (ALIGN_EPI) { if (wr == 0) PG8_BAR; }
        E(acc, cur, wr, wc, fr, fq); S.done(cur);
        if (!has_next) break;
#pragma unroll
        for (int a = 0; a < 2; ++a)
#pragma unroll
            for (int b = 0; b < 2; ++b)
#pragma unroll
                for (int m = 0; m < 4; ++m)
#pragma unroll
                    for (int n = 0; n < 2; ++n) acc[a][b][m][n] = (f32x4){0.f, 0.f, 0.f, 0.f};
        cur = nxt; cA = nA; cB = nB; ++ui;
        if constexpr (ALIGN_EPI) { if (wr == 1) PG8_BAR; }
    }
    PG8_WAIT_V(0);
    if constexpr (!ALIGN_EPI) { if (wr == 0) PG8_BAR; }
    PG8_BAR;
#undef PG8_SA
#undef PG8_SB
#undef PG8_STAGE
#undef PG8_LDA
#undef PG8_LDB
#undef PG8_MMA
#undef PG8_WAIT_V
#undef PG8_WAIT_L
#undef PG8_BAR
#undef PG8_SCHED
}
}

constexpr int NWAVES = 8;
constexpr int BATCH = 4, SEQ = 8192, D = 1024, DEPTH = 4, M = BATCH * SEQ;
constexpr int NMEM = 256, MROWS = BATCH * NMEM;
constexpr int AH = 8, AHD = 64, AW = 512, KVR = 128, IH = 8, IDIM = 32, TOPK = 256;
constexpr int PW_ = 256, CH = 4, CHD = 64, CW = 256;
constexpr int DFF = 2816, INW = 4520, INP = 5120;
constexpr float EPS = 1e-6f;
constexpr int C_QA = 0, C_CKV = 512, C_IQ = 640, C_IK = 896, C_IW = 928, C_Z = 936, C_QC = 1192, C_G = 1448;

constexpr size_t MiB = 1u << 20;
constexpr size_t WS_CTL = 0, CTL_ZERO_BYTES = 1 * MiB;
constexpr size_t WS_SS = 1 * MiB;
constexpr size_t WS_IW = 3 * MiB;
constexpr size_t WS_SGN = 4 * MiB;
constexpr size_t WS_MEMN = 5 * MiB;
constexpr size_t WS_WMEM = 7 * MiB;
constexpr size_t WS_MEMKV = 11 * MiB;
constexpr size_t WS_W1IN = 15 * MiB, WS_W1OUT = 26 * MiB, WS_WIN = 32 * MiB, WS_WA = 42 * MiB, WS_WB = 44 * MiB, WS_WC = 44 * MiB + 512 * 1024, WS_WOUT = 45 * MiB, WS_W2IN = 47 * MiB, WS_W2OUT = 58 * MiB;
constexpr size_t WS_HB = 64 * MiB;
constexpr size_t WS_ACT = 128 * MiB;
constexpr size_t WS_G = 128 * MiB;
constexpr size_t WS_QL = 320 * MiB;
constexpr size_t WS_CKV = 384 * MiB;
constexpr size_t WS_CKVRAW = 392 * MiB;
constexpr size_t WS_IQRAW = 408 * MiB;
constexpr size_t WS_IQF = 424 * MiB;
constexpr size_t WS_IK = 440 * MiB;
constexpr size_t WS_Z = 442 * MiB;
constexpr size_t WS_MERGED = 384 * MiB;
constexpr size_t WS_YB = 458 * MiB;
constexpr size_t WS_QC = 474 * MiB;
constexpr size_t WS_SEL = 490 * MiB;
constexpr size_t WS_VT = 506 * MiB;
constexpr size_t WS_WPT = 4 * MiB + 512 * 1024;
constexpr size_t WS_END = 510 * MiB;
constexpr int CW_BAR = 4096;

constexpr int RING_OFF = 0, RING_BYTES = 131072;
constexpr int LDS_BYTES = 155648;
constexpr int MISC_OFF = LDS_BYTES - 256;

#define GAS __attribute__((address_space(1)))
#define LAS __attribute__((address_space(3)))
typedef unsigned short bf16;
typedef unsigned v4u __attribute__((ext_vector_type(4)));
typedef unsigned v2u __attribute__((ext_vector_type(2)));
typedef float f32x4 __attribute__((ext_vector_type(4)));
typedef float f32x2 __attribute__((ext_vector_type(2)));
typedef GAS unsigned gu32;
#define RLX_AGENT __ATOMIC_RELAXED, __HIP_MEMORY_SCOPE_AGENT
#define LDS_WAIT() asm volatile("s_waitcnt lgkmcnt(0)" ::: "memory")
#define VM_WAIT() asm volatile("s_waitcnt vmcnt(0)" ::: "memory")
__device__ __forceinline__ unsigned f2bf(float f) { unsigned u = __builtin_bit_cast(unsigned, f); return (u + 0x7fffu + ((u >> 16) & 1u)) >> 16; }
__device__ __forceinline__ unsigned pk2(float lo, float hi) { return pg8::cvt_pk_bf16(lo, hi); }
__device__ __forceinline__ float bflo(unsigned w) { return __builtin_bit_cast(float, w << 16); }
__device__ __forceinline__ float bfhi(unsigned w) { return __builtin_bit_cast(float, w & 0xffff0000u); }
typedef _Float16 h2_t __attribute__((ext_vector_type(2)));
typedef _Float16 f16x8_t __attribute__((ext_vector_type(8)));
__device__ __forceinline__ unsigned pkh2(float lo, float hi) { const h2_t v = {(_Float16)lo, (_Float16)hi}; return __builtin_bit_cast(unsigned, v); }
__device__ __forceinline__ float hlo(unsigned w) { return (float)__builtin_bit_cast(h2_t, w)[0]; }
__device__ __forceinline__ float hhi(unsigned w) { return (float)__builtin_bit_cast(h2_t, w)[1]; }
__device__ __forceinline__ float bf2f(bf16 b) { return __builtin_bit_cast(float, ((unsigned)b) << 16); }

#define XB_TMO      128
#define XB_XCNT(j)  (256  + 64 * (j))
#define XB_XSUB(j)  (1280 + 64 * (j))
#define XB_XGEN(j)  (2304 + 64 * (j))
#define XB_TOP      3328
#define XB_TOPGEN   3392
#define XCD_BAR_WORDS 3456
#define XB_SPIN_CAP (1u << 23)

__device__ __forceinline__ unsigned xb_ld(unsigned* p)              { return __hip_atomic_load(p, __ATOMIC_RELAXED, __HIP_MEMORY_SCOPE_AGENT); }
__device__ __forceinline__ unsigned xb_add(unsigned* p, unsigned v) { return __hip_atomic_fetch_add(p, v, __ATOMIC_RELAXED, __HIP_MEMORY_SCOPE_AGENT); }
__device__ __forceinline__ unsigned xb_xcc_id() { return (unsigned)__builtin_amdgcn_s_getreg((3 << 11) | 20) & 0xFu; }
#define XB_SPIN(cond, bar) do { unsigned _sp = 0; while (cond) { __builtin_amdgcn_s_sleep(1); \
    if ((++_sp & 255u) == 0u) { if (xb_ld(&(bar)[XB_TMO])) break; if (_sp > XB_SPIN_CAP) { atomicAdd(&(bar)[XB_TMO], 1u); break; } } } } while (0)

struct XcdBarrier { unsigned* bar; unsigned x; volatile LAS unsigned* st; int wave; };

__device__ __forceinline__ XcdBarrier xcd_barrier_post(unsigned* bar, volatile LAS unsigned* st, int wave) {
    XcdBarrier b; b.bar = bar; b.x = xb_xcc_id(); b.st = st; b.wave = wave;
    if (threadIdx.x == 0) (void)xb_add(&bar[XB_XCNT(b.x)], 1u);
    return b;
}
__device__ __forceinline__ void xcd_barrier_complete(unsigned* bar, unsigned x, unsigned& nloc, unsigned& nx) {
    const unsigned G = gridDim.x * gridDim.y * gridDim.z;
    unsigned sum, cnt, mine, sp = 0u;
    for (;;) {
        sum = 0u; cnt = 0u; mine = 0u;
#pragma unroll
        for (unsigned j = 0; j < 16; ++j) { const unsigned c = xb_ld(&bar[XB_XCNT(j)]); sum += c; cnt += (c > 0u) ? 1u : 0u; mine = (j == x) ? c : mine; }
        if (sum == G) break;
        __builtin_amdgcn_s_sleep(1);
        if ((++sp & 255u) == 0u) { if (xb_ld(&bar[XB_TMO])) break; if (sp > XB_SPIN_CAP) { atomicAdd(&bar[XB_TMO], 1u); break; } }
    }
    nloc = mine > 0u ? mine : 1u; nx = cnt > 0u ? cnt : 1u;
}
__device__ __forceinline__ void xcd_barrier(const XcdBarrier& b) {
    asm volatile("s_waitcnt vmcnt(0)" ::: "memory");
    __syncthreads();
    int bw_ = b.wave; asm volatile("" : "+s"(bw_));
    if (bw_ == 0 && lane_id_v() == 0) {
        unsigned* bar = b.bar;
        __builtin_amdgcn_s_waitcnt(0);
        unsigned nloc = b.st[0], nx = b.st[1];
        if (nloc == 0u) { xcd_barrier_complete(bar, b.x, nloc, nx); b.st[0] = nloc; b.st[1] = nx; }
        const unsigned old = xb_add(&bar[XB_XSUB(b.x)], 1u);
        const unsigned gen = old / nloc;
        if (old + 1u == (gen + 1u) * nloc) {
            __builtin_amdgcn_fence(__ATOMIC_RELEASE, "agent");
            asm volatile("s_waitcnt vmcnt(0)" ::: "memory");
            const unsigned og = xb_add(&bar[XB_TOP], 1u);
            const unsigned tg = og / nx;
            if (og + 1u == (tg + 1u) * nx) xb_add(&bar[XB_TOPGEN], 1u);
            else XB_SPIN(xb_ld(&bar[XB_TOPGEN]) == tg, bar);
            __builtin_amdgcn_fence(__ATOMIC_ACQUIRE, "agent");
            xb_add(&bar[XB_XGEN(b.x)], 1u);
            asm volatile("s_waitcnt vmcnt(0)" ::: "memory");
        } else {
            XB_SPIN(xb_ld(&bar[XB_XGEN(b.x)]) == gen, bar);
            __builtin_amdgcn_fence(__ATOMIC_ACQUIRE, "agent");
            asm volatile("s_waitcnt vmcnt(0)" ::: "memory");
        }
    }
    __syncthreads();
}

struct Args {
    const float* in[23]; float* out; unsigned char* ws; int ph_lo, ph_hi;
};
template <class T> __device__ __forceinline__ T* uni(T* p) { const unsigned long long v = (unsigned long long)p; const unsigned lo = __builtin_amdgcn_readfirstlane((unsigned)v), hi = __builtin_amdgcn_readfirstlane((unsigned)(v >> 32)); return (T*)(((unsigned long long)hi << 32) | lo); }
__device__ __forceinline__ LAS unsigned char* uni_l(LAS unsigned char* p) { return (LAS unsigned char*)(unsigned)__builtin_amdgcn_readfirstlane((int)(unsigned)(size_t)p); }
__device__ __forceinline__ int uni_i(int v) { return __builtin_amdgcn_readfirstlane(v); }
struct PC { const float* const* in; float* out; unsigned char* ws; LAS unsigned char* lds; int wave, vcu, G; };
struct Frame {
    LAS unsigned char* lds;
    volatile LAS unsigned* MISC;
    gu32* ctl;
    int wave, vcu, G;
    unsigned char* ws;
};
__device__ __forceinline__ unsigned char* launder_p(unsigned char* p) { asm volatile("" : "+s"(p)); return p; }
__device__ __forceinline__ int launder_s(int v) { asm volatile("" : "+s"(v)); return v; }
__device__ __forceinline__ int launder_v(int v) { asm volatile("" : "+v"(v)); return v; }
__device__ __forceinline__ float wave_sum(float v) {
#pragma unroll
    for (int o = 1; o < 64; o <<= 1) v += __shfl_xor(v, o);
    return v;
}
__device__ __forceinline__ float wave_max(float v) {
#pragma unroll
    for (int o = 1; o < 64; o <<= 1) v = fmaxf(v, __shfl_xor(v, o));
    return v;
}

using pg8::Unit; using pg8::bf16_t;
#define LAUNDER2(a, b) asm volatile("" : "+v"(a), "+v"(b))
__device__ __forceinline__ float row_scale(const float* ss, int row) {
    const f32x4 a = *(const f32x4*)(ss + (size_t)row * 4);
    const float s = (a.x + a.y) + (a.z + a.w);
    return __builtin_amdgcn_rsqf(s * (1.0f / D) + EPS);
}
__device__ __forceinline__ float sigmoidf_(float x) { return __builtin_amdgcn_rcpf(1.0f + __expf(-x)); }
__device__ __forceinline__ pg8::u32x2 pack4(const f32x4 v) { pg8::u32x2 w; w.x = pg8::cvt_pk_bf16(v[0], v[1]); w.y = pg8::cvt_pk_bf16(v[2], v[3]); return w; }

struct EpiSwiglu {
    static constexpr bool PERM = true;
    bf16_t* O; const float* ss;
    __device__ __forceinline__ void operator()(const f32x4 (&acc)[2][2][4][2], const Unit& u, int wr, int wc, int fr_, int fq_) const {
        const int l_ = lane_id_v(); const int fr = l_ & 15, fq = l_ >> 4; (void)fr_; (void)fq_;
        int rb = wr * 64 + fr, cb = wc * 32 + 8 * fq; LAUNDER2(rb, cb);
        const int row0 = u.pm * 256 + rb, col0 = u.pn * 128 + cb;
#pragma unroll
        for (int ai = 0; ai < 2; ++ai)
#pragma unroll
            for (int m = 0; m < 4; ++m) { const int row = row0 + ai * 128 + m * 16; const float s = row_scale(ss, row);
                pg8::u32x4 w;
                { const f32x4 a = acc[ai][0][m][0] * s, b = acc[ai][1][m][0] * s; f32x4 o;
#pragma unroll
                  for (int i = 0; i < 4; ++i) o[i] = a[i] * sigmoidf_(a[i]) * b[i];
                  w.x = pg8::cvt_pk_bf16(o[0], o[1]); w.y = pg8::cvt_pk_bf16(o[2], o[3]); }
                { const f32x4 a = acc[ai][0][m][1] * s, b = acc[ai][1][m][1] * s; f32x4 o;
#pragma unroll
                  for (int i = 0; i < 4; ++i) o[i] = a[i] * sigmoidf_(a[i]) * b[i];
                  w.z = pg8::cvt_pk_bf16(o[0], o[1]); w.w = pg8::cvt_pk_bf16(o[2], o[3]); }
                *(pg8::u32x4*)(O + (size_t)row * DFF + col0) = w; }
    }
};
struct EpiResid {
    static constexpr bool PERM = true;
    const float* base; float* out; bf16_t* hb; float* ss; float alpha; LAS float* P; int dry;
    __device__ __forceinline__ void operator()(const f32x4 (&acc)[2][2][4][2], const Unit& u, int wr, int wc, int fr_, int fq_) const {
        const int l_ = lane_id_v(); const int fr = l_ & 15, fq = l_ >> 4; (void)fr_; (void)fq_;
        int rb = wr * 64 + fr, cb = wc * 32 + 8 * fq; LAUNDER2(rb, cb);
        const int row0 = u.pm * 256 + rb, col0 = u.pn * 256 + cb;
#pragma unroll
        for (int ai = 0; ai < 2; ++ai)
#pragma unroll
          for (int mh = 0; mh < 2; ++mh) {
            f32x4 bs[2][2][2];
#pragma unroll
            for (int mm = 0; mm < 2; ++mm) { const size_t off = (size_t)(row0 + ai * 128 + (2 * mh + mm) * 16) * D + col0;
#pragma unroll
                for (int bj = 0; bj < 2; ++bj)
#pragma unroll
                    for (int n = 0; n < 2; ++n) bs[mm][bj][n] = *(const f32x4*)(base + off + bj * 128 + n * 4); }
#pragma unroll
            for (int mm = 0; mm < 2; ++mm) { const int m = 2 * mh + mm; const int row = row0 + ai * 128 + m * 16; const size_t off = (size_t)row * D + col0; float q = 0.f;
#pragma unroll
                for (int bj = 0; bj < 2; ++bj) { const f32x4 v0 = bs[mm][bj][0] + acc[ai][bj][m][0] * alpha, v1 = bs[mm][bj][1] + acc[ai][bj][m][1] * alpha;
                    if (!dry) { *(f32x4*)(out + off + bj * 128) = v0; *(f32x4*)(out + off + bj * 128 + 4) = v1;
                        pg8::u32x4 w; w.x = pg8::cvt_pk_bf16(v0[0], v0[1]); w.y = pg8::cvt_pk_bf16(v0[2], v0[3]); w.z = pg8::cvt_pk_bf16(v1[0], v1[1]); w.w = pg8::cvt_pk_bf16(v1[2], v1[3]);
                        *(pg8::u32x4*)(hb + off + bj * 128) = w; }
                    q += ((v0[0] * v0[0] + v0[1] * v0[1]) + (v0[2] * v0[2] + v0[3] * v0[3])) + ((v1[0] * v1[0] + v1[1] * v1[1]) + (v1[2] * v1[2] + v1[3] * v1[3])); }
                q += __shfl_xor(q, 16); q += __shfl_xor(q, 32);
                if (fq == 0) P[(rb + ai * 128 + m * 16) * 4 + wc] = q; }
            asm volatile("" ::: "memory"); }
        asm volatile("s_waitcnt lgkmcnt(0)" ::: "memory"); __builtin_amdgcn_s_barrier(); asm volatile("" ::: "memory");
        const int tid = (wr * 4 + wc) * 64 + fq * 16 + fr;
        if (tid < 256 && !dry) { const f32x4 p = *(const LAS f32x4*)(P + tid * 4); ss[(size_t)(u.pm * 256 + tid) * 4 + u.pn] = (p.x + p.y) + (p.z + p.w); }
    }
};
struct EpiPlainBf16 {
    static constexpr bool PERM = false;
    bf16_t* O; int ldo;
    __device__ __forceinline__ void operator()(const f32x4 (&acc)[2][2][4][2], const Unit& u, int wr, int wc, int fr_, int fq_) const {
        const int l_ = lane_id_v(); const int fr = l_ & 15, fq = l_ >> 4; (void)fr_; (void)fq_;
        int rb = wr * 64 + fr, cb = wc * 32 + 4 * fq; LAUNDER2(rb, cb);
        const int row0 = u.pm * 256 + rb, col0 = u.pn * 256 + cb;
#pragma unroll
        for (int ai = 0; ai < 2; ++ai)
#pragma unroll
            for (int m = 0; m < 4; ++m) { bf16_t* rowp = O + (size_t)(row0 + ai * 128 + m * 16) * ldo + col0;
#pragma unroll
                for (int bj = 0; bj < 2; ++bj)
#pragma unroll
                    for (int n = 0; n < 2; ++n) *(pg8::u32x2*)(rowp + bj * 128 + n * 16) = pack4(acc[ai][bj][m][n]); }
    }
};
struct EpiInProj {
    static constexpr bool PERM = true;
    const float* ss; bf16_t* qa; float* ckvraw; bf16_t* ik; float* iw; bf16_t* iqraw; bf16_t* z; bf16_t* qc; bf16_t* G;
    __device__ __forceinline__ void operator()(const f32x4 (&acc)[2][2][4][2], const Unit& u, int wr, int wc, int fr_, int fq_) const {
        const int l_ = lane_id_v(); const int fr = l_ & 15, fq = l_ >> 4; (void)fr_; (void)fq_;
        int rb = wr * 64 + fr, ct = wc * 32 + 8 * fq; LAUNDER2(rb, ct);
        const int row0 = u.pm * 256 + rb; const int pn = u.pn;
        if (pn == 4) {
#pragma unroll
            for (int ai = 0; ai < 2; ++ai)
#pragma unroll
                for (int m = 0; m < 4; ++m) { const int row = row0 + ai * 128 + m * 16; const float s = row_scale(ss, row);
#pragma unroll
                    for (int n = 0; n < 2; ++n) *(f32x4*)(ckvraw + (size_t)row * KVR + ct + n * 4) = acc[ai][0][m][n] * s;
                    if (wc == 0) { const f32x4 k0 = acc[ai][1][m][0] * s, k1 = acc[ai][1][m][1] * s; pg8::u32x4 w; w.x = pkh2(k0[0], k0[1]); w.y = pkh2(k0[2], k0[3]); w.z = pkh2(k1[0], k1[1]); w.w = pkh2(k1[2], k1[3]);
                        *(pg8::u32x4*)(ik + (size_t)row * IDIM + 8 * fq) = w; }
                    if (wc == 1 && fq == 0) { *(f32x4*)(iw + (size_t)row * IH) = acc[ai][1][m][0] * s; *(f32x4*)(iw + (size_t)row * IH + 4) = acc[ai][1][m][1] * s; } }
        } else {
            bf16_t* dst0; int ld; bool sig = false; const bool f16out = (pn == 5);
            if (pn < 4) { dst0 = qa + pn * 256; ld = 1024; } else if (pn == 5) { dst0 = iqraw; ld = 256; } else if (pn == 6) { dst0 = z; ld = 256; } else if (pn == 7) { dst0 = qc; ld = 256; } else { dst0 = G + (pn - 8) * 256; ld = 3072; sig = true; }
#pragma unroll
            for (int ai = 0; ai < 2; ++ai)
#pragma unroll
                for (int m = 0; m < 4; ++m) { const int row = row0 + ai * 128 + m * 16; const float s = row_scale(ss, row); bf16_t* rowp = dst0 + (size_t)row * ld + ct;
#pragma unroll
                    for (int bj = 0; bj < 2; ++bj) { f32x4 o0 = acc[ai][bj][m][0] * s, o1 = acc[ai][bj][m][1] * s;
                        if (sig) {
#pragma unroll
                            for (int i = 0; i < 4; ++i) { o0[i] = sigmoidf_(o0[i]); o1[i] = sigmoidf_(o1[i]); } }
                        pg8::u32x4 wo;
                        if (f16out) { wo.x = pkh2(o0[0], o0[1]); wo.y = pkh2(o0[2], o0[3]); wo.z = pkh2(o1[0], o1[1]); wo.w = pkh2(o1[2], o1[3]); }
                        else { wo.x = pg8::cvt_pk_bf16(o0[0], o0[1]); wo.y = pg8::cvt_pk_bf16(o0[2], o0[3]); wo.z = pg8::cvt_pk_bf16(o1[0], o1[1]); wo.w = pg8::cvt_pk_bf16(o1[2], o1[3]); }
                        *(pg8::u32x4*)(rowp + bj * 128) = wo; } }
        }
    }
};
template <int MODE> struct EpiMerge {
    static constexpr bool PERM = false;
    bf16_t* Mg; const bf16_t* G;
    __device__ __forceinline__ void operator()(const f32x4 (&acc)[2][2][4][2], const Unit& u, int wr, int wc, int fr_, int fq_) const {
        const int l_ = lane_id_v(); const int fr = l_ & 15, fq = l_ >> 4; (void)fr_; (void)fq_;
        int rb = wr * 64 + fr, cb = wc * 32 + 4 * fq; LAUNDER2(rb, cb);
        const int row0 = u.pm * 256 + rb, col0 = u.pn * 256 + cb;
#pragma unroll
        for (int ai = 0; ai < 2; ++ai)
#pragma unroll
            for (int m = 0; m < 4; ++m) { const int row = row0 + ai * 128 + m * 16;
                const bf16_t* gp = G + (size_t)row * 3072 + MODE * 1024 + col0; bf16_t* mp = Mg + (size_t)row * D + col0;
#pragma unroll
                for (int bj = 0; bj < 2; ++bj)
#pragma unroll
                    for (int n = 0; n < 2; ++n) { const int co = bj * 128 + n * 16;
                        const pg8::u32x2 gw = *(const pg8::u32x2*)(gp + co);
                        f32x4 o = acc[ai][bj][m][n]; o[0] *= bflo(gw.x); o[1] *= bfhi(gw.x); o[2] *= bflo(gw.y); o[3] *= bfhi(gw.y);
                        if (MODE > 0) { const pg8::u32x2 pw = *(const pg8::u32x2*)(mp + co); o[0] += bflo(pw.x); o[1] += bfhi(pw.x); o[2] += bflo(pw.y); o[3] += bfhi(pw.y); }
                        *(pg8::u32x2*)(mp + co) = pack4(o); }
                asm volatile("" ::: "memory"); }
    }
};

template <class Map>
__device__ __forceinline__ void transpose_item(const float* W, int K, int N, const float* gain, bf16* WT, LAS float* scr, int item, int lane, Map map) {
    const int nblk = (N + 63) / 64, kb = item / nblk, nb = item % nblk, k0 = 64 * kb, n0 = 64 * nb;
    const int nn = n0 + 4 * (lane & 15); const bool nok = nn < N;
#pragma unroll 4
    for (int i = 0; i < 16; ++i) { const int kk = 4 * i + (lane >> 4); f32x4 v = nok ? *(const f32x4*)(W + (size_t)(k0 + kk) * N + nn) : (f32x4){0.f, 0.f, 0.f, 0.f};
        if (gain) v = v * gain[k0 + kk];
        *(LAS f32x4*)(scr + kk * 68 + 4 * (lane & 15)) = v; }
    LDS_WAIT(); asm volatile("" ::: "memory");
    const int c = lane & 7;
#pragma unroll
    for (int j = 0; j < 8; ++j) { const int n = (lane >> 3) + 8 * j; const LAS float* sp = scr + (8 * c) * 68 + n;
        v4u o; o.x = pk2(sp[0 * 68], sp[1 * 68]); o.y = pk2(sp[2 * 68], sp[3 * 68]); o.z = pk2(sp[4 * 68], sp[5 * 68]); o.w = pk2(sp[6 * 68], sp[7 * 68]);
        if (n0 + n < N) { const int dr = map(n0 + n); if (dr >= 0) *(GAS v4u*)(WT + (size_t)dr * K + k0 + 8 * c) = o; } }
    LDS_WAIT(); asm volatile("" ::: "memory");
}
struct MapId { int off; __device__ __forceinline__ int operator()(int n) const { return off + n; } };
struct MapSwiglu { __device__ __forceinline__ int operator()(int c) const { const int half = c >= DFF ? 1 : 0, j = c - half * DFF; return 256 * (j >> 7) + 128 * half + (j & 127); } };
struct MapInProj { __device__ __forceinline__ int operator()(int c) const {
    if (c < C_CKV) return -1;
    if (c < C_IQ) return 1024 + (c - C_CKV);
    if (c < C_IK) return 1280 + (c - C_IQ);
    if (c < C_IW) return 1152 + (c - C_IK);
    if (c < C_Z) return 1184 + (c - C_IW);
    if (c < C_QC) return 1536 + (c - C_Z);
    if (c < C_G) return 1792 + (c - C_QC);
    return 2048 + (c - C_G); } };
__device__ __forceinline__ void qlat_item(const float* win, const float* mixn, const float* wuk, bf16* WT, int item, int lane) {
    const int kc = item & 127, rh = (item >> 7) & 1, h = item >> 8; const int r = rh * 64 + lane;
    const f32x4* wp = (const f32x4*)(wuk + (size_t)r * (AH * AHD) + h * 64);
    float acc[8] = {0.f, 0.f, 0.f, 0.f, 0.f, 0.f, 0.f, 0.f};
#pragma unroll 1
    for (int dc = 0; dc < 4; ++dc) {
        const f32x4 w0 = wp[4 * dc], w1 = wp[4 * dc + 1], w2 = wp[4 * dc + 2], w3 = wp[4 * dc + 3];
#pragma unroll
        for (int kk = 0; kk < 8; ++kk) { const f32x4* ip = (const f32x4*)(win + (size_t)(kc * 8 + kk) * INW + h * 64 + 16 * dc);
            const f32x4 a0 = ip[0], a1 = ip[1], a2 = ip[2], a3 = ip[3];
            acc[kk] += (a0.x * w0.x + a0.y * w0.y + a0.z * w0.z + a0.w * w0.w) + (a1.x * w1.x + a1.y * w1.y + a1.z * w1.z + a1.w * w1.w)
                     + (a2.x * w2.x + a2.y * w2.y + a2.z * w2.z + a2.w * w2.w) + (a3.x * w3.x + a3.y * w3.y + a3.z * w3.z + a3.w * w3.w);
            if (kk & 1) asm volatile("" ::: "memory"); }
    }
    const f32x4 g0 = *(const f32x4*)(mixn + kc * 8), g1 = *(const f32x4*)(mixn + kc * 8 + 4);
    v4u w; w.x = pk2(acc[0] * g0.x, acc[1] * g0.y); w.y = pk2(acc[2] * g0.z, acc[3] * g0.w); w.z = pk2(acc[4] * g1.x, acc[5] * g1.y); w.w = pk2(acc[6] * g1.z, acc[7] * g1.w);
    *(GAS v4u*)(WT + (size_t)(h * 128 + r) * D + kc * 8) = w;
}
__device__ __forceinline__ void wafold_item(const float* wuv, const float* wba, bf16* WT, int item, int lane) {
    const int ng = item & 15, rg = (item >> 4) & 15, h = item >> 8; const int n = ng * 64 + lane, r0 = rg * 8;
    float acc[8] = {0.f, 0.f, 0.f, 0.f, 0.f, 0.f, 0.f, 0.f};
#pragma unroll 4
    for (int d = 0; d < 64; ++d) { const float wa = wba[(size_t)(h * 64 + d) * D + n];
#pragma unroll
        for (int j = 0; j < 8; ++j) acc[j] += wuv[(size_t)(r0 + j) * (AH * AHD) + h * 64 + d] * wa; }
    v4u w; w.x = pk2(acc[0], acc[1]); w.y = pk2(acc[2], acc[3]); w.z = pk2(acc[4], acc[5]); w.w = pk2(acc[6], acc[7]);
    *(GAS v4u*)(WT + (size_t)n * 1024 + h * 128 + r0) = w;
}
__device__ __forceinline__ int items_of(int K, int N) { return (K / 64) * ((N + 63) / 64); }

__device__ __forceinline__ void prep_layer_weights_body(const PC& F, int l) {
    struct { const float* const* in; } a{F.in};
    const int lane_ = lane_id_v();
    LAS float* scr = (LAS float*)(F.lds + RING_OFF + F.wave * 17408);
    const int gw = F.vcu * NWAVES + F.wave, NGW = F.G * NWAVES;
    const float* f1n = a.in[3] + (size_t)l * D; const float* f1in = a.in[4] + (size_t)l * D * 2 * DFF; const float* f1out = a.in[5] + (size_t)l * DFF * D;
    const float* mixn = a.in[6] + (size_t)l * D; const float* win = a.in[7] + (size_t)l * D * INW;
    const float* wba = a.in[15] + (size_t)l * AW * D; const float* wbb = a.in[16] + (size_t)l * PW_ * D; const float* wbc = a.in[17] + (size_t)l * CW * D;
    const float* wout = a.in[18] + (size_t)l * D * D;
    const float* f2n = a.in[19] + (size_t)l * D; const float* f2in = a.in[20] + (size_t)l * D * 2 * DFF; const float* f2out = a.in[21] + (size_t)l * DFF * D;
    unsigned char* ws = launder_p(F.ws);
    const float* wuk = a.in[9] + (size_t)l * KVR * AH * AHD; const float* wuv = a.in[10] + (size_t)l * KVR * AH * AHD;
    const int I0 = items_of(D, 2 * DFF), I1 = items_of(DFF, D), I2 = items_of(D, INW), I4 = items_of(PW_, D), I5 = items_of(CW, D), I6 = items_of(D, D);
    const int NIT = 2 * I0 + 2 * I1 + I2 + I4 + I5 + I6;
#pragma unroll 1
    for (int it = gw; it < NIT; it += NGW) {
        int r = it;
        if (r < I0) { transpose_item(f1in, D, 2 * DFF, f1n, (bf16*)(ws + WS_W1IN), scr, r, lane_, MapSwiglu{}); continue; } r -= I0;
        if (r < I0) { transpose_item(f2in, D, 2 * DFF, f2n, (bf16*)(ws + WS_W2IN), scr, r, lane_, MapSwiglu{}); continue; } r -= I0;
        if (r < I1) { transpose_item(f1out, DFF, D, nullptr, (bf16*)(ws + WS_W1OUT), scr, r, lane_, MapId{0}); continue; } r -= I1;
        if (r < I1) { transpose_item(f2out, DFF, D, nullptr, (bf16*)(ws + WS_W2OUT), scr, r, lane_, MapId{0}); continue; } r -= I1;
        if (r < I2) { transpose_item(win, D, INW, mixn, (bf16*)(ws + WS_WIN), scr, r, lane_, MapInProj{}); continue; } r -= I2;
        if (r < I4) { transpose_item(wbb, PW_, D, nullptr, (bf16*)(ws + WS_WB), scr, r, lane_, MapId{0}); continue; } r -= I4;
        if (r < I5) { transpose_item(wbc, CW, D, nullptr, (bf16*)(ws + WS_WC), scr, r, lane_, MapId{0}); continue; } r -= I5;
        transpose_item(wout, D, D, nullptr, (bf16*)(ws + WS_WOUT), scr, r, lane_, MapId{0});
    }
    { const float* wpool = a.in[11] + (size_t)l * 4 * 64 * 64; bf16* wpT = (bf16*)(ws + WS_WPT);
      for (int i = gw * 64 + lane_; i < 4 * 64 * 64; i += NGW * 64) { const int c = i & 63, d = (i >> 6) & 63, g = i >> 12; wpT[i] = (bf16)f2bf(wpool[(g * 64 + c) * 64 + d]); } }
    asm volatile("" ::: "memory");
#pragma unroll 1
    for (int it = gw; it < 2048; it += NGW) wafold_item(wuv, wba, (bf16*)(ws + WS_WA), it, lane_);
    asm volatile("" ::: "memory");
#pragma unroll 1
    for (int it = gw; it < 2048; it += NGW) qlat_item(win, mixn, wuk, (bf16*)(ws + WS_WIN), it, lane_);
}

__device__ __noinline__ void p0_prologue(const float* const* in_, float* out_, unsigned char* ws_, LAS unsigned char* lds_, int wave_, int vcu_, int G_) {
    const PC F{uni(in_), uni(out_), uni(ws_), uni_l(lds_), uni_i(wave_), uni_i(vcu_), uni_i(G_)}; struct { const float* const* in; } a{F.in};
    const int lane_ = lane_id_v();
    const int gw = F.vcu * NWAVES + F.wave, NGW = F.G * NWAVES;
    const float* x = a.in[0]; const float* mem = a.in[1];
    bf16* hb = (bf16*)(F.ws + WS_HB); float* ss = (float*)(F.ws + WS_SS); bf16* memn = (bf16*)(F.ws + WS_MEMN);
    for (int m = gw; m < M + MROWS; m += NGW) {
        const bool ismem = m >= M; const int r = ismem ? m - M : m;
        const GAS f32x4* xr = (const GAS f32x4*)((ismem ? mem : x) + (size_t)r * D) + lane_;
        f32x4 v[4]; float s = 0.f;
#pragma unroll
        for (int j = 0; j < 4; ++j) { v[j] = xr[64 * j]; s += (v[j].x * v[j].x + v[j].y * v[j].y) + (v[j].z * v[j].z + v[j].w * v[j].w); }
        s = wave_sum(s);
        float sc = 1.f;
        if (ismem) sc = 1.0f / sqrtf(s * (1.0f / D) + EPS);
        else if (lane_ < 4) ss[(size_t)r * 4 + lane_] = lane_ == 0 ? s : 0.f;
        GAS unsigned long long* o8 = (GAS unsigned long long*)((ismem ? memn : hb) + (size_t)r * D) + lane_;
#pragma unroll
        for (int j = 0; j < 4; ++j) o8[64 * j] = (unsigned long long)pk2(v[j].x * sc, v[j].y * sc) | ((unsigned long long)pk2(v[j].z * sc, v[j].w * sc) << 32);
    }
    LAS float* scr = (LAS float*)(F.lds + RING_OFF + F.wave * 17408);
    const int IM = items_of(D, 2 * CW);
    for (int it = gw; it < DEPTH * IM; it += NGW) { const int l = it / IM, r = it % IM;
        transpose_item(a.in[14] + (size_t)l * D * 2 * CW, D, 2 * CW, a.in[13] + (size_t)l * D, (bf16*)(F.ws + WS_WMEM), scr, r, lane_, MapId{l * 2 * CW}); }
    prep_layer_weights_body(F, 0);
}
__device__ __noinline__ void prep_layer_weights(const float* const* in_, float* out_, unsigned char* ws_, LAS unsigned char* lds_, int l, int wave_, int vcu_, int G_) {
    const PC F{uni(in_), uni(out_), uni(ws_), uni_l(lds_), uni_i(wave_), uni_i(vcu_), uni_i(G_)}; prep_layer_weights_body(F, uni_i(l));
}

__constant__ unsigned char T5_BUCKET[128] = {0, 1, 2, 3, 4, 5, 6, 7, 8, 9, 10, 11, 12, 13, 14, 15, 16, 16, 16, 17, 17, 18, 18, 18, 19, 19, 19, 20, 20, 20, 20, 21, 21, 21, 21, 22, 22, 22, 22, 22, 23, 23, 23, 23, 23, 23, 24, 24, 24, 24, 24, 24, 25, 25, 25, 25, 25, 25, 25, 26, 26, 26, 26, 26, 26, 26, 26, 27, 27, 27, 27, 27, 27, 27, 27, 27, 27, 28, 28, 28, 28, 28, 28, 28, 28, 28, 28, 29, 29, 29, 29, 29, 29, 29, 29, 29, 29, 29, 29, 30, 30, 30, 30, 30, 30, 30, 30, 30, 30, 30, 30, 30, 30, 31, 31, 31, 31, 31, 31, 31, 31, 31, 31, 31, 31, 31, 31, 31};

typedef short bf16x8_p __attribute__((ext_vector_type(8)));
__device__ __forceinline__ void prep_tokens(const float* const* in_, float* out_, unsigned char* ws_, LAS unsigned char* lds_, int l_, int wave_, int vcu_, int G_, int dry_) {
    const int dry = uni_i(dry_);
    const PC F{uni(in_), uni(out_), uni(ws_), uni_l(lds_), uni_i(wave_), uni_i(vcu_), uni_i(G_)}; struct { const float* const* in; } a{F.in}; const int l = uni_i(l_);
    unsigned char* ws = launder_p(F.ws);
    const float* ckvraw = (const float*)(ws + WS_CKVRAW); bf16* ckv = (bf16*)(ws + WS_CKV);
    const bf16* iqraw = (const bf16*)(ws + WS_IQRAW); bf16* iqf = (bf16*)(ws + WS_IQF); const float* iw = (const float*)(ws + WS_IW); unsigned* sgn = (unsigned*)(ws + WS_SGN);
    const bf16* z = (const bf16*)(ws + WS_Z); bf16* yb = (bf16*)(ws + WS_YB); bf16* qc = (bf16*)(ws + WS_QC);
    const bf16* memkv = (const bf16*)(ws + WS_MEMKV); const bf16* vT = (const bf16*)(ws + WS_VT); const bf16* wpT = (const bf16*)(ws + WS_WPT);
    const float* kvn = a.in[8] + (size_t)l * KVR; const float* pscale = a.in[12] + (size_t)l * PW_;
    const int lane = lane_id_v(), tid = F.wave * 64 + lane;
    const int tok = lane & 15, g4 = lane >> 4;
    LAS unsigned char* Ks = F.lds;
    LAS unsigned char* Vs = F.lds + 36864;
    for (int blk = F.vcu; blk < M / 128; blk += F.G) {
        const int rowb = blk * 128, b = rowb / SEQ, row0 = rowb + F.wave * 16;
#pragma unroll 1
        for (int tt = 0; tt < 16; ++tt) { const int row = row0 + tt;
            { const f32x2 v = *(const f32x2*)(ckvraw + (size_t)row * KVR + 2 * lane); const float q = wave_sum(v.x * v.x + v.y * v.y);
              const float rs = 1.0f / sqrtf(q * (1.0f / KVR) + EPS); const f32x2 g = *(const f32x2*)(kvn + 2 * lane);
              *(unsigned*)(ckv + (size_t)row * KVR + 2 * lane) = pk2(v.x * rs * g.x, v.y * rs * g.y); }
            { const float wv = iw[(size_t)row * IH + (lane >> 3)]; const float aw = fabsf(wv) * (1.0f / 16.0f);
              const v2u q = *(const v2u*)(iqraw + (size_t)row * 256 + 4 * lane);
              v2u o; o.x = pkh2(hlo(q.x) * aw, hhi(q.x) * aw); o.y = pkh2(hlo(q.y) * aw, hhi(q.y) * aw);
              *(v2u*)(iqf + (size_t)row * 256 + 4 * lane) = o;
              const unsigned long long bal = __ballot(wv < 0.f);
              unsigned mask = 0;
#pragma unroll
              for (int h = 0; h < 8; ++h) mask |= ((unsigned)(bal >> (8 * h)) & 1u) << h;
              if (lane == 0) sgn[row] = mask; } }
        { const int row = row0 + tok, spos = row % SEQ;
#pragma unroll 1
          for (int g = 0; g < 4; ++g) { const int w = 2 << g; const int cnt = (spos + 1) < w ? (spos + 1) : w; const float rc = 1.0f / (float)cnt;
              bf16x8_p pf[2];
#pragma unroll
              for (int ks = 0; ks < 2; ++ks) { const int c0 = g * 64 + 32 * ks + 8 * g4; float sum[8], z0[8];
#pragma unroll
                  for (int e = 0; e < 8; ++e) { sum[e] = 0.f; z0[e] = 0.f; }
                  for (int j = 0; j < w; ++j) { if (j < cnt) { const v4u v = *(const v4u*)(z + (size_t)(row - j) * 256 + c0);
                      const float f[8] = {bflo(v.x), bfhi(v.x), bflo(v.y), bfhi(v.y), bflo(v.z), bfhi(v.z), bflo(v.w), bfhi(v.w)};
#pragma unroll
                      for (int e = 0; e < 8; ++e) { sum[e] += f[e]; if (j == 0) z0[e] = f[e]; } } }
                  v4u pw; pw.x = pk2(sum[0] * rc - z0[0], sum[1] * rc - z0[1]); pw.y = pk2(sum[2] * rc - z0[2], sum[3] * rc - z0[3]); pw.z = pk2(sum[4] * rc - z0[4], sum[5] * rc - z0[5]); pw.w = pk2(sum[6] * rc - z0[6], sum[7] * rc - z0[7]);
                  pf[ks] = __builtin_bit_cast(bf16x8_p, pw); }
#pragma unroll
              for (int dt = 0; dt < 4; ++dt) { f32x4 acc = {0.f, 0.f, 0.f, 0.f};
#pragma unroll
                  for (int ks = 0; ks < 2; ++ks) { const bf16x8_p af = *(const bf16x8_p*)(wpT + (size_t)(g * 64 + 16 * dt + tok) * 64 + 32 * ks + 8 * g4); acc = __builtin_amdgcn_mfma_f32_16x16x32_bf16(af, pf[ks], acc, 0, 0, 0); }
                  const f32x4 ps = *(const f32x4*)(pscale + g * 64 + 16 * dt + 4 * g4);
                  v2u o; o.x = pk2(acc[0] * ps.x, acc[1] * ps.y); o.y = pk2(acc[2] * ps.z, acc[3] * ps.w);
                  *(v2u*)(yb + (size_t)row * 256 + g * 64 + 16 * dt + 4 * g4) = o; } } }
#pragma unroll 1
        for (int h = 0; h < CH; ++h) {
            __syncthreads();
#pragma unroll
            for (int e = 0; e < 4; ++e) { const int i = tid + 512 * e;
                { const int m = i >> 3, c = i & 7; const v4u v = *(const v4u*)(memkv + (size_t)(b * NMEM + m) * 2048 + l * 512 + h * 64 + c * 8); *(LAS v4u*)(Ks + m * 144 + c * 16) = v; }
                { const int d = i >> 5, c = i & 31; const v4u v = *(const v4u*)(vT + (size_t)(l * 512 + 256 + h * 64 + d) * MROWS + b * NMEM + c * 8); *(LAS v4u*)(Vs + d * 528 + c * 16) = v; } }
            LDS_WAIT(); __syncthreads();
            const int row = row0 + tok;
            bf16x8_p qf[2];
#pragma unroll
            for (int ks = 0; ks < 2; ++ks) qf[ks] = *(const bf16x8_p*)(qc + (size_t)row * 256 + h * 64 + 32 * ks + 8 * g4);
            f32x4 S[16]; float mx = -1e30f;
#pragma unroll
            for (int mt = 0; mt < 16; ++mt) { f32x4 acc = {0.f, 0.f, 0.f, 0.f};
#pragma unroll
                for (int ks = 0; ks < 2; ++ks) { const bf16x8_p kf = *(const LAS bf16x8_p*)(Ks + (16 * mt + tok) * 144 + (4 * ks + g4) * 16); acc = __builtin_amdgcn_mfma_f32_16x16x32_bf16(kf, qf[ks], acc, 0, 0, 0); }
                S[mt] = acc; mx = fmaxf(mx, fmaxf(fmaxf(acc[0], acc[1]), fmaxf(acc[2], acc[3]))); if ((mt & 3) == 3) __builtin_amdgcn_sched_barrier(0); }
            mx = fmaxf(mx, __shfl_xor(mx, 16)); mx = fmaxf(mx, __shfl_xor(mx, 32));
            float sm = 0.f;
#pragma unroll
            for (int mt = 0; mt < 16; ++mt)
#pragma unroll
                for (int r = 0; r < 4; ++r) { const float p = __expf((S[mt][r] - mx) * 0.125f); S[mt][r] = p; sm += p; }
            sm += __shfl_xor(sm, 16); sm += __shfl_xor(sm, 32);
            const float inv = 1.0f / sm;
            f32x4 oacc[4];
#pragma unroll
            for (int dt = 0; dt < 4; ++dt) oacc[dt] = (f32x4){0.f, 0.f, 0.f, 0.f};
#pragma unroll
            for (int kk = 0; kk < 8; ++kk) { v4u pw; pw.x = pg8::cvt_pk_bf16(S[2 * kk][0], S[2 * kk][1]); pw.y = pg8::cvt_pk_bf16(S[2 * kk][2], S[2 * kk][3]); pw.z = pg8::cvt_pk_bf16(S[2 * kk + 1][0], S[2 * kk + 1][1]); pw.w = pg8::cvt_pk_bf16(S[2 * kk + 1][2], S[2 * kk + 1][3]);
                const bf16x8_p pfr = __builtin_bit_cast(bf16x8_p, pw);
#pragma unroll
                for (int dt = 0; dt < 4; ++dt) { const LAS unsigned char* vp = Vs + (16 * dt + tok) * 528 + (32 * kk + 4 * g4) * 2;
                    const v2u lo = *(const LAS v2u*)vp, hi = *(const LAS v2u*)(vp + 32);
                    v4u vw; vw.x = lo.x; vw.y = lo.y; vw.z = hi.x; vw.w = hi.y;
                    oacc[dt] = __builtin_amdgcn_mfma_f32_16x16x32_bf16(__builtin_bit_cast(bf16x8_p, vw), pfr, oacc[dt], 0, 0, 0); }
                __builtin_amdgcn_sched_barrier(0); }
#pragma unroll
            for (int dt = 0; dt < 4; ++dt) { v2u o; o.x = pk2(oacc[dt][0] * inv, oacc[dt][1] * inv); o.y = pk2(oacc[dt][2] * inv, oacc[dt][3] * inv);
                if (!dry) *(v2u*)(qc + (size_t)row * 256 + h * 64 + 16 * dt + 4 * g4) = o; else asm volatile("" :: "v"(o.x), "v"(o.y)); }
        }
    }
    __syncthreads();
}

__device__ __forceinline__ unsigned key_of(float s) { const unsigned u = __builtin_bit_cast(unsigned, s); return (u & 0x80000000u) ? ~u : (u | 0x80000000u); }

typedef short bf16x8_t __attribute__((ext_vector_type(8)));
typedef short s16x4_t __attribute__((ext_vector_type(4)));
__device__ __forceinline__ void glds16(const void* gsrc, unsigned lds_dst) { unsigned keep;
    asm volatile("s_mov_b32 %0, m0\n\ts_mov_b32 m0, %2\n\ts_nop 0\n\tglobal_load_lds_dwordx4 %1, off\n\ts_mov_b32 m0, %0" : "=&s"(keep) : "v"(gsrc), "s"(lds_dst) : "memory"); }
typedef float f32x16 __attribute__((ext_vector_type(16)));
constexpr int SEL_CAP = 256;
constexpr int HSTR = 264;
constexpr int SL_HIST = 0, SL_SEL = 0, SL_CS = 32768, SL_CI = 98304, SL_KEYS = 131072, SL_ST = 147456;

#define SEL_DECLS \
    LAS unsigned char* const lds = uni_l(lds_); const int wave = uni_i(wave_), b = uni_i(b_), ub = uni_i(ub_); unsigned char* ws = uni(ws_); \
    const bf16* iqf = (const bf16*)(ws + WS_IQF); const unsigned* sgn = (const unsigned*)(ws + WS_SGN); const bf16* ik = (const bf16*)(ws + WS_IK); \
    const int lane = lane_id_v(), tid = wave * 64 + lane; const int kl = lane & 31, c5 = lane >> 5; \
    LAS unsigned* hist = (LAS unsigned*)(lds + SL_HIST); LAS unsigned short* lsel = (LAS unsigned short*)(lds + SL_SEL); LAS float* lcs = (LAS float*)(lds + SL_CS); \
    LAS unsigned short* lci = (LAS unsigned short*)(lds + SL_CI); LAS unsigned* st = (LAS unsigned*)(lds + SL_ST); LAS float* stf = (LAS float*)(lds + SL_ST); \
    const int t0 = ub * 64; const int q0 = b * SEQ + t0; const bf16* ikb = ik + (size_t)b * SEQ * IDIM; const int ntile = (t0 + 64 + 127) >> 7; \
    (void)hist; (void)lsel; (void)lcs; (void)lci; (void)stf; (void)tid;
#define SEL_LOAD_A \
    bf16x8_t af[2][2]; float sgc[2][16]; \
    { const int i = kl, a_ = i >> 3, cc_ = (i >> 2) & 1, e_ = i & 3; const int qq_ = 2 * cc_ + (a_ >> 1), hh_ = 4 * (a_ & 1) + e_; \
      _Pragma("unroll") for (int rt = 0; rt < 2; ++rt) { const unsigned flip_ = ((sgn[q0 + 8 * wave + 4 * rt + qq_] >> hh_) & 1u) ? 0x80008000u : 0u;     \
          _Pragma("unroll") for (int ks = 0; ks < 2; ++ks) { v4u w_ = *(const v4u*)(iqf + (size_t)(q0 + 8 * wave + 4 * rt + qq_) * 256 + hh_ * 32 + 16 * ks + 8 * c5); \
              w_.x ^= flip_; w_.y ^= flip_; w_.z ^= flip_; w_.w ^= flip_; af[rt][ks] = __builtin_bit_cast(bf16x8_t, w_); } } \
      _Pragma("unroll") for (int rt = 0; rt < 2; ++rt) _Pragma("unroll") for (int u = 0; u < 2; ++u) { const unsigned m_ = sgn[q0 + 8 * wave + 4 * rt + 2 * c5 + u]; \
          _Pragma("unroll") for (int h = 0; h < 8; ++h) sgc[rt][8 * u + h] = ((m_ >> h) & 1u) ? -__builtin_inff() : __builtin_inff(); } }
#define SEL_STAGE(kt_) do { const int key_ = 16 * wave + (lane >> 2); const int ch_ = (lane & 3) ^ ((key_ >> 2) & 3); \
    glds16(ikb + (size_t)(128 * (kt_) + key_) * IDIM + ch_ * 8, (unsigned)__builtin_amdgcn_readfirstlane((int)(unsigned)(size_t)(lds + SL_KEYS + ((kt_) & 1) * 8192 + wave * 1024))); } while (0)
#define SEL_MMA(acc_, rt_, kh_) do { acc_ = (f32x16){0.f,0.f,0.f,0.f,0.f,0.f,0.f,0.f,0.f,0.f,0.f,0.f,0.f,0.f,0.f,0.f}; \
    acc_ = __builtin_amdgcn_mfma_f32_32x32x16_f16(__builtin_bit_cast(f16x8_t, af[rt_][0]), __builtin_bit_cast(f16x8_t, bfr_[kh_][0]), acc_, 0, 0, 0); \
    acc_ = __builtin_amdgcn_mfma_f32_32x32x16_f16(__builtin_bit_cast(f16x8_t, af[rt_][1]), __builtin_bit_cast(f16x8_t, bfr_[kh_][1]), acc_, 0, 0, 0); } while (0)
#define SEL_SUM(acc_, rt_, kh_) do { _Pragma("unroll") for (int u = 0; u < 2; ++u) { float s_ = 0.f; \
    _Pragma("unroll") for (int h = 0; h < 8; ++h) s_ += __builtin_amdgcn_fmed3f(acc_[8 * u + h], 0.f, sgc[rt_][8 * u + h]); \
    sc[rt_][kh_][u] = s_; } } while (0)
#define SEL_SCORES(kt_) do { const LAS unsigned char* kb_ = lds + SL_KEYS + ((kt_) & 1) * 8192; bf16x8_t bfr_[4][2]; \
    _Pragma("unroll") for (int kh = 0; kh < 4; ++kh) { const int key_ = 32 * kh + kl; \
        bfr_[kh][0] = *(const LAS bf16x8_t*)(kb_ + key_ * 64 + 16 * ((0 + c5) ^ ((key_ >> 2) & 3))); \
        bfr_[kh][1] = *(const LAS bf16x8_t*)(kb_ + key_ * 64 + 16 * ((2 + c5) ^ ((key_ >> 2) & 3))); } \
    f32x16 accA_, accB_; \
    SEL_MMA(accA_, 0, 0); \
    SEL_MMA(accB_, 1, 0); __builtin_amdgcn_sched_barrier(0); SEL_SUM(accA_, 0, 0); __builtin_amdgcn_sched_barrier(0); \
    SEL_MMA(accA_, 0, 1); __builtin_amdgcn_sched_barrier(0); SEL_SUM(accB_, 1, 0); __builtin_amdgcn_sched_barrier(0); \
    SEL_MMA(accB_, 1, 1); __builtin_amdgcn_sched_barrier(0); SEL_SUM(accA_, 0, 1); __builtin_amdgcn_sched_barrier(0); \
    SEL_MMA(accA_, 0, 2); __builtin_amdgcn_sched_barrier(0); SEL_SUM(accB_, 1, 1); __builtin_amdgcn_sched_barrier(0); \
    SEL_MMA(accB_, 1, 2); __builtin_amdgcn_sched_barrier(0); SEL_SUM(accA_, 0, 2); __builtin_amdgcn_sched_barrier(0); \
    SEL_MMA(accA_, 0, 3); __builtin_amdgcn_sched_barrier(0); SEL_SUM(accB_, 1, 2); __builtin_amdgcn_sched_barrier(0); \
    SEL_MMA(accB_, 1, 3); __builtin_amdgcn_sched_barrier(0); SEL_SUM(accA_, 0, 3); __builtin_amdgcn_sched_barrier(0); \
    SEL_SUM(accB_, 1, 3); } while (0)
#define SEL_BOUNDARY(FINAL) do { \
    const int qq = tid >> 3, part = tid & 7; const LAS v4u* hp = (const LAS v4u*)(hist + qq * HSTR + 32 * part); \
    unsigned bins[32]; \
    _Pragma("unroll") for (int i = 0; i < 8; ++i) { const v4u v = hp[i]; bins[4 * i] = v.x; bins[4 * i + 1] = v.y; bins[4 * i + 2] = v.z; bins[4 * i + 3] = v.w; } \
    unsigned ps = 0; \
    _Pragma("unroll") for (int i = 0; i < 32; ++i) ps += bins[i]; \
    unsigned v = ps, tt; \
    tt = __shfl_down(v, 1, 8); if (part + 1 < 8) v += tt; \
    tt = __shfl_down(v, 2, 8); if (part + 2 < 8) v += tt; \
    tt = __shfl_down(v, 4, 8); if (part + 4 < 8) v += tt; \
    unsigned cacc = v - ps; \
    if (cacc < (unsigned)TOPK && v >= (unsigned)TOPK) { int bsel = 0; unsigned na = 0, cb = 0; bool found = false; \
        _Pragma("unroll") for (int i = 31; i >= 0; --i) { const bool hit = !found && (cacc + bins[i] >= (unsigned)TOPK); if (hit) { bsel = i; na = cacc; cb = bins[i]; found = true; } cacc += bins[i]; } \
        st[128 + qq] = (unsigned)(32 * part + bsel); if (FINAL) { st[192 + qq] = na; st[256 + qq] = cb; st[448 + qq] = cb > (unsigned)SEL_CAP ? 1u : 0u; } } } while (0)

__device__ __forceinline__ void sel_pass1(unsigned char* ws_, LAS unsigned char* lds_, int wave_, int b_, int ub_) {
    SEL_DECLS
    unsigned short* sel = (unsigned short*)(ws + WS_SEL);
    __syncthreads();
    if (ub < 4) {
        for (int i = tid; i < 64 * TOPK; i += NWAVES * 64) { const int qq = i >> 8, sl = i & 255; sel[(size_t)(q0 + qq) * TOPK + sl] = (unsigned short)(sl <= t0 + qq ? sl : 0); }
        if (tid == 0) st[512] = 1u;
        asm volatile("s_waitcnt vmcnt(0) lgkmcnt(0)" ::: "memory"); __syncthreads();
        return;
    }
    SEL_LOAD_A
    for (int i = tid; i < 64 * HSTR; i += NWAVES * 64) hist[i] = 0u;
    if (tid < 64) { st[128 + tid] = 0u; st[448 + tid] = 0u; }
    if (tid == 0) st[512] = 0u;
    float sc[2][4][2];
    float scl[2][2]; int bcur[2][2];
#pragma unroll
    for (int rt = 0; rt < 2; ++rt)
#pragma unroll
        for (int u = 0; u < 2; ++u) { scl[rt][u] = 0.f; bcur[rt][u] = 0; }
    SEL_STAGE(0);
#pragma unroll 1
    for (int kt = 0; kt < ntile; ++kt) {
        asm volatile("s_waitcnt vmcnt(0) lgkmcnt(0)" ::: "memory"); __syncthreads();
        if (kt > 0 && (kt & 3) == 0) {
            SEL_BOUNDARY(false);
            asm volatile("s_waitcnt lgkmcnt(0)" ::: "memory"); __syncthreads();
#pragma unroll
            for (int rt = 0; rt < 2; ++rt)
#pragma unroll
                for (int u = 0; u < 2; ++u) bcur[rt][u] = (int)st[128 + 8 * wave + 4 * rt + 2 * c5 + u];
        }
        if (kt + 1 < ntile) SEL_STAGE(kt + 1);
        SEL_SCORES(kt);
        if (kt == 0) {
#pragma unroll
            for (int rt = 0; rt < 2; ++rt)
#pragma unroll
                for (int u = 0; u < 2; ++u) { float mx = 0.f;
#pragma unroll
                    for (int kh = 0; kh < 4; ++kh) mx = fmaxf(mx, fabsf(sc[rt][kh][u]));
#pragma unroll
                    for (int o = 1; o < 32; o <<= 1) mx = fmaxf(mx, __shfl_xor(mx, o));
                    const float R = mx > 0.f ? mx : 1.0f;
                    scl[rt][u] = 128.0f / R;
                    if (kl == 0) stf[8 * wave + 4 * rt + 2 * c5 + u] = scl[rt][u]; }
        }
        const bool masked = 128 * kt + 127 > t0;
#pragma unroll
        for (int rt = 0; rt < 2; ++rt)
#pragma unroll
            for (int u = 0; u < 2; ++u) { const int qq = 8 * wave + 4 * rt + 2 * c5 + u; const int lim = masked ? (t0 + qq - 128 * kt - kl) : 1000;
#pragma unroll
                for (int kh = 0; kh < 4; ++kh) { const float fb = __builtin_amdgcn_fmed3f(fmaf(sc[rt][kh][u], scl[rt][u], 128.0f), 0.f, 255.f);
                    if (fb >= (float)bcur[rt][u] && 32 * kh <= lim) (void)__hip_atomic_fetch_add(hist + qq * HSTR + (int)fb, 1u, __ATOMIC_RELAXED, __HIP_MEMORY_SCOPE_WORKGROUP); } }
    }
    asm volatile("s_waitcnt vmcnt(0) lgkmcnt(0)" ::: "memory"); __syncthreads();
    SEL_BOUNDARY(true);
    if (tid < 64) { st[320 + tid] = 0u; st[384 + tid] = 0u; }
    asm volatile("s_waitcnt lgkmcnt(0)" ::: "memory"); __syncthreads();
}
__device__ __forceinline__ void sel_pass2(unsigned char* ws_, LAS unsigned char* lds_, int wave_, int b_, int ub_) {
    SEL_DECLS
    if (st[512] != 0u) return;
    if (tid < 64) { st[320 + tid] = 0u; st[384 + tid] = 0u; }
    SEL_LOAD_A
    float sc[2][4][2];
    float scl[2][2]; int bcur[2][2];
#pragma unroll
    for (int rt = 0; rt < 2; ++rt)
#pragma unroll
        for (int u = 0; u < 2; ++u) { const int qq = 8 * wave + 4 * rt + 2 * c5 + u; scl[rt][u] = stf[qq]; bcur[rt][u] = (int)st[128 + qq]; }
    SEL_STAGE(0);
#pragma unroll 1
    for (int kt = 0; kt < ntile; ++kt) {
        asm volatile("s_waitcnt vmcnt(0) lgkmcnt(0)" ::: "memory"); __syncthreads();
        if (kt + 1 < ntile) SEL_STAGE(kt + 1);
        SEL_SCORES(kt);
        const bool masked = 128 * kt + 127 > t0;
        unsigned okm = 0u, abm = 0u; unsigned basea[2][2], basec[2][2];
#pragma unroll
        for (int rt = 0; rt < 2; ++rt)
#pragma unroll
            for (int u = 0; u < 2; ++u) { const int qq = 8 * wave + 4 * rt + 2 * c5 + u; const int lim = masked ? (t0 + qq - 128 * kt - kl) : 1000; unsigned na_ = 0u, nc_ = 0u;
#pragma unroll
                for (int kh = 0; kh < 4; ++kh) { const float fb = __builtin_amdgcn_fmed3f(fmaf(sc[rt][kh][u], scl[rt][u], 128.0f), 0.f, 255.f);
                    const bool ok = fb >= (float)bcur[rt][u] && 32 * kh <= lim; const bool ab = fb >= (float)(bcur[rt][u] + 1);
                    if (ok) { okm |= 1u << (rt * 8 + u * 4 + kh); if (ab) { abm |= 1u << (rt * 8 + u * 4 + kh); ++na_; } else ++nc_; } }
                basea[rt][u] = 0u; basec[rt][u] = 0u;
                if (na_) basea[rt][u] = __hip_atomic_fetch_add(st + 320 + qq, na_, __ATOMIC_RELAXED, __HIP_MEMORY_SCOPE_WORKGROUP);
                if (nc_) basec[rt][u] = __hip_atomic_fetch_add(st + 384 + qq, nc_, __ATOMIC_RELAXED, __HIP_MEMORY_SCOPE_WORKGROUP); }
        if (okm != 0u) {
#pragma unroll
            for (int rt = 0; rt < 2; ++rt)
#pragma unroll
                for (int u = 0; u < 2; ++u) { const int qq = 8 * wave + 4 * rt + 2 * c5 + u; unsigned sa = basea[rt][u], scn = basec[rt][u];
#pragma unroll
                    for (int kh = 0; kh < 4; ++kh) { const int bit = rt * 8 + u * 4 + kh; const int kpos = 128 * kt + 32 * kh + kl;
                        if ((okm >> bit) & 1u) {
                            if ((abm >> bit) & 1u) { if (sa < (unsigned)TOPK) lsel[qq * 256 + sa] = (unsigned short)kpos; ++sa; }
                            else { if (scn < (unsigned)SEL_CAP) { lcs[qq * SEL_CAP + scn] = sc[rt][kh][u]; lci[qq * SEL_CAP + scn] = (unsigned short)kpos; } ++scn; } } } }
        }
    }
    asm volatile("s_waitcnt vmcnt(0) lgkmcnt(0)" ::: "memory"); __syncthreads();
}
__device__ __forceinline__ void sel_resolve(unsigned char* ws_, LAS unsigned char* lds_, int wave_, int b_, int ub_, int wg_, int first_) {
    SEL_DECLS
    const int wg = uni_i(wg_), first = uni_i(first_);
    unsigned short* sel = (unsigned short*)(ws + WS_SEL);
    gu32* slowl = (gu32*)(ws + WS_CTL + 65536) + (size_t)wg * 132;
    if (first && tid == 0) __hip_atomic_store(slowl, 0u, RLX_AGENT);
    if (st[512] != 0u) return;
#pragma unroll 1
    for (int qi = 0; qi < 8; ++qi) { const int qq = 8 * wave + qi; const int q = q0 + qq;
        const int na = (int)st[192 + qq], need = TOPK - na; int C = (int)st[384 + qq]; C = C < SEL_CAP ? C : SEL_CAP;
        const bool slow = st[448 + qq] != 0u;
        if (!slow) {
            LAS unsigned* sh = (LAS unsigned*)(lds + SL_KEYS + wave * 2048); LAS float* sls = (LAS float*)(lds + SL_KEYS + wave * 2048 + 256); LAS unsigned short* sli = (LAS unsigned short*)(lds + SL_KEYS + wave * 2048 + 1280);
            const float sclq = stf[qq]; const float fbase = (float)(int)st[128 + qq];
            sh[lane] = 0u;
            float cs[SEL_CAP / 64]; int ci[SEL_CAP / 64], sb[SEL_CAP / 64];
#pragma unroll
            for (int e = 0; e < SEL_CAP / 64; ++e) { const int i = lane + 64 * e; cs[e] = 0.f; ci[e] = 0; sb[e] = -1;
                if (i < C) { cs[e] = lcs[qq * SEL_CAP + i]; ci[e] = lci[qq * SEL_CAP + i];
                    const float fr_ = (fmaf(cs[e], sclq, 128.0f) - fbase) * 64.0f; sb[e] = (int)__builtin_amdgcn_fmed3f(fr_, 0.f, 63.f); } }
            LDS_WAIT();
#pragma unroll
            for (int e = 0; e < SEL_CAP / 64; ++e) if (sb[e] >= 0) (void)__hip_atomic_fetch_add(sh + sb[e], 1u, __ATOMIC_RELAXED, __HIP_MEMORY_SCOPE_WORKGROUP);
            LDS_WAIT();
            const unsigned cl = sh[lane];
            unsigned v = cl, tt;
            tt = __shfl_down(v, 1); if (lane + 1 < 64) v += tt;
            tt = __shfl_down(v, 2); if (lane + 2 < 64) v += tt;
            tt = __shfl_down(v, 4); if (lane + 4 < 64) v += tt;
            tt = __shfl_down(v, 8); if (lane + 8 < 64) v += tt;
            tt = __shfl_down(v, 16); if (lane + 16 < 64) v += tt;
            tt = __shfl_down(v, 32); if (lane + 32 < 64) v += tt;
            const unsigned ab_ = v - cl;
            const unsigned long long cross = __ballot(ab_ < (unsigned)need && v >= (unsigned)need);
            const int sstar = cross ? (int)__builtin_ctzll(cross) : 0;
            const int na2 = (int)__shfl(ab_, sstar);
            const int need2 = need - na2;
            int base = na; int nsub = 0;
#pragma unroll
            for (int e = 0; e < SEL_CAP / 64; ++e) { const bool up = sb[e] > sstar; const bool eq = sb[e] == sstar;
                const unsigned long long bu = __ballot(up), be = __ballot(eq);
                const unsigned long long lt = (lane == 0) ? 0ull : (~0ull >> (64 - lane));
                if (up) lsel[qq * 256 + base + (int)__builtin_popcountll(bu & lt)] = (unsigned short)ci[e];
                if (eq) { const int p_ = nsub + (int)__builtin_popcountll(be & lt); sls[p_] = cs[e]; sli[p_] = (unsigned short)ci[e]; }
                base += (int)__builtin_popcountll(bu); nsub += (int)__builtin_popcountll(be); }
            LDS_WAIT();
#pragma unroll 1
            for (int i0 = 0; i0 < nsub; i0 += 64) { const int i = i0 + lane;
                if (i < nsub) { const float si = sls[i]; const int ii = sli[i]; int rank = 0;
                    for (int jx = 0; jx < nsub; ++jx) { const float sj = sls[jx]; const int ij = sli[jx]; rank += (sj > si || (sj == si && ij < ii)) ? 1 : 0; }
                    if (rank < need2) lsel[qq * 256 + na + na2 + rank] = (unsigned short)ii; } }
            LDS_WAIT();
            *(v2u*)(sel + (size_t)q * TOPK + 4 * lane) = *(const LAS v2u*)(lsel + qq * 256 + 4 * lane);
        }
    }
    __syncthreads();
    if (tid == 0) { unsigned n = first ? 0u : __hip_atomic_load(slowl, RLX_AGENT);
        for (int qq = 0; qq < 64; ++qq) if (st[448 + qq] != 0u) { if (n < 128u) { __hip_atomic_store(slowl + 1 + n, (unsigned)(q0 + qq), RLX_AGENT); ++n; } }
        __hip_atomic_store(slowl, n, RLX_AGENT); }
    asm volatile("s_waitcnt vmcnt(0)" ::: "memory");
    __syncthreads();
}
#undef SEL_DECLS
#undef SEL_LOAD_A
#undef SEL_STAGE
#undef SEL_SCORES
#undef SEL_MMA
#undef SEL_SUM
#undef SEL_BOUNDARY
__device__ __forceinline__ void dsa_select_slow(unsigned char* ws_, LAS unsigned char* lds_, int wave_, int wg_) {
    LAS unsigned char* const lds = uni_l(lds_); const int wave = uni_i(wave_), wg = uni_i(wg_);
    unsigned char* ws = uni(ws_);
    const bf16* iqf = (const bf16*)(ws + WS_IQF); const unsigned* sgn = (const unsigned*)(ws + WS_SGN); const bf16* ik = (const bf16*)(ws + WS_IK);
    unsigned short* sel = (unsigned short*)(ws + WS_SEL);
    gu32* slowl = (gu32*)(ws + WS_CTL + 65536) + (size_t)wg * 132;
    const int lane = lane_id_v(), tid = wave * 64 + lane; const int kl = lane & 31, c5 = lane >> 5;
    LAS unsigned* keys = (LAS unsigned*)lds;
    LAS unsigned* hist = (LAS unsigned*)(lds + 32768);
    LAS unsigned* ctl = (LAS unsigned*)(lds + 40960);
    const int nq = (int)__builtin_amdgcn_readfirstlane(__hip_atomic_load(slowl, RLX_AGENT));
#pragma unroll 1
    for (int k = 0; k < nq; ++k) {
        const int q = (int)__builtin_amdgcn_readfirstlane(__hip_atomic_load(slowl + 1 + k, RLX_AGENT));
        const int b = q / SEQ, t = q % SEQ, n = t + 1;
        const bf16* ikb = ik + (size_t)b * SEQ * IDIM;
        __syncthreads();
        bf16x8_t af[2]; float sgc[8];
        { const int i = kl, a_ = i >> 3, e_ = i & 3; const int hh_ = 4 * (a_ & 1) + e_; const unsigned m_ = sgn[q];
          const unsigned flip_ = ((m_ >> hh_) & 1u) ? 0x80008000u : 0u;
#pragma unroll
          for (int ks = 0; ks < 2; ++ks) { v4u w_ = *(const v4u*)(iqf + (size_t)q * 256 + hh_ * 32 + 16 * ks + 8 * c5); w_.x ^= flip_; w_.y ^= flip_; w_.z ^= flip_; w_.w ^= flip_; af[ks] = __builtin_bit_cast(bf16x8_t, w_); }
#pragma unroll
          for (int h = 0; h < 8; ++h) sgc[h] = ((m_ >> h) & 1u) ? -__builtin_inff() : __builtin_inff(); }
#pragma unroll 1
        for (int kb0 = wave; kb0 * 32 < n; kb0 += 4 * NWAVES) {
            bf16x8_t kb_[4][2];
#pragma unroll
            for (int j = 0; j < 4; ++j) { int key = 32 * (kb0 + j * NWAVES) + kl; key = key < SEQ ? key : SEQ - 1;
                kb_[j][0] = *(const bf16x8_t*)(ikb + (size_t)key * IDIM + 8 * c5); kb_[j][1] = *(const bf16x8_t*)(ikb + (size_t)key * IDIM + 16 + 8 * c5); }
#pragma unroll
            for (int j = 0; j < 4; ++j) { const int key = 32 * (kb0 + j * NWAVES) + kl;
                f32x16 acc = {0.f,0.f,0.f,0.f,0.f,0.f,0.f,0.f,0.f,0.f,0.f,0.f,0.f,0.f,0.f,0.f};
                acc = __builtin_amdgcn_mfma_f32_32x32x16_f16(__builtin_bit_cast(f16x8_t, af[0]), __builtin_bit_cast(f16x8_t, kb_[j][0]), acc, 0, 0, 0); acc = __builtin_amdgcn_mfma_f32_32x32x16_f16(__builtin_bit_cast(f16x8_t, af[1]), __builtin_bit_cast(f16x8_t, kb_[j][1]), acc, 0, 0, 0);
                float sc = 0.f;
#pragma unroll
                for (int h = 0; h < 8; ++h) sc += __builtin_amdgcn_fmed3f(acc[h], 0.f, sgc[h]);
                if (c5 == 0 && key < SEQ) keys[key] = key_of(sc); } }
        if (tid == 0) { const unsigned z_ = (unsigned)launder_v(0); ctl[0] = z_; ctl[1] = z_ + (unsigned)TOPK; ctl[2] = z_; ctl[3] = z_; }
        unsigned P = 0u, Plo = 0u;
#pragma unroll 1
        for (int lev = 0; lev < 5; ++lev) {
            for (int i = tid; i < 2048; i += NWAVES * 64) hist[i] = 0u;
            asm volatile("s_waitcnt lgkmcnt(0)" ::: "memory"); __syncthreads();
#pragma unroll 1
            for (int i = 0; i < 16; ++i) { const int s_ = tid * 16 + i;
                if (s_ < n) { const unsigned hi = keys[s_], lo = 8191u - (unsigned)s_; bool mt; unsigned dg;
                    if (lev == 0) { mt = true; dg = hi >> 21; } else if (lev == 1) { mt = (hi >> 21) == P; dg = (hi >> 10) & 0x7ffu; } else if (lev == 2) { mt = (hi >> 10) == P; dg = hi & 0x3ffu; }
                    else if (lev == 3) { mt = hi == P; dg = lo >> 6; } else { mt = hi == P && (lo >> 6) == Plo; dg = lo & 63u; }
                    if (mt) (void)__hip_atomic_fetch_add(hist + dg, 1u, __ATOMIC_RELAXED, __HIP_MEMORY_SCOPE_WORKGROUP); } }
            asm volatile("s_waitcnt lgkmcnt(0)" ::: "memory"); __syncthreads();
            const unsigned need = ctl[1];
            const v4u hb = *(const LAS v4u*)(hist + 4 * tid); const unsigned ls = hb.x + hb.y + hb.z + hb.w;
            unsigned v = ls, tt;
            tt = __shfl_down(v, 1); if (lane + 1 < 64) v += tt;
            tt = __shfl_down(v, 2); if (lane + 2 < 64) v += tt;
            tt = __shfl_down(v, 4); if (lane + 4 < 64) v += tt;
            tt = __shfl_down(v, 8); if (lane + 8 < 64) v += tt;
            tt = __shfl_down(v, 16); if (lane + 16 < 64) v += tt;
            tt = __shfl_down(v, 32); if (lane + 32 < 64) v += tt;
            if (lane == 0) ctl[8 + wave] = v;
            asm volatile("s_waitcnt lgkmcnt(0)" ::: "memory"); __syncthreads();
            unsigned above = v - ls;
            for (int w2 = wave + 1; w2 < NWAVES; ++w2) above += ctl[8 + w2];
            if (above < need && above + ls >= need) { unsigned c = above; const unsigned bb[4] = {hb.x, hb.y, hb.z, hb.w}; int bsel = 0; unsigned cab = 0; bool found = false;
#pragma unroll
                for (int i = 3; i >= 0; --i) { const bool hit = !found && (c + bb[i] >= need); if (hit) { bsel = i; cab = c; found = true; } c += bb[i]; }
                const unsigned dv = (unsigned)(4 * tid + bsel);
                if (lev == 0) ctl[0] = dv; else if (lev == 1) ctl[0] = (P << 11) | dv; else if (lev == 2) ctl[0] = (P << 10) | dv; else if (lev == 3) ctl[3] = dv; else ctl[3] = (Plo << 6) | dv;
                ctl[1] = need - cab; ctl[4] = bb[bsel]; }
            asm volatile("s_waitcnt lgkmcnt(0)" ::: "memory"); __syncthreads();
            P = ctl[0]; Plo = ctl[3];
            if (lev == 2 && ctl[1] == ctl[4]) break;
        }
        unsigned short* srow = sel + (size_t)q * TOPK;
        unsigned mymask = 0u;
#pragma unroll 1
        for (int i = 0; i < 16; ++i) { const int s_ = tid * 16 + i;
            if (s_ < n) { const unsigned hi = keys[s_], lo = 8191u - (unsigned)s_; if (hi > P || (hi == P && lo >= Plo)) mymask |= 1u << i; } }
        const unsigned mycnt = (unsigned)__builtin_popcount(mymask);
        unsigned pv_ = mycnt, tt_;
        tt_ = __shfl_up(pv_, 1); if (lane >= 1) pv_ += tt_;
        tt_ = __shfl_up(pv_, 2); if (lane >= 2) pv_ += tt_;
        tt_ = __shfl_up(pv_, 4); if (lane >= 4) pv_ += tt_;
        tt_ = __shfl_up(pv_, 8); if (lane >= 8) pv_ += tt_;
        tt_ = __shfl_up(pv_, 16); if (lane >= 16) pv_ += tt_;
        tt_ = __shfl_up(pv_, 32); if (lane >= 32) pv_ += tt_;
        if (lane == 63) ctl[16 + wave] = pv_;
        asm volatile("s_waitcnt lgkmcnt(0)" ::: "memory"); __syncthreads();
        unsigned slot0 = pv_ - mycnt;
        for (int w2 = 0; w2 < wave; ++w2) slot0 += ctl[16 + w2];
#pragma unroll 1
        for (int i = 0; i < 16; ++i) if ((mymask >> i) & 1u) { if (slot0 < (unsigned)TOPK) srow[slot0] = (unsigned short)(tid * 16 + i); ++slot0; }
    }
    asm volatile("s_waitcnt vmcnt(0) lgkmcnt(0)" ::: "memory");
    __syncthreads();
}

__device__ __forceinline__ unsigned offb(unsigned row, unsigned ch) { return 256u * row + 16u * (ch ^ (((row & 3u) << 2) | ((row >> 2) & 3u))); }
__device__ __forceinline__ s16x4_t vtr(const LAS unsigned char* p) { return __builtin_bit_cast(s16x4_t, __builtin_amdgcn_ds_read_tr16_b64_v4i16((LAS s16x4_t*)p)); }

__device__ __forceinline__ void dsa_attend(unsigned char* ws_, LAS unsigned char* lds_, const float* relb_, int wave_, int vcu_, int G_, int dry_) {
    const int dry = uni_i(dry_);
    LAS unsigned char* const lds = uni_l(lds_); const int wave = uni_i(wave_), vcu = uni_i(vcu_), G = uni_i(G_);
    unsigned char* ws = uni(ws_); const float* relb = uni(relb_);
    const bf16* ckv = (const bf16*)(ws + WS_CKV); bf16* ql = (bf16*)(ws + WS_QL); const unsigned short* sel = (const unsigned short*)(ws + WS_SEL);
    const int lane = lane_id_v(), tid = wave * 64 + lane;
    LAS unsigned char* cb = lds + wave * 16384;
    LAS unsigned short* sidx = (LAS unsigned short*)(lds + 131072 + wave * 512);
    LAS float* biasd = (LAS float*)(lds + 135168);
    for (int i = tid; i < 129 * 8; i += NWAVES * 64) { const int d = i >> 3, h = i & 7; const int bk = d < 128 ? (int)T5_BUCKET[d] : 31; biasd[i] = relb[bk * 8 + h]; }
    __syncthreads();
    const int hl = lane & 15, g = lane >> 4, hq = hl & 7;
    for (int p = vcu; p < BATCH * 64; p += G) {
        const int b = p >> 6, j = p & 63;
#pragma unroll 1
        for (int half = 0; half < 2; ++half) {
            const int ub = half == 0 ? j : 127 - j;
#pragma unroll 1
            for (int qi = 0; qi < 8; ++qi) {
                const int t = ub * 64 + wave * 8 + qi; const int q = b * SEQ + t; const int nsel = (t + 1) < TOPK ? (t + 1) : TOPK;
                const bf16* ckvb = ckv + (size_t)b * SEQ * KVR; bf16* qlrow = ql + (size_t)q * 1024;
                { const v2u w = *(const v2u*)(sel + (size_t)q * TOPK + 4 * lane); *(LAS v2u*)(sidx + 4 * lane) = w; }
                bf16x8_t qf[4];
#pragma unroll
                for (int s = 0; s < 4; ++s) qf[s] = *(const bf16x8_t*)(qlrow + hq * 128 + 32 * s + 8 * g);
                LDS_WAIT();
                float mrun = -1e30f, lsum = 0.f;
                f32x4 O[8];
#pragma unroll
                for (int c = 0; c < 8; ++c) O[c] = (f32x4){0.f, 0.f, 0.f, 0.f};
#define DSA_GATHER(c_) do { LAS unsigned char* dst_ = cb + ((c_) & 1) * 8192; \
                    _Pragma("unroll") for (int k_ = 0; k_ < 8; ++k_) { const int row_ = 4 * k_ + g; const int kidx_ = sidx[32 * (c_) + row_]; \
                        const int ch_ = hl ^ ((g << 2) | (k_ & 3)); \
                        glds16(ckvb + (size_t)kidx_ * KVR + ch_ * 8, (unsigned)__builtin_amdgcn_readfirstlane((int)(unsigned)(size_t)(dst_ + k_ * 1024))); } } while (0)
                DSA_GATHER(0);
#pragma unroll 1
                for (int c = 0; c < 8; ++c) {
                    if (c < 7) { DSA_GATHER(c + 1); asm volatile("s_waitcnt vmcnt(8)" ::: "memory"); }
                    else asm volatile("s_waitcnt vmcnt(0)" ::: "memory");
                    const LAS unsigned char* img = cb + (c & 1) * 8192;
                    f32x4 S[2];
#pragma unroll
                    for (int rb = 0; rb < 2; ++rb) { S[rb] = (f32x4){0.f, 0.f, 0.f, 0.f}; const unsigned row = 8u * (hl >> 2) + 4u * rb + (hl & 3);
#pragma unroll
                        for (int s = 0; s < 4; ++s) { const bf16x8_t af = *(const LAS bf16x8_t*)(img + offb(row, 4 * s + g)); S[rb] = __builtin_amdgcn_mfma_f32_16x16x32_bf16(af, qf[s], S[rb], 0, 0, 0); } }
                    float pv[2][4]; float mx = -1e30f;
#pragma unroll
                    for (int rb = 0; rb < 2; ++rb) { const v2u iw2 = *(const LAS v2u*)(sidx + 32 * c + 8 * g + 4 * rb);
                        const int ki[4] = {(int)(iw2.x & 0xffffu), (int)(iw2.x >> 16), (int)(iw2.y & 0xffffu), (int)(iw2.y >> 16)};
#pragma unroll
                        for (int r = 0; r < 4; ++r) { int dist = t - ki[r]; dist = dist < 0 ? 0 : (dist > 128 ? 128 : dist);
                            float lg = S[rb][r] * 0.125f + biasd[dist * 8 + hq];
                            if (32 * c + 8 * g + 4 * rb + r >= nsel) lg = -1e30f;
                            pv[rb][r] = lg; mx = fmaxf(mx, lg); } }
                    mx = fmaxf(mx, __shfl_xor(mx, 16)); mx = fmaxf(mx, __shfl_xor(mx, 32));
                    const float mnew = fmaxf(mrun, mx); const float alpha = __expf(mrun - mnew); mrun = mnew;
                    float rs = 0.f;
#pragma unroll
                    for (int rb = 0; rb < 2; ++rb)
#pragma unroll
                        for (int r = 0; r < 4; ++r) { pv[rb][r] = __expf(pv[rb][r] - mnew); rs += pv[rb][r]; }
                    rs += __shfl_xor(rs, 16); rs += __shfl_xor(rs, 32);
                    lsum = lsum * alpha + rs;
                    v4u pw; pw.x = pg8::cvt_pk_bf16(pv[0][0], pv[0][1]); pw.y = pg8::cvt_pk_bf16(pv[0][2], pv[0][3]); pw.z = pg8::cvt_pk_bf16(pv[1][0], pv[1][1]); pw.w = pg8::cvt_pk_bf16(pv[1][2], pv[1][3]);
                    const bf16x8_t pf = __builtin_bit_cast(bf16x8_t, pw);
                    float al[4];
#pragma unroll
                    for (int r = 0; r < 4; ++r) al[r] = __shfl(alpha, 4 * g + r);
#pragma unroll
                    for (int cd = 0; cd < 8; ++cd) {
                        f32x4 o = O[cd]; o[0] *= al[0]; o[1] *= al[1]; o[2] *= al[2]; o[3] *= al[3];
                        const unsigned q4 = hl >> 2, p4 = hl & 3;
                        const s16x4_t b0 = vtr(img + offb(8u * g + q4, 2 * cd + (p4 >> 1)) + 8u * (p4 & 1));
                        const s16x4_t b1 = vtr(img + offb(8u * g + 4u + q4, 2 * cd + (p4 >> 1)) + 8u * (p4 & 1));
                        bf16x8_t bf; bf[0] = b0[0]; bf[1] = b0[1]; bf[2] = b0[2]; bf[3] = b0[3]; bf[4] = b1[0]; bf[5] = b1[1]; bf[6] = b1[2]; bf[7] = b1[3];
                        O[cd] = __builtin_amdgcn_mfma_f32_16x16x32_bf16(pf, bf, o, 0, 0, 0);
                    }
                }
#undef DSA_GATHER
                const float linv = 1.0f / lsum; float li[4];
#pragma unroll
                for (int r = 0; r < 4; ++r) li[r] = __shfl(linv, 4 * g + r);
                LAS unsigned short* ost = (LAS unsigned short*)cb;
                if (g < 2) {
#pragma unroll
                    for (int cd = 0; cd < 8; ++cd)
#pragma unroll
                        for (int r = 0; r < 4; ++r) ost[(4 * g + r) * 128 + 16 * cd + hl] = (unsigned short)f2bf(O[cd][r] * li[r]);
                }
                LDS_WAIT();
                { const v4u w0 = *(const LAS v4u*)(cb + 32 * lane), w1 = *(const LAS v4u*)(cb + 32 * lane + 16);
                  if (!dry) { *(v4u*)(qlrow + 16 * lane) = w0; *(v4u*)(qlrow + 16 * lane + 8) = w1; } else asm volatile("" :: "v"(w0), "v"(w1)); }
                LDS_WAIT();
            }
        }
    }
    __syncthreads();
}

__device__ __noinline__ void final_norm(const float* const* in_, float* out_, unsigned char* ws_, LAS unsigned char* lds_, int wave_, int vcu_, int G_) {
    const PC F{uni(in_), uni(out_), uni(ws_), uni_l(lds_), uni_i(wave_), uni_i(vcu_), uni_i(G_)}; struct { const float* const* in; float* out; } a{F.in, F.out};
    const int lane_ = lane_id_v(); const int gw = F.vcu * NWAVES + F.wave, NGW = F.G * NWAVES; const float* g = a.in[22];
    f32x4 gv[4];
#pragma unroll
    for (int j = 0; j < 4; ++j) gv[j] = ((const f32x4*)g)[lane_ + 64 * j];
    for (int m = gw; m < M; m += NGW) {
        GAS f32x4* xr = (GAS f32x4*)(a.out + (size_t)m * D) + lane_;
        f32x4 v[4]; float s = 0.f;
#pragma unroll
        for (int j = 0; j < 4; ++j) { v[j] = xr[64 * j]; s += (v[j].x * v[j].x + v[j].y * v[j].y) + (v[j].z * v[j].z + v[j].w * v[j].w); }
        const float rs = 1.0f / sqrtf(wave_sum(s) * (1.0f / D) + EPS);
#pragma unroll
        for (int j = 0; j < 4; ++j) xr[64 * j] = v[j] * rs * gv[j];
    }
}

#define KIN ((const float* const*)__builtin_amdgcn_kernarg_segment_ptr())
constexpr int PH_PER_LAYER = 10, PH_LAYER0 = 2, N_PHASES = PH_LAYER0 + PH_PER_LAYER * DEPTH + 1;

__global__ void __launch_bounds__(NWAVES * 64, 2) mk_fwd(Args args) {
    extern __shared__ __attribute__((aligned(16))) unsigned char lds[];
    Frame F;
    F.lds = (LAS unsigned char*)lds;
    F.MISC = (volatile LAS unsigned*)(F.lds + MISC_OFF);
    F.wave = __builtin_amdgcn_readfirstlane((int)threadIdx.x >> 6);
    F.G = gridDim.x; { const int bx = blockIdx.x; F.vcu = (F.G % 8 == 0) ? (bx % 8) * (F.G / 8) + bx / 8 : bx; }
    F.ws = args.ws; F.ctl = (gu32*)(args.ws + WS_CTL);
    if (threadIdx.x < 64) ((LAS unsigned*)(F.lds + MISC_OFF))[threadIdx.x] = 0u;
    __syncthreads();
    const int lo = args.ph_lo, hi = args.ph_hi;
    const bool multi = (hi - lo) > 1;
    XcdBarrier bar; bar.bar = (unsigned*)(F.ctl + CW_BAR); bar.x = 0; bar.st = nullptr; bar.wave = F.wave;
    if (multi) bar = xcd_barrier_post((unsigned*)(F.ctl + CW_BAR), F.MISC + 8, F.wave);
#define IN(k) (lo <= (k) && (k) < hi)
#define SEAM(k) do { if (IN(k) && IN((k) + 1)) { xcd_barrier(bar); if (PROBE_PHASE == 99) xcd_barrier(bar); } } while (0)

    if (IN(0)) {
#if EN_P0
 for (int rep = (PROBE_PHASE == 1 ? 0 : 1); rep < 2; ++rep) p0_prologue(KIN, args.out, args.ws, F.lds, F.wave, F.vcu, F.G);
#endif
 } SEAM(0);
    if (IN(1)) {
#if !((DIS_MASK >> 7) & 1)
 unsigned char* ws = launder_p(args.ws); bf16* hb = (bf16*)(ws + WS_HB); float* ss = (float*)(ws + WS_SS); (void)hb; (void)ss;
        pg8::Gemm g{(const bf16_t*)(ws + WS_MEMN), (const bf16_t*)(ws + WS_WMEM), MROWS, DEPTH * 2 * CW, D}; pg8::StaticOrder S; S.init(MROWS, DEPTH * 2 * CW, F.G, launder_s((int)blockIdx.x));
        EpiPlainBf16 E{(bf16_t*)(ws + WS_MEMKV), DEPTH * 2 * CW};
        pg8::gemm_phase<EpiPlainBf16, pg8::StaticOrder, true, true>(F.lds + RING_OFF, g, S, E, F.wave);
        { pg8::Gemm g2{(const bf16_t*)(ws + WS_WMEM), (const bf16_t*)(ws + WS_MEMN), DEPTH * 2 * CW, MROWS, D}; pg8::StaticOrder S2; S2.init(DEPTH * 2 * CW, MROWS, F.G, launder_s((int)blockIdx.x));
          EpiPlainBf16 E2{(bf16_t*)(ws + WS_VT), MROWS};
          pg8::gemm_phase<EpiPlainBf16, pg8::StaticOrder, true, true>(F.lds + RING_OFF, g2, S2, E2, F.wave); }
#endif
    } SEAM(1);

    for (int l = 0; l < DEPTH; ++l) {
        const int pb = PH_LAYER0 + PH_PER_LAYER * l;
        const float* hbase = (l == 0) ? args.in[0] : args.out;
        if (IN(pb + 0)) {
#if EN_P0
 if (l > 0) for (int rep = (PROBE_PHASE == 1 ? 0 : 1); rep < 2; ++rep) prep_layer_weights(KIN, args.out, args.ws, F.lds, l, F.wave, F.vcu, F.G);
#endif
 } SEAM(pb + 0);
        if (IN(pb + 1)) {
#if !((DIS_MASK >> 0) & 1)
 unsigned char* ws = launder_p(args.ws); bf16* hb = (bf16*)(ws + WS_HB); float* ss = (float*)(ws + WS_SS); (void)hb; (void)ss;
            pg8::Gemm g{hb, (const bf16_t*)(ws + WS_W1IN), M, 2 * DFF, D}; pg8::StaticOrder S; S.init(M, 2 * DFF, F.G, launder_s((int)blockIdx.x));
            EpiSwiglu E{(bf16_t*)(ws + WS_ACT), ss};
            for (int rep = (PROBE_PHASE == 2 ? 0 : 1); rep < 2; ++rep) pg8::gemm_phase<EpiSwiglu, pg8::StaticOrder, true, true>(F.lds + RING_OFF, g, S, E, F.wave);
#endif
        } SEAM(pb + 1);
        if (IN(pb + 2)) {
#if !((DIS_MASK >> 1) & 1)
 unsigned char* ws = launder_p(args.ws); bf16* hb = (bf16*)(ws + WS_HB); float* ss = (float*)(ws + WS_SS); (void)hb; (void)ss;
            pg8::Gemm g{(const bf16_t*)(ws + WS_ACT), (const bf16_t*)(ws + WS_W1OUT), M, D, DFF}; pg8::StaticOrder S; S.init(M, D, F.G, launder_s((int)blockIdx.x));
            for (int rep = (PROBE_PHASE == 3 ? 0 : 1); rep < 2; ++rep) { EpiResid E{hbase, args.out, hb, ss, 0.5f, (LAS float*)(F.lds + RING_BYTES), rep == 0 ? 1 : 0};
            pg8::gemm_phase<EpiResid, pg8::StaticOrder, true, true>(F.lds + RING_OFF, g, S, E, F.wave); }
#endif
        } SEAM(pb + 2);
        if (IN(pb + 3)) {
#if !((DIS_MASK >> 2) & 1)
 unsigned char* ws = launder_p(args.ws); bf16* hb = (bf16*)(ws + WS_HB); float* ss = (float*)(ws + WS_SS); (void)hb; (void)ss;
            pg8::Gemm g{hb, (const bf16_t*)(ws + WS_WIN), M, INP, D}; pg8::StaticOrder S; S.init(M, INP, F.G, launder_s((int)blockIdx.x));
            EpiInProj E{ss, (bf16_t*)(ws + WS_QL), (float*)(ws + WS_CKVRAW), (bf16_t*)(ws + WS_IK), (float*)(ws + WS_IW), (bf16_t*)(ws + WS_IQRAW), (bf16_t*)(ws + WS_Z), (bf16_t*)(ws + WS_QC), (bf16_t*)(ws + WS_G)};
            for (int rep = (PROBE_PHASE == 4 ? 0 : 1); rep < 2; ++rep) pg8::gemm_phase<EpiInProj, pg8::StaticOrder, true, true>(F.lds + RING_OFF, g, S, E, F.wave);
#endif
        } SEAM(pb + 3);
        if (IN(pb + 4)) {
#if EN_PREP
 for (int rep = (PROBE_PHASE == 5 ? 0 : 1); rep < 2; ++rep) prep_tokens(KIN, args.out, args.ws, F.lds, l, F.wave, F.vcu, F.G, rep == 0 ? 1 : 0);
#endif
 } SEAM(pb + 4);
        if (IN(pb + 5)) {
#if EN_DSA
 for (int rep = (PROBE_PHASE == 6 ? 0 : 1); rep < 2; ++rep) for (int p = F.vcu; p < BATCH * 64; p += F.G) { for (int half = 0; half < 2; ++half) { const int b_ = p >> 6, ub_ = half == 0 ? (p & 63) : 127 - (p & 63);
   sel_pass1(args.ws, F.lds, F.wave, b_, ub_); if (PROBE_PHASE == 61) sel_pass1(args.ws, F.lds, F.wave, b_, ub_); sel_pass2(args.ws, F.lds, F.wave, b_, ub_); if (PROBE_PHASE == 62) sel_pass2(args.ws, F.lds, F.wave, b_, ub_); sel_resolve(args.ws, F.lds, F.wave, b_, ub_, (int)blockIdx.x, (p == F.vcu && half == 0) ? 1 : 0); if (PROBE_PHASE == 63) sel_resolve(args.ws, F.lds, F.wave, b_, ub_, (int)blockIdx.x, 0); } }
 dsa_select_slow(args.ws, F.lds, F.wave, (int)blockIdx.x); for (int rep = (PROBE_PHASE == 7 ? 0 : 1); rep < 2; ++rep) dsa_attend(args.ws, F.lds, args.in[2], F.wave, F.vcu, F.G, rep == 0 ? 1 : 0);
#endif
 } SEAM(pb + 5);
        if (IN(pb + 6)) {
#if !((DIS_MASK >> 3) & 1)
        for (int rep6 = (PROBE_PHASE == 8 ? 0 : 1); rep6 < 2; ++rep6) {
 unsigned char* ws = launder_p(args.ws); bf16* hb = (bf16*)(ws + WS_HB); float* ss = (float*)(ws + WS_SS); (void)hb; (void)ss;
            { pg8::Gemm g{(const bf16_t*)(ws + WS_QL), (const bf16_t*)(ws + WS_WA), M, D, 1024}; pg8::StaticOrder S; S.init(M, D, F.G, launder_s((int)blockIdx.x));
              EpiMerge<0> E{(bf16_t*)(ws + WS_MERGED), (const bf16_t*)(ws + WS_G)};
              pg8::gemm_phase<EpiMerge<0>, pg8::StaticOrder, true, true>(F.lds + RING_OFF, g, S, E, F.wave); }
            { pg8::Gemm g{(const bf16_t*)(ws + WS_YB), (const bf16_t*)(ws + WS_WB), M, D, PW_}; pg8::StaticOrder S; S.init(M, D, F.G, launder_s((int)blockIdx.x));
              EpiMerge<1> E{(bf16_t*)(ws + WS_MERGED), (const bf16_t*)(ws + WS_G)};
              pg8::gemm_phase<EpiMerge<1>, pg8::StaticOrder, true, true>(F.lds + RING_OFF, g, S, E, F.wave); }
            { pg8::Gemm g{(const bf16_t*)(ws + WS_QC), (const bf16_t*)(ws + WS_WC), M, D, CW}; pg8::StaticOrder S; S.init(M, D, F.G, launder_s((int)blockIdx.x));
              EpiMerge<2> E{(bf16_t*)(ws + WS_MERGED), (const bf16_t*)(ws + WS_G)};
              pg8::gemm_phase<EpiMerge<2>, pg8::StaticOrder, true, true>(F.lds + RING_OFF, g, S, E, F.wave); }
        }
#endif
        } SEAM(pb + 6);
        if (IN(pb + 7)) {
#if !((DIS_MASK >> 4) & 1)
 unsigned char* ws = launder_p(args.ws); bf16* hb = (bf16*)(ws + WS_HB); float* ss = (float*)(ws + WS_SS); (void)hb; (void)ss;
            pg8::Gemm g{(const bf16_t*)(ws + WS_MERGED), (const bf16_t*)(ws + WS_WOUT), M, D, D}; pg8::StaticOrder S; S.init(M, D, F.G, launder_s((int)blockIdx.x));
            for (int rep = (PROBE_PHASE == 9 ? 0 : 1); rep < 2; ++rep) { EpiResid E{args.out, args.out, hb, ss, 1.0f, (LAS float*)(F.lds + RING_BYTES), rep == 0 ? 1 : 0};
            pg8::gemm_phase<EpiResid, pg8::StaticOrder, true, true>(F.lds + RING_OFF, g, S, E, F.wave); }
#endif
        } SEAM(pb + 7);
        if (IN(pb + 8)) {
#if !((DIS_MASK >> 5) & 1)
 unsigned char* ws = launder_p(args.ws); bf16* hb = (bf16*)(ws + WS_HB); float* ss = (float*)(ws + WS_SS); (void)hb; (void)ss;
            pg8::Gemm g{hb, (const bf16_t*)(ws + WS_W2IN), M, 2 * DFF, D}; pg8::StaticOrder S; S.init(M, 2 * DFF, F.G, launder_s((int)blockIdx.x));
            EpiSwiglu E{(bf16_t*)(ws + WS_ACT), ss};
            for (int rep = (PROBE_PHASE == 2 ? 0 : 1); rep < 2; ++rep) pg8::gemm_phase<EpiSwiglu, pg8::StaticOrder, true, true>(F.lds + RING_OFF, g, S, E, F.wave);
#endif
        } SEAM(pb + 8);
        if (IN(pb + 9)) {
#if !((DIS_MASK >> 6) & 1)
 unsigned char* ws = launder_p(args.ws); bf16* hb = (bf16*)(ws + WS_HB); float* ss = (float*)(ws + WS_SS); (void)hb; (void)ss;
            pg8::Gemm g{(const bf16_t*)(ws + WS_ACT), (const bf16_t*)(ws + WS_W2OUT), M, D, DFF}; pg8::StaticOrder S; S.init(M, D, F.G, launder_s((int)blockIdx.x));
            for (int rep = (PROBE_PHASE == 3 ? 0 : 1); rep < 2; ++rep) { EpiResid E{args.out, args.out, hb, ss, 0.5f, (LAS float*)(F.lds + RING_BYTES), rep == 0 ? 1 : 0};
            pg8::gemm_phase<EpiResid, pg8::StaticOrder, true, true>(F.lds + RING_OFF, g, S, E, F.wave); }
#endif
        } SEAM(pb + 9);
    }
#if EN_P0
    if (IN(N_PHASES - 1)) { final_norm(KIN, args.out, args.ws, F.lds, F.wave, F.vcu, F.G); }
#endif
#undef IN
#undef SEAM
}

extern "C" void kernel_launch(void* const* d_in, const int* in_sizes, int n_in, void* d_out, int out_size, void* d_ws, size_t ws_size, hipStream_t stream) {
    static int grid = 0;
    if (grid == 0) {
        if (n_in != 23 || in_sizes[0] != M * D || out_size != M * D || ws_size < WS_END) { fprintf(stderr, "kernel_launch: unexpected shapes (n_in %d, ws %zu)\n", n_in, ws_size); grid = -1; return; }
        int dev = 0, cus = 0, per_cu = 0;
        if (hipGetDevice(&dev) != hipSuccess || hipDeviceGetAttribute(&cus, hipDeviceAttributeMultiprocessorCount, dev) != hipSuccess) { grid = -1; return; }
        if (hipFuncSetAttribute((const void*)mk_fwd, hipFuncAttributeMaxDynamicSharedMemorySize, LDS_BYTES) != hipSuccess) { fprintf(stderr, "kernel_launch: hipFuncSetAttribute failed\n"); grid = -1; return; }
        if (hipOccupancyMaxActiveBlocksPerMultiprocessor(&per_cu, (const void*)mk_fwd, NWAVES * 64, LDS_BYTES) != hipSuccess || per_cu < 1) { fprintf(stderr, "kernel_launch: occupancy query says %d\n", per_cu); }
        (void)hipGetLastError();
        grid = cus;
    }
    if (grid < 0) return;
    if (hipMemsetAsync((char*)d_ws + WS_CTL, 0, CTL_ZERO_BYTES, stream) != hipSuccess) return;
    Args a{};
    for (int i = 0; i < 23; ++i) a.in[i] = (const float*)d_in[i];
    a.out = (float*)d_out; a.ws = (unsigned char*)d_ws;
#if MK_ONE_LAUNCH
    a.ph_lo = 0; a.ph_hi = N_PHASES;
    hipLaunchKernelGGL(mk_fwd, dim3(grid), dim3(NWAVES * 64), LDS_BYTES, stream, a);
#endif
}
```

```cpp
#include <hip/hip_runtime.h>
#include <cstdio>
#include <cstdint>

#ifndef MK_ONE_LAUNCH
#define MK_ONE_LAUNCH 1
#endif
#ifndef PROBE_PHASE
#define PROBE_PHASE 0
#endif
#ifndef EN_P0
#define EN_P0 MK_ONE_LAUNCH
#endif
#ifndef EN_PREP
#define EN_PREP MK_ONE_LAUNCH
#endif
#ifndef EN_DSA
#define EN_DSA MK_ONE_LAUNCH
#endif
#ifndef DIS_MASK
#define DIS_MASK 0
#endif
#ifndef MK_ONE_LAUNCH
#define MK_ONE_LAUNCH 1
#endif

__device__ __forceinline__ int lane_id_v() { int l; asm volatile("v_mbcnt_lo_u32_b32 %0, -1, 0\n\tv_mbcnt_hi_u32_b32 %0, -1, %0" : "=v"(l)); return l; }
namespace pg8 {
#define PG8_LAS __attribute__((address_space(3)))
typedef unsigned short bf16_t;
typedef short bf16x8 __attribute__((ext_vector_type(8)));
typedef float f32x4 __attribute__((ext_vector_type(4)));
typedef unsigned u32x4 __attribute__((ext_vector_type(4)));
typedef unsigned u32x2 __attribute__((ext_vector_type(2)));
constexpr int BM = 256, BK = 64, HALF = 128, HTB = HALF * BK * 2, STAGE_BYTES = 8 * HTB, NXCD = 8, WGM = 8;

__host__ __device__ __forceinline__ int lds_byte(int r, int c) { const int st = (r >> 4) * 2 + (c >> 5), rr = r & 15, cc = c & 31, ob = rr * 64 + cc * 2; return st * 1024 + (ob ^ (((ob >> 9) & 1) << 5)); }
__host__ __device__ __forceinline__ void stage_rc(int b, int& R, int& C) { const int st = b / 1024, sb = b % 1024, swz = sb ^ (((sb >> 9) & 1) << 5); R = (st >> 1) * 16 + swz / 64; C = (st & 1) * 32 + (swz % 64) / 2; }
__host__ __device__ __forceinline__ int perm32(int rho) { const int n = rho >> 4, i = rho & 15; return 8 * (i >> 2) + 4 * n + (i & 3); }

struct Unit { int pm, pn; };
struct Gemm { const bf16_t* A; const bf16_t* Bt; int M, N, K; };

struct StaticOrder {
    int nM, nN, nwg, G, c;
    __host__ __device__ void init(int M, int N, int G_, int c_) { nM = M / BM; nN = N / BM; nwg = nM * nN; G = G_; c = c_; }
    __host__ __device__ bool next(int i, Unit& u) const {
        const long L = (long)i * G + c; if (L >= nwg) return false;
        int wgid = (int)L; { const int q = nwg / NXCD, r = nwg % NXCD, xcd = wgid % NXCD, off = wgid / NXCD; wgid = (xcd < r ? xcd * (q + 1) : r * (q + 1) + (xcd - r) * q) + off; }
        const int nig = WGM * nN, gid = wgid / nig, fm = gid * WGM, gsz = (nM - fm) < WGM ? (nM - fm) : WGM;
        u.pm = fm + ((wgid % nig) % gsz); u.pn = (wgid % nig) / gsz; return true;
    }
    __device__ __forceinline__ void a_ready(const Unit&) const {}
    __device__ __forceinline__ void done(const Unit&) const {}
};

__device__ __forceinline__ unsigned cvt_pk_bf16(float lo, float hi) { unsigned r; asm volatile("v_cvt_pk_bf16_f32 %0, %1, %2" : "=v"(r) : "v"(lo), "v"(hi)); return r; }

template <class Epi, class Sched, bool ALIGN_EPI = false, bool SP2 = false>
__device__ __forceinline__ void gemm_phase(PG8_LAS unsigned char* lds, const Gemm g, const Sched& S, const Epi& E, const int wid_) {
    int wid = wid_; asm volatile("" : "+s"(wid));
    const int lane = lane_id_v(), tid = wid * 64 + lane,
              wr = wid >> 2, wc = wid & 3, fr = lane & 15, fq = lane >> 4;
    const int K = g.K, nt = K / BK;
    unsigned voffA[2], voffB[2];
#pragma unroll
    for (int i = 0; i < 2; ++i) { int R, C; stage_rc(tid * 16 + i * 8192, R, C); const int Rb = Epi::PERM ? ((R & ~31) + perm32(R & 31)) : R;
        voffA[i] = (unsigned)(R * K + C) * 2u; voffB[i] = (unsigned)(Rb * K + C) * 2u; }
    const size_t kstep = (size_t)(BK * 2);
    const size_t hstep = (size_t)HALF * K * 2;
    const size_t tstep = 2 * hstep;
    const unsigned ldsw = (unsigned)wid * 1024u;
    const int aoff = lds_byte(wr * 64 + fr, fq * 8), boff = lds_byte(wc * 32 + fr, fq * 8);
#define PG8_SA(b, h) (((b) * 2 + (h)) * HTB)
#define PG8_SB(b, h) ((4 + (b) * 2 + (h)) * HTB)
#define PG8_STAGE(bufoff, gbase, voff) do { _Pragma("unroll") for (int _i = 0; _i < 2; ++_i) \
        __builtin_amdgcn_global_load_lds((const unsigned*)((const char*)(gbase) + (voff)[_i]), (PG8_LAS unsigned*)(lds + (bufoff) + ldsw + _i * 8192), 16, 0, 0); } while (0)
#define PG8_LDA(dst, b, h) do { _Pragma("unroll") for (int m = 0; m < 4; ++m) _Pragma("unroll") for (int k = 0; k < 2; ++k) dst[m][k] = *(const PG8_LAS bf16x8*)(lds + PG8_SA(b, h) + aoff + m * 2048 + k * 1024); } while (0)
#define PG8_LDB(dst, b, h) do { _Pragma("unroll") for (int n = 0; n < 2; ++n) _Pragma("unroll") for (int k = 0; k < 2; ++k) dst[n][k] = *(const PG8_LAS bf16x8*)(lds + PG8_SB(b, h) + boff + n * 2048 + k * 1024); } while (0)
#define PG8_MMA(ai, bj, At, Bt) do { __builtin_amdgcn_s_setprio(1); _Pragma("unroll") for (int m = 0; m < 4; ++m) _Pragma("unroll") for (int n = 0; n < 2; ++n) _Pragma("unroll") for (int k = 0; k < 2; ++k) \
        acc[ai][bj][m][n] = __builtin_amdgcn_mfma_f32_16x16x32_bf16(Bt[n][k], At[m][k], acc[ai][bj][m][n], 0, 0, 0); __builtin_amdgcn_s_setprio(0); } while (0)
#define PG8_WAIT_V(n) asm volatile("s_waitcnt vmcnt(" #n ")" ::: "memory")
#define PG8_WAIT_L(n) asm volatile("s_waitcnt lgkmcnt(" #n ")" ::: "memory")
#define PG8_BAR __builtin_amdgcn_s_barrier()
#define PG8_SCHED __builtin_amdgcn_sched_barrier(0)
    Unit cur, nxt; int ui = 0;
    if (!S.next(0, cur)) return;
    f32x4 acc[2][2][4][2];
#pragma unroll
    for (int a = 0; a < 2; ++a)
#pragma unroll
        for (int b = 0; b < 2; ++b)
#pragma unroll
            for (int m = 0; m < 4; ++m)
#pragma unroll
                for (int n = 0; n < 2; ++n) acc[a][b][m][n] = (f32x4){0.f, 0.f, 0.f, 0.f};
    bf16x8 At[4][2], B0[2][2], B1[2][2];
    const char* cA = (const char*)g.A + (size_t)cur.pm * tstep; const char* cB = (const char*)g.Bt + (size_t)cur.pn * tstep;
    S.a_ready(cur);
    if constexpr (SP2) {
        PG8_STAGE(PG8_SB(0, 0), cB, voffB); PG8_STAGE(PG8_SB(0, 1), cB + hstep, voffB); PG8_STAGE(PG8_SA(0, 0), cA, voffA); PG8_STAGE(PG8_SA(0, 1), cA + hstep, voffA);
        if (wr == 1) PG8_BAR;
        PG8_WAIT_V(2); PG8_BAR;
        PG8_STAGE(PG8_SB(1, 0), cB + kstep, voffB); PG8_STAGE(PG8_SA(1, 0), cA + kstep, voffA); PG8_STAGE(PG8_SB(1, 1), cB + hstep + kstep, voffB);
        PG8_WAIT_V(6); PG8_BAR;
    } else {
        PG8_STAGE(PG8_SB(0, 0), cB, voffB); PG8_STAGE(PG8_SA(0, 0), cA, voffA); PG8_STAGE(PG8_SB(0, 1), cB + hstep, voffB); PG8_STAGE(PG8_SA(0, 1), cA + hstep, voffA);
        if (wr == 1) PG8_BAR;
        PG8_WAIT_V(4); PG8_BAR;
        PG8_STAGE(PG8_SB(1, 0), cB + kstep, voffB); PG8_STAGE(PG8_SA(1, 0), cA + kstep, voffA); PG8_STAGE(PG8_SB(1, 1), cB + hstep + kstep, voffB);
        PG8_WAIT_V(6); PG8_BAR;
    }
    for (;;) {
        const bool has_next = S.next(ui + 1, nxt);
        const char* nA = has_next ? (const char*)g.A + (size_t)nxt.pm * tstep : cA; const char* nB = has_next ? (const char*)g.Bt + (size_t)nxt.pn * tstep : cB;
#pragma nounroll
        for (int t = 0; t < nt; t += 2) {
            const bool last = (t == nt - 2);
            const char* a1 = cA + (size_t)(t + 1) * kstep;
            const char* a2 = last ? nA : cA + (size_t)(t + 2) * kstep; const char* b2 = last ? nB : cB + (size_t)(t + 2) * kstep;
            const char* a3 = a2 + kstep; const char* b3 = b2 + kstep;
            if (last && has_next) S.a_ready(nxt);
            if constexpr (SP2) {
            PG8_LDB(B0, 0, 0); PG8_LDB(B1, 0, 1); PG8_SCHED; PG8_LDA(At, 0, 0); PG8_STAGE(PG8_SA(1, 1), a1 + hstep, voffA);
            PG8_WAIT_V(8); PG8_WAIT_L(0); PG8_BAR; PG8_MMA(0, 0, At, B0); PG8_MMA(0, 1, At, B1); PG8_BAR; PG8_SCHED;
            PG8_LDA(At, 0, 1); PG8_STAGE(PG8_SB(0, 0), b2, voffB); PG8_STAGE(PG8_SB(0, 1), b2 + hstep, voffB); PG8_STAGE(PG8_SA(0, 0), a2, voffA);
            PG8_WAIT_V(8); PG8_WAIT_L(0); PG8_BAR; PG8_MMA(1, 0, At, B0); PG8_MMA(1, 1, At, B1); PG8_BAR; PG8_SCHED;
            PG8_LDB(B0, 1, 0); PG8_LDB(B1, 1, 1); PG8_SCHED; PG8_LDA(At, 1, 0); PG8_STAGE(PG8_SA(0, 1), a2 + hstep, voffA);
            PG8_WAIT_V(8); PG8_WAIT_L(0); PG8_BAR; PG8_MMA(0, 0, At, B0); PG8_MMA(0, 1, At, B1); PG8_BAR; PG8_SCHED;
            PG8_LDA(At, 1, 1); PG8_STAGE(PG8_SB(1, 0), b3, voffB); PG8_STAGE(PG8_SB(1, 1), b3 + hstep, voffB); PG8_STAGE(PG8_SA(1, 0), a3, voffA);
            PG8_WAIT_V(8); PG8_WAIT_L(0); PG8_BAR; PG8_MMA(1, 0, At, B0); PG8_MMA(1, 1, At, B1); PG8_BAR; PG8_SCHED;
            } else {
            PG8_LDB(B0, 0, 0); PG8_SCHED; PG8_LDA(At, 0, 0); PG8_STAGE(PG8_SA(1, 1), a1 + hstep, voffA);
            PG8_WAIT_L(8); PG8_BAR; PG8_WAIT_L(0); PG8_MMA(0, 0, At, B0); PG8_BAR; PG8_SCHED;
            PG8_LDB(B1, 0, 1); PG8_STAGE(PG8_SB(0, 0), b2, voffB);
            PG8_BAR; PG8_WAIT_L(0); PG8_MMA(0, 1, At, B1); PG8_BAR;
            PG8_LDA(At, 0, 1); PG8_STAGE(PG8_SA(0, 0), a2, voffA);
            PG8_BAR; PG8_WAIT_L(0); PG8_MMA(1, 0, At, B0); PG8_BAR; PG8_SCHED;
            PG8_STAGE(PG8_SB(0, 1), b2 + hstep, voffB);
            PG8_WAIT_V(6); PG8_BAR; PG8_MMA(1, 1, At, B1); PG8_BAR;
            PG8_LDB(B0, 1, 0); PG8_SCHED; PG8_LDA(At, 1, 0); PG8_STAGE(PG8_SA(0, 1), a2 + hstep, voffA);
            PG8_WAIT_L(8); PG8_BAR; PG8_WAIT_L(0); PG8_MMA(0, 0, At, B0); PG8_BAR; PG8_SCHED;
            PG8_LDB(B1, 1, 1); PG8_STAGE(PG8_SB(1, 0), b3, voffB);
            PG8_BAR; PG8_WAIT_L(0); PG8_MMA(0, 1, At, B1); PG8_BAR;
            PG8_LDA(At, 1, 1); PG8_STAGE(PG8_SA(1, 0), a3, voffA);
            PG8_BAR; PG8_WAIT_L(0); PG8_MMA(1, 0, At, B0); PG8_BAR; PG8_SCHED;
            PG8_STAGE(PG8_SB(1, 1), b3 + hstep, voffB);
            PG8_WAIT_V(6); PG8_BAR; PG8_MMA(1, 1, At, B1); PG8_BAR;
            }
        }
        if constexpr (ALIGN_EPI) { if (wr == 0) PG8_BAR; }
        E(acc, cur, wr, wc, fr, fq); S.done(cur);
        if (!has_next) break;
#pragma unroll
        for (int a = 0; a < 2; ++a)
#pragma unroll
            for (int b = 0; b < 2; ++b)
#pragma unroll
                for (int m = 0; m < 4; ++m)
#pragma unroll
                    for (int n = 0; n < 2; ++n) acc[a][b][m][n] = (f32x4){0.f, 0.f, 0.f, 0.f};
        cur = nxt; cA = nA; cB = nB; ++ui;
        if constexpr (ALIGN_EPI) { if (wr == 1) PG8_BAR; }
    }
    PG8_WAIT_V(0);
    if constexpr (!ALIGN_EPI) { if (wr == 0) PG8_BAR; }
    PG8_BAR;
#undef PG8_SA
#undef PG8_SB
#undef PG8_STAGE
#undef PG8_LDA
#undef PG8_LDB
#undef PG8_MMA
#undef PG8_WAIT_V
#undef PG8_WAIT_L
#undef PG8_BAR
#undef PG8_SCHED
}
}

constexpr int NWAVES = 8;
constexpr int BATCH = 4, SEQ = 8192, D = 1024, DEPTH = 4, M = BATCH * SEQ;
constexpr int NMEM = 256, MROWS = BATCH * NMEM;
constexpr int AH = 8, AHD = 64, AW = 512, KVR = 128, IH = 8, IDIM = 32, TOPK = 256;
constexpr int PW_ = 256, CH = 4, CHD = 64, CW = 256;
constexpr int DFF = 2816, INW = 4520, INP = 5120;
constexpr float EPS = 1e-6f;
constexpr int C_QA = 0, C_CKV = 512, C_IQ = 640, C_IK = 896, C_IW = 928, C_Z = 936, C_QC = 1192, C_G = 1448;

constexpr size_t MiB = 1u << 20;
constexpr size_t WS_CTL = 0, CTL_ZERO_BYTES = 1 * MiB;
constexpr size_t WS_SS = 1 * MiB;
constexpr size_t WS_IW = 3 * MiB;
constexpr size_t WS_SGN = 4 * MiB;
constexpr size_t WS_MEMN = 5 * MiB;
constexpr size_t WS_WMEM = 7 * MiB;
constexpr size_t WS_MEMKV = 11 * MiB;
constexpr size_t WS_W1IN = 15 * MiB, WS_W1OUT = 26 * MiB, WS_WIN = 32 * MiB, WS_WA = 42 * MiB, WS_WB = 44 * MiB, WS_WC = 44 * MiB + 512 * 1024, WS_WOUT = 45 * MiB, WS_W2IN = 47 * MiB, WS_W2OUT = 58 * MiB;
constexpr size_t WS_HB = 64 * MiB;
constexpr size_t WS_ACT = 128 * MiB;
constexpr size_t WS_G = 128 * MiB;
constexpr size_t WS_QL = 320 * MiB;
constexpr size_t WS_CKV = 384 * MiB;
constexpr size_t WS_CKVRAW = 392 * MiB;
constexpr size_t WS_IQRAW = 408 * MiB;
constexpr size_t WS_IQF = 424 * MiB;
constexpr size_t WS_IK = 440 * MiB;
constexpr size_t WS_Z = 442 * MiB;
constexpr size_t WS_MERGED = 384 * MiB;
constexpr size_t WS_YB = 458 * MiB;
constexpr size_t WS_QC = 474 * MiB;
constexpr size_t WS_SEL = 490 * MiB;
constexpr size_t WS_VT = 506 * MiB;
constexpr size_t WS_WPT = 4 * MiB + 512 * 1024;
constexpr size_t WS_END = 510 * MiB;
constexpr int CW_BAR = 4096;

constexpr int RING_OFF = 0, RING_BYTES = 131072;
constexpr int LDS_BYTES = 155648;
constexpr int MISC_OFF = LDS_BYTES - 256;

#define GAS __attribute__((address_space(1)))
#define LAS __attribute__((address_space(3)))
typedef unsigned short bf16;
typedef unsigned v4u __attribute__((ext_vector_type(4)));
typedef unsigned v2u __attribute__((ext_vector_type(2)));
typedef float f32x4 __attribute__((ext_vector_type(4)));
typedef float f32x2 __attribute__((ext_vector_type(2)));
typedef GAS unsigned gu32;
#define RLX_AGENT __ATOMIC_RELAXED, __HIP_MEMORY_SCOPE_AGENT
#define LDS_WAIT() asm volatile("s_waitcnt lgkmcnt(0)" ::: "memory")
#define VM_WAIT() asm volatile("s_waitcnt vmcnt(0)" ::: "memory")
__device__ __forceinline__ unsigned f2bf(float f) { unsigned u = __builtin_bit_cast(unsigned, f); return (u + 0x7fffu + ((u >> 16) & 1u)) >> 16; }
__device__ __forceinline__ unsigned pk2(float lo, float hi) { return pg8::cvt_pk_bf16(lo, hi); }
__device__ __forceinline__ float bflo(unsigned w) { return __builtin_bit_cast(float, w << 16); }
__device__ __forceinline__ float bfhi(unsigned w) { return __builtin_bit_cast(float, w & 0xffff0000u); }
typedef _Float16 h2_t __attribute__((ext_vector_type(2)));
typedef _Float16 f16x8_t __attribute__((ext_vector_type(8)));
__device__ __forceinline__ unsigned pkh2(float lo, float hi) { const h2_t v = {(_Float16)lo, (_Float16)hi}; return __builtin_bit_cast(unsigned, v); }
__device__ __forceinline__ float hlo(unsigned w) { return (float)__builtin_bit_cast(h2_t, w)[0]; }
__device__ __forceinline__ float hhi(unsigned w) { return (float)__builtin_bit_cast(h2_t, w)[1]; }
__device__ __forceinline__ float bf2f(bf16 b) { return __builtin_bit_cast(float, ((unsigned)b) << 16); }

#define XB_TMO      128
#define XB_XCNT(j)  (256  + 64 * (j))
#define XB_XSUB(j)  (1280 + 64 * (j))
#define XB_XGEN(j)  (2304 + 64 * (j))
#define XB_TOP      3328
#define XB_TOPGEN   3392
#define XCD_BAR_WORDS 3456
#define XB_SPIN_CAP (1u << 23)

__device__ __forceinline__ unsigned xb_ld(unsigned* p)              { return __hip_atomic_load(p, __ATOMIC_RELAXED, __HIP_MEMORY_SCOPE_AGENT); }
__device__ __forceinline__ unsigned xb_add(unsigned* p, unsigned v) { return __hip_atomic_fetch_add(p, v, __ATOMIC_RELAXED, __HIP_MEMORY_SCOPE_AGENT); }
__device__ __forceinline__ unsigned xb_xcc_id() { return (unsigned)__builtin_amdgcn_s_getreg((3 << 11) | 20) & 0xFu; }
#define XB_SPIN(cond, bar) do { unsigned _sp = 0; while (cond) { __builtin_amdgcn_s_sleep(1); \
    if ((++_sp & 255u) == 0u) { if (xb_ld(&(bar)[XB_TMO])) break; if (_sp > XB_SPIN_CAP) { atomicAdd(&(bar)[XB_TMO], 1u); break; } } } } while (0)

struct XcdBarrier { unsigned* bar; unsigned x; volatile LAS unsigned* st; int wave; };

__device__ __forceinline__ XcdBarrier xcd_barrier_post(unsigned* bar, volatile LAS unsigned* st, int wave) {
    XcdBarrier b; b.bar = bar; b.x = xb_xcc_id(); b.st = st; b.wave = wave;
    if (threadIdx.x == 0) (void)xb_add(&bar[XB_XCNT(b.x)], 1u);
    return b;
}
__device__ __forceinline__ void xcd_barrier_complete(unsigned* bar, unsigned x, unsigned& nloc, unsigned& nx) {
    const unsigned G = gridDim.x * gridDim.y * gridDim.z;
    unsigned sum, cnt, mine, sp = 0u;
    for (;;) {
        sum = 0u; cnt = 0u; mine = 0u;
#pragma unroll
        for (unsigned j = 0; j < 16; ++j) { const unsigned c = xb_ld(&bar[XB_XCNT(j)]); sum += c; cnt += (c > 0u) ? 1u : 0u; mine = (j == x) ? c : mine; }
        if (sum == G) break;
        __builtin_amdgcn_s_sleep(1);
        if ((++sp & 255u) == 0u) { if (xb_ld(&bar[XB_TMO])) break; if (sp > XB_SPIN_CAP) { atomicAdd(&bar[XB_TMO], 1u); break; } }
    }
    nloc = mine > 0u ? mine : 1u; nx = cnt > 0u ? cnt : 1u;
}
__device__ __forceinline__ void xcd_barrier(const XcdBarrier& b) {
    asm volatile("s_waitcnt vmcnt(0)" ::: "memory");
    __syncthreads();
    int bw_ = b.wave; asm volatile("" : "+s"(bw_));
    if (bw_ == 0 && lane_id_v() == 0) {
        unsigned* bar = b.bar;
        __builtin_amdgcn_s_waitcnt(0);
        unsigned nloc = b.st[0], nx = b.st[1];
        if (nloc == 0u) { xcd_barrier_complete(bar, b.x, nloc, nx); b.st[0] = nloc; b.st[1] = nx; }
        const unsigned old = xb_add(&bar[XB_XSUB(b.x)], 1u);
        const unsigned gen = old / nloc;
        if (old + 1u == (gen + 1u) * nloc) {
            __builtin_amdgcn_fence(__ATOMIC_RELEASE, "agent");
            asm volatile("s_waitcnt vmcnt(0)" ::: "memory");
            const unsigned og = xb_add(&bar[XB_TOP], 1u);
            const unsigned tg = og / nx;
            if (og + 1u == (tg + 1u) * nx) xb_add(&bar[XB_TOPGEN], 1u);
            else XB_SPIN(xb_ld(&bar[XB_TOPGEN]) == tg, bar);
            __builtin_amdgcn_fence(__ATOMIC_ACQUIRE, "agent");
            xb_add(&bar[XB_XGEN(b.x)], 1u);
            asm volatile("s_waitcnt vmcnt(0)" ::: "memory");
        } else {
            XB_SPIN(xb_ld(&bar[XB_XGEN(b.x)]) == gen, bar);
            __builtin_amdgcn_fence(__ATOMIC_ACQUIRE, "agent");
            asm volatile("s_waitcnt vmcnt(0)" ::: "memory");
        }
    }
    __syncthreads();
}

struct Args {
    const float* in[23]; float* out; unsigned char* ws; int ph_lo, ph_hi;
};
template <class T> __device__ __forceinline__ T* uni(T* p) { const unsigned long long v = (unsigned long long)p; const unsigned lo = __builtin_amdgcn_readfirstlane((unsigned)v), hi = __builtin_amdgcn_readfirstlane((unsigned)(v >> 32)); return (T*)(((unsigned long long)hi << 32) | lo); }
__device__ __forceinline__ LAS unsigned char* uni_l(LAS unsigned char* p) { return (LAS unsigned char*)(unsigned)__builtin_amdgcn_readfirstlane((int)(unsigned)(size_t)p); }
__device__ __forceinline__ int uni_i(int v) { return __builtin_amdgcn_readfirstlane(v); }
struct PC { const float* const* in; float* out; unsigned char* ws; LAS unsigned char* lds; int wave, vcu, G; };
struct Frame {
    LAS unsigned char* lds;
    volatile LAS unsigned* MISC;
    gu32* ctl;
    int wave, vcu, G;
    unsigned char* ws;
};
__device__ __forceinline__ unsigned char* launder_p(unsigned char* p) { asm volatile("" : "+s"(p)); return p; }
__device__ __forceinline__ int launder_s(int v) { asm volatile("" : "+s"(v)); return v; }
__device__ __forceinline__ int launder_v(int v) { asm volatile("" : "+v"(v)); return v; }
__device__ __forceinline__ float wave_sum(float v) {
#pragma unroll
    for (int o = 1; o < 64; o <<= 1) v += __shfl_xor(v, o);
    return v;
}
__device__ __forceinline__ float wave_max(float v) {
#pragma unroll
    for (int o = 1; o < 64; o <<= 1) v = fmaxf(v, __shfl_xor(v, o));
    return v;
}

using pg8::Unit; using pg8::bf16_t;
#define LAUNDER2(a, b) asm volatile("" : "+v"(a), "+v"(b))
__device__ __forceinline__ float row_scale(const float* ss, int row) {
    const f32x4 a = *(const f32x4*)(ss + (size_t)row * 4);
    const float s = (a.x + a.y) + (a.z + a.w);
    return __builtin_amdgcn_rsqf(s * (1.0f / D) + EPS);
}
__device__ __forceinline__ float sigmoidf_(float x) { return __builtin_amdgcn_rcpf(1.0f + __expf(-x)); }
__device__ __forceinline__ pg8::u32x2 pack4(const f32x4 v) { pg8::u32x2 w; w.x = pg8::cvt_pk_bf16(v[0], v[1]); w.y = pg8::cvt_pk_bf16(v[2], v[3]); return w; }

struct EpiSwiglu {
    static constexpr bool PERM = true;
    bf16_t* O; const float* ss;
    __device__ __forceinline__ void operator()(const f32x4 (&acc)[2][2][4][2], const Unit& u, int wr, int wc, int fr_, int fq_) const {
        const int l_ = lane_id_v(); const int fr = l_ & 15, fq = l_ >> 4; (void)fr_; (void)fq_;
        int rb = wr * 64 + fr, cb = wc * 32 + 8 * fq; LAUNDER2(rb, cb);
        const int row0 = u.pm * 256 + rb, col0 = u.pn * 128 + cb;
#pragma unroll
        for (int ai = 0; ai < 2; ++ai)
#pragma unroll
            for (int m = 0; m < 4; ++m) { const int row = row0 + ai * 128 + m * 16; const float s = row_scale(ss, row);
                pg8::u32x4 w;
                { const f32x4 a = acc[ai][0][m][0] * s, b = acc[ai][1][m][0] * s; f32x4 o;
#pragma unroll
                  for (int i = 0; i < 4; ++i) o[i] = a[i] * sigmoidf_(a[i]) * b[i];
                  w.x = pg8::cvt_pk_bf16(o[0], o[1]); w.y = pg8::cvt_pk_bf16(o[2], o[3]); }
                { const f32x4 a = acc[ai][0][m][1] * s, b = acc[ai][1][m][1] * s; f32x4 o;
#pragma unroll
                  for (int i = 0; i < 4; ++i) o[i] = a[i] * sigmoidf_(a[i]) * b[i];
                  w.z = pg8::cvt_pk_bf16(o[0], o[1]); w.w = pg8::cvt_pk_bf16(o[2], o[3]); }
                *(pg8::u32x4*)(O + (size_t)row * DFF + col0) = w; }
    }
};
struct EpiResid {
    static constexpr bool PERM = true;
    const float* base; float* out; bf16_t* hb; float* ss; float alpha; LAS float* P; int dry;
    __device__ __forceinline__ void operator()(const f32x4 (&acc)[2][2][4][2], const Unit& u, int wr, int wc, int fr_, int fq_) const {
        const int l_ = lane_id_v(); const int fr = l_ & 15, fq = l_ >> 4; (void)fr_; (void)fq_;
        int rb = wr * 64 + fr, cb = wc * 32 + 8 * fq; LAUNDER2(rb, cb);
        const int row0 = u.pm * 256 + rb, col0 = u.pn * 256 + cb;
#pragma unroll
        for (int ai = 0; ai < 2; ++ai)
#pragma unroll
          for (int mh = 0; mh < 2; ++mh) {
            f32x4 bs[2][2][2];
#pragma unroll
            for (int mm = 0; mm < 2; ++mm) { const size_t off = (size_t)(row0 + ai * 128 + (2 * mh + mm) * 16) * D + col0;
#pragma unroll
                for (int bj = 0; bj < 2; ++bj)
#pragma unroll
                    for (int n = 0; n < 2; ++n) bs[mm][bj][n] = *(const f32x4*)(base + off + bj * 128 + n * 4); }
#pragma unroll
            for (int mm = 0; mm < 2; ++mm) { const int m = 2 * mh + mm; const int row = row0 + ai * 128 + m * 16; const size_t off = (size_t)row * D + col0; float q = 0.f;
#pragma unroll
                for (int bj = 0; bj < 2; ++bj) { const f32x4 v0 = bs[mm][bj][0] + acc[ai][bj][m][0] * alpha, v1 = bs[mm][bj][1] + acc[ai][bj][m][1] * alpha;
                    if (!dry) { *(f32x4*)(out + off + bj * 128) = v0; *(f32x4*)(out + off + bj * 128 + 4) = v1;
                        pg8::u32x4 w; w.x = pg8::cvt_pk_bf16(v0[0], v0[1]); w.y = pg8::cvt_pk_bf16(v0[2], v0[3]); w.z = pg8::cvt_pk_bf16(v1[0], v1[1]); w.w = pg8::cvt_pk_bf16(v1[2], v1[3]);
                        *(pg8::u32x4*)(hb + off + bj * 128) = w; }
                    q += ((v0[0] * v0[0] + v0[1] * v0[1]) + (v0[2] * v0[2] + v0[3] * v0[3])) + ((v1[0] * v1[0] + v1[1] * v1[1]) + (v1[2] * v1[2] + v1[3] * v1[3])); }
                q += __shfl_xor(q, 16); q += __shfl_xor(q, 32);
                if (fq == 0) P[(rb + ai * 128 + m * 16) * 4 + wc] = q; }
            asm volatile("" ::: "memory"); }
        asm volatile("s_waitcnt lgkmcnt(0)" ::: "memory"); __builtin_amdgcn_s_barrier(); asm volatile("" ::: "memory");
        const int tid = (wr * 4 + wc) * 64 + fq * 16 + fr;
        if (tid < 256 && !dry) { const f32x4 p = *(const LAS f32x4*)(P + tid * 4); ss[(size_t)(u.pm * 256 + tid) * 4 + u.pn] = (p.x + p.y) + (p.z + p.w); }
    }
};
struct EpiPlainBf16 {
    static constexpr bool PERM = false;
    bf16_t* O; int ldo;
    __device__ __forceinline__ void operator()(const f32x4 (&acc)[2][2][4][2], const Unit& u, int wr, int wc, int fr_, int fq_) const {
        const int l_ = lane_id_v(); const int fr = l_ & 15, fq = l_ >> 4; (void)fr_; (void)fq_;
        int rb = wr * 64 + fr, cb = wc * 32 + 4 * fq; LAUNDER2(rb, cb);
        const int row0 = u.pm * 256 + rb, col0 = u.pn * 256 + cb;
#pragma unroll
        for (int ai = 0; ai < 2; ++ai)
#pragma unroll
            for (int m = 0; m < 4; ++m) { bf16_t* rowp = O + (size_t)(row0 + ai * 128 + m * 16) * ldo + col0;
#pragma unroll
                for (int bj = 0; bj < 2; ++bj)
#pragma unroll
                    for (int n = 0; n < 2; ++n) *(pg8::u32x2*)(rowp + bj * 128 + n * 16) = pack4(acc[ai][bj][m][n]); }
    }
};
struct EpiInProj {
    static constexpr bool PERM = true;
    const float* ss; bf16_t* qa; float* ckvraw; bf16_t* ik; float* iw; bf16_t* iqraw; bf16_t* z; bf16_t* qc; bf16_t* G;
    __device__ __forceinline__ void operator()(const f32x4 (&acc)[2][2][4][2], const Unit& u, int wr, int wc, int fr_, int fq_) const {
        const int l_ = lane_id_v(); const int fr = l_ & 15, fq = l_ >> 4; (void)fr_; (void)fq_;
        int rb = wr * 64 + fr, ct = wc * 32 + 8 * fq; LAUNDER2(rb, ct);
        const int row0 = u.pm * 256 + rb; const int pn = u.pn;
        if (pn == 4) {
#pragma unroll
            for (int ai = 0; ai < 2; ++ai)
#pragma unroll
                for (int m = 0; m < 4; ++m) { const int row = row0 + ai * 128 + m * 16; const float s = row_scale(ss, row);
#pragma unroll
                    for (int n = 0; n < 2; ++n) *(f32x4*)(ckvraw + (size_t)row * KVR + ct + n * 4) = acc[ai][0][m][n] * s;
                    if (wc == 0) { const f32x4 k0 = acc[ai][1][m][0] * s, k1 = acc[ai][1][m][1] * s; pg8::u32x4 w; w.x = pkh2(k0[0], k0[1]); w.y = pkh2(k0[2], k0[3]); w.z = pkh2(k1[0], k1[1]); w.w = pkh2(k1[2], k1[3]);
                        *(pg8::u32x4*)(ik + (size_t)row * IDIM + 8 * fq) = w; }
                    if (wc == 1 && fq == 0) { *(f32x4*)(iw + (size_t)row * IH) = acc[ai][1][m][0] * s; *(f32x4*)(iw + (size_t)row * IH + 4) = acc[ai][1][m][1] * s; } }
        } else {
            bf16_t* dst0; int ld; bool sig = false; const bool f16out = (pn == 5);
            if (pn < 4) { dst0 = qa + pn * 256; ld = 1024; } else if (pn == 5) { dst0 = iqraw; ld = 256; } else if (pn == 6) { dst0 = z; ld = 256; } else if (pn == 7) { dst0 = qc; ld = 256; } else { dst0 = G + (pn - 8) * 256; ld = 3072; sig = true; }
#pragma unroll
            for (int ai = 0; ai < 2; ++ai)
#pragma unroll
                for (int m = 0; m < 4; ++m) { const int row = row0 + ai * 128 + m * 16; const float s = row_scale(ss, row); bf16_t* rowp = dst0 + (size_t)row * ld + ct;
#pragma unroll
                    for (int bj = 0; bj < 2; ++bj) { f32x4 o0 = acc[ai][bj][m][0] * s, o1 = acc[ai][bj][m][1] * s;
                        if (sig) {
#pragma unroll
                            for (int i = 0; i < 4; ++i) { o0[i] = sigmoidf_(o0[i]); o1[i] = sigmoidf_(o1[i]); } }
                        pg8::u32x4 wo;
                        if (f16out) { wo.x = pkh2(o0[0], o0[1]); wo.y = pkh2(o0[2], o0[3]); wo.z = pkh2(o1[0], o1[1]); wo.w = pkh2(o1[2], o1[3]); }
                        else { wo.x = pg8::cvt_pk_bf16(o0[0], o0[1]); wo.y = pg8::cvt_pk_bf16(o0[2], o0[3]); wo.z = pg8::cvt_pk_bf16(o1[0], o1[1]); wo.w = pg8::cvt_pk_bf16(o1[2], o1[3]); }
                        *(pg8::u32x4*)(rowp + bj * 128) = wo; } }
        }
    }
};
template <int MODE> struct EpiMerge {
    static constexpr bool PERM = true;
    bf16_t* Mg; const bf16_t* G;
    __device__ __forceinline__ void operator()(const f32x4 (&acc)[2][2][4][2], const Unit& u, int wr, int wc, int fr_, int fq_) const {
        const int l_ = lane_id_v(); const int fr = l_ & 15, fq = l_ >> 4; (void)fr_; (void)fq_;
        int rb = wr * 64 + fr, cb = wc * 32 + 8 * fq; LAUNDER2(rb, cb);
        const int row0 = u.pm * 256 + rb, col0 = u.pn * 256 + cb;
#pragma unroll
        for (int ai = 0; ai < 2; ++ai)
#pragma unroll
            for (int m = 0; m < 4; ++m) { const int row = row0 + ai * 128 + m * 16;
                const bf16_t* gp = G + (size_t)row * 3072 + MODE * 1024 + col0; bf16_t* mp = Mg + (size_t)row * D + col0;
#pragma unroll
                for (int bj = 0; bj < 2; ++bj) { const int co = bj * 128;
                    const pg8::u32x4 gw = *(const pg8::u32x4*)(gp + co);
                    f32x4 o0 = acc[ai][bj][m][0], o1 = acc[ai][bj][m][1];
                    o0[0] *= bflo(gw.x); o0[1] *= bfhi(gw.x); o0[2] *= bflo(gw.y); o0[3] *= bfhi(gw.y); o1[0] *= bflo(gw.z); o1[1] *= bfhi(gw.z); o1[2] *= bflo(gw.w); o1[3] *= bfhi(gw.w);
                    if (MODE > 0) { const pg8::u32x4 pw = *(const pg8::u32x4*)(mp + co);
                        o0[0] += bflo(pw.x); o0[1] += bfhi(pw.x); o0[2] += bflo(pw.y); o0[3] += bfhi(pw.y); o1[0] += bflo(pw.z); o1[1] += bfhi(pw.z); o1[2] += bflo(pw.w); o1[3] += bfhi(pw.w); }
                    pg8::u32x4 w; w.x = pg8::cvt_pk_bf16(o0[0], o0[1]); w.y = pg8::cvt_pk_bf16(o0[2], o0[3]); w.z = pg8::cvt_pk_bf16(o1[0], o1[1]); w.w = pg8::cvt_pk_bf16(o1[2], o1[3]);
                    *(pg8::u32x4*)(mp + co) = w; asm volatile("" ::: "memory"); }
                }
    }
};

template <class Map>
__device__ __forceinline__ void transpose_item(const float* W, int K, int N, const float* gain, bf16* WT, LAS float* scr, int item, int lane, Map map) {
    const int nblk = (N + 63) / 64, kb = item / nblk, nb = item % nblk, k0 = 64 * kb, n0 = 64 * nb;
    const int nn = n0 + 4 * (lane & 15); const bool nok = nn < N;
#pragma unroll 4
    for (int i = 0; i < 16; ++i) { const int kk = 4 * i + (lane >> 4); f32x4 v = nok ? *(const f32x4*)(W + (size_t)(k0 + kk) * N + nn) : (f32x4){0.f, 0.f, 0.f, 0.f};
        if (gain) v = v * gain[k0 + kk];
        *(LAS f32x4*)(scr + kk * 68 + 4 * (lane & 15)) = v; }
    LDS_WAIT(); asm volatile("" ::: "memory");
    const int c = lane & 7;
#pragma unroll
    for (int j = 0; j < 8; ++j) { const int n = (lane >> 3) + 8 * j; const LAS float* sp = scr + (8 * c) * 68 + n;
        v4u o; o.x = pk2(sp[0 * 68], sp[1 * 68]); o.y = pk2(sp[2 * 68], sp[3 * 68]); o.z = pk2(sp[4 * 68], sp[5 * 68]); o.w = pk2(sp[6 * 68], sp[7 * 68]);
        if (n0 + n < N) { const int dr = map(n0 + n); if (dr >= 0) *(GAS v4u*)(WT + (size_t)dr * K + k0 + 8 * c) = o; } }
    LDS_WAIT(); asm volatile("" ::: "memory");
}
struct MapId { int off; __device__ __forceinline__ int operator()(int n) const { return off + n; } };
struct MapSwiglu { __device__ __forceinline__ int operator()(int c) const { const int half = c >= DFF ? 1 : 0, j = c - half * DFF; return 256 * (j >> 7) + 128 * half + (j & 127); } };
struct MapInProj { __device__ __forceinline__ int operator()(int c) const {
    if (c < C_CKV) return -1;
    if (c < C_IQ) return 1024 + (c - C_CKV);
    if (c < C_IK) return 1280 + (c - C_IQ);
    if (c < C_IW) return 1152 + (c - C_IK);
    if (c < C_Z) return 1184 + (c - C_IW);
    if (c < C_QC) return 1536 + (c - C_Z);
    if (c < C_G) return 1792 + (c - C_QC);
    return 2048 + (c - C_G); } };
__device__ __forceinline__ void qlat_item(const float* win, const float* mixn, const float* wuk, bf16* WT, int item, int lane) {
    const int kc = item & 127, rh = (item >> 7) & 1, h = item >> 8; const int r = rh * 64 + lane;
    const f32x4* wp = (const f32x4*)(wuk + (size_t)r * (AH * AHD) + h * 64);
    float acc[8] = {0.f, 0.f, 0.f, 0.f, 0.f, 0.f, 0.f, 0.f};
#pragma unroll 1
    for (int dc = 0; dc < 4; ++dc) {
        const f32x4 w0 = wp[4 * dc], w1 = wp[4 * dc + 1], w2 = wp[4 * dc + 2], w3 = wp[4 * dc + 3];
#pragma unroll
        for (int kk = 0; kk < 8; ++kk) { const f32x4* ip = (const f32x4*)(win + (size_t)(kc * 8 + kk) * INW + h * 64 + 16 * dc);
            const f32x4 a0 = ip[0], a1 = ip[1], a2 = ip[2], a3 = ip[3];
            acc[kk] += (a0.x * w0.x + a0.y * w0.y + a0.z * w0.z + a0.w * w0.w) + (a1.x * w1.x + a1.y * w1.y + a1.z * w1.z + a1.w * w1.w)
                     + (a2.x * w2.x + a2.y * w2.y + a2.z * w2.z + a2.w * w2.w) + (a3.x * w3.x + a3.y * w3.y + a3.z * w3.z + a3.w * w3.w);
            if (kk & 1) asm volatile("" ::: "memory"); }
    }
    const f32x4 g0 = *(const f32x4*)(mixn + kc * 8), g1 = *(const f32x4*)(mixn + kc * 8 + 4);
    v4u w; w.x = pk2(acc[0] * g0.x, acc[1] * g0.y); w.y = pk2(acc[2] * g0.z, acc[3] * g0.w); w.z = pk2(acc[4] * g1.x, acc[5] * g1.y); w.w = pk2(acc[6] * g1.z, acc[7] * g1.w);
    *(GAS v4u*)(WT + (size_t)(h * 128 + r) * D + kc * 8) = w;
}
__device__ __forceinline__ void wafold_item(const float* wuv, const float* wba, bf16* WT, int item, int lane) {
    const int ng = item & 15, rg = (item >> 4) & 15, h = item >> 8; const int n = ng * 64 + lane, r0 = rg * 8;
    float acc[8] = {0.f, 0.f, 0.f, 0.f, 0.f, 0.f, 0.f, 0.f};
#pragma unroll 4
    for (int d = 0; d < 64; ++d) { const float wa = wba[(size_t)(h * 64 + d) * D + n];
#pragma unroll
        for (int j = 0; j < 8; ++j) acc[j] += wuv[(size_t)(r0 + j) * (AH * AHD) + h * 64 + d] * wa; }
    v4u w; w.x = pk2(acc[0], acc[1]); w.y = pk2(acc[2], acc[3]); w.z = pk2(acc[4], acc[5]); w.w = pk2(acc[6], acc[7]);
    *(GAS v4u*)(WT + (size_t)n * 1024 + h * 128 + r0) = w;
}
__device__ __forceinline__ int items_of(int K, int N) { return (K / 64) * ((N + 63) / 64); }

__device__ __forceinline__ void prep_layer_weights_body(const PC& F, int l) {
    struct { const float* const* in; } a{F.in};
    const int lane_ = lane_id_v();
    LAS float* scr = (LAS float*)(F.lds + RING_OFF + F.wave * 17408);
    const int gw = F.vcu * NWAVES + F.wave, NGW = F.G * NWAVES;
    const float* f1n = a.in[3] + (size_t)l * D; const float* f1in = a.in[4] + (size_t)l * D * 2 * DFF; const float* f1out = a.in[5] + (size_t)l * DFF * D;
    const float* mixn = a.in[6] + (size_t)l * D; const float* win = a.in[7] + (size_t)l * D * INW;
    const float* wba = a.in[15] + (size_t)l * AW * D; const float* wbb = a.in[16] + (size_t)l * PW_ * D; const float* wbc = a.in[17] + (size_t)l * CW * D;
    const float* wout = a.in[18] + (size_t)l * D * D;
    const float* f2n = a.in[19] + (size_t)l * D; const float* f2in = a.in[20] + (size_t)l * D * 2 * DFF; const float* f2out = a.in[21] + (size_t)l * DFF * D;
    unsigned char* ws = launder_p(F.ws);
    const float* wuk = a.in[9] + (size_t)l * KVR * AH * AHD; const float* wuv = a.in[10] + (size_t)l * KVR * AH * AHD;
    const int I0 = items_of(D, 2 * DFF), I1 = items_of(DFF, D), I2 = items_of(D, INW), I4 = items_of(PW_, D), I5 = items_of(CW, D), I6 = items_of(D, D);
    const int NIT = 2 * I0 + 2 * I1 + I2 + I4 + I5 + I6;
#pragma unroll 1
    for (int it = gw; it < NIT; it += NGW) {
        int r = it;
        if (r < I0) { transpose_item(f1in, D, 2 * DFF, f1n, (bf16*)(ws + WS_W1IN), scr, r, lane_, MapSwiglu{}); continue; } r -= I0;
        if (r < I0) { transpose_item(f2in, D, 2 * DFF, f2n, (bf16*)(ws + WS_W2IN), scr, r, lane_, MapSwiglu{}); continue; } r -= I0;
        if (r < I1) { transpose_item(f1out, DFF, D, nullptr, (bf16*)(ws + WS_W1OUT), scr, r, lane_, MapId{0}); continue; } r -= I1;
        if (r < I1) { transpose_item(f2out, DFF, D, nullptr, (bf16*)(ws + WS_W2OUT), scr, r, lane_, MapId{0}); continue; } r -= I1;
        if (r < I2) { transpose_item(win, D, INW, mixn, (bf16*)(ws + WS_WIN), scr, r, lane_, MapInProj{}); continue; } r -= I2;
        if (r < I4) { transpose_item(wbb, PW_, D, nullptr, (bf16*)(ws + WS_WB), scr, r, lane_, MapId{0}); continue; } r -= I4;
        if (r < I5) { transpose_item(wbc, CW, D, nullptr, (bf16*)(ws + WS_WC), scr, r, lane_, MapId{0}); continue; } r -= I5;
        transpose_item(wout, D, D, nullptr, (bf16*)(ws + WS_WOUT), scr, r, lane_, MapId{0});
    }
    { const float* wpool = a.in[11] + (size_t)l * 4 * 64 * 64; bf16* wpT = (bf16*)(ws + WS_WPT);
      for (int i = gw * 64 + lane_; i < 4 * 64 * 64; i += NGW * 64) { const int c = i & 63, d = (i >> 6) & 63, g = i >> 12; wpT[i] = (bf16)f2bf(wpool[(g * 64 + c) * 64 + d]); } }
    asm volatile("" ::: "memory");
#pragma unroll 1
    for (int it = gw; it < 2048; it += NGW) wafold_item(wuv, wba, (bf16*)(ws + WS_WA), it, lane_);
    asm volatile("" ::: "memory");
#pragma unroll 1
    for (int it = gw; it < 2048; it += NGW) qlat_item(win, mixn, wuk, (bf16*)(ws + WS_WIN), it, lane_);
}

__device__ __noinline__ void p0_prologue(const float* const* in_, float* out_, unsigned char* ws_, LAS unsigned char* lds_, int wave_, int vcu_, int G_) {
    const PC F{uni(in_), uni(out_), uni(ws_), uni_l(lds_), uni_i(wave_), uni_i(vcu_), uni_i(G_)}; struct { const float* const* in; } a{F.in};
    const int lane_ = lane_id_v();
    const int gw = F.vcu * NWAVES + F.wave, NGW = F.G * NWAVES;
    const float* x = a.in[0]; const float* mem = a.in[1];
    bf16* hb = (bf16*)(F.ws + WS_HB); float* ss = (float*)(F.ws + WS_SS); bf16* memn = (bf16*)(F.ws + WS_MEMN);
    for (int m = gw; m < M + MROWS; m += NGW) {
        const bool ismem = m >= M; const int r = ismem ? m - M : m;
        const GAS f32x4* xr = (const GAS f32x4*)((ismem ? mem : x) + (size_t)r * D) + lane_;
        f32x4 v[4]; float s = 0.f;
#pragma unroll
        for (int j = 0; j < 4; ++j) { v[j] = xr[64 * j]; s += (v[j].x * v[j].x + v[j].y * v[j].y) + (v[j].z * v[j].z + v[j].w * v[j].w); }
        s = wave_sum(s);
        float sc = 1.f;
        if (ismem) sc = 1.0f / sqrtf(s * (1.0f / D) + EPS);
        else if (lane_ < 4) ss[(size_t)r * 4 + lane_] = lane_ == 0 ? s : 0.f;
        GAS unsigned long long* o8 = (GAS unsigned long long*)((ismem ? memn : hb) + (size_t)r * D) + lane_;
#pragma unroll
        for (int j = 0; j < 4; ++j) o8[64 * j] = (unsigned long long)pk2(v[j].x * sc, v[j].y * sc) | ((unsigned long long)pk2(v[j].z * sc, v[j].w * sc) << 32);
    }
    LAS float* scr = (LAS float*)(F.lds + RING_OFF + F.wave * 17408);
    const int IM = items_of(D, 2 * CW);
    for (int it = gw; it < DEPTH * IM; it += NGW) { const int l = it / IM, r = it % IM;
        transpose_item(a.in[14] + (size_t)l * D * 2 * CW, D, 2 * CW, a.in[13] + (size_t)l * D, (bf16*)(F.ws + WS_WMEM), scr, r, lane_, MapId{l * 2 * CW}); }
    prep_layer_weights_body(F, 0);
}
__device__ __noinline__ void prep_layer_weights(const float* const* in_, float* out_, unsigned char* ws_, LAS unsigned char* lds_, int l, int wave_, int vcu_, int G_) {
    const PC F{uni(in_), uni(out_), uni(ws_), uni_l(lds_), uni_i(wave_), uni_i(vcu_), uni_i(G_)}; prep_layer_weights_body(F, uni_i(l));
}

__constant__ unsigned char T5_BUCKET[128] = {0, 1, 2, 3, 4, 5, 6, 7, 8, 9, 10, 11, 12, 13, 14, 15, 16, 16, 16, 17, 17, 18, 18, 18, 19, 19, 19, 20, 20, 20, 20, 21, 21, 21, 21, 22, 22, 22, 22, 22, 23, 23, 23, 23, 23, 23, 24, 24, 24, 24, 24, 24, 25, 25, 25, 25, 25, 25, 25, 26, 26, 26, 26, 26, 26, 26, 26, 27, 27, 27, 27, 27, 27, 27, 27, 27, 27, 28, 28, 28, 28, 28, 28, 28, 28, 28, 28, 29, 29, 29, 29, 29, 29, 29, 29, 29, 29, 29, 29, 30, 30, 30, 30, 30, 30, 30, 30, 30, 30, 30, 30, 30, 30, 31, 31, 31, 31, 31, 31, 31, 31, 31, 31, 31, 31, 31, 31, 31};

typedef short bf16x8_p __attribute__((ext_vector_type(8)));
__device__ __forceinline__ void prep_tokens(const float* const* in_, float* out_, unsigned char* ws_, LAS unsigned char* lds_, int l_, int wave_, int vcu_, int G_, int dry_) {
    const int dry = uni_i(dry_);
    const PC F{uni(in_), uni(out_), uni(ws_), uni_l(lds_), uni_i(wave_), uni_i(vcu_), uni_i(G_)}; struct { const float* const* in; } a{F.in}; const int l = uni_i(l_);
    unsigned char* ws = launder_p(F.ws);
    const float* ckvraw = (const float*)(ws + WS_CKVRAW); bf16* ckv = (bf16*)(ws + WS_CKV);
    const bf16* iqraw = (const bf16*)(ws + WS_IQRAW); bf16* iqf = (bf16*)(ws + WS_IQF); const float* iw = (const float*)(ws + WS_IW); unsigned* sgn = (unsigned*)(ws + WS_SGN);
    const bf16* z = (const bf16*)(ws + WS_Z); bf16* yb = (bf16*)(ws + WS_YB); bf16* qc = (bf16*)(ws + WS_QC);
    const bf16* memkv = (const bf16*)(ws + WS_MEMKV); const bf16* vT = (const bf16*)(ws + WS_VT); const bf16* wpT = (const bf16*)(ws + WS_WPT);
    const float* kvn = a.in[8] + (size_t)l * KVR; const float* pscale = a.in[12] + (size_t)l * PW_;
    const int lane = lane_id_v(), tid = F.wave * 64 + lane;
    const int tok = lane & 15, g4 = lane >> 4;
    LAS unsigned char* Ks = F.lds;
    LAS unsigned char* Vs = F.lds + 36864;
    for (int blk = F.vcu; blk < M / 128; blk += F.G) {
        const int rowb = blk * 128, b = rowb / SEQ, row0 = rowb + F.wave * 16;
#pragma unroll 1
        for (int tt = 0; tt < 16; ++tt) { const int row = row0 + tt;
            { const f32x2 v = *(const f32x2*)(ckvraw + (size_t)row * KVR + 2 * lane); const float q = wave_sum(v.x * v.x + v.y * v.y);
              const float rs = 1.0f / sqrtf(q * (1.0f / KVR) + EPS); const f32x2 g = *(const f32x2*)(kvn + 2 * lane);
              *(unsigned*)(ckv + (size_t)row * KVR + 2 * lane) = pk2(v.x * rs * g.x, v.y * rs * g.y); }
            { const float wv = iw[(size_t)row * IH + (lane >> 3)]; const float aw = fabsf(wv) * (1.0f / 16.0f);
              const v2u q = *(const v2u*)(iqraw + (size_t)row * 256 + 4 * lane);
              v2u o; o.x = pkh2(hlo(q.x) * aw, hhi(q.x) * aw); o.y = pkh2(hlo(q.y) * aw, hhi(q.y) * aw);
              *(v2u*)(iqf + (size_t)row * 256 + 4 * lane) = o;
              const unsigned long long bal = __ballot(wv < 0.f);
              unsigned mask = 0;
#pragma unroll
              for (int h = 0; h < 8; ++h) mask |= ((unsigned)(bal >> (8 * h)) & 1u) << h;
              if (lane == 0) sgn[row] = mask; } }
        { const int row = row0 + tok, spos = row % SEQ;
#pragma unroll 1
          for (int g = 0; g < 4; ++g) { const int w = 2 << g; const int cnt = (spos + 1) < w ? (spos + 1) : w; const float rc = 1.0f / (float)cnt;
              bf16x8_p pf[2];
#pragma unroll
              for (int ks = 0; ks < 2; ++ks) { const int c0 = g * 64 + 32 * ks + 8 * g4; float sum[8], z0[8];
#pragma unroll
                  for (int e = 0; e < 8; ++e) { sum[e] = 0.f; z0[e] = 0.f; }
                  for (int j = 0; j < w; ++j) { if (j < cnt) { const v4u v = *(const v4u*)(z + (size_t)(row - j) * 256 + c0);
                      const float f[8] = {bflo(v.x), bfhi(v.x), bflo(v.y), bfhi(v.y), bflo(v.z), bfhi(v.z), bflo(v.w), bfhi(v.w)};
#pragma unroll
                      for (int e = 0; e < 8; ++e) { sum[e] += f[e]; if (j == 0) z0[e] = f[e]; } } }
                  v4u pw; pw.x = pk2(sum[0] * rc - z0[0], sum[1] * rc - z0[1]); pw.y = pk2(sum[2] * rc - z0[2], sum[3] * rc - z0[3]); pw.z = pk2(sum[4] * rc - z0[4], sum[5] * rc - z0[5]); pw.w = pk2(sum[6] * rc - z0[6], sum[7] * rc - z0[7]);
                  pf[ks] = __builtin_bit_cast(bf16x8_p, pw); }
#pragma unroll
              for (int dt = 0; dt < 4; ++dt) { f32x4 acc = {0.f, 0.f, 0.f, 0.f};
#pragma unroll
                  for (int ks = 0; ks < 2; ++ks) { const bf16x8_p af = *(const bf16x8_p*)(wpT + (size_t)(g * 64 + 16 * dt + tok) * 64 + 32 * ks + 8 * g4); acc = __builtin_amdgcn_mfma_f32_16x16x32_bf16(af, pf[ks], acc, 0, 0, 0); }
                  const f32x4 ps = *(const f32x4*)(pscale + g * 64 + 16 * dt + 4 * g4);
                  v2u o; o.x = pk2(acc[0] * ps.x, acc[1] * ps.y); o.y = pk2(acc[2] * ps.z, acc[3] * ps.w);
                  *(v2u*)(yb + (size_t)row * 256 + g * 64 + 16 * dt + 4 * g4) = o; } } }
#pragma unroll 1
        for (int h = 0; h < CH; ++h) {
            __syncthreads();
#pragma unroll
            for (int e = 0; e < 4; ++e) { const int i = tid + 512 * e;
                { const int m = i >> 3, c = i & 7; const v4u v = *(const v4u*)(memkv + (size_t)(b * NMEM + m) * 2048 + l * 512 + h * 64 + c * 8); *(LAS v4u*)(Ks + m * 144 + c * 16) = v; }
                { const int d = i >> 5, c = i & 31; const v4u v = *(const v4u*)(vT + (size_t)(l * 512 + 256 + h * 64 + d) * MROWS + b * NMEM + c * 8); *(LAS v4u*)(Vs + d * 528 + c * 16) = v; } }
            LDS_WAIT(); __syncthreads();
            const int row = row0 + tok;
            bf16x8_p qf[2];
#pragma unroll
            for (int ks = 0; ks < 2; ++ks) qf[ks] = *(const bf16x8_p*)(qc + (size_t)row * 256 + h * 64 + 32 * ks + 8 * g4);
            f32x4 S[16]; float mx = -1e30f;
#pragma unroll
            for (int mt = 0; mt < 16; ++mt) { f32x4 acc = {0.f, 0.f, 0.f, 0.f};
#pragma unroll
                for (int ks = 0; ks < 2; ++ks) { const bf16x8_p kf = *(const LAS bf16x8_p*)(Ks + (16 * mt + tok) * 144 + (4 * ks + g4) * 16); acc = __builtin_amdgcn_mfma_f32_16x16x32_bf16(kf, qf[ks], acc, 0, 0, 0); }
                S[mt] = acc; mx = fmaxf(mx, fmaxf(fmaxf(acc[0], acc[1]), fmaxf(acc[2], acc[3]))); if ((mt & 3) == 3) __builtin_amdgcn_sched_barrier(0); }
            mx = fmaxf(mx, __shfl_xor(mx, 16)); mx = fmaxf(mx, __shfl_xor(mx, 32));
            float sm = 0.f;
#pragma unroll
            for (int mt = 0; mt < 16; ++mt)
#pragma unroll
                for (int r = 0; r < 4; ++r) { const float p = __expf((S[mt][r] - mx) * 0.125f); S[mt][r] = p; sm += p; }
            sm += __shfl_xor(sm, 16); sm += __shfl_xor(sm, 32);
            const float inv = 1.0f / sm;
            f32x4 oacc[4];
#pragma unroll
            for (int dt = 0; dt < 4; ++dt) oacc[dt] = (f32x4){0.f, 0.f, 0.f, 0.f};
#pragma unroll
            for (int kk = 0; kk < 8; ++kk) { v4u pw; pw.x = pg8::cvt_pk_bf16(S[2 * kk][0], S[2 * kk][1]); pw.y = pg8::cvt_pk_bf16(S[2 * kk][2], S[2 * kk][3]); pw.z = pg8::cvt_pk_bf16(S[2 * kk + 1][0], S[2 * kk + 1][1]); pw.w = pg8::cvt_pk_bf16(S[2 * kk + 1][2], S[2 * kk + 1][3]);
                const bf16x8_p pfr = __builtin_bit_cast(bf16x8_p, pw);
#pragma unroll
                for (int dt = 0; dt < 4; ++dt) { const LAS unsigned char* vp = Vs + (16 * dt + tok) * 528 + (32 * kk + 4 * g4) * 2;
                    const v2u lo = *(const LAS v2u*)vp, hi = *(const LAS v2u*)(vp + 32);
                    v4u vw; vw.x = lo.x; vw.y = lo.y; vw.z = hi.x; vw.w = hi.y;
                    oacc[dt] = __builtin_amdgcn_mfma_f32_16x16x32_bf16(__builtin_bit_cast(bf16x8_p, vw), pfr, oacc[dt], 0, 0, 0); }
                __builtin_amdgcn_sched_barrier(0); }
#pragma unroll
            for (int dt = 0; dt < 4; ++dt) { v2u o; o.x = pk2(oacc[dt][0] * inv, oacc[dt][1] * inv); o.y = pk2(oacc[dt][2] * inv, oacc[dt][3] * inv);
                if (!dry) *(v2u*)(qc + (size_t)row * 256 + h * 64 + 16 * dt + 4 * g4) = o; else asm volatile("" :: "v"(o.x), "v"(o.y)); }
        }
    }
    __syncthreads();
}

__device__ __forceinline__ unsigned key_of(float s) { const unsigned u = __builtin_bit_cast(unsigned, s); return (u & 0x80000000u) ? ~u : (u | 0x80000000u); }

typedef short bf16x8_t __attribute__((ext_vector_type(8)));
typedef short s16x4_t __attribute__((ext_vector_type(4)));
__device__ __forceinline__ void glds16(const void* gsrc, unsigned lds_dst) { unsigned keep;
    asm volatile("s_mov_b32 %0, m0\n\ts_mov_b32 m0, %2\n\ts_nop 0\n\tglobal_load_lds_dwordx4 %1, off\n\ts_mov_b32 m0, %0" : "=&s"(keep) : "v"(gsrc), "s"(lds_dst) : "memory"); }
typedef float f32x16 __attribute__((ext_vector_type(16)));
constexpr int SEL_CAP = 256;
constexpr int HSTR = 264;
constexpr int SL_HIST = 0, SL_SEL = 0, SL_CS = 32768, SL_CI = 98304, SL_KEYS = 131072, SL_ST = 147456;

#define SEL_DECLS \
    LAS unsigned char* const lds = uni_l(lds_); const int wave = uni_i(wave_), b = uni_i(b_), ub = uni_i(ub_); unsigned char* ws = uni(ws_); \
    const bf16* iqf = (const bf16*)(ws + WS_IQF); const unsigned* sgn = (const unsigned*)(ws + WS_SGN); const bf16* ik = (const bf16*)(ws + WS_IK); \
    const int lane = lane_id_v(), tid = wave * 64 + lane; const int kl = lane & 31, c5 = lane >> 5; \
    LAS unsigned* hist = (LAS unsigned*)(lds + SL_HIST); LAS unsigned short* lsel = (LAS unsigned short*)(lds + SL_SEL); LAS float* lcs = (LAS float*)(lds + SL_CS); \
    LAS unsigned short* lci = (LAS unsigned short*)(lds + SL_CI); LAS unsigned* st = (LAS unsigned*)(lds + SL_ST); LAS float* stf = (LAS float*)(lds + SL_ST); \
    const int t0 = ub * 64; const int q0 = b * SEQ + t0; const bf16* ikb = ik + (size_t)b * SEQ * IDIM; const int ntile = (t0 + 64 + 127) >> 7; \
    (void)hist; (void)lsel; (void)lcs; (void)lci; (void)stf; (void)tid;
#define SEL_LOAD_A \
    bf16x8_t af[2][2]; float sgc[2][16]; \
    { const int i = kl, a_ = i >> 3, cc_ = (i >> 2) & 1, e_ = i & 3; const int qq_ = 2 * cc_ + (a_ >> 1), hh_ = 4 * (a_ & 1) + e_; \
      _Pragma("unroll") for (int rt = 0; rt < 2; ++rt) { const unsigned flip_ = ((sgn[q0 + 8 * wave + 4 * rt + qq_] >> hh_) & 1u) ? 0x80008000u : 0u;     \
          _Pragma("unroll") for (int ks = 0; ks < 2; ++ks) { v4u w_ = *(const v4u*)(iqf + (size_t)(q0 + 8 * wave + 4 * rt + qq_) * 256 + hh_ * 32 + 16 * ks + 8 * c5); \
              w_.x ^= flip_; w_.y ^= flip_; w_.z ^= flip_; w_.w ^= flip_; af[rt][ks] = __builtin_bit_cast(bf16x8_t, w_); } } \
      _Pragma("unroll") for (int rt = 0; rt < 2; ++rt) _Pragma("unroll") for (int u = 0; u < 2; ++u) { const unsigned m_ = sgn[q0 + 8 * wave + 4 * rt + 2 * c5 + u]; \
          _Pragma("unroll") for (int h = 0; h < 8; ++h) sgc[rt][8 * u + h] = ((m_ >> h) & 1u) ? -__builtin_inff() : __builtin_inff(); } }
#define SEL_STAGE(kt_) do { const int key_ = 16 * wave + (lane >> 2); const int ch_ = (lane & 3) ^ ((key_ >> 2) & 3); \
    glds16(ikb + (size_t)(128 * (kt_) + key_) * IDIM + ch_ * 8, (unsigned)__builtin_amdgcn_readfirstlane((int)(unsigned)(size_t)(lds + SL_KEYS + ((kt_) & 1) * 8192 + wave * 1024))); } while (0)
#define SEL_MMA(acc_, rt_, kh_) do { acc_ = (f32x16){0.f,0.f,0.f,0.f,0.f,0.f,0.f,0.f,0.f,0.f,0.f,0.f,0.f,0.f,0.f,0.f}; \
    acc_ = __builtin_amdgcn_mfma_f32_32x32x16_f16(__builtin_bit_cast(f16x8_t, af[rt_][0]), __builtin_bit_cast(f16x8_t, bfr_[kh_][0]), acc_, 0, 0, 0); \
    acc_ = __builtin_amdgcn_mfma_f32_32x32x16_f16(__builtin_bit_cast(f16x8_t, af[rt_][1]), __builtin_bit_cast(f16x8_t, bfr_[kh_][1]), acc_, 0, 0, 0); } while (0)
#define SEL_SUM(acc_, rt_, kh_) do { _Pragma("unroll") for (int u = 0; u < 2; ++u) { float s_ = 0.f; \
    _Pragma("unroll") for (int h = 0; h < 8; ++h) s_ += __builtin_amdgcn_fmed3f(acc_[8 * u + h], 0.f, sgc[rt_][8 * u + h]); \
    sc[rt_][kh_][u] = s_; } } while (0)
#define SEL_SCORES(kt_) do { const LAS unsigned char* kb_ = lds + SL_KEYS + ((kt_) & 1) * 8192; bf16x8_t bfr_[4][2]; \
    _Pragma("unroll") for (int kh = 0; kh < 4; ++kh) { const int key_ = 32 * kh + kl; \
        bfr_[kh][0] = *(const LAS bf16x8_t*)(kb_ + key_ * 64 + 16 * ((0 + c5) ^ ((key_ >> 2) & 3))); \
        bfr_[kh][1] = *(const LAS bf16x8_t*)(kb_ + key_ * 64 + 16 * ((2 + c5) ^ ((key_ >> 2) & 3))); } \
    f32x16 accA_, accB_; \
    SEL_MMA(accA_, 0, 0); \
    SEL_MMA(accB_, 1, 0); __builtin_amdgcn_sched_barrier(0); SEL_SUM(accA_, 0, 0); __builtin_amdgcn_sched_barrier(0); \
    SEL_MMA(accA_, 0, 1); __builtin_amdgcn_sched_barrier(0); SEL_SUM(accB_, 1, 0); __builtin_amdgcn_sched_barrier(0); \
    SEL_MMA(accB_, 1, 1); __builtin_amdgcn_sched_barrier(0); SEL_SUM(accA_, 0, 1); __builtin_amdgcn_sched_barrier(0); \
    SEL_MMA(accA_, 0, 2); __builtin_amdgcn_sched_barrier(0); SEL_SUM(accB_, 1, 1); __builtin_amdgcn_sched_barrier(0); \
    SEL_MMA(accB_, 1, 2); __builtin_amdgcn_sched_barrier(0); SEL_SUM(accA_, 0, 2); __builtin_amdgcn_sched_barrier(0); \
    SEL_MMA(accA_, 0, 3); __builtin_amdgcn_sched_barrier(0); SEL_SUM(accB_, 1, 2); __builtin_amdgcn_sched_barrier(0); \
    SEL_MMA(accB_, 1, 3); __builtin_amdgcn_sched_barrier(0); SEL_SUM(accA_, 0, 3); __builtin_amdgcn_sched_barrier(0); \
    SEL_SUM(accB_, 1, 3); } while (0)
#define SEL_BOUNDARY(FINAL) do { \
    const int qq = tid >> 3, part = tid & 7; const LAS v4u* hp = (const LAS v4u*)(hist + qq * HSTR + 32 * part); \
    unsigned bins[32]; \
    _Pragma("unroll") for (int i = 0; i < 8; ++i) { const v4u v = hp[i]; bins[4 * i] = v.x; bins[4 * i + 1] = v.y; bins[4 * i + 2] = v.z; bins[4 * i + 3] = v.w; } \
    unsigned ps = 0; \
    _Pragma("unroll") for (int i = 0; i < 32; ++i) ps += bins[i]; \
    unsigned v = ps, tt; \
    tt = __shfl_down(v, 1, 8); if (part + 1 < 8) v += tt; \
    tt = __shfl_down(v, 2, 8); if (part + 2 < 8) v += tt; \
    tt = __shfl_down(v, 4, 8); if (part + 4 < 8) v += tt; \
    unsigned cacc = v - ps; \
    if (cacc < (unsigned)TOPK && v >= (unsigned)TOPK) { int bsel = 0; unsigned na = 0, cb = 0; bool found = false; \
        _Pragma("unroll") for (int i = 31; i >= 0; --i) { const bool hit = !found && (cacc + bins[i] >= (unsigned)TOPK); if (hit) { bsel = i; na = cacc; cb = bins[i]; found = true; } cacc += bins[i]; } \
        st[128 + qq] = (unsigned)(32 * part + bsel); if (FINAL) { st[192 + qq] = na; st[256 + qq] = cb; st[448 + qq] = cb > (unsigned)SEL_CAP ? 1u : 0u; } } } while (0)

__device__ __forceinline__ void sel_pass1(unsigned char* ws_, LAS unsigned char* lds_, int wave_, int b_, int ub_) {
    SEL_DECLS
    unsigned short* sel = (unsigned short*)(ws + WS_SEL);
    __syncthreads();
    if (ub < 4) {
        for (int i = tid; i < 64 * TOPK; i += NWAVES * 64) { const int qq = i >> 8, sl = i & 255; sel[(size_t)(q0 + qq) * TOPK + sl] = (unsigned short)(sl <= t0 + qq ? sl : 0); }
        if (tid == 0) st[512] = 1u;
        asm volatile("s_waitcnt vmcnt(0) lgkmcnt(0)" ::: "memory"); __syncthreads();
        return;
    }
    SEL_LOAD_A
    for (int i = tid; i < 64 * HSTR; i += NWAVES * 64) hist[i] = 0u;
    if (tid < 64) { st[128 + tid] = 0u; st[448 + tid] = 0u; }
    if (tid == 0) st[512] = 0u;
    float sc[2][4][2];
    float scl[2][2]; int bcur[2][2];
#pragma unroll
    for (int rt = 0; rt < 2; ++rt)
#pragma unroll
        for (int u = 0; u < 2; ++u) { scl[rt][u] = 0.f; bcur[rt][u] = 0; }
    SEL_STAGE(0);
#pragma unroll 1
    for (int kt = 0; kt < ntile; ++kt) {
        asm volatile("s_waitcnt vmcnt(0) lgkmcnt(0)" ::: "memory"); __syncthreads();
        if (kt > 0 && (kt & 3) == 0) {
            SEL_BOUNDARY(false);
            asm volatile("s_waitcnt lgkmcnt(0)" ::: "memory"); __syncthreads();
#pragma unroll
            for (int rt = 0; rt < 2; ++rt)
#pragma unroll
                for (int u = 0; u < 2; ++u) bcur[rt][u] = (int)st[128 + 8 * wave + 4 * rt + 2 * c5 + u];
        }
        if (kt + 1 < ntile) SEL_STAGE(kt + 1);
        SEL_SCORES(kt);
        if (kt == 0) {
#pragma unroll
            for (int rt = 0; rt < 2; ++rt)
#pragma unroll
                for (int u = 0; u < 2; ++u) { float mx = 0.f;
#pragma unroll
                    for (int kh = 0; kh < 4; ++kh) mx = fmaxf(mx, fabsf(sc[rt][kh][u]));
#pragma unroll
                    for (int o = 1; o < 32; o <<= 1) mx = fmaxf(mx, __shfl_xor(mx, o));
                    const float R = mx > 0.f ? mx : 1.0f;
                    scl[rt][u] = 128.0f / R;
                    if (kl == 0) stf[8 * wave + 4 * rt + 2 * c5 + u] = scl[rt][u]; }
        }
        const bool masked = 128 * kt + 127 > t0;
#pragma unroll
        for (int rt = 0; rt < 2; ++rt)
#pragma unroll
            for (int u = 0; u < 2; ++u) { const int qq = 8 * wave + 4 * rt + 2 * c5 + u; const int lim = masked ? (t0 + qq - 128 * kt - kl) : 1000;
#pragma unroll
                for (int kh = 0; kh < 4; ++kh) { const float fb = __builtin_amdgcn_fmed3f(fmaf(sc[rt][kh][u], scl[rt][u], 128.0f), 0.f, 255.f);
                    if (fb >= (float)bcur[rt][u] && 32 * kh <= lim) (void)__hip_atomic_fetch_add(hist + qq * HSTR + (int)fb, 1u, __ATOMIC_RELAXED, __HIP_MEMORY_SCOPE_WORKGROUP); } }
    }
    asm volatile("s_waitcnt vmcnt(0) lgkmcnt(0)" ::: "memory"); __syncthreads();
    SEL_BOUNDARY(true);
    if (tid < 64) { st[320 + tid] = 0u; st[384 + tid] = 0u; }
    asm volatile("s_waitcnt lgkmcnt(0)" ::: "memory"); __syncthreads();
}
__device__ __forceinline__ void sel_pass2(unsigned char* ws_, LAS unsigned char* lds_, int wave_, int b_, int ub_) {
    SEL_DECLS
    if (st[512] != 0u) return;
    if (tid < 64) { st[320 + tid] = 0u; st[384 + tid] = 0u; }
    SEL_LOAD_A
    float sc[2][4][2];
    float scl[2][2]; int bcur[2][2];
#pragma unroll
    for (int rt = 0; rt < 2; ++rt)
#pragma unroll
        for (int u = 0; u < 2; ++u) { const int qq = 8 * wave + 4 * rt + 2 * c5 + u; scl[rt][u] = stf[qq]; bcur[rt][u] = (int)st[128 + qq]; }
    SEL_STAGE(0);
#pragma unroll 1
    for (int kt = 0; kt < ntile; ++kt) {
        asm volatile("s_waitcnt vmcnt(0) lgkmcnt(0)" ::: "memory"); __syncthreads();
        if (kt + 1 < ntile) SEL_STAGE(kt + 1);
        SEL_SCORES(kt);
        const bool masked = 128 * kt + 127 > t0;
        unsigned okm = 0u, abm = 0u; unsigned basea[2][2], basec[2][2];
#pragma unroll
        for (int rt = 0; rt < 2; ++rt)
#pragma unroll
            for (int u = 0; u < 2; ++u) { const int qq = 8 * wave + 4 * rt + 2 * c5 + u; const int lim = masked ? (t0 + qq - 128 * kt - kl) : 1000; unsigned na_ = 0u, nc_ = 0u;
#pragma unroll
                for (int kh = 0; kh < 4; ++kh) { const float fb = __builtin_amdgcn_fmed3f(fmaf(sc[rt][kh][u], scl[rt][u], 128.0f), 0.f, 255.f);
                    const bool ok = fb >= (float)bcur[rt][u] && 32 * kh <= lim; const bool ab = fb >= (float)(bcur[rt][u] + 1);
                    if (ok) { okm |= 1u << (rt * 8 + u * 4 + kh); if (ab) { abm |= 1u << (rt * 8 + u * 4 + kh); ++na_; } else ++nc_; } }
                basea[rt][u] = 0u; basec[rt][u] = 0u;
                if (na_) basea[rt][u] = __hip_atomic_fetch_add(st + 320 + qq, na_, __ATOMIC_RELAXED, __HIP_MEMORY_SCOPE_WORKGROUP);
                if (nc_) basec[rt][u] = __hip_atomic_fetch_add(st + 384 + qq, nc_, __ATOMIC_RELAXED, __HIP_MEMORY_SCOPE_WORKGROUP); }
        if (okm != 0u) {
#pragma unroll
            for (int rt = 0; rt < 2; ++rt)
#pragma unroll
                for (int u = 0; u < 2; ++u) { const int qq = 8 * wave + 4 * rt + 2 * c5 + u; unsigned sa = basea[rt][u], scn = basec[rt][u];
#pragma unroll
                    for (int kh = 0; kh < 4; ++kh) { const int bit = rt * 8 + u * 4 + kh; const int kpos = 128 * kt + 32 * kh + kl;
                        if ((okm >> bit) & 1u) {
                            if ((abm >> bit) & 1u) { if (sa < (unsigned)TOPK) lsel[qq * 256 + sa] = (unsigned short)kpos; ++sa; }
                            else { if (scn < (unsigned)SEL_CAP) { lcs[qq * SEL_CAP + scn] = sc[rt][kh][u]; lci[qq * SEL_CAP + scn] = (unsigned short)kpos; } ++scn; } } } }
        }
    }
    asm volatile("s_waitcnt vmcnt(0) lgkmcnt(0)" ::: "memory"); __syncthreads();
}
__device__ __forceinline__ void sel_resolve(unsigned char* ws_, LAS unsigned char* lds_, int wave_, int b_, int ub_, int wg_, int first_) {
    SEL_DECLS
    const int wg = uni_i(wg_), first = uni_i(first_);
    unsigned short* sel = (unsigned short*)(ws + WS_SEL);
    gu32* slowl = (gu32*)(ws + WS_CTL + 65536) + (size_t)wg * 132;
    if (first && tid == 0) __hip_atomic_store(slowl, 0u, RLX_AGENT);
    if (st[512] != 0u) return;
#pragma unroll 1
    for (int qi = 0; qi < 8; ++qi) { const int qq = 8 * wave + qi; const int q = q0 + qq;
        const int na = (int)st[192 + qq], need = TOPK - na; int C = (int)st[384 + qq]; C = C < SEL_CAP ? C : SEL_CAP;
        const bool slow = st[448 + qq] != 0u;
        if (!slow) {
            LAS unsigned* sh = (LAS unsigned*)(lds + SL_KEYS + wave * 2048); LAS float* sls = (LAS float*)(lds + SL_KEYS + wave * 2048 + 256); LAS unsigned short* sli = (LAS unsigned short*)(lds + SL_KEYS + wave * 2048 + 1280);
            const float sclq = stf[qq]; const float fbase = (float)(int)st[128 + qq];
            sh[lane] = 0u;
            float cs[SEL_CAP / 64]; int ci[SEL_CAP / 64], sb[SEL_CAP / 64];
#pragma unroll
            for (int e = 0; e < SEL_CAP / 64; ++e) { const int i = lane + 64 * e; cs[e] = 0.f; ci[e] = 0; sb[e] = -1;
                if (i < C) { cs[e] = lcs[qq * SEL_CAP + i]; ci[e] = lci[qq * SEL_CAP + i];
                    const float fr_ = (fmaf(cs[e], sclq, 128.0f) - fbase) * 64.0f; sb[e] = (int)__builtin_amdgcn_fmed3f(fr_, 0.f, 63.f); } }
            LDS_WAIT();
#pragma unroll
            for (int e = 0; e < SEL_CAP / 64; ++e) if (sb[e] >= 0) (void)__hip_atomic_fetch_add(sh + sb[e], 1u, __ATOMIC_RELAXED, __HIP_MEMORY_SCOPE_WORKGROUP);
            LDS_WAIT();
            const unsigned cl = sh[lane];
            unsigned v = cl, tt;
            tt = __shfl_down(v, 1); if (lane + 1 < 64) v += tt;
            tt = __shfl_down(v, 2); if (lane + 2 < 64) v += tt;
            tt = __shfl_down(v, 4); if (lane + 4 < 64) v += tt;
            tt = __shfl_down(v, 8); if (lane + 8 < 64) v += tt;
            tt = __shfl_down(v, 16); if (lane + 16 < 64) v += tt;
            tt = __shfl_down(v, 32); if (lane + 32 < 64) v += tt;
            const unsigned ab_ = v - cl;
            const unsigned long long cross = __ballot(ab_ < (unsigned)need && v >= (unsigned)need);
            const int sstar = cross ? (int)__builtin_ctzll(cross) : 0;
            const int na2 = (int)__shfl(ab_, sstar);
            const int need2 = need - na2;
            int base = na; int nsub = 0;
#pragma unroll
            for (int e = 0; e < SEL_CAP / 64; ++e) { const bool up = sb[e] > sstar; const bool eq = sb[e] == sstar;
                const unsigned long long bu = __ballot(up), be = __ballot(eq);
                const unsigned long long lt = (lane == 0) ? 0ull : (~0ull >> (64 - lane));
                if (up) lsel[qq * 256 + base + (int)__builtin_popcountll(bu & lt)] = (unsigned short)ci[e];
                if (eq) { const int p_ = nsub + (int)__builtin_popcountll(be & lt); sls[p_] = cs[e]; sli[p_] = (unsigned short)ci[e]; }
                base += (int)__builtin_popcountll(bu); nsub += (int)__builtin_popcountll(be); }
            LDS_WAIT();
#pragma unroll 1
            for (int i0 = 0; i0 < nsub; i0 += 64) { const int i = i0 + lane;
                if (i < nsub) { const float si = sls[i]; const int ii = sli[i]; int rank = 0;
                    for (int jx = 0; jx < nsub; ++jx) { const float sj = sls[jx]; const int ij = sli[jx]; rank += (sj > si || (sj == si && ij < ii)) ? 1 : 0; }
                    if (rank < need2) lsel[qq * 256 + na + na2 + rank] = (unsigned short)ii; } }
            LDS_WAIT();
            *(v2u*)(sel + (size_t)q * TOPK + 4 * lane) = *(const LAS v2u*)(lsel + qq * 256 + 4 * lane);
        }
    }
    __syncthreads();
    if (tid == 0) { unsigned n = first ? 0u : __hip_atomic_load(slowl, RLX_AGENT);
        for (int qq = 0; qq < 64; ++qq) if (st[448 + qq] != 0u) { if (n < 128u) { __hip_atomic_store(slowl + 1 + n, (unsigned)(q0 + qq), RLX_AGENT); ++n; } }
        __hip_atomic_store(slowl, n, RLX_AGENT); }
    asm volatile("s_waitcnt vmcnt(0)" ::: "memory");
    __syncthreads();
}
#undef SEL_DECLS
#undef SEL_LOAD_A
#undef SEL_STAGE
#undef SEL_SCORES
#undef SEL_MMA
#undef SEL_SUM
#undef SEL_BOUNDARY
__device__ __forceinline__ void dsa_select_slow(unsigned char* ws_, LAS unsigned char* lds_, int wave_, int wg_) {
    LAS unsigned char* const lds = uni_l(lds_); const int wave = uni_i(wave_), wg = uni_i(wg_);
    unsigned char* ws = uni(ws_);
    const bf16* iqf = (const bf16*)(ws + WS_IQF); const unsigned* sgn = (const unsigned*)(ws + WS_SGN); const bf16* ik = (const bf16*)(ws + WS_IK);
    unsigned short* sel = (unsigned short*)(ws + WS_SEL);
    gu32* slowl = (gu32*)(ws + WS_CTL + 65536) + (size_t)wg * 132;
    const int lane = lane_id_v(), tid = wave * 64 + lane; const int kl = lane & 31, c5 = lane >> 5;
    LAS unsigned* keys = (LAS unsigned*)lds;
    LAS unsigned* hist = (LAS unsigned*)(lds + 32768);
    LAS unsigned* ctl = (LAS unsigned*)(lds + 40960);
    const int nq = (int)__builtin_amdgcn_readfirstlane(__hip_atomic_load(slowl, RLX_AGENT));
#pragma unroll 1
    for (int k = 0; k < nq; ++k) {
        const int q = (int)__builtin_amdgcn_readfirstlane(__hip_atomic_load(slowl + 1 + k, RLX_AGENT));
        const int b = q / SEQ, t = q % SEQ, n = t + 1;
        const bf16* ikb = ik + (size_t)b * SEQ * IDIM;
        __syncthreads();
        bf16x8_t af[2]; float sgc[8];
        { const int i = kl, a_ = i >> 3, e_ = i & 3; const int hh_ = 4 * (a_ & 1) + e_; const unsigned m_ = sgn[q];
          const unsigned flip_ = ((m_ >> hh_) & 1u) ? 0x80008000u : 0u;
#pragma unroll
          for (int ks = 0; ks < 2; ++ks) { v4u w_ = *(const v4u*)(iqf + (size_t)q * 256 + hh_ * 32 + 16 * ks + 8 * c5); w_.x ^= flip_; w_.y ^= flip_; w_.z ^= flip_; w_.w ^= flip_; af[ks] = __builtin_bit_cast(bf16x8_t, w_); }
#pragma unroll
          for (int h = 0; h < 8; ++h) sgc[h] = ((m_ >> h) & 1u) ? -__builtin_inff() : __builtin_inff(); }
#pragma unroll 1
        for (int kb0 = wave; kb0 * 32 < n; kb0 += 4 * NWAVES) {
            bf16x8_t kb_[4][2];
#pragma unroll
            for (int j = 0; j < 4; ++j) { int key = 32 * (kb0 + j * NWAVES) + kl; key = key < SEQ ? key : SEQ - 1;
                kb_[j][0] = *(const bf16x8_t*)(ikb + (size_t)key * IDIM + 8 * c5); kb_[j][1] = *(const bf16x8_t*)(ikb + (size_t)key * IDIM + 16 + 8 * c5); }
#pragma unroll
            for (int j = 0; j < 4; ++j) { const int key = 32 * (kb0 + j * NWAVES) + kl;
                f32x16 acc = {0.f,0.f,0.f,0.f,0.f,0.f,0.f,0.f,0.f,0.f,0.f,0.f,0.f,0.f,0.f,0.f};
                acc = __builtin_amdgcn_mfma_f32_32x32x16_f16(__builtin_bit_cast(f16x8_t, af[0]), __builtin_bit_cast(f16x8_t, kb_[j][0]), acc, 0, 0, 0); acc = __builtin_amdgcn_mfma_f32_32x32x16_f16(__builtin_bit_cast(f16x8_t, af[1]), __builtin_bit_cast(f16x8_t, kb_[j][1]), acc, 0, 0, 0);
                float sc = 0.f;
#pragma unroll
                for (int h = 0; h < 8; ++h) sc += __builtin_amdgcn_fmed3f(acc[h], 0.f, sgc[h]);
                if (c5 == 0 && key < SEQ) keys[key] = key_of(sc); } }
        if (tid == 0) { const unsigned z_ = (unsigned)launder_v(0); ctl[0] = z_; ctl[1] = z_ + (unsigned)TOPK; ctl[2] = z_; ctl[3] = z_; }
        unsigned P = 0u, Plo = 0u;
#pragma unroll 1
        for (int lev = 0; lev < 5; ++lev) {
            for (int i = tid; i < 2048; i += NWAVES * 64) hist[i] = 0u;
            asm volatile("s_waitcnt lgkmcnt(0)" ::: "memory"); __syncthreads();
#pragma unroll 1
            for (int i = 0; i < 16; ++i) { const int s_ = tid * 16 + i;
                if (s_ < n) { const unsigned hi = keys[s_], lo = 8191u - (unsigned)s_; bool mt; unsigned dg;
                    if (lev == 0) { mt = true; dg = hi >> 21; } else if (lev == 1) { mt = (hi >> 21) == P; dg = (hi >> 10) & 0x7ffu; } else if (lev == 2) { mt = (hi >> 10) == P; dg = hi & 0x3ffu; }
                    else if (lev == 3) { mt = hi == P; dg = lo >> 6; } else { mt = hi == P && (lo >> 6) == Plo; dg = lo & 63u; }
                    if (mt) (void)__hip_atomic_fetch_add(hist + dg, 1u, __ATOMIC_RELAXED, __HIP_MEMORY_SCOPE_WORKGROUP); } }
            asm volatile("s_waitcnt lgkmcnt(0)" ::: "memory"); __syncthreads();
            const unsigned need = ctl[1];
            const v4u hb = *(const LAS v4u*)(hist + 4 * tid); const unsigned ls = hb.x + hb.y + hb.z + hb.w;
            unsigned v = ls, tt;
            tt = __shfl_down(v, 1); if (lane + 1 < 64) v += tt;
            tt = __shfl_down(v, 2); if (lane + 2 < 64) v += tt;
            tt = __shfl_down(v, 4); if (lane + 4 < 64) v += tt;
            tt = __shfl_down(v, 8); if (lane + 8 < 64) v += tt;
            tt = __shfl_down(v, 16); if (lane + 16 < 64) v += tt;
            tt = __shfl_down(v, 32); if (lane + 32 < 64) v += tt;
            if (lane == 0) ctl[8 + wave] = v;
            asm volatile("s_waitcnt lgkmcnt(0)" ::: "memory"); __syncthreads();
            unsigned above = v - ls;
            for (int w2 = wave + 1; w2 < NWAVES; ++w2) above += ctl[8 + w2];
            if (above < need && above + ls >= need) { unsigned c = above; const unsigned bb[4] = {hb.x, hb.y, hb.z, hb.w}; int bsel = 0; unsigned cab = 0; bool found = false;
#pragma unroll
                for (int i = 3; i >= 0; --i) { const bool hit = !found && (c + bb[i] >= need); if (hit) { bsel = i; cab = c; found = true; } c += bb[i]; }
                const unsigned dv = (unsigned)(4 * tid + bsel);
                if (lev == 0) ctl[0] = dv; else if (lev == 1) ctl[0] = (P << 11) | dv; else if (lev == 2) ctl[0] = (P << 10) | dv; else if (lev == 3) ctl[3] = dv; else ctl[3] = (Plo << 6) | dv;
                ctl[1] = need - cab; ctl[4] = bb[bsel]; }
            asm volatile("s_waitcnt lgkmcnt(0)" ::: "memory"); __syncthreads();
            P = ctl[0]; Plo = ctl[3];
            if (lev == 2 && ctl[1] == ctl[4]) break;
        }
        unsigned short* srow = sel + (size_t)q * TOPK;
        unsigned mymask = 0u;
#pragma unroll 1
        for (int i = 0; i < 16; ++i) { const int s_ = tid * 16 + i;
            if (s_ < n) { const unsigned hi = keys[s_], lo = 8191u - (unsigned)s_; if (hi > P || (hi == P && lo >= Plo)) mymask |= 1u << i; } }
        const unsigned mycnt = (unsigned)__builtin_popcount(mymask);
        unsigned pv_ = mycnt, tt_;
        tt_ = __shfl_up(pv_, 1); if (lane >= 1) pv_ += tt_;
        tt_ = __shfl_up(pv_, 2); if (lane >= 2) pv_ += tt_;
        tt_ = __shfl_up(pv_, 4); if (lane >= 4) pv_ += tt_;
        tt_ = __shfl_up(pv_, 8); if (lane >= 8) pv_ += tt_;
        tt_ = __shfl_up(pv_, 16); if (lane >= 16) pv_ += tt_;
        tt_ = __shfl_up(pv_, 32); if (lane >= 32) pv_ += tt_;
        if (lane == 63) ctl[16 + wave] = pv_;
        asm volatile("s_waitcnt lgkmcnt(0)" ::: "memory"); __syncthreads();
        unsigned slot0 = pv_ - mycnt;
        for (int w2 = 0; w2 < wave; ++w2) slot0 += ctl[16 + w2];
#pragma unroll 1
        for (int i = 0; i < 16; ++i) if ((mymask >> i) & 1u) { if (slot0 < (unsigned)TOPK) srow[slot0] = (unsigned short)(tid * 16 + i); ++slot0; }
    }
    asm volatile("s_waitcnt vmcnt(0) lgkmcnt(0)" ::: "memory");
    __syncthreads();
}

__device__ __forceinline__ unsigned offb(unsigned row, unsigned ch) { return 256u * row + 16u * (ch ^ (((row & 3u) << 2) | ((row >> 2) & 3u))); }
__device__ __forceinline__ s16x4_t vtr(const LAS unsigned char* p) { return __builtin_bit_cast(s16x4_t, __builtin_amdgcn_ds_read_tr16_b64_v4i16((LAS s16x4_t*)p)); }

__device__ __forceinline__ void dsa_attend(unsigned char* ws_, LAS unsigned char* lds_, const float* relb_, int wave_, int vcu_, int G_, int dry_) {
    const int dry = uni_i(dry_);
    LAS unsigned char* const lds = uni_l(lds_); const int wave = uni_i(wave_), vcu = uni_i(vcu_), G = uni_i(G_);
    unsigned char* ws = uni(ws_); const float* relb = uni(relb_);
    const bf16* ckv = (const bf16*)(ws + WS_CKV); bf16* ql = (bf16*)(ws + WS_QL); const unsigned short* sel = (const unsigned short*)(ws + WS_SEL);
    const int lane = lane_id_v(), tid = wave * 64 + lane;
    LAS unsigned char* cb = lds + wave * 16384;
    LAS unsigned short* sidx = (LAS unsigned short*)(lds + 131072 + wave * 512);
    LAS float* biasd = (LAS float*)(lds + 135168);
    for (int i = tid; i < 129 * 8; i += NWAVES * 64) { const int d = i >> 3, h = i & 7; const int bk = d < 128 ? (int)T5_BUCKET[d] : 31; biasd[i] = relb[bk * 8 + h]; }
    __syncthreads();
    const int hl = lane & 15, g = lane >> 4, hq = hl & 7;
    for (int p = vcu; p < BATCH * 64; p += G) {
        const int b = p >> 6, j = p & 63;
#pragma unroll 1
        for (int half = 0; half < 2; ++half) {
            const int ub = half == 0 ? j : 127 - j;
#pragma unroll 1
            for (int qi = 0; qi < 8; ++qi) {
                const int t = ub * 64 + wave * 8 + qi; const int q = b * SEQ + t; const int nsel = (t + 1) < TOPK ? (t + 1) : TOPK;
                const bf16* ckvb = ckv + (size_t)b * SEQ * KVR; bf16* qlrow = ql + (size_t)q * 1024;
                { const v2u w = *(const v2u*)(sel + (size_t)q * TOPK + 4 * lane); *(LAS v2u*)(sidx + 4 * lane) = w; }
                bf16x8_t qf[4];
#pragma unroll
                for (int s = 0; s < 4; ++s) qf[s] = *(const bf16x8_t*)(qlrow + hq * 128 + 32 * s + 8 * g);
                LDS_WAIT();
                float mrun = -1e30f, lsum = 0.f;
                f32x4 O[8];
#pragma unroll
                for (int c = 0; c < 8; ++c) O[c] = (f32x4){0.f, 0.f, 0.f, 0.f};
#define DSA_GATHER(c_) do { LAS unsigned char* dst_ = cb + ((c_) & 1) * 8192; \
                    _Pragma("unroll") for (int k_ = 0; k_ < 8; ++k_) { const int row_ = 4 * k_ + g; const int kidx_ = sidx[32 * (c_) + row_]; \
                        const int ch_ = hl ^ ((g << 2) | (k_ & 3)); \
                        glds16(ckvb + (size_t)kidx_ * KVR + ch_ * 8, (unsigned)__builtin_amdgcn_readfirstlane((int)(unsigned)(size_t)(dst_ + k_ * 1024))); } } while (0)
                DSA_GATHER(0);
#pragma unroll 1
                for (int c = 0; c < 8; ++c) {
                    if (c < 7) { DSA_GATHER(c + 1); asm volatile("s_waitcnt vmcnt(8)" ::: "memory"); }
                    else asm volatile("s_waitcnt vmcnt(0)" ::: "memory");
                    const LAS unsigned char* img = cb + (c & 1) * 8192;
                    f32x4 S[2];
#pragma unroll
                    for (int rb = 0; rb < 2; ++rb) { S[rb] = (f32x4){0.f, 0.f, 0.f, 0.f}; const unsigned row = 8u * (hl >> 2) + 4u * rb + (hl & 3);
#pragma unroll
                        for (int s = 0; s < 4; ++s) { const bf16x8_t af = *(const LAS bf16x8_t*)(img + offb(row, 4 * s + g)); S[rb] = __builtin_amdgcn_mfma_f32_16x16x32_bf16(af, qf[s], S[rb], 0, 0, 0); } }
                    float pv[2][4]; float mx = -1e30f;
#pragma unroll
                    for (int rb = 0; rb < 2; ++rb) { const v2u iw2 = *(const LAS v2u*)(sidx + 32 * c + 8 * g + 4 * rb);
                        const int ki[4] = {(int)(iw2.x & 0xffffu), (int)(iw2.x >> 16), (int)(iw2.y & 0xffffu), (int)(iw2.y >> 16)};
#pragma unroll
                        for (int r = 0; r < 4; ++r) { int dist = t - ki[r]; dist = dist < 0 ? 0 : (dist > 128 ? 128 : dist);
                            float lg = S[rb][r] * 0.125f + biasd[dist * 8 + hq];
                            if (32 * c + 8 * g + 4 * rb + r >= nsel) lg = -1e30f;
                            pv[rb][r] = lg; mx = fmaxf(mx, lg); } }
                    mx = fmaxf(mx, __shfl_xor(mx, 16)); mx = fmaxf(mx, __shfl_xor(mx, 32));
                    const float mnew = fmaxf(mrun, mx); const float alpha = __expf(mrun - mnew); mrun = mnew;
                    float rs = 0.f;
#pragma unroll
                    for (int rb = 0; rb < 2; ++rb)
#pragma unroll
                        for (int r = 0; r < 4; ++r) { pv[rb][r] = __expf(pv[rb][r] - mnew); rs += pv[rb][r]; }
                    rs += __shfl_xor(rs, 16); rs += __shfl_xor(rs, 32);
                    lsum = lsum * alpha + rs;
                    v4u pw; pw.x = pg8::cvt_pk_bf16(pv[0][0], pv[0][1]); pw.y = pg8::cvt_pk_bf16(pv[0][2], pv[0][3]); pw.z = pg8::cvt_pk_bf16(pv[1][0], pv[1][1]); pw.w = pg8::cvt_pk_bf16(pv[1][2], pv[1][3]);
                    const bf16x8_t pf = __builtin_bit_cast(bf16x8_t, pw);
                    float al[4];
#pragma unroll
                    for (int r = 0; r < 4; ++r) al[r] = __shfl(alpha, 4 * g + r);
#pragma unroll
                    for (int cd = 0; cd < 8; ++cd) {
                        f32x4 o = O[cd]; o[0] *= al[0]; o[1] *= al[1]; o[2] *= al[2]; o[3] *= al[3];
                        const unsigned q4 = hl >> 2, p4 = hl & 3;
                        const s16x4_t b0 = vtr(img + offb(8u * g + q4, 2 * cd + (p4 >> 1)) + 8u * (p4 & 1));
                        const s16x4_t b1 = vtr(img + offb(8u * g + 4u + q4, 2 * cd + (p4 >> 1)) + 8u * (p4 & 1));
                        bf16x8_t bf; bf[0] = b0[0]; bf[1] = b0[1]; bf[2] = b0[2]; bf[3] = b0[3]; bf[4] = b1[0]; bf[5] = b1[1]; bf[6] = b1[2]; bf[7] = b1[3];
                        O[cd] = __builtin_amdgcn_mfma_f32_16x16x32_bf16(pf, bf, o, 0, 0, 0);
                    }
                }
#undef DSA_GATHER
                const float linv = 1.0f / lsum; float li[4];
#pragma unroll
                for (int r = 0; r < 4; ++r) li[r] = __shfl(linv, 4 * g + r);
                LAS unsigned short* ost = (LAS unsigned short*)cb;
                if (g < 2) {
#pragma unroll
                    for (int cd = 0; cd < 8; ++cd)
#pragma unroll
                        for (int r = 0; r < 4; ++r) ost[(4 * g + r) * 128 + 16 * cd + hl] = (unsigned short)f2bf(O[cd][r] * li[r]);
                }
                LDS_WAIT();
                { const v4u w0 = *(const LAS v4u*)(cb + 32 * lane), w1 = *(const LAS v4u*)(cb + 32 * lane + 16);
                  if (!dry) { *(v4u*)(qlrow + 16 * lane) = w0; *(v4u*)(qlrow + 16 * lane + 8) = w1; } else asm volatile("" :: "v"(w0), "v"(w1)); }
                LDS_WAIT();
            }
        }
    }
    __syncthreads();
}

__device__ __noinline__ void final_norm(const float* const* in_, float* out_, unsigned char* ws_, LAS unsigned char* lds_, int wave_, int vcu_, int G_) {
    const PC F{uni(in_), uni(out_), uni(ws_), uni_l(lds_), uni_i(wave_), uni_i(vcu_), uni_i(G_)}; struct { const float* const* in; float* out; } a{F.in, F.out};
    const int lane_ = lane_id_v(); const int gw = F.vcu * NWAVES + F.wave, NGW = F.G * NWAVES; const float* g = a.in[22];
    f32x4 gv[4];
#pragma unroll
    for (int j = 0; j < 4; ++j) gv[j] = ((const f32x4*)g)[lane_ + 64 * j];
    for (int m = gw; m < M; m += NGW) {
        GAS f32x4* xr = (GAS f32x4*)(a.out + (size_t)m * D) + lane_;
        f32x4 v[4]; float s = 0.f;
#pragma unroll
        for (int j = 0; j < 4; ++j) { v[j] = xr[64 * j]; s += (v[j].x * v[j].x + v[j].y * v[j].y) + (v[j].z * v[j].z + v[j].w * v[j].w); }
        const float rs = 1.0f / sqrtf(wave_sum(s) * (1.0f / D) + EPS);
#pragma unroll
        for (int j = 0; j < 4; ++j) xr[64 * j] = v[j] * rs * gv[j];
    }
}

#define KIN ((const float* const*)__builtin_amdgcn_kernarg_segment_ptr())
constexpr int PH_PER_LAYER = 10, PH_LAYER0 = 2, N_PHASES = PH_LAYER0 + PH_PER_LAYER * DEPTH + 1;

__global__ void __launch_bounds__(NWAVES * 64, 2) mk_fwd(Args args) {
    extern __shared__ __attribute__((aligned(16))) unsigned char lds[];
    Frame F;
    F.lds = (LAS unsigned char*)lds;
    F.MISC = (volatile LAS unsigned*)(F.lds + MISC_OFF);
    F.wave = __builtin_amdgcn_readfirstlane((int)threadIdx.x >> 6);
    F.G = gridDim.x; { const int bx = blockIdx.x; F.vcu = (F.G % 8 == 0) ? (bx % 8) * (F.G / 8) + bx / 8 : bx; }
    F.ws = args.ws; F.ctl = (gu32*)(args.ws + WS_CTL);
    if (threadIdx.x < 64) ((LAS unsigned*)(F.lds + MISC_OFF))[threadIdx.x] = 0u;
    __syncthreads();
    const int lo = args.ph_lo, hi = args.ph_hi;
    const bool multi = (hi - lo) > 1;
    XcdBarrier bar; bar.bar = (unsigned*)(F.ctl + CW_BAR); bar.x = 0; bar.st = nullptr; bar.wave = F.wave;
    if (multi) bar = xcd_barrier_post((unsigned*)(F.ctl + CW_BAR), F.MISC + 8, F.wave);
#define IN(k) (lo <= (k) && (k) < hi)
#define SEAM(k) do { if (IN(k) && IN((k) + 1)) { xcd_barrier(bar); if (PROBE_PHASE == 99) xcd_barrier(bar); } } while (0)

    if (IN(0)) {
#if EN_P0
 for (int rep = (PROBE_PHASE == 1 ? 0 : 1); rep < 2; ++rep) p0_prologue(KIN, args.out, args.ws, F.lds, F.wave, F.vcu, F.G);
#endif
 } SEAM(0);
    if (IN(1)) {
#if !((DIS_MASK >> 7) & 1)
 unsigned char* ws = launder_p(args.ws); bf16* hb = (bf16*)(ws + WS_HB); float* ss = (float*)(ws + WS_SS); (void)hb; (void)ss;
        pg8::Gemm g{(const bf16_t*)(ws + WS_MEMN), (const bf16_t*)(ws + WS_WMEM), MROWS, DEPTH * 2 * CW, D}; pg8::StaticOrder S; S.init(MROWS, DEPTH * 2 * CW, F.G, launder_s((int)blockIdx.x));
        EpiPlainBf16 E{(bf16_t*)(ws + WS_MEMKV), DEPTH * 2 * CW};
        pg8::gemm_phase<EpiPlainBf16, pg8::StaticOrder, true, true>(F.lds + RING_OFF, g, S, E, F.wave);
        { pg8::Gemm g2{(const bf16_t*)(ws + WS_WMEM), (const bf16_t*)(ws + WS_MEMN), DEPTH * 2 * CW, MROWS, D}; pg8::StaticOrder S2; S2.init(DEPTH * 2 * CW, MROWS, F.G, launder_s((int)blockIdx.x));
          EpiPlainBf16 E2{(bf16_t*)(ws + WS_VT), MROWS};
          pg8::gemm_phase<EpiPlainBf16, pg8::StaticOrder, true, true>(F.lds + RING_OFF, g2, S2, E2, F.wave); }
#endif
    } SEAM(1);

    for (int l = 0; l < DEPTH; ++l) {
        const int pb = PH_LAYER0 + PH_PER_LAYER * l;
        const float* hbase = (l == 0) ? args.in[0] : args.out;
        if (IN(pb + 0)) {
#if EN_P0
 if (l > 0) for (int rep = (PROBE_PHASE == 1 ? 0 : 1); rep < 2; ++rep) prep_layer_weights(KIN, args.out, args.ws, F.lds, l, F.wave, F.vcu, F.G);
#endif
 } SEAM(pb + 0);
        if (IN(pb + 1)) {
#if !((DIS_MASK >> 0) & 1)
 unsigned char* ws = launder_p(args.ws); bf16* hb = (bf16*)(ws + WS_HB); float* ss = (float*)(ws + WS_SS); (void)hb; (void)ss;
            pg8::Gemm g{hb, (const bf16_t*)(ws + WS_W1IN), M, 2 * DFF, D}; pg8::StaticOrder S; S.init(M, 2 * DFF, F.G, launder_s((int)blockIdx.x));
            EpiSwiglu E{(bf16_t*)(ws + WS_ACT), ss};
            for (int rep = (PROBE_PHASE == 2 ? 0 : 1); rep < 2; ++rep) pg8::gemm_phase<EpiSwiglu, pg8::StaticOrder, true, true>(F.lds + RING_OFF, g, S, E, F.wave);
#endif
        } SEAM(pb + 1);
        if (IN(pb + 2)) {
#if !((DIS_MASK >> 1) & 1)
 unsigned char* ws = launder_p(args.ws); bf16* hb = (bf16*)(ws + WS_HB); float* ss = (float*)(ws + WS_SS); (void)hb; (void)ss;
            pg8::Gemm g{(const bf16_t*)(ws + WS_ACT), (const bf16_t*)(ws + WS_W1OUT), M, D, DFF}; pg8::StaticOrder S; S.init(M, D, F.G, launder_s((int)blockIdx.x));
            for (int rep = (PROBE_PHASE == 3 ? 0 : 1); rep < 2; ++rep) { EpiResid E{hbase, args.out, hb, ss, 0.5f, (LAS float*)(F.lds + RING_BYTES), rep == 0 ? 1 : 0};
            pg8::gemm_phase<EpiResid, pg8::StaticOrder, true, true>(F.lds + RING_OFF, g, S, E, F.wave); }
#endif
        } SEAM(pb + 2);
        if (IN(pb + 3)) {
#if !((DIS_MASK >> 2) & 1)
 unsigned char* ws = launder_p(args.ws); bf16* hb = (bf16*)(ws + WS_HB); float* ss = (float*)(ws + WS_SS); (void)hb; (void)ss;
            pg8::Gemm g{hb, (const bf16_t*)(ws + WS_WIN), M, INP, D}; pg8::StaticOrder S; S.init(M, INP, F.G, launder_s((int)blockIdx.x));
            EpiInProj E{ss, (bf16_t*)(ws + WS_QL), (float*)(ws + WS_CKVRAW), (bf16_t*)(ws + WS_IK), (float*)(ws + WS_IW), (bf16_t*)(ws + WS_IQRAW), (bf16_t*)(ws + WS_Z), (bf16_t*)(ws + WS_QC), (bf16_t*)(ws + WS_G)};
            for (int rep = (PROBE_PHASE == 4 ? 0 : 1); rep < 2; ++rep) pg8::gemm_phase<EpiInProj, pg8::StaticOrder, true, true>(F.lds + RING_OFF, g, S, E, F.wave);
#endif
        } SEAM(pb + 3);
        if (IN(pb + 4)) {
#if EN_PREP
 for (int rep = (PROBE_PHASE == 5 ? 0 : 1); rep < 2; ++rep) prep_tokens(KIN, args.out, args.ws, F.lds, l, F.wave, F.vcu, F.G, rep == 0 ? 1 : 0);
#endif
 } SEAM(pb + 4);
        if (IN(pb + 5)) {
#if EN_DSA
 for (int rep = (PROBE_PHASE == 6 ? 0 : 1); rep < 2; ++rep) for (int p = F.vcu; p < BATCH * 64; p += F.G) { for (int half = 0; half < 2; ++half) { const int b_ = p >> 6, ub_ = half == 0 ? (p & 63) : 127 - (p & 63);
   sel_pass1(args.ws, F.lds, F.wave, b_, ub_); if (PROBE_PHASE == 61) sel_pass1(args.ws, F.lds, F.wave, b_, ub_); sel_pass2(args.ws, F.lds, F.wave, b_, ub_); if (PROBE_PHASE == 62) sel_pass2(args.ws, F.lds, F.wave, b_, ub_); sel_resolve(args.ws, F.lds, F.wave, b_, ub_, (int)blockIdx.x, (p == F.vcu && half == 0) ? 1 : 0); if (PROBE_PHASE == 63) sel_resolve(args.ws, F.lds, F.wave, b_, ub_, (int)blockIdx.x, 0); } }
 dsa_select_slow(args.ws, F.lds, F.wave, (int)blockIdx.x); for (int rep = (PROBE_PHASE == 7 ? 0 : 1); rep < 2; ++rep) dsa_attend(args.ws, F.lds, args.in[2], F.wave, F.vcu, F.G, rep == 0 ? 1 : 0);
#endif
 } SEAM(pb + 5);
        if (IN(pb + 6)) {
#if !((DIS_MASK >> 3) & 1)
        for (int rep6 = (PROBE_PHASE == 8 ? 0 : 1); rep6 < 2; ++rep6) {
 unsigned char* ws = launder_p(args.ws); bf16* hb = (bf16*)(ws + WS_HB); float* ss = (float*)(ws + WS_SS); (void)hb; (void)ss;
            { pg8::Gemm g{(const bf16_t*)(ws + WS_QL), (const bf16_t*)(ws + WS_WA), M, D, 1024}; pg8::StaticOrder S; S.init(M, D, F.G, launder_s((int)blockIdx.x));
              EpiMerge<0> E{(bf16_t*)(ws + WS_MERGED), (const bf16_t*)(ws + WS_G)};
              pg8::gemm_phase<EpiMerge<0>, pg8::StaticOrder, true, true>(F.lds + RING_OFF, g, S, E, F.wave); }
            { pg8::Gemm g{(const bf16_t*)(ws + WS_YB), (const bf16_t*)(ws + WS_WB), M, D, PW_}; pg8::StaticOrder S; S.init(M, D, F.G, launder_s((int)blockIdx.x));
              EpiMerge<1> E{(bf16_t*)(ws + WS_MERGED), (const bf16_t*)(ws + WS_G)};
              pg8::gemm_phase<EpiMerge<1>, pg8::StaticOrder, true, true>(F.lds + RING_OFF, g, S, E, F.wave); }
            { pg8::Gemm g{(const bf16_t*)(ws + WS_QC), (const bf16_t*)(ws + WS_WC), M, D, CW}; pg8::StaticOrder S; S.init(M, D, F.G, launder_s((int)blockIdx.x));
              EpiMerge<2> E{(bf16_t*)(ws + WS_MERGED), (const bf16_t*)(ws + WS_G)};
              pg8::gemm_phase<EpiMerge<2>, pg8::StaticOrder, true, true>(F.lds + RING_OFF, g, S, E, F.wave); }
        }
#endif
        } SEAM(pb + 6);
        if (IN(pb + 7)) {
#if !((DIS_MASK >> 4) & 1)
 unsigned char* ws = launder_p(args.ws); bf16* hb = (bf16*)(ws + WS_HB); float* ss = (float*)(ws + WS_SS); (void)hb; (void)ss;
            pg8::Gemm g{(const bf16_t*)(ws + WS_MERGED), (const bf16_t*)(ws + WS_WOUT), M, D, D}; pg8::StaticOrder S; S.init(M, D, F.G, launder_s((int)blockIdx.x));
            for (int rep = (PROBE_PHASE == 9 ? 0 : 1); rep < 2; ++rep) { EpiResid E{args.out, args.out, hb, ss, 1.0f, (LAS float*)(F.lds + RING_BYTES), rep == 0 ? 1 : 0};
            pg8::gemm_phase<EpiResid, pg8::StaticOrder, true, true>(F.lds + RING_OFF, g, S, E, F.wave); }
#endif
        } SEAM(pb + 7);
        if (IN(pb + 8)) {
#if !((DIS_MASK >> 5) & 1)
 unsigned char* ws = launder_p(args.ws); bf16* hb = (bf16*)(ws + WS_HB); float* ss = (float*)(ws + WS_SS); (void)hb; (void)ss;
            pg8::Gemm g{hb, (const bf16_t*)(ws + WS_W2IN), M, 2 * DFF, D}; pg8::StaticOrder S; S.init(M, 2 * DFF, F.G, launder_s((int)blockIdx.x));
            EpiSwiglu E{(bf16_t*)(ws + WS_ACT), ss};
            for (int rep = (PROBE_PHASE == 2 ? 0 : 1); rep < 2; ++rep) pg8::gemm_phase<EpiSwiglu, pg8::StaticOrder, true, true>(F.lds + RING_OFF, g, S, E, F.wave);
#endif
        } SEAM(pb + 8);
        if (IN(pb + 9)) {
#if !((DIS_MASK >> 6) & 1)
 unsigned char* ws = launder_p(args.ws); bf16* hb = (bf16*)(ws + WS_HB); float* ss = (float*)(ws + WS_SS); (void)hb; (void)ss;
            pg8::Gemm g{(const bf16_t*)(ws + WS_ACT), (const bf16_t*)(ws + WS_W2OUT), M, D, DFF}; pg8::StaticOrder S; S.init(M, D, F.G, launder_s((int)blockIdx.x));
            for (int rep = (PROBE_PHASE == 3 ? 0 : 1); rep < 2; ++rep) { EpiResid E{args.out, args.out, hb, ss, 0.5f, (LAS float*)(F.lds + RING_BYTES), rep == 0 ? 1 : 0};
            pg8::gemm_phase<EpiResid, pg8::StaticOrder, true, true>(F.lds + RING_OFF, g, S, E, F.wave); }
#endif
        } SEAM(pb + 9);
    }
#if EN_P0
    if (IN(N_PHASES - 1)) { final_norm(KIN, args.out, args.ws, F.lds, F.wave, F.vcu, F.G); }
#endif
#undef IN
#undef SEAM
}

extern "C" void kernel_launch(void* const* d_in, const int* in_sizes, int n_in, void* d_out, int out_size, void* d_ws, size_t ws_size, hipStream_t stream) {
    static int grid = 0;
    if (grid == 0) {
        if (n_in != 23 || in_sizes[0] != M * D || out_size != M * D || ws_size < WS_END) { fprintf(stderr, "kernel_launch: unexpected shapes (n_in %d, ws %zu)\n", n_in, ws_size); grid = -1; return; }
        int dev = 0, cus = 0, per_cu = 0;
        if (hipGetDevice(&dev) != hipSuccess || hipDeviceGetAttribute(&cus, hipDeviceAttributeMultiprocessorCount, dev) != hipSuccess) { grid = -1; return; }
        if (hipFuncSetAttribute((const void*)mk_fwd, hipFuncAttributeMaxDynamicSharedMemorySize, LDS_BYTES) != hipSuccess) { fprintf(stderr, "kernel_launch: hipFuncSetAttribute failed\n"); grid = -1; return; }
        if (hipOccupancyMaxActiveBlocksPerMultiprocessor(&per_cu, (const void*)mk_fwd, NWAVES * 64, LDS_BYTES) != hipSuccess || per_cu < 1) { fprintf(stderr, "kernel_launch: occupancy query says %d\n", per_cu); }
        (void)hipGetLastError();
        grid = cus;
    }
    if (grid < 0) return;
    if (hipMemsetAsync((char*)d_ws + WS_CTL, 0, CTL_ZERO_BYTES, stream) != hipSuccess) return;
    Args a{};
    for (int i = 0; i < 23; ++i) a.in[i] = (const float*)d_in[i];
    a.out = (float*)d_out; a.ws = (unsigned char*)d_ws;
#if MK_ONE_LAUNCH
    a.ph_lo = 0; a.ph_hi = N_PHASES;
    hipLaunchKernelGGL(mk_fwd, dim3(grid), dim3(NWAVES * 64), LDS_BYTES, stream, a);
#endif
}
```

```cpp
#include <hip/hip_runtime.h>
#include <cstdio>
#include <cstdint>

#ifndef MK_ONE_LAUNCH
#define MK_ONE_LAUNCH 1
#endif
#ifndef PROBE_PHASE
#define PROBE_PHASE 0
#endif
#ifndef EN_P0
#define EN_P0 MK_ONE_LAUNCH
#endif
#ifndef EN_PREP
#define EN_PREP MK_ONE_LAUNCH
#endif
#ifndef EN_DSA
#define EN_DSA MK_ONE_LAUNCH
#endif
#ifndef DIS_MASK
#define DIS_MASK 0
#endif
#ifndef MK_ONE_LAUNCH
#define MK_ONE_LAUNCH 1
#endif

__device__ __forceinline__ int lane_id_v() { int l; asm volatile("v_mbcnt_lo_u32_b32 %0, -1, 0\n\tv_mbcnt_hi_u32_b32 %0, -1, %0" : "=v"(l)); return l; }
namespace pg8 {
#define PG8_LAS __attribute__((address_space(3)))
typedef unsigned short bf16_t;
typedef short bf16x8 __attribute__((ext_vector_type(8)));
typedef float f32x4 __attribute__((ext_vector_type(4)));
typedef unsigned u32x4 __attribute__((ext_vector_type(4)));
typedef unsigned u32x2 __attribute__((ext_vector_type(2)));
constexpr int BM = 256, BK = 64, HALF = 128, HTB = HALF * BK * 2, STAGE_BYTES = 8 * HTB, NXCD = 8, WGM = 8;

__host__ __device__ __forceinline__ int lds_byte(int r, int c) { const int st = (r >> 4) * 2 + (c >> 5), rr = r & 15, cc = c & 31, ob = rr * 64 + cc * 2; return st * 1024 + (ob ^ (((ob >> 9) & 1) << 5)); }
__host__ __device__ __forceinline__ void stage_rc(int b, int& R, int& C) { const int st = b / 1024, sb = b % 1024, swz = sb ^ (((sb >> 9) & 1) << 5); R = (st >> 1) * 16 + swz / 64; C = (st & 1) * 32 + (swz % 64) / 2; }
__host__ __device__ __forceinline__ int perm32(int rho) { const int n = rho >> 4, i = rho & 15; return 8 * (i >> 2) + 4 * n + (i & 3); }

struct Unit { int pm, pn; };
struct Gemm { const bf16_t* A; const bf16_t* Bt; int M, N, K; };

struct StaticOrder {
    int nM, nN, nwg, G, c;
    __host__ __device__ void init(int M, int N, int G_, int c_) { nM = M / BM; nN = N / BM; nwg = nM * nN; G = G_; c = c_; }
    __host__ __device__ bool next(int i, Unit& u) const {
        const long L = (long)i * G + c; if (L >= nwg) return false;
        int wgid = (int)L; { const int q = nwg / NXCD, r = nwg % NXCD, xcd = wgid % NXCD, off = wgid / NXCD; wgid = (xcd < r ? xcd * (q + 1) : r * (q + 1) + (xcd - r) * q) + off; }
        const int nig = WGM * nN, gid = wgid / nig, fm = gid * WGM, gsz = (nM - fm) < WGM ? (nM - fm) : WGM;
        u.pm = fm + ((wgid % nig) % gsz); u.pn = (wgid % nig) / gsz; return true;
    }
    __device__ __forceinline__ void a_ready(const Unit&) const {}
    __device__ __forceinline__ void done(const Unit&) const {}
};

__device__ __forceinline__ unsigned cvt_pk_bf16(float lo, float hi) { unsigned r; asm volatile("v_cvt_pk_bf16_f32 %0, %1, %2" : "=v"(r) : "v"(lo), "v"(hi)); return r; }

template <class Epi, class Sched, bool ALIGN_EPI = false, bool SP2 = false>
__device__ __forceinline__ void gemm_phase(PG8_LAS unsigned char* lds, const Gemm g, const Sched& S, const Epi& E, const int wid_) {
    int wid = wid_; asm volatile("" : "+s"(wid));
    const int lane = lane_id_v(), tid = wid * 64 + lane,
              wr = wid >> 2, wc = wid & 3, fr = lane & 15, fq = lane >> 4;
    const int K = g.K, nt = K / BK;
    unsigned voffA[2], voffB[2];
#pragma unroll
    for (int i = 0; i < 2; ++i) { int R, C; stage_rc(tid * 16 + i * 8192, R, C); const int Rb = Epi::PERM ? ((R & ~31) + perm32(R & 31)) : R;
        voffA[i] = (unsigned)(R * K + C) * 2u; voffB[i] = (unsigned)(Rb * K + C) * 2u; }
    const size_t kstep = (size_t)(BK * 2);
    const size_t hstep = (size_t)HALF * K * 2;
    const size_t tstep = 2 * hstep;
    const unsigned ldsw = (unsigned)wid * 1024u;
    const int aoff = lds_byte(wr * 64 + fr, fq * 8), boff = lds_byte(wc * 32 + fr, fq * 8);
#define PG8_SA(b, h) (((b) * 2 + (h)) * HTB)
#define PG8_SB(b, h) ((4 + (b) * 2 + (h)) * HTB)
#define PG8_STAGE(bufoff, gbase, voff) do { _Pragma("unroll") for (int _i = 0; _i < 2; ++_i) \
        __builtin_amdgcn_global_load_lds((const unsigned*)((const char*)(gbase) + (voff)[_i]), (PG8_LAS unsigned*)(lds + (bufoff) + ldsw + _i * 8192), 16, 0, 0); } while (0)
#define PG8_LDA(dst, b, h) do { _Pragma("unroll") for (int m = 0; m < 4; ++m) _Pragma("unroll") for (int k = 0; k < 2; ++k) dst[m][k] = *(const PG8_LAS bf16x8*)(lds + PG8_SA(b, h) + aoff + m * 2048 + k * 1024); } while (0)
#define PG8_LDB(dst, b, h) do { _Pragma("unroll") for (int n = 0; n < 2; ++n) _Pragma("unroll") for (int k = 0; k < 2; ++k) dst[n][k] = *(const PG8_LAS bf16x8*)(lds + PG8_SB(b, h) + boff + n * 2048 + k * 1024); } while (0)
#define PG8_MMA(ai, bj, At, Bt) do { __builtin_amdgcn_s_setprio(1); _Pragma("unroll") for (int m = 0; m < 4; ++m) _Pragma("unroll") for (int n = 0; n < 2; ++n) _Pragma("unroll") for (int k = 0; k < 2; ++k) \
        acc[ai][bj][m][n] = __builtin_amdgcn_mfma_f32_16x16x32_bf16(Bt[n][k], At[m][k], acc[ai][bj][m][n], 0, 0, 0); __builtin_amdgcn_s_setprio(0); } while (0)
#define PG8_WAIT_V(n) asm volatile("s_waitcnt vmcnt(" #n ")" ::: "memory")
#define PG8_WAIT_L(n) asm volatile("s_waitcnt lgkmcnt(" #n ")" ::: "memory")
#define PG8_BAR __builtin_amdgcn_s_barrier()
#define PG8_SCHED __builtin_amdgcn_sched_barrier(0)
    Unit cur, nxt; int ui = 0;
    if (!S.next(0, cur)) return;
    f32x4 acc[2][2][4][2];
#pragma unroll
    for (int a = 0; a < 2; ++a)
#pragma unroll
        for (int b = 0; b < 2; ++b)
#pragma unroll
            for (int m = 0; m < 4; ++m)
#pragma unroll
                for (int n = 0; n < 2; ++n) acc[a][b][m][n] = (f32x4){0.f, 0.f, 0.f, 0.f};
    bf16x8 At[4][2], B0[2][2], B1[2][2];
    const char* cA = (const char*)g.A + (size_t)cur.pm * tstep; const char* cB = (const char*)g.Bt + (size_t)cur.pn * tstep;
    S.a_ready(cur);
    if constexpr (SP2) {
        PG8_STAGE(PG8_SB(0, 0), cB, voffB); PG8_STAGE(PG8_SB(0, 1), cB + hstep, voffB); PG8_STAGE(PG8_SA(0, 0), cA, voffA); PG8_STAGE(PG8_SA(0, 1), cA + hstep, voffA);
        if (wr == 1) PG8_BAR;
        PG8_WAIT_V(2); PG8_BAR;
        PG8_STAGE(PG8_SB(1, 0), cB + kstep, voffB); PG8_STAGE(PG8_SA(1, 0), cA + kstep, voffA); PG8_STAGE(PG8_SB(1, 1), cB + hstep + kstep, voffB);
        PG8_WAIT_V(6); PG8_BAR;
    } else {
        PG8_STAGE(PG8_SB(0, 0), cB, voffB); PG8_STAGE(PG8_SA(0, 0), cA, voffA); PG8_STAGE(PG8_SB(0, 1), cB + hstep, voffB); PG8_STAGE(PG8_SA(0, 1), cA + hstep, voffA);
        if (wr == 1) PG8_BAR;
        PG8_WAIT_V(4); PG8_BAR;
        PG8_STAGE(PG8_SB(1, 0), cB + kstep, voffB); PG8_STAGE(PG8_SA(1, 0), cA + kstep, voffA); PG8_STAGE(PG8_SB(1, 1), cB + hstep + kstep, voffB);
        PG8_WAIT_V(6); PG8_BAR;
    }
    for (;;) {
        const bool has_next = S.next(ui + 1, nxt);
        const char* nA = has_next ? (const char*)g.A + (size_t)nxt.pm * tstep : cA; const char* nB = has_next ? (const char*)g.Bt + (size_t)nxt.pn * tstep : cB;
#pragma nounroll
        for (int t = 0; t < nt; t += 2) {
            const bool last = (t == nt - 2);
            const char* a1 = cA + (size_t)(t + 1) * kstep;
            const char* a2 = last ? nA : cA + (size_t)(t + 2) * kstep; const char* b2 = last ? nB : cB + (size_t)(t + 2) * kstep;
            const char* a3 = a2 + kstep; const char* b3 = b2 + kstep;
            if (last && has_next) S.a_ready(nxt);
            if constexpr (SP2) {
            PG8_LDB(B0, 0, 0); PG8_LDB(B1, 0, 1); PG8_SCHED; PG8_LDA(At, 0, 0); PG8_STAGE(PG8_SA(1, 1), a1 + hstep, voffA);
            PG8_WAIT_V(8); PG8_WAIT_L(0); PG8_BAR; PG8_MMA(0, 0, At, B0); PG8_MMA(0, 1, At, B1); PG8_BAR; PG8_SCHED;
            PG8_LDA(At, 0, 1); PG8_STAGE(PG8_SB(0, 0), b2, voffB); PG8_STAGE(PG8_SB(0, 1), b2 + hstep, voffB); PG8_STAGE(PG8_SA(0, 0), a2, voffA);
            PG8_WAIT_V(8); PG8_WAIT_L(0); PG8_BAR; PG8_MMA(1, 0, At, B0); PG8_MMA(1, 1, At, B1); PG8_BAR; PG8_SCHED;
            PG8_LDB(B0, 1, 0); PG8_LDB(B1, 1, 1); PG8_SCHED; PG8_LDA(At, 1, 0); PG8_STAGE(PG8_SA(0, 1), a2 + hstep, voffA);
            PG8_WAIT_V(8); PG8_WAIT_L(0); PG8_BAR; PG8_MMA(0, 0, At, B0); PG8_MMA(0, 1, At, B1); PG8_BAR; PG8_SCHED;
            PG8_LDA(At, 1, 1); PG8_STAGE(PG8_SB(1, 0), b3, voffB); PG8_STAGE(PG8_SB(1, 1), b3 + hstep, voffB); PG8_STAGE(PG8_SA(1, 0), a3, voffA);
            PG8_WAIT_V(8); PG8_WAIT_L(0); PG8_BAR; PG8_MMA(1, 0, At, B0); PG8_MMA(1, 1, At, B1); PG8_BAR; PG8_SCHED;
            } else {
            PG8_LDB(B0, 0, 0); PG8_SCHED; PG8_LDA(At, 0, 0); PG8_STAGE(PG8_SA(1, 1), a1 + hstep, voffA);
            PG8_WAIT_L(8); PG8_BAR; PG8_WAIT_L(0); PG8_MMA(0, 0, At, B0); PG8_BAR; PG8_SCHED;
            PG8_LDB(B1, 0, 1); PG8_STAGE(PG8_SB(0, 0), b2, voffB);
            PG8_BAR; PG8_WAIT_L(0); PG8_MMA(0, 1, At, B1); PG8_BAR;
            PG8_LDA(At, 0, 1); PG8_STAGE(PG8_SA(0, 0), a2, voffA);
            PG8_BAR; PG8_WAIT_L(0); PG8_MMA(1, 0, At, B0); PG8_BAR; PG8_SCHED;
            PG8_STAGE(PG8_SB(0, 1), b2 + hstep, voffB);
            PG8_WAIT_V(6); PG8_BAR; PG8_MMA(1, 1, At, B1); PG8_BAR;
            PG8_LDB(B0, 1, 0); PG8_SCHED; PG8_LDA(At, 1, 0); PG8_STAGE(PG8_SA(0, 1), a2 + hstep, voffA);
            PG8_WAIT_L(8); PG8_BAR; PG8_WAIT_L(0); PG8_MMA(0, 0, At, B0); PG8_BAR; PG8_SCHED;
            PG8_LDB(B1, 1, 1); PG8_STAGE(PG8_SB(1, 0), b3, voffB);
            PG8_BAR; PG8_WAIT_L(0); PG8_MMA(0, 1, At, B1); PG8_BAR;
            PG8_LDA(At, 1, 1); PG8_STAGE(PG8_SA(1, 0), a3, voffA);
            PG8_BAR; PG8_WAIT_L(0); PG8_MMA(1, 0, At, B0); PG8_BAR; PG8_SCHED;
            PG8_STAGE(PG8_SB(1, 1), b3 + hstep, voffB);
            PG8_WAIT_V(6); PG8_BAR; PG8_MMA(1, 1, At, B1); PG8_BAR;
            }
        }
        if constexpr (ALIGN_EPI) { if (wr == 0) PG8_BAR; }
        E(acc, cur, wr, wc, fr, fq); S.done(cur);
        if (!has_next) break;
#pragma unroll
        for (int a = 0; a < 2; ++a)
#pragma unroll
            for (int b = 0; b < 2; ++b)
#pragma unroll
                for (int m = 0; m < 4; ++m)
#pragma unroll
                    for (int n = 0; n < 2; ++n) acc[a][b][m][n] = (f32x4){0.f, 0.f, 0.f, 0.f};
        cur = nxt; cA = nA; cB = nB; ++ui;
        if constexpr (ALIGN_EPI) { if (wr == 1) PG8_BAR; }
    }
    PG8_WAIT_V(0);
    if constexpr (!ALIGN_EPI) { if (wr == 0) PG8_BAR; }
    PG8_BAR;
#undef PG8_SA
#undef PG8_SB
#undef PG8_STAGE
#undef PG8_LDA
#undef PG8_LDB
#undef PG8_MMA
#undef PG8_WAIT_V
#undef PG8_WAIT_L
#undef PG8_BAR
#undef PG8_SCHED
}
}

constexpr int NWAVES = 8;
constexpr int BATCH = 4, SEQ = 8192, D = 1024, DEPTH = 4, M = BATCH * SEQ;
constexpr int NMEM = 256, MROWS = BATCH * NMEM;
constexpr int AH = 8, AHD = 64, AW = 512, KVR = 128, IH = 8, IDIM = 32, TOPK = 256;
constexpr int PW_ = 256, CH = 4, CHD = 64, CW = 256;
constexpr int DFF = 2816, INW = 4520, INP = 5120;
constexpr float EPS = 1e-6f;
constexpr int C_QA = 0, C_CKV = 512, C_IQ = 640, C_IK = 896, C_IW = 928, C_Z = 936, C_QC = 1192, C_G = 1448;

constexpr size_t MiB = 1u << 20;
constexpr size_t WS_CTL = 0, CTL_ZERO_BYTES = 1 * MiB;
constexpr size_t WS_SS = 1 * MiB;
constexpr size_t WS_IW = 3 * MiB;
constexpr size_t WS_SGN = 4 * MiB;
constexpr size_t WS_MEMN = 5 * MiB;
constexpr size_t WS_WMEM = 7 * MiB;
constexpr size_t WS_MEMKV = 11 * MiB;
constexpr size_t WS_W1IN = 15 * MiB, WS_W1OUT = 26 * MiB, WS_WIN = 32 * MiB, WS_WA = 42 * MiB, WS_WB = 44 * MiB, WS_WC = 44 * MiB + 512 * 1024, WS_WOUT = 45 * MiB, WS_W2IN = 47 * MiB, WS_W2OUT = 58 * MiB;
constexpr size_t WS_HB = 64 * MiB;
constexpr size_t WS_ACT = 128 * MiB;
constexpr size_t WS_G = 128 * MiB;
constexpr size_t WS_QL = 320 * MiB;
constexpr size_t WS_CKV = 384 * MiB;
constexpr size_t WS_CKVRAW = 392 * MiB;
constexpr size_t WS_IQRAW = 408 * MiB;
constexpr size_t WS_IQF = 424 * MiB;
constexpr size_t WS_IK = 440 * MiB;
constexpr size_t WS_Z = 442 * MiB;
constexpr size_t WS_MERGED = 384 * MiB;
constexpr size_t WS_YB = 458 * MiB;
constexpr size_t WS_QC = 474 * MiB;
constexpr size_t WS_SEL = 490 * MiB;
constexpr size_t WS_VT = 506 * MiB;
constexpr size_t WS_WPT = 4 * MiB + 512 * 1024;
constexpr size_t WS_END = 510 * MiB;
constexpr int CW_BAR = 4096;

constexpr int RING_OFF = 0, RING_BYTES = 131072;
constexpr int LDS_BYTES = 155648;
constexpr int MISC_OFF = LDS_BYTES - 256;

#define GAS __attribute__((address_space(1)))
#define LAS __attribute__((address_space(3)))
typedef unsigned short bf16;
typedef unsigned v4u __attribute__((ext_vector_type(4)));
typedef unsigned v2u __attribute__((ext_vector_type(2)));
typedef float f32x4 __attribute__((ext_vector_type(4)));
typedef float f32x2 __attribute__((ext_vector_type(2)));
typedef GAS unsigned gu32;
#define RLX_AGENT __ATOMIC_RELAXED, __HIP_MEMORY_SCOPE_AGENT
#define LDS_WAIT() asm volatile("s_waitcnt lgkmcnt(0)" ::: "memory")
#define VM_WAIT() asm volatile("s_waitcnt vmcnt(0)" ::: "memory")
__device__ __forceinline__ unsigned f2bf(float f) { unsigned u = __builtin_bit_cast(unsigned, f); return (u + 0x7fffu + ((u >> 16) & 1u)) >> 16; }
__device__ __forceinline__ unsigned pk2(float lo, float hi) { return pg8::cvt_pk_bf16(lo, hi); }
__device__ __forceinline__ float bflo(unsigned w) { return __builtin_bit_cast(float, w << 16); }
__device__ __forceinline__ float bfhi(unsigned w) { return __builtin_bit_cast(float, w & 0xffff0000u); }
typedef _Float16 h2_t __attribute__((ext_vector_type(2)));
typedef _Float16 f16x8_t __attribute__((ext_vector_type(8)));
__device__ __forceinline__ unsigned pkh2(float lo, float hi) { const h2_t v = {(_Float16)lo, (_Float16)hi}; return __builtin_bit_cast(unsigned, v); }
__device__ __forceinline__ float hlo(unsigned w) { return (float)__builtin_bit_cast(h2_t, w)[0]; }
__device__ __forceinline__ float hhi(unsigned w) { return (float)__builtin_bit_cast(h2_t, w)[1]; }
__device__ __forceinline__ float bf2f(bf16 b) { return __builtin_bit_cast(float, ((unsigned)b) << 16); }

#define XB_TMO      128
#define XB_XCNT(j)  (256  + 64 * (j))
#define XB_XSUB(j)  (1280 + 64 * (j))
#define XB_XGEN(j)  (2304 + 64 * (j))
#define XB_TOP      3328
#define XB_TOPGEN   3392
#define XCD_BAR_WORDS 3456
#define XB_SPIN_CAP (1u << 23)

__device__ __forceinline__ unsigned xb_ld(unsigned* p)              { return __hip_atomic_load(p, __ATOMIC_RELAXED, __HIP_MEMORY_SCOPE_AGENT); }
__device__ __forceinline__ unsigned xb_add(unsigned* p, unsigned v) { return __hip_atomic_fetch_add(p, v, __ATOMIC_RELAXED, __HIP_MEMORY_SCOPE_AGENT); }
__device__ __forceinline__ unsigned xb_xcc_id() { return (unsigned)__builtin_amdgcn_s_getreg((3 << 11) | 20) & 0xFu; }
#define XB_SPIN(cond, bar) do { unsigned _sp = 0; while (cond) { __builtin_amdgcn_s_sleep(1); \
    if ((++_sp & 255u) == 0u) { if (xb_ld(&(bar)[XB_TMO])) break; if (_sp > XB_SPIN_CAP) { atomicAdd(&(bar)[XB_TMO], 1u); break; } } } } while (0)

struct XcdBarrier { unsigned* bar; unsigned x; volatile LAS unsigned* st; int wave; };

__device__ __forceinline__ XcdBarrier xcd_barrier_post(unsigned* bar, volatile LAS unsigned* st, int wave) {
    XcdBarrier b; b.bar = bar; b.x = xb_xcc_id(); b.st = st; b.wave = wave;
    if (threadIdx.x == 0) (void)xb_add(&bar[XB_XCNT(b.x)], 1u);
    return b;
}
__device__ __forceinline__ void xcd_barrier_complete(unsigned* bar, unsigned x, unsigned& nloc, unsigned& nx) {
    const unsigned G = gridDim.x * gridDim.y * gridDim.z;
    unsigned sum, cnt, mine, sp = 0u;
    for (;;) {
        sum = 0u; cnt = 0u; mine = 0u;
#pragma unroll
        for (unsigned j = 0; j < 16; ++j) { const unsigned c = xb_ld(&bar[XB_XCNT(j)]); sum += c; cnt += (c > 0u) ? 1u : 0u; mine = (j == x) ? c : mine; }
        if (sum == G) break;
        __builtin_amdgcn_s_sleep(1);
        if ((++sp & 255u) == 0u) { if (xb_ld(&bar[XB_TMO])) break; if (sp > XB_SPIN_CAP) { atomicAdd(&bar[XB_TMO], 1u); break; } }
    }
    nloc = mine > 0u ? mine : 1u; nx = cnt > 0u ? cnt : 1u;
}
__device__ __forceinline__ void xcd_barrier(const XcdBarrier& b) {
    asm volatile("s_waitcnt vmcnt(0)" ::: "memory");
    __syncthreads();
    int bw_ = b.wave; asm volatile("" : "+s"(bw_));
    if (bw_ == 0 && lane_id_v() == 0) {
        unsigned* bar = b.bar;
        __builtin_amdgcn_s_waitcnt(0);
        unsigned nloc = b.st[0], nx = b.st[1];
        if (nloc == 0u) { xcd_barrier_complete(bar, b.x, nloc, nx); b.st[0] = nloc; b.st[1] = nx; }
        const unsigned old = xb_add(&bar[XB_XSUB(b.x)], 1u);
        const unsigned gen = old / nloc;
        if (old + 1u == (gen + 1u) * nloc) {
            __builtin_amdgcn_fence(__ATOMIC_RELEASE, "agent");
            asm volatile("s_waitcnt vmcnt(0)" ::: "memory");
            const unsigned og = xb_add(&bar[XB_TOP], 1u);
            const unsigned tg = og / nx;
            if (og + 1u == (tg + 1u) * nx) xb_add(&bar[XB_TOPGEN], 1u);
            else XB_SPIN(xb_ld(&bar[XB_TOPGEN]) == tg, bar);
            __builtin_amdgcn_fence(__ATOMIC_ACQUIRE, "agent");
            xb_add(&bar[XB_XGEN(b.x)], 1u);
            asm volatile("s_waitcnt vmcnt(0)" ::: "memory");
        } else {
            XB_SPIN(xb_ld(&bar[XB_XGEN(b.x)]) == gen, bar);
            __builtin_amdgcn_fence(__ATOMIC_ACQUIRE, "agent");
            asm volatile("s_waitcnt vmcnt(0)" ::: "memory");
        }
    }
    __syncthreads();
}

struct Args {
    const float* in[23]; float* out; unsigned char* ws; int ph_lo, ph_hi;
};
template <class T> __device__ __forceinline__ T* uni(T* p) { const unsigned long long v = (unsigned long long)p; const unsigned lo = __builtin_amdgcn_readfirstlane((unsigned)v), hi = __builtin_amdgcn_readfirstlane((unsigned)(v >> 32)); return (T*)(((unsigned long long)hi << 32) | lo); }
__device__ __forceinline__ LAS unsigned char* uni_l(LAS unsigned char* p) { return (LAS unsigned char*)(unsigned)__builtin_amdgcn_readfirstlane((int)(unsigned)(size_t)p); }
__device__ __forceinline__ int uni_i(int v) { return __builtin_amdgcn_readfirstlane(v); }
struct PC { const float* const* in; float* out; unsigned char* ws; LAS unsigned char* lds; int wave, vcu, G; };
struct Frame {
    LAS unsigned char* lds;
    volatile LAS unsigned* MISC;
    gu32* ctl;
    int wave, vcu, G;
    unsigned char* ws;
};
__device__ __forceinline__ unsigned char* launder_p(unsigned char* p) { asm volatile("" : "+s"(p)); return p; }
__device__ __forceinline__ int launder_s(int v) { asm volatile("" : "+s"(v)); return v; }
__device__ __forceinline__ int launder_v(int v) { asm volatile("" : "+v"(v)); return v; }
__device__ __forceinline__ float wave_sum(float v) {
#pragma unroll
    for (int o = 1; o < 64; o <<= 1) v += __shfl_xor(v, o);
    return v;
}
__device__ __forceinline__ float wave_max(float v) {
#pragma unroll
    for (int o = 1; o < 64; o <<= 1) v = fmaxf(v, __shfl_xor(v, o));
    return v;
}

using pg8::Unit; using pg8::bf16_t;
#define LAUNDER2(a, b) asm volatile("" : "+v"(a), "+v"(b))
__device__ __forceinline__ float row_scale(const float* ss, int row) {
    const f32x4 a = *(const f32x4*)(ss + (size_t)row * 4);
    const float s = (a.x + a.y) + (a.z + a.w);
    return __builtin_amdgcn_rsqf(s * (1.0f / D) + EPS);
}
__device__ __forceinline__ float sigmoidf_(float x) { return __builtin_amdgcn_rcpf(1.0f + __expf(-x)); }
__device__ __forceinline__ pg8::u32x2 pack4(const f32x4 v) { pg8::u32x2 w; w.x = pg8::cvt_pk_bf16(v[0], v[1]); w.y = pg8::cvt_pk_bf16(v[2], v[3]); return w; }

struct EpiSwiglu {
    static constexpr bool PERM = true;
    bf16_t* O; const float* ss;
    __device__ __forceinline__ void operator()(const f32x4 (&acc)[2][2][4][2], const Unit& u, int wr, int wc, int fr_, int fq_) const {
        const int l_ = lane_id_v(); const int fr = l_ & 15, fq = l_ >> 4; (void)fr_; (void)fq_;
        int rb = wr * 64 + fr, cb = wc * 32 + 8 * fq; LAUNDER2(rb, cb);
        const int row0 = u.pm * 256 + rb, col0 = u.pn * 128 + cb;
#pragma unroll
        for (int ai = 0; ai < 2; ++ai)
#pragma unroll
            for (int m = 0; m < 4; ++m) { const int row = row0 + ai * 128 + m * 16; const float s = row_scale(ss, row);
                pg8::u32x4 w;
                { const f32x4 a = acc[ai][0][m][0] * s, b = acc[ai][1][m][0] * s; f32x4 o;
#pragma unroll
                  for (int i = 0; i < 4; ++i) o[i] = a[i] * sigmoidf_(a[i]) * b[i];
                  w.x = pg8::cvt_pk_bf16(o[0], o[1]); w.y = pg8::cvt_pk_bf16(o[2], o[3]); }
                { const f32x4 a = acc[ai][0][m][1] * s, b = acc[ai][1][m][1] * s; f32x4 o;
#pragma unroll
                  for (int i = 0; i < 4; ++i) o[i] = a[i] * sigmoidf_(a[i]) * b[i];
                  w.z = pg8::cvt_pk_bf16(o[0], o[1]); w.w = pg8::cvt_pk_bf16(o[2], o[3]); }
                *(pg8::u32x4*)(O + (size_t)row * DFF + col0) = w; }
    }
};
struct EpiResid {
    static constexpr bool PERM = true;
    const float* base; float* out; bf16_t* hb; float* ss; float alpha; LAS float* P; int dry;
    __device__ __forceinline__ void operator()(const f32x4 (&acc)[2][2][4][2], const Unit& u, int wr, int wc, int fr_, int fq_) const {
        const int l_ = lane_id_v(); const int fr = l_ & 15, fq = l_ >> 4; (void)fr_; (void)fq_;
        int rb = wr * 64 + fr, cb = wc * 32 + 8 * fq; LAUNDER2(rb, cb);
        const int row0 = u.pm * 256 + rb, col0 = u.pn * 256 + cb;
#pragma unroll
        for (int ai = 0; ai < 2; ++ai)
#pragma unroll
          for (int mh = 0; mh < 2; ++mh) {
            f32x4 bs[2][2][2];
#pragma unroll
            for (int mm = 0; mm < 2; ++mm) { const size_t off = (size_t)(row0 + ai * 128 + (2 * mh + mm) * 16) * D + col0;
#pragma unroll
                for (int bj = 0; bj < 2; ++bj)
#pragma unroll
                    for (int n = 0; n < 2; ++n) bs[mm][bj][n] = *(const f32x4*)(base + off + bj * 128 + n * 4); }
#pragma unroll
            for (int mm = 0; mm < 2; ++mm) { const int m = 2 * mh + mm; const int row = row0 + ai * 128 + m * 16; const size_t off = (size_t)row * D + col0; float q = 0.f;
#pragma unroll
                for (int bj = 0; bj < 2; ++bj) { const f32x4 v0 = bs[mm][bj][0] + acc[ai][bj][m][0] * alpha, v1 = bs[mm][bj][1] + acc[ai][bj][m][1] * alpha;
                    if (!dry) { *(f32x4*)(out + off + bj * 128) = v0; *(f32x4*)(out + off + bj * 128 + 4) = v1;
                        pg8::u32x4 w; w.x = pg8::cvt_pk_bf16(v0[0], v0[1]); w.y = pg8::cvt_pk_bf16(v0[2], v0[3]); w.z = pg8::cvt_pk_bf16(v1[0], v1[1]); w.w = pg8::cvt_pk_bf16(v1[2], v1[3]);
                        *(pg8::u32x4*)(hb + off + bj * 128) = w; }
                    q += ((v0[0] * v0[0] + v0[1] * v0[1]) + (v0[2] * v0[2] + v0[3] * v0[3])) + ((v1[0] * v1[0] + v1[1] * v1[1]) + (v1[2] * v1[2] + v1[3] * v1[3])); }
                q += __shfl_xor(q, 16); q += __shfl_xor(q, 32);
                if (fq == 0) P[(rb + ai * 128 + m * 16) * 4 + wc] = q; }
            asm volatile("" ::: "memory"); }
        asm volatile("s_waitcnt lgkmcnt(0)" ::: "memory"); __builtin_amdgcn_s_barrier(); asm volatile("" ::: "memory");
        const int tid = (wr * 4 + wc) * 64 + fq * 16 + fr;
        if (tid < 256 && !dry) { const f32x4 p = *(const LAS f32x4*)(P + tid * 4); ss[(size_t)(u.pm * 256 + tid) * 4 + u.pn] = (p.x + p.y) + (p.z + p.w); }
    }
};
struct EpiPlainBf16 {
    static constexpr bool PERM = false;
    bf16_t* O; int ldo;
    __device__ __forceinline__ void operator()(const f32x4 (&acc)[2][2][4][2], const Unit& u, int wr, int wc, int fr_, int fq_) const {
        const int l_ = lane_id_v(); const int fr = l_ & 15, fq = l_ >> 4; (void)fr_; (void)fq_;
        int rb = wr * 64 + fr, cb = wc * 32 + 4 * fq; LAUNDER2(rb, cb);
        const int row0 = u.pm * 256 + rb, col0 = u.pn * 256 + cb;
#pragma unroll
        for (int ai = 0; ai < 2; ++ai)
#pragma unroll
            for (int m = 0; m < 4; ++m) { bf16_t* rowp = O + (size_t)(row0 + ai * 128 + m * 16) * ldo + col0;
#pragma unroll
                for (int bj = 0; bj < 2; ++bj)
#pragma unroll
                    for (int n = 0; n < 2; ++n) *(pg8::u32x2*)(rowp + bj * 128 + n * 16) = pack4(acc[ai][bj][m][n]); }
    }
};
struct EpiInProj {
    static constexpr bool PERM = true;
    const float* ss; bf16_t* qa; float* ckvraw; bf16_t* ik; float* iw; bf16_t* iqraw; bf16_t* z; bf16_t* qc; bf16_t* G;
    __device__ __forceinline__ void operator()(const f32x4 (&acc)[2][2][4][2], const Unit& u, int wr, int wc, int fr_, int fq_) const {
        const int l_ = lane_id_v(); const int fr = l_ & 15, fq = l_ >> 4; (void)fr_; (void)fq_;
        int rb = wr * 64 + fr, ct = wc * 32 + 8 * fq; LAUNDER2(rb, ct);
        const int row0 = u.pm * 256 + rb; const int pn = u.pn;
        if (pn == 4) {
#pragma unroll
            for (int ai = 0; ai < 2; ++ai)
#pragma unroll
                for (int m = 0; m < 4; ++m) { const int row = row0 + ai * 128 + m * 16; const float s = row_scale(ss, row);
#pragma unroll
                    for (int n = 0; n < 2; ++n) *(f32x4*)(ckvraw + (size_t)row * KVR + ct + n * 4) = acc[ai][0][m][n] * s;
                    if (wc == 0) { const f32x4 k0 = acc[ai][1][m][0] * s, k1 = acc[ai][1][m][1] * s; pg8::u32x4 w; w.x = pkh2(k0[0], k0[1]); w.y = pkh2(k0[2], k0[3]); w.z = pkh2(k1[0], k1[1]); w.w = pkh2(k1[2], k1[3]);
                        *(pg8::u32x4*)(ik + (size_t)row * IDIM + 8 * fq) = w; }
                    if (wc == 1 && fq == 0) { *(f32x4*)(iw + (size_t)row * IH) = acc[ai][1][m][0] * s; *(f32x4*)(iw + (size_t)row * IH + 4) = acc[ai][1][m][1] * s; } }
        } else {
            bf16_t* dst0; int ld; bool sig = false; const bool f16out = (pn == 5);
            if (pn < 4) { dst0 = qa + pn * 256; ld = 1024; } else if (pn == 5) { dst0 = iqraw; ld = 256; } else if (pn == 6) { dst0 = z; ld = 256; } else if (pn == 7) { dst0 = qc; ld = 256; } else { dst0 = G + (pn - 8) * 256; ld = 3072; sig = true; }
#pragma unroll
            for (int ai = 0; ai < 2; ++ai)
#pragma unroll
                for (int m = 0; m < 4; ++m) { const int row = row0 + ai * 128 + m * 16; const float s = row_scale(ss, row); bf16_t* rowp = dst0 + (size_t)row * ld + ct;
#pragma unroll
                    for (int bj = 0; bj < 2; ++bj) { f32x4 o0 = acc[ai][bj][m][0] * s, o1 = acc[ai][bj][m][1] * s;
                        if (sig) {
#pragma unroll
                            for (int i = 0; i < 4; ++i) { o0[i] = sigmoidf_(o0[i]); o1[i] = sigmoidf_(o1[i]); } }
                        pg8::u32x4 wo;
                        if (f16out) { wo.x = pkh2(o0[0], o0[1]); wo.y = pkh2(o0[2], o0[3]); wo.z = pkh2(o1[0], o1[1]); wo.w = pkh2(o1[2], o1[3]); }
                        else { wo.x = pg8::cvt_pk_bf16(o0[0], o0[1]); wo.y = pg8::cvt_pk_bf16(o0[2], o0[3]); wo.z = pg8::cvt_pk_bf16(o1[0], o1[1]); wo.w = pg8::cvt_pk_bf16(o1[2], o1[3]); }
                        *(pg8::u32x4*)(rowp + bj * 128) = wo; } }
        }
    }
};
template <int MODE> struct EpiMerge {
    static constexpr bool PERM = true;
    bf16_t* Mg; const bf16_t* G;
    __device__ __forceinline__ void operator()(const f32x4 (&acc)[2][2][4][2], const Unit& u, int wr, int wc, int fr_, int fq_) const {
        const int l_ = lane_id_v(); const int fr = l_ & 15, fq = l_ >> 4; (void)fr_; (void)fq_;
        int rb = wr * 64 + fr, cb = wc * 32 + 8 * fq; LAUNDER2(rb, cb);
        const int row0 = u.pm * 256 + rb, col0 = u.pn * 256 + cb;
#pragma unroll
        for (int ai = 0; ai < 2; ++ai)
#pragma unroll
          for (int mh = 0; mh < 1; ++mh) {
            pg8::u32x4 gw[4][2], pw[4][2];
#pragma unroll
            for (int mm = 0; mm < 4; ++mm) { const int row = row0 + ai * 128 + mm * 16;
#pragma unroll
                for (int bj = 0; bj < 2; ++bj) { gw[mm][bj] = *(const pg8::u32x4*)(G + (size_t)row * 3072 + MODE * 1024 + col0 + bj * 128);
                    if (MODE > 0) pw[mm][bj] = *(const pg8::u32x4*)(Mg + (size_t)row * D + col0 + bj * 128); } }
#pragma unroll
            for (int mm = 0; mm < 4; ++mm) { const int m = mm; const int row = row0 + ai * 128 + m * 16;
#pragma unroll
                for (int bj = 0; bj < 2; ++bj) { const pg8::u32x4 g4 = gw[mm][bj];
                    f32x4 o0 = acc[ai][bj][m][0], o1 = acc[ai][bj][m][1];
                    o0[0] *= bflo(g4.x); o0[1] *= bfhi(g4.x); o0[2] *= bflo(g4.y); o0[3] *= bfhi(g4.y); o1[0] *= bflo(g4.z); o1[1] *= bfhi(g4.z); o1[2] *= bflo(g4.w); o1[3] *= bfhi(g4.w);
                    if (MODE > 0) { const pg8::u32x4 p4 = pw[mm][bj];
                        o0[0] += bflo(p4.x); o0[1] += bfhi(p4.x); o0[2] += bflo(p4.y); o0[3] += bfhi(p4.y); o1[0] += bflo(p4.z); o1[1] += bfhi(p4.z); o1[2] += bflo(p4.w); o1[3] += bfhi(p4.w); }
                    pg8::u32x4 w; w.x = pg8::cvt_pk_bf16(o0[0], o0[1]); w.y = pg8::cvt_pk_bf16(o0[2], o0[3]); w.z = pg8::cvt_pk_bf16(o1[0], o1[1]); w.w = pg8::cvt_pk_bf16(o1[2], o1[3]);
                    *(pg8::u32x4*)(Mg + (size_t)row * D + col0 + bj * 128) = w; } }
            asm volatile("" ::: "memory"); }
    }
};

template <class Map>
__device__ __forceinline__ void transpose_item(const float* W, int K, int N, const float* gain, bf16* WT, LAS float* scr, int item, int lane, Map map) {
    const int nblk = (N + 63) / 64, kb = item / nblk, nb = item % nblk, k0 = 64 * kb, n0 = 64 * nb;
    const int nn = n0 + 4 * (lane & 15); const bool nok = nn < N;
#pragma unroll 4
    for (int i = 0; i < 16; ++i) { const int kk = 4 * i + (lane >> 4); f32x4 v = nok ? *(const f32x4*)(W + (size_t)(k0 + kk) * N + nn) : (f32x4){0.f, 0.f, 0.f, 0.f};
        if (gain) v = v * gain[k0 + kk];
        *(LAS f32x4*)(scr + kk * 68 + 4 * (lane & 15)) = v; }
    LDS_WAIT(); asm volatile("" ::: "memory");
    const int c = lane & 7;
#pragma unroll
    for (int j = 0; j < 8; ++j) { const int n = (lane >> 3) + 8 * j; const LAS float* sp = scr + (8 * c) * 68 + n;
        v4u o; o.x = pk2(sp[0 * 68], sp[1 * 68]); o.y = pk2(sp[2 * 68], sp[3 * 68]); o.z = pk2(sp[4 * 68], sp[5 * 68]); o.w = pk2(sp[6 * 68], sp[7 * 68]);
        if (n0 + n < N) { const int dr = map(n0 + n); if (dr >= 0) *(GAS v4u*)(WT + (size_t)dr * K + k0 + 8 * c) = o; } }
    LDS_WAIT(); asm volatile("" ::: "memory");
}
struct MapId { int off; __device__ __forceinline__ int operator()(int n) const { return off + n; } };
struct MapSwiglu { __device__ __forceinline__ int operator()(int c) const { const int half = c >= DFF ? 1 : 0, j = c - half * DFF; return 256 * (j >> 7) + 128 * half + (j & 127); } };
struct MapInProj { __device__ __forceinline__ int operator()(int c) const {
    if (c < C_CKV) return -1;
    if (c < C_IQ) return 1024 + (c - C_CKV);
    if (c < C_IK) return 1280 + (c - C_IQ);
    if (c < C_IW) return 1152 + (c - C_IK);
    if (c < C_Z) return 1184 + (c - C_IW);
    if (c < C_QC) return 1536 + (c - C_Z);
    if (c < C_G) return 1792 + (c - C_QC);
    return 2048 + (c - C_G); } };
__device__ __forceinline__ void qlat_item(const float* win, const float* mixn, const float* wuk, bf16* WT, int item, int lane) {
    const int kc = item & 127, rh = (item >> 7) & 1, h = item >> 8; const int r = rh * 64 + lane;
    const f32x4* wp = (const f32x4*)(wuk + (size_t)r * (AH * AHD) + h * 64);
    float acc[8] = {0.f, 0.f, 0.f, 0.f, 0.f, 0.f, 0.f, 0.f};
#pragma unroll 1
    for (int dc = 0; dc < 4; ++dc) {
        const f32x4 w0 = wp[4 * dc], w1 = wp[4 * dc + 1], w2 = wp[4 * dc + 2], w3 = wp[4 * dc + 3];
#pragma unroll
        for (int kk = 0; kk < 8; ++kk) { const f32x4* ip = (const f32x4*)(win + (size_t)(kc * 8 + kk) * INW + h * 64 + 16 * dc);
            const f32x4 a0 = ip[0], a1 = ip[1], a2 = ip[2], a3 = ip[3];
            acc[kk] += (a0.x * w0.x + a0.y * w0.y + a0.z * w0.z + a0.w * w0.w) + (a1.x * w1.x + a1.y * w1.y + a1.z * w1.z + a1.w * w1.w)
                     + (a2.x * w2.x + a2.y * w2.y + a2.z * w2.z + a2.w * w2.w) + (a3.x * w3.x + a3.y * w3.y + a3.z * w3.z + a3.w * w3.w);
            if (kk & 1) asm volatile("" ::: "memory"); }
    }
    const f32x4 g0 = *(const f32x4*)(mixn + kc * 8), g1 = *(const f32x4*)(mixn + kc * 8 + 4);
    v4u w; w.x = pk2(acc[0] * g0.x, acc[1] * g0.y); w.y = pk2(acc[2] * g0.z, acc[3] * g0.w); w.z = pk2(acc[4] * g1.x, acc[5] * g1.y); w.w = pk2(acc[6] * g1.z, acc[7] * g1.w);
    *(GAS v4u*)(WT + (size_t)(h * 128 + r) * D + kc * 8) = w;
}
__device__ __forceinline__ void wafold_item(const float* wuv, const float* wba, bf16* WT, int item, int lane) {
    const int ng = item & 15, rg = (item >> 4) & 15, h = item >> 8; const int n = ng * 64 + lane, r0 = rg * 8;
    float acc[8] = {0.f, 0.f, 0.f, 0.f, 0.f, 0.f, 0.f, 0.f};
#pragma unroll 4
    for (int d = 0; d < 64; ++d) { const float wa = wba[(size_t)(h * 64 + d) * D + n];
#pragma unroll
        for (int j = 0; j < 8; ++j) acc[j] += wuv[(size_t)(r0 + j) * (AH * AHD) + h * 64 + d] * wa; }
    v4u w; w.x = pk2(acc[0], acc[1]); w.y = pk2(acc[2], acc[3]); w.z = pk2(acc[4], acc[5]); w.w = pk2(acc[6], acc[7]);
    *(GAS v4u*)(WT + (size_t)n * 1024 + h * 128 + r0) = w;
}
__device__ __forceinline__ int items_of(int K, int N) { return (K / 64) * ((N + 63) / 64); }

__device__ __forceinline__ void prep_layer_weights_body(const PC& F, int l) {
    struct { const float* const* in; } a{F.in};
    const int lane_ = lane_id_v();
    LAS float* scr = (LAS float*)(F.lds + RING_OFF + F.wave * 17408);
    const int gw = F.vcu * NWAVES + F.wave, NGW = F.G * NWAVES;
    const float* f1n = a.in[3] + (size_t)l * D; const float* f1in = a.in[4] + (size_t)l * D * 2 * DFF; const float* f1out = a.in[5] + (size_t)l * DFF * D;
    const float* mixn = a.in[6] + (size_t)l * D; const float* win = a.in[7] + (size_t)l * D * INW;
    const float* wba = a.in[15] + (size_t)l * AW * D; const float* wbb = a.in[16] + (size_t)l * PW_ * D; const float* wbc = a.in[17] + (size_t)l * CW * D;
    const float* wout = a.in[18] + (size_t)l * D * D;
    const float* f2n = a.in[19] + (size_t)l * D; const float* f2in = a.in[20] + (size_t)l * D * 2 * DFF; const float* f2out = a.in[21] + (size_t)l * DFF * D;
    unsigned char* ws = launder_p(F.ws);
    const float* wuk = a.in[9] + (size_t)l * KVR * AH * AHD; const float* wuv = a.in[10] + (size_t)l * KVR * AH * AHD;
    const int I0 = items_of(D, 2 * DFF), I1 = items_of(DFF, D), I2 = items_of(D, INW), I4 = items_of(PW_, D), I5 = items_of(CW, D), I6 = items_of(D, D);
    const int NIT = 2 * I0 + 2 * I1 + I2 + I4 + I5 + I6;
#pragma unroll 1
    for (int it = gw; it < NIT; it += NGW) {
        int r = it;
        if (r < I0) { transpose_item(f1in, D, 2 * DFF, f1n, (bf16*)(ws + WS_W1IN), scr, r, lane_, MapSwiglu{}); continue; } r -= I0;
        if (r < I0) { transpose_item(f2in, D, 2 * DFF, f2n, (bf16*)(ws + WS_W2IN), scr, r, lane_, MapSwiglu{}); continue; } r -= I0;
        if (r < I1) { transpose_item(f1out, DFF, D, nullptr, (bf16*)(ws + WS_W1OUT), scr, r, lane_, MapId{0}); continue; } r -= I1;
        if (r < I1) { transpose_item(f2out, DFF, D, nullptr, (bf16*)(ws + WS_W2OUT), scr, r, lane_, MapId{0}); continue; } r -= I1;
        if (r < I2) { transpose_item(win, D, INW, mixn, (bf16*)(ws + WS_WIN), scr, r, lane_, MapInProj{}); continue; } r -= I2;
        if (r < I4) { transpose_item(wbb, PW_, D, nullptr, (bf16*)(ws + WS_WB), scr, r, lane_, MapId{0}); continue; } r -= I4;
        if (r < I5) { transpose_item(wbc, CW, D, nullptr, (bf16*)(ws + WS_WC), scr, r, lane_, MapId{0}); continue; } r -= I5;
        transpose_item(wout, D, D, nullptr, (bf16*)(ws + WS_WOUT), scr, r, lane_, MapId{0});
    }
    { const float* wpool = a.in[11] + (size_t)l * 4 * 64 * 64; bf16* wpT = (bf16*)(ws + WS_WPT);
      for (int i = gw * 64 + lane_; i < 4 * 64 * 64; i += NGW * 64) { const int c = i & 63, d = (i >> 6) & 63, g = i >> 12; wpT[i] = (bf16)f2bf(wpool[(g * 64 + c) * 64 + d]); } }
    asm volatile("" ::: "memory");
#pragma unroll 1
    for (int it = gw; it < 2048; it += NGW) wafold_item(wuv, wba, (bf16*)(ws + WS_WA), it, lane_);
    asm volatile("" ::: "memory");
#pragma unroll 1
    for (int it = gw; it < 2048; it += NGW) qlat_item(win, mixn, wuk, (bf16*)(ws + WS_WIN), it, lane_);
}

__device__ __noinline__ void p0_prologue(const float* const* in_, float* out_, unsigned char* ws_, LAS unsigned char* lds_, int wave_, int vcu_, int G_) {
    const PC F{uni(in_), uni(out_), uni(ws_), uni_l(lds_), uni_i(wave_), uni_i(vcu_), uni_i(G_)}; struct { const float* const* in; } a{F.in};
    const int lane_ = lane_id_v();
    const int gw = F.vcu * NWAVES + F.wave, NGW = F.G * NWAVES;
    const float* x = a.in[0]; const float* mem = a.in[1];
    bf16* hb = (bf16*)(F.ws + WS_HB); float* ss = (float*)(F.ws + WS_SS); bf16* memn = (bf16*)(F.ws + WS_MEMN);
    for (int m = gw; m < M + MROWS; m += NGW) {
        const bool ismem = m >= M; const int r = ismem ? m - M : m;
        const GAS f32x4* xr = (const GAS f32x4*)((ismem ? mem : x) + (size_t)r * D) + lane_;
        f32x4 v[4]; float s = 0.f;
#pragma unroll
        for (int j = 0; j < 4; ++j) { v[j] = xr[64 * j]; s += (v[j].x * v[j].x + v[j].y * v[j].y) + (v[j].z * v[j].z + v[j].w * v[j].w); }
        s = wave_sum(s);
        float sc = 1.f;
        if (ismem) sc = 1.0f / sqrtf(s * (1.0f / D) + EPS);
        else if (lane_ < 4) ss[(size_t)r * 4 + lane_] = lane_ == 0 ? s : 0.f;
        GAS unsigned long long* o8 = (GAS unsigned long long*)((ismem ? memn : hb) + (size_t)r * D) + lane_;
#pragma unroll
        for (int j = 0; j < 4; ++j) o8[64 * j] = (unsigned long long)pk2(v[j].x * sc, v[j].y * sc) | ((unsigned long long)pk2(v[j].z * sc, v[j].w * sc) << 32);
    }
    LAS float* scr = (LAS float*)(F.lds + RING_OFF + F.wave * 17408);
    const int IM = items_of(D, 2 * CW);
    for (int it = gw; it < DEPTH * IM; it += NGW) { const int l = it / IM, r = it % IM;
        transpose_item(a.in[14] + (size_t)l * D * 2 * CW, D, 2 * CW, a.in[13] + (size_t)l * D, (bf16*)(F.ws + WS_WMEM), scr, r, lane_, MapId{l * 2 * CW}); }
    prep_layer_weights_body(F, 0);
}
__device__ __noinline__ void prep_layer_weights(const float* const* in_, float* out_, unsigned char* ws_, LAS unsigned char* lds_, int l, int wave_, int vcu_, int G_) {
    const PC F{uni(in_), uni(out_), uni(ws_), uni_l(lds_), uni_i(wave_), uni_i(vcu_), uni_i(G_)}; prep_layer_weights_body(F, uni_i(l));
}

__constant__ unsigned char T5_BUCKET[128] = {0, 1, 2, 3, 4, 5, 6, 7, 8, 9, 10, 11, 12, 13, 14, 15, 16, 16, 16, 17, 17, 18, 18, 18, 19, 19, 19, 20, 20, 20, 20, 21, 21, 21, 21, 22, 22, 22, 22, 22, 23, 23, 23, 23, 23, 23, 24, 24, 24, 24, 24, 24, 25, 25, 25, 25, 25, 25, 25, 26, 26, 26, 26, 26, 26, 26, 26, 27, 27, 27, 27, 27, 27, 27, 27, 27, 27, 28, 28, 28, 28, 28, 28, 28, 28, 28, 28, 29, 29, 29, 29, 29, 29, 29, 29, 29, 29, 29, 29, 30, 30, 30, 30, 30, 30, 30, 30, 30, 30, 30, 30, 30, 30, 31, 31, 31, 31, 31, 31, 31, 31, 31, 31, 31, 31, 31, 31, 31};

typedef short bf16x8_p __attribute__((ext_vector_type(8)));
__device__ __forceinline__ void prep_tokens(const float* const* in_, float* out_, unsigned char* ws_, LAS unsigned char* lds_, int l_, int wave_, int vcu_, int G_, int dry_) {
    const int dry = uni_i(dry_);
    const PC F{uni(in_), uni(out_), uni(ws_), uni_l(lds_), uni_i(wave_), uni_i(vcu_), uni_i(G_)}; struct { const float* const* in; } a{F.in}; const int l = uni_i(l_);
    unsigned char* ws = launder_p(F.ws);
    const float* ckvraw = (const float*)(ws + WS_CKVRAW); bf16* ckv = (bf16*)(ws + WS_CKV);
    const bf16* iqraw = (const bf16*)(ws + WS_IQRAW); bf16* iqf = (bf16*)(ws + WS_IQF); const float* iw = (const float*)(ws + WS_IW); unsigned* sgn = (unsigned*)(ws + WS_SGN);
    const bf16* z = (const bf16*)(ws + WS_Z); bf16* yb = (bf16*)(ws + WS_YB); bf16* qc = (bf16*)(ws + WS_QC);
    const bf16* memkv = (const bf16*)(ws + WS_MEMKV); const bf16* vT = (const bf16*)(ws + WS_VT); const bf16* wpT = (const bf16*)(ws + WS_WPT);
    const float* kvn = a.in[8] + (size_t)l * KVR; const float* pscale = a.in[12] + (size_t)l * PW_;
    const int lane = lane_id_v(), tid = F.wave * 64 + lane;
    const int tok = lane & 15, g4 = lane >> 4;
    LAS unsigned char* Ks = F.lds;
    LAS unsigned char* Vs = F.lds + 36864;
    for (int blk = F.vcu; blk < M / 128; blk += F.G) {
        const int rowb = blk * 128, b = rowb / SEQ, row0 = rowb + F.wave * 16;
#pragma unroll 1
        for (int tt = 0; tt < 16; ++tt) { const int row = row0 + tt;
            { const f32x2 v = *(const f32x2*)(ckvraw + (size_t)row * KVR + 2 * lane); const float q = wave_sum(v.x * v.x + v.y * v.y);
              const float rs = 1.0f / sqrtf(q * (1.0f / KVR) + EPS); const f32x2 g = *(const f32x2*)(kvn + 2 * lane);
              *(unsigned*)(ckv + (size_t)row * KVR + 2 * lane) = pk2(v.x * rs * g.x, v.y * rs * g.y); }
            { const float wv = iw[(size_t)row * IH + (lane >> 3)]; const float aw = fabsf(wv) * (1.0f / 16.0f);
              const v2u q = *(const v2u*)(iqraw + (size_t)row * 256 + 4 * lane);
              v2u o; o.x = pkh2(hlo(q.x) * aw, hhi(q.x) * aw); o.y = pkh2(hlo(q.y) * aw, hhi(q.y) * aw);
              *(v2u*)(iqf + (size_t)row * 256 + 4 * lane) = o;
              const unsigned long long bal = __ballot(wv < 0.f);
              unsigned mask = 0;
#pragma unroll
              for (int h = 0; h < 8; ++h) mask |= ((unsigned)(bal >> (8 * h)) & 1u) << h;
              if (lane == 0) sgn[row] = mask; } }
        { const int row = row0 + tok, spos = row % SEQ;
#pragma unroll 1
          for (int g = 0; g < 4; ++g) { const int w = 2 << g; const int cnt = (spos + 1) < w ? (spos + 1) : w; const float rc = 1.0f / (float)cnt;
              bf16x8_p pf[2];
#pragma unroll
              for (int ks = 0; ks < 2; ++ks) { const int c0 = g * 64 + 32 * ks + 8 * g4; float sum[8], z0[8];
#pragma unroll
                  for (int e = 0; e < 8; ++e) { sum[e] = 0.f; z0[e] = 0.f; }
                  for (int j = 0; j < w; ++j) { if (j < cnt) { const v4u v = *(const v4u*)(z + (size_t)(row - j) * 256 + c0);
                      const float f[8] = {bflo(v.x), bfhi(v.x), bflo(v.y), bfhi(v.y), bflo(v.z), bfhi(v.z), bflo(v.w), bfhi(v.w)};
#pragma unroll
                      for (int e = 0; e < 8; ++e) { sum[e] += f[e]; if (j == 0) z0[e] = f[e]; } } }
                  v4u pw; pw.x = pk2(sum[0] * rc - z0[0], sum[1] * rc - z0[1]); pw.y = pk2(sum[2] * rc - z0[2], sum[3] * rc - z0[3]); pw.z = pk2(sum[4] * rc - z0[4], sum[5] * rc - z0[5]); pw.w = pk2(sum[6] * rc - z0[6], sum[7] * rc - z0[7]);
                  pf[ks] = __builtin_bit_cast(bf16x8_p, pw); }
#pragma unroll
              for (int dt = 0; dt < 4; ++dt) { f32x4 acc = {0.f, 0.f, 0.f, 0.f};
#pragma unroll
                  for (int ks = 0; ks < 2; ++ks) { const bf16x8_p af = *(const bf16x8_p*)(wpT + (size_t)(g * 64 + 16 * dt + tok) * 64 + 32 * ks + 8 * g4); acc = __builtin_amdgcn_mfma_f32_16x16x32_bf16(af, pf[ks], acc, 0, 0, 0); }
                  const f32x4 ps = *(const f32x4*)(pscale + g * 64 + 16 * dt + 4 * g4);
                  v2u o; o.x = pk2(acc[0] * ps.x, acc[1] * ps.y); o.y = pk2(acc[2] * ps.z, acc[3] * ps.w);
                  *(v2u*)(yb + (size_t)row * 256 + g * 64 + 16 * dt + 4 * g4) = o; } } }
#pragma unroll 1
        for (int h = 0; h < CH; ++h) {
            __syncthreads();
#pragma unroll
            for (int e = 0; e < 4; ++e) { const int i = tid + 512 * e;
                { const int m = i >> 3, c = i & 7; const v4u v = *(const v4u*)(memkv + (size_t)(b * NMEM + m) * 2048 + l * 512 + h * 64 + c * 8); *(LAS v4u*)(Ks + m * 144 + c * 16) = v; }
                { const int d = i >> 5, c = i & 31; const v4u v = *(const v4u*)(vT + (size_t)(l * 512 + 256 + h * 64 + d) * MROWS + b * NMEM + c * 8); *(LAS v4u*)(Vs + d * 528 + c * 16) = v; } }
            LDS_WAIT(); __syncthreads();
            const int row = row0 + tok;
            bf16x8_p qf[2];
#pragma unroll
            for (int ks = 0; ks < 2; ++ks) qf[ks] = *(const bf16x8_p*)(qc + (size_t)row * 256 + h * 64 + 32 * ks + 8 * g4);
            f32x4 S[16]; float mx = -1e30f;
#pragma unroll
            for (int mt = 0; mt < 16; ++mt) { f32x4 acc = {0.f, 0.f, 0.f, 0.f};
#pragma unroll
                for (int ks = 0; ks < 2; ++ks) { const bf16x8_p kf = *(const LAS bf16x8_p*)(Ks + (16 * mt + tok) * 144 + (4 * ks + g4) * 16); acc = __builtin_amdgcn_mfma_f32_16x16x32_bf16(kf, qf[ks], acc, 0, 0, 0); }
                S[mt] = acc; mx = fmaxf(mx, fmaxf(fmaxf(acc[0], acc[1]), fmaxf(acc[2], acc[3]))); if ((mt & 3) == 3) __builtin_amdgcn_sched_barrier(0); }
            mx = fmaxf(mx, __shfl_xor(mx, 16)); mx = fmaxf(mx, __shfl_xor(mx, 32));
            float sm = 0.f;
#pragma unroll
            for (int mt = 0; mt < 16; ++mt)
#pragma unroll
                for (int r = 0; r < 4; ++r) { const float p = __expf((S[mt][r] - mx) * 0.125f); S[mt][r] = p; sm += p; }
            sm += __shfl_xor(sm, 16); sm += __shfl_xor(sm, 32);
            const float inv = 1.0f / sm;
            f32x4 oacc[4];
#pragma unroll
            for (int dt = 0; dt < 4; ++dt) oacc[dt] = (f32x4){0.f, 0.f, 0.f, 0.f};
#pragma unroll
            for (int kk = 0; kk < 8; ++kk) { v4u pw; pw.x = pg8::cvt_pk_bf16(S[2 * kk][0], S[2 * kk][1]); pw.y = pg8::cvt_pk_bf16(S[2 * kk][2], S[2 * kk][3]); pw.z = pg8::cvt_pk_bf16(S[2 * kk + 1][0], S[2 * kk + 1][1]); pw.w = pg8::cvt_pk_bf16(S[2 * kk + 1][2], S[2 * kk + 1][3]);
                const bf16x8_p pfr = __builtin_bit_cast(bf16x8_p, pw);
#pragma unroll
                for (int dt = 0; dt < 4; ++dt) { const LAS unsigned char* vp = Vs + (16 * dt + tok) * 528 + (32 * kk + 4 * g4) * 2;
                    const v2u lo = *(const LAS v2u*)vp, hi = *(const LAS v2u*)(vp + 32);
                    v4u vw; vw.x = lo.x; vw.y = lo.y; vw.z = hi.x; vw.w = hi.y;
                    oacc[dt] = __builtin_amdgcn_mfma_f32_16x16x32_bf16(__builtin_bit_cast(bf16x8_p, vw), pfr, oacc[dt], 0, 0, 0); }
                __builtin_amdgcn_sched_barrier(0); }
#pragma unroll
            for (int dt = 0; dt < 4; ++dt) { v2u o; o.x = pk2(oacc[dt][0] * inv, oacc[dt][1] * inv); o.y = pk2(oacc[dt][2] * inv, oacc[dt][3] * inv);
                if (!dry) *(v2u*)(qc + (size_t)row * 256 + h * 64 + 16 * dt + 4 * g4) = o; else asm volatile("" :: "v"(o.x), "v"(o.y)); }
        }
    }
    __syncthreads();
}

__device__ __forceinline__ unsigned key_of(float s) { const unsigned u = __builtin_bit_cast(unsigned, s); return (u & 0x80000000u) ? ~u : (u | 0x80000000u); }

typedef short bf16x8_t __attribute__((ext_vector_type(8)));
typedef short s16x4_t __attribute__((ext_vector_type(4)));
__device__ __forceinline__ void glds16(const void* gsrc, unsigned lds_dst) { unsigned keep;
    asm volatile("s_mov_b32 %0, m0\n\ts_mov_b32 m0, %2\n\ts_nop 0\n\tglobal_load_lds_dwordx4 %1, off\n\ts_mov_b32 m0, %0" : "=&s"(keep) : "v"(gsrc), "s"(lds_dst) : "memory"); }
typedef float f32x16 __attribute__((ext_vector_type(16)));
constexpr int SEL_CAP = 256;
constexpr int HSTR = 264;
constexpr int SL_HIST = 0, SL_SEL = 0, SL_CS = 32768, SL_CI = 98304, SL_KEYS = 131072, SL_ST = 147456;

#define SEL_DECLS \
    LAS unsigned char* const lds = uni_l(lds_); const int wave = uni_i(wave_), b = uni_i(b_), ub = uni_i(ub_); unsigned char* ws = uni(ws_); \
    const bf16* iqf = (const bf16*)(ws + WS_IQF); const unsigned* sgn = (const unsigned*)(ws + WS_SGN); const bf16* ik = (const bf16*)(ws + WS_IK); \
    const int lane = lane_id_v(), tid = wave * 64 + lane; const int kl = lane & 31, c5 = lane >> 5; \
    LAS unsigned* hist = (LAS unsigned*)(lds + SL_HIST); LAS unsigned short* lsel = (LAS unsigned short*)(lds + SL_SEL); LAS float* lcs = (LAS float*)(lds + SL_CS); \
    LAS unsigned short* lci = (LAS unsigned short*)(lds + SL_CI); LAS unsigned* st = (LAS unsigned*)(lds + SL_ST); LAS float* stf = (LAS float*)(lds + SL_ST); \
    const int t0 = ub * 64; const int q0 = b * SEQ + t0; const bf16* ikb = ik + (size_t)b * SEQ * IDIM; const int ntile = (t0 + 64 + 127) >> 7; \
    (void)hist; (void)lsel; (void)lcs; (void)lci; (void)stf; (void)tid;
#define SEL_LOAD_A \
    bf16x8_t af[2][2]; float sgc[2][16]; \
    { const int i = kl, a_ = i >> 3, cc_ = (i >> 2) & 1, e_ = i & 3; const int qq_ = 2 * cc_ + (a_ >> 1), hh_ = 4 * (a_ & 1) + e_; \
      _Pragma("unroll") for (int rt = 0; rt < 2; ++rt) { const unsigned flip_ = ((sgn[q0 + 8 * wave + 4 * rt + qq_] >> hh_) & 1u) ? 0x80008000u : 0u;     \
          _Pragma("unroll") for (int ks = 0; ks < 2; ++ks) { v4u w_ = *(const v4u*)(iqf + (size_t)(q0 + 8 * wave + 4 * rt + qq_) * 256 + hh_ * 32 + 16 * ks + 8 * c5); \
              w_.x ^= flip_; w_.y ^= flip_; w_.z ^= flip_; w_.w ^= flip_; af[rt][ks] = __builtin_bit_cast(bf16x8_t, w_); } } \
      _Pragma("unroll") for (int rt = 0; rt < 2; ++rt) _Pragma("unroll") for (int u = 0; u < 2; ++u) { const unsigned m_ = sgn[q0 + 8 * wave + 4 * rt + 2 * c5 + u]; \
          _Pragma("unroll") for (int h = 0; h < 8; ++h) sgc[rt][8 * u + h] = ((m_ >> h) & 1u) ? -__builtin_inff() : __builtin_inff(); } }
#define SEL_STAGE(kt_) do { const int key_ = 16 * wave + (lane >> 2); const int ch_ = (lane & 3) ^ ((key_ >> 2) & 3); \
    glds16(ikb + (size_t)(128 * (kt_) + key_) * IDIM + ch_ * 8, (unsigned)__builtin_amdgcn_readfirstlane((int)(unsigned)(size_t)(lds + SL_KEYS + ((kt_) & 1) * 8192 + wave * 1024))); } while (0)
#define SEL_MMA(acc_, rt_, kh_) do { acc_ = (f32x16){0.f,0.f,0.f,0.f,0.f,0.f,0.f,0.f,0.f,0.f,0.f,0.f,0.f,0.f,0.f,0.f}; \
    acc_ = __builtin_amdgcn_mfma_f32_32x32x16_f16(__builtin_bit_cast(f16x8_t, af[rt_][0]), __builtin_bit_cast(f16x8_t, bfr_[kh_][0]), acc_, 0, 0, 0); \
    acc_ = __builtin_amdgcn_mfma_f32_32x32x16_f16(__builtin_bit_cast(f16x8_t, af[rt_][1]), __builtin_bit_cast(f16x8_t, bfr_[kh_][1]), acc_, 0, 0, 0); } while (0)
#define SEL_SUM(acc_, rt_, kh_) do { _Pragma("unroll") for (int u = 0; u < 2; ++u) { float s_ = 0.f; \
    _Pragma("unroll") for (int h = 0; h < 8; ++h) s_ += __builtin_amdgcn_fmed3f(acc_[8 * u + h], 0.f, sgc[rt_][8 * u + h]); \
    sc[rt_][kh_][u] = s_; } } while (0)
#define SEL_SCORES(kt_) do { const LAS unsigned char* kb_ = lds + SL_KEYS + ((kt_) & 1) * 8192; bf16x8_t bfr_[4][2]; \
    _Pragma("unroll") for (int kh = 0; kh < 4; ++kh) { const int key_ = 32 * kh + kl; \
        bfr_[kh][0] = *(const LAS bf16x8_t*)(kb_ + key_ * 64 + 16 * ((0 + c5) ^ ((key_ >> 2) & 3))); \
        bfr_[kh][1] = *(const LAS bf16x8_t*)(kb_ + key_ * 64 + 16 * ((2 + c5) ^ ((key_ >> 2) & 3))); } \
    f32x16 accA_, accB_; \
    SEL_MMA(accA_, 0, 0); \
    SEL_MMA(accB_, 1, 0); __builtin_amdgcn_sched_barrier(0); SEL_SUM(accA_, 0, 0); __builtin_amdgcn_sched_barrier(0); \
    SEL_MMA(accA_, 0, 1); __builtin_amdgcn_sched_barrier(0); SEL_SUM(accB_, 1, 0); __builtin_amdgcn_sched_barrier(0); \
    SEL_MMA(accB_, 1, 1); __builtin_amdgcn_sched_barrier(0); SEL_SUM(accA_, 0, 1); __builtin_amdgcn_sched_barrier(0); \
    SEL_MMA(accA_, 0, 2); __builtin_amdgcn_sched_barrier(0); SEL_SUM(accB_, 1, 1); __builtin_amdgcn_sched_barrier(0); \
    SEL_MMA(accB_, 1, 2); __builtin_amdgcn_sched_barrier(0); SEL_SUM(accA_, 0, 2); __builtin_amdgcn_sched_barrier(0); \
    SEL_MMA(accA_, 0, 3); __builtin_amdgcn_sched_barrier(0); SEL_SUM(accB_, 1, 2); __builtin_amdgcn_sched_barrier(0); \
    SEL_MMA(accB_, 1, 3); __builtin_amdgcn_sched_barrier(0); SEL_SUM(accA_, 0, 3); __builtin_amdgcn_sched_barrier(0); \
    SEL_SUM(accB_, 1, 3); } while (0)
#define SEL_BOUNDARY(FINAL) do { \
    const int qq = tid >> 3, part = tid & 7; const LAS v4u* hp = (const LAS v4u*)(hist + qq * HSTR + 32 * part); \
    unsigned bins[32]; \
    _Pragma("unroll") for (int i = 0; i < 8; ++i) { const v4u v = hp[i]; bins[4 * i] = v.x; bins[4 * i + 1] = v.y; bins[4 * i + 2] = v.z; bins[4 * i + 3] = v.w; } \
    unsigned ps = 0; \
    _Pragma("unroll") for (int i = 0; i < 32; ++i) ps += bins[i]; \
    unsigned v = ps, tt; \
    tt = __shfl_down(v, 1, 8); if (part + 1 < 8) v += tt; \
    tt = __shfl_down(v, 2, 8); if (part + 2 < 8) v += tt; \
    tt = __shfl_down(v, 4, 8); if (part + 4 < 8) v += tt; \
    unsigned cacc = v - ps; \
    if (cacc < (unsigned)TOPK && v >= (unsigned)TOPK) { int bsel = 0; unsigned na = 0, cb = 0; bool found = false; \
        _Pragma("unroll") for (int i = 31; i >= 0; --i) { const bool hit = !found && (cacc + bins[i] >= (unsigned)TOPK); if (hit) { bsel = i; na = cacc; cb = bins[i]; found = true; } cacc += bins[i]; } \
        st[128 + qq] = (unsigned)(32 * part + bsel); if (FINAL) { st[192 + qq] = na; st[256 + qq] = cb; st[448 + qq] = cb > (unsigned)SEL_CAP ? 1u : 0u; } } } while (0)

__device__ __forceinline__ void sel_pass1(unsigned char* ws_, LAS unsigned char* lds_, int wave_, int b_, int ub_) {
    SEL_DECLS
    unsigned short* sel = (unsigned short*)(ws + WS_SEL);
    __syncthreads();
    if (ub < 4) {
        for (int i = tid; i < 64 * TOPK; i += NWAVES * 64) { const int qq = i >> 8, sl = i & 255; sel[(size_t)(q0 + qq) * TOPK + sl] = (unsigned short)(sl <= t0 + qq ? sl : 0); }
        if (tid == 0) st[512] = 1u;
        asm volatile("s_waitcnt vmcnt(0) lgkmcnt(0)" ::: "memory"); __syncthreads();
        return;
    }
    SEL_LOAD_A
    for (int i = tid; i < 64 * HSTR; i += NWAVES * 64) hist[i] = 0u;
    if (tid < 64) { st[128 + tid] = 0u; st[448 + tid] = 0u; }
    if (tid == 0) st[512] = 0u;
    float sc[2][4][2];
    float scl[2][2]; int bcur[2][2];
#pragma unroll
    for (int rt = 0; rt < 2; ++rt)
#pragma unroll
        for (int u = 0; u < 2; ++u) { scl[rt][u] = 0.f; bcur[rt][u] = 0; }
    SEL_STAGE(0);
#pragma unroll 1
    for (int kt = 0; kt < ntile; ++kt) {
        asm volatile("s_waitcnt vmcnt(0) lgkmcnt(0)" ::: "memory"); __syncthreads();
        if (kt > 0 && (kt & 3) == 0) {
            SEL_BOUNDARY(false);
            asm volatile("s_waitcnt lgkmcnt(0)" ::: "memory"); __syncthreads();
#pragma unroll
            for (int rt = 0; rt < 2; ++rt)
#pragma unroll
                for (int u = 0; u < 2; ++u) bcur[rt][u] = (int)st[128 + 8 * wave + 4 * rt + 2 * c5 + u];
        }
        if (kt + 1 < ntile) SEL_STAGE(kt + 1);
        SEL_SCORES(kt);
        if (kt == 0) {
#pragma unroll
            for (int rt = 0; rt < 2; ++rt)
#pragma unroll
                for (int u = 0; u < 2; ++u) { float mx = 0.f;
#pragma unroll
                    for (int kh = 0; kh < 4; ++kh) mx = fmaxf(mx, fabsf(sc[rt][kh][u]));
#pragma unroll
                    for (int o = 1; o < 32; o <<= 1) mx = fmaxf(mx, __shfl_xor(mx, o));
                    const float R = mx > 0.f ? mx : 1.0f;
                    scl[rt][u] = 128.0f / R;
                    if (kl == 0) stf[8 * wave + 4 * rt + 2 * c5 + u] = scl[rt][u]; }
        }
        const bool masked = 128 * kt + 127 > t0;
#pragma unroll
        for (int rt = 0; rt < 2; ++rt)
#pragma unroll
            for (int u = 0; u < 2; ++u) { const int qq = 8 * wave + 4 * rt + 2 * c5 + u; const int lim = masked ? (t0 + qq - 128 * kt - kl) : 1000;
#pragma unroll
                for (int kh = 0; kh < 4; ++kh) { const float fb = __builtin_amdgcn_fmed3f(fmaf(sc[rt][kh][u], scl[rt][u], 128.0f), 0.f, 255.f);
                    if (fb >= (float)bcur[rt][u] && 32 * kh <= lim) (void)__hip_atomic_fetch_add(hist + qq * HSTR + (int)fb, 1u, __ATOMIC_RELAXED, __HIP_MEMORY_SCOPE_WORKGROUP); } }
    }
    asm volatile("s_waitcnt vmcnt(0) lgkmcnt(0)" ::: "memory"); __syncthreads();
    SEL_BOUNDARY(true);
    if (tid < 64) { st[320 + tid] = 0u; st[384 + tid] = 0u; }
    asm volatile("s_waitcnt lgkmcnt(0)" ::: "memory"); __syncthreads();
}
__device__ __forceinline__ void sel_pass2(unsigned char* ws_, LAS unsigned char* lds_, int wave_, int b_, int ub_) {
    SEL_DECLS
    if (st[512] != 0u) return;
    if (tid < 64) { st[320 + tid] = 0u; st[384 + tid] = 0u; }
    SEL_LOAD_A
    float sc[2][4][2];
    float scl[2][2]; int bcur[2][2];
#pragma unroll
    for (int rt = 0; rt < 2; ++rt)
#pragma unroll
        for (int u = 0; u < 2; ++u) { const int qq = 8 * wave + 4 * rt + 2 * c5 + u; scl[rt][u] = stf[qq]; bcur[rt][u] = (int)st[128 + qq]; }
    SEL_STAGE(0);
#pragma unroll 1
    for (int kt = 0; kt < ntile; ++kt) {
        asm volatile("s_waitcnt vmcnt(0) lgkmcnt(0)" ::: "memory"); __syncthreads();
        if (kt + 1 < ntile) SEL_STAGE(kt + 1);
        SEL_SCORES(kt);
        const bool masked = 128 * kt + 127 > t0;
        unsigned okm = 0u, abm = 0u; unsigned basea[2][2], basec[2][2];
#pragma unroll
        for (int rt = 0; rt < 2; ++rt)
#pragma unroll
            for (int u = 0; u < 2; ++u) { const int qq = 8 * wave + 4 * rt + 2 * c5 + u; const int lim = masked ? (t0 + qq - 128 * kt - kl) : 1000; unsigned na_ = 0u, nc_ = 0u;
#pragma unroll
                for (int kh = 0; kh < 4; ++kh) { const float fb = __builtin_amdgcn_fmed3f(fmaf(sc[rt][kh][u], scl[rt][u], 128.0f), 0.f, 255.f);
                    const bool ok = fb >= (float)bcur[rt][u] && 32 * kh <= lim; const bool ab = fb >= (float)(bcur[rt][u] + 1);
                    if (ok) { okm |= 1u << (rt * 8 + u * 4 + kh); if (ab) { abm |= 1u << (rt * 8 + u * 4 + kh); ++na_; } else ++nc_; } }
                basea[rt][u] = 0u; basec[rt][u] = 0u;
                if (na_) basea[rt][u] = __hip_atomic_fetch_add(st + 320 + qq, na_, __ATOMIC_RELAXED, __HIP_MEMORY_SCOPE_WORKGROUP);
                if (nc_) basec[rt][u] = __hip_atomic_fetch_add(st + 384 + qq, nc_, __ATOMIC_RELAXED, __HIP_MEMORY_SCOPE_WORKGROUP); }
        if (okm != 0u) {
#pragma unroll
            for (int rt = 0; rt < 2; ++rt)
#pragma unroll
                for (int u = 0; u < 2; ++u) { const int qq = 8 * wave + 4 * rt + 2 * c5 + u; unsigned sa = basea[rt][u], scn = basec[rt][u];
#pragma unroll
                    for (int kh = 0; kh < 4; ++kh) { const int bit = rt * 8 + u * 4 + kh; const int kpos = 128 * kt + 32 * kh + kl;
                        if ((okm >> bit) & 1u) {
                            if ((abm >> bit) & 1u) { if (sa < (unsigned)TOPK) lsel[qq * 256 + sa] = (unsigned short)kpos; ++sa; }
                            else { if (scn < (unsigned)SEL_CAP) { lcs[qq * SEL_CAP + scn] = sc[rt][kh][u]; lci[qq * SEL_CAP + scn] = (unsigned short)kpos; } ++scn; } } } }
        }
    }
    asm volatile("s_waitcnt vmcnt(0) lgkmcnt(0)" ::: "memory"); __syncthreads();
}
__device__ __forceinline__ void sel_resolve(unsigned char* ws_, LAS unsigned char* lds_, int wave_, int b_, int ub_, int wg_, int first_) {
    SEL_DECLS
    const int wg = uni_i(wg_), first = uni_i(first_);
    unsigned short* sel = (unsigned short*)(ws + WS_SEL);
    gu32* slowl = (gu32*)(ws + WS_CTL + 65536) + (size_t)wg * 132;
    if (first && tid == 0) __hip_atomic_store(slowl, 0u, RLX_AGENT);
    if (st[512] != 0u) return;
#pragma unroll 1
    for (int qi = 0; qi < 8; ++qi) { const int qq = 8 * wave + qi; const int q = q0 + qq;
        const int na = (int)st[192 + qq], need = TOPK - na; int C = (int)st[384 + qq]; C = C < SEL_CAP ? C : SEL_CAP;
        const bool slow = st[448 + qq] != 0u;
        if (!slow) {
            LAS unsigned* sh = (LAS unsigned*)(lds + SL_KEYS + wave * 2048); LAS float* sls = (LAS float*)(lds + SL_KEYS + wave * 2048 + 256); LAS unsigned short* sli = (LAS unsigned short*)(lds + SL_KEYS + wave * 2048 + 1280);
            const float sclq = stf[qq]; const float fbase = (float)(int)st[128 + qq];
            sh[lane] = 0u;
            float cs[SEL_CAP / 64]; int ci[SEL_CAP / 64], sb[SEL_CAP / 64];
#pragma unroll
            for (int e = 0; e < SEL_CAP / 64; ++e) { const int i = lane + 64 * e; cs[e] = 0.f; ci[e] = 0; sb[e] = -1;
                if (i < C) { cs[e] = lcs[qq * SEL_CAP + i]; ci[e] = lci[qq * SEL_CAP + i];
                    const float fr_ = (fmaf(cs[e], sclq, 128.0f) - fbase) * 64.0f; sb[e] = (int)__builtin_amdgcn_fmed3f(fr_, 0.f, 63.f); } }
            LDS_WAIT();
#pragma unroll
            for (int e = 0; e < SEL_CAP / 64; ++e) if (sb[e] >= 0) (void)__hip_atomic_fetch_add(sh + sb[e], 1u, __ATOMIC_RELAXED, __HIP_MEMORY_SCOPE_WORKGROUP);
            LDS_WAIT();
            const unsigned cl = sh[lane];
            unsigned v = cl, tt;
            tt = __shfl_down(v, 1); if (lane + 1 < 64) v += tt;
            tt = __shfl_down(v, 2); if (lane + 2 < 64) v += tt;
            tt = __shfl_down(v, 4); if (lane + 4 < 64) v += tt;
            tt = __shfl_down(v, 8); if (lane + 8 < 64) v += tt;
            tt = __shfl_down(v, 16); if (lane + 16 < 64) v += tt;
            tt = __shfl_down(v, 32); if (lane + 32 < 64) v += tt;
            const unsigned ab_ = v - cl;
            const unsigned long long cross = __ballot(ab_ < (unsigned)need && v >= (unsigned)need);
            const int sstar = cross ? (int)__builtin_ctzll(cross) : 0;
            const int na2 = (int)__shfl(ab_, sstar);
            const int need2 = need - na2;
            int base = na; int nsub = 0;
#pragma unroll
            for (int e = 0; e < SEL_CAP / 64; ++e) { const bool up = sb[e] > sstar; const bool eq = sb[e] == sstar;
                const unsigned long long bu = __ballot(up), be = __ballot(eq);
                const unsigned long long lt = (lane == 0) ? 0ull : (~0ull >> (64 - lane));
                if (up) lsel[qq * 256 + base + (int)__builtin_popcountll(bu & lt)] = (unsigned short)ci[e];
                if (eq) { const int p_ = nsub + (int)__builtin_popcountll(be & lt); sls[p_] = cs[e]; sli[p_] = (unsigned short)ci[e]; }
                base += (int)__builtin_popcountll(bu); nsub += (int)__builtin_popcountll(be); }
            LDS_WAIT();
#pragma unroll 1
            for (int i0 = 0; i0 < nsub; i0 += 64) { const int i = i0 + lane;
                if (i < nsub) { const float si = sls[i]; const int ii = sli[i]; int rank = 0;
                    for (int jx = 0; jx < nsub; ++jx) { const float sj = sls[jx]; const int ij = sli[jx]; rank += (sj > si || (sj == si && ij < ii)) ? 1 : 0; }
                    if (rank < need2) lsel[qq * 256 + na + na2 + rank] = (unsigned short)ii; } }
            LDS_WAIT();
            *(v2u*)(sel + (size_t)q * TOPK + 4 * lane) = *(const LAS v2u*)(lsel + qq * 256 + 4 * lane);
        }
    }
    __syncthreads();
    if (tid == 0) { unsigned n = first ? 0u : __hip_atomic_load(slowl, RLX_AGENT);
        for (int qq = 0; qq < 64; ++qq) if (st[448 + qq] != 0u) { if (n < 128u) { __hip_atomic_store(slowl + 1 + n, (unsigned)(q0 + qq), RLX_AGENT); ++n; } }
        __hip_atomic_store(slowl, n, RLX_AGENT); }
    asm volatile("s_waitcnt vmcnt(0)" ::: "memory");
    __syncthreads();
}
#undef SEL_DECLS
#undef SEL_LOAD_A
#undef SEL_STAGE
#undef SEL_SCORES
#undef SEL_MMA
#undef SEL_SUM
#undef SEL_BOUNDARY
__device__ __forceinline__ void dsa_select_slow(unsigned char* ws_, LAS unsigned char* lds_, int wave_, int wg_) {
    LAS unsigned char* const lds = uni_l(lds_); const int wave = uni_i(wave_), wg = uni_i(wg_);
    unsigned char* ws = uni(ws_);
    const bf16* iqf = (const bf16*)(ws + WS_IQF); const unsigned* sgn = (const unsigned*)(ws + WS_SGN); const bf16* ik = (const bf16*)(ws + WS_IK);
    unsigned short* sel = (unsigned short*)(ws + WS_SEL);
    gu32* slowl = (gu32*)(ws + WS_CTL + 65536) + (size_t)wg * 132;
    const int lane = lane_id_v(), tid = wave * 64 + lane; const int kl = lane & 31, c5 = lane >> 5;
    LAS unsigned* keys = (LAS unsigned*)lds;
    LAS unsigned* hist = (LAS unsigned*)(lds + 32768);
    LAS unsigned* ctl = (LAS unsigned*)(lds + 40960);
    const int nq = (int)__builtin_amdgcn_readfirstlane(__hip_atomic_load(slowl, RLX_AGENT));
#pragma unroll 1
    for (int k = 0; k < nq; ++k) {
        const int q = (int)__builtin_amdgcn_readfirstlane(__hip_atomic_load(slowl + 1 + k, RLX_AGENT));
        const int b = q / SEQ, t = q % SEQ, n = t + 1;
        const bf16* ikb = ik + (size_t)b * SEQ * IDIM;
        __syncthreads();
        bf16x8_t af[2]; float sgc[8];
        { const int i = kl, a_ = i >> 3, e_ = i & 3; const int hh_ = 4 * (a_ & 1) + e_; const unsigned m_ = sgn[q];
          const unsigned flip_ = ((m_ >> hh_) & 1u) ? 0x80008000u : 0u;
#pragma unroll
          for (int ks = 0; ks < 2; ++ks) { v4u w_ = *(const v4u*)(iqf + (size_t)q * 256 + hh_ * 32 + 16 * ks + 8 * c5); w_.x ^= flip_; w_.y ^= flip_; w_.z ^= flip_; w_.w ^= flip_; af[ks] = __builtin_bit_cast(bf16x8_t, w_); }
#pragma unroll
          for (int h = 0; h < 8; ++h) sgc[h] = ((m_ >> h) & 1u) ? -__builtin_inff() : __builtin_inff(); }
#pragma unroll 1
        for (int kb0 = wave; kb0 * 32 < n; kb0 += 4 * NWAVES) {
            bf16x8_t kb_[4][2];
#pragma unroll
            for (int j = 0; j < 4; ++j) { int key = 32 * (kb0 + j * NWAVES) + kl; key = key < SEQ ? key : SEQ - 1;
                kb_[j][0] = *(const bf16x8_t*)(ikb + (size_t)key * IDIM + 8 * c5); kb_[j][1] = *(const bf16x8_t*)(ikb + (size_t)key * IDIM + 16 + 8 * c5); }
#pragma unroll
            for (int j = 0; j < 4; ++j) { const int key = 32 * (kb0 + j * NWAVES) + kl;
                f32x16 acc = {0.f,0.f,0.f,0.f,0.f,0.f,0.f,0.f,0.f,0.f,0.f,0.f,0.f,0.f,0.f,0.f};
                acc = __builtin_amdgcn_mfma_f32_32x32x16_f16(__builtin_bit_cast(f16x8_t, af[0]), __builtin_bit_cast(f16x8_t, kb_[j][0]), acc, 0, 0, 0); acc = __builtin_amdgcn_mfma_f32_32x32x16_f16(__builtin_bit_cast(f16x8_t, af[1]), __builtin_bit_cast(f16x8_t, kb_[j][1]), acc, 0, 0, 0);
                float sc = 0.f;
#pragma unroll
                for (int h = 0; h < 8; ++h) sc += __builtin_amdgcn_fmed3f(acc[h], 0.f, sgc[h]);
                if (c5 == 0 && key < SEQ) keys[key] = key_of(sc); } }
        if (tid == 0) { const unsigned z_ = (unsigned)launder_v(0); ctl[0] = z_; ctl[1] = z_ + (unsigned)TOPK; ctl[2] = z_; ctl[3] = z_; }
        unsigned P = 0u, Plo = 0u;
#pragma unroll 1
        for (int lev = 0; lev < 5; ++lev) {
            for (int i = tid; i < 2048; i += NWAVES * 64) hist[i] = 0u;
            asm volatile("s_waitcnt lgkmcnt(0)" ::: "memory"); __syncthreads();
#pragma unroll 1
            for (int i = 0; i < 16; ++i) { const int s_ = tid * 16 + i;
                if (s_ < n) { const unsigned hi = keys[s_], lo = 8191u - (unsigned)s_; bool mt; unsigned dg;
                    if (lev == 0) { mt = true; dg = hi >> 21; } else if (lev == 1) { mt = (hi >> 21) == P; dg = (hi >> 10) & 0x7ffu; } else if (lev == 2) { mt = (hi >> 10) == P; dg = hi & 0x3ffu; }
                    else if (lev == 3) { mt = hi == P; dg = lo >> 6; } else { mt = hi == P && (lo >> 6) == Plo; dg = lo & 63u; }
                    if (mt) (void)__hip_atomic_fetch_add(hist + dg, 1u, __ATOMIC_RELAXED, __HIP_MEMORY_SCOPE_WORKGROUP); } }
            asm volatile("s_waitcnt lgkmcnt(0)" ::: "memory"); __syncthreads();
            const unsigned need = ctl[1];
            const v4u hb = *(const LAS v4u*)(hist + 4 * tid); const unsigned ls = hb.x + hb.y + hb.z + hb.w;
            unsigned v = ls, tt;
            tt = __shfl_down(v, 1); if (lane + 1 < 64) v += tt;
            tt = __shfl_down(v, 2); if (lane + 2 < 64) v += tt;
            tt = __shfl_down(v, 4); if (lane + 4 < 64) v += tt;
            tt = __shfl_down(v, 8); if (lane + 8 < 64) v += tt;
            tt = __shfl_down(v, 16); if (lane + 16 < 64) v += tt;
            tt = __shfl_down(v, 32); if (lane + 32 < 64) v += tt;
            if (lane == 0) ctl[8 + wave] = v;
            asm volatile("s_waitcnt lgkmcnt(0)" ::: "memory"); __syncthreads();
            unsigned above = v - ls;
            for (int w2 = wave + 1; w2 < NWAVES; ++w2) above += ctl[8 + w2];
            if (above < need && above + ls >= need) { unsigned c = above; const unsigned bb[4] = {hb.x, hb.y, hb.z, hb.w}; int bsel = 0; unsigned cab = 0; bool found = false;
#pragma unroll
                for (int i = 3; i >= 0; --i) { const bool hit = !found && (c + bb[i] >= need); if (hit) { bsel = i; cab = c; found = true; } c += bb[i]; }
                const unsigned dv = (unsigned)(4 * tid + bsel);
                if (lev == 0) ctl[0] = dv; else if (lev == 1) ctl[0] = (P << 11) | dv; else if (lev == 2) ctl[0] = (P << 10) | dv; else if (lev == 3) ctl[3] = dv; else ctl[3] = (Plo << 6) | dv;
                ctl[1] = need - cab; ctl[4] = bb[bsel]; }
            asm volatile("s_waitcnt lgkmcnt(0)" ::: "memory"); __syncthreads();
            P = ctl[0]; Plo = ctl[3];
            if (lev == 2 && ctl[1] == ctl[4]) break;
        }
        unsigned short* srow = sel + (size_t)q * TOPK;
        unsigned mymask = 0u;
#pragma unroll 1
        for (int i = 0; i < 16; ++i) { const int s_ = tid * 16 + i;
            if (s_ < n) { const unsigned hi = keys[s_], lo = 8191u - (unsigned)s_; if (hi > P || (hi == P && lo >= Plo)) mymask |= 1u << i; } }
        const unsigned mycnt = (unsigned)__builtin_popcount(mymask);
        unsigned pv_ = mycnt, tt_;
        tt_ = __shfl_up(pv_, 1); if (lane >= 1) pv_ += tt_;
        tt_ = __shfl_up(pv_, 2); if (lane >= 2) pv_ += tt_;
        tt_ = __shfl_up(pv_, 4); if (lane >= 4) pv_ += tt_;
        tt_ = __shfl_up(pv_, 8); if (lane >= 8) pv_ += tt_;
        tt_ = __shfl_up(pv_, 16); if (lane >= 16) pv_ += tt_;
        tt_ = __shfl_up(pv_, 32); if (lane >= 32) pv_ += tt_;
        if (lane == 63) ctl[16 + wave] = pv_;
        asm volatile("s_waitcnt lgkmcnt(0)" ::: "memory"); __syncthreads();
        unsigned slot0 = pv_ - mycnt;
        for (int w2 = 0; w2 < wave; ++w2) slot0 += ctl[16 + w2];
#pragma unroll 1
        for (int i = 0; i < 16; ++i) if ((mymask >> i) & 1u) { if (slot0 < (unsigned)TOPK) srow[slot0] = (unsigned short)(tid * 16 + i); ++slot0; }
    }
    asm volatile("s_waitcnt vmcnt(0) lgkmcnt(0)" ::: "memory");
    __syncthreads();
}

__device__ __forceinline__ unsigned offb(unsigned row, unsigned ch) { return 256u * row + 16u * (ch ^ (((row & 3u) << 2) | ((row >> 2) & 3u))); }
__device__ __forceinline__ s16x4_t vtr(const LAS unsigned char* p) { return __builtin_bit_cast(s16x4_t, __builtin_amdgcn_ds_read_tr16_b64_v4i16((LAS s16x4_t*)p)); }

__device__ __forceinline__ void dsa_attend(unsigned char* ws_, LAS unsigned char* lds_, const float* relb_, int wave_, int vcu_, int G_, int dry_) {
    const int dry = uni_i(dry_);
    LAS unsigned char* const lds = uni_l(lds_); const int wave = uni_i(wave_), vcu = uni_i(vcu_), G = uni_i(G_);
    unsigned char* ws = uni(ws_); const float* relb = uni(relb_);
    const bf16* ckv = (const bf16*)(ws + WS_CKV); bf16* ql = (bf16*)(ws + WS_QL); const unsigned short* sel = (const unsigned short*)(ws + WS_SEL);
    const int lane = lane_id_v(), tid = wave * 64 + lane;
    LAS unsigned char* cb = lds + wave * 16384;
    LAS unsigned short* sidx = (LAS unsigned short*)(lds + 131072 + wave * 512);
    LAS float* biasd = (LAS float*)(lds + 135168);
    for (int i = tid; i < 129 * 8; i += NWAVES * 64) { const int d = i >> 3, h = i & 7; const int bk = d < 128 ? (int)T5_BUCKET[d] : 31; biasd[i] = relb[bk * 8 + h]; }
    __syncthreads();
    const int hl = lane & 15, g = lane >> 4, hq = hl & 7;
    for (int p = vcu; p < BATCH * 64; p += G) {
        const int b = p >> 6, j = p & 63;
#pragma unroll 1
        for (int half = 0; half < 2; ++half) {
            const int ub = half == 0 ? j : 127 - j;
#pragma unroll 1
            for (int qi = 0; qi < 8; ++qi) {
                const int t = ub * 64 + wave * 8 + qi; const int q = b * SEQ + t; const int nsel = (t + 1) < TOPK ? (t + 1) : TOPK;
                const bf16* ckvb = ckv + (size_t)b * SEQ * KVR; bf16* qlrow = ql + (size_t)q * 1024;
                { const v2u w = *(const v2u*)(sel + (size_t)q * TOPK + 4 * lane); *(LAS v2u*)(sidx + 4 * lane) = w; }
                bf16x8_t qf[4];
#pragma unroll
                for (int s = 0; s < 4; ++s) qf[s] = *(const bf16x8_t*)(qlrow + hq * 128 + 32 * s + 8 * g);
                LDS_WAIT();
                float mrun = -1e30f, lsum = 0.f;
                f32x4 O[8];
#pragma unroll
                for (int c = 0; c < 8; ++c) O[c] = (f32x4){0.f, 0.f, 0.f, 0.f};
#define DSA_GATHER(c_) do { LAS unsigned char* dst_ = cb + ((c_) & 1) * 8192; \
                    _Pragma("unroll") for (int k_ = 0; k_ < 8; ++k_) { const int row_ = 4 * k_ + g; const int kidx_ = sidx[32 * (c_) + row_]; \
                        const int ch_ = hl ^ ((g << 2) | (k_ & 3)); \
                        glds16(ckvb + (size_t)kidx_ * KVR + ch_ * 8, (unsigned)__builtin_amdgcn_readfirstlane((int)(unsigned)(size_t)(dst_ + k_ * 1024))); } } while (0)
                DSA_GATHER(0);
#pragma unroll 1
                for (int c = 0; c < 8; ++c) {
                    if (c < 7) { DSA_GATHER(c + 1); asm volatile("s_waitcnt vmcnt(8)" ::: "memory"); }
                    else asm volatile("s_waitcnt vmcnt(0)" ::: "memory");
                    const LAS unsigned char* img = cb + (c & 1) * 8192;
                    f32x4 S[2];
#pragma unroll
                    for (int rb = 0; rb < 2; ++rb) { S[rb] = (f32x4){0.f, 0.f, 0.f, 0.f}; const unsigned row = 8u * (hl >> 2) + 4u * rb + (hl & 3);
#pragma unroll
                        for (int s = 0; s < 4; ++s) { const bf16x8_t af = *(const LAS bf16x8_t*)(img + offb(row, 4 * s + g)); S[rb] = __builtin_amdgcn_mfma_f32_16x16x32_bf16(af, qf[s], S[rb], 0, 0, 0); } }
                    float pv[2][4]; float mx = -1e30f;
#pragma unroll
                    for (int rb = 0; rb < 2; ++rb) { const v2u iw2 = *(const LAS v2u*)(sidx + 32 * c + 8 * g + 4 * rb);
                        const int ki[4] = {(int)(iw2.x & 0xffffu), (int)(iw2.x >> 16), (int)(iw2.y & 0xffffu), (int)(iw2.y >> 16)};
#pragma unroll
                        for (int r = 0; r < 4; ++r) { int dist = t - ki[r]; dist = dist < 0 ? 0 : (dist > 128 ? 128 : dist);
                            float lg = S[rb][r] * 0.125f + biasd[dist * 8 + hq];
                            if (32 * c + 8 * g + 4 * rb + r >= nsel) lg = -1e30f;
                            pv[rb][r] = lg; mx = fmaxf(mx, lg); } }
                    mx = fmaxf(mx, __shfl_xor(mx, 16)); mx = fmaxf(mx, __shfl_xor(mx, 32));
                    const float mnew = fmaxf(mrun, mx); const float alpha = __expf(mrun - mnew); mrun = mnew;
                    float rs = 0.f;
#pragma unroll
                    for (int rb = 0; rb < 2; ++rb)
#pragma unroll
                        for (int r = 0; r < 4; ++r) { pv[rb][r] = __expf(pv[rb][r] - mnew); rs += pv[rb][r]; }
                    rs += __shfl_xor(rs, 16); rs += __shfl_xor(rs, 32);
                    lsum = lsum * alpha + rs;
                    v4u pw; pw.x = pg8::cvt_pk_bf16(pv[0][0], pv[0][1]); pw.y = pg8::cvt_pk_bf16(pv[0][2], pv[0][3]); pw.z = pg8::cvt_pk_bf16(pv[1][0], pv[1][1]); pw.w = pg8::cvt_pk_bf16(pv[1][2], pv[1][3]);
                    const bf16x8_t pf = __builtin_bit_cast(bf16x8_t, pw);
                    float al[4];
#pragma unroll
                    for (int r = 0; r < 4; ++r) al[r] = __shfl(alpha, 4 * g + r);
#pragma unroll
                    for (int cd = 0; cd < 8; ++cd) {
                        f32x4 o = O[cd]; o[0] *= al[0]; o[1] *= al[1]; o[2] *= al[2]; o[3] *= al[3];
                        const unsigned q4 = hl >> 2, p4 = hl & 3;
                        const s16x4_t b0 = vtr(img + offb(8u * g + q4, 2 * cd + (p4 >> 1)) + 8u * (p4 & 1));
                        const s16x4_t b1 = vtr(img + offb(8u * g + 4u + q4, 2 * cd + (p4 >> 1)) + 8u * (p4 & 1));
                        bf16x8_t bf; bf[0] = b0[0]; bf[1] = b0[1]; bf[2] = b0[2]; bf[3] = b0[3]; bf[4] = b1[0]; bf[5] = b1[1]; bf[6] = b1[2]; bf[7] = b1[3];
                        O[cd] = __builtin_amdgcn_mfma_f32_16x16x32_bf16(pf, bf, o, 0, 0, 0);
                    }
                }
#undef DSA_GATHER
                const float linv = 1.0f / lsum; float li[4];
#pragma unroll
                for (int r = 0; r < 4; ++r) li[r] = __shfl(linv, 4 * g + r);
                LAS unsigned short* ost = (LAS unsigned short*)cb;
                if (g < 2) {
#pragma unroll
                    for (int cd = 0; cd < 8; ++cd)
#pragma unroll
                        for (int r = 0; r < 4; ++r) ost[(4 * g + r) * 128 + 16 * cd + hl] = (unsigned short)f2bf(O[cd][r] * li[r]);
                }
                LDS_WAIT();
                { const v4u w0 = *(const LAS v4u*)(cb + 32 * lane), w1 = *(const LAS v4u*)(cb + 32 * lane + 16);
                  if (!dry) { *(v4u*)(qlrow + 16 * lane) = w0; *(v4u*)(qlrow + 16 * lane + 8) = w1; } else asm volatile("" :: "v"(w0), "v"(w1)); }
                LDS_WAIT();
            }
        }
    }
    __syncthreads();
}

__device__ __noinline__ void final_norm(const float* const* in_, float* out_, unsigned char* ws_, LAS unsigned char* lds_, int wave_, int vcu_, int G_) {
    const PC F{uni(in_), uni(out_), uni(ws_), uni_l(lds_), uni_i(wave_), uni_i(vcu_), uni_i(G_)}; struct { const float* const* in; float* out; } a{F.in, F.out};
    const int lane_ = lane_id_v(); const int gw = F.vcu * NWAVES + F.wave, NGW = F.G * NWAVES; const float* g = a.in[22];
    f32x4 gv[4];
#pragma unroll
    for (int j = 0; j < 4; ++j) gv[j] = ((const f32x4*)g)[lane_ + 64 * j];
    for (int m = gw; m < M; m += NGW) {
        GAS f32x4* xr = (GAS f32x4*)(a.out + (size_t)m * D) + lane_;
        f32x4 v[4]; float s = 0.f;
#pragma unroll
        for (int j = 0; j < 4; ++j) { v[j] = xr[64 * j]; s += (v[j].x * v[j].x + v[j].y * v[j].y) + (v[j].z * v[j].z + v[j].w * v[j].w); }
        const float rs = 1.0f / sqrtf(wave_sum(s) * (1.0f / D) + EPS);
#pragma unroll
        for (int j = 0; j < 4; ++j) xr[64 * j] = v[j] * rs * gv[j];
    }
}

#define KIN ((const float* const*)__builtin_amdgcn_kernarg_segment_ptr())
constexpr int PH_PER_LAYER = 10, PH_LAYER0 = 2, N_PHASES = PH_LAYER0 + PH_PER_LAYER * DEPTH + 1;

__global__ void __launch_bounds__(NWAVES * 64, 2) mk_fwd(Args args) {
    extern __shared__ __attribute__((aligned(16))) unsigned char lds[];
    Frame F;
    F.lds = (LAS unsigned char*)lds;
    F.MISC = (volatile LAS unsigned*)(F.lds + MISC_OFF);
    F.wave = __builtin_amdgcn_readfirstlane((int)threadIdx.x >> 6);
    F.G = gridDim.x; { const int bx = blockIdx.x; F.vcu = (F.G % 8 == 0) ? (bx % 8) * (F.G / 8) + bx / 8 : bx; }
    F.ws = args.ws; F.ctl = (gu32*)(args.ws + WS_CTL);
    if (threadIdx.x < 64) ((LAS unsigned*)(F.lds + MISC_OFF))[threadIdx.x] = 0u;
    __syncthreads();
    const int lo = args.ph_lo, hi = args.ph_hi;
    const bool multi = (hi - lo) > 1;
    XcdBarrier bar; bar.bar = (unsigned*)(F.ctl + CW_BAR); bar.x = 0; bar.st = nullptr; bar.wave = F.wave;
    if (multi) bar = xcd_barrier_post((unsigned*)(F.ctl + CW_BAR), F.MISC + 8, F.wave);
#define IN(k) (lo <= (k) && (k) < hi)
#define SEAM(k) do { if (IN(k) && IN((k) + 1)) { xcd_barrier(bar); if (PROBE_PHASE == 99) xcd_barrier(bar); } } while (0)

    if (IN(0)) {
#if EN_P0
 for (int rep = (PROBE_PHASE == 1 ? 0 : 1); rep < 2; ++rep) p0_prologue(KIN, args.out, args.ws, F.lds, F.wave, F.vcu, F.G);
#endif
 } SEAM(0);
    if (IN(1)) {
#if !((DIS_MASK >> 7) & 1)
 unsigned char* ws = launder_p(args.ws); bf16* hb = (bf16*)(ws + WS_HB); float* ss = (float*)(ws + WS_SS); (void)hb; (void)ss;
        pg8::Gemm g{(const bf16_t*)(ws + WS_MEMN), (const bf16_t*)(ws + WS_WMEM), MROWS, DEPTH * 2 * CW, D}; pg8::StaticOrder S; S.init(MROWS, DEPTH * 2 * CW, F.G, launder_s((int)blockIdx.x));
        EpiPlainBf16 E{(bf16_t*)(ws + WS_MEMKV), DEPTH * 2 * CW};
        pg8::gemm_phase<EpiPlainBf16, pg8::StaticOrder, true, true>(F.lds + RING_OFF, g, S, E, F.wave);
        { pg8::Gemm g2{(const bf16_t*)(ws + WS_WMEM), (const bf16_t*)(ws + WS_MEMN), DEPTH * 2 * CW, MROWS, D}; pg8::StaticOrder S2; S2.init(DEPTH * 2 * CW, MROWS, F.G, launder_s((int)blockIdx.x));
          EpiPlainBf16 E2{(bf16_t*)(ws + WS_VT), MROWS};
          pg8::gemm_phase<EpiPlainBf16, pg8::StaticOrder, true, true>(F.lds + RING_OFF, g2, S2, E2, F.wave); }
#endif
    } SEAM(1);

    for (int l = 0; l < DEPTH; ++l) {
        const int pb = PH_LAYER0 + PH_PER_LAYER * l;
        const float* hbase = (l == 0) ? args.in[0] : args.out;
        if (IN(pb + 0)) {
#if EN_P0
 if (l > 0) for (int rep = (PROBE_PHASE == 1 ? 0 : 1); rep < 2; ++rep) prep_layer_weights(KIN, args.out, args.ws, F.lds, l, F.wave, F.vcu, F.G);
#endif
 } SEAM(pb + 0);
        if (IN(pb + 1)) {
#if !((DIS_MASK >> 0) & 1)
 unsigned char* ws = launder_p(args.ws); bf16* hb = (bf16*)(ws + WS_HB); float* ss = (float*)(ws + WS_SS); (void)hb; (void)ss;
            pg8::Gemm g{hb, (const bf16_t*)(ws + WS_W1IN), M, 2 * DFF, D}; pg8::StaticOrder S; S.init(M, 2 * DFF, F.G, launder_s((int)blockIdx.x));
            EpiSwiglu E{(bf16_t*)(ws + WS_ACT), ss};
            for (int rep = (PROBE_PHASE == 2 ? 0 : 1); rep < 2; ++rep) pg8::gemm_phase<EpiSwiglu, pg8::StaticOrder, true, true>(F.lds + RING_OFF, g, S, E, F.wave);
#endif
        } SEAM(pb + 1);
        if (IN(pb + 2)) {
#if !((DIS_MASK >> 1) & 1)
 unsigned char* ws = launder_p(args.ws); bf16* hb = (bf16*)(ws + WS_HB); float* ss = (float*)(ws + WS_SS); (void)hb; (void)ss;
            pg8::Gemm g{(const bf16_t*)(ws + WS_ACT), (const bf16_t*)(ws + WS_W1OUT), M, D, DFF}; pg8::StaticOrder S; S.init(M, D, F.G, launder_s((int)blockIdx.x));
            for (int rep = (PROBE_PHASE == 3 ? 0 : 1); rep < 2; ++rep) { EpiResid E{hbase, args.out, hb, ss, 0.5f, (LAS float*)(F.lds + RING_BYTES), rep == 0 ? 1 : 0};
            pg8::gemm_phase<EpiResid, pg8::StaticOrder, true, true>(F.lds + RING_OFF, g, S, E, F.wave); }
#endif
        } SEAM(pb + 2);
        if (IN(pb + 3)) {
#if !((DIS_MASK >> 2) & 1)
 unsigned char* ws = launder_p(args.ws); bf16* hb = (bf16*)(ws + WS_HB); float* ss = (float*)(ws + WS_SS); (void)hb; (void)ss;
            pg8::Gemm g{hb, (const bf16_t*)(ws + WS_WIN), M, INP, D}; pg8::StaticOrder S; S.init(M, INP, F.G, launder_s((int)blockIdx.x));
            EpiInProj E{ss, (bf16_t*)(ws + WS_QL), (float*)(ws + WS_CKVRAW), (bf16_t*)(ws + WS_IK), (float*)(ws + WS_IW), (bf16_t*)(ws + WS_IQRAW), (bf16_t*)(ws + WS_Z), (bf16_t*)(ws + WS_QC), (bf16_t*)(ws + WS_G)};
            for (int rep = (PROBE_PHASE == 4 ? 0 : 1); rep < 2; ++rep) pg8::gemm_phase<EpiInProj, pg8::StaticOrder, true, true>(F.lds + RING_OFF, g, S, E, F.wave);
#endif
        } SEAM(pb + 3);
        if (IN(pb + 4)) {
#if EN_PREP
 for (int rep = (PROBE_PHASE == 5 ? 0 : 1); rep < 2; ++rep) prep_tokens(KIN, args.out, args.ws, F.lds, l, F.wave, F.vcu, F.G, rep == 0 ? 1 : 0);
#endif
 } SEAM(pb + 4);
        if (IN(pb + 5)) {
#if EN_DSA
 for (int rep = (PROBE_PHASE == 6 ? 0 : 1); rep < 2; ++rep) for (int p = F.vcu; p < BATCH * 64; p += F.G) { for (int half = 0; half < 2; ++half) { const int b_ = p >> 6, ub_ = half == 0 ? (p & 63) : 127 - (p & 63);
   sel_pass1(args.ws, F.lds, F.wave, b_, ub_); if (PROBE_PHASE == 61) sel_pass1(args.ws, F.lds, F.wave, b_, ub_); sel_pass2(args.ws, F.lds, F.wave, b_, ub_); if (PROBE_PHASE == 62) sel_pass2(args.ws, F.lds, F.wave, b_, ub_); sel_resolve(args.ws, F.lds, F.wave, b_, ub_, (int)blockIdx.x, (p == F.vcu && half == 0) ? 1 : 0); if (PROBE_PHASE == 63) sel_resolve(args.ws, F.lds, F.wave, b_, ub_, (int)blockIdx.x, 0); } }
 dsa_select_slow(args.ws, F.lds, F.wave, (int)blockIdx.x); for (int rep = (PROBE_PHASE == 7 ? 0 : 1); rep < 2; ++rep) dsa_attend(args.ws, F.lds, args.in[2], F.wave, F.vcu, F.G, rep == 0 ? 1 : 0);
#endif
 } SEAM(pb + 5);
        if (IN(pb + 6)) {
#if !((DIS_MASK >> 3) & 1)
        for (int rep6 = (PROBE_PHASE == 8 ? 0 : 1); rep6 < 2; ++rep6) {
 unsigned char* ws = launder_p(args.ws); bf16* hb = (bf16*)(ws + WS_HB); float* ss = (float*)(ws + WS_SS); (void)hb; (void)ss;
            { pg8::Gemm g{(const bf16_t*)(ws + WS_QL), (const bf16_t*)(ws + WS_WA), M, D, 1024}; pg8::StaticOrder S; S.init(M, D, F.G, launder_s((int)blockIdx.x));
              EpiMerge<0> E{(bf16_t*)(ws + WS_MERGED), (const bf16_t*)(ws + WS_G)};
              pg8::gemm_phase<EpiMerge<0>, pg8::StaticOrder, true, true>(F.lds + RING_OFF, g, S, E, F.wave); }
            { pg8::Gemm g{(const bf16_t*)(ws + WS_YB), (const bf16_t*)(ws + WS_WB), M, D, PW_}; pg8::StaticOrder S; S.init(M, D, F.G, launder_s((int)blockIdx.x));
              EpiMerge<1> E{(bf16_t*)(ws + WS_MERGED), (const bf16_t*)(ws + WS_G)};
              pg8::gemm_phase<EpiMerge<1>, pg8::StaticOrder, true, true>(F.lds + RING_OFF, g, S, E, F.wave); }
            { pg8::Gemm g{(const bf16_t*)(ws + WS_QC), (const bf16_t*)(ws + WS_WC), M, D, CW}; pg8::StaticOrder S; S.init(M, D, F.G, launder_s((int)blockIdx.x));
              EpiMerge<2> E{(bf16_t*)(ws + WS_MERGED), (const bf16_t*)(ws + WS_G)};
              pg8::gemm_phase<EpiMerge<2>, pg8::StaticOrder, true, true>(F.lds + RING_OFF, g, S, E, F.wave); }
        }
#endif
        } SEAM(pb + 6);
        if (IN(pb + 7)) {
#if !((DIS_MASK >> 4) & 1)
 unsigned char* ws = launder_p(args.ws); bf16* hb = (bf16*)(ws + WS_HB); float* ss = (float*)(ws + WS_SS); (void)hb; (void)ss;
            pg8::Gemm g{(const bf16_t*)(ws + WS_MERGED), (const bf16_t*)(ws + WS_WOUT), M, D, D}; pg8::StaticOrder S; S.init(M, D, F.G, launder_s((int)blockIdx.x));
            for (int rep = (PROBE_PHASE == 9 ? 0 : 1); rep < 2; ++rep) { EpiResid E{args.out, args.out, hb, ss, 1.0f, (LAS float*)(F.lds + RING_BYTES), rep == 0 ? 1 : 0};
            pg8::gemm_phase<EpiResid, pg8::StaticOrder, true, true>(F.lds + RING_OFF, g, S, E, F.wave); }
#endif
        } SEAM(pb + 7);
        if (IN(pb + 8)) {
#if !((DIS_MASK >> 5) & 1)
 unsigned char* ws = launder_p(args.ws); bf16* hb = (bf16*)(ws + WS_HB); float* ss = (float*)(ws + WS_SS); (void)hb; (void)ss;
            pg8::Gemm g{hb, (const bf16_t*)(ws + WS_W2IN), M, 2 * DFF, D}; pg8::StaticOrder S; S.init(M, 2 * DFF, F.G, launder_s((int)blockIdx.x));
            EpiSwiglu E{(bf16_t*)(ws + WS_ACT), ss};
            for (int rep = (PROBE_PHASE == 2 ? 0 : 1); rep < 2; ++rep) pg8::gemm_phase<EpiSwiglu, pg8::StaticOrder, true, true>(F.lds + RING_OFF, g, S, E, F.wave);
#endif
        } SEAM(pb + 8);
        if (IN(pb + 9)) {
#if !((DIS_MASK >> 6) & 1)
 unsigned char* ws = launder_p(args.ws); bf16* hb = (bf16*)(ws + WS_HB); float* ss = (float*)(ws + WS_SS); (void)hb; (void)ss;
            pg8::Gemm g{(const bf16_t*)(ws + WS_ACT), (const bf16_t*)(ws + WS_W2OUT), M, D, DFF}; pg8::StaticOrder S; S.init(M, D, F.G, launder_s((int)blockIdx.x));
            for (int rep = (PROBE_PHASE == 3 ? 0 : 1); rep < 2; ++rep) { EpiResid E{args.out, args.out, hb, ss, 0.5f, (LAS float*)(F.lds + RING_BYTES), rep == 0 ? 1 : 0};
            pg8::gemm_phase<EpiResid, pg8::StaticOrder, true, true>(F.lds + RING_OFF, g, S, E, F.wave); }
#endif
        } SEAM(pb + 9);
    }
#if EN_P0
    if (IN(N_PHASES - 1)) { final_norm(KIN, args.out, args.ws, F.lds, F.wave, F.vcu, F.G); }
#endif
#undef IN
#undef SEAM
}

extern "C" void kernel_launch(void* const* d_in, const int* in_sizes, int n_in, void* d_out, int out_size, void* d_ws, size_t ws_size, hipStream_t stream) {
    static int grid = 0;
    if (grid == 0) {
        if (n_in != 23 || in_sizes[0] != M * D || out_size != M * D || ws_size < WS_END) { fprintf(stderr, "kernel_launch: unexpected shapes (n_in %d, ws %zu)\n", n_in, ws_size); grid = -1; return; }
        int dev = 0, cus = 0, per_cu = 0;
        if (hipGetDevice(&dev) != hipSuccess || hipDeviceGetAttribute(&cus, hipDeviceAttributeMultiprocessorCount, dev) != hipSuccess) { grid = -1; return; }
        if (hipFuncSetAttribute((const void*)mk_fwd, hipFuncAttributeMaxDynamicSharedMemorySize, LDS_BYTES) != hipSuccess) { fprintf(stderr, "kernel_launch: hipFuncSetAttribute failed\n"); grid = -1; return; }
        if (hipOccupancyMaxActiveBlocksPerMultiprocessor(&per_cu, (const void*)mk_fwd, NWAVES * 64, LDS_BYTES) != hipSuccess || per_cu < 1) { fprintf(stderr, "kernel_launch: occupancy query says %d\n", per_cu); }
        (void)hipGetLastError();
        grid = cus;
    }
    if (grid < 0) return;
    if (hipMemsetAsync((char*)d_ws + WS_CTL, 0, CTL_ZERO_BYTES, stream) != hipSuccess) return;
    Args a{};
    for (int i = 0; i < 23; ++i) a.in[i] = (const float*)d_in[i];
    a.out = (float*)d_out; a.ws = (unsigned char*)d_ws;
#if MK_ONE_LAUNCH
    a.ph_lo = 0; a.ph_hi = N_PHASES;
    hipLaunchKernelGGL(mk_fwd, dim3(grid), dim3(NWAVES * 64), LDS_BYTES, stream, a);
#endif
}
```

```cpp
#include <hip/hip_runtime.h>
#include <cstdio>
#include <cstdint>

#ifndef MK_ONE_LAUNCH
#define MK_ONE_LAUNCH 1
#endif
#ifndef PROBE_PHASE
#define PROBE_PHASE 0
#endif
#ifndef EN_P0
#define EN_P0 MK_ONE_LAUNCH
#endif
#ifndef EN_PREP
#define EN_PREP MK_ONE_LAUNCH
#endif
#ifndef EN_DSA
#define EN_DSA MK_ONE_LAUNCH
#endif
#ifndef DIS_MASK
#define DIS_MASK 0
#endif
#ifndef MK_ONE_LAUNCH
#define MK_ONE_LAUNCH 1
#endif

__device__ __forceinline__ int lane_id_v() { int l; asm volatile("v_mbcnt_lo_u32_b32 %0, -1, 0\n\tv_mbcnt_hi_u32_b32 %0, -1, %0" : "=v"(l)); return l; }
namespace pg8 {
#define PG8_LAS __attribute__((address_space(3)))
typedef unsigned short bf16_t;
typedef short bf16x8 __attribute__((ext_vector_type(8)));
typedef float f32x4 __attribute__((ext_vector_type(4)));
typedef unsigned u32x4 __attribute__((ext_vector_type(4)));
typedef unsigned u32x2 __attribute__((ext_vector_type(2)));
constexpr int BM = 256, BK = 64, HALF = 128, HTB = HALF * BK * 2, STAGE_BYTES = 8 * HTB, NXCD = 8, WGM = 8;

__host__ __device__ __forceinline__ int lds_byte(int r, int c) { const int st = (r >> 4) * 2 + (c >> 5), rr = r & 15, cc = c & 31, ob = rr * 64 + cc * 2; return st * 1024 + (ob ^ (((ob >> 9) & 1) << 5)); }
__host__ __device__ __forceinline__ void stage_rc(int b, int& R, int& C) { const int st = b / 1024, sb = b % 1024, swz = sb ^ (((sb >> 9) & 1) << 5); R = (st >> 1) * 16 + swz / 64; C = (st & 1) * 32 + (swz % 64) / 2; }
__host__ __device__ __forceinline__ int perm32(int rho) { const int n = rho >> 4, i = rho & 15; return 8 * (i >> 2) + 4 * n + (i & 3); }

struct Unit { int pm, pn; };
struct Gemm { const bf16_t* A; const bf16_t* Bt; int M, N, K; };

struct StaticOrder {
    int nM, nN, nwg, G, c;
    __host__ __device__ void init(int M, int N, int G_, int c_) { nM = M / BM; nN = N / BM; nwg = nM * nN; G = G_; c = c_; }
    __host__ __device__ bool next(int i, Unit& u) const {
        const long L = (long)i * G + c; if (L >= nwg) return false;
        int wgid = (int)L; { const int q = nwg / NXCD, r = nwg % NXCD, xcd = wgid % NXCD, off = wgid / NXCD; wgid = (xcd < r ? xcd * (q + 1) : r * (q + 1) + (xcd - r) * q) + off; }
        const int nig = WGM * nN, gid = wgid / nig, fm = gid * WGM, gsz = (nM - fm) < WGM ? (nM - fm) : WGM;
        u.pm = fm + ((wgid % nig) % gsz); u.pn = (wgid % nig) / gsz; return true;
    }
    __device__ __forceinline__ void a_ready(const Unit&) const {}
    __device__ __forceinline__ void done(const Unit&) const {}
};

__device__ __forceinline__ unsigned cvt_pk_bf16(float lo, float hi) { unsigned r; asm volatile("v_cvt_pk_bf16_f32 %0, %1, %2" : "=v"(r) : "v"(lo), "v"(hi)); return r; }

template <class Epi, class Sched, bool ALIGN_EPI = false, bool SP2 = false>
__device__ __forceinline__ void gemm_phase(PG8_LAS unsigned char* lds, const Gemm g, const Sched& S, const Epi& E, const int wid_) {
    int wid = wid_; asm volatile("" : "+s"(wid));
    const int lane = lane_id_v(), tid = wid * 64 + lane,
              wr = wid >> 2, wc = wid & 3, fr = lane & 15, fq = lane >> 4;
    const int K = g.K, nt = K / BK;
    unsigned voffA[2], voffB[2];
#pragma unroll
    for (int i = 0; i < 2; ++i) { int R, C; stage_rc(tid * 16 + i * 8192, R, C); const int Rb = Epi::PERM ? ((R & ~31) + perm32(R & 31)) : R;
        voffA[i] = (unsigned)(R * K + C) * 2u; voffB[i] = (unsigned)(Rb * K + C) * 2u; }
    const size_t kstep = (size_t)(BK * 2);
    const size_t hstep = (size_t)HALF * K * 2;
    const size_t tstep = 2 * hstep;
    const unsigned ldsw = (unsigned)wid * 1024u;
    const int aoff = lds_byte(wr * 64 + fr, fq * 8), boff = lds_byte(wc * 32 + fr, fq * 8);
#define PG8_SA(b, h) (((b) * 2 + (h)) * HTB)
#define PG8_SB(b, h) ((4 + (b) * 2 + (h)) * HTB)
#define PG8_STAGE(bufoff, gbase, voff) do { _Pragma("unroll") for (int _i = 0; _i < 2; ++_i) \
        __builtin_amdgcn_global_load_lds((const unsigned*)((const char*)(gbase) + (voff)[_i]), (PG8_LAS unsigned*)(lds + (bufoff) + ldsw + _i * 8192), 16, 0, 0); } while (0)
#define PG8_LDA(dst, b, h) do { _Pragma("unroll") for (int m = 0; m < 4; ++m) _Pragma("unroll") for (int k = 0; k < 2; ++k) dst[m][k] = *(const PG8_LAS bf16x8*)(lds + PG8_SA(b, h) + aoff + m * 2048 + k * 1024); } while (0)
#define PG8_LDB(dst, b, h) do { _Pragma("unroll") for (int n = 0; n < 2; ++n) _Pragma("unroll") for (int k = 0; k < 2; ++k) dst[n][k] = *(const PG8_LAS bf16x8*)(lds + PG8_SB(b, h) + boff + n * 2048 + k * 1024); } while (0)
#define PG8_MMA(ai, bj, At, Bt) do { __builtin_amdgcn_s_setprio(1); _Pragma("unroll") for (int m = 0; m < 4; ++m) _Pragma("unroll") for (int n = 0; n < 2; ++n) _Pragma("unroll") for (int k = 0; k < 2; ++k) \
        acc[ai][bj][m][n] = __builtin_amdgcn_mfma_f32_16x16x32_bf16(Bt[n][k], At[m][k], acc[ai][bj][m][n], 0, 0, 0); __builtin_amdgcn_s_setprio(0); } while (0)
#define PG8_WAIT_V(n) asm volatile("s_waitcnt vmcnt(" #n ")" ::: "memory")
#define PG8_WAIT_L(n) asm volatile("s_waitcnt lgkmcnt(" #n ")" ::: "memory")
#define PG8_BAR __builtin_amdgcn_s_barrier()
#define PG8_SCHED __builtin_amdgcn_sched_barrier(0)
    Unit cur, nxt; int ui = 0;
    if (!S.next(0, cur)) return;
    f32x4 acc[2][2][4][2];
#pragma unroll
    for (int a = 0; a < 2; ++a)
#pragma unroll
        for (int b = 0; b < 2; ++b)
#pragma unroll
            for (int m = 0; m < 4; ++m)
#pragma unroll
                for (int n = 0; n < 2; ++n) acc[a][b][m][n] = (f32x4){0.f, 0.f, 0.f, 0.f};
    bf16x8 At[4][2], B0[2][2], B1[2][2];
    const char* cA = (const char*)g.A + (size_t)cur.pm * tstep; const char* cB = (const char*)g.Bt + (size_t)cur.pn * tstep;
    S.a_ready(cur);
    if constexpr (SP2) {
        PG8_STAGE(PG8_SB(0, 0), cB, voffB); PG8_STAGE(PG8_SB(0, 1), cB + hstep, voffB); PG8_STAGE(PG8_SA(0, 0), cA, voffA); PG8_STAGE(PG8_SA(0, 1), cA + hstep, voffA);
        if (wr == 1) PG8_BAR;
        PG8_WAIT_V(2); PG8_BAR;
        PG8_STAGE(PG8_SB(1, 0), cB + kstep, voffB); PG8_STAGE(PG8_SA(1, 0), cA + kstep, voffA); PG8_STAGE(PG8_SB(1, 1), cB + hstep + kstep, voffB);
        PG8_WAIT_V(6); PG8_BAR;
    } else {
        PG8_STAGE(PG8_SB(0, 0), cB, voffB); PG8_STAGE(PG8_SA(0, 0), cA, voffA); PG8_STAGE(PG8_SB(0, 1), cB + hstep, voffB); PG8_STAGE(PG8_SA(0, 1), cA + hstep, voffA);
        if (wr == 1) PG8_BAR;
        PG8_WAIT_V(4); PG8_BAR;
        PG8_STAGE(PG8_SB(1, 0), cB + kstep, voffB); PG8_STAGE(PG8_SA(1, 0), cA + kstep, voffA); PG8_STAGE(PG8_SB(1, 1), cB + hstep + kstep, voffB);
        PG8_WAIT_V(6); PG8_BAR;
    }
    for (;;) {
        const bool has_next = S.next(ui + 1, nxt);
        const char* nA = has_next ? (const char*)g.A + (size_t)nxt.pm * tstep : cA; const char* nB = has_next ? (const char*)g.Bt + (size_t)nxt.pn * tstep : cB;
#pragma nounroll
        for (int t = 0; t < nt; t += 2) {
            const bool last = (t == nt - 2);
            const char* a1 = cA + (size_t)(t + 1) * kstep;
            const char* a2 = last ? nA : cA + (size_t)(t + 2) * kstep; const char* b2 = last ? nB : cB + (size_t)(t + 2) * kstep;
            const char* a3 = a2 + kstep; const char* b3 = b2 + kstep;
            if (last && has_next) S.a_ready(nxt);
            if constexpr (SP2) {
            PG8_LDB(B0, 0, 0); PG8_LDB(B1, 0, 1); PG8_SCHED; PG8_LDA(At, 0, 0); PG8_STAGE(PG8_SA(1, 1), a1 + hstep, voffA);
            PG8_WAIT_V(8); PG8_WAIT_L(0); PG8_BAR; PG8_MMA(0, 0, At, B0); PG8_MMA(0, 1, At, B1); PG8_BAR; PG8_SCHED;
            PG8_LDA(At, 0, 1); PG8_STAGE(PG8_SB(0, 0), b2, voffB); PG8_STAGE(PG8_SB(0, 1), b2 + hstep, voffB); PG8_STAGE(PG8_SA(0, 0), a2, voffA);
            PG8_WAIT_V(8); PG8_WAIT_L(0); PG8_BAR; PG8_MMA(1, 0, At, B0); PG8_MMA(1, 1, At, B1); PG8_BAR; PG8_SCHED;
            PG8_LDB(B0, 1, 0); PG8_LDB(B1, 1, 1); PG8_SCHED; PG8_LDA(At, 1, 0); PG8_STAGE(PG8_SA(0, 1), a2 + hstep, voffA);
            PG8_WAIT_V(8); PG8_WAIT_L(0); PG8_BAR; PG8_MMA(0, 0, At, B0); PG8_MMA(0, 1, At, B1); PG8_BAR; PG8_SCHED;
            PG8_LDA(At, 1, 1); PG8_STAGE(PG8_SB(1, 0), b3, voffB); PG8_STAGE(PG8_SB(1, 1), b3 + hstep, voffB); PG8_STAGE(PG8_SA(1, 0), a3, voffA);
            PG8_WAIT_V(8); PG8_WAIT_L(0); PG8_BAR; PG8_MMA(1, 0, At, B0); PG8_MMA(1, 1, At, B1); PG8_BAR; PG8_SCHED;
            } else {
            PG8_LDB(B0, 0, 0); PG8_SCHED; PG8_LDA(At, 0, 0); PG8_STAGE(PG8_SA(1, 1), a1 + hstep, voffA);
            PG8_WAIT_L(8); PG8_BAR; PG8_WAIT_L(0); PG8_MMA(0, 0, At, B0); PG8_BAR; PG8_SCHED;
            PG8_LDB(B1, 0, 1); PG8_STAGE(PG8_SB(0, 0), b2, voffB);
            PG8_BAR; PG8_WAIT_L(0); PG8_MMA(0, 1, At, B1); PG8_BAR;
            PG8_LDA(At, 0, 1); PG8_STAGE(PG8_SA(0, 0), a2, voffA);
            PG8_BAR; PG8_WAIT_L(0); PG8_MMA(1, 0, At, B0); PG8_BAR; PG8_SCHED;
            PG8_STAGE(PG8_SB(0, 1), b2 + hstep, voffB);
            PG8_WAIT_V(6); PG8_BAR; PG8_MMA(1, 1, At, B1); PG8_BAR;
            PG8_LDB(B0, 1, 0); PG8_SCHED; PG8_LDA(At, 1, 0); PG8_STAGE(PG8_SA(0, 1), a2 + hstep, voffA);
            PG8_WAIT_L(8); PG8_BAR; PG8_WAIT_L(0); PG8_MMA(0, 0, At, B0); PG8_BAR; PG8_SCHED;
            PG8_LDB(B1, 1, 1); PG8_STAGE(PG8_SB(1, 0), b3, voffB);
            PG8_BAR; PG8_WAIT_L(0); PG8_MMA(0, 1, At, B1); PG8_BAR;
            PG8_LDA(At, 1, 1); PG8_STAGE(PG8_SA(1, 0), a3, voffA);
            PG8_BAR; PG8_WAIT_L(0); PG8_MMA(1, 0, At, B0); PG8_BAR; PG8_SCHED;
            PG8_STAGE(PG8_SB(1, 1), b3 + hstep, voffB);
            PG8_WAIT_V(6); PG8_BAR; PG8_MMA(1, 1, At, B1); PG8_BAR;
            }
        }
        if constexpr (ALIGN_EPI) { if (wr == 0) PG8_BAR; }
        E(acc, cur, wr, wc, fr, fq); S.done(cur);
        if (!has_next) break;
#pragma unroll
        for (int a = 0; a < 2; ++a)
#pragma unroll
            for (int b = 0; b < 2; ++b)
#pragma unroll
                for (int m = 0; m < 4; ++m)
#pragma unroll
                    for (int n = 0; n < 2; ++n) acc[a][b][m][n] = (f32x4){0.f, 0.f, 0.f, 0.f};
        cur = nxt; cA = nA; cB = nB; ++ui;
        if constexpr (ALIGN_EPI) { if (wr == 1) PG8_BAR; }
    }
    PG8_WAIT_V(0);
    if constexpr (!ALIGN_EPI) { if (wr == 0) PG8_BAR; }
    PG8_BAR;
#undef PG8_SA
#undef PG8_SB
#undef PG8_STAGE
#undef PG8_LDA
#undef PG8_LDB
#undef PG8_MMA
#undef PG8_WAIT_V
#undef PG8_WAIT_L
#undef PG8_BAR
#undef PG8_SCHED
}
}

constexpr int NWAVES = 8;
constexpr int BATCH = 4, SEQ = 8192, D = 1024, DEPTH = 4, M = BATCH * SEQ;
constexpr int NMEM = 256, MROWS = BATCH * NMEM;
constexpr int AH = 8, AHD = 64, AW = 512, KVR = 128, IH = 8, IDIM = 32, TOPK = 256;
constexpr int PW_ = 256, CH = 4, CHD = 64, CW = 256;
constexpr int DFF = 2816, INW = 4520, INP = 5120;
constexpr float EPS = 1e-6f;
constexpr int C_QA = 0, C_CKV = 512, C_IQ = 640, C_IK = 896, C_IW = 928, C_Z = 936, C_QC = 1192, C_G = 1448;

constexpr size_t MiB = 1u << 20;
constexpr size_t WS_CTL = 0, CTL_ZERO_BYTES = 1 * MiB;
constexpr size_t WS_SS = 1 * MiB;
constexpr size_t WS_IW = 3 * MiB;
constexpr size_t WS_SGN = 4 * MiB;
constexpr size_t WS_MEMN = 5 * MiB;
constexpr size_t WS_WMEM = 7 * MiB;
constexpr size_t WS_MEMKV = 11 * MiB;
constexpr size_t WS_W1IN = 15 * MiB, WS_W1OUT = 26 * MiB, WS_WIN = 32 * MiB, WS_WA = 42 * MiB, WS_WB = 44 * MiB, WS_WC = 44 * MiB + 512 * 1024, WS_WOUT = 45 * MiB, WS_W2IN = 47 * MiB, WS_W2OUT = 58 * MiB;
constexpr size_t WS_HB = 64 * MiB;
constexpr size_t WS_ACT = 128 * MiB;
constexpr size_t WS_G = 128 * MiB;
constexpr size_t WS_QL = 320 * MiB;
constexpr size_t WS_CKV = 384 * MiB;
constexpr size_t WS_CKVRAW = 392 * MiB;
constexpr size_t WS_IQRAW = 408 * MiB;
constexpr size_t WS_IQF = 424 * MiB;
constexpr size_t WS_IK = 440 * MiB;
constexpr size_t WS_Z = 442 * MiB;
constexpr size_t WS_MERGED = 384 * MiB;
constexpr size_t WS_YB = 458 * MiB;
constexpr size_t WS_QC = 474 * MiB;
constexpr size_t WS_SEL = 490 * MiB;
constexpr size_t WS_VT = 506 * MiB;
constexpr size_t WS_WPT = 4 * MiB + 512 * 1024;
constexpr size_t WS_END = 510 * MiB;
constexpr int CW_BAR = 4096;

constexpr int RING_OFF = 0, RING_BYTES = 131072;
constexpr int LDS_BYTES = 155648;
constexpr int MISC_OFF = LDS_BYTES - 256;

#define GAS __attribute__((address_space(1)))
#define LAS __attribute__((address_space(3)))
typedef unsigned short bf16;
typedef unsigned v4u __attribute__((ext_vector_type(4)));
typedef unsigned v2u __attribute__((ext_vector_type(2)));
typedef float f32x4 __attribute__((ext_vector_type(4)));
typedef float f32x2 __attribute__((ext_vector_type(2)));
typedef GAS unsigned gu32;
#define RLX_AGENT __ATOMIC_RELAXED, __HIP_MEMORY_SCOPE_AGENT
#define LDS_WAIT() asm volatile("s_waitcnt lgkmcnt(0)" ::: "memory")
#define VM_WAIT() asm volatile("s_waitcnt vmcnt(0)" ::: "memory")
__device__ __forceinline__ unsigned f2bf(float f) { unsigned u = __builtin_bit_cast(unsigned, f); return (u + 0x7fffu + ((u >> 16) & 1u)) >> 16; }
__device__ __forceinline__ unsigned pk2(float lo, float hi) { return pg8::cvt_pk_bf16(lo, hi); }
__device__ __forceinline__ float bflo(unsigned w) { return __builtin_bit_cast(float, w << 16); }
__device__ __forceinline__ float bfhi(unsigned w) { return __builtin_bit_cast(float, w & 0xffff0000u); }
typedef _Float16 h2_t __attribute__((ext_vector_type(2)));
typedef _Float16 f16x8_t __attribute__((ext_vector_type(8)));
__device__ __forceinline__ unsigned pkh2(float lo, float hi) { const h2_t v = {(_Float16)lo, (_Float16)hi}; return __builtin_bit_cast(unsigned, v); }
__device__ __forceinline__ float hlo(unsigned w) { return (float)__builtin_bit_cast(h2_t, w)[0]; }
__device__ __forceinline__ float hhi(unsigned w) { return (float)__builtin_bit_cast(h2_t, w)[1]; }
__device__ __forceinline__ float bf2f(bf16 b) { return __builtin_bit_cast(float, ((unsigned)b) << 16); }

#define XB_TMO      128
#define XB_XCNT(j)  (256  + 64 * (j))
#define XB_XSUB(j)  (1280 + 64 * (j))
#define XB_XGEN(j)  (2304 + 64 * (j))
#define XB_TOP      3328
#define XB_TOPGEN   3392
#define XCD_BAR_WORDS 3456
#define XB_SPIN_CAP (1u << 23)

__device__ __forceinline__ unsigned xb_ld(unsigned* p)              { return __hip_atomic_load(p, __ATOMIC_RELAXED, __HIP_MEMORY_SCOPE_AGENT); }
__device__ __forceinline__ unsigned xb_add(unsigned* p, unsigned v) { return __hip_atomic_fetch_add(p, v, __ATOMIC_RELAXED, __HIP_MEMORY_SCOPE_AGENT); }
__device__ __forceinline__ unsigned xb_xcc_id() { return (unsigned)__builtin_amdgcn_s_getreg((3 << 11) | 20) & 0xFu; }
#define XB_SPIN(cond, bar) do { unsigned _sp = 0; while (cond) { __builtin_amdgcn_s_sleep(1); \
    if ((++_sp & 255u) == 0u) { if (xb_ld(&(bar)[XB_TMO])) break; if (_sp > XB_SPIN_CAP) { atomicAdd(&(bar)[XB_TMO], 1u); break; } } } } while (0)

struct XcdBarrier { unsigned* bar; unsigned x; volatile LAS unsigned* st; int wave; };

__device__ __forceinline__ XcdBarrier xcd_barrier_post(unsigned* bar, volatile LAS unsigned* st, int wave) {
    XcdBarrier b; b.bar = bar; b.x = xb_xcc_id(); b.st = st; b.wave = wave;
    if (threadIdx.x == 0) (void)xb_add(&bar[XB_XCNT(b.x)], 1u);
    return b;
}
__device__ __forceinline__ void xcd_barrier_complete(unsigned* bar, unsigned x, unsigned& nloc, unsigned& nx) {
    const unsigned G = gridDim.x * gridDim.y * gridDim.z;
    unsigned sum, cnt, mine, sp = 0u;
    for (;;) {
        sum = 0u; cnt = 0u; mine = 0u;
#pragma unroll
        for (unsigned j = 0; j < 16; ++j) { const unsigned c = xb_ld(&bar[XB_XCNT(j)]); sum += c; cnt += (c > 0u) ? 1u : 0u; mine = (j == x) ? c : mine; }
        if (sum == G) break;
        __builtin_amdgcn_s_sleep(1);
        if ((++sp & 255u) == 0u) { if (xb_ld(&bar[XB_TMO])) break; if (sp > XB_SPIN_CAP) { atomicAdd(&bar[XB_TMO], 1u); break; } }
    }
    nloc = mine > 0u ? mine : 1u; nx = cnt > 0u ? cnt : 1u;
}
__device__ __forceinline__ void xcd_barrier(const XcdBarrier& b) {
    asm volatile("s_waitcnt vmcnt(0)" ::: "memory");
    __syncthreads();
    int bw_ = b.wave; asm volatile("" : "+s"(bw_));
    if (bw_ == 0 && lane_id_v() == 0) {
        unsigned* bar = b.bar;
        __builtin_amdgcn_s_waitcnt(0);
        unsigned nloc = b.st[0], nx = b.st[1];
        if (nloc == 0u) { xcd_barrier_complete(bar, b.x, nloc, nx); b.st[0] = nloc; b.st[1] = nx; }
        const unsigned old = xb_add(&bar[XB_XSUB(b.x)], 1u);
        const unsigned gen = old / nloc;
        if (old + 1u == (gen + 1u) * nloc) {
            __builtin_amdgcn_fence(__ATOMIC_RELEASE, "agent");
            asm volatile("s_waitcnt vmcnt(0)" ::: "memory");
            const unsigned og = xb_add(&bar[XB_TOP], 1u);
            const unsigned tg = og / nx;
            if (og + 1u == (tg + 1u) * nx) xb_add(&bar[XB_TOPGEN], 1u);
            else XB_SPIN(xb_ld(&bar[XB_TOPGEN]) == tg, bar);
            __builtin_amdgcn_fence(__ATOMIC_ACQUIRE, "agent");
            xb_add(&bar[XB_XGEN(b.x)], 1u);
            asm volatile("s_waitcnt vmcnt(0)" ::: "memory");
        } else {
            XB_SPIN(xb_ld(&bar[XB_XGEN(b.x)]) == gen, bar);
            __builtin_amdgcn_fence(__ATOMIC_ACQUIRE, "agent");
            asm volatile("s_waitcnt vmcnt(0)" ::: "memory");
        }
    }
    __syncthreads();
}

struct Args {
    const float* in[23]; float* out; unsigned char* ws; int ph_lo, ph_hi;
};
template <class T> __device__ __forceinline__ T* uni(T* p) { const unsigned long long v = (unsigned long long)p; const unsigned lo = __builtin_amdgcn_readfirstlane((unsigned)v), hi = __builtin_amdgcn_readfirstlane((unsigned)(v >> 32)); return (T*)(((unsigned long long)hi << 32) | lo); }
__device__ __forceinline__ LAS unsigned char* uni_l(LAS unsigned char* p) { return (LAS unsigned char*)(unsigned)__builtin_amdgcn_readfirstlane((int)(unsigned)(size_t)p); }
__device__ __forceinline__ int uni_i(int v) { return __builtin_amdgcn_readfirstlane(v); }
struct PC { const float* const* in; float* out; unsigned char* ws; LAS unsigned char* lds; int wave, vcu, G; };
struct Frame {
    LAS unsigned char* lds;
    volatile LAS unsigned* MISC;
    gu32* ctl;
    int wave, vcu, G;
    unsigned char* ws;
};
__device__ __forceinline__ unsigned char* launder_p(unsigned char* p) { asm volatile("" : "+s"(p)); return p; }
__device__ __forceinline__ int launder_s(int v) { asm volatile("" : "+s"(v)); return v; }
__device__ __forceinline__ int launder_v(int v) { asm volatile("" : "+v"(v)); return v; }
__device__ __forceinline__ float wave_sum(float v) {
#pragma unroll
    for (int o = 1; o < 64; o <<= 1) v += __shfl_xor(v, o);
    return v;
}
__device__ __forceinline__ float wave_max(float v) {
#pragma unroll
    for (int o = 1; o < 64; o <<= 1) v = fmaxf(v, __shfl_xor(v, o));
    return v;
}

using pg8::Unit; using pg8::bf16_t;
#define LAUNDER2(a, b) asm volatile("" : "+v"(a), "+v"(b))
__device__ __forceinline__ float row_scale(const float* ss, int row) {
    const f32x4 a = *(const f32x4*)(ss + (size_t)row * 4);
    const float s = (a.x + a.y) + (a.z + a.w);
    return __builtin_amdgcn_rsqf(s * (1.0f / D) + EPS);
}
__device__ __forceinline__ float sigmoidf_(float x) { return __builtin_amdgcn_rcpf(1.0f + __expf(-x)); }
__device__ __forceinline__ pg8::u32x2 pack4(const f32x4 v) { pg8::u32x2 w; w.x = pg8::cvt_pk_bf16(v[0], v[1]); w.y = pg8::cvt_pk_bf16(v[2], v[3]); return w; }

struct EpiSwiglu {
    static constexpr bool PERM = true;
    bf16_t* O; const float* ss;
    __device__ __forceinline__ void operator()(const f32x4 (&acc)[2][2][4][2], const Unit& u, int wr, int wc, int fr_, int fq_) const {
        const int l_ = lane_id_v(); const int fr = l_ & 15, fq = l_ >> 4; (void)fr_; (void)fq_;
        int rb = wr * 64 + fr, cb = wc * 32 + 8 * fq; LAUNDER2(rb, cb);
        const int row0 = u.pm * 256 + rb, col0 = u.pn * 128 + cb;
#pragma unroll
        for (int ai = 0; ai < 2; ++ai)
#pragma unroll
            for (int m = 0; m < 4; ++m) { const int row = row0 + ai * 128 + m * 16;
                const f32x4 sq = *(const f32x4*)(ss + (size_t)row * 4); const float k = ((sq.x + sq.y) + (sq.z + sq.w)) * (1.0f / D) + EPS; const float c1 = __builtin_amdgcn_rsqf(k) * -1.4426950408889634f;
                pg8::u32x4 w;
                { const f32x4 a = acc[ai][0][m][0], b = acc[ai][1][m][0]; f32x4 o;
#pragma unroll
                  for (int i = 0; i < 4; ++i) o[i] = (a[i] * b[i]) * __builtin_amdgcn_rcpf(fmaf(__builtin_amdgcn_exp2f(a[i] * c1), k, k));
                  w.x = pg8::cvt_pk_bf16(o[0], o[1]); w.y = pg8::cvt_pk_bf16(o[2], o[3]); }
                { const f32x4 a = acc[ai][0][m][1], b = acc[ai][1][m][1]; f32x4 o;
#pragma unroll
                  for (int i = 0; i < 4; ++i) o[i] = (a[i] * b[i]) * __builtin_amdgcn_rcpf(fmaf(__builtin_amdgcn_exp2f(a[i] * c1), k, k));
                  w.z = pg8::cvt_pk_bf16(o[0], o[1]); w.w = pg8::cvt_pk_bf16(o[2], o[3]); }
                *(pg8::u32x4*)(O + (size_t)row * DFF + col0) = w; }
    }
};
struct EpiResid {
    static constexpr bool PERM = true;
    const float* base; float* out; bf16_t* hb; float* ss; float alpha; LAS float* P; int dry;
    __device__ __forceinline__ void operator()(const f32x4 (&acc)[2][2][4][2], const Unit& u, int wr, int wc, int fr_, int fq_) const {
        const int l_ = lane_id_v(); const int fr = l_ & 15, fq = l_ >> 4; (void)fr_; (void)fq_;
        int rb = wr * 64 + fr, cb = wc * 32 + 8 * fq; LAUNDER2(rb, cb);
        const int row0 = u.pm * 256 + rb, col0 = u.pn * 256 + cb;
#pragma unroll
        for (int ai = 0; ai < 2; ++ai)
#pragma unroll
          for (int mh = 0; mh < 2; ++mh) {
            f32x4 bs[2][2][2];
#pragma unroll
            for (int mm = 0; mm < 2; ++mm) { const size_t off = (size_t)(row0 + ai * 128 + (2 * mh + mm) * 16) * D + col0;
#pragma unroll
                for (int bj = 0; bj < 2; ++bj)
#pragma unroll
                    for (int n = 0; n < 2; ++n) bs[mm][bj][n] = *(const f32x4*)(base + off + bj * 128 + n * 4); }
#pragma unroll
            for (int mm = 0; mm < 2; ++mm) { const int m = 2 * mh + mm; const int row = row0 + ai * 128 + m * 16; const size_t off = (size_t)row * D + col0; float q = 0.f;
#pragma unroll
                for (int bj = 0; bj < 2; ++bj) { const f32x4 v0 = bs[mm][bj][0] + acc[ai][bj][m][0] * alpha, v1 = bs[mm][bj][1] + acc[ai][bj][m][1] * alpha;
                    if (!dry) { *(f32x4*)(out + off + bj * 128) = v0; *(f32x4*)(out + off + bj * 128 + 4) = v1;
                        pg8::u32x4 w; w.x = pg8::cvt_pk_bf16(v0[0], v0[1]); w.y = pg8::cvt_pk_bf16(v0[2], v0[3]); w.z = pg8::cvt_pk_bf16(v1[0], v1[1]); w.w = pg8::cvt_pk_bf16(v1[2], v1[3]);
                        *(pg8::u32x4*)(hb + off + bj * 128) = w; }
                    q += ((v0[0] * v0[0] + v0[1] * v0[1]) + (v0[2] * v0[2] + v0[3] * v0[3])) + ((v1[0] * v1[0] + v1[1] * v1[1]) + (v1[2] * v1[2] + v1[3] * v1[3])); }
                q += __shfl_xor(q, 16); q += __shfl_xor(q, 32);
                if (fq == 0) P[(rb + ai * 128 + m * 16) * 4 + wc] = q; }
            asm volatile("" ::: "memory"); }
        asm volatile("s_waitcnt lgkmcnt(0)" ::: "memory"); __builtin_amdgcn_s_barrier(); asm volatile("" ::: "memory");
        const int tid = (wr * 4 + wc) * 64 + fq * 16 + fr;
        if (tid < 256 && !dry) { const f32x4 p = *(const LAS f32x4*)(P + tid * 4); ss[(size_t)(u.pm * 256 + tid) * 4 + u.pn] = (p.x + p.y) + (p.z + p.w); }
    }
};
struct EpiPlainBf16 {
    static constexpr bool PERM = false;
    bf16_t* O; int ldo;
    __device__ __forceinline__ void operator()(const f32x4 (&acc)[2][2][4][2], const Unit& u, int wr, int wc, int fr_, int fq_) const {
        const int l_ = lane_id_v(); const int fr = l_ & 15, fq = l_ >> 4; (void)fr_; (void)fq_;
        int rb = wr * 64 + fr, cb = wc * 32 + 4 * fq; LAUNDER2(rb, cb);
        const int row0 = u.pm * 256 + rb, col0 = u.pn * 256 + cb;
#pragma unroll
        for (int ai = 0; ai < 2; ++ai)
#pragma unroll
            for (int m = 0; m < 4; ++m) { bf16_t* rowp = O + (size_t)(row0 + ai * 128 + m * 16) * ldo + col0;
#pragma unroll
                for (int bj = 0; bj < 2; ++bj)
#pragma unroll
                    for (int n = 0; n < 2; ++n) *(pg8::u32x2*)(rowp + bj * 128 + n * 16) = pack4(acc[ai][bj][m][n]); }
    }
};
struct EpiInProj {
    static constexpr bool PERM = true;
    const float* ss; bf16_t* qa; float* ckvraw; bf16_t* ik; float* iw; bf16_t* iqraw; bf16_t* z; bf16_t* qc; bf16_t* G;
    __device__ __forceinline__ void operator()(const f32x4 (&acc)[2][2][4][2], const Unit& u, int wr, int wc, int fr_, int fq_) const {
        const int l_ = lane_id_v(); const int fr = l_ & 15, fq = l_ >> 4; (void)fr_; (void)fq_;
        int rb = wr * 64 + fr, ct = wc * 32 + 8 * fq; LAUNDER2(rb, ct);
        const int row0 = u.pm * 256 + rb; const int pn = u.pn;
        if (pn == 4) {
#pragma unroll
            for (int ai = 0; ai < 2; ++ai)
#pragma unroll
                for (int m = 0; m < 4; ++m) { const int row = row0 + ai * 128 + m * 16; const float s = row_scale(ss, row);
#pragma unroll
                    for (int n = 0; n < 2; ++n) *(f32x4*)(ckvraw + (size_t)row * KVR + ct + n * 4) = acc[ai][0][m][n] * s;
                    if (wc == 0) { const f32x4 k0 = acc[ai][1][m][0] * s, k1 = acc[ai][1][m][1] * s; pg8::u32x4 w; w.x = pkh2(k0[0], k0[1]); w.y = pkh2(k0[2], k0[3]); w.z = pkh2(k1[0], k1[1]); w.w = pkh2(k1[2], k1[3]);
                        *(pg8::u32x4*)(ik + (size_t)row * IDIM + 8 * fq) = w; }
                    if (wc == 1 && fq == 0) { *(f32x4*)(iw + (size_t)row * IH) = acc[ai][1][m][0] * s; *(f32x4*)(iw + (size_t)row * IH + 4) = acc[ai][1][m][1] * s; } }
        } else {
            bf16_t* dst0; int ld; bool sig = false; const bool f16out = (pn == 5);
            if (pn < 4) { dst0 = qa + pn * 256; ld = 1024; } else if (pn == 5) { dst0 = iqraw; ld = 256; } else if (pn == 6) { dst0 = z; ld = 256; } else if (pn == 7) { dst0 = qc; ld = 256; } else { dst0 = G + (pn - 8) * 256; ld = 3072; sig = true; }
#pragma unroll
            for (int ai = 0; ai < 2; ++ai)
#pragma unroll
                for (int m = 0; m < 4; ++m) { const int row = row0 + ai * 128 + m * 16; const float s = row_scale(ss, row); bf16_t* rowp = dst0 + (size_t)row * ld + ct;
#pragma unroll
                    for (int bj = 0; bj < 2; ++bj) { f32x4 o0 = acc[ai][bj][m][0] * s, o1 = acc[ai][bj][m][1] * s;
                        if (sig) {
#pragma unroll
                            for (int i = 0; i < 4; ++i) { o0[i] = sigmoidf_(o0[i]); o1[i] = sigmoidf_(o1[i]); } }
                        pg8::u32x4 wo;
                        if (f16out) { wo.x = pkh2(o0[0], o0[1]); wo.y = pkh2(o0[2], o0[3]); wo.z = pkh2(o1[0], o1[1]); wo.w = pkh2(o1[2], o1[3]); }
                        else { wo.x = pg8::cvt_pk_bf16(o0[0], o0[1]); wo.y = pg8::cvt_pk_bf16(o0[2], o0[3]); wo.z = pg8::cvt_pk_bf16(o1[0], o1[1]); wo.w = pg8::cvt_pk_bf16(o1[2], o1[3]); }
                        *(pg8::u32x4*)(rowp + bj * 128) = wo; } }
        }
    }
};
template <int MODE> struct EpiMerge {
    static constexpr bool PERM = true;
    bf16_t* Mg; const bf16_t* G;
    __device__ __forceinline__ void operator()(const f32x4 (&acc)[2][2][4][2], const Unit& u, int wr, int wc, int fr_, int fq_) const {
        const int l_ = lane_id_v(); const int fr = l_ & 15, fq = l_ >> 4; (void)fr_; (void)fq_;
        int rb = wr * 64 + fr, cb = wc * 32 + 8 * fq; LAUNDER2(rb, cb);
        const int row0 = u.pm * 256 + rb, col0 = u.pn * 256 + cb;
#pragma unroll
        for (int ai = 0; ai < 2; ++ai)
#pragma unroll
          for (int mh = 0; mh < 1; ++mh) {
            pg8::u32x4 gw[4][2], pw[4][2];
#pragma unroll
            for (int mm = 0; mm < 4; ++mm) { const int row = row0 + ai * 128 + mm * 16;
#pragma unroll
                for (int bj = 0; bj < 2; ++bj) { gw[mm][bj] = *(const pg8::u32x4*)(G + (size_t)row * 3072 + MODE * 1024 + col0 + bj * 128);
                    if (MODE > 0) pw[mm][bj] = *(const pg8::u32x4*)(Mg + (size_t)row * D + col0 + bj * 128); } }
#pragma unroll
            for (int mm = 0; mm < 4; ++mm) { const int m = mm; const int row = row0 + ai * 128 + m * 16;
#pragma unroll
                for (int bj = 0; bj < 2; ++bj) { const pg8::u32x4 g4 = gw[mm][bj];
                    f32x4 o0 = acc[ai][bj][m][0], o1 = acc[ai][bj][m][1];
                    o0[0] *= bflo(g4.x); o0[1] *= bfhi(g4.x); o0[2] *= bflo(g4.y); o0[3] *= bfhi(g4.y); o1[0] *= bflo(g4.z); o1[1] *= bfhi(g4.z); o1[2] *= bflo(g4.w); o1[3] *= bfhi(g4.w);
                    if (MODE > 0) { const pg8::u32x4 p4 = pw[mm][bj];
                        o0[0] += bflo(p4.x); o0[1] += bfhi(p4.x); o0[2] += bflo(p4.y); o0[3] += bfhi(p4.y); o1[0] += bflo(p4.z); o1[1] += bfhi(p4.z); o1[2] += bflo(p4.w); o1[3] += bfhi(p4.w); }
                    pg8::u32x4 w; w.x = pg8::cvt_pk_bf16(o0[0], o0[1]); w.y = pg8::cvt_pk_bf16(o0[2], o0[3]); w.z = pg8::cvt_pk_bf16(o1[0], o1[1]); w.w = pg8::cvt_pk_bf16(o1[2], o1[3]);
                    *(pg8::u32x4*)(Mg + (size_t)row * D + col0 + bj * 128) = w; } }
            asm volatile("" ::: "memory"); }
    }
};

template <class Map>
__device__ __forceinline__ void transpose_item(const float* W, int K, int N, const float* gain, bf16* WT, LAS float* scr, int item, int lane, Map map) {
    const int nblk = (N + 63) / 64, kb = item / nblk, nb = item % nblk, k0 = 64 * kb, n0 = 64 * nb;
    const int nn = n0 + 4 * (lane & 15); const bool nok = nn < N;
#pragma unroll 4
    for (int i = 0; i < 16; ++i) { const int kk = 4 * i + (lane >> 4); f32x4 v = nok ? *(const f32x4*)(W + (size_t)(k0 + kk) * N + nn) : (f32x4){0.f, 0.f, 0.f, 0.f};
        if (gain) v = v * gain[k0 + kk];
        *(LAS f32x4*)(scr + kk * 68 + 4 * (lane & 15)) = v; }
    LDS_WAIT(); asm volatile("" ::: "memory");
    const int c = lane & 7;
#pragma unroll
    for (int j = 0; j < 8; ++j) { const int n = (lane >> 3) + 8 * j; const LAS float* sp = scr + (8 * c) * 68 + n;
        v4u o; o.x = pk2(sp[0 * 68], sp[1 * 68]); o.y = pk2(sp[2 * 68], sp[3 * 68]); o.z = pk2(sp[4 * 68], sp[5 * 68]); o.w = pk2(sp[6 * 68], sp[7 * 68]);
        if (n0 + n < N) { const int dr = map(n0 + n); if (dr >= 0) *(GAS v4u*)(WT + (size_t)dr * K + k0 + 8 * c) = o; } }
    LDS_WAIT(); asm volatile("" ::: "memory");
}
struct MapId { int off; __device__ __forceinline__ int operator()(int n) const { return off + n; } };
struct MapSwiglu { __device__ __forceinline__ int operator()(int c) const { const int half = c >= DFF ? 1 : 0, j = c - half * DFF; return 256 * (j >> 7) + 128 * half + (j & 127); } };
struct MapInProj { __device__ __forceinline__ int operator()(int c) const {
    if (c < C_CKV) return -1;
    if (c < C_IQ) return 1024 + (c - C_CKV);
    if (c < C_IK) return 1280 + (c - C_IQ);
    if (c < C_IW) return 1152 + (c - C_IK);
    if (c < C_Z) return 1184 + (c - C_IW);
    if (c < C_QC) return 1536 + (c - C_Z);
    if (c < C_G) return 1792 + (c - C_QC);
    return 2048 + (c - C_G); } };
__device__ __forceinline__ void qlat_item(const float* win, const float* mixn, const float* wuk, bf16* WT, int item, int lane) {
    const int kc = item & 127, rh = (item >> 7) & 1, h = item >> 8; const int r = rh * 64 + lane;
    const f32x4* wp = (const f32x4*)(wuk + (size_t)r * (AH * AHD) + h * 64);
    float acc[8] = {0.f, 0.f, 0.f, 0.f, 0.f, 0.f, 0.f, 0.f};
#pragma unroll 1
    for (int dc = 0; dc < 4; ++dc) {
        const f32x4 w0 = wp[4 * dc], w1 = wp[4 * dc + 1], w2 = wp[4 * dc + 2], w3 = wp[4 * dc + 3];
#pragma unroll
        for (int kk = 0; kk < 8; ++kk) { const f32x4* ip = (const f32x4*)(win + (size_t)(kc * 8 + kk) * INW + h * 64 + 16 * dc);
            const f32x4 a0 = ip[0], a1 = ip[1], a2 = ip[2], a3 = ip[3];
            acc[kk] += (a0.x * w0.x + a0.y * w0.y + a0.z * w0.z + a0.w * w0.w) + (a1.x * w1.x + a1.y * w1.y + a1.z * w1.z + a1.w * w1.w)
                     + (a2.x * w2.x + a2.y * w2.y + a2.z * w2.z + a2.w * w2.w) + (a3.x * w3.x + a3.y * w3.y + a3.z * w3.z + a3.w * w3.w);
            if (kk & 1) asm volatile("" ::: "memory"); }
    }
    const f32x4 g0 = *(const f32x4*)(mixn + kc * 8), g1 = *(const f32x4*)(mixn + kc * 8 + 4);
    v4u w; w.x = pk2(acc[0] * g0.x, acc[1] * g0.y); w.y = pk2(acc[2] * g0.z, acc[3] * g0.w); w.z = pk2(acc[4] * g1.x, acc[5] * g1.y); w.w = pk2(acc[6] * g1.z, acc[7] * g1.w);
    *(GAS v4u*)(WT + (size_t)(h * 128 + r) * D + kc * 8) = w;
}
__device__ __forceinline__ void wafold_item(const float* wuv, const float* wba, bf16* WT, int item, int lane) {
    const int ng = item & 15, rg = (item >> 4) & 15, h = item >> 8; const int n = ng * 64 + lane, r0 = rg * 8;
    float acc[8] = {0.f, 0.f, 0.f, 0.f, 0.f, 0.f, 0.f, 0.f};
#pragma unroll 4
    for (int d = 0; d < 64; ++d) { const float wa = wba[(size_t)(h * 64 + d) * D + n];
#pragma unroll
        for (int j = 0; j < 8; ++j) acc[j] += wuv[(size_t)(r0 + j) * (AH * AHD) + h * 64 + d] * wa; }
    v4u w; w.x = pk2(acc[0], acc[1]); w.y = pk2(acc[2], acc[3]); w.z = pk2(acc[4], acc[5]); w.w = pk2(acc[6], acc[7]);
    *(GAS v4u*)(WT + (size_t)n * 1024 + h * 128 + r0) = w;
}
__device__ __forceinline__ int items_of(int K, int N) { return (K / 64) * ((N + 63) / 64); }

__device__ __forceinline__ void prep_layer_weights_body(const PC& F, int l) {
    struct { const float* const* in; } a{F.in};
    const int lane_ = lane_id_v();
    LAS float* scr = (LAS float*)(F.lds + RING_OFF + F.wave * 17408);
    const int gw = F.vcu * NWAVES + F.wave, NGW = F.G * NWAVES;
    const float* f1n = a.in[3] + (size_t)l * D; const float* f1in = a.in[4] + (size_t)l * D * 2 * DFF; const float* f1out = a.in[5] + (size_t)l * DFF * D;
    const float* mixn = a.in[6] + (size_t)l * D; const float* win = a.in[7] + (size_t)l * D * INW;
    const float* wba = a.in[15] + (size_t)l * AW * D; const float* wbb = a.in[16] + (size_t)l * PW_ * D; const float* wbc = a.in[17] + (size_t)l * CW * D;
    const float* wout = a.in[18] + (size_t)l * D * D;
    const float* f2n = a.in[19] + (size_t)l * D; const float* f2in = a.in[20] + (size_t)l * D * 2 * DFF; const float* f2out = a.in[21] + (size_t)l * DFF * D;
    unsigned char* ws = launder_p(F.ws);
    const float* wuk = a.in[9] + (size_t)l * KVR * AH * AHD; const float* wuv = a.in[10] + (size_t)l * KVR * AH * AHD;
    const int I0 = items_of(D, 2 * DFF), I1 = items_of(DFF, D), I2 = items_of(D, INW), I4 = items_of(PW_, D), I5 = items_of(CW, D), I6 = items_of(D, D);
    const int NIT = 2 * I0 + 2 * I1 + I2 + I4 + I5 + I6;
#pragma unroll 1
    for (int it = gw; it < NIT; it += NGW) {
        int r = it;
        if (r < I0) { transpose_item(f1in, D, 2 * DFF, f1n, (bf16*)(ws + WS_W1IN), scr, r, lane_, MapSwiglu{}); continue; } r -= I0;
        if (r < I0) { transpose_item(f2in, D, 2 * DFF, f2n, (bf16*)(ws + WS_W2IN), scr, r, lane_, MapSwiglu{}); continue; } r -= I0;
        if (r < I1) { transpose_item(f1out, DFF, D, nullptr, (bf16*)(ws + WS_W1OUT), scr, r, lane_, MapId{0}); continue; } r -= I1;
        if (r < I1) { transpose_item(f2out, DFF, D, nullptr, (bf16*)(ws + WS_W2OUT), scr, r, lane_, MapId{0}); continue; } r -= I1;
        if (r < I2) { transpose_item(win, D, INW, mixn, (bf16*)(ws + WS_WIN), scr, r, lane_, MapInProj{}); continue; } r -= I2;
        if (r < I4) { transpose_item(wbb, PW_, D, nullptr, (bf16*)(ws + WS_WB), scr, r, lane_, MapId{0}); continue; } r -= I4;
        if (r < I5) { transpose_item(wbc, CW, D, nullptr, (bf16*)(ws + WS_WC), scr, r, lane_, MapId{0}); continue; } r -= I5;
        transpose_item(wout, D, D, nullptr, (bf16*)(ws + WS_WOUT), scr, r, lane_, MapId{0});
    }
    { const float* wpool = a.in[11] + (size_t)l * 4 * 64 * 64; bf16* wpT = (bf16*)(ws + WS_WPT);
      for (int i = gw * 64 + lane_; i < 4 * 64 * 64; i += NGW * 64) { const int c = i & 63, d = (i >> 6) & 63, g = i >> 12; wpT[i] = (bf16)f2bf(wpool[(g * 64 + c) * 64 + d]); } }
    asm volatile("" ::: "memory");
#pragma unroll 1
    for (int it = gw; it < 2048; it += NGW) wafold_item(wuv, wba, (bf16*)(ws + WS_WA), it, lane_);
    asm volatile("" ::: "memory");
#pragma unroll 1
    for (int it = gw; it < 2048; it += NGW) qlat_item(win, mixn, wuk, (bf16*)(ws + WS_WIN), it, lane_);
}

__device__ __noinline__ void p0_prologue(const float* const* in_, float* out_, unsigned char* ws_, LAS unsigned char* lds_, int wave_, int vcu_, int G_) {
    const PC F{uni(in_), uni(out_), uni(ws_), uni_l(lds_), uni_i(wave_), uni_i(vcu_), uni_i(G_)}; struct { const float* const* in; } a{F.in};
    const int lane_ = lane_id_v();
    const int gw = F.vcu * NWAVES + F.wave, NGW = F.G * NWAVES;
    const float* x = a.in[0]; const float* mem = a.in[1];
    bf16* hb = (bf16*)(F.ws + WS_HB); float* ss = (float*)(F.ws + WS_SS); bf16* memn = (bf16*)(F.ws + WS_MEMN);
    for (int m = gw; m < M + MROWS; m += NGW) {
        const bool ismem = m >= M; const int r = ismem ? m - M : m;
        const GAS f32x4* xr = (const GAS f32x4*)((ismem ? mem : x) + (size_t)r * D) + lane_;
        f32x4 v[4]; float s = 0.f;
#pragma unroll
        for (int j = 0; j < 4; ++j) { v[j] = xr[64 * j]; s += (v[j].x * v[j].x + v[j].y * v[j].y) + (v[j].z * v[j].z + v[j].w * v[j].w); }
        s = wave_sum(s);
        float sc = 1.f;
        if (ismem) sc = 1.0f / sqrtf(s * (1.0f / D) + EPS);
        else if (lane_ < 4) ss[(size_t)r * 4 + lane_] = lane_ == 0 ? s : 0.f;
        GAS unsigned long long* o8 = (GAS unsigned long long*)((ismem ? memn : hb) + (size_t)r * D) + lane_;
#pragma unroll
        for (int j = 0; j < 4; ++j) o8[64 * j] = (unsigned long long)pk2(v[j].x * sc, v[j].y * sc) | ((unsigned long long)pk2(v[j].z * sc, v[j].w * sc) << 32);
    }
    LAS float* scr = (LAS float*)(F.lds + RING_OFF + F.wave * 17408);
    const int IM = items_of(D, 2 * CW);
    for (int it = gw; it < DEPTH * IM; it += NGW) { const int l = it / IM, r = it % IM;
        transpose_item(a.in[14] + (size_t)l * D * 2 * CW, D, 2 * CW, a.in[13] + (size_t)l * D, (bf16*)(F.ws + WS_WMEM), scr, r, lane_, MapId{l * 2 * CW}); }
    prep_layer_weights_body(F, 0);
}
__device__ __noinline__ void prep_layer_weights(const float* const* in_, float* out_, unsigned char* ws_, LAS unsigned char* lds_, int l, int wave_, int vcu_, int G_) {
    const PC F{uni(in_), uni(out_), uni(ws_), uni_l(lds_), uni_i(wave_), uni_i(vcu_), uni_i(G_)}; prep_layer_weights_body(F, uni_i(l));
}

__constant__ unsigned char T5_BUCKET[128] = {0, 1, 2, 3, 4, 5, 6, 7, 8, 9, 10, 11, 12, 13, 14, 15, 16, 16, 16, 17, 17, 18, 18, 18, 19, 19, 19, 20, 20, 20, 20, 21, 21, 21, 21, 22, 22, 22, 22, 22, 23, 23, 23, 23, 23, 23, 24, 24, 24, 24, 24, 24, 25, 25, 25, 25, 25, 25, 25, 26, 26, 26, 26, 26, 26, 26, 26, 27, 27, 27, 27, 27, 27, 27, 27, 27, 27, 28, 28, 28, 28, 28, 28, 28, 28, 28, 28, 29, 29, 29, 29, 29, 29, 29, 29, 29, 29, 29, 29, 30, 30, 30, 30, 30, 30, 30, 30, 30, 30, 30, 30, 30, 30, 31, 31, 31, 31, 31, 31, 31, 31, 31, 31, 31, 31, 31, 31, 31};

typedef short bf16x8_p __attribute__((ext_vector_type(8)));
__device__ __forceinline__ void prep_tokens(const float* const* in_, float* out_, unsigned char* ws_, LAS unsigned char* lds_, int l_, int wave_, int vcu_, int G_, int dry_) {
    const int dry = uni_i(dry_);
    const PC F{uni(in_), uni(out_), uni(ws_), uni_l(lds_), uni_i(wave_), uni_i(vcu_), uni_i(G_)}; struct { const float* const* in; } a{F.in}; const int l = uni_i(l_);
    unsigned char* ws = launder_p(F.ws);
    const float* ckvraw = (const float*)(ws + WS_CKVRAW); bf16* ckv = (bf16*)(ws + WS_CKV);
    const bf16* iqraw = (const bf16*)(ws + WS_IQRAW); bf16* iqf = (bf16*)(ws + WS_IQF); const float* iw = (const float*)(ws + WS_IW); unsigned* sgn = (unsigned*)(ws + WS_SGN);
    const bf16* z = (const bf16*)(ws + WS_Z); bf16* yb = (bf16*)(ws + WS_YB); bf16* qc = (bf16*)(ws + WS_QC);
    const bf16* memkv = (const bf16*)(ws + WS_MEMKV); const bf16* vT = (const bf16*)(ws + WS_VT); const bf16* wpT = (const bf16*)(ws + WS_WPT);
    const float* kvn = a.in[8] + (size_t)l * KVR; const float* pscale = a.in[12] + (size_t)l * PW_;
    const int lane = lane_id_v(), tid = F.wave * 64 + lane;
    const int tok = lane & 15, g4 = lane >> 4;
    LAS unsigned char* Ks = F.lds;
    LAS unsigned char* Vs = F.lds + 36864;
    for (int blk = F.vcu; blk < M / 128; blk += F.G) {
        const int rowb = blk * 128, b = rowb / SEQ, row0 = rowb + F.wave * 16;
#pragma unroll 1
        for (int tt = 0; tt < 16; ++tt) { const int row = row0 + tt;
            { const f32x2 v = *(const f32x2*)(ckvraw + (size_t)row * KVR + 2 * lane); const float q = wave_sum(v.x * v.x + v.y * v.y);
              const float rs = 1.0f / sqrtf(q * (1.0f / KVR) + EPS); const f32x2 g = *(const f32x2*)(kvn + 2 * lane);
              *(unsigned*)(ckv + (size_t)row * KVR + 2 * lane) = pk2(v.x * rs * g.x, v.y * rs * g.y); }
            { const float wv = iw[(size_t)row * IH + (lane >> 3)]; const float aw = fabsf(wv) * (1.0f / 16.0f);
              const v2u q = *(const v2u*)(iqraw + (size_t)row * 256 + 4 * lane);
              v2u o; o.x = pkh2(hlo(q.x) * aw, hhi(q.x) * aw); o.y = pkh2(hlo(q.y) * aw, hhi(q.y) * aw);
              *(v2u*)(iqf + (size_t)row * 256 + 4 * lane) = o;
              const unsigned long long bal = __ballot(wv < 0.f);
              unsigned mask = 0;
#pragma unroll
              for (int h = 0; h < 8; ++h) mask |= ((unsigned)(bal >> (8 * h)) & 1u) << h;
              if (lane == 0) sgn[row] = mask; } }
        { const int row = row0 + tok, spos = row % SEQ;
#pragma unroll 1
          for (int g = 0; g < 4; ++g) { const int w = 2 << g; const int cnt = (spos + 1) < w ? (spos + 1) : w; const float rc = 1.0f / (float)cnt;
              bf16x8_p pf[2];
#pragma unroll
              for (int ks = 0; ks < 2; ++ks) { const int c0 = g * 64 + 32 * ks + 8 * g4; float sum[8], z0[8];
#pragma unroll
                  for (int e = 0; e < 8; ++e) { sum[e] = 0.f; z0[e] = 0.f; }
                  for (int j = 0; j < w; ++j) { if (j < cnt) { const v4u v = *(const v4u*)(z + (size_t)(row - j) * 256 + c0);
                      const float f[8] = {bflo(v.x), bfhi(v.x), bflo(v.y), bfhi(v.y), bflo(v.z), bfhi(v.z), bflo(v.w), bfhi(v.w)};
#pragma unroll
                      for (int e = 0; e < 8; ++e) { sum[e] += f[e]; if (j == 0) z0[e] = f[e]; } } }
                  v4u pw; pw.x = pk2(sum[0] * rc - z0[0], sum[1] * rc - z0[1]); pw.y = pk2(sum[2] * rc - z0[2], sum[3] * rc - z0[3]); pw.z = pk2(sum[4] * rc - z0[4], sum[5] * rc - z0[5]); pw.w = pk2(sum[6] * rc - z0[6], sum[7] * rc - z0[7]);
                  pf[ks] = __builtin_bit_cast(bf16x8_p, pw); }
#pragma unroll
              for (int dt = 0; dt < 4; ++dt) { f32x4 acc = {0.f, 0.f, 0.f, 0.f};
#pragma unroll
                  for (int ks = 0; ks < 2; ++ks) { const bf16x8_p af = *(const bf16x8_p*)(wpT + (size_t)(g * 64 + 16 * dt + tok) * 64 + 32 * ks + 8 * g4); acc = __builtin_amdgcn_mfma_f32_16x16x32_bf16(af, pf[ks], acc, 0, 0, 0); }
                  const f32x4 ps = *(const f32x4*)(pscale + g * 64 + 16 * dt + 4 * g4);
                  v2u o; o.x = pk2(acc[0] * ps.x, acc[1] * ps.y); o.y = pk2(acc[2] * ps.z, acc[3] * ps.w);
                  *(v2u*)(yb + (size_t)row * 256 + g * 64 + 16 * dt + 4 * g4) = o; } } }
#pragma unroll 1
        for (int h = 0; h < CH; ++h) {
            __syncthreads();
#pragma unroll
            for (int e = 0; e < 4; ++e) { const int i = tid + 512 * e;
                { const int m = i >> 3, c = i & 7; const v4u v = *(const v4u*)(memkv + (size_t)(b * NMEM + m) * 2048 + l * 512 + h * 64 + c * 8); *(LAS v4u*)(Ks + m * 144 + c * 16) = v; }
                { const int d = i >> 5, c = i & 31; const v4u v = *(const v4u*)(vT + (size_t)(l * 512 + 256 + h * 64 + d) * MROWS + b * NMEM + c * 8); *(LAS v4u*)(Vs + d * 528 + c * 16) = v; } }
            LDS_WAIT(); __syncthreads();
            const int row = row0 + tok;
            bf16x8_p qf[2];
#pragma unroll
            for (int ks = 0; ks < 2; ++ks) qf[ks] = *(const bf16x8_p*)(qc + (size_t)row * 256 + h * 64 + 32 * ks + 8 * g4);
            f32x4 S[16]; float mx = -1e30f;
#pragma unroll
            for (int mt = 0; mt < 16; ++mt) { f32x4 acc = {0.f, 0.f, 0.f, 0.f};
#pragma unroll
                for (int ks = 0; ks < 2; ++ks) { const bf16x8_p kf = *(const LAS bf16x8_p*)(Ks + (16 * mt + tok) * 144 + (4 * ks + g4) * 16); acc = __builtin_amdgcn_mfma_f32_16x16x32_bf16(kf, qf[ks], acc, 0, 0, 0); }
                S[mt] = acc; mx = fmaxf(mx, fmaxf(fmaxf(acc[0], acc[1]), fmaxf(acc[2], acc[3]))); if ((mt & 3) == 3) __builtin_amdgcn_sched_barrier(0); }
            mx = fmaxf(mx, __shfl_xor(mx, 16)); mx = fmaxf(mx, __shfl_xor(mx, 32));
            float sm = 0.f;
#pragma unroll
            for (int mt = 0; mt < 16; ++mt)
#pragma unroll
                for (int r = 0; r < 4; ++r) { const float p = __expf((S[mt][r] - mx) * 0.125f); S[mt][r] = p; sm += p; }
            sm += __shfl_xor(sm, 16); sm += __shfl_xor(sm, 32);
            const float inv = 1.0f / sm;
            f32x4 oacc[4];
#pragma unroll
            for (int dt = 0; dt < 4; ++dt) oacc[dt] = (f32x4){0.f, 0.f, 0.f, 0.f};
#pragma unroll
            for (int kk = 0; kk < 8; ++kk) { v4u pw; pw.x = pg8::cvt_pk_bf16(S[2 * kk][0], S[2 * kk][1]); pw.y = pg8::cvt_pk_bf16(S[2 * kk][2], S[2 * kk][3]); pw.z = pg8::cvt_pk_bf16(S[2 * kk + 1][0], S[2 * kk + 1][1]); pw.w = pg8::cvt_pk_bf16(S[2 * kk + 1][2], S[2 * kk + 1][3]);
                const bf16x8_p pfr = __builtin_bit_cast(bf16x8_p, pw);
#pragma unroll
                for (int dt = 0; dt < 4; ++dt) { const LAS unsigned char* vp = Vs + (16 * dt + tok) * 528 + (32 * kk + 4 * g4) * 2;
                    const v2u lo = *(const LAS v2u*)vp, hi = *(const LAS v2u*)(vp + 32);
                    v4u vw; vw.x = lo.x; vw.y = lo.y; vw.z = hi.x; vw.w = hi.y;
                    oacc[dt] = __builtin_amdgcn_mfma_f32_16x16x32_bf16(__builtin_bit_cast(bf16x8_p, vw), pfr, oacc[dt], 0, 0, 0); }
                __builtin_amdgcn_sched_barrier(0); }
#pragma unroll
            for (int dt = 0; dt < 4; ++dt) { v2u o; o.x = pk2(oacc[dt][0] * inv, oacc[dt][1] * inv); o.y = pk2(oacc[dt][2] * inv, oacc[dt][3] * inv);
                if (!dry) *(v2u*)(qc + (size_t)row * 256 + h * 64 + 16 * dt + 4 * g4) = o; else asm volatile("" :: "v"(o.x), "v"(o.y)); }
        }
    }
    __syncthreads();
}

__device__ __forceinline__ unsigned key_of(float s) { const unsigned u = __builtin_bit_cast(unsigned, s); return (u & 0x80000000u) ? ~u : (u | 0x80000000u); }

typedef short bf16x8_t __attribute__((ext_vector_type(8)));
typedef short s16x4_t __attribute__((ext_vector_type(4)));
__device__ __forceinline__ void glds16(const void* gsrc, unsigned lds_dst) { unsigned keep;
    asm volatile("s_mov_b32 %0, m0\n\ts_mov_b32 m0, %2\n\ts_nop 0\n\tglobal_load_lds_dwordx4 %1, off\n\ts_mov_b32 m0, %0" : "=&s"(keep) : "v"(gsrc), "s"(lds_dst) : "memory"); }
typedef float f32x16 __attribute__((ext_vector_type(16)));
constexpr int SEL_CAP = 256;
constexpr int HSTR = 264;
constexpr int SL_HIST = 0, SL_SEL = 0, SL_CS = 32768, SL_CI = 98304, SL_KEYS = 131072, SL_ST = 147456;

#define SEL_DECLS \
    LAS unsigned char* const lds = uni_l(lds_); const int wave = uni_i(wave_), b = uni_i(b_), ub = uni_i(ub_); unsigned char* ws = uni(ws_); \
    const bf16* iqf = (const bf16*)(ws + WS_IQF); const unsigned* sgn = (const unsigned*)(ws + WS_SGN); const bf16* ik = (const bf16*)(ws + WS_IK); \
    const int lane = lane_id_v(), tid = wave * 64 + lane; const int kl = lane & 31, c5 = lane >> 5; \
    LAS unsigned* hist = (LAS unsigned*)(lds + SL_HIST); LAS unsigned short* lsel = (LAS unsigned short*)(lds + SL_SEL); LAS float* lcs = (LAS float*)(lds + SL_CS); \
    LAS unsigned short* lci = (LAS unsigned short*)(lds + SL_CI); LAS unsigned* st = (LAS unsigned*)(lds + SL_ST); LAS float* stf = (LAS float*)(lds + SL_ST); \
    const int t0 = ub * 64; const int q0 = b * SEQ + t0; const bf16* ikb = ik + (size_t)b * SEQ * IDIM; const int ntile = (t0 + 64 + 127) >> 7; \
    (void)hist; (void)lsel; (void)lcs; (void)lci; (void)stf; (void)tid;
#define SEL_LOAD_A \
    bf16x8_t af[2][2]; float sgc[2][16]; \
    { const int i = kl, a_ = i >> 3, cc_ = (i >> 2) & 1, e_ = i & 3; const int qq_ = 2 * cc_ + (a_ >> 1), hh_ = 4 * (a_ & 1) + e_; \
      _Pragma("unroll") for (int rt = 0; rt < 2; ++rt) { const unsigned flip_ = ((sgn[q0 + 8 * wave + 4 * rt + qq_] >> hh_) & 1u) ? 0x80008000u : 0u;     \
          _Pragma("unroll") for (int ks = 0; ks < 2; ++ks) { v4u w_ = *(const v4u*)(iqf + (size_t)(q0 + 8 * wave + 4 * rt + qq_) * 256 + hh_ * 32 + 16 * ks + 8 * c5); \
              w_.x ^= flip_; w_.y ^= flip_; w_.z ^= flip_; w_.w ^= flip_; af[rt][ks] = __builtin_bit_cast(bf16x8_t, w_); } } \
      _Pragma("unroll") for (int rt = 0; rt < 2; ++rt) _Pragma("unroll") for (int u = 0; u < 2; ++u) { const unsigned m_ = sgn[q0 + 8 * wave + 4 * rt + 2 * c5 + u]; \
          _Pragma("unroll") for (int h = 0; h < 8; ++h) sgc[rt][8 * u + h] = ((m_ >> h) & 1u) ? -__builtin_inff() : __builtin_inff(); } }
#define SEL_STAGE(kt_) do { const int key_ = 16 * wave + (lane >> 2); const int ch_ = (lane & 3) ^ ((key_ >> 2) & 3); \
    glds16(ikb + (size_t)(128 * (kt_) + key_) * IDIM + ch_ * 8, (unsigned)__builtin_amdgcn_readfirstlane((int)(unsigned)(size_t)(lds + SL_KEYS + ((kt_) & 1) * 8192 + wave * 1024))); } while (0)
#define SEL_MMA(acc_, rt_, kh_) do { acc_ = (f32x16){0.f,0.f,0.f,0.f,0.f,0.f,0.f,0.f,0.f,0.f,0.f,0.f,0.f,0.f,0.f,0.f}; \
    acc_ = __builtin_amdgcn_mfma_f32_32x32x16_f16(__builtin_bit_cast(f16x8_t, af[rt_][0]), __builtin_bit_cast(f16x8_t, bfr_[kh_][0]), acc_, 0, 0, 0); \
    acc_ = __builtin_amdgcn_mfma_f32_32x32x16_f16(__builtin_bit_cast(f16x8_t, af[rt_][1]), __builtin_bit_cast(f16x8_t, bfr_[kh_][1]), acc_, 0, 0, 0); } while (0)
#define SEL_SUM(acc_, rt_, kh_) do { _Pragma("unroll") for (int u = 0; u < 2; ++u) { float s_ = 0.f; \
    _Pragma("unroll") for (int h = 0; h < 8; ++h) s_ += __builtin_amdgcn_fmed3f(acc_[8 * u + h], 0.f, sgc[rt_][8 * u + h]); \
    sc[rt_][kh_][u] = s_; } } while (0)
#define SEL_SCORES(kt_) do { const LAS unsigned char* kb_ = lds + SL_KEYS + ((kt_) & 1) * 8192; bf16x8_t bfr_[4][2]; \
    _Pragma("unroll") for (int kh = 0; kh < 4; ++kh) { const int key_ = 32 * kh + kl; \
        bfr_[kh][0] = *(const LAS bf16x8_t*)(kb_ + key_ * 64 + 16 * ((0 + c5) ^ ((key_ >> 2) & 3))); \
        bfr_[kh][1] = *(const LAS bf16x8_t*)(kb_ + key_ * 64 + 16 * ((2 + c5) ^ ((key_ >> 2) & 3))); } \
    f32x16 accA_, accB_; \
    SEL_MMA(accA_, 0, 0); \
    SEL_MMA(accB_, 1, 0); __builtin_amdgcn_sched_barrier(0); SEL_SUM(accA_, 0, 0); __builtin_amdgcn_sched_barrier(0); \
    SEL_MMA(accA_, 0, 1); __builtin_amdgcn_sched_barrier(0); SEL_SUM(accB_, 1, 0); __builtin_amdgcn_sched_barrier(0); \
    SEL_MMA(accB_, 1, 1); __builtin_amdgcn_sched_barrier(0); SEL_SUM(accA_, 0, 1); __builtin_amdgcn_sched_barrier(0); \
    SEL_MMA(accA_, 0, 2); __builtin_amdgcn_sched_barrier(0); SEL_SUM(accB_, 1, 1); __builtin_amdgcn_sched_barrier(0); \
    SEL_MMA(accB_, 1, 2); __builtin_amdgcn_sched_barrier(0); SEL_SUM(accA_, 0, 2); __builtin_amdgcn_sched_barrier(0); \
    SEL_MMA(accA_, 0, 3); __builtin_amdgcn_sched_barrier(0); SEL_SUM(accB_, 1, 2); __builtin_amdgcn_sched_barrier(0); \
    SEL_MMA(accB_, 1, 3); __builtin_amdgcn_sched_barrier(0); SEL_SUM(accA_, 0, 3); __builtin_amdgcn_sched_barrier(0); \
    SEL_SUM(accB_, 1, 3); } while (0)
#define SEL_BOUNDARY(FINAL) do { \
    const int qq = tid >> 3, part = tid & 7; const LAS v4u* hp = (const LAS v4u*)(hist + qq * HSTR + 32 * part); \
    unsigned bins[32]; \
    _Pragma("unroll") for (int i = 0; i < 8; ++i) { const v4u v = hp[i]; bins[4 * i] = v.x; bins[4 * i + 1] = v.y; bins[4 * i + 2] = v.z; bins[4 * i + 3] = v.w; } \
    unsigned ps = 0; \
    _Pragma("unroll") for (int i = 0; i < 32; ++i) ps += bins[i]; \
    unsigned v = ps, tt; \
    tt = __shfl_down(v, 1, 8); if (part + 1 < 8) v += tt; \
    tt = __shfl_down(v, 2, 8); if (part + 2 < 8) v += tt; \
    tt = __shfl_down(v, 4, 8); if (part + 4 < 8) v += tt; \
    unsigned cacc = v - ps; \
    if (cacc < (unsigned)TOPK && v >= (unsigned)TOPK) { int bsel = 0; unsigned na = 0, cb = 0; bool found = false; \
        _Pragma("unroll") for (int i = 31; i >= 0; --i) { const bool hit = !found && (cacc + bins[i] >= (unsigned)TOPK); if (hit) { bsel = i; na = cacc; cb = bins[i]; found = true; } cacc += bins[i]; } \
        st[128 + qq] = (unsigned)(32 * part + bsel); if (FINAL) { st[192 + qq] = na; st[256 + qq] = cb; st[448 + qq] = cb > (unsigned)SEL_CAP ? 1u : 0u; } } } while (0)

__device__ __forceinline__ void sel_pass1(unsigned char* ws_, LAS unsigned char* lds_, int wave_, int b_, int ub_) {
    SEL_DECLS
    unsigned short* sel = (unsigned short*)(ws + WS_SEL);
    __syncthreads();
    if (ub < 4) {
        for (int i = tid; i < 64 * TOPK; i += NWAVES * 64) { const int qq = i >> 8, sl = i & 255; sel[(size_t)(q0 + qq) * TOPK + sl] = (unsigned short)(sl <= t0 + qq ? sl : 0); }
        if (tid == 0) st[512] = 1u;
        asm volatile("s_waitcnt vmcnt(0) lgkmcnt(0)" ::: "memory"); __syncthreads();
        return;
    }
    SEL_LOAD_A
    for (int i = tid; i < 64 * HSTR; i += NWAVES * 64) hist[i] = 0u;
    if (tid < 64) { st[128 + tid] = 0u; st[448 + tid] = 0u; }
    if (tid == 0) st[512] = 0u;
    float sc[2][4][2];
    float scl[2][2]; int bcur[2][2];
#pragma unroll
    for (int rt = 0; rt < 2; ++rt)
#pragma unroll
        for (int u = 0; u < 2; ++u) { scl[rt][u] = 0.f; bcur[rt][u] = 0; }
    SEL_STAGE(0);
#pragma unroll 1
    for (int kt = 0; kt < ntile; ++kt) {
        asm volatile("s_waitcnt vmcnt(0) lgkmcnt(0)" ::: "memory"); __syncthreads();
        if (kt > 0 && (kt & 3) == 0) {
            SEL_BOUNDARY(false);
            asm volatile("s_waitcnt lgkmcnt(0)" ::: "memory"); __syncthreads();
#pragma unroll
            for (int rt = 0; rt < 2; ++rt)
#pragma unroll
                for (int u = 0; u < 2; ++u) bcur[rt][u] = (int)st[128 + 8 * wave + 4 * rt + 2 * c5 + u];
        }
        if (kt + 1 < ntile) SEL_STAGE(kt + 1);
        SEL_SCORES(kt);
        if (kt == 0) {
#pragma unroll
            for (int rt = 0; rt < 2; ++rt)
#pragma unroll
                for (int u = 0; u < 2; ++u) { float mx = 0.f;
#pragma unroll
                    for (int kh = 0; kh < 4; ++kh) mx = fmaxf(mx, fabsf(sc[rt][kh][u]));
#pragma unroll
                    for (int o = 1; o < 32; o <<= 1) mx = fmaxf(mx, __shfl_xor(mx, o));
                    const float R = mx > 0.f ? mx : 1.0f;
                    scl[rt][u] = 128.0f / R;
                    if (kl == 0) stf[8 * wave + 4 * rt + 2 * c5 + u] = scl[rt][u]; }
        }
        const bool masked = 128 * kt + 127 > t0;
#pragma unroll
        for (int rt = 0; rt < 2; ++rt)
#pragma unroll
            for (int u = 0; u < 2; ++u) { const int qq = 8 * wave + 4 * rt + 2 * c5 + u; const int lim = masked ? (t0 + qq - 128 * kt - kl) : 1000;
#pragma unroll
                for (int kh = 0; kh < 4; ++kh) { const float fb = __builtin_amdgcn_fmed3f(fmaf(sc[rt][kh][u], scl[rt][u], 128.0f), 0.f, 255.f);
                    if (fb >= (float)bcur[rt][u] && 32 * kh <= lim) (void)__hip_atomic_fetch_add(hist + qq * HSTR + (int)fb, 1u, __ATOMIC_RELAXED, __HIP_MEMORY_SCOPE_WORKGROUP); } }
    }
    asm volatile("s_waitcnt vmcnt(0) lgkmcnt(0)" ::: "memory"); __syncthreads();
    SEL_BOUNDARY(true);
    if (tid < 64) { st[320 + tid] = 0u; st[384 + tid] = 0u; }
    asm volatile("s_waitcnt lgkmcnt(0)" ::: "memory"); __syncthreads();
}
__device__ __forceinline__ void sel_pass2(unsigned char* ws_, LAS unsigned char* lds_, int wave_, int b_, int ub_) {
    SEL_DECLS
    if (st[512] != 0u) return;
    if (tid < 64) { st[320 + tid] = 0u; st[384 + tid] = 0u; }
    SEL_LOAD_A
    float sc[2][4][2];
    float scl[2][2]; int bcur[2][2];
#pragma unroll
    for (int rt = 0; rt < 2; ++rt)
#pragma unroll
        for (int u = 0; u < 2; ++u) { const int qq = 8 * wave + 4 * rt + 2 * c5 + u; scl[rt][u] = stf[qq]; bcur[rt][u] = (int)st[128 + qq]; }
    SEL_STAGE(0);
#pragma unroll 1
    for (int kt = 0; kt < ntile; ++kt) {
        asm volatile("s_waitcnt vmcnt(0) lgkmcnt(0)" ::: "memory"); __syncthreads();
        if (kt + 1 < ntile) SEL_STAGE(kt + 1);
        SEL_SCORES(kt);
        const bool masked = 128 * kt + 127 > t0;
        unsigned okm = 0u, abm = 0u; unsigned basea[2][2], basec[2][2];
#pragma unroll
        for (int rt = 0; rt < 2; ++rt)
#pragma unroll
            for (int u = 0; u < 2; ++u) { const int qq = 8 * wave + 4 * rt + 2 * c5 + u; const int lim = masked ? (t0 + qq - 128 * kt - kl) : 1000; unsigned na_ = 0u, nc_ = 0u;
#pragma unroll
                for (int kh = 0; kh < 4; ++kh) { const float fb = __builtin_amdgcn_fmed3f(fmaf(sc[rt][kh][u], scl[rt][u], 128.0f), 0.f, 255.f);
                    const bool ok = fb >= (float)bcur[rt][u] && 32 * kh <= lim; const bool ab = fb >= (float)(bcur[rt][u] + 1);
                    if (ok) { okm |= 1u << (rt * 8 + u * 4 + kh); if (ab) { abm |= 1u << (rt * 8 + u * 4 + kh); ++na_; } else ++nc_; } }
                basea[rt][u] = 0u; basec[rt][u] = 0u;
                if (na_) basea[rt][u] = __hip_atomic_fetch_add(st + 320 + qq, na_, __ATOMIC_RELAXED, __HIP_MEMORY_SCOPE_WORKGROUP);
                if (nc_) basec[rt][u] = __hip_atomic_fetch_add(st + 384 + qq, nc_, __ATOMIC_RELAXED, __HIP_MEMORY_SCOPE_WORKGROUP); }
        if (okm != 0u) {
#pragma unroll
            for (int rt = 0; rt < 2; ++rt)
#pragma unroll
                for (int u = 0; u < 2; ++u) { const int qq = 8 * wave + 4 * rt + 2 * c5 + u; unsigned sa = basea[rt][u], scn = basec[rt][u];
#pragma unroll
                    for (int kh = 0; kh < 4; ++kh) { const int bit = rt * 8 + u * 4 + kh; const int kpos = 128 * kt + 32 * kh + kl;
                        if ((okm >> bit) & 1u) {
                            if ((abm >> bit) & 1u) { if (sa < (unsigned)TOPK) lsel[qq * 256 + sa] = (unsigned short)kpos; ++sa; }
                            else { if (scn < (unsigned)SEL_CAP) { lcs[qq * SEL_CAP + scn] = sc[rt][kh][u]; lci[qq * SEL_CAP + scn] = (unsigned short)kpos; } ++scn; } } } }
        }
    }
    asm volatile("s_waitcnt vmcnt(0) lgkmcnt(0)" ::: "memory"); __syncthreads();
}
__device__ __forceinline__ void sel_resolve(unsigned char* ws_, LAS unsigned char* lds_, int wave_, int b_, int ub_, int wg_, int first_) {
    SEL_DECLS
    const int wg = uni_i(wg_), first = uni_i(first_);
    unsigned short* sel = (unsigned short*)(ws + WS_SEL);
    gu32* slowl = (gu32*)(ws + WS_CTL + 65536) + (size_t)wg * 132;
    if (first && tid == 0) __hip_atomic_store(slowl, 0u, RLX_AGENT);
    if (st[512] != 0u) return;
#pragma unroll 1
    for (int qi = 0; qi < 8; ++qi) { const int qq = 8 * wave + qi; const int q = q0 + qq;
        const int na = (int)st[192 + qq], need = TOPK - na; int C = (int)st[384 + qq]; C = C < SEL_CAP ? C : SEL_CAP;
        const bool slow = st[448 + qq] != 0u;
        if (!slow) {
            LAS unsigned* sh = (LAS unsigned*)(lds + SL_KEYS + wave * 2048); LAS float* sls = (LAS float*)(lds + SL_KEYS + wave * 2048 + 256); LAS unsigned short* sli = (LAS unsigned short*)(lds + SL_KEYS + wave * 2048 + 1280);
            const float sclq = stf[qq]; const float fbase = (float)(int)st[128 + qq];
            sh[lane] = 0u;
            float cs[SEL_CAP / 64]; int ci[SEL_CAP / 64], sb[SEL_CAP / 64];
#pragma unroll
            for (int e = 0; e < SEL_CAP / 64; ++e) { const int i = lane + 64 * e; cs[e] = 0.f; ci[e] = 0; sb[e] = -1;
                if (i < C) { cs[e] = lcs[qq * SEL_CAP + i]; ci[e] = lci[qq * SEL_CAP + i];
                    const float fr_ = (fmaf(cs[e], sclq, 128.0f) - fbase) * 64.0f; sb[e] = (int)__builtin_amdgcn_fmed3f(fr_, 0.f, 63.f); } }
            LDS_WAIT();
#pragma unroll
            for (int e = 0; e < SEL_CAP / 64; ++e) if (sb[e] >= 0) (void)__hip_atomic_fetch_add(sh + sb[e], 1u, __ATOMIC_RELAXED, __HIP_MEMORY_SCOPE_WORKGROUP);
            LDS_WAIT();
            const unsigned cl = sh[lane];
            unsigned v = cl, tt;
            tt = __shfl_down(v, 1); if (lane + 1 < 64) v += tt;
            tt = __shfl_down(v, 2); if (lane + 2 < 64) v += tt;
            tt = __shfl_down(v, 4); if (lane + 4 < 64) v += tt;
            tt = __shfl_down(v, 8); if (lane + 8 < 64) v += tt;
            tt = __shfl_down(v, 16); if (lane + 16 < 64) v += tt;
            tt = __shfl_down(v, 32); if (lane + 32 < 64) v += tt;
            const unsigned ab_ = v - cl;
            const unsigned long long cross = __ballot(ab_ < (unsigned)need && v >= (unsigned)need);
            const int sstar = cross ? (int)__builtin_ctzll(cross) : 0;
            const int na2 = (int)__shfl(ab_, sstar);
            const int need2 = need - na2;
            int base = na; int nsub = 0;
#pragma unroll
            for (int e = 0; e < SEL_CAP / 64; ++e) { const bool up = sb[e] > sstar; const bool eq = sb[e] == sstar;
                const unsigned long long bu = __ballot(up), be = __ballot(eq);
                const unsigned long long lt = (lane == 0) ? 0ull : (~0ull >> (64 - lane));
                if (up) lsel[qq * 256 + base + (int)__builtin_popcountll(bu & lt)] = (unsigned short)ci[e];
                if (eq) { const int p_ = nsub + (int)__builtin_popcountll(be & lt); sls[p_] = cs[e]; sli[p_] = (unsigned short)ci[e]; }
                base += (int)__builtin_popcountll(bu); nsub += (int)__builtin_popcountll(be); }
            LDS_WAIT();
#pragma unroll 1
            for (int i0 = 0; i0 < nsub; i0 += 64) { const int i = i0 + lane;
                if (i < nsub) { const float si = sls[i]; const int ii = sli[i]; int rank = 0;
                    for (int jx = 0; jx < nsub; ++jx) { const float sj = sls[jx]; const int ij = sli[jx]; rank += (sj > si || (sj == si && ij < ii)) ? 1 : 0; }
                    if (rank < need2) lsel[qq * 256 + na + na2 + rank] = (unsigned short)ii; } }
            LDS_WAIT();
            *(v2u*)(sel + (size_t)q * TOPK + 4 * lane) = *(const LAS v2u*)(lsel + qq * 256 + 4 * lane);
        }
    }
    __syncthreads();
    if (tid == 0) { unsigned n = first ? 0u : __hip_atomic_load(slowl, RLX_AGENT);
        for (int qq = 0; qq < 64; ++qq) if (st[448 + qq] != 0u) { if (n < 128u) { __hip_atomic_store(slowl + 1 + n, (unsigned)(q0 + qq), RLX_AGENT); ++n; } }
        __hip_atomic_store(slowl, n, RLX_AGENT); }
    asm volatile("s_waitcnt vmcnt(0)" ::: "memory");
    __syncthreads();
}
#undef SEL_DECLS
#undef SEL_LOAD_A
#undef SEL_STAGE
#undef SEL_SCORES
#undef SEL_MMA
#undef SEL_SUM
#undef SEL_BOUNDARY
__device__ __forceinline__ void dsa_select_slow(unsigned char* ws_, LAS unsigned char* lds_, int wave_, int wg_) {
    LAS unsigned char* const lds = uni_l(lds_); const int wave = uni_i(wave_), wg = uni_i(wg_);
    unsigned char* ws = uni(ws_);
    const bf16* iqf = (const bf16*)(ws + WS_IQF); const unsigned* sgn = (const unsigned*)(ws + WS_SGN); const bf16* ik = (const bf16*)(ws + WS_IK);
    unsigned short* sel = (unsigned short*)(ws + WS_SEL);
    gu32* slowl = (gu32*)(ws + WS_CTL + 65536) + (size_t)wg * 132;
    const int lane = lane_id_v(), tid = wave * 64 + lane; const int kl = lane & 31, c5 = lane >> 5;
    LAS unsigned* keys = (LAS unsigned*)lds;
    LAS unsigned* hist = (LAS unsigned*)(lds + 32768);
    LAS unsigned* ctl = (LAS unsigned*)(lds + 40960);
    const int nq = (int)__builtin_amdgcn_readfirstlane(__hip_atomic_load(slowl, RLX_AGENT));
#pragma unroll 1
    for (int k = 0; k < nq; ++k) {
        const int q = (int)__builtin_amdgcn_readfirstlane(__hip_atomic_load(slowl + 1 + k, RLX_AGENT));
        const int b = q / SEQ, t = q % SEQ, n = t + 1;
        const bf16* ikb = ik + (size_t)b * SEQ * IDIM;
        __syncthreads();
        bf16x8_t af[2]; float sgc[8];
        { const int i = kl, a_ = i >> 3, e_ = i & 3; const int hh_ = 4 * (a_ & 1) + e_; const unsigned m_ = sgn[q];
          const unsigned flip_ = ((m_ >> hh_) & 1u) ? 0x80008000u : 0u;
#pragma unroll
          for (int ks = 0; ks < 2; ++ks) { v4u w_ = *(const v4u*)(iqf + (size_t)q * 256 + hh_ * 32 + 16 * ks + 8 * c5); w_.x ^= flip_; w_.y ^= flip_; w_.z ^= flip_; w_.w ^= flip_; af[ks] = __builtin_bit_cast(bf16x8_t, w_); }
#pragma unroll
          for (int h = 0; h < 8; ++h) sgc[h] = ((m_ >> h) & 1u) ? -__builtin_inff() : __builtin_inff(); }
#pragma unroll 1
        for (int kb0 = wave; kb0 * 32 < n; kb0 += 4 * NWAVES) {
            bf16x8_t kb_[4][2];
#pragma unroll
            for (int j = 0; j < 4; ++j) { int key = 32 * (kb0 + j * NWAVES) + kl; key = key < SEQ ? key : SEQ - 1;
                kb_[j][0] = *(const bf16x8_t*)(ikb + (size_t)key * IDIM + 8 * c5); kb_[j][1] = *(const bf16x8_t*)(ikb + (size_t)key * IDIM + 16 + 8 * c5); }
#pragma unroll
            for (int j = 0; j < 4; ++j) { const int key = 32 * (kb0 + j * NWAVES) + kl;
                f32x16 acc = {0.f,0.f,0.f,0.f,0.f,0.f,0.f,0.f,0.f,0.f,0.f,0.f,0.f,0.f,0.f,0.f};
                acc = __builtin_amdgcn_mfma_f32_32x32x16_f16(__builtin_bit_cast(f16x8_t, af[0]), __builtin_bit_cast(f16x8_t, kb_[j][0]), acc, 0, 0, 0); acc = __builtin_amdgcn_mfma_f32_32x32x16_f16(__builtin_bit_cast(f16x8_t, af[1]), __builtin_bit_cast(f16x8_t, kb_[j][1]), acc, 0, 0, 0);
                float sc = 0.f;
#pragma unroll
                for (int h = 0; h < 8; ++h) sc += __builtin_amdgcn_fmed3f(acc[h], 0.f, sgc[h]);
                if (c5 == 0 && key < SEQ) keys[key] = key_of(sc); } }
        if (tid == 0) { const unsigned z_ = (unsigned)launder_v(0); ctl[0] = z_; ctl[1] = z_ + (unsigned)TOPK; ctl[2] = z_; ctl[3] = z_; }
        unsigned P = 0u, Plo = 0u;
#pragma unroll 1
        for (int lev = 0; lev < 5; ++lev) {
            for (int i = tid; i < 2048; i += NWAVES * 64) hist[i] = 0u;
            asm volatile("s_waitcnt lgkmcnt(0)" ::: "memory"); __syncthreads();
#pragma unroll 1
            for (int i = 0; i < 16; ++i) { const int s_ = tid * 16 + i;
                if (s_ < n) { const unsigned hi = keys[s_], lo = 8191u - (unsigned)s_; bool mt; unsigned dg;
                    if (lev == 0) { mt = true; dg = hi >> 21; } else if (lev == 1) { mt = (hi >> 21) == P; dg = (hi >> 10) & 0x7ffu; } else if (lev == 2) { mt = (hi >> 10) == P; dg = hi & 0x3ffu; }
                    else if (lev == 3) { mt = hi == P; dg = lo >> 6; } else { mt = hi == P && (lo >> 6) == Plo; dg = lo & 63u; }
                    if (mt) (void)__hip_atomic_fetch_add(hist + dg, 1u, __ATOMIC_RELAXED, __HIP_MEMORY_SCOPE_WORKGROUP); } }
            asm volatile("s_waitcnt lgkmcnt(0)" ::: "memory"); __syncthreads();
            const unsigned need = ctl[1];
            const v4u hb = *(const LAS v4u*)(hist + 4 * tid); const unsigned ls = hb.x + hb.y + hb.z + hb.w;
            unsigned v = ls, tt;
            tt = __shfl_down(v, 1); if (lane + 1 < 64) v += tt;
            tt = __shfl_down(v, 2); if (lane + 2 < 64) v += tt;
            tt = __shfl_down(v, 4); if (lane + 4 < 64) v += tt;
            tt = __shfl_down(v, 8); if (lane + 8 < 64) v += tt;
            tt = __shfl_down(v, 16); if (lane + 16 < 64) v += tt;
            tt = __shfl_down(v, 32); if (lane + 32 < 64) v += tt;
            if (lane == 0) ctl[8 + wave] = v;
            asm volatile("s_waitcnt lgkmcnt(0)" ::: "memory"); __syncthreads();
            unsigned above = v - ls;
            for (int w2 = wave + 1; w2 < NWAVES; ++w2) above += ctl[8 + w2];
            if (above < need && above + ls >= need) { unsigned c = above; const unsigned bb[4] = {hb.x, hb.y, hb.z, hb.w}; int bsel = 0; unsigned cab = 0; bool found = false;
#pragma unroll
                for (int i = 3; i >= 0; --i) { const bool hit = !found && (c + bb[i] >= need); if (hit) { bsel = i; cab = c; found = true; } c += bb[i]; }
                const unsigned dv = (unsigned)(4 * tid + bsel);
                if (lev == 0) ctl[0] = dv; else if (lev == 1) ctl[0] = (P << 11) | dv; else if (lev == 2) ctl[0] = (P << 10) | dv; else if (lev == 3) ctl[3] = dv; else ctl[3] = (Plo << 6) | dv;
                ctl[1] = need - cab; ctl[4] = bb[bsel]; }
            asm volatile("s_waitcnt lgkmcnt(0)" ::: "memory"); __syncthreads();
            P = ctl[0]; Plo = ctl[3];
            if (lev == 2 && ctl[1] == ctl[4]) break;
        }
        unsigned short* srow = sel + (size_t)q * TOPK;
        unsigned mymask = 0u;
#pragma unroll 1
        for (int i = 0; i < 16; ++i) { const int s_ = tid * 16 + i;
            if (s_ < n) { const unsigned hi = keys[s_], lo = 8191u - (unsigned)s_; if (hi > P || (hi == P && lo >= Plo)) mymask |= 1u << i; } }
        const unsigned mycnt = (unsigned)__builtin_popcount(mymask);
        unsigned pv_ = mycnt, tt_;
        tt_ = __shfl_up(pv_, 1); if (lane >= 1) pv_ += tt_;
        tt_ = __shfl_up(pv_, 2); if (lane >= 2) pv_ += tt_;
        tt_ = __shfl_up(pv_, 4); if (lane >= 4) pv_ += tt_;
        tt_ = __shfl_up(pv_, 8); if (lane >= 8) pv_ += tt_;
        tt_ = __shfl_up(pv_, 16); if (lane >= 16) pv_ += tt_;
        tt_ = __shfl_up(pv_, 32); if (lane >= 32) pv_ += tt_;
        if (lane == 63) ctl[16 + wave] = pv_;
        asm volatile("s_waitcnt lgkmcnt(0)" ::: "memory"); __syncthreads();
        unsigned slot0 = pv_ - mycnt;
        for (int w2 = 0; w2 < wave; ++w2) slot0 += ctl[16 + w2];
#pragma unroll 1
        for (int i = 0; i < 16; ++i) if ((mymask >> i) & 1u) { if (slot0 < (unsigned)TOPK) srow[slot0] = (unsigned short)(tid * 16 + i); ++slot0; }
    }
    asm volatile("s_waitcnt vmcnt(0) lgkmcnt(0)" ::: "memory");
    __syncthreads();
}

__device__ __forceinline__ unsigned offb(unsigned row, unsigned ch) { return 256u * row + 16u * (ch ^ (((row & 3u) << 2) | ((row >> 2) & 3u))); }
__device__ __forceinline__ s16x4_t vtr(const LAS unsigned char* p) { return __builtin_bit_cast(s16x4_t, __builtin_amdgcn_ds_read_tr16_b64_v4i16((LAS s16x4_t*)p)); }

__device__ __forceinline__ void dsa_attend(unsigned char* ws_, LAS unsigned char* lds_, const float* relb_, int wave_, int vcu_, int G_, int dry_) {
    const int dry = uni_i(dry_);
    LAS unsigned char* const lds = uni_l(lds_); const int wave = uni_i(wave_), vcu = uni_i(vcu_), G = uni_i(G_);
    unsigned char* ws = uni(ws_); const float* relb = uni(relb_);
    const bf16* ckv = (const bf16*)(ws + WS_CKV); bf16* ql = (bf16*)(ws + WS_QL); const unsigned short* sel = (const unsigned short*)(ws + WS_SEL);
    const int lane = lane_id_v(), tid = wave * 64 + lane;
    LAS unsigned char* cb = lds + wave * 16384;
    LAS unsigned short* sidx = (LAS unsigned short*)(lds + 131072 + wave * 512);
    LAS float* biasd = (LAS float*)(lds + 135168);
    for (int i = tid; i < 129 * 8; i += NWAVES * 64) { const int d = i >> 3, h = i & 7; const int bk = d < 128 ? (int)T5_BUCKET[d] : 31; biasd[i] = relb[bk * 8 + h]; }
    __syncthreads();
    const int hl = lane & 15, g = lane >> 4, hq = hl & 7;
    for (int p = vcu; p < BATCH * 64; p += G) {
        const int b = p >> 6, j = p & 63;
#pragma unroll 1
        for (int half = 0; half < 2; ++half) {
            const int ub = half == 0 ? j : 127 - j;
#pragma unroll 1
            for (int qi = 0; qi < 8; ++qi) {
                const int t = ub * 64 + wave * 8 + qi; const int q = b * SEQ + t; const int nsel = (t + 1) < TOPK ? (t + 1) : TOPK;
                const bf16* ckvb = ckv + (size_t)b * SEQ * KVR; bf16* qlrow = ql + (size_t)q * 1024;
                { const v2u w = *(const v2u*)(sel + (size_t)q * TOPK + 4 * lane); *(LAS v2u*)(sidx + 4 * lane) = w; }
                bf16x8_t qf[4];
#pragma unroll
                for (int s = 0; s < 4; ++s) qf[s] = *(const bf16x8_t*)(qlrow + hq * 128 + 32 * s + 8 * g);
                LDS_WAIT();
                float mrun = -1e30f, lsum = 0.f;
                f32x4 O[8];
#pragma unroll
                for (int c = 0; c < 8; ++c) O[c] = (f32x4){0.f, 0.f, 0.f, 0.f};
#define DSA_GATHER(c_) do { LAS unsigned char* dst_ = cb + ((c_) & 1) * 8192; \
                    _Pragma("unroll") for (int k_ = 0; k_ < 8; ++k_) { const int row_ = 4 * k_ + g; const int kidx_ = sidx[32 * (c_) + row_]; \
                        const int ch_ = hl ^ ((g << 2) | (k_ & 3)); \
                        glds16(ckvb + (size_t)kidx_ * KVR + ch_ * 8, (unsigned)__builtin_amdgcn_readfirstlane((int)(unsigned)(size_t)(dst_ + k_ * 1024))); } } while (0)
                DSA_GATHER(0);
#pragma unroll 1
                for (int c = 0; c < 8; ++c) {
                    if (c < 7) { DSA_GATHER(c + 1); asm volatile("s_waitcnt vmcnt(8)" ::: "memory"); }
                    else asm volatile("s_waitcnt vmcnt(0)" ::: "memory");
                    const LAS unsigned char* img = cb + (c & 1) * 8192;
                    f32x4 S[2];
#pragma unroll
                    for (int rb = 0; rb < 2; ++rb) { S[rb] = (f32x4){0.f, 0.f, 0.f, 0.f}; const unsigned row = 8u * (hl >> 2) + 4u * rb + (hl & 3);
#pragma unroll
                        for (int s = 0; s < 4; ++s) { const bf16x8_t af = *(const LAS bf16x8_t*)(img + offb(row, 4 * s + g)); S[rb] = __builtin_amdgcn_mfma_f32_16x16x32_bf16(af, qf[s], S[rb], 0, 0, 0); } }
                    float pv[2][4]; float mx = -1e30f;
#pragma unroll
                    for (int rb = 0; rb < 2; ++rb) { const v2u iw2 = *(const LAS v2u*)(sidx + 32 * c + 8 * g + 4 * rb);
                        const int ki[4] = {(int)(iw2.x & 0xffffu), (int)(iw2.x >> 16), (int)(iw2.y & 0xffffu), (int)(iw2.y >> 16)};
#pragma unroll
                        for (int r = 0; r < 4; ++r) { int dist = t - ki[r]; dist = dist < 0 ? 0 : (dist > 128 ? 128 : dist);
                            float lg = S[rb][r] * 0.125f + biasd[dist * 8 + hq];
                            if (32 * c + 8 * g + 4 * rb + r >= nsel) lg = -1e30f;
                            pv[rb][r] = lg; mx = fmaxf(mx, lg); } }
                    mx = fmaxf(mx, __shfl_xor(mx, 16)); mx = fmaxf(mx, __shfl_xor(mx, 32));
                    const float mnew = fmaxf(mrun, mx); const float alpha = __expf(mrun - mnew); mrun = mnew;
                    float rs = 0.f;
#pragma unroll
                    for (int rb = 0; rb < 2; ++rb)
#pragma unroll
                        for (int r = 0; r < 4; ++r) { pv[rb][r] = __expf(pv[rb][r] - mnew); rs += pv[rb][r]; }
                    rs += __shfl_xor(rs, 16); rs += __shfl_xor(rs, 32);
                    lsum = lsum * alpha + rs;
                    v4u pw; pw.x = pg8::cvt_pk_bf16(pv[0][0], pv[0][1]); pw.y = pg8::cvt_pk_bf16(pv[0][2], pv[0][3]); pw.z = pg8::cvt_pk_bf16(pv[1][0], pv[1][1]); pw.w = pg8::cvt_pk_bf16(pv[1][2], pv[1][3]);
                    const bf16x8_t pf = __builtin_bit_cast(bf16x8_t, pw);
                    float al[4];
#pragma unroll
                    for (int r = 0; r < 4; ++r) al[r] = __shfl(alpha, 4 * g + r);
#pragma unroll
                    for (int cd = 0; cd < 8; ++cd) {
                        f32x4 o = O[cd]; o[0] *= al[0]; o[1] *= al[1]; o[2] *= al[2]; o[3] *= al[3];
                        const unsigned q4 = hl >> 2, p4 = hl & 3;
                        const s16x4_t b0 = vtr(img + offb(8u * g + q4, 2 * cd + (p4 >> 1)) + 8u * (p4 & 1));
                        const s16x4_t b1 = vtr(img + offb(8u * g + 4u + q4, 2 * cd + (p4 >> 1)) + 8u * (p4 & 1));
                        bf16x8_t bf; bf[0] = b0[0]; bf[1] = b0[1]; bf[2] = b0[2]; bf[3] = b0[3]; bf[4] = b1[0]; bf[5] = b1[1]; bf[6] = b1[2]; bf[7] = b1[3];
                        O[cd] = __builtin_amdgcn_mfma_f32_16x16x32_bf16(pf, bf, o, 0, 0, 0);
                    }
                }
#undef DSA_GATHER
                const float linv = 1.0f / lsum; float li[4];
#pragma unroll
                for (int r = 0; r < 4; ++r) li[r] = __shfl(linv, 4 * g + r);
                LAS unsigned short* ost = (LAS unsigned short*)cb;
                if (g < 2) {
#pragma unroll
                    for (int cd = 0; cd < 8; ++cd)
#pragma unroll
                        for (int r = 0; r < 4; ++r) ost[(4 * g + r) * 128 + 16 * cd + hl] = (unsigned short)f2bf(O[cd][r] * li[r]);
                }
                LDS_WAIT();
                { const v4u w0 = *(const LAS v4u*)(cb + 32 * lane), w1 = *(const LAS v4u*)(cb + 32 * lane + 16);
                  if (!dry) { *(v4u*)(qlrow + 16 * lane) = w0; *(v4u*)(qlrow + 16 * lane + 8) = w1; } else asm volatile("" :: "v"(w0), "v"(w1)); }
                LDS_WAIT();
            }
        }
    }
    __syncthreads();
}

__device__ __noinline__ void final_norm(const float* const* in_, float* out_, unsigned char* ws_, LAS unsigned char* lds_, int wave_, int vcu_, int G_) {
    const PC F{uni(in_), uni(out_), uni(ws_), uni_l(lds_), uni_i(wave_), uni_i(vcu_), uni_i(G_)}; struct { const float* const* in; float* out; } a{F.in, F.out};
    const int lane_ = lane_id_v(); const int gw = F.vcu * NWAVES + F.wave, NGW = F.G * NWAVES; const float* g = a.in[22];
    f32x4 gv[4];
#pragma unroll
    for (int j = 0; j < 4; ++j) gv[j] = ((const f32x4*)g)[lane_ + 64 * j];
    for (int m = gw; m < M; m += NGW) {
        GAS f32x4* xr = (GAS f32x4*)(a.out + (size_t)m * D) + lane_;
        f32x4 v[4]; float s = 0.f;
#pragma unroll
        for (int j = 0; j < 4; ++j) { v[j] = xr[64 * j]; s += (v[j].x * v[j].x + v[j].y * v[j].y) + (v[j].z * v[j].z + v[j].w * v[j].w); }
        const float rs = 1.0f / sqrtf(wave_sum(s) * (1.0f / D) + EPS);
#pragma unroll
        for (int j = 0; j < 4; ++j) xr[64 * j] = v[j] * rs * gv[j];
    }
}

#define KIN ((const float* const*)__builtin_amdgcn_kernarg_segment_ptr())
constexpr int PH_PER_LAYER = 10, PH_LAYER0 = 2, N_PHASES = PH_LAYER0 + PH_PER_LAYER * DEPTH + 1;

__global__ void __launch_bounds__(NWAVES * 64, 2) mk_fwd(Args args) {
    extern __shared__ __attribute__((aligned(16))) unsigned char lds[];
    Frame F;
    F.lds = (LAS unsigned char*)lds;
    F.MISC = (volatile LAS unsigned*)(F.lds + MISC_OFF);
    F.wave = __builtin_amdgcn_readfirstlane((int)threadIdx.x >> 6);
    F.G = gridDim.x; { const int bx = blockIdx.x; F.vcu = (F.G % 8 == 0) ? (bx % 8) * (F.G / 8) + bx / 8 : bx; }
    F.ws = args.ws; F.ctl = (gu32*)(args.ws + WS_CTL);
    if (threadIdx.x < 64) ((LAS unsigned*)(F.lds + MISC_OFF))[threadIdx.x] = 0u;
    __syncthreads();
    const int lo = args.ph_lo, hi = args.ph_hi;
    const bool multi = (hi - lo) > 1;
    XcdBarrier bar; bar.bar = (unsigned*)(F.ctl + CW_BAR); bar.x = 0; bar.st = nullptr; bar.wave = F.wave;
    if (multi) bar = xcd_barrier_post((unsigned*)(F.ctl + CW_BAR), F.MISC + 8, F.wave);
#define IN(k) (lo <= (k) && (k) < hi)
#define SEAM(k) do { if (IN(k) && IN((k) + 1)) { xcd_barrier(bar); if (PROBE_PHASE == 99) xcd_barrier(bar); } } while (0)

    if (IN(0)) {
#if EN_P0
 for (int rep = (PROBE_PHASE == 1 ? 0 : 1); rep < 2; ++rep) p0_prologue(KIN, args.out, args.ws, F.lds, F.wave, F.vcu, F.G);
#endif
 } SEAM(0);
    if (IN(1)) {
#if !((DIS_MASK >> 7) & 1)
 unsigned char* ws = launder_p(args.ws); bf16* hb = (bf16*)(ws + WS_HB); float* ss = (float*)(ws + WS_SS); (void)hb; (void)ss;
        pg8::Gemm g{(const bf16_t*)(ws + WS_MEMN), (const bf16_t*)(ws + WS_WMEM), MROWS, DEPTH * 2 * CW, D}; pg8::StaticOrder S; S.init(MROWS, DEPTH * 2 * CW, F.G, launder_s((int)blockIdx.x));
        EpiPlainBf16 E{(bf16_t*)(ws + WS_MEMKV), DEPTH * 2 * CW};
        pg8::gemm_phase<EpiPlainBf16, pg8::StaticOrder, true, true>(F.lds + RING_OFF, g, S, E, F.wave);
        { pg8::Gemm g2{(const bf16_t*)(ws + WS_WMEM), (const bf16_t*)(ws + WS_MEMN), DEPTH * 2 * CW, MROWS, D}; pg8::StaticOrder S2; S2.init(DEPTH * 2 * CW, MROWS, F.G, launder_s((int)blockIdx.x));
          EpiPlainBf16 E2{(bf16_t*)(ws + WS_VT), MROWS};
          pg8::gemm_phase<EpiPlainBf16, pg8::StaticOrder, true, true>(F.lds + RING_OFF, g2, S2, E2, F.wave); }
#endif
    } SEAM(1);

    for (int l = 0; l < DEPTH; ++l) {
        const int pb = PH_LAYER0 + PH_PER_LAYER * l;
        const float* hbase = (l == 0) ? args.in[0] : args.out;
        if (IN(pb + 0)) {
#if EN_P0
 if (l > 0) for (int rep = (PROBE_PHASE == 1 ? 0 : 1); rep < 2; ++rep) prep_layer_weights(KIN, args.out, args.ws, F.lds, l, F.wave, F.vcu, F.G);
#endif
 } SEAM(pb + 0);
        if (IN(pb + 1)) {
#if !((DIS_MASK >> 0) & 1)
 unsigned char* ws = launder_p(args.ws); bf16* hb = (bf16*)(ws + WS_HB); float* ss = (float*)(ws + WS_SS); (void)hb; (void)ss;
            pg8::Gemm g{hb, (const bf16_t*)(ws + WS_W1IN), M, 2 * DFF, D}; pg8::StaticOrder S; S.init(M, 2 * DFF, F.G, launder_s((int)blockIdx.x));
            EpiSwiglu E{(bf16_t*)(ws + WS_ACT), ss};
            for (int rep = (PROBE_PHASE == 2 ? 0 : 1); rep < 2; ++rep) pg8::gemm_phase<EpiSwiglu, pg8::StaticOrder, true, true>(F.lds + RING_OFF, g, S, E, F.wave);
#endif
        } SEAM(pb + 1);
        if (IN(pb + 2)) {
#if !((DIS_MASK >> 1) & 1)
 unsigned char* ws = launder_p(args.ws); bf16* hb = (bf16*)(ws + WS_HB); float* ss = (float*)(ws + WS_SS); (void)hb; (void)ss;
            pg8::Gemm g{(const bf16_t*)(ws + WS_ACT), (const bf16_t*)(ws + WS_W1OUT), M, D, DFF}; pg8::StaticOrder S; S.init(M, D, F.G, launder_s((int)blockIdx.x));
            for (int rep = (PROBE_PHASE == 3 ? 0 : 1); rep < 2; ++rep) { EpiResid E{hbase, args.out, hb, ss, 0.5f, (LAS float*)(F.lds + RING_BYTES), rep == 0 ? 1 : 0};
            pg8::gemm_phase<EpiResid, pg8::StaticOrder, true, true>(F.lds + RING_OFF, g, S, E, F.wave); }
#endif
        } SEAM(pb + 2);
        if (IN(pb + 3)) {
#if !((DIS_MASK >> 2) & 1)
 unsigned char* ws = launder_p(args.ws); bf16* hb = (bf16*)(ws + WS_HB); float* ss = (float*)(ws + WS_SS); (void)hb; (void)ss;
            pg8::Gemm g{hb, (const bf16_t*)(ws + WS_WIN), M, INP, D}; pg8::StaticOrder S; S.init(M, INP, F.G, launder_s((int)blockIdx.x));
            EpiInProj E{ss, (bf16_t*)(ws + WS_QL), (float*)(ws + WS_CKVRAW), (bf16_t*)(ws + WS_IK), (float*)(ws + WS_IW), (bf16_t*)(ws + WS_IQRAW), (bf16_t*)(ws + WS_Z), (bf16_t*)(ws + WS_QC), (bf16_t*)(ws + WS_G)};
            for (int rep = (PROBE_PHASE == 4 ? 0 : 1); rep < 2; ++rep) pg8::gemm_phase<EpiInProj, pg8::StaticOrder, true, true>(F.lds + RING_OFF, g, S, E, F.wave);
#endif
        } SEAM(pb + 3);
        if (IN(pb + 4)) {
#if EN_PREP
 for (int rep = (PROBE_PHASE == 5 ? 0 : 1); rep < 2; ++rep) prep_tokens(KIN, args.out, args.ws, F.lds, l, F.wave, F.vcu, F.G, rep == 0 ? 1 : 0);
#endif
 } SEAM(pb + 4);
        if (IN(pb + 5)) {
#if EN_DSA
 for (int rep = (PROBE_PHASE == 6 ? 0 : 1); rep < 2; ++rep) for (int p = F.vcu; p < BATCH * 64; p += F.G) { for (int half = 0; half < 2; ++half) { const int b_ = p >> 6, ub_ = half == 0 ? (p & 63) : 127 - (p & 63);
   sel_pass1(args.ws, F.lds, F.wave, b_, ub_); if (PROBE_PHASE == 61) sel_pass1(args.ws, F.lds, F.wave, b_, ub_); sel_pass2(args.ws, F.lds, F.wave, b_, ub_); if (PROBE_PHASE == 62) sel_pass2(args.ws, F.lds, F.wave, b_, ub_); sel_resolve(args.ws, F.lds, F.wave, b_, ub_, (int)blockIdx.x, (p == F.vcu && half == 0) ? 1 : 0); if (PROBE_PHASE == 63) sel_resolve(args.ws, F.lds, F.wave, b_, ub_, (int)blockIdx.x, 0); } }
 dsa_select_slow(args.ws, F.lds, F.wave, (int)blockIdx.x); for (int rep = (PROBE_PHASE == 7 ? 0 : 1); rep < 2; ++rep) dsa_attend(args.ws, F.lds, args.in[2], F.wave, F.vcu, F.G, rep == 0 ? 1 : 0);
#endif
 } SEAM(pb + 5);
        if (IN(pb + 6)) {
#if !((DIS_MASK >> 3) & 1)
        for (int rep6 = (PROBE_PHASE == 8 ? 0 : 1); rep6 < 2; ++rep6) {
 unsigned char* ws = launder_p(args.ws); bf16* hb = (bf16*)(ws + WS_HB); float* ss = (float*)(ws + WS_SS); (void)hb; (void)ss;
            { pg8::Gemm g{(const bf16_t*)(ws + WS_QL), (const bf16_t*)(ws + WS_WA), M, D, 1024}; pg8::StaticOrder S; S.init(M, D, F.G, launder_s((int)blockIdx.x));
              EpiMerge<0> E{(bf16_t*)(ws + WS_MERGED), (const bf16_t*)(ws + WS_G)};
              pg8::gemm_phase<EpiMerge<0>, pg8::StaticOrder, true, true>(F.lds + RING_OFF, g, S, E, F.wave); }
            { pg8::Gemm g{(const bf16_t*)(ws + WS_YB), (const bf16_t*)(ws + WS_WB), M, D, PW_}; pg8::StaticOrder S; S.init(M, D, F.G, launder_s((int)blockIdx.x));
              EpiMerge<1> E{(bf16_t*)(ws + WS_MERGED), (const bf16_t*)(ws + WS_G)};
              pg8::gemm_phase<EpiMerge<1>, pg8::StaticOrder, true, true>(F.lds + RING_OFF, g, S, E, F.wave); }
            { pg8::Gemm g{(const bf16_t*)(ws + WS_QC), (const bf16_t*)(ws + WS_WC), M, D, CW}; pg8::StaticOrder S; S.init(M, D, F.G, launder_s((int)blockIdx.x));
              EpiMerge<2> E{(bf16_t*)(ws + WS_MERGED), (const bf16_t*)(ws + WS_G)};
              pg8::gemm_phase<EpiMerge<2>, pg8::StaticOrder, true, true>(F.lds + RING_OFF, g, S, E, F.wave); }
        }
#endif
        } SEAM(pb + 6);
        if (IN(pb + 7)) {
#if !((DIS_MASK >> 4) & 1)
 unsigned char* ws = launder_p(args.ws); bf16* hb = (bf16*)(ws + WS_HB); float* ss = (float*)(ws + WS_SS); (void)hb; (void)ss;
            pg8::Gemm g{(const bf16_t*)(ws + WS_MERGED), (const bf16_t*)(ws + WS_WOUT), M, D, D}; pg8::StaticOrder S; S.init(M, D, F.G, launder_s((int)blockIdx.x));
            for (int rep = (PROBE_PHASE == 9 ? 0 : 1); rep < 2; ++rep) { EpiResid E{args.out, args.out, hb, ss, 1.0f, (LAS float*)(F.lds + RING_BYTES), rep == 0 ? 1 : 0};
            pg8::gemm_phase<EpiResid, pg8::StaticOrder, true, true>(F.lds + RING_OFF, g, S, E, F.wave); }
#endif
        } SEAM(pb + 7);
        if (IN(pb + 8)) {
#if !((DIS_MASK >> 5) & 1)
 unsigned char* ws = launder_p(args.ws); bf16* hb = (bf16*)(ws + WS_HB); float* ss = (float*)(ws + WS_SS); (void)hb; (void)ss;
            pg8::Gemm g{hb, (const bf16_t*)(ws + WS_W2IN), M, 2 * DFF, D}; pg8::StaticOrder S; S.init(M, 2 * DFF, F.G, launder_s((int)blockIdx.x));
            EpiSwiglu E{(bf16_t*)(ws + WS_ACT), ss};
            for (int rep = (PROBE_PHASE == 2 ? 0 : 1); rep < 2; ++rep) pg8::gemm_phase<EpiSwiglu, pg8::StaticOrder, true, true>(F.lds + RING_OFF, g, S, E, F.wave);
#endif
        } SEAM(pb + 8);
        if (IN(pb + 9)) {
#if !((DIS_MASK >> 6) & 1)
 unsigned char* ws = launder_p(args.ws); bf16* hb = (bf16*)(ws + WS_HB); float* ss = (float*)(ws + WS_SS); (void)hb; (void)ss;
            pg8::Gemm g{(const bf16_t*)(ws + WS_ACT), (const bf16_t*)(ws + WS_W2OUT), M, D, DFF}; pg8::StaticOrder S; S.init(M, D, F.G, launder_s((int)blockIdx.x));
            for (int rep = (PROBE_PHASE == 3 ? 0 : 1); rep < 2; ++rep) { EpiResid E{args.out, args.out, hb, ss, 0.5f, (LAS float*)(F.lds + RING_BYTES), rep == 0 ? 1 : 0};
            pg8::gemm_phase<EpiResid, pg8::StaticOrder, true, true>(F.lds + RING_OFF, g, S, E, F.wave); }
#endif
        } SEAM(pb + 9);
    }
#if EN_P0
    if (IN(N_PHASES - 1)) { final_norm(KIN, args.out, args.ws, F.lds, F.wave, F.vcu, F.G); }
#endif
#undef IN
#undef SEAM
}

extern "C" void kernel_launch(void* const* d_in, const int* in_sizes, int n_in, void* d_out, int out_size, void* d_ws, size_t ws_size, hipStream_t stream) {
    static int grid = 0;
    if (grid == 0) {
        if (n_in != 23 || in_sizes[0] != M * D || out_size != M * D || ws_size < WS_END) { fprintf(stderr, "kernel_launch: unexpected shapes (n_in %d, ws %zu)\n", n_in, ws_size); grid = -1; return; }
        int dev = 0, cus = 0, per_cu = 0;
        if (hipGetDevice(&dev) != hipSuccess || hipDeviceGetAttribute(&cus, hipDeviceAttributeMultiprocessorCount, dev) != hipSuccess) { grid = -1; return; }
        if (hipFuncSetAttribute((const void*)mk_fwd, hipFuncAttributeMaxDynamicSharedMemorySize, LDS_BYTES) != hipSuccess) { fprintf(stderr, "kernel_launch: hipFuncSetAttribute failed\n"); grid = -1; return; }
        if (hipOccupancyMaxActiveBlocksPerMultiprocessor(&per_cu, (const void*)mk_fwd, NWAVES * 64, LDS_BYTES) != hipSuccess || per_cu < 1) { fprintf(stderr, "kernel_launch: occupancy query says %d\n", per_cu); }
        (void)hipGetLastError();
        grid = cus;
    }
    if (grid < 0) return;
    if (hipMemsetAsync((char*)d_ws + WS_CTL, 0, CTL_ZERO_BYTES, stream) != hipSuccess) return;
    Args a{};
    for (int i = 0; i < 23; ++i) a.in[i] = (const float*)d_in[i];
    a.out = (float*)d_out; a.ws = (unsigned char*)d_ws;
#if MK_ONE_LAUNCH
    a.ph_lo = 0; a.ph_hi = N_PHASES;
    hipLaunchKernelGGL(mk_fwd, dim3(grid), dim3(NWAVES * 64), LDS_BYTES, stream, a);
#endif
}
```

```cpp
#include <hip/hip_runtime.h>
#include <cstdio>
#include <cstdint>

#ifndef MK_ONE_LAUNCH
#define MK_ONE_LAUNCH 1
#endif
#ifndef PROBE_PHASE
#define PROBE_PHASE 0
#endif
#ifndef EN_P0
#define EN_P0 MK_ONE_LAUNCH
#endif
#ifndef EN_PREP
#define EN_PREP MK_ONE_LAUNCH
#endif
#ifndef EN_DSA
#define EN_DSA MK_ONE_LAUNCH
#endif
#ifndef DIS_MASK
#define DIS_MASK 0
#endif
#ifndef MK_ONE_LAUNCH
#define MK_ONE_LAUNCH 1
#endif

__device__ __forceinline__ int lane_id_v() { int l; asm volatile("v_mbcnt_lo_u32_b32 %0, -1, 0\n\tv_mbcnt_hi_u32_b32 %0, -1, %0" : "=v"(l)); return l; }
namespace pg8 {
#define PG8_LAS __attribute__((address_space(3)))
typedef unsigned short bf16_t;
typedef short bf16x8 __attribute__((ext_vector_type(8)));
typedef float f32x4 __attribute__((ext_vector_type(4)));
typedef unsigned u32x4 __attribute__((ext_vector_type(4)));
typedef unsigned u32x2 __attribute__((ext_vector_type(2)));
constexpr int BM = 256, BK = 64, HALF = 128, HTB = HALF * BK * 2, STAGE_BYTES = 8 * HTB, NXCD = 8, WGM = 8;

__host__ __device__ __forceinline__ int lds_byte(int r, int c) { const int st = (r >> 4) * 2 + (c >> 5), rr = r & 15, cc = c & 31, ob = rr * 64 + cc * 2; return st * 1024 + (ob ^ (((ob >> 9) & 1) << 5)); }
__host__ __device__ __forceinline__ void stage_rc(int b, int& R, int& C) { const int st = b / 1024, sb = b % 1024, swz = sb ^ (((sb >> 9) & 1) << 5); R = (st >> 1) * 16 + swz / 64; C = (st & 1) * 32 + (swz % 64) / 2; }
__host__ __device__ __forceinline__ int perm32(int rho) { const int n = rho >> 4, i = rho & 15; return 8 * (i >> 2) + 4 * n + (i & 3); }

struct Unit { int pm, pn; };
struct Gemm { const bf16_t* A; const bf16_t* Bt; int M, N, K; };

struct StaticOrder {
    int nM, nN, nwg, G, c;
    __host__ __device__ void init(int M, int N, int G_, int c_) { nM = M / BM; nN = N / BM; nwg = nM * nN; G = G_; c = c_; }
    __host__ __device__ bool next(int i, Unit& u) const {
        const long L = (long)i * G + c; if (L >= nwg) return false;
        int wgid = (int)L; { const int q = nwg / NXCD, r = nwg % NXCD, xcd = wgid % NXCD, off = wgid / NXCD; wgid = (xcd < r ? xcd * (q + 1) : r * (q + 1) + (xcd - r) * q) + off; }
        const int nig = WGM * nN, gid = wgid / nig, fm = gid * WGM, gsz = (nM - fm) < WGM ? (nM - fm) : WGM;
        u.pm = fm + ((wgid % nig) % gsz); u.pn = (wgid % nig) / gsz; return true;
    }
    __device__ __forceinline__ void a_ready(const Unit&) const {}
    __device__ __forceinline__ void done(const Unit&) const {}
};

__device__ __forceinline__ unsigned cvt_pk_bf16(float lo, float hi) { unsigned r; asm volatile("v_cvt_pk_bf16_f32 %0, %1, %2" : "=v"(r) : "v"(lo), "v"(hi)); return r; }

template <class Epi, class Sched, bool ALIGN_EPI = false, bool SP2 = false>
__device__ __forceinline__ void gemm_phase(PG8_LAS unsigned char* lds, const Gemm g, const Sched& S, const Epi& E, const int wid_) {
    int wid = wid_; asm volatile("" : "+s"(wid));
    const int lane = lane_id_v(), tid = wid * 64 + lane,
              wr = wid >> 2, wc = wid & 3, fr = lane & 15, fq = lane >> 4;
    const int K = g.K, nt = K / BK;
    unsigned voffA[2], voffB[2];
#pragma unroll
    for (int i = 0; i < 2; ++i) { int R, C; stage_rc(tid * 16 + i * 8192, R, C); const int Rb = Epi::PERM ? ((R & ~31) + perm32(R & 31)) : R;
        voffA[i] = (unsigned)(R * K + C) * 2u; voffB[i] = (unsigned)(Rb * K + C) * 2u; }
    const size_t kstep = (size_t)(BK * 2);
    const size_t hstep = (size_t)HALF * K * 2;
    const size_t tstep = 2 * hstep;
    const unsigned ldsw = (unsigned)wid * 1024u;
    const int aoff = lds_byte(wr * 64 + fr, fq * 8), boff = lds_byte(wc * 32 + fr, fq * 8);
#define PG8_SA(b, h) (((b) * 2 + (h)) * HTB)
#define PG8_SB(b, h) ((4 + (b) * 2 + (h)) * HTB)
#define PG8_STAGE(bufoff, gbase, voff) do { _Pragma("unroll") for (int _i = 0; _i < 2; ++_i) \
        __builtin_amdgcn_global_load_lds((const unsigned*)((const char*)(gbase) + (voff)[_i]), (PG8_LAS unsigned*)(lds + (bufoff) + ldsw + _i * 8192), 16, 0, 0); } while (0)
#define PG8_LDA(dst, b, h) do { _Pragma("unroll") for (int m = 0; m < 4; ++m) _Pragma("unroll") for (int k = 0; k < 2; ++k) dst[m][k] = *(const PG8_LAS bf16x8*)(lds + PG8_SA(b, h) + aoff + m * 2048 + k * 1024); } while (0)
#define PG8_LDB(dst, b, h) do { _Pragma("unroll") for (int n = 0; n < 2; ++n) _Pragma("unroll") for (int k = 0; k < 2; ++k) dst[n][k] = *(const PG8_LAS bf16x8*)(lds + PG8_SB(b, h) + boff + n * 2048 + k * 1024); } while (0)
#define PG8_MMA(ai, bj, At, Bt) do { __builtin_amdgcn_s_setprio(1); _Pragma("unroll") for (int m = 0; m < 4; ++m) _Pragma("unroll") for (int n = 0; n < 2; ++n) _Pragma("unroll") for (int k = 0; k < 2; ++k) \
        acc[ai][bj][m][n] = __builtin_amdgcn_mfma_f32_16x16x32_bf16(Bt[n][k], At[m][k], acc[ai][bj][m][n], 0, 0, 0); __builtin_amdgcn_s_setprio(0); } while (0)
#define PG8_WAIT_V(n) asm volatile("s_waitcnt vmcnt(" #n ")" ::: "memory")
#define PG8_WAIT_L(n) asm volatile("s_waitcnt lgkmcnt(" #n ")" ::: "memory")
#define PG8_BAR __builtin_amdgcn_s_barrier()
#define PG8_SCHED __builtin_amdgcn_sched_barrier(0)
    Unit cur, nxt; int ui = 0;
    if (!S.next(0, cur)) return;
    f32x4 acc[2][2][4][2];
#pragma unroll
    for (int a = 0; a < 2; ++a)
#pragma unroll
        for (int b = 0; b < 2; ++b)
#pragma unroll
            for (int m = 0; m < 4; ++m)
#pragma unroll
                for (int n = 0; n < 2; ++n) acc[a][b][m][n] = (f32x4){0.f, 0.f, 0.f, 0.f};
    bf16x8 At[4][2], B0[2][2], B1[2][2];
    const char* cA = (const char*)g.A + (size_t)cur.pm * tstep; const char* cB = (const char*)g.Bt + (size_t)cur.pn * tstep;
    S.a_ready(cur);
    if constexpr (SP2) {
        PG8_STAGE(PG8_SB(0, 0), cB, voffB); PG8_STAGE(PG8_SB(0, 1), cB + hstep, voffB); PG8_STAGE(PG8_SA(0, 0), cA, voffA); PG8_STAGE(PG8_SA(0, 1), cA + hstep, voffA);
        if (wr == 1) PG8_BAR;
        PG8_WAIT_V(2); PG8_BAR;
        PG8_STAGE(PG8_SB(1, 0), cB + kstep, voffB); PG8_STAGE(PG8_SA(1, 0), cA + kstep, voffA); PG8_STAGE(PG8_SB(1, 1), cB + hstep + kstep, voffB);
        PG8_WAIT_V(6); PG8_BAR;
    } else {
        PG8_STAGE(PG8_SB(0, 0), cB, voffB); PG8_STAGE(PG8_SA(0, 0), cA, voffA); PG8_STAGE(PG8_SB(0, 1), cB + hstep, voffB); PG8_STAGE(PG8_SA(0, 1), cA + hstep, voffA);
        if (wr == 1) PG8_BAR;
        PG8_WAIT_V(4); PG8_BAR;
        PG8_STAGE(PG8_SB(1, 0), cB + kstep, voffB); PG8_STAGE(PG8_SA(1, 0), cA + kstep, voffA); PG8_STAGE(PG8_SB(1, 1), cB + hstep + kstep, voffB);
        PG8_WAIT_V(6); PG8_BAR;
    }
    for (;;) {
        const bool has_next = S.next(ui + 1, nxt);
        const char* nA = has_next ? (const char*)g.A + (size_t)nxt.pm * tstep : cA; const char* nB = has_next ? (const char*)g.Bt + (size_t)nxt.pn * tstep : cB;
#pragma nounroll
        for (int t = 0; t < nt; t += 2) {
            const bool last = (t == nt - 2);
            const char* a1 = cA + (size_t)(t + 1) * kstep;
            const char* a2 = last ? nA : cA + (size_t)(t + 2) * kstep; const char* b2 = last ? nB : cB + (size_t)(t + 2) * kstep;
            const char* a3 = a2 + kstep; const char* b3 = b2 + kstep;
            if (last && has_next) S.a_ready(nxt);
            if constexpr (SP2) {
            PG8_LDB(B0, 0, 0); PG8_LDB(B1, 0, 1); PG8_SCHED; PG8_LDA(At, 0, 0); PG8_STAGE(PG8_SA(1, 1), a1 + hstep, voffA);
            PG8_WAIT_V(8); PG8_WAIT_L(0); PG8_BAR; PG8_MMA(0, 0, At, B0); PG8_MMA(0, 1, At, B1); PG8_BAR; PG8_SCHED;
            PG8_LDA(At, 0, 1); PG8_STAGE(PG8_SB(0, 0), b2, voffB); PG8_STAGE(PG8_SB(0, 1), b2 + hstep, voffB); PG8_STAGE(PG8_SA(0, 0), a2, voffA);
            PG8_WAIT_V(8); PG8_WAIT_L(0); PG8_BAR; PG8_MMA(1, 0, At, B0); PG8_MMA(1, 1, At, B1); PG8_BAR; PG8_SCHED;
            PG8_LDB(B0, 1, 0); PG8_LDB(B1, 1, 1); PG8_SCHED; PG8_LDA(At, 1, 0); PG8_STAGE(PG8_SA(0, 1), a2 + hstep, voffA);
            PG8_WAIT_V(8); PG8_WAIT_L(0); PG8_BAR; PG8_MMA(0, 0, At, B0); PG8_MMA(0, 1, At, B1); PG8_BAR; PG8_SCHED;
            PG8_LDA(At, 1, 1); PG8_STAGE(PG8_SB(1, 0), b3, voffB); PG8_STAGE(PG8_SB(1, 1), b3 + hstep, voffB); PG8_STAGE(PG8_SA(1, 0), a3, voffA);
            PG8_WAIT_V(8); PG8_WAIT_L(0); PG8_BAR; PG8_MMA(1, 0, At, B0); PG8_MMA(1, 1, At, B1); PG8_BAR; PG8_SCHED;
            } else {
            PG8_LDB(B0, 0, 0); PG8_SCHED; PG8_LDA(At, 0, 0); PG8_STAGE(PG8_SA(1, 1), a1 + hstep, voffA);
            PG8_WAIT_L(8); PG8_BAR; PG8_WAIT_L(0); PG8_MMA(0, 0, At, B0); PG8_BAR; PG8_SCHED;
            PG8_LDB(B1, 0, 1); PG8_STAGE(PG8_SB(0, 0), b2, voffB);
            PG8_BAR; PG8_WAIT_L(0); PG8_MMA(0, 1, At, B1); PG8_BAR;
            PG8_LDA(At, 0, 1); PG8_STAGE(PG8_SA(0, 0), a2, voffA);
            PG8_BAR; PG8_WAIT_L(0); PG8_MMA(1, 0, At, B0); PG8_BAR; PG8_SCHED;
            PG8_STAGE(PG8_SB(0, 1), b2 + hstep, voffB);
            PG8_WAIT_V(6); PG8_BAR; PG8_MMA(1, 1, At, B1); PG8_BAR;
            PG8_LDB(B0, 1, 0); PG8_SCHED; PG8_LDA(At, 1, 0); PG8_STAGE(PG8_SA(0, 1), a2 + hstep, voffA);
            PG8_WAIT_L(8); PG8_BAR; PG8_WAIT_L(0); PG8_MMA(0, 0, At, B0); PG8_BAR; PG8_SCHED;
            PG8_LDB(B1, 1, 1); PG8_STAGE(PG8_SB(1, 0), b3, voffB);
            PG8_BAR; PG8_WAIT_L(0); PG8_MMA(0, 1, At, B1); PG8_BAR;
            PG8_LDA(At, 1, 1); PG8_STAGE(PG8_SA(1, 0), a3, voffA);
            PG8_BAR; PG8_WAIT_L(0); PG8_MMA(1, 0, At, B0); PG8_BAR; PG8_SCHED;
            PG8_STAGE(PG8_SB(1, 1), b3 + hstep, voffB);
            PG8_WAIT_V(6); PG8_BAR; PG8_MMA(1, 1, At, B1); PG8_BAR;
            }
        }
        if constexpr (ALIGN_EPI) { if (wr == 0) PG8_BAR; }
        E(acc, cur, wr, wc, fr, fq); S.done(cur);
        if (!has_next) break;
#pragma unroll
        for (int a = 0; a < 2; ++a)
#pragma unroll
            for (int b = 0; b < 2; ++b)
#pragma unroll
                for (int m = 0; m < 4; ++m)
#pragma unroll
                    for (int n = 0; n < 2; ++n) acc[a][b][m][n] = (f32x4){0.f, 0.f, 0.f, 0.f};
        cur = nxt; cA = nA; cB = nB; ++ui;
        if constexpr (ALIGN_EPI) { if (wr == 1) PG8_BAR; }
    }
    PG8_WAIT_V(0);
    if constexpr (!ALIGN_EPI) { if (wr == 0) PG8_BAR; }
    PG8_BAR;
#undef PG8_SA
#undef PG8_SB
#undef PG8_STAGE
#undef PG8_LDA
#undef PG8_LDB
#undef PG8_MMA
#undef PG8_WAIT_V
#undef PG8_WAIT_L
#undef PG8_BAR
#undef PG8_SCHED
}
}

constexpr int NWAVES = 8;
constexpr int BATCH = 4, SEQ = 8192, D = 1024, DEPTH = 4, M = BATCH * SEQ;
constexpr int NMEM = 256, MROWS = BATCH * NMEM;
constexpr int AH = 8, AHD = 64, AW = 512, KVR = 128, IH = 8, IDIM = 32, TOPK = 256;
constexpr int PW_ = 256, CH = 4, CHD = 64, CW = 256;
constexpr int DFF = 2816, INW = 4520, INP = 5120;
constexpr float EPS = 1e-6f;
constexpr int C_QA = 0, C_CKV = 512, C_IQ = 640, C_IK = 896, C_IW = 928, C_Z = 936, C_QC = 1192, C_G = 1448;

constexpr size_t MiB = 1u << 20;
constexpr size_t WS_CTL = 0, CTL_ZERO_BYTES = 1 * MiB;
constexpr size_t WS_SS = 1 * MiB;
constexpr size_t WS_IW = 3 * MiB;
constexpr size_t WS_SGN = 4 * MiB;
constexpr size_t WS_MEMN = 5 * MiB;
constexpr size_t WS_WMEM = 7 * MiB;
constexpr size_t WS_MEMKV = 11 * MiB;
constexpr size_t WS_W1IN = 15 * MiB, WS_W1OUT = 26 * MiB, WS_WIN = 32 * MiB, WS_WA = 42 * MiB, WS_WB = 44 * MiB, WS_WC = 44 * MiB + 512 * 1024, WS_WOUT = 45 * MiB, WS_W2IN = 47 * MiB, WS_W2OUT = 58 * MiB;
constexpr size_t WS_HB = 64 * MiB;
constexpr size_t WS_ACT = 128 * MiB;
constexpr size_t WS_G = 128 * MiB;
constexpr size_t WS_QL = 320 * MiB;
constexpr size_t WS_CKV = 384 * MiB;
constexpr size_t WS_CKVRAW = 392 * MiB;
constexpr size_t WS_IQRAW = 408 * MiB;
constexpr size_t WS_IQF = 424 * MiB;
constexpr size_t WS_IK = 440 * MiB;
constexpr size_t WS_Z = 442 * MiB;
constexpr size_t WS_MERGED = 384 * MiB;
constexpr size_t WS_YB = 458 * MiB;
constexpr size_t WS_QC = 474 * MiB;
constexpr size_t WS_SEL = 490 * MiB;
constexpr size_t WS_VT = 506 * MiB;
constexpr size_t WS_WPT = 4 * MiB + 512 * 1024;
constexpr size_t WS_END = 510 * MiB;
constexpr int CW_BAR = 4096;

constexpr int RING_OFF = 0, RING_BYTES = 131072;
constexpr int LDS_BYTES = 155648;
constexpr int MISC_OFF = LDS_BYTES - 256;

#define GAS __attribute__((address_space(1)))
#define LAS __attribute__((address_space(3)))
typedef unsigned short bf16;
typedef unsigned v4u __attribute__((ext_vector_type(4)));
typedef unsigned v2u __attribute__((ext_vector_type(2)));
typedef float f32x4 __attribute__((ext_vector_type(4)));
typedef float f32x2 __attribute__((ext_vector_type(2)));
typedef GAS unsigned gu32;
#define RLX_AGENT __ATOMIC_RELAXED, __HIP_MEMORY_SCOPE_AGENT
#define LDS_WAIT() asm volatile("s_waitcnt lgkmcnt(0)" ::: "memory")
#define VM_WAIT() asm volatile("s_waitcnt vmcnt(0)" ::: "memory")
__device__ __forceinline__ unsigned f2bf(float f) { unsigned u = __builtin_bit_cast(unsigned, f); return (u + 0x7fffu + ((u >> 16) & 1u)) >> 16; }
__device__ __forceinline__ unsigned pk2(float lo, float hi) { return pg8::cvt_pk_bf16(lo, hi); }
__device__ __forceinline__ float bflo(unsigned w) { return __builtin_bit_cast(float, w << 16); }
__device__ __forceinline__ float bfhi(unsigned w) { return __builtin_bit_cast(float, w & 0xffff0000u); }
typedef _Float16 h2_t __attribute__((ext_vector_type(2)));
typedef _Float16 f16x8_t __attribute__((ext_vector_type(8)));
__device__ __forceinline__ unsigned pkh2(float lo, float hi) { const h2_t v = {(_Float16)lo, (_Float16)hi}; return __builtin_bit_cast(unsigned, v); }
__device__ __forceinline__ float hlo(unsigned w) { return (float)__builtin_bit_cast(h2_t, w)[0]; }
__device__ __forceinline__ float hhi(unsigned w) { return (float)__builtin_bit_cast(h2_t, w)[1]; }
__device__ __forceinline__ float bf2f(bf16 b) { return __builtin_bit_cast(float, ((unsigned)b) << 16); }

#define XB_TMO      128
#define XB_XCNT(j)  (256  + 64 * (j))
#define XB_XSUB(j)  (1280 + 64 * (j))
#define XB_XGEN(j)  (2304 + 64 * (j))
#define XB_TOP      3328
#define XB_TOPGEN   3392
#define XCD_BAR_WORDS 3456
#define XB_SPIN_CAP (1u << 23)

__device__ __forceinline__ unsigned xb_ld(unsigned* p)              { return __hip_atomic_load(p, __ATOMIC_RELAXED, __HIP_MEMORY_SCOPE_AGENT); }
__device__ __forceinline__ unsigned xb_add(unsigned* p, unsigned v) { return __hip_atomic_fetch_add(p, v, __ATOMIC_RELAXED, __HIP_MEMORY_SCOPE_AGENT); }
__device__ __forceinline__ unsigned xb_xcc_id() { return (unsigned)__builtin_amdgcn_s_getreg((3 << 11) | 20) & 0xFu; }
#define XB_SPIN(cond, bar) do { unsigned _sp = 0; while (cond) { __builtin_amdgcn_s_sleep(1); \
    if ((++_sp & 255u) == 0u) { if (xb_ld(&(bar)[XB_TMO])) break; if (_sp > XB_SPIN_CAP) { atomicAdd(&(bar)[XB_TMO], 1u); break; } } } } while (0)

struct XcdBarrier { unsigned* bar; unsigned x; volatile LAS unsigned* st; int wave; };

__device__ __forceinline__ XcdBarrier xcd_barrier_post(unsigned* bar, volatile LAS unsigned* st, int wave) {
    XcdBarrier b; b.bar = bar; b.x = xb_xcc_id(); b.st = st; b.wave = wave;
    if (threadIdx.x == 0) (void)xb_add(&bar[XB_XCNT(b.x)], 1u);
    return b;
}
__device__ __forceinline__ void xcd_barrier_complete(unsigned* bar, unsigned x, unsigned& nloc, unsigned& nx) {
    const unsigned G = gridDim.x * gridDim.y * gridDim.z;
    unsigned sum, cnt, mine, sp = 0u;
    for (;;) {
        sum = 0u; cnt = 0u; mine = 0u;
#pragma unroll
        for (unsigned j = 0; j < 16; ++j) { const unsigned c = xb_ld(&bar[XB_XCNT(j)]); sum += c; cnt += (c > 0u) ? 1u : 0u; mine = (j == x) ? c : mine; }
        if (sum == G) break;
        __builtin_amdgcn_s_sleep(1);
        if ((++sp & 255u) == 0u) { if (xb_ld(&bar[XB_TMO])) break; if (sp > XB_SPIN_CAP) { atomicAdd(&bar[XB_TMO], 1u); break; } }
    }
    nloc = mine > 0u ? mine : 1u; nx = cnt > 0u ? cnt : 1u;
}
__device__ __forceinline__ void xcd_barrier(const XcdBarrier& b) {
    asm volatile("s_waitcnt vmcnt(0)" ::: "memory");
    __syncthreads();
    int bw_ = b.wave; asm volatile("" : "+s"(bw_));
    if (bw_ == 0 && lane_id_v() == 0) {
        unsigned* bar = b.bar;
        __builtin_amdgcn_s_waitcnt(0);
        unsigned nloc = b.st[0], nx = b.st[1];
        if (nloc == 0u) { xcd_barrier_complete(bar, b.x, nloc, nx); b.st[0] = nloc; b.st[1] = nx; }
        const unsigned old = xb_add(&bar[XB_XSUB(b.x)], 1u);
        const unsigned gen = old / nloc;
        if (old + 1u == (gen + 1u) * nloc) {
            __builtin_amdgcn_fence(__ATOMIC_RELEASE, "agent");
            asm volatile("s_waitcnt vmcnt(0)" ::: "memory");
            const unsigned og = xb_add(&bar[XB_TOP], 1u);
            const unsigned tg = og / nx;
            if (og + 1u == (tg + 1u) * nx) xb_add(&bar[XB_TOPGEN], 1u);
            else XB_SPIN(xb_ld(&bar[XB_TOPGEN]) == tg, bar);
            __builtin_amdgcn_fence(__ATOMIC_ACQUIRE, "agent");
            xb_add(&bar[XB_XGEN(b.x)], 1u);
            asm volatile("s_waitcnt vmcnt(0)" ::: "memory");
        } else {
            XB_SPIN(xb_ld(&bar[XB_XGEN(b.x)]) == gen, bar);
            __builtin_amdgcn_fence(__ATOMIC_ACQUIRE, "agent");
            asm volatile("s_waitcnt vmcnt(0)" ::: "memory");
        }
    }
    __syncthreads();
}

struct Args {
    const float* in[23]; float* out; unsigned char* ws; int ph_lo, ph_hi;
};
template <class T> __device__ __forceinline__ T* uni(T* p) { const unsigned long long v = (unsigned long long)p; const unsigned lo = __builtin_amdgcn_readfirstlane((unsigned)v), hi = __builtin_amdgcn_readfirstlane((unsigned)(v >> 32)); return (T*)(((unsigned long long)hi << 32) | lo); }
__device__ __forceinline__ LAS unsigned char* uni_l(LAS unsigned char* p) { return (LAS unsigned char*)(unsigned)__builtin_amdgcn_readfirstlane((int)(unsigned)(size_t)p); }
__device__ __forceinline__ int uni_i(int v) { return __builtin_amdgcn_readfirstlane(v); }
struct PC { const float* const* in; float* out; unsigned char* ws; LAS unsigned char* lds; int wave, vcu, G; };
struct Frame {
    LAS unsigned char* lds;
    volatile LAS unsigned* MISC;
    gu32* ctl;
    int wave, vcu, G;
    unsigned char* ws;
};
__device__ __forceinline__ unsigned char* launder_p(unsigned char* p) { asm volatile("" : "+s"(p)); return p; }
__device__ __forceinline__ int launder_s(int v) { asm volatile("" : "+s"(v)); return v; }
__device__ __forceinline__ int launder_v(int v) { asm volatile("" : "+v"(v)); return v; }
__device__ __forceinline__ float wave_sum(float v) {
#pragma unroll
    for (int o = 1; o < 64; o <<= 1) v += __shfl_xor(v, o);
    return v;
}
__device__ __forceinline__ float wave_max(float v) {
#pragma unroll
    for (int o = 1; o < 64; o <<= 1) v = fmaxf(v, __shfl_xor(v, o));
    return v;
}

using pg8::Unit; using pg8::bf16_t;
#define LAUNDER2(a, b) asm volatile("" : "+v"(a), "+v"(b))
__device__ __forceinline__ float row_scale(const float* ss, int row) {
    const f32x4 a = *(const f32x4*)(ss + (size_t)row * 4);
    const float s = (a.x + a.y) + (a.z + a.w);
    return __builtin_amdgcn_rsqf(s * (1.0f / D) + EPS);
}
__device__ __forceinline__ float sigmoidf_(float x) { return __builtin_amdgcn_rcpf(1.0f + __expf(-x)); }
__device__ __forceinline__ pg8::u32x2 pack4(const f32x4 v) { pg8::u32x2 w; w.x = pg8::cvt_pk_bf16(v[0], v[1]); w.y = pg8::cvt_pk_bf16(v[2], v[3]); return w; }

struct EpiSwiglu {
    static constexpr bool PERM = true;
    bf16_t* O; const float* ss;
    __device__ __forceinline__ void operator()(const f32x4 (&acc)[2][2][4][2], const Unit& u, int wr, int wc, int fr_, int fq_) const {
        const int l_ = lane_id_v(); const int fr = l_ & 15, fq = l_ >> 4; (void)fr_; (void)fq_;
        int rb = wr * 64 + fr, cb = wc * 32 + 8 * fq; LAUNDER2(rb, cb);
        const int row0 = u.pm * 256 + rb, col0 = u.pn * 128 + cb;
#pragma unroll
        for (int ai = 0; ai < 2; ++ai)
#pragma unroll
            for (int m = 0; m < 4; ++m) { const int row = row0 + ai * 128 + m * 16;
                const f32x4 sq = *(const f32x4*)(ss + (size_t)row * 4); const float k = ((sq.x + sq.y) + (sq.z + sq.w)) * (1.0f / D) + EPS; const float c1 = __builtin_amdgcn_rsqf(k) * -1.4426950408889634f;
                pg8::u32x4 w;
                { const f32x4 a = acc[ai][0][m][0], b = acc[ai][1][m][0]; f32x4 o;
#pragma unroll
                  for (int i = 0; i < 4; ++i) o[i] = (a[i] * b[i]) * __builtin_amdgcn_rcpf(fmaf(__builtin_amdgcn_exp2f(a[i] * c1), k, k));
                  w.x = pg8::cvt_pk_bf16(o[0], o[1]); w.y = pg8::cvt_pk_bf16(o[2], o[3]); }
                { const f32x4 a = acc[ai][0][m][1], b = acc[ai][1][m][1]; f32x4 o;
#pragma unroll
                  for (int i = 0; i < 4; ++i) o[i] = (a[i] * b[i]) * __builtin_amdgcn_rcpf(fmaf(__builtin_amdgcn_exp2f(a[i] * c1), k, k));
                  w.z = pg8::cvt_pk_bf16(o[0], o[1]); w.w = pg8::cvt_pk_bf16(o[2], o[3]); }
                *(pg8::u32x4*)(O + (size_t)row * DFF + col0) = w; }
    }
};
struct EpiResid {
    static constexpr bool PERM = true;
    const float* base; float* out; bf16_t* hb; float* ss; float alpha; LAS float* P; int dry;
    __device__ __forceinline__ void operator()(const f32x4 (&acc)[2][2][4][2], const Unit& u, int wr, int wc, int fr_, int fq_) const {
        const int l_ = lane_id_v(); const int fr = l_ & 15, fq = l_ >> 4; (void)fr_; (void)fq_;
        int rb = wr * 64 + fr, cb = wc * 32 + 8 * fq; LAUNDER2(rb, cb);
        const int row0 = u.pm * 256 + rb, col0 = u.pn * 256 + cb;
#pragma unroll
        for (int ai = 0; ai < 2; ++ai)
#pragma unroll
          for (int mh = 0; mh < 2; ++mh) {
            f32x4 bs[2][2][2];
#pragma unroll
            for (int mm = 0; mm < 2; ++mm) { const size_t off = (size_t)(row0 + ai * 128 + (2 * mh + mm) * 16) * D + col0;
#pragma unroll
                for (int bj = 0; bj < 2; ++bj)
#pragma unroll
                    for (int n = 0; n < 2; ++n) bs[mm][bj][n] = *(const f32x4*)(base + off + bj * 128 + n * 4); }
#pragma unroll
            for (int mm = 0; mm < 2; ++mm) { const int m = 2 * mh + mm; const int row = row0 + ai * 128 + m * 16; const size_t off = (size_t)row * D + col0; float q = 0.f;
#pragma unroll
                for (int bj = 0; bj < 2; ++bj) { const f32x4 v0 = bs[mm][bj][0] + acc[ai][bj][m][0] * alpha, v1 = bs[mm][bj][1] + acc[ai][bj][m][1] * alpha;
                    if (!dry) { *(f32x4*)(out + off + bj * 128) = v0; *(f32x4*)(out + off + bj * 128 + 4) = v1;
                        pg8::u32x4 w; w.x = pg8::cvt_pk_bf16(v0[0], v0[1]); w.y = pg8::cvt_pk_bf16(v0[2], v0[3]); w.z = pg8::cvt_pk_bf16(v1[0], v1[1]); w.w = pg8::cvt_pk_bf16(v1[2], v1[3]);
                        *(pg8::u32x4*)(hb + off + bj * 128) = w; }
                    q += ((v0[0] * v0[0] + v0[1] * v0[1]) + (v0[2] * v0[2] + v0[3] * v0[3])) + ((v1[0] * v1[0] + v1[1] * v1[1]) + (v1[2] * v1[2] + v1[3] * v1[3])); }
                q += __shfl_xor(q, 16); q += __shfl_xor(q, 32);
                if (fq == 0) P[(rb + ai * 128 + m * 16) * 4 + wc] = q; }
            asm volatile("" ::: "memory"); }
        asm volatile("s_waitcnt lgkmcnt(0)" ::: "memory"); __builtin_amdgcn_s_barrier(); asm volatile("" ::: "memory");
        const int tid = (wr * 4 + wc) * 64 + fq * 16 + fr;
        if (tid < 256 && !dry) { const f32x4 p = *(const LAS f32x4*)(P + tid * 4); ss[(size_t)(u.pm * 256 + tid) * 4 + u.pn] = (p.x + p.y) + (p.z + p.w); }
    }
};
struct EpiPlainBf16 {
    static constexpr bool PERM = false;
    bf16_t* O; int ldo;
    __device__ __forceinline__ void operator()(const f32x4 (&acc)[2][2][4][2], const Unit& u, int wr, int wc, int fr_, int fq_) const {
        const int l_ = lane_id_v(); const int fr = l_ & 15, fq = l_ >> 4; (void)fr_; (void)fq_;
        int rb = wr * 64 + fr, cb = wc * 32 + 4 * fq; LAUNDER2(rb, cb);
        const int row0 = u.pm * 256 + rb, col0 = u.pn * 256 + cb;
#pragma unroll
        for (int ai = 0; ai < 2; ++ai)
#pragma unroll
            for (int m = 0; m < 4; ++m) { bf16_t* rowp = O + (size_t)(row0 + ai * 128 + m * 16) * ldo + col0;
#pragma unroll
                for (int bj = 0; bj < 2; ++bj)
#pragma unroll
                    for (int n = 0; n < 2; ++n) *(pg8::u32x2*)(rowp + bj * 128 + n * 16) = pack4(acc[ai][bj][m][n]); }
    }
};
struct EpiInProj {
    static constexpr bool PERM = true;
    const float* ss; bf16_t* qa; float* ckvraw; bf16_t* ik; float* iw; bf16_t* iqraw; bf16_t* z; bf16_t* qc; bf16_t* G;
    __device__ __forceinline__ void operator()(const f32x4 (&acc)[2][2][4][2], const Unit& u, int wr, int wc, int fr_, int fq_) const {
        const int l_ = lane_id_v(); const int fr = l_ & 15, fq = l_ >> 4; (void)fr_; (void)fq_;
        int rb = wr * 64 + fr, ct = wc * 32 + 8 * fq; LAUNDER2(rb, ct);
        const int row0 = u.pm * 256 + rb; const int pn = u.pn;
        if (pn == 4) {
#pragma unroll
            for (int ai = 0; ai < 2; ++ai)
#pragma unroll
                for (int m = 0; m < 4; ++m) { const int row = row0 + ai * 128 + m * 16; const float s = row_scale(ss, row);
#pragma unroll
                    for (int n = 0; n < 2; ++n) *(f32x4*)(ckvraw + (size_t)row * KVR + ct + n * 4) = acc[ai][0][m][n] * s;
                    if (wc == 0) { const f32x4 k0 = acc[ai][1][m][0] * s, k1 = acc[ai][1][m][1] * s; pg8::u32x4 w; w.x = pkh2(k0[0], k0[1]); w.y = pkh2(k0[2], k0[3]); w.z = pkh2(k1[0], k1[1]); w.w = pkh2(k1[2], k1[3]);
                        *(pg8::u32x4*)(ik + (size_t)row * IDIM + 8 * fq) = w; }
                    if (wc == 1 && fq == 0) { *(f32x4*)(iw + (size_t)row * IH) = acc[ai][1][m][0] * s; *(f32x4*)(iw + (size_t)row * IH + 4) = acc[ai][1][m][1] * s; } }
        } else {
            bf16_t* dst0; int ld; bool sig = false; const bool f16out = (pn == 5);
            if (pn < 4) { dst0 = qa + pn * 256; ld = 1024; } else if (pn == 5) { dst0 = iqraw; ld = 256; } else if (pn == 6) { dst0 = z; ld = 256; } else if (pn == 7) { dst0 = qc; ld = 256; } else { dst0 = G + (pn - 8) * 256; ld = 3072; sig = true; }
#pragma unroll
            for (int ai = 0; ai < 2; ++ai)
#pragma unroll
                for (int m = 0; m < 4; ++m) { const int row = row0 + ai * 128 + m * 16; const float s = row_scale(ss, row); bf16_t* rowp = dst0 + (size_t)row * ld + ct;
#pragma unroll
                    for (int bj = 0; bj < 2; ++bj) { f32x4 o0, o1;
                        if (sig) { const float c1 = s * -1.4426950408889634f;
#pragma unroll
                            for (int i = 0; i < 4; ++i) { o0[i] = __builtin_amdgcn_rcpf(1.0f + __builtin_amdgcn_exp2f(acc[ai][bj][m][0][i] * c1)); o1[i] = __builtin_amdgcn_rcpf(1.0f + __builtin_amdgcn_exp2f(acc[ai][bj][m][1][i] * c1)); } }
                        else { o0 = acc[ai][bj][m][0] * s; o1 = acc[ai][bj][m][1] * s; }
                        pg8::u32x4 wo;
                        if (f16out) { wo.x = pkh2(o0[0], o0[1]); wo.y = pkh2(o0[2], o0[3]); wo.z = pkh2(o1[0], o1[1]); wo.w = pkh2(o1[2], o1[3]); }
                        else { wo.x = pg8::cvt_pk_bf16(o0[0], o0[1]); wo.y = pg8::cvt_pk_bf16(o0[2], o0[3]); wo.z = pg8::cvt_pk_bf16(o1[0], o1[1]); wo.w = pg8::cvt_pk_bf16(o1[2], o1[3]); }
                        *(pg8::u32x4*)(rowp + bj * 128) = wo; } }
        }
    }
};
template <int MODE> struct EpiMerge {
    static constexpr bool PERM = true;
    bf16_t* Mg; const bf16_t* G;
    __device__ __forceinline__ void operator()(const f32x4 (&acc)[2][2][4][2], const Unit& u, int wr, int wc, int fr_, int fq_) const {
        const int l_ = lane_id_v(); const int fr = l_ & 15, fq = l_ >> 4; (void)fr_; (void)fq_;
        int rb = wr * 64 + fr, cb = wc * 32 + 8 * fq; LAUNDER2(rb, cb);
        const int row0 = u.pm * 256 + rb, col0 = u.pn * 256 + cb;
#pragma unroll
        for (int ai = 0; ai < 2; ++ai)
#pragma unroll
          for (int mh = 0; mh < 1; ++mh) {
            pg8::u32x4 gw[4][2], pw[4][2];
#pragma unroll
            for (int mm = 0; mm < 4; ++mm) { const int row = row0 + ai * 128 + mm * 16;
#pragma unroll
                for (int bj = 0; bj < 2; ++bj) { gw[mm][bj] = *(const pg8::u32x4*)(G + (size_t)row * 3072 + MODE * 1024 + col0 + bj * 128);
                    if (MODE > 0) pw[mm][bj] = *(const pg8::u32x4*)(Mg + (size_t)row * D + col0 + bj * 128); } }
#pragma unroll
            for (int mm = 0; mm < 4; ++mm) { const int m = mm; const int row = row0 + ai * 128 + m * 16;
#pragma unroll
                for (int bj = 0; bj < 2; ++bj) { const pg8::u32x4 g4 = gw[mm][bj];
                    f32x4 o0 = acc[ai][bj][m][0], o1 = acc[ai][bj][m][1];
                    o0[0] *= bflo(g4.x); o0[1] *= bfhi(g4.x); o0[2] *= bflo(g4.y); o0[3] *= bfhi(g4.y); o1[0] *= bflo(g4.z); o1[1] *= bfhi(g4.z); o1[2] *= bflo(g4.w); o1[3] *= bfhi(g4.w);
                    if (MODE > 0) { const pg8::u32x4 p4 = pw[mm][bj];
                        o0[0] += bflo(p4.x); o0[1] += bfhi(p4.x); o0[2] += bflo(p4.y); o0[3] += bfhi(p4.y); o1[0] += bflo(p4.z); o1[1] += bfhi(p4.z); o1[2] += bflo(p4.w); o1[3] += bfhi(p4.w); }
                    pg8::u32x4 w; w.x = pg8::cvt_pk_bf16(o0[0], o0[1]); w.y = pg8::cvt_pk_bf16(o0[2], o0[3]); w.z = pg8::cvt_pk_bf16(o1[0], o1[1]); w.w = pg8::cvt_pk_bf16(o1[2], o1[3]);
                    *(pg8::u32x4*)(Mg + (size_t)row * D + col0 + bj * 128) = w; } }
            asm volatile("" ::: "memory"); }
    }
};

template <class Map>
__device__ __forceinline__ void transpose_item(const float* W, int K, int N, const float* gain, bf16* WT, LAS float* scr, int item, int lane, Map map) {
    const int nblk = (N + 63) / 64, kb = item / nblk, nb = item % nblk, k0 = 64 * kb, n0 = 64 * nb;
    const int nn = n0 + 4 * (lane & 15); const bool nok = nn < N;
#pragma unroll 4
    for (int i = 0; i < 16; ++i) { const int kk = 4 * i + (lane >> 4); f32x4 v = nok ? *(const f32x4*)(W + (size_t)(k0 + kk) * N + nn) : (f32x4){0.f, 0.f, 0.f, 0.f};
        if (gain) v = v * gain[k0 + kk];
        *(LAS f32x4*)(scr + kk * 68 + 4 * (lane & 15)) = v; }
    LDS_WAIT(); asm volatile("" ::: "memory");
    const int c = lane & 7;
#pragma unroll
    for (int j = 0; j < 8; ++j) { const int n = (lane >> 3) + 8 * j; const LAS float* sp = scr + (8 * c) * 68 + n;
        v4u o; o.x = pk2(sp[0 * 68], sp[1 * 68]); o.y = pk2(sp[2 * 68], sp[3 * 68]); o.z = pk2(sp[4 * 68], sp[5 * 68]); o.w = pk2(sp[6 * 68], sp[7 * 68]);
        if (n0 + n < N) { const int dr = map(n0 + n); if (dr >= 0) *(GAS v4u*)(WT + (size_t)dr * K + k0 + 8 * c) = o; } }
    LDS_WAIT(); asm volatile("" ::: "memory");
}
struct MapId { int off; __device__ __forceinline__ int operator()(int n) const { return off + n; } };
struct MapSwiglu { __device__ __forceinline__ int operator()(int c) const { const int half = c >= DFF ? 1 : 0, j = c - half * DFF; return 256 * (j >> 7) + 128 * half + (j & 127); } };
struct MapInProj { __device__ __forceinline__ int operator()(int c) const {
    if (c < C_CKV) return -1;
    if (c < C_IQ) return 1024 + (c - C_CKV);
    if (c < C_IK) return 1280 + (c - C_IQ);
    if (c < C_IW) return 1152 + (c - C_IK);
    if (c < C_Z) return 1184 + (c - C_IW);
    if (c < C_QC) return 1536 + (c - C_Z);
    if (c < C_G) return 1792 + (c - C_QC);
    return 2048 + (c - C_G); } };
__device__ __forceinline__ void qlat_item(const float* win, const float* mixn, const float* wuk, bf16* WT, int item, int lane) {
    const int kc = item & 127, rh = (item >> 7) & 1, h = item >> 8; const int r = rh * 64 + lane;
    const f32x4* wp = (const f32x4*)(wuk + (size_t)r * (AH * AHD) + h * 64);
    float acc[8] = {0.f, 0.f, 0.f, 0.f, 0.f, 0.f, 0.f, 0.f};
#pragma unroll 1
    for (int dc = 0; dc < 4; ++dc) {
        const f32x4 w0 = wp[4 * dc], w1 = wp[4 * dc + 1], w2 = wp[4 * dc + 2], w3 = wp[4 * dc + 3];
#pragma unroll
        for (int kk = 0; kk < 8; ++kk) { const f32x4* ip = (const f32x4*)(win + (size_t)(kc * 8 + kk) * INW + h * 64 + 16 * dc);
            const f32x4 a0 = ip[0], a1 = ip[1], a2 = ip[2], a3 = ip[3];
            acc[kk] += (a0.x * w0.x + a0.y * w0.y + a0.z * w0.z + a0.w * w0.w) + (a1.x * w1.x + a1.y * w1.y + a1.z * w1.z + a1.w * w1.w)
                     + (a2.x * w2.x + a2.y * w2.y + a2.z * w2.z + a2.w * w2.w) + (a3.x * w3.x + a3.y * w3.y + a3.z * w3.z + a3.w * w3.w);
            if (kk & 1) asm volatile("" ::: "memory"); }
    }
    const f32x4 g0 = *(const f32x4*)(mixn + kc * 8), g1 = *(const f32x4*)(mixn + kc * 8 + 4);
    v4u w; w.x = pk2(acc[0] * g0.x, acc[1] * g0.y); w.y = pk2(acc[2] * g0.z, acc[3] * g0.w); w.z = pk2(acc[4] * g1.x, acc[5] * g1.y); w.w = pk2(acc[6] * g1.z, acc[7] * g1.w);
    *(GAS v4u*)(WT + (size_t)(h * 128 + r) * D + kc * 8) = w;
}
__device__ __forceinline__ void wafold_item(const float* wuv, const float* wba, bf16* WT, int item, int lane) {
    const int ng = item & 15, rg = (item >> 4) & 15, h = item >> 8; const int n = ng * 64 + lane, r0 = rg * 8;
    float acc[8] = {0.f, 0.f, 0.f, 0.f, 0.f, 0.f, 0.f, 0.f};
#pragma unroll 4
    for (int d = 0; d < 64; ++d) { const float wa = wba[(size_t)(h * 64 + d) * D + n];
#pragma unroll
        for (int j = 0; j < 8; ++j) acc[j] += wuv[(size_t)(r0 + j) * (AH * AHD) + h * 64 + d] * wa; }
    v4u w; w.x = pk2(acc[0], acc[1]); w.y = pk2(acc[2], acc[3]); w.z = pk2(acc[4], acc[5]); w.w = pk2(acc[6], acc[7]);
    *(GAS v4u*)(WT + (size_t)n * 1024 + h * 128 + r0) = w;
}
__device__ __forceinline__ int items_of(int K, int N) { return (K / 64) * ((N + 63) / 64); }

__device__ __forceinline__ void prep_layer_weights_body(const PC& F, int l) {
    struct { const float* const* in; } a{F.in};
    const int lane_ = lane_id_v();
    LAS float* scr = (LAS float*)(F.lds + RING_OFF + F.wave * 17408);
    const int gw = F.vcu * NWAVES + F.wave, NGW = F.G * NWAVES;
    const float* f1n = a.in[3] + (size_t)l * D; const float* f1in = a.in[4] + (size_t)l * D * 2 * DFF; const float* f1out = a.in[5] + (size_t)l * DFF * D;
    const float* mixn = a.in[6] + (size_t)l * D; const float* win = a.in[7] + (size_t)l * D * INW;
    const float* wba = a.in[15] + (size_t)l * AW * D; const float* wbb = a.in[16] + (size_t)l * PW_ * D; const float* wbc = a.in[17] + (size_t)l * CW * D;
    const float* wout = a.in[18] + (size_t)l * D * D;
    const float* f2n = a.in[19] + (size_t)l * D; const float* f2in = a.in[20] + (size_t)l * D * 2 * DFF; const float* f2out = a.in[21] + (size_t)l * DFF * D;
    unsigned char* ws = launder_p(F.ws);
    const float* wuk = a.in[9] + (size_t)l * KVR * AH * AHD; const float* wuv = a.in[10] + (size_t)l * KVR * AH * AHD;
    const int I0 = items_of(D, 2 * DFF), I1 = items_of(DFF, D), I2 = items_of(D, INW), I4 = items_of(PW_, D), I5 = items_of(CW, D), I6 = items_of(D, D);
    const int NIT = 2 * I0 + 2 * I1 + I2 + I4 + I5 + I6;
#pragma unroll 1
    for (int it = gw; it < NIT; it += NGW) {
        int r = it;
        if (r < I0) { transpose_item(f1in, D, 2 * DFF, f1n, (bf16*)(ws + WS_W1IN), scr, r, lane_, MapSwiglu{}); continue; } r -= I0;
        if (r < I0) { transpose_item(f2in, D, 2 * DFF, f2n, (bf16*)(ws + WS_W2IN), scr, r, lane_, MapSwiglu{}); continue; } r -= I0;
        if (r < I1) { transpose_item(f1out, DFF, D, nullptr, (bf16*)(ws + WS_W1OUT), scr, r, lane_, MapId{0}); continue; } r -= I1;
        if (r < I1) { transpose_item(f2out, DFF, D, nullptr, (bf16*)(ws + WS_W2OUT), scr, r, lane_, MapId{0}); continue; } r -= I1;
        if (r < I2) { transpose_item(win, D, INW, mixn, (bf16*)(ws + WS_WIN), scr, r, lane_, MapInProj{}); continue; } r -= I2;
        if (r < I4) { transpose_item(wbb, PW_, D, nullptr, (bf16*)(ws + WS_WB), scr, r, lane_, MapId{0}); continue; } r -= I4;
        if (r < I5) { transpose_item(wbc, CW, D, nullptr, (bf16*)(ws + WS_WC), scr, r, lane_, MapId{0}); continue; } r -= I5;
        transpose_item(wout, D, D, nullptr, (bf16*)(ws + WS_WOUT), scr, r, lane_, MapId{0});
    }
    { const float* wpool = a.in[11] + (size_t)l * 4 * 64 * 64; bf16* wpT = (bf16*)(ws + WS_WPT);
      for (int i = gw * 64 + lane_; i < 4 * 64 * 64; i += NGW * 64) { const int c = i & 63, d = (i >> 6) & 63, g = i >> 12; wpT[i] = (bf16)f2bf(wpool[(g * 64 + c) * 64 + d]); } }
    asm volatile("" ::: "memory");
#pragma unroll 1
    for (int it = gw; it < 2048; it += NGW) wafold_item(wuv, wba, (bf16*)(ws + WS_WA), it, lane_);
    asm volatile("" ::: "memory");
#pragma unroll 1
    for (int it = gw; it < 2048; it += NGW) qlat_item(win, mixn, wuk, (bf16*)(ws + WS_WIN), it, lane_);
}

__device__ __noinline__ void p0_prologue(const float* const* in_, float* out_, unsigned char* ws_, LAS unsigned char* lds_, int wave_, int vcu_, int G_) {
    const PC F{uni(in_), uni(out_), uni(ws_), uni_l(lds_), uni_i(wave_), uni_i(vcu_), uni_i(G_)}; struct { const float* const* in; } a{F.in};
    const int lane_ = lane_id_v();
    const int gw = F.vcu * NWAVES + F.wave, NGW = F.G * NWAVES;
    const float* x = a.in[0]; const float* mem = a.in[1];
    bf16* hb = (bf16*)(F.ws + WS_HB); float* ss = (float*)(F.ws + WS_SS); bf16* memn = (bf16*)(F.ws + WS_MEMN);
    for (int m = gw; m < M + MROWS; m += NGW) {
        const bool ismem = m >= M; const int r = ismem ? m - M : m;
        const GAS f32x4* xr = (const GAS f32x4*)((ismem ? mem : x) + (size_t)r * D) + lane_;
        f32x4 v[4]; float s = 0.f;
#pragma unroll
        for (int j = 0; j < 4; ++j) { v[j] = xr[64 * j]; s += (v[j].x * v[j].x + v[j].y * v[j].y) + (v[j].z * v[j].z + v[j].w * v[j].w); }
        s = wave_sum(s);
        float sc = 1.f;
        if (ismem) sc = 1.0f / sqrtf(s * (1.0f / D) + EPS);
        else if (lane_ < 4) ss[(size_t)r * 4 + lane_] = lane_ == 0 ? s : 0.f;
        GAS unsigned long long* o8 = (GAS unsigned long long*)((ismem ? memn : hb) + (size_t)r * D) + lane_;
#pragma unroll
        for (int j = 0; j < 4; ++j) o8[64 * j] = (unsigned long long)pk2(v[j].x * sc, v[j].y * sc) | ((unsigned long long)pk2(v[j].z * sc, v[j].w * sc) << 32);
    }
    LAS float* scr = (LAS float*)(F.lds + RING_OFF + F.wave * 17408);
    const int IM = items_of(D, 2 * CW);
    for (int it = gw; it < DEPTH * IM; it += NGW) { const int l = it / IM, r = it % IM;
        transpose_item(a.in[14] + (size_t)l * D * 2 * CW, D, 2 * CW, a.in[13] + (size_t)l * D, (bf16*)(F.ws + WS_WMEM), scr, r, lane_, MapId{l * 2 * CW}); }
    prep_layer_weights_body(F, 0);
}
__device__ __noinline__ void prep_layer_weights(const float* const* in_, float* out_, unsigned char* ws_, LAS unsigned char* lds_, int l, int wave_, int vcu_, int G_) {
    const PC F{uni(in_), uni(out_), uni(ws_), uni_l(lds_), uni_i(wave_), uni_i(vcu_), uni_i(G_)}; prep_layer_weights_body(F, uni_i(l));
}

__constant__ unsigned char T5_BUCKET[128] = {0, 1, 2, 3, 4, 5, 6, 7, 8, 9, 10, 11, 12, 13, 14, 15, 16, 16, 16, 17, 17, 18, 18, 18, 19, 19, 19, 20, 20, 20, 20, 21, 21, 21, 21, 22, 22, 22, 22, 22, 23, 23, 23, 23, 23, 23, 24, 24, 24, 24, 24, 24, 25, 25, 25, 25, 25, 25, 25, 26, 26, 26, 26, 26, 26, 26, 26, 27, 27, 27, 27, 27, 27, 27, 27, 27, 27, 28, 28, 28, 28, 28, 28, 28, 28, 28, 28, 29, 29, 29, 29, 29, 29, 29, 29, 29, 29, 29, 29, 30, 30, 30, 30, 30, 30, 30, 30, 30, 30, 30, 30, 30, 30, 31, 31, 31, 31, 31, 31, 31, 31, 31, 31, 31, 31, 31, 31, 31};

typedef short bf16x8_p __attribute__((ext_vector_type(8)));
__device__ __forceinline__ void prep_tokens(const float* const* in_, float* out_, unsigned char* ws_, LAS unsigned char* lds_, int l_, int wave_, int vcu_, int G_, int dry_) {
    const int dry = uni_i(dry_);
    const PC F{uni(in_), uni(out_), uni(ws_), uni_l(lds_), uni_i(wave_), uni_i(vcu_), uni_i(G_)}; struct { const float* const* in; } a{F.in}; const int l = uni_i(l_);
    unsigned char* ws = launder_p(F.ws);
    const float* ckvraw = (const float*)(ws + WS_CKVRAW); bf16* ckv = (bf16*)(ws + WS_CKV);
    const bf16* iqraw = (const bf16*)(ws + WS_IQRAW); bf16* iqf = (bf16*)(ws + WS_IQF); const float* iw = (const float*)(ws + WS_IW); unsigned* sgn = (unsigned*)(ws + WS_SGN);
    const bf16* z = (const bf16*)(ws + WS_Z); bf16* yb = (bf16*)(ws + WS_YB); bf16* qc = (bf16*)(ws + WS_QC);
    const bf16* memkv = (const bf16*)(ws + WS_MEMKV); const bf16* vT = (const bf16*)(ws + WS_VT); const bf16* wpT = (const bf16*)(ws + WS_WPT);
    const float* kvn = a.in[8] + (size_t)l * KVR; const float* pscale = a.in[12] + (size_t)l * PW_;
    const int lane = lane_id_v(), tid = F.wave * 64 + lane;
    const int tok = lane & 15, g4 = lane >> 4;
    LAS unsigned char* Ks = F.lds;
    LAS unsigned char* Vs = F.lds + 36864;
    for (int blk = F.vcu; blk < M / 128; blk += F.G) {
        const int rowb = blk * 128, b = rowb / SEQ, row0 = rowb + F.wave * 16;
#pragma unroll 1
        for (int tt = 0; tt < 16; ++tt) { const int row = row0 + tt;
            { const f32x2 v = *(const f32x2*)(ckvraw + (size_t)row * KVR + 2 * lane); const float q = wave_sum(v.x * v.x + v.y * v.y);
              const float rs = 1.0f / sqrtf(q * (1.0f / KVR) + EPS); const f32x2 g = *(const f32x2*)(kvn + 2 * lane);
              *(unsigned*)(ckv + (size_t)row * KVR + 2 * lane) = pk2(v.x * rs * g.x, v.y * rs * g.y); }
            { const float wv = iw[(size_t)row * IH + (lane >> 3)]; const float aw = fabsf(wv) * (1.0f / 16.0f);
              const v2u q = *(const v2u*)(iqraw + (size_t)row * 256 + 4 * lane);
              v2u o; o.x = pkh2(hlo(q.x) * aw, hhi(q.x) * aw); o.y = pkh2(hlo(q.y) * aw, hhi(q.y) * aw);
              *(v2u*)(iqf + (size_t)row * 256 + 4 * lane) = o;
              const unsigned long long bal = __ballot(wv < 0.f);
              unsigned mask = 0;
#pragma unroll
              for (int h = 0; h < 8; ++h) mask |= ((unsigned)(bal >> (8 * h)) & 1u) << h;
              if (lane == 0) sgn[row] = mask; } }
        { const int row = row0 + tok, spos = row % SEQ;
#pragma unroll 1
          for (int g = 0; g < 4; ++g) { const int w = 2 << g; const int cnt = (spos + 1) < w ? (spos + 1) : w; const float rc = 1.0f / (float)cnt;
              bf16x8_p pf[2];
#pragma unroll
              for (int ks = 0; ks < 2; ++ks) { const int c0 = g * 64 + 32 * ks + 8 * g4; float sum[8], z0[8];
#pragma unroll
                  for (int e = 0; e < 8; ++e) { sum[e] = 0.f; z0[e] = 0.f; }
                  for (int j = 0; j < w; ++j) { if (j < cnt) { const v4u v = *(const v4u*)(z + (size_t)(row - j) * 256 + c0);
                      const float f[8] = {bflo(v.x), bfhi(v.x), bflo(v.y), bfhi(v.y), bflo(v.z), bfhi(v.z), bflo(v.w), bfhi(v.w)};
#pragma unroll
                      for (int e = 0; e < 8; ++e) { sum[e] += f[e]; if (j == 0) z0[e] = f[e]; } } }
                  v4u pw; pw.x = pk2(sum[0] * rc - z0[0], sum[1] * rc - z0[1]); pw.y = pk2(sum[2] * rc - z0[2], sum[3] * rc - z0[3]); pw.z = pk2(sum[4] * rc - z0[4], sum[5] * rc - z0[5]); pw.w = pk2(sum[6] * rc - z0[6], sum[7] * rc - z0[7]);
                  pf[ks] = __builtin_bit_cast(bf16x8_p, pw); }
#pragma unroll
              for (int dt = 0; dt < 4; ++dt) { f32x4 acc = {0.f, 0.f, 0.f, 0.f};
#pragma unroll
                  for (int ks = 0; ks < 2; ++ks) { const bf16x8_p af = *(const bf16x8_p*)(wpT + (size_t)(g * 64 + 16 * dt + tok) * 64 + 32 * ks + 8 * g4); acc = __builtin_amdgcn_mfma_f32_16x16x32_bf16(af, pf[ks], acc, 0, 0, 0); }
                  const f32x4 ps = *(const f32x4*)(pscale + g * 64 + 16 * dt + 4 * g4);
                  v2u o; o.x = pk2(acc[0] * ps.x, acc[1] * ps.y); o.y = pk2(acc[2] * ps.z, acc[3] * ps.w);
                  *(v2u*)(yb + (size_t)row * 256 + g * 64 + 16 * dt + 4 * g4) = o; } } }
#pragma unroll 1
        for (int h = 0; h < CH; ++h) {
            __syncthreads();
#pragma unroll
            for (int e = 0; e < 4; ++e) { const int i = tid + 512 * e;
                { const int m = i >> 3, c = i & 7; const v4u v = *(const v4u*)(memkv + (size_t)(b * NMEM + m) * 2048 + l * 512 + h * 64 + c * 8); *(LAS v4u*)(Ks + m * 144 + c * 16) = v; }
                { const int d = i >> 5, c = i & 31; const v4u v = *(const v4u*)(vT + (size_t)(l * 512 + 256 + h * 64 + d) * MROWS + b * NMEM + c * 8); *(LAS v4u*)(Vs + d * 528 + c * 16) = v; } }
            LDS_WAIT(); __syncthreads();
            const int row = row0 + tok;
            bf16x8_p qf[2];
#pragma unroll
            for (int ks = 0; ks < 2; ++ks) qf[ks] = *(const bf16x8_p*)(qc + (size_t)row * 256 + h * 64 + 32 * ks + 8 * g4);
            f32x4 S[16]; float mx = -1e30f;
#pragma unroll
            for (int mt = 0; mt < 16; ++mt) { f32x4 acc = {0.f, 0.f, 0.f, 0.f};
#pragma unroll
                for (int ks = 0; ks < 2; ++ks) { const bf16x8_p kf = *(const LAS bf16x8_p*)(Ks + (16 * mt + tok) * 144 + (4 * ks + g4) * 16); acc = __builtin_amdgcn_mfma_f32_16x16x32_bf16(kf, qf[ks], acc, 0, 0, 0); }
                S[mt] = acc; mx = fmaxf(mx, fmaxf(fmaxf(acc[0], acc[1]), fmaxf(acc[2], acc[3]))); if ((mt & 3) == 3) __builtin_amdgcn_sched_barrier(0); }
            mx = fmaxf(mx, __shfl_xor(mx, 16)); mx = fmaxf(mx, __shfl_xor(mx, 32));
            float sm = 0.f;
#pragma unroll
            for (int mt = 0; mt < 16; ++mt)
#pragma unroll
                for (int r = 0; r < 4; ++r) { const float p = __expf((S[mt][r] - mx) * 0.125f); S[mt][r] = p; sm += p; }
            sm += __shfl_xor(sm, 16); sm += __shfl_xor(sm, 32);
            const float inv = 1.0f / sm;
            f32x4 oacc[4];
#pragma unroll
            for (int dt = 0; dt < 4; ++dt) oacc[dt] = (f32x4){0.f, 0.f, 0.f, 0.f};
#pragma unroll
            for (int kk = 0; kk < 8; ++kk) { v4u pw; pw.x = pg8::cvt_pk_bf16(S[2 * kk][0], S[2 * kk][1]); pw.y = pg8::cvt_pk_bf16(S[2 * kk][2], S[2 * kk][3]); pw.z = pg8::cvt_pk_bf16(S[2 * kk + 1][0], S[2 * kk + 1][1]); pw.w = pg8::cvt_pk_bf16(S[2 * kk + 1][2], S[2 * kk + 1][3]);
                const bf16x8_p pfr = __builtin_bit_cast(bf16x8_p, pw);
#pragma unroll
                for (int dt = 0; dt < 4; ++dt) { const LAS unsigned char* vp = Vs + (16 * dt + tok) * 528 + (32 * kk + 4 * g4) * 2;
                    const v2u lo = *(const LAS v2u*)vp, hi = *(const LAS v2u*)(vp + 32);
                    v4u vw; vw.x = lo.x; vw.y = lo.y; vw.z = hi.x; vw.w = hi.y;
                    oacc[dt] = __builtin_amdgcn_mfma_f32_16x16x32_bf16(__builtin_bit_cast(bf16x8_p, vw), pfr, oacc[dt], 0, 0, 0); }
                __builtin_amdgcn_sched_barrier(0); }
#pragma unroll
            for (int dt = 0; dt < 4; ++dt) { v2u o; o.x = pk2(oacc[dt][0] * inv, oacc[dt][1] * inv); o.y = pk2(oacc[dt][2] * inv, oacc[dt][3] * inv);
                if (!dry) *(v2u*)(qc + (size_t)row * 256 + h * 64 + 16 * dt + 4 * g4) = o; else asm volatile("" :: "v"(o.x), "v"(o.y)); }
        }
    }
    __syncthreads();
}

__device__ __forceinline__ unsigned key_of(float s) { const unsigned u = __builtin_bit_cast(unsigned, s); return (u & 0x80000000u) ? ~u : (u | 0x80000000u); }

typedef short bf16x8_t __attribute__((ext_vector_type(8)));
typedef short s16x4_t __attribute__((ext_vector_type(4)));
__device__ __forceinline__ void glds16(const void* gsrc, unsigned lds_dst) { unsigned keep;
    asm volatile("s_mov_b32 %0, m0\n\ts_mov_b32 m0, %2\n\ts_nop 0\n\tglobal_load_lds_dwordx4 %1, off\n\ts_mov_b32 m0, %0" : "=&s"(keep) : "v"(gsrc), "s"(lds_dst) : "memory"); }
typedef float f32x16 __attribute__((ext_vector_type(16)));
constexpr int SEL_CAP = 256;
constexpr int HSTR = 264;
constexpr int SL_HIST = 0, SL_SEL = 0, SL_CS = 32768, SL_CI = 98304, SL_KEYS = 131072, SL_ST = 147456;

#define SEL_DECLS \
    LAS unsigned char* const lds = uni_l(lds_); const int wave = uni_i(wave_), b = uni_i(b_), ub = uni_i(ub_); unsigned char* ws = uni(ws_); \
    const bf16* iqf = (const bf16*)(ws + WS_IQF); const unsigned* sgn = (const unsigned*)(ws + WS_SGN); const bf16* ik = (const bf16*)(ws + WS_IK); \
    const int lane = lane_id_v(), tid = wave * 64 + lane; const int kl = lane & 31, c5 = lane >> 5; \
    LAS unsigned* hist = (LAS unsigned*)(lds + SL_HIST); LAS unsigned short* lsel = (LAS unsigned short*)(lds + SL_SEL); LAS float* lcs = (LAS float*)(lds + SL_CS); \
    LAS unsigned short* lci = (LAS unsigned short*)(lds + SL_CI); LAS unsigned* st = (LAS unsigned*)(lds + SL_ST); LAS float* stf = (LAS float*)(lds + SL_ST); \
    const int t0 = ub * 64; const int q0 = b * SEQ + t0; const bf16* ikb = ik + (size_t)b * SEQ * IDIM; const int ntile = (t0 + 64 + 127) >> 7; \
    (void)hist; (void)lsel; (void)lcs; (void)lci; (void)stf; (void)tid;
#define SEL_LOAD_A \
    bf16x8_t af[2][2]; float sgc[2][16]; \
    { const int i = kl, a_ = i >> 3, cc_ = (i >> 2) & 1, e_ = i & 3; const int qq_ = 2 * cc_ + (a_ >> 1), hh_ = 4 * (a_ & 1) + e_; \
      _Pragma("unroll") for (int rt = 0; rt < 2; ++rt) { const unsigned flip_ = ((sgn[q0 + 8 * wave + 4 * rt + qq_] >> hh_) & 1u) ? 0x80008000u : 0u;     \
          _Pragma("unroll") for (int ks = 0; ks < 2; ++ks) { v4u w_ = *(const v4u*)(iqf + (size_t)(q0 + 8 * wave + 4 * rt + qq_) * 256 + hh_ * 32 + 16 * ks + 8 * c5); \
              w_.x ^= flip_; w_.y ^= flip_; w_.z ^= flip_; w_.w ^= flip_; af[rt][ks] = __builtin_bit_cast(bf16x8_t, w_); } } \
      _Pragma("unroll") for (int rt = 0; rt < 2; ++rt) _Pragma("unroll") for (int u = 0; u < 2; ++u) { const unsigned m_ = sgn[q0 + 8 * wave + 4 * rt + 2 * c5 + u]; \
          _Pragma("unroll") for (int h = 0; h < 8; ++h) sgc[rt][8 * u + h] = ((m_ >> h) & 1u) ? -__builtin_inff() : __builtin_inff(); } }
#define SEL_STAGE(kt_) do { const int key_ = 16 * wave + (lane >> 2); const int ch_ = (lane & 3) ^ ((key_ >> 2) & 3); \
    glds16(ikb + (size_t)(128 * (kt_) + key_) * IDIM + ch_ * 8, (unsigned)__builtin_amdgcn_readfirstlane((int)(unsigned)(size_t)(lds + SL_KEYS + ((kt_) & 1) * 8192 + wave * 1024))); } while (0)
#define SEL_MMA(acc_, rt_, kh_) do { acc_ = (f32x16){0.f,0.f,0.f,0.f,0.f,0.f,0.f,0.f,0.f,0.f,0.f,0.f,0.f,0.f,0.f,0.f}; \
    acc_ = __builtin_amdgcn_mfma_f32_32x32x16_f16(__builtin_bit_cast(f16x8_t, af[rt_][0]), __builtin_bit_cast(f16x8_t, bfr_[kh_][0]), acc_, 0, 0, 0); \
    acc_ = __builtin_amdgcn_mfma_f32_32x32x16_f16(__builtin_bit_cast(f16x8_t, af[rt_][1]), __builtin_bit_cast(f16x8_t, bfr_[kh_][1]), acc_, 0, 0, 0); } while (0)
#define SEL_SUM(acc_, rt_, kh_) do { _Pragma("unroll") for (int u = 0; u < 2; ++u) { float s_ = 0.f; \
    _Pragma("unroll") for (int h = 0; h < 8; ++h) s_ += __builtin_amdgcn_fmed3f(acc_[8 * u + h], 0.f, sgc[rt_][8 * u + h]); \
    sc[rt_][kh_][u] = s_; } } while (0)
#define SEL_SCORES(kt_) do { const LAS unsigned char* kb_ = lds + SL_KEYS + ((kt_) & 1) * 8192; bf16x8_t bfr_[4][2]; \
    _Pragma("unroll") for (int kh = 0; kh < 4; ++kh) { const int key_ = 32 * kh + kl; \
        bfr_[kh][0] = *(const LAS bf16x8_t*)(kb_ + key_ * 64 + 16 * ((0 + c5) ^ ((key_ >> 2) & 3))); \
        bfr_[kh][1] = *(const LAS bf16x8_t*)(kb_ + key_ * 64 + 16 * ((2 + c5) ^ ((key_ >> 2) & 3))); } \
    f32x16 accA_, accB_; \
    SEL_MMA(accA_, 0, 0); \
    SEL_MMA(accB_, 1, 0); __builtin_amdgcn_sched_barrier(0); SEL_SUM(accA_, 0, 0); __builtin_amdgcn_sched_barrier(0); \
    SEL_MMA(accA_, 0, 1); __builtin_amdgcn_sched_barrier(0); SEL_SUM(accB_, 1, 0); __builtin_amdgcn_sched_barrier(0); \
    SEL_MMA(accB_, 1, 1); __builtin_amdgcn_sched_barrier(0); SEL_SUM(accA_, 0, 1); __builtin_amdgcn_sched_barrier(0); \
    SEL_MMA(accA_, 0, 2); __builtin_amdgcn_sched_barrier(0); SEL_SUM(accB_, 1, 1); __builtin_amdgcn_sched_barrier(0); \
    SEL_MMA(accB_, 1, 2); __builtin_amdgcn_sched_barrier(0); SEL_SUM(accA_, 0, 2); __builtin_amdgcn_sched_barrier(0); \
    SEL_MMA(accA_, 0, 3); __builtin_amdgcn_sched_barrier(0); SEL_SUM(accB_, 1, 2); __builtin_amdgcn_sched_barrier(0); \
    SEL_MMA(accB_, 1, 3); __builtin_amdgcn_sched_barrier(0); SEL_SUM(accA_, 0, 3); __builtin_amdgcn_sched_barrier(0); \
    SEL_SUM(accB_, 1, 3); } while (0)
#define SEL_BOUNDARY(FINAL) do { \
    const int qq = tid >> 3, part = tid & 7; const LAS v4u* hp = (const LAS v4u*)(hist + qq * HSTR + 32 * part); \
    unsigned bins[32]; \
    _Pragma("unroll") for (int i = 0; i < 8; ++i) { const v4u v = hp[i]; bins[4 * i] = v.x; bins[4 * i + 1] = v.y; bins[4 * i + 2] = v.z; bins[4 * i + 3] = v.w; } \
    unsigned ps = 0; \
    _Pragma("unroll") for (int i = 0; i < 32; ++i) ps += bins[i]; \
    unsigned v = ps, tt; \
    tt = __shfl_down(v, 1, 8); if (part + 1 < 8) v += tt; \
    tt = __shfl_down(v, 2, 8); if (part + 2 < 8) v += tt; \
    tt = __shfl_down(v, 4, 8); if (part + 4 < 8) v += tt; \
    unsigned cacc = v - ps; \
    if (cacc < (unsigned)TOPK && v >= (unsigned)TOPK) { int bsel = 0; unsigned na = 0, cb = 0; bool found = false; \
        _Pragma("unroll") for (int i = 31; i >= 0; --i) { const bool hit = !found && (cacc + bins[i] >= (unsigned)TOPK); if (hit) { bsel = i; na = cacc; cb = bins[i]; found = true; } cacc += bins[i]; } \
        st[128 + qq] = (unsigned)(32 * part + bsel); if (FINAL) { st[192 + qq] = na; st[256 + qq] = cb; st[448 + qq] = cb > (unsigned)SEL_CAP ? 1u : 0u; } } } while (0)

__device__ __forceinline__ void sel_pass1(unsigned char* ws_, LAS unsigned char* lds_, int wave_, int b_, int ub_) {
    SEL_DECLS
    unsigned short* sel = (unsigned short*)(ws + WS_SEL);
    __syncthreads();
    if (ub < 4) {
        for (int i = tid; i < 64 * TOPK; i += NWAVES * 64) { const int qq = i >> 8, sl = i & 255; sel[(size_t)(q0 + qq) * TOPK + sl] = (unsigned short)(sl <= t0 + qq ? sl : 0); }
        if (tid == 0) st[512] = 1u;
        asm volatile("s_waitcnt vmcnt(0) lgkmcnt(0)" ::: "memory"); __syncthreads();
        return;
    }
    SEL_LOAD_A
    for (int i = tid; i < 64 * HSTR; i += NWAVES * 64) hist[i] = 0u;
    if (tid < 64) { st[128 + tid] = 0u; st[448 + tid] = 0u; }
    if (tid == 0) st[512] = 0u;
    float sc[2][4][2];
    float scl[2][2]; int bcur[2][2];
#pragma unroll
    for (int rt = 0; rt < 2; ++rt)
#pragma unroll
        for (int u = 0; u < 2; ++u) { scl[rt][u] = 0.f; bcur[rt][u] = 0; }
    SEL_STAGE(0);
#pragma unroll 1
    for (int kt = 0; kt < ntile; ++kt) {
        asm volatile("s_waitcnt vmcnt(0) lgkmcnt(0)" ::: "memory"); __syncthreads();
        if (kt > 0 && (kt & 3) == 0) {
            SEL_BOUNDARY(false);
            asm volatile("s_waitcnt lgkmcnt(0)" ::: "memory"); __syncthreads();
#pragma unroll
            for (int rt = 0; rt < 2; ++rt)
#pragma unroll
                for (int u = 0; u < 2; ++u) bcur[rt][u] = (int)st[128 + 8 * wave + 4 * rt + 2 * c5 + u];
        }
        if (kt + 1 < ntile) SEL_STAGE(kt + 1);
        SEL_SCORES(kt);
        if (kt == 0) {
#pragma unroll
            for (int rt = 0; rt < 2; ++rt)
#pragma unroll
                for (int u = 0; u < 2; ++u) { float mx = 0.f;
#pragma unroll
                    for (int kh = 0; kh < 4; ++kh) mx = fmaxf(mx, fabsf(sc[rt][kh][u]));
#pragma unroll
                    for (int o = 1; o < 32; o <<= 1) mx = fmaxf(mx, __shfl_xor(mx, o));
                    const float R = mx > 0.f ? mx : 1.0f;
                    scl[rt][u] = 128.0f / R;
                    if (kl == 0) stf[8 * wave + 4 * rt + 2 * c5 + u] = scl[rt][u]; }
        }
        const bool masked = 128 * kt + 127 > t0;
#pragma unroll
        for (int rt = 0; rt < 2; ++rt)
#pragma unroll
            for (int u = 0; u < 2; ++u) { const int qq = 8 * wave + 4 * rt + 2 * c5 + u; const int lim = masked ? (t0 + qq - 128 * kt - kl) : 1000;
#pragma unroll
                for (int kh = 0; kh < 4; ++kh) { const float fb = __builtin_amdgcn_fmed3f(fmaf(sc[rt][kh][u], scl[rt][u], 128.0f), 0.f, 255.f);
                    if (fb >= (float)bcur[rt][u] && 32 * kh <= lim) (void)__hip_atomic_fetch_add(hist + qq * HSTR + (int)fb, 1u, __ATOMIC_RELAXED, __HIP_MEMORY_SCOPE_WORKGROUP); } }
    }
    asm volatile("s_waitcnt vmcnt(0) lgkmcnt(0)" ::: "memory"); __syncthreads();
    SEL_BOUNDARY(true);
    if (tid < 64) { st[320 + tid] = 0u; st[384 + tid] = 0u; }
    asm volatile("s_waitcnt lgkmcnt(0)" ::: "memory"); __syncthreads();
}
__device__ __forceinline__ void sel_pass2(unsigned char* ws_, LAS unsigned char* lds_, int wave_, int b_, int ub_) {
    SEL_DECLS
    if (st[512] != 0u) return;
    if (tid < 64) { st[320 + tid] = 0u; st[384 + tid] = 0u; }
    SEL_LOAD_A
    float sc[2][4][2];
    float scl[2][2]; int bcur[2][2];
#pragma unroll
    for (int rt = 0; rt < 2; ++rt)
#pragma unroll
        for (int u = 0; u < 2; ++u) { const int qq = 8 * wave + 4 * rt + 2 * c5 + u; scl[rt][u] = stf[qq]; bcur[rt][u] = (int)st[128 + qq]; }
    SEL_STAGE(0);
#pragma unroll 1
    for (int kt = 0; kt < ntile; ++kt) {
        asm volatile("s_waitcnt vmcnt(0) lgkmcnt(0)" ::: "memory"); __syncthreads();
        if (kt + 1 < ntile) SEL_STAGE(kt + 1);
        SEL_SCORES(kt);
        const bool masked = 128 * kt + 127 > t0;
        unsigned okm = 0u, abm = 0u; unsigned basea[2][2], basec[2][2];
#pragma unroll
        for (int rt = 0; rt < 2; ++rt)
#pragma unroll
            for (int u = 0; u < 2; ++u) { const int qq = 8 * wave + 4 * rt + 2 * c5 + u; const int lim = masked ? (t0 + qq - 128 * kt - kl) : 1000; unsigned na_ = 0u, nc_ = 0u;
#pragma unroll
                for (int kh = 0; kh < 4; ++kh) { const float fb = __builtin_amdgcn_fmed3f(fmaf(sc[rt][kh][u], scl[rt][u], 128.0f), 0.f, 255.f);
                    const bool ok = fb >= (float)bcur[rt][u] && 32 * kh <= lim; const bool ab = ok && fb >= (float)(bcur[rt][u] + 1);
                    const unsigned okb = ok ? 1u : 0u, abb = ab ? 1u : 0u;
                    okm |= okb << (rt * 8 + u * 4 + kh); abm |= abb << (rt * 8 + u * 4 + kh); na_ += abb; nc_ += okb - abb; }
                basea[rt][u] = 0u; basec[rt][u] = 0u;
                if (na_) basea[rt][u] = __hip_atomic_fetch_add(st + 320 + qq, na_, __ATOMIC_RELAXED, __HIP_MEMORY_SCOPE_WORKGROUP);
                if (nc_) basec[rt][u] = __hip_atomic_fetch_add(st + 384 + qq, nc_, __ATOMIC_RELAXED, __HIP_MEMORY_SCOPE_WORKGROUP); }
        if (okm != 0u) {
#pragma unroll
            for (int rt = 0; rt < 2; ++rt)
#pragma unroll
                for (int u = 0; u < 2; ++u) { const int qq = 8 * wave + 4 * rt + 2 * c5 + u; unsigned sa = basea[rt][u], scn = basec[rt][u];
#pragma unroll
                    for (int kh = 0; kh < 4; ++kh) { const int bit = rt * 8 + u * 4 + kh; const int kpos = 128 * kt + 32 * kh + kl;
                        if ((okm >> bit) & 1u) {
                            if ((abm >> bit) & 1u) { if (sa < (unsigned)TOPK) lsel[qq * 256 + sa] = (unsigned short)kpos; ++sa; }
                            else { if (scn < (unsigned)SEL_CAP) { lcs[qq * SEL_CAP + scn] = sc[rt][kh][u]; lci[qq * SEL_CAP + scn] = (unsigned short)kpos; } ++scn; } } } }
        }
    }
    asm volatile("s_waitcnt vmcnt(0) lgkmcnt(0)" ::: "memory"); __syncthreads();
}
__device__ __forceinline__ void sel_resolve(unsigned char* ws_, LAS unsigned char* lds_, int wave_, int b_, int ub_, int wg_, int first_) {
    SEL_DECLS
    const int wg = uni_i(wg_), first = uni_i(first_);
    unsigned short* sel = (unsigned short*)(ws + WS_SEL);
    gu32* slowl = (gu32*)(ws + WS_CTL + 65536) + (size_t)wg * 132;
    if (first && tid == 0) __hip_atomic_store(slowl, 0u, RLX_AGENT);
    if (st[512] != 0u) return;
#pragma unroll 1
    for (int qi = 0; qi < 8; ++qi) { const int qq = 8 * wave + qi; const int q = q0 + qq;
        const int na = (int)st[192 + qq], need = TOPK - na; int C = (int)st[384 + qq]; C = C < SEL_CAP ? C : SEL_CAP;
        const bool slow = st[448 + qq] != 0u;
        if (!slow) {
            LAS unsigned* sh = (LAS unsigned*)(lds + SL_KEYS + wave * 2048); LAS float* sls = (LAS float*)(lds + SL_KEYS + wave * 2048 + 256); LAS unsigned short* sli = (LAS unsigned short*)(lds + SL_KEYS + wave * 2048 + 1280);
            const float sclq = stf[qq]; const float fbase = (float)(int)st[128 + qq];
            sh[lane] = 0u;
            float cs[SEL_CAP / 64]; int ci[SEL_CAP / 64], sb[SEL_CAP / 64];
#pragma unroll
            for (int e = 0; e < SEL_CAP / 64; ++e) { const int i = lane + 64 * e; cs[e] = 0.f; ci[e] = 0; sb[e] = -1;
                if (i < C) { cs[e] = lcs[qq * SEL_CAP + i]; ci[e] = lci[qq * SEL_CAP + i];
                    const float fr_ = (fmaf(cs[e], sclq, 128.0f) - fbase) * 64.0f; sb[e] = (int)__builtin_amdgcn_fmed3f(fr_, 0.f, 63.f); } }
            LDS_WAIT();
#pragma unroll
            for (int e = 0; e < SEL_CAP / 64; ++e) if (sb[e] >= 0) (void)__hip_atomic_fetch_add(sh + sb[e], 1u, __ATOMIC_RELAXED, __HIP_MEMORY_SCOPE_WORKGROUP);
            LDS_WAIT();
            const unsigned cl = sh[lane];
            unsigned v = cl, tt;
            tt = __shfl_down(v, 1); if (lane + 1 < 64) v += tt;
            tt = __shfl_down(v, 2); if (lane + 2 < 64) v += tt;
            tt = __shfl_down(v, 4); if (lane + 4 < 64) v += tt;
            tt = __shfl_down(v, 8); if (lane + 8 < 64) v += tt;
            tt = __shfl_down(v, 16); if (lane + 16 < 64) v += tt;
            tt = __shfl_down(v, 32); if (lane + 32 < 64) v += tt;
            const unsigned ab_ = v - cl;
            const unsigned long long cross = __ballot(ab_ < (unsigned)need && v >= (unsigned)need);
            const int sstar = cross ? (int)__builtin_ctzll(cross) : 0;
            const int na2 = (int)__shfl(ab_, sstar);
            const int need2 = need - na2;
            int base = na; int nsub = 0;
#pragma unroll
            for (int e = 0; e < SEL_CAP / 64; ++e) { const bool up = sb[e] > sstar; const bool eq = sb[e] == sstar;
                const unsigned long long bu = __ballot(up), be = __ballot(eq);
                const unsigned long long lt = (lane == 0) ? 0ull : (~0ull >> (64 - lane));
                if (up) lsel[qq * 256 + base + (int)__builtin_popcountll(bu & lt)] = (unsigned short)ci[e];
                if (eq) { const int p_ = nsub + (int)__builtin_popcountll(be & lt); sls[p_] = cs[e]; sli[p_] = (unsigned short)ci[e]; }
                base += (int)__builtin_popcountll(bu); nsub += (int)__builtin_popcountll(be); }
            LDS_WAIT();
#pragma unroll 1
            for (int i0 = 0; i0 < nsub; i0 += 64) { const int i = i0 + lane;
                if (i < nsub) { const float si = sls[i]; const int ii = sli[i]; int rank = 0;
                    for (int jx = 0; jx < nsub; ++jx) { const float sj = sls[jx]; const int ij = sli[jx]; rank += (sj > si || (sj == si && ij < ii)) ? 1 : 0; }
                    if (rank < need2) lsel[qq * 256 + na + na2 + rank] = (unsigned short)ii; } }
            LDS_WAIT();
            *(v2u*)(sel + (size_t)q * TOPK + 4 * lane) = *(const LAS v2u*)(lsel + qq * 256 + 4 * lane);
        }
    }
    __syncthreads();
    if (tid == 0) { unsigned n = first ? 0u : __hip_atomic_load(slowl, RLX_AGENT);
        for (int qq = 0; qq < 64; ++qq) if (st[448 + qq] != 0u) { if (n < 128u) { __hip_atomic_store(slowl + 1 + n, (unsigned)(q0 + qq), RLX_AGENT); ++n; } }
        __hip_atomic_store(slowl, n, RLX_AGENT); }
    asm volatile("s_waitcnt vmcnt(0)" ::: "memory");
    __syncthreads();
}
#undef SEL_DECLS
#undef SEL_LOAD_A
#undef SEL_STAGE
#undef SEL_SCORES
#undef SEL_MMA
#undef SEL_SUM
#undef SEL_BOUNDARY
__device__ __forceinline__ void dsa_select_slow(unsigned char* ws_, LAS unsigned char* lds_, int wave_, int wg_) {
    LAS unsigned char* const lds = uni_l(lds_); const int wave = uni_i(wave_), wg = uni_i(wg_);
    unsigned char* ws = uni(ws_);
    const bf16* iqf = (const bf16*)(ws + WS_IQF); const unsigned* sgn = (const unsigned*)(ws + WS_SGN); const bf16* ik = (const bf16*)(ws + WS_IK);
    unsigned short* sel = (unsigned short*)(ws + WS_SEL);
    gu32* slowl = (gu32*)(ws + WS_CTL + 65536) + (size_t)wg * 132;
    const int lane = lane_id_v(), tid = wave * 64 + lane; const int kl = lane & 31, c5 = lane >> 5;
    LAS unsigned* keys = (LAS unsigned*)lds;
    LAS unsigned* hist = (LAS unsigned*)(lds + 32768);
    LAS unsigned* ctl = (LAS unsigned*)(lds + 40960);
    const int nq = (int)__builtin_amdgcn_readfirstlane(__hip_atomic_load(slowl, RLX_AGENT));
#pragma unroll 1
    for (int k = 0; k < nq; ++k) {
        const int q = (int)__builtin_amdgcn_readfirstlane(__hip_atomic_load(slowl + 1 + k, RLX_AGENT));
        const int b = q / SEQ, t = q % SEQ, n = t + 1;
        const bf16* ikb = ik + (size_t)b * SEQ * IDIM;
        __syncthreads();
        bf16x8_t af[2]; float sgc[8];
        { const int i = kl, a_ = i >> 3, e_ = i & 3; const int hh_ = 4 * (a_ & 1) + e_; const unsigned m_ = sgn[q];
          const unsigned flip_ = ((m_ >> hh_) & 1u) ? 0x80008000u : 0u;
#pragma unroll
          for (int ks = 0; ks < 2; ++ks) { v4u w_ = *(const v4u*)(iqf + (size_t)q * 256 + hh_ * 32 + 16 * ks + 8 * c5); w_.x ^= flip_; w_.y ^= flip_; w_.z ^= flip_; w_.w ^= flip_; af[ks] = __builtin_bit_cast(bf16x8_t, w_); }
#pragma unroll
          for (int h = 0; h < 8; ++h) sgc[h] = ((m_ >> h) & 1u) ? -__builtin_inff() : __builtin_inff(); }
#pragma unroll 1
        for (int kb0 = wave; kb0 * 32 < n; kb0 += 4 * NWAVES) {
            bf16x8_t kb_[4][2];
#pragma unroll
            for (int j = 0; j < 4; ++j) { int key = 32 * (kb0 + j * NWAVES) + kl; key = key < SEQ ? key : SEQ - 1;
                kb_[j][0] = *(const bf16x8_t*)(ikb + (size_t)key * IDIM + 8 * c5); kb_[j][1] = *(const bf16x8_t*)(ikb + (size_t)key * IDIM + 16 + 8 * c5); }
#pragma unroll
            for (int j = 0; j < 4; ++j) { const int key = 32 * (kb0 + j * NWAVES) + kl;
                f32x16 acc = {0.f,0.f,0.f,0.f,0.f,0.f,0.f,0.f,0.f,0.f,0.f,0.f,0.f,0.f,0.f,0.f};
                acc = __builtin_amdgcn_mfma_f32_32x32x16_f16(__builtin_bit_cast(f16x8_t, af[0]), __builtin_bit_cast(f16x8_t, kb_[j][0]), acc, 0, 0, 0); acc = __builtin_amdgcn_mfma_f32_32x32x16_f16(__builtin_bit_cast(f16x8_t, af[1]), __builtin_bit_cast(f16x8_t, kb_[j][1]), acc, 0, 0, 0);
                float sc = 0.f;
#pragma unroll
                for (int h = 0; h < 8; ++h) sc += __builtin_amdgcn_fmed3f(acc[h], 0.f, sgc[h]);
                if (c5 == 0 && key < SEQ) keys[key] = key_of(sc); } }
        if (tid == 0) { const unsigned z_ = (unsigned)launder_v(0); ctl[0] = z_; ctl[1] = z_ + (unsigned)TOPK; ctl[2] = z_; ctl[3] = z_; }
        unsigned P = 0u, Plo = 0u;
#pragma unroll 1
        for (int lev = 0; lev < 5; ++lev) {
            for (int i = tid; i < 2048; i += NWAVES * 64) hist[i] = 0u;
            asm volatile("s_waitcnt lgkmcnt(0)" ::: "memory"); __syncthreads();
#pragma unroll 1
            for (int i = 0; i < 16; ++i) { const int s_ = tid * 16 + i;
                if (s_ < n) { const unsigned hi = keys[s_], lo = 8191u - (unsigned)s_; bool mt; unsigned dg;
                    if (lev == 0) { mt = true; dg = hi >> 21; } else if (lev == 1) { mt = (hi >> 21) == P; dg = (hi >> 10) & 0x7ffu; } else if (lev == 2) { mt = (hi >> 10) == P; dg = hi & 0x3ffu; }
                    else if (lev == 3) { mt = hi == P; dg = lo >> 6; } else { mt = hi == P && (lo >> 6) == Plo; dg = lo & 63u; }
                    if (mt) (void)__hip_atomic_fetch_add(hist + dg, 1u, __ATOMIC_RELAXED, __HIP_MEMORY_SCOPE_WORKGROUP); } }
            asm volatile("s_waitcnt lgkmcnt(0)" ::: "memory"); __syncthreads();
            const unsigned need = ctl[1];
            const v4u hb = *(const LAS v4u*)(hist + 4 * tid); const unsigned ls = hb.x + hb.y + hb.z + hb.w;
            unsigned v = ls, tt;
            tt = __shfl_down(v, 1); if (lane + 1 < 64) v += tt;
            tt = __shfl_down(v, 2); if (lane + 2 < 64) v += tt;
            tt = __shfl_down(v, 4); if (lane + 4 < 64) v += tt;
            tt = __shfl_down(v, 8); if (lane + 8 < 64) v += tt;
            tt = __shfl_down(v, 16); if (lane + 16 < 64) v += tt;
            tt = __shfl_down(v, 32); if (lane + 32 < 64) v += tt;
            if (lane == 0) ctl[8 + wave] = v;
            asm volatile("s_waitcnt lgkmcnt(0)" ::: "memory"); __syncthreads();
            unsigned above = v - ls;
            for (int w2 = wave + 1; w2 < NWAVES; ++w2) above += ctl[8 + w2];
            if (above < need && above + ls >= need) { unsigned c = above; const unsigned bb[4] = {hb.x, hb.y, hb.z, hb.w}; int bsel = 0; unsigned cab = 0; bool found = false;
#pragma unroll
                for (int i = 3; i >= 0; --i) { const bool hit = !found && (c + bb[i] >= need); if (hit) { bsel = i; cab = c; found = true; } c += bb[i]; }
                const unsigned dv = (unsigned)(4 * tid + bsel);
                if (lev == 0) ctl[0] = dv; else if (lev == 1) ctl[0] = (P << 11) | dv; else if (lev == 2) ctl[0] = (P << 10) | dv; else if (lev == 3) ctl[3] = dv; else ctl[3] = (Plo << 6) | dv;
                ctl[1] = need - cab; ctl[4] = bb[bsel]; }
            asm volatile("s_waitcnt lgkmcnt(0)" ::: "memory"); __syncthreads();
            P = ctl[0]; Plo = ctl[3];
            if (lev == 2 && ctl[1] == ctl[4]) break;
        }
        unsigned short* srow = sel + (size_t)q * TOPK;
        unsigned mymask = 0u;
#pragma unroll 1
        for (int i = 0; i < 16; ++i) { const int s_ = tid * 16 + i;
            if (s_ < n) { const unsigned hi = keys[s_], lo = 8191u - (unsigned)s_; if (hi > P || (hi == P && lo >= Plo)) mymask |= 1u << i; } }
        const unsigned mycnt = (unsigned)__builtin_popcount(mymask);
        unsigned pv_ = mycnt, tt_;
        tt_ = __shfl_up(pv_, 1); if (lane >= 1) pv_ += tt_;
        tt_ = __shfl_up(pv_, 2); if (lane >= 2) pv_ += tt_;
        tt_ = __shfl_up(pv_, 4); if (lane >= 4) pv_ += tt_;
        tt_ = __shfl_up(pv_, 8); if (lane >= 8) pv_ += tt_;
        tt_ = __shfl_up(pv_, 16); if (lane >= 16) pv_ += tt_;
        tt_ = __shfl_up(pv_, 32); if (lane >= 32) pv_ += tt_;
        if (lane == 63) ctl[16 + wave] = pv_;
        asm volatile("s_waitcnt lgkmcnt(0)" ::: "memory"); __syncthreads();
        unsigned slot0 = pv_ - mycnt;
        for (int w2 = 0; w2 < wave; ++w2) slot0 += ctl[16 + w2];
#pragma unroll 1
        for (int i = 0; i < 16; ++i) if ((mymask >> i) & 1u) { if (slot0 < (unsigned)TOPK) srow[slot0] = (unsigned short)(tid * 16 + i); ++slot0; }
    }
    asm volatile("s_waitcnt vmcnt(0) lgkmcnt(0)" ::: "memory");
    __syncthreads();
}

__device__ __forceinline__ unsigned offb(unsigned row, unsigned ch) { return 256u * row + 16u * (ch ^ (((row & 3u) << 2) | ((row >> 2) & 3u))); }
__device__ __forceinline__ s16x4_t vtr(const LAS unsigned char* p) { return __builtin_bit_cast(s16x4_t, __builtin_amdgcn_ds_read_tr16_b64_v4i16((LAS s16x4_t*)p)); }

__device__ __forceinline__ void dsa_attend(unsigned char* ws_, LAS unsigned char* lds_, const float* relb_, int wave_, int vcu_, int G_, int dry_) {
    const int dry = uni_i(dry_);
    LAS unsigned char* const lds = uni_l(lds_); const int wave = uni_i(wave_), vcu = uni_i(vcu_), G = uni_i(G_);
    unsigned char* ws = uni(ws_); const float* relb = uni(relb_);
    const bf16* ckv = (const bf16*)(ws + WS_CKV); bf16* ql = (bf16*)(ws + WS_QL); const unsigned short* sel = (const unsigned short*)(ws + WS_SEL);
    const int lane = lane_id_v(), tid = wave * 64 + lane;
    LAS unsigned char* cb = lds + wave * 16384;
    LAS unsigned short* sidx = (LAS unsigned short*)(lds + 131072 + wave * 512);
    LAS float* biasd = (LAS float*)(lds + 135168);
    for (int i = tid; i < 129 * 8; i += NWAVES * 64) { const int d = i >> 3, h = i & 7; const int bk = d < 128 ? (int)T5_BUCKET[d] : 31; biasd[i] = relb[bk * 8 + h]; }
    __syncthreads();
    const int hl = lane & 15, g = lane >> 4, hq = hl & 7;
    for (int p = vcu; p < BATCH * 64; p += G) {
        const int b = p >> 6, j = p & 63;
#pragma unroll 1
        for (int half = 0; half < 2; ++half) {
            const int ub = half == 0 ? j : 127 - j;
#pragma unroll 1
            for (int qi = 0; qi < 8; ++qi) {
                const int t = ub * 64 + wave * 8 + qi; const int q = b * SEQ + t; const int nsel = (t + 1) < TOPK ? (t + 1) : TOPK;
                const bf16* ckvb = ckv + (size_t)b * SEQ * KVR; bf16* qlrow = ql + (size_t)q * 1024;
                { const v2u w = *(const v2u*)(sel + (size_t)q * TOPK + 4 * lane); *(LAS v2u*)(sidx + 4 * lane) = w; }
                bf16x8_t qf[4];
#pragma unroll
                for (int s = 0; s < 4; ++s) qf[s] = *(const bf16x8_t*)(qlrow + hq * 128 + 32 * s + 8 * g);
                LDS_WAIT();
                float mrun = -1e30f, lsum = 0.f;
                f32x4 O[8];
#pragma unroll
                for (int c = 0; c < 8; ++c) O[c] = (f32x4){0.f, 0.f, 0.f, 0.f};
#define DSA_GATHER(c_) do { LAS unsigned char* dst_ = cb + ((c_) & 1) * 8192; \
                    _Pragma("unroll") for (int k_ = 0; k_ < 8; ++k_) { const int row_ = 4 * k_ + g; const int kidx_ = sidx[32 * (c_) + row_]; \
                        const int ch_ = hl ^ ((g << 2) | (k_ & 3)); \
                        glds16(ckvb + (size_t)kidx_ * KVR + ch_ * 8, (unsigned)__builtin_amdgcn_readfirstlane((int)(unsigned)(size_t)(dst_ + k_ * 1024))); } } while (0)
                DSA_GATHER(0);
#pragma unroll 1
                for (int c = 0; c < 8; ++c) {
                    if (c < 7) { DSA_GATHER(c + 1); asm volatile("s_waitcnt vmcnt(8)" ::: "memory"); }
                    else asm volatile("s_waitcnt vmcnt(0)" ::: "memory");
                    const LAS unsigned char* img = cb + (c & 1) * 8192;
                    f32x4 S[2];
#pragma unroll
                    for (int rb = 0; rb < 2; ++rb) { S[rb] = (f32x4){0.f, 0.f, 0.f, 0.f}; const unsigned row = 8u * (hl >> 2) + 4u * rb + (hl & 3);
#pragma unroll
                        for (int s = 0; s < 4; ++s) { const bf16x8_t af = *(const LAS bf16x8_t*)(img + offb(row, 4 * s + g)); S[rb] = __builtin_amdgcn_mfma_f32_16x16x32_bf16(af, qf[s], S[rb], 0, 0, 0); } }
                    float pv[2][4]; float mx = -1e30f;
#pragma unroll
                    for (int rb = 0; rb < 2; ++rb) { const v2u iw2 = *(const LAS v2u*)(sidx + 32 * c + 8 * g + 4 * rb);
                        const int ki[4] = {(int)(iw2.x & 0xffffu), (int)(iw2.x >> 16), (int)(iw2.y & 0xffffu), (int)(iw2.y >> 16)};
#pragma unroll
                        for (int r = 0; r < 4; ++r) { int dist = t - ki[r]; dist = dist < 0 ? 0 : (dist > 128 ? 128 : dist);
                            float lg = S[rb][r] * 0.125f + biasd[dist * 8 + hq];
                            if (32 * c + 8 * g + 4 * rb + r >= nsel) lg = -1e30f;
                            pv[rb][r] = lg; mx = fmaxf(mx, lg); } }
                    mx = fmaxf(mx, __shfl_xor(mx, 16)); mx = fmaxf(mx, __shfl_xor(mx, 32));
                    const float mnew = fmaxf(mrun, mx); const float alpha = __expf(mrun - mnew); mrun = mnew;
                    float rs = 0.f;
#pragma unroll
                    for (int rb = 0; rb < 2; ++rb)
#pragma unroll
                        for (int r = 0; r < 4; ++r) { pv[rb][r] = __expf(pv[rb][r] - mnew); rs += pv[rb][r]; }
                    rs += __shfl_xor(rs, 16); rs += __shfl_xor(rs, 32);
                    lsum = lsum * alpha + rs;
                    v4u pw; pw.x = pg8::cvt_pk_bf16(pv[0][0], pv[0][1]); pw.y = pg8::cvt_pk_bf16(pv[0][2], pv[0][3]); pw.z = pg8::cvt_pk_bf16(pv[1][0], pv[1][1]); pw.w = pg8::cvt_pk_bf16(pv[1][2], pv[1][3]);
                    const bf16x8_t pf = __builtin_bit_cast(bf16x8_t, pw);
                    float al[4];
#pragma unroll
                    for (int r = 0; r < 4; ++r) al[r] = __shfl(alpha, 4 * g + r);
#pragma unroll
                    for (int cd = 0; cd < 8; ++cd) {
                        f32x4 o = O[cd]; o[0] *= al[0]; o[1] *= al[1]; o[2] *= al[2]; o[3] *= al[3];
                        const unsigned q4 = hl >> 2, p4 = hl & 3;
                        const s16x4_t b0 = vtr(img + offb(8u * g + q4, 2 * cd + (p4 >> 1)) + 8u * (p4 & 1));
                        const s16x4_t b1 = vtr(img + offb(8u * g + 4u + q4, 2 * cd + (p4 >> 1)) + 8u * (p4 & 1));
                        bf16x8_t bf; bf[0] = b0[0]; bf[1] = b0[1]; bf[2] = b0[2]; bf[3] = b0[3]; bf[4] = b1[0]; bf[5] = b1[1]; bf[6] = b1[2]; bf[7] = b1[3];
                        O[cd] = __builtin_amdgcn_mfma_f32_16x16x32_bf16(pf, bf, o, 0, 0, 0);
                    }
                }
#undef DSA_GATHER
                const float linv = 1.0f / lsum; float li[4];
#pragma unroll
                for (int r = 0; r < 4; ++r) li[r] = __shfl(linv, 4 * g + r);
                LAS unsigned short* ost = (LAS unsigned short*)cb;
                if (g < 2) {
#pragma unroll
                    for (int cd = 0; cd < 8; ++cd)
#pragma unroll
                        for (int r = 0; r < 4; ++r) ost[(4 * g + r) * 128 + 16 * cd + hl] = (unsigned short)f2bf(O[cd][r] * li[r]);
                }
                LDS_WAIT();
                { const v4u w0 = *(const LAS v4u*)(cb + 32 * lane), w1 = *(const LAS v4u*)(cb + 32 * lane + 16);
                  if (!dry) { *(v4u*)(qlrow + 16 * lane) = w0; *(v4u*)(qlrow + 16 * lane + 8) = w1; } else asm volatile("" :: "v"(w0), "v"(w1)); }
                LDS_WAIT();
            }
        }
    }
    __syncthreads();
}

__device__ __noinline__ void final_norm(const float* const* in_, float* out_, unsigned char* ws_, LAS unsigned char* lds_, int wave_, int vcu_, int G_) {
    const PC F{uni(in_), uni(out_), uni(ws_), uni_l(lds_), uni_i(wave_), uni_i(vcu_), uni_i(G_)}; struct { const float* const* in; float* out; } a{F.in, F.out};
    const int lane_ = lane_id_v(); const int gw = F.vcu * NWAVES + F.wave, NGW = F.G * NWAVES; const float* g = a.in[22];
    f32x4 gv[4];
#pragma unroll
    for (int j = 0; j < 4; ++j) gv[j] = ((const f32x4*)g)[lane_ + 64 * j];
    for (int m = gw; m < M; m += NGW) {
        GAS f32x4* xr = (GAS f32x4*)(a.out + (size_t)m * D) + lane_;
        f32x4 v[4]; float s = 0.f;
#pragma unroll
        for (int j = 0; j < 4; ++j) { v[j] = xr[64 * j]; s += (v[j].x * v[j].x + v[j].y * v[j].y) + (v[j].z * v[j].z + v[j].w * v[j].w); }
        const float rs = 1.0f / sqrtf(wave_sum(s) * (1.0f / D) + EPS);
#pragma unroll
        for (int j = 0; j < 4; ++j) xr[64 * j] = v[j] * rs * gv[j];
    }
}

#define KIN ((const float* const*)__builtin_amdgcn_kernarg_segment_ptr())
constexpr int PH_PER_LAYER = 10, PH_LAYER0 = 2, N_PHASES = PH_LAYER0 + PH_PER_LAYER * DEPTH + 1;

__global__ void __launch_bounds__(NWAVES * 64, 2) mk_fwd(Args args) {
    extern __shared__ __attribute__((aligned(16))) unsigned char lds[];
    Frame F;
    F.lds = (LAS unsigned char*)lds;
    F.MISC = (volatile LAS unsigned*)(F.lds + MISC_OFF);
    F.wave = __builtin_amdgcn_readfirstlane((int)threadIdx.x >> 6);
    F.G = gridDim.x; { const int bx = blockIdx.x; F.vcu = (F.G % 8 == 0) ? (bx % 8) * (F.G / 8) + bx / 8 : bx; }
    F.ws = args.ws; F.ctl = (gu32*)(args.ws + WS_CTL);
    if (threadIdx.x < 64) ((LAS unsigned*)(F.lds + MISC_OFF))[threadIdx.x] = 0u;
    __syncthreads();
    const int lo = args.ph_lo, hi = args.ph_hi;
    const bool multi = (hi - lo) > 1;
    XcdBarrier bar; bar.bar = (unsigned*)(F.ctl + CW_BAR); bar.x = 0; bar.st = nullptr; bar.wave = F.wave;
    if (multi) bar = xcd_barrier_post((unsigned*)(F.ctl + CW_BAR), F.MISC + 8, F.wave);
#define IN(k) (lo <= (k) && (k) < hi)
#define SEAM(k) do { if (IN(k) && IN((k) + 1)) { xcd_barrier(bar); if (PROBE_PHASE == 99) xcd_barrier(bar); } } while (0)

    if (IN(0)) {
#if EN_P0
 for (int rep = (PROBE_PHASE == 1 ? 0 : 1); rep < 2; ++rep) p0_prologue(KIN, args.out, args.ws, F.lds, F.wave, F.vcu, F.G);
#endif
 } SEAM(0);
    if (IN(1)) {
#if !((DIS_MASK >> 7) & 1)
 unsigned char* ws = launder_p(args.ws); bf16* hb = (bf16*)(ws + WS_HB); float* ss = (float*)(ws + WS_SS); (void)hb; (void)ss;
        pg8::Gemm g{(const bf16_t*)(ws + WS_MEMN), (const bf16_t*)(ws + WS_WMEM), MROWS, DEPTH * 2 * CW, D}; pg8::StaticOrder S; S.init(MROWS, DEPTH * 2 * CW, F.G, launder_s((int)blockIdx.x));
        EpiPlainBf16 E{(bf16_t*)(ws + WS_MEMKV), DEPTH * 2 * CW};
        pg8::gemm_phase<EpiPlainBf16, pg8::StaticOrder, true, true>(F.lds + RING_OFF, g, S, E, F.wave);
        { pg8::Gemm g2{(const bf16_t*)(ws + WS_WMEM), (const bf16_t*)(ws + WS_MEMN), DEPTH * 2 * CW, MROWS, D}; pg8::StaticOrder S2; S2.init(DEPTH * 2 * CW, MROWS, F.G, launder_s((int)blockIdx.x));
          EpiPlainBf16 E2{(bf16_t*)(ws + WS_VT), MROWS};
          pg8::gemm_phase<EpiPlainBf16, pg8::StaticOrder, true, true>(F.lds + RING_OFF, g2, S2, E2, F.wave); }
#endif
    } SEAM(1);

    for (int l = 0; l < DEPTH; ++l) {
        const int pb = PH_LAYER0 + PH_PER_LAYER * l;
        const float* hbase = (l == 0) ? args.in[0] : args.out;
        if (IN(pb + 0)) {
#if EN_P0
 if (l > 0) for (int rep = (PROBE_PHASE == 1 ? 0 : 1); rep < 2; ++rep) prep_layer_weights(KIN, args.out, args.ws, F.lds, l, F.wave, F.vcu, F.G);
#endif
 } SEAM(pb + 0);
        if (IN(pb + 1)) {
#if !((DIS_MASK >> 0) & 1)
 unsigned char* ws = launder_p(args.ws); bf16* hb = (bf16*)(ws + WS_HB); float* ss = (float*)(ws + WS_SS); (void)hb; (void)ss;
            pg8::Gemm g{hb, (const bf16_t*)(ws + WS_W1IN), M, 2 * DFF, D}; pg8::StaticOrder S; S.init(M, 2 * DFF, F.G, launder_s((int)blockIdx.x));
            EpiSwiglu E{(bf16_t*)(ws + WS_ACT), ss};
            for (int rep = (PROBE_PHASE == 2 ? 0 : 1); rep < 2; ++rep) pg8::gemm_phase<EpiSwiglu, pg8::StaticOrder, true, true>(F.lds + RING_OFF, g, S, E, F.wave);
#endif
        } SEAM(pb + 1);
        if (IN(pb + 2)) {
#if !((DIS_MASK >> 1) & 1)
 unsigned char* ws = launder_p(args.ws); bf16* hb = (bf16*)(ws + WS_HB); float* ss = (float*)(ws + WS_SS); (void)hb; (void)ss;
            pg8::Gemm g{(const bf16_t*)(ws + WS_ACT), (const bf16_t*)(ws + WS_W1OUT), M, D, DFF}; pg8::StaticOrder S; S.init(M, D, F.G, launder_s((int)blockIdx.x));
            for (int rep = (PROBE_PHASE == 3 ? 0 : 1); rep < 2; ++rep) { EpiResid E{hbase, args.out, hb, ss, 0.5f, (LAS float*)(F.lds + RING_BYTES), rep == 0 ? 1 : 0};
            pg8::gemm_phase<EpiResid, pg8::StaticOrder, true, true>(F.lds + RING_OFF, g, S, E, F.wave); }
#endif
        } SEAM(pb + 2);
        if (IN(pb + 3)) {
#if !((DIS_MASK >> 2) & 1)
 unsigned char* ws = launder_p(args.ws); bf16* hb = (bf16*)(ws + WS_HB); float* ss = (float*)(ws + WS_SS); (void)hb; (void)ss;
            pg8::Gemm g{hb, (const bf16_t*)(ws + WS_WIN), M, INP, D}; pg8::StaticOrder S; S.init(M, INP, F.G, launder_s((int)blockIdx.x));
            EpiInProj E{ss, (bf16_t*)(ws + WS_QL), (float*)(ws + WS_CKVRAW), (bf16_t*)(ws + WS_IK), (float*)(ws + WS_IW), (bf16_t*)(ws + WS_IQRAW), (bf16_t*)(ws + WS_Z), (bf16_t*)(ws + WS_QC), (bf16_t*)(ws + WS_G)};
            for (int rep = (PROBE_PHASE == 4 ? 0 : 1); rep < 2; ++rep) pg8::gemm_phase<EpiInProj, pg8::StaticOrder, true, true>(F.lds + RING_OFF, g, S, E, F.wave);
#endif
        } SEAM(pb + 3);
        if (IN(pb + 4)) {
#if EN_PREP
 for (int rep = (PROBE_PHASE == 5 ? 0 : 1); rep < 2; ++rep) prep_tokens(KIN, args.out, args.ws, F.lds, l, F.wave, F.vcu, F.G, rep == 0 ? 1 : 0);
#endif
 } SEAM(pb + 4);
        if (IN(pb + 5)) {
#if EN_DSA
 for (int rep = (PROBE_PHASE == 6 ? 0 : 1); rep < 2; ++rep) for (int p = F.vcu; p < BATCH * 64; p += F.G) { for (int half = 0; half < 2; ++half) { const int b_ = p >> 6, ub_ = half == 0 ? (p & 63) : 127 - (p & 63);
   sel_pass1(args.ws, F.lds, F.wave, b_, ub_); if (PROBE_PHASE == 61) sel_pass1(args.ws, F.lds, F.wave, b_, ub_); sel_pass2(args.ws, F.lds, F.wave, b_, ub_); if (PROBE_PHASE == 62) sel_pass2(args.ws, F.lds, F.wave, b_, ub_); sel_resolve(args.ws, F.lds, F.wave, b_, ub_, (int)blockIdx.x, (p == F.vcu && half == 0) ? 1 : 0); if (PROBE_PHASE == 63) sel_resolve(args.ws, F.lds, F.wave, b_, ub_, (int)blockIdx.x, 0); } }
 dsa_select_slow(args.ws, F.lds, F.wave, (int)blockIdx.x); for (int rep = (PROBE_PHASE == 7 ? 0 : 1); rep < 2; ++rep) dsa_attend(args.ws, F.lds, args.in[2], F.wave, F.vcu, F.G, rep == 0 ? 1 : 0);
#endif
 } SEAM(pb + 5);
        if (IN(pb + 6)) {
#if !((DIS_MASK >> 3) & 1)
        for (int rep6 = (PROBE_PHASE == 8 ? 0 : 1); rep6 < 2; ++rep6) {
 unsigned char* ws = launder_p(args.ws); bf16* hb = (bf16*)(ws + WS_HB); float* ss = (float*)(ws + WS_SS); (void)hb; (void)ss;
            { pg8::Gemm g{(const bf16_t*)(ws + WS_QL), (const bf16_t*)(ws + WS_WA), M, D, 1024}; pg8::StaticOrder S; S.init(M, D, F.G, launder_s((int)blockIdx.x));
              EpiMerge<0> E{(bf16_t*)(ws + WS_MERGED), (const bf16_t*)(ws + WS_G)};
              pg8::gemm_phase<EpiMerge<0>, pg8::StaticOrder, true, true>(F.lds + RING_OFF, g, S, E, F.wave); }
            { pg8::Gemm g{(const bf16_t*)(ws + WS_YB), (const bf16_t*)(ws + WS_WB), M, D, PW_}; pg8::StaticOrder S; S.init(M, D, F.G, launder_s((int)blockIdx.x));
              EpiMerge<1> E{(bf16_t*)(ws + WS_MERGED), (const bf16_t*)(ws + WS_G)};
              pg8::gemm_phase<EpiMerge<1>, pg8::StaticOrder, true, true>(F.lds + RING_OFF, g, S, E, F.wave); }
            { pg8::Gemm g{(const bf16_t*)(ws + WS_QC), (const bf16_t*)(ws + WS_WC), M, D, CW}; pg8::StaticOrder S; S.init(M, D, F.G, launder_s((int)blockIdx.x));
              EpiMerge<2> E{(bf16_t*)(ws + WS_MERGED), (const bf16_t*)(ws + WS_G)};
              pg8::gemm_phase<EpiMerge<2>, pg8::StaticOrder, true, true>(F.lds + RING_OFF, g, S, E, F.wave); }
        }
#endif
        } SEAM(pb + 6);
        if (IN(pb + 7)) {
#if !((DIS_MASK >> 4) & 1)
 unsigned char* ws = launder_p(args.ws); bf16* hb = (bf16*)(ws + WS_HB); float* ss = (float*)(ws + WS_SS); (void)hb; (void)ss;
            pg8::Gemm g{(const bf16_t*)(ws + WS_MERGED), (const bf16_t*)(ws + WS_WOUT), M, D, D}; pg8::StaticOrder S; S.init(M, D, F.G, launder_s((int)blockIdx.x));
            for (int rep = (PROBE_PHASE == 9 ? 0 : 1); rep < 2; ++rep) { EpiResid E{args.out, args.out, hb, ss, 1.0f, (LAS float*)(F.lds + RING_BYTES), rep == 0 ? 1 : 0};
            pg8::gemm_phase<EpiResid, pg8::StaticOrder, true, true>(F.lds + RING_OFF, g, S, E, F.wave); }
#endif
        } SEAM(pb + 7);
        if (IN(pb + 8)) {
#if !((DIS_MASK >> 5) & 1)
 unsigned char* ws = launder_p(args.ws); bf16* hb = (bf16*)(ws + WS_HB); float* ss = (float*)(ws + WS_SS); (void)hb; (void)ss;
            pg8::Gemm g{hb, (const bf16_t*)(ws + WS_W2IN), M, 2 * DFF, D}; pg8::StaticOrder S; S.init(M, 2 * DFF, F.G, launder_s((int)blockIdx.x));
            EpiSwiglu E{(bf16_t*)(ws + WS_ACT), ss};
            for (int rep = (PROBE_PHASE == 2 ? 0 : 1); rep < 2; ++rep) pg8::gemm_phase<EpiSwiglu, pg8::StaticOrder, true, true>(F.lds + RING_OFF, g, S, E, F.wave);
#endif
        } SEAM(pb + 8);
        if (IN(pb + 9)) {
#if !((DIS_MASK >> 6) & 1)
 unsigned char* ws = launder_p(args.ws); bf16* hb = (bf16*)(ws + WS_HB); float* ss = (float*)(ws + WS_SS); (void)hb; (void)ss;
            pg8::Gemm g{(const bf16_t*)(ws + WS_ACT), (const bf16_t*)(ws + WS_W2OUT), M, D, DFF}; pg8::StaticOrder S; S.init(M, D, F.G, launder_s((int)blockIdx.x));
            for (int rep = (PROBE_PHASE == 3 ? 0 : 1); rep < 2; ++rep) { EpiResid E{args.out, args.out, hb, ss, 0.5f, (LAS float*)(F.lds + RING_BYTES), rep == 0 ? 1 : 0};
            pg8::gemm_phase<EpiResid, pg8::StaticOrder, true, true>(F.lds + RING_OFF, g, S, E, F.wave); }
#endif
        } SEAM(pb + 9);
    }
#if EN_P0
    if (IN(N_PHASES - 1)) { final_norm(KIN, args.out, args.ws, F.lds, F.wave, F.vcu, F.G); }
#endif
#undef IN
#undef SEAM
}

extern "C" void kernel_launch(void* const* d_in, const int* in_sizes, int n_in, void* d_out, int out_size, void* d_ws, size_t ws_size, hipStream_t stream) {
    static int grid = 0;
    if (grid == 0) {
        if (n_in != 23 || in_sizes[0] != M * D || out_size != M * D || ws_size < WS_END) { fprintf(stderr, "kernel_launch: unexpected shapes (n_in %d, ws %zu)\n", n_in, ws_size); grid = -1; return; }
        int dev = 0, cus = 0, per_cu = 0;
        if (hipGetDevice(&dev) != hipSuccess || hipDeviceGetAttribute(&cus, hipDeviceAttributeMultiprocessorCount, dev) != hipSuccess) { grid = -1; return; }
        if (hipFuncSetAttribute((const void*)mk_fwd, hipFuncAttributeMaxDynamicSharedMemorySize, LDS_BYTES) != hipSuccess) { fprintf(stderr, "kernel_launch: hipFuncSetAttribute failed\n"); grid = -1; return; }
        if (hipOccupancyMaxActiveBlocksPerMultiprocessor(&per_cu, (const void*)mk_fwd, NWAVES * 64, LDS_BYTES) != hipSuccess || per_cu < 1) { fprintf(stderr, "kernel_launch: occupancy query says %d\n", per_cu); }
        (void)hipGetLastError();
        grid = cus;
    }
    if (grid < 0) return;
    if (hipMemsetAsync((char*)d_ws + WS_CTL, 0, CTL_ZERO_BYTES, stream) != hipSuccess) return;
    Args a{};
    for (int i = 0; i < 23; ++i) a.in[i] = (const float*)d_in[i];
    a.out = (float*)d_out; a.ws = (unsigned char*)d_ws;
#if MK_ONE_LAUNCH
    a.ph_lo = 0; a.ph_hi = N_PHASES;
    hipLaunchKernelGGL(mk_fwd, dim3(grid), dim3(NWAVES * 64), LDS_BYTES, stream, a);
#endif
}
```

```cpp
#include <hip/hip_runtime.h>
#include <cstdio>
#include <cstdint>

#ifndef MK_ONE_LAUNCH
#define MK_ONE_LAUNCH 1
#endif
#ifndef PROBE_PHASE
#define PROBE_PHASE 0
#endif
#ifndef EN_P0
#define EN_P0 MK_ONE_LAUNCH
#endif
#ifndef EN_PREP
#define EN_PREP MK_ONE_LAUNCH
#endif
#ifndef EN_DSA
#define EN_DSA MK_ONE_LAUNCH
#endif
#ifndef DIS_MASK
#define DIS_MASK 0
#endif
#ifndef MK_ONE_LAUNCH
#define MK_ONE_LAUNCH 1
#endif

__device__ __forceinline__ int lane_id_v() { int l; asm volatile("v_mbcnt_lo_u32_b32 %0, -1, 0\n\tv_mbcnt_hi_u32_b32 %0, -1, %0" : "=v"(l)); return l; }
namespace pg8 {
#define PG8_LAS __attribute__((address_space(3)))
typedef unsigned short bf16_t;
typedef short bf16x8 __attribute__((ext_vector_type(8)));
typedef float f32x4 __attribute__((ext_vector_type(4)));
typedef unsigned u32x4 __attribute__((ext_vector_type(4)));
typedef unsigned u32x2 __attribute__((ext_vector_type(2)));
constexpr int BM = 256, BK = 64, HALF = 128, HTB = HALF * BK * 2, STAGE_BYTES = 8 * HTB, NXCD = 8, WGM = 8;

__host__ __device__ __forceinline__ int lds_byte(int r, int c) { const int st = (r >> 4) * 2 + (c >> 5), rr = r & 15, cc = c & 31, ob = rr * 64 + cc * 2; return st * 1024 + (ob ^ (((ob >> 9) & 1) << 5)); }
__host__ __device__ __forceinline__ void stage_rc(int b, int& R, int& C) { const int st = b / 1024, sb = b % 1024, swz = sb ^ (((sb >> 9) & 1) << 5); R = (st >> 1) * 16 + swz / 64; C = (st & 1) * 32 + (swz % 64) / 2; }
__host__ __device__ __forceinline__ int perm32(int rho) { const int n = rho >> 4, i = rho & 15; return 8 * (i >> 2) + 4 * n + (i & 3); }

struct Unit { int pm, pn; };
struct Gemm { const bf16_t* A; const bf16_t* Bt; int M, N, K; };

struct StaticOrder {
    int nM, nN, nwg, G, c;
    __host__ __device__ void init(int M, int N, int G_, int c_) { nM = M / BM; nN = N / BM; nwg = nM * nN; G = G_; c = c_; }
    __host__ __device__ bool next(int i, Unit& u) const {
        const long L = (long)i * G + c; if (L >= nwg) return false;
        int wgid = (int)L; { const int q = nwg / NXCD, r = nwg % NXCD, xcd = wgid % NXCD, off = wgid / NXCD; wgid = (xcd < r ? xcd * (q + 1) : r * (q + 1) + (xcd - r) * q) + off; }
        const int nig = WGM * nN, gid = wgid / nig, fm = gid * WGM, gsz = (nM - fm) < WGM ? (nM - fm) : WGM;
        u.pm = fm + ((wgid % nig) % gsz); u.pn = (wgid % nig) / gsz; return true;
    }
    __device__ __forceinline__ void a_ready(const Unit&) const {}
    __device__ __forceinline__ void done(const Unit&) const {}
};

__device__ __forceinline__ unsigned cvt_pk_bf16(float lo, float hi) { unsigned r; asm volatile("v_cvt_pk_bf16_f32 %0, %1, %2" : "=v"(r) : "v"(lo), "v"(hi)); return r; }

template <class Epi, class Sched, bool ALIGN_EPI = false, bool SP2 = false>
__device__ __forceinline__ void gemm_phase(PG8_LAS unsigned char* lds, const Gemm g, const Sched& S, const Epi& E, const int wid_) {
    int wid = wid_; asm volatile("" : "+s"(wid));
    const int lane = lane_id_v(), tid = wid * 64 + lane,
              wr = wid >> 2, wc = wid & 3, fr = lane & 15, fq = lane >> 4;
    const int K = g.K, nt = K / BK;
    unsigned voffA[2], voffB[2];
#pragma unroll
    for (int i = 0; i < 2; ++i) { int R, C; stage_rc(tid * 16 + i * 8192, R, C); const int Rb = Epi::PERM ? ((R & ~31) + perm32(R & 31)) : R;
        voffA[i] = (unsigned)(R * K + C) * 2u; voffB[i] = (unsigned)(Rb * K + C) * 2u; }
    const size_t kstep = (size_t)(BK * 2);
    const size_t hstep = (size_t)HALF * K * 2;
    const size_t tstep = 2 * hstep;
    const unsigned ldsw = (unsigned)wid * 1024u;
    const int aoff = lds_byte(wr * 64 + fr, fq * 8), boff = lds_byte(wc * 32 + fr, fq * 8);
#define PG8_SA(b, h) (((b) * 2 + (h)) * HTB)
#define PG8_SB(b, h) ((4 + (b) * 2 + (h)) * HTB)
#define PG8_STAGE(bufoff, gbase, voff) do { _Pragma("unroll") for (int _i = 0; _i < 2; ++_i) \
        __builtin_amdgcn_global_load_lds((const unsigned*)((const char*)(gbase) + (voff)[_i]), (PG8_LAS unsigned*)(lds + (bufoff) + ldsw + _i * 8192), 16, 0, 0); } while (0)
#define PG8_LDA(dst, b, h) do { _Pragma("unroll") for (int m = 0; m < 4; ++m) _Pragma("unroll") for (int k = 0; k < 2; ++k) dst[m][k] = *(const PG8_LAS bf16x8*)(lds + PG8_SA(b, h) + aoff + m * 2048 + k * 1024); } while (0)
#define PG8_LDB(dst, b, h) do { _Pragma("unroll") for (int n = 0; n < 2; ++n) _Pragma("unroll") for (int k = 0; k < 2; ++k) dst[n][k] = *(const PG8_LAS bf16x8*)(lds + PG8_SB(b, h) + boff + n * 2048 + k * 1024); } while (0)
#define PG8_MMA(ai, bj, At, Bt) do { __builtin_amdgcn_s_setprio(1); _Pragma("unroll") for (int m = 0; m < 4; ++m) _Pragma("unroll") for (int n = 0; n < 2; ++n) _Pragma("unroll") for (int k = 0; k < 2; ++k) \
        acc[ai][bj][m][n] = __builtin_amdgcn_mfma_f32_16x16x32_bf16(Bt[n][k], At[m][k], acc[ai][bj][m][n], 0, 0, 0); __builtin_amdgcn_s_setprio(0); } while (0)
#define PG8_WAIT_V(n) asm volatile("s_waitcnt vmcnt(" #n ")" ::: "memory")
#define PG8_WAIT_L(n) asm volatile("s_waitcnt lgkmcnt(" #n ")" ::: "memory")
#define PG8_BAR __builtin_amdgcn_s_barrier()
#define PG8_SCHED __builtin_amdgcn_sched_barrier(0)
    Unit cur, nxt; int ui = 0;
    if (!S.next(0, cur)) return;
    f32x4 acc[2][2][4][2];
#pragma unroll
    for (int a = 0; a < 2; ++a)
#pragma unroll
        for (int b = 0; b < 2; ++b)
#pragma unroll
            for (int m = 0; m < 4; ++m)
#pragma unroll
                for (int n = 0; n < 2; ++n) acc[a][b][m][n] = (f32x4){0.f, 0.f, 0.f, 0.f};
    bf16x8 At[4][2], B0[2][2], B1[2][2];
    const char* cA = (const char*)g.A + (size_t)cur.pm * tstep; const char* cB = (const char*)g.Bt + (size_t)cur.pn * tstep;
    S.a_ready(cur);
    if constexpr (SP2) {
        PG8_STAGE(PG8_SB(0, 0), cB, voffB); PG8_STAGE(PG8_SB(0, 1), cB + hstep, voffB); PG8_STAGE(PG8_SA(0, 0), cA, voffA); PG8_STAGE(PG8_SA(0, 1), cA + hstep, voffA);
        if (wr == 1) PG8_BAR;
        PG8_WAIT_V(2); PG8_BAR;
        PG8_STAGE(PG8_SB(1, 0), cB + kstep, voffB); PG8_STAGE(PG8_SA(1, 0), cA + kstep, voffA); PG8_STAGE(PG8_SB(1, 1), cB + hstep + kstep, voffB);
        PG8_WAIT_V(6); PG8_BAR;
    } else {
        PG8_STAGE(PG8_SB(0, 0), cB, voffB); PG8_STAGE(PG8_SA(0, 0), cA, voffA); PG8_STAGE(PG8_SB(0, 1), cB + hstep, voffB); PG8_STAGE(PG8_SA(0, 1), cA + hstep, voffA);
        if (wr == 1) PG8_BAR;
        PG8_WAIT_V(4); PG8_BAR;
        PG8_STAGE(PG8_SB(1, 0), cB + kstep, voffB); PG8_STAGE(PG8_SA(1, 0), cA + kstep, voffA); PG8_STAGE(PG8_SB(1, 1), cB + hstep + kstep, voffB);
        PG8_WAIT_V(6); PG8_BAR;
    }
    for (;;) {
        const bool has_next = S.next(ui + 1, nxt);
        const char* nA = has_next ? (const char*)g.A + (size_t)nxt.pm * tstep : cA; const char* nB = has_next ? (const char*)g.Bt + (size_t)nxt.pn * tstep : cB;
#pragma nounroll
        for (int t = 0; t < nt; t += 2) {
            const bool last = (t == nt - 2);
            const char* a1 = cA + (size_t)(t + 1) * kstep;
            const char* a2 = last ? nA : cA + (size_t)(t + 2) * kstep; const char* b2 = last ? nB : cB + (size_t)(t + 2) * kstep;
            const char* a3 = a2 + kstep; const char* b3 = b2 + kstep;
            if (last && has_next) S.a_ready(nxt);
            if constexpr (SP2) {
            PG8_LDB(B0, 0, 0); PG8_LDB(B1, 0, 1); PG8_SCHED; PG8_LDA(At, 0, 0); PG8_STAGE(PG8_SA(1, 1), a1 + hstep, voffA);
            PG8_WAIT_V(8); PG8_WAIT_L(0); PG8_BAR; PG8_MMA(0, 0, At, B0); PG8_MMA(0, 1, At, B1); PG8_BAR; PG8_SCHED;
            PG8_LDA(At, 0, 1); PG8_STAGE(PG8_SB(0, 0), b2, voffB); PG8_STAGE(PG8_SB(0, 1), b2 + hstep, voffB); PG8_STAGE(PG8_SA(0, 0), a2, voffA);
            PG8_WAIT_V(8); PG8_WAIT_L(0); PG8_BAR; PG8_MMA(1, 0, At, B0); PG8_MMA(1, 1, At, B1); PG8_BAR; PG8_SCHED;
            PG8_LDB(B0, 1, 0); PG8_LDB(B1, 1, 1); PG8_SCHED; PG8_LDA(At, 1, 0); PG8_STAGE(PG8_SA(0, 1), a2 + hstep, voffA);
            PG8_WAIT_V(8); PG8_WAIT_L(0); PG8_BAR; PG8_MMA(0, 0, At, B0); PG8_MMA(0, 1, At, B1); PG8_BAR; PG8_SCHED;
            PG8_LDA(At, 1, 1); PG8_STAGE(PG8_SB(1, 0), b3, voffB); PG8_STAGE(PG8_SB(1, 1), b3 + hstep, voffB); PG8_STAGE(PG8_SA(1, 0), a3, voffA);
            PG8_WAIT_V(8); PG8_WAIT_L(0); PG8_BAR; PG8_MMA(1, 0, At, B0); PG8_MMA(1, 1, At, B1); PG8_BAR; PG8_SCHED;
            } else {
            PG8_LDB(B0, 0, 0); PG8_SCHED; PG8_LDA(At, 0, 0); PG8_STAGE(PG8_SA(1, 1), a1 + hstep, voffA);
            PG8_WAIT_L(8); PG8_BAR; PG8_WAIT_L(0); PG8_MMA(0, 0, At, B0); PG8_BAR; PG8_SCHED;
            PG8_LDB(B1, 0, 1); PG8_STAGE(PG8_SB(0, 0), b2, voffB);
            PG8_BAR; PG8_WAIT_L(0); PG8_MMA(0, 1, At, B1); PG8_BAR;
            PG8_LDA(At, 0, 1); PG8_STAGE(PG8_SA(0, 0), a2, voffA);
            PG8_BAR; PG8_WAIT_L(0); PG8_MMA(1, 0, At, B0); PG8_BAR; PG8_SCHED;
            PG8_STAGE(PG8_SB(0, 1), b2 + hstep, voffB);
            PG8_WAIT_V(6); PG8_BAR; PG8_MMA(1, 1, At, B1); PG8_BAR;
            PG8_LDB(B0, 1, 0); PG8_SCHED; PG8_LDA(At, 1, 0); PG8_STAGE(PG8_SA(0, 1), a2 + hstep, voffA);
            PG8_WAIT_L(8); PG8_BAR; PG8_WAIT_L(0); PG8_MMA(0, 0, At, B0); PG8_BAR; PG8_SCHED;
            PG8_LDB(B1, 1, 1); PG8_STAGE(PG8_SB(1, 0), b3, voffB);
            PG8_BAR; PG8_WAIT_L(0); PG8_MMA(0, 1, At, B1); PG8_BAR;
            PG8_LDA(At, 1, 1); PG8_STAGE(PG8_SA(1, 0), a3, voffA);
            PG8_BAR; PG8_WAIT_L(0); PG8_MMA(1, 0, At, B0); PG8_BAR; PG8_SCHED;
            PG8_STAGE(PG8_SB(1, 1), b3 + hstep, voffB);
            PG8_WAIT_V(6); PG8_BAR; PG8_MMA(1, 1, At, B1); PG8_BAR;
            }
        }
        if constexpr (ALIGN_EPI) { if (wr == 0) PG8_BAR; }
        E(acc, cur, wr, wc, fr, fq); S.done(cur);
        if (!has_next) break;
#pragma unroll
        for (int a = 0; a < 2; ++a)
#pragma unroll
            for (int b = 0; b < 2; ++b)
#pragma unroll
                for (int m = 0; m < 4; ++m)
#pragma unroll
                    for (int n = 0; n < 2; ++n) acc[a][b][m][n] = (f32x4){0.f, 0.f, 0.f, 0.f};
        cur = nxt; cA = nA; cB = nB; ++ui;
        if constexpr (ALIGN_EPI) { if (wr == 1) PG8_BAR; }
    }
    PG8_WAIT_V(0);
    if constexpr (!ALIGN_EPI) { if (wr == 0) PG8_BAR; }
    PG8_BAR;
#undef PG8_SA
#undef PG8_SB
#undef PG8_STAGE
#undef PG8_LDA
#undef PG8_LDB
#undef PG8_MMA
#undef PG8_WAIT_V
#undef PG8_WAIT_L
#undef PG8_BAR
#undef PG8_SCHED
}
}

constexpr int NWAVES = 8;
constexpr int BATCH = 4, SEQ = 8192, D = 1024, DEPTH = 4, M = BATCH * SEQ;
constexpr int NMEM = 256, MROWS = BATCH * NMEM;
constexpr int AH = 8, AHD = 64, AW = 512, KVR = 128, IH = 8, IDIM = 32, TOPK = 256;
constexpr int PW_ = 256, CH = 4, CHD = 64, CW = 256;
constexpr int DFF = 2816, INW = 4520, INP = 5120;
constexpr float EPS = 1e-6f;
constexpr int C_QA = 0, C_CKV = 512, C_IQ = 640, C_IK = 896, C_IW = 928, C_Z = 936, C_QC = 1192, C_G = 1448;

constexpr size_t MiB = 1u << 20;
constexpr size_t WS_CTL = 0, CTL_ZERO_BYTES = 1 * MiB;
constexpr size_t WS_SS = 1 * MiB;
constexpr size_t WS_IW = 3 * MiB;
constexpr size_t WS_SGN = 4 * MiB;
constexpr size_t WS_MEMN = 5 * MiB;
constexpr size_t WS_WMEM = 7 * MiB;
constexpr size_t WS_MEMKV = 11 * MiB;
constexpr size_t WS_W1IN = 15 * MiB, WS_W1OUT = 26 * MiB, WS_WIN = 32 * MiB, WS_WA = 42 * MiB, WS_WB = 44 * MiB, WS_WC = 44 * MiB + 512 * 1024, WS_WOUT = 45 * MiB, WS_W2IN = 47 * MiB, WS_W2OUT = 58 * MiB;
constexpr size_t WS_HB = 64 * MiB;
constexpr size_t WS_ACT = 128 * MiB;
constexpr size_t WS_G = 128 * MiB;
constexpr size_t WS_QL = 320 * MiB;
constexpr size_t WS_CKV = 384 * MiB;
constexpr size_t WS_CKVRAW = 392 * MiB;
constexpr size_t WS_IQRAW = 408 * MiB;
constexpr size_t WS_IQF = 424 * MiB;
constexpr size_t WS_IK = 440 * MiB;
constexpr size_t WS_Z = 442 * MiB;
constexpr size_t WS_MERGED = 384 * MiB;
constexpr size_t WS_YB = 458 * MiB;
constexpr size_t WS_QC = 474 * MiB;
constexpr size_t WS_SEL = 490 * MiB;
constexpr size_t WS_VT = 506 * MiB;
constexpr size_t WS_WPT = 4 * MiB + 512 * 1024;
constexpr size_t WS_END = 510 * MiB;
constexpr int CW_BAR = 4096;

constexpr int RING_OFF = 0, RING_BYTES = 131072;
constexpr int LDS_BYTES = 155648;
constexpr int MISC_OFF = LDS_BYTES - 256;

#define GAS __attribute__((address_space(1)))
#define LAS __attribute__((address_space(3)))
typedef unsigned short bf16;
typedef unsigned v4u __attribute__((ext_vector_type(4)));
typedef unsigned v2u __attribute__((ext_vector_type(2)));
typedef float f32x4 __attribute__((ext_vector_type(4)));
typedef float f32x2 __attribute__((ext_vector_type(2)));
typedef GAS unsigned gu32;
#define RLX_AGENT __ATOMIC_RELAXED, __HIP_MEMORY_SCOPE_AGENT
#define LDS_WAIT() asm volatile("s_waitcnt lgkmcnt(0)" ::: "memory")
#define VM_WAIT() asm volatile("s_waitcnt vmcnt(0)" ::: "memory")
__device__ __forceinline__ unsigned f2bf(float f) { unsigned u = __builtin_bit_cast(unsigned, f); return (u + 0x7fffu + ((u >> 16) & 1u)) >> 16; }
__device__ __forceinline__ unsigned pk2(float lo, float hi) { return pg8::cvt_pk_bf16(lo, hi); }
__device__ __forceinline__ float bflo(unsigned w) { return __builtin_bit_cast(float, w << 16); }
__device__ __forceinline__ float bfhi(unsigned w) { return __builtin_bit_cast(float, w & 0xffff0000u); }
typedef _Float16 h2_t __attribute__((ext_vector_type(2)));
typedef _Float16 f16x8_t __attribute__((ext_vector_type(8)));
__device__ __forceinline__ unsigned pkh2(float lo, float hi) { const h2_t v = {(_Float16)lo, (_Float16)hi}; return __builtin_bit_cast(unsigned, v); }
__device__ __forceinline__ float hlo(unsigned w) { return (float)__builtin_bit_cast(h2_t, w)[0]; }
__device__ __forceinline__ float hhi(unsigned w) { return (float)__builtin_bit_cast(h2_t, w)[1]; }
__device__ __forceinline__ float bf2f(bf16 b) { return __builtin_bit_cast(float, ((unsigned)b) << 16); }

#define XB_TMO      128
#define XB_XCNT(j)  (256  + 64 * (j))
#define XB_XSUB(j)  (1280 + 64 * (j))
#define XB_XGEN(j)  (2304 + 64 * (j))
#define XB_TOP      3328
#define XB_TOPGEN   3392
#define XCD_BAR_WORDS 3456
#define XB_SPIN_CAP (1u << 23)

__device__ __forceinline__ unsigned xb_ld(unsigned* p)              { return __hip_atomic_load(p, __ATOMIC_RELAXED, __HIP_MEMORY_SCOPE_AGENT); }
__device__ __forceinline__ unsigned xb_add(unsigned* p, unsigned v) { return __hip_atomic_fetch_add(p, v, __ATOMIC_RELAXED, __HIP_MEMORY_SCOPE_AGENT); }
__device__ __forceinline__ unsigned xb_xcc_id() { return (unsigned)__builtin_amdgcn_s_getreg((3 << 11) | 20) & 0xFu; }
#define XB_SPIN(cond, bar) do { unsigned _sp = 0; while (cond) { __builtin_amdgcn_s_sleep(1); \
    if ((++_sp & 255u) == 0u) { if (xb_ld(&(bar)[XB_TMO])) break; if (_sp > XB_SPIN_CAP) { atomicAdd(&(bar)[XB_TMO], 1u); break; } } } } while (0)

struct XcdBarrier { unsigned* bar; unsigned x; volatile LAS unsigned* st; int wave; };

__device__ __forceinline__ XcdBarrier xcd_barrier_post(unsigned* bar, volatile LAS unsigned* st, int wave) {
    XcdBarrier b; b.bar = bar; b.x = xb_xcc_id(); b.st = st; b.wave = wave;
    if (threadIdx.x == 0) (void)xb_add(&bar[XB_XCNT(b.x)], 1u);
    return b;
}
__device__ __forceinline__ void xcd_barrier_complete(unsigned* bar, unsigned x, unsigned& nloc, unsigned& nx) {
    const unsigned G = gridDim.x * gridDim.y * gridDim.z;
    unsigned sum, cnt, mine, sp = 0u;
    for (;;) {
        sum = 0u; cnt = 0u; mine = 0u;
#pragma unroll
        for (unsigned j = 0; j < 16; ++j) { const unsigned c = xb_ld(&bar[XB_XCNT(j)]); sum += c; cnt += (c > 0u) ? 1u : 0u; mine = (j == x) ? c : mine; }
        if (sum == G) break;
        __builtin_amdgcn_s_sleep(1);
        if ((++sp & 255u) == 0u) { if (xb_ld(&bar[XB_TMO])) break; if (sp > XB_SPIN_CAP) { atomicAdd(&bar[XB_TMO], 1u); break; } }
    }
    nloc = mine > 0u ? mine : 1u; nx = cnt > 0u ? cnt : 1u;
}
__device__ __forceinline__ void xcd_barrier(const XcdBarrier& b) {
    asm volatile("s_waitcnt vmcnt(0)" ::: "memory");
    __syncthreads();
    int bw_ = b.wave; asm volatile("" : "+s"(bw_));
    if (bw_ == 0 && lane_id_v() == 0) {
        unsigned* bar = b.bar;
        __builtin_amdgcn_s_waitcnt(0);
        unsigned nloc = b.st[0], nx = b.st[1];
        if (nloc == 0u) { xcd_barrier_complete(bar, b.x, nloc, nx); b.st[0] = nloc; b.st[1] = nx; }
        const unsigned old = xb_add(&bar[XB_XSUB(b.x)], 1u);
        const unsigned gen = old / nloc;
        if (old + 1u == (gen + 1u) * nloc) {
            __builtin_amdgcn_fence(__ATOMIC_RELEASE, "agent");
            asm volatile("s_waitcnt vmcnt(0)" ::: "memory");
            const unsigned og = xb_add(&bar[XB_TOP], 1u);
            const unsigned tg = og / nx;
            if (og + 1u == (tg + 1u) * nx) xb_add(&bar[XB_TOPGEN], 1u);
            else XB_SPIN(xb_ld(&bar[XB_TOPGEN]) == tg, bar);
            __builtin_amdgcn_fence(__ATOMIC_ACQUIRE, "agent");
            xb_add(&bar[XB_XGEN(b.x)], 1u);
            asm volatile("s_waitcnt vmcnt(0)" ::: "memory");
        } else {
            XB_SPIN(xb_ld(&bar[XB_XGEN(b.x)]) == gen, bar);
            __builtin_amdgcn_fence(__ATOMIC_ACQUIRE, "agent");
            asm volatile("s_waitcnt vmcnt(0)" ::: "memory");
        }
    }
    __syncthreads();
}

struct Args {
    const float* in[23]; float* out; unsigned char* ws; int ph_lo, ph_hi;
};
template <class T> __device__ __forceinline__ T* uni(T* p) { const unsigned long long v = (unsigned long long)p; const unsigned lo = __builtin_amdgcn_readfirstlane((unsigned)v), hi = __builtin_amdgcn_readfirstlane((unsigned)(v >> 32)); return (T*)(((unsigned long long)hi << 32) | lo); }
__device__ __forceinline__ LAS unsigned char* uni_l(LAS unsigned char* p) { return (LAS unsigned char*)(unsigned)__builtin_amdgcn_readfirstlane((int)(unsigned)(size_t)p); }
__device__ __forceinline__ int uni_i(int v) { return __builtin_amdgcn_readfirstlane(v); }
struct PC { const float* const* in; float* out; unsigned char* ws; LAS unsigned char* lds; int wave, vcu, G; };
struct Frame {
    LAS unsigned char* lds;
    volatile LAS unsigned* MISC;
    gu32* ctl;
    int wave, vcu, G;
    unsigned char* ws;
};
__device__ __forceinline__ unsigned char* launder_p(unsigned char* p) { asm volatile("" : "+s"(p)); return p; }
__device__ __forceinline__ int launder_s(int v) { asm volatile("" : "+s"(v)); return v; }
__device__ __forceinline__ int launder_v(int v) { asm volatile("" : "+v"(v)); return v; }
__device__ __forceinline__ float wave_sum(float v) {
#pragma unroll
    for (int o = 1; o < 64; o <<= 1) v += __shfl_xor(v, o);
    return v;
}
__device__ __forceinline__ float wave_max(float v) {
#pragma unroll
    for (int o = 1; o < 64; o <<= 1) v = fmaxf(v, __shfl_xor(v, o));
    return v;
}

using pg8::Unit; using pg8::bf16_t;
#define LAUNDER2(a, b) asm volatile("" : "+v"(a), "+v"(b))
__device__ __forceinline__ float row_scale(const float* ss, int row) {
    const f32x4 a = *(const f32x4*)(ss + (size_t)row * 4);
    const float s = (a.x + a.y) + (a.z + a.w);
    return __builtin_amdgcn_rsqf(s * (1.0f / D) + EPS);
}
__device__ __forceinline__ float sigmoidf_(float x) { return __builtin_amdgcn_rcpf(1.0f + __expf(-x)); }
__device__ __forceinline__ pg8::u32x2 pack4(const f32x4 v) { pg8::u32x2 w; w.x = pg8::cvt_pk_bf16(v[0], v[1]); w.y = pg8::cvt_pk_bf16(v[2], v[3]); return w; }

struct EpiSwiglu {
    static constexpr bool PERM = true;
    bf16_t* O; const float* ss;
    __device__ __forceinline__ void operator()(const f32x4 (&acc)[2][2][4][2], const Unit& u, int wr, int wc, int fr_, int fq_) const {
        const int l_ = lane_id_v(); const int fr = l_ & 15, fq = l_ >> 4; (void)fr_; (void)fq_;
        int rb = wr * 64 + fr, cb = wc * 32 + 8 * fq; LAUNDER2(rb, cb);
        const int row0 = u.pm * 256 + rb, col0 = u.pn * 128 + cb;
#pragma unroll
        for (int ai = 0; ai < 2; ++ai)
#pragma unroll
            for (int m = 0; m < 4; ++m) { const int row = row0 + ai * 128 + m * 16;
                const f32x4 sq = *(const f32x4*)(ss + (size_t)row * 4); const float k = ((sq.x + sq.y) + (sq.z + sq.w)) * (1.0f / D) + EPS; const float c1 = __builtin_amdgcn_rsqf(k) * -1.4426950408889634f;
                pg8::u32x4 w;
                { const f32x4 a = acc[ai][0][m][0], b = acc[ai][1][m][0]; f32x4 o;
#pragma unroll
                  for (int i = 0; i < 4; ++i) o[i] = (a[i] * b[i]) * __builtin_amdgcn_rcpf(fmaf(__builtin_amdgcn_exp2f(a[i] * c1), k, k));
                  w.x = pg8::cvt_pk_bf16(o[0], o[1]); w.y = pg8::cvt_pk_bf16(o[2], o[3]); }
                { const f32x4 a = acc[ai][0][m][1], b = acc[ai][1][m][1]; f32x4 o;
#pragma unroll
                  for (int i = 0; i < 4; ++i) o[i] = (a[i] * b[i]) * __builtin_amdgcn_rcpf(fmaf(__builtin_amdgcn_exp2f(a[i] * c1), k, k));
                  w.z = pg8::cvt_pk_bf16(o[0], o[1]); w.w = pg8::cvt_pk_bf16(o[2], o[3]); }
                *(pg8::u32x4*)(O + (size_t)row * DFF + col0) = w; }
    }
};
struct EpiResid {
    static constexpr bool PERM = true;
    const float* base; float* out; bf16_t* hb; float* ss; float alpha; LAS float* P; int dry;
    __device__ __forceinline__ void operator()(const f32x4 (&acc)[2][2][4][2], const Unit& u, int wr, int wc, int fr_, int fq_) const {
        const int l_ = lane_id_v(); const int fr = l_ & 15, fq = l_ >> 4; (void)fr_; (void)fq_;
        int rb = wr * 64 + fr, cb = wc * 32 + 8 * fq; LAUNDER2(rb, cb);
        const int row0 = u.pm * 256 + rb, col0 = u.pn * 256 + cb;
#pragma unroll
        for (int ai = 0; ai < 2; ++ai)
#pragma unroll
          for (int mh = 0; mh < 2; ++mh) {
            f32x4 bs[2][2][2];
#pragma unroll
            for (int mm = 0; mm < 2; ++mm) { const size_t off = (size_t)(row0 + ai * 128 + (2 * mh + mm) * 16) * D + col0;
#pragma unroll
                for (int bj = 0; bj < 2; ++bj)
#pragma unroll
                    for (int n = 0; n < 2; ++n) bs[mm][bj][n] = *(const f32x4*)(base + off + bj * 128 + n * 4); }
#pragma unroll
            for (int mm = 0; mm < 2; ++mm) { const int m = 2 * mh + mm; const int row = row0 + ai * 128 + m * 16; const size_t off = (size_t)row * D + col0; float q = 0.f;
#pragma unroll
                for (int bj = 0; bj < 2; ++bj) { const f32x4 v0 = bs[mm][bj][0] + acc[ai][bj][m][0] * alpha, v1 = bs[mm][bj][1] + acc[ai][bj][m][1] * alpha;
                    if (!dry) { *(f32x4*)(out + off + bj * 128) = v0; *(f32x4*)(out + off + bj * 128 + 4) = v1;
                        pg8::u32x4 w; w.x = pg8::cvt_pk_bf16(v0[0], v0[1]); w.y = pg8::cvt_pk_bf16(v0[2], v0[3]); w.z = pg8::cvt_pk_bf16(v1[0], v1[1]); w.w = pg8::cvt_pk_bf16(v1[2], v1[3]);
                        *(pg8::u32x4*)(hb + off + bj * 128) = w; }
                    q += ((v0[0] * v0[0] + v0[1] * v0[1]) + (v0[2] * v0[2] + v0[3] * v0[3])) + ((v1[0] * v1[0] + v1[1] * v1[1]) + (v1[2] * v1[2] + v1[3] * v1[3])); }
                q += __shfl_xor(q, 16); q += __shfl_xor(q, 32);
                if (fq == 0) P[(rb + ai * 128 + m * 16) * 4 + wc] = q; }
            asm volatile("" ::: "memory"); }
        asm volatile("s_waitcnt lgkmcnt(0)" ::: "memory"); __builtin_amdgcn_s_barrier(); asm volatile("" ::: "memory");
        const int tid = (wr * 4 + wc) * 64 + fq * 16 + fr;
        if (tid < 256 && !dry) { const f32x4 p = *(const LAS f32x4*)(P + tid * 4); ss[(size_t)(u.pm * 256 + tid) * 4 + u.pn] = (p.x + p.y) + (p.z + p.w); }
    }
};
struct EpiPlainBf16 {
    static constexpr bool PERM = false;
    bf16_t* O; int ldo;
    __device__ __forceinline__ void operator()(const f32x4 (&acc)[2][2][4][2], const Unit& u, int wr, int wc, int fr_, int fq_) const {
        const int l_ = lane_id_v(); const int fr = l_ & 15, fq = l_ >> 4; (void)fr_; (void)fq_;
        int rb = wr * 64 + fr, cb = wc * 32 + 4 * fq; LAUNDER2(rb, cb);
        const int row0 = u.pm * 256 + rb, col0 = u.pn * 256 + cb;
#pragma unroll
        for (int ai = 0; ai < 2; ++ai)
#pragma unroll
            for (int m = 0; m < 4; ++m) { bf16_t* rowp = O + (size_t)(row0 + ai * 128 + m * 16) * ldo + col0;
#pragma unroll
                for (int bj = 0; bj < 2; ++bj)
#pragma unroll
                    for (int n = 0; n < 2; ++n) *(pg8::u32x2*)(rowp + bj * 128 + n * 16) = pack4(acc[ai][bj][m][n]); }
    }
};
struct EpiInProj {
    static constexpr bool PERM = true;
    const float* ss; bf16_t* qa; float* ckvraw; bf16_t* ik; float* iw; bf16_t* iqraw; bf16_t* z; bf16_t* qc; bf16_t* G;
    __device__ __forceinline__ void operator()(const f32x4 (&acc)[2][2][4][2], const Unit& u, int wr, int wc, int fr_, int fq_) const {
        const int l_ = lane_id_v(); const int fr = l_ & 15, fq = l_ >> 4; (void)fr_; (void)fq_;
        int rb = wr * 64 + fr, ct = wc * 32 + 8 * fq; LAUNDER2(rb, ct);
        const int row0 = u.pm * 256 + rb; const int pn = u.pn;
        if (pn == 4) {
#pragma unroll
            for (int ai = 0; ai < 2; ++ai)
#pragma unroll
                for (int m = 0; m < 4; ++m) { const int row = row0 + ai * 128 + m * 16; const float s = row_scale(ss, row);
#pragma unroll
                    for (int n = 0; n < 2; ++n) *(f32x4*)(ckvraw + (size_t)row * KVR + ct + n * 4) = acc[ai][0][m][n] * s;
                    if (wc == 0) { const f32x4 k0 = acc[ai][1][m][0] * s, k1 = acc[ai][1][m][1] * s; pg8::u32x4 w; w.x = pkh2(k0[0], k0[1]); w.y = pkh2(k0[2], k0[3]); w.z = pkh2(k1[0], k1[1]); w.w = pkh2(k1[2], k1[3]);
                        *(pg8::u32x4*)(ik + (size_t)row * IDIM + 8 * fq) = w; }
                    if (wc == 1 && fq == 0) { *(f32x4*)(iw + (size_t)row * IH) = acc[ai][1][m][0] * s; *(f32x4*)(iw + (size_t)row * IH + 4) = acc[ai][1][m][1] * s; } }
        } else {
            bf16_t* dst0; int ld; bool sig = false; const bool f16out = (pn == 5);
            if (pn < 4) { dst0 = qa + pn * 256; ld = 1024; } else if (pn == 5) { dst0 = iqraw; ld = 256; } else if (pn == 6) { dst0 = z; ld = 256; } else if (pn == 7) { dst0 = qc; ld = 256; } else { dst0 = G + (pn - 8) * 256; ld = 3072; sig = true; }
#pragma unroll
            for (int ai = 0; ai < 2; ++ai)
#pragma unroll
                for (int m = 0; m < 4; ++m) { const int row = row0 + ai * 128 + m * 16; const float s = row_scale(ss, row); bf16_t* rowp = dst0 + (size_t)row * ld + ct;
#pragma unroll
                    for (int bj = 0; bj < 2; ++bj) { f32x4 o0, o1;
                        if (sig) { const float c1 = s * -1.4426950408889634f;
#pragma unroll
                            for (int i = 0; i < 4; ++i) { o0[i] = __builtin_amdgcn_rcpf(1.0f + __builtin_amdgcn_exp2f(acc[ai][bj][m][0][i] * c1)); o1[i] = __builtin_amdgcn_rcpf(1.0f + __builtin_amdgcn_exp2f(acc[ai][bj][m][1][i] * c1)); } }
                        else { o0 = acc[ai][bj][m][0] * s; o1 = acc[ai][bj][m][1] * s; }
                        pg8::u32x4 wo;
                        if (f16out) { wo.x = pkh2(o0[0], o0[1]); wo.y = pkh2(o0[2], o0[3]); wo.z = pkh2(o1[0], o1[1]); wo.w = pkh2(o1[2], o1[3]); }
                        else { wo.x = pg8::cvt_pk_bf16(o0[0], o0[1]); wo.y = pg8::cvt_pk_bf16(o0[2], o0[3]); wo.z = pg8::cvt_pk_bf16(o1[0], o1[1]); wo.w = pg8::cvt_pk_bf16(o1[2], o1[3]); }
                        *(pg8::u32x4*)(rowp + bj * 128) = wo; } }
        }
    }
};
template <int MODE> struct EpiMerge {
    static constexpr bool PERM = true;
    bf16_t* Mg; const bf16_t* G;
    __device__ __forceinline__ void operator()(const f32x4 (&acc)[2][2][4][2], const Unit& u, int wr, int wc, int fr_, int fq_) const {
        const int l_ = lane_id_v(); const int fr = l_ & 15, fq = l_ >> 4; (void)fr_; (void)fq_;
        int rb = wr * 64 + fr, cb = wc * 32 + 8 * fq; LAUNDER2(rb, cb);
        const int row0 = u.pm * 256 + rb, col0 = u.pn * 256 + cb;
#pragma unroll
        for (int ai = 0; ai < 2; ++ai)
#pragma unroll
          for (int mh = 0; mh < 1; ++mh) {
            pg8::u32x4 gw[4][2], pw[4][2];
#pragma unroll
            for (int mm = 0; mm < 4; ++mm) { const int row = row0 + ai * 128 + mm * 16;
#pragma unroll
                for (int bj = 0; bj < 2; ++bj) { gw[mm][bj] = *(const pg8::u32x4*)(G + (size_t)row * 3072 + MODE * 1024 + col0 + bj * 128);
                    if (MODE > 0) pw[mm][bj] = *(const pg8::u32x4*)(Mg + (size_t)row * D + col0 + bj * 128); } }
#pragma unroll
            for (int mm = 0; mm < 4; ++mm) { const int m = mm; const int row = row0 + ai * 128 + m * 16;
#pragma unroll
                for (int bj = 0; bj < 2; ++bj) { const pg8::u32x4 g4 = gw[mm][bj];
                    f32x4 o0 = acc[ai][bj][m][0], o1 = acc[ai][bj][m][1];
                    o0[0] *= bflo(g4.x); o0[1] *= bfhi(g4.x); o0[2] *= bflo(g4.y); o0[3] *= bfhi(g4.y); o1[0] *= bflo(g4.z); o1[1] *= bfhi(g4.z); o1[2] *= bflo(g4.w); o1[3] *= bfhi(g4.w);
                    if (MODE > 0) { const pg8::u32x4 p4 = pw[mm][bj];
                        o0[0] += bflo(p4.x); o0[1] += bfhi(p4.x); o0[2] += bflo(p4.y); o0[3] += bfhi(p4.y); o1[0] += bflo(p4.z); o1[1] += bfhi(p4.z); o1[2] += bflo(p4.w); o1[3] += bfhi(p4.w); }
                    pg8::u32x4 w; w.x = pg8::cvt_pk_bf16(o0[0], o0[1]); w.y = pg8::cvt_pk_bf16(o0[2], o0[3]); w.z = pg8::cvt_pk_bf16(o1[0], o1[1]); w.w = pg8::cvt_pk_bf16(o1[2], o1[3]);
                    *(pg8::u32x4*)(Mg + (size_t)row * D + col0 + bj * 128) = w; } }
            asm volatile("" ::: "memory"); }
    }
};

template <class Map>
__device__ __forceinline__ void transpose_item(const float* W, int K, int N, const float* gain, bf16* WT, LAS float* scr, int item, int lane, Map map) {
    const int nblk = (N + 63) / 64, kb = item / nblk, nb = item % nblk, k0 = 64 * kb, n0 = 64 * nb;
    const int nn = n0 + 4 * (lane & 15); const bool nok = nn < N;
#pragma unroll 4
    for (int i = 0; i < 16; ++i) { const int kk = 4 * i + (lane >> 4); f32x4 v = nok ? *(const f32x4*)(W + (size_t)(k0 + kk) * N + nn) : (f32x4){0.f, 0.f, 0.f, 0.f};
        if (gain) v = v * gain[k0 + kk];
        *(LAS f32x4*)(scr + kk * 68 + 4 * (lane & 15)) = v; }
    LDS_WAIT(); asm volatile("" ::: "memory");
    const int c = lane & 7;
#pragma unroll
    for (int j = 0; j < 8; ++j) { const int n = (lane >> 3) + 8 * j; const LAS float* sp = scr + (8 * c) * 68 + n;
        v4u o; o.x = pk2(sp[0 * 68], sp[1 * 68]); o.y = pk2(sp[2 * 68], sp[3 * 68]); o.z = pk2(sp[4 * 68], sp[5 * 68]); o.w = pk2(sp[6 * 68], sp[7 * 68]);
        if (n0 + n < N) { const int dr = map(n0 + n); if (dr >= 0) *(GAS v4u*)(WT + (size_t)dr * K + k0 + 8 * c) = o; } }
    LDS_WAIT(); asm volatile("" ::: "memory");
}
struct MapId { int off; __device__ __forceinline__ int operator()(int n) const { return off + n; } };
struct MapSwiglu { __device__ __forceinline__ int operator()(int c) const { const int half = c >= DFF ? 1 : 0, j = c - half * DFF; return 256 * (j >> 7) + 128 * half + (j & 127); } };
struct MapInProj { __device__ __forceinline__ int operator()(int c) const {
    if (c < C_CKV) return -1;
    if (c < C_IQ) return 1024 + (c - C_CKV);
    if (c < C_IK) return 1280 + (c - C_IQ);
    if (c < C_IW) return 1152 + (c - C_IK);
    if (c < C_Z) return 1184 + (c - C_IW);
    if (c < C_QC) return 1536 + (c - C_Z);
    if (c < C_G) return 1792 + (c - C_QC);
    return 2048 + (c - C_G); } };
__device__ __forceinline__ void qlat_item(const float* win, const float* mixn, const float* wuk, bf16* WT, int item, int lane) {
    const int kc = item & 127, rh = (item >> 7) & 1, h = item >> 8; const int r = rh * 64 + lane;
    const f32x4* wp = (const f32x4*)(wuk + (size_t)r * (AH * AHD) + h * 64);
    float acc[8] = {0.f, 0.f, 0.f, 0.f, 0.f, 0.f, 0.f, 0.f};
#pragma unroll 1
    for (int dc = 0; dc < 4; ++dc) {
        const f32x4 w0 = wp[4 * dc], w1 = wp[4 * dc + 1], w2 = wp[4 * dc + 2], w3 = wp[4 * dc + 3];
#pragma unroll
        for (int kk = 0; kk < 8; ++kk) { const f32x4* ip = (const f32x4*)(win + (size_t)(kc * 8 + kk) * INW + h * 64 + 16 * dc);
            const f32x4 a0 = ip[0], a1 = ip[1], a2 = ip[2], a3 = ip[3];
            acc[kk] += (a0.x * w0.x + a0.y * w0.y + a0.z * w0.z + a0.w * w0.w) + (a1.x * w1.x + a1.y * w1.y + a1.z * w1.z + a1.w * w1.w)
                     + (a2.x * w2.x + a2.y * w2.y + a2.z * w2.z + a2.w * w2.w) + (a3.x * w3.x + a3.y * w3.y + a3.z * w3.z + a3.w * w3.w);
            if (kk & 1) asm volatile("" ::: "memory"); }
    }
    const f32x4 g0 = *(const f32x4*)(mixn + kc * 8), g1 = *(const f32x4*)(mixn + kc * 8 + 4);
    v4u w; w.x = pk2(acc[0] * g0.x, acc[1] * g0.y); w.y = pk2(acc[2] * g0.z, acc[3] * g0.w); w.z = pk2(acc[4] * g1.x, acc[5] * g1.y); w.w = pk2(acc[6] * g1.z, acc[7] * g1.w);
    *(GAS v4u*)(WT + (size_t)(h * 128 + r) * D + kc * 8) = w;
}
__device__ __forceinline__ void wafold_item(const float* wuv, const float* wba, bf16* WT, int item, int lane) {
    const int ng = item & 15, rg = (item >> 4) & 15, h = item >> 8; const int n = ng * 64 + lane, r0 = rg * 8;
    float acc[8] = {0.f, 0.f, 0.f, 0.f, 0.f, 0.f, 0.f, 0.f};
#pragma unroll 4
    for (int d = 0; d < 64; ++d) { const float wa = wba[(size_t)(h * 64 + d) * D + n];
#pragma unroll
        for (int j = 0; j < 8; ++j) acc[j] += wuv[(size_t)(r0 + j) * (AH * AHD) + h * 64 + d] * wa; }
    v4u w; w.x = pk2(acc[0], acc[1]); w.y = pk2(acc[2], acc[3]); w.z = pk2(acc[4], acc[5]); w.w = pk2(acc[6], acc[7]);
    *(GAS v4u*)(WT + (size_t)n * 1024 + h * 128 + r0) = w;
}
__device__ __forceinline__ int items_of(int K, int N) { return (K / 64) * ((N + 63) / 64); }

__device__ __forceinline__ void prep_layer_weights_body(const PC& F, int l) {
    struct { const float* const* in; } a{F.in};
    const int lane_ = lane_id_v();
    LAS float* scr = (LAS float*)(F.lds + RING_OFF + F.wave * 17408);
    const int gw = F.vcu * NWAVES + F.wave, NGW = F.G * NWAVES;
    const float* f1n = a.in[3] + (size_t)l * D; const float* f1in = a.in[4] + (size_t)l * D * 2 * DFF; const float* f1out = a.in[5] + (size_t)l * DFF * D;
    const float* mixn = a.in[6] + (size_t)l * D; const float* win = a.in[7] + (size_t)l * D * INW;
    const float* wba = a.in[15] + (size_t)l * AW * D; const float* wbb = a.in[16] + (size_t)l * PW_ * D; const float* wbc = a.in[17] + (size_t)l * CW * D;
    const float* wout = a.in[18] + (size_t)l * D * D;
    const float* f2n = a.in[19] + (size_t)l * D; const float* f2in = a.in[20] + (size_t)l * D * 2 * DFF; const float* f2out = a.in[21] + (size_t)l * DFF * D;
    unsigned char* ws = launder_p(F.ws);
    const float* wuk = a.in[9] + (size_t)l * KVR * AH * AHD; const float* wuv = a.in[10] + (size_t)l * KVR * AH * AHD;
    const int I0 = items_of(D, 2 * DFF), I1 = items_of(DFF, D), I2 = items_of(D, INW), I4 = items_of(PW_, D), I5 = items_of(CW, D), I6 = items_of(D, D);
    const int NIT = 2 * I0 + 2 * I1 + I2 + I4 + I5 + I6;
#pragma unroll 1
    for (int it = gw; it < NIT; it += NGW) {
        int r = it;
        if (r < I0) { transpose_item(f1in, D, 2 * DFF, f1n, (bf16*)(ws + WS_W1IN), scr, r, lane_, MapSwiglu{}); continue; } r -= I0;
        if (r < I0) { transpose_item(f2in, D, 2 * DFF, f2n, (bf16*)(ws + WS_W2IN), scr, r, lane_, MapSwiglu{}); continue; } r -= I0;
        if (r < I1) { transpose_item(f1out, DFF, D, nullptr, (bf16*)(ws + WS_W1OUT), scr, r, lane_, MapId{0}); continue; } r -= I1;
        if (r < I1) { transpose_item(f2out, DFF, D, nullptr, (bf16*)(ws + WS_W2OUT), scr, r, lane_, MapId{0}); continue; } r -= I1;
        if (r < I2) { transpose_item(win, D, INW, mixn, (bf16*)(ws + WS_WIN), scr, r, lane_, MapInProj{}); continue; } r -= I2;
        if (r < I4) { transpose_item(wbb, PW_, D, nullptr, (bf16*)(ws + WS_WB), scr, r, lane_, MapId{0}); continue; } r -= I4;
        if (r < I5) { transpose_item(wbc, CW, D, nullptr, (bf16*)(ws + WS_WC), scr, r, lane_, MapId{0}); continue; } r -= I5;
        transpose_item(wout, D, D, nullptr, (bf16*)(ws + WS_WOUT), scr, r, lane_, MapId{0});
    }
    { const float* wpool = a.in[11] + (size_t)l * 4 * 64 * 64; bf16* wpT = (bf16*)(ws + WS_WPT);
      for (int i = gw * 64 + lane_; i < 4 * 64 * 64; i += NGW * 64) { const int c = i & 63, d = (i >> 6) & 63, g = i >> 12; wpT[i] = (bf16)f2bf(wpool[(g * 64 + c) * 64 + d]); } }
    asm volatile("" ::: "memory");
#pragma unroll 1
    for (int it = gw; it < 2048; it += NGW) wafold_item(wuv, wba, (bf16*)(ws + WS_WA), it, lane_);
    asm volatile("" ::: "memory");
#pragma unroll 1
    for (int it = gw; it < 2048; it += NGW) qlat_item(win, mixn, wuk, (bf16*)(ws + WS_WIN), it, lane_);
}

__device__ __noinline__ void p0_prologue(const float* const* in_, float* out_, unsigned char* ws_, LAS unsigned char* lds_, int wave_, int vcu_, int G_) {
    const PC F{uni(in_), uni(out_), uni(ws_), uni_l(lds_), uni_i(wave_), uni_i(vcu_), uni_i(G_)}; struct { const float* const* in; } a{F.in};
    const int lane_ = lane_id_v();
    const int gw = F.vcu * NWAVES + F.wave, NGW = F.G * NWAVES;
    const float* x = a.in[0]; const float* mem = a.in[1];
    bf16* hb = (bf16*)(F.ws + WS_HB); float* ss = (float*)(F.ws + WS_SS); bf16* memn = (bf16*)(F.ws + WS_MEMN);
    for (int m = gw; m < M + MROWS; m += NGW) {
        const bool ismem = m >= M; const int r = ismem ? m - M : m;
        const GAS f32x4* xr = (const GAS f32x4*)((ismem ? mem : x) + (size_t)r * D) + lane_;
        f32x4 v[4]; float s = 0.f;
#pragma unroll
        for (int j = 0; j < 4; ++j) { v[j] = xr[64 * j]; s += (v[j].x * v[j].x + v[j].y * v[j].y) + (v[j].z * v[j].z + v[j].w * v[j].w); }
        s = wave_sum(s);
        float sc = 1.f;
        if (ismem) sc = 1.0f / sqrtf(s * (1.0f / D) + EPS);
        else if (lane_ < 4) ss[(size_t)r * 4 + lane_] = lane_ == 0 ? s : 0.f;
        GAS unsigned long long* o8 = (GAS unsigned long long*)((ismem ? memn : hb) + (size_t)r * D) + lane_;
#pragma unroll
        for (int j = 0; j < 4; ++j) o8[64 * j] = (unsigned long long)pk2(v[j].x * sc, v[j].y * sc) | ((unsigned long long)pk2(v[j].z * sc, v[j].w * sc) << 32);
    }
    LAS float* scr = (LAS float*)(F.lds + RING_OFF + F.wave * 17408);
    const int IM = items_of(D, 2 * CW);
    for (int it = gw; it < DEPTH * IM; it += NGW) { const int l = it / IM, r = it % IM;
        transpose_item(a.in[14] + (size_t)l * D * 2 * CW, D, 2 * CW, a.in[13] + (size_t)l * D, (bf16*)(F.ws + WS_WMEM), scr, r, lane_, MapId{l * 2 * CW}); }
    prep_layer_weights_body(F, 0);
}
__device__ __noinline__ void prep_layer_weights(const float* const* in_, float* out_, unsigned char* ws_, LAS unsigned char* lds_, int l, int wave_, int vcu_, int G_) {
    const PC F{uni(in_), uni(out_), uni(ws_), uni_l(lds_), uni_i(wave_), uni_i(vcu_), uni_i(G_)}; prep_layer_weights_body(F, uni_i(l));
}

__constant__ unsigned char T5_BUCKET[128] = {0, 1, 2, 3, 4, 5, 6, 7, 8, 9, 10, 11, 12, 13, 14, 15, 16, 16, 16, 17, 17, 18, 18, 18, 19, 19, 19, 20, 20, 20, 20, 21, 21, 21, 21, 22, 22, 22, 22, 22, 23, 23, 23, 23, 23, 23, 24, 24, 24, 24, 24, 24, 25, 25, 25, 25, 25, 25, 25, 26, 26, 26, 26, 26, 26, 26, 26, 27, 27, 27, 27, 27, 27, 27, 27, 27, 27, 28, 28, 28, 28, 28, 28, 28, 28, 28, 28, 29, 29, 29, 29, 29, 29, 29, 29, 29, 29, 29, 29, 30, 30, 30, 30, 30, 30, 30, 30, 30, 30, 30, 30, 30, 30, 31, 31, 31, 31, 31, 31, 31, 31, 31, 31, 31, 31, 31, 31, 31};

typedef short bf16x8_p __attribute__((ext_vector_type(8)));
__device__ __forceinline__ void prep_tokens(const float* const* in_, float* out_, unsigned char* ws_, LAS unsigned char* lds_, int l_, int wave_, int vcu_, int G_, int dry_) {
    const int dry = uni_i(dry_);
    const PC F{uni(in_), uni(out_), uni(ws_), uni_l(lds_), uni_i(wave_), uni_i(vcu_), uni_i(G_)}; struct { const float* const* in; } a{F.in}; const int l = uni_i(l_);
    unsigned char* ws = launder_p(F.ws);
    const float* ckvraw = (const float*)(ws + WS_CKVRAW); bf16* ckv = (bf16*)(ws + WS_CKV);
    const bf16* iqraw = (const bf16*)(ws + WS_IQRAW); bf16* iqf = (bf16*)(ws + WS_IQF); const float* iw = (const float*)(ws + WS_IW); unsigned* sgn = (unsigned*)(ws + WS_SGN);
    const bf16* z = (const bf16*)(ws + WS_Z); bf16* yb = (bf16*)(ws + WS_YB); bf16* qc = (bf16*)(ws + WS_QC);
    const bf16* memkv = (const bf16*)(ws + WS_MEMKV); const bf16* vT = (const bf16*)(ws + WS_VT); const bf16* wpT = (const bf16*)(ws + WS_WPT);
    const float* kvn = a.in[8] + (size_t)l * KVR; const float* pscale = a.in[12] + (size_t)l * PW_;
    const int lane = lane_id_v(), tid = F.wave * 64 + lane;
    const int tok = lane & 15, g4 = lane >> 4;
    LAS unsigned char* Ks = F.lds;
    LAS unsigned char* Vs = F.lds + 36864;
    for (int blk = F.vcu; blk < M / 128; blk += F.G) {
        const int rowb = blk * 128, b = rowb / SEQ, row0 = rowb + F.wave * 16;
#pragma unroll 1
        for (int tt = 0; tt < 16; ++tt) { const int row = row0 + tt;
            { const f32x2 v = *(const f32x2*)(ckvraw + (size_t)row * KVR + 2 * lane); const float q = wave_sum(v.x * v.x + v.y * v.y);
              const float rs = 1.0f / sqrtf(q * (1.0f / KVR) + EPS); const f32x2 g = *(const f32x2*)(kvn + 2 * lane);
              *(unsigned*)(ckv + (size_t)row * KVR + 2 * lane) = pk2(v.x * rs * g.x, v.y * rs * g.y); }
            { const float wv = iw[(size_t)row * IH + (lane >> 3)]; const float aw = fabsf(wv) * (1.0f / 16.0f);
              const v2u q = *(const v2u*)(iqraw + (size_t)row * 256 + 4 * lane);
              v2u o; o.x = pkh2(hlo(q.x) * aw, hhi(q.x) * aw); o.y = pkh2(hlo(q.y) * aw, hhi(q.y) * aw);
              *(v2u*)(iqf + (size_t)row * 256 + 4 * lane) = o;
              const unsigned long long bal = __ballot(wv < 0.f);
              unsigned mask = 0;
#pragma unroll
              for (int h = 0; h < 8; ++h) mask |= ((unsigned)(bal >> (8 * h)) & 1u) << h;
              if (lane == 0) sgn[row] = mask; } }
        { const int row = row0 + tok, spos = row % SEQ;
#pragma unroll 1
          for (int g = 0; g < 4; ++g) { const int w = 2 << g; const int cnt = (spos + 1) < w ? (spos + 1) : w; const float rc = 1.0f / (float)cnt;
              bf16x8_p pf[2];
#pragma unroll
              for (int ks = 0; ks < 2; ++ks) { const int c0 = g * 64 + 32 * ks + 8 * g4; float sum[8], z0[8];
#pragma unroll
                  for (int e = 0; e < 8; ++e) { sum[e] = 0.f; z0[e] = 0.f; }
                  for (int j = 0; j < w; ++j) { if (j < cnt) { const v4u v = *(const v4u*)(z + (size_t)(row - j) * 256 + c0);
                      const float f[8] = {bflo(v.x), bfhi(v.x), bflo(v.y), bfhi(v.y), bflo(v.z), bfhi(v.z), bflo(v.w), bfhi(v.w)};
#pragma unroll
                      for (int e = 0; e < 8; ++e) { sum[e] += f[e]; if (j == 0) z0[e] = f[e]; } } }
                  v4u pw; pw.x = pk2(sum[0] * rc - z0[0], sum[1] * rc - z0[1]); pw.y = pk2(sum[2] * rc - z0[2], sum[3] * rc - z0[3]); pw.z = pk2(sum[4] * rc - z0[4], sum[5] * rc - z0[5]); pw.w = pk2(sum[6] * rc - z0[6], sum[7] * rc - z0[7]);
                  pf[ks] = __builtin_bit_cast(bf16x8_p, pw); }
#pragma unroll
              for (int dt = 0; dt < 4; ++dt) { f32x4 acc = {0.f, 0.f, 0.f, 0.f};
#pragma unroll
                  for (int ks = 0; ks < 2; ++ks) { const bf16x8_p af = *(const bf16x8_p*)(wpT + (size_t)(g * 64 + 16 * dt + tok) * 64 + 32 * ks + 8 * g4); acc = __builtin_amdgcn_mfma_f32_16x16x32_bf16(af, pf[ks], acc, 0, 0, 0); }
                  const f32x4 ps = *(const f32x4*)(pscale + g * 64 + 16 * dt + 4 * g4);
                  v2u o; o.x = pk2(acc[0] * ps.x, acc[1] * ps.y); o.y = pk2(acc[2] * ps.z, acc[3] * ps.w);
                  *(v2u*)(yb + (size_t)row * 256 + g * 64 + 16 * dt + 4 * g4) = o; } } }
#pragma unroll 1
        for (int h = 0; h < CH; ++h) {
            __syncthreads();
#pragma unroll
            for (int e = 0; e < 4; ++e) { const int i = tid + 512 * e;
                { const int m = i >> 3, c = i & 7; const v4u v = *(const v4u*)(memkv + (size_t)(b * NMEM + m) * 2048 + l * 512 + h * 64 + c * 8); *(LAS v4u*)(Ks + m * 144 + c * 16) = v; }
                { const int d = i >> 5, c = i & 31; const v4u v = *(const v4u*)(vT + (size_t)(l * 512 + 256 + h * 64 + d) * MROWS + b * NMEM + c * 8); *(LAS v4u*)(Vs + d * 528 + c * 16) = v; } }
            LDS_WAIT(); __syncthreads();
            const int row = row0 + tok;
            bf16x8_p qf[2];
#pragma unroll
            for (int ks = 0; ks < 2; ++ks) qf[ks] = *(const bf16x8_p*)(qc + (size_t)row * 256 + h * 64 + 32 * ks + 8 * g4);
            f32x4 S[16]; float mx = -1e30f;
#pragma unroll
            for (int mt = 0; mt < 16; ++mt) { f32x4 acc = {0.f, 0.f, 0.f, 0.f};
#pragma unroll
                for (int ks = 0; ks < 2; ++ks) { const bf16x8_p kf = *(const LAS bf16x8_p*)(Ks + (16 * mt + tok) * 144 + (4 * ks + g4) * 16); acc = __builtin_amdgcn_mfma_f32_16x16x32_bf16(kf, qf[ks], acc, 0, 0, 0); }
                S[mt] = acc; mx = fmaxf(mx, fmaxf(fmaxf(acc[0], acc[1]), fmaxf(acc[2], acc[3]))); if ((mt & 3) == 3) __builtin_amdgcn_sched_barrier(0); }
            mx = fmaxf(mx, __shfl_xor(mx, 16)); mx = fmaxf(mx, __shfl_xor(mx, 32));
            float sm = 0.f;
#pragma unroll
            for (int mt = 0; mt < 16; ++mt)
#pragma unroll
                for (int r = 0; r < 4; ++r) { const float p = __expf((S[mt][r] - mx) * 0.125f); S[mt][r] = p; sm += p; }
            sm += __shfl_xor(sm, 16); sm += __shfl_xor(sm, 32);
            const float inv = 1.0f / sm;
            f32x4 oacc[4];
#pragma unroll
            for (int dt = 0; dt < 4; ++dt) oacc[dt] = (f32x4){0.f, 0.f, 0.f, 0.f};
#pragma unroll
            for (int kk = 0; kk < 8; ++kk) { v4u pw; pw.x = pg8::cvt_pk_bf16(S[2 * kk][0], S[2 * kk][1]); pw.y = pg8::cvt_pk_bf16(S[2 * kk][2], S[2 * kk][3]); pw.z = pg8::cvt_pk_bf16(S[2 * kk + 1][0], S[2 * kk + 1][1]); pw.w = pg8::cvt_pk_bf16(S[2 * kk + 1][2], S[2 * kk + 1][3]);
                const bf16x8_p pfr = __builtin_bit_cast(bf16x8_p, pw);
#pragma unroll
                for (int dt = 0; dt < 4; ++dt) { const LAS unsigned char* vp = Vs + (16 * dt + tok) * 528 + (32 * kk + 4 * g4) * 2;
                    const v2u lo = *(const LAS v2u*)vp, hi = *(const LAS v2u*)(vp + 32);
                    v4u vw; vw.x = lo.x; vw.y = lo.y; vw.z = hi.x; vw.w = hi.y;
                    oacc[dt] = __builtin_amdgcn_mfma_f32_16x16x32_bf16(__builtin_bit_cast(bf16x8_p, vw), pfr, oacc[dt], 0, 0, 0); }
                __builtin_amdgcn_sched_barrier(0); }
#pragma unroll
            for (int dt = 0; dt < 4; ++dt) { v2u o; o.x = pk2(oacc[dt][0] * inv, oacc[dt][1] * inv); o.y = pk2(oacc[dt][2] * inv, oacc[dt][3] * inv);
                if (!dry) *(v2u*)(qc + (size_t)row * 256 + h * 64 + 16 * dt + 4 * g4) = o; else asm volatile("" :: "v"(o.x), "v"(o.y)); }
        }
    }
    __syncthreads();
}

__device__ __forceinline__ unsigned key_of(float s) { const unsigned u = __builtin_bit_cast(unsigned, s); return (u & 0x80000000u) ? ~u : (u | 0x80000000u); }

typedef short bf16x8_t __attribute__((ext_vector_type(8)));
typedef short s16x4_t __attribute__((ext_vector_type(4)));
__device__ __forceinline__ void glds16(const void* gsrc, unsigned lds_dst) { unsigned keep;
    asm volatile("s_mov_b32 %0, m0\n\ts_mov_b32 m0, %2\n\ts_nop 0\n\tglobal_load_lds_dwordx4 %1, off\n\ts_mov_b32 m0, %0" : "=&s"(keep) : "v"(gsrc), "s"(lds_dst) : "memory"); }
typedef float f32x16 __attribute__((ext_vector_type(16)));
constexpr int SEL_CAP = 256;
constexpr int HSTR = 264;
constexpr int SL_HIST = 0, SL_SEL = 0, SL_CS = 32768, SL_CI = 98304, SL_KEYS = 131072, SL_ST = 147456;

#define SEL_DECLS \
    LAS unsigned char* const lds = uni_l(lds_); const int wave = uni_i(wave_), b = uni_i(b_), ub = uni_i(ub_); unsigned char* ws = uni(ws_); \
    const bf16* iqf = (const bf16*)(ws + WS_IQF); const unsigned* sgn = (const unsigned*)(ws + WS_SGN); const bf16* ik = (const bf16*)(ws + WS_IK); \
    const int lane = lane_id_v(), tid = wave * 64 + lane; const int kl = lane & 31, c5 = lane >> 5; \
    LAS unsigned* hist = (LAS unsigned*)(lds + SL_HIST); LAS unsigned short* lsel = (LAS unsigned short*)(lds + SL_SEL); LAS float* lcs = (LAS float*)(lds + SL_CS); \
    LAS unsigned short* lci = (LAS unsigned short*)(lds + SL_CI); LAS unsigned* st = (LAS unsigned*)(lds + SL_ST); LAS float* stf = (LAS float*)(lds + SL_ST); \
    const int t0 = ub * 64; const int q0 = b * SEQ + t0; const bf16* ikb = ik + (size_t)b * SEQ * IDIM; const int ntile = (t0 + 64 + 127) >> 7; \
    (void)hist; (void)lsel; (void)lcs; (void)lci; (void)stf; (void)tid;
#define SEL_LOAD_A \
    bf16x8_t af[2][2]; float sgc[2][16]; \
    { const int i = kl, a_ = i >> 3, cc_ = (i >> 2) & 1, e_ = i & 3; const int qq_ = 2 * cc_ + (a_ >> 1), hh_ = 4 * (a_ & 1) + e_; \
      _Pragma("unroll") for (int rt = 0; rt < 2; ++rt) { const unsigned flip_ = ((sgn[q0 + 8 * wave + 4 * rt + qq_] >> hh_) & 1u) ? 0x80008000u : 0u;     \
          _Pragma("unroll") for (int ks = 0; ks < 2; ++ks) { v4u w_ = *(const v4u*)(iqf + (size_t)(q0 + 8 * wave + 4 * rt + qq_) * 256 + hh_ * 32 + 16 * ks + 8 * c5); \
              w_.x ^= flip_; w_.y ^= flip_; w_.z ^= flip_; w_.w ^= flip_; af[rt][ks] = __builtin_bit_cast(bf16x8_t, w_); } } \
      _Pragma("unroll") for (int rt = 0; rt < 2; ++rt) _Pragma("unroll") for (int u = 0; u < 2; ++u) { const unsigned m_ = sgn[q0 + 8 * wave + 4 * rt + 2 * c5 + u]; \
          _Pragma("unroll") for (int h = 0; h < 8; ++h) sgc[rt][8 * u + h] = ((m_ >> h) & 1u) ? -__builtin_inff() : __builtin_inff(); } }
#define SEL_STAGE(kt_) do { const int key_ = 16 * wave + (lane >> 2); const int ch_ = (lane & 3) ^ ((key_ >> 2) & 3); \
    glds16(ikb + (size_t)(128 * (kt_) + key_) * IDIM + ch_ * 8, (unsigned)__builtin_amdgcn_readfirstlane((int)(unsigned)(size_t)(lds + SL_KEYS + ((kt_) & 1) * 8192 + wave * 1024))); } while (0)
#define SEL_MMA(acc_, rt_, kh_) do { acc_ = (f32x16){0.f,0.f,0.f,0.f,0.f,0.f,0.f,0.f,0.f,0.f,0.f,0.f,0.f,0.f,0.f,0.f}; \
    acc_ = __builtin_amdgcn_mfma_f32_32x32x16_f16(__builtin_bit_cast(f16x8_t, af[rt_][0]), __builtin_bit_cast(f16x8_t, bfr_[kh_][0]), acc_, 0, 0, 0); \
    acc_ = __builtin_amdgcn_mfma_f32_32x32x16_f16(__builtin_bit_cast(f16x8_t, af[rt_][1]), __builtin_bit_cast(f16x8_t, bfr_[kh_][1]), acc_, 0, 0, 0); } while (0)
#define SEL_SUM(acc_, rt_, kh_) do { _Pragma("unroll") for (int u = 0; u < 2; ++u) { float s_ = 0.f; \
    _Pragma("unroll") for (int h = 0; h < 8; ++h) s_ += __builtin_amdgcn_fmed3f(acc_[8 * u + h], 0.f, sgc[rt_][8 * u + h]); \
    sc[rt_][kh_][u] = s_; } } while (0)
#define SEL_SCORES(kt_) do { const LAS unsigned char* kb_ = lds + SL_KEYS + ((kt_) & 1) * 8192; bf16x8_t bfr_[4][2]; \
    _Pragma("unroll") for (int kh = 0; kh < 4; ++kh) { const int key_ = 32 * kh + kl; \
        bfr_[kh][0] = *(const LAS bf16x8_t*)(kb_ + key_ * 64 + 16 * ((0 + c5) ^ ((key_ >> 2) & 3))); \
        bfr_[kh][1] = *(const LAS bf16x8_t*)(kb_ + key_ * 64 + 16 * ((2 + c5) ^ ((key_ >> 2) & 3))); } \
    f32x16 accA_, accB_; \
    SEL_MMA(accA_, 0, 0); \
    SEL_MMA(accB_, 1, 0); __builtin_amdgcn_sched_barrier(0); SEL_SUM(accA_, 0, 0); __builtin_amdgcn_sched_barrier(0); \
    SEL_MMA(accA_, 0, 1); __builtin_amdgcn_sched_barrier(0); SEL_SUM(accB_, 1, 0); __builtin_amdgcn_sched_barrier(0); \
    SEL_MMA(accB_, 1, 1); __builtin_amdgcn_sched_barrier(0); SEL_SUM(accA_, 0, 1); __builtin_amdgcn_sched_barrier(0); \
    SEL_MMA(accA_, 0, 2); __builtin_amdgcn_sched_barrier(0); SEL_SUM(accB_, 1, 1); __builtin_amdgcn_sched_barrier(0); \
    SEL_MMA(accB_, 1, 2); __builtin_amdgcn_sched_barrier(0); SEL_SUM(accA_, 0, 2); __builtin_amdgcn_sched_barrier(0); \
    SEL_MMA(accA_, 0, 3); __builtin_amdgcn_sched_barrier(0); SEL_SUM(accB_, 1, 2); __builtin_amdgcn_sched_barrier(0); \
    SEL_MMA(accB_, 1, 3); __builtin_amdgcn_sched_barrier(0); SEL_SUM(accA_, 0, 3); __builtin_amdgcn_sched_barrier(0); \
    SEL_SUM(accB_, 1, 3); } while (0)
#define SEL_BOUNDARY(FINAL) do { \
    const int qq = tid >> 3, part = tid & 7; const LAS v4u* hp = (const LAS v4u*)(hist + qq * HSTR + 32 * part); \
    unsigned bins[32]; \
    _Pragma("unroll") for (int i = 0; i < 8; ++i) { const v4u v = hp[i]; bins[4 * i] = v.x; bins[4 * i + 1] = v.y; bins[4 * i + 2] = v.z; bins[4 * i + 3] = v.w; } \
    unsigned ps = 0; \
    _Pragma("unroll") for (int i = 0; i < 32; ++i) ps += bins[i]; \
    unsigned v = ps, tt; \
    tt = __shfl_down(v, 1, 8); if (part + 1 < 8) v += tt; \
    tt = __shfl_down(v, 2, 8); if (part + 2 < 8) v += tt; \
    tt = __shfl_down(v, 4, 8); if (part + 4 < 8) v += tt; \
    unsigned cacc = v - ps; \
    if (cacc < (unsigned)TOPK && v >= (unsigned)TOPK) { int bsel = 0; unsigned na = 0, cb = 0; bool found = false; \
        _Pragma("unroll") for (int i = 31; i >= 0; --i) { const bool hit = !found && (cacc + bins[i] >= (unsigned)TOPK); if (hit) { bsel = i; na = cacc; cb = bins[i]; found = true; } cacc += bins[i]; } \
        st[128 + qq] = (unsigned)(32 * part + bsel); if (FINAL) { st[192 + qq] = na; st[256 + qq] = cb; st[448 + qq] = cb > (unsigned)SEL_CAP ? 1u : 0u; } } } while (0)

__device__ __forceinline__ void sel_pass1(unsigned char* ws_, LAS unsigned char* lds_, int wave_, int b_, int ub_) {
    SEL_DECLS
    unsigned short* sel = (unsigned short*)(ws + WS_SEL);
    __syncthreads();
    if (ub < 4) {
        for (int i = tid; i < 64 * TOPK; i += NWAVES * 64) { const int qq = i >> 8, sl = i & 255; sel[(size_t)(q0 + qq) * TOPK + sl] = (unsigned short)(sl <= t0 + qq ? sl : 0); }
        if (tid == 0) st[512] = 1u;
        asm volatile("s_waitcnt vmcnt(0) lgkmcnt(0)" ::: "memory"); __syncthreads();
        return;
    }
    SEL_LOAD_A
    for (int i = tid; i < 64 * HSTR; i += NWAVES * 64) hist[i] = 0u;
    if (tid < 64) { st[128 + tid] = 0u; st[448 + tid] = 0u; }
    if (tid == 0) st[512] = 0u;
    float sc[2][4][2];
    float scl[2][2]; int bcur[2][2];
#pragma unroll
    for (int rt = 0; rt < 2; ++rt)
#pragma unroll
        for (int u = 0; u < 2; ++u) { scl[rt][u] = 0.f; bcur[rt][u] = 0; }
    SEL_STAGE(0);
#pragma unroll 1
    for (int kt = 0; kt < ntile; ++kt) {
        asm volatile("s_waitcnt vmcnt(0) lgkmcnt(0)" ::: "memory"); __syncthreads();
        if (kt > 0 && (kt & 3) == 0) {
            SEL_BOUNDARY(false);
            asm volatile("s_waitcnt lgkmcnt(0)" ::: "memory"); __syncthreads();
#pragma unroll
            for (int rt = 0; rt < 2; ++rt)
#pragma unroll
                for (int u = 0; u < 2; ++u) bcur[rt][u] = (int)st[128 + 8 * wave + 4 * rt + 2 * c5 + u];
        }
        if (kt + 1 < ntile) SEL_STAGE(kt + 1);
        SEL_SCORES(kt);
        if (kt == 0) {
#pragma unroll
            for (int rt = 0; rt < 2; ++rt)
#pragma unroll
                for (int u = 0; u < 2; ++u) { float mx = 0.f;
#pragma unroll
                    for (int kh = 0; kh < 4; ++kh) mx = fmaxf(mx, fabsf(sc[rt][kh][u]));
#pragma unroll
                    for (int o = 1; o < 32; o <<= 1) mx = fmaxf(mx, __shfl_xor(mx, o));
                    const float R = mx > 0.f ? mx : 1.0f;
                    scl[rt][u] = 128.0f / R;
                    if (kl == 0) stf[8 * wave + 4 * rt + 2 * c5 + u] = scl[rt][u]; }
        }
        const bool masked = 128 * kt + 127 > t0;
#pragma unroll
        for (int rt = 0; rt < 2; ++rt)
#pragma unroll
            for (int u = 0; u < 2; ++u) { const int qq = 8 * wave + 4 * rt + 2 * c5 + u; const int lim = masked ? (t0 + qq - 128 * kt - kl) : 1000;
#pragma unroll
                for (int kh = 0; kh < 4; ++kh) { const float fb = __builtin_amdgcn_fmed3f(fmaf(sc[rt][kh][u], scl[rt][u], 128.0f), 0.f, 255.f);
                    if (fb >= (float)bcur[rt][u] && 32 * kh <= lim) (void)__hip_atomic_fetch_add(hist + qq * HSTR + (int)fb, 1u, __ATOMIC_RELAXED, __HIP_MEMORY_SCOPE_WORKGROUP); } }
    }
    asm volatile("s_waitcnt vmcnt(0) lgkmcnt(0)" ::: "memory"); __syncthreads();
    SEL_BOUNDARY(true);
    if (tid < 64) { st[320 + tid] = 0u; st[384 + tid] = 0u; }
    asm volatile("s_waitcnt lgkmcnt(0)" ::: "memory"); __syncthreads();
}
__device__ __forceinline__ void sel_pass2(unsigned char* ws_, LAS unsigned char* lds_, int wave_, int b_, int ub_) {
    SEL_DECLS
    if (st[512] != 0u) return;
    if (tid < 64) { st[320 + tid] = 0u; st[384 + tid] = 0u; }
    SEL_LOAD_A
    float sc[2][4][2];
    float scl[2][2]; int bcur[2][2];
#pragma unroll
    for (int rt = 0; rt < 2; ++rt)
#pragma unroll
        for (int u = 0; u < 2; ++u) { const int qq = 8 * wave + 4 * rt + 2 * c5 + u; scl[rt][u] = stf[qq]; bcur[rt][u] = (int)st[128 + qq]; }
    SEL_STAGE(0);
#pragma unroll 1
    for (int kt = 0; kt < ntile; ++kt) {
        asm volatile("s_waitcnt vmcnt(0) lgkmcnt(0)" ::: "memory"); __syncthreads();
        if (kt + 1 < ntile) SEL_STAGE(kt + 1);
        SEL_SCORES(kt);
        const bool masked = 128 * kt + 127 > t0;
        unsigned okm = 0u, abm = 0u; unsigned basea[2][2], basec[2][2];
#pragma unroll
        for (int rt = 0; rt < 2; ++rt)
#pragma unroll
            for (int u = 0; u < 2; ++u) { const int qq = 8 * wave + 4 * rt + 2 * c5 + u; const int lim = masked ? (t0 + qq - 128 * kt - kl) : 1000; unsigned na_ = 0u, nc_ = 0u;
#pragma unroll
                for (int kh = 0; kh < 4; ++kh) { const float fb = __builtin_amdgcn_fmed3f(fmaf(sc[rt][kh][u], scl[rt][u], 128.0f), 0.f, 255.f);
                    const bool ok = fb >= (float)bcur[rt][u] && 32 * kh <= lim; const bool ab = ok && fb >= (float)(bcur[rt][u] + 1);
                    const unsigned okb = ok ? 1u : 0u, abb = ab ? 1u : 0u;
                    okm |= okb << (rt * 8 + u * 4 + kh); abm |= abb << (rt * 8 + u * 4 + kh); na_ += abb; nc_ += okb - abb; }
                basea[rt][u] = 0u; basec[rt][u] = 0u;
                if (na_) basea[rt][u] = __hip_atomic_fetch_add(st + 320 + qq, na_, __ATOMIC_RELAXED, __HIP_MEMORY_SCOPE_WORKGROUP);
                if (nc_) basec[rt][u] = __hip_atomic_fetch_add(st + 384 + qq, nc_, __ATOMIC_RELAXED, __HIP_MEMORY_SCOPE_WORKGROUP); }
        if (okm != 0u) {
#pragma unroll
            for (int rt = 0; rt < 2; ++rt)
#pragma unroll
                for (int u = 0; u < 2; ++u) { const int qq = 8 * wave + 4 * rt + 2 * c5 + u; unsigned sa = basea[rt][u], scn = basec[rt][u];
#pragma unroll
                    for (int kh = 0; kh < 4; ++kh) { const int bit = rt * 8 + u * 4 + kh; const int kpos = 128 * kt + 32 * kh + kl;
                        const unsigned pa = (abm >> bit) & 1u, pc = ((okm & ~abm) >> bit) & 1u;
                        if (pa) lsel[qq * 256 + (sa < (unsigned)(TOPK - 1) ? sa : (unsigned)(TOPK - 1))] = (unsigned short)kpos;
                        if (pc) { const unsigned sl = scn < (unsigned)(SEL_CAP - 1) ? scn : (unsigned)(SEL_CAP - 1); lcs[qq * SEL_CAP + sl] = sc[rt][kh][u]; lci[qq * SEL_CAP + sl] = (unsigned short)kpos; }
                        sa += pa; scn += pc; } }
        }
    }
    asm volatile("s_waitcnt vmcnt(0) lgkmcnt(0)" ::: "memory"); __syncthreads();
}
__device__ __forceinline__ void sel_resolve(unsigned char* ws_, LAS unsigned char* lds_, int wave_, int b_, int ub_, int wg_, int first_) {
    SEL_DECLS
    const int wg = uni_i(wg_), first = uni_i(first_);
    unsigned short* sel = (unsigned short*)(ws + WS_SEL);
    gu32* slowl = (gu32*)(ws + WS_CTL + 65536) + (size_t)wg * 132;
    if (first && tid == 0) __hip_atomic_store(slowl, 0u, RLX_AGENT);
    if (st[512] != 0u) return;
#pragma unroll 1
    for (int qi = 0; qi < 8; ++qi) { const int qq = 8 * wave + qi; const int q = q0 + qq;
        const int na = (int)st[192 + qq], need = TOPK - na; int C = (int)st[384 + qq]; C = C < SEL_CAP ? C : SEL_CAP;
        const bool slow = st[448 + qq] != 0u;
        if (!slow) {
            LAS unsigned* sh = (LAS unsigned*)(lds + SL_KEYS + wave * 2048); LAS float* sls = (LAS float*)(lds + SL_KEYS + wave * 2048 + 256); LAS unsigned short* sli = (LAS unsigned short*)(lds + SL_KEYS + wave * 2048 + 1280);
            const float sclq = stf[qq]; const float fbase = (float)(int)st[128 + qq];
            sh[lane] = 0u;
            float cs[SEL_CAP / 64]; int ci[SEL_CAP / 64], sb[SEL_CAP / 64];
#pragma unroll
            for (int e = 0; e < SEL_CAP / 64; ++e) { const int i = lane + 64 * e; cs[e] = 0.f; ci[e] = 0; sb[e] = -1;
                if (i < C) { cs[e] = lcs[qq * SEL_CAP + i]; ci[e] = lci[qq * SEL_CAP + i];
                    const float fr_ = (fmaf(cs[e], sclq, 128.0f) - fbase) * 64.0f; sb[e] = (int)__builtin_amdgcn_fmed3f(fr_, 0.f, 63.f); } }
            LDS_WAIT();
#pragma unroll
            for (int e = 0; e < SEL_CAP / 64; ++e) if (sb[e] >= 0) (void)__hip_atomic_fetch_add(sh + sb[e], 1u, __ATOMIC_RELAXED, __HIP_MEMORY_SCOPE_WORKGROUP);
            LDS_WAIT();
            const unsigned cl = sh[lane];
            unsigned v = cl, tt;
            tt = __shfl_down(v, 1); if (lane + 1 < 64) v += tt;
            tt = __shfl_down(v, 2); if (lane + 2 < 64) v += tt;
            tt = __shfl_down(v, 4); if (lane + 4 < 64) v += tt;
            tt = __shfl_down(v, 8); if (lane + 8 < 64) v += tt;
            tt = __shfl_down(v, 16); if (lane + 16 < 64) v += tt;
            tt = __shfl_down(v, 32); if (lane + 32 < 64) v += tt;
            const unsigned ab_ = v - cl;
            const unsigned long long cross = __ballot(ab_ < (unsigned)need && v >= (unsigned)need);
            const int sstar = cross ? (int)__builtin_ctzll(cross) : 0;
            const int na2 = (int)__shfl(ab_, sstar);
            const int need2 = need - na2;
            int base = na; int nsub = 0;
#pragma unroll
            for (int e = 0; e < SEL_CAP / 64; ++e) { const bool up = sb[e] > sstar; const bool eq = sb[e] == sstar;
                const unsigned long long bu = __ballot(up), be = __ballot(eq);
                const unsigned long long lt = (lane == 0) ? 0ull : (~0ull >> (64 - lane));
                if (up) lsel[qq * 256 + base + (int)__builtin_popcountll(bu & lt)] = (unsigned short)ci[e];
                if (eq) { const int p_ = nsub + (int)__builtin_popcountll(be & lt); sls[p_] = cs[e]; sli[p_] = (unsigned short)ci[e]; }
                base += (int)__builtin_popcountll(bu); nsub += (int)__builtin_popcountll(be); }
            LDS_WAIT();
#pragma unroll 1
            for (int i0 = 0; i0 < nsub; i0 += 64) { const int i = i0 + lane;
                if (i < nsub) { const float si = sls[i]; const int ii = sli[i]; int rank = 0;
                    for (int jx = 0; jx < nsub; ++jx) { const float sj = sls[jx]; const int ij = sli[jx]; rank += (sj > si || (sj == si && ij < ii)) ? 1 : 0; }
                    if (rank < need2) lsel[qq * 256 + na + na2 + rank] = (unsigned short)ii; } }
            LDS_WAIT();
            *(v2u*)(sel + (size_t)q * TOPK + 4 * lane) = *(const LAS v2u*)(lsel + qq * 256 + 4 * lane);
        }
    }
    __syncthreads();
    if (tid == 0) { unsigned n = first ? 0u : __hip_atomic_load(slowl, RLX_AGENT);
        for (int qq = 0; qq < 64; ++qq) if (st[448 + qq] != 0u) { if (n < 128u) { __hip_atomic_store(slowl + 1 + n, (unsigned)(q0 + qq), RLX_AGENT); ++n; } }
        __hip_atomic_store(slowl, n, RLX_AGENT); }
    asm volatile("s_waitcnt vmcnt(0)" ::: "memory");
    __syncthreads();
}
#undef SEL_DECLS
#undef SEL_LOAD_A
#undef SEL_STAGE
#undef SEL_SCORES
#undef SEL_MMA
#undef SEL_SUM
#undef SEL_BOUNDARY
__device__ __forceinline__ void dsa_select_slow(unsigned char* ws_, LAS unsigned char* lds_, int wave_, int wg_) {
    LAS unsigned char* const lds = uni_l(lds_); const int wave = uni_i(wave_), wg = uni_i(wg_);
    unsigned char* ws = uni(ws_);
    const bf16* iqf = (const bf16*)(ws + WS_IQF); const unsigned* sgn = (const unsigned*)(ws + WS_SGN); const bf16* ik = (const bf16*)(ws + WS_IK);
    unsigned short* sel = (unsigned short*)(ws + WS_SEL);
    gu32* slowl = (gu32*)(ws + WS_CTL + 65536) + (size_t)wg * 132;
    const int lane = lane_id_v(), tid = wave * 64 + lane; const int kl = lane & 31, c5 = lane >> 5;
    LAS unsigned* keys = (LAS unsigned*)lds;
    LAS unsigned* hist = (LAS unsigned*)(lds + 32768);
    LAS unsigned* ctl = (LAS unsigned*)(lds + 40960);
    const int nq = (int)__builtin_amdgcn_readfirstlane(__hip_atomic_load(slowl, RLX_AGENT));
#pragma unroll 1
    for (int k = 0; k < nq; ++k) {
        const int q = (int)__builtin_amdgcn_readfirstlane(__hip_atomic_load(slowl + 1 + k, RLX_AGENT));
        const int b = q / SEQ, t = q % SEQ, n = t + 1;
        const bf16* ikb = ik + (size_t)b * SEQ * IDIM;
        __syncthreads();
        bf16x8_t af[2]; float sgc[8];
        { const int i = kl, a_ = i >> 3, e_ = i & 3; const int hh_ = 4 * (a_ & 1) + e_; const unsigned m_ = sgn[q];
          const unsigned flip_ = ((m_ >> hh_) & 1u) ? 0x80008000u : 0u;
#pragma unroll
          for (int ks = 0; ks < 2; ++ks) { v4u w_ = *(const v4u*)(iqf + (size_t)q * 256 + hh_ * 32 + 16 * ks + 8 * c5); w_.x ^= flip_; w_.y ^= flip_; w_.z ^= flip_; w_.w ^= flip_; af[ks] = __builtin_bit_cast(bf16x8_t, w_); }
#pragma unroll
          for (int h = 0; h < 8; ++h) sgc[h] = ((m_ >> h) & 1u) ? -__builtin_inff() : __builtin_inff(); }
#pragma unroll 1
        for (int kb0 = wave; kb0 * 32 < n; kb0 += 4 * NWAVES) {
            bf16x8_t kb_[4][2];
#pragma unroll
            for (int j = 0; j < 4; ++j) { int key = 32 * (kb0 + j * NWAVES) + kl; key = key < SEQ ? key : SEQ - 1;
                kb_[j][0] = *(const bf16x8_t*)(ikb + (size_t)key * IDIM + 8 * c5); kb_[j][1] = *(const bf16x8_t*)(ikb + (size_t)key * IDIM + 16 + 8 * c5); }
#pragma unroll
            for (int j = 0; j < 4; ++j) { const int key = 32 * (kb0 + j * NWAVES) + kl;
                f32x16 acc = {0.f,0.f,0.f,0.f,0.f,0.f,0.f,0.f,0.f,0.f,0.f,0.f,0.f,0.f,0.f,0.f};
                acc = __builtin_amdgcn_mfma_f32_32x32x16_f16(__builtin_bit_cast(f16x8_t, af[0]), __builtin_bit_cast(f16x8_t, kb_[j][0]), acc, 0, 0, 0); acc = __builtin_amdgcn_mfma_f32_32x32x16_f16(__builtin_bit_cast(f16x8_t, af[1]), __builtin_bit_cast(f16x8_t, kb_[j][1]), acc, 0, 0, 0);
                float sc = 0.f;
#pragma unroll
                for (int h = 0; h < 8; ++h) sc += __builtin_amdgcn_fmed3f(acc[h], 0.f, sgc[h]);
                if (c5 == 0 && key < SEQ) keys[key] = key_of(sc); } }
        if (tid == 0) { const unsigned z_ = (unsigned)launder_v(0); ctl[0] = z_; ctl[1] = z_ + (unsigned)TOPK; ctl[2] = z_; ctl[3] = z_; }
        unsigned P = 0u, Plo = 0u;
#pragma unroll 1
        for (int lev = 0; lev < 5; ++lev) {
            for (int i = tid; i < 2048; i += NWAVES * 64) hist[i] = 0u;
            asm volatile("s_waitcnt lgkmcnt(0)" ::: "memory"); __syncthreads();
#pragma unroll 1
            for (int i = 0; i < 16; ++i) { const int s_ = tid * 16 + i;
                if (s_ < n) { const unsigned hi = keys[s_], lo = 8191u - (unsigned)s_; bool mt; unsigned dg;
                    if (lev == 0) { mt = true; dg = hi >> 21; } else if (lev == 1) { mt = (hi >> 21) == P; dg = (hi >> 10) & 0x7ffu; } else if (lev == 2) { mt = (hi >> 10) == P; dg = hi & 0x3ffu; }
                    else if (lev == 3) { mt = hi == P; dg = lo >> 6; } else { mt = hi == P && (lo >> 6) == Plo; dg = lo & 63u; }
                    if (mt) (void)__hip_atomic_fetch_add(hist + dg, 1u, __ATOMIC_RELAXED, __HIP_MEMORY_SCOPE_WORKGROUP); } }
            asm volatile("s_waitcnt lgkmcnt(0)" ::: "memory"); __syncthreads();
            const unsigned need = ctl[1];
            const v4u hb = *(const LAS v4u*)(hist + 4 * tid); const unsigned ls = hb.x + hb.y + hb.z + hb.w;
            unsigned v = ls, tt;
            tt = __shfl_down(v, 1); if (lane + 1 < 64) v += tt;
            tt = __shfl_down(v, 2); if (lane + 2 < 64) v += tt;
            tt = __shfl_down(v, 4); if (lane + 4 < 64) v += tt;
            tt = __shfl_down(v, 8); if (lane + 8 < 64) v += tt;
            tt = __shfl_down(v, 16); if (lane + 16 < 64) v += tt;
            tt = __shfl_down(v, 32); if (lane + 32 < 64) v += tt;
            if (lane == 0) ctl[8 + wave] = v;
            asm volatile("s_waitcnt lgkmcnt(0)" ::: "memory"); __syncthreads();
            unsigned above = v - ls;
            for (int w2 = wave + 1; w2 < NWAVES; ++w2) above += ctl[8 + w2];
            if (above < need && above + ls >= need) { unsigned c = above; const unsigned bb[4] = {hb.x, hb.y, hb.z, hb.w}; int bsel = 0; unsigned cab = 0; bool found = false;
#pragma unroll
                for (int i = 3; i >= 0; --i) { const bool hit = !found && (c + bb[i] >= need); if (hit) { bsel = i; cab = c; found = true; } c += bb[i]; }
                const unsigned dv = (unsigned)(4 * tid + bsel);
                if (lev == 0) ctl[0] = dv; else if (lev == 1) ctl[0] = (P << 11) | dv; else if (lev == 2) ctl[0] = (P << 10) | dv; else if (lev == 3) ctl[3] = dv; else ctl[3] = (Plo << 6) | dv;
                ctl[1] = need - cab; ctl[4] = bb[bsel]; }
            asm volatile("s_waitcnt lgkmcnt(0)" ::: "memory"); __syncthreads();
            P = ctl[0]; Plo = ctl[3];
            if (lev == 2 && ctl[1] == ctl[4]) break;
        }
        unsigned short* srow = sel + (size_t)q * TOPK;
        unsigned mymask = 0u;
#pragma unroll 1
        for (int i = 0; i < 16; ++i) { const int s_ = tid * 16 + i;
            if (s_ < n) { const unsigned hi = keys[s_], lo = 8191u - (unsigned)s_; if (hi > P || (hi == P && lo >= Plo)) mymask |= 1u << i; } }
        const unsigned mycnt = (unsigned)__builtin_popcount(mymask);
        unsigned pv_ = mycnt, tt_;
        tt_ = __shfl_up(pv_, 1); if (lane >= 1) pv_ += tt_;
        tt_ = __shfl_up(pv_, 2); if (lane >= 2) pv_ += tt_;
        tt_ = __shfl_up(pv_, 4); if (lane >= 4) pv_ += tt_;
        tt_ = __shfl_up(pv_, 8); if (lane >= 8) pv_ += tt_;
        tt_ = __shfl_up(pv_, 16); if (lane >= 16) pv_ += tt_;
        tt_ = __shfl_up(pv_, 32); if (lane >= 32) pv_ += tt_;
        if (lane == 63) ctl[16 + wave] = pv_;
        asm volatile("s_waitcnt lgkmcnt(0)" ::: "memory"); __syncthreads();
        unsigned slot0 = pv_ - mycnt;
        for (int w2 = 0; w2 < wave; ++w2) slot0 += ctl[16 + w2];
#pragma unroll 1
        for (int i = 0; i < 16; ++i) if ((mymask >> i) & 1u) { if (slot0 < (unsigned)TOPK) srow[slot0] = (unsigned short)(tid * 16 + i); ++slot0; }
    }
    asm volatile("s_waitcnt vmcnt(0) lgkmcnt(0)" ::: "memory");
    __syncthreads();
}

__device__ __forceinline__ unsigned offb(unsigned row, unsigned ch) { return 256u * row + 16u * (ch ^ (((row & 3u) << 2) | ((row >> 2) & 3u))); }
__device__ __forceinline__ s16x4_t vtr(const LAS unsigned char* p) { return __builtin_bit_cast(s16x4_t, __builtin_amdgcn_ds_read_tr16_b64_v4i16((LAS s16x4_t*)p)); }

__device__ __forceinline__ void dsa_attend(unsigned char* ws_, LAS unsigned char* lds_, const float* relb_, int wave_, int vcu_, int G_, int dry_) {
    const int dry = uni_i(dry_);
    LAS unsigned char* const lds = uni_l(lds_); const int wave = uni_i(wave_), vcu = uni_i(vcu_), G = uni_i(G_);
    unsigned char* ws = uni(ws_); const float* relb = uni(relb_);
    const bf16* ckv = (const bf16*)(ws + WS_CKV); bf16* ql = (bf16*)(ws + WS_QL); const unsigned short* sel = (const unsigned short*)(ws + WS_SEL);
    const int lane = lane_id_v(), tid = wave * 64 + lane;
    LAS unsigned char* cb = lds + wave * 16384;
    LAS unsigned short* sidx = (LAS unsigned short*)(lds + 131072 + wave * 512);
    LAS float* biasd = (LAS float*)(lds + 135168);
    for (int i = tid; i < 129 * 8; i += NWAVES * 64) { const int d = i >> 3, h = i & 7; const int bk = d < 128 ? (int)T5_BUCKET[d] : 31; biasd[i] = relb[bk * 8 + h]; }
    __syncthreads();
    const int hl = lane & 15, g = lane >> 4, hq = hl & 7;
    for (int p = vcu; p < BATCH * 64; p += G) {
        const int b = p >> 6, j = p & 63;
#pragma unroll 1
        for (int half = 0; half < 2; ++half) {
            const int ub = half == 0 ? j : 127 - j;
#pragma unroll 1
            for (int qi = 0; qi < 8; ++qi) {
                const int t = ub * 64 + wave * 8 + qi; const int q = b * SEQ + t; const int nsel = (t + 1) < TOPK ? (t + 1) : TOPK;
                const bf16* ckvb = ckv + (size_t)b * SEQ * KVR; bf16* qlrow = ql + (size_t)q * 1024;
                { const v2u w = *(const v2u*)(sel + (size_t)q * TOPK + 4 * lane); *(LAS v2u*)(sidx + 4 * lane) = w; }
                bf16x8_t qf[4];
#pragma unroll
                for (int s = 0; s < 4; ++s) qf[s] = *(const bf16x8_t*)(qlrow + hq * 128 + 32 * s + 8 * g);
                LDS_WAIT();
                float mrun = -1e30f, lsum = 0.f;
                f32x4 O[8];
#pragma unroll
                for (int c = 0; c < 8; ++c) O[c] = (f32x4){0.f, 0.f, 0.f, 0.f};
#define DSA_GATHER(c_) do { LAS unsigned char* dst_ = cb + ((c_) & 1) * 8192; \
                    _Pragma("unroll") for (int k_ = 0; k_ < 8; ++k_) { const int row_ = 4 * k_ + g; const int kidx_ = sidx[32 * (c_) + row_]; \
                        const int ch_ = hl ^ ((g << 2) | (k_ & 3)); \
                        glds16(ckvb + (size_t)kidx_ * KVR + ch_ * 8, (unsigned)__builtin_amdgcn_readfirstlane((int)(unsigned)(size_t)(dst_ + k_ * 1024))); } } while (0)
                DSA_GATHER(0);
#pragma unroll 1
                for (int c = 0; c < 8; ++c) {
                    if (c < 7) { DSA_GATHER(c + 1); asm volatile("s_waitcnt vmcnt(8)" ::: "memory"); }
                    else asm volatile("s_waitcnt vmcnt(0)" ::: "memory");
                    const LAS unsigned char* img = cb + (c & 1) * 8192;
                    f32x4 S[2];
#pragma unroll
                    for (int rb = 0; rb < 2; ++rb) { S[rb] = (f32x4){0.f, 0.f, 0.f, 0.f}; const unsigned row = 8u * (hl >> 2) + 4u * rb + (hl & 3);
#pragma unroll
                        for (int s = 0; s < 4; ++s) { const bf16x8_t af = *(const LAS bf16x8_t*)(img + offb(row, 4 * s + g)); S[rb] = __builtin_amdgcn_mfma_f32_16x16x32_bf16(af, qf[s], S[rb], 0, 0, 0); } }
                    float pv[2][4]; float mx = -1e30f;
#pragma unroll
                    for (int rb = 0; rb < 2; ++rb) { const v2u iw2 = *(const LAS v2u*)(sidx + 32 * c + 8 * g + 4 * rb);
                        const int ki[4] = {(int)(iw2.x & 0xffffu), (int)(iw2.x >> 16), (int)(iw2.y & 0xffffu), (int)(iw2.y >> 16)};
#pragma unroll
                        for (int r = 0; r < 4; ++r) { int dist = t - ki[r]; dist = dist < 0 ? 0 : (dist > 128 ? 128 : dist);
                            float lg = S[rb][r] * 0.125f + biasd[dist * 8 + hq];
                            if (32 * c + 8 * g + 4 * rb + r >= nsel) lg = -1e30f;
                            pv[rb][r] = lg; mx = fmaxf(mx, lg); } }
                    mx = fmaxf(mx, __shfl_xor(mx, 16)); mx = fmaxf(mx, __shfl_xor(mx, 32));
                    const float mnew = fmaxf(mrun, mx); const float alpha = __expf(mrun - mnew); mrun = mnew;
                    float rs = 0.f;
#pragma unroll
                    for (int rb = 0; rb < 2; ++rb)
#pragma unroll
                        for (int r = 0; r < 4; ++r) { pv[rb][r] = __expf(pv[rb][r] - mnew); rs += pv[rb][r]; }
                    rs += __shfl_xor(rs, 16); rs += __shfl_xor(rs, 32);
                    lsum = lsum * alpha + rs;
                    v4u pw; pw.x = pg8::cvt_pk_bf16(pv[0][0], pv[0][1]); pw.y = pg8::cvt_pk_bf16(pv[0][2], pv[0][3]); pw.z = pg8::cvt_pk_bf16(pv[1][0], pv[1][1]); pw.w = pg8::cvt_pk_bf16(pv[1][2], pv[1][3]);
                    const bf16x8_t pf = __builtin_bit_cast(bf16x8_t, pw);
                    float al[4];
#pragma unroll
                    for (int r = 0; r < 4; ++r) al[r] = __shfl(alpha, 4 * g + r);
#pragma unroll
                    for (int cd = 0; cd < 8; ++cd) {
                        f32x4 o = O[cd]; o[0] *= al[0]; o[1] *= al[1]; o[2] *= al[2]; o[3] *= al[3];
                        const unsigned q4 = hl >> 2, p4 = hl & 3;
                        const s16x4_t b0 = vtr(img + offb(8u * g + q4, 2 * cd + (p4 >> 1)) + 8u * (p4 & 1));
                        const s16x4_t b1 = vtr(img + offb(8u * g + 4u + q4, 2 * cd + (p4 >> 1)) + 8u * (p4 & 1));
                        bf16x8_t bf; bf[0] = b0[0]; bf[1] = b0[1]; bf[2] = b0[2]; bf[3] = b0[3]; bf[4] = b1[0]; bf[5] = b1[1]; bf[6] = b1[2]; bf[7] = b1[3];
                        O[cd] = __builtin_amdgcn_mfma_f32_16x16x32_bf16(pf, bf, o, 0, 0, 0);
                    }
                }
#undef DSA_GATHER
                const float linv = 1.0f / lsum; float li[4];
#pragma unroll
                for (int r = 0; r < 4; ++r) li[r] = __shfl(linv, 4 * g + r);
                LAS unsigned short* ost = (LAS unsigned short*)cb;
                if (g < 2) {
#pragma unroll
                    for (int cd = 0; cd < 8; ++cd)
#pragma unroll
                        for (int r = 0; r < 4; ++r) ost[(4 * g + r) * 128 + 16 * cd + hl] = (unsigned short)f2bf(O[cd][r] * li[r]);
                }
                LDS_WAIT();
                { const v4u w0 = *(const LAS v4u*)(cb + 32 * lane), w1 = *(const LAS v4u*)(cb + 32 * lane + 16);
                  if (!dry) { *(v4u*)(qlrow + 16 * lane) = w0; *(v4u*)(qlrow + 16 * lane + 8) = w1; } else asm volatile("" :: "v"(w0), "v"(w1)); }
                LDS_WAIT();
            }
        }
    }
    __syncthreads();
}

__device__ __noinline__ void final_norm(const float* const* in_, float* out_, unsigned char* ws_, LAS unsigned char* lds_, int wave_, int vcu_, int G_) {
    const PC F{uni(in_), uni(out_), uni(ws_), uni_l(lds_), uni_i(wave_), uni_i(vcu_), uni_i(G_)}; struct { const float* const* in; float* out; } a{F.in, F.out};
    const int lane_ = lane_id_v(); const int gw = F.vcu * NWAVES + F.wave, NGW = F.G * NWAVES; const float* g = a.in[22];
    f32x4 gv[4];
#pragma unroll
    for (int j = 0; j < 4; ++j) gv[j] = ((const f32x4*)g)[lane_ + 64 * j];
    for (int m = gw; m < M; m += NGW) {
        GAS f32x4* xr = (GAS f32x4*)(a.out + (size_t)m * D) + lane_;
        f32x4 v[4]; float s = 0.f;
#pragma unroll
        for (int j = 0; j < 4; ++j) { v[j] = xr[64 * j]; s += (v[j].x * v[j].x + v[j].y * v[j].y) + (v[j].z * v[j].z + v[j].w * v[j].w); }
        const float rs = 1.0f / sqrtf(wave_sum(s) * (1.0f / D) + EPS);
#pragma unroll
        for (int j = 0; j < 4; ++j) xr[64 * j] = v[j] * rs * gv[j];
    }
}

#define KIN ((const float* const*)__builtin_amdgcn_kernarg_segment_ptr())
constexpr int PH_PER_LAYER = 10, PH_LAYER0 = 2, N_PHASES = PH_LAYER0 + PH_PER_LAYER * DEPTH + 1;

__global__ void __launch_bounds__(NWAVES * 64, 2) mk_fwd(Args args) {
    extern __shared__ __attribute__((aligned(16))) unsigned char lds[];
    Frame F;
    F.lds = (LAS unsigned char*)lds;
    F.MISC = (volatile LAS unsigned*)(F.lds + MISC_OFF);
    F.wave = __builtin_amdgcn_readfirstlane((int)threadIdx.x >> 6);
    F.G = gridDim.x; { const int bx = blockIdx.x; F.vcu = (F.G % 8 == 0) ? (bx % 8) * (F.G / 8) + bx / 8 : bx; }
    F.ws = args.ws; F.ctl = (gu32*)(args.ws + WS_CTL);
    if (threadIdx.x < 64) ((LAS unsigned*)(F.lds + MISC_OFF))[threadIdx.x] = 0u;
    __syncthreads();
    const int lo = args.ph_lo, hi = args.ph_hi;
    const bool multi = (hi - lo) > 1;
    XcdBarrier bar; bar.bar = (unsigned*)(F.ctl + CW_BAR); bar.x = 0; bar.st = nullptr; bar.wave = F.wave;
    if (multi) bar = xcd_barrier_post((unsigned*)(F.ctl + CW_BAR), F.MISC + 8, F.wave);
#define IN(k) (lo <= (k) && (k) < hi)
#define SEAM(k) do { if (IN(k) && IN((k) + 1)) { xcd_barrier(bar); if (PROBE_PHASE == 99) xcd_barrier(bar); } } while (0)

    if (IN(0)) {
#if EN_P0
 for (int rep = (PROBE_PHASE == 1 ? 0 : 1); rep < 2; ++rep) p0_prologue(KIN, args.out, args.ws, F.lds, F.wave, F.vcu, F.G);
#endif
 } SEAM(0);
    if (IN(1)) {
#if !((DIS_MASK >> 7) & 1)
 unsigned char* ws = launder_p(args.ws); bf16* hb = (bf16*)(ws + WS_HB); float* ss = (float*)(ws + WS_SS); (void)hb; (void)ss;
        pg8::Gemm g{(const bf16_t*)(ws + WS_MEMN), (const bf16_t*)(ws + WS_WMEM), MROWS, DEPTH * 2 * CW, D}; pg8::StaticOrder S; S.init(MROWS, DEPTH * 2 * CW, F.G, launder_s((int)blockIdx.x));
        EpiPlainBf16 E{(bf16_t*)(ws + WS_MEMKV), DEPTH * 2 * CW};
        pg8::gemm_phase<EpiPlainBf16, pg8::StaticOrder, true, true>(F.lds + RING_OFF, g, S, E, F.wave);
        { pg8::Gemm g2{(const bf16_t*)(ws + WS_WMEM), (const bf16_t*)(ws + WS_MEMN), DEPTH * 2 * CW, MROWS, D}; pg8::StaticOrder S2; S2.init(DEPTH * 2 * CW, MROWS, F.G, launder_s((int)blockIdx.x));
          EpiPlainBf16 E2{(bf16_t*)(ws + WS_VT), MROWS};
          pg8::gemm_phase<EpiPlainBf16, pg8::StaticOrder, true, true>(F.lds + RING_OFF, g2, S2, E2, F.wave); }
#endif
    } SEAM(1);

    for (int l = 0; l < DEPTH; ++l) {
        const int pb = PH_LAYER0 + PH_PER_LAYER * l;
        const float* hbase = (l == 0) ? args.in[0] : args.out;
        if (IN(pb + 0)) {
#if EN_P0
 if (l > 0) for (int rep = (PROBE_PHASE == 1 ? 0 : 1); rep < 2; ++rep) prep_layer_weights(KIN, args.out, args.ws, F.lds, l, F.wave, F.vcu, F.G);
#endif
 } SEAM(pb + 0);
        if (IN(pb + 1)) {
#if !((DIS_MASK >> 0) & 1)
 unsigned char* ws = launder_p(args.ws); bf16* hb = (bf16*)(ws + WS_HB); float* ss = (float*)(ws + WS_SS); (void)hb; (void)ss;
            pg8::Gemm g{hb, (const bf16_t*)(ws + WS_W1IN), M, 2 * DFF, D}; pg8::StaticOrder S; S.init(M, 2 * DFF, F.G, launder_s((int)blockIdx.x));
            EpiSwiglu E{(bf16_t*)(ws + WS_ACT), ss};
            for (int rep = (PROBE_PHASE == 2 ? 0 : 1); rep < 2; ++rep) pg8::gemm_phase<EpiSwiglu, pg8::StaticOrder, true, true>(F.lds + RING_OFF, g, S, E, F.wave);
#endif
        } SEAM(pb + 1);
        if (IN(pb + 2)) {
#if !((DIS_MASK >> 1) & 1)
 unsigned char* ws = launder_p(args.ws); bf16* hb = (bf16*)(ws + WS_HB); float* ss = (float*)(ws + WS_SS); (void)hb; (void)ss;
            pg8::Gemm g{(const bf16_t*)(ws + WS_ACT), (const bf16_t*)(ws + WS_W1OUT), M, D, DFF}; pg8::StaticOrder S; S.init(M, D, F.G, launder_s((int)blockIdx.x));
            for (int rep = (PROBE_PHASE == 3 ? 0 : 1); rep < 2; ++rep) { EpiResid E{hbase, args.out, hb, ss, 0.5f, (LAS float*)(F.lds + RING_BYTES), rep == 0 ? 1 : 0};
            pg8::gemm_phase<EpiResid, pg8::StaticOrder, true, true>(F.lds + RING_OFF, g, S, E, F.wave); }
#endif
        } SEAM(pb + 2);
        if (IN(pb + 3)) {
#if !((DIS_MASK >> 2) & 1)
 unsigned char* ws = launder_p(args.ws); bf16* hb = (bf16*)(ws + WS_HB); float* ss = (float*)(ws + WS_SS); (void)hb; (void)ss;
            pg8::Gemm g{hb, (const bf16_t*)(ws + WS_WIN), M, INP, D}; pg8::StaticOrder S; S.init(M, INP, F.G, launder_s((int)blockIdx.x));
            EpiInProj E{ss, (bf16_t*)(ws + WS_QL), (float*)(ws + WS_CKVRAW), (bf16_t*)(ws + WS_IK), (float*)(ws + WS_IW), (bf16_t*)(ws + WS_IQRAW), (bf16_t*)(ws + WS_Z), (bf16_t*)(ws + WS_QC), (bf16_t*)(ws + WS_G)};
            for (int rep = (PROBE_PHASE == 4 ? 0 : 1); rep < 2; ++rep) pg8::gemm_phase<EpiInProj, pg8::StaticOrder, true, true>(F.lds + RING_OFF, g, S, E, F.wave);
#endif
        } SEAM(pb + 3);
        if (IN(pb + 4)) {
#if EN_PREP
 for (int rep = (PROBE_PHASE == 5 ? 0 : 1); rep < 2; ++rep) prep_tokens(KIN, args.out, args.ws, F.lds, l, F.wave, F.vcu, F.G, rep == 0 ? 1 : 0);
#endif
 } SEAM(pb + 4);
        if (IN(pb + 5)) {
#if EN_DSA
 for (int rep = (PROBE_PHASE == 6 ? 0 : 1); rep < 2; ++rep) for (int p = F.vcu; p < BATCH * 64; p += F.G) { for (int half = 0; half < 2; ++half) { const int b_ = p >> 6, ub_ = half == 0 ? (p & 63) : 127 - (p & 63);
   sel_pass1(args.ws, F.lds, F.wave, b_, ub_); if (PROBE_PHASE == 61) sel_pass1(args.ws, F.lds, F.wave, b_, ub_); sel_pass2(args.ws, F.lds, F.wave, b_, ub_); if (PROBE_PHASE == 62) sel_pass2(args.ws, F.lds, F.wave, b_, ub_); sel_resolve(args.ws, F.lds, F.wave, b_, ub_, (int)blockIdx.x, (p == F.vcu && half == 0) ? 1 : 0); if (PROBE_PHASE == 63) sel_resolve(args.ws, F.lds, F.wave, b_, ub_, (int)blockIdx.x, 0); } }
 dsa_select_slow(args.ws, F.lds, F.wave, (int)blockIdx.x); for (int rep = (PROBE_PHASE == 7 ? 0 : 1); rep < 2; ++rep) dsa_attend(args.ws, F.lds, args.in[2], F.wave, F.vcu, F.G, rep == 0 ? 1 : 0);
#endif
 } SEAM(pb + 5);
        if (IN(pb + 6)) {
#if !((DIS_MASK >> 3) & 1)
        for (int rep6 = (PROBE_PHASE == 8 ? 0 : 1); rep6 < 2; ++rep6) {
 unsigned char* ws = launder_p(args.ws); bf16* hb = (bf16*)(ws + WS_HB); float* ss = (float*)(ws + WS_SS); (void)hb; (void)ss;
            { pg8::Gemm g{(const bf16_t*)(ws + WS_QL), (const bf16_t*)(ws + WS_WA), M, D, 1024}; pg8::StaticOrder S; S.init(M, D, F.G, launder_s((int)blockIdx.x));
              EpiMerge<0> E{(bf16_t*)(ws + WS_MERGED), (const bf16_t*)(ws + WS_G)};
              pg8::gemm_phase<EpiMerge<0>, pg8::StaticOrder, true, true>(F.lds + RING_OFF, g, S, E, F.wave); }
            { pg8::Gemm g{(const bf16_t*)(ws + WS_YB), (const bf16_t*)(ws + WS_WB), M, D, PW_}; pg8::StaticOrder S; S.init(M, D, F.G, launder_s((int)blockIdx.x));
              EpiMerge<1> E{(bf16_t*)(ws + WS_MERGED), (const bf16_t*)(ws + WS_G)};
              pg8::gemm_phase<EpiMerge<1>, pg8::StaticOrder, true, true>(F.lds + RING_OFF, g, S, E, F.wave); }
            { pg8::Gemm g{(const bf16_t*)(ws + WS_QC), (const bf16_t*)(ws + WS_WC), M, D, CW}; pg8::StaticOrder S; S.init(M, D, F.G, launder_s((int)blockIdx.x));
              EpiMerge<2> E{(bf16_t*)(ws + WS_MERGED), (const bf16_t*)(ws + WS_G)};
              pg8::gemm_phase<EpiMerge<2>, pg8::StaticOrder, true, true>(F.lds + RING_OFF, g, S, E, F.wave); }
        }
#endif
        } SEAM(pb + 6);
        if (IN(pb + 7)) {
#if !((DIS_MASK >> 4) & 1)
 unsigned char* ws = launder_p(args.ws); bf16* hb = (bf16*)(ws + WS_HB); float* ss = (float*)(ws + WS_SS); (void)hb; (void)ss;
            pg8::Gemm g{(const bf16_t*)(ws + WS_MERGED), (const bf16_t*)(ws + WS_WOUT), M, D, D}; pg8::StaticOrder S; S.init(M, D, F.G, launder_s((int)blockIdx.x));
            for (int rep = (PROBE_PHASE == 9 ? 0 : 1); rep < 2; ++rep) { EpiResid E{args.out, args.out, hb, ss, 1.0f, (LAS float*)(F.lds + RING_BYTES), rep == 0 ? 1 : 0};
            pg8::gemm_phase<EpiResid, pg8::StaticOrder, true, true>(F.lds + RING_OFF, g, S, E, F.wave); }
#endif
        } SEAM(pb + 7);
        if (IN(pb + 8)) {
#if !((DIS_MASK >> 5) & 1)
 unsigned char* ws = launder_p(args.ws); bf16* hb = (bf16*)(ws + WS_HB); float* ss = (float*)(ws + WS_SS); (void)hb; (void)ss;
            pg8::Gemm g{hb, (const bf16_t*)(ws + WS_W2IN), M, 2 * DFF, D}; pg8::StaticOrder S; S.init(M, 2 * DFF, F.G, launder_s((int)blockIdx.x));
            EpiSwiglu E{(bf16_t*)(ws + WS_ACT), ss};
            for (int rep = (PROBE_PHASE == 2 ? 0 : 1); rep < 2; ++rep) pg8::gemm_phase<EpiSwiglu, pg8::StaticOrder, true, true>(F.lds + RING_OFF, g, S, E, F.wave);
#endif
        } SEAM(pb + 8);
        if (IN(pb + 9)) {
#if !((DIS_MASK >> 6) & 1)
 unsigned char* ws = launder_p(args.ws); bf16* hb = (bf16*)(ws + WS_HB); float* ss = (float*)(ws + WS_SS); (void)hb; (void)ss;
            pg8::Gemm g{(const bf16_t*)(ws + WS_ACT), (const bf16_t*)(ws + WS_W2OUT), M, D, DFF}; pg8::StaticOrder S; S.init(M, D, F.G, launder_s((int)blockIdx.x));
            for (int rep = (PROBE_PHASE == 3 ? 0 : 1); rep < 2; ++rep) { EpiResid E{args.out, args.out, hb, ss, 0.5f, (LAS float*)(F.lds + RING_BYTES), rep == 0 ? 1 : 0};
            pg8::gemm_phase<EpiResid, pg8::StaticOrder, true, true>(F.lds + RING_OFF, g, S, E, F.wave); }
#endif
        } SEAM(pb + 9);
    }
#if EN_P0
    if (IN(N_PHASES - 1)) { final_norm(KIN, args.out, args.ws, F.lds, F.wave, F.vcu, F.G); }
#endif
#undef IN
#undef SEAM
}

extern "C" void kernel_launch(void* const* d_in, const int* in_sizes, int n_in, void* d_out, int out_size, void* d_ws, size_t ws_size, hipStream_t stream) {
    static int grid = 0;
    if (grid == 0) {
        if (n_in != 23 || in_sizes[0] != M * D || out_size != M * D || ws_size < WS_END) { fprintf(stderr, "kernel_launch: unexpected shapes (n_in %d, ws %zu)\n", n_in, ws_size); grid = -1; return; }
        int dev = 0, cus = 0, per_cu = 0;
        if (hipGetDevice(&dev) != hipSuccess || hipDeviceGetAttribute(&cus, hipDeviceAttributeMultiprocessorCount, dev) != hipSuccess) { grid = -1; return; }
        if (hipFuncSetAttribute((const void*)mk_fwd, hipFuncAttributeMaxDynamicSharedMemorySize, LDS_BYTES) != hipSuccess) { fprintf(stderr, "kernel_launch: hipFuncSetAttribute failed\n"); grid = -1; return; }
        if (hipOccupancyMaxActiveBlocksPerMultiprocessor(&per_cu, (const void*)mk_fwd, NWAVES * 64, LDS_BYTES) != hipSuccess || per_cu < 1) { fprintf(stderr, "kernel_launch: occupancy query says %d\n", per_cu); }
        (void)hipGetLastError();
        grid = cus;
    }
    if (grid < 0) return;
    if (hipMemsetAsync((char*)d_ws + WS_CTL, 0, CTL_ZERO_BYTES, stream) != hipSuccess) return;
    Args a{};
    for (int i = 0; i < 23; ++i) a.in[i] = (const float*)d_in[i];
    a.out = (float*)d_out; a.ws = (unsigned char*)d_ws;
#if MK_ONE_LAUNCH
    a.ph_lo = 0; a.ph_hi = N_PHASES;
    hipLaunchKernelGGL(mk_fwd, dim3(grid), dim3(NWAVES * 64), LDS_BYTES, stream, a);
#endif
}
```

```cpp
#include <hip/hip_runtime.h>
#include <cstdio>
#include <cstdint>

#ifndef MK_ONE_LAUNCH
#define MK_ONE_LAUNCH 1
#endif
#ifndef PROBE_PHASE
#define PROBE_PHASE 0
#endif
#ifndef EN_P0
#define EN_P0 MK_ONE_LAUNCH
#endif
#ifndef EN_PREP
#define EN_PREP MK_ONE_LAUNCH
#endif
#ifndef EN_DSA
#define EN_DSA MK_ONE_LAUNCH
#endif
#ifndef DIS_MASK
#define DIS_MASK 0
#endif
#ifndef MK_ONE_LAUNCH
#define MK_ONE_LAUNCH 1
#endif

__device__ __forceinline__ int lane_id_v() { int l; asm volatile("v_mbcnt_lo_u32_b32 %0, -1, 0\n\tv_mbcnt_hi_u32_b32 %0, -1, %0" : "=v"(l)); return l; }
namespace pg8 {
#define PG8_LAS __attribute__((address_space(3)))
typedef unsigned short bf16_t;
typedef short bf16x8 __attribute__((ext_vector_type(8)));
typedef float f32x4 __attribute__((ext_vector_type(4)));
typedef unsigned u32x4 __attribute__((ext_vector_type(4)));
typedef unsigned u32x2 __attribute__((ext_vector_type(2)));
constexpr int BM = 256, BK = 64, HALF = 128, HTB = HALF * BK * 2, STAGE_BYTES = 8 * HTB, NXCD = 8, WGM = 8;

__host__ __device__ __forceinline__ int lds_byte(int r, int c) { const int st = (r >> 4) * 2 + (c >> 5), rr = r & 15, cc = c & 31, ob = rr * 64 + cc * 2; return st * 1024 + (ob ^ (((ob >> 9) & 1) << 5)); }
__host__ __device__ __forceinline__ void stage_rc(int b, int& R, int& C) { const int st = b / 1024, sb = b % 1024, swz = sb ^ (((sb >> 9) & 1) << 5); R = (st >> 1) * 16 + swz / 64; C = (st & 1) * 32 + (swz % 64) / 2; }
__host__ __device__ __forceinline__ int perm32(int rho) { const int n = rho >> 4, i = rho & 15; return 8 * (i >> 2) + 4 * n + (i & 3); }

struct Unit { int pm, pn; };
struct Gemm { const bf16_t* A; const bf16_t* Bt; int M, N, K; };

struct StaticOrder {
    int nM, nN, nwg, G, c;
    __host__ __device__ void init(int M, int N, int G_, int c_) { nM = M / BM; nN = N / BM; nwg = nM * nN; G = G_; c = c_; }
    __host__ __device__ bool next(int i, Unit& u) const {
        const long L = (long)i * G + c; if (L >= nwg) return false;
        int wgid = (int)L; { const int q = nwg / NXCD, r = nwg % NXCD, xcd = wgid % NXCD, off = wgid / NXCD; wgid = (xcd < r ? xcd * (q + 1) : r * (q + 1) + (xcd - r) * q) + off; }
        const int nig = WGM * nN, gid = wgid / nig, fm = gid * WGM, gsz = (nM - fm) < WGM ? (nM - fm) : WGM;
        u.pm = fm + ((wgid % nig) % gsz); u.pn = (wgid % nig) / gsz; return true;
    }
    __device__ __forceinline__ void a_ready(const Unit&) const {}
    __device__ __forceinline__ void done(const Unit&) const {}
};

__device__ __forceinline__ unsigned cvt_pk_bf16(float lo, float hi) { unsigned r; asm volatile("v_cvt_pk_bf16_f32 %0, %1, %2" : "=v"(r) : "v"(lo), "v"(hi)); return r; }

template <class Epi, class Sched, bool ALIGN_EPI = false, bool SP2 = false>
__device__ __forceinline__ void gemm_phase(PG8_LAS unsigned char* lds, const Gemm g, const Sched& S, const Epi& E, const int wid_) {
    int wid = wid_; asm volatile("" : "+s"(wid));
    const int lane = lane_id_v(), tid = wid * 64 + lane,
              wr = wid >> 2, wc = wid & 3, fr = lane & 15, fq = lane >> 4;
    const int K = g.K, nt = K / BK;
    unsigned voffA[2], voffB[2];
#pragma unroll
    for (int i = 0; i < 2; ++i) { int R, C; stage_rc(tid * 16 + i * 8192, R, C); const int Rb = Epi::PERM ? ((R & ~31) + perm32(R & 31)) : R;
        voffA[i] = (unsigned)(R * K + C) * 2u; voffB[i] = (unsigned)(Rb * K + C) * 2u; }
    const size_t kstep = (size_t)(BK * 2);
    const size_t hstep = (size_t)HALF * K * 2;
    const size_t tstep = 2 * hstep;
    const unsigned ldsw = (unsigned)wid * 1024u;
    const int aoff = lds_byte(wr * 64 + fr, fq * 8), boff = lds_byte(wc * 32 + fr, fq * 8);
#define PG8_SA(b, h) (((b) * 2 + (h)) * HTB)
#define PG8_SB(b, h) ((4 + (b) * 2 + (h)) * HTB)
#define PG8_STAGE(bufoff, gbase, voff) do { _Pragma("unroll") for (int _i = 0; _i < 2; ++_i) \
        __builtin_amdgcn_global_load_lds((const unsigned*)((const char*)(gbase) + (voff)[_i]), (PG8_LAS unsigned*)(lds + (bufoff) + ldsw + _i * 8192), 16, 0, 0); } while (0)
#define PG8_LDA(dst, b, h) do { _Pragma("unroll") for (int m = 0; m < 4; ++m) _Pragma("unroll") for (int k = 0; k < 2; ++k) dst[m][k] = *(const PG8_LAS bf16x8*)(lds + PG8_SA(b, h) + aoff + m * 2048 + k * 1024); } while (0)
#define PG8_LDB(dst, b, h) do { _Pragma("unroll") for (int n = 0; n < 2; ++n) _Pragma("unroll") for (int k = 0; k < 2; ++k) dst[n][k] = *(const PG8_LAS bf16x8*)(lds + PG8_SB(b, h) + boff + n * 2048 + k * 1024); } while (0)
#define PG8_MMA(ai, bj, At, Bt) do { __builtin_amdgcn_s_setprio(1); _Pragma("unroll") for (int m = 0; m < 4; ++m) _Pragma("unroll") for (int n = 0; n < 2; ++n) _Pragma("unroll") for (int k = 0; k < 2; ++k) \
        acc[ai][bj][m][n] = __builtin_amdgcn_mfma_f32_16x16x32_bf16(Bt[n][k], At[m][k], acc[ai][bj][m][n], 0, 0, 0); __builtin_amdgcn_s_setprio(0); } while (0)
#define PG8_WAIT_V(n) asm volatile("s_waitcnt vmcnt(" #n ")" ::: "memory")
#define PG8_WAIT_L(n) asm volatile("s_waitcnt lgkmcnt(" #n ")" ::: "memory")
#define PG8_BAR __builtin_amdgcn_s_barrier()
#define PG8_SCHED __builtin_amdgcn_sched_barrier(0)
    Unit cur, nxt; int ui = 0;
    if (!S.next(0, cur)) return;
    f32x4 acc[2][2][4][2];
#pragma unroll
    for (int a = 0; a < 2; ++a)
#pragma unroll
        for (int b = 0; b < 2; ++b)
#pragma unroll
            for (int m = 0; m < 4; ++m)
#pragma unroll
                for (int n = 0; n < 2; ++n) acc[a][b][m][n] = (f32x4){0.f, 0.f, 0.f, 0.f};
    bf16x8 At[4][2], B0[2][2], B1[2][2];
    const char* cA = (const char*)g.A + (size_t)cur.pm * tstep; const char* cB = (const char*)g.Bt + (size_t)cur.pn * tstep;
    S.a_ready(cur);
    if constexpr (SP2) {
        PG8_STAGE(PG8_SB(0, 0), cB, voffB); PG8_STAGE(PG8_SB(0, 1), cB + hstep, voffB); PG8_STAGE(PG8_SA(0, 0), cA, voffA); PG8_STAGE(PG8_SA(0, 1), cA + hstep, voffA);
        if (wr == 1) PG8_BAR;
        PG8_WAIT_V(2); PG8_BAR;
        PG8_STAGE(PG8_SB(1, 0), cB + kstep, voffB); PG8_STAGE(PG8_SA(1, 0), cA + kstep, voffA); PG8_STAGE(PG8_SB(1, 1), cB + hstep + kstep, voffB);
        PG8_WAIT_V(6); PG8_BAR;
    } else {
        PG8_STAGE(PG8_SB(0, 0), cB, voffB); PG8_STAGE(PG8_SA(0, 0), cA, voffA); PG8_STAGE(PG8_SB(0, 1), cB + hstep, voffB); PG8_STAGE(PG8_SA(0, 1), cA + hstep, voffA);
        if (wr == 1) PG8_BAR;
        PG8_WAIT_V(4); PG8_BAR;
        PG8_STAGE(PG8_SB(1, 0), cB + kstep, voffB); PG8_STAGE(PG8_SA(1, 0), cA + kstep, voffA); PG8_STAGE(PG8_SB(1, 1), cB + hstep + kstep, voffB);
        PG8_WAIT_V(6); PG8_BAR;
    }
    for (;;) {
        const bool has_next = S.next(ui + 1, nxt);
        const char* nA = has_next ? (const char*)g.A + (size_t)nxt.pm * tstep : cA; const char* nB = has_next ? (const char*)g.Bt + (size_t)nxt.pn * tstep : cB;
#pragma nounroll
        for (int t = 0; t < nt; t += 2) {
            const bool last = (t == nt - 2);
            const char* a1 = cA + (size_t)(t + 1) * kstep;
            const char* a2 = last ? nA : cA + (size_t)(t + 2) * kstep; const char* b2 = last ? nB : cB + (size_t)(t + 2) * kstep;
            const char* a3 = a2 + kstep; const char* b3 = b2 + kstep;
            if (last && has_next) S.a_ready(nxt);
            if constexpr (SP2) {
            PG8_LDB(B0, 0, 0); PG8_LDB(B1, 0, 1); PG8_SCHED; PG8_LDA(At, 0, 0); PG8_STAGE(PG8_SA(1, 1), a1 + hstep, voffA);
            PG8_WAIT_V(8); PG8_WAIT_L(0); PG8_BAR; PG8_MMA(0, 0, At, B0); PG8_MMA(0, 1, At, B1); PG8_BAR; PG8_SCHED;
            PG8_LDA(At, 0, 1); PG8_STAGE(PG8_SB(0, 0), b2, voffB); PG8_STAGE(PG8_SB(0, 1), b2 + hstep, voffB); PG8_STAGE(PG8_SA(0, 0), a2, voffA);
            PG8_WAIT_V(8); PG8_WAIT_L(0); PG8_BAR; PG8_MMA(1, 0, At, B0); PG8_MMA(1, 1, At, B1); PG8_BAR; PG8_SCHED;
            PG8_LDB(B0, 1, 0); PG8_LDB(B1, 1, 1); PG8_SCHED; PG8_LDA(At, 1, 0); PG8_STAGE(PG8_SA(0, 1), a2 + hstep, voffA);
            PG8_WAIT_V(8); PG8_WAIT_L(0); PG8_BAR; PG8_MMA(0, 0, At, B0); PG8_MMA(0, 1, At, B1); PG8_BAR; PG8_SCHED;
            PG8_LDA(At, 1, 1); PG8_STAGE(PG8_SB(1, 0), b3, voffB); PG8_STAGE(PG8_SB(1, 1), b3 + hstep, voffB); PG8_STAGE(PG8_SA(1, 0), a3, voffA);
            PG8_WAIT_V(8); PG8_WAIT_L(0); PG8_BAR; PG8_MMA(1, 0, At, B0); PG8_MMA(1, 1, At, B1); PG8_BAR; PG8_SCHED;
            } else {
            PG8_LDB(B0, 0, 0); PG8_SCHED; PG8_LDA(At, 0, 0); PG8_STAGE(PG8_SA(1, 1), a1 + hstep, voffA);
            PG8_WAIT_L(8); PG8_BAR; PG8_WAIT_L(0); PG8_MMA(0, 0, At, B0); PG8_BAR; PG8_SCHED;
            PG8_LDB(B1, 0, 1); PG8_STAGE(PG8_SB(0, 0), b2, voffB);
            PG8_BAR; PG8_WAIT_L(0); PG8_MMA(0, 1, At, B1); PG8_BAR;
            PG8_LDA(At, 0, 1); PG8_STAGE(PG8_SA(0, 0), a2, voffA);
            PG8_BAR; PG8_WAIT_L(0); PG8_MMA(1, 0, At, B0); PG8_BAR; PG8_SCHED;
            PG8_STAGE(PG8_SB(0, 1), b2 + hstep, voffB);
            PG8_WAIT_V(6); PG8_BAR; PG8_MMA(1, 1, At, B1); PG8_BAR;
            PG8_LDB(B0, 1, 0); PG8_SCHED; PG8_LDA(At, 1, 0); PG8_STAGE(PG8_SA(0, 1), a2 + hstep, voffA);
            PG8_WAIT_L(8); PG8_BAR; PG8_WAIT_L(0); PG8_MMA(0, 0, At, B0); PG8_BAR; PG8_SCHED;
            PG8_LDB(B1, 1, 1); PG8_STAGE(PG8_SB(1, 0), b3, voffB);
            PG8_BAR; PG8_WAIT_L(0); PG8_MMA(0, 1, At, B1); PG8_BAR;
            PG8_LDA(At, 1, 1); PG8_STAGE(PG8_SA(1, 0), a3, voffA);
            PG8_BAR; PG8_WAIT_L(0); PG8_MMA(1, 0, At, B0); PG8_BAR; PG8_SCHED;
            PG8_STAGE(PG8_SB(1, 1), b3 + hstep, voffB);
            PG8_WAIT_V(6); PG8_BAR; PG8_MMA(1, 1, At, B1); PG8_BAR;
            }
        }
        if constexpr (ALIGN_EPI) { if (wr == 0) PG8_BAR; }
        E(acc, cur, wr, wc, fr, fq); S.done(cur);
        if (!has_next) break;
#pragma unroll
        for (int a = 0; a < 2; ++a)
#pragma unroll
            for (int b = 0; b < 2; ++b)
#pragma unroll
                for (int m = 0; m < 4; ++m)
#pragma unroll
                    for (int n = 0; n < 2; ++n) acc[a][b][m][n] = (f32x4){0.f, 0.f, 0.f, 0.f};
        cur = nxt; cA = nA; cB = nB; ++ui;
        if constexpr (ALIGN_EPI) { if (wr == 1) PG8_BAR; }
    }
    PG8_WAIT_V(0);
    if constexpr (!ALIGN_EPI) { if (wr == 0) PG8_BAR; }
    PG8_BAR;
#undef PG8_SA
#undef PG8_SB
#undef PG8_STAGE
#undef PG8_LDA
#undef PG8_LDB
#undef PG8_MMA
#undef PG8_WAIT_V
#undef PG8_WAIT_L
#undef PG8_BAR
#undef PG8_SCHED
}
}

constexpr int NWAVES = 8;
constexpr int BATCH = 4, SEQ = 8192, D = 1024, DEPTH = 4, M = BATCH * SEQ;
constexpr int NMEM = 256, MROWS = BATCH * NMEM;
constexpr int AH = 8, AHD = 64, AW = 512, KVR = 128, IH = 8, IDIM = 32, TOPK = 256;
constexpr int PW_ = 256, CH = 4, CHD = 64, CW = 256;
constexpr int DFF = 2816, INW = 4520, INP = 5120;
constexpr float EPS = 1e-6f;
constexpr int C_QA = 0, C_CKV = 512, C_IQ = 640, C_IK = 896, C_IW = 928, C_Z = 936, C_QC = 1192, C_G = 1448;

constexpr size_t MiB = 1u << 20;
constexpr size_t WS_CTL = 0, CTL_ZERO_BYTES = 1 * MiB;
constexpr size_t WS_SS = 1 * MiB;
constexpr size_t WS_IW = 3 * MiB;
constexpr size_t WS_SGN = 4 * MiB;
constexpr size_t WS_MEMN = 5 * MiB;
constexpr size_t WS_WMEM = 7 * MiB;
constexpr size_t WS_MEMKV = 11 * MiB;
constexpr size_t WS_W1IN = 15 * MiB, WS_W1OUT = 26 * MiB, WS_WIN = 32 * MiB, WS_WA = 42 * MiB, WS_WB = 44 * MiB, WS_WC = 44 * MiB + 512 * 1024, WS_WOUT = 45 * MiB, WS_W2IN = 47 * MiB, WS_W2OUT = 58 * MiB;
constexpr size_t WS_HB = 64 * MiB;
constexpr size_t WS_ACT = 128 * MiB;
constexpr size_t WS_G = 128 * MiB;
constexpr size_t WS_QL = 320 * MiB;
constexpr size_t WS_CKV = 384 * MiB;
constexpr size_t WS_CKVRAW = 392 * MiB;
constexpr size_t WS_IQRAW = 408 * MiB;
constexpr size_t WS_IQF = 424 * MiB;
constexpr size_t WS_IK = 440 * MiB;
constexpr size_t WS_Z = 442 * MiB;
constexpr size_t WS_MERGED = 384 * MiB;
constexpr size_t WS_YB = 458 * MiB;
constexpr size_t WS_QC = 474 * MiB;
constexpr size_t WS_SEL = 490 * MiB;
constexpr size_t WS_VT = 506 * MiB;
constexpr size_t WS_WPT = 4 * MiB + 512 * 1024;
constexpr size_t WS_END = 510 * MiB;
constexpr int CW_BAR = 4096;

constexpr int RING_OFF = 0, RING_BYTES = 131072;
constexpr int LDS_BYTES = 155648;
constexpr int MISC_OFF = LDS_BYTES - 256;

#define GAS __attribute__((address_space(1)))
#define LAS __attribute__((address_space(3)))
typedef unsigned short bf16;
typedef unsigned v4u __attribute__((ext_vector_type(4)));
typedef unsigned v2u __attribute__((ext_vector_type(2)));
typedef float f32x4 __attribute__((ext_vector_type(4)));
typedef float f32x2 __attribute__((ext_vector_type(2)));
typedef GAS unsigned gu32;
#define RLX_AGENT __ATOMIC_RELAXED, __HIP_MEMORY_SCOPE_AGENT
#define LDS_WAIT() asm volatile("s_waitcnt lgkmcnt(0)" ::: "memory")
#define VM_WAIT() asm volatile("s_waitcnt vmcnt(0)" ::: "memory")
__device__ __forceinline__ unsigned f2bf(float f) { unsigned u = __builtin_bit_cast(unsigned, f); return (u + 0x7fffu + ((u >> 16) & 1u)) >> 16; }
__device__ __forceinline__ unsigned pk2(float lo, float hi) { return pg8::cvt_pk_bf16(lo, hi); }
__device__ __forceinline__ float bflo(unsigned w) { return __builtin_bit_cast(float, w << 16); }
__device__ __forceinline__ float bfhi(unsigned w) { return __builtin_bit_cast(float, w & 0xffff0000u); }
typedef _Float16 h2_t __attribute__((ext_vector_type(2)));
typedef _Float16 f16x8_t __attribute__((ext_vector_type(8)));
__device__ __forceinline__ unsigned pkh2(float lo, float hi) { const h2_t v = {(_Float16)lo, (_Float16)hi}; return __builtin_bit_cast(unsigned, v); }
__device__ __forceinline__ float hlo(unsigned w) { return (float)__builtin_bit_cast(h2_t, w)[0]; }
__device__ __forceinline__ float hhi(unsigned w) { return (float)__builtin_bit_cast(h2_t, w)[1]; }
__device__ __forceinline__ float bf2f(bf16 b) { return __builtin_bit_cast(float, ((unsigned)b) << 16); }

#define XB_TMO      128
#define XB_XCNT(j)  (256  + 64 * (j))
#define XB_XSUB(j)  (1280 + 64 * (j))
#define XB_XGEN(j)  (2304 + 64 * (j))
#define XB_TOP      3328
#define XB_TOPGEN   3392
#define XCD_BAR_WORDS 3456
#define XB_SPIN_CAP (1u << 23)

__device__ __forceinline__ unsigned xb_ld(unsigned* p)              { return __hip_atomic_load(p, __ATOMIC_RELAXED, __HIP_MEMORY_SCOPE_AGENT); }
__device__ __forceinline__ unsigned xb_add(unsigned* p, unsigned v) { return __hip_atomic_fetch_add(p, v, __ATOMIC_RELAXED, __HIP_MEMORY_SCOPE_AGENT); }
__device__ __forceinline__ unsigned xb_xcc_id() { return (unsigned)__builtin_amdgcn_s_getreg((3 << 11) | 20) & 0xFu; }
#define XB_SPIN(cond, bar) do { unsigned _sp = 0; while (cond) { __builtin_amdgcn_s_sleep(1); \
    if ((++_sp & 255u) == 0u) { if (xb_ld(&(bar)[XB_TMO])) break; if (_sp > XB_SPIN_CAP) { atomicAdd(&(bar)[XB_TMO], 1u); break; } } } } while (0)

struct XcdBarrier { unsigned* bar; unsigned x; volatile LAS unsigned* st; int wave; };

__device__ __forceinline__ XcdBarrier xcd_barrier_post(unsigned* bar, volatile LAS unsigned* st, int wave) {
    XcdBarrier b; b.bar = bar; b.x = xb_xcc_id(); b.st = st; b.wave = wave;
    if (threadIdx.x == 0) (void)xb_add(&bar[XB_XCNT(b.x)], 1u);
    return b;
}
__device__ __forceinline__ void xcd_barrier_complete(unsigned* bar, unsigned x, unsigned& nloc, unsigned& nx) {
    const unsigned G = gridDim.x * gridDim.y * gridDim.z;
    unsigned sum, cnt, mine, sp = 0u;
    for (;;) {
        sum = 0u; cnt = 0u; mine = 0u;
#pragma unroll
        for (unsigned j = 0; j < 16; ++j) { const unsigned c = xb_ld(&bar[XB_XCNT(j)]); sum += c; cnt += (c > 0u) ? 1u : 0u; mine = (j == x) ? c : mine; }
        if (sum == G) break;
        __builtin_amdgcn_s_sleep(1);
        if ((++sp & 255u) == 0u) { if (xb_ld(&bar[XB_TMO])) break; if (sp > XB_SPIN_CAP) { atomicAdd(&bar[XB_TMO], 1u); break; } }
    }
    nloc = mine > 0u ? mine : 1u; nx = cnt > 0u ? cnt : 1u;
}
__device__ __forceinline__ void xcd_barrier(const XcdBarrier& b) {
    asm volatile("s_waitcnt vmcnt(0)" ::: "memory");
    __syncthreads();
    int bw_ = b.wave; asm volatile("" : "+s"(bw_));
    if (bw_ == 0 && lane_id_v() == 0) {
        unsigned* bar = b.bar;
        __builtin_amdgcn_s_waitcnt(0);
        unsigned nloc = b.st[0], nx = b.st[1];
        if (nloc == 0u) { xcd_barrier_complete(bar, b.x, nloc, nx); b.st[0] = nloc; b.st[1] = nx; }
        const unsigned old = xb_add(&bar[XB_XSUB(b.x)], 1u);
        const unsigned gen = old / nloc;
        if (old + 1u == (gen + 1u) * nloc) {
            __builtin_amdgcn_fence(__ATOMIC_RELEASE, "agent");
            asm volatile("s_waitcnt vmcnt(0)" ::: "memory");
            const unsigned og = xb_add(&bar[XB_TOP], 1u);
            const unsigned tg = og / nx;
            if (og + 1u == (tg + 1u) * nx) xb_add(&bar[XB_TOPGEN], 1u);
            else XB_SPIN(xb_ld(&bar[XB_TOPGEN]) == tg, bar);
            __builtin_amdgcn_fence(__ATOMIC_ACQUIRE, "agent");
            xb_add(&bar[XB_XGEN(b.x)], 1u);
            asm volatile("s_waitcnt vmcnt(0)" ::: "memory");
        } else {
            XB_SPIN(xb_ld(&bar[XB_XGEN(b.x)]) == gen, bar);
            __builtin_amdgcn_fence(__ATOMIC_ACQUIRE, "agent");
            asm volatile("s_waitcnt vmcnt(0)" ::: "memory");
        }
    }
    __syncthreads();
}

struct Args {
    const float* in[23]; float* out; unsigned char* ws; int ph_lo, ph_hi;
};
template <class T> __device__ __forceinline__ T* uni(T* p) { const unsigned long long v = (unsigned long long)p; const unsigned lo = __builtin_amdgcn_readfirstlane((unsigned)v), hi = __builtin_amdgcn_readfirstlane((unsigned)(v >> 32)); return (T*)(((unsigned long long)hi << 32) | lo); }
__device__ __forceinline__ LAS unsigned char* uni_l(LAS unsigned char* p) { return (LAS unsigned char*)(unsigned)__builtin_amdgcn_readfirstlane((int)(unsigned)(size_t)p); }
__device__ __forceinline__ int uni_i(int v) { return __builtin_amdgcn_readfirstlane(v); }
struct PC { const float* const* in; float* out; unsigned char* ws; LAS unsigned char* lds; int wave, vcu, G; };
struct Frame {
    LAS unsigned char* lds;
    volatile LAS unsigned* MISC;
    gu32* ctl;
    int wave, vcu, G;
    unsigned char* ws;
};
__device__ __forceinline__ unsigned char* launder_p(unsigned char* p) { asm volatile("" : "+s"(p)); return p; }
__device__ __forceinline__ int launder_s(int v) { asm volatile("" : "+s"(v)); return v; }
__device__ __forceinline__ int launder_v(int v) { asm volatile("" : "+v"(v)); return v; }
__device__ __forceinline__ float wave_sum(float v) {
#pragma unroll
    for (int o = 1; o < 64; o <<= 1) v += __shfl_xor(v, o);
    return v;
}
__device__ __forceinline__ float wave_max(float v) {
#pragma unroll
    for (int o = 1; o < 64; o <<= 1) v = fmaxf(v, __shfl_xor(v, o));
    return v;
}

using pg8::Unit; using pg8::bf16_t;
#define LAUNDER2(a, b) asm volatile("" : "+v"(a), "+v"(b))
__device__ __forceinline__ float row_scale(const float* ss, int row) {
    const f32x4 a = *(const f32x4*)(ss + (size_t)row * 4);
    const float s = (a.x + a.y) + (a.z + a.w);
    return __builtin_amdgcn_rsqf(s * (1.0f / D) + EPS);
}
__device__ __forceinline__ float sigmoidf_(float x) { return __builtin_amdgcn_rcpf(1.0f + __expf(-x)); }
__device__ __forceinline__ pg8::u32x2 pack4(const f32x4 v) { pg8::u32x2 w; w.x = pg8::cvt_pk_bf16(v[0], v[1]); w.y = pg8::cvt_pk_bf16(v[2], v[3]); return w; }

struct EpiSwiglu {
    static constexpr bool PERM = true;
    bf16_t* O; const float* ss;
    __device__ __forceinline__ void operator()(const f32x4 (&acc)[2][2][4][2], const Unit& u, int wr, int wc, int fr_, int fq_) const {
        const int l_ = lane_id_v(); const int fr = l_ & 15, fq = l_ >> 4; (void)fr_; (void)fq_;
        int rb = wr * 64 + fr, cb = wc * 32 + 8 * fq; LAUNDER2(rb, cb);
        const int row0 = u.pm * 256 + rb, col0 = u.pn * 128 + cb;
#pragma unroll
        for (int ai = 0; ai < 2; ++ai)
#pragma unroll
            for (int m = 0; m < 4; ++m) { const int row = row0 + ai * 128 + m * 16;
                const f32x4 sq = *(const f32x4*)(ss + (size_t)row * 4); const float k = ((sq.x + sq.y) + (sq.z + sq.w)) * (1.0f / D) + EPS; const float c1 = __builtin_amdgcn_rsqf(k) * -1.4426950408889634f;
                pg8::u32x4 w;
                { const f32x4 a = acc[ai][0][m][0], b = acc[ai][1][m][0]; f32x4 o;
#pragma unroll
                  for (int i = 0; i < 4; ++i) o[i] = (a[i] * b[i]) * __builtin_amdgcn_rcpf(fmaf(__builtin_amdgcn_exp2f(a[i] * c1), k, k));
                  w.x = pg8::cvt_pk_bf16(o[0], o[1]); w.y = pg8::cvt_pk_bf16(o[2], o[3]); }
                { const f32x4 a = acc[ai][0][m][1], b = acc[ai][1][m][1]; f32x4 o;
#pragma unroll
                  for (int i = 0; i < 4; ++i) o[i] = (a[i] * b[i]) * __builtin_amdgcn_rcpf(fmaf(__builtin_amdgcn_exp2f(a[i] * c1), k, k));
                  w.z = pg8::cvt_pk_bf16(o[0], o[1]); w.w = pg8::cvt_pk_bf16(o[2], o[3]); }
                *(pg8::u32x4*)(O + (size_t)row * DFF + col0) = w; }
    }
};
struct EpiResid {
    static constexpr bool PERM = true;
    const float* base; float* out; bf16_t* hb; float* ss; float alpha; LAS float* P; int dry;
    __device__ __forceinline__ void operator()(const f32x4 (&acc)[2][2][4][2], const Unit& u, int wr, int wc, int fr_, int fq_) const {
        const int l_ = lane_id_v(); const int fr = l_ & 15, fq = l_ >> 4; (void)fr_; (void)fq_;
        int rb = wr * 64 + fr, cb = wc * 32 + 8 * fq; LAUNDER2(rb, cb);
        const int row0 = u.pm * 256 + rb, col0 = u.pn * 256 + cb;
#pragma unroll
        for (int ai = 0; ai < 2; ++ai)
#pragma unroll
          for (int mh = 0; mh < 2; ++mh) {
            f32x4 bs[2][2][2];
#pragma unroll
            for (int mm = 0; mm < 2; ++mm) { const size_t off = (size_t)(row0 + ai * 128 + (2 * mh + mm) * 16) * D + col0;
#pragma unroll
                for (int bj = 0; bj < 2; ++bj)
#pragma unroll
                    for (int n = 0; n < 2; ++n) bs[mm][bj][n] = *(const f32x4*)(base + off + bj * 128 + n * 4); }
#pragma unroll
            for (int mm = 0; mm < 2; ++mm) { const int m = 2 * mh + mm; const int row = row0 + ai * 128 + m * 16; const size_t off = (size_t)row * D + col0; float q = 0.f;
#pragma unroll
                for (int bj = 0; bj < 2; ++bj) { const f32x4 v0 = bs[mm][bj][0] + acc[ai][bj][m][0] * alpha, v1 = bs[mm][bj][1] + acc[ai][bj][m][1] * alpha;
                    if (!dry) { *(f32x4*)(out + off + bj * 128) = v0; *(f32x4*)(out + off + bj * 128 + 4) = v1;
                        pg8::u32x4 w; w.x = pg8::cvt_pk_bf16(v0[0], v0[1]); w.y = pg8::cvt_pk_bf16(v0[2], v0[3]); w.z = pg8::cvt_pk_bf16(v1[0], v1[1]); w.w = pg8::cvt_pk_bf16(v1[2], v1[3]);
                        *(pg8::u32x4*)(hb + off + bj * 128) = w; }
                    q += ((v0[0] * v0[0] + v0[1] * v0[1]) + (v0[2] * v0[2] + v0[3] * v0[3])) + ((v1[0] * v1[0] + v1[1] * v1[1]) + (v1[2] * v1[2] + v1[3] * v1[3])); }
                q += __shfl_xor(q, 16); q += __shfl_xor(q, 32);
                if (fq == 0) P[(rb + ai * 128 + m * 16) * 4 + wc] = q; }
            asm volatile("" ::: "memory"); }
        asm volatile("s_waitcnt lgkmcnt(0)" ::: "memory"); __builtin_amdgcn_s_barrier(); asm volatile("" ::: "memory");
        const int tid = (wr * 4 + wc) * 64 + fq * 16 + fr;
        if (tid < 256 && !dry) { const f32x4 p = *(const LAS f32x4*)(P + tid * 4); ss[(size_t)(u.pm * 256 + tid) * 4 + u.pn] = (p.x + p.y) + (p.z + p.w); }
    }
};
struct EpiPlainBf16 {
    static constexpr bool PERM = false;
    bf16_t* O; int ldo;
    __device__ __forceinline__ void operator()(const f32x4 (&acc)[2][2][4][2], const Unit& u, int wr, int wc, int fr_, int fq_) const {
        const int l_ = lane_id_v(); const int fr = l_ & 15, fq = l_ >> 4; (void)fr_; (void)fq_;
        int rb = wr * 64 + fr, cb = wc * 32 + 4 * fq; LAUNDER2(rb, cb);
        const int row0 = u.pm * 256 + rb, col0 = u.pn * 256 + cb;
#pragma unroll
        for (int ai = 0; ai < 2; ++ai)
#pragma unroll
            for (int m = 0; m < 4; ++m) { bf16_t* rowp = O + (size_t)(row0 + ai * 128 + m * 16) * ldo + col0;
#pragma unroll
                for (int bj = 0; bj < 2; ++bj)
#pragma unroll
                    for (int n = 0; n < 2; ++n) *(pg8::u32x2*)(rowp + bj * 128 + n * 16) = pack4(acc[ai][bj][m][n]); }
    }
};
struct EpiInProj {
    static constexpr bool PERM = true;
    const float* ss; bf16_t* qa; float* ckvraw; bf16_t* ik; float* iw; bf16_t* iqraw; bf16_t* z; bf16_t* qc; bf16_t* G;
    __device__ __forceinline__ void operator()(const f32x4 (&acc)[2][2][4][2], const Unit& u, int wr, int wc, int fr_, int fq_) const {
        const int l_ = lane_id_v(); const int fr = l_ & 15, fq = l_ >> 4; (void)fr_; (void)fq_;
        int rb = wr * 64 + fr, ct = wc * 32 + 8 * fq; LAUNDER2(rb, ct);
        const int row0 = u.pm * 256 + rb; const int pn = u.pn;
        if (pn == 4) {
#pragma unroll
            for (int ai = 0; ai < 2; ++ai)
#pragma unroll
                for (int m = 0; m < 4; ++m) { const int row = row0 + ai * 128 + m * 16; const float s = row_scale(ss, row);
#pragma unroll
                    for (int n = 0; n < 2; ++n) *(f32x4*)(ckvraw + (size_t)row * KVR + ct + n * 4) = acc[ai][0][m][n] * s;
                    if (wc == 0) { const f32x4 k0 = acc[ai][1][m][0] * s, k1 = acc[ai][1][m][1] * s; pg8::u32x4 w; w.x = pkh2(k0[0], k0[1]); w.y = pkh2(k0[2], k0[3]); w.z = pkh2(k1[0], k1[1]); w.w = pkh2(k1[2], k1[3]);
                        *(pg8::u32x4*)(ik + (size_t)row * IDIM + 8 * fq) = w; }
                    if (wc == 1 && fq == 0) { *(f32x4*)(iw + (size_t)row * IH) = acc[ai][1][m][0] * s; *(f32x4*)(iw + (size_t)row * IH + 4) = acc[ai][1][m][1] * s; } }
        } else {
            bf16_t* dst0; int ld; bool sig = false; const bool f16out = (pn == 5);
            if (pn < 4) { dst0 = qa + pn * 256; ld = 1024; } else if (pn == 5) { dst0 = iqraw; ld = 256; } else if (pn == 6) { dst0 = z; ld = 256; } else if (pn == 7) { dst0 = qc; ld = 256; } else { dst0 = G + (pn - 8) * 256; ld = 3072; sig = true; }
#pragma unroll
            for (int ai = 0; ai < 2; ++ai)
#pragma unroll
                for (int m = 0; m < 4; ++m) { const int row = row0 + ai * 128 + m * 16; const float s = row_scale(ss, row); bf16_t* rowp = dst0 + (size_t)row * ld + ct;
#pragma unroll
                    for (int bj = 0; bj < 2; ++bj) { f32x4 o0, o1;
                        if (sig) { const float c1 = s * -1.4426950408889634f;
#pragma unroll
                            for (int i = 0; i < 4; ++i) { o0[i] = __builtin_amdgcn_rcpf(1.0f + __builtin_amdgcn_exp2f(acc[ai][bj][m][0][i] * c1)); o1[i] = __builtin_amdgcn_rcpf(1.0f + __builtin_amdgcn_exp2f(acc[ai][bj][m][1][i] * c1)); } }
                        else { o0 = acc[ai][bj][m][0] * s; o1 = acc[ai][bj][m][1] * s; }
                        pg8::u32x4 wo;
                        if (f16out) { wo.x = pkh2(o0[0], o0[1]); wo.y = pkh2(o0[2], o0[3]); wo.z = pkh2(o1[0], o1[1]); wo.w = pkh2(o1[2], o1[3]); }
                        else { wo.x = pg8::cvt_pk_bf16(o0[0], o0[1]); wo.y = pg8::cvt_pk_bf16(o0[2], o0[3]); wo.z = pg8::cvt_pk_bf16(o1[0], o1[1]); wo.w = pg8::cvt_pk_bf16(o1[2], o1[3]); }
                        *(pg8::u32x4*)(rowp + bj * 128) = wo; } }
        }
    }
};
template <int MODE> struct EpiMerge {
    static constexpr bool PERM = true;
    bf16_t* Mg; const bf16_t* G;
    __device__ __forceinline__ void operator()(const f32x4 (&acc)[2][2][4][2], const Unit& u, int wr, int wc, int fr_, int fq_) const {
        const int l_ = lane_id_v(); const int fr = l_ & 15, fq = l_ >> 4; (void)fr_; (void)fq_;
        int rb = wr * 64 + fr, cb = wc * 32 + 8 * fq; LAUNDER2(rb, cb);
        const int row0 = u.pm * 256 + rb, col0 = u.pn * 256 + cb;
#pragma unroll
        for (int ai = 0; ai < 2; ++ai)
#pragma unroll
          for (int mh = 0; mh < 1; ++mh) {
            pg8::u32x4 gw[4][2], pw[4][2];
#pragma unroll
            for (int mm = 0; mm < 4; ++mm) { const int row = row0 + ai * 128 + mm * 16;
#pragma unroll
                for (int bj = 0; bj < 2; ++bj) { gw[mm][bj] = *(const pg8::u32x4*)(G + (size_t)row * 3072 + MODE * 1024 + col0 + bj * 128);
                    if (MODE > 0) pw[mm][bj] = *(const pg8::u32x4*)(Mg + (size_t)row * D + col0 + bj * 128); } }
#pragma unroll
            for (int mm = 0; mm < 4; ++mm) { const int m = mm; const int row = row0 + ai * 128 + m * 16;
#pragma unroll
                for (int bj = 0; bj < 2; ++bj) { const pg8::u32x4 g4 = gw[mm][bj];
                    f32x4 o0 = acc[ai][bj][m][0], o1 = acc[ai][bj][m][1];
                    o0[0] *= bflo(g4.x); o0[1] *= bfhi(g4.x); o0[2] *= bflo(g4.y); o0[3] *= bfhi(g4.y); o1[0] *= bflo(g4.z); o1[1] *= bfhi(g4.z); o1[2] *= bflo(g4.w); o1[3] *= bfhi(g4.w);
                    if (MODE > 0) { const pg8::u32x4 p4 = pw[mm][bj];
                        o0[0] += bflo(p4.x); o0[1] += bfhi(p4.x); o0[2] += bflo(p4.y); o0[3] += bfhi(p4.y); o1[0] += bflo(p4.z); o1[1] += bfhi(p4.z); o1[2] += bflo(p4.w); o1[3] += bfhi(p4.w); }
                    pg8::u32x4 w; w.x = pg8::cvt_pk_bf16(o0[0], o0[1]); w.y = pg8::cvt_pk_bf16(o0[2], o0[3]); w.z = pg8::cvt_pk_bf16(o1[0], o1[1]); w.w = pg8::cvt_pk_bf16(o1[2], o1[3]);
                    *(pg8::u32x4*)(Mg + (size_t)row * D + col0 + bj * 128) = w; } }
            asm volatile("" ::: "memory"); }
    }
};

template <class Map>
__device__ __forceinline__ void transpose_item(const float* W, int K, int N, const float* gain, bf16* WT, LAS float* scr, int item, int lane, Map map) {
    const int nblk = (N + 63) / 64, kb = item / nblk, nb = item % nblk, k0 = 64 * kb, n0 = 64 * nb;
    const int nn = n0 + 4 * (lane & 15); const bool nok = nn < N;
#pragma unroll 4
    for (int i = 0; i < 16; ++i) { const int kk = 4 * i + (lane >> 4); f32x4 v = nok ? *(const f32x4*)(W + (size_t)(k0 + kk) * N + nn) : (f32x4){0.f, 0.f, 0.f, 0.f};
        if (gain) v = v * gain[k0 + kk];
        *(LAS f32x4*)(scr + kk * 68 + 4 * (lane & 15)) = v; }
    LDS_WAIT(); asm volatile("" ::: "memory");
    const int c = lane & 7;
#pragma unroll
    for (int j = 0; j < 8; ++j) { const int n = (lane >> 3) + 8 * j; const LAS float* sp = scr + (8 * c) * 68 + n;
        v4u o; o.x = pk2(sp[0 * 68], sp[1 * 68]); o.y = pk2(sp[2 * 68], sp[3 * 68]); o.z = pk2(sp[4 * 68], sp[5 * 68]); o.w = pk2(sp[6 * 68], sp[7 * 68]);
        if (n0 + n < N) { const int dr = map(n0 + n); if (dr >= 0) *(GAS v4u*)(WT + (size_t)dr * K + k0 + 8 * c) = o; } }
    LDS_WAIT(); asm volatile("" ::: "memory");
}
struct MapId { int off; __device__ __forceinline__ int operator()(int n) const { return off + n; } };
struct MapSwiglu { __device__ __forceinline__ int operator()(int c) const { const int half = c >= DFF ? 1 : 0, j = c - half * DFF; return 256 * (j >> 7) + 128 * half + (j & 127); } };
struct MapInProj { __device__ __forceinline__ int operator()(int c) const {
    if (c < C_CKV) return -1;
    if (c < C_IQ) return 1024 + (c - C_CKV);
    if (c < C_IK) return 1280 + (c - C_IQ);
    if (c < C_IW) return 1152 + (c - C_IK);
    if (c < C_Z) return 1184 + (c - C_IW);
    if (c < C_QC) return 1536 + (c - C_Z);
    if (c < C_G) return 1792 + (c - C_QC);
    return 2048 + (c - C_G); } };
__device__ __forceinline__ void qlat_item(const float* win, const float* mixn, const float* wuk, bf16* WT, int item, int lane) {
    const int kc = item & 127, rh = (item >> 7) & 1, h = item >> 8; const int r = rh * 64 + lane;
    const f32x4* wp = (const f32x4*)(wuk + (size_t)r * (AH * AHD) + h * 64);
    float acc[8] = {0.f, 0.f, 0.f, 0.f, 0.f, 0.f, 0.f, 0.f};
#pragma unroll 1
    for (int dc = 0; dc < 4; ++dc) {
        const f32x4 w0 = wp[4 * dc], w1 = wp[4 * dc + 1], w2 = wp[4 * dc + 2], w3 = wp[4 * dc + 3];
#pragma unroll
        for (int kk = 0; kk < 8; ++kk) { const f32x4* ip = (const f32x4*)(win + (size_t)(kc * 8 + kk) * INW + h * 64 + 16 * dc);
            const f32x4 a0 = ip[0], a1 = ip[1], a2 = ip[2], a3 = ip[3];
            acc[kk] += (a0.x * w0.x + a0.y * w0.y + a0.z * w0.z + a0.w * w0.w) + (a1.x * w1.x + a1.y * w1.y + a1.z * w1.z + a1.w * w1.w)
                     + (a2.x * w2.x + a2.y * w2.y + a2.z * w2.z + a2.w * w2.w) + (a3.x * w3.x + a3.y * w3.y + a3.z * w3.z + a3.w * w3.w);
            if (kk & 1) asm volatile("" ::: "memory"); }
    }
    const f32x4 g0 = *(const f32x4*)(mixn + kc * 8), g1 = *(const f32x4*)(mixn + kc * 8 + 4);
    v4u w; w.x = pk2(acc[0] * g0.x, acc[1] * g0.y); w.y = pk2(acc[2] * g0.z, acc[3] * g0.w); w.z = pk2(acc[4] * g1.x, acc[5] * g1.y); w.w = pk2(acc[6] * g1.z, acc[7] * g1.w);
    *(GAS v4u*)(WT + (size_t)(h * 128 + r) * D + kc * 8) = w;
}
__device__ __forceinline__ void wafold_item(const float* wuv, const float* wba, bf16* WT, int item, int lane) {
    const int ng = item & 15, rg = (item >> 4) & 15, h = item >> 8; const int n = ng * 64 + lane, r0 = rg * 8;
    float acc[8] = {0.f, 0.f, 0.f, 0.f, 0.f, 0.f, 0.f, 0.f};
#pragma unroll 4
    for (int d = 0; d < 64; ++d) { const float wa = wba[(size_t)(h * 64 + d) * D + n];
#pragma unroll
        for (int j = 0; j < 8; ++j) acc[j] += wuv[(size_t)(r0 + j) * (AH * AHD) + h * 64 + d] * wa; }
    v4u w; w.x = pk2(acc[0], acc[1]); w.y = pk2(acc[2], acc[3]); w.z = pk2(acc[4], acc[5]); w.w = pk2(acc[6], acc[7]);
    *(GAS v4u*)(WT + (size_t)n * 1024 + h * 128 + r0) = w;
}
__device__ __forceinline__ int items_of(int K, int N) { return (K / 64) * ((N + 63) / 64); }

__device__ __forceinline__ void prep_layer_weights_body(const PC& F, int l) {
    struct { const float* const* in; } a{F.in};
    const int lane_ = lane_id_v();
    LAS float* scr = (LAS float*)(F.lds + RING_OFF + F.wave * 17408);
    const int gw = F.vcu * NWAVES + F.wave, NGW = F.G * NWAVES;
    const float* f1n = a.in[3] + (size_t)l * D; const float* f1in = a.in[4] + (size_t)l * D * 2 * DFF; const float* f1out = a.in[5] + (size_t)l * DFF * D;
    const float* mixn = a.in[6] + (size_t)l * D; const float* win = a.in[7] + (size_t)l * D * INW;
    const float* wba = a.in[15] + (size_t)l * AW * D; const float* wbb = a.in[16] + (size_t)l * PW_ * D; const float* wbc = a.in[17] + (size_t)l * CW * D;
    const float* wout = a.in[18] + (size_t)l * D * D;
    const float* f2n = a.in[19] + (size_t)l * D; const float* f2in = a.in[20] + (size_t)l * D * 2 * DFF; const float* f2out = a.in[21] + (size_t)l * DFF * D;
    unsigned char* ws = launder_p(F.ws);
    const float* wuk = a.in[9] + (size_t)l * KVR * AH * AHD; const float* wuv = a.in[10] + (size_t)l * KVR * AH * AHD;
    const int I0 = items_of(D, 2 * DFF), I1 = items_of(DFF, D), I2 = items_of(D, INW), I4 = items_of(PW_, D), I5 = items_of(CW, D), I6 = items_of(D, D);
    const int NIT = 2 * I0 + 2 * I1 + I2 + I4 + I5 + I6;
#pragma unroll 1
    for (int it = gw; it < NIT; it += NGW) {
        int r = it;
        if (r < I0) { transpose_item(f1in, D, 2 * DFF, f1n, (bf16*)(ws + WS_W1IN), scr, r, lane_, MapSwiglu{}); continue; } r -= I0;
        if (r < I0) { transpose_item(f2in, D, 2 * DFF, f2n, (bf16*)(ws + WS_W2IN), scr, r, lane_, MapSwiglu{}); continue; } r -= I0;
        if (r < I1) { transpose_item(f1out, DFF, D, nullptr, (bf16*)(ws + WS_W1OUT), scr, r, lane_, MapId{0}); continue; } r -= I1;
        if (r < I1) { transpose_item(f2out, DFF, D, nullptr, (bf16*)(ws + WS_W2OUT), scr, r, lane_, MapId{0}); continue; } r -= I1;
        if (r < I2) { transpose_item(win, D, INW, mixn, (bf16*)(ws + WS_WIN), scr, r, lane_, MapInProj{}); continue; } r -= I2;
        if (r < I4) { transpose_item(wbb, PW_, D, nullptr, (bf16*)(ws + WS_WB), scr, r, lane_, MapId{0}); continue; } r -= I4;
        if (r < I5) { transpose_item(wbc, CW, D, nullptr, (bf16*)(ws + WS_WC), scr, r, lane_, MapId{0}); continue; } r -= I5;
        transpose_item(wout, D, D, nullptr, (bf16*)(ws + WS_WOUT), scr, r, lane_, MapId{0});
    }
    { const float* wpool = a.in[11] + (size_t)l * 4 * 64 * 64; bf16* wpT = (bf16*)(ws + WS_WPT);
      for (int i = gw * 64 + lane_; i < 4 * 64 * 64; i += NGW * 64) { const int c = i & 63, d = (i >> 6) & 63, g = i >> 12; wpT[i] = (bf16)f2bf(wpool[(g * 64 + c) * 64 + d]); } }
    asm volatile("" ::: "memory");
#pragma unroll 1
    for (int it = gw; it < 2048; it += NGW) wafold_item(wuv, wba, (bf16*)(ws + WS_WA), it, lane_);
    asm volatile("" ::: "memory");
#pragma unroll 1
    for (int it = gw; it < 2048; it += NGW) qlat_item(win, mixn, wuk, (bf16*)(ws + WS_WIN), it, lane_);
}

__device__ __noinline__ void p0_prologue(const float* const* in_, float* out_, unsigned char* ws_, LAS unsigned char* lds_, int wave_, int vcu_, int G_) {
    const PC F{uni(in_), uni(out_), uni(ws_), uni_l(lds_), uni_i(wave_), uni_i(vcu_), uni_i(G_)}; struct { const float* const* in; } a{F.in};
    const int lane_ = lane_id_v();
    const int gw = F.vcu * NWAVES + F.wave, NGW = F.G * NWAVES;
    const float* x = a.in[0]; const float* mem = a.in[1];
    bf16* hb = (bf16*)(F.ws + WS_HB); float* ss = (float*)(F.ws + WS_SS); bf16* memn = (bf16*)(F.ws + WS_MEMN);
    for (int m = gw; m < M + MROWS; m += NGW) {
        const bool ismem = m >= M; const int r = ismem ? m - M : m;
        const GAS f32x4* xr = (const GAS f32x4*)((ismem ? mem : x) + (size_t)r * D) + lane_;
        f32x4 v[4]; float s = 0.f;
#pragma unroll
        for (int j = 0; j < 4; ++j) { v[j] = xr[64 * j]; s += (v[j].x * v[j].x + v[j].y * v[j].y) + (v[j].z * v[j].z + v[j].w * v[j].w); }
        s = wave_sum(s);
        float sc = 1.f;
        if (ismem) sc = 1.0f / sqrtf(s * (1.0f / D) + EPS);
        else if (lane_ < 4) ss[(size_t)r * 4 + lane_] = lane_ == 0 ? s : 0.f;
        GAS unsigned long long* o8 = (GAS unsigned long long*)((ismem ? memn : hb) + (size_t)r * D) + lane_;
#pragma unroll
        for (int j = 0; j < 4; ++j) o8[64 * j] = (unsigned long long)pk2(v[j].x * sc, v[j].y * sc) | ((unsigned long long)pk2(v[j].z * sc, v[j].w * sc) << 32);
    }
    LAS float* scr = (LAS float*)(F.lds + RING_OFF + F.wave * 17408);
    const int IM = items_of(D, 2 * CW);
    for (int it = gw; it < DEPTH * IM; it += NGW) { const int l = it / IM, r = it % IM;
        transpose_item(a.in[14] + (size_t)l * D * 2 * CW, D, 2 * CW, a.in[13] + (size_t)l * D, (bf16*)(F.ws + WS_WMEM), scr, r, lane_, MapId{l * 2 * CW}); }
    prep_layer_weights_body(F, 0);
}
__device__ __noinline__ void prep_layer_weights(const float* const* in_, float* out_, unsigned char* ws_, LAS unsigned char* lds_, int l, int wave_, int vcu_, int G_) {
    const PC F{uni(in_), uni(out_), uni(ws_), uni_l(lds_), uni_i(wave_), uni_i(vcu_), uni_i(G_)}; prep_layer_weights_body(F, uni_i(l));
}

__constant__ unsigned char T5_BUCKET[128] = {0, 1, 2, 3, 4, 5, 6, 7, 8, 9, 10, 11, 12, 13, 14, 15, 16, 16, 16, 17, 17, 18, 18, 18, 19, 19, 19, 20, 20, 20, 20, 21, 21, 21, 21, 22, 22, 22, 22, 22, 23, 23, 23, 23, 23, 23, 24, 24, 24, 24, 24, 24, 25, 25, 25, 25, 25, 25, 25, 26, 26, 26, 26, 26, 26, 26, 26, 27, 27, 27, 27, 27, 27, 27, 27, 27, 27, 28, 28, 28, 28, 28, 28, 28, 28, 28, 28, 29, 29, 29, 29, 29, 29, 29, 29, 29, 29, 29, 29, 30, 30, 30, 30, 30, 30, 30, 30, 30, 30, 30, 30, 30, 30, 31, 31, 31, 31, 31, 31, 31, 31, 31, 31, 31, 31, 31, 31, 31};

typedef short bf16x8_p __attribute__((ext_vector_type(8)));
__device__ __forceinline__ void prep_tokens(const float* const* in_, float* out_, unsigned char* ws_, LAS unsigned char* lds_, int l_, int wave_, int vcu_, int G_, int dry_) {
    const int dry = uni_i(dry_);
    const PC F{uni(in_), uni(out_), uni(ws_), uni_l(lds_), uni_i(wave_), uni_i(vcu_), uni_i(G_)}; struct { const float* const* in; } a{F.in}; const int l = uni_i(l_);
    unsigned char* ws = launder_p(F.ws);
    const float* ckvraw = (const float*)(ws + WS_CKVRAW); bf16* ckv = (bf16*)(ws + WS_CKV);
    const bf16* iqraw = (const bf16*)(ws + WS_IQRAW); bf16* iqf = (bf16*)(ws + WS_IQF); const float* iw = (const float*)(ws + WS_IW); unsigned* sgn = (unsigned*)(ws + WS_SGN);
    const bf16* z = (const bf16*)(ws + WS_Z); bf16* yb = (bf16*)(ws + WS_YB); bf16* qc = (bf16*)(ws + WS_QC);
    const bf16* memkv = (const bf16*)(ws + WS_MEMKV); const bf16* vT = (const bf16*)(ws + WS_VT); const bf16* wpT = (const bf16*)(ws + WS_WPT);
    const float* kvn = a.in[8] + (size_t)l * KVR; const float* pscale = a.in[12] + (size_t)l * PW_;
    const int lane = lane_id_v(), tid = F.wave * 64 + lane;
    const int tok = lane & 15, g4 = lane >> 4;
    LAS unsigned char* Ks = F.lds;
    LAS unsigned char* Vs = F.lds + 36864;
    for (int blk = F.vcu; blk < M / 128; blk += F.G) {
        const int rowb = blk * 128, b = rowb / SEQ, row0 = rowb + F.wave * 16;
#pragma unroll 1
        for (int tt = 0; tt < 16; ++tt) { const int row = row0 + tt;
            { const f32x2 v = *(const f32x2*)(ckvraw + (size_t)row * KVR + 2 * lane); const float q = wave_sum(v.x * v.x + v.y * v.y);
              const float rs = 1.0f / sqrtf(q * (1.0f / KVR) + EPS); const f32x2 g = *(const f32x2*)(kvn + 2 * lane);
              *(unsigned*)(ckv + (size_t)row * KVR + 2 * lane) = pk2(v.x * rs * g.x, v.y * rs * g.y); }
            { const float wv = iw[(size_t)row * IH + (lane >> 3)]; const float aw = fabsf(wv) * (1.0f / 16.0f);
              const v2u q = *(const v2u*)(iqraw + (size_t)row * 256 + 4 * lane);
              v2u o; o.x = pkh2(hlo(q.x) * aw, hhi(q.x) * aw); o.y = pkh2(hlo(q.y) * aw, hhi(q.y) * aw);
              *(v2u*)(iqf + (size_t)row * 256 + 4 * lane) = o;
              const unsigned long long bal = __ballot(wv < 0.f);
              unsigned mask = 0;
#pragma unroll
              for (int h = 0; h < 8; ++h) mask |= ((unsigned)(bal >> (8 * h)) & 1u) << h;
              if (lane == 0) sgn[row] = mask; } }
        { const int row = row0 + tok, spos = row % SEQ;
#pragma unroll 1
          for (int g = 0; g < 4; ++g) { const int w = 2 << g; const int cnt = (spos + 1) < w ? (spos + 1) : w; const float rc = 1.0f / (float)cnt;
              bf16x8_p pf[2];
#pragma unroll
              for (int ks = 0; ks < 2; ++ks) { const int c0 = g * 64 + 32 * ks + 8 * g4; float sum[8], z0[8];
#pragma unroll
                  for (int e = 0; e < 8; ++e) { sum[e] = 0.f; z0[e] = 0.f; }
                  for (int j = 0; j < w; ++j) { if (j < cnt) { const v4u v = *(const v4u*)(z + (size_t)(row - j) * 256 + c0);
                      const float f[8] = {bflo(v.x), bfhi(v.x), bflo(v.y), bfhi(v.y), bflo(v.z), bfhi(v.z), bflo(v.w), bfhi(v.w)};
#pragma unroll
                      for (int e = 0; e < 8; ++e) { sum[e] += f[e]; if (j == 0) z0[e] = f[e]; } } }
                  v4u pw; pw.x = pk2(sum[0] * rc - z0[0], sum[1] * rc - z0[1]); pw.y = pk2(sum[2] * rc - z0[2], sum[3] * rc - z0[3]); pw.z = pk2(sum[4] * rc - z0[4], sum[5] * rc - z0[5]); pw.w = pk2(sum[6] * rc - z0[6], sum[7] * rc - z0[7]);
                  pf[ks] = __builtin_bit_cast(bf16x8_p, pw); }
#pragma unroll
              for (int dt = 0; dt < 4; ++dt) { f32x4 acc = {0.f, 0.f, 0.f, 0.f};
#pragma unroll
                  for (int ks = 0; ks < 2; ++ks) { const bf16x8_p af = *(const bf16x8_p*)(wpT + (size_t)(g * 64 + 16 * dt + tok) * 64 + 32 * ks + 8 * g4); acc = __builtin_amdgcn_mfma_f32_16x16x32_bf16(af, pf[ks], acc, 0, 0, 0); }
                  const f32x4 ps = *(const f32x4*)(pscale + g * 64 + 16 * dt + 4 * g4);
                  v2u o; o.x = pk2(acc[0] * ps.x, acc[1] * ps.y); o.y = pk2(acc[2] * ps.z, acc[3] * ps.w);
                  *(v2u*)(yb + (size_t)row * 256 + g * 64 + 16 * dt + 4 * g4) = o; } } }
#pragma unroll 1
        for (int h = 0; h < CH; ++h) {
            __syncthreads();
#pragma unroll
            for (int e = 0; e < 4; ++e) { const int i = tid + 512 * e;
                { const int m = i >> 3, c = i & 7; const v4u v = *(const v4u*)(memkv + (size_t)(b * NMEM + m) * 2048 + l * 512 + h * 64 + c * 8); *(LAS v4u*)(Ks + m * 144 + c * 16) = v; }
                { const int d = i >> 5, c = i & 31; const v4u v = *(const v4u*)(vT + (size_t)(l * 512 + 256 + h * 64 + d) * MROWS + b * NMEM + c * 8); *(LAS v4u*)(Vs + d * 528 + c * 16) = v; } }
            LDS_WAIT(); __syncthreads();
            const int row = row0 + tok;
            bf16x8_p qf[2];
#pragma unroll
            for (int ks = 0; ks < 2; ++ks) qf[ks] = *(const bf16x8_p*)(qc + (size_t)row * 256 + h * 64 + 32 * ks + 8 * g4);
            f32x4 S[16]; float mx = -1e30f;
#pragma unroll
            for (int mt = 0; mt < 16; ++mt) { f32x4 acc = {0.f, 0.f, 0.f, 0.f};
#pragma unroll
                for (int ks = 0; ks < 2; ++ks) { const bf16x8_p kf = *(const LAS bf16x8_p*)(Ks + (16 * mt + tok) * 144 + (4 * ks + g4) * 16); acc = __builtin_amdgcn_mfma_f32_16x16x32_bf16(kf, qf[ks], acc, 0, 0, 0); }
                S[mt] = acc; mx = fmaxf(mx, fmaxf(fmaxf(acc[0], acc[1]), fmaxf(acc[2], acc[3]))); if ((mt & 3) == 3) __builtin_amdgcn_sched_barrier(0); }
            mx = fmaxf(mx, __shfl_xor(mx, 16)); mx = fmaxf(mx, __shfl_xor(mx, 32));
            float sm = 0.f;
#pragma unroll
            for (int mt = 0; mt < 16; ++mt)
#pragma unroll
                for (int r = 0; r < 4; ++r) { const float p = __expf((S[mt][r] - mx) * 0.125f); S[mt][r] = p; sm += p; }
            sm += __shfl_xor(sm, 16); sm += __shfl_xor(sm, 32);
            const float inv = 1.0f / sm;
            f32x4 oacc[4];
#pragma unroll
            for (int dt = 0; dt < 4; ++dt) oacc[dt] = (f32x4){0.f, 0.f, 0.f, 0.f};
#pragma unroll
            for (int kk = 0; kk < 8; ++kk) { v4u pw; pw.x = pg8::cvt_pk_bf16(S[2 * kk][0], S[2 * kk][1]); pw.y = pg8::cvt_pk_bf16(S[2 * kk][2], S[2 * kk][3]); pw.z = pg8::cvt_pk_bf16(S[2 * kk + 1][0], S[2 * kk + 1][1]); pw.w = pg8::cvt_pk_bf16(S[2 * kk + 1][2], S[2 * kk + 1][3]);
                const bf16x8_p pfr = __builtin_bit_cast(bf16x8_p, pw);
#pragma unroll
                for (int dt = 0; dt < 4; ++dt) { const LAS unsigned char* vp = Vs + (16 * dt + tok) * 528 + (32 * kk + 4 * g4) * 2;
                    const v2u lo = *(const LAS v2u*)vp, hi = *(const LAS v2u*)(vp + 32);
                    v4u vw; vw.x = lo.x; vw.y = lo.y; vw.z = hi.x; vw.w = hi.y;
                    oacc[dt] = __builtin_amdgcn_mfma_f32_16x16x32_bf16(__builtin_bit_cast(bf16x8_p, vw), pfr, oacc[dt], 0, 0, 0); }
                __builtin_amdgcn_sched_barrier(0); }
#pragma unroll
            for (int dt = 0; dt < 4; ++dt) { v2u o; o.x = pk2(oacc[dt][0] * inv, oacc[dt][1] * inv); o.y = pk2(oacc[dt][2] * inv, oacc[dt][3] * inv);
                if (!dry) *(v2u*)(qc + (size_t)row * 256 + h * 64 + 16 * dt + 4 * g4) = o; else asm volatile("" :: "v"(o.x), "v"(o.y)); }
        }
    }
    __syncthreads();
}

__device__ __forceinline__ unsigned key_of(float s) { const unsigned u = __builtin_bit_cast(unsigned, s); return (u & 0x80000000u) ? ~u : (u | 0x80000000u); }

typedef short bf16x8_t __attribute__((ext_vector_type(8)));
typedef short s16x4_t __attribute__((ext_vector_type(4)));
__device__ __forceinline__ void glds16(const void* gsrc, unsigned lds_dst) { unsigned keep;
    asm volatile("s_mov_b32 %0, m0\n\ts_mov_b32 m0, %2\n\ts_nop 0\n\tglobal_load_lds_dwordx4 %1, off\n\ts_mov_b32 m0, %0" : "=&s"(keep) : "v"(gsrc), "s"(lds_dst) : "memory"); }
typedef float f32x16 __attribute__((ext_vector_type(16)));
constexpr int SEL_CAP = 256;
constexpr int HSTR = 264;
constexpr int SL_HIST = 0, SL_SEL = 0, SL_CS = 32768, SL_CI = 98304, SL_KEYS = 131072, SL_ST = 147456;

#define SEL_DECLS \
    LAS unsigned char* const lds = uni_l(lds_); const int wave = uni_i(wave_), b = uni_i(b_), ub = uni_i(ub_); unsigned char* ws = uni(ws_); \
    const bf16* iqf = (const bf16*)(ws + WS_IQF); const unsigned* sgn = (const unsigned*)(ws + WS_SGN); const bf16* ik = (const bf16*)(ws + WS_IK); \
    const int lane = lane_id_v(), tid = wave * 64 + lane; const int kl = lane & 31, c5 = lane >> 5; \
    LAS unsigned* hist = (LAS unsigned*)(lds + SL_HIST); LAS unsigned short* lsel = (LAS unsigned short*)(lds + SL_SEL); LAS float* lcs = (LAS float*)(lds + SL_CS); \
    LAS unsigned short* lci = (LAS unsigned short*)(lds + SL_CI); LAS unsigned* st = (LAS unsigned*)(lds + SL_ST); LAS float* stf = (LAS float*)(lds + SL_ST); \
    const int t0 = ub * 64; const int q0 = b * SEQ + t0; const bf16* ikb = ik + (size_t)b * SEQ * IDIM; const int ntile = (t0 + 64 + 127) >> 7; \
    (void)hist; (void)lsel; (void)lcs; (void)lci; (void)stf; (void)tid;
#define SEL_LOAD_A \
    bf16x8_t af[2][2]; float sgc[2][16]; \
    { const int i = kl, a_ = i >> 3, cc_ = (i >> 2) & 1, e_ = i & 3; const int qq_ = 2 * cc_ + (a_ >> 1), hh_ = 4 * (a_ & 1) + e_; \
      _Pragma("unroll") for (int rt = 0; rt < 2; ++rt) { const unsigned flip_ = ((sgn[q0 + 8 * wave + 4 * rt + qq_] >> hh_) & 1u) ? 0x80008000u : 0u;     \
          _Pragma("unroll") for (int ks = 0; ks < 2; ++ks) { v4u w_ = *(const v4u*)(iqf + (size_t)(q0 + 8 * wave + 4 * rt + qq_) * 256 + hh_ * 32 + 16 * ks + 8 * c5); \
              w_.x ^= flip_; w_.y ^= flip_; w_.z ^= flip_; w_.w ^= flip_; af[rt][ks] = __builtin_bit_cast(bf16x8_t, w_); } } \
      _Pragma("unroll") for (int rt = 0; rt < 2; ++rt) _Pragma("unroll") for (int u = 0; u < 2; ++u) { const unsigned m_ = sgn[q0 + 8 * wave + 4 * rt + 2 * c5 + u]; \
          _Pragma("unroll") for (int h = 0; h < 8; ++h) sgc[rt][8 * u + h] = ((m_ >> h) & 1u) ? -__builtin_inff() : __builtin_inff(); } }
#define SEL_STAGE(kt_) do { const int key_ = 16 * wave + (lane >> 2); const int ch_ = (lane & 3) ^ ((key_ >> 2) & 3); \
    glds16(ikb + (size_t)(128 * (kt_) + key_) * IDIM + ch_ * 8, (unsigned)__builtin_amdgcn_readfirstlane((int)(unsigned)(size_t)(lds + SL_KEYS + ((kt_) & 1) * 8192 + wave * 1024))); } while (0)
#define SEL_MMA(acc_, rt_, kh_) do { acc_ = (f32x16){0.f,0.f,0.f,0.f,0.f,0.f,0.f,0.f,0.f,0.f,0.f,0.f,0.f,0.f,0.f,0.f}; \
    acc_ = __builtin_amdgcn_mfma_f32_32x32x16_f16(__builtin_bit_cast(f16x8_t, af[rt_][0]), __builtin_bit_cast(f16x8_t, bfr_[kh_][0]), acc_, 0, 0, 0); \
    acc_ = __builtin_amdgcn_mfma_f32_32x32x16_f16(__builtin_bit_cast(f16x8_t, af[rt_][1]), __builtin_bit_cast(f16x8_t, bfr_[kh_][1]), acc_, 0, 0, 0); } while (0)
#define SEL_SUM(acc_, rt_, kh_) do { _Pragma("unroll") for (int u = 0; u < 2; ++u) { float s_ = 0.f; \
    _Pragma("unroll") for (int h = 0; h < 8; ++h) s_ += __builtin_amdgcn_fmed3f(acc_[8 * u + h], 0.f, sgc[rt_][8 * u + h]); \
    sc[rt_][kh_][u] = s_; } } while (0)
#define SEL_SCORES(kt_) do { const LAS unsigned char* kb_ = lds + SL_KEYS + ((kt_) & 1) * 8192; bf16x8_t bfr_[4][2]; \
    _Pragma("unroll") for (int kh = 0; kh < 4; ++kh) { const int key_ = 32 * kh + kl; \
        bfr_[kh][0] = *(const LAS bf16x8_t*)(kb_ + key_ * 64 + 16 * ((0 + c5) ^ ((key_ >> 2) & 3))); \
        bfr_[kh][1] = *(const LAS bf16x8_t*)(kb_ + key_ * 64 + 16 * ((2 + c5) ^ ((key_ >> 2) & 3))); } \
    f32x16 accA_, accB_; \
    SEL_MMA(accA_, 0, 0); \
    SEL_MMA(accB_, 1, 0); __builtin_amdgcn_sched_barrier(0); SEL_SUM(accA_, 0, 0); __builtin_amdgcn_sched_barrier(0); \
    SEL_MMA(accA_, 0, 1); __builtin_amdgcn_sched_barrier(0); SEL_SUM(accB_, 1, 0); __builtin_amdgcn_sched_barrier(0); \
    SEL_MMA(accB_, 1, 1); __builtin_amdgcn_sched_barrier(0); SEL_SUM(accA_, 0, 1); __builtin_amdgcn_sched_barrier(0); \
    SEL_MMA(accA_, 0, 2); __builtin_amdgcn_sched_barrier(0); SEL_SUM(accB_, 1, 1); __builtin_amdgcn_sched_barrier(0); \
    SEL_MMA(accB_, 1, 2); __builtin_amdgcn_sched_barrier(0); SEL_SUM(accA_, 0, 2); __builtin_amdgcn_sched_barrier(0); \
    SEL_MMA(accA_, 0, 3); __builtin_amdgcn_sched_barrier(0); SEL_SUM(accB_, 1, 2); __builtin_amdgcn_sched_barrier(0); \
    SEL_MMA(accB_, 1, 3); __builtin_amdgcn_sched_barrier(0); SEL_SUM(accA_, 0, 3); __builtin_amdgcn_sched_barrier(0); \
    SEL_SUM(accB_, 1, 3); } while (0)
#define SEL_BOUNDARY(FINAL) do { \
    const int qq = tid >> 3, part = tid & 7; const LAS v4u* hp = (const LAS v4u*)(hist + qq * HSTR + 32 * part); \
    unsigned bins[32]; \
    _Pragma("unroll") for (int i = 0; i < 8; ++i) { const v4u v = hp[i]; bins[4 * i] = v.x; bins[4 * i + 1] = v.y; bins[4 * i + 2] = v.z; bins[4 * i + 3] = v.w; } \
    unsigned ps = 0; \
    _Pragma("unroll") for (int i = 0; i < 32; ++i) ps += bins[i]; \
    unsigned v = ps, tt; \
    tt = __shfl_down(v, 1, 8); if (part + 1 < 8) v += tt; \
    tt = __shfl_down(v, 2, 8); if (part + 2 < 8) v += tt; \
    tt = __shfl_down(v, 4, 8); if (part + 4 < 8) v += tt; \
    unsigned cacc = v - ps; \
    if (cacc < (unsigned)TOPK && v >= (unsigned)TOPK) { int bsel = 0; unsigned na = 0, cb = 0; bool found = false; \
        _Pragma("unroll") for (int i = 31; i >= 0; --i) { const bool hit = !found && (cacc + bins[i] >= (unsigned)TOPK); if (hit) { bsel = i; na = cacc; cb = bins[i]; found = true; } cacc += bins[i]; } \
        st[128 + qq] = (unsigned)(32 * part + bsel); if (FINAL) { st[192 + qq] = na; st[256 + qq] = cb; st[448 + qq] = cb > (unsigned)SEL_CAP ? 1u : 0u; } } } while (0)

__device__ __forceinline__ void sel_pass1(unsigned char* ws_, LAS unsigned char* lds_, int wave_, int b_, int ub_) {
    SEL_DECLS
    unsigned short* sel = (unsigned short*)(ws + WS_SEL);
    __syncthreads();
    if (ub < 4) {
        for (int i = tid; i < 64 * TOPK; i += NWAVES * 64) { const int qq = i >> 8, sl = i & 255; sel[(size_t)(q0 + qq) * TOPK + sl] = (unsigned short)(sl <= t0 + qq ? sl : 0); }
        if (tid == 0) st[512] = 1u;
        asm volatile("s_waitcnt vmcnt(0) lgkmcnt(0)" ::: "memory"); __syncthreads();
        return;
    }
    SEL_LOAD_A
    for (int i = tid; i < 64 * HSTR; i += NWAVES * 64) hist[i] = 0u;
    if (tid < 64) { st[128 + tid] = 0u; st[448 + tid] = 0u; }
    if (tid == 0) st[512] = 0u;
    float sc[2][4][2];
    float scl[2][2]; int bcur[2][2];
#pragma unroll
    for (int rt = 0; rt < 2; ++rt)
#pragma unroll
        for (int u = 0; u < 2; ++u) { scl[rt][u] = 0.f; bcur[rt][u] = 0; }
    SEL_STAGE(0);
#pragma unroll 1
    for (int kt = 0; kt < ntile; ++kt) {
        asm volatile("s_waitcnt vmcnt(0) lgkmcnt(0)" ::: "memory"); __syncthreads();
        if (kt > 0 && (kt & 3) == 0) {
            SEL_BOUNDARY(false);
            asm volatile("s_waitcnt lgkmcnt(0)" ::: "memory"); __syncthreads();
#pragma unroll
            for (int rt = 0; rt < 2; ++rt)
#pragma unroll
                for (int u = 0; u < 2; ++u) bcur[rt][u] = (int)st[128 + 8 * wave + 4 * rt + 2 * c5 + u];
        }
        if (kt + 1 < ntile) SEL_STAGE(kt + 1);
        SEL_SCORES(kt);
        if (kt == 0) {
#pragma unroll
            for (int rt = 0; rt < 2; ++rt)
#pragma unroll
                for (int u = 0; u < 2; ++u) { float mx = 0.f;
#pragma unroll
                    for (int kh = 0; kh < 4; ++kh) mx = fmaxf(mx, fabsf(sc[rt][kh][u]));
#pragma unroll
                    for (int o = 1; o < 32; o <<= 1) mx = fmaxf(mx, __shfl_xor(mx, o));
                    const float R = mx > 0.f ? mx : 1.0f;
                    scl[rt][u] = 128.0f / R;
                    if (kl == 0) stf[8 * wave + 4 * rt + 2 * c5 + u] = scl[rt][u]; }
        }
        const bool masked = 128 * kt + 127 > t0;
        if (masked) {
#pragma unroll
        for (int rt = 0; rt < 2; ++rt)
#pragma unroll
            for (int u = 0; u < 2; ++u) { const int qq = 8 * wave + 4 * rt + 2 * c5 + u; const int lim = t0 + qq - 128 * kt - kl;
#pragma unroll
                for (int kh = 0; kh < 4; ++kh) { const float fb = __builtin_amdgcn_fmed3f(fmaf(sc[rt][kh][u], scl[rt][u], 128.0f), 0.f, 255.f);
                    if (fb >= (float)bcur[rt][u] && 32 * kh <= lim) (void)__hip_atomic_fetch_add(hist + qq * HSTR + (int)fb, 1u, __ATOMIC_RELAXED, __HIP_MEMORY_SCOPE_WORKGROUP); } }
        } else {
#pragma unroll
        for (int rt = 0; rt < 2; ++rt)
#pragma unroll
            for (int u = 0; u < 2; ++u) { const int qq = 8 * wave + 4 * rt + 2 * c5 + u;
#pragma unroll
                for (int kh = 0; kh < 4; ++kh) { const float fb = __builtin_amdgcn_fmed3f(fmaf(sc[rt][kh][u], scl[rt][u], 128.0f), 0.f, 255.f);
                    if (fb >= (float)bcur[rt][u]) (void)__hip_atomic_fetch_add(hist + qq * HSTR + (int)fb, 1u, __ATOMIC_RELAXED, __HIP_MEMORY_SCOPE_WORKGROUP); } }
        }
    }
    asm volatile("s_waitcnt vmcnt(0) lgkmcnt(0)" ::: "memory"); __syncthreads();
    SEL_BOUNDARY(true);
    if (tid < 64) { st[320 + tid] = 0u; st[384 + tid] = 0u; }
    asm volatile("s_waitcnt lgkmcnt(0)" ::: "memory"); __syncthreads();
}
__device__ __forceinline__ void sel_pass2(unsigned char* ws_, LAS unsigned char* lds_, int wave_, int b_, int ub_) {
    SEL_DECLS
    if (st[512] != 0u) return;
    if (tid < 64) { st[320 + tid] = 0u; st[384 + tid] = 0u; }
    SEL_LOAD_A
    float sc[2][4][2];
    float scl[2][2]; int bcur[2][2];
#pragma unroll
    for (int rt = 0; rt < 2; ++rt)
#pragma unroll
        for (int u = 0; u < 2; ++u) { const int qq = 8 * wave + 4 * rt + 2 * c5 + u; scl[rt][u] = stf[qq]; bcur[rt][u] = (int)st[128 + qq]; }
    SEL_STAGE(0);
#pragma unroll 1
    for (int kt = 0; kt < ntile; ++kt) {
        asm volatile("s_waitcnt vmcnt(0) lgkmcnt(0)" ::: "memory"); __syncthreads();
        if (kt + 1 < ntile) SEL_STAGE(kt + 1);
        SEL_SCORES(kt);
        const bool masked = 128 * kt + 127 > t0;
        float fbv[2][2][4];
#pragma unroll
        for (int rt = 0; rt < 2; ++rt)
#pragma unroll
            for (int u = 0; u < 2; ++u)
#pragma unroll
                for (int kh = 0; kh < 4; ++kh) fbv[rt][u][kh] = __builtin_amdgcn_fmed3f(fmaf(sc[rt][kh][u], scl[rt][u], 128.0f), 0.f, 255.f);
        if (masked) {
#pragma unroll
            for (int rt = 0; rt < 2; ++rt)
#pragma unroll
                for (int u = 0; u < 2; ++u) { const int lim = t0 + (8 * wave + 4 * rt + 2 * c5 + u) - 128 * kt - kl;
#pragma unroll
                    for (int kh = 0; kh < 4; ++kh) fbv[rt][u][kh] = 32 * kh <= lim ? fbv[rt][u][kh] : -1.0f; }
        }
        unsigned basea[2][2], basec[2][2];
#pragma unroll
        for (int rt = 0; rt < 2; ++rt)
#pragma unroll
            for (int u = 0; u < 2; ++u) { const int qq = 8 * wave + 4 * rt + 2 * c5 + u; unsigned na_ = 0u, nk_ = 0u; const float bc0 = (float)bcur[rt][u], bc1 = (float)(bcur[rt][u] + 1);
#pragma unroll
                for (int kh = 0; kh < 4; ++kh) { const float fb = fbv[rt][u][kh]; na_ += fb >= bc1 ? 1u : 0u; nk_ += fb >= bc0 ? 1u : 0u; }
                unsigned base_ = 0u;
                if (nk_) base_ = __hip_atomic_fetch_add(st + 320 + qq, na_ + ((nk_ - na_) << 16), __ATOMIC_RELAXED, __HIP_MEMORY_SCOPE_WORKGROUP);
                basea[rt][u] = base_ & 0xffffu; basec[rt][u] = base_ >> 16; }
#pragma unroll
        for (int rt = 0; rt < 2; ++rt)
#pragma unroll
            for (int u = 0; u < 2; ++u) { const int qq = 8 * wave + 4 * rt + 2 * c5 + u; unsigned sa = basea[rt][u], scn = basec[rt][u]; const float bc0 = (float)bcur[rt][u], bc1 = (float)(bcur[rt][u] + 1);
#pragma unroll
                for (int kh = 0; kh < 4; ++kh) { const int kpos = 128 * kt + 32 * kh + kl; const float fb = fbv[rt][u][kh];
                    const bool pa = fb >= bc1, pc = fb >= bc0 && !pa;
                    if (pa) lsel[qq * 256 + (sa < (unsigned)(TOPK - 1) ? sa : (unsigned)(TOPK - 1))] = (unsigned short)kpos;
                    if (pc) { const unsigned sl = scn < (unsigned)(SEL_CAP - 1) ? scn : (unsigned)(SEL_CAP - 1); lcs[qq * SEL_CAP + sl] = sc[rt][kh][u]; lci[qq * SEL_CAP + sl] = (unsigned short)kpos; }
                    sa += pa ? 1u : 0u; scn += pc ? 1u : 0u; } }
    }
    asm volatile("s_waitcnt vmcnt(0) lgkmcnt(0)" ::: "memory"); __syncthreads();
}
__device__ __forceinline__ void sel_resolve(unsigned char* ws_, LAS unsigned char* lds_, int wave_, int b_, int ub_, int wg_, int first_) {
    SEL_DECLS
    const int wg = uni_i(wg_), first = uni_i(first_);
    unsigned short* sel = (unsigned short*)(ws + WS_SEL);
    gu32* slowl = (gu32*)(ws + WS_CTL + 65536) + (size_t)wg * 132;
    if (first && tid == 0) __hip_atomic_store(slowl, 0u, RLX_AGENT);
    if (st[512] != 0u) return;
#pragma unroll 1
    for (int qi = 0; qi < 8; ++qi) { const int qq = 8 * wave + qi; const int q = q0 + qq;
        const int na = (int)st[192 + qq], need = TOPK - na; int C = (int)(st[320 + qq] >> 16); C = C < SEL_CAP ? C : SEL_CAP;
        const bool slow = st[448 + qq] != 0u;
        if (!slow) {
            LAS unsigned* sh = (LAS unsigned*)(lds + SL_KEYS + wave * 2048); LAS float* sls = (LAS float*)(lds + SL_KEYS + wave * 2048 + 256); LAS unsigned short* sli = (LAS unsigned short*)(lds + SL_KEYS + wave * 2048 + 1280);
            const float sclq = stf[qq]; const float fbase = (float)(int)st[128 + qq];
            sh[lane] = 0u;
            float cs[SEL_CAP / 64]; int ci[SEL_CAP / 64], sb[SEL_CAP / 64];
#pragma unroll
            for (int e = 0; e < SEL_CAP / 64; ++e) { const int i = lane + 64 * e; cs[e] = 0.f; ci[e] = 0; sb[e] = -1;
                if (i < C) { cs[e] = lcs[qq * SEL_CAP + i]; ci[e] = lci[qq * SEL_CAP + i];
                    const float fr_ = (fmaf(cs[e], sclq, 128.0f) - fbase) * 64.0f; sb[e] = (int)__builtin_amdgcn_fmed3f(fr_, 0.f, 63.f); } }
            LDS_WAIT();
#pragma unroll
            for (int e = 0; e < SEL_CAP / 64; ++e) if (sb[e] >= 0) (void)__hip_atomic_fetch_add(sh + sb[e], 1u, __ATOMIC_RELAXED, __HIP_MEMORY_SCOPE_WORKGROUP);
            LDS_WAIT();
            const unsigned cl = sh[lane];
            unsigned v = cl, tt;
            tt = __shfl_down(v, 1); if (lane + 1 < 64) v += tt;
            tt = __shfl_down(v, 2); if (lane + 2 < 64) v += tt;
            tt = __shfl_down(v, 4); if (lane + 4 < 64) v += tt;
            tt = __shfl_down(v, 8); if (lane + 8 < 64) v += tt;
            tt = __shfl_down(v, 16); if (lane + 16 < 64) v += tt;
            tt = __shfl_down(v, 32); if (lane + 32 < 64) v += tt;
            const unsigned ab_ = v - cl;
            const unsigned long long cross = __ballot(ab_ < (unsigned)need && v >= (unsigned)need);
            const int sstar = cross ? (int)__builtin_ctzll(cross) : 0;
            const int na2 = (int)__shfl(ab_, sstar);
            const int need2 = need - na2;
            int base = na; int nsub = 0;
#pragma unroll
            for (int e = 0; e < SEL_CAP / 64; ++e) { const bool up = sb[e] > sstar; const bool eq = sb[e] == sstar;
                const unsigned long long bu = __ballot(up), be = __ballot(eq);
                const unsigned long long lt = (lane == 0) ? 0ull : (~0ull >> (64 - lane));
                if (up) lsel[qq * 256 + base + (int)__builtin_popcountll(bu & lt)] = (unsigned short)ci[e];
                if (eq) { const int p_ = nsub + (int)__builtin_popcountll(be & lt); sls[p_] = cs[e]; sli[p_] = (unsigned short)ci[e]; }
                base += (int)__builtin_popcountll(bu); nsub += (int)__builtin_popcountll(be); }
            LDS_WAIT();
#pragma unroll 1
            for (int i0 = 0; i0 < nsub; i0 += 64) { const int i = i0 + lane;
                if (i < nsub) { const float si = sls[i]; const int ii = sli[i]; int rank = 0;
                    for (int jx = 0; jx < nsub; ++jx) { const float sj = sls[jx]; const int ij = sli[jx]; rank += (sj > si || (sj == si && ij < ii)) ? 1 : 0; }
                    if (rank < need2) lsel[qq * 256 + na + na2 + rank] = (unsigned short)ii; } }
            LDS_WAIT();
            *(v2u*)(sel + (size_t)q * TOPK + 4 * lane) = *(const LAS v2u*)(lsel + qq * 256 + 4 * lane);
        }
    }
    __syncthreads();
    if (tid == 0) { unsigned n = first ? 0u : __hip_atomic_load(slowl, RLX_AGENT);
        for (int qq = 0; qq < 64; ++qq) if (st[448 + qq] != 0u) { if (n < 128u) { __hip_atomic_store(slowl + 1 + n, (unsigned)(q0 + qq), RLX_AGENT); ++n; } }
        __hip_atomic_store(slowl, n, RLX_AGENT); }
    asm volatile("s_waitcnt vmcnt(0)" ::: "memory");
    __syncthreads();
}
#undef SEL_DECLS
#undef SEL_LOAD_A
#undef SEL_STAGE
#undef SEL_SCORES
#undef SEL_MMA
#undef SEL_SUM
#undef SEL_BOUNDARY
__device__ __forceinline__ void dsa_select_slow(unsigned char* ws_, LAS unsigned char* lds_, int wave_, int wg_) {
    LAS unsigned char* const lds = uni_l(lds_); const int wave = uni_i(wave_), wg = uni_i(wg_);
    unsigned char* ws = uni(ws_);
    const bf16* iqf = (const bf16*)(ws + WS_IQF); const unsigned* sgn = (const unsigned*)(ws + WS_SGN); const bf16* ik = (const bf16*)(ws + WS_IK);
    unsigned short* sel = (unsigned short*)(ws + WS_SEL);
    gu32* slowl = (gu32*)(ws + WS_CTL + 65536) + (size_t)wg * 132;
    const int lane = lane_id_v(), tid = wave * 64 + lane; const int kl = lane & 31, c5 = lane >> 5;
    LAS unsigned* keys = (LAS unsigned*)lds;
    LAS unsigned* hist = (LAS unsigned*)(lds + 32768);
    LAS unsigned* ctl = (LAS unsigned*)(lds + 40960);
    const int nq = (int)__builtin_amdgcn_readfirstlane(__hip_atomic_load(slowl, RLX_AGENT));
#pragma unroll 1
    for (int k = 0; k < nq; ++k) {
        const int q = (int)__builtin_amdgcn_readfirstlane(__hip_atomic_load(slowl + 1 + k, RLX_AGENT));
        const int b = q / SEQ, t = q % SEQ, n = t + 1;
        const bf16* ikb = ik + (size_t)b * SEQ * IDIM;
        __syncthreads();
        bf16x8_t af[2]; float sgc[8];
        { const int i = kl, a_ = i >> 3, e_ = i & 3; const int hh_ = 4 * (a_ & 1) + e_; const unsigned m_ = sgn[q];
          const unsigned flip_ = ((m_ >> hh_) & 1u) ? 0x80008000u : 0u;
#pragma unroll
          for (int ks = 0; ks < 2; ++ks) { v4u w_ = *(const v4u*)(iqf + (size_t)q * 256 + hh_ * 32 + 16 * ks + 8 * c5); w_.x ^= flip_; w_.y ^= flip_; w_.z ^= flip_; w_.w ^= flip_; af[ks] = __builtin_bit_cast(bf16x8_t, w_); }
#pragma unroll
          for (int h = 0; h < 8; ++h) sgc[h] = ((m_ >> h) & 1u) ? -__builtin_inff() : __builtin_inff(); }
#pragma unroll 1
        for (int kb0 = wave; kb0 * 32 < n; kb0 += 4 * NWAVES) {
            bf16x8_t kb_[4][2];
#pragma unroll
            for (int j = 0; j < 4; ++j) { int key = 32 * (kb0 + j * NWAVES) + kl; key = key < SEQ ? key : SEQ - 1;
                kb_[j][0] = *(const bf16x8_t*)(ikb + (size_t)key * IDIM + 8 * c5); kb_[j][1] = *(const bf16x8_t*)(ikb + (size_t)key * IDIM + 16 + 8 * c5); }
#pragma unroll
            for (int j = 0; j < 4; ++j) { const int key = 32 * (kb0 + j * NWAVES) + kl;
                f32x16 acc = {0.f,0.f,0.f,0.f,0.f,0.f,0.f,0.f,0.f,0.f,0.f,0.f,0.f,0.f,0.f,0.f};
                acc = __builtin_amdgcn_mfma_f32_32x32x16_f16(__builtin_bit_cast(f16x8_t, af[0]), __builtin_bit_cast(f16x8_t, kb_[j][0]), acc, 0, 0, 0); acc = __builtin_amdgcn_mfma_f32_32x32x16_f16(__builtin_bit_cast(f16x8_t, af[1]), __builtin_bit_cast(f16x8_t, kb_[j][1]), acc, 0, 0, 0);
                float sc = 0.f;
#pragma unroll
                for (int h = 0; h < 8; ++h) sc += __builtin_amdgcn_fmed3f(acc[h], 0.f, sgc[h]);
                if (c5 == 0 && key < SEQ) keys[key] = key_of(sc); } }
        if (tid == 0) { const unsigned z_ = (unsigned)launder_v(0); ctl[0] = z_; ctl[1] = z_ + (unsigned)TOPK; ctl[2] = z_; ctl[3] = z_; }
        unsigned P = 0u, Plo = 0u;
#pragma unroll 1
        for (int lev = 0; lev < 5; ++lev) {
            for (int i = tid; i < 2048; i += NWAVES * 64) hist[i] = 0u;
            asm volatile("s_waitcnt lgkmcnt(0)" ::: "memory"); __syncthreads();
#pragma unroll 1
            for (int i = 0; i < 16; ++i) { const int s_ = tid * 16 + i;
                if (s_ < n) { const unsigned hi = keys[s_], lo = 8191u - (unsigned)s_; bool mt; unsigned dg;
                    if (lev == 0) { mt = true; dg = hi >> 21; } else if (lev == 1) { mt = (hi >> 21) == P; dg = (hi >> 10) & 0x7ffu; } else if (lev == 2) { mt = (hi >> 10) == P; dg = hi & 0x3ffu; }
                    else if (lev == 3) { mt = hi == P; dg = lo >> 6; } else { mt = hi == P && (lo >> 6) == Plo; dg = lo & 63u; }
                    if (mt) (void)__hip_atomic_fetch_add(hist + dg, 1u, __ATOMIC_RELAXED, __HIP_MEMORY_SCOPE_WORKGROUP); } }
            asm volatile("s_waitcnt lgkmcnt(0)" ::: "memory"); __syncthreads();
            const unsigned need = ctl[1];
            const v4u hb = *(const LAS v4u*)(hist + 4 * tid); const unsigned ls = hb.x + hb.y + hb.z + hb.w;
            unsigned v = ls, tt;
            tt = __shfl_down(v, 1); if (lane + 1 < 64) v += tt;
            tt = __shfl_down(v, 2); if (lane + 2 < 64) v += tt;
            tt = __shfl_down(v, 4); if (lane + 4 < 64) v += tt;
            tt = __shfl_down(v, 8); if (lane + 8 < 64) v += tt;
            tt = __shfl_down(v, 16); if (lane + 16 < 64) v += tt;
            tt = __shfl_down(v, 32); if (lane + 32 < 64) v += tt;
            if (lane == 0) ctl[8 + wave] = v;
            asm volatile("s_waitcnt lgkmcnt(0)" ::: "memory"); __syncthreads();
            unsigned above = v - ls;
            for (int w2 = wave + 1; w2 < NWAVES; ++w2) above += ctl[8 + w2];
            if (above < need && above + ls >= need) { unsigned c = above; const unsigned bb[4] = {hb.x, hb.y, hb.z, hb.w}; int bsel = 0; unsigned cab = 0; bool found = false;
#pragma unroll
                for (int i = 3; i >= 0; --i) { const bool hit = !found && (c + bb[i] >= need); if (hit) { bsel = i; cab = c; found = true; } c += bb[i]; }
                const unsigned dv = (unsigned)(4 * tid + bsel);
                if (lev == 0) ctl[0] = dv; else if (lev == 1) ctl[0] = (P << 11) | dv; else if (lev == 2) ctl[0] = (P << 10) | dv; else if (lev == 3) ctl[3] = dv; else ctl[3] = (Plo << 6) | dv;
                ctl[1] = need - cab; ctl[4] = bb[bsel]; }
            asm volatile("s_waitcnt lgkmcnt(0)" ::: "memory"); __syncthreads();
            P = ctl[0]; Plo = ctl[3];
            if (lev == 2 && ctl[1] == ctl[4]) break;
        }
        unsigned short* srow = sel + (size_t)q * TOPK;
        unsigned mymask = 0u;
#pragma unroll 1
        for (int i = 0; i < 16; ++i) { const int s_ = tid * 16 + i;
            if (s_ < n) { const unsigned hi = keys[s_], lo = 8191u - (unsigned)s_; if (hi > P || (hi == P && lo >= Plo)) mymask |= 1u << i; } }
        const unsigned mycnt = (unsigned)__builtin_popcount(mymask);
        unsigned pv_ = mycnt, tt_;
        tt_ = __shfl_up(pv_, 1); if (lane >= 1) pv_ += tt_;
        tt_ = __shfl_up(pv_, 2); if (lane >= 2) pv_ += tt_;
        tt_ = __shfl_up(pv_, 4); if (lane >= 4) pv_ += tt_;
        tt_ = __shfl_up(pv_, 8); if (lane >= 8) pv_ += tt_;
        tt_ = __shfl_up(pv_, 16); if (lane >= 16) pv_ += tt_;
        tt_ = __shfl_up(pv_, 32); if (lane >= 32) pv_ += tt_;
        if (lane == 63) ctl[16 + wave] = pv_;
        asm volatile("s_waitcnt lgkmcnt(0)" ::: "memory"); __syncthreads();
        unsigned slot0 = pv_ - mycnt;
        for (int w2 = 0; w2 < wave; ++w2) slot0 += ctl[16 + w2];
#pragma unroll 1
        for (int i = 0; i < 16; ++i) if ((mymask >> i) & 1u) { if (slot0 < (unsigned)TOPK) srow[slot0] = (unsigned short)(tid * 16 + i); ++slot0; }
    }
    asm volatile("s_waitcnt vmcnt(0) lgkmcnt(0)" ::: "memory");
    __syncthreads();
}

__device__ __forceinline__ unsigned offb(unsigned row, unsigned ch) { return 256u * row + 16u * (ch ^ (((row & 3u) << 2) | ((row >> 2) & 3u))); }
__device__ __forceinline__ s16x4_t vtr(const LAS unsigned char* p) { return __builtin_bit_cast(s16x4_t, __builtin_amdgcn_ds_read_tr16_b64_v4i16((LAS s16x4_t*)p)); }

__device__ __forceinline__ void dsa_attend(unsigned char* ws_, LAS unsigned char* lds_, const float* relb_, int wave_, int vcu_, int G_, int dry_) {
    const int dry = uni_i(dry_);
    LAS unsigned char* const lds = uni_l(lds_); const int wave = uni_i(wave_), vcu = uni_i(vcu_), G = uni_i(G_);
    unsigned char* ws = uni(ws_); const float* relb = uni(relb_);
    const bf16* ckv = (const bf16*)(ws + WS_CKV); bf16* ql = (bf16*)(ws + WS_QL); const unsigned short* sel = (const unsigned short*)(ws + WS_SEL);
    const int lane = lane_id_v(), tid = wave * 64 + lane;
    LAS unsigned char* cb = lds + wave * 16384;
    LAS unsigned short* sidx = (LAS unsigned short*)(lds + 131072 + wave * 512);
    LAS float* biasd = (LAS float*)(lds + 135168);
    for (int i = tid; i < 129 * 8; i += NWAVES * 64) { const int d = i >> 3, h = i & 7; const int bk = d < 128 ? (int)T5_BUCKET[d] : 31; biasd[i] = relb[bk * 8 + h]; }
    __syncthreads();
    const int hl = lane & 15, g = lane >> 4, hq = hl & 7;
    for (int p = vcu; p < BATCH * 64; p += G) {
        const int b = p >> 6, j = p & 63;
#pragma unroll 1
        for (int half = 0; half < 2; ++half) {
            const int ub = half == 0 ? j : 127 - j;
#pragma unroll 1
            for (int qi = 0; qi < 8; ++qi) {
                const int t = ub * 64 + wave * 8 + qi; const int q = b * SEQ + t; const int nsel = (t + 1) < TOPK ? (t + 1) : TOPK;
                const bf16* ckvb = ckv + (size_t)b * SEQ * KVR; bf16* qlrow = ql + (size_t)q * 1024;
                { const v2u w = *(const v2u*)(sel + (size_t)q * TOPK + 4 * lane); *(LAS v2u*)(sidx + 4 * lane) = w; }
                bf16x8_t qf[4];
#pragma unroll
                for (int s = 0; s < 4; ++s) qf[s] = *(const bf16x8_t*)(qlrow + hq * 128 + 32 * s + 8 * g);
                LDS_WAIT();
                float mrun = -1e30f, lsum = 0.f;
                f32x4 O[8];
#pragma unroll
                for (int c = 0; c < 8; ++c) O[c] = (f32x4){0.f, 0.f, 0.f, 0.f};
#define DSA_GATHER(c_) do { LAS unsigned char* dst_ = cb + ((c_) & 1) * 8192; \
                    _Pragma("unroll") for (int k_ = 0; k_ < 8; ++k_) { const int row_ = 4 * k_ + g; const int kidx_ = sidx[32 * (c_) + row_]; \
                        const int ch_ = hl ^ ((g << 2) | (k_ & 3)); \
                        glds16(ckvb + (size_t)kidx_ * KVR + ch_ * 8, (unsigned)__builtin_amdgcn_readfirstlane((int)(unsigned)(size_t)(dst_ + k_ * 1024))); } } while (0)
                DSA_GATHER(0);
#pragma unroll 1
                for (int c = 0; c < 8; ++c) {
                    if (c < 7) { DSA_GATHER(c + 1); asm volatile("s_waitcnt vmcnt(8)" ::: "memory"); }
                    else asm volatile("s_waitcnt vmcnt(0)" ::: "memory");
                    const LAS unsigned char* img = cb + (c & 1) * 8192;
                    f32x4 S[2];
#pragma unroll
                    for (int rb = 0; rb < 2; ++rb) { S[rb] = (f32x4){0.f, 0.f, 0.f, 0.f}; const unsigned row = 8u * (hl >> 2) + 4u * rb + (hl & 3);
#pragma unroll
                        for (int s = 0; s < 4; ++s) { const bf16x8_t af = *(const LAS bf16x8_t*)(img + offb(row, 4 * s + g)); S[rb] = __builtin_amdgcn_mfma_f32_16x16x32_bf16(af, qf[s], S[rb], 0, 0, 0); } }
                    float pv[2][4]; float mx = -1e30f;
#pragma unroll
                    for (int rb = 0; rb < 2; ++rb) { const v2u iw2 = *(const LAS v2u*)(sidx + 32 * c + 8 * g + 4 * rb);
                        const int ki[4] = {(int)(iw2.x & 0xffffu), (int)(iw2.x >> 16), (int)(iw2.y & 0xffffu), (int)(iw2.y >> 16)};
#pragma unroll
                        for (int r = 0; r < 4; ++r) { int dist = t - ki[r]; dist = dist < 0 ? 0 : (dist > 128 ? 128 : dist);
                            float lg = S[rb][r] * 0.125f + biasd[dist * 8 + hq];
                            if (32 * c + 8 * g + 4 * rb + r >= nsel) lg = -1e30f;
                            pv[rb][r] = lg; mx = fmaxf(mx, lg); } }
                    mx = fmaxf(mx, __shfl_xor(mx, 16)); mx = fmaxf(mx, __shfl_xor(mx, 32));
                    const float mnew = fmaxf(mrun, mx); const float alpha = __expf(mrun - mnew); mrun = mnew;
                    float rs = 0.f;
#pragma unroll
                    for (int rb = 0; rb < 2; ++rb)
#pragma unroll
                        for (int r = 0; r < 4; ++r) { pv[rb][r] = __expf(pv[rb][r] - mnew); rs += pv[rb][r]; }
                    rs += __shfl_xor(rs, 16); rs += __shfl_xor(rs, 32);
                    lsum = lsum * alpha + rs;
                    v4u pw; pw.x = pg8::cvt_pk_bf16(pv[0][0], pv[0][1]); pw.y = pg8::cvt_pk_bf16(pv[0][2], pv[0][3]); pw.z = pg8::cvt_pk_bf16(pv[1][0], pv[1][1]); pw.w = pg8::cvt_pk_bf16(pv[1][2], pv[1][3]);
                    const bf16x8_t pf = __builtin_bit_cast(bf16x8_t, pw);
                    float al[4];
#pragma unroll
                    for (int r = 0; r < 4; ++r) al[r] = __shfl(alpha, 4 * g + r);
#pragma unroll
                    for (int cd = 0; cd < 8; ++cd) {
                        f32x4 o = O[cd]; o[0] *= al[0]; o[1] *= al[1]; o[2] *= al[2]; o[3] *= al[3];
                        const unsigned q4 = hl >> 2, p4 = hl & 3;
                        const s16x4_t b0 = vtr(img + offb(8u * g + q4, 2 * cd + (p4 >> 1)) + 8u * (p4 & 1));
                        const s16x4_t b1 = vtr(img + offb(8u * g + 4u + q4, 2 * cd + (p4 >> 1)) + 8u * (p4 & 1));
                        bf16x8_t bf; bf[0] = b0[0]; bf[1] = b0[1]; bf[2] = b0[2]; bf[3] = b0[3]; bf[4] = b1[0]; bf[5] = b1[1]; bf[6] = b1[2]; bf[7] = b1[3];
                        O[cd] = __builtin_amdgcn_mfma_f32_16x16x32_bf16(pf, bf, o, 0, 0, 0);
                    }
                }
#undef DSA_GATHER
                const float linv = 1.0f / lsum; float li[4];
#pragma unroll
                for (int r = 0; r < 4; ++r) li[r] = __shfl(linv, 4 * g + r);
                LAS unsigned short* ost = (LAS unsigned short*)cb;
                if (g < 2) {
#pragma unroll
                    for (int cd = 0; cd < 8; ++cd)
#pragma unroll
                        for (int r = 0; r < 4; ++r) ost[(4 * g + r) * 128 + 16 * cd + hl] = (unsigned short)f2bf(O[cd][r] * li[r]);
                }
                LDS_WAIT();
                { const v4u w0 = *(const LAS v4u*)(cb + 32 * lane), w1 = *(const LAS v4u*)(cb + 32 * lane + 16);
                  if (!dry) { *(v4u*)(qlrow + 16 * lane) = w0; *(v4u*)(qlrow + 16 * lane + 8) = w1; } else asm volatile("" :: "v"(w0), "v"(w1)); }
                LDS_WAIT();
            }
        }
    }
    __syncthreads();
}

__device__ __noinline__ void final_norm(const float* const* in_, float* out_, unsigned char* ws_, LAS unsigned char* lds_, int wave_, int vcu_, int G_) {
    const PC F{uni(in_), uni(out_), uni(ws_), uni_l(lds_), uni_i(wave_), uni_i(vcu_), uni_i(G_)}; struct { const float* const* in; float* out; } a{F.in, F.out};
    const int lane_ = lane_id_v(); const int gw = F.vcu * NWAVES + F.wave, NGW = F.G * NWAVES; const float* g = a.in[22];
    f32x4 gv[4];
#pragma unroll
    for (int j = 0; j < 4; ++j) gv[j] = ((const f32x4*)g)[lane_ + 64 * j];
    for (int m = gw; m < M; m += NGW) {
        GAS f32x4* xr = (GAS f32x4*)(a.out + (size_t)m * D) + lane_;
        f32x4 v[4]; float s = 0.f;
#pragma unroll
        for (int j = 0; j < 4; ++j) { v[j] = xr[64 * j]; s += (v[j].x * v[j].x + v[j].y * v[j].y) + (v[j].z * v[j].z + v[j].w * v[j].w); }
        const float rs = 1.0f / sqrtf(wave_sum(s) * (1.0f / D) + EPS);
#pragma unroll
        for (int j = 0; j < 4; ++j) xr[64 * j] = v[j] * rs * gv[j];
    }
}

#define KIN ((const float* const*)__builtin_amdgcn_kernarg_segment_ptr())
constexpr int PH_PER_LAYER = 10, PH_LAYER0 = 2, N_PHASES = PH_LAYER0 + PH_PER_LAYER * DEPTH + 1;

__global__ void __launch_bounds__(NWAVES * 64, 2) mk_fwd(Args args) {
    extern __shared__ __attribute__((aligned(16))) unsigned char lds[];
    Frame F;
    F.lds = (LAS unsigned char*)lds;
    F.MISC = (volatile LAS unsigned*)(F.lds + MISC_OFF);
    F.wave = __builtin_amdgcn_readfirstlane((int)threadIdx.x >> 6);
    F.G = gridDim.x; { const int bx = blockIdx.x; F.vcu = (F.G % 8 == 0) ? (bx % 8) * (F.G / 8) + bx / 8 : bx; }
    F.ws = args.ws; F.ctl = (gu32*)(args.ws + WS_CTL);
    if (threadIdx.x < 64) ((LAS unsigned*)(F.lds + MISC_OFF))[threadIdx.x] = 0u;
    __syncthreads();
    const int lo = args.ph_lo, hi = args.ph_hi;
    const bool multi = (hi - lo) > 1;
    XcdBarrier bar; bar.bar = (unsigned*)(F.ctl + CW_BAR); bar.x = 0; bar.st = nullptr; bar.wave = F.wave;
    if (multi) bar = xcd_barrier_post((unsigned*)(F.ctl + CW_BAR), F.MISC + 8, F.wave);
#define IN(k) (lo <= (k) && (k) < hi)
#define SEAM(k) do { if (IN(k) && IN((k) + 1)) { xcd_barrier(bar); if (PROBE_PHASE == 99) xcd_barrier(bar); } } while (0)

    if (IN(0)) {
#if EN_P0
 for (int rep = (PROBE_PHASE == 1 ? 0 : 1); rep < 2; ++rep) p0_prologue(KIN, args.out, args.ws, F.lds, F.wave, F.vcu, F.G);
#endif
 } SEAM(0);
    if (IN(1)) {
#if !((DIS_MASK >> 7) & 1)
 unsigned char* ws = launder_p(args.ws); bf16* hb = (bf16*)(ws + WS_HB); float* ss = (float*)(ws + WS_SS); (void)hb; (void)ss;
        pg8::Gemm g{(const bf16_t*)(ws + WS_MEMN), (const bf16_t*)(ws + WS_WMEM), MROWS, DEPTH * 2 * CW, D}; pg8::StaticOrder S; S.init(MROWS, DEPTH * 2 * CW, F.G, launder_s((int)blockIdx.x));
        EpiPlainBf16 E{(bf16_t*)(ws + WS_MEMKV), DEPTH * 2 * CW};
        pg8::gemm_phase<EpiPlainBf16, pg8::StaticOrder, true, true>(F.lds + RING_OFF, g, S, E, F.wave);
        { pg8::Gemm g2{(const bf16_t*)(ws + WS_WMEM), (const bf16_t*)(ws + WS_MEMN), DEPTH * 2 * CW, MROWS, D}; pg8::StaticOrder S2; S2.init(DEPTH * 2 * CW, MROWS, F.G, launder_s((int)blockIdx.x));
          EpiPlainBf16 E2{(bf16_t*)(ws + WS_VT), MROWS};
          pg8::gemm_phase<EpiPlainBf16, pg8::StaticOrder, true, true>(F.lds + RING_OFF, g2, S2, E2, F.wave); }
#endif
    } SEAM(1);

    for (int l = 0; l < DEPTH; ++l) {
        const int pb = PH_LAYER0 + PH_PER_LAYER * l;
        const float* hbase = (l == 0) ? args.in[0] : args.out;
        if (IN(pb + 0)) {
#if EN_P0
 if (l > 0) for (int rep = (PROBE_PHASE == 1 ? 0 : 1); rep < 2; ++rep) prep_layer_weights(KIN, args.out, args.ws, F.lds, l, F.wave, F.vcu, F.G);
#endif
 } SEAM(pb + 0);
        if (IN(pb + 1)) {
#if !((DIS_MASK >> 0) & 1)
 unsigned char* ws = launder_p(args.ws); bf16* hb = (bf16*)(ws + WS_HB); float* ss = (float*)(ws + WS_SS); (void)hb; (void)ss;
            pg8::Gemm g{hb, (const bf16_t*)(ws + WS_W1IN), M, 2 * DFF, D}; pg8::StaticOrder S; S.init(M, 2 * DFF, F.G, launder_s((int)blockIdx.x));
            EpiSwiglu E{(bf16_t*)(ws + WS_ACT), ss};
            for (int rep = (PROBE_PHASE == 2 ? 0 : 1); rep < 2; ++rep) pg8::gemm_phase<EpiSwiglu, pg8::StaticOrder, true, true>(F.lds + RING_OFF, g, S, E, F.wave);
#endif
        } SEAM(pb + 1);
        if (IN(pb + 2)) {
#if !((DIS_MASK >> 1) & 1)
 unsigned char* ws = launder_p(args.ws); bf16* hb = (bf16*)(ws + WS_HB); float* ss = (float*)(ws + WS_SS); (void)hb; (void)ss;
            pg8::Gemm g{(const bf16_t*)(ws + WS_ACT), (const bf16_t*)(ws + WS_W1OUT), M, D, DFF}; pg8::StaticOrder S; S.init(M, D, F.G, launder_s((int)blockIdx.x));
            for (int rep = (PROBE_PHASE == 3 ? 0 : 1); rep < 2; ++rep) { EpiResid E{hbase, args.out, hb, ss, 0.5f, (LAS float*)(F.lds + RING_BYTES), rep == 0 ? 1 : 0};
            pg8::gemm_phase<EpiResid, pg8::StaticOrder, true, true>(F.lds + RING_OFF, g, S, E, F.wave); }
#endif
        } SEAM(pb + 2);
        if (IN(pb + 3)) {
#if !((DIS_MASK >> 2) & 1)
 unsigned char* ws = launder_p(args.ws); bf16* hb = (bf16*)(ws + WS_HB); float* ss = (float*)(ws + WS_SS); (void)hb; (void)ss;
            pg8::Gemm g{hb, (const bf16_t*)(ws + WS_WIN), M, INP, D}; pg8::StaticOrder S; S.init(M, INP, F.G, launder_s((int)blockIdx.x));
            EpiInProj E{ss, (bf16_t*)(ws + WS_QL), (float*)(ws + WS_CKVRAW), (bf16_t*)(ws + WS_IK), (float*)(ws + WS_IW), (bf16_t*)(ws + WS_IQRAW), (bf16_t*)(ws + WS_Z), (bf16_t*)(ws + WS_QC), (bf16_t*)(ws + WS_G)};
            for (int rep = (PROBE_PHASE == 4 ? 0 : 1); rep < 2; ++rep) pg8::gemm_phase<EpiInProj, pg8::StaticOrder, true, true>(F.lds + RING_OFF, g, S, E, F.wave);
#endif
        } SEAM(pb + 3);
        if (IN(pb + 4)) {
#if EN_PREP
 for (int rep = (PROBE_PHASE == 5 ? 0 : 1); rep < 2; ++rep) prep_tokens(KIN, args.out, args.ws, F.lds, l, F.wave, F.vcu, F.G, rep == 0 ? 1 : 0);
#endif
 } SEAM(pb + 4);
        if (IN(pb + 5)) {
#if EN_DSA
 for (int rep = (PROBE_PHASE == 6 ? 0 : 1); rep < 2; ++rep) for (int p = F.vcu; p < BATCH * 64; p += F.G) { for (int half = 0; half < 2; ++half) { const int b_ = p >> 6, ub_ = half == 0 ? (p & 63) : 127 - (p & 63);
   sel_pass1(args.ws, F.lds, F.wave, b_, ub_); if (PROBE_PHASE == 61) sel_pass1(args.ws, F.lds, F.wave, b_, ub_); sel_pass2(args.ws, F.lds, F.wave, b_, ub_); if (PROBE_PHASE == 62) sel_pass2(args.ws, F.lds, F.wave, b_, ub_); sel_resolve(args.ws, F.lds, F.wave, b_, ub_, (int)blockIdx.x, (p == F.vcu && half == 0) ? 1 : 0); if (PROBE_PHASE == 63) sel_resolve(args.ws, F.lds, F.wave, b_, ub_, (int)blockIdx.x, 0); } }
 dsa_select_slow(args.ws, F.lds, F.wave, (int)blockIdx.x); for (int rep = (PROBE_PHASE == 7 ? 0 : 1); rep < 2; ++rep) dsa_attend(args.ws, F.lds, args.in[2], F.wave, F.vcu, F.G, rep == 0 ? 1 : 0);
#endif
 } SEAM(pb + 5);
        if (IN(pb + 6)) {
#if !((DIS_MASK >> 3) & 1)
        for (int rep6 = (PROBE_PHASE == 8 ? 0 : 1); rep6 < 2; ++rep6) {
 unsigned char* ws = launder_p(args.ws); bf16* hb = (bf16*)(ws + WS_HB); float* ss = (float*)(ws + WS_SS); (void)hb; (void)ss;
            { pg8::Gemm g{(const bf16_t*)(ws + WS_QL), (const bf16_t*)(ws + WS_WA), M, D, 1024}; pg8::StaticOrder S; S.init(M, D, F.G, launder_s((int)blockIdx.x));
              EpiMerge<0> E{(bf16_t*)(ws + WS_MERGED), (const bf16_t*)(ws + WS_G)};
              pg8::gemm_phase<EpiMerge<0>, pg8::StaticOrder, true, true>(F.lds + RING_OFF, g, S, E, F.wave); }
            { pg8::Gemm g{(const bf16_t*)(ws + WS_YB), (const bf16_t*)(ws + WS_WB), M, D, PW_}; pg8::StaticOrder S; S.init(M, D, F.G, launder_s((int)blockIdx.x));
              EpiMerge<1> E{(bf16_t*)(ws + WS_MERGED), (const bf16_t*)(ws + WS_G)};
              pg8::gemm_phase<EpiMerge<1>, pg8::StaticOrder, true, true>(F.lds + RING_OFF, g, S, E, F.wave); }
            { pg8::Gemm g{(const bf16_t*)(ws + WS_QC), (const bf16_t*)(ws + WS_WC), M, D, CW}; pg8::StaticOrder S; S.init(M, D, F.G, launder_s((int)blockIdx.x));
              EpiMerge<2> E{(bf16_t*)(ws + WS_MERGED), (const bf16_t*)(ws + WS_G)};
              pg8::gemm_phase<EpiMerge<2>, pg8::StaticOrder, true, true>(F.lds + RING_OFF, g, S, E, F.wave); }
        }
#endif
        } SEAM(pb + 6);
        if (IN(pb + 7)) {
#if !((DIS_MASK >> 4) & 1)
 unsigned char* ws = launder_p(args.ws); bf16* hb = (bf16*)(ws + WS_HB); float* ss = (float*)(ws + WS_SS); (void)hb; (void)ss;
            pg8::Gemm g{(const bf16_t*)(ws + WS_MERGED), (const bf16_t*)(ws + WS_WOUT), M, D, D}; pg8::StaticOrder S; S.init(M, D, F.G, launder_s((int)blockIdx.x));
            for (int rep = (PROBE_PHASE == 9 ? 0 : 1); rep < 2; ++rep) { EpiResid E{args.out, args.out, hb, ss, 1.0f, (LAS float*)(F.lds + RING_BYTES), rep == 0 ? 1 : 0};
            pg8::gemm_phase<EpiResid, pg8::StaticOrder, true, true>(F.lds + RING_OFF, g, S, E, F.wave); }
#endif
        } SEAM(pb + 7);
        if (IN(pb + 8)) {
#if !((DIS_MASK >> 5) & 1)
 unsigned char* ws = launder_p(args.ws); bf16* hb = (bf16*)(ws + WS_HB); float* ss = (float*)(ws + WS_SS); (void)hb; (void)ss;
            pg8::Gemm g{hb, (const bf16_t*)(ws + WS_W2IN), M, 2 * DFF, D}; pg8::StaticOrder S; S.init(M, 2 * DFF, F.G, launder_s((int)blockIdx.x));
            EpiSwiglu E{(bf16_t*)(ws + WS_ACT), ss};
            for (int rep = (PROBE_PHASE == 2 ? 0 : 1); rep < 2; ++rep) pg8::gemm_phase<EpiSwiglu, pg8::StaticOrder, true, true>(F.lds + RING_OFF, g, S, E, F.wave);
#endif
        } SEAM(pb + 8);
        if (IN(pb + 9)) {
#if !((DIS_MASK >> 6) & 1)
 unsigned char* ws = launder_p(args.ws); bf16* hb = (bf16*)(ws + WS_HB); float* ss = (float*)(ws + WS_SS); (void)hb; (void)ss;
            pg8::Gemm g{(const bf16_t*)(ws + WS_ACT), (const bf16_t*)(ws + WS_W2OUT), M, D, DFF}; pg8::StaticOrder S; S.init(M, D, F.G, launder_s((int)blockIdx.x));
            for (int rep = (PROBE_PHASE == 3 ? 0 : 1); rep < 2; ++rep) { EpiResid E{args.out, args.out, hb, ss, 0.5f, (LAS float*)(F.lds + RING_BYTES), rep == 0 ? 1 : 0};
            pg8::gemm_phase<EpiResid, pg8::StaticOrder, true, true>(F.lds + RING_OFF, g, S, E, F.wave); }
#endif
        } SEAM(pb + 9);
    }
#if EN_P0
    if (IN(N_PHASES - 1)) { final_norm(KIN, args.out, args.ws, F.lds, F.wave, F.vcu, F.G); }
#endif
#undef IN
#undef SEAM
}

extern "C" void kernel_launch(void* const* d_in, const int* in_sizes, int n_in, void* d_out, int out_size, void* d_ws, size_t ws_size, hipStream_t stream) {
    static int grid = 0;
    if (grid == 0) {
        if (n_in != 23 || in_sizes[0] != M * D || out_size != M * D || ws_size < WS_END) { fprintf(stderr, "kernel_launch: unexpected shapes (n_in %d, ws %zu)\n", n_in, ws_size); grid = -1; return; }
        int dev = 0, cus = 0, per_cu = 0;
        if (hipGetDevice(&dev) != hipSuccess || hipDeviceGetAttribute(&cus, hipDeviceAttributeMultiprocessorCount, dev) != hipSuccess) { grid = -1; return; }
        if (hipFuncSetAttribute((const void*)mk_fwd, hipFuncAttributeMaxDynamicSharedMemorySize, LDS_BYTES) != hipSuccess) { fprintf(stderr, "kernel_launch: hipFuncSetAttribute failed\n"); grid = -1; return; }
        if (hipOccupancyMaxActiveBlocksPerMultiprocessor(&per_cu, (const void*)mk_fwd, NWAVES * 64, LDS_BYTES) != hipSuccess || per_cu < 1) { fprintf(stderr, "kernel_launch: occupancy query says %d\n", per_cu); }
        (void)hipGetLastError();
        grid = cus;
    }
    if (grid < 0) return;
    if (hipMemsetAsync((char*)d_ws + WS_CTL, 0, CTL_ZERO_BYTES, stream) != hipSuccess) return;
    Args a{};
    for (int i = 0; i < 23; ++i) a.in[i] = (const float*)d_in[i];
    a.out = (float*)d_out; a.ws = (unsigned char*)d_ws;
#if MK_ONE_LAUNCH
    a.ph_lo = 0; a.ph_hi = N_PHASES;
    hipLaunchKernelGGL(mk_fwd, dim3(grid), dim3(NWAVES * 64), LDS_BYTES, stream, a);
#endif
}
```

```cpp
#include <hip/hip_runtime.h>
#include <cstdio>
#include <cstdint>

#ifndef MK_ONE_LAUNCH
#define MK_ONE_LAUNCH 1
#endif
#ifndef PROBE_PHASE
#define PROBE_PHASE 0
#endif
#ifndef EN_P0
#define EN_P0 MK_ONE_LAUNCH
#endif
#ifndef EN_PREP
#define EN_PREP MK_ONE_LAUNCH
#endif
#ifndef EN_DSA
#define EN_DSA MK_ONE_LAUNCH
#endif
#ifndef DIS_MASK
#define DIS_MASK 0
#endif
#ifndef MK_ONE_LAUNCH
#define MK_ONE_LAUNCH 1
#endif

__device__ __forceinline__ int lane_id_v() { int l; asm volatile("v_mbcnt_lo_u32_b32 %0, -1, 0\n\tv_mbcnt_hi_u32_b32 %0, -1, %0" : "=v"(l)); return l; }
namespace pg8 {
#define PG8_LAS __attribute__((address_space(3)))
typedef unsigned short bf16_t;
typedef short bf16x8 __attribute__((ext_vector_type(8)));
typedef float f32x4 __attribute__((ext_vector_type(4)));
typedef unsigned u32x4 __attribute__((ext_vector_type(4)));
typedef unsigned u32x2 __attribute__((ext_vector_type(2)));
constexpr int BM = 256, BK = 64, HALF = 128, HTB = HALF * BK * 2, STAGE_BYTES = 8 * HTB, NXCD = 8, WGM = 8;

__host__ __device__ __forceinline__ int lds_byte(int r, int c) { const int st = (r >> 4) * 2 + (c >> 5), rr = r & 15, cc = c & 31, ob = rr * 64 + cc * 2; return st * 1024 + (ob ^ (((ob >> 9) & 1) << 5)); }
__host__ __device__ __forceinline__ void stage_rc(int b, int& R, int& C) { const int st = b / 1024, sb = b % 1024, swz = sb ^ (((sb >> 9) & 1) << 5); R = (st >> 1) * 16 + swz / 64; C = (st & 1) * 32 + (swz % 64) / 2; }
__host__ __device__ __forceinline__ int perm32(int rho) { const int n = rho >> 4, i = rho & 15; return 8 * (i >> 2) + 4 * n + (i & 3); }

struct Unit { int pm, pn; };
struct Gemm { const bf16_t* A; const bf16_t* Bt; int M, N, K; };

struct StaticOrder {
    int nM, nN, nwg, G, c;
    __host__ __device__ void init(int M, int N, int G_, int c_) { nM = M / BM; nN = N / BM; nwg = nM * nN; G = G_; c = c_; }
    __host__ __device__ bool next(int i, Unit& u) const {
        const long L = (long)i * G + c; if (L >= nwg) return false;
        int wgid = (int)L; { const int q = nwg / NXCD, r = nwg % NXCD, xcd = wgid % NXCD, off = wgid / NXCD; wgid = (xcd < r ? xcd * (q + 1) : r * (q + 1) + (xcd - r) * q) + off; }
        const int nig = WGM * nN, gid = wgid / nig, fm = gid * WGM, gsz = (nM - fm) < WGM ? (nM - fm) : WGM;
        u.pm = fm + ((wgid % nig) % gsz); u.pn = (wgid % nig) / gsz; return true;
    }
    __device__ __forceinline__ void a_ready(const Unit&) const {}
    __device__ __forceinline__ void done(const Unit&) const {}
};

__device__ __forceinline__ unsigned cvt_pk_bf16(float lo, float hi) { unsigned r; asm volatile("v_cvt_pk_bf16_f32 %0, %1, %2" : "=v"(r) : "v"(lo), "v"(hi)); return r; }

template <class Epi, class Sched, bool ALIGN_EPI = false, bool SP2 = false>
__device__ __forceinline__ void gemm_phase(PG8_LAS unsigned char* lds, const Gemm g, const Sched& S, const Epi& E, const int wid_) {
    int wid = wid_; asm volatile("" : "+s"(wid));
    const int lane = lane_id_v(), tid = wid * 64 + lane,
              wr = wid >> 2, wc = wid & 3, fr = lane & 15, fq = lane >> 4;
    const int K = g.K, nt = K / BK;
    unsigned voffA[2], voffB[2];
#pragma unroll
    for (int i = 0; i < 2; ++i) { int R, C; stage_rc(tid * 16 + i * 8192, R, C); const int Rb = Epi::PERM ? ((R & ~31) + perm32(R & 31)) : R;
        voffA[i] = (unsigned)(R * K + C) * 2u; voffB[i] = (unsigned)(Rb * K + C) * 2u; }
    const size_t kstep = (size_t)(BK * 2);
    const size_t hstep = (size_t)HALF * K * 2;
    const size_t tstep = 2 * hstep;
    const unsigned ldsw = (unsigned)wid * 1024u;
    const int aoff = lds_byte(wr * 64 + fr, fq * 8), boff = lds_byte(wc * 32 + fr, fq * 8);
#define PG8_SA(b, h) (((b) * 2 + (h)) * HTB)
#define PG8_SB(b, h) ((4 + (b) * 2 + (h)) * HTB)
#define PG8_STAGE(bufoff, gbase, voff) do { _Pragma("unroll") for (int _i = 0; _i < 2; ++_i) \
        __builtin_amdgcn_global_load_lds((const unsigned*)((const char*)(gbase) + (voff)[_i]), (PG8_LAS unsigned*)(lds + (bufoff) + ldsw + _i * 8192), 16, 0, 0); } while (0)
#define PG8_LDA(dst, b, h) do { _Pragma("unroll") for (int m = 0; m < 4; ++m) _Pragma("unroll") for (int k = 0; k < 2; ++k) dst[m][k] = *(const PG8_LAS bf16x8*)(lds + PG8_SA(b, h) + aoff + m * 2048 + k * 1024); } while (0)
#define PG8_LDB(dst, b, h) do { _Pragma("unroll") for (int n = 0; n < 2; ++n) _Pragma("unroll") for (int k = 0; k < 2; ++k) dst[n][k] = *(const PG8_LAS bf16x8*)(lds + PG8_SB(b, h) + boff + n * 2048 + k * 1024); } while (0)
#define PG8_MMA(ai, bj, At, Bt) do { __builtin_amdgcn_s_setprio(1); _Pragma("unroll") for (int m = 0; m < 4; ++m) _Pragma("unroll") for (int n = 0; n < 2; ++n) _Pragma("unroll") for (int k = 0; k < 2; ++k) \
        acc[ai][bj][m][n] = __builtin_amdgcn_mfma_f32_16x16x32_bf16(Bt[n][k], At[m][k], acc[ai][bj][m][n], 0, 0, 0); __builtin_amdgcn_s_setprio(0); } while (0)
#define PG8_WAIT_V(n) asm volatile("s_waitcnt vmcnt(" #n ")" ::: "memory")
#define PG8_WAIT_L(n) asm volatile("s_waitcnt lgkmcnt(" #n ")" ::: "memory")
#define PG8_BAR __builtin_amdgcn_s_barrier()
#define PG8_SCHED __builtin_amdgcn_sched_barrier(0)
    Unit cur, nxt; int ui = 0;
    if (!S.next(0, cur)) return;
    f32x4 acc[2][2][4][2];
#pragma unroll
    for (int a = 0; a < 2; ++a)
#pragma unroll
        for (int b = 0; b < 2; ++b)
#pragma unroll
            for (int m = 0; m < 4; ++m)
#pragma unroll
                for (int n = 0; n < 2; ++n) acc[a][b][m][n] = (f32x4){0.f, 0.f, 0.f, 0.f};
    bf16x8 At[4][2], B0[2][2], B1[2][2];
    const char* cA = (const char*)g.A + (size_t)cur.pm * tstep; const char* cB = (const char*)g.Bt + (size_t)cur.pn * tstep;
    S.a_ready(cur);
    if constexpr (SP2) {
        PG8_STAGE(PG8_SB(0, 0), cB, voffB); PG8_STAGE(PG8_SB(0, 1), cB + hstep, voffB); PG8_STAGE(PG8_SA(0, 0), cA, voffA); PG8_STAGE(PG8_SA(0, 1), cA + hstep, voffA);
        if (wr == 1) PG8_BAR;
        PG8_WAIT_V(2); PG8_BAR;
        PG8_STAGE(PG8_SB(1, 0), cB + kstep, voffB); PG8_STAGE(PG8_SA(1, 0), cA + kstep, voffA); PG8_STAGE(PG8_SB(1, 1), cB + hstep + kstep, voffB);
        PG8_WAIT_V(6); PG8_BAR;
    } else {
        PG8_STAGE(PG8_SB(0, 0), cB, voffB); PG8_STAGE(PG8_SA(0, 0), cA, voffA); PG8_STAGE(PG8_SB(0, 1), cB + hstep, voffB); PG8_STAGE(PG8_SA(0, 1), cA + hstep, voffA);
        if (wr == 1) PG8_BAR;
        PG8_WAIT_V(4); PG8_BAR;
        PG8_STAGE(PG8_SB(1, 0), cB + kstep, voffB); PG8_STAGE(PG8_SA(1, 0), cA + kstep, voffA); PG8_STAGE(PG8_SB(1, 1), cB + hstep + kstep, voffB);
        PG8_WAIT_V(6); PG8_BAR;
    }
    for (;;) {
        const bool has_next = S.next(ui + 1, nxt);
        const char* nA = has_next ? (const char*)g.A + (size_t)nxt.pm * tstep : cA; const char* nB = has_next ? (const char*)g.Bt + (size_t)nxt.pn * tstep : cB;
#pragma nounroll
        for (int t = 0; t < nt; t += 2) {
            const bool last = (t == nt - 2);
            const char* a1 = cA + (size_t)(t + 1) * kstep;
            const char* a2 = last ? nA : cA + (size_t)(t + 2) * kstep; const char* b2 = last ? nB : cB + (size_t)(t + 2) * kstep;
            const char* a3 = a2 + kstep; const char* b3 = b2 + kstep;
            if (last && has_next) S.a_ready(nxt);
            if constexpr (SP2) {
            PG8_LDB(B0, 0, 0); PG8_LDB(B1, 0, 1); PG8_SCHED; PG8_LDA(At, 0, 0); PG8_STAGE(PG8_SA(1, 1), a1 + hstep, voffA);
            PG8_WAIT_V(8); PG8_WAIT_L(0); PG8_BAR; PG8_MMA(0, 0, At, B0); PG8_MMA(0, 1, At, B1); PG8_BAR; PG8_SCHED;
            PG8_LDA(At, 0, 1); PG8_STAGE(PG8_SB(0, 0), b2, voffB); PG8_STAGE(PG8_SB(0, 1), b2 + hstep, voffB); PG8_STAGE(PG8_SA(0, 0), a2, voffA);
            PG8_WAIT_V(8); PG8_WAIT_L(0); PG8_BAR; PG8_MMA(1, 0, At, B0); PG8_MMA(1, 1, At, B1); PG8_BAR; PG8_SCHED;
            PG8_LDB(B0, 1, 0); PG8_LDB(B1, 1, 1); PG8_SCHED; PG8_LDA(At, 1, 0); PG8_STAGE(PG8_SA(0, 1), a2 + hstep, voffA);
            PG8_WAIT_V(8); PG8_WAIT_L(0); PG8_BAR; PG8_MMA(0, 0, At, B0); PG8_MMA(0, 1, At, B1); PG8_BAR; PG8_SCHED;
            PG8_LDA(At, 1, 1); PG8_STAGE(PG8_SB(1, 0), b3, voffB); PG8_STAGE(PG8_SB(1, 1), b3 + hstep, voffB); PG8_STAGE(PG8_SA(1, 0), a3, voffA);
            PG8_WAIT_V(8); PG8_WAIT_L(0); PG8_BAR; PG8_MMA(1, 0, At, B0); PG8_MMA(1, 1, At, B1); PG8_BAR; PG8_SCHED;
            } else {
            PG8_LDB(B0, 0, 0); PG8_SCHED; PG8_LDA(At, 0, 0); PG8_STAGE(PG8_SA(1, 1), a1 + hstep, voffA);
            PG8_WAIT_L(8); PG8_BAR; PG8_WAIT_L(0); PG8_MMA(0, 0, At, B0); PG8_BAR; PG8_SCHED;
            PG8_LDB(B1, 0, 1); PG8_STAGE(PG8_SB(0, 0), b2, voffB);
            PG8_BAR; PG8_WAIT_L(0); PG8_MMA(0, 1, At, B1); PG8_BAR;
            PG8_LDA(At, 0, 1); PG8_STAGE(PG8_SA(0, 0), a2, voffA);
            PG8_BAR; PG8_WAIT_L(0); PG8_MMA(1, 0, At, B0); PG8_BAR; PG8_SCHED;
            PG8_STAGE(PG8_SB(0, 1), b2 + hstep, voffB);
            PG8_WAIT_V(6); PG8_BAR; PG8_MMA(1, 1, At, B1); PG8_BAR;
            PG8_LDB(B0, 1, 0); PG8_SCHED; PG8_LDA(At, 1, 0); PG8_STAGE(PG8_SA(0, 1), a2 + hstep, voffA);
            PG8_WAIT_L(8); PG8_BAR; PG8_WAIT_L(0); PG8_MMA(0, 0, At, B0); PG8_BAR; PG8_SCHED;
            PG8_LDB(B1, 1, 1); PG8_STAGE(PG8_SB(1, 0), b3, voffB);
            PG8_BAR; PG8_WAIT_L(0); PG8_MMA(0, 1, At, B1); PG8_BAR;
            PG8_LDA(At, 1, 1); PG8_STAGE(PG8_SA(1, 0), a3, voffA);
            PG8_BAR; PG8_WAIT_L(0); PG8_MMA(1, 0, At, B0); PG8_BAR; PG8_SCHED;
            PG8_STAGE(PG8_SB(1, 1), b3 + hstep, voffB);
            PG8_WAIT_V(6); PG8_BAR; PG8_MMA(1, 1, At, B1); PG8_BAR;
            }
        }
        if constexpr (ALIGN_EPI) { if (wr == 0) PG8_BAR; }
        E(acc, cur, wr, wc, fr, fq); S.done(cur);
        if (!has_next) break;
#pragma unroll
        for (int a = 0; a < 2; ++a)
#pragma unroll
            for (int b = 0; b < 2; ++b)
#pragma unroll
                for (int m = 0; m < 4; ++m)
#pragma unroll
                    for (int n = 0; n < 2; ++n) acc[a][b][m][n] = (f32x4){0.f, 0.f, 0.f, 0.f};
        cur = nxt; cA = nA; cB = nB; ++ui;
        if constexpr (ALIGN_EPI) { if (wr == 1) PG8_BAR; }
    }
    PG8_WAIT_V(0);
    if constexpr (!ALIGN_EPI) { if (wr == 0) PG8_BAR; }
    PG8_BAR;
#undef PG8_SA
#undef PG8_SB
#undef PG8_STAGE
#undef PG8_LDA
#undef PG8_LDB
#undef PG8_MMA
#undef PG8_WAIT_V
#undef PG8_WAIT_L
#undef PG8_BAR
#undef PG8_SCHED
}
}

constexpr int NWAVES = 8;
constexpr int BATCH = 4, SEQ = 8192, D = 1024, DEPTH = 4, M = BATCH * SEQ;
constexpr int NMEM = 256, MROWS = BATCH * NMEM;
constexpr int AH = 8, AHD = 64, AW = 512, KVR = 128, IH = 8, IDIM = 32, TOPK = 256;
constexpr int PW_ = 256, CH = 4, CHD = 64, CW = 256;
constexpr int DFF = 2816, INW = 4520, INP = 5120;
constexpr float EPS = 1e-6f;
constexpr int C_QA = 0, C_CKV = 512, C_IQ = 640, C_IK = 896, C_IW = 928, C_Z = 936, C_QC = 1192, C_G = 1448;

constexpr size_t MiB = 1u << 20;
constexpr size_t WS_CTL = 0, CTL_ZERO_BYTES = 1 * MiB;
constexpr size_t WS_SS = 1 * MiB;
constexpr size_t WS_IW = 3 * MiB;
constexpr size_t WS_SGN = 4 * MiB;
constexpr size_t WS_MEMN = 5 * MiB;
constexpr size_t WS_WMEM = 7 * MiB;
constexpr size_t WS_MEMKV = 11 * MiB;
constexpr size_t WS_W1IN = 15 * MiB, WS_W1OUT = 26 * MiB, WS_WIN = 32 * MiB, WS_WA = 42 * MiB, WS_WB = 44 * MiB, WS_WC = 44 * MiB + 512 * 1024, WS_WOUT = 45 * MiB, WS_W2IN = 47 * MiB, WS_W2OUT = 58 * MiB;
constexpr size_t WS_HB = 64 * MiB;
constexpr size_t WS_ACT = 128 * MiB;
constexpr size_t WS_G = 128 * MiB;
constexpr size_t WS_QL = 320 * MiB;
constexpr size_t WS_CKV = 384 * MiB;
constexpr size_t WS_CKVRAW = 392 * MiB;
constexpr size_t WS_IQRAW = 408 * MiB;
constexpr size_t WS_IQF = 424 * MiB;
constexpr size_t WS_IK = 440 * MiB;
constexpr size_t WS_Z = 442 * MiB;
constexpr size_t WS_MERGED = 384 * MiB;
constexpr size_t WS_YB = 458 * MiB;
constexpr size_t WS_QC = 474 * MiB;
constexpr size_t WS_SEL = 490 * MiB;
constexpr size_t WS_VT = 506 * MiB;
constexpr size_t WS_WPT = 4 * MiB + 512 * 1024;
constexpr size_t WS_END = 510 * MiB;
constexpr int CW_BAR = 4096;

constexpr int RING_OFF = 0, RING_BYTES = 131072;
constexpr int LDS_BYTES = 155648;
constexpr int MISC_OFF = LDS_BYTES - 256;

#define GAS __attribute__((address_space(1)))
#define LAS __attribute__((address_space(3)))
typedef unsigned short bf16;
typedef unsigned v4u __attribute__((ext_vector_type(4)));
typedef unsigned v2u __attribute__((ext_vector_type(2)));
typedef float f32x4 __attribute__((ext_vector_type(4)));
typedef float f32x2 __attribute__((ext_vector_type(2)));
typedef GAS unsigned gu32;
#define RLX_AGENT __ATOMIC_RELAXED, __HIP_MEMORY_SCOPE_AGENT
#define LDS_WAIT() asm volatile("s_waitcnt lgkmcnt(0)" ::: "memory")
#define VM_WAIT() asm volatile("s_waitcnt vmcnt(0)" ::: "memory")
__device__ __forceinline__ unsigned f2bf(float f) { unsigned u = __builtin_bit_cast(unsigned, f); return (u + 0x7fffu + ((u >> 16) & 1u)) >> 16; }
__device__ __forceinline__ unsigned pk2(float lo, float hi) { return pg8::cvt_pk_bf16(lo, hi); }
__device__ __forceinline__ float bflo(unsigned w) { return __builtin_bit_cast(float, w << 16); }
__device__ __forceinline__ float bfhi(unsigned w) { return __builtin_bit_cast(float, w & 0xffff0000u); }
typedef _Float16 h2_t __attribute__((ext_vector_type(2)));
typedef _Float16 f16x8_t __attribute__((ext_vector_type(8)));
__device__ __forceinline__ unsigned pkh2(float lo, float hi) { const h2_t v = {(_Float16)lo, (_Float16)hi}; return __builtin_bit_cast(unsigned, v); }
__device__ __forceinline__ float hlo(unsigned w) { return (float)__builtin_bit_cast(h2_t, w)[0]; }
__device__ __forceinline__ float hhi(unsigned w) { return (float)__builtin_bit_cast(h2_t, w)[1]; }
__device__ __forceinline__ float bf2f(bf16 b) { return __builtin_bit_cast(float, ((unsigned)b) << 16); }

#define XB_TMO      128
#define XB_XCNT(j)  (256  + 64 * (j))
#define XB_XSUB(j)  (1280 + 64 * (j))
#define XB_XGEN(j)  (2304 + 64 * (j))
#define XB_TOP      3328
#define XB_TOPGEN   3392
#define XCD_BAR_WORDS 3456
#define XB_SPIN_CAP (1u << 23)

__device__ __forceinline__ unsigned xb_ld(unsigned* p)              { return __hip_atomic_load(p, __ATOMIC_RELAXED, __HIP_MEMORY_SCOPE_AGENT); }
__device__ __forceinline__ unsigned xb_add(unsigned* p, unsigned v) { return __hip_atomic_fetch_add(p, v, __ATOMIC_RELAXED, __HIP_MEMORY_SCOPE_AGENT); }
__device__ __forceinline__ unsigned xb_xcc_id() { return (unsigned)__builtin_amdgcn_s_getreg((3 << 11) | 20) & 0xFu; }
#define XB_SPIN(cond, bar) do { unsigned _sp = 0; while (cond) { __builtin_amdgcn_s_sleep(1); \
    if ((++_sp & 255u) == 0u) { if (xb_ld(&(bar)[XB_TMO])) break; if (_sp > XB_SPIN_CAP) { atomicAdd(&(bar)[XB_TMO], 1u); break; } } } } while (0)

struct XcdBarrier { unsigned* bar; unsigned x; volatile LAS unsigned* st; int wave; };

__device__ __forceinline__ XcdBarrier xcd_barrier_post(unsigned* bar, volatile LAS unsigned* st, int wave) {
    XcdBarrier b; b.bar = bar; b.x = xb_xcc_id(); b.st = st; b.wave = wave;
    if (threadIdx.x == 0) (void)xb_add(&bar[XB_XCNT(b.x)], 1u);
    return b;
}
__device__ __forceinline__ void xcd_barrier_complete(unsigned* bar, unsigned x, unsigned& nloc, unsigned& nx) {
    const unsigned G = gridDim.x * gridDim.y * gridDim.z;
    unsigned sum, cnt, mine, sp = 0u;
    for (;;) {
        sum = 0u; cnt = 0u; mine = 0u;
#pragma unroll
        for (unsigned j = 0; j < 16; ++j) { const unsigned c = xb_ld(&bar[XB_XCNT(j)]); sum += c; cnt += (c > 0u) ? 1u : 0u; mine = (j == x) ? c : mine; }
        if (sum == G) break;
        __builtin_amdgcn_s_sleep(1);
        if ((++sp & 255u) == 0u) { if (xb_ld(&bar[XB_TMO])) break; if (sp > XB_SPIN_CAP) { atomicAdd(&bar[XB_TMO], 1u); break; } }
    }
    nloc = mine > 0u ? mine : 1u; nx = cnt > 0u ? cnt : 1u;
}
__device__ __forceinline__ void xcd_barrier(const XcdBarrier& b) {
    asm volatile("s_waitcnt vmcnt(0)" ::: "memory");
    __syncthreads();
    int bw_ = b.wave; asm volatile("" : "+s"(bw_));
    if (bw_ == 0 && lane_id_v() == 0) {
        unsigned* bar = b.bar;
        __builtin_amdgcn_s_waitcnt(0);
        unsigned nloc = b.st[0], nx = b.st[1];
        if (nloc == 0u) { xcd_barrier_complete(bar, b.x, nloc, nx); b.st[0] = nloc; b.st[1] = nx; }
        const unsigned old = xb_add(&bar[XB_XSUB(b.x)], 1u);
        const unsigned gen = old / nloc;
        if (old + 1u == (gen + 1u) * nloc) {
            __builtin_amdgcn_fence(__ATOMIC_RELEASE, "agent");
            asm volatile("s_waitcnt vmcnt(0)" ::: "memory");
            const unsigned og = xb_add(&bar[XB_TOP], 1u);
            const unsigned tg = og / nx;
            if (og + 1u == (tg + 1u) * nx) xb_add(&bar[XB_TOPGEN], 1u);
            else XB_SPIN(xb_ld(&bar[XB_TOPGEN]) == tg, bar);
            __builtin_amdgcn_fence(__ATOMIC_ACQUIRE, "agent");
            xb_add(&bar[XB_XGEN(b.x)], 1u);
            asm volatile("s_waitcnt vmcnt(0)" ::: "memory");
        } else {
            XB_SPIN(xb_ld(&bar[XB_XGEN(b.x)]) == gen, bar);
            __builtin_amdgcn_fence(__ATOMIC_ACQUIRE, "agent");
            asm volatile("s_waitcnt vmcnt(0)" ::: "memory");
        }
    }
    __syncthreads();
}

struct Args {
    const float* in[23]; float* out; unsigned char* ws; int ph_lo, ph_hi;
};
template <class T> __device__ __forceinline__ T* uni(T* p) { const unsigned long long v = (unsigned long long)p; const unsigned lo = __builtin_amdgcn_readfirstlane((unsigned)v), hi = __builtin_amdgcn_readfirstlane((unsigned)(v >> 32)); return (T*)(((unsigned long long)hi << 32) | lo); }
__device__ __forceinline__ LAS unsigned char* uni_l(LAS unsigned char* p) { return (LAS unsigned char*)(unsigned)__builtin_amdgcn_readfirstlane((int)(unsigned)(size_t)p); }
__device__ __forceinline__ int uni_i(int v) { return __builtin_amdgcn_readfirstlane(v); }
struct PC { const float* const* in; float* out; unsigned char* ws; LAS unsigned char* lds; int wave, vcu, G; };
struct Frame {
    LAS unsigned char* lds;
    volatile LAS unsigned* MISC;
    gu32* ctl;
    int wave, vcu, G;
    unsigned char* ws;
};
__device__ __forceinline__ unsigned char* launder_p(unsigned char* p) { asm volatile("" : "+s"(p)); return p; }
__device__ __forceinline__ int launder_s(int v) { asm volatile("" : "+s"(v)); return v; }
__device__ __forceinline__ int launder_v(int v) { asm volatile("" : "+v"(v)); return v; }
__device__ __forceinline__ float wave_sum(float v) {
#pragma unroll
    for (int o = 1; o < 64; o <<= 1) v += __shfl_xor(v, o);
    return v;
}
__device__ __forceinline__ float wave_max(float v) {
#pragma unroll
    for (int o = 1; o < 64; o <<= 1) v = fmaxf(v, __shfl_xor(v, o));
    return v;
}

using pg8::Unit; using pg8::bf16_t;
#define LAUNDER2(a, b) asm volatile("" : "+v"(a), "+v"(b))
__device__ __forceinline__ float row_scale(const float* ss, int row) {
    const f32x4 a = *(const f32x4*)(ss + (size_t)row * 4);
    const float s = (a.x + a.y) + (a.z + a.w);
    return __builtin_amdgcn_rsqf(s * (1.0f / D) + EPS);
}
__device__ __forceinline__ float sigmoidf_(float x) { return __builtin_amdgcn_rcpf(1.0f + __expf(-x)); }
__device__ __forceinline__ pg8::u32x2 pack4(const f32x4 v) { pg8::u32x2 w; w.x = pg8::cvt_pk_bf16(v[0], v[1]); w.y = pg8::cvt_pk_bf16(v[2], v[3]); return w; }

struct EpiSwiglu {
    static constexpr bool PERM = true;
    bf16_t* O; const float* ss;
    __device__ __forceinline__ void operator()(const f32x4 (&acc)[2][2][4][2], const Unit& u, int wr, int wc, int fr_, int fq_) const {
        const int l_ = lane_id_v(); const int fr = l_ & 15, fq = l_ >> 4; (void)fr_; (void)fq_;
        int rb = wr * 64 + fr, cb = wc * 32 + 8 * fq; LAUNDER2(rb, cb);
        const int row0 = u.pm * 256 + rb, col0 = u.pn * 128 + cb;
#pragma unroll
        for (int ai = 0; ai < 2; ++ai)
#pragma unroll
            for (int m = 0; m < 4; ++m) { const int row = row0 + ai * 128 + m * 16;
                const f32x4 sq = *(const f32x4*)(ss + (size_t)row * 4); const float k = ((sq.x + sq.y) + (sq.z + sq.w)) * (1.0f / D) + EPS; const float c1 = __builtin_amdgcn_rsqf(k) * -1.4426950408889634f;
                pg8::u32x4 w;
                { const f32x4 a = acc[ai][0][m][0], b = acc[ai][1][m][0]; f32x4 o;
#pragma unroll
                  for (int i = 0; i < 4; ++i) o[i] = (a[i] * b[i]) * __builtin_amdgcn_rcpf(fmaf(__builtin_amdgcn_exp2f(a[i] * c1), k, k));
                  w.x = pg8::cvt_pk_bf16(o[0], o[1]); w.y = pg8::cvt_pk_bf16(o[2], o[3]); }
                { const f32x4 a = acc[ai][0][m][1], b = acc[ai][1][m][1]; f32x4 o;
#pragma unroll
                  for (int i = 0; i < 4; ++i) o[i] = (a[i] * b[i]) * __builtin_amdgcn_rcpf(fmaf(__builtin_amdgcn_exp2f(a[i] * c1), k, k));
                  w.z = pg8::cvt_pk_bf16(o[0], o[1]); w.w = pg8::cvt_pk_bf16(o[2], o[3]); }
                *(pg8::u32x4*)(O + (size_t)row * DFF + col0) = w; }
    }
};
struct EpiResid {
    static constexpr bool PERM = true;
    const float* base; float* out; bf16_t* hb; float* ss; float alpha; LAS float* P; int dry;
    __device__ __forceinline__ void operator()(const f32x4 (&acc)[2][2][4][2], const Unit& u, int wr, int wc, int fr_, int fq_) const {
        const int l_ = lane_id_v(); const int fr = l_ & 15, fq = l_ >> 4; (void)fr_; (void)fq_;
        int rb = wr * 64 + fr, cb = wc * 32 + 8 * fq; LAUNDER2(rb, cb);
        const int row0 = u.pm * 256 + rb, col0 = u.pn * 256 + cb;
#pragma unroll
        for (int ai = 0; ai < 2; ++ai)
#pragma unroll
          for (int mh = 0; mh < 2; ++mh) {
            f32x4 bs[2][2][2];
#pragma unroll
            for (int mm = 0; mm < 2; ++mm) { const size_t off = (size_t)(row0 + ai * 128 + (2 * mh + mm) * 16) * D + col0;
#pragma unroll
                for (int bj = 0; bj < 2; ++bj)
#pragma unroll
                    for (int n = 0; n < 2; ++n) bs[mm][bj][n] = *(const f32x4*)(base + off + bj * 128 + n * 4); }
#pragma unroll
            for (int mm = 0; mm < 2; ++mm) { const int m = 2 * mh + mm; const int row = row0 + ai * 128 + m * 16; const size_t off = (size_t)row * D + col0; float q = 0.f;
#pragma unroll
                for (int bj = 0; bj < 2; ++bj) { const f32x4 v0 = bs[mm][bj][0] + acc[ai][bj][m][0] * alpha, v1 = bs[mm][bj][1] + acc[ai][bj][m][1] * alpha;
                    if (!dry) { *(f32x4*)(out + off + bj * 128) = v0; *(f32x4*)(out + off + bj * 128 + 4) = v1;
                        pg8::u32x4 w; w.x = pg8::cvt_pk_bf16(v0[0], v0[1]); w.y = pg8::cvt_pk_bf16(v0[2], v0[3]); w.z = pg8::cvt_pk_bf16(v1[0], v1[1]); w.w = pg8::cvt_pk_bf16(v1[2], v1[3]);
                        *(pg8::u32x4*)(hb + off + bj * 128) = w; }
                    q += ((v0[0] * v0[0] + v0[1] * v0[1]) + (v0[2] * v0[2] + v0[3] * v0[3])) + ((v1[0] * v1[0] + v1[1] * v1[1]) + (v1[2] * v1[2] + v1[3] * v1[3])); }
                q += __shfl_xor(q, 16); q += __shfl_xor(q, 32);
                if (fq == 0) P[(rb + ai * 128 + m * 16) * 4 + wc] = q; }
            asm volatile("" ::: "memory"); }
        asm volatile("s_waitcnt lgkmcnt(0)" ::: "memory"); __builtin_amdgcn_s_barrier(); asm volatile("" ::: "memory");
        const int tid = (wr * 4 + wc) * 64 + fq * 16 + fr;
        if (tid < 256 && !dry) { const f32x4 p = *(const LAS f32x4*)(P + tid * 4); ss[(size_t)(u.pm * 256 + tid) * 4 + u.pn] = (p.x + p.y) + (p.z + p.w); }
    }
};
struct EpiPlainBf16 {
    static constexpr bool PERM = false;
    bf16_t* O; int ldo;
    __device__ __forceinline__ void operator()(const f32x4 (&acc)[2][2][4][2], const Unit& u, int wr, int wc, int fr_, int fq_) const {
        const int l_ = lane_id_v(); const int fr = l_ & 15, fq = l_ >> 4; (void)fr_; (void)fq_;
        int rb = wr * 64 + fr, cb = wc * 32 + 4 * fq; LAUNDER2(rb, cb);
        const int row0 = u.pm * 256 + rb, col0 = u.pn * 256 + cb;
#pragma unroll
        for (int ai = 0; ai < 2; ++ai)
#pragma unroll
            for (int m = 0; m < 4; ++m) { bf16_t* rowp = O + (size_t)(row0 + ai * 128 + m * 16) * ldo + col0;
#pragma unroll
                for (int bj = 0; bj < 2; ++bj)
#pragma unroll
                    for (int n = 0; n < 2; ++n) *(pg8::u32x2*)(rowp + bj * 128 + n * 16) = pack4(acc[ai][bj][m][n]); }
    }
};
struct EpiInProj {
    static constexpr bool PERM = true;
    const float* ss; bf16_t* qa; float* ckvraw; bf16_t* ik; float* iw; bf16_t* iqraw; bf16_t* z; bf16_t* qc; bf16_t* G;
    __device__ __forceinline__ void operator()(const f32x4 (&acc)[2][2][4][2], const Unit& u, int wr, int wc, int fr_, int fq_) const {
        const int l_ = lane_id_v(); const int fr = l_ & 15, fq = l_ >> 4; (void)fr_; (void)fq_;
        int rb = wr * 64 + fr, ct = wc * 32 + 8 * fq; LAUNDER2(rb, ct);
        const int row0 = u.pm * 256 + rb; const int pn = u.pn;
        if (pn == 4) {
#pragma unroll
            for (int ai = 0; ai < 2; ++ai)
#pragma unroll
                for (int m = 0; m < 4; ++m) { const int row = row0 + ai * 128 + m * 16; const float s = row_scale(ss, row);
#pragma unroll
                    for (int n = 0; n < 2; ++n) *(f32x4*)(ckvraw + (size_t)row * KVR + ct + n * 4) = acc[ai][0][m][n] * s;
                    if (wc == 0) { const f32x4 k0 = acc[ai][1][m][0] * s, k1 = acc[ai][1][m][1] * s; pg8::u32x4 w; w.x = pkh2(k0[0], k0[1]); w.y = pkh2(k0[2], k0[3]); w.z = pkh2(k1[0], k1[1]); w.w = pkh2(k1[2], k1[3]);
                        *(pg8::u32x4*)(ik + (size_t)row * IDIM + 8 * fq) = w; }
                    if (wc == 1 && fq == 0) { *(f32x4*)(iw + (size_t)row * IH) = acc[ai][1][m][0] * s; *(f32x4*)(iw + (size_t)row * IH + 4) = acc[ai][1][m][1] * s; } }
        } else {
            bf16_t* dst0; int ld; bool sig = false; const bool f16out = (pn == 5);
            if (pn < 4) { dst0 = qa + pn * 256; ld = 1024; } else if (pn == 5) { dst0 = iqraw; ld = 256; } else if (pn == 6) { dst0 = z; ld = 256; } else if (pn == 7) { dst0 = qc; ld = 256; } else { dst0 = G + (pn - 8) * 256; ld = 3072; sig = true; }
#pragma unroll
            for (int ai = 0; ai < 2; ++ai)
#pragma unroll
                for (int m = 0; m < 4; ++m) { const int row = row0 + ai * 128 + m * 16; const float s = row_scale(ss, row); bf16_t* rowp = dst0 + (size_t)row * ld + ct;
#pragma unroll
                    for (int bj = 0; bj < 2; ++bj) { f32x4 o0, o1;
                        if (sig) { const float c1 = s * -1.4426950408889634f;
#pragma unroll
                            for (int i = 0; i < 4; ++i) { o0[i] = __builtin_amdgcn_rcpf(1.0f + __builtin_amdgcn_exp2f(acc[ai][bj][m][0][i] * c1)); o1[i] = __builtin_amdgcn_rcpf(1.0f + __builtin_amdgcn_exp2f(acc[ai][bj][m][1][i] * c1)); } }
                        else { o0 = acc[ai][bj][m][0] * s; o1 = acc[ai][bj][m][1] * s; }
                        pg8::u32x4 wo;
                        if (f16out) { wo.x = pkh2(o0[0], o0[1]); wo.y = pkh2(o0[2], o0[3]); wo.z = pkh2(o1[0], o1[1]); wo.w = pkh2(o1[2], o1[3]); }
                        else { wo.x = pg8::cvt_pk_bf16(o0[0], o0[1]); wo.y = pg8::cvt_pk_bf16(o0[2], o0[3]); wo.z = pg8::cvt_pk_bf16(o1[0], o1[1]); wo.w = pg8::cvt_pk_bf16(o1[2], o1[3]); }
                        *(pg8::u32x4*)(rowp + bj * 128) = wo; } }
        }
    }
};
template <int MODE> struct EpiMerge {
    static constexpr bool PERM = true;
    bf16_t* Mg; const bf16_t* G;
    __device__ __forceinline__ void operator()(const f32x4 (&acc)[2][2][4][2], const Unit& u, int wr, int wc, int fr_, int fq_) const {
        const int l_ = lane_id_v(); const int fr = l_ & 15, fq = l_ >> 4; (void)fr_; (void)fq_;
        int rb = wr * 64 + fr, cb = wc * 32 + 8 * fq; LAUNDER2(rb, cb);
        const int row0 = u.pm * 256 + rb, col0 = u.pn * 256 + cb;
#pragma unroll
        for (int ai = 0; ai < 2; ++ai)
#pragma unroll
          for (int mh = 0; mh < 1; ++mh) {
            pg8::u32x4 gw[4][2], pw[4][2];
#pragma unroll
            for (int mm = 0; mm < 4; ++mm) { const int row = row0 + ai * 128 + mm * 16;
#pragma unroll
                for (int bj = 0; bj < 2; ++bj) { gw[mm][bj] = *(const pg8::u32x4*)(G + (size_t)row * 3072 + MODE * 1024 + col0 + bj * 128);
                    if (MODE > 0) pw[mm][bj] = *(const pg8::u32x4*)(Mg + (size_t)row * D + col0 + bj * 128); } }
#pragma unroll
            for (int mm = 0; mm < 4; ++mm) { const int m = mm; const int row = row0 + ai * 128 + m * 16;
#pragma unroll
                for (int bj = 0; bj < 2; ++bj) { const pg8::u32x4 g4 = gw[mm][bj];
                    f32x4 o0 = acc[ai][bj][m][0], o1 = acc[ai][bj][m][1];
                    o0[0] *= bflo(g4.x); o0[1] *= bfhi(g4.x); o0[2] *= bflo(g4.y); o0[3] *= bfhi(g4.y); o1[0] *= bflo(g4.z); o1[1] *= bfhi(g4.z); o1[2] *= bflo(g4.w); o1[3] *= bfhi(g4.w);
                    if (MODE > 0) { const pg8::u32x4 p4 = pw[mm][bj];
                        o0[0] += bflo(p4.x); o0[1] += bfhi(p4.x); o0[2] += bflo(p4.y); o0[3] += bfhi(p4.y); o1[0] += bflo(p4.z); o1[1] += bfhi(p4.z); o1[2] += bflo(p4.w); o1[3] += bfhi(p4.w); }
                    pg8::u32x4 w; w.x = pg8::cvt_pk_bf16(o0[0], o0[1]); w.y = pg8::cvt_pk_bf16(o0[2], o0[3]); w.z = pg8::cvt_pk_bf16(o1[0], o1[1]); w.w = pg8::cvt_pk_bf16(o1[2], o1[3]);
                    *(pg8::u32x4*)(Mg + (size_t)row * D + col0 + bj * 128) = w; } }
            asm volatile("" ::: "memory"); }
    }
};

template <class Map>
__device__ __forceinline__ void transpose_item(const float* W, int K, int N, const float* gain, bf16* WT, LAS float* scr, int item, int lane, Map map) {
    const int nblk = (N + 63) / 64, kb = item / nblk, nb = item % nblk, k0 = 64 * kb, n0 = 64 * nb;
    const int nn = n0 + 4 * (lane & 15); const bool nok = nn < N;
#pragma unroll 4
    for (int i = 0; i < 16; ++i) { const int kk = 4 * i + (lane >> 4); f32x4 v = nok ? *(const f32x4*)(W + (size_t)(k0 + kk) * N + nn) : (f32x4){0.f, 0.f, 0.f, 0.f};
        if (gain) v = v * gain[k0 + kk];
        *(LAS f32x4*)(scr + kk * 68 + 4 * (lane & 15)) = v; }
    LDS_WAIT(); asm volatile("" ::: "memory");
    const int c = lane & 7;
#pragma unroll
    for (int j = 0; j < 8; ++j) { const int n = (lane >> 3) + 8 * j; const LAS float* sp = scr + (8 * c) * 68 + n;
        v4u o; o.x = pk2(sp[0 * 68], sp[1 * 68]); o.y = pk2(sp[2 * 68], sp[3 * 68]); o.z = pk2(sp[4 * 68], sp[5 * 68]); o.w = pk2(sp[6 * 68], sp[7 * 68]);
        if (n0 + n < N) { const int dr = map(n0 + n); if (dr >= 0) *(GAS v4u*)(WT + (size_t)dr * K + k0 + 8 * c) = o; } }
    LDS_WAIT(); asm volatile("" ::: "memory");
}
struct MapId { int off; __device__ __forceinline__ int operator()(int n) const { return off + n; } };
struct MapSwiglu { __device__ __forceinline__ int operator()(int c) const { const int half = c >= DFF ? 1 : 0, j = c - half * DFF; return 256 * (j >> 7) + 128 * half + (j & 127); } };
struct MapInProj { __device__ __forceinline__ int operator()(int c) const {
    if (c < C_CKV) return -1;
    if (c < C_IQ) return 1024 + (c - C_CKV);
    if (c < C_IK) return 1280 + (c - C_IQ);
    if (c < C_IW) return 1152 + (c - C_IK);
    if (c < C_Z) return 1184 + (c - C_IW);
    if (c < C_QC) return 1536 + (c - C_Z);
    if (c < C_G) return 1792 + (c - C_QC);
    return 2048 + (c - C_G); } };
__device__ __forceinline__ void qlat_item(const float* win, const float* mixn, const float* wuk, bf16* WT, int item, int lane) {
    const int kc = item & 127, rh = (item >> 7) & 1, h = item >> 8; const int r = rh * 64 + lane;
    const f32x4* wp = (const f32x4*)(wuk + (size_t)r * (AH * AHD) + h * 64);
    float acc[8] = {0.f, 0.f, 0.f, 0.f, 0.f, 0.f, 0.f, 0.f};
#pragma unroll 1
    for (int dc = 0; dc < 4; ++dc) {
        const f32x4 w0 = wp[4 * dc], w1 = wp[4 * dc + 1], w2 = wp[4 * dc + 2], w3 = wp[4 * dc + 3];
#pragma unroll
        for (int kk = 0; kk < 8; ++kk) { const f32x4* ip = (const f32x4*)(win + (size_t)(kc * 8 + kk) * INW + h * 64 + 16 * dc);
            const f32x4 a0 = ip[0], a1 = ip[1], a2 = ip[2], a3 = ip[3];
            acc[kk] += (a0.x * w0.x + a0.y * w0.y + a0.z * w0.z + a0.w * w0.w) + (a1.x * w1.x + a1.y * w1.y + a1.z * w1.z + a1.w * w1.w)
                     + (a2.x * w2.x + a2.y * w2.y + a2.z * w2.z + a2.w * w2.w) + (a3.x * w3.x + a3.y * w3.y + a3.z * w3.z + a3.w * w3.w);
            if (kk & 1) asm volatile("" ::: "memory"); }
    }
    const f32x4 g0 = *(const f32x4*)(mixn + kc * 8), g1 = *(const f32x4*)(mixn + kc * 8 + 4);
    v4u w; w.x = pk2(acc[0] * g0.x, acc[1] * g0.y); w.y = pk2(acc[2] * g0.z, acc[3] * g0.w); w.z = pk2(acc[4] * g1.x, acc[5] * g1.y); w.w = pk2(acc[6] * g1.z, acc[7] * g1.w);
    *(GAS v4u*)(WT + (size_t)(h * 128 + r) * D + kc * 8) = w;
}
__device__ __forceinline__ void wafold_item(const float* wuv, const float* wba, bf16* WT, int item, int lane) {
    const int ng = item & 15, rg = (item >> 4) & 15, h = item >> 8; const int n = ng * 64 + lane, r0 = rg * 8;
    float acc[8] = {0.f, 0.f, 0.f, 0.f, 0.f, 0.f, 0.f, 0.f};
#pragma unroll 4
    for (int d = 0; d < 64; ++d) { const float wa = wba[(size_t)(h * 64 + d) * D + n];
#pragma unroll
        for (int j = 0; j < 8; ++j) acc[j] += wuv[(size_t)(r0 + j) * (AH * AHD) + h * 64 + d] * wa; }
    v4u w; w.x = pk2(acc[0], acc[1]); w.y = pk2(acc[2], acc[3]); w.z = pk2(acc[4], acc[5]); w.w = pk2(acc[6], acc[7]);
    *(GAS v4u*)(WT + (size_t)n * 1024 + h * 128 + r0) = w;
}
__device__ __forceinline__ int items_of(int K, int N) { return (K / 64) * ((N + 63) / 64); }

__device__ __forceinline__ void prep_layer_weights_body(const PC& F, int l) {
    struct { const float* const* in; } a{F.in};
    const int lane_ = lane_id_v();
    LAS float* scr = (LAS float*)(F.lds + RING_OFF + F.wave * 17408);
    const int gw = F.vcu * NWAVES + F.wave, NGW = F.G * NWAVES;
    const float* f1n = a.in[3] + (size_t)l * D; const float* f1in = a.in[4] + (size_t)l * D * 2 * DFF; const float* f1out = a.in[5] + (size_t)l * DFF * D;
    const float* mixn = a.in[6] + (size_t)l * D; const float* win = a.in[7] + (size_t)l * D * INW;
    const float* wba = a.in[15] + (size_t)l * AW * D; const float* wbb = a.in[16] + (size_t)l * PW_ * D; const float* wbc = a.in[17] + (size_t)l * CW * D;
    const float* wout = a.in[18] + (size_t)l * D * D;
    const float* f2n = a.in[19] + (size_t)l * D; const float* f2in = a.in[20] + (size_t)l * D * 2 * DFF; const float* f2out = a.in[21] + (size_t)l * DFF * D;
    unsigned char* ws = launder_p(F.ws);
    const float* wuk = a.in[9] + (size_t)l * KVR * AH * AHD; const float* wuv = a.in[10] + (size_t)l * KVR * AH * AHD;
    const int I0 = items_of(D, 2 * DFF), I1 = items_of(DFF, D), I2 = items_of(D, INW), I4 = items_of(PW_, D), I5 = items_of(CW, D), I6 = items_of(D, D);
    const int NIT = 2 * I0 + 2 * I1 + I2 + I4 + I5 + I6;
#pragma unroll 1
    for (int it = gw; it < NIT; it += NGW) {
        int r = it;
        if (r < I0) { transpose_item(f1in, D, 2 * DFF, f1n, (bf16*)(ws + WS_W1IN), scr, r, lane_, MapSwiglu{}); continue; } r -= I0;
        if (r < I0) { transpose_item(f2in, D, 2 * DFF, f2n, (bf16*)(ws + WS_W2IN), scr, r, lane_, MapSwiglu{}); continue; } r -= I0;
        if (r < I1) { transpose_item(f1out, DFF, D, nullptr, (bf16*)(ws + WS_W1OUT), scr, r, lane_, MapId{0}); continue; } r -= I1;
        if (r < I1) { transpose_item(f2out, DFF, D, nullptr, (bf16*)(ws + WS_W2OUT), scr, r, lane_, MapId{0}); continue; } r -= I1;
        if (r < I2) { transpose_item(win, D, INW, mixn, (bf16*)(ws + WS_WIN), scr, r, lane_, MapInProj{}); continue; } r -= I2;
        if (r < I4) { transpose_item(wbb, PW_, D, nullptr, (bf16*)(ws + WS_WB), scr, r, lane_, MapId{0}); continue; } r -= I4;
        if (r < I5) { transpose_item(wbc, CW, D, nullptr, (bf16*)(ws + WS_WC), scr, r, lane_, MapId{0}); continue; } r -= I5;
        transpose_item(wout, D, D, nullptr, (bf16*)(ws + WS_WOUT), scr, r, lane_, MapId{0});
    }
    { const float* wpool = a.in[11] + (size_t)l * 4 * 64 * 64; bf16* wpT = (bf16*)(ws + WS_WPT);
      for (int i = gw * 64 + lane_; i < 4 * 64 * 64; i += NGW * 64) { const int c = i & 63, d = (i >> 6) & 63, g = i >> 12; wpT[i] = (bf16)f2bf(wpool[(g * 64 + c) * 64 + d]); } }
    asm volatile("" ::: "memory");
#pragma unroll 1
    for (int it = gw; it < 2048; it += NGW) wafold_item(wuv, wba, (bf16*)(ws + WS_WA), it, lane_);
    asm volatile("" ::: "memory");
#pragma unroll 1
    for (int it = gw; it < 2048; it += NGW) qlat_item(win, mixn, wuk, (bf16*)(ws + WS_WIN), it, lane_);
}

__device__ __noinline__ void p0_prologue(const float* const* in_, float* out_, unsigned char* ws_, LAS unsigned char* lds_, int wave_, int vcu_, int G_) {
    const PC F{uni(in_), uni(out_), uni(ws_), uni_l(lds_), uni_i(wave_), uni_i(vcu_), uni_i(G_)}; struct { const float* const* in; } a{F.in};
    const int lane_ = lane_id_v();
    const int gw = F.vcu * NWAVES + F.wave, NGW = F.G * NWAVES;
    const float* x = a.in[0]; const float* mem = a.in[1];
    bf16* hb = (bf16*)(F.ws + WS_HB); float* ss = (float*)(F.ws + WS_SS); bf16* memn = (bf16*)(F.ws + WS_MEMN);
    for (int m = gw; m < M + MROWS; m += NGW) {
        const bool ismem = m >= M; const int r = ismem ? m - M : m;
        const GAS f32x4* xr = (const GAS f32x4*)((ismem ? mem : x) + (size_t)r * D) + lane_;
        f32x4 v[4]; float s = 0.f;
#pragma unroll
        for (int j = 0; j < 4; ++j) { v[j] = xr[64 * j]; s += (v[j].x * v[j].x + v[j].y * v[j].y) + (v[j].z * v[j].z + v[j].w * v[j].w); }
        s = wave_sum(s);
        float sc = 1.f;
        if (ismem) sc = 1.0f / sqrtf(s * (1.0f / D) + EPS);
        else if (lane_ < 4) ss[(size_t)r * 4 + lane_] = lane_ == 0 ? s : 0.f;
        GAS unsigned long long* o8 = (GAS unsigned long long*)((ismem ? memn : hb) + (size_t)r * D) + lane_;
#pragma unroll
        for (int j = 0; j < 4; ++j) o8[64 * j] = (unsigned long long)pk2(v[j].x * sc, v[j].y * sc) | ((unsigned long long)pk2(v[j].z * sc, v[j].w * sc) << 32);
    }
    LAS float* scr = (LAS float*)(F.lds + RING_OFF + F.wave * 17408);
    const int IM = items_of(D, 2 * CW);
    for (int it = gw; it < DEPTH * IM; it += NGW) { const int l = it / IM, r = it % IM;
        transpose_item(a.in[14] + (size_t)l * D * 2 * CW, D, 2 * CW, a.in[13] + (size_t)l * D, (bf16*)(F.ws + WS_WMEM), scr, r, lane_, MapId{l * 2 * CW}); }
    prep_layer_weights_body(F, 0);
}
__device__ __noinline__ void prep_layer_weights(const float* const* in_, float* out_, unsigned char* ws_, LAS unsigned char* lds_, int l, int wave_, int vcu_, int G_) {
    const PC F{uni(in_), uni(out_), uni(ws_), uni_l(lds_), uni_i(wave_), uni_i(vcu_), uni_i(G_)}; prep_layer_weights_body(F, uni_i(l));
}

__constant__ unsigned char T5_BUCKET[128] = {0, 1, 2, 3, 4, 5, 6, 7, 8, 9, 10, 11, 12, 13, 14, 15, 16, 16, 16, 17, 17, 18, 18, 18, 19, 19, 19, 20, 20, 20, 20, 21, 21, 21, 21, 22, 22, 22, 22, 22, 23, 23, 23, 23, 23, 23, 24, 24, 24, 24, 24, 24, 25, 25, 25, 25, 25, 25, 25, 26, 26, 26, 26, 26, 26, 26, 26, 27, 27, 27, 27, 27, 27, 27, 27, 27, 27, 28, 28, 28, 28, 28, 28, 28, 28, 28, 28, 29, 29, 29, 29, 29, 29, 29, 29, 29, 29, 29, 29, 30, 30, 30, 30, 30, 30, 30, 30, 30, 30, 30, 30, 30, 30, 31, 31, 31, 31, 31, 31, 31, 31, 31, 31, 31, 31, 31, 31, 31};

typedef short bf16x8_p __attribute__((ext_vector_type(8)));
__device__ __forceinline__ void prep_tokens(const float* const* in_, float* out_, unsigned char* ws_, LAS unsigned char* lds_, int l_, int wave_, int vcu_, int G_, int dry_) {
    const int dry = uni_i(dry_);
    const PC F{uni(in_), uni(out_), uni(ws_), uni_l(lds_), uni_i(wave_), uni_i(vcu_), uni_i(G_)}; struct { const float* const* in; } a{F.in}; const int l = uni_i(l_);
    unsigned char* ws = launder_p(F.ws);
    const float* ckvraw = (const float*)(ws + WS_CKVRAW); bf16* ckv = (bf16*)(ws + WS_CKV);
    const bf16* iqraw = (const bf16*)(ws + WS_IQRAW); bf16* iqf = (bf16*)(ws + WS_IQF); const float* iw = (const float*)(ws + WS_IW); unsigned* sgn = (unsigned*)(ws + WS_SGN);
    const bf16* z = (const bf16*)(ws + WS_Z); bf16* yb = (bf16*)(ws + WS_YB); bf16* qc = (bf16*)(ws + WS_QC);
    const bf16* memkv = (const bf16*)(ws + WS_MEMKV); const bf16* vT = (const bf16*)(ws + WS_VT); const bf16* wpT = (const bf16*)(ws + WS_WPT);
    const float* kvn = a.in[8] + (size_t)l * KVR; const float* pscale = a.in[12] + (size_t)l * PW_;
    const int lane = lane_id_v(), tid = F.wave * 64 + lane;
    const int tok = lane & 15, g4 = lane >> 4;
    LAS unsigned char* Ks = F.lds;
    LAS unsigned char* Vs = F.lds + 36864;
    for (int blk = F.vcu; blk < M / 128; blk += F.G) {
        const int rowb = blk * 128, b = rowb / SEQ, row0 = rowb + F.wave * 16;
#pragma unroll 1
        for (int tt = 0; tt < 16; ++tt) { const int row = row0 + tt;
            { const f32x2 v = *(const f32x2*)(ckvraw + (size_t)row * KVR + 2 * lane); const float q = wave_sum(v.x * v.x + v.y * v.y);
              const float rs = 1.0f / sqrtf(q * (1.0f / KVR) + EPS); const f32x2 g = *(const f32x2*)(kvn + 2 * lane);
              *(unsigned*)(ckv + (size_t)row * KVR + 2 * lane) = pk2(v.x * rs * g.x, v.y * rs * g.y); }
            { const float wv = iw[(size_t)row * IH + (lane >> 3)]; const float aw = fabsf(wv) * (1.0f / 16.0f);
              const v2u q = *(const v2u*)(iqraw + (size_t)row * 256 + 4 * lane);
              v2u o; o.x = pkh2(hlo(q.x) * aw, hhi(q.x) * aw); o.y = pkh2(hlo(q.y) * aw, hhi(q.y) * aw);
              *(v2u*)(iqf + (size_t)row * 256 + 4 * lane) = o;
              const unsigned long long bal = __ballot(wv < 0.f);
              unsigned mask = 0;
#pragma unroll
              for (int h = 0; h < 8; ++h) mask |= ((unsigned)(bal >> (8 * h)) & 1u) << h;
              if (lane == 0) sgn[row] = mask; } }
        { const int row = row0 + tok, spos = row % SEQ;
#pragma unroll 1
          for (int g = 0; g < 4; ++g) { const int w = 2 << g; const int cnt = (spos + 1) < w ? (spos + 1) : w; const float rc = 1.0f / (float)cnt;
              bf16x8_p pf[2];
#pragma unroll
              for (int ks = 0; ks < 2; ++ks) { const int c0 = g * 64 + 32 * ks + 8 * g4; float sum[8], z0[8];
#pragma unroll
                  for (int e = 0; e < 8; ++e) { sum[e] = 0.f; z0[e] = 0.f; }
                  for (int j = 0; j < w; ++j) { if (j < cnt) { const v4u v = *(const v4u*)(z + (size_t)(row - j) * 256 + c0);
                      const float f[8] = {bflo(v.x), bfhi(v.x), bflo(v.y), bfhi(v.y), bflo(v.z), bfhi(v.z), bflo(v.w), bfhi(v.w)};
#pragma unroll
                      for (int e = 0; e < 8; ++e) { sum[e] += f[e]; if (j == 0) z0[e] = f[e]; } } }
                  v4u pw; pw.x = pk2(sum[0] * rc - z0[0], sum[1] * rc - z0[1]); pw.y = pk2(sum[2] * rc - z0[2], sum[3] * rc - z0[3]); pw.z = pk2(sum[4] * rc - z0[4], sum[5] * rc - z0[5]); pw.w = pk2(sum[6] * rc - z0[6], sum[7] * rc - z0[7]);
                  pf[ks] = __builtin_bit_cast(bf16x8_p, pw); }
#pragma unroll
              for (int dt = 0; dt < 4; ++dt) { f32x4 acc = {0.f, 0.f, 0.f, 0.f};
#pragma unroll
                  for (int ks = 0; ks < 2; ++ks) { const bf16x8_p af = *(const bf16x8_p*)(wpT + (size_t)(g * 64 + 16 * dt + tok) * 64 + 32 * ks + 8 * g4); acc = __builtin_amdgcn_mfma_f32_16x16x32_bf16(af, pf[ks], acc, 0, 0, 0); }
                  const f32x4 ps = *(const f32x4*)(pscale + g * 64 + 16 * dt + 4 * g4);
                  v2u o; o.x = pk2(acc[0] * ps.x, acc[1] * ps.y); o.y = pk2(acc[2] * ps.z, acc[3] * ps.w);
                  *(v2u*)(yb + (size_t)row * 256 + g * 64 + 16 * dt + 4 * g4) = o; } } }
#pragma unroll 1
        for (int h = 0; h < CH; ++h) {
            __syncthreads();
#pragma unroll
            for (int e = 0; e < 4; ++e) { const int i = tid + 512 * e;
                { const int m = i >> 3, c = i & 7; const v4u v = *(const v4u*)(memkv + (size_t)(b * NMEM + m) * 2048 + l * 512 + h * 64 + c * 8); *(LAS v4u*)(Ks + m * 144 + c * 16) = v; }
                { const int d = i >> 5, c = i & 31; const v4u v = *(const v4u*)(vT + (size_t)(l * 512 + 256 + h * 64 + d) * MROWS + b * NMEM + c * 8); *(LAS v4u*)(Vs + d * 528 + c * 16) = v; } }
            LDS_WAIT(); __syncthreads();
            const int row = row0 + tok;
            bf16x8_p qf[2];
#pragma unroll
            for (int ks = 0; ks < 2; ++ks) qf[ks] = *(const bf16x8_p*)(qc + (size_t)row * 256 + h * 64 + 32 * ks + 8 * g4);
            f32x4 S[16]; float mx = -1e30f;
#pragma unroll
            for (int mt = 0; mt < 16; ++mt) { f32x4 acc = {0.f, 0.f, 0.f, 0.f};
#pragma unroll
                for (int ks = 0; ks < 2; ++ks) { const bf16x8_p kf = *(const LAS bf16x8_p*)(Ks + (16 * mt + tok) * 144 + (4 * ks + g4) * 16); acc = __builtin_amdgcn_mfma_f32_16x16x32_bf16(kf, qf[ks], acc, 0, 0, 0); }
                S[mt] = acc; mx = fmaxf(mx, fmaxf(fmaxf(acc[0], acc[1]), fmaxf(acc[2], acc[3]))); if ((mt & 3) == 3) __builtin_amdgcn_sched_barrier(0); }
            mx = fmaxf(mx, __shfl_xor(mx, 16)); mx = fmaxf(mx, __shfl_xor(mx, 32));
            float sm = 0.f;
#pragma unroll
            for (int mt = 0; mt < 16; ++mt)
#pragma unroll
                for (int r = 0; r < 4; ++r) { const float p = __expf((S[mt][r] - mx) * 0.125f); S[mt][r] = p; sm += p; }
            sm += __shfl_xor(sm, 16); sm += __shfl_xor(sm, 32);
            const float inv = 1.0f / sm;
            f32x4 oacc[4];
#pragma unroll
            for (int dt = 0; dt < 4; ++dt) oacc[dt] = (f32x4){0.f, 0.f, 0.f, 0.f};
#pragma unroll
            for (int kk = 0; kk < 8; ++kk) { v4u pw; pw.x = pg8::cvt_pk_bf16(S[2 * kk][0], S[2 * kk][1]); pw.y = pg8::cvt_pk_bf16(S[2 * kk][2], S[2 * kk][3]); pw.z = pg8::cvt_pk_bf16(S[2 * kk + 1][0], S[2 * kk + 1][1]); pw.w = pg8::cvt_pk_bf16(S[2 * kk + 1][2], S[2 * kk + 1][3]);
                const bf16x8_p pfr = __builtin_bit_cast(bf16x8_p, pw);
#pragma unroll
                for (int dt = 0; dt < 4; ++dt) { const LAS unsigned char* vp = Vs + (16 * dt + tok) * 528 + (32 * kk + 4 * g4) * 2;
                    const v2u lo = *(const LAS v2u*)vp, hi = *(const LAS v2u*)(vp + 32);
                    v4u vw; vw.x = lo.x; vw.y = lo.y; vw.z = hi.x; vw.w = hi.y;
                    oacc[dt] = __builtin_amdgcn_mfma_f32_16x16x32_bf16(__builtin_bit_cast(bf16x8_p, vw), pfr, oacc[dt], 0, 0, 0); }
                __builtin_amdgcn_sched_barrier(0); }
#pragma unroll
            for (int dt = 0; dt < 4; ++dt) { v2u o; o.x = pk2(oacc[dt][0] * inv, oacc[dt][1] * inv); o.y = pk2(oacc[dt][2] * inv, oacc[dt][3] * inv);
                if (!dry) *(v2u*)(qc + (size_t)row * 256 + h * 64 + 16 * dt + 4 * g4) = o; else asm volatile("" :: "v"(o.x), "v"(o.y)); }
        }
    }
    __syncthreads();
}

__device__ __forceinline__ unsigned key_of(float s) { const unsigned u = __builtin_bit_cast(unsigned, s); return (u & 0x80000000u) ? ~u : (u | 0x80000000u); }

typedef short bf16x8_t __attribute__((ext_vector_type(8)));
typedef short s16x4_t __attribute__((ext_vector_type(4)));
__device__ __forceinline__ void glds16(const void* gsrc, unsigned lds_dst) { unsigned keep;
    asm volatile("s_mov_b32 %0, m0\n\ts_mov_b32 m0, %2\n\ts_nop 0\n\tglobal_load_lds_dwordx4 %1, off\n\ts_mov_b32 m0, %0" : "=&s"(keep) : "v"(gsrc), "s"(lds_dst) : "memory"); }
typedef float f32x16 __attribute__((ext_vector_type(16)));
constexpr int SEL_CAP = 256;
constexpr int HSTR = 264;
constexpr int SL_HIST = 0, SL_SEL = 0, SL_CS = 32768, SL_CI = 98304, SL_KEYS = 131072, SL_ST = 147456;

#define SEL_DECLS \
    LAS unsigned char* const lds = uni_l(lds_); const int wave = uni_i(wave_), b = uni_i(b_), ub = uni_i(ub_); unsigned char* ws = uni(ws_); \
    const bf16* iqf = (const bf16*)(ws + WS_IQF); const unsigned* sgn = (const unsigned*)(ws + WS_SGN); const bf16* ik = (const bf16*)(ws + WS_IK); \
    const int lane = lane_id_v(), tid = wave * 64 + lane; const int kl = lane & 31, c5 = lane >> 5; \
    LAS unsigned* hist = (LAS unsigned*)(lds + SL_HIST); LAS unsigned short* lsel = (LAS unsigned short*)(lds + SL_SEL); LAS float* lcs = (LAS float*)(lds + SL_CS); \
    LAS unsigned short* lci = (LAS unsigned short*)(lds + SL_CI); LAS unsigned* st = (LAS unsigned*)(lds + SL_ST); LAS float* stf = (LAS float*)(lds + SL_ST); \
    const int t0 = ub * 64; const int q0 = b * SEQ + t0; const bf16* ikb = ik + (size_t)b * SEQ * IDIM; const int ntile = (t0 + 64 + 127) >> 7; \
    (void)hist; (void)lsel; (void)lcs; (void)lci; (void)stf; (void)tid;
#define SEL_LOAD_A \
    bf16x8_t af[2][2]; float sgc[2][16]; \
    { const int i = kl, a_ = i >> 3, cc_ = (i >> 2) & 1, e_ = i & 3; const int qq_ = 2 * cc_ + (a_ >> 1), hh_ = 4 * (a_ & 1) + e_; \
      _Pragma("unroll") for (int rt = 0; rt < 2; ++rt) { const unsigned flip_ = ((sgn[q0 + 8 * wave + 4 * rt + qq_] >> hh_) & 1u) ? 0x80008000u : 0u;     \
          _Pragma("unroll") for (int ks = 0; ks < 2; ++ks) { v4u w_ = *(const v4u*)(iqf + (size_t)(q0 + 8 * wave + 4 * rt + qq_) * 256 + hh_ * 32 + 16 * ks + 8 * c5); \
              w_.x ^= flip_; w_.y ^= flip_; w_.z ^= flip_; w_.w ^= flip_; af[rt][ks] = __builtin_bit_cast(bf16x8_t, w_); } } \
      _Pragma("unroll") for (int rt = 0; rt < 2; ++rt) _Pragma("unroll") for (int u = 0; u < 2; ++u) { const unsigned m_ = sgn[q0 + 8 * wave + 4 * rt + 2 * c5 + u]; \
          _Pragma("unroll") for (int h = 0; h < 8; ++h) sgc[rt][8 * u + h] = ((m_ >> h) & 1u) ? -__builtin_inff() : __builtin_inff(); } }
#define SEL_STAGE(kt_) do { const int key_ = 16 * wave + (lane >> 2); const int ch_ = (lane & 3) ^ ((key_ >> 2) & 3); \
    glds16(ikb + (size_t)(128 * (kt_) + key_) * IDIM + ch_ * 8, (unsigned)__builtin_amdgcn_readfirstlane((int)(unsigned)(size_t)(lds + SL_KEYS + ((kt_) & 1) * 8192 + wave * 1024))); } while (0)
#define SEL_MMA(acc_, rt_, kh_) do { acc_ = (f32x16){0.f,0.f,0.f,0.f,0.f,0.f,0.f,0.f,0.f,0.f,0.f,0.f,0.f,0.f,0.f,0.f}; \
    acc_ = __builtin_amdgcn_mfma_f32_32x32x16_f16(__builtin_bit_cast(f16x8_t, af[rt_][0]), __builtin_bit_cast(f16x8_t, bfr_[kh_][0]), acc_, 0, 0, 0); \
    acc_ = __builtin_amdgcn_mfma_f32_32x32x16_f16(__builtin_bit_cast(f16x8_t, af[rt_][1]), __builtin_bit_cast(f16x8_t, bfr_[kh_][1]), acc_, 0, 0, 0); } while (0)
#define SEL_SUM(acc_, rt_, kh_) do { _Pragma("unroll") for (int u = 0; u < 2; ++u) { float s_ = 0.f; \
    _Pragma("unroll") for (int h = 0; h < 8; ++h) s_ += __builtin_amdgcn_fmed3f(acc_[8 * u + h], 0.f, sgc[rt_][8 * u + h]); \
    sc[rt_][kh_][u] = s_; } } while (0)
#define SEL_SCORES(kt_) do { const LAS unsigned char* kb_ = lds + SL_KEYS + ((kt_) & 1) * 8192; bf16x8_t bfr_[4][2]; \
    _Pragma("unroll") for (int kh = 0; kh < 4; ++kh) { const int key_ = 32 * kh + kl; \
        bfr_[kh][0] = *(const LAS bf16x8_t*)(kb_ + key_ * 64 + 16 * ((0 + c5) ^ ((key_ >> 2) & 3))); \
        bfr_[kh][1] = *(const LAS bf16x8_t*)(kb_ + key_ * 64 + 16 * ((2 + c5) ^ ((key_ >> 2) & 3))); } \
    f32x16 accA_, accB_; \
    SEL_MMA(accA_, 0, 0); \
    SEL_MMA(accB_, 1, 0); __builtin_amdgcn_sched_barrier(0); SEL_SUM(accA_, 0, 0); __builtin_amdgcn_sched_barrier(0); \
    SEL_MMA(accA_, 0, 1); __builtin_amdgcn_sched_barrier(0); SEL_SUM(accB_, 1, 0); __builtin_amdgcn_sched_barrier(0); \
    SEL_MMA(accB_, 1, 1); __builtin_amdgcn_sched_barrier(0); SEL_SUM(accA_, 0, 1); __builtin_amdgcn_sched_barrier(0); \
    SEL_MMA(accA_, 0, 2); __builtin_amdgcn_sched_barrier(0); SEL_SUM(accB_, 1, 1); __builtin_amdgcn_sched_barrier(0); \
    SEL_MMA(accB_, 1, 2); __builtin_amdgcn_sched_barrier(0); SEL_SUM(accA_, 0, 2); __builtin_amdgcn_sched_barrier(0); \
    SEL_MMA(accA_, 0, 3); __builtin_amdgcn_sched_barrier(0); SEL_SUM(accB_, 1, 2); __builtin_amdgcn_sched_barrier(0); \
    SEL_MMA(accB_, 1, 3); __builtin_amdgcn_sched_barrier(0); SEL_SUM(accA_, 0, 3); __builtin_amdgcn_sched_barrier(0); \
    SEL_SUM(accB_, 1, 3); } while (0)
#define SEL_BOUNDARY(FINAL) do { \
    const int qq = tid >> 3, part = tid & 7; const LAS v4u* hp = (const LAS v4u*)(hist + qq * HSTR + 32 * part); \
    unsigned bins[32]; \
    _Pragma("unroll") for (int i = 0; i < 8; ++i) { const v4u v = hp[i]; bins[4 * i] = v.x; bins[4 * i + 1] = v.y; bins[4 * i + 2] = v.z; bins[4 * i + 3] = v.w; } \
    unsigned ps = 0; \
    _Pragma("unroll") for (int i = 0; i < 32; ++i) ps += bins[i]; \
    unsigned v = ps, tt; \
    tt = __shfl_down(v, 1, 8); if (part + 1 < 8) v += tt; \
    tt = __shfl_down(v, 2, 8); if (part + 2 < 8) v += tt; \
    tt = __shfl_down(v, 4, 8); if (part + 4 < 8) v += tt; \
    unsigned cacc = v - ps; \
    if (cacc < (unsigned)TOPK && v >= (unsigned)TOPK) { int bsel = 0; unsigned na = 0, cb = 0; bool found = false; \
        _Pragma("unroll") for (int i = 31; i >= 0; --i) { const bool hit = !found && (cacc + bins[i] >= (unsigned)TOPK); if (hit) { bsel = i; na = cacc; cb = bins[i]; found = true; } cacc += bins[i]; } \
        st[128 + qq] = (unsigned)(32 * part + bsel); if (FINAL) { st[192 + qq] = na; st[256 + qq] = cb; st[448 + qq] = cb > (unsigned)SEL_CAP ? 1u : 0u; } } } while (0)

__device__ __forceinline__ void sel_pass1(unsigned char* ws_, LAS unsigned char* lds_, int wave_, int b_, int ub_) {
    SEL_DECLS
    unsigned short* sel = (unsigned short*)(ws + WS_SEL);
    __syncthreads();
    if (ub < 4) {
        for (int i = tid; i < 64 * TOPK; i += NWAVES * 64) { const int qq = i >> 8, sl = i & 255; sel[(size_t)(q0 + qq) * TOPK + sl] = (unsigned short)(sl <= t0 + qq ? sl : 0); }
        if (tid == 0) st[512] = 1u;
        asm volatile("s_waitcnt vmcnt(0) lgkmcnt(0)" ::: "memory"); __syncthreads();
        return;
    }
    SEL_LOAD_A
    for (int i = tid; i < 64 * HSTR; i += NWAVES * 64) hist[i] = 0u;
    if (tid < 64) { st[128 + tid] = 0u; st[448 + tid] = 0u; }
    if (tid == 0) st[512] = 0u;
    float sc[2][4][2];
    float scl[2][2]; int bcur[2][2];
#pragma unroll
    for (int rt = 0; rt < 2; ++rt)
#pragma unroll
        for (int u = 0; u < 2; ++u) { scl[rt][u] = 0.f; bcur[rt][u] = 0; }
    SEL_STAGE(0);
#pragma unroll 1
    for (int kt = 0; kt < ntile; ++kt) {
        asm volatile("s_waitcnt vmcnt(0) lgkmcnt(0)" ::: "memory"); __syncthreads();
        if (kt > 0 && (kt & 3) == 0) {
            SEL_BOUNDARY(false);
            asm volatile("s_waitcnt lgkmcnt(0)" ::: "memory"); __syncthreads();
#pragma unroll
            for (int rt = 0; rt < 2; ++rt)
#pragma unroll
                for (int u = 0; u < 2; ++u) bcur[rt][u] = (int)st[128 + 8 * wave + 4 * rt + 2 * c5 + u];
        }
        if (kt + 1 < ntile) SEL_STAGE(kt + 1);
        SEL_SCORES(kt);
        if (kt == 0) {
#pragma unroll
            for (int rt = 0; rt < 2; ++rt)
#pragma unroll
                for (int u = 0; u < 2; ++u) { float mx = 0.f;
#pragma unroll
                    for (int kh = 0; kh < 4; ++kh) mx = fmaxf(mx, fabsf(sc[rt][kh][u]));
#pragma unroll
                    for (int o = 1; o < 32; o <<= 1) mx = fmaxf(mx, __shfl_xor(mx, o));
                    const float R = mx > 0.f ? mx : 1.0f;
                    scl[rt][u] = 128.0f / R;
                    if (kl == 0) stf[8 * wave + 4 * rt + 2 * c5 + u] = scl[rt][u]; }
        }
        const bool masked = 128 * kt + 127 > t0;
        if (masked) {
#pragma unroll
        for (int rt = 0; rt < 2; ++rt)
#pragma unroll
            for (int u = 0; u < 2; ++u) { const int qq = 8 * wave + 4 * rt + 2 * c5 + u; const int lim = t0 + qq - 128 * kt - kl;
#pragma unroll
                for (int kh = 0; kh < 4; ++kh) { const float fb = __builtin_amdgcn_fmed3f(fmaf(sc[rt][kh][u], scl[rt][u], 128.0f), 0.f, 255.f);
                    if (fb >= (float)bcur[rt][u] && 32 * kh <= lim) (void)__hip_atomic_fetch_add(hist + qq * HSTR + (int)fb, 1u, __ATOMIC_RELAXED, __HIP_MEMORY_SCOPE_WORKGROUP); } }
        } else {
#pragma unroll
        for (int rt = 0; rt < 2; ++rt)
#pragma unroll
            for (int u = 0; u < 2; ++u) { const int qq = 8 * wave + 4 * rt + 2 * c5 + u;
#pragma unroll
                for (int kh = 0; kh < 4; ++kh) { const float fb = __builtin_amdgcn_fmed3f(fmaf(sc[rt][kh][u], scl[rt][u], 128.0f), 0.f, 255.f);
                    if (fb >= (float)bcur[rt][u]) (void)__hip_atomic_fetch_add(hist + qq * HSTR + (int)fb, 1u, __ATOMIC_RELAXED, __HIP_MEMORY_SCOPE_WORKGROUP); } }
        }
    }
    asm volatile("s_waitcnt vmcnt(0) lgkmcnt(0)" ::: "memory"); __syncthreads();
    SEL_BOUNDARY(true);
    if (tid < 64) { st[320 + tid] = 0u; st[384 + tid] = 0u; }
    asm volatile("s_waitcnt lgkmcnt(0)" ::: "memory"); __syncthreads();
}
__device__ __forceinline__ void sel_pass2(unsigned char* ws_, LAS unsigned char* lds_, int wave_, int b_, int ub_) {
    SEL_DECLS
    if (st[512] != 0u) return;
    if (tid < 64) { st[320 + tid] = 0u; st[384 + tid] = 0u; }
    SEL_LOAD_A
    float sc[2][4][2];
    float scl[2][2]; int bcur[2][2];
#pragma unroll
    for (int rt = 0; rt < 2; ++rt)
#pragma unroll
        for (int u = 0; u < 2; ++u) { const int qq = 8 * wave + 4 * rt + 2 * c5 + u; scl[rt][u] = stf[qq]; bcur[rt][u] = (int)st[128 + qq]; }
    SEL_STAGE(0);
#pragma unroll 1
    for (int kt = 0; kt < ntile; ++kt) {
        asm volatile("s_waitcnt vmcnt(0) lgkmcnt(0)" ::: "memory"); __syncthreads();
        if (kt + 1 < ntile) SEL_STAGE(kt + 1);
        SEL_SCORES(kt);
        const bool masked = 128 * kt + 127 > t0;
        float fbv[2][2][4];
#pragma unroll
        for (int rt = 0; rt < 2; ++rt)
#pragma unroll
            for (int u = 0; u < 2; ++u)
#pragma unroll
                for (int kh = 0; kh < 4; ++kh) fbv[rt][u][kh] = __builtin_amdgcn_fmed3f(fmaf(sc[rt][kh][u], scl[rt][u], 128.0f), 0.f, 255.f);
        if (masked) {
#pragma unroll
            for (int rt = 0; rt < 2; ++rt)
#pragma unroll
                for (int u = 0; u < 2; ++u) { const int lim = t0 + (8 * wave + 4 * rt + 2 * c5 + u) - 128 * kt - kl;
#pragma unroll
                    for (int kh = 0; kh < 4; ++kh) fbv[rt][u][kh] = 32 * kh <= lim ? fbv[rt][u][kh] : -1.0f; }
        }
        unsigned basea[2][2], basec[2][2];
#pragma unroll
        for (int rt = 0; rt < 2; ++rt)
#pragma unroll
            for (int u = 0; u < 2; ++u) { const int qq = 8 * wave + 4 * rt + 2 * c5 + u; unsigned na_ = 0u, nk_ = 0u; const float bc0 = (float)bcur[rt][u], bc1 = (float)(bcur[rt][u] + 1);
#pragma unroll
                for (int kh = 0; kh < 4; ++kh) { const float fb = fbv[rt][u][kh]; na_ += fb >= bc1 ? 1u : 0u; nk_ += fb >= bc0 ? 1u : 0u; }
                unsigned base_ = 0u;
                if (nk_) base_ = __hip_atomic_fetch_add(st + 320 + qq, na_ + ((nk_ - na_) << 16), __ATOMIC_RELAXED, __HIP_MEMORY_SCOPE_WORKGROUP);
                basea[rt][u] = base_ & 0xffffu; basec[rt][u] = base_ >> 16; }
#pragma unroll
        for (int rt = 0; rt < 2; ++rt)
#pragma unroll
            for (int u = 0; u < 2; ++u) { const int qq = 8 * wave + 4 * rt + 2 * c5 + u; unsigned sa = basea[rt][u], scn = basec[rt][u]; const float bc0 = (float)bcur[rt][u], bc1 = (float)(bcur[rt][u] + 1);
#pragma unroll
                for (int kh = 0; kh < 4; ++kh) { const int kpos = 128 * kt + 32 * kh + kl; const float fb = fbv[rt][u][kh];
                    const bool pa = fb >= bc1, pc = fb >= bc0 && !pa;
                    if (pa) lsel[qq * 256 + (sa < (unsigned)(TOPK - 1) ? sa : (unsigned)(TOPK - 1))] = (unsigned short)kpos;
                    if (pc) { const unsigned sl = scn < (unsigned)(SEL_CAP - 1) ? scn : (unsigned)(SEL_CAP - 1); lcs[qq * SEL_CAP + sl] = sc[rt][kh][u]; lci[qq * SEL_CAP + sl] = (unsigned short)kpos; }
                    sa += pa ? 1u : 0u; scn += pc ? 1u : 0u; } }
    }
    asm volatile("s_waitcnt vmcnt(0) lgkmcnt(0)" ::: "memory"); __syncthreads();
}
__device__ __forceinline__ void sel_resolve(unsigned char* ws_, LAS unsigned char* lds_, int wave_, int b_, int ub_, int wg_, int first_) {
    SEL_DECLS
    const int wg = uni_i(wg_), first = uni_i(first_);
    unsigned short* sel = (unsigned short*)(ws + WS_SEL);
    gu32* slowl = (gu32*)(ws + WS_CTL + 65536) + (size_t)wg * 132;
    if (first && tid == 0) __hip_atomic_store(slowl, 0u, RLX_AGENT);
    if (st[512] != 0u) return;
#pragma unroll 1
    for (int qi = 0; qi < 8; ++qi) { const int qq = 8 * wave + qi; const int q = q0 + qq;
        const int na = (int)st[192 + qq], need = TOPK - na; int C = (int)(st[320 + qq] >> 16); C = C < SEL_CAP ? C : SEL_CAP;
        const bool slow = st[448 + qq] != 0u;
        if (!slow) {
            LAS unsigned* sh = (LAS unsigned*)(lds + SL_KEYS + wave * 2048); LAS float* sls = (LAS float*)(lds + SL_KEYS + wave * 2048 + 256); LAS unsigned short* sli = (LAS unsigned short*)(lds + SL_KEYS + wave * 2048 + 1280);
            const float sclq = stf[qq]; const float fbase = (float)(int)st[128 + qq];
            sh[lane] = 0u;
            float cs[SEL_CAP / 64]; int ci[SEL_CAP / 64], sb[SEL_CAP / 64];
#pragma unroll
            for (int e = 0; e < SEL_CAP / 64; ++e) { const int i = lane + 64 * e; cs[e] = 0.f; ci[e] = 0; sb[e] = -1;
                if (i < C) { cs[e] = lcs[qq * SEL_CAP + i]; ci[e] = lci[qq * SEL_CAP + i];
                    const float fr_ = (fmaf(cs[e], sclq, 128.0f) - fbase) * 64.0f; sb[e] = (int)__builtin_amdgcn_fmed3f(fr_, 0.f, 63.f); } }
            LDS_WAIT();
#pragma unroll
            for (int e = 0; e < SEL_CAP / 64; ++e) if (sb[e] >= 0) (void)__hip_atomic_fetch_add(sh + sb[e], 1u, __ATOMIC_RELAXED, __HIP_MEMORY_SCOPE_WORKGROUP);
            LDS_WAIT();
            const unsigned cl = sh[lane];
            unsigned v = cl, tt;
            tt = __shfl_down(v, 1); if (lane + 1 < 64) v += tt;
            tt = __shfl_down(v, 2); if (lane + 2 < 64) v += tt;
            tt = __shfl_down(v, 4); if (lane + 4 < 64) v += tt;
            tt = __shfl_down(v, 8); if (lane + 8 < 64) v += tt;
            tt = __shfl_down(v, 16); if (lane + 16 < 64) v += tt;
            tt = __shfl_down(v, 32); if (lane + 32 < 64) v += tt;
            const unsigned ab_ = v - cl;
            const unsigned long long cross = __ballot(ab_ < (unsigned)need && v >= (unsigned)need);
            const int sstar = cross ? (int)__builtin_ctzll(cross) : 0;
            const int na2 = (int)__shfl(ab_, sstar);
            const int need2 = need - na2;
            int base = na; int nsub = 0;
#pragma unroll
            for (int e = 0; e < SEL_CAP / 64; ++e) { const bool up = sb[e] > sstar; const bool eq = sb[e] == sstar;
                const unsigned long long bu = __ballot(up), be = __ballot(eq);
                const unsigned long long lt = (lane == 0) ? 0ull : (~0ull >> (64 - lane));
                if (up) lsel[qq * 256 + base + (int)__builtin_popcountll(bu & lt)] = (unsigned short)ci[e];
                if (eq) { const int p_ = nsub + (int)__builtin_popcountll(be & lt); sls[p_] = cs[e]; sli[p_] = (unsigned short)ci[e]; }
                base += (int)__builtin_popcountll(bu); nsub += (int)__builtin_popcountll(be); }
            LDS_WAIT();
#pragma unroll 1
            for (int i0 = 0; i0 < nsub; i0 += 64) { const int i = i0 + lane;
                if (i < nsub) { const float si = sls[i]; const int ii = sli[i]; int rank = 0;
                    for (int jx = 0; jx < nsub; ++jx) { const float sj = sls[jx]; const int ij = sli[jx]; rank += (sj > si || (sj == si && ij < ii)) ? 1 : 0; }
                    if (rank < need2) lsel[qq * 256 + na + na2 + rank] = (unsigned short)ii; } }
            LDS_WAIT();
            *(v2u*)(sel + (size_t)q * TOPK + 4 * lane) = *(const LAS v2u*)(lsel + qq * 256 + 4 * lane);
        }
    }
    __syncthreads();
    if (tid == 0) { unsigned n = first ? 0u : __hip_atomic_load(slowl, RLX_AGENT);
        for (int qq = 0; qq < 64; ++qq) if (st[448 + qq] != 0u) { if (n < 128u) { __hip_atomic_store(slowl + 1 + n, (unsigned)(q0 + qq), RLX_AGENT); ++n; } }
        __hip_atomic_store(slowl, n, RLX_AGENT); }
    asm volatile("s_waitcnt vmcnt(0)" ::: "memory");
    __syncthreads();
}
#undef SEL_DECLS
#undef SEL_LOAD_A
#undef SEL_STAGE
#undef SEL_SCORES
#undef SEL_MMA
#undef SEL_SUM
#undef SEL_BOUNDARY
__device__ __forceinline__ void dsa_select_slow(unsigned char* ws_, LAS unsigned char* lds_, int wave_, int wg_) {
    LAS unsigned char* const lds = uni_l(lds_); const int wave = uni_i(wave_), wg = uni_i(wg_);
    unsigned char* ws = uni(ws_);
    const bf16* iqf = (const bf16*)(ws + WS_IQF); const unsigned* sgn = (const unsigned*)(ws + WS_SGN); const bf16* ik = (const bf16*)(ws + WS_IK);
    unsigned short* sel = (unsigned short*)(ws + WS_SEL);
    gu32* slowl = (gu32*)(ws + WS_CTL + 65536) + (size_t)wg * 132;
    const int lane = lane_id_v(), tid = wave * 64 + lane; const int kl = lane & 31, c5 = lane >> 5;
    LAS unsigned* keys = (LAS unsigned*)lds;
    LAS unsigned* hist = (LAS unsigned*)(lds + 32768);
    LAS unsigned* ctl = (LAS unsigned*)(lds + 40960);
    const int nq = (int)__builtin_amdgcn_readfirstlane(__hip_atomic_load(slowl, RLX_AGENT));
#pragma unroll 1
    for (int k = 0; k < nq; ++k) {
        const int q = (int)__builtin_amdgcn_readfirstlane(__hip_atomic_load(slowl + 1 + k, RLX_AGENT));
        const int b = q / SEQ, t = q % SEQ, n = t + 1;
        const bf16* ikb = ik + (size_t)b * SEQ * IDIM;
        __syncthreads();
        bf16x8_t af[2]; float sgc[8];
        { const int i = kl, a_ = i >> 3, e_ = i & 3; const int hh_ = 4 * (a_ & 1) + e_; const unsigned m_ = sgn[q];
          const unsigned flip_ = ((m_ >> hh_) & 1u) ? 0x80008000u : 0u;
#pragma unroll
          for (int ks = 0; ks < 2; ++ks) { v4u w_ = *(const v4u*)(iqf + (size_t)q * 256 + hh_ * 32 + 16 * ks + 8 * c5); w_.x ^= flip_; w_.y ^= flip_; w_.z ^= flip_; w_.w ^= flip_; af[ks] = __builtin_bit_cast(bf16x8_t, w_); }
#pragma unroll
          for (int h = 0; h < 8; ++h) sgc[h] = ((m_ >> h) & 1u) ? -__builtin_inff() : __builtin_inff(); }
#pragma unroll 1
        for (int kb0 = wave; kb0 * 32 < n; kb0 += 4 * NWAVES) {
            bf16x8_t kb_[4][2];
#pragma unroll
            for (int j = 0; j < 4; ++j) { int key = 32 * (kb0 + j * NWAVES) + kl; key = key < SEQ ? key : SEQ - 1;
                kb_[j][0] = *(const bf16x8_t*)(ikb + (size_t)key * IDIM + 8 * c5); kb_[j][1] = *(const bf16x8_t*)(ikb + (size_t)key * IDIM + 16 + 8 * c5); }
#pragma unroll
            for (int j = 0; j < 4; ++j) { const int key = 32 * (kb0 + j * NWAVES) + kl;
                f32x16 acc = {0.f,0.f,0.f,0.f,0.f,0.f,0.f,0.f,0.f,0.f,0.f,0.f,0.f,0.f,0.f,0.f};
                acc = __builtin_amdgcn_mfma_f32_32x32x16_f16(__builtin_bit_cast(f16x8_t, af[0]), __builtin_bit_cast(f16x8_t, kb_[j][0]), acc, 0, 0, 0); acc = __builtin_amdgcn_mfma_f32_32x32x16_f16(__builtin_bit_cast(f16x8_t, af[1]), __builtin_bit_cast(f16x8_t, kb_[j][1]), acc, 0, 0, 0);
                float sc = 0.f;
#pragma unroll
                for (int h = 0; h < 8; ++h) sc += __builtin_amdgcn_fmed3f(acc[h], 0.f, sgc[h]);
                if (c5 == 0 && key < SEQ) keys[key] = key_of(sc); } }
        if (tid == 0) { const unsigned z_ = (unsigned)launder_v(0); ctl[0] = z_; ctl[1] = z_ + (unsigned)TOPK; ctl[2] = z_; ctl[3] = z_; }
        unsigned P = 0u, Plo = 0u;
#pragma unroll 1
        for (int lev = 0; lev < 5; ++lev) {
            for (int i = tid; i < 2048; i += NWAVES * 64) hist[i] = 0u;
            asm volatile("s_waitcnt lgkmcnt(0)" ::: "memory"); __syncthreads();
#pragma unroll 1
            for (int i = 0; i < 16; ++i) { const int s_ = tid * 16 + i;
                if (s_ < n) { const unsigned hi = keys[s_], lo = 8191u - (unsigned)s_; bool mt; unsigned dg;
                    if (lev == 0) { mt = true; dg = hi >> 21; } else if (lev == 1) { mt = (hi >> 21) == P; dg = (hi >> 10) & 0x7ffu; } else if (lev == 2) { mt = (hi >> 10) == P; dg = hi & 0x3ffu; }
                    else if (lev == 3) { mt = hi == P; dg = lo >> 6; } else { mt = hi == P && (lo >> 6) == Plo; dg = lo & 63u; }
                    if (mt) (void)__hip_atomic_fetch_add(hist + dg, 1u, __ATOMIC_RELAXED, __HIP_MEMORY_SCOPE_WORKGROUP); } }
            asm volatile("s_waitcnt lgkmcnt(0)" ::: "memory"); __syncthreads();
            const unsigned need = ctl[1];
            const v4u hb = *(const LAS v4u*)(hist + 4 * tid); const unsigned ls = hb.x + hb.y + hb.z + hb.w;
            unsigned v = ls, tt;
            tt = __shfl_down(v, 1); if (lane + 1 < 64) v += tt;
            tt = __shfl_down(v, 2); if (lane + 2 < 64) v += tt;
            tt = __shfl_down(v, 4); if (lane + 4 < 64) v += tt;
            tt = __shfl_down(v, 8); if (lane + 8 < 64) v += tt;
            tt = __shfl_down(v, 16); if (lane + 16 < 64) v += tt;
            tt = __shfl_down(v, 32); if (lane + 32 < 64) v += tt;
            if (lane == 0) ctl[8 + wave] = v;
            asm volatile("s_waitcnt lgkmcnt(0)" ::: "memory"); __syncthreads();
            unsigned above = v - ls;
            for (int w2 = wave + 1; w2 < NWAVES; ++w2) above += ctl[8 + w2];
            if (above < need && above + ls >= need) { unsigned c = above; const unsigned bb[4] = {hb.x, hb.y, hb.z, hb.w}; int bsel = 0; unsigned cab = 0; bool found = false;
#pragma unroll
                for (int i = 3; i >= 0; --i) { const bool hit = !found && (c + bb[i] >= need); if (hit) { bsel = i; cab = c; found = true; } c += bb[i]; }
                const unsigned dv = (unsigned)(4 * tid + bsel);
                if (lev == 0) ctl[0] = dv; else if (lev == 1) ctl[0] = (P << 11) | dv; else if (lev == 2) ctl[0] = (P << 10) | dv; else if (lev == 3) ctl[3] = dv; else ctl[3] = (Plo << 6) | dv;
                ctl[1] = need - cab; ctl[4] = bb[bsel]; }
            asm volatile("s_waitcnt lgkmcnt(0)" ::: "memory"); __syncthreads();
            P = ctl[0]; Plo = ctl[3];
            if (lev == 2 && ctl[1] == ctl[4]) break;
        }
        unsigned short* srow = sel + (size_t)q * TOPK;
        unsigned mymask = 0u;
#pragma unroll 1
        for (int i = 0; i < 16; ++i) { const int s_ = tid * 16 + i;
            if (s_ < n) { const unsigned hi = keys[s_], lo = 8191u - (unsigned)s_; if (hi > P || (hi == P && lo >= Plo)) mymask |= 1u << i; } }
        const unsigned mycnt = (unsigned)__builtin_popcount(mymask);
        unsigned pv_ = mycnt, tt_;
        tt_ = __shfl_up(pv_, 1); if (lane >= 1) pv_ += tt_;
        tt_ = __shfl_up(pv_, 2); if (lane >= 2) pv_ += tt_;
        tt_ = __shfl_up(pv_, 4); if (lane >= 4) pv_ += tt_;
        tt_ = __shfl_up(pv_, 8); if (lane >= 8) pv_ += tt_;
        tt_ = __shfl_up(pv_, 16); if (lane >= 16) pv_ += tt_;
        tt_ = __shfl_up(pv_, 32); if (lane >= 32) pv_ += tt_;
        if (lane == 63) ctl[16 + wave] = pv_;
        asm volatile("s_waitcnt lgkmcnt(0)" ::: "memory"); __syncthreads();
        unsigned slot0 = pv_ - mycnt;
        for (int w2 = 0; w2 < wave; ++w2) slot0 += ctl[16 + w2];
#pragma unroll 1
        for (int i = 0; i < 16; ++i) if ((mymask >> i) & 1u) { if (slot0 < (unsigned)TOPK) srow[slot0] = (unsigned short)(tid * 16 + i); ++slot0; }
    }
    asm volatile("s_waitcnt vmcnt(0) lgkmcnt(0)" ::: "memory");
    __syncthreads();
}

__device__ __forceinline__ unsigned offb(unsigned row, unsigned ch) { return 256u * row + 16u * (ch ^ (((row & 3u) << 2) | ((row >> 2) & 3u))); }
__device__ __forceinline__ void plswap16(float& a, float& b) { asm volatile("s_nop 1\n\tv_permlane16_swap_b32 %0, %1" : "+v"(a), "+v"(b)); }
__device__ __forceinline__ void plswap32(float& a, float& b) { asm volatile("s_nop 1\n\tv_permlane32_swap_b32 %0, %1" : "+v"(a), "+v"(b)); }
__device__ __forceinline__ float rowpair_max(float x) { float a = x, b = x; plswap16(a, b); float m = fmaxf(a, b); a = m; b = m; plswap32(a, b); return fmaxf(a, b); }
__device__ __forceinline__ float rowpair_sum(float x) { float a = x, b = x; plswap16(a, b); float m = a + b; a = m; b = m; plswap32(a, b); return a + b; }
__device__ __forceinline__ s16x4_t vtr(const LAS unsigned char* p) { return __builtin_bit_cast(s16x4_t, __builtin_amdgcn_ds_read_tr16_b64_v4i16((LAS s16x4_t*)p)); }

__device__ __forceinline__ void dsa_attend(unsigned char* ws_, LAS unsigned char* lds_, const float* relb_, int wave_, int vcu_, int G_, int dry_) {
    const int dry = uni_i(dry_);
    LAS unsigned char* const lds = uni_l(lds_); const int wave = uni_i(wave_), vcu = uni_i(vcu_), G = uni_i(G_);
    unsigned char* ws = uni(ws_); const float* relb = uni(relb_);
    const bf16* ckv = (const bf16*)(ws + WS_CKV); bf16* ql = (bf16*)(ws + WS_QL); const unsigned short* sel = (const unsigned short*)(ws + WS_SEL);
    const int lane = lane_id_v(), tid = wave * 64 + lane;
    LAS unsigned char* cb = lds + wave * 16384;
    LAS unsigned short* sidx = (LAS unsigned short*)(lds + 131072 + wave * 512);
    LAS float* biasd = (LAS float*)(lds + 135168);
    for (int i = tid; i < 129 * 8; i += NWAVES * 64) { const int d = i >> 3, h = i & 7; const int bk = d < 128 ? (int)T5_BUCKET[d] : 31; biasd[i] = relb[bk * 8 + h]; }
    __syncthreads();
    const int hl = lane & 15, g = lane >> 4, hq = hl & 7;
    unsigned qko[2][4], pvo[8][2];
#pragma unroll
    for (int rb = 0; rb < 2; ++rb)
#pragma unroll
        for (int s4 = 0; s4 < 4; ++s4) qko[rb][s4] = offb(8u * (hl >> 2) + 4u * rb + (hl & 3), 4 * s4 + g);
#pragma unroll
    for (int cd = 0; cd < 8; ++cd) { const unsigned q4 = hl >> 2, p4 = hl & 3;
        pvo[cd][0] = offb(8u * g + q4, 2 * cd + (p4 >> 1)) + 8u * (p4 & 1); pvo[cd][1] = offb(8u * g + 4u + q4, 2 * cd + (p4 >> 1)) + 8u * (p4 & 1); }
    for (int p = vcu; p < BATCH * 64; p += G) {
        const int b = p >> 6, j = p & 63;
#pragma unroll 1
        for (int half = 0; half < 2; ++half) {
            const int ub = half == 0 ? j : 127 - j;
#pragma unroll 1
            for (int qi = 0; qi < 8; ++qi) {
                const int t = ub * 64 + wave * 8 + qi; const int q = b * SEQ + t; const int nsel = (t + 1) < TOPK ? (t + 1) : TOPK;
                const bf16* ckvb = ckv + (size_t)b * SEQ * KVR; bf16* qlrow = ql + (size_t)q * 1024;
                { const v2u w = *(const v2u*)(sel + (size_t)q * TOPK + 4 * lane); *(LAS v2u*)(sidx + 4 * lane) = w; }
                bf16x8_t qf[4];
#pragma unroll
                for (int s = 0; s < 4; ++s) qf[s] = *(const bf16x8_t*)(qlrow + hq * 128 + 32 * s + 8 * g);
                LDS_WAIT();
                float mrun = -1e30f, lsum = 0.f;
                f32x4 O[8];
#pragma unroll
                for (int c = 0; c < 8; ++c) O[c] = (f32x4){0.f, 0.f, 0.f, 0.f};
#define DSA_GATHER(c_) do { LAS unsigned char* dst_ = cb + ((c_) & 1) * 8192; \
                    _Pragma("unroll") for (int k_ = 0; k_ < 8; ++k_) { const int row_ = 4 * k_ + g; const int kidx_ = sidx[32 * (c_) + row_]; \
                        const int ch_ = hl ^ ((g << 2) | (k_ & 3)); \
                        glds16(ckvb + (size_t)kidx_ * KVR + ch_ * 8, (unsigned)__builtin_amdgcn_readfirstlane((int)(unsigned)(size_t)(dst_ + k_ * 1024))); } } while (0)
                DSA_GATHER(0);
#define DSA_CHUNK(c_, BOFF_) do { const int c = (c_); \
                    if (c < 7) { DSA_GATHER(c + 1); asm volatile("s_waitcnt vmcnt(8)" ::: "memory"); } \
                    else asm volatile("s_waitcnt vmcnt(0)" ::: "memory"); \
                    const LAS unsigned char* img = cb + (BOFF_); \
                    f32x4 S[2]; \
                    _Pragma("unroll") for (int rb = 0; rb < 2; ++rb) { S[rb] = (f32x4){0.f, 0.f, 0.f, 0.f}; \
                        _Pragma("unroll") for (int s = 0; s < 4; ++s) { const bf16x8_t af = *(const LAS bf16x8_t*)(img + qko[rb][s]); S[rb] = __builtin_amdgcn_mfma_f32_16x16x32_bf16(af, qf[s], S[rb], 0, 0, 0); } } \
                    float pv[2][4]; float mx = -1e30f; \
                    _Pragma("unroll") for (int rb = 0; rb < 2; ++rb) { const v2u iw2 = *(const LAS v2u*)(sidx + 32 * c + 8 * g + 4 * rb); \
                        const int ki[4] = {(int)(iw2.x & 0xffffu), (int)(iw2.x >> 16), (int)(iw2.y & 0xffffu), (int)(iw2.y >> 16)}; \
                        _Pragma("unroll") for (int r = 0; r < 4; ++r) { int dist = t - ki[r]; dist = dist < 0 ? 0 : (dist > 128 ? 128 : dist); \
                            float lg = S[rb][r] * 0.125f + biasd[dist * 8 + hq]; \
                            if (32 * c + 8 * g + 4 * rb + r >= nsel) lg = -1e30f; \
                            pv[rb][r] = lg; mx = fmaxf(mx, lg); } } \
                    mx = rowpair_max(mx); \
                    const float mnew = fmaxf(mrun, mx); const float alpha = __expf(mrun - mnew); mrun = mnew; \
                    float rs = 0.f; \
                    _Pragma("unroll") for (int rb = 0; rb < 2; ++rb) \
                        _Pragma("unroll") for (int r = 0; r < 4; ++r) { pv[rb][r] = __expf(pv[rb][r] - mnew); rs += pv[rb][r]; } \
                    rs = rowpair_sum(rs); \
                    lsum = lsum * alpha + rs; \
                    v4u pw; pw.x = pg8::cvt_pk_bf16(pv[0][0], pv[0][1]); pw.y = pg8::cvt_pk_bf16(pv[0][2], pv[0][3]); pw.z = pg8::cvt_pk_bf16(pv[1][0], pv[1][1]); pw.w = pg8::cvt_pk_bf16(pv[1][2], pv[1][3]); \
                    const bf16x8_t pf = __builtin_bit_cast(bf16x8_t, pw); \
                    float al[4]; \
                    _Pragma("unroll") for (int r = 0; r < 4; ++r) al[r] = __shfl(alpha, 4 * g + r); \
                    _Pragma("unroll") for (int cd = 0; cd < 8; ++cd) { \
                        f32x4 o = O[cd]; o[0] *= al[0]; o[1] *= al[1]; o[2] *= al[2]; o[3] *= al[3]; \
                        const s16x4_t b0 = vtr(img + pvo[cd][0]); const s16x4_t b1 = vtr(img + pvo[cd][1]); \
                        bf16x8_t bf; bf[0] = b0[0]; bf[1] = b0[1]; bf[2] = b0[2]; bf[3] = b0[3]; bf[4] = b1[0]; bf[5] = b1[1]; bf[6] = b1[2]; bf[7] = b1[3]; \
                        O[cd] = __builtin_amdgcn_mfma_f32_16x16x32_bf16(pf, bf, o, 0, 0, 0); } } while (0)
#pragma unroll 1
                for (int c2 = 0; c2 < 4; ++c2) { DSA_CHUNK(2 * c2, 0); DSA_CHUNK(2 * c2 + 1, 8192); }
#undef DSA_CHUNK
#undef DSA_GATHER
                const float linv = 1.0f / lsum; float li[4];
#pragma unroll
                for (int r = 0; r < 4; ++r) li[r] = __shfl(linv, 4 * g + r);
                LAS unsigned short* ost = (LAS unsigned short*)cb;
                if (g < 2) {
#pragma unroll
                    for (int cd = 0; cd < 8; ++cd)
#pragma unroll
                        for (int r = 0; r < 4; ++r) ost[(4 * g + r) * 128 + 16 * cd + hl] = (unsigned short)f2bf(O[cd][r] * li[r]);
                }
                LDS_WAIT();
                { const v4u w0 = *(const LAS v4u*)(cb + 32 * lane), w1 = *(const LAS v4u*)(cb + 32 * lane + 16);
                  if (!dry) { *(v4u*)(qlrow + 16 * lane) = w0; *(v4u*)(qlrow + 16 * lane + 8) = w1; } else asm volatile("" :: "v"(w0), "v"(w1)); }
                LDS_WAIT();
            }
        }
    }
    __syncthreads();
}

__device__ __noinline__ void final_norm(const float* const* in_, float* out_, unsigned char* ws_, LAS unsigned char* lds_, int wave_, int vcu_, int G_) {
    const PC F{uni(in_), uni(out_), uni(ws_), uni_l(lds_), uni_i(wave_), uni_i(vcu_), uni_i(G_)}; struct { const float* const* in; float* out; } a{F.in, F.out};
    const int lane_ = lane_id_v(); const int gw = F.vcu * NWAVES + F.wave, NGW = F.G * NWAVES; const float* g = a.in[22];
    f32x4 gv[4];
#pragma unroll
    for (int j = 0; j < 4; ++j) gv[j] = ((const f32x4*)g)[lane_ + 64 * j];
    for (int m = gw; m < M; m += NGW) {
        GAS f32x4* xr = (GAS f32x4*)(a.out + (size_t)m * D) + lane_;
        f32x4 v[4]; float s = 0.f;
#pragma unroll
        for (int j = 0; j < 4; ++j) { v[j] = xr[64 * j]; s += (v[j].x * v[j].x + v[j].y * v[j].y) + (v[j].z * v[j].z + v[j].w * v[j].w); }
        const float rs = 1.0f / sqrtf(wave_sum(s) * (1.0f / D) + EPS);
#pragma unroll
        for (int j = 0; j < 4; ++j) xr[64 * j] = v[j] * rs * gv[j];
    }
}

#define KIN ((const float* const*)__builtin_amdgcn_kernarg_segment_ptr())
constexpr int PH_PER_LAYER = 10, PH_LAYER0 = 2, N_PHASES = PH_LAYER0 + PH_PER_LAYER * DEPTH + 1;

__global__ void __launch_bounds__(NWAVES * 64, 2) mk_fwd(Args args) {
    extern __shared__ __attribute__((aligned(16))) unsigned char lds[];
    Frame F;
    F.lds = (LAS unsigned char*)lds;
    F.MISC = (volatile LAS unsigned*)(F.lds + MISC_OFF);
    F.wave = __builtin_amdgcn_readfirstlane((int)threadIdx.x >> 6);
    F.G = gridDim.x; { const int bx = blockIdx.x; F.vcu = (F.G % 8 == 0) ? (bx % 8) * (F.G / 8) + bx / 8 : bx; }
    F.ws = args.ws; F.ctl = (gu32*)(args.ws + WS_CTL);
    if (threadIdx.x < 64) ((LAS unsigned*)(F.lds + MISC_OFF))[threadIdx.x] = 0u;
    __syncthreads();
    const int lo = args.ph_lo, hi = args.ph_hi;
    const bool multi = (hi - lo) > 1;
    XcdBarrier bar; bar.bar = (unsigned*)(F.ctl + CW_BAR); bar.x = 0; bar.st = nullptr; bar.wave = F.wave;
    if (multi) bar = xcd_barrier_post((unsigned*)(F.ctl + CW_BAR), F.MISC + 8, F.wave);
#define IN(k) (lo <= (k) && (k) < hi)
#define SEAM(k) do { if (IN(k) && IN((k) + 1)) { xcd_barrier(bar); if (PROBE_PHASE == 99) xcd_barrier(bar); } } while (0)

    if (IN(0)) {
#if EN_P0
 for (int rep = (PROBE_PHASE == 1 ? 0 : 1); rep < 2; ++rep) p0_prologue(KIN, args.out, args.ws, F.lds, F.wave, F.vcu, F.G);
#endif
 } SEAM(0);
    if (IN(1)) {
#if !((DIS_MASK >> 7) & 1)
 unsigned char* ws = launder_p(args.ws); bf16* hb = (bf16*)(ws + WS_HB); float* ss = (float*)(ws + WS_SS); (void)hb; (void)ss;
        pg8::Gemm g{(const bf16_t*)(ws + WS_MEMN), (const bf16_t*)(ws + WS_WMEM), MROWS, DEPTH * 2 * CW, D}; pg8::StaticOrder S; S.init(MROWS, DEPTH * 2 * CW, F.G, launder_s((int)blockIdx.x));
        EpiPlainBf16 E{(bf16_t*)(ws + WS_MEMKV), DEPTH * 2 * CW};
        pg8::gemm_phase<EpiPlainBf16, pg8::StaticOrder, true, true>(F.lds + RING_OFF, g, S, E, F.wave);
        { pg8::Gemm g2{(const bf16_t*)(ws + WS_WMEM), (const bf16_t*)(ws + WS_MEMN), DEPTH * 2 * CW, MROWS, D}; pg8::StaticOrder S2; S2.init(DEPTH * 2 * CW, MROWS, F.G, launder_s((int)blockIdx.x));
          EpiPlainBf16 E2{(bf16_t*)(ws + WS_VT), MROWS};
          pg8::gemm_phase<EpiPlainBf16, pg8::StaticOrder, true, true>(F.lds + RING_OFF, g2, S2, E2, F.wave); }
#endif
    } SEAM(1);

    for (int l = 0; l < DEPTH; ++l) {
        const int pb = PH_LAYER0 + PH_PER_LAYER * l;
        const float* hbase = (l == 0) ? args.in[0] : args.out;
        if (IN(pb + 0)) {
#if EN_P0
 if (l > 0) for (int rep = (PROBE_PHASE == 1 ? 0 : 1); rep < 2; ++rep) prep_layer_weights(KIN, args.out, args.ws, F.lds, l, F.wave, F.vcu, F.G);
#endif
 } SEAM(pb + 0);
        if (IN(pb + 1)) {
#if !((DIS_MASK >> 0) & 1)
 unsigned char* ws = launder_p(args.ws); bf16* hb = (bf16*)(ws + WS_HB); float* ss = (float*)(ws + WS_SS); (void)hb; (void)ss;
            pg8::Gemm g{hb, (const bf16_t*)(ws + WS_W1IN), M, 2 * DFF, D}; pg8::StaticOrder S; S.init(M, 2 * DFF, F.G, launder_s((int)blockIdx.x));
            EpiSwiglu E{(bf16_t*)(ws + WS_ACT), ss};
            for (int rep = (PROBE_PHASE == 2 ? 0 : 1); rep < 2; ++rep) pg8::gemm_phase<EpiSwiglu, pg8::StaticOrder, true, true>(F.lds + RING_OFF, g, S, E, F.wave);
#endif
        } SEAM(pb + 1);
        if (IN(pb + 2)) {
#if !((DIS_MASK >> 1) & 1)
 unsigned char* ws = launder_p(args.ws); bf16* hb = (bf16*)(ws + WS_HB); float* ss = (float*)(ws + WS_SS); (void)hb; (void)ss;
            pg8::Gemm g{(const bf16_t*)(ws + WS_ACT), (const bf16_t*)(ws + WS_W1OUT), M, D, DFF}; pg8::StaticOrder S; S.init(M, D, F.G, launder_s((int)blockIdx.x));
            for (int rep = (PROBE_PHASE == 3 ? 0 : 1); rep < 2; ++rep) { EpiResid E{hbase, args.out, hb, ss, 0.5f, (LAS float*)(F.lds + RING_BYTES), rep == 0 ? 1 : 0};
            pg8::gemm_phase<EpiResid, pg8::StaticOrder, true, true>(F.lds + RING_OFF, g, S, E, F.wave); }
#endif
        } SEAM(pb + 2);
        if (IN(pb + 3)) {
#if !((DIS_MASK >> 2) & 1)
 unsigned char* ws = launder_p(args.ws); bf16* hb = (bf16*)(ws + WS_HB); float* ss = (float*)(ws + WS_SS); (void)hb; (void)ss;
            pg8::Gemm g{hb, (const bf16_t*)(ws + WS_WIN), M, INP, D}; pg8::StaticOrder S; S.init(M, INP, F.G, launder_s((int)blockIdx.x));
            EpiInProj E{ss, (bf16_t*)(ws + WS_QL), (float*)(ws + WS_CKVRAW), (bf16_t*)(ws + WS_IK), (float*)(ws + WS_IW), (bf16_t*)(ws + WS_IQRAW), (bf16_t*)(ws + WS_Z), (bf16_t*)(ws + WS_QC), (bf16_t*)(ws + WS_G)};
            for (int rep = (PROBE_PHASE == 4 ? 0 : 1); rep < 2; ++rep) pg8::gemm_phase<EpiInProj, pg8::StaticOrder, true, true>(F.lds + RING_OFF, g, S, E, F.wave);
#endif
        } SEAM(pb + 3);
        if (IN(pb + 4)) {
#if EN_PREP
 for (int rep = (PROBE_PHASE == 5 ? 0 : 1); rep < 2; ++rep) prep_tokens(KIN, args.out, args.ws, F.lds, l, F.wave, F.vcu, F.G, rep == 0 ? 1 : 0);
#endif
 } SEAM(pb + 4);
        if (IN(pb + 5)) {
#if EN_DSA
 for (int rep = (PROBE_PHASE == 6 ? 0 : 1); rep < 2; ++rep) for (int p = F.vcu; p < BATCH * 64; p += F.G) { for (int half = 0; half < 2; ++half) { const int b_ = p >> 6, ub_ = half == 0 ? (p & 63) : 127 - (p & 63);
   sel_pass1(args.ws, F.lds, F.wave, b_, ub_); if (PROBE_PHASE == 61) sel_pass1(args.ws, F.lds, F.wave, b_, ub_); sel_pass2(args.ws, F.lds, F.wave, b_, ub_); if (PROBE_PHASE == 62) sel_pass2(args.ws, F.lds, F.wave, b_, ub_); sel_resolve(args.ws, F.lds, F.wave, b_, ub_, (int)blockIdx.x, (p == F.vcu && half == 0) ? 1 : 0); if (PROBE_PHASE == 63) sel_resolve(args.ws, F.lds, F.wave, b_, ub_, (int)blockIdx.x, 0); } }
 dsa_select_slow(args.ws, F.lds, F.wave, (int)blockIdx.x); for (int rep = (PROBE_PHASE == 7 ? 0 : 1); rep < 2; ++rep) dsa_attend(args.ws, F.lds, args.in[2], F.wave, F.vcu, F.G, rep == 0 ? 1 : 0);
#endif
 } SEAM(pb + 5);
        if (IN(pb + 6)) {
#if !((DIS_MASK >> 3) & 1)
        for (int rep6 = (PROBE_PHASE == 8 ? 0 : 1); rep6 < 2; ++rep6) {
 unsigned char* ws = launder_p(args.ws); bf16* hb = (bf16*)(ws + WS_HB); float* ss = (float*)(ws + WS_SS); (void)hb; (void)ss;
            { pg8::Gemm g{(const bf16_t*)(ws + WS_QL), (const bf16_t*)(ws + WS_WA), M, D, 1024}; pg8::StaticOrder S; S.init(M, D, F.G, launder_s((int)blockIdx.x));
              EpiMerge<0> E{(bf16_t*)(ws + WS_MERGED), (const bf16_t*)(ws + WS_G)};
              pg8::gemm_phase<EpiMerge<0>, pg8::StaticOrder, true, true>(F.lds + RING_OFF, g, S, E, F.wave); }
            { pg8::Gemm g{(const bf16_t*)(ws + WS_YB), (const bf16_t*)(ws + WS_WB), M, D, PW_}; pg8::StaticOrder S; S.init(M, D, F.G, launder_s((int)blockIdx.x));
              EpiMerge<1> E{(bf16_t*)(ws + WS_MERGED), (const bf16_t*)(ws + WS_G)};
              pg8::gemm_phase<EpiMerge<1>, pg8::StaticOrder, true, true>(F.lds + RING_OFF, g, S, E, F.wave); }
            { pg8::Gemm g{(const bf16_t*)(ws + WS_QC), (const bf16_t*)(ws + WS_WC), M, D, CW}; pg8::StaticOrder S; S.init(M, D, F.G, launder_s((int)blockIdx.x));
              EpiMerge<2> E{(bf16_t*)(ws + WS_MERGED), (const bf16_t*)(ws + WS_G)};
              pg8::gemm_phase<EpiMerge<2>, pg8::StaticOrder, true, true>(F.lds + RING_OFF, g, S, E, F.wave); }
        }
#endif
        } SEAM(pb + 6);
        if (IN(pb + 7)) {
#if !((DIS_MASK >> 4) & 1)
 unsigned char* ws = launder_p(args.ws); bf16* hb = (bf16*)(ws + WS_HB); float* ss = (float*)(ws + WS_SS); (void)hb; (void)ss;
            pg8::Gemm g{(const bf16_t*)(ws + WS_MERGED), (const bf16_t*)(ws + WS_WOUT), M, D, D}; pg8::StaticOrder S; S.init(M, D, F.G, launder_s((int)blockIdx.x));
            for (int rep = (PROBE_PHASE == 9 ? 0 : 1); rep < 2; ++rep) { EpiResid E{args.out, args.out, hb, ss, 1.0f, (LAS float*)(F.lds + RING_BYTES), rep == 0 ? 1 : 0};
            pg8::gemm_phase<EpiResid, pg8::StaticOrder, true, true>(F.lds + RING_OFF, g, S, E, F.wave); }
#endif
        } SEAM(pb + 7);
        if (IN(pb + 8)) {
#if !((DIS_MASK >> 5) & 1)
 unsigned char* ws = launder_p(args.ws); bf16* hb = (bf16*)(ws + WS_HB); float* ss = (float*)(ws + WS_SS); (void)hb; (void)ss;
            pg8::Gemm g{hb, (const bf16_t*)(ws + WS_W2IN), M, 2 * DFF, D}; pg8::StaticOrder S; S.init(M, 2 * DFF, F.G, launder_s((int)blockIdx.x));
            EpiSwiglu E{(bf16_t*)(ws + WS_ACT), ss};
            for (int rep = (PROBE_PHASE == 2 ? 0 : 1); rep < 2; ++rep) pg8::gemm_phase<EpiSwiglu, pg8::StaticOrder, true, true>(F.lds + RING_OFF, g, S, E, F.wave);
#endif
        } SEAM(pb + 8);
        if (IN(pb + 9)) {
#if !((DIS_MASK >> 6) & 1)
 unsigned char* ws = launder_p(args.ws); bf16* hb = (bf16*)(ws + WS_HB); float* ss = (float*)(ws + WS_SS); (void)hb; (void)ss;
            pg8::Gemm g{(const bf16_t*)(ws + WS_ACT), (const bf16_t*)(ws + WS_W2OUT), M, D, DFF}; pg8::StaticOrder S; S.init(M, D, F.G, launder_s((int)blockIdx.x));
            for (int rep = (PROBE_PHASE == 3 ? 0 : 1); rep < 2; ++rep) { EpiResid E{args.out, args.out, hb, ss, 0.5f, (LAS float*)(F.lds + RING_BYTES), rep == 0 ? 1 : 0};
            pg8::gemm_phase<EpiResid, pg8::StaticOrder, true, true>(F.lds + RING_OFF, g, S, E, F.wave); }
#endif
        } SEAM(pb + 9);
    }
#if EN_P0
    if (IN(N_PHASES - 1)) { final_norm(KIN, args.out, args.ws, F.lds, F.wave, F.vcu, F.G); }
#endif
#undef IN
#undef SEAM
}

extern "C" void kernel_launch(void* const* d_in, const int* in_sizes, int n_in, void* d_out, int out_size, void* d_ws, size_t ws_size, hipStream_t stream) {
    static int grid = 0;
    if (grid == 0) {
        if (n_in != 23 || in_sizes[0] != M * D || out_size != M * D || ws_size < WS_END) { fprintf(stderr, "kernel_launch: unexpected shapes (n_in %d, ws %zu)\n", n_in, ws_size); grid = -1; return; }
        int dev = 0, cus = 0, per_cu = 0;
        if (hipGetDevice(&dev) != hipSuccess || hipDeviceGetAttribute(&cus, hipDeviceAttributeMultiprocessorCount, dev) != hipSuccess) { grid = -1; return; }
        if (hipFuncSetAttribute((const void*)mk_fwd, hipFuncAttributeMaxDynamicSharedMemorySize, LDS_BYTES) != hipSuccess) { fprintf(stderr, "kernel_launch: hipFuncSetAttribute failed\n"); grid = -1; return; }
        if (hipOccupancyMaxActiveBlocksPerMultiprocessor(&per_cu, (const void*)mk_fwd, NWAVES * 64, LDS_BYTES) != hipSuccess || per_cu < 1) { fprintf(stderr, "kernel_launch: occupancy query says %d\n", per_cu); }
        (void)hipGetLastError();
        grid = cus;
    }
    if (grid < 0) return;
    if (hipMemsetAsync((char*)d_ws + WS_CTL, 0, CTL_ZERO_BYTES, stream) != hipSuccess) return;
    Args a{};
    for (int i = 0; i < 23; ++i) a.in[i] = (const float*)d_in[i];
    a.out = (float*)d_out; a.ws = (unsigned char*)d_ws;
#if MK_ONE_LAUNCH
    a.ph_lo = 0; a.ph_hi = N_PHASES;
    hipLaunchKernelGGL(mk_fwd, dim3(grid), dim3(NWAVES * 64), LDS_BYTES, stream, a);
#endif
}
```

```cpp
#include <hip/hip_runtime.h>
#include <cstdio>
#include <cstdint>

#ifndef MK_ONE_LAUNCH
#define MK_ONE_LAUNCH 1
#endif
#ifndef PROBE_PHASE
#define PROBE_PHASE 0
#endif
#ifndef EN_P0
#define EN_P0 MK_ONE_LAUNCH
#endif
#ifndef EN_PREP
#define EN_PREP MK_ONE_LAUNCH
#endif
#ifndef EN_DSA
#define EN_DSA MK_ONE_LAUNCH
#endif
#ifndef DIS_MASK
#define DIS_MASK 0
#endif
#ifndef MK_ONE_LAUNCH
#define MK_ONE_LAUNCH 1
#endif

__device__ __forceinline__ int lane_id_v() { int l; asm volatile("v_mbcnt_lo_u32_b32 %0, -1, 0\n\tv_mbcnt_hi_u32_b32 %0, -1, %0" : "=v"(l)); return l; }
namespace pg8 {
#define PG8_LAS __attribute__((address_space(3)))
typedef unsigned short bf16_t;
typedef short bf16x8 __attribute__((ext_vector_type(8)));
typedef float f32x4 __attribute__((ext_vector_type(4)));
typedef unsigned u32x4 __attribute__((ext_vector_type(4)));
typedef unsigned u32x2 __attribute__((ext_vector_type(2)));
constexpr int BM = 256, BK = 64, HALF = 128, HTB = HALF * BK * 2, STAGE_BYTES = 8 * HTB, NXCD = 8, WGM = 8;

__host__ __device__ __forceinline__ int lds_byte(int r, int c) { const int st = (r >> 4) * 2 + (c >> 5), rr = r & 15, cc = c & 31, ob = rr * 64 + cc * 2; return st * 1024 + (ob ^ (((ob >> 9) & 1) << 5)); }
__host__ __device__ __forceinline__ void stage_rc(int b, int& R, int& C) { const int st = b / 1024, sb = b % 1024, swz = sb ^ (((sb >> 9) & 1) << 5); R = (st >> 1) * 16 + swz / 64; C = (st & 1) * 32 + (swz % 64) / 2; }
__host__ __device__ __forceinline__ int perm32(int rho) { const int n = rho >> 4, i = rho & 15; return 8 * (i >> 2) + 4 * n + (i & 3); }

struct Unit { int pm, pn; };
struct Gemm { const bf16_t* A; const bf16_t* Bt; int M, N, K; };

struct StaticOrder {
    int nM, nN, nwg, G, c;
    __host__ __device__ void init(int M, int N, int G_, int c_) { nM = M / BM; nN = N / BM; nwg = nM * nN; G = G_; c = c_; }
    __host__ __device__ bool next(int i, Unit& u) const {
        const long L = (long)i * G + c; if (L >= nwg) return false;
        int wgid = (int)L; { const int q = nwg / NXCD, r = nwg % NXCD, xcd = wgid % NXCD, off = wgid / NXCD; wgid = (xcd < r ? xcd * (q + 1) : r * (q + 1) + (xcd - r) * q) + off; }
        const int nig = WGM * nN, gid = wgid / nig, fm = gid * WGM, gsz = (nM - fm) < WGM ? (nM - fm) : WGM;
        u.pm = fm + ((wgid % nig) % gsz); u.pn = (wgid % nig) / gsz; return true;
    }
    __device__ __forceinline__ void a_ready(const Unit&) const {}
    __device__ __forceinline__ void done(const Unit&) const {}
};

__device__ __forceinline__ unsigned cvt_pk_bf16(float lo, float hi) { unsigned r; asm volatile("v_cvt_pk_bf16_f32 %0, %1, %2" : "=v"(r) : "v"(lo), "v"(hi)); return r; }

template <class Epi, class Sched, bool ALIGN_EPI = false, bool SP2 = false>
__device__ __forceinline__ void gemm_phase(PG8_LAS unsigned char* lds, const Gemm g, const Sched& S, const Epi& E, const int wid_) {
    int wid = wid_; asm volatile("" : "+s"(wid));
    const int lane = lane_id_v(), tid = wid * 64 + lane,
              wr = wid >> 2, wc = wid & 3, fr = lane & 15, fq = lane >> 4;
    const int K = g.K, nt = K / BK;
    unsigned voffA[2], voffB[2];
#pragma unroll
    for (int i = 0; i < 2; ++i) { int R, C; stage_rc(tid * 16 + i * 8192, R, C); const int Rb = Epi::PERM ? ((R & ~31) + perm32(R & 31)) : R;
        voffA[i] = (unsigned)(R * K + C) * 2u; voffB[i] = (unsigned)(Rb * K + C) * 2u; }
    const size_t kstep = (size_t)(BK * 2);
    const size_t hstep = (size_t)HALF * K * 2;
    const size_t tstep = 2 * hstep;
    const unsigned ldsw = (unsigned)wid * 1024u;
    const int aoff = lds_byte(wr * 64 + fr, fq * 8), boff = lds_byte(wc * 32 + fr, fq * 8);
#define PG8_SA(b, h) (((b) * 2 + (h)) * HTB)
#define PG8_SB(b, h) ((4 + (b) * 2 + (h)) * HTB)
#define PG8_STAGE(bufoff, gbase, voff) do { _Pragma("unroll") for (int _i = 0; _i < 2; ++_i) \
        __builtin_amdgcn_global_load_lds((const unsigned*)((const char*)(gbase) + (voff)[_i]), (PG8_LAS unsigned*)(lds + (bufoff) + ldsw + _i * 8192), 16, 0, 0); } while (0)
#define PG8_LDA(dst, b, h) do { _Pragma("unroll") for (int m = 0; m < 4; ++m) _Pragma("unroll") for (int k = 0; k < 2; ++k) dst[m][k] = *(const PG8_LAS bf16x8*)(lds + PG8_SA(b, h) + aoff + m * 2048 + k * 1024); } while (0)
#define PG8_LDB(dst, b, h) do { _Pragma("unroll") for (int n = 0; n < 2; ++n) _Pragma("unroll") for (int k = 0; k < 2; ++k) dst[n][k] = *(const PG8_LAS bf16x8*)(lds + PG8_SB(b, h) + boff + n * 2048 + k * 1024); } while (0)
#define PG8_MMA(ai, bj, At, Bt) do { __builtin_amdgcn_s_setprio(1); _Pragma("unroll") for (int m = 0; m < 4; ++m) _Pragma("unroll") for (int n = 0; n < 2; ++n) _Pragma("unroll") for (int k = 0; k < 2; ++k) \
        acc[ai][bj][m][n] = __builtin_amdgcn_mfma_f32_16x16x32_bf16(Bt[n][k], At[m][k], acc[ai][bj][m][n], 0, 0, 0); __builtin_amdgcn_s_setprio(0); } while (0)
#define PG8_WAIT_V(n) asm volatile("s_waitcnt vmcnt(" #n ")" ::: "memory")
#define PG8_WAIT_L(n) asm volatile("s_waitcnt lgkmcnt(" #n ")" ::: "memory")
#define PG8_BAR __builtin_amdgcn_s_barrier()
#define PG8_SCHED __builtin_amdgcn_sched_barrier(0)
    Unit cur, nxt; int ui = 0;
    if (!S.next(0, cur)) return;
    f32x4 acc[2][2][4][2];
#pragma unroll
    for (int a = 0; a < 2; ++a)
#pragma unroll
        for (int b = 0; b < 2; ++b)
#pragma unroll
            for (int m = 0; m < 4; ++m)
#pragma unroll
                for (int n = 0; n < 2; ++n) acc[a][b][m][n] = (f32x4){0.f, 0.f, 0.f, 0.f};
    bf16x8 At[4][2], B0[2][2], B1[2][2];
    const char* cA = (const char*)g.A + (size_t)cur.pm * tstep; const char* cB = (const char*)g.Bt + (size_t)cur.pn * tstep;
    S.a_ready(cur);
    if constexpr (SP2) {
        PG8_STAGE(PG8_SB(0, 0), cB, voffB); PG8_STAGE(PG8_SB(0, 1), cB + hstep, voffB); PG8_STAGE(PG8_SA(0, 0), cA, voffA); PG8_STAGE(PG8_SA(0, 1), cA + hstep, voffA);
        if (wr == 1) PG8_BAR;
        PG8_WAIT_V(2); PG8_BAR;
        PG8_STAGE(PG8_SB(1, 0), cB + kstep, voffB); PG8_STAGE(PG8_SA(1, 0), cA + kstep, voffA); PG8_STAGE(PG8_SB(1, 1), cB + hstep + kstep, voffB);
        PG8_WAIT_V(6); PG8_BAR;
    } else {
        PG8_STAGE(PG8_SB(0, 0), cB, voffB); PG8_STAGE(PG8_SA(0, 0), cA, voffA); PG8_STAGE(PG8_SB(0, 1), cB + hstep, voffB); PG8_STAGE(PG8_SA(0, 1), cA + hstep, voffA);
        if (wr == 1) PG8_BAR;
        PG8_WAIT_V(4); PG8_BAR;
        PG8_STAGE(PG8_SB(1, 0), cB + kstep, voffB); PG8_STAGE(PG8_SA(1, 0), cA + kstep, voffA); PG8_STAGE(PG8_SB(1, 1), cB + hstep + kstep, voffB);
        PG8_WAIT_V(6); PG8_BAR;
    }
    for (;;) {
        const bool has_next = S.next(ui + 1, nxt);
        const char* nA = has_next ? (const char*)g.A + (size_t)nxt.pm * tstep : cA; const char* nB = has_next ? (const char*)g.Bt + (size_t)nxt.pn * tstep : cB;
#pragma nounroll
        for (int t = 0; t < nt; t += 2) {
            const bool last = (t == nt - 2);
            const char* a1 = cA + (size_t)(t + 1) * kstep;
            const char* a2 = last ? nA : cA + (size_t)(t + 2) * kstep; const char* b2 = last ? nB : cB + (size_t)(t + 2) * kstep;
            const char* a3 = a2 + kstep; const char* b3 = b2 + kstep;
            if (last && has_next) S.a_ready(nxt);
            if constexpr (SP2) {
            PG8_LDB(B0, 0, 0); PG8_LDB(B1, 0, 1); PG8_SCHED; PG8_LDA(At, 0, 0); PG8_STAGE(PG8_SA(1, 1), a1 + hstep, voffA);
            PG8_WAIT_V(8); PG8_WAIT_L(0); PG8_BAR; PG8_MMA(0, 0, At, B0); PG8_MMA(0, 1, At, B1); PG8_BAR; PG8_SCHED;
            PG8_LDA(At, 0, 1); PG8_STAGE(PG8_SB(0, 0), b2, voffB); PG8_STAGE(PG8_SB(0, 1), b2 + hstep, voffB); PG8_STAGE(PG8_SA(0, 0), a2, voffA);
            PG8_WAIT_V(8); PG8_WAIT_L(0); PG8_BAR; PG8_MMA(1, 0, At, B0); PG8_MMA(1, 1, At, B1); PG8_BAR; PG8_SCHED;
            PG8_LDB(B0, 1, 0); PG8_LDB(B1, 1, 1); PG8_SCHED; PG8_LDA(At, 1, 0); PG8_STAGE(PG8_SA(0, 1), a2 + hstep, voffA);
            PG8_WAIT_V(8); PG8_WAIT_L(0); PG8_BAR; PG8_MMA(0, 0, At, B0); PG8_MMA(0, 1, At, B1); PG8_BAR; PG8_SCHED;
            PG8_LDA(At, 1, 1); PG8_STAGE(PG8_SB(1, 0), b3, voffB); PG8_STAGE(PG8_SB(1, 1), b3 + hstep, voffB); PG8_STAGE(PG8_SA(1, 0), a3, voffA);
            PG8_WAIT_V(8); PG8_WAIT_L(0); PG8_BAR; PG8_MMA(1, 0, At, B0); PG8_MMA(1, 1, At, B1); PG8_BAR; PG8_SCHED;
            } else {
            PG8_LDB(B0, 0, 0); PG8_SCHED; PG8_LDA(At, 0, 0); PG8_STAGE(PG8_SA(1, 1), a1 + hstep, voffA);
            PG8_WAIT_L(8); PG8_BAR; PG8_WAIT_L(0); PG8_MMA(0, 0, At, B0); PG8_BAR; PG8_SCHED;
            PG8_LDB(B1, 0, 1); PG8_STAGE(PG8_SB(0, 0), b2, voffB);
            PG8_BAR; PG8_WAIT_L(0); PG8_MMA(0, 1, At, B1); PG8_BAR;
            PG8_LDA(At, 0, 1); PG8_STAGE(PG8_SA(0, 0), a2, voffA);
            PG8_BAR; PG8_WAIT_L(0); PG8_MMA(1, 0, At, B0); PG8_BAR; PG8_SCHED;
            PG8_STAGE(PG8_SB(0, 1), b2 + hstep, voffB);
            PG8_WAIT_V(6); PG8_BAR; PG8_MMA(1, 1, At, B1); PG8_BAR;
            PG8_LDB(B0, 1, 0); PG8_SCHED; PG8_LDA(At, 1, 0); PG8_STAGE(PG8_SA(0, 1), a2 + hstep, voffA);
            PG8_WAIT_L(8); PG8_BAR; PG8_WAIT_L(0); PG8_MMA(0, 0, At, B0); PG8_BAR; PG8_SCHED;
            PG8_LDB(B1, 1, 1); PG8_STAGE(PG8_SB(1, 0), b3, voffB);
            PG8_BAR; PG8_WAIT_L(0); PG8_MMA(0, 1, At, B1); PG8_BAR;
            PG8_LDA(At, 1, 1); PG8_STAGE(PG8_SA(1, 0), a3, voffA);
            PG8_BAR; PG8_WAIT_L(0); PG8_MMA(1, 0, At, B0); PG8_BAR; PG8_SCHED;
            PG8_STAGE(PG8_SB(1, 1), b3 + hstep, voffB);
            PG8_WAIT_V(6); PG8_BAR; PG8_MMA(1, 1, At, B1); PG8_BAR;
            }
        }
        if constexpr (ALIGN_EPI) { if (wr == 0) PG8_BAR; }
        E(acc, cur, wr, wc, fr, fq); S.done(cur);
        if (!has_next) break;
#pragma unroll
        for (int a = 0; a < 2; ++a)
#pragma unroll
            for (int b = 0; b < 2; ++b)
#pragma unroll
                for (int m = 0; m < 4; ++m)
#pragma unroll
                    for (int n = 0; n < 2; ++n) acc[a][b][m][n] = (f32x4){0.f, 0.f, 0.f, 0.f};
        cur = nxt; cA = nA; cB = nB; ++ui;
        if constexpr (ALIGN_EPI) { if (wr == 1) PG8_BAR; }
    }
    PG8_WAIT_V(0);
    if constexpr (!ALIGN_EPI) { if (wr == 0) PG8_BAR; }
    PG8_BAR;
#undef PG8_SA
#undef PG8_SB
#undef PG8_STAGE
#undef PG8_LDA
#undef PG8_LDB
#undef PG8_MMA
#undef PG8_WAIT_V
#undef PG8_WAIT_L
#undef PG8_BAR
#undef PG8_SCHED
}
}

constexpr int NWAVES = 8;
constexpr int BATCH = 4, SEQ = 8192, D = 1024, DEPTH = 4, M = BATCH * SEQ;
constexpr int NMEM = 256, MROWS = BATCH * NMEM;
constexpr int AH = 8, AHD = 64, AW = 512, KVR = 128, IH = 8, IDIM = 32, TOPK = 256;
constexpr int PW_ = 256, CH = 4, CHD = 64, CW = 256;
constexpr int DFF = 2816, INW = 4520, INP = 5120;
constexpr float EPS = 1e-6f;
constexpr int C_QA = 0, C_CKV = 512, C_IQ = 640, C_IK = 896, C_IW = 928, C_Z = 936, C_QC = 1192, C_G = 1448;

constexpr size_t MiB = 1u << 20;
constexpr size_t WS_CTL = 0, CTL_ZERO_BYTES = 1 * MiB;
constexpr size_t WS_SS = 1 * MiB;
constexpr size_t WS_IW = 3 * MiB;
constexpr size_t WS_SGN = 4 * MiB;
constexpr size_t WS_MEMN = 5 * MiB;
constexpr size_t WS_WMEM = 7 * MiB;
constexpr size_t WS_MEMKV = 11 * MiB;
constexpr size_t WS_W1IN = 15 * MiB, WS_W1OUT = 26 * MiB, WS_WIN = 32 * MiB, WS_WA = 42 * MiB, WS_WB = 44 * MiB, WS_WC = 44 * MiB + 512 * 1024, WS_WOUT = 45 * MiB, WS_W2IN = 47 * MiB, WS_W2OUT = 58 * MiB;
constexpr size_t WS_HB = 64 * MiB;
constexpr size_t WS_ACT = 128 * MiB;
constexpr size_t WS_G = 128 * MiB;
constexpr size_t WS_QL = 320 * MiB;
constexpr size_t WS_CKV = 384 * MiB;
constexpr size_t WS_CKVRAW = 392 * MiB;
constexpr size_t WS_IQRAW = 408 * MiB;
constexpr size_t WS_IQF = 424 * MiB;
constexpr size_t WS_IK = 440 * MiB;
constexpr size_t WS_Z = 442 * MiB;
constexpr size_t WS_MERGED = 384 * MiB;
constexpr size_t WS_YB = 458 * MiB;
constexpr size_t WS_QC = 474 * MiB;
constexpr size_t WS_SEL = 490 * MiB;
constexpr size_t WS_VT = 506 * MiB;
constexpr size_t WS_WPT = 4 * MiB + 512 * 1024;
constexpr size_t WS_END = 510 * MiB;
constexpr int CW_BAR = 4096;

constexpr int RING_OFF = 0, RING_BYTES = 131072;
constexpr int LDS_BYTES = 155648;
constexpr int MISC_OFF = LDS_BYTES - 256;

#define GAS __attribute__((address_space(1)))
#define LAS __attribute__((address_space(3)))
typedef unsigned short bf16;
typedef unsigned v4u __attribute__((ext_vector_type(4)));
typedef unsigned v2u __attribute__((ext_vector_type(2)));
typedef float f32x4 __attribute__((ext_vector_type(4)));
typedef float f32x2 __attribute__((ext_vector_type(2)));
typedef GAS unsigned gu32;
#define RLX_AGENT __ATOMIC_RELAXED, __HIP_MEMORY_SCOPE_AGENT
#define LDS_WAIT() asm volatile("s_waitcnt lgkmcnt(0)" ::: "memory")
#define VM_WAIT() asm volatile("s_waitcnt vmcnt(0)" ::: "memory")
__device__ __forceinline__ unsigned f2bf(float f) { unsigned u = __builtin_bit_cast(unsigned, f); return (u + 0x7fffu + ((u >> 16) & 1u)) >> 16; }
__device__ __forceinline__ unsigned pk2(float lo, float hi) { return pg8::cvt_pk_bf16(lo, hi); }
__device__ __forceinline__ float bflo(unsigned w) { return __builtin_bit_cast(float, w << 16); }
__device__ __forceinline__ float bfhi(unsigned w) { return __builtin_bit_cast(float, w & 0xffff0000u); }
typedef _Float16 h2_t __attribute__((ext_vector_type(2)));
typedef _Float16 f16x8_t __attribute__((ext_vector_type(8)));
__device__ __forceinline__ unsigned pkh2(float lo, float hi) { const h2_t v = {(_Float16)lo, (_Float16)hi}; return __builtin_bit_cast(unsigned, v); }
__device__ __forceinline__ float hlo(unsigned w) { return (float)__builtin_bit_cast(h2_t, w)[0]; }
__device__ __forceinline__ float hhi(unsigned w) { return (float)__builtin_bit_cast(h2_t, w)[1]; }
__device__ __forceinline__ float bf2f(bf16 b) { return __builtin_bit_cast(float, ((unsigned)b) << 16); }

#define XB_TMO      128
#define XB_XCNT(j)  (256  + 64 * (j))
#define XB_XSUB(j)  (1280 + 64 * (j))
#define XB_XGEN(j)  (2304 + 64 * (j))
#define XB_TOP      3328
#define XB_TOPGEN   3392
#define XCD_BAR_WORDS 3456
#define XB_SPIN_CAP (1u << 23)

__device__ __forceinline__ unsigned xb_ld(unsigned* p)              { return __hip_atomic_load(p, __ATOMIC_RELAXED, __HIP_MEMORY_SCOPE_AGENT); }
__device__ __forceinline__ unsigned xb_add(unsigned* p, unsigned v) { return __hip_atomic_fetch_add(p, v, __ATOMIC_RELAXED, __HIP_MEMORY_SCOPE_AGENT); }
__device__ __forceinline__ unsigned xb_xcc_id() { return (unsigned)__builtin_amdgcn_s_getreg((3 << 11) | 20) & 0xFu; }
#define XB_SPIN(cond, bar) do { unsigned _sp = 0; while (cond) { __builtin_amdgcn_s_sleep(1); \
    if ((++_sp & 255u) == 0u) { if (xb_ld(&(bar)[XB_TMO])) break; if (_sp > XB_SPIN_CAP) { atomicAdd(&(bar)[XB_TMO], 1u); break; } } } } while (0)

struct XcdBarrier { unsigned* bar; unsigned x; volatile LAS unsigned* st; int wave; };

__device__ __forceinline__ XcdBarrier xcd_barrier_post(unsigned* bar, volatile LAS unsigned* st, int wave) {
    XcdBarrier b; b.bar = bar; b.x = xb_xcc_id(); b.st = st; b.wave = wave;
    if (threadIdx.x == 0) (void)xb_add(&bar[XB_XCNT(b.x)], 1u);
    return b;
}
__device__ __forceinline__ void xcd_barrier_complete(unsigned* bar, unsigned x, unsigned& nloc, unsigned& nx) {
    const unsigned G = gridDim.x * gridDim.y * gridDim.z;
    unsigned sum, cnt, mine, sp = 0u;
    for (;;) {
        sum = 0u; cnt = 0u; mine = 0u;
#pragma unroll
        for (unsigned j = 0; j < 16; ++j) { const unsigned c = xb_ld(&bar[XB_XCNT(j)]); sum += c; cnt += (c > 0u) ? 1u : 0u; mine = (j == x) ? c : mine; }
        if (sum == G) break;
        __builtin_amdgcn_s_sleep(1);
        if ((++sp & 255u) == 0u) { if (xb_ld(&bar[XB_TMO])) break; if (sp > XB_SPIN_CAP) { atomicAdd(&bar[XB_TMO], 1u); break; } }
    }
    nloc = mine > 0u ? mine : 1u; nx = cnt > 0u ? cnt : 1u;
}
__device__ __forceinline__ void xcd_barrier(const XcdBarrier& b) {
    asm volatile("s_waitcnt vmcnt(0)" ::: "memory");
    __syncthreads();
    int bw_ = b.wave; asm volatile("" : "+s"(bw_));
    if (bw_ == 0 && lane_id_v() == 0) {
        unsigned* bar = b.bar;
        __builtin_amdgcn_s_waitcnt(0);
        unsigned nloc = b.st[0], nx = b.st[1];
        if (nloc == 0u) { xcd_barrier_complete(bar, b.x, nloc, nx); b.st[0] = nloc; b.st[1] = nx; }
        const unsigned old = xb_add(&bar[XB_XSUB(b.x)], 1u);
        const unsigned gen = old / nloc;
        if (old + 1u == (gen + 1u) * nloc) {
            __builtin_amdgcn_fence(__ATOMIC_RELEASE, "agent");
            asm volatile("s_waitcnt vmcnt(0)" ::: "memory");
            const unsigned og = xb_add(&bar[XB_TOP], 1u);
            const unsigned tg = og / nx;
            if (og + 1u == (tg + 1u) * nx) xb_add(&bar[XB_TOPGEN], 1u);
            else XB_SPIN(xb_ld(&bar[XB_TOPGEN]) == tg, bar);
            __builtin_amdgcn_fence(__ATOMIC_ACQUIRE, "agent");
            xb_add(&bar[XB_XGEN(b.x)], 1u);
            asm volatile("s_waitcnt vmcnt(0)" ::: "memory");
        } else {
            XB_SPIN(xb_ld(&bar[XB_XGEN(b.x)]) == gen, bar);
            __builtin_amdgcn_fence(__ATOMIC_ACQUIRE, "agent");
            asm volatile("s_waitcnt vmcnt(0)" ::: "memory");
        }
    }
    __syncthreads();
}

struct Args {
    const float* in[23]; float* out; unsigned char* ws; int ph_lo, ph_hi;
};
template <class T> __device__ __forceinline__ T* uni(T* p) { const unsigned long long v = (unsigned long long)p; const unsigned lo = __builtin_amdgcn_readfirstlane((unsigned)v), hi = __builtin_amdgcn_readfirstlane((unsigned)(v >> 32)); return (T*)(((unsigned long long)hi << 32) | lo); }
__device__ __forceinline__ LAS unsigned char* uni_l(LAS unsigned char* p) { return (LAS unsigned char*)(unsigned)__builtin_amdgcn_readfirstlane((int)(unsigned)(size_t)p); }
__device__ __forceinline__ int uni_i(int v) { return __builtin_amdgcn_readfirstlane(v); }
struct PC { const float* const* in; float* out; unsigned char* ws; LAS unsigned char* lds; int wave, vcu, G; };
struct Frame {
    LAS unsigned char* lds;
    volatile LAS unsigned* MISC;
    gu32* ctl;
    int wave, vcu, G;
    unsigned char* ws;
};
__device__ __forceinline__ unsigned char* launder_p(unsigned char* p) { asm volatile("" : "+s"(p)); return p; }
__device__ __forceinline__ int launder_s(int v) { asm volatile("" : "+s"(v)); return v; }
__device__ __forceinline__ int launder_v(int v) { asm volatile("" : "+v"(v)); return v; }
__device__ __forceinline__ float wave_sum(float v) {
#pragma unroll
    for (int o = 1; o < 64; o <<= 1) v += __shfl_xor(v, o);
    return v;
}
__device__ __forceinline__ float wave_max(float v) {
#pragma unroll
    for (int o = 1; o < 64; o <<= 1) v = fmaxf(v, __shfl_xor(v, o));
    return v;
}

using pg8::Unit; using pg8::bf16_t;
#define LAUNDER2(a, b) asm volatile("" : "+v"(a), "+v"(b))
__device__ __forceinline__ float row_scale(const float* ss, int row) {
    const f32x4 a = *(const f32x4*)(ss + (size_t)row * 4);
    const float s = (a.x + a.y) + (a.z + a.w);
    return __builtin_amdgcn_rsqf(s * (1.0f / D) + EPS);
}
__device__ __forceinline__ float sigmoidf_(float x) { return __builtin_amdgcn_rcpf(1.0f + __expf(-x)); }
__device__ __forceinline__ pg8::u32x2 pack4(const f32x4 v) { pg8::u32x2 w; w.x = pg8::cvt_pk_bf16(v[0], v[1]); w.y = pg8::cvt_pk_bf16(v[2], v[3]); return w; }

struct EpiSwiglu {
    static constexpr bool PERM = true;
    bf16_t* O; const float* ss;
    __device__ __forceinline__ void operator()(const f32x4 (&acc)[2][2][4][2], const Unit& u, int wr, int wc, int fr_, int fq_) const {
        const int l_ = lane_id_v(); const int fr = l_ & 15, fq = l_ >> 4; (void)fr_; (void)fq_;
        int rb = wr * 64 + fr, cb = wc * 32 + 8 * fq; LAUNDER2(rb, cb);
        const int row0 = u.pm * 256 + rb, col0 = u.pn * 128 + cb;
#pragma unroll
        for (int ai = 0; ai < 2; ++ai)
#pragma unroll
            for (int m = 0; m < 4; ++m) { const int row = row0 + ai * 128 + m * 16;
                const f32x4 sq = *(const f32x4*)(ss + (size_t)row * 4); const float k = ((sq.x + sq.y) + (sq.z + sq.w)) * (1.0f / D) + EPS; const float c1 = __builtin_amdgcn_rsqf(k) * -1.4426950408889634f;
                pg8::u32x4 w;
                { const f32x4 a = acc[ai][0][m][0], b = acc[ai][1][m][0]; f32x4 o;
#pragma unroll
                  for (int i = 0; i < 4; ++i) o[i] = (a[i] * b[i]) * __builtin_amdgcn_rcpf(fmaf(__builtin_amdgcn_exp2f(a[i] * c1), k, k));
                  w.x = pg8::cvt_pk_bf16(o[0], o[1]); w.y = pg8::cvt_pk_bf16(o[2], o[3]); }
                { const f32x4 a = acc[ai][0][m][1], b = acc[ai][1][m][1]; f32x4 o;
#pragma unroll
                  for (int i = 0; i < 4; ++i) o[i] = (a[i] * b[i]) * __builtin_amdgcn_rcpf(fmaf(__builtin_amdgcn_exp2f(a[i] * c1), k, k));
                  w.z = pg8::cvt_pk_bf16(o[0], o[1]); w.w = pg8::cvt_pk_bf16(o[2], o[3]); }
                *(pg8::u32x4*)(O + (size_t)row * DFF + col0) = w; }
    }
};
struct EpiResid {
    static constexpr bool PERM = true;
    const float* base; float* out; bf16_t* hb; float* ss; float alpha; LAS float* P; int dry;
    __device__ __forceinline__ void operator()(const f32x4 (&acc)[2][2][4][2], const Unit& u, int wr, int wc, int fr_, int fq_) const {
        const int l_ = lane_id_v(); const int fr = l_ & 15, fq = l_ >> 4; (void)fr_; (void)fq_;
        int rb = wr * 64 + fr, cb = wc * 32 + 8 * fq; LAUNDER2(rb, cb);
        const int row0 = u.pm * 256 + rb, col0 = u.pn * 256 + cb;
#pragma unroll
        for (int ai = 0; ai < 2; ++ai)
#pragma unroll
          for (int mh = 0; mh < 2; ++mh) {
            f32x4 bs[2][2][2];
#pragma unroll
            for (int mm = 0; mm < 2; ++mm) { const size_t off = (size_t)(row0 + ai * 128 + (2 * mh + mm) * 16) * D + col0;
#pragma unroll
                for (int bj = 0; bj < 2; ++bj)
#pragma unroll
                    for (int n = 0; n < 2; ++n) bs[mm][bj][n] = *(const f32x4*)(base + off + bj * 128 + n * 4); }
#pragma unroll
            for (int mm = 0; mm < 2; ++mm) { const int m = 2 * mh + mm; const int row = row0 + ai * 128 + m * 16; const size_t off = (size_t)row * D + col0; float q = 0.f;
#pragma unroll
                for (int bj = 0; bj < 2; ++bj) { const f32x4 v0 = bs[mm][bj][0] + acc[ai][bj][m][0] * alpha, v1 = bs[mm][bj][1] + acc[ai][bj][m][1] * alpha;
                    if (!dry) { *(f32x4*)(out + off + bj * 128) = v0; *(f32x4*)(out + off + bj * 128 + 4) = v1;
                        pg8::u32x4 w; w.x = pg8::cvt_pk_bf16(v0[0], v0[1]); w.y = pg8::cvt_pk_bf16(v0[2], v0[3]); w.z = pg8::cvt_pk_bf16(v1[0], v1[1]); w.w = pg8::cvt_pk_bf16(v1[2], v1[3]);
                        *(pg8::u32x4*)(hb + off + bj * 128) = w; }
                    q += ((v0[0] * v0[0] + v0[1] * v0[1]) + (v0[2] * v0[2] + v0[3] * v0[3])) + ((v1[0] * v1[0] + v1[1] * v1[1]) + (v1[2] * v1[2] + v1[3] * v1[3])); }
                q += __shfl_xor(q, 16); q += __shfl_xor(q, 32);
                if (fq == 0) P[(rb + ai * 128 + m * 16) * 4 + wc] = q; }
            asm volatile("" ::: "memory"); }
        asm volatile("s_waitcnt lgkmcnt(0)" ::: "memory"); __builtin_amdgcn_s_barrier(); asm volatile("" ::: "memory");
        const int tid = (wr * 4 + wc) * 64 + fq * 16 + fr;
        if (tid < 256 && !dry) { const f32x4 p = *(const LAS f32x4*)(P + tid * 4); ss[(size_t)(u.pm * 256 + tid) * 4 + u.pn] = (p.x + p.y) + (p.z + p.w); }
    }
};
struct EpiPlainBf16 {
    static constexpr bool PERM = false;
    bf16_t* O; int ldo;
    __device__ __forceinline__ void operator()(const f32x4 (&acc)[2][2][4][2], const Unit& u, int wr, int wc, int fr_, int fq_) const {
        const int l_ = lane_id_v(); const int fr = l_ & 15, fq = l_ >> 4; (void)fr_; (void)fq_;
        int rb = wr * 64 + fr, cb = wc * 32 + 4 * fq; LAUNDER2(rb, cb);
        const int row0 = u.pm * 256 + rb, col0 = u.pn * 256 + cb;
#pragma unroll
        for (int ai = 0; ai < 2; ++ai)
#pragma unroll
            for (int m = 0; m < 4; ++m) { bf16_t* rowp = O + (size_t)(row0 + ai * 128 + m * 16) * ldo + col0;
#pragma unroll
                for (int bj = 0; bj < 2; ++bj)
#pragma unroll
                    for (int n = 0; n < 2; ++n) *(pg8::u32x2*)(rowp + bj * 128 + n * 16) = pack4(acc[ai][bj][m][n]); }
    }
};
struct EpiInProj {
    static constexpr bool PERM = true;
    const float* ss; bf16_t* qa; float* ckvraw; bf16_t* ik; float* iw; bf16_t* iqraw; bf16_t* z; bf16_t* qc; bf16_t* G;
    __device__ __forceinline__ void operator()(const f32x4 (&acc)[2][2][4][2], const Unit& u, int wr, int wc, int fr_, int fq_) const {
        const int l_ = lane_id_v(); const int fr = l_ & 15, fq = l_ >> 4; (void)fr_; (void)fq_;
        int rb = wr * 64 + fr, ct = wc * 32 + 8 * fq; LAUNDER2(rb, ct);
        const int row0 = u.pm * 256 + rb; const int pn = u.pn;
        if (pn == 4) {
#pragma unroll
            for (int ai = 0; ai < 2; ++ai)
#pragma unroll
                for (int m = 0; m < 4; ++m) { const int row = row0 + ai * 128 + m * 16; const float s = row_scale(ss, row);
#pragma unroll
                    for (int n = 0; n < 2; ++n) *(f32x4*)(ckvraw + (size_t)row * KVR + ct + n * 4) = acc[ai][0][m][n] * s;
                    if (wc == 0) { const f32x4 k0 = acc[ai][1][m][0] * s, k1 = acc[ai][1][m][1] * s; pg8::u32x4 w; w.x = pkh2(k0[0], k0[1]); w.y = pkh2(k0[2], k0[3]); w.z = pkh2(k1[0], k1[1]); w.w = pkh2(k1[2], k1[3]);
                        *(pg8::u32x4*)(ik + (size_t)row * IDIM + 8 * fq) = w; }
                    if (wc == 1 && fq == 0) { *(f32x4*)(iw + (size_t)row * IH) = acc[ai][1][m][0] * s; *(f32x4*)(iw + (size_t)row * IH + 4) = acc[ai][1][m][1] * s; } }
        } else {
            bf16_t* dst0; int ld; bool sig = false; const bool f16out = (pn == 5);
            if (pn < 4) { dst0 = qa + pn * 256; ld = 1024; } else if (pn == 5) { dst0 = iqraw; ld = 256; } else if (pn == 6) { dst0 = z; ld = 256; } else if (pn == 7) { dst0 = qc; ld = 256; } else { dst0 = G + (pn - 8) * 256; ld = 3072; sig = true; }
#pragma unroll
            for (int ai = 0; ai < 2; ++ai)
#pragma unroll
                for (int m = 0; m < 4; ++m) { const int row = row0 + ai * 128 + m * 16; const float s = row_scale(ss, row); bf16_t* rowp = dst0 + (size_t)row * ld + ct;
#pragma unroll
                    for (int bj = 0; bj < 2; ++bj) { f32x4 o0, o1;
                        if (sig) { const float c1 = s * -1.4426950408889634f;
#pragma unroll
                            for (int i = 0; i < 4; ++i) { o0[i] = __builtin_amdgcn_rcpf(1.0f + __builtin_amdgcn_exp2f(acc[ai][bj][m][0][i] * c1)); o1[i] = __builtin_amdgcn_rcpf(1.0f + __builtin_amdgcn_exp2f(acc[ai][bj][m][1][i] * c1)); } }
                        else { o0 = acc[ai][bj][m][0] * s; o1 = acc[ai][bj][m][1] * s; }
                        pg8::u32x4 wo;
                        if (f16out) { wo.x = pkh2(o0[0], o0[1]); wo.y = pkh2(o0[2], o0[3]); wo.z = pkh2(o1[0], o1[1]); wo.w = pkh2(o1[2], o1[3]); }
                        else { wo.x = pg8::cvt_pk_bf16(o0[0], o0[1]); wo.y = pg8::cvt_pk_bf16(o0[2], o0[3]); wo.z = pg8::cvt_pk_bf16(o1[0], o1[1]); wo.w = pg8::cvt_pk_bf16(o1[2], o1[3]); }
                        *(pg8::u32x4*)(rowp + bj * 128) = wo; } }
        }
    }
};
template <int MODE> struct EpiMerge {
    static constexpr bool PERM = true;
    bf16_t* Mg; const bf16_t* G;
    __device__ __forceinline__ void operator()(const f32x4 (&acc)[2][2][4][2], const Unit& u, int wr, int wc, int fr_, int fq_) const {
        const int l_ = lane_id_v(); const int fr = l_ & 15, fq = l_ >> 4; (void)fr_; (void)fq_;
        int rb = wr * 64 + fr, cb = wc * 32 + 8 * fq; LAUNDER2(rb, cb);
        const int row0 = u.pm * 256 + rb, col0 = u.pn * 256 + cb;
#pragma unroll
        for (int ai = 0; ai < 2; ++ai)
#pragma unroll
          for (int mh = 0; mh < 1; ++mh) {
            pg8::u32x4 gw[4][2], pw[4][2];
#pragma unroll
            for (int mm = 0; mm < 4; ++mm) { const int row = row0 + ai * 128 + mm * 16;
#pragma unroll
                for (int bj = 0; bj < 2; ++bj) { gw[mm][bj] = *(const pg8::u32x4*)(G + (size_t)row * 3072 + MODE * 1024 + col0 + bj * 128);
                    if (MODE > 0) pw[mm][bj] = *(const pg8::u32x4*)(Mg + (size_t)row * D + col0 + bj * 128); } }
#pragma unroll
            for (int mm = 0; mm < 4; ++mm) { const int m = mm; const int row = row0 + ai * 128 + m * 16;
#pragma unroll
                for (int bj = 0; bj < 2; ++bj) { const pg8::u32x4 g4 = gw[mm][bj];
                    f32x4 o0 = acc[ai][bj][m][0], o1 = acc[ai][bj][m][1];
                    o0[0] *= bflo(g4.x); o0[1] *= bfhi(g4.x); o0[2] *= bflo(g4.y); o0[3] *= bfhi(g4.y); o1[0] *= bflo(g4.z); o1[1] *= bfhi(g4.z); o1[2] *= bflo(g4.w); o1[3] *= bfhi(g4.w);
                    if (MODE > 0) { const pg8::u32x4 p4 = pw[mm][bj];
                        o0[0] += bflo(p4.x); o0[1] += bfhi(p4.x); o0[2] += bflo(p4.y); o0[3] += bfhi(p4.y); o1[0] += bflo(p4.z); o1[1] += bfhi(p4.z); o1[2] += bflo(p4.w); o1[3] += bfhi(p4.w); }
                    pg8::u32x4 w; w.x = pg8::cvt_pk_bf16(o0[0], o0[1]); w.y = pg8::cvt_pk_bf16(o0[2], o0[3]); w.z = pg8::cvt_pk_bf16(o1[0], o1[1]); w.w = pg8::cvt_pk_bf16(o1[2], o1[3]);
                    *(pg8::u32x4*)(Mg + (size_t)row * D + col0 + bj * 128) = w; } }
            asm volatile("" ::: "memory"); }
    }
};

template <class Map>
__device__ __forceinline__ void transpose_item(const float* W, int K, int N, const float* gain, bf16* WT, LAS float* scr, int item, int lane, Map map) {
    const int nblk = (N + 63) / 64, kb = item / nblk, nb = item % nblk, k0 = 64 * kb, n0 = 64 * nb;
    const int nn = n0 + 4 * (lane & 15); const bool nok = nn < N;
#pragma unroll 4
    for (int i = 0; i < 16; ++i) { const int kk = 4 * i + (lane >> 4); f32x4 v = nok ? *(const f32x4*)(W + (size_t)(k0 + kk) * N + nn) : (f32x4){0.f, 0.f, 0.f, 0.f};
        if (gain) v = v * gain[k0 + kk];
        *(LAS f32x4*)(scr + kk * 68 + 4 * (lane & 15)) = v; }
    LDS_WAIT(); asm volatile("" ::: "memory");
    const int c = lane & 7;
#pragma unroll
    for (int j = 0; j < 8; ++j) { const int n = (lane >> 3) + 8 * j; const LAS float* sp = scr + (8 * c) * 68 + n;
        v4u o; o.x = pk2(sp[0 * 68], sp[1 * 68]); o.y = pk2(sp[2 * 68], sp[3 * 68]); o.z = pk2(sp[4 * 68], sp[5 * 68]); o.w = pk2(sp[6 * 68], sp[7 * 68]);
        if (n0 + n < N) { const int dr = map(n0 + n); if (dr >= 0) *(GAS v4u*)(WT + (size_t)dr * K + k0 + 8 * c) = o; } }
    LDS_WAIT(); asm volatile("" ::: "memory");
}
struct MapId { int off; __device__ __forceinline__ int operator()(int n) const { return off + n; } };
struct MapSwiglu { __device__ __forceinline__ int operator()(int c) const { const int half = c >= DFF ? 1 : 0, j = c - half * DFF; return 256 * (j >> 7) + 128 * half + (j & 127); } };
struct MapInProj { __device__ __forceinline__ int operator()(int c) const {
    if (c < C_CKV) return -1;
    if (c < C_IQ) return 1024 + (c - C_CKV);
    if (c < C_IK) return 1280 + (c - C_IQ);
    if (c < C_IW) return 1152 + (c - C_IK);
    if (c < C_Z) return 1184 + (c - C_IW);
    if (c < C_QC) return 1536 + (c - C_Z);
    if (c < C_G) return 1792 + (c - C_QC);
    return 2048 + (c - C_G); } };
__device__ __forceinline__ void qlat_item(const float* win, const float* mixn, const float* wuk, bf16* WT, int item, int lane) {
    const int kc = item & 127, rh = (item >> 7) & 1, h = item >> 8; const int r = rh * 64 + lane;
    const f32x4* wp = (const f32x4*)(wuk + (size_t)r * (AH * AHD) + h * 64);
    float acc[8] = {0.f, 0.f, 0.f, 0.f, 0.f, 0.f, 0.f, 0.f};
#pragma unroll 1
    for (int dc = 0; dc < 4; ++dc) {
        const f32x4 w0 = wp[4 * dc], w1 = wp[4 * dc + 1], w2 = wp[4 * dc + 2], w3 = wp[4 * dc + 3];
#pragma unroll
        for (int kk = 0; kk < 8; ++kk) { const f32x4* ip = (const f32x4*)(win + (size_t)(kc * 8 + kk) * INW + h * 64 + 16 * dc);
            const f32x4 a0 = ip[0], a1 = ip[1], a2 = ip[2], a3 = ip[3];
            acc[kk] += (a0.x * w0.x + a0.y * w0.y + a0.z * w0.z + a0.w * w0.w) + (a1.x * w1.x + a1.y * w1.y + a1.z * w1.z + a1.w * w1.w)
                     + (a2.x * w2.x + a2.y * w2.y + a2.z * w2.z + a2.w * w2.w) + (a3.x * w3.x + a3.y * w3.y + a3.z * w3.z + a3.w * w3.w);
            if (kk & 1) asm volatile("" ::: "memory"); }
    }
    const f32x4 g0 = *(const f32x4*)(mixn + kc * 8), g1 = *(const f32x4*)(mixn + kc * 8 + 4);
    v4u w; w.x = pk2(acc[0] * g0.x, acc[1] * g0.y); w.y = pk2(acc[2] * g0.z, acc[3] * g0.w); w.z = pk2(acc[4] * g1.x, acc[5] * g1.y); w.w = pk2(acc[6] * g1.z, acc[7] * g1.w);
    *(GAS v4u*)(WT + (size_t)(h * 128 + r) * D + kc * 8) = w;
}
__device__ __forceinline__ void wafold_item(const float* wuv, const float* wba, bf16* WT, int item, int lane) {
    const int ng = item & 15, rg = (item >> 4) & 15, h = item >> 8; const int n = ng * 64 + lane, r0 = rg * 8;
    float acc[8] = {0.f, 0.f, 0.f, 0.f, 0.f, 0.f, 0.f, 0.f};
#pragma unroll 4
    for (int d = 0; d < 64; ++d) { const float wa = wba[(size_t)(h * 64 + d) * D + n];
#pragma unroll
        for (int j = 0; j < 8; ++j) acc[j] += wuv[(size_t)(r0 + j) * (AH * AHD) + h * 64 + d] * wa; }
    v4u w; w.x = pk2(acc[0], acc[1]); w.y = pk2(acc[2], acc[3]); w.z = pk2(acc[4], acc[5]); w.w = pk2(acc[6], acc[7]);
    *(GAS v4u*)(WT + (size_t)n * 1024 + h * 128 + r0) = w;
}
__device__ __forceinline__ int items_of(int K, int N) { return (K / 64) * ((N + 63) / 64); }

__device__ __forceinline__ void prep_layer_weights_body(const PC& F, int l) {
    struct { const float* const* in; } a{F.in};
    const int lane_ = lane_id_v();
    LAS float* scr = (LAS float*)(F.lds + RING_OFF + F.wave * 17408);
    const int gw = F.vcu * NWAVES + F.wave, NGW = F.G * NWAVES;
    const float* f1n = a.in[3] + (size_t)l * D; const float* f1in = a.in[4] + (size_t)l * D * 2 * DFF; const float* f1out = a.in[5] + (size_t)l * DFF * D;
    const float* mixn = a.in[6] + (size_t)l * D; const float* win = a.in[7] + (size_t)l * D * INW;
    const float* wba = a.in[15] + (size_t)l * AW * D; const float* wbb = a.in[16] + (size_t)l * PW_ * D; const float* wbc = a.in[17] + (size_t)l * CW * D;
    const float* wout = a.in[18] + (size_t)l * D * D;
    const float* f2n = a.in[19] + (size_t)l * D; const float* f2in = a.in[20] + (size_t)l * D * 2 * DFF; const float* f2out = a.in[21] + (size_t)l * DFF * D;
    unsigned char* ws = launder_p(F.ws);
    const float* wuk = a.in[9] + (size_t)l * KVR * AH * AHD; const float* wuv = a.in[10] + (size_t)l * KVR * AH * AHD;
    const int I0 = items_of(D, 2 * DFF), I1 = items_of(DFF, D), I2 = items_of(D, INW), I4 = items_of(PW_, D), I5 = items_of(CW, D), I6 = items_of(D, D);
    const int NIT = 2 * I0 + 2 * I1 + I2 + I4 + I5 + I6;
#pragma unroll 1
    for (int it = gw; it < NIT; it += NGW) {
        int r = it;
        if (r < I0) { transpose_item(f1in, D, 2 * DFF, f1n, (bf16*)(ws + WS_W1IN), scr, r, lane_, MapSwiglu{}); continue; } r -= I0;
        if (r < I0) { transpose_item(f2in, D, 2 * DFF, f2n, (bf16*)(ws + WS_W2IN), scr, r, lane_, MapSwiglu{}); continue; } r -= I0;
        if (r < I1) { transpose_item(f1out, DFF, D, nullptr, (bf16*)(ws + WS_W1OUT), scr, r, lane_, MapId{0}); continue; } r -= I1;
        if (r < I1) { transpose_item(f2out, DFF, D, nullptr, (bf16*)(ws + WS_W2OUT), scr, r, lane_, MapId{0}); continue; } r -= I1;
        if (r < I2) { transpose_item(win, D, INW, mixn, (bf16*)(ws + WS_WIN), scr, r, lane_, MapInProj{}); continue; } r -= I2;
        if (r < I4) { transpose_item(wbb, PW_, D, nullptr, (bf16*)(ws + WS_WB), scr, r, lane_, MapId{0}); continue; } r -= I4;
        if (r < I5) { transpose_item(wbc, CW, D, nullptr, (bf16*)(ws + WS_WC), scr, r, lane_, MapId{0}); continue; } r -= I5;
        transpose_item(wout, D, D, nullptr, (bf16*)(ws + WS_WOUT), scr, r, lane_, MapId{0});
    }
    { const float* wpool = a.in[11] + (size_t)l * 4 * 64 * 64; bf16* wpT = (bf16*)(ws + WS_WPT);
      for (int i = gw * 64 + lane_; i < 4 * 64 * 64; i += NGW * 64) { const int c = i & 63, d = (i >> 6) & 63, g = i >> 12; wpT[i] = (bf16)f2bf(wpool[(g * 64 + c) * 64 + d]); } }
    asm volatile("" ::: "memory");
#pragma unroll 1
    for (int it = gw; it < 2048; it += NGW) wafold_item(wuv, wba, (bf16*)(ws + WS_WA), it, lane_);
    asm volatile("" ::: "memory");
#pragma unroll 1
    for (int it = gw; it < 2048; it += NGW) qlat_item(win, mixn, wuk, (bf16*)(ws + WS_WIN), it, lane_);
}

__device__ __noinline__ void p0_prologue(const float* const* in_, float* out_, unsigned char* ws_, LAS unsigned char* lds_, int wave_, int vcu_, int G_) {
    const PC F{uni(in_), uni(out_), uni(ws_), uni_l(lds_), uni_i(wave_), uni_i(vcu_), uni_i(G_)}; struct { const float* const* in; } a{F.in};
    const int lane_ = lane_id_v();
    const int gw = F.vcu * NWAVES + F.wave, NGW = F.G * NWAVES;
    const float* x = a.in[0]; const float* mem = a.in[1];
    bf16* hb = (bf16*)(F.ws + WS_HB); float* ss = (float*)(F.ws + WS_SS); bf16* memn = (bf16*)(F.ws + WS_MEMN);
    for (int m = gw; m < M + MROWS; m += NGW) {
        const bool ismem = m >= M; const int r = ismem ? m - M : m;
        const GAS f32x4* xr = (const GAS f32x4*)((ismem ? mem : x) + (size_t)r * D) + lane_;
        f32x4 v[4]; float s = 0.f;
#pragma unroll
        for (int j = 0; j < 4; ++j) { v[j] = xr[64 * j]; s += (v[j].x * v[j].x + v[j].y * v[j].y) + (v[j].z * v[j].z + v[j].w * v[j].w); }
        s = wave_sum(s);
        float sc = 1.f;
        if (ismem) sc = 1.0f / sqrtf(s * (1.0f / D) + EPS);
        else if (lane_ < 4) ss[(size_t)r * 4 + lane_] = lane_ == 0 ? s : 0.f;
        GAS unsigned long long* o8 = (GAS unsigned long long*)((ismem ? memn : hb) + (size_t)r * D) + lane_;
#pragma unroll
        for (int j = 0; j < 4; ++j) o8[64 * j] = (unsigned long long)pk2(v[j].x * sc, v[j].y * sc) | ((unsigned long long)pk2(v[j].z * sc, v[j].w * sc) << 32);
    }
    LAS float* scr = (LAS float*)(F.lds + RING_OFF + F.wave * 17408);
    const int IM = items_of(D, 2 * CW);
    for (int it = gw; it < DEPTH * IM; it += NGW) { const int l = it / IM, r = it % IM;
        transpose_item(a.in[14] + (size_t)l * D * 2 * CW, D, 2 * CW, a.in[13] + (size_t)l * D, (bf16*)(F.ws + WS_WMEM), scr, r, lane_, MapId{l * 2 * CW}); }
    prep_layer_weights_body(F, 0);
}
__device__ __noinline__ void prep_layer_weights(const float* const* in_, float* out_, unsigned char* ws_, LAS unsigned char* lds_, int l, int wave_, int vcu_, int G_) {
    const PC F{uni(in_), uni(out_), uni(ws_), uni_l(lds_), uni_i(wave_), uni_i(vcu_), uni_i(G_)}; prep_layer_weights_body(F, uni_i(l));
}

__constant__ unsigned char T5_BUCKET[128] = {0, 1, 2, 3, 4, 5, 6, 7, 8, 9, 10, 11, 12, 13, 14, 15, 16, 16, 16, 17, 17, 18, 18, 18, 19, 19, 19, 20, 20, 20, 20, 21, 21, 21, 21, 22, 22, 22, 22, 22, 23, 23, 23, 23, 23, 23, 24, 24, 24, 24, 24, 24, 25, 25, 25, 25, 25, 25, 25, 26, 26, 26, 26, 26, 26, 26, 26, 27, 27, 27, 27, 27, 27, 27, 27, 27, 27, 28, 28, 28, 28, 28, 28, 28, 28, 28, 28, 29, 29, 29, 29, 29, 29, 29, 29, 29, 29, 29, 29, 30, 30, 30, 30, 30, 30, 30, 30, 30, 30, 30, 30, 30, 30, 31, 31, 31, 31, 31, 31, 31, 31, 31, 31, 31, 31, 31, 31, 31};

typedef short bf16x8_p __attribute__((ext_vector_type(8)));
__device__ __forceinline__ void prep_tokens(const float* const* in_, float* out_, unsigned char* ws_, LAS unsigned char* lds_, int l_, int wave_, int vcu_, int G_, int dry_) {
    const int dry = uni_i(dry_);
    const PC F{uni(in_), uni(out_), uni(ws_), uni_l(lds_), uni_i(wave_), uni_i(vcu_), uni_i(G_)}; struct { const float* const* in; } a{F.in}; const int l = uni_i(l_);
    unsigned char* ws = launder_p(F.ws);
    const float* ckvraw = (const float*)(ws + WS_CKVRAW); bf16* ckv = (bf16*)(ws + WS_CKV);
    const bf16* iqraw = (const bf16*)(ws + WS_IQRAW); bf16* iqf = (bf16*)(ws + WS_IQF); const float* iw = (const float*)(ws + WS_IW); unsigned* sgn = (unsigned*)(ws + WS_SGN);
    const bf16* z = (const bf16*)(ws + WS_Z); bf16* yb = (bf16*)(ws + WS_YB); bf16* qc = (bf16*)(ws + WS_QC);
    const bf16* memkv = (const bf16*)(ws + WS_MEMKV); const bf16* vT = (const bf16*)(ws + WS_VT); const bf16* wpT = (const bf16*)(ws + WS_WPT);
    const float* kvn = a.in[8] + (size_t)l * KVR; const float* pscale = a.in[12] + (size_t)l * PW_;
    const int lane = lane_id_v(), tid = F.wave * 64 + lane;
    const int tok = lane & 15, g4 = lane >> 4;
    LAS unsigned char* Ks = F.lds;
    LAS unsigned char* Vs = F.lds + 36864;
    for (int blk = F.vcu; blk < M / 128; blk += F.G) {
        const int rowb = blk * 128, b = rowb / SEQ, row0 = rowb + F.wave * 16;
#pragma unroll 1
        for (int tt = 0; tt < 16; ++tt) { const int row = row0 + tt;
            { const f32x2 v = *(const f32x2*)(ckvraw + (size_t)row * KVR + 2 * lane); const float q = wave_sum(v.x * v.x + v.y * v.y);
              const float rs = 1.0f / sqrtf(q * (1.0f / KVR) + EPS); const f32x2 g = *(const f32x2*)(kvn + 2 * lane);
              *(unsigned*)(ckv + (size_t)row * KVR + 2 * lane) = pk2(v.x * rs * g.x, v.y * rs * g.y); }
            { const float wv = iw[(size_t)row * IH + (lane >> 3)]; const float aw = fabsf(wv) * (1.0f / 16.0f);
              const v2u q = *(const v2u*)(iqraw + (size_t)row * 256 + 4 * lane);
              v2u o; o.x = pkh2(hlo(q.x) * aw, hhi(q.x) * aw); o.y = pkh2(hlo(q.y) * aw, hhi(q.y) * aw);
              *(v2u*)(iqf + (size_t)row * 256 + 4 * lane) = o;
              const unsigned long long bal = __ballot(wv < 0.f);
              unsigned mask = 0;
#pragma unroll
              for (int h = 0; h < 8; ++h) mask |= ((unsigned)(bal >> (8 * h)) & 1u) << h;
              if (lane == 0) sgn[row] = mask; } }
        { const int row = row0 + tok, spos = row % SEQ;
#pragma unroll 1
          for (int g = 0; g < 4; ++g) { const int w = 2 << g; const int cnt = (spos + 1) < w ? (spos + 1) : w; const float rc = 1.0f / (float)cnt;
              bf16x8_p pf[2];
#pragma unroll
              for (int ks = 0; ks < 2; ++ks) { const int c0 = g * 64 + 32 * ks + 8 * g4; float sum[8], z0[8];
#pragma unroll
                  for (int e = 0; e < 8; ++e) { sum[e] = 0.f; z0[e] = 0.f; }
                  for (int j = 0; j < w; ++j) { if (j < cnt) { const v4u v = *(const v4u*)(z + (size_t)(row - j) * 256 + c0);
                      const float f[8] = {bflo(v.x), bfhi(v.x), bflo(v.y), bfhi(v.y), bflo(v.z), bfhi(v.z), bflo(v.w), bfhi(v.w)};
#pragma unroll
                      for (int e = 0; e < 8; ++e) { sum[e] += f[e]; if (j == 0) z0[e] = f[e]; } } }
                  v4u pw; pw.x = pk2(sum[0] * rc - z0[0], sum[1] * rc - z0[1]); pw.y = pk2(sum[2] * rc - z0[2], sum[3] * rc - z0[3]); pw.z = pk2(sum[4] * rc - z0[4], sum[5] * rc - z0[5]); pw.w = pk2(sum[6] * rc - z0[6], sum[7] * rc - z0[7]);
                  pf[ks] = __builtin_bit_cast(bf16x8_p, pw); }
#pragma unroll
              for (int dt = 0; dt < 4; ++dt) { f32x4 acc = {0.f, 0.f, 0.f, 0.f};
#pragma unroll
                  for (int ks = 0; ks < 2; ++ks) { const bf16x8_p af = *(const bf16x8_p*)(wpT + (size_t)(g * 64 + 16 * dt + tok) * 64 + 32 * ks + 8 * g4); acc = __builtin_amdgcn_mfma_f32_16x16x32_bf16(af, pf[ks], acc, 0, 0, 0); }
                  const f32x4 ps = *(const f32x4*)(pscale + g * 64 + 16 * dt + 4 * g4);
                  v2u o; o.x = pk2(acc[0] * ps.x, acc[1] * ps.y); o.y = pk2(acc[2] * ps.z, acc[3] * ps.w);
                  *(v2u*)(yb + (size_t)row * 256 + g * 64 + 16 * dt + 4 * g4) = o; } } }
#pragma unroll 1
        for (int h = 0; h < CH; ++h) {
            __syncthreads();
#pragma unroll
            for (int e = 0; e < 4; ++e) { const int i = tid + 512 * e;
                { const int m = i >> 3, c = i & 7; const v4u v = *(const v4u*)(memkv + (size_t)(b * NMEM + m) * 2048 + l * 512 + h * 64 + c * 8); *(LAS v4u*)(Ks + m * 144 + c * 16) = v; }
                { const int d = i >> 5, c = i & 31; const v4u v = *(const v4u*)(vT + (size_t)(l * 512 + 256 + h * 64 + d) * MROWS + b * NMEM + c * 8); *(LAS v4u*)(Vs + d * 528 + c * 16) = v; } }
            LDS_WAIT(); __syncthreads();
            const int row = row0 + tok;
            bf16x8_p qf[2];
#pragma unroll
            for (int ks = 0; ks < 2; ++ks) qf[ks] = *(const bf16x8_p*)(qc + (size_t)row * 256 + h * 64 + 32 * ks + 8 * g4);
            f32x4 S[16]; float mx = -1e30f;
#pragma unroll
            for (int mt = 0; mt < 16; ++mt) { f32x4 acc = {0.f, 0.f, 0.f, 0.f};
#pragma unroll
                for (int ks = 0; ks < 2; ++ks) { const bf16x8_p kf = *(const LAS bf16x8_p*)(Ks + (16 * mt + tok) * 144 + (4 * ks + g4) * 16); acc = __builtin_amdgcn_mfma_f32_16x16x32_bf16(kf, qf[ks], acc, 0, 0, 0); }
                S[mt] = acc; mx = fmaxf(mx, fmaxf(fmaxf(acc[0], acc[1]), fmaxf(acc[2], acc[3]))); if ((mt & 3) == 3) __builtin_amdgcn_sched_barrier(0); }
            mx = fmaxf(mx, __shfl_xor(mx, 16)); mx = fmaxf(mx, __shfl_xor(mx, 32));
            float sm = 0.f;
#pragma unroll
            for (int mt = 0; mt < 16; ++mt)
#pragma unroll
                for (int r = 0; r < 4; ++r) { const float p = __expf((S[mt][r] - mx) * 0.125f); S[mt][r] = p; sm += p; }
            sm += __shfl_xor(sm, 16); sm += __shfl_xor(sm, 32);
            const float inv = 1.0f / sm;
            f32x4 oacc[4];
#pragma unroll
            for (int dt = 0; dt < 4; ++dt) oacc[dt] = (f32x4){0.f, 0.f, 0.f, 0.f};
#pragma unroll
            for (int kk = 0; kk < 8; ++kk) { v4u pw; pw.x = pg8::cvt_pk_bf16(S[2 * kk][0], S[2 * kk][1]); pw.y = pg8::cvt_pk_bf16(S[2 * kk][2], S[2 * kk][3]); pw.z = pg8::cvt_pk_bf16(S[2 * kk + 1][0], S[2 * kk + 1][1]); pw.w = pg8::cvt_pk_bf16(S[2 * kk + 1][2], S[2 * kk + 1][3]);
                const bf16x8_p pfr = __builtin_bit_cast(bf16x8_p, pw);
#pragma unroll
                for (int dt = 0; dt < 4; ++dt) { const LAS unsigned char* vp = Vs + (16 * dt + tok) * 528 + (32 * kk + 4 * g4) * 2;
                    const v2u lo = *(const LAS v2u*)vp, hi = *(const LAS v2u*)(vp + 32);
                    v4u vw; vw.x = lo.x; vw.y = lo.y; vw.z = hi.x; vw.w = hi.y;
                    oacc[dt] = __builtin_amdgcn_mfma_f32_16x16x32_bf16(__builtin_bit_cast(bf16x8_p, vw), pfr, oacc[dt], 0, 0, 0); }
                __builtin_amdgcn_sched_barrier(0); }
#pragma unroll
            for (int dt = 0; dt < 4; ++dt) { v2u o; o.x = pk2(oacc[dt][0] * inv, oacc[dt][1] * inv); o.y = pk2(oacc[dt][2] * inv, oacc[dt][3] * inv);
                if (!dry) *(v2u*)(qc + (size_t)row * 256 + h * 64 + 16 * dt + 4 * g4) = o; else asm volatile("" :: "v"(o.x), "v"(o.y)); }
        }
    }
    __syncthreads();
}

__device__ __forceinline__ unsigned key_of(float s) { const unsigned u = __builtin_bit_cast(unsigned, s); return (u & 0x80000000u) ? ~u : (u | 0x80000000u); }

typedef short bf16x8_t __attribute__((ext_vector_type(8)));
typedef short s16x4_t __attribute__((ext_vector_type(4)));
__device__ __forceinline__ void glds16(const void* gsrc, unsigned lds_dst) { unsigned keep;
    asm volatile("s_mov_b32 %0, m0\n\ts_mov_b32 m0, %2\n\ts_nop 0\n\tglobal_load_lds_dwordx4 %1, off\n\ts_mov_b32 m0, %0" : "=&s"(keep) : "v"(gsrc), "s"(lds_dst) : "memory"); }
typedef float f32x16 __attribute__((ext_vector_type(16)));
constexpr int SEL_CAP = 256;
constexpr int HSTR = 264;
constexpr int SL_HIST = 0, SL_SEL = 0, SL_CS = 32768, SL_CI = 98304, SL_KEYS = 131072, SL_ST = 147456;

#define SEL_DECLS \
    LAS unsigned char* const lds = uni_l(lds_); const int wave = uni_i(wave_), b = uni_i(b_), ub = uni_i(ub_); unsigned char* ws = uni(ws_); \
    const bf16* iqf = (const bf16*)(ws + WS_IQF); const unsigned* sgn = (const unsigned*)(ws + WS_SGN); const bf16* ik = (const bf16*)(ws + WS_IK); \
    const int lane = lane_id_v(), tid = wave * 64 + lane; const int kl = lane & 31, c5 = lane >> 5; \
    LAS unsigned* hist = (LAS unsigned*)(lds + SL_HIST); LAS unsigned short* lsel = (LAS unsigned short*)(lds + SL_SEL); LAS float* lcs = (LAS float*)(lds + SL_CS); \
    LAS unsigned short* lci = (LAS unsigned short*)(lds + SL_CI); LAS unsigned* st = (LAS unsigned*)(lds + SL_ST); LAS float* stf = (LAS float*)(lds + SL_ST); \
    const int t0 = ub * 64; const int q0 = b * SEQ + t0; const bf16* ikb = ik + (size_t)b * SEQ * IDIM; const int ntile = (t0 + 64 + 127) >> 7; \
    (void)hist; (void)lsel; (void)lcs; (void)lci; (void)stf; (void)tid;
#define SEL_LOAD_A \
    bf16x8_t af[2][2]; float sgc[2][16]; \
    { const int i = kl, a_ = i >> 3, cc_ = (i >> 2) & 1, e_ = i & 3; const int qq_ = 2 * cc_ + (a_ >> 1), hh_ = 4 * (a_ & 1) + e_; \
      _Pragma("unroll") for (int rt = 0; rt < 2; ++rt) { const unsigned flip_ = ((sgn[q0 + 8 * wave + 4 * rt + qq_] >> hh_) & 1u) ? 0x80008000u : 0u;     \
          _Pragma("unroll") for (int ks = 0; ks < 2; ++ks) { v4u w_ = *(const v4u*)(iqf + (size_t)(q0 + 8 * wave + 4 * rt + qq_) * 256 + hh_ * 32 + 16 * ks + 8 * c5); \
              w_.x ^= flip_; w_.y ^= flip_; w_.z ^= flip_; w_.w ^= flip_; af[rt][ks] = __builtin_bit_cast(bf16x8_t, w_); } } \
      _Pragma("unroll") for (int rt = 0; rt < 2; ++rt) _Pragma("unroll") for (int u = 0; u < 2; ++u) { const unsigned m_ = sgn[q0 + 8 * wave + 4 * rt + 2 * c5 + u]; \
          _Pragma("unroll") for (int h = 0; h < 8; ++h) sgc[rt][8 * u + h] = ((m_ >> h) & 1u) ? -__builtin_inff() : __builtin_inff(); } }
#define SEL_STAGE(kt_) do { const int key_ = 16 * wave + (lane >> 2); const int ch_ = (lane & 3) ^ ((key_ >> 2) & 3); \
    glds16(ikb + (size_t)(128 * (kt_) + key_) * IDIM + ch_ * 8, (unsigned)__builtin_amdgcn_readfirstlane((int)(unsigned)(size_t)(lds + SEL_KBUF(kt_) + wave * 1024))); } while (0)
#define SEL_MMA(acc_, rt_, kh_) do { acc_ = (f32x16){0.f,0.f,0.f,0.f,0.f,0.f,0.f,0.f,0.f,0.f,0.f,0.f,0.f,0.f,0.f,0.f}; \
    acc_ = __builtin_amdgcn_mfma_f32_32x32x16_f16(__builtin_bit_cast(f16x8_t, af[rt_][0]), __builtin_bit_cast(f16x8_t, bfr_[kh_][0]), acc_, 0, 0, 0); \
    acc_ = __builtin_amdgcn_mfma_f32_32x32x16_f16(__builtin_bit_cast(f16x8_t, af[rt_][1]), __builtin_bit_cast(f16x8_t, bfr_[kh_][1]), acc_, 0, 0, 0); } while (0)
#define SEL_SUM(acc_, rt_, kh_) do { _Pragma("unroll") for (int u = 0; u < 2; ++u) { float s_ = 0.f; \
    _Pragma("unroll") for (int h = 0; h < 8; ++h) s_ += __builtin_amdgcn_fmed3f(acc_[8 * u + h], 0.f, sgc[rt_][8 * u + h]); \
    sc[rt_][kh_][u] = s_; } } while (0)
#define SEL_SCORES(kt_) do { const LAS unsigned char* kb_ = lds + SEL_KBUF(kt_); bf16x8_t bfr_[4][2]; \
    _Pragma("unroll") for (int kh = 0; kh < 4; ++kh) { const int key_ = 32 * kh + kl; \
        bfr_[kh][0] = *(const LAS bf16x8_t*)(kb_ + key_ * 64 + 16 * ((0 + c5) ^ ((key_ >> 2) & 3))); \
        bfr_[kh][1] = *(const LAS bf16x8_t*)(kb_ + key_ * 64 + 16 * ((2 + c5) ^ ((key_ >> 2) & 3))); } \
    f32x16 accA_, accB_; \
    SEL_MMA(accA_, 0, 0); \
    SEL_MMA(accB_, 1, 0); __builtin_amdgcn_sched_barrier(0); SEL_SUM(accA_, 0, 0); __builtin_amdgcn_sched_barrier(0); \
    SEL_MMA(accA_, 0, 1); __builtin_amdgcn_sched_barrier(0); SEL_SUM(accB_, 1, 0); __builtin_amdgcn_sched_barrier(0); \
    SEL_MMA(accB_, 1, 1); __builtin_amdgcn_sched_barrier(0); SEL_SUM(accA_, 0, 1); __builtin_amdgcn_sched_barrier(0); \
    SEL_MMA(accA_, 0, 2); __builtin_amdgcn_sched_barrier(0); SEL_SUM(accB_, 1, 1); __builtin_amdgcn_sched_barrier(0); \
    SEL_MMA(accB_, 1, 2); __builtin_amdgcn_sched_barrier(0); SEL_SUM(accA_, 0, 2); __builtin_amdgcn_sched_barrier(0); \
    SEL_MMA(accA_, 0, 3); __builtin_amdgcn_sched_barrier(0); SEL_SUM(accB_, 1, 2); __builtin_amdgcn_sched_barrier(0); \
    SEL_MMA(accB_, 1, 3); __builtin_amdgcn_sched_barrier(0); SEL_SUM(accA_, 0, 3); __builtin_amdgcn_sched_barrier(0); \
    SEL_SUM(accB_, 1, 3); } while (0)
#define SEL_BOUNDARY(FINAL) do { \
    const int qq = tid >> 3, part = tid & 7; const LAS v4u* hp = (const LAS v4u*)(hist + qq * HSTR + 32 * part); \
    unsigned bins[32]; \
    _Pragma("unroll") for (int i = 0; i < 8; ++i) { const v4u v = hp[i]; bins[4 * i] = v.x; bins[4 * i + 1] = v.y; bins[4 * i + 2] = v.z; bins[4 * i + 3] = v.w; } \
    unsigned ps = 0; \
    _Pragma("unroll") for (int i = 0; i < 32; ++i) ps += bins[i]; \
    unsigned v = ps, tt; \
    tt = __shfl_down(v, 1, 8); if (part + 1 < 8) v += tt; \
    tt = __shfl_down(v, 2, 8); if (part + 2 < 8) v += tt; \
    tt = __shfl_down(v, 4, 8); if (part + 4 < 8) v += tt; \
    unsigned cacc = v - ps; \
    if (cacc < (unsigned)TOPK && v >= (unsigned)TOPK) { int bsel = 0; unsigned na = 0, cb = 0; bool found = false; \
        _Pragma("unroll") for (int i = 31; i >= 0; --i) { const bool hit = !found && (cacc + bins[i] >= (unsigned)TOPK); if (hit) { bsel = i; na = cacc; cb = bins[i]; found = true; } cacc += bins[i]; } \
        st[128 + qq] = (unsigned)(32 * part + bsel); if (FINAL) { st[192 + qq] = na; st[256 + qq] = cb; st[448 + qq] = cb > (unsigned)SEL_CAP ? 1u : 0u; } } } while (0)

#define SEL_KBUF(kt_) (69632 + ((kt_) & 3) * 8192)
__device__ __forceinline__ void sel_pass1(unsigned char* ws_, LAS unsigned char* lds_, int wave_, int b_, int ub_) {
    SEL_DECLS
    unsigned short* sel = (unsigned short*)(ws + WS_SEL);
    __syncthreads();
    if (ub < 4) {
        for (int i = tid; i < 64 * TOPK; i += NWAVES * 64) { const int qq = i >> 8, sl = i & 255; sel[(size_t)(q0 + qq) * TOPK + sl] = (unsigned short)(sl <= t0 + qq ? sl : 0); }
        if (tid == 0) st[512] = 1u;
        asm volatile("s_waitcnt vmcnt(0) lgkmcnt(0)" ::: "memory"); __syncthreads();
        return;
    }
    SEL_LOAD_A
    for (int i = tid; i < 64 * HSTR; i += NWAVES * 64) hist[i] = 0u;
    if (tid < 64) { st[128 + tid] = 0u; st[448 + tid] = 0u; }
    if (tid == 0) st[512] = 0u;
    float sc[2][4][2];
    float scl[2][2]; int bcur[2][2];
#pragma unroll
    for (int rt = 0; rt < 2; ++rt)
#pragma unroll
        for (int u = 0; u < 2; ++u) { scl[rt][u] = 0.f; bcur[rt][u] = 0; }
    SEL_STAGE(0); if (ntile > 1) SEL_STAGE(1);
#pragma unroll 1
    for (int kt2 = 0; kt2 < ntile; kt2 += 2) {
        asm volatile("s_waitcnt vmcnt(0) lgkmcnt(0)" ::: "memory"); __syncthreads();
        if (kt2 > 0 && (kt2 & 3) == 0) {
            SEL_BOUNDARY(false);
            asm volatile("s_waitcnt lgkmcnt(0)" ::: "memory"); __syncthreads();
#pragma unroll
            for (int rt = 0; rt < 2; ++rt)
#pragma unroll
                for (int u = 0; u < 2; ++u) bcur[rt][u] = (int)st[128 + 8 * wave + 4 * rt + 2 * c5 + u];
        }
        if (kt2 + 2 < ntile) SEL_STAGE(kt2 + 2);
        if (kt2 + 3 < ntile) SEL_STAGE(kt2 + 3);
#pragma unroll 1
        for (int kt = kt2; kt < kt2 + 2 && kt < ntile; ++kt) {
        SEL_SCORES(kt);
        if (kt == 0) {
#pragma unroll
            for (int rt = 0; rt < 2; ++rt)
#pragma unroll
                for (int u = 0; u < 2; ++u) { float mx = 0.f;
#pragma unroll
                    for (int kh = 0; kh < 4; ++kh) mx = fmaxf(mx, fabsf(sc[rt][kh][u]));
#pragma unroll
                    for (int o = 1; o < 32; o <<= 1) mx = fmaxf(mx, __shfl_xor(mx, o));
                    const float R = mx > 0.f ? mx : 1.0f;
                    scl[rt][u] = 128.0f / R;
                    if (kl == 0) stf[8 * wave + 4 * rt + 2 * c5 + u] = scl[rt][u]; }
        }
        const bool masked = 128 * kt + 127 > t0;
        if (masked) {
#pragma unroll
        for (int rt = 0; rt < 2; ++rt)
#pragma unroll
            for (int u = 0; u < 2; ++u) { const int qq = 8 * wave + 4 * rt + 2 * c5 + u; const int lim = t0 + qq - 128 * kt - kl;
#pragma unroll
                for (int kh = 0; kh < 4; ++kh) { const float fb = __builtin_amdgcn_fmed3f(fmaf(sc[rt][kh][u], scl[rt][u], 128.0f), 0.f, 255.f);
                    if (fb >= (float)bcur[rt][u] && 32 * kh <= lim) (void)__hip_atomic_fetch_add(hist + qq * HSTR + (int)fb, 1u, __ATOMIC_RELAXED, __HIP_MEMORY_SCOPE_WORKGROUP); } }
        } else {
#pragma unroll
        for (int rt = 0; rt < 2; ++rt)
#pragma unroll
            for (int u = 0; u < 2; ++u) { const int qq = 8 * wave + 4 * rt + 2 * c5 + u;
#pragma unroll
                for (int kh = 0; kh < 4; ++kh) { const float fb = __builtin_amdgcn_fmed3f(fmaf(sc[rt][kh][u], scl[rt][u], 128.0f), 0.f, 255.f);
                    if (fb >= (float)bcur[rt][u]) (void)__hip_atomic_fetch_add(hist + qq * HSTR + (int)fb, 1u, __ATOMIC_RELAXED, __HIP_MEMORY_SCOPE_WORKGROUP); } }
        }
        }
    }
    asm volatile("s_waitcnt vmcnt(0) lgkmcnt(0)" ::: "memory"); __syncthreads();
    SEL_BOUNDARY(true);
    if (tid < 64) { st[320 + tid] = 0u; st[384 + tid] = 0u; }
    asm volatile("s_waitcnt lgkmcnt(0)" ::: "memory"); __syncthreads();
}
#undef SEL_KBUF
#define SEL_KBUF(kt_) (SL_KEYS + ((kt_) & 1) * 8192)
__device__ __forceinline__ void sel_pass2(unsigned char* ws_, LAS unsigned char* lds_, int wave_, int b_, int ub_) {
    SEL_DECLS
    if (st[512] != 0u) return;
    if (tid < 64) { st[320 + tid] = 0u; st[384 + tid] = 0u; }
    SEL_LOAD_A
    float sc[2][4][2];
    float scl[2][2]; int bcur[2][2];
#pragma unroll
    for (int rt = 0; rt < 2; ++rt)
#pragma unroll
        for (int u = 0; u < 2; ++u) { const int qq = 8 * wave + 4 * rt + 2 * c5 + u; scl[rt][u] = stf[qq]; bcur[rt][u] = (int)st[128 + qq]; }
    SEL_STAGE(0);
#pragma unroll 1
    for (int kt = 0; kt < ntile; ++kt) {
        asm volatile("s_waitcnt vmcnt(0) lgkmcnt(0)" ::: "memory"); __syncthreads();
        if (kt + 1 < ntile) SEL_STAGE(kt + 1);
        SEL_SCORES(kt);
        const bool masked = 128 * kt + 127 > t0;
        float fbv[2][2][4];
#pragma unroll
        for (int rt = 0; rt < 2; ++rt)
#pragma unroll
            for (int u = 0; u < 2; ++u)
#pragma unroll
                for (int kh = 0; kh < 4; ++kh) fbv[rt][u][kh] = __builtin_amdgcn_fmed3f(fmaf(sc[rt][kh][u], scl[rt][u], 128.0f), 0.f, 255.f);
        if (masked) {
#pragma unroll
            for (int rt = 0; rt < 2; ++rt)
#pragma unroll
                for (int u = 0; u < 2; ++u) { const int lim = t0 + (8 * wave + 4 * rt + 2 * c5 + u) - 128 * kt - kl;
#pragma unroll
                    for (int kh = 0; kh < 4; ++kh) fbv[rt][u][kh] = 32 * kh <= lim ? fbv[rt][u][kh] : -1.0f; }
        }
        unsigned basea[2][2], basec[2][2];
#pragma unroll
        for (int rt = 0; rt < 2; ++rt)
#pragma unroll
            for (int u = 0; u < 2; ++u) { const int qq = 8 * wave + 4 * rt + 2 * c5 + u; unsigned na_ = 0u, nk_ = 0u; const float bc0 = (float)bcur[rt][u], bc1 = (float)(bcur[rt][u] + 1);
#pragma unroll
                for (int kh = 0; kh < 4; ++kh) { const float fb = fbv[rt][u][kh]; na_ += fb >= bc1 ? 1u : 0u; nk_ += fb >= bc0 ? 1u : 0u; }
                unsigned base_ = 0u;
                if (nk_) base_ = __hip_atomic_fetch_add(st + 320 + qq, na_ + ((nk_ - na_) << 16), __ATOMIC_RELAXED, __HIP_MEMORY_SCOPE_WORKGROUP);
                basea[rt][u] = base_ & 0xffffu; basec[rt][u] = base_ >> 16; }
#pragma unroll
        for (int rt = 0; rt < 2; ++rt)
#pragma unroll
            for (int u = 0; u < 2; ++u) { const int qq = 8 * wave + 4 * rt + 2 * c5 + u; unsigned sa = basea[rt][u], scn = basec[rt][u]; const float bc0 = (float)bcur[rt][u], bc1 = (float)(bcur[rt][u] + 1);
#pragma unroll
                for (int kh = 0; kh < 4; ++kh) { const int kpos = 128 * kt + 32 * kh + kl; const float fb = fbv[rt][u][kh];
                    const bool pa = fb >= bc1, pc = fb >= bc0 && !pa;
                    if (pa) lsel[qq * 256 + (sa < (unsigned)(TOPK - 1) ? sa : (unsigned)(TOPK - 1))] = (unsigned short)kpos;
                    if (pc) { const unsigned sl = scn < (unsigned)(SEL_CAP - 1) ? scn : (unsigned)(SEL_CAP - 1); lcs[qq * SEL_CAP + sl] = sc[rt][kh][u]; lci[qq * SEL_CAP + sl] = (unsigned short)kpos; }
                    sa += pa ? 1u : 0u; scn += pc ? 1u : 0u; } }
    }
    asm volatile("s_waitcnt vmcnt(0) lgkmcnt(0)" ::: "memory"); __syncthreads();
}
__device__ __forceinline__ void sel_resolve(unsigned char* ws_, LAS unsigned char* lds_, int wave_, int b_, int ub_, int wg_, int first_) {
    SEL_DECLS
    const int wg = uni_i(wg_), first = uni_i(first_);
    unsigned short* sel = (unsigned short*)(ws + WS_SEL);
    gu32* slowl = (gu32*)(ws + WS_CTL + 65536) + (size_t)wg * 132;
    if (first && tid == 0) __hip_atomic_store(slowl, 0u, RLX_AGENT);
    if (st[512] != 0u) return;
#pragma unroll 1
    for (int qi = 0; qi < 8; ++qi) { const int qq = 8 * wave + qi; const int q = q0 + qq;
        const int na = (int)st[192 + qq], need = TOPK - na; int C = (int)(st[320 + qq] >> 16); C = C < SEL_CAP ? C : SEL_CAP;
        const bool slow = st[448 + qq] != 0u;
        if (!slow) {
            LAS unsigned* sh = (LAS unsigned*)(lds + SL_KEYS + wave * 2048); LAS float* sls = (LAS float*)(lds + SL_KEYS + wave * 2048 + 256); LAS unsigned short* sli = (LAS unsigned short*)(lds + SL_KEYS + wave * 2048 + 1280);
            const float sclq = stf[qq]; const float fbase = (float)(int)st[128 + qq];
            sh[lane] = 0u;
            float cs[SEL_CAP / 64]; int ci[SEL_CAP / 64], sb[SEL_CAP / 64];
#pragma unroll
            for (int e = 0; e < SEL_CAP / 64; ++e) { const int i = lane + 64 * e; cs[e] = 0.f; ci[e] = 0; sb[e] = -1;
                if (i < C) { cs[e] = lcs[qq * SEL_CAP + i]; ci[e] = lci[qq * SEL_CAP + i];
                    const float fr_ = (fmaf(cs[e], sclq, 128.0f) - fbase) * 64.0f; sb[e] = (int)__builtin_amdgcn_fmed3f(fr_, 0.f, 63.f); } }
            LDS_WAIT();
#pragma unroll
            for (int e = 0; e < SEL_CAP / 64; ++e) if (sb[e] >= 0) (void)__hip_atomic_fetch_add(sh + sb[e], 1u, __ATOMIC_RELAXED, __HIP_MEMORY_SCOPE_WORKGROUP);
            LDS_WAIT();
            const unsigned cl = sh[lane];
            unsigned v = cl, tt;
            tt = __shfl_down(v, 1); if (lane + 1 < 64) v += tt;
            tt = __shfl_down(v, 2); if (lane + 2 < 64) v += tt;
            tt = __shfl_down(v, 4); if (lane + 4 < 64) v += tt;
            tt = __shfl_down(v, 8); if (lane + 8 < 64) v += tt;
            tt = __shfl_down(v, 16); if (lane + 16 < 64) v += tt;
            tt = __shfl_down(v, 32); if (lane + 32 < 64) v += tt;
            const unsigned ab_ = v - cl;
            const unsigned long long cross = __ballot(ab_ < (unsigned)need && v >= (unsigned)need);
            const int sstar = cross ? (int)__builtin_ctzll(cross) : 0;
            const int na2 = (int)__shfl(ab_, sstar);
            const int need2 = need - na2;
            int base = na; int nsub = 0;
#pragma unroll
            for (int e = 0; e < SEL_CAP / 64; ++e) { const bool up = sb[e] > sstar; const bool eq = sb[e] == sstar;
                const unsigned long long bu = __ballot(up), be = __ballot(eq);
                const unsigned long long lt = (lane == 0) ? 0ull : (~0ull >> (64 - lane));
                if (up) lsel[qq * 256 + base + (int)__builtin_popcountll(bu & lt)] = (unsigned short)ci[e];
                if (eq) { const int p_ = nsub + (int)__builtin_popcountll(be & lt); sls[p_] = cs[e]; sli[p_] = (unsigned short)ci[e]; }
                base += (int)__builtin_popcountll(bu); nsub += (int)__builtin_popcountll(be); }
            LDS_WAIT();
#pragma unroll 1
            for (int i0 = 0; i0 < nsub; i0 += 64) { const int i = i0 + lane;
                if (i < nsub) { const float si = sls[i]; const int ii = sli[i]; int rank = 0;
                    for (int jx = 0; jx < nsub; ++jx) { const float sj = sls[jx]; const int ij = sli[jx]; rank += (sj > si || (sj == si && ij < ii)) ? 1 : 0; }
                    if (rank < need2) lsel[qq * 256 + na + na2 + rank] = (unsigned short)ii; } }
            LDS_WAIT();
            *(v2u*)(sel + (size_t)q * TOPK + 4 * lane) = *(const LAS v2u*)(lsel + qq * 256 + 4 * lane);
        }
    }
    __syncthreads();
    if (tid == 0) { unsigned n = first ? 0u : __hip_atomic_load(slowl, RLX_AGENT);
        for (int qq = 0; qq < 64; ++qq) if (st[448 + qq] != 0u) { if (n < 128u) { __hip_atomic_store(slowl + 1 + n, (unsigned)(q0 + qq), RLX_AGENT); ++n; } }
        __hip_atomic_store(slowl, n, RLX_AGENT); }
    asm volatile("s_waitcnt vmcnt(0)" ::: "memory");
    __syncthreads();
}
#undef SEL_DECLS
#undef SEL_LOAD_A
#undef SEL_STAGE
#undef SEL_SCORES
#undef SEL_KBUF
#undef SEL_MMA
#undef SEL_SUM
#undef SEL_BOUNDARY
__device__ __forceinline__ void dsa_select_slow(unsigned char* ws_, LAS unsigned char* lds_, int wave_, int wg_) {
    LAS unsigned char* const lds = uni_l(lds_); const int wave = uni_i(wave_), wg = uni_i(wg_);
    unsigned char* ws = uni(ws_);
    const bf16* iqf = (const bf16*)(ws + WS_IQF); const unsigned* sgn = (const unsigned*)(ws + WS_SGN); const bf16* ik = (const bf16*)(ws + WS_IK);
    unsigned short* sel = (unsigned short*)(ws + WS_SEL);
    gu32* slowl = (gu32*)(ws + WS_CTL + 65536) + (size_t)wg * 132;
    const int lane = lane_id_v(), tid = wave * 64 + lane; const int kl = lane & 31, c5 = lane >> 5;
    LAS unsigned* keys = (LAS unsigned*)lds;
    LAS unsigned* hist = (LAS unsigned*)(lds + 32768);
    LAS unsigned* ctl = (LAS unsigned*)(lds + 40960);
    const int nq = (int)__builtin_amdgcn_readfirstlane(__hip_atomic_load(slowl, RLX_AGENT));
#pragma unroll 1
    for (int k = 0; k < nq; ++k) {
        const int q = (int)__builtin_amdgcn_readfirstlane(__hip_atomic_load(slowl + 1 + k, RLX_AGENT));
        const int b = q / SEQ, t = q % SEQ, n = t + 1;
        const bf16* ikb = ik + (size_t)b * SEQ * IDIM;
        __syncthreads();
        bf16x8_t af[2]; float sgc[8];
        { const int i = kl, a_ = i >> 3, e_ = i & 3; const int hh_ = 4 * (a_ & 1) + e_; const unsigned m_ = sgn[q];
          const unsigned flip_ = ((m_ >> hh_) & 1u) ? 0x80008000u : 0u;
#pragma unroll
          for (int ks = 0; ks < 2; ++ks) { v4u w_ = *(const v4u*)(iqf + (size_t)q * 256 + hh_ * 32 + 16 * ks + 8 * c5); w_.x ^= flip_; w_.y ^= flip_; w_.z ^= flip_; w_.w ^= flip_; af[ks] = __builtin_bit_cast(bf16x8_t, w_); }
#pragma unroll
          for (int h = 0; h < 8; ++h) sgc[h] = ((m_ >> h) & 1u) ? -__builtin_inff() : __builtin_inff(); }
#pragma unroll 1
        for (int kb0 = wave; kb0 * 32 < n; kb0 += 4 * NWAVES) {
            bf16x8_t kb_[4][2];
#pragma unroll
            for (int j = 0; j < 4; ++j) { int key = 32 * (kb0 + j * NWAVES) + kl; key = key < SEQ ? key : SEQ - 1;
                kb_[j][0] = *(const bf16x8_t*)(ikb + (size_t)key * IDIM + 8 * c5); kb_[j][1] = *(const bf16x8_t*)(ikb + (size_t)key * IDIM + 16 + 8 * c5); }
#pragma unroll
            for (int j = 0; j < 4; ++j) { const int key = 32 * (kb0 + j * NWAVES) + kl;
                f32x16 acc = {0.f,0.f,0.f,0.f,0.f,0.f,0.f,0.f,0.f,0.f,0.f,0.f,0.f,0.f,0.f,0.f};
                acc = __builtin_amdgcn_mfma_f32_32x32x16_f16(__builtin_bit_cast(f16x8_t, af[0]), __builtin_bit_cast(f16x8_t, kb_[j][0]), acc, 0, 0, 0); acc = __builtin_amdgcn_mfma_f32_32x32x16_f16(__builtin_bit_cast(f16x8_t, af[1]), __builtin_bit_cast(f16x8_t, kb_[j][1]), acc, 0, 0, 0);
                float sc = 0.f;
#pragma unroll
                for (int h = 0; h < 8; ++h) sc += __builtin_amdgcn_fmed3f(acc[h], 0.f, sgc[h]);
                if (c5 == 0 && key < SEQ) keys[key] = key_of(sc); } }
        if (tid == 0) { const unsigned z_ = (unsigned)launder_v(0); ctl[0] = z_; ctl[1] = z_ + (unsigned)TOPK; ctl[2] = z_; ctl[3] = z_; }
        unsigned P = 0u, Plo = 0u;
#pragma unroll 1
        for (int lev = 0; lev < 5; ++lev) {
            for (int i = tid; i < 2048; i += NWAVES * 64) hist[i] = 0u;
            asm volatile("s_waitcnt lgkmcnt(0)" ::: "memory"); __syncthreads();
#pragma unroll 1
            for (int i = 0; i < 16; ++i) { const int s_ = tid * 16 + i;
                if (s_ < n) { const unsigned hi = keys[s_], lo = 8191u - (unsigned)s_; bool mt; unsigned dg;
                    if (lev == 0) { mt = true; dg = hi >> 21; } else if (lev == 1) { mt = (hi >> 21) == P; dg = (hi >> 10) & 0x7ffu; } else if (lev == 2) { mt = (hi >> 10) == P; dg = hi & 0x3ffu; }
                    else if (lev == 3) { mt = hi == P; dg = lo >> 6; } else { mt = hi == P && (lo >> 6) == Plo; dg = lo & 63u; }
                    if (mt) (void)__hip_atomic_fetch_add(hist + dg, 1u, __ATOMIC_RELAXED, __HIP_MEMORY_SCOPE_WORKGROUP); } }
            asm volatile("s_waitcnt lgkmcnt(0)" ::: "memory"); __syncthreads();
            const unsigned need = ctl[1];
            const v4u hb = *(const LAS v4u*)(hist + 4 * tid); const unsigned ls = hb.x + hb.y + hb.z + hb.w;
            unsigned v = ls, tt;
            tt = __shfl_down(v, 1); if (lane + 1 < 64) v += tt;
            tt = __shfl_down(v, 2); if (lane + 2 < 64) v += tt;
            tt = __shfl_down(v, 4); if (lane + 4 < 64) v += tt;
            tt = __shfl_down(v, 8); if (lane + 8 < 64) v += tt;
            tt = __shfl_down(v, 16); if (lane + 16 < 64) v += tt;
            tt = __shfl_down(v, 32); if (lane + 32 < 64) v += tt;
            if (lane == 0) ctl[8 + wave] = v;
            asm volatile("s_waitcnt lgkmcnt(0)" ::: "memory"); __syncthreads();
            unsigned above = v - ls;
            for (int w2 = wave + 1; w2 < NWAVES; ++w2) above += ctl[8 + w2];
            if (above < need && above + ls >= need) { unsigned c = above; const unsigned bb[4] = {hb.x, hb.y, hb.z, hb.w}; int bsel = 0; unsigned cab = 0; bool found = false;
#pragma unroll
                for (int i = 3; i >= 0; --i) { const bool hit = !found && (c + bb[i] >= need); if (hit) { bsel = i; cab = c; found = true; } c += bb[i]; }
                const unsigned dv = (unsigned)(4 * tid + bsel);
                if (lev == 0) ctl[0] = dv; else if (lev == 1) ctl[0] = (P << 11) | dv; else if (lev == 2) ctl[0] = (P << 10) | dv; else if (lev == 3) ctl[3] = dv; else ctl[3] = (Plo << 6) | dv;
                ctl[1] = need - cab; ctl[4] = bb[bsel]; }
            asm volatile("s_waitcnt lgkmcnt(0)" ::: "memory"); __syncthreads();
            P = ctl[0]; Plo = ctl[3];
            if (lev == 2 && ctl[1] == ctl[4]) break;
        }
        unsigned short* srow = sel + (size_t)q * TOPK;
        unsigned mymask = 0u;
#pragma unroll 1
        for (int i = 0; i < 16; ++i) { const int s_ = tid * 16 + i;
            if (s_ < n) { const unsigned hi = keys[s_], lo = 8191u - (unsigned)s_; if (hi > P || (hi == P && lo >= Plo)) mymask |= 1u << i; } }
        const unsigned mycnt = (unsigned)__builtin_popcount(mymask);
        unsigned pv_ = mycnt, tt_;
        tt_ = __shfl_up(pv_, 1); if (lane >= 1) pv_ += tt_;
        tt_ = __shfl_up(pv_, 2); if (lane >= 2) pv_ += tt_;
        tt_ = __shfl_up(pv_, 4); if (lane >= 4) pv_ += tt_;
        tt_ = __shfl_up(pv_, 8); if (lane >= 8) pv_ += tt_;
        tt_ = __shfl_up(pv_, 16); if (lane >= 16) pv_ += tt_;
        tt_ = __shfl_up(pv_, 32); if (lane >= 32) pv_ += tt_;
        if (lane == 63) ctl[16 + wave] = pv_;
        asm volatile("s_waitcnt lgkmcnt(0)" ::: "memory"); __syncthreads();
        unsigned slot0 = pv_ - mycnt;
        for (int w2 = 0; w2 < wave; ++w2) slot0 += ctl[16 + w2];
#pragma unroll 1
        for (int i = 0; i < 16; ++i) if ((mymask >> i) & 1u) { if (slot0 < (unsigned)TOPK) srow[slot0] = (unsigned short)(tid * 16 + i); ++slot0; }
    }
    asm volatile("s_waitcnt vmcnt(0) lgkmcnt(0)" ::: "memory");
    __syncthreads();
}

__device__ __forceinline__ unsigned offb(unsigned row, unsigned ch) { return 256u * row + 16u * (ch ^ (((row & 3u) << 2) | ((row >> 2) & 3u))); }
__device__ __forceinline__ void plswap16(float& a, float& b) { asm volatile("s_nop 1\n\tv_permlane16_swap_b32 %0, %1" : "+v"(a), "+v"(b)); }
__device__ __forceinline__ void plswap32(float& a, float& b) { asm volatile("s_nop 1\n\tv_permlane32_swap_b32 %0, %1" : "+v"(a), "+v"(b)); }
__device__ __forceinline__ float rowpair_max(float x) { float a = x, b = x; plswap16(a, b); float m = fmaxf(a, b); a = m; b = m; plswap32(a, b); return fmaxf(a, b); }
__device__ __forceinline__ float rowpair_sum(float x) { float a = x, b = x; plswap16(a, b); float m = a + b; a = m; b = m; plswap32(a, b); return a + b; }
__device__ __forceinline__ s16x4_t vtr(const LAS unsigned char* p) { return __builtin_bit_cast(s16x4_t, __builtin_amdgcn_ds_read_tr16_b64_v4i16((LAS s16x4_t*)p)); }

__device__ __forceinline__ void dsa_attend(unsigned char* ws_, LAS unsigned char* lds_, const float* relb_, int wave_, int vcu_, int G_, int dry_) {
    const int dry = uni_i(dry_);
    LAS unsigned char* const lds = uni_l(lds_); const int wave = uni_i(wave_), vcu = uni_i(vcu_), G = uni_i(G_);
    unsigned char* ws = uni(ws_); const float* relb = uni(relb_);
    const bf16* ckv = (const bf16*)(ws + WS_CKV); bf16* ql = (bf16*)(ws + WS_QL); const unsigned short* sel = (const unsigned short*)(ws + WS_SEL);
    const int lane = lane_id_v(), tid = wave * 64 + lane;
    LAS unsigned char* cb = lds + wave * 16384;
    LAS unsigned short* sidx = (LAS unsigned short*)(lds + 131072 + wave * 512);
    LAS float* biasd = (LAS float*)(lds + 135168);
    for (int i = tid; i < 129 * 8; i += NWAVES * 64) { const int d = i >> 3, h = i & 7; const int bk = d < 128 ? (int)T5_BUCKET[d] : 31; biasd[i] = relb[bk * 8 + h]; }
    __syncthreads();
    const int hl = lane & 15, g = lane >> 4, hq = hl & 7;
    unsigned qko[2][4], pvo[8][2];
#pragma unroll
    for (int rb = 0; rb < 2; ++rb)
#pragma unroll
        for (int s4 = 0; s4 < 4; ++s4) qko[rb][s4] = offb(8u * (hl >> 2) + 4u * rb + (hl & 3), 4 * s4 + g);
#pragma unroll
    for (int cd = 0; cd < 8; ++cd) { const unsigned q4 = hl >> 2, p4 = hl & 3;
        pvo[cd][0] = offb(8u * g + q4, 2 * cd + (p4 >> 1)) + 8u * (p4 & 1); pvo[cd][1] = offb(8u * g + 4u + q4, 2 * cd + (p4 >> 1)) + 8u * (p4 & 1); }
    for (int p = vcu; p < BATCH * 64; p += G) {
        const int b = p >> 6, j = p & 63;
#pragma unroll 1
        for (int half = 0; half < 2; ++half) {
            const int ub = half == 0 ? j : 127 - j;
#pragma unroll 1
            for (int qi = 0; qi < 8; ++qi) {
                const int t = ub * 64 + wave * 8 + qi; const int q = b * SEQ + t; const int nsel = (t + 1) < TOPK ? (t + 1) : TOPK;
                const bf16* ckvb = ckv + (size_t)b * SEQ * KVR; bf16* qlrow = ql + (size_t)q * 1024;
                { const v2u w = *(const v2u*)(sel + (size_t)q * TOPK + 4 * lane); *(LAS v2u*)(sidx + 4 * lane) = w; }
                bf16x8_t qf[4];
#pragma unroll
                for (int s = 0; s < 4; ++s) qf[s] = *(const bf16x8_t*)(qlrow + hq * 128 + 32 * s + 8 * g);
                LDS_WAIT();
                float mrun = -1e30f, lsum = 0.f;
                f32x4 O[8];
#pragma unroll
                for (int c = 0; c < 8; ++c) O[c] = (f32x4){0.f, 0.f, 0.f, 0.f};
#define DSA_GATHER(c_) do { LAS unsigned char* dst_ = cb + ((c_) & 1) * 8192; \
                    _Pragma("unroll") for (int k_ = 0; k_ < 8; ++k_) { const int row_ = 4 * k_ + g; const int kidx_ = sidx[32 * (c_) + row_]; \
                        const int ch_ = hl ^ ((g << 2) | (k_ & 3)); \
                        glds16(ckvb + (size_t)kidx_ * KVR + ch_ * 8, (unsigned)__builtin_amdgcn_readfirstlane((int)(unsigned)(size_t)(dst_ + k_ * 1024))); } } while (0)
                DSA_GATHER(0);
#define DSA_CHUNK(c_, BOFF_) do { const int c = (c_); \
                    if (c < 7) { DSA_GATHER(c + 1); asm volatile("s_waitcnt vmcnt(8)" ::: "memory"); } \
                    else asm volatile("s_waitcnt vmcnt(0)" ::: "memory"); \
                    const LAS unsigned char* img = cb + (BOFF_); \
                    f32x4 S[2]; \
                    _Pragma("unroll") for (int rb = 0; rb < 2; ++rb) { S[rb] = (f32x4){0.f, 0.f, 0.f, 0.f}; \
                        _Pragma("unroll") for (int s = 0; s < 4; ++s) { const bf16x8_t af = *(const LAS bf16x8_t*)(img + qko[rb][s]); S[rb] = __builtin_amdgcn_mfma_f32_16x16x32_bf16(af, qf[s], S[rb], 0, 0, 0); } } \
                    float pv[2][4]; float mx = -1e30f; \
                    _Pragma("unroll") for (int rb = 0; rb < 2; ++rb) { const v2u iw2 = *(const LAS v2u*)(sidx + 32 * c + 8 * g + 4 * rb); \
                        const int ki[4] = {(int)(iw2.x & 0xffffu), (int)(iw2.x >> 16), (int)(iw2.y & 0xffffu), (int)(iw2.y >> 16)}; \
                        _Pragma("unroll") for (int r = 0; r < 4; ++r) { int dist = t - ki[r]; dist = dist < 0 ? 0 : (dist > 128 ? 128 : dist); \
                            float lg = S[rb][r] * 0.125f + biasd[dist * 8 + hq]; \
                            if (32 * c + 8 * g + 4 * rb + r >= nsel) lg = -1e30f; \
                            pv[rb][r] = lg; mx = fmaxf(mx, lg); } } \
                    mx = rowpair_max(mx); \
                    const float mnew = fmaxf(mrun, mx); const float alpha = __expf(mrun - mnew); mrun = mnew; \
                    float rs = 0.f; \
                    _Pragma("unroll") for (int rb = 0; rb < 2; ++rb) \
                        _Pragma("unroll") for (int r = 0; r < 4; ++r) { pv[rb][r] = __expf(pv[rb][r] - mnew); rs += pv[rb][r]; } \
                    rs = rowpair_sum(rs); \
                    lsum = lsum * alpha + rs; \
                    v4u pw; pw.x = pg8::cvt_pk_bf16(pv[0][0], pv[0][1]); pw.y = pg8::cvt_pk_bf16(pv[0][2], pv[0][3]); pw.z = pg8::cvt_pk_bf16(pv[1][0], pv[1][1]); pw.w = pg8::cvt_pk_bf16(pv[1][2], pv[1][3]); \
                    const bf16x8_t pf = __builtin_bit_cast(bf16x8_t, pw); \
                    float al[4]; \
                    _Pragma("unroll") for (int r = 0; r < 4; ++r) al[r] = __shfl(alpha, 4 * g + r); \
                    _Pragma("unroll") for (int cd = 0; cd < 8; ++cd) { \
                        f32x4 o = O[cd]; o[0] *= al[0]; o[1] *= al[1]; o[2] *= al[2]; o[3] *= al[3]; \
                        const s16x4_t b0 = vtr(img + pvo[cd][0]); const s16x4_t b1 = vtr(img + pvo[cd][1]); \
                        bf16x8_t bf; bf[0] = b0[0]; bf[1] = b0[1]; bf[2] = b0[2]; bf[3] = b0[3]; bf[4] = b1[0]; bf[5] = b1[1]; bf[6] = b1[2]; bf[7] = b1[3]; \
                        O[cd] = __builtin_amdgcn_mfma_f32_16x16x32_bf16(pf, bf, o, 0, 0, 0); } } while (0)
#pragma unroll 1
                for (int c2 = 0; c2 < 4; ++c2) { DSA_CHUNK(2 * c2, 0); DSA_CHUNK(2 * c2 + 1, 8192); }
#undef DSA_CHUNK
#undef DSA_GATHER
                const float linv = 1.0f / lsum; float li[4];
#pragma unroll
                for (int r = 0; r < 4; ++r) li[r] = __shfl(linv, 4 * g + r);
                LAS unsigned short* ost = (LAS unsigned short*)cb;
                if (g < 2) {
#pragma unroll
                    for (int cd = 0; cd < 8; ++cd)
#pragma unroll
                        for (int r = 0; r < 4; ++r) ost[(4 * g + r) * 128 + 16 * cd + hl] = (unsigned short)f2bf(O[cd][r] * li[r]);
                }
                LDS_WAIT();
                { const v4u w0 = *(const LAS v4u*)(cb + 32 * lane), w1 = *(const LAS v4u*)(cb + 32 * lane + 16);
                  if (!dry) { *(v4u*)(qlrow + 16 * lane) = w0; *(v4u*)(qlrow + 16 * lane + 8) = w1; } else asm volatile("" :: "v"(w0), "v"(w1)); }
                LDS_WAIT();
            }
        }
    }
    __syncthreads();
}

__device__ __noinline__ void final_norm(const float* const* in_, float* out_, unsigned char* ws_, LAS unsigned char* lds_, int wave_, int vcu_, int G_) {
    const PC F{uni(in_), uni(out_), uni(ws_), uni_l(lds_), uni_i(wave_), uni_i(vcu_), uni_i(G_)}; struct { const float* const* in; float* out; } a{F.in, F.out};
    const int lane_ = lane_id_v(); const int gw = F.vcu * NWAVES + F.wave, NGW = F.G * NWAVES; const float* g = a.in[22];
    f32x4 gv[4];
#pragma unroll
    for (int j = 0; j < 4; ++j) gv[j] = ((const f32x4*)g)[lane_ + 64 * j];
    for (int m = gw; m < M; m += NGW) {
        GAS f32x4* xr = (GAS f32x4*)(a.out + (size_t)m * D) + lane_;
        f32x4 v[4]; float s = 0.f;
#pragma unroll
        for (int j = 0; j < 4; ++j) { v[j] = xr[64 * j]; s += (v[j].x * v[j].x + v[j].y * v[j].y) + (v[j].z * v[j].z + v[j].w * v[j].w); }
        const float rs = 1.0f / sqrtf(wave_sum(s) * (1.0f / D) + EPS);
#pragma unroll
        for (int j = 0; j < 4; ++j) xr[64 * j] = v[j] * rs * gv[j];
    }
}

#define KIN ((const float* const*)__builtin_amdgcn_kernarg_segment_ptr())
constexpr int PH_PER_LAYER = 10, PH_LAYER0 = 2, N_PHASES = PH_LAYER0 + PH_PER_LAYER * DEPTH + 1;

__global__ void __launch_bounds__(NWAVES * 64, 2) mk_fwd(Args args) {
    extern __shared__ __attribute__((aligned(16))) unsigned char lds[];
    Frame F;
    F.lds = (LAS unsigned char*)lds;
    F.MISC = (volatile LAS unsigned*)(F.lds + MISC_OFF);
    F.wave = __builtin_amdgcn_readfirstlane((int)threadIdx.x >> 6);
    F.G = gridDim.x; { const int bx = blockIdx.x; F.vcu = (F.G % 8 == 0) ? (bx % 8) * (F.G / 8) + bx / 8 : bx; }
    F.ws = args.ws; F.ctl = (gu32*)(args.ws + WS_CTL);
    if (threadIdx.x < 64) ((LAS unsigned*)(F.lds + MISC_OFF))[threadIdx.x] = 0u;
    __syncthreads();
    const int lo = args.ph_lo, hi = args.ph_hi;
    const bool multi = (hi - lo) > 1;
    XcdBarrier bar; bar.bar = (unsigned*)(F.ctl + CW_BAR); bar.x = 0; bar.st = nullptr; bar.wave = F.wave;
    if (multi) bar = xcd_barrier_post((unsigned*)(F.ctl + CW_BAR), F.MISC + 8, F.wave);
#define IN(k) (lo <= (k) && (k) < hi)
#define SEAM(k) do { if (IN(k) && IN((k) + 1)) { xcd_barrier(bar); if (PROBE_PHASE == 99) xcd_barrier(bar); } } while (0)

    if (IN(0)) {
#if EN_P0
 for (int rep = (PROBE_PHASE == 1 ? 0 : 1); rep < 2; ++rep) p0_prologue(KIN, args.out, args.ws, F.lds, F.wave, F.vcu, F.G);
#endif
 } SEAM(0);
    if (IN(1)) {
#if !((DIS_MASK >> 7) & 1)
 unsigned char* ws = launder_p(args.ws); bf16* hb = (bf16*)(ws + WS_HB); float* ss = (float*)(ws + WS_SS); (void)hb; (void)ss;
        pg8::Gemm g{(const bf16_t*)(ws + WS_MEMN), (const bf16_t*)(ws + WS_WMEM), MROWS, DEPTH * 2 * CW, D}; pg8::StaticOrder S; S.init(MROWS, DEPTH * 2 * CW, F.G, launder_s((int)blockIdx.x));
        EpiPlainBf16 E{(bf16_t*)(ws + WS_MEMKV), DEPTH * 2 * CW};
        pg8::gemm_phase<EpiPlainBf16, pg8::StaticOrder, true, true>(F.lds + RING_OFF, g, S, E, F.wave);
        { pg8::Gemm g2{(const bf16_t*)(ws + WS_WMEM), (const bf16_t*)(ws + WS_MEMN), DEPTH * 2 * CW, MROWS, D}; pg8::StaticOrder S2; S2.init(DEPTH * 2 * CW, MROWS, F.G, launder_s((int)blockIdx.x));
          EpiPlainBf16 E2{(bf16_t*)(ws + WS_VT), MROWS};
          pg8::gemm_phase<EpiPlainBf16, pg8::StaticOrder, true, true>(F.lds + RING_OFF, g2, S2, E2, F.wave); }
#endif
    } SEAM(1);

    for (int l = 0; l < DEPTH; ++l) {
        const int pb = PH_LAYER0 + PH_PER_LAYER * l;
        const float* hbase = (l == 0) ? args.in[0] : args.out;
        if (IN(pb + 0)) {
#if EN_P0
 if (l > 0) for (int rep = (PROBE_PHASE == 1 ? 0 : 1); rep < 2; ++rep) prep_layer_weights(KIN, args.out, args.ws, F.lds, l, F.wave, F.vcu, F.G);
#endif
 } SEAM(pb + 0);
        if (IN(pb + 1)) {
#if !((DIS_MASK >> 0) & 1)
 unsigned char* ws = launder_p(args.ws); bf16* hb = (bf16*)(ws + WS_HB); float* ss = (float*)(ws + WS_SS); (void)hb; (void)ss;
            pg8::Gemm g{hb, (const bf16_t*)(ws + WS_W1IN), M, 2 * DFF, D}; pg8::StaticOrder S; S.init(M, 2 * DFF, F.G, launder_s((int)blockIdx.x));
            EpiSwiglu E{(bf16_t*)(ws + WS_ACT), ss};
            for (int rep = (PROBE_PHASE == 2 ? 0 : 1); rep < 2; ++rep) pg8::gemm_phase<EpiSwiglu, pg8::StaticOrder, true, true>(F.lds + RING_OFF, g, S, E, F.wave);
#endif
        } SEAM(pb + 1);
        if (IN(pb + 2)) {
#if !((DIS_MASK >> 1) & 1)
 unsigned char* ws = launder_p(args.ws); bf16* hb = (bf16*)(ws + WS_HB); float* ss = (float*)(ws + WS_SS); (void)hb; (void)ss;
            pg8::Gemm g{(const bf16_t*)(ws + WS_ACT), (const bf16_t*)(ws + WS_W1OUT), M, D, DFF}; pg8::StaticOrder S; S.init(M, D, F.G, launder_s((int)blockIdx.x));
            for (int rep = (PROBE_PHASE == 3 ? 0 : 1); rep < 2; ++rep) { EpiResid E{hbase, args.out, hb, ss, 0.5f, (LAS float*)(F.lds + RING_BYTES), rep == 0 ? 1 : 0};
            pg8::gemm_phase<EpiResid, pg8::StaticOrder, true, true>(F.lds + RING_OFF, g, S, E, F.wave); }
#endif
        } SEAM(pb + 2);
        if (IN(pb + 3)) {
#if !((DIS_MASK >> 2) & 1)
 unsigned char* ws = launder_p(args.ws); bf16* hb = (bf16*)(ws + WS_HB); float* ss = (float*)(ws + WS_SS); (void)hb; (void)ss;
            pg8::Gemm g{hb, (const bf16_t*)(ws + WS_WIN), M, INP, D}; pg8::StaticOrder S; S.init(M, INP, F.G, launder_s((int)blockIdx.x));
            EpiInProj E{ss, (bf16_t*)(ws + WS_QL), (float*)(ws + WS_CKVRAW), (bf16_t*)(ws + WS_IK), (float*)(ws + WS_IW), (bf16_t*)(ws + WS_IQRAW), (bf16_t*)(ws + WS_Z), (bf16_t*)(ws + WS_QC), (bf16_t*)(ws + WS_G)};
            for (int rep = (PROBE_PHASE == 4 ? 0 : 1); rep < 2; ++rep) pg8::gemm_phase<EpiInProj, pg8::StaticOrder, true, true>(F.lds + RING_OFF, g, S, E, F.wave);
#endif
        } SEAM(pb + 3);
        if (IN(pb + 4)) {
#if EN_PREP
 for (int rep = (PROBE_PHASE == 5 ? 0 : 1); rep < 2; ++rep) prep_tokens(KIN, args.out, args.ws, F.lds, l, F.wave, F.vcu, F.G, rep == 0 ? 1 : 0);
#endif
 } SEAM(pb + 4);
        if (IN(pb + 5)) {
#if EN_DSA
 for (int rep = (PROBE_PHASE == 6 ? 0 : 1); rep < 2; ++rep) for (int p = F.vcu; p < BATCH * 64; p += F.G) { for (int half = 0; half < 2; ++half) { const int b_ = p >> 6, ub_ = half == 0 ? (p & 63) : 127 - (p & 63);
   sel_pass1(args.ws, F.lds, F.wave, b_, ub_); if (PROBE_PHASE == 61) sel_pass1(args.ws, F.lds, F.wave, b_, ub_); sel_pass2(args.ws, F.lds, F.wave, b_, ub_); if (PROBE_PHASE == 62) sel_pass2(args.ws, F.lds, F.wave, b_, ub_); sel_resolve(args.ws, F.lds, F.wave, b_, ub_, (int)blockIdx.x, (p == F.vcu && half == 0) ? 1 : 0); if (PROBE_PHASE == 63) sel_resolve(args.ws, F.lds, F.wave, b_, ub_, (int)blockIdx.x, 0); } }
 dsa_select_slow(args.ws, F.lds, F.wave, (int)blockIdx.x); for (int rep = (PROBE_PHASE == 7 ? 0 : 1); rep < 2; ++rep) dsa_attend(args.ws, F.lds, args.in[2], F.wave, F.vcu, F.G, rep == 0 ? 1 : 0);
#endif
 } SEAM(pb + 5);
        if (IN(pb + 6)) {
#if !((DIS_MASK >> 3) & 1)
        for (int rep6 = (PROBE_PHASE == 8 ? 0 : 1); rep6 < 2; ++rep6) {
 unsigned char* ws = launder_p(args.ws); bf16* hb = (bf16*)(ws + WS_HB); float* ss = (float*)(ws + WS_SS); (void)hb; (void)ss;
            { pg8::Gemm g{(const bf16_t*)(ws + WS_QL), (const bf16_t*)(ws + WS_WA), M, D, 1024}; pg8::StaticOrder S; S.init(M, D, F.G, launder_s((int)blockIdx.x));
              EpiMerge<0> E{(bf16_t*)(ws + WS_MERGED), (const bf16_t*)(ws + WS_G)};
              pg8::gemm_phase<EpiMerge<0>, pg8::StaticOrder, true, true>(F.lds + RING_OFF, g, S, E, F.wave); }
            { pg8::Gemm g{(const bf16_t*)(ws + WS_YB), (const bf16_t*)(ws + WS_WB), M, D, PW_}; pg8::StaticOrder S; S.init(M, D, F.G, launder_s((int)blockIdx.x));
              EpiMerge<1> E{(bf16_t*)(ws + WS_MERGED), (const bf16_t*)(ws + WS_G)};
              pg8::gemm_phase<EpiMerge<1>, pg8::StaticOrder, true, true>(F.lds + RING_OFF, g, S, E, F.wave); }
            { pg8::Gemm g{(const bf16_t*)(ws + WS_QC), (const bf16_t*)(ws + WS_WC), M, D, CW}; pg8::StaticOrder S; S.init(M, D, F.G, launder_s((int)blockIdx.x));
              EpiMerge<2> E{(bf16_t*)(ws + WS_MERGED), (const bf16_t*)(ws + WS_G)};
              pg8::gemm_phase<EpiMerge<2>, pg8::StaticOrder, true, true>(F.lds + RING_OFF, g, S, E, F.wave); }
        }
#endif
        } SEAM(pb + 6);
        if (IN(pb + 7)) {
#if !((DIS_MASK >> 4) & 1)
 unsigned char* ws = launder_p(args.ws); bf16* hb = (bf16*)(ws + WS_HB); float* ss = (float*)(ws + WS_SS); (void)hb; (void)ss;
            pg8::Gemm g{(const bf16_t*)(ws + WS_MERGED), (const bf16_t*)(ws + WS_WOUT), M, D, D}; pg8::StaticOrder S; S.init(M, D, F.G, launder_s((int)blockIdx.x));
            for (int rep = (PROBE_PHASE == 9 ? 0 : 1); rep < 2; ++rep) { EpiResid E{args.out, args.out, hb, ss, 1.0f, (LAS float*)(F.lds + RING_BYTES), rep == 0 ? 1 : 0};
            pg8::gemm_phase<EpiResid, pg8::StaticOrder, true, true>(F.lds + RING_OFF, g, S, E, F.wave); }
#endif
        } SEAM(pb + 7);
        if (IN(pb + 8)) {
#if !((DIS_MASK >> 5) & 1)
 unsigned char* ws = launder_p(args.ws); bf16* hb = (bf16*)(ws + WS_HB); float* ss = (float*)(ws + WS_SS); (void)hb; (void)ss;
            pg8::Gemm g{hb, (const bf16_t*)(ws + WS_W2IN), M, 2 * DFF, D}; pg8::StaticOrder S; S.init(M, 2 * DFF, F.G, launder_s((int)blockIdx.x));
            EpiSwiglu E{(bf16_t*)(ws + WS_ACT), ss};
            for (int rep = (PROBE_PHASE == 2 ? 0 : 1); rep < 2; ++rep) pg8::gemm_phase<EpiSwiglu, pg8::StaticOrder, true, true>(F.lds + RING_OFF, g, S, E, F.wave);
#endif
        } SEAM(pb + 8);
        if (IN(pb + 9)) {
#if !((DIS_MASK >> 6) & 1)
 unsigned char* ws = launder_p(args.ws); bf16* hb = (bf16*)(ws + WS_HB); float* ss = (float*)(ws + WS_SS); (void)hb; (void)ss;
            pg8::Gemm g{(const bf16_t*)(ws + WS_ACT), (const bf16_t*)(ws + WS_W2OUT), M, D, DFF}; pg8::StaticOrder S; S.init(M, D, F.G, launder_s((int)blockIdx.x));
            for (int rep = (PROBE_PHASE == 3 ? 0 : 1); rep < 2; ++rep) { EpiResid E{args.out, args.out, hb, ss, 0.5f, (LAS float*)(F.lds + RING_BYTES), rep == 0 ? 1 : 0};
            pg8::gemm_phase<EpiResid, pg8::StaticOrder, true, true>(F.lds + RING_OFF, g, S, E, F.wave); }
#endif
        } SEAM(pb + 9);
    }
#if EN_P0
    if (IN(N_PHASES - 1)) { final_norm(KIN, args.out, args.ws, F.lds, F.wave, F.vcu, F.G); }
#endif
#undef IN
#undef SEAM
}

extern "C" void kernel_launch(void* const* d_in, const int* in_sizes, int n_in, void* d_out, int out_size, void* d_ws, size_t ws_size, hipStream_t stream) {
    static int grid = 0;
    if (grid == 0) {
        if (n_in != 23 || in_sizes[0] != M * D || out_size != M * D || ws_size < WS_END) { fprintf(stderr, "kernel_launch: unexpected shapes (n_in %d, ws %zu)\n", n_in, ws_size); grid = -1; return; }
        int dev = 0, cus = 0, per_cu = 0;
        if (hipGetDevice(&dev) != hipSuccess || hipDeviceGetAttribute(&cus, hipDeviceAttributeMultiprocessorCount, dev) != hipSuccess) { grid = -1; return; }
        if (hipFuncSetAttribute((const void*)mk_fwd, hipFuncAttributeMaxDynamicSharedMemorySize, LDS_BYTES) != hipSuccess) { fprintf(stderr, "kernel_launch: hipFuncSetAttribute failed\n"); grid = -1; return; }
        if (hipOccupancyMaxActiveBlocksPerMultiprocessor(&per_cu, (const void*)mk_fwd, NWAVES * 64, LDS_BYTES) != hipSuccess || per_cu < 1) { fprintf(stderr, "kernel_launch: occupancy query says %d\n", per_cu); }
        (void)hipGetLastError();
        grid = cus;
    }
    if (grid < 0) return;
    if (hipMemsetAsync((char*)d_ws + WS_CTL, 0, CTL_ZERO_BYTES, stream) != hipSuccess) return;
    Args a{};
    for (int i = 0; i < 23; ++i) a.in[i] = (const float*)d_in[i];
    a.out = (float*)d_out; a.ws = (unsigned char*)d_ws;
#if MK_ONE_LAUNCH
    a.ph_lo = 0; a.ph_hi = N_PHASES;
    hipLaunchKernelGGL(mk_fwd, dim3(grid), dim3(NWAVES * 64), LDS_BYTES, stream, a);
#endif
}
```

```cpp
#include <hip/hip_runtime.h>
#include <cstdio>
#include <cstdint>

#ifndef MK_ONE_LAUNCH
#define MK_ONE_LAUNCH 1
#endif
#ifndef PROBE_PHASE
#define PROBE_PHASE 0
#endif
#ifndef EN_P0
#define EN_P0 MK_ONE_LAUNCH
#endif
#ifndef EN_PREP
#define EN_PREP MK_ONE_LAUNCH
#endif
#ifndef EN_DSA
#define EN_DSA MK_ONE_LAUNCH
#endif
#ifndef DIS_MASK
#define DIS_MASK 0
#endif
#ifndef MK_ONE_LAUNCH
#define MK_ONE_LAUNCH 1
#endif

__device__ __forceinline__ int lane_id_v() { int l; asm volatile("v_mbcnt_lo_u32_b32 %0, -1, 0\n\tv_mbcnt_hi_u32_b32 %0, -1, %0" : "=v"(l)); return l; }
namespace pg8 {
#define PG8_LAS __attribute__((address_space(3)))
typedef unsigned short bf16_t;
typedef short bf16x8 __attribute__((ext_vector_type(8)));
typedef float f32x4 __attribute__((ext_vector_type(4)));
typedef unsigned u32x4 __attribute__((ext_vector_type(4)));
typedef unsigned u32x2 __attribute__((ext_vector_type(2)));
constexpr int BM = 256, BK = 64, HALF = 128, HTB = HALF * BK * 2, STAGE_BYTES = 8 * HTB, NXCD = 8, WGM = 8;

__host__ __device__ __forceinline__ int lds_byte(int r, int c) { const int st = (r >> 4) * 2 + (c >> 5), rr = r & 15, cc = c & 31, ob = rr * 64 + cc * 2; return st * 1024 + (ob ^ (((ob >> 9) & 1) << 5)); }
__host__ __device__ __forceinline__ void stage_rc(int b, int& R, int& C) { const int st = b / 1024, sb = b % 1024, swz = sb ^ (((sb >> 9) & 1) << 5); R = (st >> 1) * 16 + swz / 64; C = (st & 1) * 32 + (swz % 64) / 2; }
__host__ __device__ __forceinline__ int perm32(int rho) { const int n = rho >> 4, i = rho & 15; return 8 * (i >> 2) + 4 * n + (i & 3); }

struct Unit { int pm, pn; };
struct Gemm { const bf16_t* A; const bf16_t* Bt; int M, N, K; };

struct StaticOrder {
    int nM, nN, nwg, G, c;
    __host__ __device__ void init(int M, int N, int G_, int c_) { nM = M / BM; nN = N / BM; nwg = nM * nN; G = G_; c = c_; }
    __host__ __device__ bool next(int i, Unit& u) const {
        const long L = (long)i * G + c; if (L >= nwg) return false;
        int wgid = (int)L; { const int q = nwg / NXCD, r = nwg % NXCD, xcd = wgid % NXCD, off = wgid / NXCD; wgid = (xcd < r ? xcd * (q + 1) : r * (q + 1) + (xcd - r) * q) + off; }
        const int nig = WGM * nN, gid = wgid / nig, fm = gid * WGM, gsz = (nM - fm) < WGM ? (nM - fm) : WGM;
        u.pm = fm + ((wgid % nig) % gsz); u.pn = (wgid % nig) / gsz; return true;
    }
    __device__ __forceinline__ void a_ready(const Unit&) const {}
    __device__ __forceinline__ void done(const Unit&) const {}
};

__device__ __forceinline__ unsigned cvt_pk_bf16(float lo, float hi) { unsigned r; asm volatile("v_cvt_pk_bf16_f32 %0, %1, %2" : "=v"(r) : "v"(lo), "v"(hi)); return r; }

template <class Epi, class Sched, bool ALIGN_EPI = false, bool SP2 = false>
__device__ __forceinline__ void gemm_phase(PG8_LAS unsigned char* lds, const Gemm g, const Sched& S, const Epi& E, const int wid_) {
    int wid = wid_; asm volatile("" : "+s"(wid));
    const int lane = lane_id_v(), tid = wid * 64 + lane,
              wr = wid >> 2, wc = wid & 3, fr = lane & 15, fq = lane >> 4;
    const int K = g.K, nt = K / BK;
    unsigned voffA[2], voffB[2];
#pragma unroll
    for (int i = 0; i < 2; ++i) { int R, C; stage_rc(tid * 16 + i * 8192, R, C); const int Rb = Epi::PERM ? ((R & ~31) + perm32(R & 31)) : R;
        voffA[i] = (unsigned)(R * K + C) * 2u; voffB[i] = (unsigned)(Rb * K + C) * 2u; }
    const size_t kstep = (size_t)(BK * 2);
    const size_t hstep = (size_t)HALF * K * 2;
    const size_t tstep = 2 * hstep;
    const unsigned ldsw = (unsigned)wid * 1024u;
    const int aoff = lds_byte(wr * 64 + fr, fq * 8), boff = lds_byte(wc * 32 + fr, fq * 8);
#define PG8_SA(b, h) (((b) * 2 + (h)) * HTB)
#define PG8_SB(b, h) ((4 + (b) * 2 + (h)) * HTB)
#define PG8_STAGE(bufoff, gbase, voff) do { _Pragma("unroll") for (int _i = 0; _i < 2; ++_i) \
        __builtin_amdgcn_global_load_lds((const unsigned*)((const char*)(gbase) + (voff)[_i]), (PG8_LAS unsigned*)(lds + (bufoff) + ldsw + _i * 8192), 16, 0, 0); } while (0)
#define PG8_LDA(dst, b, h) do { _Pragma("unroll") for (int m = 0; m < 4; ++m) _Pragma("unroll") for (int k = 0; k < 2; ++k) dst[m][k] = *(const PG8_LAS bf16x8*)(lds + PG8_SA(b, h) + aoff + m * 2048 + k * 1024); } while (0)
#define PG8_LDB(dst, b, h) do { _Pragma("unroll") for (int n = 0; n < 2; ++n) _Pragma("unroll") for (int k = 0; k < 2; ++k) dst[n][k] = *(const PG8_LAS bf16x8*)(lds + PG8_SB(b, h) + boff + n * 2048 + k * 1024); } while (0)
#define PG8_MMA(ai, bj, At, Bt) do { __builtin_amdgcn_s_setprio(1); _Pragma("unroll") for (int m = 0; m < 4; ++m) _Pragma("unroll") for (int n = 0; n < 2; ++n) _Pragma("unroll") for (int k = 0; k < 2; ++k) \
        acc[ai][bj][m][n] = __builtin_amdgcn_mfma_f32_16x16x32_bf16(Bt[n][k], At[m][k], acc[ai][bj][m][n], 0, 0, 0); __builtin_amdgcn_s_setprio(0); } while (0)
#define PG8_WAIT_V(n) asm volatile("s_waitcnt vmcnt(" #n ")" ::: "memory")
#define PG8_WAIT_L(n) asm volatile("s_waitcnt lgkmcnt(" #n ")" ::: "memory")
#define PG8_BAR __builtin_amdgcn_s_barrier()
#define PG8_SCHED __builtin_amdgcn_sched_barrier(0)
    Unit cur, nxt; int ui = 0;
    if (!S.next(0, cur)) return;
    f32x4 acc[2][2][4][2];
#pragma unroll
    for (int a = 0; a < 2; ++a)
#pragma unroll
        for (int b = 0; b < 2; ++b)
#pragma unroll
            for (int m = 0; m < 4; ++m)
#pragma unroll
                for (int n = 0; n < 2; ++n) acc[a][b][m][n] = (f32x4){0.f, 0.f, 0.f, 0.f};
    bf16x8 At[4][2], B0[2][2], B1[2][2];
    const char* cA = (const char*)g.A + (size_t)cur.pm * tstep; const char* cB = (const char*)g.Bt + (size_t)cur.pn * tstep;
    S.a_ready(cur);
    if constexpr (SP2) {
        PG8_STAGE(PG8_SB(0, 0), cB, voffB); PG8_STAGE(PG8_SB(0, 1), cB + hstep, voffB); PG8_STAGE(PG8_SA(0, 0), cA, voffA); PG8_STAGE(PG8_SA(0, 1), cA + hstep, voffA);
        if (wr == 1) PG8_BAR;
        PG8_WAIT_V(2); PG8_BAR;
        PG8_STAGE(PG8_SB(1, 0), cB + kstep, voffB); PG8_STAGE(PG8_SA(1, 0), cA + kstep, voffA); PG8_STAGE(PG8_SB(1, 1), cB + hstep + kstep, voffB);
        PG8_WAIT_V(6); PG8_BAR;
    } else {
        PG8_STAGE(PG8_SB(0, 0), cB, voffB); PG8_STAGE(PG8_SA(0, 0), cA, voffA); PG8_STAGE(PG8_SB(0, 1), cB + hstep, voffB); PG8_STAGE(PG8_SA(0, 1), cA + hstep, voffA);
        if (wr == 1) PG8_BAR;
        PG8_WAIT_V(4); PG8_BAR;
        PG8_STAGE(PG8_SB(1, 0), cB + kstep, voffB); PG8_STAGE(PG8_SA(1, 0), cA + kstep, voffA); PG8_STAGE(PG8_SB(1, 1), cB + hstep + kstep, voffB);
        PG8_WAIT_V(6); PG8_BAR;
    }
    for (;;) {
        const bool has_next = S.next(ui + 1, nxt);
        const char* nA = has_next ? (const char*)g.A + (size_t)nxt.pm * tstep : cA; const char* nB = has_next ? (const char*)g.Bt + (size_t)nxt.pn * tstep : cB;
#pragma nounroll
        for (int t = 0; t < nt; t += 2) {
            const bool last = (t == nt - 2);
            const char* a1 = cA + (size_t)(t + 1) * kstep;
            const char* a2 = last ? nA : cA + (size_t)(t + 2) * kstep; const char* b2 = last ? nB : cB + (size_t)(t + 2) * kstep;
            const char* a3 = a2 + kstep; const char* b3 = b2 + kstep;
            if (last && has_next) S.a_ready(nxt);
            if constexpr (SP2) {
            PG8_LDB(B0, 0, 0); PG8_LDB(B1, 0, 1); PG8_SCHED; PG8_LDA(At, 0, 0); PG8_STAGE(PG8_SA(1, 1), a1 + hstep, voffA);
            PG8_WAIT_V(8); PG8_WAIT_L(0); PG8_BAR; PG8_MMA(0, 0, At, B0); PG8_MMA(0, 1, At, B1); PG8_BAR; PG8_SCHED;
            PG8_LDA(At, 0, 1); PG8_STAGE(PG8_SB(0, 0), b2, voffB); PG8_STAGE(PG8_SB(0, 1), b2 + hstep, voffB); PG8_STAGE(PG8_SA(0, 0), a2, voffA);
            PG8_WAIT_V(8); PG8_WAIT_L(0); PG8_BAR; PG8_MMA(1, 0, At, B0); PG8_MMA(1, 1, At, B1); PG8_BAR; PG8_SCHED;
            PG8_LDB(B0, 1, 0); PG8_LDB(B1, 1, 1); PG8_SCHED; PG8_LDA(At, 1, 0); PG8_STAGE(PG8_SA(0, 1), a2 + hstep, voffA);
            PG8_WAIT_V(8); PG8_WAIT_L(0); PG8_BAR; PG8_MMA(0, 0, At, B0); PG8_MMA(0, 1, At, B1); PG8_BAR; PG8_SCHED;
            PG8_LDA(At, 1, 1); PG8_STAGE(PG8_SB(1, 0), b3, voffB); PG8_STAGE(PG8_SB(1, 1), b3 + hstep, voffB); PG8_STAGE(PG8_SA(1, 0), a3, voffA);
            PG8_WAIT_V(8); PG8_WAIT_L(0); PG8_BAR; PG8_MMA(1, 0, At, B0); PG8_MMA(1, 1, At, B1); PG8_BAR; PG8_SCHED;
            } else {
            PG8_LDB(B0, 0, 0); PG8_SCHED; PG8_LDA(At, 0, 0); PG8_STAGE(PG8_SA(1, 1), a1 + hstep, voffA);
            PG8_WAIT_L(8); PG8_BAR; PG8_WAIT_L(0); PG8_MMA(0, 0, At, B0); PG8_BAR; PG8_SCHED;
            PG8_LDB(B1, 0, 1); PG8_STAGE(PG8_SB(0, 0), b2, voffB);
            PG8_BAR; PG8_WAIT_L(0); PG8_MMA(0, 1, At, B1); PG8_BAR;
            PG8_LDA(At, 0, 1); PG8_STAGE(PG8_SA(0, 0), a2, voffA);
            PG8_BAR; PG8_WAIT_L(0); PG8_MMA(1, 0, At, B0); PG8_BAR; PG8_SCHED;
            PG8_STAGE(PG8_SB(0, 1), b2 + hstep, voffB);
            PG8_WAIT_V(6); PG8_BAR; PG8_MMA(1, 1, At, B1); PG8_BAR;
            PG8_LDB(B0, 1, 0); PG8_SCHED; PG8_LDA(At, 1, 0); PG8_STAGE(PG8_SA(0, 1), a2 + hstep, voffA);
            PG8_WAIT_L(8); PG8_BAR; PG8_WAIT_L(0); PG8_MMA(0, 0, At, B0); PG8_BAR; PG8_SCHED;
            PG8_LDB(B1, 1, 1); PG8_STAGE(PG8_SB(1, 0), b3, voffB);
            PG8_BAR; PG8_WAIT_L(0); PG8_MMA(0, 1, At, B1); PG8_BAR;
            PG8_LDA(At, 1, 1); PG8_STAGE(PG8_SA(1, 0), a3, voffA);
            PG8_BAR; PG8_WAIT_L(0); PG8_MMA(1, 0, At, B0); PG8_BAR; PG8_SCHED;
            PG8_STAGE(PG8_SB(1, 1), b3 + hstep, voffB);
            PG8_WAIT_V(6); PG8_BAR; PG8_MMA(1, 1, At, B1); PG8_BAR;
            }
        }
        if constexpr (ALIGN_EPI) { if (wr == 0) PG8_BAR; }
        E(acc, cur, wr, wc, fr, fq); S.done(cur);
        if (!has_next) break;
#pragma unroll
        for (int a = 0; a < 2; ++a)
#pragma unroll
            for (int b = 0; b < 2; ++b)
#pragma unroll
                for (int m = 0; m < 4; ++m)
#pragma unroll
                    for (int n = 0; n < 2; ++n) acc[a][b][m][n] = (f32x4){0.f, 0.f, 0.f, 0.f};
        cur = nxt; cA = nA; cB = nB; ++ui;
        if constexpr (ALIGN_EPI) { if (wr == 1) PG8_BAR; }
    }
    PG8_WAIT_V(0);
    if constexpr (!ALIGN_EPI) { if (wr == 0) PG8_BAR; }
    PG8_BAR;
#undef PG8_SA
#undef PG8_SB
#undef PG8_STAGE
#undef PG8_LDA
#undef PG8_LDB
#undef PG8_MMA
#undef PG8_WAIT_V
#undef PG8_WAIT_L
#undef PG8_BAR
#undef PG8_SCHED
}
template <class Epi, class Sched>
__device__ __forceinline__ void gemm_phase_merge(PG8_LAS unsigned char* lds, const Gemm g, const bf16_t* A2, const bf16_t* B2, const int nt0, const int nt1, const Sched& S, const Epi& E, const int wid_) {
    int wid = wid_; asm volatile("" : "+s"(wid));
    const int lane = lane_id_v(), tid = wid * 64 + lane,
              wr = wid >> 2, wc = wid & 3, fr = lane & 15, fq = lane >> 4;
    const int K = g.K, nt = nt0 + 2 * nt1;
    unsigned voffA[2], voffB[2];
#pragma unroll
    for (int i = 0; i < 2; ++i) { int R, C; stage_rc(tid * 16 + i * 8192, R, C); const int Rb = Epi::PERM ? ((R & ~31) + perm32(R & 31)) : R;
        voffA[i] = (unsigned)(R * K + C) * 2u; voffB[i] = (unsigned)(Rb * K + C) * 2u; }
    const size_t kstep = (size_t)(BK * 2);
    const size_t hstep = (size_t)HALF * K * 2;
    const size_t tstep = 2 * hstep;
    const unsigned ldsw = (unsigned)wid * 1024u;
    const int aoff = lds_byte(wr * 64 + fr, fq * 8), boff = lds_byte(wc * 32 + fr, fq * 8);
#define PG8_SA(b, h) (((b) * 2 + (h)) * HTB)
#define PG8_SB(b, h) ((4 + (b) * 2 + (h)) * HTB)
#define PG8_STAGE(bufoff, gbase, voff) do { _Pragma("unroll") for (int _i = 0; _i < 2; ++_i) \
        __builtin_amdgcn_global_load_lds((const unsigned*)((const char*)(gbase) + (voff)[_i]), (PG8_LAS unsigned*)(lds + (bufoff) + ldsw + _i * 8192), 16, 0, 0); } while (0)
#define PG8_LDA(dst, b, h) do { _Pragma("unroll") for (int m = 0; m < 4; ++m) _Pragma("unroll") for (int k = 0; k < 2; ++k) dst[m][k] = *(const PG8_LAS bf16x8*)(lds + PG8_SA(b, h) + aoff + m * 2048 + k * 1024); } while (0)
#define PG8_LDB(dst, b, h) do { _Pragma("unroll") for (int n = 0; n < 2; ++n) _Pragma("unroll") for (int k = 0; k < 2; ++k) dst[n][k] = *(const PG8_LAS bf16x8*)(lds + PG8_SB(b, h) + boff + n * 2048 + k * 1024); } while (0)
#define PG8_MMA(ai, bj, At, Bt) do { __builtin_amdgcn_s_setprio(1); _Pragma("unroll") for (int m = 0; m < 4; ++m) _Pragma("unroll") for (int n = 0; n < 2; ++n) _Pragma("unroll") for (int k = 0; k < 2; ++k) \
        acc[ai][bj][m][n] = __builtin_amdgcn_mfma_f32_16x16x32_bf16(Bt[n][k], At[m][k], acc[ai][bj][m][n], 0, 0, 0); __builtin_amdgcn_s_setprio(0); } while (0)
#define PG8_WAIT_V(n) asm volatile("s_waitcnt vmcnt(" #n ")" ::: "memory")
#define PG8_WAIT_L(n) asm volatile("s_waitcnt lgkmcnt(" #n ")" ::: "memory")
#define PG8_BAR __builtin_amdgcn_s_barrier()
#define PG8_SCHED __builtin_amdgcn_sched_barrier(0)
    Unit cur, nxt; int ui = 0;
    if (!S.next(0, cur)) return;
    f32x4 acc[2][2][4][2];
#pragma unroll
    for (int a = 0; a < 2; ++a)
#pragma unroll
        for (int b = 0; b < 2; ++b)
#pragma unroll
            for (int m = 0; m < 4; ++m)
#pragma unroll
                for (int n = 0; n < 2; ++n) acc[a][b][m][n] = (f32x4){0.f, 0.f, 0.f, 0.f};
    bf16x8 At[4][2], B0[2][2], B1[2][2];
    const char* cA = (const char*)g.A + (size_t)cur.pm * tstep; const char* cB = (const char*)g.Bt + (size_t)cur.pn * tstep;
    const char* cA2 = (const char*)A2 + (size_t)cur.pm * tstep - (size_t)nt0 * kstep; const char* cB2 = (const char*)B2 + (size_t)cur.pn * tstep - (size_t)nt0 * kstep;
#define PG8_KA(j_) (((j_) < nt0 ? cA : cA2) + (size_t)(j_) * kstep)
#define PG8_KB(j_) (((j_) < nt0 ? cB : cB2) + (size_t)(j_) * kstep)
    S.a_ready(cur);
        PG8_STAGE(PG8_SB(0, 0), cB, voffB); PG8_STAGE(PG8_SB(0, 1), cB + hstep, voffB); PG8_STAGE(PG8_SA(0, 0), cA, voffA); PG8_STAGE(PG8_SA(0, 1), cA + hstep, voffA);
        if (wr == 1) PG8_BAR;
        PG8_WAIT_V(2); PG8_BAR;
        PG8_STAGE(PG8_SB(1, 0), cB + kstep, voffB); PG8_STAGE(PG8_SA(1, 0), cA + kstep, voffA); PG8_STAGE(PG8_SB(1, 1), cB + hstep + kstep, voffB);
        PG8_WAIT_V(6); PG8_BAR;
    for (;;) {
        const bool has_next = S.next(ui + 1, nxt);
        const char* nA = has_next ? (const char*)g.A + (size_t)nxt.pm * tstep : cA; const char* nB = has_next ? (const char*)g.Bt + (size_t)nxt.pn * tstep : cB;
#define PG8_KBODY do { const bool last = (t == nt - 2); \
            const char* a1 = PG8_KA(t + 1); \
            const char* a2 = last ? nA : PG8_KA(t + 2); const char* b2 = last ? nB : PG8_KB(t + 2); \
            const char* a3 = last ? nA + kstep : PG8_KA(t + 3); const char* b3 = last ? nB + kstep : PG8_KB(t + 3); \
            if (last && has_next) S.a_ready(nxt); \
            PG8_LDB(B0, 0, 0); PG8_LDB(B1, 0, 1); PG8_SCHED; PG8_LDA(At, 0, 0); PG8_STAGE(PG8_SA(1, 1), a1 + hstep, voffA); \
            PG8_WAIT_V(8); PG8_WAIT_L(0); PG8_BAR; PG8_MMA(0, 0, At, B0); PG8_MMA(0, 1, At, B1); PG8_BAR; PG8_SCHED; \
            PG8_LDA(At, 0, 1); PG8_STAGE(PG8_SB(0, 0), b2, voffB); PG8_STAGE(PG8_SB(0, 1), b2 + hstep, voffB); PG8_STAGE(PG8_SA(0, 0), a2, voffA); \
            PG8_WAIT_V(8); PG8_WAIT_L(0); PG8_BAR; PG8_MMA(1, 0, At, B0); PG8_MMA(1, 1, At, B1); PG8_BAR; PG8_SCHED; \
            PG8_LDB(B0, 1, 0); PG8_LDB(B1, 1, 1); PG8_SCHED; PG8_LDA(At, 1, 0); PG8_STAGE(PG8_SA(0, 1), a2 + hstep, voffA); \
            PG8_WAIT_V(8); PG8_WAIT_L(0); PG8_BAR; PG8_MMA(0, 0, At, B0); PG8_MMA(0, 1, At, B1); PG8_BAR; PG8_SCHED; \
            PG8_LDA(At, 1, 1); PG8_STAGE(PG8_SB(1, 0), b3, voffB); PG8_STAGE(PG8_SB(1, 1), b3 + hstep, voffB); PG8_STAGE(PG8_SA(1, 0), a3, voffA); \
            PG8_WAIT_V(8); PG8_WAIT_L(0); PG8_BAR; PG8_MMA(1, 0, At, B0); PG8_MMA(1, 1, At, B1); PG8_BAR; PG8_SCHED; } while (0)
#pragma nounroll
        for (int t = 0; t < nt0; t += 2) PG8_KBODY;
        E.mid(acc, cur, wr, wc, 0);
#pragma nounroll
        for (int t = nt0; t < nt0 + nt1; t += 2) PG8_KBODY;
        E.mid(acc, cur, wr, wc, 1);
#pragma nounroll
        for (int t = nt0 + nt1; t < nt; t += 2) PG8_KBODY;
#undef PG8_KBODY
        if (wr == 0) PG8_BAR;
        E.fin(acc, cur, wr, wc); S.done(cur);
        if (!has_next) break;
#pragma unroll
        for (int a = 0; a < 2; ++a)
#pragma unroll
            for (int b = 0; b < 2; ++b)
#pragma unroll
                for (int m = 0; m < 4; ++m)
#pragma unroll
                    for (int n = 0; n < 2; ++n) acc[a][b][m][n] = (f32x4){0.f, 0.f, 0.f, 0.f};
        cur = nxt; cA = nA; cB = nB; ++ui;
        cA2 = (const char*)A2 + (size_t)cur.pm * tstep - (size_t)nt0 * kstep; cB2 = (const char*)B2 + (size_t)cur.pn * tstep - (size_t)nt0 * kstep;
        if (wr == 1) PG8_BAR;
    }
    PG8_WAIT_V(0);
    PG8_BAR;
#undef PG8_KA
#undef PG8_KB
#undef PG8_SA
#undef PG8_SB
#undef PG8_STAGE
#undef PG8_LDA
#undef PG8_LDB
#undef PG8_MMA
#undef PG8_WAIT_V
#undef PG8_WAIT_L
#undef PG8_BAR
#undef PG8_SCHED
}
}

constexpr int NWAVES = 8;
constexpr int BATCH = 4, SEQ = 8192, D = 1024, DEPTH = 4, M = BATCH * SEQ;
constexpr int NMEM = 256, MROWS = BATCH * NMEM;
constexpr int AH = 8, AHD = 64, AW = 512, KVR = 128, IH = 8, IDIM = 32, TOPK = 256;
constexpr int PW_ = 256, CH = 4, CHD = 64, CW = 256;
constexpr int DFF = 2816, INW = 4520, INP = 5120;
constexpr float EPS = 1e-6f;
constexpr int C_QA = 0, C_CKV = 512, C_IQ = 640, C_IK = 896, C_IW = 928, C_Z = 936, C_QC = 1192, C_G = 1448;

constexpr size_t MiB = 1u << 20;
constexpr size_t WS_CTL = 0, CTL_ZERO_BYTES = 1 * MiB;
constexpr size_t WS_SS = 1 * MiB;
constexpr size_t WS_IW = 3 * MiB;
constexpr size_t WS_SGN = 4 * MiB;
constexpr size_t WS_MEMN = 5 * MiB;
constexpr size_t WS_WMEM = 7 * MiB;
constexpr size_t WS_MEMKV = 11 * MiB;
constexpr size_t WS_W1IN = 15 * MiB, WS_W1OUT = 26 * MiB, WS_WIN = 32 * MiB, WS_WA = 42 * MiB, WS_WB = 44 * MiB, WS_WC = 44 * MiB + 512 * 1024, WS_WOUT = 45 * MiB, WS_W2IN = 47 * MiB, WS_W2OUT = 58 * MiB;
constexpr size_t WS_HB = 64 * MiB;
constexpr size_t WS_ACT = 128 * MiB;
constexpr size_t WS_G = 128 * MiB;
constexpr size_t WS_QL = 320 * MiB;
constexpr size_t WS_CKV = 384 * MiB;
constexpr size_t WS_CKVRAW = 392 * MiB;
constexpr size_t WS_IQRAW = 408 * MiB;
constexpr size_t WS_IQF = 424 * MiB;
constexpr size_t WS_IK = 440 * MiB;
constexpr size_t WS_Z = 442 * MiB;
constexpr size_t WS_MERGED = 384 * MiB;
constexpr size_t WS_YB = 458 * MiB;
constexpr size_t WS_QC = 474 * MiB;
constexpr size_t WS_SEL = 490 * MiB;
constexpr size_t WS_VT = 506 * MiB;
constexpr size_t WS_WPT = 4 * MiB + 512 * 1024;
constexpr size_t WS_WBC = 458 * MiB;
constexpr size_t WS_END = 510 * MiB;
constexpr int CW_BAR = 4096;

constexpr int RING_OFF = 0, RING_BYTES = 131072;
constexpr int LDS_BYTES = 155648;
constexpr int MISC_OFF = LDS_BYTES - 256;

#define GAS __attribute__((address_space(1)))
#define LAS __attribute__((address_space(3)))
typedef unsigned short bf16;
typedef unsigned v4u __attribute__((ext_vector_type(4)));
typedef unsigned v2u __attribute__((ext_vector_type(2)));
typedef float f32x4 __attribute__((ext_vector_type(4)));
typedef float f32x2 __attribute__((ext_vector_type(2)));
typedef GAS unsigned gu32;
#define RLX_AGENT __ATOMIC_RELAXED, __HIP_MEMORY_SCOPE_AGENT
#define LDS_WAIT() asm volatile("s_waitcnt lgkmcnt(0)" ::: "memory")
#define VM_WAIT() asm volatile("s_waitcnt vmcnt(0)" ::: "memory")
__device__ __forceinline__ unsigned f2bf(float f) { unsigned u = __builtin_bit_cast(unsigned, f); return (u + 0x7fffu + ((u >> 16) & 1u)) >> 16; }
__device__ __forceinline__ unsigned pk2(float lo, float hi) { return pg8::cvt_pk_bf16(lo, hi); }
__device__ __forceinline__ float bflo(unsigned w) { return __builtin_bit_cast(float, w << 16); }
__device__ __forceinline__ float bfhi(unsigned w) { return __builtin_bit_cast(float, w & 0xffff0000u); }
typedef _Float16 h2_t __attribute__((ext_vector_type(2)));
typedef _Float16 f16x8_t __attribute__((ext_vector_type(8)));
__device__ __forceinline__ unsigned pkh2(float lo, float hi) { const h2_t v = {(_Float16)lo, (_Float16)hi}; return __builtin_bit_cast(unsigned, v); }
__device__ __forceinline__ float hlo(unsigned w) { return (float)__builtin_bit_cast(h2_t, w)[0]; }
__device__ __forceinline__ float hhi(unsigned w) { return (float)__builtin_bit_cast(h2_t, w)[1]; }
__device__ __forceinline__ float bf2f(bf16 b) { return __builtin_bit_cast(float, ((unsigned)b) << 16); }

#define XB_TMO      128
#define XB_XCNT(j)  (256  + 64 * (j))
#define XB_XSUB(j)  (1280 + 64 * (j))
#define XB_XGEN(j)  (2304 + 64 * (j))
#define XB_TOP      3328
#define XB_TOPGEN   3392
#define XCD_BAR_WORDS 3456
#define XB_SPIN_CAP (1u << 23)

__device__ __forceinline__ unsigned xb_ld(unsigned* p)              { return __hip_atomic_load(p, __ATOMIC_RELAXED, __HIP_MEMORY_SCOPE_AGENT); }
__device__ __forceinline__ unsigned xb_add(unsigned* p, unsigned v) { return __hip_atomic_fetch_add(p, v, __ATOMIC_RELAXED, __HIP_MEMORY_SCOPE_AGENT); }
__device__ __forceinline__ unsigned xb_xcc_id() { return (unsigned)__builtin_amdgcn_s_getreg((3 << 11) | 20) & 0xFu; }
#define XB_SPIN(cond, bar) do { unsigned _sp = 0; while (cond) { __builtin_amdgcn_s_sleep(1); \
    if ((++_sp & 255u) == 0u) { if (xb_ld(&(bar)[XB_TMO])) break; if (_sp > XB_SPIN_CAP) { atomicAdd(&(bar)[XB_TMO], 1u); break; } } } } while (0)

struct XcdBarrier { unsigned* bar; unsigned x; volatile LAS unsigned* st; int wave; };

__device__ __forceinline__ XcdBarrier xcd_barrier_post(unsigned* bar, volatile LAS unsigned* st, int wave) {
    XcdBarrier b; b.bar = bar; b.x = xb_xcc_id(); b.st = st; b.wave = wave;
    if (threadIdx.x == 0) (void)xb_add(&bar[XB_XCNT(b.x)], 1u);
    return b;
}
__device__ __forceinline__ void xcd_barrier_complete(unsigned* bar, unsigned x, unsigned& nloc, unsigned& nx) {
    const unsigned G = gridDim.x * gridDim.y * gridDim.z;
    unsigned sum, cnt, mine, sp = 0u;
    for (;;) {
        sum = 0u; cnt = 0u; mine = 0u;
#pragma unroll
        for (unsigned j = 0; j < 16; ++j) { const unsigned c = xb_ld(&bar[XB_XCNT(j)]); sum += c; cnt += (c > 0u) ? 1u : 0u; mine = (j == x) ? c : mine; }
        if (sum == G) break;
        __builtin_amdgcn_s_sleep(1);
        if ((++sp & 255u) == 0u) { if (xb_ld(&bar[XB_TMO])) break; if (sp > XB_SPIN_CAP) { atomicAdd(&bar[XB_TMO], 1u); break; } }
    }
    nloc = mine > 0u ? mine : 1u; nx = cnt > 0u ? cnt : 1u;
}
__device__ __forceinline__ void xcd_barrier(const XcdBarrier& b) {
    asm volatile("s_waitcnt vmcnt(0)" ::: "memory");
    __syncthreads();
    int bw_ = b.wave; asm volatile("" : "+s"(bw_));
    if (bw_ == 0 && lane_id_v() == 0) {
        unsigned* bar = b.bar;
        __builtin_amdgcn_s_waitcnt(0);
        unsigned nloc = b.st[0], nx = b.st[1];
        if (nloc == 0u) { xcd_barrier_complete(bar, b.x, nloc, nx); b.st[0] = nloc; b.st[1] = nx; }
        const unsigned old = xb_add(&bar[XB_XSUB(b.x)], 1u);
        const unsigned gen = old / nloc;
        if (old + 1u == (gen + 1u) * nloc) {
            __builtin_amdgcn_fence(__ATOMIC_RELEASE, "agent");
            asm volatile("s_waitcnt vmcnt(0)" ::: "memory");
            const unsigned og = xb_add(&bar[XB_TOP], 1u);
            const unsigned tg = og / nx;
            if (og + 1u == (tg + 1u) * nx) xb_add(&bar[XB_TOPGEN], 1u);
            else XB_SPIN(xb_ld(&bar[XB_TOPGEN]) == tg, bar);
            __builtin_amdgcn_fence(__ATOMIC_ACQUIRE, "agent");
            xb_add(&bar[XB_XGEN(b.x)], 1u);
            asm volatile("s_waitcnt vmcnt(0)" ::: "memory");
        } else {
            XB_SPIN(xb_ld(&bar[XB_XGEN(b.x)]) == gen, bar);
            __builtin_amdgcn_fence(__ATOMIC_ACQUIRE, "agent");
            asm volatile("s_waitcnt vmcnt(0)" ::: "memory");
        }
    }
    __syncthreads();
}

struct Args {
    const float* in[23]; float* out; unsigned char* ws; int ph_lo, ph_hi;
};
template <class T> __device__ __forceinline__ T* uni(T* p) { const unsigned long long v = (unsigned long long)p; const unsigned lo = __builtin_amdgcn_readfirstlane((unsigned)v), hi = __builtin_amdgcn_readfirstlane((unsigned)(v >> 32)); return (T*)(((unsigned long long)hi << 32) | lo); }
__device__ __forceinline__ LAS unsigned char* uni_l(LAS unsigned char* p) { return (LAS unsigned char*)(unsigned)__builtin_amdgcn_readfirstlane((int)(unsigned)(size_t)p); }
__device__ __forceinline__ int uni_i(int v) { return __builtin_amdgcn_readfirstlane(v); }
struct PC { const float* const* in; float* out; unsigned char* ws; LAS unsigned char* lds; int wave, vcu, G; };
struct Frame {
    LAS unsigned char* lds;
    volatile LAS unsigned* MISC;
    gu32* ctl;
    int wave, vcu, G;
    unsigned char* ws;
};
__device__ __forceinline__ unsigned char* launder_p(unsigned char* p) { asm volatile("" : "+s"(p)); return p; }
__device__ __forceinline__ int launder_s(int v) { asm volatile("" : "+s"(v)); return v; }
__device__ __forceinline__ int launder_v(int v) { asm volatile("" : "+v"(v)); return v; }
__device__ __forceinline__ float wave_sum(float v) {
#pragma unroll
    for (int o = 1; o < 64; o <<= 1) v += __shfl_xor(v, o);
    return v;
}
__device__ __forceinline__ float wave_max(float v) {
#pragma unroll
    for (int o = 1; o < 64; o <<= 1) v = fmaxf(v, __shfl_xor(v, o));
    return v;
}

using pg8::Unit; using pg8::bf16_t;
#define LAUNDER2(a, b) asm volatile("" : "+v"(a), "+v"(b))
__device__ __forceinline__ float row_scale(const float* ss, int row) {
    const f32x4 a = *(const f32x4*)(ss + (size_t)row * 4);
    const float s = (a.x + a.y) + (a.z + a.w);
    return __builtin_amdgcn_rsqf(s * (1.0f / D) + EPS);
}
__device__ __forceinline__ float sigmoidf_(float x) { return __builtin_amdgcn_rcpf(1.0f + __expf(-x)); }
__device__ __forceinline__ pg8::u32x2 pack4(const f32x4 v) { pg8::u32x2 w; w.x = pg8::cvt_pk_bf16(v[0], v[1]); w.y = pg8::cvt_pk_bf16(v[2], v[3]); return w; }

struct EpiSwiglu {
    static constexpr bool PERM = true;
    bf16_t* O; const float* ss;
    __device__ __forceinline__ void operator()(const f32x4 (&acc)[2][2][4][2], const Unit& u, int wr, int wc, int fr_, int fq_) const {
        const int l_ = lane_id_v(); const int fr = l_ & 15, fq = l_ >> 4; (void)fr_; (void)fq_;
        int rb = wr * 64 + fr, cb = wc * 32 + 8 * fq; LAUNDER2(rb, cb);
        const int row0 = u.pm * 256 + rb, col0 = u.pn * 128 + cb;
        f32x4 sq8[2][4];
#pragma unroll
        for (int ai = 0; ai < 2; ++ai)
#pragma unroll
            for (int m = 0; m < 4; ++m) sq8[ai][m] = *(const GAS f32x4*)(ss + (size_t)(row0 + ai * 128 + m * 16) * 4);
#pragma unroll
        for (int ai = 0; ai < 2; ++ai)
#pragma unroll
            for (int m = 0; m < 4; ++m) { const int row = row0 + ai * 128 + m * 16;
                const f32x4 sq = sq8[ai][m]; const float k = ((sq.x + sq.y) + (sq.z + sq.w)) * (1.0f / D) + EPS; const float c1 = __builtin_amdgcn_rsqf(k) * -1.4426950408889634f;
                pg8::u32x4 w;
                { const f32x4 a = acc[ai][0][m][0], b = acc[ai][1][m][0]; f32x4 o;
#pragma unroll
                  for (int i = 0; i < 4; ++i) o[i] = (a[i] * b[i]) * __builtin_amdgcn_rcpf(fmaf(__builtin_amdgcn_exp2f(a[i] * c1), k, k));
                  w.x = pg8::cvt_pk_bf16(o[0], o[1]); w.y = pg8::cvt_pk_bf16(o[2], o[3]); }
                { const f32x4 a = acc[ai][0][m][1], b = acc[ai][1][m][1]; f32x4 o;
#pragma unroll
                  for (int i = 0; i < 4; ++i) o[i] = (a[i] * b[i]) * __builtin_amdgcn_rcpf(fmaf(__builtin_amdgcn_exp2f(a[i] * c1), k, k));
                  w.z = pg8::cvt_pk_bf16(o[0], o[1]); w.w = pg8::cvt_pk_bf16(o[2], o[3]); }
                __builtin_nontemporal_store(w, (GAS pg8::u32x4*)(O + (size_t)row * DFF + col0)); }
    }
};
struct EpiResid {
    static constexpr bool PERM = true;
    const float* base; float* out; bf16_t* hb; float* ss; float alpha; LAS float* P; int dry;
    __device__ __forceinline__ void operator()(const f32x4 (&acc)[2][2][4][2], const Unit& u, int wr, int wc, int fr_, int fq_) const {
        const int l_ = lane_id_v(); const int fr = l_ & 15, fq = l_ >> 4; (void)fr_; (void)fq_;
        int rb = wr * 64 + fr, cb = wc * 32 + 8 * fq; LAUNDER2(rb, cb);
        const int row0 = u.pm * 256 + rb, col0 = u.pn * 256 + cb;
#pragma unroll
        for (int ai = 0; ai < 2; ++ai)
#pragma unroll
          for (int mh = 0; mh < 2; ++mh) {
            f32x4 bs[2][2][2];
#pragma unroll
            for (int mm = 0; mm < 2; ++mm) { const size_t off = (size_t)(row0 + ai * 128 + (2 * mh + mm) * 16) * D + col0;
#pragma unroll
                for (int bj = 0; bj < 2; ++bj)
#pragma unroll
                    for (int n = 0; n < 2; ++n) bs[mm][bj][n] = *(const GAS f32x4*)(base + off + bj * 128 + n * 4); }
#pragma unroll
            for (int mm = 0; mm < 2; ++mm) { const int m = 2 * mh + mm; const int row = row0 + ai * 128 + m * 16; const size_t off = (size_t)row * D + col0; float q = 0.f;
#pragma unroll
                for (int bj = 0; bj < 2; ++bj) { const f32x4 v0 = bs[mm][bj][0] + acc[ai][bj][m][0] * alpha, v1 = bs[mm][bj][1] + acc[ai][bj][m][1] * alpha;
                    if (!dry) { *(GAS f32x4*)(out + off + bj * 128) = v0; *(GAS f32x4*)(out + off + bj * 128 + 4) = v1;
                        pg8::u32x4 w; w.x = pg8::cvt_pk_bf16(v0[0], v0[1]); w.y = pg8::cvt_pk_bf16(v0[2], v0[3]); w.z = pg8::cvt_pk_bf16(v1[0], v1[1]); w.w = pg8::cvt_pk_bf16(v1[2], v1[3]);
                        *(GAS pg8::u32x4*)(hb + off + bj * 128) = w; }
                    q += ((v0[0] * v0[0] + v0[1] * v0[1]) + (v0[2] * v0[2] + v0[3] * v0[3])) + ((v1[0] * v1[0] + v1[1] * v1[1]) + (v1[2] * v1[2] + v1[3] * v1[3])); }
                q += __shfl_xor(q, 16); q += __shfl_xor(q, 32);
                if (fq == 0) P[(rb + ai * 128 + m * 16) * 4 + wc] = q; }
            asm volatile("" ::: "memory"); }
        asm volatile("s_waitcnt lgkmcnt(0)" ::: "memory"); __builtin_amdgcn_s_barrier(); asm volatile("" ::: "memory");
        const int tid = (wr * 4 + wc) * 64 + fq * 16 + fr;
        if (tid < 256 && !dry) { const f32x4 p = *(const LAS f32x4*)(P + tid * 4); ss[(size_t)(u.pm * 256 + tid) * 4 + u.pn] = (p.x + p.y) + (p.z + p.w); }
    }
};
struct EpiPlainBf16 {
    static constexpr bool PERM = false;
    bf16_t* O; int ldo;
    __device__ __forceinline__ void operator()(const f32x4 (&acc)[2][2][4][2], const Unit& u, int wr, int wc, int fr_, int fq_) const {
        const int l_ = lane_id_v(); const int fr = l_ & 15, fq = l_ >> 4; (void)fr_; (void)fq_;
        int rb = wr * 64 + fr, cb = wc * 32 + 4 * fq; LAUNDER2(rb, cb);
        const int row0 = u.pm * 256 + rb, col0 = u.pn * 256 + cb;
#pragma unroll
        for (int ai = 0; ai < 2; ++ai)
#pragma unroll
            for (int m = 0; m < 4; ++m) { bf16_t* rowp = O + (size_t)(row0 + ai * 128 + m * 16) * ldo + col0;
#pragma unroll
                for (int bj = 0; bj < 2; ++bj)
#pragma unroll
                    for (int n = 0; n < 2; ++n) *(pg8::u32x2*)(rowp + bj * 128 + n * 16) = pack4(acc[ai][bj][m][n]); }
    }
};
struct EpiInProj {
    static constexpr bool PERM = true;
    const float* ss; bf16_t* qa; float* ckvraw; bf16_t* ik; float* iw; bf16_t* iqraw; bf16_t* z; bf16_t* qc; bf16_t* G;
    __device__ __forceinline__ void operator()(const f32x4 (&acc)[2][2][4][2], const Unit& u, int wr, int wc, int fr_, int fq_) const {
        const int l_ = lane_id_v(); const int fr = l_ & 15, fq = l_ >> 4; (void)fr_; (void)fq_;
        int rb = wr * 64 + fr, ct = wc * 32 + 8 * fq; LAUNDER2(rb, ct);
        const int row0 = u.pm * 256 + rb; const int pn = u.pn;
        if (pn == 4) {
#pragma unroll
            for (int ai = 0; ai < 2; ++ai)
#pragma unroll
                for (int m = 0; m < 4; ++m) { const int row = row0 + ai * 128 + m * 16; const float s = row_scale(ss, row);
#pragma unroll
                    for (int n = 0; n < 2; ++n) *(GAS f32x4*)(ckvraw + (size_t)row * KVR + ct + n * 4) = acc[ai][0][m][n] * s;
                    if (wc == 0) { const f32x4 k0 = acc[ai][1][m][0] * s, k1 = acc[ai][1][m][1] * s; pg8::u32x4 w; w.x = pkh2(k0[0], k0[1]); w.y = pkh2(k0[2], k0[3]); w.z = pkh2(k1[0], k1[1]); w.w = pkh2(k1[2], k1[3]);
                        *(pg8::u32x4*)(ik + (size_t)row * IDIM + 8 * fq) = w; }
                    if (wc == 1 && fq == 0) { *(f32x4*)(iw + (size_t)row * IH) = acc[ai][1][m][0] * s; *(f32x4*)(iw + (size_t)row * IH + 4) = acc[ai][1][m][1] * s; } }
        } else {
            bf16_t* dst0; int ld; bool sig = false; const bool f16out = (pn == 5);
            if (pn < 4) { dst0 = qa + pn * 256; ld = 1024; } else if (pn == 5) { dst0 = iqraw; ld = 256; } else if (pn == 6) { dst0 = z; ld = 256; } else if (pn == 7) { dst0 = qc; ld = 256; } else { dst0 = G + (pn - 8) * 256; ld = 3072; sig = true; }
#pragma unroll
            for (int ai = 0; ai < 2; ++ai)
#pragma unroll
                for (int m = 0; m < 4; ++m) { const int row = row0 + ai * 128 + m * 16; const float s = row_scale(ss, row); bf16_t* rowp = dst0 + (size_t)row * ld + ct;
#pragma unroll
                    for (int bj = 0; bj < 2; ++bj) { f32x4 o0, o1;
                        if (sig) { const float c1 = s * -1.4426950408889634f;
#pragma unroll
                            for (int i = 0; i < 4; ++i) { o0[i] = __builtin_amdgcn_rcpf(1.0f + __builtin_amdgcn_exp2f(acc[ai][bj][m][0][i] * c1)); o1[i] = __builtin_amdgcn_rcpf(1.0f + __builtin_amdgcn_exp2f(acc[ai][bj][m][1][i] * c1)); } }
                        else { o0 = acc[ai][bj][m][0] * s; o1 = acc[ai][bj][m][1] * s; }
                        pg8::u32x4 wo;
                        if (f16out) { wo.x = pkh2(o0[0], o0[1]); wo.y = pkh2(o0[2], o0[3]); wo.z = pkh2(o1[0], o1[1]); wo.w = pkh2(o1[2], o1[3]); }
                        else { wo.x = pg8::cvt_pk_bf16(o0[0], o0[1]); wo.y = pg8::cvt_pk_bf16(o0[2], o0[3]); wo.z = pg8::cvt_pk_bf16(o1[0], o1[1]); wo.w = pg8::cvt_pk_bf16(o1[2], o1[3]); }
                        *(GAS pg8::u32x4*)(rowp + bj * 128) = wo; } }
        }
    }
};
template <int MODE> struct EpiMerge {
    static constexpr bool PERM = true;
    bf16_t* Mg; const bf16_t* G;
    __device__ __forceinline__ void operator()(const f32x4 (&acc)[2][2][4][2], const Unit& u, int wr, int wc, int fr_, int fq_) const {
        const int l_ = lane_id_v(); const int fr = l_ & 15, fq = l_ >> 4; (void)fr_; (void)fq_;
        int rb = wr * 64 + fr, cb = wc * 32 + 8 * fq; LAUNDER2(rb, cb);
        const int row0 = u.pm * 256 + rb, col0 = u.pn * 256 + cb;
#pragma unroll
        for (int ai = 0; ai < 2; ++ai)
#pragma unroll
          for (int mh = 0; mh < 1; ++mh) {
            pg8::u32x4 gw[4][2], pw[4][2];
#pragma unroll
            for (int mm = 0; mm < 4; ++mm) { const int row = row0 + ai * 128 + mm * 16;
#pragma unroll
                for (int bj = 0; bj < 2; ++bj) { gw[mm][bj] = *(const pg8::u32x4*)(G + (size_t)row * 3072 + MODE * 1024 + col0 + bj * 128);
                    if (MODE > 0) pw[mm][bj] = *(const pg8::u32x4*)(Mg + (size_t)row * D + col0 + bj * 128); } }
#pragma unroll
            for (int mm = 0; mm < 4; ++mm) { const int m = mm; const int row = row0 + ai * 128 + m * 16;
#pragma unroll
                for (int bj = 0; bj < 2; ++bj) { const pg8::u32x4 g4 = gw[mm][bj];
                    f32x4 o0 = acc[ai][bj][m][0], o1 = acc[ai][bj][m][1];
                    o0[0] *= bflo(g4.x); o0[1] *= bfhi(g4.x); o0[2] *= bflo(g4.y); o0[3] *= bfhi(g4.y); o1[0] *= bflo(g4.z); o1[1] *= bfhi(g4.z); o1[2] *= bflo(g4.w); o1[3] *= bfhi(g4.w);
                    if (MODE > 0) { const pg8::u32x4 p4 = pw[mm][bj];
                        o0[0] += bflo(p4.x); o0[1] += bfhi(p4.x); o0[2] += bflo(p4.y); o0[3] += bfhi(p4.y); o1[0] += bflo(p4.z); o1[1] += bfhi(p4.z); o1[2] += bflo(p4.w); o1[3] += bfhi(p4.w); }
                    pg8::u32x4 w; w.x = pg8::cvt_pk_bf16(o0[0], o0[1]); w.y = pg8::cvt_pk_bf16(o0[2], o0[3]); w.z = pg8::cvt_pk_bf16(o1[0], o1[1]); w.w = pg8::cvt_pk_bf16(o1[2], o1[3]);
                    *(pg8::u32x4*)(Mg + (size_t)row * D + col0 + bj * 128) = w; } }
            asm volatile("" ::: "memory"); }
    }
};

struct EpiMergeF {
    static constexpr bool PERM = true;
    bf16_t* Mg; const bf16_t* G;
    __device__ __forceinline__ void mid(f32x4 (&acc)[2][2][4][2], const Unit& u, int wr, int wc, int which) const {
        const int l_ = lane_id_v(); const int fr = l_ & 15, fq = l_ >> 4;
        int rb = wr * 64 + fr, cb = wc * 32 + 8 * fq; LAUNDER2(rb, cb);
        const int row0 = u.pm * 256 + rb, col0 = u.pn * 256 + cb + which * 1024;
#pragma unroll
        for (int ai = 0; ai < 2; ++ai) {
            pg8::u32x4 ga[4][2], gb[4][2];
#pragma unroll
            for (int mm = 0; mm < 4; ++mm) { const bf16_t* gp = G + (size_t)(row0 + ai * 128 + mm * 16) * 3072 + col0;
#pragma unroll
                for (int bj = 0; bj < 2; ++bj) { ga[mm][bj] = *(const GAS pg8::u32x4*)(gp + bj * 128); gb[mm][bj] = *(const GAS pg8::u32x4*)(gp + 1024 + bj * 128); } }
#pragma unroll
            for (int mm = 0; mm < 4; ++mm)
#pragma unroll
                for (int bj = 0; bj < 2; ++bj) { const pg8::u32x4 a4 = ga[mm][bj], b4 = gb[mm][bj];
                    const unsigned aw[4] = {a4.x, a4.y, a4.z, a4.w}, bw[4] = {b4.x, b4.y, b4.z, b4.w};
#pragma unroll
                    for (int k = 0; k < 4; ++k) { const float r0 = bflo(aw[k]) * __builtin_amdgcn_rcpf(fmaxf(bflo(bw[k]), 1e-30f)), r1 = bfhi(aw[k]) * __builtin_amdgcn_rcpf(fmaxf(bfhi(bw[k]), 1e-30f));
                        acc[ai][bj][mm][k >> 1][2 * (k & 1)] *= r0; acc[ai][bj][mm][k >> 1][2 * (k & 1) + 1] *= r1; } }
            asm volatile("" ::: "memory"); }
    }
    __device__ __forceinline__ void fin(const f32x4 (&acc)[2][2][4][2], const Unit& u, int wr, int wc) const {
        const int l_ = lane_id_v(); const int fr = l_ & 15, fq = l_ >> 4;
        int rb = wr * 64 + fr, cb = wc * 32 + 8 * fq; LAUNDER2(rb, cb);
        const int row0 = u.pm * 256 + rb, col0 = u.pn * 256 + cb;
        pg8::u32x4 gw[2][4][2];
#pragma unroll
        for (int ai = 0; ai < 2; ++ai)
#pragma unroll
            for (int mm = 0; mm < 4; ++mm)
#pragma unroll
                for (int bj = 0; bj < 2; ++bj) gw[ai][mm][bj] = *(const pg8::u32x4*)(G + (size_t)(row0 + ai * 128 + mm * 16) * 3072 + 2048 + col0 + bj * 128);
#pragma unroll
        for (int ai = 0; ai < 2; ++ai)
#pragma unroll
            for (int mm = 0; mm < 4; ++mm) { const int row = row0 + ai * 128 + mm * 16;
#pragma unroll
                for (int bj = 0; bj < 2; ++bj) { const pg8::u32x4 g4 = gw[ai][mm][bj];
                    f32x4 o0 = acc[ai][bj][mm][0], o1 = acc[ai][bj][mm][1];
                    o0[0] *= bflo(g4.x); o0[1] *= bfhi(g4.x); o0[2] *= bflo(g4.y); o0[3] *= bfhi(g4.y); o1[0] *= bflo(g4.z); o1[1] *= bfhi(g4.z); o1[2] *= bflo(g4.w); o1[3] *= bfhi(g4.w);
                    pg8::u32x4 w; w.x = pg8::cvt_pk_bf16(o0[0], o0[1]); w.y = pg8::cvt_pk_bf16(o0[2], o0[3]); w.z = pg8::cvt_pk_bf16(o1[0], o1[1]); w.w = pg8::cvt_pk_bf16(o1[2], o1[3]);
                    *(pg8::u32x4*)(Mg + (size_t)row * D + col0 + bj * 128) = w; } }
    }
};

template <class Map>
__device__ __forceinline__ void transpose_item(const float* W, int K, int N, const float* gain, bf16* WT, LAS float* scr, int item, int lane, Map map, int ldk = 0) {
    const int nblk = (N + 63) / 64, kb = item / nblk, nb = item % nblk, k0 = 64 * kb, n0 = 64 * nb;
    const int nn = n0 + 4 * (lane & 15); const bool nok = nn < N;
#pragma unroll
    for (int i0 = 0; i0 < 16; i0 += 8) { f32x4 vb[8]; float gb[8];
#pragma unroll
        for (int u = 0; u < 8; ++u) { const int kk = 4 * (i0 + u) + (lane >> 4); vb[u] = nok ? __builtin_nontemporal_load((const GAS f32x4*)(W + (size_t)(k0 + kk) * N + nn)) : (f32x4){0.f, 0.f, 0.f, 0.f}; gb[u] = gain ? gain[k0 + kk] : 1.0f; }
#pragma unroll
        for (int u = 0; u < 8; ++u) { const int kk = 4 * (i0 + u) + (lane >> 4); f32x4 v = vb[u];
            if (gain) v = v * gb[u];
            *(LAS f32x4*)(scr + kk * 68 + 4 * (lane & 15)) = v; } }
    LDS_WAIT(); asm volatile("" ::: "memory");
    const int c = lane & 7;
#pragma unroll
    for (int j = 0; j < 8; ++j) { const int n = (lane >> 3) + 8 * j; const LAS float* sp = scr + (8 * c) * 68 + n;
        v4u o; o.x = pk2(sp[0 * 68], sp[1 * 68]); o.y = pk2(sp[2 * 68], sp[3 * 68]); o.z = pk2(sp[4 * 68], sp[5 * 68]); o.w = pk2(sp[6 * 68], sp[7 * 68]);
        if (n0 + n < N) { const int dr = map(n0 + n); if (dr >= 0) *(GAS v4u*)(WT + (size_t)dr * (ldk ? ldk : K) + k0 + 8 * c) = o; } }
    LDS_WAIT(); asm volatile("" ::: "memory");
}
struct MapId { int off; __device__ __forceinline__ int operator()(int n) const { return off + n; } };
struct MapSwiglu { __device__ __forceinline__ int operator()(int c) const { const int half = c >= DFF ? 1 : 0, j = c - half * DFF; return 256 * (j >> 7) + 128 * half + (j & 127); } };
struct MapInProj { __device__ __forceinline__ int operator()(int c) const {
    if (c < C_CKV) return -1;
    if (c < C_IQ) return 1024 + (c - C_CKV);
    if (c < C_IK) return 1280 + (c - C_IQ);
    if (c < C_IW) return 1152 + (c - C_IK);
    if (c < C_Z) return 1184 + (c - C_IW);
    if (c < C_QC) return 1536 + (c - C_Z);
    if (c < C_G) return 1792 + (c - C_QC);
    return 2048 + (c - C_G); } };
__device__ __forceinline__ void qlat_item(const float* win, const float* mixn, const float* wuk, bf16* WT, int item, int lane) {
    const int kc = item & 127, rh = (item >> 7) & 1, h = item >> 8; const int r = rh * 64 + lane;
    const f32x4* wp = (const f32x4*)(wuk + (size_t)r * (AH * AHD) + h * 64);
    float acc[8] = {0.f, 0.f, 0.f, 0.f, 0.f, 0.f, 0.f, 0.f};
#pragma unroll 1
    for (int dc = 0; dc < 4; ++dc) {
        const f32x4 w0 = wp[4 * dc], w1 = wp[4 * dc + 1], w2 = wp[4 * dc + 2], w3 = wp[4 * dc + 3];
#pragma unroll
        for (int kk = 0; kk < 8; ++kk) { const f32x4* ip = (const f32x4*)(win + (size_t)(kc * 8 + kk) * INW + h * 64 + 16 * dc);
            const f32x4 a0 = ip[0], a1 = ip[1], a2 = ip[2], a3 = ip[3];
            acc[kk] += (a0.x * w0.x + a0.y * w0.y + a0.z * w0.z + a0.w * w0.w) + (a1.x * w1.x + a1.y * w1.y + a1.z * w1.z + a1.w * w1.w)
                     + (a2.x * w2.x + a2.y * w2.y + a2.z * w2.z + a2.w * w2.w) + (a3.x * w3.x + a3.y * w3.y + a3.z * w3.z + a3.w * w3.w);
            if (kk & 1) asm volatile("" ::: "memory"); }
    }
    const f32x4 g0 = *(const f32x4*)(mixn + kc * 8), g1 = *(const f32x4*)(mixn + kc * 8 + 4);
    v4u w; w.x = pk2(acc[0] * g0.x, acc[1] * g0.y); w.y = pk2(acc[2] * g0.z, acc[3] * g0.w); w.z = pk2(acc[4] * g1.x, acc[5] * g1.y); w.w = pk2(acc[6] * g1.z, acc[7] * g1.w);
    *(GAS v4u*)(WT + (size_t)(h * 128 + r) * D + kc * 8) = w;
}
__device__ __forceinline__ void wafold_item(const float* wuv, const float* wba, bf16* WT, int item, int lane) {
    const int ng = item & 15, rg = (item >> 4) & 15, h = item >> 8; const int n = ng * 64 + lane, r0 = rg * 8;
    float acc[8] = {0.f, 0.f, 0.f, 0.f, 0.f, 0.f, 0.f, 0.f};
#pragma unroll 4
    for (int d = 0; d < 64; ++d) { const float wa = wba[(size_t)(h * 64 + d) * D + n];
#pragma unroll
        for (int j = 0; j < 8; ++j) acc[j] += wuv[(size_t)(r0 + j) * (AH * AHD) + h * 64 + d] * wa; }
    v4u w; w.x = pk2(acc[0], acc[1]); w.y = pk2(acc[2], acc[3]); w.z = pk2(acc[4], acc[5]); w.w = pk2(acc[6], acc[7]);
    *(GAS v4u*)(WT + (size_t)n * 1024 + h * 128 + r0) = w;
}
__device__ __forceinline__ int items_of(int K, int N) { return (K / 64) * ((N + 63) / 64); }

__device__ __forceinline__ void prep_layer_weights_body(const PC& F, int l) {
    struct { const float* const* in; } a{F.in};
    const int lane_ = lane_id_v();
    LAS float* scr = (LAS float*)(F.lds + RING_OFF + F.wave * 17408);
    const int gw = F.vcu * NWAVES + F.wave, NGW = F.G * NWAVES;
    const float* f1n = a.in[3] + (size_t)l * D; const float* f1in = a.in[4] + (size_t)l * D * 2 * DFF; const float* f1out = a.in[5] + (size_t)l * DFF * D;
    const float* mixn = a.in[6] + (size_t)l * D; const float* win = a.in[7] + (size_t)l * D * INW;
    const float* wba = a.in[15] + (size_t)l * AW * D; const float* wbb = a.in[16] + (size_t)l * PW_ * D; const float* wbc = a.in[17] + (size_t)l * CW * D;
    const float* wout = a.in[18] + (size_t)l * D * D;
    const float* f2n = a.in[19] + (size_t)l * D; const float* f2in = a.in[20] + (size_t)l * D * 2 * DFF; const float* f2out = a.in[21] + (size_t)l * DFF * D;
    unsigned char* ws = launder_p(F.ws);
    const float* wuk = a.in[9] + (size_t)l * KVR * AH * AHD; const float* wuv = a.in[10] + (size_t)l * KVR * AH * AHD;
    const int I0 = items_of(D, 2 * DFF), I1 = items_of(DFF, D), I2 = items_of(D, INW), I4 = items_of(PW_, D), I5 = items_of(CW, D), I6 = items_of(D, D);
    const int NIT = 2 * I0 + 2 * I1 + I2 + I4 + I5 + I6;
#pragma unroll 1
    for (int it = gw; it < NIT; it += NGW) {
        int r = it;
        if (r < I0) { transpose_item(f1in, D, 2 * DFF, f1n, (bf16*)(ws + WS_W1IN), scr, r, lane_, MapSwiglu{}); continue; } r -= I0;
        if (r < I0) { transpose_item(f2in, D, 2 * DFF, f2n, (bf16*)(ws + WS_W2IN), scr, r, lane_, MapSwiglu{}); continue; } r -= I0;
        if (r < I1) { transpose_item(f1out, DFF, D, nullptr, (bf16*)(ws + WS_W1OUT), scr, r, lane_, MapId{0}); continue; } r -= I1;
        if (r < I1) { transpose_item(f2out, DFF, D, nullptr, (bf16*)(ws + WS_W2OUT), scr, r, lane_, MapId{0}); continue; } r -= I1;
        if (r < I2) { transpose_item(win, D, INW, mixn, (bf16*)(ws + WS_WIN), scr, r, lane_, MapInProj{}); continue; } r -= I2;
        if (r < I4) { transpose_item(wbb, PW_, D, nullptr, (bf16*)(ws + WS_WBC), scr, r, lane_, MapId{0}, 1024); continue; } r -= I4;
        if (r < I5) { transpose_item(wbc, CW, D, nullptr, (bf16*)(ws + WS_WBC) + 256, scr, r, lane_, MapId{0}, 1024); continue; } r -= I5;
        transpose_item(wout, D, D, nullptr, (bf16*)(ws + WS_WOUT), scr, r, lane_, MapId{0});
    }
    { const float* wpool = a.in[11] + (size_t)l * 4 * 64 * 64; bf16* wpT = (bf16*)(ws + WS_WPT);
      for (int i = gw * 64 + lane_; i < 4 * 64 * 64; i += NGW * 64) { const int c = i & 63, d = (i >> 6) & 63, g = i >> 12; wpT[i] = (bf16)f2bf(wpool[(g * 64 + c) * 64 + d]); } }
    asm volatile("" ::: "memory");
#pragma unroll 1
    for (int it = gw; it < 2048; it += NGW) wafold_item(wuv, wba, (bf16*)(ws + WS_WA), it, lane_);
    asm volatile("" ::: "memory");
#pragma unroll 1
    for (int it = gw; it < 2048; it += NGW) qlat_item(win, mixn, wuk, (bf16*)(ws + WS_WIN), it, lane_);
}

__device__ __noinline__ void p0_prologue(const float* const* in_, float* out_, unsigned char* ws_, LAS unsigned char* lds_, int wave_, int vcu_, int G_) {
    const PC F{uni(in_), uni(out_), uni(ws_), uni_l(lds_), uni_i(wave_), uni_i(vcu_), uni_i(G_)}; struct { const float* const* in; } a{F.in};
    const int lane_ = lane_id_v();
    const int gw = F.vcu * NWAVES + F.wave, NGW = F.G * NWAVES;
    const float* x = a.in[0]; const float* mem = a.in[1];
    bf16* hb = (bf16*)(F.ws + WS_HB); float* ss = (float*)(F.ws + WS_SS); bf16* memn = (bf16*)(F.ws + WS_MEMN);
    for (int m = gw; m < M + MROWS; m += NGW) {
        const bool ismem = m >= M; const int r = ismem ? m - M : m;
        const GAS f32x4* xr = (const GAS f32x4*)((ismem ? mem : x) + (size_t)r * D) + lane_;
        f32x4 v[4]; float s = 0.f;
#pragma unroll
        for (int j = 0; j < 4; ++j) { v[j] = xr[64 * j]; s += (v[j].x * v[j].x + v[j].y * v[j].y) + (v[j].z * v[j].z + v[j].w * v[j].w); }
        s = wave_sum(s);
        float sc = 1.f;
        if (ismem) sc = 1.0f / sqrtf(s * (1.0f / D) + EPS);
        else if (lane_ < 4) ss[(size_t)r * 4 + lane_] = lane_ == 0 ? s : 0.f;
        GAS unsigned long long* o8 = (GAS unsigned long long*)((ismem ? memn : hb) + (size_t)r * D) + lane_;
#pragma unroll
        for (int j = 0; j < 4; ++j) o8[64 * j] = (unsigned long long)pk2(v[j].x * sc, v[j].y * sc) | ((unsigned long long)pk2(v[j].z * sc, v[j].w * sc) << 32);
    }
    LAS float* scr = (LAS float*)(F.lds + RING_OFF + F.wave * 17408);
    const int IM = items_of(D, 2 * CW);
    for (int it = gw; it < DEPTH * IM; it += NGW) { const int l = it / IM, r = it % IM;
        transpose_item(a.in[14] + (size_t)l * D * 2 * CW, D, 2 * CW, a.in[13] + (size_t)l * D, (bf16*)(F.ws + WS_WMEM), scr, r, lane_, MapId{l * 2 * CW}); }
    prep_layer_weights_body(F, 0);
}
__device__ __noinline__ void prep_layer_weights(const float* const* in_, float* out_, unsigned char* ws_, LAS unsigned char* lds_, int l, int wave_, int vcu_, int G_) {
    const PC F{uni(in_), uni(out_), uni(ws_), uni_l(lds_), uni_i(wave_), uni_i(vcu_), uni_i(G_)}; prep_layer_weights_body(F, uni_i(l));
}

__constant__ unsigned char T5_BUCKET[128] = {0, 1, 2, 3, 4, 5, 6, 7, 8, 9, 10, 11, 12, 13, 14, 15, 16, 16, 16, 17, 17, 18, 18, 18, 19, 19, 19, 20, 20, 20, 20, 21, 21, 21, 21, 22, 22, 22, 22, 22, 23, 23, 23, 23, 23, 23, 24, 24, 24, 24, 24, 24, 25, 25, 25, 25, 25, 25, 25, 26, 26, 26, 26, 26, 26, 26, 26, 27, 27, 27, 27, 27, 27, 27, 27, 27, 27, 28, 28, 28, 28, 28, 28, 28, 28, 28, 28, 29, 29, 29, 29, 29, 29, 29, 29, 29, 29, 29, 29, 30, 30, 30, 30, 30, 30, 30, 30, 30, 30, 30, 30, 30, 30, 31, 31, 31, 31, 31, 31, 31, 31, 31, 31, 31, 31, 31, 31, 31};

typedef short bf16x8_p __attribute__((ext_vector_type(8)));
__device__ __forceinline__ void prep_tokens(const float* const* in_, float* out_, unsigned char* ws_, LAS unsigned char* lds_, int l_, int wave_, int vcu_, int G_, int dry_) {
    const int dry = uni_i(dry_);
    const PC F{uni(in_), uni(out_), uni(ws_), uni_l(lds_), uni_i(wave_), uni_i(vcu_), uni_i(G_)}; struct { const float* const* in; } a{F.in}; const int l = uni_i(l_);
    unsigned char* ws = launder_p(F.ws);
    const float* ckvraw = (const float*)(ws + WS_CKVRAW); bf16* ckv = (bf16*)(ws + WS_CKV);
    const bf16* iqraw = (const bf16*)(ws + WS_IQRAW); bf16* iqf = (bf16*)(ws + WS_IQF); const float* iw = (const float*)(ws + WS_IW); unsigned* sgn = (unsigned*)(ws + WS_SGN);
    const bf16* z = (const bf16*)(ws + WS_Z); bf16* ybc = (bf16*)(ws + WS_HB); const bf16* qc = (const bf16*)(ws + WS_QC);
    const bf16* memkv = (const bf16*)(ws + WS_MEMKV); const bf16* vT = (const bf16*)(ws + WS_VT); const bf16* wpT = (const bf16*)(ws + WS_WPT);
    const float* kvn = a.in[8] + (size_t)l * KVR; const float* pscale = a.in[12] + (size_t)l * PW_;
    const int lane = lane_id_v(), tid = F.wave * 64 + lane;
    const int tok = lane & 15, g4 = lane >> 4;
    LAS unsigned char* Ks = F.lds;
    LAS unsigned char* Vs = F.lds + 36864;
    for (int blk = F.vcu; blk < M / 128; blk += F.G) {
        const int rowb = blk * 128, b = rowb / SEQ, row0 = rowb + F.wave * 16;
        const f32x2 gkv = *(const f32x2*)(kvn + 2 * lane);
#pragma unroll 1
        for (int t0 = 0; t0 < 16; t0 += 4) {
            f32x2 cv4[4]; float wv4[4]; v2u qv4[4];
#pragma unroll
            for (int u = 0; u < 4; ++u) { const int row = row0 + t0 + u; cv4[u] = *(const f32x2*)(ckvraw + (size_t)row * KVR + 2 * lane); wv4[u] = iw[(size_t)row * IH + (lane >> 3)]; qv4[u] = *(const v2u*)(iqraw + (size_t)row * 256 + 4 * lane); }
#pragma unroll
            for (int u = 0; u < 4; ++u) { const int row = row0 + t0 + u;
            { const f32x2 v = cv4[u]; const float q = wave_sum(v.x * v.x + v.y * v.y);
              const float rs = 1.0f / sqrtf(q * (1.0f / KVR) + EPS); const f32x2 g = gkv;
              *(unsigned*)(ckv + (size_t)row * KVR + 2 * lane) = pk2(v.x * rs * g.x, v.y * rs * g.y); }
            { const float wv = wv4[u]; const float aw = fabsf(wv) * (1.0f / 16.0f);
              const v2u q = qv4[u];
              v2u o; o.x = pkh2(hlo(q.x) * aw, hhi(q.x) * aw); o.y = pkh2(hlo(q.y) * aw, hhi(q.y) * aw);
              *(v2u*)(iqf + (size_t)row * 256 + 4 * lane) = o;
              const unsigned long long bal = __ballot(wv < 0.f);
              unsigned mask = 0;
#pragma unroll
              for (int h = 0; h < 8; ++h) mask |= ((unsigned)(bal >> (8 * h)) & 1u) << h;
              if (lane == 0) sgn[row] = mask; } } }
        { const int row = row0 + tok, spos = row % SEQ;
#pragma unroll
          for (int g = 0; g < 4; ++g) { const int w = 2 << g; const int cnt = (spos + 1) < w ? (spos + 1) : w; const float rc = 1.0f / (float)cnt;
              bf16x8_p pf[2];
#pragma unroll
              for (int ks = 0; ks < 2; ++ks) { const int c0 = g * 64 + 32 * ks + 8 * g4; float sum[8], z0[8];
#pragma unroll
                  for (int e = 0; e < 8; ++e) { sum[e] = 0.f; z0[e] = 0.f; }
                  constexpr int JB = 8;
#pragma unroll
                  for (int j0 = 0; j0 < w; j0 += JB) { v4u vv[JB];
#pragma unroll
                      for (int u = 0; u < JB; ++u) { const int j = j0 + u; if (j < w) { const bool ok = j < cnt; vv[u] = *(const GAS v4u*)(z + (size_t)(row - (ok ? j : 0)) * 256 + c0); } }
#pragma unroll
                      for (int u = 0; u < JB; ++u) { const int j = j0 + u; if (j < w) { const bool ok = j < cnt; v4u v = vv[u];
                      if (j > 0) { v.x = ok ? v.x : 0u; v.y = ok ? v.y : 0u; v.z = ok ? v.z : 0u; v.w = ok ? v.w : 0u; }
                      const float f[8] = {bflo(v.x), bfhi(v.x), bflo(v.y), bfhi(v.y), bflo(v.z), bfhi(v.z), bflo(v.w), bfhi(v.w)};
#pragma unroll
                      for (int e = 0; e < 8; ++e) { sum[e] += f[e]; if (j == 0) z0[e] = f[e]; } } } }
                  v4u pw; pw.x = pk2(sum[0] * rc - z0[0], sum[1] * rc - z0[1]); pw.y = pk2(sum[2] * rc - z0[2], sum[3] * rc - z0[3]); pw.z = pk2(sum[4] * rc - z0[4], sum[5] * rc - z0[5]); pw.w = pk2(sum[6] * rc - z0[6], sum[7] * rc - z0[7]);
                  pf[ks] = __builtin_bit_cast(bf16x8_p, pw); }
              bf16x8_p af4[4][2]; f32x4 ps4[4];
#pragma unroll
              for (int dt = 0; dt < 4; ++dt) { ps4[dt] = *(const f32x4*)(pscale + g * 64 + 16 * dt + 4 * g4);
#pragma unroll
                  for (int ks = 0; ks < 2; ++ks) af4[dt][ks] = *(const bf16x8_p*)(wpT + (size_t)(g * 64 + 16 * dt + tok) * 64 + 32 * ks + 8 * g4); }
#pragma unroll
              for (int dt = 0; dt < 4; ++dt) { f32x4 acc = {0.f, 0.f, 0.f, 0.f};
#pragma unroll
                  for (int ks = 0; ks < 2; ++ks) { const bf16x8_p af = af4[dt][ks]; acc = __builtin_amdgcn_mfma_f32_16x16x32_bf16(af, pf[ks], acc, 0, 0, 0); }
                  const f32x4 ps = ps4[dt];
                  v2u o; o.x = pk2(acc[0] * ps.x, acc[1] * ps.y); o.y = pk2(acc[2] * ps.z, acc[3] * ps.w);
                  *(v2u*)(ybc + (size_t)row * 1024 + g * 64 + 16 * dt + 4 * g4) = o; } } }
        v4u kst[4], vst[4];
#define MEM_LOAD(h_) do { _Pragma("unroll") for (int e = 0; e < 4; ++e) { const int i = tid + 512 * e; \
                { const int m = i >> 3, c = i & 7; kst[e] = *(const v4u*)(memkv + (size_t)(b * NMEM + m) * 2048 + l * 512 + (h_) * 64 + c * 8); } \
                { const int d = i >> 5, c = i & 31; vst[e] = *(const v4u*)(vT + (size_t)(l * 512 + 256 + (h_) * 64 + d) * MROWS + b * NMEM + c * 8); } } } while (0)
#pragma unroll 1
        for (int h = 0; h < CH; ++h) {
            MEM_LOAD(h);
            const int row = row0 + tok;
            bf16x8_p qf[2];
#pragma unroll
            for (int ks = 0; ks < 2; ++ks) qf[ks] = *(const bf16x8_p*)(qc + (size_t)row * 256 + h * 64 + 32 * ks + 8 * g4);
            __syncthreads();
#pragma unroll
            for (int e = 0; e < 4; ++e) { const int i = tid + 512 * e;
                { const int m = i >> 3, c = i & 7; *(LAS v4u*)(Ks + m * 144 + c * 16) = kst[e]; }
                { const int d = i >> 5, c = i & 31; *(LAS v4u*)(Vs + d * 528 + c * 16) = vst[e]; } }
            LDS_WAIT(); __syncthreads();
            f32x4 S[16]; float mx = -1e30f;
#pragma unroll
            for (int mt = 0; mt < 16; ++mt) { f32x4 acc = {0.f, 0.f, 0.f, 0.f};
#pragma unroll
                for (int ks = 0; ks < 2; ++ks) { const bf16x8_p kf = *(const LAS bf16x8_p*)(Ks + (16 * mt + tok) * 144 + (4 * ks + g4) * 16); acc = __builtin_amdgcn_mfma_f32_16x16x32_bf16(kf, qf[ks], acc, 0, 0, 0); }
                S[mt] = acc; mx = fmaxf(mx, fmaxf(fmaxf(acc[0], acc[1]), fmaxf(acc[2], acc[3]))); if ((mt & 3) == 3) __builtin_amdgcn_sched_barrier(0); }
            mx = fmaxf(mx, __shfl_xor(mx, 16)); mx = fmaxf(mx, __shfl_xor(mx, 32));
            float sm = 0.f;
#pragma unroll
            for (int mt = 0; mt < 16; ++mt)
#pragma unroll
                for (int r = 0; r < 4; ++r) { const float p = __expf((S[mt][r] - mx) * 0.125f); S[mt][r] = p; sm += p; }
            sm += __shfl_xor(sm, 16); sm += __shfl_xor(sm, 32);
            const float inv = 1.0f / sm;
            f32x4 oacc[4];
#pragma unroll
            for (int dt = 0; dt < 4; ++dt) oacc[dt] = (f32x4){0.f, 0.f, 0.f, 0.f};
#pragma unroll
            for (int kk = 0; kk < 8; ++kk) { v4u pw; pw.x = pg8::cvt_pk_bf16(S[2 * kk][0], S[2 * kk][1]); pw.y = pg8::cvt_pk_bf16(S[2 * kk][2], S[2 * kk][3]); pw.z = pg8::cvt_pk_bf16(S[2 * kk + 1][0], S[2 * kk + 1][1]); pw.w = pg8::cvt_pk_bf16(S[2 * kk + 1][2], S[2 * kk + 1][3]);
                const bf16x8_p pfr = __builtin_bit_cast(bf16x8_p, pw);
#pragma unroll
                for (int dt = 0; dt < 4; ++dt) { const LAS unsigned char* vp = Vs + (16 * dt + tok) * 528 + (32 * kk + 4 * g4) * 2;
                    const v2u lo = *(const LAS v2u*)vp, hi = *(const LAS v2u*)(vp + 32);
                    v4u vw; vw.x = lo.x; vw.y = lo.y; vw.z = hi.x; vw.w = hi.y;
                    oacc[dt] = __builtin_amdgcn_mfma_f32_16x16x32_bf16(__builtin_bit_cast(bf16x8_p, vw), pfr, oacc[dt], 0, 0, 0); }
                __builtin_amdgcn_sched_barrier(0); }
#pragma unroll
            for (int dt = 0; dt < 4; ++dt) { v2u o; o.x = pk2(oacc[dt][0] * inv, oacc[dt][1] * inv); o.y = pk2(oacc[dt][2] * inv, oacc[dt][3] * inv);
                if (!dry) *(v2u*)(ybc + (size_t)row * 1024 + 256 + h * 64 + 16 * dt + 4 * g4) = o; else asm volatile("" :: "v"(o.x), "v"(o.y)); }
        }
#undef MEM_LOAD
    }
    __syncthreads();
}

__device__ __forceinline__ unsigned key_of(float s) { const unsigned u = __builtin_bit_cast(unsigned, s); return (u & 0x80000000u) ? ~u : (u | 0x80000000u); }

typedef short bf16x8_t __attribute__((ext_vector_type(8)));
typedef short s16x4_t __attribute__((ext_vector_type(4)));
__device__ __forceinline__ void glds16(const void* gsrc, unsigned lds_dst) { unsigned keep;
    asm volatile("s_mov_b32 %0, m0\n\ts_mov_b32 m0, %2\n\ts_nop 0\n\tglobal_load_lds_dwordx4 %1, off\n\ts_mov_b32 m0, %0" : "=&s"(keep) : "v"(gsrc), "s"(lds_dst) : "memory"); }
typedef float f32x16 __attribute__((ext_vector_type(16)));
constexpr int SEL_CAP = 256;
constexpr int HSTR = 264;
constexpr int SL_HIST = 0, SL_SEL = 0, SL_CS = 32768, SL_CI = 98304, SL_KEYS = 131072, SL_ST = 147456;

#define SEL_DECLS \
    LAS unsigned char* const lds = uni_l(lds_); const int wave = uni_i(wave_), b = uni_i(b_), ub = uni_i(ub_); unsigned char* ws = uni(ws_); \
    const bf16* iqf = (const bf16*)(ws + WS_IQF); const unsigned* sgn = (const unsigned*)(ws + WS_SGN); const bf16* ik = (const bf16*)(ws + WS_IK); \
    const int lane = lane_id_v(), tid = wave * 64 + lane; const int kl = lane & 31, c5 = lane >> 5; \
    LAS unsigned* hist = (LAS unsigned*)(lds + SL_HIST); LAS unsigned short* lsel = (LAS unsigned short*)(lds + SL_SEL); LAS float* lcs = (LAS float*)(lds + SL_CS); \
    LAS unsigned short* lci = (LAS unsigned short*)(lds + SL_CI); LAS unsigned* st = (LAS unsigned*)(lds + SL_ST); LAS float* stf = (LAS float*)(lds + SL_ST); \
    const int t0 = ub * 64; const int q0 = b * SEQ + t0; const bf16* ikb = ik + (size_t)b * SEQ * IDIM; const int ntile = (t0 + 64 + 127) >> 7; \
    (void)hist; (void)lsel; (void)lcs; (void)lci; (void)stf; (void)tid;
#define SEL_LOAD_A \
    bf16x8_t af[2][2]; float sgc[2][16]; \
    { const int i = kl, a_ = i >> 3, cc_ = (i >> 2) & 1, e_ = i & 3; const int qq_ = 2 * cc_ + (a_ >> 1), hh_ = 4 * (a_ & 1) + e_; \
      _Pragma("unroll") for (int rt = 0; rt < 2; ++rt) { const unsigned flip_ = ((sgn[q0 + 8 * wave + 4 * rt + qq_] >> hh_) & 1u) ? 0x80008000u : 0u;     \
          _Pragma("unroll") for (int ks = 0; ks < 2; ++ks) { v4u w_ = *(const v4u*)(iqf + (size_t)(q0 + 8 * wave + 4 * rt + qq_) * 256 + hh_ * 32 + 16 * ks + 8 * c5); \
              w_.x ^= flip_; w_.y ^= flip_; w_.z ^= flip_; w_.w ^= flip_; af[rt][ks] = __builtin_bit_cast(bf16x8_t, w_); } } \
      _Pragma("unroll") for (int rt = 0; rt < 2; ++rt) _Pragma("unroll") for (int u = 0; u < 2; ++u) { const unsigned m_ = sgn[q0 + 8 * wave + 4 * rt + 2 * c5 + u]; \
          _Pragma("unroll") for (int h = 0; h < 8; ++h) sgc[rt][8 * u + h] = ((m_ >> h) & 1u) ? -__builtin_inff() : __builtin_inff(); } }
#define SEL_STAGE(kt_) do { const int key_ = 16 * wave + (lane >> 2); const int ch_ = (lane & 3) ^ ((key_ >> 2) & 3); \
    glds16(ikb + (size_t)(128 * (kt_) + key_) * IDIM + ch_ * 8, (unsigned)__builtin_amdgcn_readfirstlane((int)(unsigned)(size_t)(lds + SEL_KBUF(kt_) + wave * 1024))); } while (0)
#define SEL_MMA(acc_, rt_, kh_) do { acc_ = (f32x16){0.f,0.f,0.f,0.f,0.f,0.f,0.f,0.f,0.f,0.f,0.f,0.f,0.f,0.f,0.f,0.f}; \
    acc_ = __builtin_amdgcn_mfma_f32_32x32x16_f16(__builtin_bit_cast(f16x8_t, af[rt_][0]), __builtin_bit_cast(f16x8_t, bfr_[kh_][0]), acc_, 0, 0, 0); \
    acc_ = __builtin_amdgcn_mfma_f32_32x32x16_f16(__builtin_bit_cast(f16x8_t, af[rt_][1]), __builtin_bit_cast(f16x8_t, bfr_[kh_][1]), acc_, 0, 0, 0); } while (0)
#define SEL_SUM(acc_, rt_, kh_) do { _Pragma("unroll") for (int u = 0; u < 2; ++u) { float s_ = 0.f; \
    _Pragma("unroll") for (int h = 0; h < 8; ++h) s_ += __builtin_amdgcn_fmed3f(acc_[8 * u + h], 0.f, sgc[rt_][8 * u + h]); \
    sc[rt_][kh_][u] = s_; } } while (0)
#define SEL_SCORES(kt_) do { const LAS unsigned char* kb_ = lds + SEL_KBUF(kt_); bf16x8_t bfr_[4][2]; \
    _Pragma("unroll") for (int kh = 0; kh < 4; ++kh) { const int key_ = 32 * kh + kl; \
        bfr_[kh][0] = *(const LAS bf16x8_t*)(kb_ + key_ * 64 + 16 * ((0 + c5) ^ ((key_ >> 2) & 3))); \
        bfr_[kh][1] = *(const LAS bf16x8_t*)(kb_ + key_ * 64 + 16 * ((2 + c5) ^ ((key_ >> 2) & 3))); } \
    f32x16 accA_, accB_; \
    SEL_MMA(accA_, 0, 0); \
    SEL_MMA(accB_, 1, 0); __builtin_amdgcn_sched_barrier(0); SEL_SUM(accA_, 0, 0); __builtin_amdgcn_sched_barrier(0); \
    SEL_MMA(accA_, 0, 1); __builtin_amdgcn_sched_barrier(0); SEL_SUM(accB_, 1, 0); __builtin_amdgcn_sched_barrier(0); \
    SEL_MMA(accB_, 1, 1); __builtin_amdgcn_sched_barrier(0); SEL_SUM(accA_, 0, 1); __builtin_amdgcn_sched_barrier(0); \
    SEL_MMA(accA_, 0, 2); __builtin_amdgcn_sched_barrier(0); SEL_SUM(accB_, 1, 1); __builtin_amdgcn_sched_barrier(0); \
    SEL_MMA(accB_, 1, 2); __builtin_amdgcn_sched_barrier(0); SEL_SUM(accA_, 0, 2); __builtin_amdgcn_sched_barrier(0); \
    SEL_MMA(accA_, 0, 3); __builtin_amdgcn_sched_barrier(0); SEL_SUM(accB_, 1, 2); __builtin_amdgcn_sched_barrier(0); \
    SEL_MMA(accB_, 1, 3); __builtin_amdgcn_sched_barrier(0); SEL_SUM(accA_, 0, 3); __builtin_amdgcn_sched_barrier(0); \
    SEL_SUM(accB_, 1, 3); } while (0)
#define SEL_BOUNDARY(FINAL) do { \
    const int qq = tid >> 3, part = tid & 7; const LAS v4u* hp = (const LAS v4u*)(hist + qq * HSTR + 32 * part); \
    unsigned bins[32]; \
    _Pragma("unroll") for (int i = 0; i < 8; ++i) { const v4u v = hp[i]; bins[4 * i] = v.x; bins[4 * i + 1] = v.y; bins[4 * i + 2] = v.z; bins[4 * i + 3] = v.w; } \
    unsigned ps = 0; \
    _Pragma("unroll") for (int i = 0; i < 32; ++i) ps += bins[i]; \
    unsigned v = ps, tt; \
    tt = __shfl_down(v, 1, 8); if (part + 1 < 8) v += tt; \
    tt = __shfl_down(v, 2, 8); if (part + 2 < 8) v += tt; \
    tt = __shfl_down(v, 4, 8); if (part + 4 < 8) v += tt; \
    unsigned cacc = v - ps; \
    if (cacc < (unsigned)TOPK && v >= (unsigned)TOPK) { int bsel = 0; unsigned na = 0, cb = 0; bool found = false; \
        _Pragma("unroll") for (int i = 31; i >= 0; --i) { const bool hit = !found && (cacc + bins[i] >= (unsigned)TOPK); if (hit) { bsel = i; na = cacc; cb = bins[i]; found = true; } cacc += bins[i]; } \
        st[128 + qq] = (unsigned)(32 * part + bsel); if (FINAL) { st[192 + qq] = na; st[256 + qq] = cb; st[448 + qq] = cb > (unsigned)SEL_CAP ? 1u : 0u; } } } while (0)

#define SEL_KBUF(kt_) (69632 + ((kt_) & 3) * 8192)
__device__ __forceinline__ void sel_pass1(unsigned char* ws_, LAS unsigned char* lds_, int wave_, int b_, int ub_) {
    SEL_DECLS
    unsigned short* sel = (unsigned short*)(ws + WS_SEL);
    __syncthreads();
    if (ub < 4) {
        for (int i = tid; i < 64 * TOPK; i += NWAVES * 64) { const int qq = i >> 8, sl = i & 255; sel[(size_t)(q0 + qq) * TOPK + sl] = (unsigned short)(sl <= t0 + qq ? sl : 0); }
        if (tid == 0) st[512] = 1u;
        asm volatile("s_waitcnt vmcnt(0) lgkmcnt(0)" ::: "memory"); __syncthreads();
        return;
    }
    SEL_LOAD_A
    for (int i = tid; i < 64 * HSTR; i += NWAVES * 64) hist[i] = 0u;
    if (tid < 64) { st[128 + tid] = 0u; st[448 + tid] = 0u; }
    if (tid == 0) st[512] = 0u;
    float sc[2][4][2];
    float scl[2][2]; int bcur[2][2];
#pragma unroll
    for (int rt = 0; rt < 2; ++rt)
#pragma unroll
        for (int u = 0; u < 2; ++u) { scl[rt][u] = 0.f; bcur[rt][u] = 0; }
    SEL_STAGE(0); if (ntile > 1) SEL_STAGE(1);
#pragma unroll 1
    for (int kt2 = 0; kt2 < ntile; kt2 += 2) {
        asm volatile("s_waitcnt vmcnt(0) lgkmcnt(0)" ::: "memory"); __syncthreads();
        if (kt2 > 0 && (kt2 & 3) == 0) {
            SEL_BOUNDARY(false);
            asm volatile("s_waitcnt lgkmcnt(0)" ::: "memory"); __syncthreads();
#pragma unroll
            for (int rt = 0; rt < 2; ++rt)
#pragma unroll
                for (int u = 0; u < 2; ++u) bcur[rt][u] = (int)st[128 + 8 * wave + 4 * rt + 2 * c5 + u];
        }
        if (kt2 + 2 < ntile) SEL_STAGE(kt2 + 2);
        if (kt2 + 3 < ntile) SEL_STAGE(kt2 + 3);
#pragma unroll 1
        for (int kt = kt2; kt < kt2 + 2 && kt < ntile; ++kt) {
        SEL_SCORES(kt);
        if (kt == 0) {
#pragma unroll
            for (int rt = 0; rt < 2; ++rt)
#pragma unroll
                for (int u = 0; u < 2; ++u) { float mx = 0.f;
#pragma unroll
                    for (int kh = 0; kh < 4; ++kh) mx = fmaxf(mx, fabsf(sc[rt][kh][u]));
#pragma unroll
                    for (int o = 1; o < 32; o <<= 1) mx = fmaxf(mx, __shfl_xor(mx, o));
                    const float R = mx > 0.f ? mx : 1.0f;
                    scl[rt][u] = 128.0f / R;
                    if (kl == 0) stf[8 * wave + 4 * rt + 2 * c5 + u] = scl[rt][u]; }
        }
        const bool masked = 128 * kt + 127 > t0;
        if (masked) {
#pragma unroll
        for (int rt = 0; rt < 2; ++rt)
#pragma unroll
            for (int u = 0; u < 2; ++u) { const int qq = 8 * wave + 4 * rt + 2 * c5 + u; const int lim = t0 + qq - 128 * kt - kl;
#pragma unroll
                for (int kh = 0; kh < 4; ++kh) { const float fb = __builtin_amdgcn_fmed3f(fmaf(sc[rt][kh][u], scl[rt][u], 128.0f), 0.f, 255.f);
                    if (fb >= (float)bcur[rt][u] && 32 * kh <= lim) (void)__hip_atomic_fetch_add(hist + qq * HSTR + (int)fb, 1u, __ATOMIC_RELAXED, __HIP_MEMORY_SCOPE_WORKGROUP); } }
        } else {
#pragma unroll
        for (int rt = 0; rt < 2; ++rt)
#pragma unroll
            for (int u = 0; u < 2; ++u) { const int qq = 8 * wave + 4 * rt + 2 * c5 + u;
#pragma unroll
                for (int kh = 0; kh < 4; ++kh) { const float fb = __builtin_amdgcn_fmed3f(fmaf(sc[rt][kh][u], scl[rt][u], 128.0f), 0.f, 255.f);
                    if (fb >= (float)bcur[rt][u]) (void)__hip_atomic_fetch_add(hist + qq * HSTR + (int)fb, 1u, __ATOMIC_RELAXED, __HIP_MEMORY_SCOPE_WORKGROUP); } }
        }
        }
    }
    asm volatile("s_waitcnt vmcnt(0) lgkmcnt(0)" ::: "memory"); __syncthreads();
    SEL_BOUNDARY(true);
    if (tid < 64) { st[320 + tid] = 0u; st[384 + tid] = 0u; }
    asm volatile("s_waitcnt lgkmcnt(0)" ::: "memory"); __syncthreads();
}
#undef SEL_KBUF
#define SEL_KBUF(kt_) (SL_KEYS + ((kt_) & 1) * 8192)
__device__ __forceinline__ void sel_pass2(unsigned char* ws_, LAS unsigned char* lds_, int wave_, int b_, int ub_) {
    SEL_DECLS
    if (st[512] != 0u) return;
    if (tid < 64) { st[320 + tid] = 0u; st[384 + tid] = 0u; }
    SEL_LOAD_A
    float sc[2][4][2];
    float scl[2][2]; int bcur[2][2];
#pragma unroll
    for (int rt = 0; rt < 2; ++rt)
#pragma unroll
        for (int u = 0; u < 2; ++u) { const int qq = 8 * wave + 4 * rt + 2 * c5 + u; scl[rt][u] = stf[qq]; bcur[rt][u] = (int)st[128 + qq]; }
    SEL_STAGE(0);
#pragma unroll 1
    for (int kt = 0; kt < ntile; ++kt) {
        asm volatile("s_waitcnt vmcnt(0) lgkmcnt(0)" ::: "memory"); __syncthreads();
        if (kt + 1 < ntile) SEL_STAGE(kt + 1);
        SEL_SCORES(kt);
        const bool masked = 128 * kt + 127 > t0;
        float fbv[2][2][4];
#pragma unroll
        for (int rt = 0; rt < 2; ++rt)
#pragma unroll
            for (int u = 0; u < 2; ++u)
#pragma unroll
                for (int kh = 0; kh < 4; ++kh) fbv[rt][u][kh] = __builtin_amdgcn_fmed3f(fmaf(sc[rt][kh][u], scl[rt][u], 128.0f), 0.f, 255.f);
        if (masked) {
#pragma unroll
            for (int rt = 0; rt < 2; ++rt)
#pragma unroll
                for (int u = 0; u < 2; ++u) { const int lim = t0 + (8 * wave + 4 * rt + 2 * c5 + u) - 128 * kt - kl;
#pragma unroll
                    for (int kh = 0; kh < 4; ++kh) fbv[rt][u][kh] = 32 * kh <= lim ? fbv[rt][u][kh] : -1.0f; }
        }
        unsigned basea[2][2], basec[2][2];
#pragma unroll
        for (int rt = 0; rt < 2; ++rt)
#pragma unroll
            for (int u = 0; u < 2; ++u) { const int qq = 8 * wave + 4 * rt + 2 * c5 + u; unsigned na_ = 0u, nk_ = 0u; const float bc0 = (float)bcur[rt][u], bc1 = (float)(bcur[rt][u] + 1);
#pragma unroll
                for (int kh = 0; kh < 4; ++kh) { const float fb = fbv[rt][u][kh]; na_ += fb >= bc1 ? 1u : 0u; nk_ += fb >= bc0 ? 1u : 0u; }
                unsigned base_ = 0u;
                if (nk_) base_ = __hip_atomic_fetch_add(st + 320 + qq, na_ + ((nk_ - na_) << 16), __ATOMIC_RELAXED, __HIP_MEMORY_SCOPE_WORKGROUP);
                basea[rt][u] = base_ & 0xffffu; basec[rt][u] = base_ >> 16; }
#pragma unroll
        for (int rt = 0; rt < 2; ++rt)
#pragma unroll
            for (int u = 0; u < 2; ++u) { const int qq = 8 * wave + 4 * rt + 2 * c5 + u; unsigned sa = basea[rt][u], scn = basec[rt][u]; const float bc0 = (float)bcur[rt][u], bc1 = (float)(bcur[rt][u] + 1);
#pragma unroll
                for (int kh = 0; kh < 4; ++kh) { const int kpos = 128 * kt + 32 * kh + kl; const float fb = fbv[rt][u][kh];
                    const bool pa = fb >= bc1, pc = fb >= bc0 && !pa;
                    if (pa) lsel[qq * 256 + (sa < (unsigned)(TOPK - 1) ? sa : (unsigned)(TOPK - 1))] = (unsigned short)kpos;
                    if (pc) { const unsigned sl = scn < (unsigned)(SEL_CAP - 1) ? scn : (unsigned)(SEL_CAP - 1); lcs[qq * SEL_CAP + sl] = sc[rt][kh][u]; lci[qq * SEL_CAP + sl] = (unsigned short)kpos; }
                    sa += pa ? 1u : 0u; scn += pc ? 1u : 0u; } }
    }
    asm volatile("s_waitcnt vmcnt(0) lgkmcnt(0)" ::: "memory"); __syncthreads();
}
__device__ __forceinline__ void sel_resolve(unsigned char* ws_, LAS unsigned char* lds_, int wave_, int b_, int ub_, int wg_, int first_) {
    SEL_DECLS
    const int wg = uni_i(wg_), first = uni_i(first_);
    unsigned short* sel = (unsigned short*)(ws + WS_SEL);
    gu32* slowl = (gu32*)(ws + WS_CTL + 65536) + (size_t)wg * 132;
    if (first && tid == 0) __hip_atomic_store(slowl, 0u, RLX_AGENT);
    if (st[512] != 0u) return;
#pragma unroll 1
    for (int qi = 0; qi < 8; ++qi) { const int qq = 8 * wave + qi; const int q = q0 + qq;
        const int na = (int)st[192 + qq], need = TOPK - na; int C = (int)(st[320 + qq] >> 16); C = C < SEL_CAP ? C : SEL_CAP;
        const bool slow = st[448 + qq] != 0u;
        if (!slow) {
            LAS unsigned* sh = (LAS unsigned*)(lds + SL_KEYS + wave * 2048); LAS float* sls = (LAS float*)(lds + SL_KEYS + wave * 2048 + 256); LAS unsigned short* sli = (LAS unsigned short*)(lds + SL_KEYS + wave * 2048 + 1280);
            const float sclq = stf[qq]; const float fbase = (float)(int)st[128 + qq];
            sh[lane] = 0u;
            float cs[SEL_CAP / 64]; int ci[SEL_CAP / 64], sb[SEL_CAP / 64];
#pragma unroll
            for (int e = 0; e < SEL_CAP / 64; ++e) { const int i = lane + 64 * e; cs[e] = 0.f; ci[e] = 0; sb[e] = -1;
                if (i < C) { cs[e] = lcs[qq * SEL_CAP + i]; ci[e] = lci[qq * SEL_CAP + i];
                    const float fr_ = (fmaf(cs[e], sclq, 128.0f) - fbase) * 64.0f; sb[e] = (int)__builtin_amdgcn_fmed3f(fr_, 0.f, 63.f); } }
            LDS_WAIT();
#pragma unroll
            for (int e = 0; e < SEL_CAP / 64; ++e) if (sb[e] >= 0) (void)__hip_atomic_fetch_add(sh + sb[e], 1u, __ATOMIC_RELAXED, __HIP_MEMORY_SCOPE_WORKGROUP);
            LDS_WAIT();
            const unsigned cl = sh[lane];
            unsigned v = cl, tt;
            tt = __shfl_down(v, 1); if (lane + 1 < 64) v += tt;
            tt = __shfl_down(v, 2); if (lane + 2 < 64) v += tt;
            tt = __shfl_down(v, 4); if (lane + 4 < 64) v += tt;
            tt = __shfl_down(v, 8); if (lane + 8 < 64) v += tt;
            tt = __shfl_down(v, 16); if (lane + 16 < 64) v += tt;
            tt = __shfl_down(v, 32); if (lane + 32 < 64) v += tt;
            const unsigned ab_ = v - cl;
            const unsigned long long cross = __ballot(ab_ < (unsigned)need && v >= (unsigned)need);
            const int sstar = cross ? (int)__builtin_ctzll(cross) : 0;
            const int na2 = (int)__shfl(ab_, sstar);
            const int need2 = need - na2;
            int base = na; int nsub = 0;
#pragma unroll
            for (int e = 0; e < SEL_CAP / 64; ++e) { const bool up = sb[e] > sstar; const bool eq = sb[e] == sstar;
                const unsigned long long bu = __ballot(up), be = __ballot(eq);
                const unsigned long long lt = (lane == 0) ? 0ull : (~0ull >> (64 - lane));
                if (up) lsel[qq * 256 + base + (int)__builtin_popcountll(bu & lt)] = (unsigned short)ci[e];
                if (eq) { const int p_ = nsub + (int)__builtin_popcountll(be & lt); sls[p_] = cs[e]; sli[p_] = (unsigned short)ci[e]; }
                base += (int)__builtin_popcountll(bu); nsub += (int)__builtin_popcountll(be); }
            LDS_WAIT();
#pragma unroll 1
            for (int i0 = 0; i0 < nsub; i0 += 64) { const int i = i0 + lane;
                if (i < nsub) { const float si = sls[i]; const int ii = sli[i]; int rank = 0;
                    for (int jx = 0; jx < nsub; ++jx) { const float sj = sls[jx]; const int ij = sli[jx]; rank += (sj > si || (sj == si && ij < ii)) ? 1 : 0; }
                    if (rank < need2) lsel[qq * 256 + na + na2 + rank] = (unsigned short)ii; } }
            LDS_WAIT();
            *(v2u*)(sel + (size_t)q * TOPK + 4 * lane) = *(const LAS v2u*)(lsel + qq * 256 + 4 * lane);
        }
    }
    __syncthreads();
    if (tid == 0) { unsigned n = first ? 0u : __hip_atomic_load(slowl, RLX_AGENT);
        for (int qq = 0; qq < 64; ++qq) if (st[448 + qq] != 0u) { if (n < 128u) { __hip_atomic_store(slowl + 1 + n, (unsigned)(q0 + qq), RLX_AGENT); ++n; } }
        __hip_atomic_store(slowl, n, RLX_AGENT); }
    asm volatile("s_waitcnt vmcnt(0)" ::: "memory");
    __syncthreads();
}
#undef SEL_DECLS
#undef SEL_LOAD_A
#undef SEL_STAGE
#undef SEL_SCORES
#undef SEL_KBUF
#undef SEL_MMA
#undef SEL_SUM
#undef SEL_BOUNDARY
__device__ __forceinline__ void dsa_select_slow(unsigned char* ws_, LAS unsigned char* lds_, int wave_, int wg_) {
    LAS unsigned char* const lds = uni_l(lds_); const int wave = uni_i(wave_), wg = uni_i(wg_);
    unsigned char* ws = uni(ws_);
    const bf16* iqf = (const bf16*)(ws + WS_IQF); const unsigned* sgn = (const unsigned*)(ws + WS_SGN); const bf16* ik = (const bf16*)(ws + WS_IK);
    unsigned short* sel = (unsigned short*)(ws + WS_SEL);
    gu32* slowl = (gu32*)(ws + WS_CTL + 65536) + (size_t)wg * 132;
    const int lane = lane_id_v(), tid = wave * 64 + lane; const int kl = lane & 31, c5 = lane >> 5;
    LAS unsigned* keys = (LAS unsigned*)lds;
    LAS unsigned* hist = (LAS unsigned*)(lds + 32768);
    LAS unsigned* ctl = (LAS unsigned*)(lds + 40960);
    const int nq = (int)__builtin_amdgcn_readfirstlane(__hip_atomic_load(slowl, RLX_AGENT));
#pragma unroll 1
    for (int k = 0; k < nq; ++k) {
        const int q = (int)__builtin_amdgcn_readfirstlane(__hip_atomic_load(slowl + 1 + k, RLX_AGENT));
        const int b = q / SEQ, t = q % SEQ, n = t + 1;
        const bf16* ikb = ik + (size_t)b * SEQ * IDIM;
        __syncthreads();
        bf16x8_t af[2]; float sgc[8];
        { const int i = kl, a_ = i >> 3, e_ = i & 3; const int hh_ = 4 * (a_ & 1) + e_; const unsigned m_ = sgn[q];
          const unsigned flip_ = ((m_ >> hh_) & 1u) ? 0x80008000u : 0u;
#pragma unroll
          for (int ks = 0; ks < 2; ++ks) { v4u w_ = *(const v4u*)(iqf + (size_t)q * 256 + hh_ * 32 + 16 * ks + 8 * c5); w_.x ^= flip_; w_.y ^= flip_; w_.z ^= flip_; w_.w ^= flip_; af[ks] = __builtin_bit_cast(bf16x8_t, w_); }
#pragma unroll
          for (int h = 0; h < 8; ++h) sgc[h] = ((m_ >> h) & 1u) ? -__builtin_inff() : __builtin_inff(); }
#pragma unroll 1
        for (int kb0 = wave; kb0 * 32 < n; kb0 += 4 * NWAVES) {
            bf16x8_t kb_[4][2];
#pragma unroll
            for (int j = 0; j < 4; ++j) { int key = 32 * (kb0 + j * NWAVES) + kl; key = key < SEQ ? key : SEQ - 1;
                kb_[j][0] = *(const bf16x8_t*)(ikb + (size_t)key * IDIM + 8 * c5); kb_[j][1] = *(const bf16x8_t*)(ikb + (size_t)key * IDIM + 16 + 8 * c5); }
#pragma unroll
            for (int j = 0; j < 4; ++j) { const int key = 32 * (kb0 + j * NWAVES) + kl;
                f32x16 acc = {0.f,0.f,0.f,0.f,0.f,0.f,0.f,0.f,0.f,0.f,0.f,0.f,0.f,0.f,0.f,0.f};
                acc = __builtin_amdgcn_mfma_f32_32x32x16_f16(__builtin_bit_cast(f16x8_t, af[0]), __builtin_bit_cast(f16x8_t, kb_[j][0]), acc, 0, 0, 0); acc = __builtin_amdgcn_mfma_f32_32x32x16_f16(__builtin_bit_cast(f16x8_t, af[1]), __builtin_bit_cast(f16x8_t, kb_[j][1]), acc, 0, 0, 0);
                float sc = 0.f;
#pragma unroll
                for (int h = 0; h < 8; ++h) sc += __builtin_amdgcn_fmed3f(acc[h], 0.f, sgc[h]);
                if (c5 == 0 && key < SEQ) keys[key] = key_of(sc); } }
        if (tid == 0) { const unsigned z_ = (unsigned)launder_v(0); ctl[0] = z_; ctl[1] = z_ + (unsigned)TOPK; ctl[2] = z_; ctl[3] = z_; }
        unsigned P = 0u, Plo = 0u;
#pragma unroll 1
        for (int lev = 0; lev < 5; ++lev) {
            for (int i = tid; i < 2048; i += NWAVES * 64) hist[i] = 0u;
            asm volatile("s_waitcnt lgkmcnt(0)" ::: "memory"); __syncthreads();
#pragma unroll 1
            for (int i = 0; i < 16; ++i) { const int s_ = tid * 16 + i;
                if (s_ < n) { const unsigned hi = keys[s_], lo = 8191u - (unsigned)s_; bool mt; unsigned dg;
                    if (lev == 0) { mt = true; dg = hi >> 21; } else if (lev == 1) { mt = (hi >> 21) == P; dg = (hi >> 10) & 0x7ffu; } else if (lev == 2) { mt = (hi >> 10) == P; dg = hi & 0x3ffu; }
                    else if (lev == 3) { mt = hi == P; dg = lo >> 6; } else { mt = hi == P && (lo >> 6) == Plo; dg = lo & 63u; }
                    if (mt) (void)__hip_atomic_fetch_add(hist + dg, 1u, __ATOMIC_RELAXED, __HIP_MEMORY_SCOPE_WORKGROUP); } }
            asm volatile("s_waitcnt lgkmcnt(0)" ::: "memory"); __syncthreads();
            const unsigned need = ctl[1];
            const v4u hb = *(const LAS v4u*)(hist + 4 * tid); const unsigned ls = hb.x + hb.y + hb.z + hb.w;
            unsigned v = ls, tt;
            tt = __shfl_down(v, 1); if (lane + 1 < 64) v += tt;
            tt = __shfl_down(v, 2); if (lane + 2 < 64) v += tt;
            tt = __shfl_down(v, 4); if (lane + 4 < 64) v += tt;
            tt = __shfl_down(v, 8); if (lane + 8 < 64) v += tt;
            tt = __shfl_down(v, 16); if (lane + 16 < 64) v += tt;
            tt = __shfl_down(v, 32); if (lane + 32 < 64) v += tt;
            if (lane == 0) ctl[8 + wave] = v;
            asm volatile("s_waitcnt lgkmcnt(0)" ::: "memory"); __syncthreads();
            unsigned above = v - ls;
            for (int w2 = wave + 1; w2 < NWAVES; ++w2) above += ctl[8 + w2];
            if (above < need && above + ls >= need) { unsigned c = above; const unsigned bb[4] = {hb.x, hb.y, hb.z, hb.w}; int bsel = 0; unsigned cab = 0; bool found = false;
#pragma unroll
                for (int i = 3; i >= 0; --i) { const bool hit = !found && (c + bb[i] >= need); if (hit) { bsel = i; cab = c; found = true; } c += bb[i]; }
                const unsigned dv = (unsigned)(4 * tid + bsel);
                if (lev == 0) ctl[0] = dv; else if (lev == 1) ctl[0] = (P << 11) | dv; else if (lev == 2) ctl[0] = (P << 10) | dv; else if (lev == 3) ctl[3] = dv; else ctl[3] = (Plo << 6) | dv;
                ctl[1] = need - cab; ctl[4] = bb[bsel]; }
            asm volatile("s_waitcnt lgkmcnt(0)" ::: "memory"); __syncthreads();
            P = ctl[0]; Plo = ctl[3];
            if (lev == 2 && ctl[1] == ctl[4]) break;
        }
        unsigned short* srow = sel + (size_t)q * TOPK;
        unsigned mymask = 0u;
#pragma unroll 1
        for (int i = 0; i < 16; ++i) { const int s_ = tid * 16 + i;
            if (s_ < n) { const unsigned hi = keys[s_], lo = 8191u - (unsigned)s_; if (hi > P || (hi == P && lo >= Plo)) mymask |= 1u << i; } }
        const unsigned mycnt = (unsigned)__builtin_popcount(mymask);
        unsigned pv_ = mycnt, tt_;
        tt_ = __shfl_up(pv_, 1); if (lane >= 1) pv_ += tt_;
        tt_ = __shfl_up(pv_, 2); if (lane >= 2) pv_ += tt_;
        tt_ = __shfl_up(pv_, 4); if (lane >= 4) pv_ += tt_;
        tt_ = __shfl_up(pv_, 8); if (lane >= 8) pv_ += tt_;
        tt_ = __shfl_up(pv_, 16); if (lane >= 16) pv_ += tt_;
        tt_ = __shfl_up(pv_, 32); if (lane >= 32) pv_ += tt_;
        if (lane == 63) ctl[16 + wave] = pv_;
        asm volatile("s_waitcnt lgkmcnt(0)" ::: "memory"); __syncthreads();
        unsigned slot0 = pv_ - mycnt;
        for (int w2 = 0; w2 < wave; ++w2) slot0 += ctl[16 + w2];
#pragma unroll 1
        for (int i = 0; i < 16; ++i) if ((mymask >> i) & 1u) { if (slot0 < (unsigned)TOPK) srow[slot0] = (unsigned short)(tid * 16 + i); ++slot0; }
    }
    asm volatile("s_waitcnt vmcnt(0) lgkmcnt(0)" ::: "memory");
    __syncthreads();
}

__device__ __forceinline__ unsigned offb(unsigned row, unsigned ch) { return 256u * row + 16u * (ch ^ (((row & 3u) << 2) | ((row >> 2) & 3u))); }
__device__ __forceinline__ void plswap16(float& a, float& b) { asm volatile("s_nop 1\n\tv_permlane16_swap_b32 %0, %1" : "+v"(a), "+v"(b)); }
__device__ __forceinline__ void plswap32(float& a, float& b) { asm volatile("s_nop 1\n\tv_permlane32_swap_b32 %0, %1" : "+v"(a), "+v"(b)); }
__device__ __forceinline__ float rowpair_max(float x) { float a = x, b = x; plswap16(a, b); float m = fmaxf(a, b); a = m; b = m; plswap32(a, b); return fmaxf(a, b); }
__device__ __forceinline__ float rowpair_sum(float x) { float a = x, b = x; plswap16(a, b); float m = a + b; a = m; b = m; plswap32(a, b); return a + b; }
__device__ __forceinline__ s16x4_t vtr(const LAS unsigned char* p) { return __builtin_bit_cast(s16x4_t, __builtin_amdgcn_ds_read_tr16_b64_v4i16((LAS s16x4_t*)p)); }

__device__ __forceinline__ void dsa_attend(unsigned char* ws_, LAS unsigned char* lds_, const float* relb_, int wave_, int vcu_, int G_, int dry_) {
    const int dry = uni_i(dry_);
    LAS unsigned char* const lds = uni_l(lds_); const int wave = uni_i(wave_), vcu = uni_i(vcu_), G = uni_i(G_);
    unsigned char* ws = uni(ws_); const float* relb = uni(relb_);
    const bf16* ckv = (const bf16*)(ws + WS_CKV); bf16* ql = (bf16*)(ws + WS_QL); const unsigned short* sel = (const unsigned short*)(ws + WS_SEL);
    const int lane = lane_id_v(), tid = wave * 64 + lane;
    LAS unsigned char* cb = lds + wave * 16384;
    LAS unsigned short* sidx = (LAS unsigned short*)(lds + 131072 + wave * 512);
    LAS float* biasd = (LAS float*)(lds + 135168);
    for (int i = tid; i < 129 * 8; i += NWAVES * 64) { const int d = i >> 3, h = i & 7; const int bk = d < 128 ? (int)T5_BUCKET[d] : 31; biasd[i] = relb[bk * 8 + h]; }
    __syncthreads();
    const int hl = lane & 15, g = lane >> 4, hq = hl & 7;
    unsigned qko[2][4], pvo[8][2];
#pragma unroll
    for (int rb = 0; rb < 2; ++rb)
#pragma unroll
        for (int s4 = 0; s4 < 4; ++s4) qko[rb][s4] = offb(8u * (hl >> 2) + 4u * rb + (hl & 3), 4 * s4 + g);
#pragma unroll
    for (int cd = 0; cd < 8; ++cd) { const unsigned q4 = hl >> 2, p4 = hl & 3;
        pvo[cd][0] = offb(8u * g + q4, 2 * cd + (p4 >> 1)) + 8u * (p4 & 1); pvo[cd][1] = offb(8u * g + 4u + q4, 2 * cd + (p4 >> 1)) + 8u * (p4 & 1); }
    for (int p = vcu; p < BATCH * 64; p += G) {
        const int b = p >> 6, j = p & 63;
#pragma unroll 1
        for (int half = 0; half < 2; ++half) {
            const int ub = half == 0 ? j : 127 - j;
#pragma unroll 1
            for (int qi = 0; qi < 8; ++qi) {
                const int t = ub * 64 + wave * 8 + qi; const int q = b * SEQ + t; const int nsel = (t + 1) < TOPK ? (t + 1) : TOPK;
                const bf16* ckvb = ckv + (size_t)b * SEQ * KVR; bf16* qlrow = ql + (size_t)q * 1024;
                const v2u selw = *(const v2u*)(sel + (size_t)q * TOPK + 4 * lane);
                bf16x8_t qf[4];
#pragma unroll
                for (int s = 0; s < 4; ++s) qf[s] = *(const bf16x8_t*)(qlrow + hq * 128 + 32 * s + 8 * g);
                *(LAS v2u*)(sidx + 4 * lane) = selw;
                LDS_WAIT();
                float mrun = -1e30f, lsum = 0.f;
                f32x4 O[8];
#pragma unroll
                for (int c = 0; c < 8; ++c) O[c] = (f32x4){0.f, 0.f, 0.f, 0.f};
#define DSA_GATHER(c_) do { LAS unsigned char* dst_ = cb + ((c_) & 1) * 8192; \
                    int kidx_[8]; \
                    _Pragma("unroll") for (int k_ = 0; k_ < 8; ++k_) kidx_[k_] = sidx[32 * (c_) + 4 * k_ + g]; \
                    _Pragma("unroll") for (int k_ = 0; k_ < 8; ++k_) { \
                        const int ch_ = hl ^ ((g << 2) | (k_ & 3)); \
                        glds16(ckvb + (size_t)kidx_[k_] * KVR + ch_ * 8, (unsigned)__builtin_amdgcn_readfirstlane((int)(unsigned)(size_t)(dst_ + k_ * 1024))); } } while (0)
                DSA_GATHER(0);
                asm volatile("" : "+v"(qf[0]), "+v"(qf[1]), "+v"(qf[2]), "+v"(qf[3]));
#define DSA_CHUNK(c_, BOFF_) do { const int c = (c_); \
                    if (c < 7) { DSA_GATHER(c + 1); asm volatile("s_waitcnt vmcnt(8)" ::: "memory"); } \
                    else asm volatile("s_waitcnt vmcnt(0)" ::: "memory"); \
                    const LAS unsigned char* img = cb + (BOFF_); \
                    f32x4 S[2]; \
                    _Pragma("unroll") for (int rb = 0; rb < 2; ++rb) { S[rb] = (f32x4){0.f, 0.f, 0.f, 0.f}; \
                        _Pragma("unroll") for (int s = 0; s < 4; ++s) { const bf16x8_t af = *(const LAS bf16x8_t*)(img + qko[rb][s]); S[rb] = __builtin_amdgcn_mfma_f32_16x16x32_bf16(af, qf[s], S[rb], 0, 0, 0); } } \
                    float pv[2][4]; float mx = -1e30f; \
                    _Pragma("unroll") for (int rb = 0; rb < 2; ++rb) { const v2u iw2 = *(const LAS v2u*)(sidx + 32 * c + 8 * g + 4 * rb); \
                        const int ki[4] = {(int)(iw2.x & 0xffffu), (int)(iw2.x >> 16), (int)(iw2.y & 0xffffu), (int)(iw2.y >> 16)}; \
                        _Pragma("unroll") for (int r = 0; r < 4; ++r) { int dist = t - ki[r]; dist = dist < 0 ? 0 : (dist > 128 ? 128 : dist); \
                            float lg = S[rb][r] * 0.125f + biasd[dist * 8 + hq]; \
                            if (32 * c + 8 * g + 4 * rb + r >= nsel) lg = -1e30f; \
                            pv[rb][r] = lg; mx = fmaxf(mx, lg); } } \
                    mx = rowpair_max(mx); \
                    const float mnew = fmaxf(mrun, mx); const float alpha = __expf(mrun - mnew); mrun = mnew; \
                    float rs = 0.f; \
                    _Pragma("unroll") for (int rb = 0; rb < 2; ++rb) \
                        _Pragma("unroll") for (int r = 0; r < 4; ++r) { pv[rb][r] = __expf(pv[rb][r] - mnew); rs += pv[rb][r]; } \
                    rs = rowpair_sum(rs); \
                    lsum = lsum * alpha + rs; \
                    v4u pw; pw.x = pg8::cvt_pk_bf16(pv[0][0], pv[0][1]); pw.y = pg8::cvt_pk_bf16(pv[0][2], pv[0][3]); pw.z = pg8::cvt_pk_bf16(pv[1][0], pv[1][1]); pw.w = pg8::cvt_pk_bf16(pv[1][2], pv[1][3]); \
                    const bf16x8_t pf = __builtin_bit_cast(bf16x8_t, pw); \
                      \
                      \
                    _Pragma("unroll") for (int cd = 0; cd < 8; ++cd) { \
                        f32x4 o = O[cd]; o[0] *= alpha; o[1] *= alpha; o[2] *= alpha; o[3] *= alpha; \
                        const s16x4_t b0 = vtr(img + pvo[cd][0]); const s16x4_t b1 = vtr(img + pvo[cd][1]); \
                        bf16x8_t bf; bf[0] = b0[0]; bf[1] = b0[1]; bf[2] = b0[2]; bf[3] = b0[3]; bf[4] = b1[0]; bf[5] = b1[1]; bf[6] = b1[2]; bf[7] = b1[3]; \
                        O[cd] = __builtin_amdgcn_mfma_f32_16x16x32_bf16(bf, pf, o, 0, 0, 0); } } while (0)
#pragma unroll 1
                for (int c2 = 0; c2 < 4; ++c2) { DSA_CHUNK(2 * c2, 0); DSA_CHUNK(2 * c2 + 1, 8192); }
#undef DSA_CHUNK
#undef DSA_GATHER
                const float linv = 1.0f / lsum;
                if (hl < 8) {
#pragma unroll
                    for (int cd = 0; cd < 8; ++cd) { v2u w; w.x = pk2(O[cd][0] * linv, O[cd][1] * linv); w.y = pk2(O[cd][2] * linv, O[cd][3] * linv);
                        *(LAS v2u*)(cb + hl * 256 + (16 * cd + 4 * g) * 2) = w; }
                }
                LDS_WAIT();
                { const v4u w0 = *(const LAS v4u*)(cb + 32 * lane), w1 = *(const LAS v4u*)(cb + 32 * lane + 16);
                  if (!dry) { *(v4u*)(qlrow + 16 * lane) = w0; *(v4u*)(qlrow + 16 * lane + 8) = w1; } else asm volatile("" :: "v"(w0), "v"(w1)); }
                LDS_WAIT();
            }
        }
    }
    __syncthreads();
}

__device__ __noinline__ void final_norm(const float* const* in_, float* out_, unsigned char* ws_, LAS unsigned char* lds_, int wave_, int vcu_, int G_) {
    const PC F{uni(in_), uni(out_), uni(ws_), uni_l(lds_), uni_i(wave_), uni_i(vcu_), uni_i(G_)}; struct { const float* const* in; float* out; } a{F.in, F.out};
    const int lane_ = lane_id_v(); const int gw = F.vcu * NWAVES + F.wave, NGW = F.G * NWAVES; const float* g = a.in[22];
    f32x4 gv[4];
#pragma unroll
    for (int j = 0; j < 4; ++j) gv[j] = ((const f32x4*)g)[lane_ + 64 * j];
    for (int m = gw; m < M; m += NGW) {
        GAS f32x4* xr = (GAS f32x4*)(a.out + (size_t)m * D) + lane_;
        f32x4 v[4]; float s = 0.f;
#pragma unroll
        for (int j = 0; j < 4; ++j) { v[j] = xr[64 * j]; s += (v[j].x * v[j].x + v[j].y * v[j].y) + (v[j].z * v[j].z + v[j].w * v[j].w); }
        const float rs = 1.0f / sqrtf(wave_sum(s) * (1.0f / D) + EPS);
#pragma unroll
        for (int j = 0; j < 4; ++j) xr[64 * j] = v[j] * rs * gv[j];
    }
}

#define KIN ((const float* const*)__builtin_amdgcn_kernarg_segment_ptr())
constexpr int PH_PER_LAYER = 10, PH_LAYER0 = 2, N_PHASES = PH_LAYER0 + PH_PER_LAYER * DEPTH + 1;

__global__ void __launch_bounds__(NWAVES * 64, 2) mk_fwd(Args args) {
    extern __shared__ __attribute__((aligned(16))) unsigned char lds[];
    Frame F;
    F.lds = (LAS unsigned char*)lds;
    F.MISC = (volatile LAS unsigned*)(F.lds + MISC_OFF);
    F.wave = __builtin_amdgcn_readfirstlane((int)threadIdx.x >> 6);
    F.G = gridDim.x; { const int bx = blockIdx.x; F.vcu = (F.G % 8 == 0) ? (bx % 8) * (F.G / 8) + bx / 8 : bx; }
    F.ws = args.ws; F.ctl = (gu32*)(args.ws + WS_CTL);
    if (threadIdx.x < 64) ((LAS unsigned*)(F.lds + MISC_OFF))[threadIdx.x] = 0u;
    __syncthreads();
    const int lo = args.ph_lo, hi = args.ph_hi;
    const bool multi = (hi - lo) > 1;
    XcdBarrier bar; bar.bar = (unsigned*)(F.ctl + CW_BAR); bar.x = 0; bar.st = nullptr; bar.wave = F.wave;
    if (multi) bar = xcd_barrier_post((unsigned*)(F.ctl + CW_BAR), F.MISC + 8, F.wave);
#define IN(k) (lo <= (k) && (k) < hi)
#define SEAM(k) do { if (IN(k) && IN((k) + 1)) { xcd_barrier(bar); if (PROBE_PHASE == 99) xcd_barrier(bar); } } while (0)

    if (IN(0)) {
#if EN_P0
 for (int rep = (PROBE_PHASE == 1 ? 0 : 1); rep < 2; ++rep) p0_prologue(KIN, args.out, args.ws, F.lds, F.wave, F.vcu, F.G);
#endif
 } SEAM(0);
    if (IN(1)) {
#if !((DIS_MASK >> 7) & 1)
 unsigned char* ws = launder_p(args.ws); bf16* hb = (bf16*)(ws + WS_HB); float* ss = (float*)(ws + WS_SS); (void)hb; (void)ss;
        pg8::Gemm g{(const bf16_t*)(ws + WS_MEMN), (const bf16_t*)(ws + WS_WMEM), MROWS, DEPTH * 2 * CW, D}; pg8::StaticOrder S; S.init(MROWS, DEPTH * 2 * CW, F.G, launder_s((int)blockIdx.x));
        EpiPlainBf16 E{(bf16_t*)(ws + WS_MEMKV), DEPTH * 2 * CW};
        pg8::gemm_phase<EpiPlainBf16, pg8::StaticOrder, true, true>(F.lds + RING_OFF, g, S, E, F.wave);
        { pg8::Gemm g2{(const bf16_t*)(ws + WS_WMEM), (const bf16_t*)(ws + WS_MEMN), DEPTH * 2 * CW, MROWS, D}; pg8::StaticOrder S2; S2.init(DEPTH * 2 * CW, MROWS, F.G, launder_s((int)blockIdx.x));
          EpiPlainBf16 E2{(bf16_t*)(ws + WS_VT), MROWS};
          pg8::gemm_phase<EpiPlainBf16, pg8::StaticOrder, true, true>(F.lds + RING_OFF, g2, S2, E2, F.wave); }
#endif
    } SEAM(1);

    for (int l = 0; l < DEPTH; ++l) {
        const int pb = PH_LAYER0 + PH_PER_LAYER * l;
        const float* hbase = (l == 0) ? args.in[0] : args.out;
        if (IN(pb + 0)) {
#if EN_P0
 if (l > 0) for (int rep = (PROBE_PHASE == 1 ? 0 : 1); rep < 2; ++rep) prep_layer_weights(KIN, args.out, args.ws, F.lds, l, F.wave, F.vcu, F.G);
#endif
 } SEAM(pb + 0);
        if (IN(pb + 1)) {
#if !((DIS_MASK >> 0) & 1)
 unsigned char* ws = launder_p(args.ws); bf16* hb = (bf16*)(ws + WS_HB); float* ss = (float*)(ws + WS_SS); (void)hb; (void)ss;
            pg8::Gemm g{hb, (const bf16_t*)(ws + WS_W1IN), M, 2 * DFF, D}; pg8::StaticOrder S; S.init(M, 2 * DFF, F.G, launder_s((int)blockIdx.x));
            EpiSwiglu E{(bf16_t*)(ws + WS_ACT), ss};
            for (int rep = (PROBE_PHASE == 2 ? 0 : 1); rep < 2; ++rep) pg8::gemm_phase<EpiSwiglu, pg8::StaticOrder, true, true>(F.lds + RING_OFF, g, S, E, F.wave);
#endif
        } SEAM(pb + 1);
        if (IN(pb + 2)) {
#if !((DIS_MASK >> 1) & 1)
 unsigned char* ws = launder_p(args.ws); bf16* hb = (bf16*)(ws + WS_HB); float* ss = (float*)(ws + WS_SS); (void)hb; (void)ss;
            pg8::Gemm g{(const bf16_t*)(ws + WS_ACT), (const bf16_t*)(ws + WS_W1OUT), M, D, DFF}; pg8::StaticOrder S; S.init(M, D, F.G, launder_s((int)blockIdx.x));
            for (int rep = (PROBE_PHASE == 3 ? 0 : 1); rep < 2; ++rep) { EpiResid E{hbase, args.out, hb, ss, 0.5f, (LAS float*)(F.lds + RING_BYTES), rep == 0 ? 1 : 0};
            pg8::gemm_phase<EpiResid, pg8::StaticOrder, true, true>(F.lds + RING_OFF, g, S, E, F.wave); }
#endif
        } SEAM(pb + 2);
        if (IN(pb + 3)) {
#if !((DIS_MASK >> 2) & 1)
 unsigned char* ws = launder_p(args.ws); bf16* hb = (bf16*)(ws + WS_HB); float* ss = (float*)(ws + WS_SS); (void)hb; (void)ss;
            pg8::Gemm g{hb, (const bf16_t*)(ws + WS_WIN), M, INP, D}; pg8::StaticOrder S; S.init(M, INP, F.G, launder_s((int)blockIdx.x));
            EpiInProj E{ss, (bf16_t*)(ws + WS_QL), (float*)(ws + WS_CKVRAW), (bf16_t*)(ws + WS_IK), (float*)(ws + WS_IW), (bf16_t*)(ws + WS_IQRAW), (bf16_t*)(ws + WS_Z), (bf16_t*)(ws + WS_QC), (bf16_t*)(ws + WS_G)};
            for (int rep = (PROBE_PHASE == 4 ? 0 : 1); rep < 2; ++rep) pg8::gemm_phase<EpiInProj, pg8::StaticOrder, true, true>(F.lds + RING_OFF, g, S, E, F.wave);
#endif
        } SEAM(pb + 3);
        if (IN(pb + 4)) {
#if EN_PREP
 for (int rep = (PROBE_PHASE == 5 ? 0 : 1); rep < 2; ++rep) prep_tokens(KIN, args.out, args.ws, F.lds, l, F.wave, F.vcu, F.G, rep == 0 ? 1 : 0);
#endif
 } SEAM(pb + 4);
        if (IN(pb + 5)) {
#if EN_DSA
 for (int rep = (PROBE_PHASE == 6 ? 0 : 1); rep < 2; ++rep) for (int p = F.vcu; p < BATCH * 64; p += F.G) { for (int half = 0; half < 2; ++half) { const int b_ = p >> 6, ub_ = half == 0 ? (p & 63) : 127 - (p & 63);
   sel_pass1(args.ws, F.lds, F.wave, b_, ub_); if (PROBE_PHASE == 61) sel_pass1(args.ws, F.lds, F.wave, b_, ub_); sel_pass2(args.ws, F.lds, F.wave, b_, ub_); if (PROBE_PHASE == 62) sel_pass2(args.ws, F.lds, F.wave, b_, ub_); sel_resolve(args.ws, F.lds, F.wave, b_, ub_, (int)blockIdx.x, (p == F.vcu && half == 0) ? 1 : 0); if (PROBE_PHASE == 63) sel_resolve(args.ws, F.lds, F.wave, b_, ub_, (int)blockIdx.x, 0); } }
 dsa_select_slow(args.ws, F.lds, F.wave, (int)blockIdx.x); for (int rep = (PROBE_PHASE == 7 ? 0 : 1); rep < 2; ++rep) dsa_attend(args.ws, F.lds, args.in[2], F.wave, F.vcu, F.G, rep == 0 ? 1 : 0);
#endif
 } SEAM(pb + 5);
        if (IN(pb + 6)) {
#if !((DIS_MASK >> 3) & 1)
        for (int rep6 = (PROBE_PHASE == 8 ? 0 : 1); rep6 < 2; ++rep6) {
 unsigned char* ws = launder_p(args.ws); bf16* hb = (bf16*)(ws + WS_HB); float* ss = (float*)(ws + WS_SS); (void)hb; (void)ss;
            { pg8::Gemm g{(const bf16_t*)(ws + WS_QL), (const bf16_t*)(ws + WS_WA), M, D, 1024}; pg8::StaticOrder S; S.init(M, D, F.G, launder_s((int)blockIdx.x));
              EpiMergeF E{(bf16_t*)(ws + WS_MERGED), (const bf16_t*)(ws + WS_G)};
              pg8::gemm_phase_merge<EpiMergeF, pg8::StaticOrder>(F.lds + RING_OFF, g, (const bf16_t*)(ws + WS_HB), (const bf16_t*)(ws + WS_WBC), 1024 / 64, 256 / 64, S, E, F.wave); }
        }
#endif
        } SEAM(pb + 6);
        if (IN(pb + 7)) {
#if !((DIS_MASK >> 4) & 1)
 unsigned char* ws = launder_p(args.ws); bf16* hb = (bf16*)(ws + WS_HB); float* ss = (float*)(ws + WS_SS); (void)hb; (void)ss;
            pg8::Gemm g{(const bf16_t*)(ws + WS_MERGED), (const bf16_t*)(ws + WS_WOUT), M, D, D}; pg8::StaticOrder S; S.init(M, D, F.G, launder_s((int)blockIdx.x));
            for (int rep = (PROBE_PHASE == 9 ? 0 : 1); rep < 2; ++rep) { EpiResid E{args.out, args.out, hb, ss, 1.0f, (LAS float*)(F.lds + RING_BYTES), rep == 0 ? 1 : 0};
            pg8::gemm_phase<EpiResid, pg8::StaticOrder, true, true>(F.lds + RING_OFF, g, S, E, F.wave); }
#endif
        } SEAM(pb + 7);
        if (IN(pb + 8)) {
#if !((DIS_MASK >> 5) & 1)
 unsigned char* ws = launder_p(args.ws); bf16* hb = (bf16*)(ws + WS_HB); float* ss = (float*)(ws + WS_SS); (void)hb; (void)ss;
            pg8::Gemm g{hb, (const bf16_t*)(ws + WS_W2IN), M, 2 * DFF, D}; pg8::StaticOrder S; S.init(M, 2 * DFF, F.G, launder_s((int)blockIdx.x));
            EpiSwiglu E{(bf16_t*)(ws + WS_ACT), ss};
            for (int rep = (PROBE_PHASE == 2 ? 0 : 1); rep < 2; ++rep) pg8::gemm_phase<EpiSwiglu, pg8::StaticOrder, true, true>(F.lds + RING_OFF, g, S, E, F.wave);
#endif
        } SEAM(pb + 8);
        if (IN(pb + 9)) {
#if !((DIS_MASK >> 6) & 1)
 unsigned char* ws = launder_p(args.ws); bf16* hb = (bf16*)(ws + WS_HB); float* ss = (float*)(ws + WS_SS); (void)hb; (void)ss;
            pg8::Gemm g{(const bf16_t*)(ws + WS_ACT), (const bf16_t*)(ws + WS_W2OUT), M, D, DFF}; pg8::StaticOrder S; S.init(M, D, F.G, launder_s((int)blockIdx.x));
            for (int rep = (PROBE_PHASE == 3 ? 0 : 1); rep < 2; ++rep) { EpiResid E{args.out, args.out, hb, ss, 0.5f, (LAS float*)(F.lds + RING_BYTES), rep == 0 ? 1 : 0};
            pg8::gemm_phase<EpiResid, pg8::StaticOrder, true, true>(F.lds + RING_OFF, g, S, E, F.wave); }
#endif
        } SEAM(pb + 9);
    }
#if EN_P0
    if (IN(N_PHASES - 1)) { final_norm(KIN, args.out, args.ws, F.lds, F.wave, F.vcu, F.G); }
#endif
#undef IN
#undef SEAM
}

extern "C" void kernel_launch(void* const* d_in, const int* in_sizes, int n_in, void* d_out, int out_size, void* d_ws, size_t ws_size, hipStream_t stream) {
    static int grid = 0;
    if (grid == 0) {
        if (n_in != 23 || in_sizes[0] != M * D || out_size != M * D || ws_size < WS_END) { fprintf(stderr, "kernel_launch: unexpected shapes (n_in %d, ws %zu)\n", n_in, ws_size); grid = -1; return; }
        int dev = 0, cus = 0, per_cu = 0;
        if (hipGetDevice(&dev) != hipSuccess || hipDeviceGetAttribute(&cus, hipDeviceAttributeMultiprocessorCount, dev) != hipSuccess) { grid = -1; return; }
        if (hipFuncSetAttribute((const void*)mk_fwd, hipFuncAttributeMaxDynamicSharedMemorySize, LDS_BYTES) != hipSuccess) { fprintf(stderr, "kernel_launch: hipFuncSetAttribute failed\n"); grid = -1; return; }
        if (hipOccupancyMaxActiveBlocksPerMultiprocessor(&per_cu, (const void*)mk_fwd, NWAVES * 64, LDS_BYTES) != hipSuccess || per_cu < 1) { fprintf(stderr, "kernel_launch: occupancy query says %d\n", per_cu); }
        (void)hipGetLastError();
        grid = cus;
    }
    if (grid < 0) return;
    if (hipMemsetAsync((char*)d_ws + WS_CTL, 0, CTL_ZERO_BYTES, stream) != hipSuccess) return;
    Args a{};
    for (int i = 0; i < 23; ++i) a.in[i] = (const float*)d_in[i];
    a.out = (float*)d_out; a.ws = (unsigned char*)d_ws;
#if MK_ONE_LAUNCH
    a.ph_lo = 0; a.ph_hi = N_PHASES;
    hipLaunchKernelGGL(mk_fwd, dim3(grid), dim3(NWAVES * 64), LDS_BYTES, stream, a);
#endif
}
```
